# Optimizing an MI355X kernel written in HIP

```python
import jax, jax.numpy as jnp
from jax import lax
import numpy as np

D_MODEL = 1024
BATCH = 8
SEQ = 2048
DEPTH = 4

CTX_LEN = 256
GRID_W = 64

N_MIXERS = 3
N_RG_LAYERS = (DEPTH + 2) // 3
N_MLA_LAYERS = (DEPTH + 1) // 3
N_MLSTM_LAYERS = DEPTH // 3

RG_WIDTH = D_MODEL
RG_BLOCKS = 16
RG_BLOCK_W = RG_WIDTH // RG_BLOCKS
RG_CONV_W = 4
RG_C = 8.0

MLA_HEADS = 16
MLA_Q_RANK = D_MODEL // 4
MLA_KV_RANK = D_MODEL // 8
MLA_NOPE = 64
MLA_ROPE = 32
MLA_V = 64
MLA_QK = MLA_NOPE + MLA_ROPE
ATTN_SCALE = MLA_QK ** -0.5
ROPE_AXIS_DIM = MLA_ROPE // 2
ROPE_BASE = 10000.0
Q_BLOCK = 128

ML_HEADS = 4
ML_DV = D_MODEL // ML_HEADS
ML_DQK = ML_DV // 2
ML_IN = 2 * ML_HEADS * ML_DQK + 2 * ML_HEADS * ML_DV + 4 * ML_HEADS
ML_CHUNK = 64
ML_M_INIT = -1e30

MOE_GROUPS = 8
MOE_PER_GROUP = 8
MOE_EXPERTS = MOE_GROUPS * MOE_PER_GROUP
MOE_TOPK = 2
MOE_FF = D_MODEL // 4
MOE_BLOCK = 128

RMS_EPS = 1e-6

kernel_name = "hybrid_flow_backbone_rglru_mla_mlstm_hmoe"


def rms_norm(x, g):
    xf = x.astype(jnp.float32)
    y = xf * lax.rsqrt(jnp.mean(xf * xf, axis=-1, keepdims=True) + RMS_EPS)
    return (y * g.astype(jnp.float32)).astype(x.dtype)


def depthwise_conv(u, w, b):
    left = RG_CONV_W // 2
    y = lax.conv_general_dilated(u, w[:, None, :].astype(u.dtype), window_strides=(1,),
                                 padding=[(left, RG_CONV_W - 1 - left)],
                                 dimension_numbers=('NWC', 'WIO', 'NWC'),
                                 feature_group_count=u.shape[-1])
    return y + b


def _lin_combine(left, right):
    a1, b1 = left
    a2, b2 = right
    return a1 * a2, a2 * b1 + b2


def rglru_scan(u, w_gate, b_gate, lam, h0):
    B, L, _ = u.shape
    ub = u.reshape(B, L, RG_BLOCKS, RG_BLOCK_W)
    g = jnp.einsum('blni,gnij->gblnj', ub, w_gate.astype(jnp.float32)).reshape(2, B, L, RG_WIDTH)
    g = g + b_gate.astype(jnp.float32)[:, None, None, :]
    r = jax.nn.sigmoid(g[0])
    i_g = jax.nn.sigmoid(g[1])
    log_a = -RG_C * r * jax.nn.softplus(-lam.astype(jnp.float32))
    a = jnp.exp(log_a)
    b = jnp.sqrt(-jnp.expm1(2.0 * log_a)) * (i_g * u)
    a_cum, b_cum = lax.associative_scan(_lin_combine, (a, b), axis=1)
    return a_cum * h0[:, None, :] + b_cum


def rglru_mixer(h_ctx, h_lat, w_in, conv_w, conv_b, gate_w, gate_b, lam, w_out):
    def branches(h):
        gate, u = jnp.split(h @ w_in, 2, axis=-1)
        return jax.nn.gelu(gate), depthwise_conv(u, conv_w, conv_b).astype(jnp.float32)

    g_ctx, u_ctx = branches(h_ctx)
    g_lat, u_lat = branches(h_lat)
    zero = jnp.zeros((h_lat.shape[0], RG_WIDTH), jnp.float32)
    hc_f = rglru_scan(u_ctx, gate_w[0], gate_b[0], lam[0], zero)
    hl_f = rglru_scan(u_lat, gate_w[0], gate_b[0], lam[0], hc_f[:, -1])
    hc_b = rglru_scan(jnp.flip(u_ctx, 1), gate_w[1], gate_b[1], lam[1], zero)
    hl_b = rglru_scan(jnp.flip(u_lat, 1), gate_w[1], gate_b[1], lam[1], hc_b[:, -1])
    y_ctx = (g_ctx * (hc_f + jnp.flip(hc_b, 1)).astype(g_ctx.dtype)) @ w_out
    y_lat = (g_lat * (hl_f + jnp.flip(hl_b, 1)).astype(g_lat.dtype)) @ w_out
    return y_ctx, y_lat


def rope_2d(t, ang_row, ang_col):
    def rot(z, ang):
        z1, z2 = jnp.split(z, 2, axis=-1)
        cs = jnp.cos(ang)[None, :, None, :].astype(z.dtype)
        sn = jnp.sin(ang)[None, :, None, :].astype(z.dtype)
        return jnp.concatenate([z1 * cs - z2 * sn, z2 * cs + z1 * sn], axis=-1)
    t_row, t_col = jnp.split(t, 2, axis=-1)
    return jnp.concatenate([rot(t_row, ang_row), rot(t_col, ang_col)], axis=-1)


def mla_project(h, w_down, q_norm, kv_norm, w_uq, w_ukv, qk_norm, angles):
    B, L, _ = h.shape
    cq, ckv, k_rope = jnp.split(h @ w_down, [MLA_Q_RANK, MLA_Q_RANK + MLA_KV_RANK], axis=-1)
    q = (rms_norm(cq, q_norm) @ w_uq).reshape(B, L, MLA_HEADS, MLA_QK)
    kv = (rms_norm(ckv, kv_norm) @ w_ukv).reshape(B, L, MLA_HEADS, MLA_NOPE + MLA_V)
    k_nope, v = jnp.split(kv, [MLA_NOPE], axis=-1)
    k = jnp.concatenate([k_nope, jnp.broadcast_to(k_rope[:, :, None, :], (B, L, MLA_HEADS, MLA_ROPE))], axis=-1)
    q = rms_norm(q, qk_norm[0])
    k = rms_norm(k, qk_norm[1])
    if angles is not None:
        ang_row, ang_col = angles
        q = jnp.concatenate([q[..., :MLA_NOPE], rope_2d(q[..., MLA_NOPE:], ang_row, ang_col)], axis=-1)
        k = jnp.concatenate([k[..., :MLA_NOPE], rope_2d(k[..., MLA_NOPE:], ang_row, ang_col)], axis=-1)
    return q, k, v


def block_attention(q, k, v):
    B, Lq, H, dq = q.shape
    qb = jnp.moveaxis(q.reshape(B, Lq // Q_BLOCK, Q_BLOCK, H, dq), 1, 0)

    def one_block(qi):
        s = jnp.einsum('bqhd,bkhd->bhqk', qi, k).astype(jnp.float32) * ATTN_SCALE
        p = jax.nn.softmax(s, axis=-1).astype(v.dtype)
        return jnp.einsum('bhqk,bkhd->bqhd', p, v)

    o = lax.map(one_block, qb)
    return jnp.moveaxis(o, 0, 1).reshape(B, Lq, H * v.shape[-1])


def mla_mixer(h_ctx, h_lat, w_down, q_norm, kv_norm, w_uq, w_ukv, qk_norm, w_o, angles):
    qc, kc, vc = mla_project(h_ctx, w_down, q_norm, kv_norm, w_uq, w_ukv, qk_norm, None)
    ql, kl, vl = mla_project(h_lat, w_down, q_norm, kv_norm, w_uq, w_ukv, qk_norm, angles)
    o_ctx = block_attention(qc, kc, vc)
    o_lat = block_attention(ql, jnp.concatenate([kc, kl], axis=1), jnp.concatenate([vc, vl], axis=1))
    return o_ctx @ w_o, o_lat @ w_o


def mlstm_chunked(q, k, v, ig, lf, state):
    B, H, L, _ = q.shape
    n_chunks = L // ML_CHUNK

    def to_chunks(t):
        return jnp.moveaxis(t.reshape(B, H, n_chunks, ML_CHUNK, *t.shape[3:]), 2, 0)

    causal = jnp.tril(jnp.ones((ML_CHUNK, ML_CHUNK), dtype=bool))

    def step(carry, inp):
        C, n, m = carry
        qc, kc, vc, igc, lfc = inp
        b = jnp.cumsum(lfc, axis=-1)
        d_log = jnp.where(causal, b[..., :, None] - b[..., None, :] + igc[..., None, :], -jnp.inf)
        inter_log = b + m[..., None]
        m_t = jnp.maximum(inter_log, jnp.max(d_log, axis=-1))
        s = jnp.einsum('bhtd,bhsd->bhts', qc, kc) * jnp.exp(d_log - m_t[..., None])
        inter = jnp.exp(inter_log - m_t)
        num = jnp.einsum('bhts,bhse->bhte', s, vc) + inter[..., None] * jnp.einsum('bhtd,bhde->bhte', qc, C)
        den = jnp.sum(s, axis=-1) + inter * jnp.einsum('bhtd,bhd->bht', qc, n)
        h = num / jnp.maximum(jnp.abs(den), jnp.exp(-m_t))[..., None]
        b_last = b[..., -1]
        w_log = b_last[..., None] - b + igc
        m_new = jnp.maximum(b_last + m, jnp.max(w_log, axis=-1))
        w = jnp.exp(w_log - m_new[..., None])
        decay = jnp.exp(b_last + m - m_new)
        C_new = decay[..., None, None] * C + jnp.einsum('bhs,bhsd,bhse->bhde', w, kc, vc)
        n_new = decay[..., None] * n + jnp.einsum('bhs,bhsd->bhd', w, kc)
        return (C_new, n_new, m_new), h

    state, h = lax.scan(step, state, tuple(to_chunks(t) for t in (q, k, v, ig, lf)))
    return jnp.moveaxis(h, 0, 2).reshape(B, H, L, v.shape[-1]), state


def mlstm_mixer(h_ctx, h_lat, w_in, gate_b, out_norm, w_out):
    def project(h):
        B, L, _ = h.shape
        q, k, v, og, gates = jnp.split(h @ w_in, [ML_HEADS * ML_DQK, 2 * ML_HEADS * ML_DQK,
                                                  2 * ML_HEADS * ML_DQK + ML_HEADS * ML_DV,
                                                  2 * ML_HEADS * ML_DQK + 2 * ML_HEADS * ML_DV], axis=-1)
        heads = lambda t: jnp.moveaxis(t.reshape(B, L, ML_HEADS, -1), 1, 2).astype(jnp.float32)
        gates = jnp.moveaxis((gates.reshape(B, L, 4, ML_HEADS) + gate_b).astype(jnp.float32), 1, 3)
        return heads(q) * ML_DQK ** -0.5, heads(k), heads(v), og, gates

    qc, kc, vc, ogc, gc = project(h_ctx)
    ql, kl, vl, ogl, gl = project(h_lat)
    B = h_lat.shape[0]
    init = (jnp.zeros((B, ML_HEADS, ML_DQK, ML_DV), jnp.float32),
            jnp.zeros((B, ML_HEADS, ML_DQK), jnp.float32),
            jnp.full((B, ML_HEADS), ML_M_INIT, jnp.float32))
    flip = lambda t: jnp.flip(t, axis=2)
    lsig = jax.nn.log_sigmoid
    hc_f, st_f = mlstm_chunked(qc, kc, vc, gc[:, 0], lsig(gc[:, 1]), init)
    hl_f, _ = mlstm_chunked(ql, kl, vl, gl[:, 0], lsig(gl[:, 1]), st_f)
    hc_b, st_b = mlstm_chunked(flip(qc), flip(kc), flip(vc), flip(gc[:, 2]), flip(lsig(gc[:, 3])), init)
    hl_b, _ = mlstm_chunked(flip(ql), flip(kl), flip(vl), flip(gl[:, 2]), flip(lsig(gl[:, 3])), st_b)

    def readout(h_sum, og):
        B_, H, L, _ = h_sum.shape
        hn = rms_norm(jnp.moveaxis(h_sum, 1, 2), out_norm.reshape(ML_HEADS, ML_DV)).reshape(B_, L, H * ML_DV)
        return (hn.astype(og.dtype) * jax.nn.sigmoid(og)) @ w_out

    return readout(hc_f + flip(hc_b), ogc), readout(hl_f + flip(hl_b), ogl)


def grouped_expert_ffn(h, expert_id, weights, w_gate_up, w_down):
    N, D = h.shape
    NK = N * MOE_TOPK
    n_blocks = -(-NK // MOE_BLOCK) + MOE_EXPERTS
    e_flat = expert_id.reshape(NK)
    order = jnp.argsort(e_flat)
    e_sorted = e_flat[order]
    tok_sorted = (order // MOE_TOPK).astype(jnp.int32)
    w_sorted = weights.reshape(NK)[order]
    counts = jnp.bincount(e_flat, length=MOE_EXPERTS)
    starts = jnp.cumsum(counts) - counts
    padded = (counts + MOE_BLOCK - 1) // MOE_BLOCK * MOE_BLOCK
    pad_end = jnp.cumsum(padded)
    pad_start = pad_end - padded
    dest = pad_start[e_sorted] + jnp.arange(NK, dtype=jnp.int32) - starts[e_sorted]
    slot_token = jnp.full((n_blocks * MOE_BLOCK,), N, jnp.int32).at[dest].set(tok_sorted)
    block_expert = jnp.minimum(jnp.searchsorted(pad_end, jnp.arange(n_blocks, dtype=jnp.int32) * MOE_BLOCK,
                                                side='right'), MOE_EXPERTS - 1)
    h_pad = jnp.concatenate([h, jnp.zeros((1, D), h.dtype)], axis=0)

    def run_block(args):
        idx, e = args
        gate, up = jnp.split(h_pad[idx] @ w_gate_up[e], 2, axis=-1)
        return (jax.nn.silu(gate) * up) @ w_down[e]

    y_slots = lax.map(run_block, (slot_token.reshape(n_blocks, MOE_BLOCK), block_expert)).reshape(-1, D)
    contrib = y_slots[dest] * w_sorted[:, None].astype(y_slots.dtype)
    return jax.ops.segment_sum(contrib, tok_sorted, num_segments=N)


def hier_moe(h, w_group, b_group, w_expert, b_expert, w_gate_up, w_down):
    N = h.shape[0]
    g_prob = jax.nn.softmax((h @ w_group + b_group).astype(jnp.float32), axis=-1)
    p_top, g_sel = lax.top_k(g_prob, 1)
    e_logits = (h @ w_expert + b_expert).astype(jnp.float32).reshape(N, MOE_GROUPS, MOE_PER_GROUP)
    e_in_group = jnp.take_along_axis(e_logits, g_sel[:, :, None], axis=1)[:, 0]
    e_top, e_sel = lax.top_k(e_in_group, MOE_TOPK)
    weights = jax.nn.softmax(e_top, axis=-1) * p_top
    expert_id = g_sel * MOE_PER_GROUP + e_sel
    return grouped_expert_ffn(h, expert_id, weights, w_gate_up, w_down)


def setup_inputs(seed: int = 0) -> dict:
    key = jax.random.key(seed)
    keys = iter(list(jax.random.split(key, 40)))
    f32 = jnp.float32
    nrm = lambda shape, scale: jax.random.normal(next(keys), shape, f32) * scale
    gain = lambda shape: 1.0 + nrm(shape, 0.02)
    D = D_MODEL
    x = nrm((BATCH, SEQ, D), 1.0)
    c = nrm((BATCH, D), 1.0)
    ctx = nrm((BATCH, CTX_LEN, D), 1.0)
    c_ctx = nrm((D,), 1.0)
    ada_w = nrm((DEPTH, D, 6 * D), 0.5 * D ** -0.5)
    ada_b = nrm((DEPTH, 6 * D), 0.02)
    norm_mix = gain((DEPTH, D))
    norm_ffn = gain((DEPTH, D))
    rg_w_in = nrm((N_RG_LAYERS, D, 2 * RG_WIDTH), D ** -0.5)
    rg_conv_w = nrm((N_RG_LAYERS, RG_CONV_W, RG_WIDTH), RG_CONV_W ** -0.5)
    rg_conv_b = nrm((N_RG_LAYERS, RG_WIDTH), 0.02)
    rg_gate_w = nrm((N_RG_LAYERS, 2, 2, RG_BLOCKS, RG_BLOCK_W, RG_BLOCK_W), RG_BLOCK_W ** -0.5)
    rg_gate_b = nrm((N_RG_LAYERS, 2, 2, RG_WIDTH), 0.02)
    a0 = jax.random.uniform(next(keys), (N_RG_LAYERS, 2, RG_WIDTH), f32, 0.9, 0.999)
    rg_lambda = jnp.log(a0) - jnp.log1p(-a0)
    rg_w_out = nrm((N_RG_LAYERS, RG_WIDTH, D), RG_WIDTH ** -0.5)
    mla_w_down = nrm((N_MLA_LAYERS, D, MLA_Q_RANK + MLA_KV_RANK + MLA_ROPE), D ** -0.5)
    mla_q_norm = gain((N_MLA_LAYERS, MLA_Q_RANK))
    mla_kv_norm = gain((N_MLA_LAYERS, MLA_KV_RANK))
    mla_w_uq = nrm((N_MLA_LAYERS, MLA_Q_RANK, MLA_HEADS * MLA_QK), MLA_Q_RANK ** -0.5)
    mla_w_ukv = nrm((N_MLA_LAYERS, MLA_KV_RANK, MLA_HEADS * (MLA_NOPE + MLA_V)), MLA_KV_RANK ** -0.5)
    mla_qk_norm = gain((N_MLA_LAYERS, 2, MLA_QK))
    mla_w_o = nrm((N_MLA_LAYERS, MLA_HEADS * MLA_V, D), (MLA_HEADS * MLA_V) ** -0.5)
    ml_w_in = nrm((N_MLSTM_LAYERS, D, ML_IN), D ** -0.5)
    ml_gate_b = nrm((N_MLSTM_LAYERS, 4, ML_HEADS), 0.1) + jnp.array([0.0, 3.0, 0.0, 3.0], f32)[None, :, None]
    ml_out_norm = gain((N_MLSTM_LAYERS, ML_HEADS * ML_DV))
    ml_w_out = nrm((N_MLSTM_LAYERS, ML_HEADS * ML_DV, D), (ML_HEADS * ML_DV) ** -0.5)
    moe_w_group = nrm((DEPTH, D, MOE_GROUPS), D ** -0.5)
    moe_b_group = nrm((DEPTH, MOE_GROUPS), 0.01)
    moe_w_expert = nrm((DEPTH, D, MOE_EXPERTS), D ** -0.5)
    moe_b_expert = nrm((DEPTH, MOE_EXPERTS), 0.01)
    moe_w_gate_up = nrm((DEPTH, MOE_EXPERTS, D, 2 * MOE_FF), D ** -0.5)
    moe_w_down = nrm((DEPTH, MOE_EXPERTS, MOE_FF, D), MOE_FF ** -0.5)
    return {"x": x, "c": c, "ctx": ctx, "c_ctx": c_ctx,
            "ada_w": ada_w, "ada_b": ada_b, "norm_mix": norm_mix, "norm_ffn": norm_ffn,
            "rg_w_in": rg_w_in, "rg_conv_w": rg_conv_w, "rg_conv_b": rg_conv_b, "rg_gate_w": rg_gate_w,
            "rg_gate_b": rg_gate_b, "rg_lambda": rg_lambda, "rg_w_out": rg_w_out,
            "mla_w_down": mla_w_down, "mla_q_norm": mla_q_norm, "mla_kv_norm": mla_kv_norm,
            "mla_w_uq": mla_w_uq, "mla_w_ukv": mla_w_ukv, "mla_qk_norm": mla_qk_norm, "mla_w_o": mla_w_o,
            "ml_w_in": ml_w_in, "ml_gate_b": ml_gate_b, "ml_out_norm": ml_out_norm, "ml_w_out": ml_w_out,
            "moe_w_group": moe_w_group, "moe_b_group": moe_b_group, "moe_w_expert": moe_w_expert,
            "moe_b_expert": moe_b_expert, "moe_w_gate_up": moe_w_gate_up, "moe_w_down": moe_w_down}


def reference(x, c, ctx, c_ctx, ada_w, ada_b, norm_mix, norm_ffn,
              rg_w_in, rg_conv_w, rg_conv_b, rg_gate_w, rg_gate_b, rg_lambda, rg_w_out,
              mla_w_down, mla_q_norm, mla_kv_norm, mla_w_uq, mla_w_ukv, mla_qk_norm, mla_w_o,
              ml_w_in, ml_gate_b, ml_out_norm, ml_w_out,
              moe_w_group, moe_b_group, moe_w_expert, moe_b_expert, moe_w_gate_up, moe_w_down):
    B, L, D = x.shape
    ROWS = L // GRID_W
    row = jnp.broadcast_to(jnp.arange(ROWS, dtype=jnp.float32)[:, None], (ROWS, GRID_W)).reshape(L)
    col = jnp.broadcast_to(jnp.arange(GRID_W, dtype=jnp.float32)[None, :], (ROWS, GRID_W)).reshape(L)
    inv_freq = ROPE_BASE ** (-jnp.arange(0, ROPE_AXIS_DIM, 2, dtype=jnp.float32) / ROPE_AXIS_DIM)
    angles = (row[:, None] * inv_freq, col[:, None] * inv_freq)

    for i in range(DEPTH):
        last = i == DEPTH - 1
        mod_lat = (jax.nn.silu(c) @ ada_w[i] + ada_b[i]).reshape(B, 6, 1, D)
        mod_ctx = (jax.nn.silu(c_ctx) @ ada_w[i] + ada_b[i]).reshape(6, D)
        h_lat = rms_norm(x, norm_mix[i]) * (1 + mod_lat[:, 1]) + mod_lat[:, 0]
        h_ctx = rms_norm(ctx, norm_mix[i]) * (1 + mod_ctx[1]) + mod_ctx[0]
        kind, j = i % N_MIXERS, i // N_MIXERS
        if kind == 0:
            y_ctx, y_lat = rglru_mixer(h_ctx, h_lat, rg_w_in[j], rg_conv_w[j], rg_conv_b[j], rg_gate_w[j],
                                       rg_gate_b[j], rg_lambda[j], rg_w_out[j])
        elif kind == 1:
            y_ctx, y_lat = mla_mixer(h_ctx, h_lat, mla_w_down[j], mla_q_norm[j], mla_kv_norm[j], mla_w_uq[j],
                                     mla_w_ukv[j], mla_qk_norm[j], mla_w_o[j], angles)
        else:
            y_ctx, y_lat = mlstm_mixer(h_ctx, h_lat, ml_w_in[j], ml_gate_b[j], ml_out_norm[j], ml_w_out[j])
        x = x + mod_lat[:, 2] * y_lat
        f_lat = rms_norm(x, norm_ffn[i]) * (1 + mod_lat[:, 4]) + mod_lat[:, 3]
        moe_params = (moe_w_group[i], moe_b_group[i], moe_w_expert[i], moe_b_expert[i],
                      moe_w_gate_up[i], moe_w_down[i])
        if last:
            x = x + mod_lat[:, 5] * hier_moe(f_lat.reshape(B * L, D), *moe_params).reshape(B, L, D)
        else:
            ctx = ctx + mod_ctx[2] * y_ctx
            f_ctx = rms_norm(ctx, norm_ffn[i]) * (1 + mod_ctx[4]) + mod_ctx[3]
            y = hier_moe(jnp.concatenate([f_lat.reshape(B * L, D), f_ctx.reshape(-1, D)], axis=0), *moe_params)
            x = x + mod_lat[:, 5] * y[:B * L].reshape(B, L, D)
            ctx = ctx + mod_ctx[5] * y[B * L:].reshape(B, -1, D)
    return x
```

```cpp
#include <hip/hip_runtime.h>
#include <stdint.h>
#include <string.h>
#include <stdio.h>

#ifndef MK_ONE_LAUNCH
#define MK_ONE_LAUNCH 1
#endif

#define DI __device__ __forceinline__
typedef unsigned short bf16_t;
typedef __attribute__((ext_vector_type(8))) short bf16x8;
typedef __attribute__((ext_vector_type(4))) float f32x4;
typedef __attribute__((ext_vector_type(16))) float f32x16;
typedef __attribute__((ext_vector_type(2))) float f32x2;
typedef __attribute__((ext_vector_type(2))) __bf16 bfx2;
typedef __attribute__((ext_vector_type(4))) unsigned u32x4;
typedef __attribute__((ext_vector_type(2))) unsigned u32x2;

constexpr int D = 1024, NB = 8, SEQ = 2048, CTXL = 256;
constexpr int NLAT = NB * SEQ, NCTX = NB * CTXL, NTOK = NLAT + NCTX;
constexpr int NKEY = CTXL + SEQ;
constexpr int NTHR = 256;
constexpr int LDS_BYTES = 73728;
constexpr int LDS_AUX = 65536;
constexpr int LDS_BARW = LDS_BYTES - 16;
constexpr float EPS = 1e-6f;

constexpr size_t al256(size_t x) { return (x + 255) & ~(size_t)255; }
constexpr size_t WS_CTL = 0;
constexpr size_t CTL_BYTES = 65536;
constexpr size_t CTL_CNT = 16384;
constexpr size_t WS_MOD = WS_CTL + CTL_BYTES;
constexpr size_t WS_X = al256(WS_MOD + 4 * 9 * 6144 * 4);
constexpr size_t WS_H = al256(WS_X + (size_t)NTOK * D * 4);
constexpr size_t WS_SCR = al256(WS_H + (size_t)NTOK * D * 2);
constexpr size_t SCR_BYTES = (size_t)256 << 20;
constexpr size_t TOKD2 = (size_t)NTOK * D * 2;
constexpr size_t RG_G = WS_SCR, RG_U = RG_G + TOKD2, RG_HS = RG_U + TOKD2, RG_A2 = RG_HS + 2 * TOKD2;
constexpr size_t MLA_CQ = WS_SCR;
constexpr size_t MLA_CKV = MLA_CQ + (size_t)NTOK * 256 * 2;
constexpr size_t MLA_KR = MLA_CKV + (size_t)NTOK * 128 * 2;
constexpr size_t MLA_Q = MLA_KR + (size_t)NTOK * 32 * 4;
constexpr size_t MLA_K = MLA_Q + (size_t)NTOK * 1536 * 2;
constexpr size_t MLA_VT = MLA_K + (size_t)NB * 16 * NKEY * 96 * 2;
constexpr size_t MLA_O = MLA_VT + (size_t)NB * 16 * 64 * NKEY * 2;
constexpr size_t MLA_END = MLA_O + TOKD2;
constexpr size_t ML_Q = WS_SCR;
constexpr size_t ML_K = ML_Q + (size_t)NTOK * 512 * 2;
constexpr size_t ML_KT = ML_K + (size_t)NTOK * 512 * 2;
constexpr size_t ML_VT = ML_KT + (size_t)NTOK * 512 * 2;
constexpr size_t ML_OG = ML_VT + TOKD2;
constexpr size_t ML_GT = ML_OG + TOKD2;
constexpr size_t ML_HS = ML_GT + (size_t)NTOK * 16 * 4;
constexpr size_t ML_A2 = ML_HS + 2 * TOKD2;
constexpr size_t ML_END = ML_A2 + TOKD2;
static_assert(RG_A2 + TOKD2 <= WS_SCR + SCR_BYTES && MLA_END <= WS_SCR + SCR_BYTES && ML_END <= WS_SCR + SCR_BYTES, "scratch");
constexpr size_t WS_LIST = WS_SCR + SCR_BYTES;
constexpr size_t WS_WSLOT = al256(WS_LIST + (size_t)64 * NTOK * 4);
constexpr size_t WS_HMID = al256(WS_WSLOT + (size_t)2 * NTOK * 4);
constexpr size_t WS_Y = al256(WS_HMID + (size_t)2 * NTOK * 256 * 2);
constexpr size_t WS_W = al256(WS_Y + (size_t)2 * NTOK * D * 2);
constexpr size_t W_RGIN = WS_W;
constexpr size_t W_RGOUT = W_RGIN + (size_t)2 * 2048 * 1024 * 2;
constexpr size_t W_RGG = W_RGOUT + (size_t)2 * 1024 * 1024 * 2;
constexpr size_t W_MDOWN = W_RGG + (size_t)2 * 2 * 16 * 128 * 64 * 2;
constexpr size_t W_MUQ = W_MDOWN + (size_t)512 * 1024 * 2;
constexpr size_t W_MUKV = W_MUQ + (size_t)1536 * 256 * 2;
constexpr size_t W_MO = W_MUKV + (size_t)2048 * 128 * 2;
constexpr size_t W_MLIN = W_MO + (size_t)1024 * 1024 * 2;
constexpr size_t W_MLOUT = W_MLIN + (size_t)3200 * 1024 * 2;
constexpr size_t W_RT = W_MLOUT + (size_t)1024 * 1024 * 2;
constexpr size_t W_GU = al256(W_RT + (size_t)4 * 2 * 80 * 1024 * 2);
constexpr size_t W_DN = W_GU + (size_t)256 * 512 * 1024 * 2;
constexpr size_t WS_END = W_DN + (size_t)256 * 1024 * 256 * 2;

struct TDesc {
    const float* src; bf16_t* dst; const float* rscale;
    long sb, db;
    int K, N, Npad, batch;
    int perm, tiles_k, tiles_n, tile0;
};
constexpr int NTD = 18;
struct Args {
    const float* in[32];
    float* out;
    unsigned char* ws;
    TDesc td[NTD];
    int ntiles_total, ph_lo, ph_hi, pad0;
};

DI float bf2f(bf16_t v) { return __uint_as_float((unsigned)v << 16); }
DI unsigned pk2(float a, float b) { f32x2 v = {a, b}; bfx2 r = __builtin_convertvector(v, bfx2); return __builtin_bit_cast(unsigned, r); }
DI bf16_t f2bf(float a) { return (bf16_t)(pk2(a, 0.f) & 0xffffu); }
DI float lof(unsigned u) { return __uint_as_float(u << 16); }
DI float hif(unsigned u) { return __uint_as_float(u & 0xffff0000u); }
DI float sigmoidf_(float x) { return 1.f / (1.f + __expf(-x)); }
DI float gelu_tanh(float x) { float u = 0.7978845608028654f * (x + 0.044715f * x * x * x); float e = __expf(2.f * u); return 0.5f * x * (2.f - 2.f / (e + 1.f)); }
DI int tok_modrow(int t) { return t < NLAT ? (t >> 11) : 8; }
DI void dma16(const void* g, char* l) { __builtin_amdgcn_global_load_lds((const unsigned*)g, (unsigned*)l, 16, 0, 0); }
DI void wait_vm0() { asm volatile("s_waitcnt vmcnt(0)" ::: "memory"); }
DI int swz128(int row, int chunk) { return row * 128 + ((chunk ^ (row & 7)) << 4); }
DI int swz256(int row, int chunk) { return row * 256 + ((chunk ^ (row & 15)) << 4); }
DI f32x4 mfma16(bf16x8 a, bf16x8 b, f32x4 c) { return __builtin_amdgcn_mfma_f32_16x16x32_bf16(a, b, c, 0, 0, 0); }
DI f32x16 mfma32(bf16x8 a, bf16x8 b, f32x16 c) { return __builtin_amdgcn_mfma_f32_32x32x16_bf16(a, b, c, 0, 0, 0); }
DI bf16x8 ldsv8(const char* p) { return *(const bf16x8*)p; }

__shared__ __attribute__((aligned(16))) char lds[LDS_BYTES];

#define XB_TMO      128
#define XB_XCNT(j)  (256  + 64 * (j))
#define XB_XSUB(j)  (1280 + 64 * (j))
#define XB_XGEN(j)  (2304 + 64 * (j))
#define XB_TOP      3328
#define XB_TOPGEN   3392
#define XCD_BAR_WORDS 3456
#define XB_SPIN_CAP (1u << 22)
#define LAS __attribute__((address_space(3)))
DI unsigned xb_ld(unsigned* p)              { return __hip_atomic_load(p, __ATOMIC_RELAXED, __HIP_MEMORY_SCOPE_AGENT); }
DI unsigned xb_add(unsigned* p, unsigned v) { return __hip_atomic_fetch_add(p, v, __ATOMIC_RELAXED, __HIP_MEMORY_SCOPE_AGENT); }
DI unsigned xb_xcc_id() { return (unsigned)__builtin_amdgcn_s_getreg((3 << 11) | 20) & 0xFu; }
#define XB_SPIN(cond, bar) do { unsigned _sp = 0; while (cond) { __builtin_amdgcn_s_sleep(1); \
    if ((++_sp & 255u) == 0u) { if (xb_ld(&(bar)[XB_TMO])) break; if (_sp > XB_SPIN_CAP) { atomicAdd(&(bar)[XB_TMO], 1u); break; } } } } while (0)
struct XcdBarrier { unsigned* bar; unsigned x; volatile LAS unsigned* st; };
DI XcdBarrier xcd_barrier_post(unsigned* bar, volatile LAS unsigned* st) {
    XcdBarrier b; b.bar = bar; b.x = xb_xcc_id(); b.st = st;
    if (threadIdx.x == 0) (void)xb_add(&bar[XB_XCNT(b.x)], 1u);
    return b;
}
DI void xcd_barrier_complete(unsigned* bar, unsigned x, unsigned& nloc, unsigned& nx) {
    const unsigned G = gridDim.x * gridDim.y * gridDim.z;
    unsigned sum, cnt, mine, sp = 0u;
    for (;;) {
        sum = 0u; cnt = 0u; mine = 0u;
#pragma unroll
        for (unsigned j = 0; j < 16; ++j) { const unsigned c = xb_ld(&bar[XB_XCNT(j)]); sum += c; cnt += (c > 0u) ? 1u : 0u; mine = (j == x) ? c : mine; }
        if (sum == G) break;
        __builtin_amdgcn_s_sleep(1);
        if ((++sp & 255u) == 0u) { if (xb_ld(&bar[XB_TMO])) break; if (sp > XB_SPIN_CAP) { atomicAdd(&bar[XB_TMO], 1u); break; } }
    }
    nloc = mine > 0u ? mine : 1u; nx = cnt > 0u ? cnt : 1u;
}
DI void xcd_barrier(const XcdBarrier& b) {
    asm volatile("s_waitcnt vmcnt(0)" ::: "memory");
    __syncthreads();
    if (threadIdx.x == 0) {
        unsigned* bar = b.bar;
        __builtin_amdgcn_s_waitcnt(0);
        unsigned nloc = b.st[0], nx = b.st[1];
        if (nloc == 0u) { xcd_barrier_complete(bar, b.x, nloc, nx); b.st[0] = nloc; b.st[1] = nx; }
        const unsigned old = xb_add(&bar[XB_XSUB(b.x)], 1u);
        const unsigned gen = old / nloc;
        if (old + 1u == (gen + 1u) * nloc) {
            __builtin_amdgcn_fence(__ATOMIC_RELEASE, "agent");
            asm volatile("s_waitcnt vmcnt(0)" ::: "memory");
            const unsigned og = xb_add(&bar[XB_TOP], 1u);
            const unsigned tg = og / nx;
            if (og + 1u == (tg + 1u) * nx) xb_add(&bar[XB_TOPGEN], 1u);
            else XB_SPIN(xb_ld(&bar[XB_TOPGEN]) == tg, bar);
            __builtin_amdgcn_fence(__ATOMIC_ACQUIRE, "agent");
            xb_add(&bar[XB_XGEN(b.x)], 1u);
            asm volatile("s_waitcnt vmcnt(0)" ::: "memory");
        } else {
            XB_SPIN(xb_ld(&bar[XB_XGEN(b.x)]) == gen, bar);
            __builtin_amdgcn_fence(__ATOMIC_ACQUIRE, "agent");
            asm volatile("s_waitcnt vmcnt(0)" ::: "memory");
        }
    }
    __syncthreads();
}

DI void phase_prologue(const Args& a) {
    const int tid = threadIdx.x;
    const int n_ada = 96, n_rt = 4;
    const int total = n_ada + n_rt + a.ntiles_total;
    float* sc = (float*)lds;
    for (int u = blockIdx.x; u < total; u += gridDim.x) {
        __syncthreads();
        if (u < n_ada) {
            const float* c = a.in[1]; const float* cc = a.in[3];
            for (int i = tid; i < 9 * 1024; i += NTHR) {
                float v = i < 8192 ? c[i] : cc[i - 8192];
                sc[i] = v / (1.f + __expf(-v));
            }
            __syncthreads();
            const int n = u * 256 + tid, li = n / 6144, nn = n - li * 6144;
            const float* w = a.in[4] + (size_t)li * 1024 * 6144 + nn;
            float acc[9];
#pragma unroll
            for (int r = 0; r < 9; ++r) acc[r] = 0.f;
#pragma unroll 8
            for (int k = 0; k < 1024; ++k) {
                const float wv = w[(size_t)k * 6144];
#pragma unroll
                for (int r = 0; r < 9; ++r) acc[r] += sc[r * 1024 + k] * wv;
            }
            const float bias = a.in[5][li * 6144 + nn];
            float* mod = (float*)(a.ws + WS_MOD) + (size_t)li * 9 * 6144 + nn;
#pragma unroll
            for (int r = 0; r < 9; ++r) mod[(size_t)r * 6144] = acc[r] + bias;
        } else if (u < n_ada + n_rt) {
            const int li = u - n_ada;
            bf16_t* rt = (bf16_t*)(a.ws + W_RT) + (size_t)li * 2 * 80 * 1024;
            const float* wg = a.in[26] + (size_t)li * 1024 * 8;
            const float* we = a.in[28] + (size_t)li * 1024 * 64;
            for (int i = tid; i < 80 * 1024; i += NTHR) {
                const int n = i >> 10, k = i & 1023;
                float v = n < 8 ? wg[k * 8 + n] : (n < 72 ? we[k * 64 + (n - 8)] : 0.f);
                const bf16_t h = f2bf(v);
                rt[i] = h;
                rt[80 * 1024 + i] = f2bf(v - bf2f(h));
            }
        } else {
            const int tix = u - n_ada - n_rt;
            int di = 0;
#pragma unroll 1
            for (int i = 1; i < NTD; ++i) if (tix >= a.td[i].tile0) di = i;
            const TDesc& td = a.td[di];
            int rem = tix - td.tile0;
            const int per = td.tiles_k * td.tiles_n;
            const int bi = rem / per; rem -= bi * per;
            const int tk = rem % td.tiles_k, tn = rem / td.tiles_k;
            const float* src = td.src + (size_t)bi * td.sb;
            bf16_t* dst = td.dst + (size_t)bi * td.db;
            const int k0 = tk * 64, n0 = tn * 64;
#pragma unroll 4
            for (int i = 0; i < 16; ++i) {
                const int k = i * 4 + (tid >> 6), n = tid & 63;
                float v = 0.f;
                if (n0 + n < td.N) v = src[(size_t)(k0 + k) * td.N + n0 + n];
                if (td.rscale) v *= td.rscale[k0 + k];
                sc[k * 65 + n] = v;
            }
            __syncthreads();
#pragma unroll
            for (int i = 0; i < 2; ++i) {
                const int id = tid + i * 256, n = id >> 3, kc = id & 7;
                u32x4 o;
                o[0] = pk2(sc[(kc * 8 + 0) * 65 + n], sc[(kc * 8 + 1) * 65 + n]);
                o[1] = pk2(sc[(kc * 8 + 2) * 65 + n], sc[(kc * 8 + 3) * 65 + n]);
                o[2] = pk2(sc[(kc * 8 + 4) * 65 + n], sc[(kc * 8 + 5) * 65 + n]);
                o[3] = pk2(sc[(kc * 8 + 6) * 65 + n], sc[(kc * 8 + 7) * 65 + n]);
                int nd = n0 + n;
                if (nd < td.Npad) {
                    if (td.perm) { const int c = nd & 255, up = nd >> 8; nd = ((c >> 4) << 5) + (up << 4) + (c & 15); }
                    *(u32x4*)(dst + (size_t)nd * td.K + k0 + kc * 8) = o;
                }
            }
        }
    }
}

template <int MODE>
DI void phase_token(const Args& a, const int li) {
    const int tid = threadIdx.x, lane = tid & 63, wave = tid >> 6;
    const int r = lane & 15, q = lane >> 4;
    float* X = (float*)(a.ws + WS_X);
    bf16_t* H = (bf16_t*)(a.ws + WS_H);
    const bf16_t* Y = (const bf16_t*)(a.ws + WS_Y);
    const float* MOD = (const float*)(a.ws + WS_MOD);
    const bool combine = (MODE == 0 && li > 0) || MODE == 2;
    const int ngroups = (MODE == 2 || (MODE == 1 && li == 3)) ? NLAT / 16 : NTOK / 16;
    float* lg = (float*)(lds + wave * 16 * 80 * 4);
    for (int g = blockIdx.x * 4 + wave; g < ngroups; g += gridDim.x * 4) {
        const int t = g * 16 + r;
        const int mr = tok_modrow(g * 16);
        const float* xsrc = (MODE == 0 && li == 0) ? (t < NLAT ? a.in[0] + (size_t)t * D : a.in[2] + (size_t)(t - NLAT) * D) : X + (size_t)t * D;
        const bf16_t* y0 = Y + (size_t)(2 * t) * D;
        const bf16_t* y1 = y0 + D;
        const int lprev = MODE == 2 ? 3 : li - 1;
        const float* g5 = MOD + ((size_t)(lprev < 0 ? 0 : lprev) * 9 + mr) * 6144 + 5 * 1024;
        float ss = 0.f;
        if (MODE != 2) {
#pragma unroll 4
            for (int kk = 0; kk < 32; ++kk) {
                const int k = kk * 32 + q * 8;
                f32x4 x0 = *(const f32x4*)(xsrc + k), x1 = *(const f32x4*)(xsrc + k + 4);
                if (combine) {
                    const u32x4 ya = *(const u32x4*)(y0 + k), yb = *(const u32x4*)(y1 + k);
                    const f32x4 ga = *(const f32x4*)(g5 + k), gb = *(const f32x4*)(g5 + k + 4);
                    x0[0] += ga[0] * (lof(ya[0]) + lof(yb[0])); x0[1] += ga[1] * (hif(ya[0]) + hif(yb[0]));
                    x0[2] += ga[2] * (lof(ya[1]) + lof(yb[1])); x0[3] += ga[3] * (hif(ya[1]) + hif(yb[1]));
                    x1[0] += gb[0] * (lof(ya[2]) + lof(yb[2])); x1[1] += gb[1] * (hif(ya[2]) + hif(yb[2]));
                    x1[2] += gb[2] * (lof(ya[3]) + lof(yb[3])); x1[3] += gb[3] * (hif(ya[3]) + hif(yb[3]));
                }
#pragma unroll
                for (int j = 0; j < 4; ++j) ss += x0[j] * x0[j] + x1[j] * x1[j];
            }
            ss += __shfl_xor(ss, 16); ss += __shfl_xor(ss, 32);
        }
        const float rstd = rsqrtf(ss * (1.f / 1024.f) + EPS);
        const float* gn = (MODE == 1 ? a.in[7] : a.in[6]) + (size_t)li * D;
        const float* mscale = MOD + ((size_t)li * 9 + mr) * 6144 + (MODE == 1 ? 4 : 1) * 1024;
        const float* mshift = MOD + ((size_t)li * 9 + mr) * 6144 + (MODE == 1 ? 3 : 0) * 1024;
        const bf16_t* rwh = (const bf16_t*)(a.ws + W_RT) + (size_t)li * 2 * 80 * 1024 + (size_t)r * 1024 + q * 8;
        f32x4 lacc[5];
#pragma unroll
        for (int i = 0; i < 5; ++i) lacc[i] = (f32x4){0.f, 0.f, 0.f, 0.f};
#pragma unroll 2
        for (int kk = 0; kk < 32; ++kk) {
            const int k = kk * 32 + q * 8;
            f32x4 x0 = *(const f32x4*)(xsrc + k), x1 = *(const f32x4*)(xsrc + k + 4);
            if (combine) {
                const u32x4 ya = *(const u32x4*)(y0 + k), yb = *(const u32x4*)(y1 + k);
                const f32x4 ga = *(const f32x4*)(g5 + k), gb = *(const f32x4*)(g5 + k + 4);
                x0[0] += ga[0] * (lof(ya[0]) + lof(yb[0])); x0[1] += ga[1] * (hif(ya[0]) + hif(yb[0]));
                x0[2] += ga[2] * (lof(ya[1]) + lof(yb[1])); x0[3] += ga[3] * (hif(ya[1]) + hif(yb[1]));
                x1[0] += gb[0] * (lof(ya[2]) + lof(yb[2])); x1[1] += gb[1] * (hif(ya[2]) + hif(yb[2]));
                x1[2] += gb[2] * (lof(ya[3]) + lof(yb[3])); x1[3] += gb[3] * (hif(ya[3]) + hif(yb[3]));
            }
            if (MODE == 2) {
                *(f32x4*)(a.out + (size_t)t * D + k) = x0; *(f32x4*)(a.out + (size_t)t * D + k + 4) = x1;
                continue;
            }
            if (MODE == 0 && (li == 0 || combine)) { *(f32x4*)(X + (size_t)t * D + k) = x0; *(f32x4*)(X + (size_t)t * D + k + 4) = x1; }
            const f32x4 n0 = *(const f32x4*)(gn + k), n1 = *(const f32x4*)(gn + k + 4);
            const f32x4 s0 = *(const f32x4*)(mscale + k), s1 = *(const f32x4*)(mscale + k + 4);
            const f32x4 h0 = *(const f32x4*)(mshift + k), h1 = *(const f32x4*)(mshift + k + 4);
            float f[8];
#pragma unroll
            for (int j = 0; j < 4; ++j) {
                f[j] = x0[j] * rstd * n0[j] * (1.f + s0[j]) + h0[j];
                f[4 + j] = x1[j] * rstd * n1[j] * (1.f + s1[j]) + h1[j];
            }
            u32x4 hv;
            hv[0] = pk2(f[0], f[1]); hv[1] = pk2(f[2], f[3]); hv[2] = pk2(f[4], f[5]); hv[3] = pk2(f[6], f[7]);
            *(u32x4*)(H + (size_t)t * D + k) = hv;
            if (MODE == 1) {
                u32x4 lv;
                lv[0] = pk2(f[0] - lof(hv[0]), f[1] - hif(hv[0])); lv[1] = pk2(f[2] - lof(hv[1]), f[3] - hif(hv[1]));
                lv[2] = pk2(f[4] - lof(hv[2]), f[5] - hif(hv[2])); lv[3] = pk2(f[6] - lof(hv[3]), f[7] - hif(hv[3]));
                const bf16x8 fh = __builtin_bit_cast(bf16x8, hv), fl = __builtin_bit_cast(bf16x8, lv);
#pragma unroll
                for (int nt = 0; nt < 5; ++nt) {
                    const bf16x8 wh = *(const bf16x8*)(rwh + (size_t)nt * 16 * 1024 + kk * 32);
                    const bf16x8 wl = *(const bf16x8*)(rwh + (size_t)(80 + nt * 16) * 1024 + kk * 32);
                    lacc[nt] = mfma16(fh, wh, lacc[nt]);
                    lacc[nt] = mfma16(fh, wl, lacc[nt]);
                    lacc[nt] = mfma16(fl, wh, lacc[nt]);
                }
            }
        }
        if (MODE == 1) {
#pragma unroll
            for (int nt = 0; nt < 5; ++nt)
#pragma unroll
                for (int j = 0; j < 4; ++j) lg[(q * 4 + j) * 80 + nt * 16 + r] = lacc[nt][j];
            asm volatile("s_waitcnt lgkmcnt(0)" ::: "memory");
            __builtin_amdgcn_wave_barrier();
            if (lane < 16) {
                const float* L = lg + lane * 80;
                const float* bg = a.in[27] + li * 8;
                const float* be = a.in[29] + li * 64;
                float gmax = -3.0e38f; int gi = 0; float gl[8];
#pragma unroll
                for (int j = 0; j < 8; ++j) { gl[j] = L[j] + bg[j]; if (gl[j] > gmax) { gmax = gl[j]; gi = j; } }
                float ps = 0.f;
#pragma unroll
                for (int j = 0; j < 8; ++j) ps += __expf(gl[j] - gmax);
                const float ptop = 1.f / ps;
                float e1 = -3.0e38f, e2 = -3.0e38f; int i1 = 0, i2 = 0;
#pragma unroll
                for (int j = 0; j < 8; ++j) {
                    const float v = L[8 + gi * 8 + j] + be[gi * 8 + j];
                    if (v > e1) { e2 = e1; i2 = i1; e1 = v; i1 = j; } else if (v > e2) { e2 = v; i2 = j; }
                }
                const float ex = __expf(e2 - e1);
                const float w1 = ptop / (1.f + ex), w2 = ptop * ex / (1.f + ex);
                const int tt = g * 16 + lane;
                int* cnt = (int*)(a.ws + WS_CTL + CTL_CNT) + li * 64;
                int* list = (int*)(a.ws + WS_LIST);
                float* wsl = (float*)(a.ws + WS_WSLOT);
                const int ea = gi * 8 + i1, eb = gi * 8 + i2;
                const int pa = atomicAdd(&cnt[ea], 1); list[(size_t)ea * NTOK + pa] = 2 * tt; wsl[2 * tt] = w1;
                const int pb = atomicAdd(&cnt[eb], 1); list[(size_t)eb * NTOK + pb] = 2 * tt + 1; wsl[2 * tt + 1] = w2;
            }
            __builtin_amdgcn_wave_barrier();
        }
    }
}

template <int WM, int WN, int MT, int NT, class AP>
DI void gemm_tile(AP arow, const bf16_t* Bt, const int ldb, const int K, f32x4 (&acc)[MT][NT]) {
    constexpr int BM = WM * MT * 16, BN = WN * NT * 16;
    constexpr int A_BYTES = BM * 128, B_BYTES = BN * 128, STAGE = A_BYTES + B_BYTES;
    constexpr int ACH = BM * 8 / NTHR, BCH = BN * 8 / NTHR;
    static_assert(2 * STAGE <= LDS_AUX, "gemm LDS");
    const int tid = threadIdx.x, lane = tid & 63, wave = tid >> 6;
    const int wm = wave / WN, wn = wave % WN;
    const int fr = lane & 15, fq = lane >> 4;
    const bf16_t* ap[ACH]; const bf16_t* bp[BCH];
#pragma unroll
    for (int i = 0; i < ACH; ++i) { const int idx = tid + i * NTHR, row = idx >> 3, c = (idx & 7) ^ (row & 7); ap[i] = arow(row) + c * 8; }
#pragma unroll
    for (int i = 0; i < BCH; ++i) { const int idx = tid + i * NTHR, row = idx >> 3, c = (idx & 7) ^ (row & 7); bp[i] = Bt + (size_t)row * ldb + c * 8; }
#pragma unroll
    for (int i = 0; i < MT; ++i)
#pragma unroll
        for (int j = 0; j < NT; ++j) acc[i][j] = (f32x4){0.f, 0.f, 0.f, 0.f};
    const int KT = K >> 6;
    {
        char* sa = lds; char* sb = lds + A_BYTES;
#pragma unroll
        for (int i = 0; i < ACH; ++i) dma16(ap[i], sa + (tid + i * NTHR) * 16);
#pragma unroll
        for (int i = 0; i < BCH; ++i) dma16(bp[i], sb + (tid + i * NTHR) * 16);
    }
#pragma unroll 1
    for (int kt = 0; kt < KT; ++kt) {
        wait_vm0();
        __syncthreads();
        if (kt + 1 < KT) {
            char* sa = lds + ((kt + 1) & 1) * STAGE; char* sb = sa + A_BYTES;
            const int ko = (kt + 1) * 64;
#pragma unroll
            for (int i = 0; i < ACH; ++i) dma16(ap[i] + ko, sa + (tid + i * NTHR) * 16);
#pragma unroll
            for (int i = 0; i < BCH; ++i) dma16(bp[i] + ko, sb + (tid + i * NTHR) * 16);
        }
        const char* sa = lds + (kt & 1) * STAGE; const char* sb = sa + A_BYTES;
#pragma unroll
        for (int kk = 0; kk < 2; ++kk) {
            bf16x8 xf[MT], wf[NT];
#pragma unroll
            for (int i = 0; i < MT; ++i) xf[i] = ldsv8(sa + swz128(wm * MT * 16 + i * 16 + fr, kk * 4 + fq));
#pragma unroll
            for (int j = 0; j < NT; ++j) wf[j] = ldsv8(sb + swz128(wn * NT * 16 + j * 16 + fr, kk * 4 + fq));
#pragma unroll
            for (int i = 0; i < MT; ++i)
#pragma unroll
                for (int j = 0; j < NT; ++j) acc[i][j] = mfma16(wf[j], xf[i], acc[i][j]);
        }
    }
    __syncthreads();
}

DI void st_bf4(bf16_t* p, const f32x4 v) { u32x2 o; o[0] = pk2(v[0], v[1]); o[1] = pk2(v[2], v[3]); *(u32x2*)p = o; }

template <class Epi>
DI void gemm_dense_phase(const bf16_t* A, const int lda, const int mrows, const bf16_t* Bt, const int N, const int K, Epi epi) {
    const int mt = mrows / 128, nt = N / 128;
    for (int u = blockIdx.x; u < mt * nt; u += gridDim.x) {
        const int m0 = (u % mt) * 128, n0 = (u / mt) * 128;
        f32x4 acc[4][4];
        gemm_tile<2, 2, 4, 4>([&](int r) { return A + (size_t)(m0 + r) * lda; }, Bt + (size_t)n0 * K, K, K, acc);
        const int lane = threadIdx.x & 63, wave = threadIdx.x >> 6;
        const int mb = m0 + (wave >> 1) * 64 + (lane & 15), nb = n0 + (wave & 1) * 64 + (lane >> 4) * 4;
#pragma unroll
        for (int i = 0; i < 4; ++i)
#pragma unroll
            for (int j = 0; j < 4; ++j) epi(mb + i * 16, nb + j * 16, acc[i][j]);
    }
}

DI void epi_residual(const Args& a, int li, int chunk, int t, int n, const f32x4 v) {
    float* X = (float*)(a.ws + WS_X) + (size_t)t * D + n;
    const float* g = (const float*)(a.ws + WS_MOD) + ((size_t)li * 9 + tok_modrow(t)) * 6144 + chunk * 1024 + n;
    f32x4 x = *(f32x4*)X; const f32x4 gg = *(const f32x4*)g;
    x[0] += gg[0] * v[0]; x[1] += gg[1] * v[1]; x[2] += gg[2] * v[2]; x[3] += gg[3] * v[3];
    *(f32x4*)X = x;
}

DI void phase_rg_in(const Args& a, int j) {
    bf16_t* G = (bf16_t*)(a.ws + RG_G); bf16_t* U = (bf16_t*)(a.ws + RG_U);
    gemm_dense_phase((const bf16_t*)(a.ws + WS_H), D, NTOK, (const bf16_t*)(a.ws + W_RGIN) + (size_t)j * 2048 * 1024, 2048, 1024,
        [&](int t, int n, const f32x4 v) {
            if (n < 1024) { f32x4 g; g[0] = gelu_tanh(v[0]); g[1] = gelu_tanh(v[1]); g[2] = gelu_tanh(v[2]); g[3] = gelu_tanh(v[3]); st_bf4(G + (size_t)t * D + n, g); }
            else st_bf4(U + (size_t)t * D + (n - 1024), v);
        });
}

DI void phase_rg_scan(const Args& a, int j) {
    const int tid = threadIdx.x, lane = tid & 63, wave = tid >> 6;
    const int fr = lane & 15, fq = lane >> 4;
    const bf16_t* U = (const bf16_t*)(a.ws + RG_U);
    bf16_t* HS = (bf16_t*)(a.ws + RG_HS);
    char* sW = lds;
    char* sX = lds + 8192;
    float* sU = (float*)(lds + 16384);
    float* sUc = (float*)(lds + 33792);
    float* sA = (float*)(lds + 41984);
    float* sB = (float*)(lds + 50176);
    float* sSegA = (float*)(lds + 58368);
    float* sSegH = (float*)(lds + 59392);
    float* sCarry = (float*)(lds + 60416);
    float* sPar = (float*)(lds + 60544);
    for (int u = blockIdx.x; u < 512; u += gridDim.x) {
        const int half = u & 1, dir = (u >> 1) & 1, blk = (u >> 2) & 15, b = u >> 6;
        const int cin0 = blk * 64, co0 = blk * 64 + half * 32;
        __syncthreads();
        {
            const bf16_t* Wg = (const bf16_t*)(a.ws + W_RGG) + ((size_t)((j * 2 + dir) * 16 + blk)) * 128 * 64;
#pragma unroll
            for (int i = 0; i < 2; ++i) {
                const int idx = tid + i * NTHR, row = idx >> 3, c = idx & 7;
                const int srow = (row >> 5) * 64 + half * 32 + (row & 31);
                *(u32x4*)(sW + swz128(row, c)) = *(const u32x4*)(Wg + (size_t)srow * 64 + c * 8);
            }
            const float* cw = a.in[9] + (size_t)j * 4 * 1024; const float* cb = a.in[10] + (size_t)j * 1024;
            if (tid < 64) { for (int i = 0; i < 4; ++i) sPar[i * 64 + tid] = cw[i * 1024 + cin0 + tid]; sPar[256 + tid] = cb[cin0 + tid]; }
            if (tid < 32) {
                const float* gb = a.in[12] + ((size_t)(j * 2 + dir) * 2) * 1024;
                sPar[320 + tid] = gb[co0 + tid]; sPar[352 + tid] = gb[1024 + co0 + tid];
                const float lam = a.in[13][(size_t)(j * 2 + dir) * 1024 + co0 + tid];
                sPar[384 + tid] = log1pf(__expf(-lam));
                sCarry[tid] = 0.f;
            }
        }
        __syncthreads();
#pragma unroll 1
        for (int ci = 0; ci < 36; ++ci) {
            const int seg = ci >= 4, L = seg ? SEQ : CTXL, nch = L / 64, jc = seg ? ci - 4 : ci;
            const int oc = dir ? nch - 1 - jc : jc;
            const int rb = seg ? b * SEQ : NLAT + b * CTXL;
            const int s0 = oc * 64;
            for (int i = tid; i < 67 * 8; i += NTHR) {
                const int row = i >> 3, c = i & 7, s = s0 - 2 + row;
                float v[8];
                if (s >= 0 && s < L) {
                    const u32x4 raw = *(const u32x4*)(U + (size_t)(rb + s) * D + cin0 + c * 8);
                    v[0] = lof(raw[0]); v[1] = hif(raw[0]); v[2] = lof(raw[1]); v[3] = hif(raw[1]);
                    v[4] = lof(raw[2]); v[5] = hif(raw[2]); v[6] = lof(raw[3]); v[7] = hif(raw[3]);
                } else {
#pragma unroll
                    for (int e = 0; e < 8; ++e) v[e] = 0.f;
                }
#pragma unroll
                for (int e = 0; e < 8; ++e) sU[row * 64 + c * 8 + e] = v[e];
            }
            __syncthreads();
#pragma unroll
            for (int i = 0; i < 2; ++i) {
                const int idx = tid + i * NTHR, tk = idx >> 3, c = idx & 7;
                float o[8];
#pragma unroll
                for (int e = 0; e < 8; ++e) {
                    const int ch = c * 8 + e;
                    float acc = sPar[256 + ch];
#pragma unroll
                    for (int w = 0; w < 4; ++w) acc += sPar[w * 64 + ch] * sU[(tk + w) * 64 + ch];
                    o[e] = acc;
                }
                u32x4 pv; pv[0] = pk2(o[0], o[1]); pv[1] = pk2(o[2], o[3]); pv[2] = pk2(o[4], o[5]); pv[3] = pk2(o[6], o[7]);
                *(u32x4*)(sX + swz128(tk, c)) = pv;
                if ((c >> 2) == half) {
#pragma unroll
                    for (int e = 0; e < 8; ++e) sUc[tk * 32 + (c & 3) * 8 + e] = o[e];
                }
            }
            __syncthreads();
            {
                f32x4 acc[4];
#pragma unroll
                for (int jt = 0; jt < 4; ++jt) acc[jt] = (f32x4){0.f, 0.f, 0.f, 0.f};
#pragma unroll
                for (int kk = 0; kk < 2; ++kk) {
                    const bf16x8 xf = ldsv8(sX + swz128(wave * 16 + fr, kk * 4 + fq));
#pragma unroll
                    for (int jt = 0; jt < 4; ++jt) acc[jt] = mfma16(ldsv8(sW + swz128(jt * 16 + fr, kk * 4 + fq)), xf, acc[jt]);
                }
                const int tk = wave * 16 + fr;
#pragma unroll
                for (int jt = 0; jt < 2; ++jt)
#pragma unroll
                    for (int e = 0; e < 4; ++e) {
                        const int cc = jt * 16 + fq * 4 + e;
                        const float rg = sigmoidf_(acc[jt][e] + sPar[320 + cc]);
                        const float ig = sigmoidf_(acc[jt + 2][e] + sPar[352 + cc]);
                        const float la = -8.f * rg * sPar[384 + cc];
                        const float av = __expf(la);
                        const float bv = sqrtf(fmaxf(1.f - av * av, 0.f)) * ig * sUc[tk * 32 + cc];
                        sA[tk * 32 + cc] = av; sB[tk * 32 + cc] = bv;
                    }
            }
            __syncthreads();
            {
                const int ch = tid & 31, sg = tid >> 5;
                float av[8], bv[8];
#pragma unroll
                for (int e = 0; e < 8; ++e) { const int i = sg * 8 + e, tk = dir ? 63 - i : i; av[e] = sA[tk * 32 + ch]; bv[e] = sB[tk * 32 + ch]; }
                float Ap = 1.f, Hh = 0.f;
#pragma unroll
                for (int e = 0; e < 8; ++e) { Hh = av[e] * Hh + bv[e]; Ap *= av[e]; }
                sSegA[sg * 32 + ch] = Ap; sSegH[sg * 32 + ch] = Hh;
                __syncthreads();
                float hin = sCarry[ch];
                for (int s2 = 0; s2 < sg; ++s2) hin = sSegA[s2 * 32 + ch] * hin + sSegH[s2 * 32 + ch];
                __syncthreads();
                bf16_t* hs = HS + (size_t)dir * NTOK * D + (size_t)rb * D + co0 + ch;
#pragma unroll
                for (int e = 0; e < 8; ++e) {
                    hin = av[e] * hin + bv[e];
                    const int i = sg * 8 + e, tk = dir ? 63 - i : i;
                    hs[(size_t)(s0 + tk) * D] = f2bf(hin);
                }
                if (sg == 7) sCarry[ch] = hin;
            }
            __syncthreads();
        }
    }
}

DI void phase_rg_combine(const Args& a) {
    const u32x4* G = (const u32x4*)(a.ws + RG_G);
    const u32x4* H0 = (const u32x4*)(a.ws + RG_HS);
    const u32x4* H1 = (const u32x4*)(a.ws + RG_HS + TOKD2);
    u32x4* A2 = (u32x4*)(a.ws + RG_A2);
    const size_t n = (size_t)NTOK * D / 8;
    for (size_t i = (size_t)blockIdx.x * NTHR + threadIdx.x; i < n; i += (size_t)gridDim.x * NTHR) {
        const u32x4 g = G[i], h0 = H0[i], h1 = H1[i];
        u32x4 o;
#pragma unroll
        for (int e = 0; e < 4; ++e) o[e] = pk2(lof(g[e]) * (lof(h0[e]) + lof(h1[e])), hif(g[e]) * (hif(h0[e]) + hif(h1[e])));
        A2[i] = o;
    }
}

DI void phase_rg_out(const Args& a, int li, int j) {
    gemm_dense_phase((const bf16_t*)(a.ws + RG_A2), D, li == 3 ? NLAT : NTOK, (const bf16_t*)(a.ws + W_RGOUT) + (size_t)j * 1024 * 1024, 1024, 1024,
        [&](int t, int n, const f32x4 v) { epi_residual(a, li, 2, t, n, v); });
}

DI void phase_mla_down(const Args& a) {
    bf16_t* CQ = (bf16_t*)(a.ws + MLA_CQ); bf16_t* CKV = (bf16_t*)(a.ws + MLA_CKV); float* KR = (float*)(a.ws + MLA_KR);
    gemm_dense_phase((const bf16_t*)(a.ws + WS_H), D, NTOK, (const bf16_t*)(a.ws + W_MDOWN), 512, 1024,
        [&](int t, int n, const f32x4 v) {
            if (n < 256) st_bf4(CQ + (size_t)t * 256 + n, v);
            else if (n < 384) st_bf4(CKV + (size_t)t * 128 + (n - 256), v);
            else if (n < 416) *(f32x4*)(KR + (size_t)t * 32 + (n - 384)) = v;
        });
}

DI int perm_key(int kp) { return (kp & ~12) | ((kp & 4) << 1) | ((kp & 8) >> 1); }

DI void phase_mla_up(const Args& a) {
    const int tid = threadIdx.x, lane = tid & 63;
    const int fq = lane >> 4;
    const bf16_t* CQ = (const bf16_t*)(a.ws + MLA_CQ); const bf16_t* CKV = (const bf16_t*)(a.ws + MLA_CKV); const float* KR = (const float*)(a.ws + MLA_KR);
    bf16_t* Q = (bf16_t*)(a.ws + MLA_Q); bf16_t* Kb = (bf16_t*)(a.ws + MLA_K); bf16_t* VT = (bf16_t*)(a.ws + MLA_VT);
    const float* qkn = a.in[20];
    float* rstd = (float*)(lds + LDS_AUX);
    const int MT_ = NTOK / 128;
    const int nq = MT_ * 16, nkv = MT_ * 16;
    const float QSCALE = 0.10206207261596575f * 1.4426950408889634f;
    for (int u = blockIdx.x; u < nq + nkv; u += gridDim.x) {
        const bool isq = u < nq;
        const int uu = isq ? u : u - nq;
        const int m0 = (uu % MT_) * 128, head = uu / MT_;
        __syncthreads();
        {
            const int row = tid >> 1, hf = tid & 1;
            float ss = 0.f;
            if (isq) {
                const u32x4* p = (const u32x4*)(CQ + (size_t)(m0 + row) * 256 + hf * 128);
#pragma unroll
                for (int i = 0; i < 16; ++i) { const u32x4 v = p[i];
#pragma unroll
                    for (int e = 0; e < 4; ++e) { const float x = lof(v[e]), y = hif(v[e]); ss += x * x + y * y; } }
            } else {
                const u32x4* p = (const u32x4*)(CKV + (size_t)(m0 + row) * 128 + hf * 64);
#pragma unroll
                for (int i = 0; i < 8; ++i) { const u32x4 v = p[i];
#pragma unroll
                    for (int e = 0; e < 4; ++e) { const float x = lof(v[e]), y = hif(v[e]); ss += x * x + y * y; } }
            }
            ss += __shfl_xor(ss, 1);
            if (hf == 0) rstd[row] = rsqrtf(ss * (isq ? 1.f / 256.f : 1.f / 128.f) + EPS);
        }
        __syncthreads();
        if (isq) {
            f32x4 hold[2][6];
            gemm_tile<4, 1, 2, 6>([&](int r) { return CQ + (size_t)(m0 + r) * 256; }, (const bf16_t*)(a.ws + W_MUQ) + (size_t)head * 96 * 256, 256, 256, hold);
            const int wave = tid >> 6;
#pragma unroll
            for (int i = 0; i < 2; ++i) { const float rs = rstd[wave * 32 + i * 16 + (lane & 15)];
#pragma unroll
                for (int jn = 0; jn < 6; ++jn) hold[i][jn] *= rs; }
#pragma unroll
            for (int i = 0; i < 2; ++i) {
                const int m = wave * 32 + i * 16 + (lane & 15), t = m0 + m;
                float ss = 0.f;
#pragma unroll
                for (int jn = 0; jn < 6; ++jn)
#pragma unroll
                    for (int e = 0; e < 4; ++e) ss += hold[i][jn][e] * hold[i][jn][e];
                ss += __shfl_xor(ss, 16); ss += __shfl_xor(ss, 32);
                const float rs = rsqrtf(ss * (1.f / 96.f) + EPS);
                f32x4 o[6];
#pragma unroll
                for (int jn = 0; jn < 6; ++jn)
#pragma unroll
                    for (int e = 0; e < 4; ++e) o[jn][e] = hold[i][jn][e] * rs * qkn[jn * 16 + fq * 4 + e];
#pragma unroll
                for (int jn = 4; jn < 6; ++jn) {
                    f32x4 other;
#pragma unroll
                    for (int e = 0; e < 4; ++e) other[e] = __shfl_xor(o[jn][e], 32);
                    if (t < NLAT) {
                        const int s = t & (SEQ - 1);
                        const float pos = (float)(jn == 4 ? (s >> 6) : (s & 63));
#pragma unroll
                        for (int e = 0; e < 4; ++e) {
                            const int fi = (fq & 1) * 4 + e;
                            const float ang = pos * __powf(10000.f, -(float)fi * 0.125f);
                            float sn, cs; sincosf(ang, &sn, &cs);
                            o[jn][e] = (fq < 2) ? o[jn][e] * cs - other[e] * sn : o[jn][e] * cs + other[e] * sn;
                        }
                    }
                }
                bf16_t* qp = Q + (size_t)t * 1536 + head * 96 + fq * 4;
#pragma unroll
                for (int jn = 0; jn < 6; ++jn) st_bf4(qp + jn * 16, o[jn] * QSCALE);
            }
        } else {
            f32x4 hold[4][4];
            gemm_tile<2, 2, 4, 4>([&](int r) { return CKV + (size_t)(m0 + r) * 128; }, (const bf16_t*)(a.ws + W_MUKV) + (size_t)head * 128 * 128, 128, 128, hold);
            const int wave = tid >> 6, wm = wave >> 1, wn = wave & 1;
#pragma unroll
            for (int i = 0; i < 4; ++i) { const float rs = rstd[wm * 64 + i * 16 + (lane & 15)];
#pragma unroll
                for (int jn = 0; jn < 4; ++jn) hold[i][jn] *= rs; }
#pragma unroll
            for (int i = 0; i < 4; ++i) {
                const int m = wm * 64 + i * 16 + (lane & 15), t = m0 + m;
                const int bb = t < NLAT ? (t >> 11) : ((t - NLAT) >> 8);
                const int kp = t < NLAT ? CTXL + (t & (SEQ - 1)) : ((t - NLAT) & (CTXL - 1));
                if (wn == 0) {
                    const int base = (fq >> 1) * 16 + (fq & 1) * 4;
                    const f32x4 z1 = *(const f32x4*)(KR + (size_t)t * 32 + base);
                    const f32x4 z2 = *(const f32x4*)(KR + (size_t)t * 32 + base + 8);
                    float ss = 0.f;
#pragma unroll
                    for (int jn = 0; jn < 4; ++jn)
#pragma unroll
                        for (int e = 0; e < 4; ++e) ss += hold[i][jn][e] * hold[i][jn][e];
#pragma unroll
                    for (int e = 0; e < 4; ++e) ss += z1[e] * z1[e] + z2[e] * z2[e];
                    ss += __shfl_xor(ss, 16); ss += __shfl_xor(ss, 32);
                    const float rs = rsqrtf(ss * (1.f / 96.f) + EPS);
                    bf16_t* kpn = Kb + ((size_t)(bb * 16 + head) * NKEY + kp) * 96;
#pragma unroll
                    for (int jn = 0; jn < 4; ++jn) {
                        f32x4 o;
#pragma unroll
                        for (int e = 0; e < 4; ++e) o[e] = hold[i][jn][e] * rs * qkn[96 + jn * 16 + fq * 4 + e];
                        st_bf4(kpn + jn * 16 + fq * 4, o);
                    }
                    f32x4 o1, o2;
#pragma unroll
                    for (int e = 0; e < 4; ++e) {
                        float a1 = z1[e] * rs * qkn[96 + 64 + base + e], a2 = z2[e] * rs * qkn[96 + 64 + base + 8 + e];
                        if (t < NLAT) {
                            const int s = t & (SEQ - 1);
                            const float pos = (float)((fq >> 1) == 0 ? (s >> 6) : (s & 63));
                            const int fi = (fq & 1) * 4 + e;
                            const float ang = pos * __powf(10000.f, -(float)fi * 0.125f);
                            float sn, cs; sincosf(ang, &sn, &cs);
                            const float b1 = a1 * cs - a2 * sn, b2 = a2 * cs + a1 * sn;
                            a1 = b1; a2 = b2;
                        }
                        o1[e] = a1; o2[e] = a2;
                    }
                    st_bf4(kpn + 64 + base, o1);
                    st_bf4(kpn + 64 + base + 8, o2);
                } else {
                    bf16_t* vp = VT + ((size_t)(bb * 16 + head) * 64) * NKEY + perm_key(kp);
#pragma unroll
                    for (int jn = 0; jn < 4; ++jn)
#pragma unroll
                        for (int e = 0; e < 4; ++e) vp[(size_t)(jn * 16 + fq * 4 + e) * NKEY] = f2bf(hold[i][jn][e]);
                }
            }
        }
    }
}

DI void phase_mla_attn(const Args& a) {
    const int tid = threadIdx.x, lane = tid & 63, wave = tid >> 6;
    const int r = lane & 31, h = lane >> 5;
    const bf16_t* Q = (const bf16_t*)(a.ws + MLA_Q); const bf16_t* Kb = (const bf16_t*)(a.ws + MLA_K); const bf16_t* VT = (const bf16_t*)(a.ws + MLA_VT);
    bf16_t* O = (bf16_t*)(a.ws + MLA_O);
    constexpr int KT_B = 64 * 256, VT_B = 64 * 128, ST_B = KT_B + VT_B;
    for (int u = blockIdx.x; u < 2048 + 256; u += gridDim.x) {
        const bool isctx = u >= 2048;
        const int uu = isctx ? u - 2048 : u;
        const int qb = isctx ? (uu & 1) : (uu & 15), head = isctx ? ((uu >> 1) & 15) : ((uu >> 4) & 15), b = isctx ? (uu >> 5) : (uu >> 8);
        const int ntile = isctx ? CTXL / 64 : NKEY / 64;
        const int t = (isctx ? NLAT + b * CTXL : b * SEQ) + qb * 128 + wave * 32 + r;
        const bf16_t* kbase = Kb + (size_t)(b * 16 + head) * NKEY * 96;
        const bf16_t* vbase = VT + (size_t)(b * 16 + head) * 64 * NKEY;
        bf16x8 qf[6];
#pragma unroll
        for (int kk = 0; kk < 6; ++kk) qf[kk] = *(const bf16x8*)(Q + (size_t)t * 1536 + head * 96 + kk * 16 + h * 8);
        f32x16 o[2];
#pragma unroll
        for (int e = 0; e < 16; ++e) { o[0][e] = 0.f; o[1][e] = 0.f; }
        float mrun = -INFINITY, lsum = 0.f;
        __syncthreads();
        auto stage = [&](int kt, int buf) {
            char* sk = lds + buf * ST_B; char* sv = sk + KT_B;
            const int key0 = kt * 64;
#pragma unroll
            for (int i = 0; i < 4; ++i) {
                const int idx = tid + i * NTHR, row = idx >> 4; int c = (idx & 15) ^ (row & 15); if (c >= 12) c = 0;
                dma16(kbase + (size_t)(key0 + row) * 96 + c * 8, sk + idx * 16);
            }
#pragma unroll
            for (int i = 0; i < 2; ++i) {
                const int idx = tid + i * NTHR, row = idx >> 3, c = (idx & 7) ^ ((row >> 1) & 7);
                dma16(vbase + (size_t)row * NKEY + key0 + c * 8, sv + idx * 16);
            }
        };
        stage(0, 0);
#pragma unroll 1
        for (int kt = 0; kt < ntile; ++kt) {
            wait_vm0();
            __syncthreads();
            if (kt + 1 < ntile) stage(kt + 1, (kt + 1) & 1);
            const char* sk = lds + (kt & 1) * ST_B; const char* sv = sk + KT_B;
            f32x16 st[2];
#pragma unroll
            for (int e = 0; e < 16; ++e) { st[0][e] = 0.f; st[1][e] = 0.f; }
#pragma unroll
            for (int kk = 0; kk < 6; ++kk)
#pragma unroll
                for (int si = 0; si < 2; ++si) {
                    const int s = si * 32 + r;
                    st[si] = mfma32(ldsv8(sk + swz256(s, kk * 2 + h)), qf[kk], st[si]);
                }
            float mx = st[0][0];
#pragma unroll
            for (int e = 0; e < 16; ++e) { mx = fmaxf(mx, st[0][e]); mx = fmaxf(mx, st[1][e]); }
            mx = fmaxf(mx, __shfl_xor(mx, 32));
            const float mnew = fmaxf(mrun, mx);
            const float alpha = __builtin_amdgcn_exp2f(mrun - mnew);
            mrun = mnew;
            float ps = 0.f;
#pragma unroll
            for (int si = 0; si < 2; ++si)
#pragma unroll
                for (int e = 0; e < 16; ++e) { const float p = __builtin_amdgcn_exp2f(st[si][e] - mnew); st[si][e] = p; ps += p; }
            lsum = lsum * alpha + ps;
#pragma unroll
            for (int e = 0; e < 16; ++e) { o[0][e] *= alpha; o[1][e] *= alpha; }
#pragma unroll
            for (int si = 0; si < 2; ++si)
#pragma unroll
                for (int ks = 0; ks < 2; ++ks) {
                    u32x4 pp;
                    pp[0] = pk2(st[si][8 * ks + 0], st[si][8 * ks + 1]); pp[1] = pk2(st[si][8 * ks + 2], st[si][8 * ks + 3]);
                    pp[2] = pk2(st[si][8 * ks + 4], st[si][8 * ks + 5]); pp[3] = pk2(st[si][8 * ks + 6], st[si][8 * ks + 7]);
                    const bf16x8 pf = __builtin_bit_cast(bf16x8, pp);
#pragma unroll
                    for (int et = 0; et < 2; ++et) {
                        const int e = et * 32 + r;
                        o[et] = mfma32(ldsv8(sv + e * 128 + (((si * 4 + ks * 2 + h) ^ ((e >> 1) & 7)) << 4)), pf, o[et]);
                    }
                }
        }
        lsum += __shfl_xor(lsum, 32);
        const float inv = 1.f / lsum;
#pragma unroll
        for (int et = 0; et < 2; ++et)
#pragma unroll
            for (int g = 0; g < 4; ++g) {
                f32x4 v; v[0] = o[et][4 * g] * inv; v[1] = o[et][4 * g + 1] * inv; v[2] = o[et][4 * g + 2] * inv; v[3] = o[et][4 * g + 3] * inv;
                st_bf4(O + (size_t)t * D + head * 64 + et * 32 + 8 * g + 4 * h, v);
            }
    }
}

DI void phase_mla_out(const Args& a, int li) {
    gemm_dense_phase((const bf16_t*)(a.ws + MLA_O), D, NTOK, (const bf16_t*)(a.ws + W_MO), 1024, 1024,
        [&](int t, int n, const f32x4 v) { epi_residual(a, li, 2, t, n, v); });
}

DI void phase_ml_in(const Args& a) {
    bf16_t* Qm = (bf16_t*)(a.ws + ML_Q); bf16_t* Km = (bf16_t*)(a.ws + ML_K); bf16_t* KT = (bf16_t*)(a.ws + ML_KT); bf16_t* VT = (bf16_t*)(a.ws + ML_VT);
    bf16_t* OG = (bf16_t*)(a.ws + ML_OG); float* GT = (float*)(a.ws + ML_GT);
    const float* gb = a.in[23];
    gemm_dense_phase((const bf16_t*)(a.ws + WS_H), D, NTOK, (const bf16_t*)(a.ws + W_MLIN), 3200, 1024,
        [&](int t, int n, const f32x4 v) {
            if (n < 512) st_bf4(Qm + (size_t)t * 512 + n, v * 0.08838834764831845f);
            else if (n < 1024) {
                st_bf4(Km + (size_t)t * 512 + (n - 512), v);
#pragma unroll
                for (int e = 0; e < 4; ++e) KT[(size_t)(n - 512 + e) * NTOK + t] = f2bf(v[e]);
            } else if (n < 2048) {
#pragma unroll
                for (int e = 0; e < 4; ++e) VT[(size_t)(n - 1024 + e) * NTOK + t] = f2bf(v[e]);
            } else if (n < 3072) {
                f32x4 s; s[0] = sigmoidf_(v[0]); s[1] = sigmoidf_(v[1]); s[2] = sigmoidf_(v[2]); s[3] = sigmoidf_(v[3]);
                st_bf4(OG + (size_t)t * D + (n - 2048), s);
            } else if (n < 3088) {
                f32x4 s; s[0] = v[0] + gb[n - 3072]; s[1] = v[1] + gb[n - 3071]; s[2] = v[2] + gb[n - 3070]; s[3] = v[3] + gb[n - 3069];
                *(f32x4*)(GT + (size_t)t * 16 + (n - 3072)) = s;
            }
        });
}

DI void phase_ml_scan(const Args& a) {
    const int tid = threadIdx.x, lane = tid & 63, wave = tid >> 6;
    const int fr = lane & 15, fq = lane >> 4;
    const bf16_t* Qm = (const bf16_t*)(a.ws + ML_Q); const bf16_t* Km = (const bf16_t*)(a.ws + ML_K);
    const bf16_t* KT = (const bf16_t*)(a.ws + ML_KT); const bf16_t* VT = (const bf16_t*)(a.ws + ML_VT);
    const float* GT = (const float*)(a.ws + ML_GT);
    bf16_t* HS = (bf16_t*)(a.ws + ML_HS);
    char* sQ = lds;
    char* sK = lds + 16384;
    char* sS = sK;
    char* sKT = lds + 32768;
    char* sVT = lds + 49152;
    char* sCT = lds + 55296;
    float* sRow = (float*)(lds + 67584);
    float* sCol = sRow + 64;
    float* sInt = sCol + 64;
    float* sNrm = sInt + 64;
    float* sWv = sNrm + 64;
    float* sSc = sWv + 64;
    for (int u = blockIdx.x; u < 512; u += gridDim.x) {
        const int sl = u & 7, dir = (u >> 3) & 1, head = (u >> 4) & 3, b = u >> 6;
        __syncthreads();
        for (int i = tid; i < 12288 / 16; i += NTHR) *(u32x4*)(sCT + i * 16) = (u32x4){0u, 0u, 0u, 0u};
        for (int i = tid; i < 16 * 8; i += NTHR) {
            const int row = 32 + (i >> 3), c = i & 7;
            const unsigned v = row == 32 ? 0x3f803f80u : 0u;
            *(u32x4*)(sVT + swz128(row, c)) = (u32x4){v, v, v, v};
        }
        if (tid == 0) sSc[1] = -1e30f;
        f32x4 accC[2][3];
#pragma unroll
        for (int i = 0; i < 2; ++i)
#pragma unroll
            for (int jn = 0; jn < 3; ++jn) accC[i][jn] = (f32x4){0.f, 0.f, 0.f, 0.f};
        __syncthreads();
#pragma unroll 1
        for (int ci = 0; ci < 36; ++ci) {
            const int seg = ci >= 4, L = seg ? SEQ : CTXL, nch = L / 64, jc = seg ? ci - 4 : ci;
            const int oc = dir ? nch - 1 - jc : jc;
            const int t0 = (seg ? b * SEQ : NLAT + b * CTXL) + oc * 64;
#pragma unroll
            for (int i = 0; i < 4; ++i) {
                const int idx = tid + i * NTHR, row = idx >> 4, c = (idx & 15) ^ (row & 15);
                dma16(Qm + (size_t)(t0 + row) * 512 + head * 128 + c * 8, sQ + idx * 16);
                dma16(Km + (size_t)(t0 + row) * 512 + head * 128 + c * 8, sK + idx * 16);
            }
#pragma unroll
            for (int i = 0; i < 4; ++i) {
                const int idx = tid + i * NTHR, row = idx >> 3, c = (idx & 7) ^ (row & 7);
                dma16(KT + (size_t)(head * 128 + row) * NTOK + t0 + c * 8, sKT + idx * 16);
            }
            {
                const int idx = tid, row = idx >> 3, c = (idx & 7) ^ (row & 7);
                dma16(VT + (size_t)(head * 256 + sl * 32 + row) * NTOK + t0 + c * 8, sVT + idx * 16);
            }
            if (wave == 0) {
                const int s = dir ? 63 - lane : lane;
                const float ig = GT[(size_t)(t0 + s) * 16 + dir * 8 + head];
                const float fg = GT[(size_t)(t0 + s) * 16 + dir * 8 + 4 + head];
                const float lf = fminf(fg, 0.f) - log1pf(__expf(-fabsf(fg)));
                float bc = lf;
#pragma unroll
                for (int d = 1; d < 64; d <<= 1) { const float o = __shfl_up(bc, d); if (lane >= d) bc += o; }
                const float av = ig - bc;
                float pm = av;
#pragma unroll
                for (int d = 1; d < 64; d <<= 1) { const float o = __shfl_up(pm, d); if (lane >= d) pm = fmaxf(pm, o); }
                const float mst = sSc[1];
                const float mm = fmaxf(mst, pm);
                sRow[s] = -mm;
                sCol[s] = av;
                sInt[s] = __expf(mst - mm);
                sNrm[s] = __expf(-(bc + mm));
                const float mmL = __shfl(mm, 63), bL = __shfl(bc, 63);
                sWv[s] = __expf(av - mmL);
                if (lane == 0) { sSc[0] = __expf(mst - mmL); sSc[1] = bL + mmL; }
            }
            wait_vm0();
            __syncthreads();
            f32x4 sacc[4];
#pragma unroll
            for (int jt = 0; jt < 4; ++jt) sacc[jt] = (f32x4){0.f, 0.f, 0.f, 0.f};
#pragma unroll
            for (int kk = 0; kk < 4; ++kk) {
                const bf16x8 qf = ldsv8(sQ + swz256(wave * 16 + fr, kk * 4 + fq));
#pragma unroll
                for (int jt = 0; jt < 4; ++jt) sacc[jt] = mfma16(ldsv8(sK + swz256(jt * 16 + fr, kk * 4 + fq)), qf, sacc[jt]);
            }
            __syncthreads();
            {
                const int tq = wave * 16 + fr;
                const float rt = sRow[tq];
#pragma unroll
                for (int jt = 0; jt < 4; ++jt) {
                    f32x4 v;
#pragma unroll
                    for (int e = 0; e < 4; ++e) {
                        const int s = jt * 16 + fq * 4 + e;
                        const bool ok = dir ? (s >= tq) : (s <= tq);
                        v[e] = ok ? sacc[jt][e] * __expf(rt + sCol[s]) : 0.f;
                    }
                    u32x2 pv; pv[0] = pk2(v[0], v[1]); pv[1] = pk2(v[2], v[3]);
                    *(u32x2*)(sS + swz128(tq, jt * 2 + (fq >> 1)) + (fq & 1) * 8) = pv;
                }
            }
            __syncthreads();
            {
                f32x4 n1[3], n2[3];
#pragma unroll
                for (int jt = 0; jt < 3; ++jt) { n1[jt] = (f32x4){0.f, 0.f, 0.f, 0.f}; n2[jt] = (f32x4){0.f, 0.f, 0.f, 0.f}; }
#pragma unroll
                for (int kk = 0; kk < 2; ++kk) {
                    const bf16x8 sf = ldsv8(sS + swz128(wave * 16 + fr, kk * 4 + fq));
#pragma unroll
                    for (int jt = 0; jt < 3; ++jt) n1[jt] = mfma16(ldsv8(sVT + swz128(jt * 16 + fr, kk * 4 + fq)), sf, n1[jt]);
                }
#pragma unroll
                for (int kk = 0; kk < 4; ++kk) {
                    const bf16x8 qf = ldsv8(sQ + swz256(wave * 16 + fr, kk * 4 + fq));
#pragma unroll
                    for (int jt = 0; jt < 3; ++jt) n2[jt] = mfma16(ldsv8(sCT + swz256(jt * 16 + fr, kk * 4 + fq)), qf, n2[jt]);
                }
                const int tq = wave * 16 + fr;
                const float it = sInt[tq];
                float den = n1[2][0] + it * n2[2][0];
                den = __shfl(den, fr);
                const float dn = fmaxf(fabsf(den), sNrm[tq]);
                const float inv = 1.f / dn;
                bf16_t* hp = HS + (size_t)dir * NTOK * D + (size_t)(t0 + tq) * D + head * 256 + sl * 32 + fq * 4;
#pragma unroll
                for (int jt = 0; jt < 2; ++jt) {
                    f32x4 v;
#pragma unroll
                    for (int e = 0; e < 4; ++e) v[e] = (n1[jt][e] + it * n2[jt][e]) * inv;
                    st_bf4(hp + jt * 16, v);
                }
            }
            {
                const float decay = sSc[0];
#pragma unroll
                for (int i = 0; i < 2; ++i)
#pragma unroll
                    for (int jn = 0; jn < 3; ++jn) accC[i][jn] *= decay;
#pragma unroll
                for (int kk = 0; kk < 2; ++kk) {
                    bf16x8 vf[3];
#pragma unroll
                    for (int jn = 0; jn < 3; ++jn) vf[jn] = ldsv8(sVT + swz128(jn * 16 + fr, kk * 4 + fq));
                    const f32x4 w0 = *(const f32x4*)(sWv + kk * 32 + fq * 8), w1 = *(const f32x4*)(sWv + kk * 32 + fq * 8 + 4);
#pragma unroll
                    for (int i = 0; i < 2; ++i) {
                        const u32x4 kr = *(const u32x4*)(sKT + swz128((wave * 2 + i) * 16 + fr, kk * 4 + fq));
                        u32x4 ks;
                        ks[0] = pk2(lof(kr[0]) * w0[0], hif(kr[0]) * w0[1]); ks[1] = pk2(lof(kr[1]) * w0[2], hif(kr[1]) * w0[3]);
                        ks[2] = pk2(lof(kr[2]) * w1[0], hif(kr[2]) * w1[1]); ks[3] = pk2(lof(kr[3]) * w1[2], hif(kr[3]) * w1[3]);
                        const bf16x8 kf = __builtin_bit_cast(bf16x8, ks);
#pragma unroll
                        for (int jn = 0; jn < 3; ++jn) accC[i][jn] = mfma16(kf, vf[jn], accC[i][jn]);
                    }
                }
            }
            __syncthreads();
#pragma unroll
            for (int i = 0; i < 2; ++i)
#pragma unroll
                for (int jn = 0; jn < 3; ++jn) {
                    const int dd = (wave * 2 + i) * 16 + fq * 4, ee = jn * 16 + fr;
                    u32x2 pv; pv[0] = pk2(accC[i][jn][0], accC[i][jn][1]); pv[1] = pk2(accC[i][jn][2], accC[i][jn][3]);
                    *(u32x2*)(sCT + swz256(ee, dd >> 3) + (dd & 7) * 2) = pv;
                }
            __syncthreads();
        }
    }
}

DI void phase_ml_readout(const Args& a) {
    const int tid = threadIdx.x, lane = tid & 63, wave = tid >> 6;
    const bf16_t* H0 = (const bf16_t*)(a.ws + ML_HS); const bf16_t* H1 = H0 + (size_t)NTOK * D;
    const bf16_t* OG = (const bf16_t*)(a.ws + ML_OG); bf16_t* A2 = (bf16_t*)(a.ws + ML_A2);
    const float* on = a.in[24];
    for (int t = blockIdx.x * 4 + wave; t < NTOK; t += gridDim.x * 4) {
        const size_t off = (size_t)t * D + lane * 16;
        const u32x4 a0 = *(const u32x4*)(H0 + off), a1 = *(const u32x4*)(H0 + off + 8);
        const u32x4 b0 = *(const u32x4*)(H1 + off), b1 = *(const u32x4*)(H1 + off + 8);
        float v[16];
#pragma unroll
        for (int e = 0; e < 4; ++e) {
            v[2 * e] = lof(a0[e]) + lof(b0[e]); v[2 * e + 1] = hif(a0[e]) + hif(b0[e]);
            v[8 + 2 * e] = lof(a1[e]) + lof(b1[e]); v[8 + 2 * e + 1] = hif(a1[e]) + hif(b1[e]);
        }
        float ss = 0.f;
#pragma unroll
        for (int e = 0; e < 16; ++e) ss += v[e] * v[e];
        ss += __shfl_xor(ss, 1); ss += __shfl_xor(ss, 2); ss += __shfl_xor(ss, 4); ss += __shfl_xor(ss, 8);
        const float rs = rsqrtf(ss * (1.f / 256.f) + EPS);
        const u32x4 g0 = *(const u32x4*)(OG + off), g1 = *(const u32x4*)(OG + off + 8);
        const float* onp = on + lane * 16;
        u32x4 o0, o1;
#pragma unroll
        for (int e = 0; e < 4; ++e) {
            o0[e] = pk2(v[2 * e] * rs * onp[2 * e] * lof(g0[e]), v[2 * e + 1] * rs * onp[2 * e + 1] * hif(g0[e]));
            o1[e] = pk2(v[8 + 2 * e] * rs * onp[8 + 2 * e] * lof(g1[e]), v[8 + 2 * e + 1] * rs * onp[8 + 2 * e + 1] * hif(g1[e]));
        }
        *(u32x4*)(A2 + off) = o0; *(u32x4*)(A2 + off + 8) = o1;
    }
}

DI void phase_ml_out(const Args& a, int li) {
    gemm_dense_phase((const bf16_t*)(a.ws + ML_A2), D, NTOK, (const bf16_t*)(a.ws + W_MLOUT), 1024, 1024,
        [&](int t, int n, const f32x4 v) { epi_residual(a, li, 2, t, n, v); });
}

template <int STAGE>
DI void phase_moe(const Args& a, int li) {
    const int tid = threadIdx.x, lane = tid & 63, wave = tid >> 6;
    const int fr = lane & 15, fq = lane >> 4, wm = wave >> 1, wn = wave & 1;
    const int* cnt = (const int*)(a.ws + WS_CTL + CTL_CNT) + li * 64;
    const int* list = (const int*)(a.ws + WS_LIST);
    const float* wsl = (const float*)(a.ws + WS_WSLOT);
    const bf16_t* F = (const bf16_t*)(a.ws + WS_H);
    bf16_t* HM = (bf16_t*)(a.ws + WS_HMID); bf16_t* Y = (bf16_t*)(a.ws + WS_Y);
    int* pre = (int*)(lds + LDS_AUX);
    int* srow = pre + 80;
    __syncthreads();
    if (tid == 0) { int s = 0; for (int e = 0; e < 64; ++e) { pre[e] = s; s += (cnt[e] + 127) >> 7; } pre[64] = s; }
    __syncthreads();
    const int T = pre[64];
    constexpr int NTN = STAGE == 0 ? 4 : 8;
    for (int u = blockIdx.x; u < T * NTN; u += gridDim.x) {
        const int ti = u % T, nt = u / T;
        int e = 0;
#pragma unroll 1
        for (int s = 32; s > 0; s >>= 1) if (pre[e + s] <= ti) e += s;
        const int r0 = (ti - pre[e]) * 128, ce = cnt[e];
        __syncthreads();
        if (tid < 128) srow[tid] = list[(size_t)e * NTOK + min(r0 + tid, ce - 1)];
        __syncthreads();
        f32x4 acc[4][4];
        if (STAGE == 0) {
            gemm_tile<2, 2, 4, 4>([&](int r) { return F + (size_t)(srow[r] >> 1) * D; },
                (const bf16_t*)(a.ws + W_GU) + ((size_t)(li * 64 + e) * 512 + nt * 128) * 1024, 1024, 1024, acc);
#pragma unroll
            for (int i = 0; i < 4; ++i) {
                const int m = wm * 64 + i * 16 + fr;
                if (r0 + m < ce) {
                    bf16_t* hp = HM + (size_t)srow[m] * 256 + fq * 4;
#pragma unroll
                    for (int p = 0; p < 2; ++p) {
                        f32x4 v;
#pragma unroll
                        for (int x = 0; x < 4; ++x) { const float g = acc[i][2 * p][x]; v[x] = g / (1.f + __expf(-g)) * acc[i][2 * p + 1][x]; }
                        st_bf4(hp + (nt * 4 + wn * 2 + p) * 16, v);
                    }
                }
            }
        } else {
            gemm_tile<2, 2, 4, 4>([&](int r) { return HM + (size_t)srow[r] * 256; },
                (const bf16_t*)(a.ws + W_DN) + ((size_t)(li * 64 + e) * 1024 + nt * 128) * 256, 256, 256, acc);
#pragma unroll
            for (int i = 0; i < 4; ++i) {
                const int m = wm * 64 + i * 16 + fr;
                if (r0 + m < ce) {
                    const int slot = srow[m];
                    const float w = wsl[slot];
                    bf16_t* yp = Y + (size_t)slot * D + nt * 128 + wn * 64 + fq * 4;
#pragma unroll
                    for (int j = 0; j < 4; ++j) st_bf4(yp + j * 16, acc[i][j] * w);
                }
            }
        }
    }
}

#ifndef DBG_STOP
#define DBG_STOP 99
#endif
#ifndef DBG_OFF
#define DBG_OFF 0
#endif
DI void phase_dbg(const Args& a) {
    const size_t n = (size_t)NLAT * D;
    const float* X = (const float*)(a.ws + WS_X);
    const bf16_t* B = (const bf16_t*)(a.ws + (size_t)DBG_OFF);
    for (size_t i = (size_t)blockIdx.x * NTHR + threadIdx.x; i < n; i += (size_t)gridDim.x * NTHR)
        a.out[i] = DBG_OFF ? bf2f(B[i]) : X[i];
}

constexpr int NPH = 34;
__global__ void __launch_bounds__(NTHR, 2) fwd(const Args a) {
    if (threadIdx.x == 0) *(uint4*)(lds + LDS_BARW) = make_uint4(0u, 0u, 0u, 0u);
    __syncthreads();
    XcdBarrier bar;
    const bool multi = (a.ph_hi - a.ph_lo) > 1;
    if (multi) bar = xcd_barrier_post((unsigned*)(a.ws + WS_CTL), (volatile LAS unsigned*)(lds + LDS_BARW));
#define RUN(id, ...) do { if (a.ph_lo <= (id) && (id) < a.ph_hi) { __VA_ARGS__; if ((id) + 1 < a.ph_hi) xcd_barrier(bar); } } while (0)
    RUN(0, phase_prologue(a));
    RUN(1, phase_token<0>(a, 0));
    RUN(2, phase_rg_in(a, 0));
    RUN(3, phase_rg_scan(a, 0));
    RUN(4, phase_rg_combine(a));
    RUN(5, phase_rg_out(a, 0, 0));
    RUN(6, phase_token<1>(a, 0));
    RUN(7, phase_moe<0>(a, 0));
    RUN(8, phase_moe<1>(a, 0));
    RUN(9, phase_token<0>(a, 1));
    RUN(10, phase_mla_down(a));
    RUN(11, phase_mla_up(a));
    RUN(12, phase_mla_attn(a));
    RUN(13, phase_mla_out(a, 1));
    RUN(14, phase_token<1>(a, 1));
    RUN(15, phase_moe<0>(a, 1));
    RUN(16, phase_moe<1>(a, 1));
    RUN(17, phase_token<0>(a, 2));
    RUN(18, phase_ml_in(a));
    RUN(19, phase_ml_scan(a));
    RUN(20, phase_ml_readout(a));
    RUN(21, phase_ml_out(a, 2));
    RUN(22, phase_token<1>(a, 2));
    RUN(23, phase_moe<0>(a, 2));
    RUN(24, phase_moe<1>(a, 2));
    RUN(25, phase_token<0>(a, 3));
    RUN(26, phase_rg_in(a, 1));
    RUN(27, phase_rg_scan(a, 1));
    RUN(28, phase_rg_combine(a));
    RUN(29, phase_rg_out(a, 3, 1));
    RUN(30, phase_token<1>(a, 3));
    RUN(31, phase_moe<0>(a, 3));
    RUN(32, phase_moe<1>(a, 3));
    RUN(33, phase_token<2>(a, 3));
    RUN(34, phase_dbg(a));
#undef RUN
}

static void add_td(Args& a, int& n, int& tile0, const float* src, bf16_t* dst, const float* rscale, long sb, long db, int K, int N, int Npad, int batch, int perm) {
    TDesc& t = a.td[n++];
    t.src = src; t.dst = dst; t.rscale = rscale; t.sb = sb; t.db = db; t.K = K; t.N = N; t.Npad = Npad; t.batch = batch; t.perm = perm;
    t.tiles_k = K / 64; t.tiles_n = (Npad + 63) / 64; t.tile0 = tile0;
    tile0 += batch * t.tiles_k * t.tiles_n;
}

extern "C" void kernel_launch(void* const* d_in, const int* in_sizes, int n_in, void* d_out, int out_size, void* d_ws, size_t ws_size, hipStream_t stream) {
    static int grid = 0;
    if (grid == 0) {
        if (n_in != 32 || out_size != NLAT * D || ws_size < WS_END) { fprintf(stderr, "kernel_launch: unexpected sizes (n_in %d out %d ws %zu need %zu)\n", n_in, out_size, ws_size, (size_t)WS_END); grid = -1; return; }
        int dev = 0, cus = 0, per_cu = 0;
        (void)hipGetDevice(&dev);
        (void)hipDeviceGetAttribute(&cus, hipDeviceAttributeMultiprocessorCount, dev);
        if (hipOccupancyMaxActiveBlocksPerMultiprocessor(&per_cu, (const void*)fwd, NTHR, 0) != hipSuccess) per_cu = 0;
        (void)hipGetLastError();
        if (per_cu < 2) fprintf(stderr, "kernel_launch: note: occupancy query reports %d blocks per CU (need 2)\n", per_cu);
        grid = cus * (per_cu >= 2 ? 2 : (per_cu >= 1 ? 1 : 2));
    }
    if (grid < 0) return;
    (void)in_sizes;
    (void)hipMemsetAsync((char*)d_ws + WS_CTL, 0, CTL_BYTES, stream);
    Args a;
    memset(&a, 0, sizeof(a));
    for (int i = 0; i < 32; ++i) a.in[i] = (const float*)d_in[i];
    a.out = (float*)d_out; a.ws = (unsigned char*)d_ws;
    unsigned char* ws = (unsigned char*)d_ws;
    int n = 0, tile0 = 0;
    add_td(a, n, tile0, a.in[8], (bf16_t*)(ws + W_RGIN), nullptr, 1024L * 2048, 2048L * 1024, 1024, 2048, 2048, 2, 0);
    add_td(a, n, tile0, a.in[14], (bf16_t*)(ws + W_RGOUT), nullptr, 1024L * 1024, 1024L * 1024, 1024, 1024, 1024, 2, 0);
    for (int j = 0; j < 2; ++j) for (int dir = 0; dir < 2; ++dir) for (int g = 0; g < 2; ++g)
        add_td(a, n, tile0, a.in[11] + (size_t)((j * 2 + dir) * 2 + g) * 16 * 4096, (bf16_t*)(ws + W_RGG) + (size_t)(j * 2 + dir) * 16 * 8192 + g * 4096, nullptr, 4096, 8192, 64, 64, 64, 16, 0);
    add_td(a, n, tile0, a.in[15], (bf16_t*)(ws + W_MDOWN), nullptr, 0, 0, 1024, 416, 512, 1, 0);
    add_td(a, n, tile0, a.in[18], (bf16_t*)(ws + W_MUQ), a.in[16], 0, 0, 256, 1536, 1536, 1, 0);
    add_td(a, n, tile0, a.in[19], (bf16_t*)(ws + W_MUKV), a.in[17], 0, 0, 128, 2048, 2048, 1, 0);
    add_td(a, n, tile0, a.in[21], (bf16_t*)(ws + W_MO), nullptr, 0, 0, 1024, 1024, 1024, 1, 0);
    add_td(a, n, tile0, a.in[22], (bf16_t*)(ws + W_MLIN), nullptr, 0, 0, 1024, 3088, 3200, 1, 0);
    add_td(a, n, tile0, a.in[25], (bf16_t*)(ws + W_MLOUT), nullptr, 0, 0, 1024, 1024, 1024, 1, 0);
    add_td(a, n, tile0, a.in[30], (bf16_t*)(ws + W_GU), nullptr, 1024L * 512, 512L * 1024, 1024, 512, 512, 256, 1);
    add_td(a, n, tile0, a.in[31], (bf16_t*)(ws + W_DN), nullptr, 256L * 1024, 1024L * 256, 256, 1024, 1024, 256, 0);
    a.ntiles_total = tile0;
    if (n != NTD) { fprintf(stderr, "kernel_launch: descriptor count %d != %d\n", n, NTD); return; }
#if MK_ONE_LAUNCH
    a.ph_lo = 0; a.ph_hi = NPH;
    hipLaunchKernelGGL(fwd, dim3(grid), dim3(NTHR), 0, stream, a);
#else
    for (int ph = 0; ph < NPH && ph <= DBG_STOP; ++ph) {
        a.ph_lo = ph; a.ph_hi = ph + 1;
        hipLaunchKernelGGL(fwd, dim3(grid), dim3(NTHR), 0, stream, a);
    }
    if (DBG_STOP < NPH) { a.ph_lo = 34; a.ph_hi = 35; hipLaunchKernelGGL(fwd, dim3(grid), dim3(NTHR), 0, stream, a); }
#endif
}
```

```cpp
#include <hip/hip_runtime.h>
#include <stdint.h>
#include <string.h>
#include <stdio.h>

#ifndef MK_ONE_LAUNCH
#define MK_ONE_LAUNCH 1
#endif

#define DI __device__ __forceinline__
typedef unsigned short bf16_t;
typedef __attribute__((ext_vector_type(8))) short bf16x8;
typedef __attribute__((ext_vector_type(4))) float f32x4;
typedef __attribute__((ext_vector_type(16))) float f32x16;
typedef __attribute__((ext_vector_type(2))) float f32x2;
typedef __attribute__((ext_vector_type(2))) __bf16 bfx2;
typedef __attribute__((ext_vector_type(4))) unsigned u32x4;
typedef __attribute__((ext_vector_type(2))) unsigned u32x2;

constexpr int D = 1024, NB = 8, SEQ = 2048, CTXL = 256;
constexpr int NLAT = NB * SEQ, NCTX = NB * CTXL, NTOK = NLAT + NCTX;
constexpr int NKEY = CTXL + SEQ;
constexpr int NTHR = 256;
constexpr int LDS_BYTES = 73728;
constexpr int LDS_AUX = 65536;
constexpr int LDS_BARW = LDS_BYTES - 16;
constexpr float EPS = 1e-6f;

constexpr size_t al256(size_t x) { return (x + 255) & ~(size_t)255; }
constexpr size_t WS_CTL = 0;
constexpr size_t CTL_BYTES = 65536;
constexpr size_t CTL_CNT = 16384;
constexpr size_t WS_MOD = WS_CTL + CTL_BYTES;
constexpr size_t WS_X = al256(WS_MOD + 4 * 9 * 6144 * 4);
constexpr size_t WS_H = al256(WS_X + (size_t)NTOK * D * 4);
constexpr size_t WS_SCR = al256(WS_H + (size_t)NTOK * D * 2);
constexpr size_t SCR_BYTES = (size_t)256 << 20;
constexpr size_t TOKD2 = (size_t)NTOK * D * 2;
constexpr size_t RG_G = WS_SCR, RG_U = RG_G + TOKD2, RG_HS = RG_U + TOKD2, RG_A2 = RG_HS + 2 * TOKD2;
constexpr size_t MLA_CQ = WS_SCR;
constexpr size_t MLA_CKV = MLA_CQ + (size_t)NTOK * 256 * 2;
constexpr size_t MLA_KR = MLA_CKV + (size_t)NTOK * 128 * 2;
constexpr size_t MLA_Q = MLA_KR + (size_t)NTOK * 32 * 4;
constexpr size_t MLA_K = MLA_Q + (size_t)NTOK * 1536 * 2;
constexpr size_t MLA_VT = MLA_K + (size_t)NB * 16 * NKEY * 96 * 2;
constexpr size_t MLA_O = MLA_VT + (size_t)NB * 16 * 64 * NKEY * 2;
constexpr size_t MLA_END = MLA_O + TOKD2;
constexpr size_t ML_Q = WS_SCR;
constexpr size_t ML_K = ML_Q + (size_t)NTOK * 512 * 2;
constexpr size_t ML_KT = ML_K + (size_t)NTOK * 512 * 2;
constexpr size_t ML_VT = ML_KT + (size_t)NTOK * 512 * 2;
constexpr size_t ML_OG = ML_VT + TOKD2;
constexpr size_t ML_GT = ML_OG + TOKD2;
constexpr size_t ML_HS = ML_GT + (size_t)NTOK * 16 * 4;
constexpr size_t ML_A2 = ML_HS + 2 * TOKD2;
constexpr size_t ML_END = ML_A2 + TOKD2;
static_assert(RG_A2 + TOKD2 <= WS_SCR + SCR_BYTES && MLA_END <= WS_SCR + SCR_BYTES && ML_END <= WS_SCR + SCR_BYTES, "scratch");
constexpr size_t WS_LIST = WS_SCR + SCR_BYTES;
constexpr size_t WS_WSLOT = al256(WS_LIST + (size_t)64 * NTOK * 4);
constexpr size_t WS_HMID = al256(WS_WSLOT + (size_t)2 * NTOK * 4);
constexpr size_t WS_Y = al256(WS_HMID + (size_t)2 * NTOK * 256 * 2);
constexpr size_t WS_W = al256(WS_Y + (size_t)2 * NTOK * D * 2);
constexpr size_t W_RGIN = WS_W;
constexpr size_t W_RGOUT = W_RGIN + (size_t)2 * 2048 * 1024 * 2;
constexpr size_t W_RGG = W_RGOUT + (size_t)2 * 1024 * 1024 * 2;
constexpr size_t W_MDOWN = W_RGG + (size_t)2 * 2 * 16 * 128 * 64 * 2;
constexpr size_t W_MUQ = W_MDOWN + (size_t)512 * 1024 * 2;
constexpr size_t W_MUKV = W_MUQ + (size_t)1536 * 256 * 2;
constexpr size_t W_MO = W_MUKV + (size_t)2048 * 128 * 2;
constexpr size_t W_MLIN = W_MO + (size_t)1024 * 1024 * 2;
constexpr size_t W_MLOUT = W_MLIN + (size_t)3200 * 1024 * 2;
constexpr size_t W_RT = W_MLOUT + (size_t)1024 * 1024 * 2;
constexpr size_t W_GU = al256(W_RT + (size_t)4 * 2 * 80 * 1024 * 2);
constexpr size_t W_DN = W_GU + (size_t)256 * 512 * 1024 * 2;
constexpr size_t WS_END = W_DN + (size_t)256 * 1024 * 256 * 2;

struct TDesc {
    const float* src; bf16_t* dst; const float* rscale;
    long sb, db;
    int K, N, Npad, batch;
    int perm, tiles_k, tiles_n, tile0;
};
constexpr int NTD = 18;
struct Args {
    const float* in[32];
    float* out;
    unsigned char* ws;
    TDesc td[NTD];
    int ntiles_total, ph_lo, ph_hi, pad0;
};

DI float bf2f(bf16_t v) { return __uint_as_float((unsigned)v << 16); }
DI unsigned pk2(float a, float b) { f32x2 v = {a, b}; bfx2 r = __builtin_convertvector(v, bfx2); return __builtin_bit_cast(unsigned, r); }
DI bf16_t f2bf(float a) { return (bf16_t)(pk2(a, 0.f) & 0xffffu); }
DI float lof(unsigned u) { return __uint_as_float(u << 16); }
DI float hif(unsigned u) { return __uint_as_float(u & 0xffff0000u); }
DI float rcpf_(float x) { return __builtin_amdgcn_rcpf(x); }
DI float sigmoidf_(float x) { return rcpf_(1.f + __expf(-x)); }
DI float gelu_tanh(float x) { float u = 0.7978845608028654f * (x + 0.044715f * x * x * x); float e = __expf(2.f * u); return x * (1.f - rcpf_(e + 1.f)); }
DI int tok_modrow(int t) { return t < NLAT ? (t >> 11) : 8; }
DI void dma16(const void* g, char* l) { __builtin_amdgcn_global_load_lds((const unsigned*)g, (unsigned*)l, 16, 0, 0); }
DI void wait_vm0() { asm volatile("s_waitcnt vmcnt(0)" ::: "memory"); }
DI int swz128(int row, int chunk) { return row * 128 + ((chunk ^ (row & 7)) << 4); }
DI int swz256(int row, int chunk) { return row * 256 + ((chunk ^ (row & 15)) << 4); }
DI f32x4 mfma16(bf16x8 a, bf16x8 b, f32x4 c) { return __builtin_amdgcn_mfma_f32_16x16x32_bf16(a, b, c, 0, 0, 0); }
DI f32x16 mfma32(bf16x8 a, bf16x8 b, f32x16 c) { return __builtin_amdgcn_mfma_f32_32x32x16_bf16(a, b, c, 0, 0, 0); }
DI bf16x8 ldsv8(const char* p) { return *(const bf16x8*)p; }
DI void st_bf4(bf16_t* p, const f32x4 v) { u32x2 o; o[0] = pk2(v[0], v[1]); o[1] = pk2(v[2], v[3]); *(u32x2*)p = o; }

__shared__ __attribute__((aligned(16))) char lds[LDS_BYTES];

#define XB_TMO      128
#define XB_XCNT(j)  (256  + 64 * (j))
#define XB_XSUB(j)  (1280 + 64 * (j))
#define XB_XGEN(j)  (2304 + 64 * (j))
#define XB_TOP      3328
#define XB_TOPGEN   3392
#define XCD_BAR_WORDS 3456
#define XB_SPIN_CAP (1u << 22)
#define LAS __attribute__((address_space(3)))
DI unsigned xb_ld(unsigned* p)              { return __hip_atomic_load(p, __ATOMIC_RELAXED, __HIP_MEMORY_SCOPE_AGENT); }
DI unsigned xb_add(unsigned* p, unsigned v) { return __hip_atomic_fetch_add(p, v, __ATOMIC_RELAXED, __HIP_MEMORY_SCOPE_AGENT); }
DI unsigned xb_xcc_id() { return (unsigned)__builtin_amdgcn_s_getreg((3 << 11) | 20) & 0xFu; }
#define XB_SPIN(cond, bar) do { unsigned _sp = 0; while (cond) { __builtin_amdgcn_s_sleep(1); \
    if ((++_sp & 255u) == 0u) { if (xb_ld(&(bar)[XB_TMO])) break; if (_sp > XB_SPIN_CAP) { atomicAdd(&(bar)[XB_TMO], 1u); break; } } } } while (0)
struct XcdBarrier { unsigned* bar; unsigned x; volatile LAS unsigned* st; };
DI XcdBarrier xcd_barrier_post(unsigned* bar, volatile LAS unsigned* st) {
    XcdBarrier b; b.bar = bar; b.x = xb_xcc_id(); b.st = st;
    if (threadIdx.x == 0) (void)xb_add(&bar[XB_XCNT(b.x)], 1u);
    return b;
}
DI void xcd_barrier_complete(unsigned* bar, unsigned x, unsigned& nloc, unsigned& nx) {
    const unsigned G = gridDim.x * gridDim.y * gridDim.z;
    unsigned sum, cnt, mine, sp = 0u;
    for (;;) {
        sum = 0u; cnt = 0u; mine = 0u;
#pragma unroll
        for (unsigned j = 0; j < 16; ++j) { const unsigned c = xb_ld(&bar[XB_XCNT(j)]); sum += c; cnt += (c > 0u) ? 1u : 0u; mine = (j == x) ? c : mine; }
        if (sum == G) break;
        __builtin_amdgcn_s_sleep(1);
        if ((++sp & 255u) == 0u) { if (xb_ld(&bar[XB_TMO])) break; if (sp > XB_SPIN_CAP) { atomicAdd(&bar[XB_TMO], 1u); break; } }
    }
    nloc = mine > 0u ? mine : 1u; nx = cnt > 0u ? cnt : 1u;
}
DI void xcd_barrier(const XcdBarrier& b) {
    asm volatile("s_waitcnt vmcnt(0)" ::: "memory");
    __syncthreads();
    if (threadIdx.x == 0) {
        unsigned* bar = b.bar;
        __builtin_amdgcn_s_waitcnt(0);
        unsigned nloc = b.st[0], nx = b.st[1];
        if (nloc == 0u) { xcd_barrier_complete(bar, b.x, nloc, nx); b.st[0] = nloc; b.st[1] = nx; }
        const unsigned old = xb_add(&bar[XB_XSUB(b.x)], 1u);
        const unsigned gen = old / nloc;
        if (old + 1u == (gen + 1u) * nloc) {
            __builtin_amdgcn_fence(__ATOMIC_RELEASE, "agent");
            asm volatile("s_waitcnt vmcnt(0)" ::: "memory");
            const unsigned og = xb_add(&bar[XB_TOP], 1u);
            const unsigned tg = og / nx;
            if (og + 1u == (tg + 1u) * nx) xb_add(&bar[XB_TOPGEN], 1u);
            else XB_SPIN(xb_ld(&bar[XB_TOPGEN]) == tg, bar);
            __builtin_amdgcn_fence(__ATOMIC_ACQUIRE, "agent");
            xb_add(&bar[XB_XGEN(b.x)], 1u);
            asm volatile("s_waitcnt vmcnt(0)" ::: "memory");
        } else {
            XB_SPIN(xb_ld(&bar[XB_XGEN(b.x)]) == gen, bar);
            __builtin_amdgcn_fence(__ATOMIC_ACQUIRE, "agent");
            asm volatile("s_waitcnt vmcnt(0)" ::: "memory");
        }
    }
    __syncthreads();
}

DI void phase_prologue(const Args& a) {
    const int tid = threadIdx.x;
    const int n_ada = 96, n_rt = 4;
    const int total = n_ada + n_rt + a.ntiles_total;
    float* sc = (float*)lds;
    for (int u = blockIdx.x; u < total; u += gridDim.x) {
        __syncthreads();
        if (u < n_ada) {
            const float* c = a.in[1]; const float* cc = a.in[3];
            for (int i = tid; i < 9 * 1024; i += NTHR) {
                float v = i < 8192 ? c[i] : cc[i - 8192];
                sc[i] = v / (1.f + __expf(-v));
            }
            __syncthreads();
            const int n = u * 256 + tid, li = n / 6144, nn = n - li * 6144;
            const float* w = a.in[4] + (size_t)li * 1024 * 6144 + nn;
            float acc[9];
#pragma unroll
            for (int r = 0; r < 9; ++r) acc[r] = 0.f;
            const float* wp = w;
#pragma unroll 1
            for (int k0 = 0; k0 < 1024; k0 += 16) {
                float wv[16];
#pragma unroll
                for (int kk = 0; kk < 16; ++kk) { wv[kk] = *wp; wp += 6144; }
#pragma unroll
                for (int kk = 0; kk < 16; kk += 4)
#pragma unroll
                    for (int r = 0; r < 9; ++r) {
                        const f32x4 s4 = *(const f32x4*)(sc + r * 1024 + k0 + kk);
                        acc[r] += s4[0] * wv[kk] + s4[1] * wv[kk + 1] + s4[2] * wv[kk + 2] + s4[3] * wv[kk + 3];
                    }
            }
            const float bias = a.in[5][li * 6144 + nn];
            float* mod = (float*)(a.ws + WS_MOD) + (size_t)li * 9 * 6144 + nn;
#pragma unroll
            for (int r = 0; r < 9; ++r) mod[(size_t)r * 6144] = acc[r] + bias;
        } else if (u < n_ada + n_rt) {
            const int li = u - n_ada;
            bf16_t* rt = (bf16_t*)(a.ws + W_RT) + (size_t)li * 2 * 80 * 1024;
            const float* wg = a.in[26] + (size_t)li * 1024 * 8;
            const float* we = a.in[28] + (size_t)li * 1024 * 64;
            for (int i = tid; i < 80 * 1024; i += NTHR) {
                const int n = i >> 10, k = i & 1023;
                float v = n < 8 ? wg[k * 8 + n] : (n < 72 ? we[k * 64 + (n - 8)] : 0.f);
                const bf16_t h = f2bf(v);
                rt[i] = h;
                rt[80 * 1024 + i] = f2bf(v - bf2f(h));
            }
        } else {
            const int tix = u - n_ada - n_rt;
            int di = 0;
#pragma unroll 1
            for (int i = 1; i < NTD; ++i) if (tix >= a.td[i].tile0) di = i;
            const TDesc& td = a.td[di];
            int rem = tix - td.tile0;
            const int per = td.tiles_k * td.tiles_n;
            const int bi = rem / per; rem -= bi * per;
            const int tk = rem % td.tiles_k, tn = rem / td.tiles_k;
            const float* src = td.src + (size_t)bi * td.sb;
            bf16_t* dst = td.dst + (size_t)bi * td.db;
            const int k0 = tk * 128, n0 = tn * 64;
            const int c4 = tid & 15, kr = tid >> 4;
            const int N = td.N, K = td.K;
            f32x4 L0[4], L1[4];
            const bool nok = n0 + 4 * c4 < N;
#pragma unroll
            for (int i = 0; i < 4; ++i) {
                const int k = k0 + 32 * i + 2 * kr;
                L0[i] = (f32x4){0.f, 0.f, 0.f, 0.f}; L1[i] = L0[i];
                if (nok && k < K) {
                    L0[i] = *(const f32x4*)(src + (size_t)k * N + n0 + 4 * c4);
                    L1[i] = *(const f32x4*)(src + (size_t)(k + 1) * N + n0 + 4 * c4);
                    if (td.rscale) { L0[i] *= td.rscale[k]; L1[i] *= td.rscale[k + 1]; }
                }
            }
            unsigned* st = (unsigned*)lds;
#pragma unroll
            for (int i = 0; i < 4; ++i) {
                const int kp = 16 * i + kr;
#pragma unroll
                for (int j = 0; j < 4; ++j) st[(4 * c4 + j) * 68 + kp] = pk2(L0[i][j], L1[i][j]);
            }
            __syncthreads();
#pragma unroll
            for (int i = 0; i < 4; ++i) {
                const int id = tid + i * 256, n = id >> 4, kc = id & 15;
                const u32x4 o = *(const u32x4*)(st + n * 68 + kc * 4);
                int nd = n0 + n;
                if (nd < td.Npad && k0 + kc * 8 < K) {
                    if (td.perm) { const int c = nd & 255, up = nd >> 8; nd = ((c >> 4) << 5) + (up << 4) + (c & 15); }
                    *(u32x4*)(dst + (size_t)nd * K + k0 + kc * 8) = o;
                }
            }
        }
    }
}

template <int MODE>
DI void phase_token(const Args& a, const int li) {
    const int tid = threadIdx.x, lane = tid & 63, wave = tid >> 6;
    const int r = lane & 15, q = lane >> 4;
    float* X = (float*)(a.ws + WS_X);
    bf16_t* H = (bf16_t*)(a.ws + WS_H);
    const bf16_t* Y = (const bf16_t*)(a.ws + WS_Y);
    const float* MOD = (const float*)(a.ws + WS_MOD);
    const bool combine = (MODE == 0 && li > 0) || MODE == 2;
    const int ngroups = (MODE == 2 || (MODE == 1 && li == 3)) ? NLAT / 16 : NTOK / 16;
    float* lg = (float*)(lds + wave * 16 * 80 * 4);
    for (int g = blockIdx.x * 4 + wave; g < ngroups; g += gridDim.x * 4) {
        const int t = g * 16 + r;
        const int mr = tok_modrow(g * 16);
        const float* xsrc = (MODE == 0 && li == 0) ? (t < NLAT ? a.in[0] + (size_t)t * D : a.in[2] + (size_t)(t - NLAT) * D) : X + (size_t)t * D;
        const bf16_t* y0 = Y + (size_t)(2 * t) * D;
        const bf16_t* y1 = y0 + D;
        const int lprev = MODE == 2 ? 3 : li - 1;
        const float* g5 = MOD + ((size_t)(lprev < 0 ? 0 : lprev) * 9 + mr) * 6144 + 5 * 1024;
        float ss = 0.f;
        if (MODE != 2) {
#pragma unroll 4
            for (int kk = 0; kk < 32; ++kk) {
                const int k = kk * 32 + q * 8;
                f32x4 x0 = *(const f32x4*)(xsrc + k), x1 = *(const f32x4*)(xsrc + k + 4);
                if (combine) {
                    const u32x4 ya = *(const u32x4*)(y0 + k), yb = *(const u32x4*)(y1 + k);
                    const f32x4 ga = *(const f32x4*)(g5 + k), gb = *(const f32x4*)(g5 + k + 4);
                    x0[0] += ga[0] * (lof(ya[0]) + lof(yb[0])); x0[1] += ga[1] * (hif(ya[0]) + hif(yb[0]));
                    x0[2] += ga[2] * (lof(ya[1]) + lof(yb[1])); x0[3] += ga[3] * (hif(ya[1]) + hif(yb[1]));
                    x1[0] += gb[0] * (lof(ya[2]) + lof(yb[2])); x1[1] += gb[1] * (hif(ya[2]) + hif(yb[2]));
                    x1[2] += gb[2] * (lof(ya[3]) + lof(yb[3])); x1[3] += gb[3] * (hif(ya[3]) + hif(yb[3]));
                }
#pragma unroll
                for (int j = 0; j < 4; ++j) ss += x0[j] * x0[j] + x1[j] * x1[j];
            }
            ss += __shfl_xor(ss, 16); ss += __shfl_xor(ss, 32);
        }
        const float rstd = rsqrtf(ss * (1.f / 1024.f) + EPS);
        const float* gn = (MODE == 1 ? a.in[7] : a.in[6]) + (size_t)li * D;
        const float* mscale = MOD + ((size_t)li * 9 + mr) * 6144 + (MODE == 1 ? 4 : 1) * 1024;
        const float* mshift = MOD + ((size_t)li * 9 + mr) * 6144 + (MODE == 1 ? 3 : 0) * 1024;
        const bf16_t* rwh = (const bf16_t*)(a.ws + W_RT) + (size_t)li * 2 * 80 * 1024 + (size_t)r * 1024 + q * 8;
        f32x4 lacc[5];
#pragma unroll
        for (int i = 0; i < 5; ++i) lacc[i] = (f32x4){0.f, 0.f, 0.f, 0.f};
#pragma unroll 2
        for (int kk = 0; kk < 32; ++kk) {
            const int k = kk * 32 + q * 8;
            f32x4 x0 = *(const f32x4*)(xsrc + k), x1 = *(const f32x4*)(xsrc + k + 4);
            if (combine) {
                const u32x4 ya = *(const u32x4*)(y0 + k), yb = *(const u32x4*)(y1 + k);
                const f32x4 ga = *(const f32x4*)(g5 + k), gb = *(const f32x4*)(g5 + k + 4);
                x0[0] += ga[0] * (lof(ya[0]) + lof(yb[0])); x0[1] += ga[1] * (hif(ya[0]) + hif(yb[0]));
                x0[2] += ga[2] * (lof(ya[1]) + lof(yb[1])); x0[3] += ga[3] * (hif(ya[1]) + hif(yb[1]));
                x1[0] += gb[0] * (lof(ya[2]) + lof(yb[2])); x1[1] += gb[1] * (hif(ya[2]) + hif(yb[2]));
                x1[2] += gb[2] * (lof(ya[3]) + lof(yb[3])); x1[3] += gb[3] * (hif(ya[3]) + hif(yb[3]));
            }
            if (MODE == 2) {
                *(f32x4*)(a.out + (size_t)t * D + k) = x0; *(f32x4*)(a.out + (size_t)t * D + k + 4) = x1;
                continue;
            }
            if (MODE == 0 && (li == 0 || combine)) { *(f32x4*)(X + (size_t)t * D + k) = x0; *(f32x4*)(X + (size_t)t * D + k + 4) = x1; }
            const f32x4 n0 = *(const f32x4*)(gn + k), n1 = *(const f32x4*)(gn + k + 4);
            const f32x4 s0 = *(const f32x4*)(mscale + k), s1 = *(const f32x4*)(mscale + k + 4);
            const f32x4 h0 = *(const f32x4*)(mshift + k), h1 = *(const f32x4*)(mshift + k + 4);
            float f[8];
#pragma unroll
            for (int j = 0; j < 4; ++j) {
                f[j] = x0[j] * rstd * n0[j] * (1.f + s0[j]) + h0[j];
                f[4 + j] = x1[j] * rstd * n1[j] * (1.f + s1[j]) + h1[j];
            }
            u32x4 hv;
            hv[0] = pk2(f[0], f[1]); hv[1] = pk2(f[2], f[3]); hv[2] = pk2(f[4], f[5]); hv[3] = pk2(f[6], f[7]);
            *(u32x4*)(H + (size_t)t * D + k) = hv;
            if (MODE == 1) {
                u32x4 lv;
                lv[0] = pk2(f[0] - lof(hv[0]), f[1] - hif(hv[0])); lv[1] = pk2(f[2] - lof(hv[1]), f[3] - hif(hv[1]));
                lv[2] = pk2(f[4] - lof(hv[2]), f[5] - hif(hv[2])); lv[3] = pk2(f[6] - lof(hv[3]), f[7] - hif(hv[3]));
                const bf16x8 fh = __builtin_bit_cast(bf16x8, hv), fl = __builtin_bit_cast(bf16x8, lv);
#pragma unroll
                for (int nt = 0; nt < 5; ++nt) {
                    const bf16x8 wh = *(const bf16x8*)(rwh + (size_t)nt * 16 * 1024 + kk * 32);
                    const bf16x8 wl = *(const bf16x8*)(rwh + (size_t)(80 + nt * 16) * 1024 + kk * 32);
                    lacc[nt] = mfma16(fh, wh, lacc[nt]);
                    lacc[nt] = mfma16(fh, wl, lacc[nt]);
                    lacc[nt] = mfma16(fl, wh, lacc[nt]);
                }
            }
        }
        if (MODE == 1) {
#pragma unroll
            for (int nt = 0; nt < 5; ++nt)
#pragma unroll
                for (int j = 0; j < 4; ++j) lg[(q * 4 + j) * 80 + nt * 16 + r] = lacc[nt][j];
            asm volatile("s_waitcnt lgkmcnt(0)" ::: "memory");
            __builtin_amdgcn_wave_barrier();
            if (lane < 16) {
                const float* L = lg + lane * 80;
                const float* bg = a.in[27] + li * 8;
                const float* be = a.in[29] + li * 64;
                float gmax = -3.0e38f; int gi = 0; float gl[8];
#pragma unroll
                for (int j = 0; j < 8; ++j) { gl[j] = L[j] + bg[j]; if (gl[j] > gmax) { gmax = gl[j]; gi = j; } }
                float ps = 0.f;
#pragma unroll
                for (int j = 0; j < 8; ++j) ps += __expf(gl[j] - gmax);
                const float ptop = 1.f / ps;
                float e1 = -3.0e38f, e2 = -3.0e38f; int i1 = 0, i2 = 0;
#pragma unroll
                for (int j = 0; j < 8; ++j) {
                    const float v = L[8 + gi * 8 + j] + be[gi * 8 + j];
                    if (v > e1) { e2 = e1; i2 = i1; e1 = v; i1 = j; } else if (v > e2) { e2 = v; i2 = j; }
                }
                const float ex = __expf(e2 - e1);
                const float w1 = ptop / (1.f + ex), w2 = ptop * ex / (1.f + ex);
                const int tt = g * 16 + lane;
                int* cnt = (int*)(a.ws + WS_CTL + CTL_CNT) + li * 64;
                int* list = (int*)(a.ws + WS_LIST);
                float* wsl = (float*)(a.ws + WS_WSLOT);
                const int ea = gi * 8 + i1, eb = gi * 8 + i2;
                const int pa = atomicAdd(&cnt[ea], 1); list[(size_t)ea * NTOK + pa] = 2 * tt; wsl[2 * tt] = w1;
                const int pb = atomicAdd(&cnt[eb], 1); list[(size_t)eb * NTOK + pb] = 2 * tt + 1; wsl[2 * tt + 1] = w2;
            }
            __builtin_amdgcn_wave_barrier();
        }
    }
}

DI float wave_sum(float v) {
    v += __shfl_xor(v, 1); v += __shfl_xor(v, 2); v += __shfl_xor(v, 4); v += __shfl_xor(v, 8); v += __shfl_xor(v, 16); v += __shfl_xor(v, 32);
    return v;
}
template <int MODE>
DI void phase_token_row(const Args& a, const int li) {
    const int tid = threadIdx.x, lane = tid & 63, wave = tid >> 6;
    float* X = (float*)(a.ws + WS_X);
    bf16_t* H = (bf16_t*)(a.ws + WS_H);
    const bf16_t* Y = (const bf16_t*)(a.ws + WS_Y);
    const float* MOD = (const float*)(a.ws + WS_MOD);
    const bool combine = MODE == 2 || li > 0;
    const bool first = MODE == 0 && li == 0;
    const int npairs = (MODE == 2 ? NLAT : NTOK) / 2;
    const int lprev = MODE == 2 ? 3 : (li > 0 ? li - 1 : 0);
    const float* gn = a.in[6] + (size_t)li * D;
    for (int p = blockIdx.x * 4 + wave; p < npairs; p += gridDim.x * 4) {
        const int t0 = 2 * p, mr = tok_modrow(t0);
        f32x4 x[2][4];
#pragma unroll
        for (int i = 0; i < 2; ++i) {
            const int t = t0 + i;
            const float* xs = first ? (t < NLAT ? a.in[0] + (size_t)t * D : a.in[2] + (size_t)(t - NLAT) * D) : X + (size_t)t * D;
#pragma unroll
            for (int j = 0; j < 4; ++j) x[i][j] = *(const f32x4*)(xs + 256 * j + 4 * lane);
        }
        if (combine) {
            const float* g5 = MOD + ((size_t)lprev * 9 + mr) * 6144 + 5 * 1024;
            f32x4 g[4];
#pragma unroll
            for (int j = 0; j < 4; ++j) g[j] = *(const f32x4*)(g5 + 256 * j + 4 * lane);
#pragma unroll
            for (int i = 0; i < 2; ++i) {
                const bf16_t* y0 = Y + (size_t)(2 * (t0 + i)) * D;
#pragma unroll
                for (int j = 0; j < 4; ++j) {
                    const u32x2 ya = *(const u32x2*)(y0 + 256 * j + 4 * lane), yb = *(const u32x2*)(y0 + D + 256 * j + 4 * lane);
                    x[i][j][0] += g[j][0] * (lof(ya[0]) + lof(yb[0])); x[i][j][1] += g[j][1] * (hif(ya[0]) + hif(yb[0]));
                    x[i][j][2] += g[j][2] * (lof(ya[1]) + lof(yb[1])); x[i][j][3] += g[j][3] * (hif(ya[1]) + hif(yb[1]));
                }
            }
        }
        if (MODE == 2) {
#pragma unroll
            for (int i = 0; i < 2; ++i)
#pragma unroll
                for (int j = 0; j < 4; ++j) *(f32x4*)(a.out + (size_t)(t0 + i) * D + 256 * j + 4 * lane) = x[i][j];
            continue;
        }
        float rstd[2];
#pragma unroll
        for (int i = 0; i < 2; ++i) {
            float ss = 0.f;
#pragma unroll
            for (int j = 0; j < 4; ++j) ss += x[i][j][0] * x[i][j][0] + x[i][j][1] * x[i][j][1] + x[i][j][2] * x[i][j][2] + x[i][j][3] * x[i][j][3];
            rstd[i] = rsqrtf(wave_sum(ss) * (1.f / 1024.f) + EPS);
        }
        const float* msc = MOD + ((size_t)li * 9 + mr) * 6144 + 1 * 1024;
        const float* msh = MOD + ((size_t)li * 9 + mr) * 6144;
#pragma unroll
        for (int j = 0; j < 4; ++j) {
            const f32x4 n4 = *(const f32x4*)(gn + 256 * j + 4 * lane), s4 = *(const f32x4*)(msc + 256 * j + 4 * lane), h4 = *(const f32x4*)(msh + 256 * j + 4 * lane);
            const f32x4 gs = n4 * (s4 + 1.f);
#pragma unroll
            for (int i = 0; i < 2; ++i) {
                const f32x4 f = x[i][j] * rstd[i] * gs + h4;
                st_bf4(H + (size_t)(t0 + i) * D + 256 * j + 4 * lane, f);
                if (first || combine) *(f32x4*)(X + (size_t)(t0 + i) * D + 256 * j + 4 * lane) = x[i][j];
            }
        }
    }
}

DI void phase_token_router(const Args& a, const int li) {
    const int tid = threadIdx.x, lane = tid & 63, wave = tid >> 6;
    const int r = lane & 15, q = lane >> 4;
    const float* X = (const float*)(a.ws + WS_X);
    bf16_t* H = (bf16_t*)(a.ws + WS_H);
    const float* MOD = (const float*)(a.ws + WS_MOD);
    const float* gn = a.in[7] + (size_t)li * D;
    const int ngroups = (li == 3 ? NLAT : NTOK) / 16;
    char* sHi = lds; char* sLo = lds + 32768;
    float* sP = (float*)lds;
    float* sL = (float*)(lds + 32768);
    const bf16_t* rwh = (const bf16_t*)(a.ws + W_RT) + (size_t)li * 2 * 80 * 1024 + (size_t)r * 1024 + q * 8;
    for (int g = blockIdx.x; g < ngroups; g += gridDim.x) {
        const int mr = tok_modrow(g * 16);
        const float* msc = MOD + ((size_t)li * 9 + mr) * 6144 + 4 * 1024;
        const float* msh = MOD + ((size_t)li * 9 + mr) * 6144 + 3 * 1024;
        __syncthreads();
        {
            f32x4 x[4][4];
#pragma unroll
            for (int i = 0; i < 4; ++i)
#pragma unroll
                for (int j = 0; j < 4; ++j) x[i][j] = *(const f32x4*)(X + (size_t)(g * 16 + wave * 4 + i) * D + 256 * j + 4 * lane);
            float rstd[4];
#pragma unroll
            for (int i = 0; i < 4; ++i) {
                float ss = 0.f;
#pragma unroll
                for (int j = 0; j < 4; ++j) ss += x[i][j][0] * x[i][j][0] + x[i][j][1] * x[i][j][1] + x[i][j][2] * x[i][j][2] + x[i][j][3] * x[i][j][3];
                rstd[i] = rsqrtf(wave_sum(ss) * (1.f / 1024.f) + EPS);
            }
#pragma unroll
            for (int j = 0; j < 4; ++j) {
                const f32x4 n4 = *(const f32x4*)(gn + 256 * j + 4 * lane), s4 = *(const f32x4*)(msc + 256 * j + 4 * lane), h4 = *(const f32x4*)(msh + 256 * j + 4 * lane);
                const f32x4 gs = n4 * (s4 + 1.f);
#pragma unroll
                for (int i = 0; i < 4; ++i) {
                    const int row = wave * 4 + i;
                    const f32x4 f = x[i][j] * rstd[i] * gs + h4;
                    u32x2 hv; hv[0] = pk2(f[0], f[1]); hv[1] = pk2(f[2], f[3]);
                    u32x2 lv; lv[0] = pk2(f[0] - lof(hv[0]), f[1] - hif(hv[0])); lv[1] = pk2(f[2] - lof(hv[1]), f[3] - hif(hv[1]));
                    *(u32x2*)(H + (size_t)(g * 16 + row) * D + 256 * j + 4 * lane) = hv;
                    const int off = row * 2048 + (((32 * j + (lane >> 1)) ^ row) << 4) + (lane & 1) * 8;
                    *(u32x2*)(sHi + off) = hv; *(u32x2*)(sLo + off) = lv;
                }
            }
        }
        __syncthreads();
        f32x4 lacc[5];
#pragma unroll
        for (int i = 0; i < 5; ++i) lacc[i] = (f32x4){0.f, 0.f, 0.f, 0.f};
#pragma unroll 2
        for (int s = 0; s < 8; ++s) {
            const int kk = wave * 8 + s;
            const int off = r * 2048 + (((kk * 4 + q) ^ r) << 4);
            const bf16x8 fh = ldsv8(sHi + off), fl = ldsv8(sLo + off);
#pragma unroll
            for (int nt = 0; nt < 5; ++nt) {
                const bf16x8 wh = *(const bf16x8*)(rwh + (size_t)nt * 16 * 1024 + kk * 32);
                const bf16x8 wl = *(const bf16x8*)(rwh + (size_t)(80 + nt * 16) * 1024 + kk * 32);
                lacc[nt] = mfma16(fh, wh, lacc[nt]);
                lacc[nt] = mfma16(fh, wl, lacc[nt]);
                lacc[nt] = mfma16(fl, wh, lacc[nt]);
            }
        }
        __syncthreads();
#pragma unroll
        for (int nt = 0; nt < 5; ++nt)
#pragma unroll
            for (int j = 0; j < 4; ++j) sP[(wave * 16 + q * 4 + j) * 80 + nt * 16 + r] = lacc[nt][j];
        __syncthreads();
        for (int i = tid; i < 16 * 80; i += NTHR) sL[i] = sP[i] + sP[1280 + i] + sP[2560 + i] + sP[3840 + i];
        __syncthreads();
        if (tid < 16) {
            const float* L = sL + tid * 80;
            const float* bg = a.in[27] + li * 8;
            const float* be = a.in[29] + li * 64;
            float gmax = -3.0e38f; int gi = 0; float gl[8];
#pragma unroll
            for (int j = 0; j < 8; ++j) { gl[j] = L[j] + bg[j]; if (gl[j] > gmax) { gmax = gl[j]; gi = j; } }
            float ps = 0.f;
#pragma unroll
            for (int j = 0; j < 8; ++j) ps += __expf(gl[j] - gmax);
            const float ptop = 1.f / ps;
            float e1 = -3.0e38f, e2 = -3.0e38f; int i1 = 0, i2 = 0;
#pragma unroll
            for (int j = 0; j < 8; ++j) {
                const float v = L[8 + gi * 8 + j] + be[gi * 8 + j];
                if (v > e1) { e2 = e1; i2 = i1; e1 = v; i1 = j; } else if (v > e2) { e2 = v; i2 = j; }
            }
            const float ex = __expf(e2 - e1);
            const float w1 = ptop / (1.f + ex), w2 = ptop * ex / (1.f + ex);
            const int tt = g * 16 + tid;
            int* cnt = (int*)(a.ws + WS_CTL + CTL_CNT) + li * 64;
            int* list = (int*)(a.ws + WS_LIST);
            float* wsl = (float*)(a.ws + WS_WSLOT);
            const int ea = gi * 8 + i1, eb = gi * 8 + i2;
            const int pa = atomicAdd(&cnt[ea], 1); list[(size_t)ea * NTOK + pa] = 2 * tt; wsl[2 * tt] = w1;
            const int pb = atomicAdd(&cnt[eb], 1); list[(size_t)eb * NTOK + pb] = 2 * tt + 1; wsl[2 * tt + 1] = w2;
        }
    }
}

template <int WM, int WN, int MT, int NT, bool PFALL = true, class AP>
DI void gemm_tile(AP arow, const bf16_t* Bt, const int ldb, const int K, f32x4 (&acc)[MT][NT]) {
    constexpr int BM = WM * MT * 16, BN = WN * NT * 16;
    constexpr int A_BYTES = BM * 128, B_BYTES = BN * 128, STAGE = A_BYTES + B_BYTES;
    constexpr int ACH = BM * 8 / NTHR, BCH = BN * 8 / NTHR;
    static_assert(2 * STAGE <= LDS_AUX, "gemm LDS");
    const int tid = threadIdx.x, lane = tid & 63, wave = tid >> 6;
    const int wm = wave / WN, wn = wave % WN;
    const int fr = lane & 15, fq = lane >> 4;
    const bf16_t* ap[ACH]; const bf16_t* bp[BCH];
#pragma unroll
    for (int i = 0; i < ACH; ++i) { const int idx = tid + i * NTHR, row = idx >> 3, c = (idx & 7) ^ (row & 7); ap[i] = arow(row) + c * 8; }
#pragma unroll
    for (int i = 0; i < BCH; ++i) { const int idx = tid + i * NTHR, row = idx >> 3, c = (idx & 7) ^ (row & 7); bp[i] = Bt + (size_t)row * ldb + c * 8; }
#pragma unroll
    for (int i = 0; i < MT; ++i)
#pragma unroll
        for (int j = 0; j < NT; ++j) acc[i][j] = (f32x4){0.f, 0.f, 0.f, 0.f};
    const int KT = K >> 6;
    {
        char* sa = lds; char* sb = lds + A_BYTES;
#pragma unroll
        for (int i = 0; i < ACH; ++i) dma16(ap[i], sa + (tid + i * NTHR) * 16);
#pragma unroll
        for (int i = 0; i < BCH; ++i) dma16(bp[i], sb + (tid + i * NTHR) * 16);
    }
#pragma unroll 1
    for (int kt = 0; kt < KT; ++kt) {
        wait_vm0();
        __syncthreads();
        if (kt + 1 < KT) {
            char* sa = lds + ((kt + 1) & 1) * STAGE; char* sb = sa + A_BYTES;
            const int ko = (kt + 1) * 64;
#pragma unroll
            for (int i = 0; i < ACH; ++i) dma16(ap[i] + ko, sa + (tid + i * NTHR) * 16);
#pragma unroll
            for (int i = 0; i < BCH; ++i) dma16(bp[i] + ko, sb + (tid + i * NTHR) * 16);
        }
        const char* sa = lds + (kt & 1) * STAGE; const char* sb = sa + A_BYTES;
        if (PFALL) {
            bf16x8 xf[2][MT], wf[2][NT];
#pragma unroll
            for (int kk = 0; kk < 2; ++kk) {
#pragma unroll
                for (int i = 0; i < MT; ++i) xf[kk][i] = ldsv8(sa + swz128(wm * MT * 16 + i * 16 + fr, kk * 4 + fq));
#pragma unroll
                for (int j = 0; j < NT; ++j) wf[kk][j] = ldsv8(sb + swz128(wn * NT * 16 + j * 16 + fr, kk * 4 + fq));
            }
            __builtin_amdgcn_sched_barrier(0);
            __builtin_amdgcn_s_setprio(1);
#pragma unroll
            for (int kk = 0; kk < 2; ++kk)
#pragma unroll
                for (int i = 0; i < MT; ++i)
#pragma unroll
                    for (int j = 0; j < NT; ++j) acc[i][j] = mfma16(wf[kk][j], xf[kk][i], acc[i][j]);
            __builtin_amdgcn_s_setprio(0);
        } else {
#pragma unroll
            for (int kk = 0; kk < 2; ++kk) {
                bf16x8 xf[MT], wf[NT];
#pragma unroll
                for (int i = 0; i < MT; ++i) xf[i] = ldsv8(sa + swz128(wm * MT * 16 + i * 16 + fr, kk * 4 + fq));
#pragma unroll
                for (int j = 0; j < NT; ++j) wf[j] = ldsv8(sb + swz128(wn * NT * 16 + j * 16 + fr, kk * 4 + fq));
#pragma unroll
                for (int i = 0; i < MT; ++i)
#pragma unroll
                    for (int j = 0; j < NT; ++j) acc[i][j] = mfma16(wf[j], xf[i], acc[i][j]);
            }
        }
    }
    __syncthreads();
}


struct GemmPipe {
    static constexpr int A_BYTES = 128 * 128, STAGE = 2 * A_BYTES;
    const bf16_t* ap[4]; const bf16_t* bp[4];
    template <class AP>
    DI void setup(AP arow, const bf16_t* Bt, const int ldb) {
        const int tid = threadIdx.x;
#pragma unroll
        for (int i = 0; i < 4; ++i) {
            const int idx = tid + i * NTHR, row = idx >> 3, c = (idx & 7) ^ (row & 7);
            ap[i] = arow(row) + c * 8; bp[i] = Bt + (size_t)row * ldb + c * 8;
        }
    }
    DI void issue(const int kt, const int buf) const {
        const int tid = threadIdx.x;
        char* sa = lds + buf * STAGE; char* sb = sa + A_BYTES;
        const int ko = kt * 64;
#pragma unroll
        for (int i = 0; i < 4; ++i) dma16(ap[i] + ko, sa + (tid + i * NTHR) * 16);
#pragma unroll
        for (int i = 0; i < 4; ++i) dma16(bp[i] + ko, sb + (tid + i * NTHR) * 16);
    }
    template <int PM>
    DI void run_probe(const int K, f32x4 (&acc)[4][4]) const {
        const int tid = threadIdx.x, lane = tid & 63, wave = tid >> 6;
        const int wm = wave >> 1, wn = wave & 1, fr = lane & 15, fq = lane >> 4;
#pragma unroll
        for (int i = 0; i < 4; ++i)
#pragma unroll
            for (int j = 0; j < 4; ++j) acc[i][j] = (f32x4){0.f, 0.f, 0.f, 0.f};
        const int KT = K >> 6;
#pragma unroll 1
        for (int kt = 0; kt < KT; ++kt) {
            if (PM & 4) { wait_vm0(); __syncthreads(); }
            if ((PM & 1) && kt + 1 < KT) issue(kt + 1, (kt + 1) & 1);
            if (PM & 2) {
                const char* sa = lds + (kt & 1) * STAGE; const char* sb = sa + A_BYTES;
                bf16x8 xf[2][4], wf[2][4];
#pragma unroll
                for (int kk = 0; kk < 2; ++kk) {
#pragma unroll
                    for (int i = 0; i < 4; ++i) xf[kk][i] = ldsv8(sa + swz128(wm * 64 + i * 16 + fr, kk * 4 + fq));
#pragma unroll
                    for (int j = 0; j < 4; ++j) wf[kk][j] = ldsv8(sb + swz128(wn * 64 + j * 16 + fr, kk * 4 + fq));
                }
                __builtin_amdgcn_sched_barrier(0);
                __builtin_amdgcn_s_setprio(1);
#pragma unroll
                for (int kk = 0; kk < 2; ++kk)
#pragma unroll
                    for (int i = 0; i < 4; ++i)
#pragma unroll
                        for (int j = 0; j < 4; ++j) acc[i][j] = mfma16(wf[kk][j], xf[kk][i], acc[i][j]);
                __builtin_amdgcn_s_setprio(0);
            }
        }
        wait_vm0();
    }
    DI void run(const int K, f32x4 (&acc)[4][4]) const {
        const int tid = threadIdx.x, lane = tid & 63, wave = tid >> 6;
        const int wm = wave >> 1, wn = wave & 1, fr = lane & 15, fq = lane >> 4;
#pragma unroll
        for (int i = 0; i < 4; ++i)
#pragma unroll
            for (int j = 0; j < 4; ++j) acc[i][j] = (f32x4){0.f, 0.f, 0.f, 0.f};
        const int KT = K >> 6;
#pragma unroll 1
        for (int kt = 0; kt < KT; ++kt) {
            wait_vm0();
            __syncthreads();
            if (kt + 1 < KT) issue(kt + 1, (kt + 1) & 1);
            const char* sa = lds + (kt & 1) * STAGE; const char* sb = sa + A_BYTES;
            bf16x8 xf[2][4], wf[2][4];
#pragma unroll
            for (int kk = 0; kk < 2; ++kk) {
#pragma unroll
                for (int i = 0; i < 4; ++i) xf[kk][i] = ldsv8(sa + swz128(wm * 64 + i * 16 + fr, kk * 4 + fq));
#pragma unroll
                for (int j = 0; j < 4; ++j) wf[kk][j] = ldsv8(sb + swz128(wn * 64 + j * 16 + fr, kk * 4 + fq));
            }
            __builtin_amdgcn_sched_barrier(0);
            __builtin_amdgcn_s_setprio(1);
#pragma unroll
            for (int kk = 0; kk < 2; ++kk)
#pragma unroll
                for (int i = 0; i < 4; ++i)
#pragma unroll
                    for (int j = 0; j < 4; ++j) acc[i][j] = mfma16(wf[kk][j], xf[kk][i], acc[i][j]);
            __builtin_amdgcn_s_setprio(0);
        }
    }
};

constexpr int EPI_OFF = 32768;
DI int lane_m(int i) { const int t = threadIdx.x; return ((t >> 7) & 1) * 64 + i * 16 + (t & 15); }
DI int lane_n(int j) { const int t = threadIdx.x; return ((t >> 6) & 1) * 64 + j * 16 + ((t >> 4) & 3) * 4; }
DI int opaque_tid() { int t = threadIdx.x; asm volatile("" : "+v"(t)); return t; }
DI int lane_m(int t, int i) { return ((t >> 7) & 1) * 64 + i * 16 + (t & 15); }
DI int lane_n(int t, int j) { return ((t >> 6) & 1) * 64 + j * 16 + ((t >> 4) & 3) * 4; }
template <class XF>
DI void epi_stage_bf16(const f32x4 (&acc)[4][4], XF xf) {
    const int tz = opaque_tid();
#pragma unroll
    for (int i = 0; i < 4; ++i) {
        const int m = lane_m(tz, i);
#pragma unroll
        for (int j = 0; j < 4; ++j) {
            const int n = lane_n(tz, j);
            const f32x4 v = xf(i, j, acc[i][j]);
            u32x2 o; o[0] = pk2(v[0], v[1]); o[1] = pk2(v[2], v[3]);
            *(u32x2*)(lds + EPI_OFF + m * 256 + (((n >> 3) ^ (m & 15)) << 4) + (n & 4) * 2) = o;
        }
    }
}
template <class DP, class OK>
DI void epi_flush_bf16(DP dst, OK ok) {
    const int tz = opaque_tid();
#pragma unroll
    for (int it = 0; it < 8; ++it) {
        const int idx = tz + it * NTHR, row = idx >> 4, ch = idx & 15;
        const u32x4 v = *(const u32x4*)(lds + EPI_OFF + row * 256 + ((ch ^ (row & 15)) << 4));
        if (ok(row)) *(u32x4*)(dst(row) + ch * 8) = v;
    }
}
template <class XF>
DI void epi_stage_bf16_T(const f32x4 (&acc)[4][4], XF xf) {
    const int tz = opaque_tid();
    const bool odd = tz & 1;
#pragma unroll
    for (int i = 0; i < 4; ++i) {
        const int m = lane_m(tz, i) & ~1;
#pragma unroll
        for (int j = 0; j < 4; ++j) {
            const int n = lane_n(tz, j) + (odd ? 2 : 0);
            const f32x4 v = xf(i, j, acc[i][j]);
            const float r0 = __shfl_xor(odd ? v[0] : v[2], 1), r1 = __shfl_xor(odd ? v[1] : v[3], 1);
            const unsigned w0 = odd ? pk2(r0, v[2]) : pk2(v[0], r0), w1 = odd ? pk2(r1, v[3]) : pk2(v[1], r1);
            *(unsigned*)(lds + EPI_OFF + n * 256 + (((m >> 3) ^ (n & 15)) << 4) + (m & 6) * 2) = w0;
            *(unsigned*)(lds + EPI_OFF + (n + 1) * 256 + (((m >> 3) ^ ((n + 1) & 15)) << 4) + (m & 6) * 2) = w1;
        }
    }
}
DI void epi_resid_f32(const Args& a, const int li, const int m0, const int n0, const f32x4 (&acc)[4][4]) {
    const int tz = opaque_tid();
    float* X = (float*)(a.ws + WS_X);
    const float* gate = (const float*)(a.ws + WS_MOD) + ((size_t)li * 9 + tok_modrow(m0)) * 6144 + 2 * 1024 + n0;
#pragma unroll
    for (int j = 0; j < 4; ++j) {
        const int n = lane_n(tz, j);
        const f32x4 g = *(const f32x4*)(gate + n);
#pragma unroll
        for (int i = 0; i < 4; ++i) {
            float* xp = X + (size_t)(m0 + lane_m(tz, i)) * D + n0 + n;
            f32x4 x = *(const f32x4*)xp;
            x += g * acc[i][j];
            *(f32x4*)xp = x;
        }
    }
}

template <bool XPF = true, class TE>
DI void gemm_dense_phase(const bf16_t* A, const int lda, const int mrows, const bf16_t* Bt, const int N, const int K, TE tile_epi) {
    const int mt = mrows / 128, nt = N / 128;
    const int mpx = mt >> 3, bmb = mpx >> 1, full = mpx * 8;
    auto decode = [&](int u, int& m0, int& n0) {
        const int xc = u & 7, s = u >> 3;
        const int bn = s / full, rem = s - bn * full;
        const int w = min(8, nt - 8 * bn);
        const int bm = rem / (bmb * w), rem2 = rem - bm * (bmb * w);
        const int ni = rem2 / bmb, mi = rem2 - ni * bmb;
        m0 = (xc * mpx + bm * bmb + mi) * 128; n0 = (bn * 8 + ni) * 128;
    };
    GemmPipe g;
    int u = blockIdx.x, m0 = 0, n0 = 0;
    __syncthreads();
    if (u < mt * nt) { decode(u, m0, n0); g.setup([&](int r) { return A + (size_t)(m0 + r) * lda; }, Bt + (size_t)n0 * K, K); g.issue(0, 0); }
    while (u < mt * nt) {
        f32x4 acc[4][4];
        g.run(K, acc);
        const int cm0 = m0, cn0 = n0;
        u += gridDim.x;
        if (XPF) {
            if (u < mt * nt) { decode(u, m0, n0); g.setup([&](int r) { return A + (size_t)(m0 + r) * lda; }, Bt + (size_t)n0 * K, K); g.issue(0, 0); }
            tile_epi(cm0, cn0, acc);
        } else {
            tile_epi(cm0, cn0, acc);
            __syncthreads();
            if (u < mt * nt) { decode(u, m0, n0); g.setup([&](int r) { return A + (size_t)(m0 + r) * lda; }, Bt + (size_t)n0 * K, K); g.issue(0, 0); }
        }
    }
    __syncthreads();
}
template <class XF, class DP>
DI void epi_bf16_rowmajor(const f32x4 (&acc)[4][4], XF xf, DP dst) {
    __syncthreads();
    epi_stage_bf16(acc, xf);
    __syncthreads();
    epi_flush_bf16(dst, [](int) { return true; });
}

DI void phase_rg_in(const Args& a, int j) {
    bf16_t* G = (bf16_t*)(a.ws + RG_G); bf16_t* U = (bf16_t*)(a.ws + RG_U);
    gemm_dense_phase((const bf16_t*)(a.ws + WS_H), D, NTOK, (const bf16_t*)(a.ws + W_RGIN) + (size_t)j * 2048 * 1024, 2048, 1024,
        [&](int m0, int n0, const f32x4 (&acc)[4][4]) {
            if (n0 < 1024)
                epi_bf16_rowmajor(acc, [](int, int, const f32x4 v) { f32x4 g; g[0] = gelu_tanh(v[0]); g[1] = gelu_tanh(v[1]); g[2] = gelu_tanh(v[2]); g[3] = gelu_tanh(v[3]); return g; },
                                  [&](int row) { return G + (size_t)(m0 + row) * D + n0; });
            else
                epi_bf16_rowmajor(acc, [](int, int, const f32x4 v) { return v; }, [&](int row) { return U + (size_t)(m0 + row) * D + (n0 - 1024); });
        });
}

DI void phase_rg_scan(const Args& a, int j) {
    const int tid = threadIdx.x, lane = tid & 63, wave = tid >> 6;
    const int fr = lane & 15, fq = lane >> 4;
    const bf16_t* U = (const bf16_t*)(a.ws + RG_U);
    bf16_t* HS = (bf16_t*)(a.ws + RG_HS);
    char* sW = lds;
    char* sX = lds + 8192;
    float* sUc = (float*)(lds + 24576);
    float* sA = (float*)(lds + 40960);
    float* sB = (float*)(lds + 49664);
    const int c = tid & 7;
    for (int u = blockIdx.x; u < 512; u += gridDim.x) {
        const int half = u & 1, dir = (u >> 1) & 1, blk = (u >> 2) & 15, b = u >> 6;
        const int cin0 = blk * 64, co0 = blk * 64 + half * 32;
        __syncthreads();
        {
            const bf16_t* Wg = (const bf16_t*)(a.ws + W_RGG) + ((size_t)((j * 2 + dir) * 16 + blk)) * 128 * 64;
#pragma unroll
            for (int i = 0; i < 2; ++i) {
                const int idx = tid + i * NTHR, row = idx >> 3, cc = idx & 7;
                const int srow = (row >> 5) * 64 + half * 32 + (row & 31);
                *(u32x4*)(sW + swz128(row, cc)) = *(const u32x4*)(Wg + (size_t)srow * 64 + cc * 8);
            }
        }
        float carry = 0.f;
        float cw[4][8], cb[8];
        {
            const float* cwp = a.in[9] + (size_t)j * 4 * 1024 + cin0 + c * 8; const float* cbp = a.in[10] + (size_t)j * 1024 + cin0 + c * 8;
#pragma unroll
            for (int w = 0; w < 4; ++w) { const f32x4 v0 = *(const f32x4*)(cwp + w * 1024), v1 = *(const f32x4*)(cwp + w * 1024 + 4);
#pragma unroll
                for (int e = 0; e < 4; ++e) { cw[w][e] = v0[e]; cw[w][4 + e] = v1[e]; } }
            const f32x4 v0 = *(const f32x4*)cbp, v1 = *(const f32x4*)(cbp + 4);
#pragma unroll
            for (int e = 0; e < 4; ++e) { cb[e] = v0[e]; cb[4 + e] = v1[e]; }
        }
        float bg0[8], bg1[8], spl[8];
        {
            const float* gb = a.in[12] + ((size_t)(j * 2 + dir) * 2) * 1024 + co0;
            const float* lm = a.in[13] + (size_t)(j * 2 + dir) * 1024 + co0;
#pragma unroll
            for (int jt = 0; jt < 2; ++jt)
#pragma unroll
                for (int e = 0; e < 4; ++e) {
                    const int cc = jt * 16 + fq * 4 + e;
                    bg0[jt * 4 + e] = gb[cc]; bg1[jt * 4 + e] = gb[1024 + cc];
                    spl[jt * 4 + e] = -8.f * log1pf(__expf(-lm[cc]));
                }
        }
        u32x4 pu[2][4];
        auto load_chunk = [&](int ci) {
            const int seg = ci >= 4, L = seg ? SEQ : CTXL, nch = L / 64, jc = seg ? ci - 4 : ci;
            const int oc = dir ? nch - 1 - jc : jc;
            const int rb = seg ? b * SEQ : NLAT + b * CTXL;
            const int s0 = oc * 64;
#pragma unroll
            for (int it = 0; it < 2; ++it) {
                const int tk = (tid >> 3) + it * 32;
#pragma unroll
                for (int w = 0; w < 4; ++w) {
                    const int s = s0 + tk + w - 2;
                    pu[it][w] = (u32x4){0u, 0u, 0u, 0u};
                    if (s >= 0 && s < L) pu[it][w] = *(const u32x4*)(U + (size_t)(rb + s) * D + cin0 + c * 8);
                }
            }
        };
        load_chunk(0);
        __syncthreads();
#pragma unroll 1
        for (int ci = 0; ci < 36; ++ci) {
            const int seg = ci >= 4, L = seg ? SEQ : CTXL, nch = L / 64, jc = seg ? ci - 4 : ci;
            const int oc = dir ? nch - 1 - jc : jc;
            const int rb = seg ? b * SEQ : NLAT + b * CTXL;
            const int s0 = oc * 64;
            char* sXc = sX + (ci & 1) * 8192; float* sUcc = sUc + (ci & 1) * 2048;
#pragma unroll
            for (int it = 0; it < 2; ++it) {
                const int tk = (tid >> 3) + it * 32;
                float o[8];
#pragma unroll
                for (int e = 0; e < 8; ++e) o[e] = cb[e];
#pragma unroll
                for (int w = 0; w < 4; ++w) {
                    const u32x4 r4 = pu[it][w];
#pragma unroll
                    for (int e = 0; e < 4; ++e) { o[2 * e] += cw[w][2 * e] * lof(r4[e]); o[2 * e + 1] += cw[w][2 * e + 1] * hif(r4[e]); }
                }
                u32x4 pv; pv[0] = pk2(o[0], o[1]); pv[1] = pk2(o[2], o[3]); pv[2] = pk2(o[4], o[5]); pv[3] = pk2(o[6], o[7]);
                *(u32x4*)(sXc + swz128(tk, c)) = pv;
                if ((c >> 2) == half) {
                    *(f32x4*)(sUcc + tk * 32 + (c & 3) * 8) = (f32x4){o[0], o[1], o[2], o[3]};
                    *(f32x4*)(sUcc + tk * 32 + (c & 3) * 8 + 4) = (f32x4){o[4], o[5], o[6], o[7]};
                }
            }
            if (ci + 1 < 36) load_chunk(ci + 1);
            __syncthreads();
            {
                f32x4 acc[4];
#pragma unroll
                for (int jt = 0; jt < 4; ++jt) acc[jt] = (f32x4){0.f, 0.f, 0.f, 0.f};
#pragma unroll
                for (int kk = 0; kk < 2; ++kk) {
                    const bf16x8 xf = ldsv8(sXc + swz128(wave * 16 + fr, kk * 4 + fq));
#pragma unroll
                    for (int jt = 0; jt < 4; ++jt) acc[jt] = mfma16(ldsv8(sW + swz128(jt * 16 + fr, kk * 4 + fq)), xf, acc[jt]);
                }
                const int tk = wave * 16 + fr;
#pragma unroll
                for (int jt = 0; jt < 2; ++jt) {
                    const f32x4 uc = *(const f32x4*)(sUcc + tk * 32 + jt * 16 + fq * 4);
                    f32x4 av4, bv4;
#pragma unroll
                    for (int e = 0; e < 4; ++e) {
                        const float rg = sigmoidf_(acc[jt][e] + bg0[jt * 4 + e]);
                        const float ig = sigmoidf_(acc[jt + 2][e] + bg1[jt * 4 + e]);
                        const float av = __expf(rg * spl[jt * 4 + e]);
                        av4[e] = av;
                        bv4[e] = sqrtf(fmaxf(1.f - av * av, 0.f)) * ig * uc[e];
                    }
#pragma unroll
                    for (int e = 0; e < 4; ++e) { sA[(jt * 16 + fq * 4 + e) * 68 + tk] = av4[e]; sB[(jt * 16 + fq * 4 + e) * 68 + tk] = bv4[e]; }
                }
            }
            __syncthreads();
            {
                const int ch = wave * 8 + (lane & 7), sg = lane >> 3;
                const int tb = dir ? 56 - sg * 8 : sg * 8;
                const f32x4 a0 = *(const f32x4*)(sA + ch * 68 + tb), a1 = *(const f32x4*)(sA + ch * 68 + tb + 4);
                const f32x4 b0 = *(const f32x4*)(sB + ch * 68 + tb), b1 = *(const f32x4*)(sB + ch * 68 + tb + 4);
                float av[8], bv[8];
#pragma unroll
                for (int e = 0; e < 4; ++e) {
                    av[e] = dir ? a1[3 - e] : a0[e]; av[4 + e] = dir ? a0[3 - e] : a1[e];
                    bv[e] = dir ? b1[3 - e] : b0[e]; bv[4 + e] = dir ? b0[3 - e] : b1[e];
                }
                float Ap = 1.f, Hh = 0.f;
#pragma unroll
                for (int e = 0; e < 8; ++e) { Hh = av[e] * Hh + bv[e]; Ap *= av[e]; }
#pragma unroll
                for (int d = 8; d < 64; d <<= 1) {
                    const float Ao = __shfl_up(Ap, d), Ho = __shfl_up(Hh, d);
                    if (lane >= d) { Hh = Ap * Ho + Hh; Ap = Ap * Ao; }
                }
                float Aex = __shfl_up(Ap, 8), Hex = __shfl_up(Hh, 8);
                if (sg == 0) { Aex = 1.f; Hex = 0.f; }
                float hin = Aex * carry + Hex;
                const float cnew = Ap * carry + Hh;
                carry = __shfl(cnew, 56 + (lane & 7));
                bf16_t* hs = HS + (size_t)dir * NTOK * D + (size_t)rb * D + co0 + ch;
#pragma unroll
                for (int e = 0; e < 8; ++e) {
                    hin = av[e] * hin + bv[e];
                    const int i = sg * 8 + e, tk = dir ? 63 - i : i;
                    hs[(size_t)(s0 + tk) * D] = f2bf(hin);
                }
            }
        }
    }
}

DI void phase_rg_combine(const Args& a) {
    const u32x4* G = (const u32x4*)(a.ws + RG_G);
    const u32x4* H0 = (const u32x4*)(a.ws + RG_HS);
    const u32x4* H1 = (const u32x4*)(a.ws + RG_HS + TOKD2);
    u32x4* A2 = (u32x4*)(a.ws + RG_A2);
    const size_t n = (size_t)NTOK * D / 8;
    for (size_t i = (size_t)blockIdx.x * NTHR + threadIdx.x; i < n; i += (size_t)gridDim.x * NTHR) {
        const u32x4 g = G[i], h0 = H0[i], h1 = H1[i];
        u32x4 o;
#pragma unroll
        for (int e = 0; e < 4; ++e) o[e] = pk2(lof(g[e]) * (lof(h0[e]) + lof(h1[e])), hif(g[e]) * (hif(h0[e]) + hif(h1[e])));
        A2[i] = o;
    }
}

DI void phase_rg_out(const Args& a, int li, int j) {
    gemm_dense_phase((const bf16_t*)(a.ws + RG_A2), D, li == 3 ? NLAT : NTOK, (const bf16_t*)(a.ws + W_RGOUT) + (size_t)j * 1024 * 1024, 1024, 1024,
        [&](int m0, int n0, const f32x4 (&acc)[4][4]) { epi_resid_f32(a, li, m0, n0, acc); });
}

DI void phase_mla_down(const Args& a) {
    bf16_t* CQ = (bf16_t*)(a.ws + MLA_CQ); bf16_t* CKV = (bf16_t*)(a.ws + MLA_CKV); float* KR = (float*)(a.ws + MLA_KR);
    gemm_dense_phase((const bf16_t*)(a.ws + WS_H), D, NTOK, (const bf16_t*)(a.ws + W_MDOWN), 512, 1024,
        [&](int m0, int n0, const f32x4 (&acc)[4][4]) {
            if (n0 < 256) epi_bf16_rowmajor(acc, [](int, int, const f32x4 v) { return v; }, [&](int row) { return CQ + (size_t)(m0 + row) * 256 + n0; });
            else if (n0 == 256) epi_bf16_rowmajor(acc, [](int, int, const f32x4 v) { return v; }, [&](int row) { return CKV + (size_t)(m0 + row) * 128; });
            else {
#pragma unroll
                for (int i = 0; i < 4; ++i)
#pragma unroll
                    for (int j = 0; j < 2; ++j) { const int n = lane_n(j); if (n < 32) *(f32x4*)(KR + (size_t)(m0 + lane_m(i)) * 32 + n) = acc[i][j]; }
            }
        });
}

DI int perm_key(int kp) { return (kp & ~12) | ((kp & 4) << 1) | ((kp & 8) >> 1); }

DI void phase_mla_up(const Args& a) {
    const int tid = threadIdx.x, lane = tid & 63;
    const int fq = lane >> 4;
    const bf16_t* CQ = (const bf16_t*)(a.ws + MLA_CQ); const bf16_t* CKV = (const bf16_t*)(a.ws + MLA_CKV); const float* KR = (const float*)(a.ws + MLA_KR);
    bf16_t* Q = (bf16_t*)(a.ws + MLA_Q); bf16_t* Kb = (bf16_t*)(a.ws + MLA_K); bf16_t* VT = (bf16_t*)(a.ws + MLA_VT);
    const float* qkn = a.in[20];
    float* rstd = (float*)(lds + LDS_AUX);
    const int MT_ = NTOK / 128;
    const int nq = MT_ * 16, nkv = MT_ * 16;
    const float QSCALE = 0.10206207261596575f * 1.4426950408889634f;
    for (int u = blockIdx.x; u < nq + nkv; u += gridDim.x) {
        const bool isq = u < nq;
        const int uu = isq ? u : u - nq;
        const int m0 = (uu % MT_) * 128, head = uu / MT_;
        __syncthreads();
        {
            const int row = tid >> 1, hf = tid & 1;
            float ss = 0.f;
            if (isq) {
                const u32x4* p = (const u32x4*)(CQ + (size_t)(m0 + row) * 256 + hf * 128);
#pragma unroll
                for (int i = 0; i < 16; ++i) { const u32x4 v = p[i];
#pragma unroll
                    for (int e = 0; e < 4; ++e) { const float x = lof(v[e]), y = hif(v[e]); ss += x * x + y * y; } }
            } else {
                const u32x4* p = (const u32x4*)(CKV + (size_t)(m0 + row) * 128 + hf * 64);
#pragma unroll
                for (int i = 0; i < 8; ++i) { const u32x4 v = p[i];
#pragma unroll
                    for (int e = 0; e < 4; ++e) { const float x = lof(v[e]), y = hif(v[e]); ss += x * x + y * y; } }
            }
            ss += __shfl_xor(ss, 1);
            if (hf == 0) rstd[row] = rsqrtf(ss * (isq ? 1.f / 256.f : 1.f / 128.f) + EPS);
        }
        __syncthreads();
        if (isq) {
            f32x4 hold[2][6];
            gemm_tile<4, 1, 2, 6, false>([&](int r) { return CQ + (size_t)(m0 + r) * 256; }, (const bf16_t*)(a.ws + W_MUQ) + (size_t)head * 96 * 256, 256, 256, hold);
            const int wave = tid >> 6;
#pragma unroll
            for (int i = 0; i < 2; ++i) { const float rs = rstd[wave * 32 + i * 16 + (lane & 15)];
#pragma unroll
                for (int jn = 0; jn < 6; ++jn) hold[i][jn] *= rs; }
#pragma unroll
            for (int i = 0; i < 2; ++i) {
                const int m = wave * 32 + i * 16 + (lane & 15), t = m0 + m;
                float ss = 0.f;
#pragma unroll
                for (int jn = 0; jn < 6; ++jn)
#pragma unroll
                    for (int e = 0; e < 4; ++e) ss += hold[i][jn][e] * hold[i][jn][e];
                ss += __shfl_xor(ss, 16); ss += __shfl_xor(ss, 32);
                const float rs = rsqrtf(ss * (1.f / 96.f) + EPS);
                f32x4 o[6];
#pragma unroll
                for (int jn = 0; jn < 6; ++jn)
#pragma unroll
                    for (int e = 0; e < 4; ++e) o[jn][e] = hold[i][jn][e] * rs * qkn[jn * 16 + fq * 4 + e];
#pragma unroll
                for (int jn = 4; jn < 6; ++jn) {
                    f32x4 other;
#pragma unroll
                    for (int e = 0; e < 4; ++e) other[e] = __shfl_xor(o[jn][e], 32);
                    if (t < NLAT) {
                        const int s = t & (SEQ - 1);
                        const float pos = (float)(jn == 4 ? (s >> 6) : (s & 63));
#pragma unroll
                        for (int e = 0; e < 4; ++e) {
                            const int fi = (fq & 1) * 4 + e;
                            const float ang = pos * __powf(10000.f, -(float)fi * 0.125f);
                            float sn, cs; sincosf(ang, &sn, &cs);
                            o[jn][e] = (fq < 2) ? o[jn][e] * cs - other[e] * sn : o[jn][e] * cs + other[e] * sn;
                        }
                    }
                }
                bf16_t* qp = Q + (size_t)t * 1536 + head * 96 + fq * 4;
#pragma unroll
                for (int jn = 0; jn < 6; ++jn) st_bf4(qp + jn * 16, o[jn] * QSCALE);
            }
        } else {
            f32x4 hold[4][4];
            gemm_tile<2, 2, 4, 4, false>([&](int r) { return CKV + (size_t)(m0 + r) * 128; }, (const bf16_t*)(a.ws + W_MUKV) + (size_t)head * 128 * 128, 128, 128, hold);
            const int wave = tid >> 6, wm = wave >> 1, wn = wave & 1;
#pragma unroll
            for (int i = 0; i < 4; ++i) { const float rs = rstd[wm * 64 + i * 16 + (lane & 15)];
#pragma unroll
                for (int jn = 0; jn < 4; ++jn) hold[i][jn] *= rs; }
#pragma unroll
            for (int i = 0; i < 4; ++i) {
                const int m = wm * 64 + i * 16 + (lane & 15), t = m0 + m;
                const int bb = t < NLAT ? (t >> 11) : ((t - NLAT) >> 8);
                const int kp = t < NLAT ? CTXL + (t & (SEQ - 1)) : ((t - NLAT) & (CTXL - 1));
                if (wn == 0) {
                    const int base = (fq >> 1) * 16 + (fq & 1) * 4;
                    const f32x4 z1 = *(const f32x4*)(KR + (size_t)t * 32 + base);
                    const f32x4 z2 = *(const f32x4*)(KR + (size_t)t * 32 + base + 8);
                    float ss = 0.f;
#pragma unroll
                    for (int jn = 0; jn < 4; ++jn)
#pragma unroll
                        for (int e = 0; e < 4; ++e) ss += hold[i][jn][e] * hold[i][jn][e];
#pragma unroll
                    for (int e = 0; e < 4; ++e) ss += z1[e] * z1[e] + z2[e] * z2[e];
                    ss += __shfl_xor(ss, 16); ss += __shfl_xor(ss, 32);
                    const float rs = rsqrtf(ss * (1.f / 96.f) + EPS);
                    bf16_t* kpn = Kb + ((size_t)(bb * 16 + head) * NKEY + kp) * 96;
#pragma unroll
                    for (int jn = 0; jn < 4; ++jn) {
                        f32x4 o;
#pragma unroll
                        for (int e = 0; e < 4; ++e) o[e] = hold[i][jn][e] * rs * qkn[96 + jn * 16 + fq * 4 + e];
                        st_bf4(kpn + jn * 16 + fq * 4, o);
                    }
                    f32x4 o1, o2;
#pragma unroll
                    for (int e = 0; e < 4; ++e) {
                        float a1 = z1[e] * rs * qkn[96 + 64 + base + e], a2 = z2[e] * rs * qkn[96 + 64 + base + 8 + e];
                        if (t < NLAT) {
                            const int s = t & (SEQ - 1);
                            const float pos = (float)((fq >> 1) == 0 ? (s >> 6) : (s & 63));
                            const int fi = (fq & 1) * 4 + e;
                            const float ang = pos * __powf(10000.f, -(float)fi * 0.125f);
                            float sn, cs; sincosf(ang, &sn, &cs);
                            const float b1 = a1 * cs - a2 * sn, b2 = a2 * cs + a1 * sn;
                            a1 = b1; a2 = b2;
                        }
                        o1[e] = a1; o2[e] = a2;
                    }
                    st_bf4(kpn + 64 + base, o1);
                    st_bf4(kpn + 64 + base + 8, o2);
                } else {
                    bf16_t* vp = VT + ((size_t)(bb * 16 + head) * 64) * NKEY + perm_key(kp);
#pragma unroll
                    for (int jn = 0; jn < 4; ++jn)
#pragma unroll
                        for (int e = 0; e < 4; ++e) vp[(size_t)(jn * 16 + fq * 4 + e) * NKEY] = f2bf(hold[i][jn][e]);
                }
            }
        }
    }
}

DI void phase_mla_attn(const Args& a) {
    const int tid = threadIdx.x, lane = tid & 63, wave = tid >> 6;
    const int r = lane & 31, h = lane >> 5;
    const bf16_t* Q = (const bf16_t*)(a.ws + MLA_Q); const bf16_t* Kb = (const bf16_t*)(a.ws + MLA_K); const bf16_t* VT = (const bf16_t*)(a.ws + MLA_VT);
    bf16_t* O = (bf16_t*)(a.ws + MLA_O);
    constexpr int KT_B = 64 * 256, VT_B = 64 * 128, ST_B = KT_B + VT_B;
    for (int u = blockIdx.x; u < 2048 + 256; u += gridDim.x) {
        const bool isctx = u >= 2048;
        const int uu = isctx ? u - 2048 : u;
        const int qb = isctx ? (uu & 1) : (uu & 15), head = isctx ? ((uu >> 1) & 15) : ((uu >> 4) & 15), b = isctx ? (uu >> 5) : (uu >> 8);
        const int ntile = isctx ? CTXL / 64 : NKEY / 64;
        const int t = (isctx ? NLAT + b * CTXL : b * SEQ) + qb * 128 + wave * 32 + r;
        const bf16_t* kbase = Kb + (size_t)(b * 16 + head) * NKEY * 96;
        const bf16_t* vbase = VT + (size_t)(b * 16 + head) * 64 * NKEY;
        bf16x8 qf[6];
#pragma unroll
        for (int kk = 0; kk < 6; ++kk) qf[kk] = *(const bf16x8*)(Q + (size_t)t * 1536 + head * 96 + kk * 16 + h * 8);
        f32x16 o[2];
#pragma unroll
        for (int e = 0; e < 16; ++e) { o[0][e] = 0.f; o[1][e] = 0.f; }
        float mrun = -INFINITY, lsum = 0.f;
        __syncthreads();
        auto stage = [&](int kt, int buf) {
            char* sk = lds + buf * ST_B; char* sv = sk + KT_B;
            const int key0 = kt * 64;
#pragma unroll
            for (int i = 0; i < 4; ++i) {
                const int idx = tid + i * NTHR, row = idx >> 4; int c = (idx & 15) ^ (row & 15); if (c >= 12) c = 0;
                dma16(kbase + (size_t)(key0 + row) * 96 + c * 8, sk + idx * 16);
            }
#pragma unroll
            for (int i = 0; i < 2; ++i) {
                const int idx = tid + i * NTHR, row = idx >> 3, c = (idx & 7) ^ ((row >> 1) & 7);
                dma16(vbase + (size_t)row * NKEY + key0 + c * 8, sv + idx * 16);
            }
        };
        stage(0, 0);
#pragma unroll 1
        for (int kt = 0; kt < ntile; ++kt) {
            wait_vm0();
            __syncthreads();
            if (kt + 1 < ntile) stage(kt + 1, (kt + 1) & 1);
            const char* sk = lds + (kt & 1) * ST_B; const char* sv = sk + KT_B;
            f32x16 st[2];
#pragma unroll
            for (int e = 0; e < 16; ++e) { st[0][e] = 0.f; st[1][e] = 0.f; }
#pragma unroll
            for (int kk = 0; kk < 6; ++kk)
#pragma unroll
                for (int si = 0; si < 2; ++si) {
                    const int s = si * 32 + r;
                    st[si] = mfma32(ldsv8(sk + swz256(s, kk * 2 + h)), qf[kk], st[si]);
                }
            float mx = st[0][0];
#pragma unroll
            for (int e = 0; e < 16; ++e) { mx = fmaxf(mx, st[0][e]); mx = fmaxf(mx, st[1][e]); }
            mx = fmaxf(mx, __shfl_xor(mx, 32));
            const float mnew = fmaxf(mrun, mx);
            const float alpha = __builtin_amdgcn_exp2f(mrun - mnew);
            mrun = mnew;
            float ps = 0.f;
#pragma unroll
            for (int si = 0; si < 2; ++si)
#pragma unroll
                for (int e = 0; e < 16; ++e) { const float p = __builtin_amdgcn_exp2f(st[si][e] - mnew); st[si][e] = p; ps += p; }
            lsum = lsum * alpha + ps;
#pragma unroll
            for (int e = 0; e < 16; ++e) { o[0][e] *= alpha; o[1][e] *= alpha; }
#pragma unroll
            for (int si = 0; si < 2; ++si)
#pragma unroll
                for (int ks = 0; ks < 2; ++ks) {
                    u32x4 pp;
                    pp[0] = pk2(st[si][8 * ks + 0], st[si][8 * ks + 1]); pp[1] = pk2(st[si][8 * ks + 2], st[si][8 * ks + 3]);
                    pp[2] = pk2(st[si][8 * ks + 4], st[si][8 * ks + 5]); pp[3] = pk2(st[si][8 * ks + 6], st[si][8 * ks + 7]);
                    const bf16x8 pf = __builtin_bit_cast(bf16x8, pp);
#pragma unroll
                    for (int et = 0; et < 2; ++et) {
                        const int e = et * 32 + r;
                        o[et] = mfma32(ldsv8(sv + e * 128 + (((si * 4 + ks * 2 + h) ^ ((e >> 1) & 7)) << 4)), pf, o[et]);
                    }
                }
        }
        lsum += __shfl_xor(lsum, 32);
        const float inv = 1.f / lsum;
#pragma unroll
        for (int et = 0; et < 2; ++et)
#pragma unroll
            for (int g = 0; g < 4; ++g) {
                f32x4 v; v[0] = o[et][4 * g] * inv; v[1] = o[et][4 * g + 1] * inv; v[2] = o[et][4 * g + 2] * inv; v[3] = o[et][4 * g + 3] * inv;
                st_bf4(O + (size_t)t * D + head * 64 + et * 32 + 8 * g + 4 * h, v);
            }
    }
}

DI void phase_mla_out(const Args& a, int li) {
    gemm_dense_phase((const bf16_t*)(a.ws + MLA_O), D, NTOK, (const bf16_t*)(a.ws + W_MO), 1024, 1024,
        [&](int m0, int n0, const f32x4 (&acc)[4][4]) { epi_resid_f32(a, li, m0, n0, acc); });
}

DI void phase_ml_in(const Args& a) {
    bf16_t* Qm = (bf16_t*)(a.ws + ML_Q); bf16_t* Km = (bf16_t*)(a.ws + ML_K); bf16_t* KT = (bf16_t*)(a.ws + ML_KT); bf16_t* VT = (bf16_t*)(a.ws + ML_VT);
    bf16_t* OG = (bf16_t*)(a.ws + ML_OG); float* GT = (float*)(a.ws + ML_GT);
    const float* gb = a.in[23];
    auto ident = [](int, int, const f32x4 v) { return v; };
    gemm_dense_phase<false>((const bf16_t*)(a.ws + WS_H), D, NTOK, (const bf16_t*)(a.ws + W_MLIN), 3200, 1024,
        [&](int m0, int n0, const f32x4 (&acc)[4][4]) {
            if (n0 < 512) {
                epi_bf16_rowmajor(acc, [](int, int, const f32x4 v) { return v * 0.08838834764831845f; }, [&](int row) { return Qm + (size_t)(m0 + row) * 512 + n0; });
            } else if (n0 < 1024) {
                epi_bf16_rowmajor(acc, ident, [&](int row) { return Km + (size_t)(m0 + row) * 512 + (n0 - 512); });
                __syncthreads();
                epi_stage_bf16_T(acc, ident);
                __syncthreads();
                epi_flush_bf16([&](int row) { return KT + (size_t)(n0 - 512 + row) * NTOK + m0; }, [](int) { return true; });
            } else if (n0 < 2048) {
                __syncthreads();
                epi_stage_bf16_T(acc, ident);
                __syncthreads();
                epi_flush_bf16([&](int row) { return VT + (size_t)(n0 - 1024 + row) * NTOK + m0; }, [](int) { return true; });
            } else if (n0 < 3072) {
                epi_bf16_rowmajor(acc, [](int, int, const f32x4 v) { f32x4 s; s[0] = sigmoidf_(v[0]); s[1] = sigmoidf_(v[1]); s[2] = sigmoidf_(v[2]); s[3] = sigmoidf_(v[3]); return s; },
                                  [&](int row) { return OG + (size_t)(m0 + row) * D + (n0 - 2048); });
            } else {
#pragma unroll
                for (int i = 0; i < 4; ++i) {
                    const int n = lane_n(0);
                    if (n < 16) { f32x4 s = acc[i][0]; s[0] += gb[n]; s[1] += gb[n + 1]; s[2] += gb[n + 2]; s[3] += gb[n + 3]; *(f32x4*)(GT + (size_t)(m0 + lane_m(i)) * 16 + n) = s; }
                }
            }
        });
}

DI void phase_ml_scan(const Args& a) {
    const int tid = threadIdx.x, lane = tid & 63, wave = tid >> 6;
    const int fr = lane & 15, fq = lane >> 4;
    const bf16_t* Qm = (const bf16_t*)(a.ws + ML_Q); const bf16_t* Km = (const bf16_t*)(a.ws + ML_K);
    const bf16_t* KT = (const bf16_t*)(a.ws + ML_KT); const bf16_t* VT = (const bf16_t*)(a.ws + ML_VT);
    const float* GT = (const float*)(a.ws + ML_GT);
    bf16_t* HS = (bf16_t*)(a.ws + ML_HS);
    char* sQ = lds;
    char* sK = lds + 16384;
    char* sS = sK;
    char* sKT = lds + 32768;
    char* sVT = lds + 49152;
    char* sCT = lds + 55296;
    float* sRow = (float*)(lds + 67584);
    float* sCol = sRow + 64;
    float* sInt = sCol + 64;
    float* sNrm = sInt + 64;
    float* sWv = sNrm + 64;
    float* sSc = sWv + 64;
    for (int u = blockIdx.x; u < 512; u += gridDim.x) {
        const int sl = u & 7, dir = (u >> 3) & 1, head = (u >> 4) & 3, b = u >> 6;
        __syncthreads();
        for (int i = tid; i < 12288 / 16; i += NTHR) *(u32x4*)(sCT + i * 16) = (u32x4){0u, 0u, 0u, 0u};
        for (int i = tid; i < 16 * 8; i += NTHR) {
            const int row = 32 + (i >> 3), c = i & 7;
            const unsigned v = row == 32 ? 0x3f803f80u : 0u;
            *(u32x4*)(sVT + swz128(row, c)) = (u32x4){v, v, v, v};
        }
        if (tid == 0) sSc[1] = -1e30f;
        f32x4 accC[2][3];
#pragma unroll
        for (int i = 0; i < 2; ++i)
#pragma unroll
            for (int jn = 0; jn < 3; ++jn) accC[i][jn] = (f32x4){0.f, 0.f, 0.f, 0.f};
        __syncthreads();
#pragma unroll 1
        for (int ci = 0; ci < 36; ++ci) {
            const int seg = ci >= 4, L = seg ? SEQ : CTXL, nch = L / 64, jc = seg ? ci - 4 : ci;
            const int oc = dir ? nch - 1 - jc : jc;
            const int t0 = (seg ? b * SEQ : NLAT + b * CTXL) + oc * 64;
#pragma unroll
            for (int i = 0; i < 4; ++i) {
                const int idx = tid + i * NTHR, row = idx >> 4, c = (idx & 15) ^ (row & 15);
                dma16(Qm + (size_t)(t0 + row) * 512 + head * 128 + c * 8, sQ + idx * 16);
                dma16(Km + (size_t)(t0 + row) * 512 + head * 128 + c * 8, sK + idx * 16);
            }
#pragma unroll
            for (int i = 0; i < 4; ++i) {
                const int idx = tid + i * NTHR, row = idx >> 3, c = (idx & 7) ^ (row & 7);
                dma16(KT + (size_t)(head * 128 + row) * NTOK + t0 + c * 8, sKT + idx * 16);
            }
            {
                const int idx = tid, row = idx >> 3, c = (idx & 7) ^ (row & 7);
                dma16(VT + (size_t)(head * 256 + sl * 32 + row) * NTOK + t0 + c * 8, sVT + idx * 16);
            }
            if (wave == 0) {
                const int s = dir ? 63 - lane : lane;
                const float ig = GT[(size_t)(t0 + s) * 16 + dir * 8 + head];
                const float fg = GT[(size_t)(t0 + s) * 16 + dir * 8 + 4 + head];
                const float lf = fminf(fg, 0.f) - log1pf(__expf(-fabsf(fg)));
                float bc = lf;
#pragma unroll
                for (int d = 1; d < 64; d <<= 1) { const float o = __shfl_up(bc, d); if (lane >= d) bc += o; }
                const float av = ig - bc;
                float pm = av;
#pragma unroll
                for (int d = 1; d < 64; d <<= 1) { const float o = __shfl_up(pm, d); if (lane >= d) pm = fmaxf(pm, o); }
                const float mst = sSc[1];
                const float mm = fmaxf(mst, pm);
                sRow[s] = -mm;
                sCol[s] = av;
                sInt[s] = __expf(mst - mm);
                sNrm[s] = __expf(-(bc + mm));
                const float mmL = __shfl(mm, 63), bL = __shfl(bc, 63);
                sWv[s] = __expf(av - mmL);
                if (lane == 0) { sSc[0] = __expf(mst - mmL); sSc[1] = bL + mmL; }
            }
            wait_vm0();
            __syncthreads();
            f32x4 sacc[4];
#pragma unroll
            for (int jt = 0; jt < 4; ++jt) sacc[jt] = (f32x4){0.f, 0.f, 0.f, 0.f};
#pragma unroll
            for (int kk = 0; kk < 4; ++kk) {
                const bf16x8 qf = ldsv8(sQ + swz256(wave * 16 + fr, kk * 4 + fq));
#pragma unroll
                for (int jt = 0; jt < 4; ++jt) sacc[jt] = mfma16(ldsv8(sK + swz256(jt * 16 + fr, kk * 4 + fq)), qf, sacc[jt]);
            }
            __syncthreads();
            {
                const int tq = wave * 16 + fr;
                const float rt = sRow[tq];
#pragma unroll
                for (int jt = 0; jt < 4; ++jt) {
                    f32x4 v;
#pragma unroll
                    for (int e = 0; e < 4; ++e) {
                        const int s = jt * 16 + fq * 4 + e;
                        const bool ok = dir ? (s >= tq) : (s <= tq);
                        v[e] = ok ? sacc[jt][e] * __expf(rt + sCol[s]) : 0.f;
                    }
                    u32x2 pv; pv[0] = pk2(v[0], v[1]); pv[1] = pk2(v[2], v[3]);
                    *(u32x2*)(sS + swz128(tq, jt * 2 + (fq >> 1)) + (fq & 1) * 8) = pv;
                }
            }
            __syncthreads();
            {
                f32x4 n1[3], n2[3];
#pragma unroll
                for (int jt = 0; jt < 3; ++jt) { n1[jt] = (f32x4){0.f, 0.f, 0.f, 0.f}; n2[jt] = (f32x4){0.f, 0.f, 0.f, 0.f}; }
#pragma unroll
                for (int kk = 0; kk < 2; ++kk) {
                    const bf16x8 sf = ldsv8(sS + swz128(wave * 16 + fr, kk * 4 + fq));
#pragma unroll
                    for (int jt = 0; jt < 3; ++jt) n1[jt] = mfma16(ldsv8(sVT + swz128(jt * 16 + fr, kk * 4 + fq)), sf, n1[jt]);
                }
#pragma unroll
                for (int kk = 0; kk < 4; ++kk) {
                    const bf16x8 qf = ldsv8(sQ + swz256(wave * 16 + fr, kk * 4 + fq));
#pragma unroll
                    for (int jt = 0; jt < 3; ++jt) n2[jt] = mfma16(ldsv8(sCT + swz256(jt * 16 + fr, kk * 4 + fq)), qf, n2[jt]);
                }
                const int tq = wave * 16 + fr;
                const float it = sInt[tq];
                float den = n1[2][0] + it * n2[2][0];
                den = __shfl(den, fr);
                const float dn = fmaxf(fabsf(den), sNrm[tq]);
                const float inv = 1.f / dn;
                bf16_t* hp = HS + (size_t)dir * NTOK * D + (size_t)(t0 + tq) * D + head * 256 + sl * 32 + fq * 4;
#pragma unroll
                for (int jt = 0; jt < 2; ++jt) {
                    f32x4 v;
#pragma unroll
                    for (int e = 0; e < 4; ++e) v[e] = (n1[jt][e] + it * n2[jt][e]) * inv;
                    st_bf4(hp + jt * 16, v);
                }
            }
            {
                const float decay = sSc[0];
#pragma unroll
                for (int i = 0; i < 2; ++i)
#pragma unroll
                    for (int jn = 0; jn < 3; ++jn) accC[i][jn] *= decay;
#pragma unroll
                for (int kk = 0; kk < 2; ++kk) {
                    bf16x8 vf[3];
#pragma unroll
                    for (int jn = 0; jn < 3; ++jn) vf[jn] = ldsv8(sVT + swz128(jn * 16 + fr, kk * 4 + fq));
                    const f32x4 w0 = *(const f32x4*)(sWv + kk * 32 + fq * 8), w1 = *(const f32x4*)(sWv + kk * 32 + fq * 8 + 4);
#pragma unroll
                    for (int i = 0; i < 2; ++i) {
                        const u32x4 kr = *(const u32x4*)(sKT + swz128((wave * 2 + i) * 16 + fr, kk * 4 + fq));
                        u32x4 ks;
                        ks[0] = pk2(lof(kr[0]) * w0[0], hif(kr[0]) * w0[1]); ks[1] = pk2(lof(kr[1]) * w0[2], hif(kr[1]) * w0[3]);
                        ks[2] = pk2(lof(kr[2]) * w1[0], hif(kr[2]) * w1[1]); ks[3] = pk2(lof(kr[3]) * w1[2], hif(kr[3]) * w1[3]);
                        const bf16x8 kf = __builtin_bit_cast(bf16x8, ks);
#pragma unroll
                        for (int jn = 0; jn < 3; ++jn) accC[i][jn] = mfma16(kf, vf[jn], accC[i][jn]);
                    }
                }
            }
            __syncthreads();
#pragma unroll
            for (int i = 0; i < 2; ++i)
#pragma unroll
                for (int jn = 0; jn < 3; ++jn) {
                    const int dd = (wave * 2 + i) * 16 + fq * 4, ee = jn * 16 + fr;
                    u32x2 pv; pv[0] = pk2(accC[i][jn][0], accC[i][jn][1]); pv[1] = pk2(accC[i][jn][2], accC[i][jn][3]);
                    *(u32x2*)(sCT + swz256(ee, dd >> 3) + (dd & 7) * 2) = pv;
                }
            __syncthreads();
        }
    }
}

DI void phase_ml_readout(const Args& a) {
    const int tid = threadIdx.x, lane = tid & 63, wave = tid >> 6;
    const bf16_t* H0 = (const bf16_t*)(a.ws + ML_HS); const bf16_t* H1 = H0 + (size_t)NTOK * D;
    const bf16_t* OG = (const bf16_t*)(a.ws + ML_OG); bf16_t* A2 = (bf16_t*)(a.ws + ML_A2);
    const float* on = a.in[24];
    for (int t = blockIdx.x * 4 + wave; t < NTOK; t += gridDim.x * 4) {
        const size_t off = (size_t)t * D + lane * 16;
        const u32x4 a0 = *(const u32x4*)(H0 + off), a1 = *(const u32x4*)(H0 + off + 8);
        const u32x4 b0 = *(const u32x4*)(H1 + off), b1 = *(const u32x4*)(H1 + off + 8);
        float v[16];
#pragma unroll
        for (int e = 0; e < 4; ++e) {
            v[2 * e] = lof(a0[e]) + lof(b0[e]); v[2 * e + 1] = hif(a0[e]) + hif(b0[e]);
            v[8 + 2 * e] = lof(a1[e]) + lof(b1[e]); v[8 + 2 * e + 1] = hif(a1[e]) + hif(b1[e]);
        }
        float ss = 0.f;
#pragma unroll
        for (int e = 0; e < 16; ++e) ss += v[e] * v[e];
        ss += __shfl_xor(ss, 1); ss += __shfl_xor(ss, 2); ss += __shfl_xor(ss, 4); ss += __shfl_xor(ss, 8);
        const float rs = rsqrtf(ss * (1.f / 256.f) + EPS);
        const u32x4 g0 = *(const u32x4*)(OG + off), g1 = *(const u32x4*)(OG + off + 8);
        const float* onp = on + lane * 16;
        u32x4 o0, o1;
#pragma unroll
        for (int e = 0; e < 4; ++e) {
            o0[e] = pk2(v[2 * e] * rs * onp[2 * e] * lof(g0[e]), v[2 * e + 1] * rs * onp[2 * e + 1] * hif(g0[e]));
            o1[e] = pk2(v[8 + 2 * e] * rs * onp[8 + 2 * e] * lof(g1[e]), v[8 + 2 * e + 1] * rs * onp[8 + 2 * e + 1] * hif(g1[e]));
        }
        *(u32x4*)(A2 + off) = o0; *(u32x4*)(A2 + off + 8) = o1;
    }
}

DI void phase_ml_out(const Args& a, int li) {
    gemm_dense_phase((const bf16_t*)(a.ws + ML_A2), D, NTOK, (const bf16_t*)(a.ws + W_MLOUT), 1024, 1024,
        [&](int m0, int n0, const f32x4 (&acc)[4][4]) { epi_resid_f32(a, li, m0, n0, acc); });
}

template <int STAGE>
DI void phase_moe(const Args& a, int li) {
    const int tid = threadIdx.x, lane = tid & 63, wave = tid >> 6;
    const int fr = lane & 15, fq = lane >> 4, wm = wave >> 1, wn = wave & 1;
    const int* cnt = (const int*)(a.ws + WS_CTL + CTL_CNT) + li * 64;
    const int* list = (const int*)(a.ws + WS_LIST);
    const float* wsl = (const float*)(a.ws + WS_WSLOT);
    const bf16_t* F = (const bf16_t*)(a.ws + WS_H);
    bf16_t* HM = (bf16_t*)(a.ws + WS_HMID); bf16_t* Y = (bf16_t*)(a.ws + WS_Y);
    int* pre = (int*)(lds + LDS_AUX);
    int* srowb = pre + 16;
    const int xc = blockIdx.x & 7, rank = blockIdx.x >> 3, nrank = gridDim.x >> 3;
    __syncthreads();
    if (tid == 0) { int s = 0; for (int i = 0; i < 8; ++i) { pre[i] = s; s += (cnt[xc + 8 * i] + 127) >> 7; } pre[8] = s; }
    __syncthreads();
    const int T = pre[8];
    constexpr int NTN = STAGE == 0 ? 4 : 8;
    constexpr int KK = STAGE == 0 ? 1024 : 256;
    const int total = T * NTN;
    int e = 0, r0 = 0, ce = 0, nt = 0, cur = 0;
    auto decode = [&](int u) {
        const int ti = u / NTN; nt = u % NTN;
        int ei = 0;
#pragma unroll 1
        for (int s = 4; s > 0; s >>= 1) if (pre[ei + s] <= ti) ei += s;
        e = xc + 8 * ei; r0 = (ti - pre[ei]) * 128; ce = cnt[e];
    };
    GemmPipe g;
    auto prep = [&](int buf) {
        int* srow = srowb + buf * 128;
        if (tid < 128) srow[tid] = list[(size_t)e * NTOK + min(r0 + tid, ce - 1)];
        __syncthreads();
        if (STAGE == 0) g.setup([&](int r) { return F + (size_t)(srow[r] >> 1) * D; }, (const bf16_t*)(a.ws + W_GU) + ((size_t)(li * 64 + e) * 512 + nt * 128) * 1024, 1024);
        else g.setup([&](int r) { return HM + (size_t)srow[r] * 256; }, (const bf16_t*)(a.ws + W_DN) + ((size_t)(li * 64 + e) * 1024 + nt * 128) * 256, 256);
        g.issue(0, 0);
    };
    int u = rank;
    if (u < total) { decode(u); prep(cur); }
    while (u < total) {
        f32x4 acc[4][4];
        g.run(KK, acc);
        const int cr0 = r0, cce = ce, cnt_ = nt;
        const int* srow = srowb + cur * 128;
        u += nrank;
        if (u < total) { decode(u); prep(cur ^ 1); }
        if (STAGE == 0) {
            __syncthreads();
            {
                const int tz = opaque_tid();
#pragma unroll
                for (int i = 0; i < 4; ++i) {
                    const int m = lane_m(tz, i);
#pragma unroll
                    for (int p = 0; p < 2; ++p) {
                        const int c = (((tz >> 6) & 1) * 2 + p) * 16 + ((tz >> 4) & 3) * 4;
                        f32x4 v;
#pragma unroll
                        for (int x = 0; x < 4; ++x) { const float gg = acc[i][2 * p][x]; v[x] = gg * rcpf_(1.f + __expf(-gg)) * acc[i][2 * p + 1][x]; }
                        u32x2 o; o[0] = pk2(v[0], v[1]); o[1] = pk2(v[2], v[3]);
                        *(u32x2*)(lds + EPI_OFF + m * 128 + (((c >> 3) ^ (m & 7)) << 4) + (c & 4) * 2) = o;
                    }
                }
            }
            __syncthreads();
            {
                const int tz = opaque_tid();
#pragma unroll
                for (int it = 0; it < 4; ++it) {
                    const int idx = tz + it * NTHR, row = idx >> 3, ch = idx & 7;
                    const u32x4 v = *(const u32x4*)(lds + EPI_OFF + row * 128 + ((ch ^ (row & 7)) << 4));
                    if (cr0 + row < cce) *(u32x4*)(HM + (size_t)srow[row] * 256 + cnt_ * 64 + ch * 8) = v;
                }
            }
        } else {
            float wrow[4];
            {
                const int tz = opaque_tid();
#pragma unroll
                for (int i = 0; i < 4; ++i) wrow[i] = wsl[srow[lane_m(tz, i)]];
            }
            __syncthreads();
            epi_stage_bf16(acc, [&](int i, int, const f32x4 v) { return v * wrow[i]; });
            __syncthreads();
            epi_flush_bf16([&](int row) { return Y + (size_t)srow[row] * D + cnt_ * 128; }, [&](int row) { return cr0 + row < cce; });
        }
        cur ^= 1;
    }
    __syncthreads();
}

#ifndef DBG_GPROBE
#define DBG_GPROBE -1
#endif
template <int PM>
DI void phase_gemm_probe(const Args& a) {
    const bf16_t* A = (const bf16_t*)(a.ws + WS_H); const bf16_t* Bt = (const bf16_t*)(a.ws + W_RGIN);
    float* dummy = (float*)(a.ws + RG_A2);
    const int mt = 144, nt = 16, K = 1024;
    GemmPipe g;
    __syncthreads();
    for (int u = blockIdx.x; u < mt * nt; u += gridDim.x) {
        const int m0 = (u % mt) * 128, n0 = (u / mt) * 128;
        g.setup([&](int r) { return A + (size_t)(m0 + r) * 1024; }, Bt + (size_t)n0 * K, K);
        if (PM & 1) g.issue(0, 0);
        f32x4 acc[4][4];
        g.run_probe<PM>(K, acc);
        float s = 0.f;
#pragma unroll
        for (int i = 0; i < 4; ++i)
#pragma unroll
            for (int j = 0; j < 4; ++j) s += acc[i][j][0] + acc[i][j][1] + acc[i][j][2] + acc[i][j][3];
        if (s == 12345.678f) dummy[threadIdx.x] = s;
        if (PM & 8) {
            bf16_t* Yd = (bf16_t*)(a.ws + WS_Y);
            const int lane = threadIdx.x & 63, wave = threadIdx.x >> 6;
            const int mb = m0 + (wave >> 1) * 64 + (lane & 15), nb = n0 + (wave & 1) * 64 + (lane >> 4) * 4;
#pragma unroll
            for (int i = 0; i < 4; ++i)
#pragma unroll
                for (int j = 0; j < 4; ++j) {
                    f32x4 v = acc[i][j];
                    if (PM & 16) { v[0] = gelu_tanh(v[0]); v[1] = gelu_tanh(v[1]); v[2] = gelu_tanh(v[2]); v[3] = gelu_tanh(v[3]); }
                    st_bf4(Yd + (size_t)(mb + i * 16) * 2048 + nb + j * 16, v);
                }
        }
        __syncthreads();
    }
}

#ifndef DBG_STOP
#define DBG_STOP 99
#endif
#ifndef DBG_OFF
#define DBG_OFF 0
#endif
DI void phase_dbg(const Args& a) {
    const size_t n = (size_t)NLAT * D;
    const float* X = (const float*)(a.ws + WS_X);
    const bf16_t* B = (const bf16_t*)(a.ws + (size_t)DBG_OFF);
    for (size_t i = (size_t)blockIdx.x * NTHR + threadIdx.x; i < n; i += (size_t)gridDim.x * NTHR)
        a.out[i] = DBG_OFF ? bf2f(B[i]) : X[i];
}

constexpr int NPH = 34;
__global__ void __launch_bounds__(NTHR, 2) fwd(const Args a) {
    if (threadIdx.x == 0) *(uint4*)(lds + LDS_BARW) = make_uint4(0u, 0u, 0u, 0u);
    __syncthreads();
    XcdBarrier bar;
    const bool multi = (a.ph_hi - a.ph_lo) > 1;
    if (multi) bar = xcd_barrier_post((unsigned*)(a.ws + WS_CTL), (volatile LAS unsigned*)(lds + LDS_BARW));
#ifndef DBG_REP
#define DBG_REP -1
#endif
#ifndef DBG_REPN
#define DBG_REPN 3
#endif
#define RUN(id, ...) do { if (a.ph_lo <= (id) && (id) < a.ph_hi) { \
        if ((id) == DBG_REP) { for (int rep_ = 1; rep_ < DBG_REPN; ++rep_) { __VA_ARGS__; xcd_barrier(bar); } } \
        __VA_ARGS__; if ((id) + 1 < a.ph_hi) xcd_barrier(bar); } } while (0)
    RUN(0, phase_prologue(a));
    RUN(1, phase_token_row<0>(a, 0));
    RUN(2, phase_rg_in(a, 0));
    if (DBG_GPROBE >= 0) { RUN(2, phase_gemm_probe<(DBG_GPROBE < 0 ? 7 : DBG_GPROBE)>(a)); }
    RUN(3, phase_rg_scan(a, 0));
    RUN(4, phase_rg_combine(a));
    RUN(5, phase_rg_out(a, 0, 0));
    RUN(6, phase_token_router(a, 0));
    RUN(7, phase_moe<0>(a, 0));
    RUN(8, phase_moe<1>(a, 0));
    RUN(9, phase_token_row<0>(a, 1));
    RUN(10, phase_mla_down(a));
    RUN(11, phase_mla_up(a));
    RUN(12, phase_mla_attn(a));
    RUN(13, phase_mla_out(a, 1));
    RUN(14, phase_token_router(a, 1));
    RUN(15, phase_moe<0>(a, 1));
    RUN(16, phase_moe<1>(a, 1));
    RUN(17, phase_token_row<0>(a, 2));
    RUN(18, phase_ml_in(a));
    RUN(19, phase_ml_scan(a));
    RUN(20, phase_ml_readout(a));
    RUN(21, phase_ml_out(a, 2));
    RUN(22, phase_token_router(a, 2));
    RUN(23, phase_moe<0>(a, 2));
    RUN(24, phase_moe<1>(a, 2));
    RUN(25, phase_token_row<0>(a, 3));
    RUN(26, phase_rg_in(a, 1));
    RUN(27, phase_rg_scan(a, 1));
    RUN(28, phase_rg_combine(a));
    RUN(29, phase_rg_out(a, 3, 1));
    RUN(30, phase_token_router(a, 3));
    RUN(31, phase_moe<0>(a, 3));
    RUN(32, phase_moe<1>(a, 3));
    RUN(33, phase_token_row<2>(a, 3));
    RUN(34, phase_dbg(a));
#undef RUN
}

static void add_td(Args& a, int& n, int& tile0, const float* src, bf16_t* dst, const float* rscale, long sb, long db, int K, int N, int Npad, int batch, int perm) {
    TDesc& t = a.td[n++];
    t.src = src; t.dst = dst; t.rscale = rscale; t.sb = sb; t.db = db; t.K = K; t.N = N; t.Npad = Npad; t.batch = batch; t.perm = perm;
    t.tiles_k = (K + 127) / 128; t.tiles_n = (Npad + 63) / 64; t.tile0 = tile0;
    tile0 += batch * t.tiles_k * t.tiles_n;
}

extern "C" void kernel_launch(void* const* d_in, const int* in_sizes, int n_in, void* d_out, int out_size, void* d_ws, size_t ws_size, hipStream_t stream) {
    static int grid = 0;
    if (grid == 0) {
        if (n_in != 32 || out_size != NLAT * D || ws_size < WS_END) { fprintf(stderr, "kernel_launch: unexpected sizes (n_in %d out %d ws %zu need %zu)\n", n_in, out_size, ws_size, (size_t)WS_END); grid = -1; return; }
        int dev = 0, cus = 0, per_cu = 0;
        (void)hipGetDevice(&dev);
        (void)hipDeviceGetAttribute(&cus, hipDeviceAttributeMultiprocessorCount, dev);
        if (hipOccupancyMaxActiveBlocksPerMultiprocessor(&per_cu, (const void*)fwd, NTHR, 0) != hipSuccess) per_cu = 0;
        (void)hipGetLastError();
        if (per_cu < 2) fprintf(stderr, "kernel_launch: note: occupancy query reports %d blocks per CU (need 2)\n", per_cu);
        grid = cus * (per_cu >= 2 ? 2 : (per_cu >= 1 ? 1 : 2));
    }
    if (grid < 0) return;
    (void)in_sizes;
    (void)hipMemsetAsync((char*)d_ws + WS_CTL, 0, CTL_BYTES, stream);
    Args a;
    memset(&a, 0, sizeof(a));
    for (int i = 0; i < 32; ++i) a.in[i] = (const float*)d_in[i];
    a.out = (float*)d_out; a.ws = (unsigned char*)d_ws;
    unsigned char* ws = (unsigned char*)d_ws;
    int n = 0, tile0 = 0;
    add_td(a, n, tile0, a.in[8], (bf16_t*)(ws + W_RGIN), nullptr, 1024L * 2048, 2048L * 1024, 1024, 2048, 2048, 2, 0);
    add_td(a, n, tile0, a.in[14], (bf16_t*)(ws + W_RGOUT), nullptr, 1024L * 1024, 1024L * 1024, 1024, 1024, 1024, 2, 0);
    for (int j = 0; j < 2; ++j) for (int dir = 0; dir < 2; ++dir) for (int g = 0; g < 2; ++g)
        add_td(a, n, tile0, a.in[11] + (size_t)((j * 2 + dir) * 2 + g) * 16 * 4096, (bf16_t*)(ws + W_RGG) + (size_t)(j * 2 + dir) * 16 * 8192 + g * 4096, nullptr, 4096, 8192, 64, 64, 64, 16, 0);
    add_td(a, n, tile0, a.in[15], (bf16_t*)(ws + W_MDOWN), nullptr, 0, 0, 1024, 416, 512, 1, 0);
    add_td(a, n, tile0, a.in[18], (bf16_t*)(ws + W_MUQ), a.in[16], 0, 0, 256, 1536, 1536, 1, 0);
    add_td(a, n, tile0, a.in[19], (bf16_t*)(ws + W_MUKV), a.in[17], 0, 0, 128, 2048, 2048, 1, 0);
    add_td(a, n, tile0, a.in[21], (bf16_t*)(ws + W_MO), nullptr, 0, 0, 1024, 1024, 1024, 1, 0);
    add_td(a, n, tile0, a.in[22], (bf16_t*)(ws + W_MLIN), nullptr, 0, 0, 1024, 3088, 3200, 1, 0);
    add_td(a, n, tile0, a.in[25], (bf16_t*)(ws + W_MLOUT), nullptr, 0, 0, 1024, 1024, 1024, 1, 0);
    add_td(a, n, tile0, a.in[30], (bf16_t*)(ws + W_GU), nullptr, 1024L * 512, 512L * 1024, 1024, 512, 512, 256, 1);
    add_td(a, n, tile0, a.in[31], (bf16_t*)(ws + W_DN), nullptr, 256L * 1024, 1024L * 256, 256, 1024, 1024, 256, 0);
    a.ntiles_total = tile0;
    if (n != NTD) { fprintf(stderr, "kernel_launch: descriptor count %d != %d\n", n, NTD); return; }
#if MK_ONE_LAUNCH
    a.ph_lo = 0; a.ph_hi = NPH;
    hipLaunchKernelGGL(fwd, dim3(grid), dim3(NTHR), 0, stream, a);
#else
    for (int ph = 0; ph < NPH && ph <= DBG_STOP; ++ph) {
        a.ph_lo = ph; a.ph_hi = ph + 1;
        hipLaunchKernelGGL(fwd, dim3(grid), dim3(NTHR), 0, stream, a);
    }
    if (DBG_STOP < NPH) { a.ph_lo = 34; a.ph_hi = 35; hipLaunchKernelGGL(fwd, dim3(grid), dim3(NTHR), 0, stream, a); }
#endif
}
```

```cpp
#include <hip/hip_runtime.h>
#include <stdint.h>
#include <string.h>
#include <stdio.h>

#ifndef MK_ONE_LAUNCH
#define MK_ONE_LAUNCH 1
#endif

#define DI __device__ __forceinline__
typedef unsigned short bf16_t;
typedef __attribute__((ext_vector_type(8))) short bf16x8;
typedef __attribute__((ext_vector_type(4))) float f32x4;
typedef __attribute__((ext_vector_type(16))) float f32x16;
typedef __attribute__((ext_vector_type(2))) float f32x2;
typedef __attribute__((ext_vector_type(2))) __bf16 bfx2;
typedef __attribute__((ext_vector_type(4))) unsigned u32x4;
typedef __attribute__((ext_vector_type(2))) unsigned u32x2;

constexpr int D = 1024, NB = 8, SEQ = 2048, CTXL = 256;
constexpr int NLAT = NB * SEQ, NCTX = NB * CTXL, NTOK = NLAT + NCTX;
constexpr int NKEY = CTXL + SEQ;
constexpr int NTHR = 256;
constexpr int LDS_BYTES = 73728;
constexpr int LDS_AUX = 65536;
constexpr int LDS_BARW = LDS_BYTES - 16;
constexpr float EPS = 1e-6f;

constexpr size_t al256(size_t x) { return (x + 255) & ~(size_t)255; }
constexpr size_t WS_CTL = 0;
constexpr size_t CTL_BYTES = 65536;
constexpr size_t CTL_CNT = 16384;
constexpr size_t CTL_ROPE = 32768;
constexpr size_t WS_MOD = WS_CTL + CTL_BYTES;
constexpr size_t WS_X = al256(WS_MOD + 4 * 9 * 6144 * 4);
constexpr size_t WS_H = al256(WS_X + (size_t)NTOK * D * 4);
constexpr size_t WS_SCR = al256(WS_H + (size_t)NTOK * D * 2);
constexpr size_t SCR_BYTES = (size_t)256 << 20;
constexpr size_t TOKD2 = (size_t)NTOK * D * 2;
constexpr size_t RG_G = WS_SCR, RG_U = RG_G + TOKD2, RG_HS = RG_U + TOKD2, RG_A2 = RG_HS + 2 * TOKD2;
constexpr size_t MLA_CQ = WS_SCR;
constexpr size_t MLA_CKV = MLA_CQ + (size_t)NTOK * 256 * 2;
constexpr size_t MLA_KR = MLA_CKV + (size_t)NTOK * 128 * 2;
constexpr size_t MLA_Q = MLA_KR + (size_t)NTOK * 32 * 4;
constexpr size_t MLA_K = MLA_Q + (size_t)NTOK * 1536 * 2;
constexpr size_t MLA_VT = MLA_K + (size_t)NB * 16 * NKEY * 96 * 2;
constexpr size_t MLA_O = MLA_VT + (size_t)NB * 16 * 64 * NKEY * 2;
constexpr size_t MLA_END = MLA_O + TOKD2;
constexpr size_t ML_Q = WS_SCR;
constexpr size_t ML_K = ML_Q + (size_t)NTOK * 512 * 2;
constexpr size_t ML_KT = ML_K + (size_t)NTOK * 512 * 2;
constexpr size_t ML_VT = ML_KT + (size_t)NTOK * 512 * 2;
constexpr size_t ML_OG = ML_VT + TOKD2;
constexpr size_t ML_GT = ML_OG + TOKD2;
constexpr size_t ML_HS = ML_GT + (size_t)NTOK * 16 * 4;
constexpr size_t ML_A2 = ML_HS + 2 * TOKD2;
constexpr size_t ML_END = ML_A2 + TOKD2;
static_assert(RG_A2 + TOKD2 <= WS_SCR + SCR_BYTES && MLA_END <= WS_SCR + SCR_BYTES && ML_END <= WS_SCR + SCR_BYTES, "scratch");
constexpr size_t WS_LIST = WS_SCR + SCR_BYTES;
constexpr size_t WS_WSLOT = al256(WS_LIST + (size_t)64 * NTOK * 4);
constexpr size_t WS_HMID = al256(WS_WSLOT + (size_t)2 * NTOK * 4);
constexpr size_t WS_Y = al256(WS_HMID + (size_t)2 * NTOK * 256 * 2);
constexpr size_t WS_W = al256(WS_Y + (size_t)2 * NTOK * D * 2);
constexpr size_t W_RGIN = WS_W;
constexpr size_t W_RGOUT = W_RGIN + (size_t)2 * 2048 * 1024 * 2;
constexpr size_t W_RGG = W_RGOUT + (size_t)2 * 1024 * 1024 * 2;
constexpr size_t W_MDOWN = W_RGG + (size_t)2 * 2 * 16 * 128 * 64 * 2;
constexpr size_t W_MUQ = W_MDOWN + (size_t)512 * 1024 * 2;
constexpr size_t W_MUKV = W_MUQ + (size_t)1536 * 256 * 2;
constexpr size_t W_MO = W_MUKV + (size_t)2048 * 128 * 2;
constexpr size_t W_MLIN = W_MO + (size_t)1024 * 1024 * 2;
constexpr size_t W_MLOUT = W_MLIN + (size_t)3200 * 1024 * 2;
constexpr size_t W_RT = W_MLOUT + (size_t)1024 * 1024 * 2;
constexpr size_t W_GU = al256(W_RT + (size_t)4 * 2 * 80 * 1024 * 2);
constexpr size_t W_DN = W_GU + (size_t)256 * 512 * 1024 * 2;
constexpr size_t WS_END = W_DN + (size_t)256 * 1024 * 256 * 2;

struct TDesc {
    const float* src; bf16_t* dst; const float* rscale;
    long sb, db;
    int K, N, Npad, batch;
    int perm, tiles_k, tiles_n, tile0;
};
constexpr int NTD = 18;
struct Args {
    const float* in[32];
    float* out;
    unsigned char* ws;
    TDesc td[NTD];
    int ntiles_total, ph_lo, ph_hi, pad0;
};

DI float bf2f(bf16_t v) { return __uint_as_float((unsigned)v << 16); }
DI unsigned pk2(float a, float b) { f32x2 v = {a, b}; bfx2 r = __builtin_convertvector(v, bfx2); return __builtin_bit_cast(unsigned, r); }
DI bf16_t f2bf(float a) { return (bf16_t)(pk2(a, 0.f) & 0xffffu); }
DI float lof(unsigned u) { return __uint_as_float(u << 16); }
DI float hif(unsigned u) { return __uint_as_float(u & 0xffff0000u); }
DI float rcpf_(float x) { return __builtin_amdgcn_rcpf(x); }
DI float fexp(float x) { return __builtin_amdgcn_exp2f(x * 1.4426950408889634f); }
DI float sigmoidf_(float x) { return rcpf_(1.f + fexp(-x)); }
DI float gelu_tanh(float x) { float u = 0.7978845608028654f * (x + 0.044715f * x * x * x); float e = fexp(2.f * u); return x * (1.f - rcpf_(e + 1.f)); }
DI int tok_modrow(int t) { return t < NLAT ? (t >> 11) : 8; }
DI void dma16(const void* g, char* l) { __builtin_amdgcn_global_load_lds((const unsigned*)g, (unsigned*)l, 16, 0, 0); }
DI void wait_vm0() { asm volatile("s_waitcnt vmcnt(0)" ::: "memory"); }
DI int swz128(int row, int chunk) { return row * 128 + ((chunk ^ (row & 7)) << 4); }
DI int swz256(int row, int chunk) { return row * 256 + ((chunk ^ (row & 15)) << 4); }
DI f32x4 mfma16(bf16x8 a, bf16x8 b, f32x4 c) { return __builtin_amdgcn_mfma_f32_16x16x32_bf16(a, b, c, 0, 0, 0); }
DI f32x16 mfma32(bf16x8 a, bf16x8 b, f32x16 c) { return __builtin_amdgcn_mfma_f32_32x32x16_bf16(a, b, c, 0, 0, 0); }
DI bf16x8 ldsv8(const char* p) { return *(const bf16x8*)p; }
DI void st_bf4(bf16_t* p, const f32x4 v) { u32x2 o; o[0] = pk2(v[0], v[1]); o[1] = pk2(v[2], v[3]); *(u32x2*)p = o; }

__shared__ __attribute__((aligned(16))) char lds[LDS_BYTES];

#define XB_TMO      128
#define XB_XCNT(j)  (256  + 64 * (j))
#define XB_XSUB(j)  (1280 + 64 * (j))
#define XB_XGEN(j)  (2304 + 64 * (j))
#define XB_TOP      3328
#define XB_TOPGEN   3392
#define XCD_BAR_WORDS 3456
#define XB_SPIN_CAP (1u << 22)
#define LAS __attribute__((address_space(3)))
DI unsigned xb_ld(unsigned* p)              { return __hip_atomic_load(p, __ATOMIC_RELAXED, __HIP_MEMORY_SCOPE_AGENT); }
DI unsigned xb_add(unsigned* p, unsigned v) { return __hip_atomic_fetch_add(p, v, __ATOMIC_RELAXED, __HIP_MEMORY_SCOPE_AGENT); }
DI unsigned xb_xcc_id() { return (unsigned)__builtin_amdgcn_s_getreg((3 << 11) | 20) & 0xFu; }
#define XB_SPIN(cond, bar) do { unsigned _sp = 0; while (cond) { __builtin_amdgcn_s_sleep(1); \
    if ((++_sp & 255u) == 0u) { if (xb_ld(&(bar)[XB_TMO])) break; if (_sp > XB_SPIN_CAP) { atomicAdd(&(bar)[XB_TMO], 1u); break; } } } } while (0)
struct XcdBarrier { unsigned* bar; unsigned x; volatile LAS unsigned* st; };
DI XcdBarrier xcd_barrier_post(unsigned* bar, volatile LAS unsigned* st) {
    XcdBarrier b; b.bar = bar; b.x = xb_xcc_id(); b.st = st;
    if (threadIdx.x == 0) (void)xb_add(&bar[XB_XCNT(b.x)], 1u);
    return b;
}
DI void xcd_barrier_complete(unsigned* bar, unsigned x, unsigned& nloc, unsigned& nx) {
    const unsigned G = gridDim.x * gridDim.y * gridDim.z;
    unsigned sum, cnt, mine, sp = 0u;
    for (;;) {
        sum = 0u; cnt = 0u; mine = 0u;
#pragma unroll
        for (unsigned j = 0; j < 16; ++j) { const unsigned c = xb_ld(&bar[XB_XCNT(j)]); sum += c; cnt += (c > 0u) ? 1u : 0u; mine = (j == x) ? c : mine; }
        if (sum == G) break;
        __builtin_amdgcn_s_sleep(1);
        if ((++sp & 255u) == 0u) { if (xb_ld(&bar[XB_TMO])) break; if (sp > XB_SPIN_CAP) { atomicAdd(&bar[XB_TMO], 1u); break; } }
    }
    nloc = mine > 0u ? mine : 1u; nx = cnt > 0u ? cnt : 1u;
}
DI void xcd_barrier(const XcdBarrier& b) {
    asm volatile("s_waitcnt vmcnt(0)" ::: "memory");
    __syncthreads();
    if (threadIdx.x == 0) {
        unsigned* bar = b.bar;
        __builtin_amdgcn_s_waitcnt(0);
        unsigned nloc = b.st[0], nx = b.st[1];
        if (nloc == 0u) { xcd_barrier_complete(bar, b.x, nloc, nx); b.st[0] = nloc; b.st[1] = nx; }
        const unsigned old = xb_add(&bar[XB_XSUB(b.x)], 1u);
        const unsigned gen = old / nloc;
        if (old + 1u == (gen + 1u) * nloc) {
            __builtin_amdgcn_fence(__ATOMIC_RELEASE, "agent");
            asm volatile("s_waitcnt vmcnt(0)" ::: "memory");
            const unsigned og = xb_add(&bar[XB_TOP], 1u);
            const unsigned tg = og / nx;
            if (og + 1u == (tg + 1u) * nx) xb_add(&bar[XB_TOPGEN], 1u);
            else XB_SPIN(xb_ld(&bar[XB_TOPGEN]) == tg, bar);
            __builtin_amdgcn_fence(__ATOMIC_ACQUIRE, "agent");
            xb_add(&bar[XB_XGEN(b.x)], 1u);
            asm volatile("s_waitcnt vmcnt(0)" ::: "memory");
        } else {
            XB_SPIN(xb_ld(&bar[XB_XGEN(b.x)]) == gen, bar);
            __builtin_amdgcn_fence(__ATOMIC_ACQUIRE, "agent");
            asm volatile("s_waitcnt vmcnt(0)" ::: "memory");
        }
    }
    __syncthreads();
}

DI void phase_prologue(const Args& a) {
    const int tid = threadIdx.x;
    const int n_ada = 96, n_rt = 4;
    const int total = n_ada + n_rt + a.ntiles_total;
    float* sc = (float*)lds;
    for (int u = blockIdx.x; u < total; u += gridDim.x) {
        __syncthreads();
        if (u < n_ada) {
            const float* c = a.in[1]; const float* cc = a.in[3];
            for (int i = tid; i < 9 * 1024; i += NTHR) {
                float v = i < 8192 ? c[i] : cc[i - 8192];
                sc[i] = v / (1.f + __expf(-v));
            }
            __syncthreads();
            const int n = u * 256 + tid, li = n / 6144, nn = n - li * 6144;
            const float* w = a.in[4] + (size_t)li * 1024 * 6144 + nn;
            float acc[9];
#pragma unroll
            for (int r = 0; r < 9; ++r) acc[r] = 0.f;
            const float* wp = w;
#pragma unroll 1
            for (int k0 = 0; k0 < 1024; k0 += 16) {
                float wv[16];
#pragma unroll
                for (int kk = 0; kk < 16; ++kk) { wv[kk] = *wp; wp += 6144; }
#pragma unroll
                for (int kk = 0; kk < 16; kk += 4)
#pragma unroll
                    for (int r = 0; r < 9; ++r) {
                        const f32x4 s4 = *(const f32x4*)(sc + r * 1024 + k0 + kk);
                        acc[r] += s4[0] * wv[kk] + s4[1] * wv[kk + 1] + s4[2] * wv[kk + 2] + s4[3] * wv[kk + 3];
                    }
            }
            const float bias = a.in[5][li * 6144 + nn];
            float* mod = (float*)(a.ws + WS_MOD) + (size_t)li * 9 * 6144 + nn;
#pragma unroll
            for (int r = 0; r < 9; ++r) mod[(size_t)r * 6144] = acc[r] + bias;
        } else if (u < n_ada + n_rt) {
            const int li = u - n_ada;
            bf16_t* rt = (bf16_t*)(a.ws + W_RT) + (size_t)li * 2 * 80 * 1024;
            const float* wg = a.in[26] + (size_t)li * 1024 * 8;
            const float* we = a.in[28] + (size_t)li * 1024 * 64;
            if (li == 0) {
                float* rt_ = (float*)(a.ws + WS_CTL + CTL_ROPE);
                for (int i = tid; i < 512; i += NTHR) {
                    const int pos = i >> 3, fi = i & 7;
                    const float ang = (float)pos * powf(10000.f, -(float)fi * 0.125f);
                    rt_[i] = cosf(ang); rt_[512 + i] = sinf(ang);
                }
            }
            for (int i = tid; i < 80 * 1024; i += NTHR) {
                const int n = i >> 10, k = i & 1023;
                float v = n < 8 ? wg[k * 8 + n] : (n < 72 ? we[k * 64 + (n - 8)] : 0.f);
                const bf16_t h = f2bf(v);
                rt[i] = h;
                rt[80 * 1024 + i] = f2bf(v - bf2f(h));
            }
        } else {
            const int tix = u - n_ada - n_rt;
            int di = 0;
#pragma unroll 1
            for (int i = 1; i < NTD; ++i) if (tix >= a.td[i].tile0) di = i;
            const TDesc& td = a.td[di];
            int rem = tix - td.tile0;
            const int per = td.tiles_k * td.tiles_n;
            const int bi = rem / per; rem -= bi * per;
            const int tk = rem % td.tiles_k, tn = rem / td.tiles_k;
            const float* src = td.src + (size_t)bi * td.sb;
            bf16_t* dst = td.dst + (size_t)bi * td.db;
            const int k0 = tk * 128, n0 = tn * 64;
            const int c4 = tid & 15, kr = tid >> 4;
            const int N = td.N, K = td.K;
            f32x4 L0[4], L1[4];
            const bool nok = n0 + 4 * c4 < N;
#pragma unroll
            for (int i = 0; i < 4; ++i) {
                const int k = k0 + 32 * i + 2 * kr;
                L0[i] = (f32x4){0.f, 0.f, 0.f, 0.f}; L1[i] = L0[i];
                if (nok && k < K) {
                    L0[i] = *(const f32x4*)(src + (size_t)k * N + n0 + 4 * c4);
                    L1[i] = *(const f32x4*)(src + (size_t)(k + 1) * N + n0 + 4 * c4);
                    if (td.rscale) { L0[i] *= td.rscale[k]; L1[i] *= td.rscale[k + 1]; }
                }
            }
            unsigned* st = (unsigned*)lds;
#pragma unroll
            for (int i = 0; i < 4; ++i) {
                const int kp = 16 * i + kr;
#pragma unroll
                for (int j = 0; j < 4; ++j) st[(4 * c4 + j) * 68 + kp] = pk2(L0[i][j], L1[i][j]);
            }
            __syncthreads();
#pragma unroll
            for (int i = 0; i < 4; ++i) {
                const int id = tid + i * 256, n = id >> 4, kc = id & 15;
                const u32x4 o = *(const u32x4*)(st + n * 68 + kc * 4);
                int nd = n0 + n;
                if (nd < td.Npad && k0 + kc * 8 < K) {
                    if (td.perm) { const int c = nd & 255, up = nd >> 8; nd = ((c >> 4) << 5) + (up << 4) + (c & 15); }
                    *(u32x4*)(dst + (size_t)nd * K + k0 + kc * 8) = o;
                }
            }
        }
    }
}

template <int MODE>
DI void phase_token(const Args& a, const int li) {
    const int tid = threadIdx.x, lane = tid & 63, wave = tid >> 6;
    const int r = lane & 15, q = lane >> 4;
    float* X = (float*)(a.ws + WS_X);
    bf16_t* H = (bf16_t*)(a.ws + WS_H);
    const bf16_t* Y = (const bf16_t*)(a.ws + WS_Y);
    const float* MOD = (const float*)(a.ws + WS_MOD);
    const bool combine = (MODE == 0 && li > 0) || MODE == 2;
    const int ngroups = (MODE == 2 || (MODE == 1 && li == 3)) ? NLAT / 16 : NTOK / 16;
    float* lg = (float*)(lds + wave * 16 * 80 * 4);
    for (int g = blockIdx.x * 4 + wave; g < ngroups; g += gridDim.x * 4) {
        const int t = g * 16 + r;
        const int mr = tok_modrow(g * 16);
        const float* xsrc = (MODE == 0 && li == 0) ? (t < NLAT ? a.in[0] + (size_t)t * D : a.in[2] + (size_t)(t - NLAT) * D) : X + (size_t)t * D;
        const bf16_t* y0 = Y + (size_t)(2 * t) * D;
        const bf16_t* y1 = y0 + D;
        const int lprev = MODE == 2 ? 3 : li - 1;
        const float* g5 = MOD + ((size_t)(lprev < 0 ? 0 : lprev) * 9 + mr) * 6144 + 5 * 1024;
        float ss = 0.f;
        if (MODE != 2) {
#pragma unroll 4
            for (int kk = 0; kk < 32; ++kk) {
                const int k = kk * 32 + q * 8;
                f32x4 x0 = *(const f32x4*)(xsrc + k), x1 = *(const f32x4*)(xsrc + k + 4);
                if (combine) {
                    const u32x4 ya = *(const u32x4*)(y0 + k), yb = *(const u32x4*)(y1 + k);
                    const f32x4 ga = *(const f32x4*)(g5 + k), gb = *(const f32x4*)(g5 + k + 4);
                    x0[0] += ga[0] * (lof(ya[0]) + lof(yb[0])); x0[1] += ga[1] * (hif(ya[0]) + hif(yb[0]));
                    x0[2] += ga[2] * (lof(ya[1]) + lof(yb[1])); x0[3] += ga[3] * (hif(ya[1]) + hif(yb[1]));
                    x1[0] += gb[0] * (lof(ya[2]) + lof(yb[2])); x1[1] += gb[1] * (hif(ya[2]) + hif(yb[2]));
                    x1[2] += gb[2] * (lof(ya[3]) + lof(yb[3])); x1[3] += gb[3] * (hif(ya[3]) + hif(yb[3]));
                }
#pragma unroll
                for (int j = 0; j < 4; ++j) ss += x0[j] * x0[j] + x1[j] * x1[j];
            }
            ss += __shfl_xor(ss, 16); ss += __shfl_xor(ss, 32);
        }
        const float rstd = rsqrtf(ss * (1.f / 1024.f) + EPS);
        const float* gn = (MODE == 1 ? a.in[7] : a.in[6]) + (size_t)li * D;
        const float* mscale = MOD + ((size_t)li * 9 + mr) * 6144 + (MODE == 1 ? 4 : 1) * 1024;
        const float* mshift = MOD + ((size_t)li * 9 + mr) * 6144 + (MODE == 1 ? 3 : 0) * 1024;
        const bf16_t* rwh = (const bf16_t*)(a.ws + W_RT) + (size_t)li * 2 * 80 * 1024 + (size_t)r * 1024 + q * 8;
        f32x4 lacc[5];
#pragma unroll
        for (int i = 0; i < 5; ++i) lacc[i] = (f32x4){0.f, 0.f, 0.f, 0.f};
#pragma unroll 2
        for (int kk = 0; kk < 32; ++kk) {
            const int k = kk * 32 + q * 8;
            f32x4 x0 = *(const f32x4*)(xsrc + k), x1 = *(const f32x4*)(xsrc + k + 4);
            if (combine) {
                const u32x4 ya = *(const u32x4*)(y0 + k), yb = *(const u32x4*)(y1 + k);
                const f32x4 ga = *(const f32x4*)(g5 + k), gb = *(const f32x4*)(g5 + k + 4);
                x0[0] += ga[0] * (lof(ya[0]) + lof(yb[0])); x0[1] += ga[1] * (hif(ya[0]) + hif(yb[0]));
                x0[2] += ga[2] * (lof(ya[1]) + lof(yb[1])); x0[3] += ga[3] * (hif(ya[1]) + hif(yb[1]));
                x1[0] += gb[0] * (lof(ya[2]) + lof(yb[2])); x1[1] += gb[1] * (hif(ya[2]) + hif(yb[2]));
                x1[2] += gb[2] * (lof(ya[3]) + lof(yb[3])); x1[3] += gb[3] * (hif(ya[3]) + hif(yb[3]));
            }
            if (MODE == 2) {
                *(f32x4*)(a.out + (size_t)t * D + k) = x0; *(f32x4*)(a.out + (size_t)t * D + k + 4) = x1;
                continue;
            }
            if (MODE == 0 && (li == 0 || combine)) { *(f32x4*)(X + (size_t)t * D + k) = x0; *(f32x4*)(X + (size_t)t * D + k + 4) = x1; }
            const f32x4 n0 = *(const f32x4*)(gn + k), n1 = *(const f32x4*)(gn + k + 4);
            const f32x4 s0 = *(const f32x4*)(mscale + k), s1 = *(const f32x4*)(mscale + k + 4);
            const f32x4 h0 = *(const f32x4*)(mshift + k), h1 = *(const f32x4*)(mshift + k + 4);
            float f[8];
#pragma unroll
            for (int j = 0; j < 4; ++j) {
                f[j] = x0[j] * rstd * n0[j] * (1.f + s0[j]) + h0[j];
                f[4 + j] = x1[j] * rstd * n1[j] * (1.f + s1[j]) + h1[j];
            }
            u32x4 hv;
            hv[0] = pk2(f[0], f[1]); hv[1] = pk2(f[2], f[3]); hv[2] = pk2(f[4], f[5]); hv[3] = pk2(f[6], f[7]);
            *(u32x4*)(H + (size_t)t * D + k) = hv;
            if (MODE == 1) {
                u32x4 lv;
                lv[0] = pk2(f[0] - lof(hv[0]), f[1] - hif(hv[0])); lv[1] = pk2(f[2] - lof(hv[1]), f[3] - hif(hv[1]));
                lv[2] = pk2(f[4] - lof(hv[2]), f[5] - hif(hv[2])); lv[3] = pk2(f[6] - lof(hv[3]), f[7] - hif(hv[3]));
                const bf16x8 fh = __builtin_bit_cast(bf16x8, hv), fl = __builtin_bit_cast(bf16x8, lv);
#pragma unroll
                for (int nt = 0; nt < 5; ++nt) {
                    const bf16x8 wh = *(const bf16x8*)(rwh + (size_t)nt * 16 * 1024 + kk * 32);
                    const bf16x8 wl = *(const bf16x8*)(rwh + (size_t)(80 + nt * 16) * 1024 + kk * 32);
                    lacc[nt] = mfma16(fh, wh, lacc[nt]);
                    lacc[nt] = mfma16(fh, wl, lacc[nt]);
                    lacc[nt] = mfma16(fl, wh, lacc[nt]);
                }
            }
        }
        if (MODE == 1) {
#pragma unroll
            for (int nt = 0; nt < 5; ++nt)
#pragma unroll
                for (int j = 0; j < 4; ++j) lg[(q * 4 + j) * 80 + nt * 16 + r] = lacc[nt][j];
            asm volatile("s_waitcnt lgkmcnt(0)" ::: "memory");
            __builtin_amdgcn_wave_barrier();
            if (lane < 16) {
                const float* L = lg + lane * 80;
                const float* bg = a.in[27] + li * 8;
                const float* be = a.in[29] + li * 64;
                float gmax = -3.0e38f; int gi = 0; float gl[8];
#pragma unroll
                for (int j = 0; j < 8; ++j) { gl[j] = L[j] + bg[j]; if (gl[j] > gmax) { gmax = gl[j]; gi = j; } }
                float ps = 0.f;
#pragma unroll
                for (int j = 0; j < 8; ++j) ps += __expf(gl[j] - gmax);
                const float ptop = 1.f / ps;
                float e1 = -3.0e38f, e2 = -3.0e38f; int i1 = 0, i2 = 0;
#pragma unroll
                for (int j = 0; j < 8; ++j) {
                    const float v = L[8 + gi * 8 + j] + be[gi * 8 + j];
                    if (v > e1) { e2 = e1; i2 = i1; e1 = v; i1 = j; } else if (v > e2) { e2 = v; i2 = j; }
                }
                const float ex = __expf(e2 - e1);
                const float w1 = ptop / (1.f + ex), w2 = ptop * ex / (1.f + ex);
                const int tt = g * 16 + lane;
                int* cnt = (int*)(a.ws + WS_CTL + CTL_CNT) + li * 64;
                int* list = (int*)(a.ws + WS_LIST);
                float* wsl = (float*)(a.ws + WS_WSLOT);
                const int ea = gi * 8 + i1, eb = gi * 8 + i2;
                const int pa = atomicAdd(&cnt[ea], 1); list[(size_t)ea * NTOK + pa] = 2 * tt; wsl[2 * tt] = w1;
                const int pb = atomicAdd(&cnt[eb], 1); list[(size_t)eb * NTOK + pb] = 2 * tt + 1; wsl[2 * tt + 1] = w2;
            }
            __builtin_amdgcn_wave_barrier();
        }
    }
}

DI float wave_sum(float v) {
    v += __shfl_xor(v, 1); v += __shfl_xor(v, 2); v += __shfl_xor(v, 4); v += __shfl_xor(v, 8); v += __shfl_xor(v, 16); v += __shfl_xor(v, 32);
    return v;
}
template <int MODE>
DI void phase_token_row(const Args& a, const int li) {
    const int tid = threadIdx.x, lane = tid & 63, wave = tid >> 6;
    float* X = (float*)(a.ws + WS_X);
    bf16_t* H = (bf16_t*)(a.ws + WS_H);
    const bf16_t* Y = (const bf16_t*)(a.ws + WS_Y);
    const float* MOD = (const float*)(a.ws + WS_MOD);
    const bool combine = MODE == 2 || li > 0;
    const bool first = MODE == 0 && li == 0;
    const int npairs = (MODE == 2 ? NLAT : NTOK) / 2;
    const int lprev = MODE == 2 ? 3 : (li > 0 ? li - 1 : 0);
    const float* gn = a.in[6] + (size_t)li * D;
    for (int p = blockIdx.x * 4 + wave; p < npairs; p += gridDim.x * 4) {
        const int t0 = 2 * p, mr = tok_modrow(t0);
        f32x4 x[2][4];
#pragma unroll
        for (int i = 0; i < 2; ++i) {
            const int t = t0 + i;
            const float* xs = first ? (t < NLAT ? a.in[0] + (size_t)t * D : a.in[2] + (size_t)(t - NLAT) * D) : X + (size_t)t * D;
#pragma unroll
            for (int j = 0; j < 4; ++j) x[i][j] = *(const f32x4*)(xs + 256 * j + 4 * lane);
        }
        if (combine) {
            const float* g5 = MOD + ((size_t)lprev * 9 + mr) * 6144 + 5 * 1024;
            f32x4 g[4];
#pragma unroll
            for (int j = 0; j < 4; ++j) g[j] = *(const f32x4*)(g5 + 256 * j + 4 * lane);
#pragma unroll
            for (int i = 0; i < 2; ++i) {
                const bf16_t* y0 = Y + (size_t)(2 * (t0 + i)) * D;
#pragma unroll
                for (int j = 0; j < 4; ++j) {
                    const u32x2 ya = *(const u32x2*)(y0 + 256 * j + 4 * lane), yb = *(const u32x2*)(y0 + D + 256 * j + 4 * lane);
                    x[i][j][0] += g[j][0] * (lof(ya[0]) + lof(yb[0])); x[i][j][1] += g[j][1] * (hif(ya[0]) + hif(yb[0]));
                    x[i][j][2] += g[j][2] * (lof(ya[1]) + lof(yb[1])); x[i][j][3] += g[j][3] * (hif(ya[1]) + hif(yb[1]));
                }
            }
        }
        if (MODE == 2) {
#pragma unroll
            for (int i = 0; i < 2; ++i)
#pragma unroll
                for (int j = 0; j < 4; ++j) *(f32x4*)(a.out + (size_t)(t0 + i) * D + 256 * j + 4 * lane) = x[i][j];
            continue;
        }
        float rstd[2];
#pragma unroll
        for (int i = 0; i < 2; ++i) {
            float ss = 0.f;
#pragma unroll
            for (int j = 0; j < 4; ++j) ss += x[i][j][0] * x[i][j][0] + x[i][j][1] * x[i][j][1] + x[i][j][2] * x[i][j][2] + x[i][j][3] * x[i][j][3];
            rstd[i] = rsqrtf(wave_sum(ss) * (1.f / 1024.f) + EPS);
        }
        const float* msc = MOD + ((size_t)li * 9 + mr) * 6144 + 1 * 1024;
        const float* msh = MOD + ((size_t)li * 9 + mr) * 6144;
#pragma unroll
        for (int j = 0; j < 4; ++j) {
            const f32x4 n4 = *(const f32x4*)(gn + 256 * j + 4 * lane), s4 = *(const f32x4*)(msc + 256 * j + 4 * lane), h4 = *(const f32x4*)(msh + 256 * j + 4 * lane);
            const f32x4 gs = n4 * (s4 + 1.f);
#pragma unroll
            for (int i = 0; i < 2; ++i) {
                const f32x4 f = x[i][j] * rstd[i] * gs + h4;
                st_bf4(H + (size_t)(t0 + i) * D + 256 * j + 4 * lane, f);
                if (first || combine) *(f32x4*)(X + (size_t)(t0 + i) * D + 256 * j + 4 * lane) = x[i][j];
            }
        }
    }
}

DI void phase_token_router(const Args& a, const int li) {
    const int tid = threadIdx.x, lane = tid & 63, wave = tid >> 6;
    const int r = lane & 15, q = lane >> 4;
    const float* X = (const float*)(a.ws + WS_X);
    bf16_t* H = (bf16_t*)(a.ws + WS_H);
    const float* MOD = (const float*)(a.ws + WS_MOD);
    const float* gn = a.in[7] + (size_t)li * D;
    const int ngroups = (li == 3 ? NLAT : NTOK) / 16;
    char* sHi = lds; char* sLo = lds + 32768;
    float* sP = (float*)lds;
    float* sL = (float*)(lds + 32768);
    const bf16_t* rwh = (const bf16_t*)(a.ws + W_RT) + (size_t)li * 2 * 80 * 1024 + (size_t)r * 1024 + q * 8;
    for (int g = blockIdx.x; g < ngroups; g += gridDim.x) {
        const int mr = tok_modrow(g * 16);
        const float* msc = MOD + ((size_t)li * 9 + mr) * 6144 + 4 * 1024;
        const float* msh = MOD + ((size_t)li * 9 + mr) * 6144 + 3 * 1024;
        __syncthreads();
        {
            f32x4 x[4][4];
#pragma unroll
            for (int i = 0; i < 4; ++i)
#pragma unroll
                for (int j = 0; j < 4; ++j) x[i][j] = *(const f32x4*)(X + (size_t)(g * 16 + wave * 4 + i) * D + 256 * j + 4 * lane);
            float rstd[4];
#pragma unroll
            for (int i = 0; i < 4; ++i) {
                float ss = 0.f;
#pragma unroll
                for (int j = 0; j < 4; ++j) ss += x[i][j][0] * x[i][j][0] + x[i][j][1] * x[i][j][1] + x[i][j][2] * x[i][j][2] + x[i][j][3] * x[i][j][3];
                rstd[i] = rsqrtf(wave_sum(ss) * (1.f / 1024.f) + EPS);
            }
#pragma unroll
            for (int j = 0; j < 4; ++j) {
                const f32x4 n4 = *(const f32x4*)(gn + 256 * j + 4 * lane), s4 = *(const f32x4*)(msc + 256 * j + 4 * lane), h4 = *(const f32x4*)(msh + 256 * j + 4 * lane);
                const f32x4 gs = n4 * (s4 + 1.f);
#pragma unroll
                for (int i = 0; i < 4; ++i) {
                    const int row = wave * 4 + i;
                    const f32x4 f = x[i][j] * rstd[i] * gs + h4;
                    u32x2 hv; hv[0] = pk2(f[0], f[1]); hv[1] = pk2(f[2], f[3]);
                    u32x2 lv; lv[0] = pk2(f[0] - lof(hv[0]), f[1] - hif(hv[0])); lv[1] = pk2(f[2] - lof(hv[1]), f[3] - hif(hv[1]));
                    *(u32x2*)(H + (size_t)(g * 16 + row) * D + 256 * j + 4 * lane) = hv;
                    const int off = row * 2048 + (((32 * j + (lane >> 1)) ^ row) << 4) + (lane & 1) * 8;
                    *(u32x2*)(sHi + off) = hv; *(u32x2*)(sLo + off) = lv;
                }
            }
        }
        __syncthreads();
        f32x4 lacc[5];
#pragma unroll
        for (int i = 0; i < 5; ++i) lacc[i] = (f32x4){0.f, 0.f, 0.f, 0.f};
#pragma unroll 2
        for (int s = 0; s < 8; ++s) {
            const int kk = wave * 8 + s;
            const int off = r * 2048 + (((kk * 4 + q) ^ r) << 4);
            const bf16x8 fh = ldsv8(sHi + off), fl = ldsv8(sLo + off);
#pragma unroll
            for (int nt = 0; nt < 5; ++nt) {
                const bf16x8 wh = *(const bf16x8*)(rwh + (size_t)nt * 16 * 1024 + kk * 32);
                const bf16x8 wl = *(const bf16x8*)(rwh + (size_t)(80 + nt * 16) * 1024 + kk * 32);
                lacc[nt] = mfma16(fh, wh, lacc[nt]);
                lacc[nt] = mfma16(fh, wl, lacc[nt]);
                lacc[nt] = mfma16(fl, wh, lacc[nt]);
            }
        }
        __syncthreads();
#pragma unroll
        for (int nt = 0; nt < 5; ++nt)
#pragma unroll
            for (int j = 0; j < 4; ++j) sP[(wave * 16 + q * 4 + j) * 80 + nt * 16 + r] = lacc[nt][j];
        __syncthreads();
        for (int i = tid; i < 16 * 80; i += NTHR) sL[i] = sP[i] + sP[1280 + i] + sP[2560 + i] + sP[3840 + i];
        __syncthreads();
        if (tid < 16) {
            const float* L = sL + tid * 80;
            const float* bg = a.in[27] + li * 8;
            const float* be = a.in[29] + li * 64;
            float gmax = -3.0e38f; int gi = 0; float gl[8];
#pragma unroll
            for (int j = 0; j < 8; ++j) { gl[j] = L[j] + bg[j]; if (gl[j] > gmax) { gmax = gl[j]; gi = j; } }
            float ps = 0.f;
#pragma unroll
            for (int j = 0; j < 8; ++j) ps += __expf(gl[j] - gmax);
            const float ptop = 1.f / ps;
            float e1 = -3.0e38f, e2 = -3.0e38f; int i1 = 0, i2 = 0;
#pragma unroll
            for (int j = 0; j < 8; ++j) {
                const float v = L[8 + gi * 8 + j] + be[gi * 8 + j];
                if (v > e1) { e2 = e1; i2 = i1; e1 = v; i1 = j; } else if (v > e2) { e2 = v; i2 = j; }
            }
            const float ex = __expf(e2 - e1);
            const float w1 = ptop / (1.f + ex), w2 = ptop * ex / (1.f + ex);
            const int tt = g * 16 + tid;
            int* cnt = (int*)(a.ws + WS_CTL + CTL_CNT) + li * 64;
            int* list = (int*)(a.ws + WS_LIST);
            float* wsl = (float*)(a.ws + WS_WSLOT);
            const int ea = gi * 8 + i1, eb = gi * 8 + i2;
            const int pa = atomicAdd(&cnt[ea], 1); list[(size_t)ea * NTOK + pa] = 2 * tt; wsl[2 * tt] = w1;
            const int pb = atomicAdd(&cnt[eb], 1); list[(size_t)eb * NTOK + pb] = 2 * tt + 1; wsl[2 * tt + 1] = w2;
        }
    }
}

template <int WM, int WN, int MT, int NT, bool PFALL = true, class AP>
DI void gemm_tile(AP arow, const bf16_t* Bt, const int ldb, const int K, f32x4 (&acc)[MT][NT], float* ssq = nullptr) {
    constexpr int BM = WM * MT * 16, BN = WN * NT * 16;
    constexpr int A_BYTES = BM * 128, B_BYTES = BN * 128, STAGE = A_BYTES + B_BYTES;
    constexpr int ACH = BM * 8 / NTHR, BCH = BN * 8 / NTHR;
    static_assert(2 * STAGE <= LDS_AUX, "gemm LDS");
    const int tid = threadIdx.x, lane = tid & 63, wave = tid >> 6;
    const int wm = wave / WN, wn = wave % WN;
    const int fr = lane & 15, fq = lane >> 4;
    const bf16_t* ap[ACH]; const bf16_t* bp[BCH];
#pragma unroll
    for (int i = 0; i < ACH; ++i) { const int idx = tid + i * NTHR, row = idx >> 3, c = (idx & 7) ^ (row & 7); ap[i] = arow(row) + c * 8; }
#pragma unroll
    for (int i = 0; i < BCH; ++i) { const int idx = tid + i * NTHR, row = idx >> 3, c = (idx & 7) ^ (row & 7); bp[i] = Bt + (size_t)row * ldb + c * 8; }
#pragma unroll
    for (int i = 0; i < MT; ++i)
#pragma unroll
        for (int j = 0; j < NT; ++j) acc[i][j] = (f32x4){0.f, 0.f, 0.f, 0.f};
    const int KT = K >> 6;
    {
        char* sa = lds; char* sb = lds + A_BYTES;
#pragma unroll
        for (int i = 0; i < ACH; ++i) dma16(ap[i], sa + (tid + i * NTHR) * 16);
#pragma unroll
        for (int i = 0; i < BCH; ++i) dma16(bp[i], sb + (tid + i * NTHR) * 16);
    }
#pragma unroll 1
    for (int kt = 0; kt < KT; ++kt) {
        wait_vm0();
        __syncthreads();
        if (kt + 1 < KT) {
            char* sa = lds + ((kt + 1) & 1) * STAGE; char* sb = sa + A_BYTES;
            const int ko = (kt + 1) * 64;
#pragma unroll
            for (int i = 0; i < ACH; ++i) dma16(ap[i] + ko, sa + (tid + i * NTHR) * 16);
#pragma unroll
            for (int i = 0; i < BCH; ++i) dma16(bp[i] + ko, sb + (tid + i * NTHR) * 16);
        }
        const char* sa = lds + (kt & 1) * STAGE; const char* sb = sa + A_BYTES;
        if (PFALL) {
            bf16x8 xf[2][MT], wf[2][NT];
#pragma unroll
            for (int kk = 0; kk < 2; ++kk) {
#pragma unroll
                for (int i = 0; i < MT; ++i) xf[kk][i] = ldsv8(sa + swz128(wm * MT * 16 + i * 16 + fr, kk * 4 + fq));
#pragma unroll
                for (int j = 0; j < NT; ++j) wf[kk][j] = ldsv8(sb + swz128(wn * NT * 16 + j * 16 + fr, kk * 4 + fq));
            }
            __builtin_amdgcn_sched_barrier(0);
            __builtin_amdgcn_s_setprio(1);
#pragma unroll
            for (int kk = 0; kk < 2; ++kk)
#pragma unroll
                for (int i = 0; i < MT; ++i)
#pragma unroll
                    for (int j = 0; j < NT; ++j) acc[i][j] = mfma16(wf[kk][j], xf[kk][i], acc[i][j]);
            __builtin_amdgcn_s_setprio(0);
        } else {
#pragma unroll
            for (int kk = 0; kk < 2; ++kk) {
                bf16x8 xf[MT], wf[NT];
#pragma unroll
                for (int i = 0; i < MT; ++i) xf[i] = ldsv8(sa + swz128(wm * MT * 16 + i * 16 + fr, kk * 4 + fq));
#pragma unroll
                for (int j = 0; j < NT; ++j) wf[j] = ldsv8(sb + swz128(wn * NT * 16 + j * 16 + fr, kk * 4 + fq));
#pragma unroll
                for (int i = 0; i < MT; ++i)
#pragma unroll
                    for (int j = 0; j < NT; ++j) acc[i][j] = mfma16(wf[j], xf[i], acc[i][j]);
                if (ssq) {
#pragma unroll
                    for (int i = 0; i < MT; ++i) {
                        const u32x4 xu = __builtin_bit_cast(u32x4, xf[i]);
#pragma unroll
                        for (int d = 0; d < 4; ++d) { const bfx2 p = __builtin_bit_cast(bfx2, xu[d]); ssq[i] = __builtin_amdgcn_fdot2_f32_bf16(p, p, ssq[i], false); }
                    }
                }
            }
        }
    }
    __syncthreads();
}


struct GemmPipe {
    static constexpr int A_BYTES = 128 * 128, STAGE = 2 * A_BYTES;
    const bf16_t* ap[4]; const bf16_t* bp[4];
    template <class AP>
    DI void setup(AP arow, const bf16_t* Bt, const int ldb) {
        const int tid = threadIdx.x;
#pragma unroll
        for (int i = 0; i < 4; ++i) {
            const int idx = tid + i * NTHR, row = idx >> 3, c = (idx & 7) ^ (row & 7);
            ap[i] = arow(row) + c * 8; bp[i] = Bt + (size_t)row * ldb + c * 8;
        }
    }
    DI void issue(const int kt, const int buf) const {
        const int tid = threadIdx.x;
        char* sa = lds + buf * STAGE; char* sb = sa + A_BYTES;
        const int ko = kt * 64;
#pragma unroll
        for (int i = 0; i < 4; ++i) dma16(ap[i] + ko, sa + (tid + i * NTHR) * 16);
#pragma unroll
        for (int i = 0; i < 4; ++i) dma16(bp[i] + ko, sb + (tid + i * NTHR) * 16);
    }
    template <int PM>
    DI void run_probe(const int K, f32x4 (&acc)[4][4]) const {
        const int tid = threadIdx.x, lane = tid & 63, wave = tid >> 6;
        const int wm = wave >> 1, wn = wave & 1, fr = lane & 15, fq = lane >> 4;
#pragma unroll
        for (int i = 0; i < 4; ++i)
#pragma unroll
            for (int j = 0; j < 4; ++j) acc[i][j] = (f32x4){0.f, 0.f, 0.f, 0.f};
        const int KT = K >> 6;
#pragma unroll 1
        for (int kt = 0; kt < KT; ++kt) {
            if (PM & 4) { wait_vm0(); __syncthreads(); }
            if ((PM & 1) && kt + 1 < KT) issue(kt + 1, (kt + 1) & 1);
            if (PM & 2) {
                const char* sa = lds + (kt & 1) * STAGE; const char* sb = sa + A_BYTES;
                bf16x8 xf[2][4], wf[2][4];
#pragma unroll
                for (int kk = 0; kk < 2; ++kk) {
#pragma unroll
                    for (int i = 0; i < 4; ++i) xf[kk][i] = ldsv8(sa + swz128(wm * 64 + i * 16 + fr, kk * 4 + fq));
#pragma unroll
                    for (int j = 0; j < 4; ++j) wf[kk][j] = ldsv8(sb + swz128(wn * 64 + j * 16 + fr, kk * 4 + fq));
                }
                __builtin_amdgcn_sched_barrier(0);
                __builtin_amdgcn_s_setprio(1);
#pragma unroll
                for (int kk = 0; kk < 2; ++kk)
#pragma unroll
                    for (int i = 0; i < 4; ++i)
#pragma unroll
                        for (int j = 0; j < 4; ++j) acc[i][j] = mfma16(wf[kk][j], xf[kk][i], acc[i][j]);
                __builtin_amdgcn_s_setprio(0);
            }
        }
        wait_vm0();
    }
    DI void run(const int K, f32x4 (&acc)[4][4]) const {
        const int tid = threadIdx.x, lane = tid & 63, wave = tid >> 6;
        const int wm = wave >> 1, wn = wave & 1, fr = lane & 15, fq = lane >> 4;
#pragma unroll
        for (int i = 0; i < 4; ++i)
#pragma unroll
            for (int j = 0; j < 4; ++j) acc[i][j] = (f32x4){0.f, 0.f, 0.f, 0.f};
        const int KT = K >> 6;
#pragma unroll 1
        for (int kt = 0; kt < KT; ++kt) {
            wait_vm0();
            __syncthreads();
            if (kt + 1 < KT) issue(kt + 1, (kt + 1) & 1);
            const char* sa = lds + (kt & 1) * STAGE; const char* sb = sa + A_BYTES;
            bf16x8 xf[2][4], wf[2][4];
#pragma unroll
            for (int kk = 0; kk < 2; ++kk) {
#pragma unroll
                for (int i = 0; i < 4; ++i) xf[kk][i] = ldsv8(sa + swz128(wm * 64 + i * 16 + fr, kk * 4 + fq));
#pragma unroll
                for (int j = 0; j < 4; ++j) wf[kk][j] = ldsv8(sb + swz128(wn * 64 + j * 16 + fr, kk * 4 + fq));
            }
            __builtin_amdgcn_sched_barrier(0);
            __builtin_amdgcn_s_setprio(1);
#pragma unroll
            for (int kk = 0; kk < 2; ++kk)
#pragma unroll
                for (int i = 0; i < 4; ++i)
#pragma unroll
                    for (int j = 0; j < 4; ++j) acc[i][j] = mfma16(wf[kk][j], xf[kk][i], acc[i][j]);
            __builtin_amdgcn_s_setprio(0);
        }
    }
};

constexpr int EPI_OFF = 32768;
DI int lane_m(int i) { const int t = threadIdx.x; return ((t >> 7) & 1) * 64 + i * 16 + (t & 15); }
DI int lane_n(int j) { const int t = threadIdx.x; return ((t >> 6) & 1) * 64 + j * 16 + ((t >> 4) & 3) * 4; }
DI int opaque_tid() { int t = threadIdx.x; asm volatile("" : "+v"(t)); return t; }
DI int lane_m(int t, int i) { return ((t >> 7) & 1) * 64 + i * 16 + (t & 15); }
DI int lane_n(int t, int j) { return ((t >> 6) & 1) * 64 + j * 16 + ((t >> 4) & 3) * 4; }
template <class XF>
DI void epi_stage_bf16(const f32x4 (&acc)[4][4], XF xf) {
    const int tz = opaque_tid();
#pragma unroll
    for (int i = 0; i < 4; ++i) {
        const int m = lane_m(tz, i);
#pragma unroll
        for (int j = 0; j < 4; ++j) {
            const int n = lane_n(tz, j);
            const f32x4 v = xf(i, j, acc[i][j]);
            u32x2 o; o[0] = pk2(v[0], v[1]); o[1] = pk2(v[2], v[3]);
            *(u32x2*)(lds + EPI_OFF + m * 256 + (((n >> 3) ^ (m & 15)) << 4) + (n & 4) * 2) = o;
        }
    }
}
template <class DP, class OK>
DI void epi_flush_bf16(DP dst, OK ok) {
    const int tz = opaque_tid();
#pragma unroll
    for (int it = 0; it < 8; ++it) {
        const int idx = tz + it * NTHR, row = idx >> 4, ch = idx & 15;
        const u32x4 v = *(const u32x4*)(lds + EPI_OFF + row * 256 + ((ch ^ (row & 15)) << 4));
        if (ok(row)) *(u32x4*)(dst(row) + ch * 8) = v;
    }
}
template <class XF>
DI void epi_stage_bf16_T(const f32x4 (&acc)[4][4], XF xf) {
    const int tz = opaque_tid();
    const bool odd = tz & 1;
#pragma unroll
    for (int i = 0; i < 4; ++i) {
        const int m = lane_m(tz, i) & ~1;
#pragma unroll
        for (int j = 0; j < 4; ++j) {
            const int n = lane_n(tz, j) + (odd ? 2 : 0);
            const f32x4 v = xf(i, j, acc[i][j]);
            const float r0 = __shfl_xor(odd ? v[0] : v[2], 1), r1 = __shfl_xor(odd ? v[1] : v[3], 1);
            const unsigned w0 = odd ? pk2(r0, v[2]) : pk2(v[0], r0), w1 = odd ? pk2(r1, v[3]) : pk2(v[1], r1);
            *(unsigned*)(lds + EPI_OFF + n * 256 + (((m >> 3) ^ (n & 15)) << 4) + (m & 6) * 2) = w0;
            *(unsigned*)(lds + EPI_OFF + (n + 1) * 256 + (((m >> 3) ^ ((n + 1) & 15)) << 4) + (m & 6) * 2) = w1;
        }
    }
}
DI void epi_resid_f32(const Args& a, const int li, const int m0, const int n0, const f32x4 (&acc)[4][4]) {
    const int tz = opaque_tid();
    float* X = (float*)(a.ws + WS_X);
    const float* gate = (const float*)(a.ws + WS_MOD) + ((size_t)li * 9 + tok_modrow(m0)) * 6144 + 2 * 1024 + n0;
#pragma unroll
    for (int j = 0; j < 4; ++j) {
        const int n = lane_n(tz, j);
        const f32x4 g = *(const f32x4*)(gate + n);
#pragma unroll
        for (int i = 0; i < 4; ++i) {
            float* xp = X + (size_t)(m0 + lane_m(tz, i)) * D + n0 + n;
            f32x4 x = *(const f32x4*)xp;
            x += g * acc[i][j];
            *(f32x4*)xp = x;
        }
    }
}

template <bool XPF = true, class TE>
DI void gemm_dense_phase(const bf16_t* A, const int lda, const int mrows, const bf16_t* Bt, const int N, const int K, TE tile_epi) {
    const int mt = mrows / 128, nt = N / 128;
    const int mpx = mt >> 3, bmb = mpx >> 1, full = mpx * 8;
    auto decode = [&](int u, int& m0, int& n0) {
        const int xc = u & 7, s = u >> 3;
        const int bn = s / full, rem = s - bn * full;
        const int w = min(8, nt - 8 * bn);
        const int bm = rem / (bmb * w), rem2 = rem - bm * (bmb * w);
        const int ni = rem2 / bmb, mi = rem2 - ni * bmb;
        m0 = (xc * mpx + bm * bmb + mi) * 128; n0 = (bn * 8 + ni) * 128;
    };
    GemmPipe g;
    int u = blockIdx.x, m0 = 0, n0 = 0;
    __syncthreads();
    if (u < mt * nt) { decode(u, m0, n0); g.setup([&](int r) { return A + (size_t)(m0 + r) * lda; }, Bt + (size_t)n0 * K, K); g.issue(0, 0); }
    while (u < mt * nt) {
        f32x4 acc[4][4];
        g.run(K, acc);
        const int cm0 = m0, cn0 = n0;
        u += gridDim.x;
        if (XPF) {
            if (u < mt * nt) { decode(u, m0, n0); g.setup([&](int r) { return A + (size_t)(m0 + r) * lda; }, Bt + (size_t)n0 * K, K); g.issue(0, 0); }
            tile_epi(cm0, cn0, acc);
        } else {
            tile_epi(cm0, cn0, acc);
            __syncthreads();
            if (u < mt * nt) { decode(u, m0, n0); g.setup([&](int r) { return A + (size_t)(m0 + r) * lda; }, Bt + (size_t)n0 * K, K); g.issue(0, 0); }
        }
    }
    __syncthreads();
}
template <class XF, class DP>
DI void epi_bf16_rowmajor(const f32x4 (&acc)[4][4], XF xf, DP dst) {
    __syncthreads();
    epi_stage_bf16(acc, xf);
    __syncthreads();
    epi_flush_bf16(dst, [](int) { return true; });
}

struct CvTile { const float* src; bf16_t* dst; int K, N, perm, k0, n0; };
DI CvTile moe_cv_tile(const Args& a, const int L, const int t) {
    CvTile c;
    const int e = t / 96, r = t - e * 96;
    if (r < 64) {
        c.src = a.in[30] + (size_t)(L * 64 + e) * 1024 * 512; c.dst = (bf16_t*)(a.ws + W_GU) + (size_t)(L * 64 + e) * 512 * 1024;
        c.K = 1024; c.N = 512; c.perm = 1; c.k0 = (r & 7) * 128; c.n0 = (r >> 3) * 64;
    } else {
        const int r2 = r - 64;
        c.src = a.in[31] + (size_t)(L * 64 + e) * 256 * 1024; c.dst = (bf16_t*)(a.ws + W_DN) + (size_t)(L * 64 + e) * 1024 * 256;
        c.K = 256; c.N = 1024; c.perm = 0; c.k0 = (r2 & 1) * 128; c.n0 = (r2 >> 1) * 64;
    }
    return c;
}
DI void cv_load(const CvTile& c, f32x4 (&L0)[4], f32x4 (&L1)[4]) {
    const int tid = threadIdx.x, c4 = tid & 15, kr = tid >> 4;
    const float* p = c.src + (size_t)(c.k0 + 2 * kr) * c.N + c.n0 + 4 * c4;
#pragma unroll
    for (int i = 0; i < 4; ++i) { L0[i] = *(const f32x4*)(p + (size_t)(32 * i) * c.N); L1[i] = *(const f32x4*)(p + (size_t)(32 * i + 1) * c.N); }
}
DI void cv_pack(unsigned* st, const f32x4 (&L0)[4], const f32x4 (&L1)[4]) {
    const int tid = threadIdx.x, c4 = tid & 15, kr = tid >> 4;
#pragma unroll
    for (int i = 0; i < 4; ++i)
#pragma unroll
        for (int j = 0; j < 4; ++j) st[(4 * c4 + j) * 68 + 16 * i + kr] = pk2(L0[i][j], L1[i][j]);
}
DI void cv_flush(const CvTile& c, const unsigned* st) {
    const int tid = threadIdx.x;
#pragma unroll
    for (int i = 0; i < 4; ++i) {
        const int id = tid + i * 256, n = id >> 4, kc = id & 15;
        const u32x4 o = *(const u32x4*)(st + n * 68 + kc * 4);
        int nd = c.n0 + n;
        if (c.perm) { const int cc = nd & 255, up = nd >> 8; nd = ((cc >> 4) << 5) + (up << 4) + (cc & 15); }
        *(u32x4*)(c.dst + (size_t)nd * c.K + c.k0 + kc * 8) = o;
    }
}

DI void phase_rg_in(const Args& a, int j) {
    bf16_t* G = (bf16_t*)(a.ws + RG_G); bf16_t* U = (bf16_t*)(a.ws + RG_U);
    gemm_dense_phase((const bf16_t*)(a.ws + WS_H), D, NTOK, (const bf16_t*)(a.ws + W_RGIN) + (size_t)j * 2048 * 1024, 2048, 1024,
        [&](int m0, int n0, const f32x4 (&acc)[4][4]) {
            if (n0 < 1024)
                epi_bf16_rowmajor(acc, [](int, int, const f32x4 v) { f32x4 g; g[0] = gelu_tanh(v[0]); g[1] = gelu_tanh(v[1]); g[2] = gelu_tanh(v[2]); g[3] = gelu_tanh(v[3]); return g; },
                                  [&](int row) { return G + (size_t)(m0 + row) * D + n0; });
            else
                epi_bf16_rowmajor(acc, [](int, int, const f32x4 v) { return v; }, [&](int row) { return U + (size_t)(m0 + row) * D + (n0 - 1024); });
        });
}

template <int VAR = 0, int HOST = 0>
DI void phase_rg_scan(const Args& a, int j) {
    const int tid = threadIdx.x, lane = tid & 63, wave = tid >> 6;
    const int fr = lane & 15, fq = lane >> 4;
    const bf16_t* U = (const bf16_t*)(a.ws + RG_U);
    bf16_t* HS = (bf16_t*)(a.ws + (VAR ? WS_Y : RG_HS));
    char* sW = lds;
    char* sX = lds + 8192;
    float* sUc = (float*)(lds + 16384);
    float* sA = (float*)(lds + 24576);
    float* sB = (float*)(lds + 33280);
    bf16_t* sO = (bf16_t*)(lds + 41984);
    unsigned* sCv = (unsigned*)(lds + 50176);
    const int c = tid & 7;
    for (int u = blockIdx.x; u < 512; u += gridDim.x) {
        const int half = u & 1, dir = (u >> 1) & 1, blk = (u >> 2) & 15, b = u >> 6;
        const int cin0 = blk * 64, co0 = blk * 64 + half * 32;
        __syncthreads();
        {
            const bf16_t* Wg = (const bf16_t*)(a.ws + W_RGG) + ((size_t)((j * 2 + dir) * 16 + blk)) * 128 * 64;
#pragma unroll
            for (int i = 0; i < 2; ++i) {
                const int idx = tid + i * NTHR, row = idx >> 3, cc = idx & 7;
                const int srow = (row >> 5) * 64 + half * 32 + (row & 31);
                *(u32x4*)(sW + swz128(row, cc)) = *(const u32x4*)(Wg + (size_t)srow * 64 + cc * 8);
            }
        }
        float carry = 0.f;
        float cw[4][8], cb[8];
        {
            const float* cwp = a.in[9] + (size_t)j * 4 * 1024 + cin0 + c * 8; const float* cbp = a.in[10] + (size_t)j * 1024 + cin0 + c * 8;
#pragma unroll
            for (int w = 0; w < 4; ++w) { const f32x4 v0 = *(const f32x4*)(cwp + w * 1024), v1 = *(const f32x4*)(cwp + w * 1024 + 4);
#pragma unroll
                for (int e = 0; e < 4; ++e) { cw[w][e] = v0[e]; cw[w][4 + e] = v1[e]; } }
            const f32x4 v0 = *(const f32x4*)cbp, v1 = *(const f32x4*)(cbp + 4);
#pragma unroll
            for (int e = 0; e < 4; ++e) { cb[e] = v0[e]; cb[4 + e] = v1[e]; }
        }
        float bg0[8], bg1[8], spl[8];
        {
            const float* gb = a.in[12] + ((size_t)(j * 2 + dir) * 2) * 1024 + co0;
            const float* lm = a.in[13] + (size_t)(j * 2 + dir) * 1024 + co0;
#pragma unroll
            for (int jt = 0; jt < 2; ++jt)
#pragma unroll
                for (int e = 0; e < 4; ++e) {
                    const int cc = jt * 16 + fq * 4 + e;
                    bg0[jt * 4 + e] = gb[cc]; bg1[jt * 4 + e] = gb[1024 + cc];
                    spl[jt * 4 + e] = -8.f * log1pf(__expf(-lm[cc]));
                }
        }
        u32x4 pu[2][4];
        auto load_chunk = [&](int ci) {
            const int seg = ci >= 4, L = seg ? SEQ : CTXL, nch = L / 64, jc = seg ? ci - 4 : ci;
            const int oc = dir ? nch - 1 - jc : jc;
            const int rb = seg ? b * SEQ : NLAT + b * CTXL;
            const int s0 = oc * 64;
#pragma unroll
            for (int it = 0; it < 2; ++it) {
                const int tk = (tid >> 3) + it * 32;
#pragma unroll
                for (int w = 0; w < 4; ++w) {
                    const int s = s0 + tk + w - 2;
                    const int sc_ = min(max(s, 0), L - 1);
                    const u32x4 ld = *(const u32x4*)(U + (size_t)(rb + sc_) * D + cin0 + c * 8);
                    const unsigned msk = (s >= 0 && s < L) ? 0xffffffffu : 0u;
                    pu[it][w] = (u32x4){ld[0] & msk, ld[1] & msk, ld[2] & msk, ld[3] & msk};
                }
            }
        };
        load_chunk(0);
        __syncthreads();
        size_t prev_base = 0;
        constexpr int CV_TILES = HOST ? 6144 : 0;
        CvTile cvp; cvp.src = nullptr; cvp.dst = nullptr; cvp.K = 0; cvp.N = 0; cvp.perm = 0; cvp.k0 = 0; cvp.n0 = 0;
        bool cvp_ok = false;
#pragma unroll 1
        for (int ci = 0; ci < 36; ++ci) {
            f32x4 cv0[4], cv1[4];
            CvTile cvc = cvp;
            const int cvq = (ci / 3) * 512 + u;
            const bool cv_ok = HOST && (ci % 3 == 0) && cvq < CV_TILES;
            if (cv_ok) { cvc = moe_cv_tile(a, 1, cvq); cv_load(cvc, cv0, cv1); }
            const int seg = ci >= 4, L = seg ? SEQ : CTXL, nch = L / 64, jc = seg ? ci - 4 : ci;
            const int oc = dir ? nch - 1 - jc : jc;
            const int rb = seg ? b * SEQ : NLAT + b * CTXL;
            const int s0 = oc * 64;
            char* sXc = sX; float* sUcc = sUc;
#pragma unroll
            for (int it = 0; it < 2; ++it) {
                const int tk = (tid >> 3) + it * 32;
                float o[8];
#pragma unroll
                for (int e = 0; e < 8; ++e) o[e] = cb[e];
#pragma unroll
                for (int w = 0; w < 4; ++w) {
                    const u32x4 r4 = pu[it][w];
#pragma unroll
                    for (int e = 0; e < 4; ++e) { o[2 * e] += cw[w][2 * e] * lof(r4[e]); o[2 * e + 1] += cw[w][2 * e + 1] * hif(r4[e]); }
                }
                u32x4 pv; pv[0] = pk2(o[0], o[1]); pv[1] = pk2(o[2], o[3]); pv[2] = pk2(o[4], o[5]); pv[3] = pk2(o[6], o[7]);
                *(u32x4*)(sXc + swz128(tk, c)) = pv;
                if ((c >> 2) == half) {
                    *(f32x4*)(sUcc + tk * 32 + (c & 3) * 8) = (f32x4){o[0], o[1], o[2], o[3]};
                    *(f32x4*)(sUcc + tk * 32 + (c & 3) * 8 + 4) = (f32x4){o[4], o[5], o[6], o[7]};
                }
            }
            if (ci + 1 < 36) load_chunk(ci + 1);
            __syncthreads();
            if (HOST && cvp_ok) cv_flush(cvp, sCv);
            if (ci > 0) {
                const u32x4 v = *(const u32x4*)(sO + ((ci - 1) & 1) * 2048 + tid * 8);
                *(u32x4*)(HS + prev_base + (size_t)(tid >> 2) * D + (tid & 3) * 8) = v;
            }
            {
                f32x4 acc[4];
#pragma unroll
                for (int jt = 0; jt < 4; ++jt) acc[jt] = (f32x4){0.f, 0.f, 0.f, 0.f};
#pragma unroll
                for (int kk = 0; kk < 2; ++kk) {
                    const bf16x8 xf = ldsv8(sXc + swz128(wave * 16 + fr, kk * 4 + fq));
#pragma unroll
                    for (int jt = 0; jt < 4; ++jt) acc[jt] = mfma16(ldsv8(sW + swz128(jt * 16 + fr, kk * 4 + fq)), xf, acc[jt]);
                }
                const int tk = wave * 16 + fr;
#pragma unroll
                for (int jt = 0; jt < 2; ++jt) {
                    const f32x4 uc = *(const f32x4*)(sUcc + tk * 32 + jt * 16 + fq * 4);
                    f32x4 av4, bv4;
#pragma unroll
                    for (int e = 0; e < 4; ++e) {
                        if (VAR & 2) { av4[e] = 0.5f + 0.001f * acc[jt][e]; bv4[e] = uc[e] + acc[jt + 2][e]; continue; }
                        const float rg = sigmoidf_(acc[jt][e] + bg0[jt * 4 + e]);
                        const float ig = sigmoidf_(acc[jt + 2][e] + bg1[jt * 4 + e]);
                        const float av = fexp(rg * spl[jt * 4 + e]);
                        av4[e] = av;
                        bv4[e] = __builtin_amdgcn_sqrtf(fmaxf(1.f - av * av, 0.f)) * ig * uc[e];
                    }
#pragma unroll
                    for (int e = 0; e < 4; ++e) { sA[(jt * 16 + fq * 4 + e) * 68 + tk] = av4[e]; sB[(jt * 16 + fq * 4 + e) * 68 + tk] = bv4[e]; }
                }
            }
            __syncthreads();
            if (!(VAR & 4)) {
                const int ch = wave * 8 + (lane & 7), sg = lane >> 3;
                const int tb = dir ? 56 - sg * 8 : sg * 8;
                const f32x4 a0 = *(const f32x4*)(sA + ch * 68 + tb), a1 = *(const f32x4*)(sA + ch * 68 + tb + 4);
                const f32x4 b0 = *(const f32x4*)(sB + ch * 68 + tb), b1 = *(const f32x4*)(sB + ch * 68 + tb + 4);
                float av[8], bv[8];
#pragma unroll
                for (int e = 0; e < 4; ++e) {
                    av[e] = dir ? a1[3 - e] : a0[e]; av[4 + e] = dir ? a0[3 - e] : a1[e];
                    bv[e] = dir ? b1[3 - e] : b0[e]; bv[4 + e] = dir ? b0[3 - e] : b1[e];
                }
                float Ap = 1.f, Hh = 0.f;
#pragma unroll
                for (int e = 0; e < 8; ++e) { Hh = av[e] * Hh + bv[e]; Ap *= av[e]; }
#pragma unroll
                for (int d = 8; d < 64; d <<= 1) {
                    const float Ao = __shfl_up(Ap, d), Ho = __shfl_up(Hh, d);
                    if (lane >= d) { Hh = Ap * Ho + Hh; Ap = Ap * Ao; }
                }
                float Aex = __shfl_up(Ap, 8), Hex = __shfl_up(Hh, 8);
                if (sg == 0) { Aex = 1.f; Hex = 0.f; }
                float hin = Aex * carry + Hex;
                const float cnew = Ap * carry + Hh;
                carry = __shfl(cnew, 56 + (lane & 7));
                bf16_t* so = sO + (ci & 1) * 2048 + ch;
#pragma unroll
                for (int e = 0; e < 8; ++e) {
                    hin = av[e] * hin + bv[e];
                    const int i = sg * 8 + e, tk = dir ? 63 - i : i;
                    so[tk * 32] = f2bf(hin);
                }
            }
            prev_base = (size_t)dir * NTOK * D + (size_t)(rb + s0) * D + co0;
            if (HOST) { if (cv_ok) cv_pack(sCv, cv0, cv1); cvp = cvc; cvp_ok = cv_ok; }
        }
        __syncthreads();
        if (HOST && cvp_ok) cv_flush(cvp, sCv);
        {
            const u32x4 v = *(const u32x4*)(sO + (35 & 1) * 2048 + tid * 8);
            *(u32x4*)(HS + prev_base + (size_t)(tid >> 2) * D + (tid & 3) * 8) = v;
        }
    }
}

DI void phase_rg_combine(const Args& a) {
    const u32x4* G = (const u32x4*)(a.ws + RG_G);
    const u32x4* H0 = (const u32x4*)(a.ws + RG_HS);
    const u32x4* H1 = (const u32x4*)(a.ws + RG_HS + TOKD2);
    u32x4* A2 = (u32x4*)(a.ws + RG_A2);
    const size_t n = (size_t)NTOK * D / 8;
    for (size_t i = (size_t)blockIdx.x * NTHR + threadIdx.x; i < n; i += (size_t)gridDim.x * NTHR) {
        const u32x4 g = G[i], h0 = H0[i], h1 = H1[i];
        u32x4 o;
#pragma unroll
        for (int e = 0; e < 4; ++e) o[e] = pk2(lof(g[e]) * (lof(h0[e]) + lof(h1[e])), hif(g[e]) * (hif(h0[e]) + hif(h1[e])));
        A2[i] = o;
    }
}

DI void phase_rg_out(const Args& a, int li, int j) {
    gemm_dense_phase((const bf16_t*)(a.ws + RG_A2), D, li == 3 ? NLAT : NTOK, (const bf16_t*)(a.ws + W_RGOUT) + (size_t)j * 1024 * 1024, 1024, 1024,
        [&](int m0, int n0, const f32x4 (&acc)[4][4]) { epi_resid_f32(a, li, m0, n0, acc); });
}

DI void phase_mla_down(const Args& a) {
    bf16_t* CQ = (bf16_t*)(a.ws + MLA_CQ); bf16_t* CKV = (bf16_t*)(a.ws + MLA_CKV); float* KR = (float*)(a.ws + MLA_KR);
    gemm_dense_phase((const bf16_t*)(a.ws + WS_H), D, NTOK, (const bf16_t*)(a.ws + W_MDOWN), 512, 1024,
        [&](int m0, int n0, const f32x4 (&acc)[4][4]) {
            if (n0 < 256) epi_bf16_rowmajor(acc, [](int, int, const f32x4 v) { return v; }, [&](int row) { return CQ + (size_t)(m0 + row) * 256 + n0; });
            else if (n0 == 256) epi_bf16_rowmajor(acc, [](int, int, const f32x4 v) { return v; }, [&](int row) { return CKV + (size_t)(m0 + row) * 128; });
            else {
#pragma unroll
                for (int i = 0; i < 4; ++i)
#pragma unroll
                    for (int j = 0; j < 2; ++j) { const int n = lane_n(j); if (n < 32) *(f32x4*)(KR + (size_t)(m0 + lane_m(i)) * 32 + n) = acc[i][j]; }
            }
        });
}

DI int perm_key(int kp) { return (kp & ~12) | ((kp & 4) << 1) | ((kp & 8) >> 1); }

DI void phase_mla_up(const Args& a) {
    const int tid = threadIdx.x;
    const bf16_t* CQ = (const bf16_t*)(a.ws + MLA_CQ); const bf16_t* CKV = (const bf16_t*)(a.ws + MLA_CKV); const float* KR = (const float*)(a.ws + MLA_KR);
    bf16_t* Q = (bf16_t*)(a.ws + MLA_Q); bf16_t* Kb = (bf16_t*)(a.ws + MLA_K); bf16_t* VT = (bf16_t*)(a.ws + MLA_VT);
    const float* qkn = a.in[20];
    const float* RC = (const float*)(a.ws + WS_CTL + CTL_ROPE); const float* RS = RC + 512;
    const int MT_ = NTOK / 128;
    const int nq = MT_ * 16, nkv = MT_ * 16;
    const float QSCALE = 0.10206207261596575f * 1.4426950408889634f;
    for (int u = blockIdx.x; u < nq + nkv; u += gridDim.x) {
        const bool isq = u < nq;
        const int uu = isq ? u : u - nq;
        const int m0 = (uu % MT_) * 128, head = uu / MT_;
        const bool islat = m0 < NLAT;
        const int bb = islat ? (m0 >> 11) : ((m0 - NLAT) >> 8);
        const int kp0 = islat ? CTXL + (m0 & (SEQ - 1)) : ((m0 - NLAT) & (CTXL - 1));
        __syncthreads();
        if (isq) {
            f32x4 hold[2][6];
            float ssq[2] = {0.f, 0.f};
            gemm_tile<4, 1, 2, 6, false>([&](int r) { return CQ + (size_t)(m0 + r) * 256; }, (const bf16_t*)(a.ws + W_MUQ) + (size_t)head * 96 * 256, 256, 256, hold, ssq);
            const int tz = opaque_tid();
            const int wave = tz >> 6, fq = (tz >> 4) & 3, fr = tz & 15;
#pragma unroll
            for (int i = 0; i < 2; ++i) {
                const int m = wave * 32 + i * 16 + fr;
                float sq = ssq[i]; sq += __shfl_xor(sq, 16); sq += __shfl_xor(sq, 32);
                const float rs0 = rsqrtf(sq * (1.f / 256.f) + EPS);
                float ss = 0.f;
#pragma unroll
                for (int jn = 0; jn < 6; ++jn) { hold[i][jn] *= rs0;
#pragma unroll
                    for (int e = 0; e < 4; ++e) ss += hold[i][jn][e] * hold[i][jn][e]; }
                ss += __shfl_xor(ss, 16); ss += __shfl_xor(ss, 32);
                const float rs = rsqrtf(ss * (1.f / 96.f) + EPS) ;
                f32x4 o[6];
#pragma unroll
                for (int jn = 0; jn < 6; ++jn) { const f32x4 g4 = *(const f32x4*)(qkn + jn * 16 + fq * 4); o[jn] = hold[i][jn] * rs * g4; }
#pragma unroll
                for (int jn = 4; jn < 6; ++jn) {
                    f32x4 other;
#pragma unroll
                    for (int e = 0; e < 4; ++e) other[e] = __shfl_xor(o[jn][e], 32);
                    if (islat) {
                        const int s = (m0 + m) & (SEQ - 1);
                        const int pos = jn == 4 ? (s >> 6) : (s & 63);
                        const f32x4 cs = *(const f32x4*)(RC + pos * 8 + (fq & 1) * 4), sn = *(const f32x4*)(RS + pos * 8 + (fq & 1) * 4);
#pragma unroll
                        for (int e = 0; e < 4; ++e) o[jn][e] = (fq < 2) ? o[jn][e] * cs[e] - other[e] * sn[e] : o[jn][e] * cs[e] + other[e] * sn[e];
                    }
                }
#pragma unroll
                for (int jn = 0; jn < 6; ++jn) {
                    const f32x4 v = o[jn] * QSCALE;
                    u32x2 pv; pv[0] = pk2(v[0], v[1]); pv[1] = pk2(v[2], v[3]);
                    *(u32x2*)(lds + m * 256 + (((jn * 2 + (fq >> 1)) ^ (m & 15)) << 4) + (fq & 1) * 8) = pv;
                }
            }
            __syncthreads();
#pragma unroll
            for (int it = 0; it < 8; ++it) {
                const int idx = tz + it * NTHR, row = idx >> 4, ch = idx & 15;
                if (ch < 12) {
                    const u32x4 v = *(const u32x4*)(lds + row * 256 + ((ch ^ (row & 15)) << 4));
                    *(u32x4*)(Q + (size_t)(m0 + row) * 1536 + head * 96 + ch * 8) = v;
                }
            }
        } else {
            f32x4 hold[4][4];
            float ssq[4] = {0.f, 0.f, 0.f, 0.f};
            gemm_tile<2, 2, 4, 4, false>([&](int r) { return CKV + (size_t)(m0 + r) * 128; }, (const bf16_t*)(a.ws + W_MUKV) + (size_t)head * 128 * 128, 128, 128, hold, ssq);
            const int tz = opaque_tid();
            const int wave = tz >> 6, wm = wave >> 1, wn = wave & 1, fq = (tz >> 4) & 3, fr = tz & 15;
            char* sK = lds; char* sV = lds + 32768;
#pragma unroll
            for (int i = 0; i < 4; ++i) {
                const int m = wm * 64 + i * 16 + fr, t = m0 + m;
                float sq = ssq[i]; sq += __shfl_xor(sq, 16); sq += __shfl_xor(sq, 32);
                const float rs0 = rsqrtf(sq * (1.f / 128.f) + EPS);
#pragma unroll
                for (int jn = 0; jn < 4; ++jn) hold[i][jn] *= rs0;
                if (wn == 0) {
                    const int base = (fq >> 1) * 16 + (fq & 1) * 4;
                    const f32x4 z1 = *(const f32x4*)(KR + (size_t)t * 32 + base);
                    const f32x4 z2 = *(const f32x4*)(KR + (size_t)t * 32 + base + 8);
                    float ss = 0.f;
#pragma unroll
                    for (int jn = 0; jn < 4; ++jn)
#pragma unroll
                        for (int e = 0; e < 4; ++e) ss += hold[i][jn][e] * hold[i][jn][e];
#pragma unroll
                    for (int e = 0; e < 4; ++e) ss += z1[e] * z1[e] + z2[e] * z2[e];
                    ss += __shfl_xor(ss, 16); ss += __shfl_xor(ss, 32);
                    const float rs = rsqrtf(ss * (1.f / 96.f) + EPS);
#pragma unroll
                    for (int jn = 0; jn < 4; ++jn) {
                        const f32x4 g4 = *(const f32x4*)(qkn + 96 + jn * 16 + fq * 4);
                        const f32x4 v = hold[i][jn] * rs * g4;
                        u32x2 pv; pv[0] = pk2(v[0], v[1]); pv[1] = pk2(v[2], v[3]);
                        *(u32x2*)(sK + m * 256 + (((jn * 2 + (fq >> 1)) ^ (m & 15)) << 4) + (fq & 1) * 8) = pv;
                    }
                    const f32x4 g1 = *(const f32x4*)(qkn + 96 + 64 + base), g2 = *(const f32x4*)(qkn + 96 + 64 + base + 8);
                    f32x4 a1 = z1 * rs * g1, a2 = z2 * rs * g2;
                    if (islat) {
                        const int s = t & (SEQ - 1);
                        const int pos = (fq >> 1) == 0 ? (s >> 6) : (s & 63);
                        const f32x4 cs = *(const f32x4*)(RC + pos * 8 + (fq & 1) * 4), sn = *(const f32x4*)(RS + pos * 8 + (fq & 1) * 4);
                        const f32x4 b1 = a1 * cs - a2 * sn, b2 = a2 * cs + a1 * sn;
                        a1 = b1; a2 = b2;
                    }
                    u32x2 p1, p2; p1[0] = pk2(a1[0], a1[1]); p1[1] = pk2(a1[2], a1[3]); p2[0] = pk2(a2[0], a2[1]); p2[1] = pk2(a2[2], a2[3]);
                    const int c1 = 8 + (fq >> 1) * 2;
                    *(u32x2*)(sK + m * 256 + ((c1 ^ (m & 15)) << 4) + (fq & 1) * 8) = p1;
                    *(u32x2*)(sK + m * 256 + (((c1 + 1) ^ (m & 15)) << 4) + (fq & 1) * 8) = p2;
                }
                {
                    const bool odd = fr & 1;
                    const int mp = perm_key(m & ~1);
#pragma unroll
                    for (int jn = 0; jn < 4; ++jn) {
                        const f32x4 v = hold[i][jn];
                        const float r0 = __shfl_xor(odd ? v[0] : v[2], 1), r1 = __shfl_xor(odd ? v[1] : v[3], 1);
                        if (wn == 1) {
                            const int e0 = jn * 16 + fq * 4 + (odd ? 2 : 0);
                            const unsigned w0 = odd ? pk2(r0, v[2]) : pk2(v[0], r0), w1 = odd ? pk2(r1, v[3]) : pk2(v[1], r1);
                            *(unsigned*)(sV + e0 * 256 + (((mp >> 3) ^ (e0 & 15)) << 4) + (mp & 6) * 2) = w0;
                            *(unsigned*)(sV + (e0 + 1) * 256 + (((mp >> 3) ^ ((e0 + 1) & 15)) << 4) + (mp & 6) * 2) = w1;
                        }
                    }
                }
            }
            __syncthreads();
            bf16_t* kdst = Kb + ((size_t)(bb * 16 + head) * NKEY + kp0) * 96;
#pragma unroll
            for (int it = 0; it < 8; ++it) {
                const int idx = tz + it * NTHR, row = idx >> 4, ch = idx & 15;
                if (ch < 12) {
                    const u32x4 v = *(const u32x4*)(sK + row * 256 + ((ch ^ (row & 15)) << 4));
                    *(u32x4*)(kdst + (size_t)row * 96 + ch * 8) = v;
                }
            }
            bf16_t* vdst = VT + ((size_t)(bb * 16 + head) * 64) * NKEY + kp0;
#pragma unroll
            for (int it = 0; it < 4; ++it) {
                const int idx = tz + it * NTHR, row = idx >> 4, ch = idx & 15;
                const u32x4 v = *(const u32x4*)(sV + row * 256 + ((ch ^ (row & 15)) << 4));
                *(u32x4*)(vdst + (size_t)row * NKEY + ch * 8) = v;
            }
        }
    }
}

DI void phase_mla_attn(const Args& a) {
    const int tid = threadIdx.x, lane = tid & 63, wave = tid >> 6;
    const int r = lane & 31, h = lane >> 5;
    const bf16_t* Q = (const bf16_t*)(a.ws + MLA_Q); const bf16_t* Kb = (const bf16_t*)(a.ws + MLA_K); const bf16_t* VT = (const bf16_t*)(a.ws + MLA_VT);
    bf16_t* O = (bf16_t*)(a.ws + MLA_O);
    constexpr int KT_B = 64 * 256, VT_B = 64 * 128, ST_B = KT_B + VT_B;
    unsigned* sCv = (unsigned*)(lds + 49152);
    const int cv_per = 12288 / gridDim.x;
    int cvn = 0, itc = 0;
    bool cv_pack_p = false, cv_flush_p = false;
    CvTile cvB, cvC; cvB.src = nullptr; cvB.dst = nullptr; cvB.K = 0; cvB.N = 0; cvB.perm = 0; cvB.k0 = 0; cvB.n0 = 0; cvC = cvB;
    f32x4 cv0[4], cv1[4];
#pragma unroll
    for (int i = 0; i < 4; ++i) { cv0[i] = (f32x4){0.f, 0.f, 0.f, 0.f}; cv1[i] = cv0[i]; }
    auto cv_step = [&](bool may_load) {
        if (cv_flush_p) { cv_flush(cvC, sCv); cv_flush_p = false; }
        if (cv_pack_p) { cv_pack(sCv, cv0, cv1); cvC = cvB; cv_flush_p = true; cv_pack_p = false; }
        if (may_load && cvn < cv_per) {
            const int t = cvn * gridDim.x + blockIdx.x;
            cvB = moe_cv_tile(a, 2 + t / 6144, t % 6144); cv_load(cvB, cv0, cv1); cv_pack_p = true; ++cvn;
        }
    };
    for (int u = blockIdx.x; u < 2048 + 256; u += gridDim.x) {
        const bool isctx = u >= 2048;
        const int uu = isctx ? u - 2048 : u;
        const int qb = isctx ? (uu & 1) : (uu & 15), head = isctx ? ((uu >> 1) & 15) : ((uu >> 4) & 15), b = isctx ? (uu >> 5) : (uu >> 8);
        const int ntile = isctx ? CTXL / 64 : NKEY / 64;
        const int t = (isctx ? NLAT + b * CTXL : b * SEQ) + qb * 128 + wave * 32 + r;
        const bf16_t* kbase = Kb + (size_t)(b * 16 + head) * NKEY * 96;
        const bf16_t* vbase = VT + (size_t)(b * 16 + head) * 64 * NKEY;
        bf16x8 qf[6];
#pragma unroll
        for (int kk = 0; kk < 6; ++kk) qf[kk] = *(const bf16x8*)(Q + (size_t)t * 1536 + head * 96 + kk * 16 + h * 8);
        f32x16 o[2];
#pragma unroll
        for (int e = 0; e < 16; ++e) { o[0][e] = 0.f; o[1][e] = 0.f; }
        float mrun = -INFINITY, lsum = 0.f;
        __syncthreads();
        auto stage = [&](int kt, int buf) {
            char* sk = lds + buf * ST_B; char* sv = sk + KT_B;
            const int key0 = kt * 64;
#pragma unroll
            for (int i = 0; i < 4; ++i) {
                const int idx = tid + i * NTHR, row = idx >> 4; int c = (idx & 15) ^ (row & 15); if (c >= 12) c = 0;
                dma16(kbase + (size_t)(key0 + row) * 96 + c * 8, sk + idx * 16);
            }
#pragma unroll
            for (int i = 0; i < 2; ++i) {
                const int idx = tid + i * NTHR, row = idx >> 3, c = (idx & 7) ^ ((row >> 1) & 7);
                dma16(vbase + (size_t)row * NKEY + key0 + c * 8, sv + idx * 16);
            }
        };
        stage(0, 0);
#pragma unroll 1
        for (int kt = 0; kt < ntile; ++kt) {
            wait_vm0();
            __syncthreads();
            if (kt + 1 < ntile) stage(kt + 1, (kt + 1) & 1);
            cv_step((itc % 5) == 0); ++itc;
            const char* sk = lds + (kt & 1) * ST_B; const char* sv = sk + KT_B;
            f32x16 st[2];
#pragma unroll
            for (int e = 0; e < 16; ++e) { st[0][e] = 0.f; st[1][e] = 0.f; }
#pragma unroll
            for (int kk = 0; kk < 6; ++kk)
#pragma unroll
                for (int si = 0; si < 2; ++si) {
                    const int s = si * 32 + r;
                    st[si] = mfma32(ldsv8(sk + swz256(s, kk * 2 + h)), qf[kk], st[si]);
                }
            float mx = st[0][0];
#pragma unroll
            for (int e = 0; e < 16; ++e) { mx = fmaxf(mx, st[0][e]); mx = fmaxf(mx, st[1][e]); }
            mx = fmaxf(mx, __shfl_xor(mx, 32));
            const float mnew = fmaxf(mrun, mx);
            const float alpha = __builtin_amdgcn_exp2f(mrun - mnew);
            mrun = mnew;
            float ps = 0.f;
#pragma unroll
            for (int si = 0; si < 2; ++si)
#pragma unroll
                for (int e = 0; e < 16; ++e) { const float p = __builtin_amdgcn_exp2f(st[si][e] - mnew); st[si][e] = p; ps += p; }
            lsum = lsum * alpha + ps;
#pragma unroll
            for (int e = 0; e < 16; ++e) { o[0][e] *= alpha; o[1][e] *= alpha; }
#pragma unroll
            for (int si = 0; si < 2; ++si)
#pragma unroll
                for (int ks = 0; ks < 2; ++ks) {
                    u32x4 pp;
                    pp[0] = pk2(st[si][8 * ks + 0], st[si][8 * ks + 1]); pp[1] = pk2(st[si][8 * ks + 2], st[si][8 * ks + 3]);
                    pp[2] = pk2(st[si][8 * ks + 4], st[si][8 * ks + 5]); pp[3] = pk2(st[si][8 * ks + 6], st[si][8 * ks + 7]);
                    const bf16x8 pf = __builtin_bit_cast(bf16x8, pp);
#pragma unroll
                    for (int et = 0; et < 2; ++et) {
                        const int e = et * 32 + r;
                        o[et] = mfma32(ldsv8(sv + e * 128 + (((si * 4 + ks * 2 + h) ^ ((e >> 1) & 7)) << 4)), pf, o[et]);
                    }
                }
        }
        lsum += __shfl_xor(lsum, 32);
        const float inv = 1.f / lsum;
#pragma unroll
        for (int et = 0; et < 2; ++et)
#pragma unroll
            for (int g = 0; g < 4; ++g) {
                f32x4 v; v[0] = o[et][4 * g] * inv; v[1] = o[et][4 * g + 1] * inv; v[2] = o[et][4 * g + 2] * inv; v[3] = o[et][4 * g + 3] * inv;
                st_bf4(O + (size_t)t * D + head * 64 + et * 32 + 8 * g + 4 * h, v);
            }
    }
    while (cvn < cv_per || cv_pack_p || cv_flush_p) { __syncthreads(); cv_step(!cv_pack_p && !cv_flush_p); }
}

DI void phase_mla_out(const Args& a, int li) {
    gemm_dense_phase((const bf16_t*)(a.ws + MLA_O), D, NTOK, (const bf16_t*)(a.ws + W_MO), 1024, 1024,
        [&](int m0, int n0, const f32x4 (&acc)[4][4]) { epi_resid_f32(a, li, m0, n0, acc); });
}

DI void phase_ml_in(const Args& a) {
    bf16_t* Qm = (bf16_t*)(a.ws + ML_Q); bf16_t* Km = (bf16_t*)(a.ws + ML_K); bf16_t* KT = (bf16_t*)(a.ws + ML_KT); bf16_t* VT = (bf16_t*)(a.ws + ML_VT);
    bf16_t* OG = (bf16_t*)(a.ws + ML_OG); float* GT = (float*)(a.ws + ML_GT);
    const float* gb = a.in[23];
    auto ident = [](int, int, const f32x4 v) { return v; };
    gemm_dense_phase<false>((const bf16_t*)(a.ws + WS_H), D, NTOK, (const bf16_t*)(a.ws + W_MLIN), 3200, 1024,
        [&](int m0, int n0, const f32x4 (&acc)[4][4]) {
            if (n0 < 512) {
                epi_bf16_rowmajor(acc, [](int, int, const f32x4 v) { return v * 0.08838834764831845f; }, [&](int row) { return Qm + (size_t)(m0 + row) * 512 + n0; });
            } else if (n0 < 1024) {
                epi_bf16_rowmajor(acc, ident, [&](int row) { return Km + (size_t)(m0 + row) * 512 + (n0 - 512); });
                __syncthreads();
                epi_stage_bf16_T(acc, ident);
                __syncthreads();
                epi_flush_bf16([&](int row) { return KT + (size_t)(n0 - 512 + row) * NTOK + m0; }, [](int) { return true; });
            } else if (n0 < 2048) {
                __syncthreads();
                epi_stage_bf16_T(acc, ident);
                __syncthreads();
                epi_flush_bf16([&](int row) { return VT + (size_t)(n0 - 1024 + row) * NTOK + m0; }, [](int) { return true; });
            } else if (n0 < 3072) {
                epi_bf16_rowmajor(acc, [](int, int, const f32x4 v) { f32x4 s; s[0] = sigmoidf_(v[0]); s[1] = sigmoidf_(v[1]); s[2] = sigmoidf_(v[2]); s[3] = sigmoidf_(v[3]); return s; },
                                  [&](int row) { return OG + (size_t)(m0 + row) * D + (n0 - 2048); });
            } else {
#pragma unroll
                for (int i = 0; i < 4; ++i) {
                    const int n = lane_n(0);
                    if (n < 16) { f32x4 s = acc[i][0]; s[0] += gb[n]; s[1] += gb[n + 1]; s[2] += gb[n + 2]; s[3] += gb[n + 3]; *(f32x4*)(GT + (size_t)(m0 + lane_m(i)) * 16 + n) = s; }
                }
            }
        });
}

DI void phase_ml_scan(const Args& a) {
    const int tid = threadIdx.x, lane = tid & 63, wave = tid >> 6;
    const int fr = lane & 15, fq = lane >> 4;
    const bf16_t* Qm = (const bf16_t*)(a.ws + ML_Q); const bf16_t* Km = (const bf16_t*)(a.ws + ML_K);
    const bf16_t* KT = (const bf16_t*)(a.ws + ML_KT); const bf16_t* VT = (const bf16_t*)(a.ws + ML_VT);
    const float* GT = (const float*)(a.ws + ML_GT);
    bf16_t* HS = (bf16_t*)(a.ws + ML_HS);
    char* sQ = lds;
    char* sK = lds + 16384;
    char* sS = sK;
    char* sKT = lds + 32768;
    char* sVT = lds + 49152;
    char* sCT = lds + 55296;
    float* sRow = (float*)(lds + 67584);
    float* sCol = sRow + 64;
    float* sInt = sCol + 64;
    float* sNrm = sInt + 64;
    float* sWv = sNrm + 64;
    float* sSc = sWv + 64;
    for (int u = blockIdx.x; u < 512; u += gridDim.x) {
        const int sl = u & 7, dir = (u >> 3) & 1, head = (u >> 4) & 3, b = u >> 6;
        __syncthreads();
        for (int i = tid; i < 12288 / 16; i += NTHR) *(u32x4*)(sCT + i * 16) = (u32x4){0u, 0u, 0u, 0u};
        for (int i = tid; i < 16 * 8; i += NTHR) {
            const int row = 32 + (i >> 3), c = i & 7;
            const unsigned v = row == 32 ? 0x3f803f80u : 0u;
            *(u32x4*)(sVT + swz128(row, c)) = (u32x4){v, v, v, v};
        }
        if (tid == 0) sSc[1] = -1e30f;
        f32x4 accC[2][3];
#pragma unroll
        for (int i = 0; i < 2; ++i)
#pragma unroll
            for (int jn = 0; jn < 3; ++jn) accC[i][jn] = (f32x4){0.f, 0.f, 0.f, 0.f};
        __syncthreads();
#pragma unroll 1
        for (int ci = 0; ci < 36; ++ci) {
            const int seg = ci >= 4, L = seg ? SEQ : CTXL, nch = L / 64, jc = seg ? ci - 4 : ci;
            const int oc = dir ? nch - 1 - jc : jc;
            const int t0 = (seg ? b * SEQ : NLAT + b * CTXL) + oc * 64;
#pragma unroll
            for (int i = 0; i < 4; ++i) {
                const int idx = tid + i * NTHR, row = idx >> 4, c = (idx & 15) ^ (row & 15);
                dma16(Qm + (size_t)(t0 + row) * 512 + head * 128 + c * 8, sQ + idx * 16);
                dma16(Km + (size_t)(t0 + row) * 512 + head * 128 + c * 8, sK + idx * 16);
            }
#pragma unroll
            for (int i = 0; i < 4; ++i) {
                const int idx = tid + i * NTHR, row = idx >> 3, c = (idx & 7) ^ (row & 7);
                dma16(KT + (size_t)(head * 128 + row) * NTOK + t0 + c * 8, sKT + idx * 16);
            }
            {
                const int idx = tid, row = idx >> 3, c = (idx & 7) ^ (row & 7);
                dma16(VT + (size_t)(head * 256 + sl * 32 + row) * NTOK + t0 + c * 8, sVT + idx * 16);
            }
            if (wave == 0) {
                const int s = dir ? 63 - lane : lane;
                const float ig = GT[(size_t)(t0 + s) * 16 + dir * 8 + head];
                const float fg = GT[(size_t)(t0 + s) * 16 + dir * 8 + 4 + head];
                const float lf = fminf(fg, 0.f) - log1pf(__expf(-fabsf(fg)));
                float bc = lf;
#pragma unroll
                for (int d = 1; d < 64; d <<= 1) { const float o = __shfl_up(bc, d); if (lane >= d) bc += o; }
                const float av = ig - bc;
                float pm = av;
#pragma unroll
                for (int d = 1; d < 64; d <<= 1) { const float o = __shfl_up(pm, d); if (lane >= d) pm = fmaxf(pm, o); }
                const float mst = sSc[1];
                const float mm = fmaxf(mst, pm);
                sRow[s] = -mm;
                sCol[s] = av;
                sInt[s] = __expf(mst - mm);
                sNrm[s] = __expf(-(bc + mm));
                const float mmL = __shfl(mm, 63), bL = __shfl(bc, 63);
                sWv[s] = __expf(av - mmL);
                if (lane == 0) { sSc[0] = __expf(mst - mmL); sSc[1] = bL + mmL; }
            }
            wait_vm0();
            __syncthreads();
            f32x4 sacc[4];
#pragma unroll
            for (int jt = 0; jt < 4; ++jt) sacc[jt] = (f32x4){0.f, 0.f, 0.f, 0.f};
#pragma unroll
            for (int kk = 0; kk < 4; ++kk) {
                const bf16x8 qf = ldsv8(sQ + swz256(wave * 16 + fr, kk * 4 + fq));
#pragma unroll
                for (int jt = 0; jt < 4; ++jt) sacc[jt] = mfma16(ldsv8(sK + swz256(jt * 16 + fr, kk * 4 + fq)), qf, sacc[jt]);
            }
            __syncthreads();
            {
                const int tq = wave * 16 + fr;
                const float rt = sRow[tq];
#pragma unroll
                for (int jt = 0; jt < 4; ++jt) {
                    f32x4 v;
#pragma unroll
                    for (int e = 0; e < 4; ++e) {
                        const int s = jt * 16 + fq * 4 + e;
                        const bool ok = dir ? (s >= tq) : (s <= tq);
                        v[e] = ok ? sacc[jt][e] * fexp(rt + sCol[s]) : 0.f;
                    }
                    u32x2 pv; pv[0] = pk2(v[0], v[1]); pv[1] = pk2(v[2], v[3]);
                    *(u32x2*)(sS + swz128(tq, jt * 2 + (fq >> 1)) + (fq & 1) * 8) = pv;
                }
            }
            __syncthreads();
            {
                f32x4 n1[3], n2[3];
#pragma unroll
                for (int jt = 0; jt < 3; ++jt) { n1[jt] = (f32x4){0.f, 0.f, 0.f, 0.f}; n2[jt] = (f32x4){0.f, 0.f, 0.f, 0.f}; }
#pragma unroll
                for (int kk = 0; kk < 2; ++kk) {
                    const bf16x8 sf = ldsv8(sS + swz128(wave * 16 + fr, kk * 4 + fq));
#pragma unroll
                    for (int jt = 0; jt < 3; ++jt) n1[jt] = mfma16(ldsv8(sVT + swz128(jt * 16 + fr, kk * 4 + fq)), sf, n1[jt]);
                }
#pragma unroll
                for (int kk = 0; kk < 4; ++kk) {
                    const bf16x8 qf = ldsv8(sQ + swz256(wave * 16 + fr, kk * 4 + fq));
#pragma unroll
                    for (int jt = 0; jt < 3; ++jt) n2[jt] = mfma16(ldsv8(sCT + swz256(jt * 16 + fr, kk * 4 + fq)), qf, n2[jt]);
                }
                const int tq = wave * 16 + fr;
                const float it = sInt[tq];
                float den = n1[2][0] + it * n2[2][0];
                den = __shfl(den, fr);
                const float dn = fmaxf(fabsf(den), sNrm[tq]);
                const float inv = 1.f / dn;
                bf16_t* hp = HS + (size_t)dir * NTOK * D + (size_t)(t0 + tq) * D + head * 256 + sl * 32 + fq * 4;
#pragma unroll
                for (int jt = 0; jt < 2; ++jt) {
                    f32x4 v;
#pragma unroll
                    for (int e = 0; e < 4; ++e) v[e] = (n1[jt][e] + it * n2[jt][e]) * inv;
                    st_bf4(hp + jt * 16, v);
                }
            }
            {
                const float decay = sSc[0];
#pragma unroll
                for (int i = 0; i < 2; ++i)
#pragma unroll
                    for (int jn = 0; jn < 3; ++jn) accC[i][jn] *= decay;
#pragma unroll
                for (int kk = 0; kk < 2; ++kk) {
                    bf16x8 vf[3];
#pragma unroll
                    for (int jn = 0; jn < 3; ++jn) vf[jn] = ldsv8(sVT + swz128(jn * 16 + fr, kk * 4 + fq));
                    const f32x4 w0 = *(const f32x4*)(sWv + kk * 32 + fq * 8), w1 = *(const f32x4*)(sWv + kk * 32 + fq * 8 + 4);
#pragma unroll
                    for (int i = 0; i < 2; ++i) {
                        const u32x4 kr = *(const u32x4*)(sKT + swz128((wave * 2 + i) * 16 + fr, kk * 4 + fq));
                        u32x4 ks;
                        ks[0] = pk2(lof(kr[0]) * w0[0], hif(kr[0]) * w0[1]); ks[1] = pk2(lof(kr[1]) * w0[2], hif(kr[1]) * w0[3]);
                        ks[2] = pk2(lof(kr[2]) * w1[0], hif(kr[2]) * w1[1]); ks[3] = pk2(lof(kr[3]) * w1[2], hif(kr[3]) * w1[3]);
                        const bf16x8 kf = __builtin_bit_cast(bf16x8, ks);
#pragma unroll
                        for (int jn = 0; jn < 3; ++jn) accC[i][jn] = mfma16(kf, vf[jn], accC[i][jn]);
                    }
                }
            }
            __syncthreads();
#pragma unroll
            for (int i = 0; i < 2; ++i)
#pragma unroll
                for (int jn = 0; jn < 3; ++jn) {
                    const int dd = (wave * 2 + i) * 16 + fq * 4, ee = jn * 16 + fr;
                    u32x2 pv; pv[0] = pk2(accC[i][jn][0], accC[i][jn][1]); pv[1] = pk2(accC[i][jn][2], accC[i][jn][3]);
                    *(u32x2*)(sCT + swz256(ee, dd >> 3) + (dd & 7) * 2) = pv;
                }
            __syncthreads();
        }
    }
}

DI void phase_ml_readout(const Args& a) {
    const int tid = threadIdx.x, lane = tid & 63, wave = tid >> 6;
    const bf16_t* H0 = (const bf16_t*)(a.ws + ML_HS); const bf16_t* H1 = H0 + (size_t)NTOK * D;
    const bf16_t* OG = (const bf16_t*)(a.ws + ML_OG); bf16_t* A2 = (bf16_t*)(a.ws + ML_A2);
    const float* on = a.in[24];
    for (int t = blockIdx.x * 4 + wave; t < NTOK; t += gridDim.x * 4) {
        const size_t off = (size_t)t * D + lane * 16;
        const u32x4 a0 = *(const u32x4*)(H0 + off), a1 = *(const u32x4*)(H0 + off + 8);
        const u32x4 b0 = *(const u32x4*)(H1 + off), b1 = *(const u32x4*)(H1 + off + 8);
        float v[16];
#pragma unroll
        for (int e = 0; e < 4; ++e) {
            v[2 * e] = lof(a0[e]) + lof(b0[e]); v[2 * e + 1] = hif(a0[e]) + hif(b0[e]);
            v[8 + 2 * e] = lof(a1[e]) + lof(b1[e]); v[8 + 2 * e + 1] = hif(a1[e]) + hif(b1[e]);
        }
        float ss = 0.f;
#pragma unroll
        for (int e = 0; e < 16; ++e) ss += v[e] * v[e];
        ss += __shfl_xor(ss, 1); ss += __shfl_xor(ss, 2); ss += __shfl_xor(ss, 4); ss += __shfl_xor(ss, 8);
        const float rs = rsqrtf(ss * (1.f / 256.f) + EPS);
        const u32x4 g0 = *(const u32x4*)(OG + off), g1 = *(const u32x4*)(OG + off + 8);
        const float* onp = on + lane * 16;
        u32x4 o0, o1;
#pragma unroll
        for (int e = 0; e < 4; ++e) {
            o0[e] = pk2(v[2 * e] * rs * onp[2 * e] * lof(g0[e]), v[2 * e + 1] * rs * onp[2 * e + 1] * hif(g0[e]));
            o1[e] = pk2(v[8 + 2 * e] * rs * onp[8 + 2 * e] * lof(g1[e]), v[8 + 2 * e + 1] * rs * onp[8 + 2 * e + 1] * hif(g1[e]));
        }
        *(u32x4*)(A2 + off) = o0; *(u32x4*)(A2 + off + 8) = o1;
    }
}

DI void phase_ml_out(const Args& a, int li) {
    gemm_dense_phase((const bf16_t*)(a.ws + ML_A2), D, NTOK, (const bf16_t*)(a.ws + W_MLOUT), 1024, 1024,
        [&](int m0, int n0, const f32x4 (&acc)[4][4]) { epi_resid_f32(a, li, m0, n0, acc); });
}

template <int STAGE>
DI void phase_moe(const Args& a, int li) {
    const int tid = threadIdx.x, lane = tid & 63, wave = tid >> 6;
    const int fr = lane & 15, fq = lane >> 4, wm = wave >> 1, wn = wave & 1;
    const int* cnt = (const int*)(a.ws + WS_CTL + CTL_CNT) + li * 64;
    const int* list = (const int*)(a.ws + WS_LIST);
    const float* wsl = (const float*)(a.ws + WS_WSLOT);
    const bf16_t* F = (const bf16_t*)(a.ws + WS_H);
    bf16_t* HM = (bf16_t*)(a.ws + WS_HMID); bf16_t* Y = (bf16_t*)(a.ws + WS_Y);
    int* pre = (int*)(lds + LDS_AUX);
    int* srowb = pre + 16;
    const int xc = blockIdx.x & 7, rank = blockIdx.x >> 3, nrank = gridDim.x >> 3;
    __syncthreads();
    if (tid == 0) { int s = 0; for (int i = 0; i < 8; ++i) { pre[i] = s; s += (cnt[xc + 8 * i] + 127) >> 7; } pre[8] = s; }
    __syncthreads();
    const int T = pre[8];
    constexpr int NTN = STAGE == 0 ? 4 : 8;
    constexpr int KK = STAGE == 0 ? 1024 : 256;
    const int total = T * NTN;
    int e = 0, r0 = 0, ce = 0, nt = 0, cur = 0;
    auto decode = [&](int u) {
        const int ti = u / NTN; nt = u % NTN;
        int ei = 0;
#pragma unroll 1
        for (int s = 4; s > 0; s >>= 1) if (pre[ei + s] <= ti) ei += s;
        e = xc + 8 * ei; r0 = (ti - pre[ei]) * 128; ce = cnt[e];
    };
    GemmPipe g;
    auto prep = [&](int buf) {
        int* srow = srowb + buf * 128;
        if (tid < 128) srow[tid] = list[(size_t)e * NTOK + min(r0 + tid, ce - 1)];
        __syncthreads();
        if (STAGE == 0) g.setup([&](int r) { return F + (size_t)(srow[r] >> 1) * D; }, (const bf16_t*)(a.ws + W_GU) + ((size_t)(li * 64 + e) * 512 + nt * 128) * 1024, 1024);
        else g.setup([&](int r) { return HM + (size_t)srow[r] * 256; }, (const bf16_t*)(a.ws + W_DN) + ((size_t)(li * 64 + e) * 1024 + nt * 128) * 256, 256);
        g.issue(0, 0);
    };
    int u = rank;
    if (u < total) { decode(u); prep(cur); }
    while (u < total) {
        f32x4 acc[4][4];
        g.run(KK, acc);
        const int cr0 = r0, cce = ce, cnt_ = nt;
        const int* srow = srowb + cur * 128;
        u += nrank;
        if (u < total) { decode(u); prep(cur ^ 1); }
        if (STAGE == 0) {
            __syncthreads();
            {
                const int tz = opaque_tid();
#pragma unroll
                for (int i = 0; i < 4; ++i) {
                    const int m = lane_m(tz, i);
#pragma unroll
                    for (int p = 0; p < 2; ++p) {
                        const int c = (((tz >> 6) & 1) * 2 + p) * 16 + ((tz >> 4) & 3) * 4;
                        f32x4 v;
#pragma unroll
                        for (int x = 0; x < 4; ++x) { const float gg = acc[i][2 * p][x]; v[x] = gg * rcpf_(1.f + fexp(-gg)) * acc[i][2 * p + 1][x]; }
                        u32x2 o; o[0] = pk2(v[0], v[1]); o[1] = pk2(v[2], v[3]);
                        *(u32x2*)(lds + EPI_OFF + m * 128 + (((c >> 3) ^ (m & 7)) << 4) + (c & 4) * 2) = o;
                    }
                }
            }
            __syncthreads();
            {
                const int tz = opaque_tid();
#pragma unroll
                for (int it = 0; it < 4; ++it) {
                    const int idx = tz + it * NTHR, row = idx >> 3, ch = idx & 7;
                    const u32x4 v = *(const u32x4*)(lds + EPI_OFF + row * 128 + ((ch ^ (row & 7)) << 4));
                    if (cr0 + row < cce) *(u32x4*)(HM + (size_t)srow[row] * 256 + cnt_ * 64 + ch * 8) = v;
                }
            }
        } else {
            float wrow[4];
            {
                const int tz = opaque_tid();
#pragma unroll
                for (int i = 0; i < 4; ++i) wrow[i] = wsl[srow[lane_m(tz, i)]];
            }
            __syncthreads();
            epi_stage_bf16(acc, [&](int i, int, const f32x4 v) { return v * wrow[i]; });
            __syncthreads();
            epi_flush_bf16([&](int row) { return Y + (size_t)srow[row] * D + cnt_ * 128; }, [&](int row) { return cr0 + row < cce; });
        }
        cur ^= 1;
    }
    __syncthreads();
}

#ifndef DBG_GPROBE
#define DBG_GPROBE -1
#endif
template <int PM>
DI void phase_gemm_probe(const Args& a) {
    const bf16_t* A = (const bf16_t*)(a.ws + WS_H); const bf16_t* Bt = (const bf16_t*)(a.ws + W_RGIN);
    float* dummy = (float*)(a.ws + RG_A2);
    const int mt = 144, nt = 16, K = 1024;
    GemmPipe g;
    __syncthreads();
    for (int u = blockIdx.x; u < mt * nt; u += gridDim.x) {
        const int m0 = (u % mt) * 128, n0 = (u / mt) * 128;
        g.setup([&](int r) { return A + (size_t)(m0 + r) * 1024; }, Bt + (size_t)n0 * K, K);
        if (PM & 1) g.issue(0, 0);
        f32x4 acc[4][4];
        g.run_probe<PM>(K, acc);
        float s = 0.f;
#pragma unroll
        for (int i = 0; i < 4; ++i)
#pragma unroll
            for (int j = 0; j < 4; ++j) s += acc[i][j][0] + acc[i][j][1] + acc[i][j][2] + acc[i][j][3];
        if (s == 12345.678f) dummy[threadIdx.x] = s;
        if (PM & 8) {
            bf16_t* Yd = (bf16_t*)(a.ws + WS_Y);
            const int lane = threadIdx.x & 63, wave = threadIdx.x >> 6;
            const int mb = m0 + (wave >> 1) * 64 + (lane & 15), nb = n0 + (wave & 1) * 64 + (lane >> 4) * 4;
#pragma unroll
            for (int i = 0; i < 4; ++i)
#pragma unroll
                for (int j = 0; j < 4; ++j) {
                    f32x4 v = acc[i][j];
                    if (PM & 16) { v[0] = gelu_tanh(v[0]); v[1] = gelu_tanh(v[1]); v[2] = gelu_tanh(v[2]); v[3] = gelu_tanh(v[3]); }
                    st_bf4(Yd + (size_t)(mb + i * 16) * 2048 + nb + j * 16, v);
                }
        }
        __syncthreads();
    }
}

#ifndef DBG_STOP
#define DBG_STOP 99
#endif
#ifndef DBG_OFF
#define DBG_OFF 0
#endif
DI void phase_dbg(const Args& a) {
    const size_t n = (size_t)NLAT * D;
    const float* X = (const float*)(a.ws + WS_X);
    const bf16_t* B = (const bf16_t*)(a.ws + (size_t)DBG_OFF);
    for (size_t i = (size_t)blockIdx.x * NTHR + threadIdx.x; i < n; i += (size_t)gridDim.x * NTHR)
        a.out[i] = DBG_OFF ? bf2f(B[i]) : X[i];
}

constexpr int NPH = 34;
__global__ void __launch_bounds__(NTHR, 2) fwd(const Args a) {
    if (threadIdx.x == 0) *(uint4*)(lds + LDS_BARW) = make_uint4(0u, 0u, 0u, 0u);
    __syncthreads();
    XcdBarrier bar;
    const bool multi = (a.ph_hi - a.ph_lo) > 1;
    if (multi) bar = xcd_barrier_post((unsigned*)(a.ws + WS_CTL), (volatile LAS unsigned*)(lds + LDS_BARW));
#ifndef DBG_REP
#define DBG_REP -1
#endif
#ifndef DBG_REPN
#define DBG_REPN 3
#endif
#define RUN(id, ...) do { if (a.ph_lo <= (id) && (id) < a.ph_hi) { \
        if ((id) == DBG_REP) { for (int rep_ = 1; rep_ < DBG_REPN; ++rep_) { __VA_ARGS__; xcd_barrier(bar); } } \
        __VA_ARGS__; if ((id) + 1 < a.ph_hi) xcd_barrier(bar); } } while (0)
    RUN(0, phase_prologue(a));
    RUN(1, phase_token_row<0>(a, 0));
    RUN(2, phase_rg_in(a, 0));
    if (DBG_GPROBE >= 0) { RUN(2, phase_gemm_probe<(DBG_GPROBE < 0 ? 7 : DBG_GPROBE)>(a)); }
#ifdef DBG_SCANVAR
    RUN(3, phase_rg_scan<DBG_SCANVAR>(a, 0));
#endif
    RUN(3, phase_rg_scan<0, 1>(a, 0));
    RUN(4, phase_rg_combine(a));
    RUN(5, phase_rg_out(a, 0, 0));
    RUN(6, phase_token_router(a, 0));
    RUN(7, phase_moe<0>(a, 0));
    RUN(8, phase_moe<1>(a, 0));
    RUN(9, phase_token_row<0>(a, 1));
    RUN(10, phase_mla_down(a));
    RUN(11, phase_mla_up(a));
    RUN(12, phase_mla_attn(a));
    RUN(13, phase_mla_out(a, 1));
    RUN(14, phase_token_router(a, 1));
    RUN(15, phase_moe<0>(a, 1));
    RUN(16, phase_moe<1>(a, 1));
    RUN(17, phase_token_row<0>(a, 2));
    RUN(18, phase_ml_in(a));
    RUN(19, phase_ml_scan(a));
    RUN(20, phase_ml_readout(a));
    RUN(21, phase_ml_out(a, 2));
    RUN(22, phase_token_router(a, 2));
    RUN(23, phase_moe<0>(a, 2));
    RUN(24, phase_moe<1>(a, 2));
    RUN(25, phase_token_row<0>(a, 3));
    RUN(26, phase_rg_in(a, 1));
    RUN(27, phase_rg_scan(a, 1));
    RUN(28, phase_rg_combine(a));
    RUN(29, phase_rg_out(a, 3, 1));
    RUN(30, phase_token_router(a, 3));
    RUN(31, phase_moe<0>(a, 3));
    RUN(32, phase_moe<1>(a, 3));
    RUN(33, phase_token_row<2>(a, 3));
    RUN(34, phase_dbg(a));
#undef RUN
}

static void add_td(Args& a, int& n, int& tile0, const float* src, bf16_t* dst, const float* rscale, long sb, long db, int K, int N, int Npad, int batch, int perm) {
    TDesc& t = a.td[n++];
    t.src = src; t.dst = dst; t.rscale = rscale; t.sb = sb; t.db = db; t.K = K; t.N = N; t.Npad = Npad; t.batch = batch; t.perm = perm;
    t.tiles_k = (K + 127) / 128; t.tiles_n = (Npad + 63) / 64; t.tile0 = tile0;
    tile0 += batch * t.tiles_k * t.tiles_n;
}

extern "C" void kernel_launch(void* const* d_in, const int* in_sizes, int n_in, void* d_out, int out_size, void* d_ws, size_t ws_size, hipStream_t stream) {
    static int grid = 0;
    if (grid == 0) {
        if (n_in != 32 || out_size != NLAT * D || ws_size < WS_END) { fprintf(stderr, "kernel_launch: unexpected sizes (n_in %d out %d ws %zu need %zu)\n", n_in, out_size, ws_size, (size_t)WS_END); grid = -1; return; }
        int dev = 0, cus = 0, per_cu = 0;
        (void)hipGetDevice(&dev);
        (void)hipDeviceGetAttribute(&cus, hipDeviceAttributeMultiprocessorCount, dev);
        if (hipOccupancyMaxActiveBlocksPerMultiprocessor(&per_cu, (const void*)fwd, NTHR, 0) != hipSuccess) per_cu = 0;
        (void)hipGetLastError();
        if (per_cu < 2) fprintf(stderr, "kernel_launch: note: occupancy query reports %d blocks per CU (need 2)\n", per_cu);
        grid = cus * (per_cu >= 2 ? 2 : (per_cu >= 1 ? 1 : 2));
    }
    if (grid < 0) return;
    (void)in_sizes;
    (void)hipMemsetAsync((char*)d_ws + WS_CTL, 0, CTL_BYTES, stream);
    Args a;
    memset(&a, 0, sizeof(a));
    for (int i = 0; i < 32; ++i) a.in[i] = (const float*)d_in[i];
    a.out = (float*)d_out; a.ws = (unsigned char*)d_ws;
    unsigned char* ws = (unsigned char*)d_ws;
    int n = 0, tile0 = 0;
    add_td(a, n, tile0, a.in[8], (bf16_t*)(ws + W_RGIN), nullptr, 1024L * 2048, 2048L * 1024, 1024, 2048, 2048, 2, 0);
    add_td(a, n, tile0, a.in[14], (bf16_t*)(ws + W_RGOUT), nullptr, 1024L * 1024, 1024L * 1024, 1024, 1024, 1024, 2, 0);
    for (int j = 0; j < 2; ++j) for (int dir = 0; dir < 2; ++dir) for (int g = 0; g < 2; ++g)
        add_td(a, n, tile0, a.in[11] + (size_t)((j * 2 + dir) * 2 + g) * 16 * 4096, (bf16_t*)(ws + W_RGG) + (size_t)(j * 2 + dir) * 16 * 8192 + g * 4096, nullptr, 4096, 8192, 64, 64, 64, 16, 0);
    add_td(a, n, tile0, a.in[15], (bf16_t*)(ws + W_MDOWN), nullptr, 0, 0, 1024, 416, 512, 1, 0);
    add_td(a, n, tile0, a.in[18], (bf16_t*)(ws + W_MUQ), a.in[16], 0, 0, 256, 1536, 1536, 1, 0);
    add_td(a, n, tile0, a.in[19], (bf16_t*)(ws + W_MUKV), a.in[17], 0, 0, 128, 2048, 2048, 1, 0);
    add_td(a, n, tile0, a.in[21], (bf16_t*)(ws + W_MO), nullptr, 0, 0, 1024, 1024, 1024, 1, 0);
    add_td(a, n, tile0, a.in[22], (bf16_t*)(ws + W_MLIN), nullptr, 0, 0, 1024, 3088, 3200, 1, 0);
    add_td(a, n, tile0, a.in[25], (bf16_t*)(ws + W_MLOUT), nullptr, 0, 0, 1024, 1024, 1024, 1, 0);
    add_td(a, n, tile0, a.in[30], (bf16_t*)(ws + W_GU), nullptr, 1024L * 512, 512L * 1024, 1024, 512, 512, 64, 1);
    add_td(a, n, tile0, a.in[31], (bf16_t*)(ws + W_DN), nullptr, 256L * 1024, 1024L * 256, 256, 1024, 1024, 64, 0);
    a.ntiles_total = tile0;
    if (n != NTD) { fprintf(stderr, "kernel_launch: descriptor count %d != %d\n", n, NTD); return; }
#if MK_ONE_LAUNCH
    a.ph_lo = 0; a.ph_hi = NPH;
    hipLaunchKernelGGL(fwd, dim3(grid), dim3(NTHR), 0, stream, a);
#else
    for (int ph = 0; ph < NPH && ph <= DBG_STOP; ++ph) {
        a.ph_lo = ph; a.ph_hi = ph + 1;
        hipLaunchKernelGGL(fwd, dim3(grid), dim3(NTHR), 0, stream, a);
    }
    if (DBG_STOP < NPH) { a.ph_lo = 34; a.ph_hi = 35; hipLaunchKernelGGL(fwd, dim3(grid), dim3(NTHR), 0, stream, a); }
#endif
}
```

```cpp
#include <hip/hip_runtime.h>
#include <stdint.h>
#include <string.h>
#include <stdio.h>

#ifndef MK_ONE_LAUNCH
#define MK_ONE_LAUNCH 1
#endif

#define DI __device__ __forceinline__
typedef unsigned short bf16_t;
typedef __attribute__((ext_vector_type(8))) short bf16x8;
typedef __attribute__((ext_vector_type(4))) float f32x4;
typedef __attribute__((ext_vector_type(16))) float f32x16;
typedef __attribute__((ext_vector_type(2))) float f32x2;
typedef __attribute__((ext_vector_type(2))) __bf16 bfx2;
typedef __attribute__((ext_vector_type(4))) unsigned u32x4;
typedef __attribute__((ext_vector_type(2))) unsigned u32x2;

constexpr int D = 1024, NB = 8, SEQ = 2048, CTXL = 256;
constexpr int NLAT = NB * SEQ, NCTX = NB * CTXL, NTOK = NLAT + NCTX;
constexpr int NKEY = CTXL + SEQ;
constexpr int NTHR = 256;
constexpr int LDS_BYTES = 73728;
constexpr int LDS_AUX = 65536;
constexpr int LDS_BARW = LDS_BYTES - 16;
constexpr float EPS = 1e-6f;

constexpr size_t al256(size_t x) { return (x + 255) & ~(size_t)255; }
constexpr size_t WS_CTL = 0;
constexpr size_t CTL_BYTES = 65536;
constexpr size_t CTL_CNT = 16384;
constexpr size_t CTL_ROPE = 32768;
constexpr size_t WS_MOD = WS_CTL + CTL_BYTES;
constexpr size_t WS_X = al256(WS_MOD + 4 * 9 * 6144 * 4);
constexpr size_t WS_H = al256(WS_X + (size_t)NTOK * D * 4);
constexpr size_t WS_SCR = al256(WS_H + (size_t)NTOK * D * 2);
constexpr size_t SCR_BYTES = (size_t)256 << 20;
constexpr size_t TOKD2 = (size_t)NTOK * D * 2;
constexpr size_t RG_G = WS_SCR, RG_U = RG_G + TOKD2, RG_HS = RG_U + TOKD2, RG_A2 = RG_HS + 2 * TOKD2;
constexpr size_t MLA_CQ = WS_SCR;
constexpr size_t MLA_CKV = MLA_CQ + (size_t)NTOK * 256 * 2;
constexpr size_t MLA_KR = MLA_CKV + (size_t)NTOK * 128 * 2;
constexpr size_t MLA_Q = MLA_KR + (size_t)NTOK * 32 * 4;
constexpr size_t MLA_K = MLA_Q + (size_t)NTOK * 1536 * 2;
constexpr size_t MLA_VT = MLA_K + (size_t)NB * 16 * NKEY * 96 * 2;
constexpr size_t MLA_O = MLA_VT + (size_t)NB * 16 * 64 * NKEY * 2;
constexpr size_t MLA_END = MLA_O + TOKD2;
constexpr size_t ML_Q = WS_SCR;
constexpr size_t ML_K = ML_Q + (size_t)NTOK * 512 * 2;
constexpr size_t ML_KT = ML_K + (size_t)NTOK * 512 * 2;
constexpr size_t ML_VT = ML_KT + (size_t)NTOK * 512 * 2;
constexpr size_t ML_OG = ML_VT + TOKD2;
constexpr size_t ML_GT = ML_OG + TOKD2;
constexpr size_t ML_HS = ML_GT + (size_t)NTOK * 16 * 4;
constexpr size_t ML_A2 = ML_HS + 2 * TOKD2;
constexpr size_t ML_END = ML_A2 + TOKD2;
static_assert(RG_A2 + TOKD2 <= WS_SCR + SCR_BYTES && MLA_END <= WS_SCR + SCR_BYTES && ML_END <= WS_SCR + SCR_BYTES, "scratch");
constexpr size_t WS_LIST = WS_SCR + SCR_BYTES;
constexpr size_t WS_WSLOT = al256(WS_LIST + (size_t)64 * NTOK * 4);
constexpr size_t WS_HMID = al256(WS_WSLOT + (size_t)2 * NTOK * 4);
constexpr size_t WS_Y = al256(WS_HMID + (size_t)2 * NTOK * 256 * 2);
constexpr size_t WS_W = al256(WS_Y + (size_t)2 * NTOK * D * 2);
constexpr size_t W_RGIN = WS_W;
constexpr size_t W_RGOUT = W_RGIN + (size_t)2 * 2048 * 1024 * 2;
constexpr size_t W_RGG = W_RGOUT + (size_t)2 * 1024 * 1024 * 2;
constexpr size_t W_MDOWN = W_RGG + (size_t)2 * 2 * 16 * 128 * 64 * 2;
constexpr size_t W_MUQ = W_MDOWN + (size_t)512 * 1024 * 2;
constexpr size_t W_MUKV = W_MUQ + (size_t)1536 * 256 * 2;
constexpr size_t W_MO = W_MUKV + (size_t)2048 * 128 * 2;
constexpr size_t W_MLIN = W_MO + (size_t)1024 * 1024 * 2;
constexpr size_t W_MLOUT = W_MLIN + (size_t)3200 * 1024 * 2;
constexpr size_t W_RT = W_MLOUT + (size_t)1024 * 1024 * 2;
constexpr size_t W_GU = al256(W_RT + (size_t)4 * 2 * 80 * 1024 * 2);
constexpr size_t W_DN = W_GU + (size_t)256 * 512 * 1024 * 2;
constexpr size_t WS_END = W_DN + (size_t)256 * 1024 * 256 * 2;

struct TDesc {
    const float* src; bf16_t* dst; const float* rscale;
    long sb, db;
    int K, N, Npad, batch;
    int perm, tiles_k, tiles_n, tile0;
};
constexpr int NTD = 18;
struct Args {
    const float* in[32];
    float* out;
    unsigned char* ws;
    TDesc td[NTD];
    int ntiles_total, ph_lo, ph_hi, pad0;
};

DI float bf2f(bf16_t v) { return __uint_as_float((unsigned)v << 16); }
DI unsigned pk2(float a, float b) { f32x2 v = {a, b}; bfx2 r = __builtin_convertvector(v, bfx2); return __builtin_bit_cast(unsigned, r); }
DI bf16_t f2bf(float a) { return (bf16_t)(pk2(a, 0.f) & 0xffffu); }
DI float lof(unsigned u) { return __uint_as_float(u << 16); }
DI float hif(unsigned u) { return __uint_as_float(u & 0xffff0000u); }
DI float rcpf_(float x) { return __builtin_amdgcn_rcpf(x); }
DI float fexp(float x) { return __builtin_amdgcn_exp2f(x * 1.4426950408889634f); }
DI float sigmoidf_(float x) { return rcpf_(1.f + fexp(-x)); }
DI float gelu_tanh(float x) { float u = 0.7978845608028654f * (x + 0.044715f * x * x * x); float e = fexp(2.f * u); return x * (1.f - rcpf_(e + 1.f)); }
DI int tok_modrow(int t) { return t < NLAT ? (t >> 11) : 8; }
DI void dma16(const void* g, char* l) { __builtin_amdgcn_global_load_lds((const unsigned*)g, (unsigned*)l, 16, 0, 0); }
DI void wait_vm0() { asm volatile("s_waitcnt vmcnt(0)" ::: "memory"); }
DI int swz128(int row, int chunk) { return row * 128 + ((chunk ^ (row & 7)) << 4); }
DI int swz256(int row, int chunk) { return row * 256 + ((chunk ^ (row & 15)) << 4); }
DI f32x4 mfma16(bf16x8 a, bf16x8 b, f32x4 c) { return __builtin_amdgcn_mfma_f32_16x16x32_bf16(a, b, c, 0, 0, 0); }
DI f32x16 mfma32(bf16x8 a, bf16x8 b, f32x16 c) { return __builtin_amdgcn_mfma_f32_32x32x16_bf16(a, b, c, 0, 0, 0); }
DI bf16x8 ldsv8(const char* p) { return *(const bf16x8*)p; }
DI void st_bf4(bf16_t* p, const f32x4 v) { u32x2 o; o[0] = pk2(v[0], v[1]); o[1] = pk2(v[2], v[3]); *(u32x2*)p = o; }

__shared__ __attribute__((aligned(16))) char lds[LDS_BYTES];

#define XB_TMO      128
#define XB_XCNT(j)  (256  + 64 * (j))
#define XB_XSUB(j)  (1280 + 64 * (j))
#define XB_XGEN(j)  (2304 + 64 * (j))
#define XB_TOP      3328
#define XB_TOPGEN   3392
#define XCD_BAR_WORDS 3456
#define XB_SPIN_CAP (1u << 22)
#define LAS __attribute__((address_space(3)))
DI unsigned xb_ld(unsigned* p)              { return __hip_atomic_load(p, __ATOMIC_RELAXED, __HIP_MEMORY_SCOPE_AGENT); }
DI unsigned xb_add(unsigned* p, unsigned v) { return __hip_atomic_fetch_add(p, v, __ATOMIC_RELAXED, __HIP_MEMORY_SCOPE_AGENT); }
DI unsigned xb_xcc_id() { return (unsigned)__builtin_amdgcn_s_getreg((3 << 11) | 20) & 0xFu; }
#define XB_SPIN(cond, bar) do { unsigned _sp = 0; while (cond) { __builtin_amdgcn_s_sleep(1); \
    if ((++_sp & 255u) == 0u) { if (xb_ld(&(bar)[XB_TMO])) break; if (_sp > XB_SPIN_CAP) { atomicAdd(&(bar)[XB_TMO], 1u); break; } } } } while (0)
struct XcdBarrier { unsigned* bar; unsigned x; volatile LAS unsigned* st; };
DI XcdBarrier xcd_barrier_post(unsigned* bar, volatile LAS unsigned* st) {
    XcdBarrier b; b.bar = bar; b.x = xb_xcc_id(); b.st = st;
    if (threadIdx.x == 0) (void)xb_add(&bar[XB_XCNT(b.x)], 1u);
    return b;
}
DI void xcd_barrier_complete(unsigned* bar, unsigned x, unsigned& nloc, unsigned& nx) {
    const unsigned G = gridDim.x * gridDim.y * gridDim.z;
    unsigned sum, cnt, mine, sp = 0u;
    for (;;) {
        sum = 0u; cnt = 0u; mine = 0u;
#pragma unroll
        for (unsigned j = 0; j < 16; ++j) { const unsigned c = xb_ld(&bar[XB_XCNT(j)]); sum += c; cnt += (c > 0u) ? 1u : 0u; mine = (j == x) ? c : mine; }
        if (sum == G) break;
        __builtin_amdgcn_s_sleep(1);
        if ((++sp & 255u) == 0u) { if (xb_ld(&bar[XB_TMO])) break; if (sp > XB_SPIN_CAP) { atomicAdd(&bar[XB_TMO], 1u); break; } }
    }
    nloc = mine > 0u ? mine : 1u; nx = cnt > 0u ? cnt : 1u;
}
DI void xcd_barrier(const XcdBarrier& b) {
    asm volatile("s_waitcnt vmcnt(0)" ::: "memory");
    __syncthreads();
    if (threadIdx.x == 0) {
        unsigned* bar = b.bar;
        __builtin_amdgcn_s_waitcnt(0);
        unsigned nloc = b.st[0], nx = b.st[1];
        if (nloc == 0u) { xcd_barrier_complete(bar, b.x, nloc, nx); b.st[0] = nloc; b.st[1] = nx; }
        const unsigned old = xb_add(&bar[XB_XSUB(b.x)], 1u);
        const unsigned gen = old / nloc;
        if (old + 1u == (gen + 1u) * nloc) {
            __builtin_amdgcn_fence(__ATOMIC_RELEASE, "agent");
            asm volatile("s_waitcnt vmcnt(0)" ::: "memory");
            const unsigned og = xb_add(&bar[XB_TOP], 1u);
            const unsigned tg = og / nx;
            if (og + 1u == (tg + 1u) * nx) xb_add(&bar[XB_TOPGEN], 1u);
            else XB_SPIN(xb_ld(&bar[XB_TOPGEN]) == tg, bar);
            __builtin_amdgcn_fence(__ATOMIC_ACQUIRE, "agent");
            xb_add(&bar[XB_XGEN(b.x)], 1u);
            asm volatile("s_waitcnt vmcnt(0)" ::: "memory");
        } else {
            XB_SPIN(xb_ld(&bar[XB_XGEN(b.x)]) == gen, bar);
            __builtin_amdgcn_fence(__ATOMIC_ACQUIRE, "agent");
            asm volatile("s_waitcnt vmcnt(0)" ::: "memory");
        }
    }
    __syncthreads();
}

struct CvTile { const float* src; bf16_t* dst; int K, N, perm, k0, n0; };
DI CvTile moe_cv_tile(const Args& a, const int L, const int t) {
    CvTile c;
    const int e = t / 96, r = t - e * 96;
    if (r < 64) {
        c.src = a.in[30] + (size_t)(L * 64 + e) * 1024 * 512; c.dst = (bf16_t*)(a.ws + W_GU) + (size_t)(L * 64 + e) * 512 * 1024;
        c.K = 1024; c.N = 512; c.perm = 1; c.k0 = (r & 7) * 128; c.n0 = (r >> 3) * 64;
    } else {
        const int r2 = r - 64;
        c.src = a.in[31] + (size_t)(L * 64 + e) * 256 * 1024; c.dst = (bf16_t*)(a.ws + W_DN) + (size_t)(L * 64 + e) * 1024 * 256;
        c.K = 256; c.N = 1024; c.perm = 0; c.k0 = (r2 & 1) * 128; c.n0 = (r2 >> 1) * 64;
    }
    return c;
}
DI void cv_load(const CvTile& c, f32x4 (&L0)[4], f32x4 (&L1)[4]) {
    const int tid = threadIdx.x, c4 = tid & 15, kr = tid >> 4;
    const float* p = c.src + (size_t)(c.k0 + 2 * kr) * c.N + c.n0 + 4 * c4;
#pragma unroll
    for (int i = 0; i < 4; ++i) { L0[i] = *(const f32x4*)(p + (size_t)(32 * i) * c.N); L1[i] = *(const f32x4*)(p + (size_t)(32 * i + 1) * c.N); }
}
DI void cv_pack(unsigned* st, const f32x4 (&L0)[4], const f32x4 (&L1)[4]) {
    const int tid = threadIdx.x, c4 = tid & 15, kr = tid >> 4;
#pragma unroll
    for (int i = 0; i < 4; ++i)
#pragma unroll
        for (int j = 0; j < 4; ++j) st[(4 * c4 + j) * 68 + 16 * i + kr] = pk2(L0[i][j], L1[i][j]);
}
DI void cv_flush(const CvTile& c, const unsigned* st) {
    const int tid = threadIdx.x;
#pragma unroll
    for (int i = 0; i < 4; ++i) {
        const int id = tid + i * 256, n = id >> 4, kc = id & 15;
        const u32x4 o = *(const u32x4*)(st + n * 68 + kc * 4);
        int nd = c.n0 + n;
        if (c.perm) { const int cc = nd & 255, up = nd >> 8; nd = ((cc >> 4) << 5) + (up << 4) + (cc & 15); }
        *(u32x4*)(c.dst + (size_t)nd * c.K + c.k0 + kc * 8) = o;
    }
}

DI void phase_prologue(const Args& a) {
    const int tid = threadIdx.x;
    const int n_ada = 384, n_rt = 4;
    const int total = n_ada + n_rt;
    float* sc = (float*)lds;
    for (int u = blockIdx.x; u < total; u += gridDim.x) {
        __syncthreads();
        if (u < n_ada) {
            const float* c = a.in[1]; const float* cc = a.in[3];
            for (int i = tid; i < 9 * 1024; i += NTHR) {
                float v = i < 8192 ? c[i] : cc[i - 8192];
                sc[i] = v / (1.f + __expf(-v));
            }
            __syncthreads();
            const int n = u * 64 + (tid & 63), li = n / 6144, nn = n - li * 6144, kq = tid >> 6;
            const float* wp = a.in[4] + (size_t)li * 1024 * 6144 + (size_t)(kq * 256) * 6144 + nn;
            float acc[9];
#pragma unroll
            for (int r = 0; r < 9; ++r) acc[r] = 0.f;
#pragma unroll 1
            for (int k0 = kq * 256; k0 < kq * 256 + 256; k0 += 16) {
                float wv[16];
#pragma unroll
                for (int kk = 0; kk < 16; ++kk) { wv[kk] = *wp; wp += 6144; }
#pragma unroll
                for (int kk = 0; kk < 16; kk += 4)
#pragma unroll
                    for (int r = 0; r < 9; ++r) {
                        const f32x4 s4 = *(const f32x4*)(sc + r * 1024 + k0 + kk);
                        acc[r] += s4[0] * wv[kk] + s4[1] * wv[kk + 1] + s4[2] * wv[kk + 2] + s4[3] * wv[kk + 3];
                    }
            }
            float* part = sc + 9 * 1024;
#pragma unroll
            for (int r = 0; r < 9; ++r) part[(kq * 9 + r) * 64 + (tid & 63)] = acc[r];
            __syncthreads();
            for (int i = tid; i < 9 * 64; i += NTHR) {
                const int r = i >> 6, cidx = i & 63;
                const int n2 = u * 64 + cidx, l2 = n2 / 6144, nn2 = n2 - l2 * 6144;
                const float v = ((part[(0 * 9 + r) * 64 + cidx] + part[(1 * 9 + r) * 64 + cidx]) + part[(2 * 9 + r) * 64 + cidx]) + part[(3 * 9 + r) * 64 + cidx];
                ((float*)(a.ws + WS_MOD))[((size_t)l2 * 9 + r) * 6144 + nn2] = v + a.in[5][l2 * 6144 + nn2];
            }
        } else if (u < n_ada + n_rt) {
            const int li = u - n_ada;
            bf16_t* rt = (bf16_t*)(a.ws + W_RT) + (size_t)li * 2 * 80 * 1024;
            const float* wg = a.in[26] + (size_t)li * 1024 * 8;
            const float* we = a.in[28] + (size_t)li * 1024 * 64;
            if (li == 0) {
                float* rt_ = (float*)(a.ws + WS_CTL + CTL_ROPE);
                for (int i = tid; i < 512; i += NTHR) {
                    const int pos = i >> 3, fi = i & 7;
                    const float ang = (float)pos * powf(10000.f, -(float)fi * 0.125f);
                    rt_[i] = cosf(ang); rt_[512 + i] = sinf(ang);
                }
            }
            for (int i = tid; i < 80 * 1024; i += NTHR) {
                const int n = i >> 10, k = i & 1023;
                float v = n < 8 ? wg[k * 8 + n] : (n < 72 ? we[k * 64 + (n - 8)] : 0.f);
                const bf16_t h = f2bf(v);
                rt[i] = h;
                rt[80 * 1024 + i] = f2bf(v - bf2f(h));
            }
        }
    }
    struct PTile { const float* src; bf16_t* dst; const float* rscale; int K, N, Npad, perm, k0, n0; };
    auto decode = [&](int tix) {
        int di = 0;
#pragma unroll 1
        for (int i = 1; i < NTD; ++i) if (tix >= a.td[i].tile0) di = i;
        const TDesc& td = a.td[di];
        int rem = tix - td.tile0;
        const int per = td.tiles_k * td.tiles_n;
        const int bi = rem / per; rem -= bi * per;
        PTile p;
        p.src = td.src + (size_t)bi * td.sb; p.dst = td.dst + (size_t)bi * td.db; p.rscale = td.rscale;
        p.K = td.K; p.N = td.N; p.Npad = td.Npad; p.perm = td.perm;
        p.n0 = (rem % td.tiles_n) * 64; p.k0 = (rem / td.tiles_n) * 128;
        return p;
    };
    auto pload = [&](const PTile& p, f32x4 (&L0)[4], f32x4 (&L1)[4]) {
        const int c4 = tid & 15, kr = tid >> 4;
        const bool nok = p.n0 + 4 * c4 < p.N;
#pragma unroll
        for (int i = 0; i < 4; ++i) {
            const int k = p.k0 + 32 * i + 2 * kr;
            L0[i] = (f32x4){0.f, 0.f, 0.f, 0.f}; L1[i] = L0[i];
            if (nok && k < p.K) {
                L0[i] = *(const f32x4*)(p.src + (size_t)k * p.N + p.n0 + 4 * c4);
                L1[i] = *(const f32x4*)(p.src + (size_t)(k + 1) * p.N + p.n0 + 4 * c4);
                if (p.rscale) { L0[i] *= p.rscale[k]; L1[i] *= p.rscale[k + 1]; }
            }
        }
    };
    auto pflush = [&](const PTile& p, const unsigned* st) {
#pragma unroll
        for (int i = 0; i < 4; ++i) {
            const int id = tid + i * 256, n = id >> 4, kc = id & 15;
            const u32x4 o = *(const u32x4*)(st + n * 68 + kc * 4);
            int nd = p.n0 + n;
            if (nd < p.Npad && p.k0 + kc * 8 < p.K) {
                if (p.perm) { const int c = nd & 255, up = nd >> 8; nd = ((c >> 4) << 5) + (up << 4) + (c & 15); }
                *(u32x4*)(p.dst + (size_t)nd * p.K + p.k0 + kc * 8) = o;
            }
        }
    };
    {
        unsigned* st0 = (unsigned*)lds; unsigned* st1 = st0 + 64 * 68;
        const int nt_ = a.ntiles_total, G = gridDim.x;
        int t0 = blockIdx.x, t1 = blockIdx.x + G;
        PTile p0 = decode(0), p1 = p0;
        f32x4 A0[4], A1[4], B0[4], B1[4];
        __syncthreads();
        if (t0 < nt_) { p0 = decode(t0); pload(p0, A0, A1); }
        if (t1 < nt_) { p1 = decode(t1); pload(p1, B0, B1); }
        while (t0 < nt_) {
            PTile q0 = p0, q1 = p1;
            const bool v1 = t1 < nt_;
            cv_pack(st0, A0, A1);
            if (t0 + 2 * G < nt_) { p0 = decode(t0 + 2 * G); pload(p0, A0, A1); }
            if (v1) {
                cv_pack(st1, B0, B1);
                if (t1 + 2 * G < nt_) { p1 = decode(t1 + 2 * G); pload(p1, B0, B1); }
            }
            __syncthreads();
            pflush(q0, st0);
            if (v1) pflush(q1, st1);
            __syncthreads();
            t0 += 2 * G; t1 += 2 * G;
        }
    }
}

template <int MODE>
DI void phase_token(const Args& a, const int li) {
    const int tid = threadIdx.x, lane = tid & 63, wave = tid >> 6;
    const int r = lane & 15, q = lane >> 4;
    float* X = (float*)(a.ws + WS_X);
    bf16_t* H = (bf16_t*)(a.ws + WS_H);
    const bf16_t* Y = (const bf16_t*)(a.ws + WS_Y);
    const float* MOD = (const float*)(a.ws + WS_MOD);
    const bool combine = (MODE == 0 && li > 0) || MODE == 2;
    const int ngroups = (MODE == 2 || (MODE == 1 && li == 3)) ? NLAT / 16 : NTOK / 16;
    float* lg = (float*)(lds + wave * 16 * 80 * 4);
    for (int g = blockIdx.x * 4 + wave; g < ngroups; g += gridDim.x * 4) {
        const int t = g * 16 + r;
        const int mr = tok_modrow(g * 16);
        const float* xsrc = (MODE == 0 && li == 0) ? (t < NLAT ? a.in[0] + (size_t)t * D : a.in[2] + (size_t)(t - NLAT) * D) : X + (size_t)t * D;
        const bf16_t* y0 = Y + (size_t)(2 * t) * D;
        const bf16_t* y1 = y0 + D;
        const int lprev = MODE == 2 ? 3 : li - 1;
        const float* g5 = MOD + ((size_t)(lprev < 0 ? 0 : lprev) * 9 + mr) * 6144 + 5 * 1024;
        float ss = 0.f;
        if (MODE != 2) {
#pragma unroll 4
            for (int kk = 0; kk < 32; ++kk) {
                const int k = kk * 32 + q * 8;
                f32x4 x0 = *(const f32x4*)(xsrc + k), x1 = *(const f32x4*)(xsrc + k + 4);
                if (combine) {
                    const u32x4 ya = *(const u32x4*)(y0 + k), yb = *(const u32x4*)(y1 + k);
                    const f32x4 ga = *(const f32x4*)(g5 + k), gb = *(const f32x4*)(g5 + k + 4);
                    x0[0] += ga[0] * (lof(ya[0]) + lof(yb[0])); x0[1] += ga[1] * (hif(ya[0]) + hif(yb[0]));
                    x0[2] += ga[2] * (lof(ya[1]) + lof(yb[1])); x0[3] += ga[3] * (hif(ya[1]) + hif(yb[1]));
                    x1[0] += gb[0] * (lof(ya[2]) + lof(yb[2])); x1[1] += gb[1] * (hif(ya[2]) + hif(yb[2]));
                    x1[2] += gb[2] * (lof(ya[3]) + lof(yb[3])); x1[3] += gb[3] * (hif(ya[3]) + hif(yb[3]));
                }
#pragma unroll
                for (int j = 0; j < 4; ++j) ss += x0[j] * x0[j] + x1[j] * x1[j];
            }
            ss += __shfl_xor(ss, 16); ss += __shfl_xor(ss, 32);
        }
        const float rstd = rsqrtf(ss * (1.f / 1024.f) + EPS);
        const float* gn = (MODE == 1 ? a.in[7] : a.in[6]) + (size_t)li * D;
        const float* mscale = MOD + ((size_t)li * 9 + mr) * 6144 + (MODE == 1 ? 4 : 1) * 1024;
        const float* mshift = MOD + ((size_t)li * 9 + mr) * 6144 + (MODE == 1 ? 3 : 0) * 1024;
        const bf16_t* rwh = (const bf16_t*)(a.ws + W_RT) + (size_t)li * 2 * 80 * 1024 + (size_t)r * 1024 + q * 8;
        f32x4 lacc[5];
#pragma unroll
        for (int i = 0; i < 5; ++i) lacc[i] = (f32x4){0.f, 0.f, 0.f, 0.f};
#pragma unroll 2
        for (int kk = 0; kk < 32; ++kk) {
            const int k = kk * 32 + q * 8;
            f32x4 x0 = *(const f32x4*)(xsrc + k), x1 = *(const f32x4*)(xsrc + k + 4);
            if (combine) {
                const u32x4 ya = *(const u32x4*)(y0 + k), yb = *(const u32x4*)(y1 + k);
                const f32x4 ga = *(const f32x4*)(g5 + k), gb = *(const f32x4*)(g5 + k + 4);
                x0[0] += ga[0] * (lof(ya[0]) + lof(yb[0])); x0[1] += ga[1] * (hif(ya[0]) + hif(yb[0]));
                x0[2] += ga[2] * (lof(ya[1]) + lof(yb[1])); x0[3] += ga[3] * (hif(ya[1]) + hif(yb[1]));
                x1[0] += gb[0] * (lof(ya[2]) + lof(yb[2])); x1[1] += gb[1] * (hif(ya[2]) + hif(yb[2]));
                x1[2] += gb[2] * (lof(ya[3]) + lof(yb[3])); x1[3] += gb[3] * (hif(ya[3]) + hif(yb[3]));
            }
            if (MODE == 2) {
                *(f32x4*)(a.out + (size_t)t * D + k) = x0; *(f32x4*)(a.out + (size_t)t * D + k + 4) = x1;
                continue;
            }
            if (MODE == 0 && (li == 0 || combine)) { *(f32x4*)(X + (size_t)t * D + k) = x0; *(f32x4*)(X + (size_t)t * D + k + 4) = x1; }
            const f32x4 n0 = *(const f32x4*)(gn + k), n1 = *(const f32x4*)(gn + k + 4);
            const f32x4 s0 = *(const f32x4*)(mscale + k), s1 = *(const f32x4*)(mscale + k + 4);
            const f32x4 h0 = *(const f32x4*)(mshift + k), h1 = *(const f32x4*)(mshift + k + 4);
            float f[8];
#pragma unroll
            for (int j = 0; j < 4; ++j) {
                f[j] = x0[j] * rstd * n0[j] * (1.f + s0[j]) + h0[j];
                f[4 + j] = x1[j] * rstd * n1[j] * (1.f + s1[j]) + h1[j];
            }
            u32x4 hv;
            hv[0] = pk2(f[0], f[1]); hv[1] = pk2(f[2], f[3]); hv[2] = pk2(f[4], f[5]); hv[3] = pk2(f[6], f[7]);
            *(u32x4*)(H + (size_t)t * D + k) = hv;
            if (MODE == 1) {
                u32x4 lv;
                lv[0] = pk2(f[0] - lof(hv[0]), f[1] - hif(hv[0])); lv[1] = pk2(f[2] - lof(hv[1]), f[3] - hif(hv[1]));
                lv[2] = pk2(f[4] - lof(hv[2]), f[5] - hif(hv[2])); lv[3] = pk2(f[6] - lof(hv[3]), f[7] - hif(hv[3]));
                const bf16x8 fh = __builtin_bit_cast(bf16x8, hv), fl = __builtin_bit_cast(bf16x8, lv);
#pragma unroll
                for (int nt = 0; nt < 5; ++nt) {
                    const bf16x8 wh = *(const bf16x8*)(rwh + (size_t)nt * 16 * 1024 + kk * 32);
                    const bf16x8 wl = *(const bf16x8*)(rwh + (size_t)(80 + nt * 16) * 1024 + kk * 32);
                    lacc[nt] = mfma16(fh, wh, lacc[nt]);
                    lacc[nt] = mfma16(fh, wl, lacc[nt]);
                    lacc[nt] = mfma16(fl, wh, lacc[nt]);
                }
            }
        }
        if (MODE == 1) {
#pragma unroll
            for (int nt = 0; nt < 5; ++nt)
#pragma unroll
                for (int j = 0; j < 4; ++j) lg[(q * 4 + j) * 80 + nt * 16 + r] = lacc[nt][j];
            asm volatile("s_waitcnt lgkmcnt(0)" ::: "memory");
            __builtin_amdgcn_wave_barrier();
            if (lane < 16) {
                const float* L = lg + lane * 80;
                const float* bg = a.in[27] + li * 8;
                const float* be = a.in[29] + li * 64;
                float gmax = -3.0e38f; int gi = 0; float gl[8];
#pragma unroll
                for (int j = 0; j < 8; ++j) { gl[j] = L[j] + bg[j]; if (gl[j] > gmax) { gmax = gl[j]; gi = j; } }
                float ps = 0.f;
#pragma unroll
                for (int j = 0; j < 8; ++j) ps += __expf(gl[j] - gmax);
                const float ptop = 1.f / ps;
                float e1 = -3.0e38f, e2 = -3.0e38f; int i1 = 0, i2 = 0;
#pragma unroll
                for (int j = 0; j < 8; ++j) {
                    const float v = L[8 + gi * 8 + j] + be[gi * 8 + j];
                    if (v > e1) { e2 = e1; i2 = i1; e1 = v; i1 = j; } else if (v > e2) { e2 = v; i2 = j; }
                }
                const float ex = __expf(e2 - e1);
                const float w1 = ptop / (1.f + ex), w2 = ptop * ex / (1.f + ex);
                const int tt = g * 16 + lane;
                int* cnt = (int*)(a.ws + WS_CTL + CTL_CNT) + li * 64;
                int* list = (int*)(a.ws + WS_LIST);
                float* wsl = (float*)(a.ws + WS_WSLOT);
                const int ea = gi * 8 + i1, eb = gi * 8 + i2;
                const int pa = atomicAdd(&cnt[ea], 1); list[(size_t)ea * NTOK + pa] = 2 * tt; wsl[2 * tt] = w1;
                const int pb = atomicAdd(&cnt[eb], 1); list[(size_t)eb * NTOK + pb] = 2 * tt + 1; wsl[2 * tt + 1] = w2;
            }
            __builtin_amdgcn_wave_barrier();
        }
    }
}

DI float wave_sum(float v) {
    v += __shfl_xor(v, 1); v += __shfl_xor(v, 2); v += __shfl_xor(v, 4); v += __shfl_xor(v, 8); v += __shfl_xor(v, 16); v += __shfl_xor(v, 32);
    return v;
}
template <int MODE>
DI void phase_token_row(const Args& a, const int li) {
    const int tid = threadIdx.x, lane = tid & 63, wave = tid >> 6;
    float* X = (float*)(a.ws + WS_X);
    bf16_t* H = (bf16_t*)(a.ws + WS_H);
    const bf16_t* Y = (const bf16_t*)(a.ws + WS_Y);
    const float* MOD = (const float*)(a.ws + WS_MOD);
    const bool combine = MODE == 2 || li > 0;
    const bool first = MODE == 0 && li == 0;
    const int npairs = (MODE == 2 ? NLAT : NTOK) / 2;
    const int lprev = MODE == 2 ? 3 : (li > 0 ? li - 1 : 0);
    const float* gn = a.in[6] + (size_t)li * D;
    for (int p = blockIdx.x * 4 + wave; p < npairs; p += gridDim.x * 4) {
        const int t0 = 2 * p, mr = tok_modrow(t0);
        f32x4 x[2][4];
#pragma unroll
        for (int i = 0; i < 2; ++i) {
            const int t = t0 + i;
            const float* xs = first ? (t < NLAT ? a.in[0] + (size_t)t * D : a.in[2] + (size_t)(t - NLAT) * D) : X + (size_t)t * D;
#pragma unroll
            for (int j = 0; j < 4; ++j) x[i][j] = *(const f32x4*)(xs + 256 * j + 4 * lane);
        }
        if (combine) {
            const float* g5 = MOD + ((size_t)lprev * 9 + mr) * 6144 + 5 * 1024;
            f32x4 g[4];
#pragma unroll
            for (int j = 0; j < 4; ++j) g[j] = *(const f32x4*)(g5 + 256 * j + 4 * lane);
#pragma unroll
            for (int i = 0; i < 2; ++i) {
                const bf16_t* y0 = Y + (size_t)(2 * (t0 + i)) * D;
#pragma unroll
                for (int j = 0; j < 4; ++j) {
                    const u32x2 ya = *(const u32x2*)(y0 + 256 * j + 4 * lane), yb = *(const u32x2*)(y0 + D + 256 * j + 4 * lane);
                    x[i][j][0] += g[j][0] * (lof(ya[0]) + lof(yb[0])); x[i][j][1] += g[j][1] * (hif(ya[0]) + hif(yb[0]));
                    x[i][j][2] += g[j][2] * (lof(ya[1]) + lof(yb[1])); x[i][j][3] += g[j][3] * (hif(ya[1]) + hif(yb[1]));
                }
            }
        }
        if (MODE == 2) {
#pragma unroll
            for (int i = 0; i < 2; ++i)
#pragma unroll
                for (int j = 0; j < 4; ++j) *(f32x4*)(a.out + (size_t)(t0 + i) * D + 256 * j + 4 * lane) = x[i][j];
            continue;
        }
        float rstd[2];
#pragma unroll
        for (int i = 0; i < 2; ++i) {
            float ss = 0.f;
#pragma unroll
            for (int j = 0; j < 4; ++j) ss += x[i][j][0] * x[i][j][0] + x[i][j][1] * x[i][j][1] + x[i][j][2] * x[i][j][2] + x[i][j][3] * x[i][j][3];
            rstd[i] = rsqrtf(wave_sum(ss) * (1.f / 1024.f) + EPS);
        }
        const float* msc = MOD + ((size_t)li * 9 + mr) * 6144 + 1 * 1024;
        const float* msh = MOD + ((size_t)li * 9 + mr) * 6144;
#pragma unroll
        for (int j = 0; j < 4; ++j) {
            const f32x4 n4 = *(const f32x4*)(gn + 256 * j + 4 * lane), s4 = *(const f32x4*)(msc + 256 * j + 4 * lane), h4 = *(const f32x4*)(msh + 256 * j + 4 * lane);
            const f32x4 gs = n4 * (s4 + 1.f);
#pragma unroll
            for (int i = 0; i < 2; ++i) {
                const f32x4 f = x[i][j] * rstd[i] * gs + h4;
                st_bf4(H + (size_t)(t0 + i) * D + 256 * j + 4 * lane, f);
                if (first || combine) *(f32x4*)(X + (size_t)(t0 + i) * D + 256 * j + 4 * lane) = x[i][j];
            }
        }
    }
}

DI void phase_token_router(const Args& a, const int li) {
    const int tid = threadIdx.x, lane = tid & 63, wave = tid >> 6;
    const int r = lane & 15, q = lane >> 4;
    const float* X = (const float*)(a.ws + WS_X);
    bf16_t* H = (bf16_t*)(a.ws + WS_H);
    const float* MOD = (const float*)(a.ws + WS_MOD);
    const float* gn = a.in[7] + (size_t)li * D;
    const int ngroups = (li == 3 ? NLAT : NTOK) / 16;
    char* sHi = lds; char* sLo = lds + 32768;
    float* sP = (float*)lds;
    float* sL = (float*)(lds + 32768);
    const bf16_t* rwh = (const bf16_t*)(a.ws + W_RT) + (size_t)li * 2 * 80 * 1024 + (size_t)r * 1024 + q * 8;
    for (int g = blockIdx.x; g < ngroups; g += gridDim.x) {
        const int mr = tok_modrow(g * 16);
        const float* msc = MOD + ((size_t)li * 9 + mr) * 6144 + 4 * 1024;
        const float* msh = MOD + ((size_t)li * 9 + mr) * 6144 + 3 * 1024;
        __syncthreads();
        {
            f32x4 x[4][4];
#pragma unroll
            for (int i = 0; i < 4; ++i)
#pragma unroll
                for (int j = 0; j < 4; ++j) x[i][j] = *(const f32x4*)(X + (size_t)(g * 16 + wave * 4 + i) * D + 256 * j + 4 * lane);
            float rstd[4];
#pragma unroll
            for (int i = 0; i < 4; ++i) {
                float ss = 0.f;
#pragma unroll
                for (int j = 0; j < 4; ++j) ss += x[i][j][0] * x[i][j][0] + x[i][j][1] * x[i][j][1] + x[i][j][2] * x[i][j][2] + x[i][j][3] * x[i][j][3];
                rstd[i] = rsqrtf(wave_sum(ss) * (1.f / 1024.f) + EPS);
            }
#pragma unroll
            for (int j = 0; j < 4; ++j) {
                const f32x4 n4 = *(const f32x4*)(gn + 256 * j + 4 * lane), s4 = *(const f32x4*)(msc + 256 * j + 4 * lane), h4 = *(const f32x4*)(msh + 256 * j + 4 * lane);
                const f32x4 gs = n4 * (s4 + 1.f);
#pragma unroll
                for (int i = 0; i < 4; ++i) {
                    const int row = wave * 4 + i;
                    const f32x4 f = x[i][j] * rstd[i] * gs + h4;
                    u32x2 hv; hv[0] = pk2(f[0], f[1]); hv[1] = pk2(f[2], f[3]);
                    u32x2 lv; lv[0] = pk2(f[0] - lof(hv[0]), f[1] - hif(hv[0])); lv[1] = pk2(f[2] - lof(hv[1]), f[3] - hif(hv[1]));
                    *(u32x2*)(H + (size_t)(g * 16 + row) * D + 256 * j + 4 * lane) = hv;
                    const int off = row * 2048 + (((32 * j + (lane >> 1)) ^ row) << 4) + (lane & 1) * 8;
                    *(u32x2*)(sHi + off) = hv; *(u32x2*)(sLo + off) = lv;
                }
            }
        }
        __syncthreads();
        f32x4 lacc[5];
#pragma unroll
        for (int i = 0; i < 5; ++i) lacc[i] = (f32x4){0.f, 0.f, 0.f, 0.f};
#pragma unroll 2
        for (int s = 0; s < 8; ++s) {
            const int kk = wave * 8 + s;
            const int off = r * 2048 + (((kk * 4 + q) ^ r) << 4);
            const bf16x8 fh = ldsv8(sHi + off), fl = ldsv8(sLo + off);
#pragma unroll
            for (int nt = 0; nt < 5; ++nt) {
                const bf16x8 wh = *(const bf16x8*)(rwh + (size_t)nt * 16 * 1024 + kk * 32);
                const bf16x8 wl = *(const bf16x8*)(rwh + (size_t)(80 + nt * 16) * 1024 + kk * 32);
                lacc[nt] = mfma16(fh, wh, lacc[nt]);
                lacc[nt] = mfma16(fh, wl, lacc[nt]);
                lacc[nt] = mfma16(fl, wh, lacc[nt]);
            }
        }
        __syncthreads();
#pragma unroll
        for (int nt = 0; nt < 5; ++nt)
#pragma unroll
            for (int j = 0; j < 4; ++j) sP[(wave * 16 + q * 4 + j) * 80 + nt * 16 + r] = lacc[nt][j];
        __syncthreads();
        for (int i = tid; i < 16 * 80; i += NTHR) sL[i] = sP[i] + sP[1280 + i] + sP[2560 + i] + sP[3840 + i];
        __syncthreads();
        if (tid < 16) {
            const float* L = sL + tid * 80;
            const float* bg = a.in[27] + li * 8;
            const float* be = a.in[29] + li * 64;
            float gmax = -3.0e38f; int gi = 0; float gl[8];
#pragma unroll
            for (int j = 0; j < 8; ++j) { gl[j] = L[j] + bg[j]; if (gl[j] > gmax) { gmax = gl[j]; gi = j; } }
            float ps = 0.f;
#pragma unroll
            for (int j = 0; j < 8; ++j) ps += __expf(gl[j] - gmax);
            const float ptop = 1.f / ps;
            float e1 = -3.0e38f, e2 = -3.0e38f; int i1 = 0, i2 = 0;
#pragma unroll
            for (int j = 0; j < 8; ++j) {
                const float v = L[8 + gi * 8 + j] + be[gi * 8 + j];
                if (v > e1) { e2 = e1; i2 = i1; e1 = v; i1 = j; } else if (v > e2) { e2 = v; i2 = j; }
            }
            const float ex = __expf(e2 - e1);
            const float w1 = ptop / (1.f + ex), w2 = ptop * ex / (1.f + ex);
            const int tt = g * 16 + tid;
            int* cnt = (int*)(a.ws + WS_CTL + CTL_CNT) + li * 64;
            int* list = (int*)(a.ws + WS_LIST);
            float* wsl = (float*)(a.ws + WS_WSLOT);
            const int ea = gi * 8 + i1, eb = gi * 8 + i2;
            const int pa = atomicAdd(&cnt[ea], 1); list[(size_t)ea * NTOK + pa] = 2 * tt; wsl[2 * tt] = w1;
            const int pb = atomicAdd(&cnt[eb], 1); list[(size_t)eb * NTOK + pb] = 2 * tt + 1; wsl[2 * tt + 1] = w2;
        }
    }
}

template <int WM, int WN, int MT, int NT, bool PFALL = true, class AP>
DI void gemm_tile(AP arow, const bf16_t* Bt, const int ldb, const int K, f32x4 (&acc)[MT][NT], float* ssq = nullptr) {
    constexpr int BM = WM * MT * 16, BN = WN * NT * 16;
    constexpr int A_BYTES = BM * 128, B_BYTES = BN * 128, STAGE = A_BYTES + B_BYTES;
    constexpr int ACH = BM * 8 / NTHR, BCH = BN * 8 / NTHR;
    static_assert(2 * STAGE <= LDS_AUX, "gemm LDS");
    const int tid = threadIdx.x, lane = tid & 63, wave = tid >> 6;
    const int wm = wave / WN, wn = wave % WN;
    const int fr = lane & 15, fq = lane >> 4;
    const bf16_t* ap[ACH]; const bf16_t* bp[BCH];
#pragma unroll
    for (int i = 0; i < ACH; ++i) { const int idx = tid + i * NTHR, row = idx >> 3, c = (idx & 7) ^ (row & 7); ap[i] = arow(row) + c * 8; }
#pragma unroll
    for (int i = 0; i < BCH; ++i) { const int idx = tid + i * NTHR, row = idx >> 3, c = (idx & 7) ^ (row & 7); bp[i] = Bt + (size_t)row * ldb + c * 8; }
#pragma unroll
    for (int i = 0; i < MT; ++i)
#pragma unroll
        for (int j = 0; j < NT; ++j) acc[i][j] = (f32x4){0.f, 0.f, 0.f, 0.f};
    const int KT = K >> 6;
    {
        char* sa = lds; char* sb = lds + A_BYTES;
#pragma unroll
        for (int i = 0; i < ACH; ++i) dma16(ap[i], sa + (tid + i * NTHR) * 16);
#pragma unroll
        for (int i = 0; i < BCH; ++i) dma16(bp[i], sb + (tid + i * NTHR) * 16);
    }
#pragma unroll 1
    for (int kt = 0; kt < KT; ++kt) {
        wait_vm0();
        __syncthreads();
        if (kt + 1 < KT) {
            char* sa = lds + ((kt + 1) & 1) * STAGE; char* sb = sa + A_BYTES;
            const int ko = (kt + 1) * 64;
#pragma unroll
            for (int i = 0; i < ACH; ++i) dma16(ap[i] + ko, sa + (tid + i * NTHR) * 16);
#pragma unroll
            for (int i = 0; i < BCH; ++i) dma16(bp[i] + ko, sb + (tid + i * NTHR) * 16);
        }
        const char* sa = lds + (kt & 1) * STAGE; const char* sb = sa + A_BYTES;
        if (PFALL) {
            bf16x8 xf[2][MT], wf[2][NT];
#pragma unroll
            for (int kk = 0; kk < 2; ++kk) {
#pragma unroll
                for (int i = 0; i < MT; ++i) xf[kk][i] = ldsv8(sa + swz128(wm * MT * 16 + i * 16 + fr, kk * 4 + fq));
#pragma unroll
                for (int j = 0; j < NT; ++j) wf[kk][j] = ldsv8(sb + swz128(wn * NT * 16 + j * 16 + fr, kk * 4 + fq));
            }
            __builtin_amdgcn_sched_barrier(0);
            __builtin_amdgcn_s_setprio(1);
#pragma unroll
            for (int kk = 0; kk < 2; ++kk)
#pragma unroll
                for (int i = 0; i < MT; ++i)
#pragma unroll
                    for (int j = 0; j < NT; ++j) acc[i][j] = mfma16(wf[kk][j], xf[kk][i], acc[i][j]);
            __builtin_amdgcn_s_setprio(0);
        } else {
#pragma unroll
            for (int kk = 0; kk < 2; ++kk) {
                bf16x8 xf[MT], wf[NT];
#pragma unroll
                for (int i = 0; i < MT; ++i) xf[i] = ldsv8(sa + swz128(wm * MT * 16 + i * 16 + fr, kk * 4 + fq));
#pragma unroll
                for (int j = 0; j < NT; ++j) wf[j] = ldsv8(sb + swz128(wn * NT * 16 + j * 16 + fr, kk * 4 + fq));
#pragma unroll
                for (int i = 0; i < MT; ++i)
#pragma unroll
                    for (int j = 0; j < NT; ++j) acc[i][j] = mfma16(wf[j], xf[i], acc[i][j]);
                if (ssq) {
#pragma unroll
                    for (int i = 0; i < MT; ++i) {
                        const u32x4 xu = __builtin_bit_cast(u32x4, xf[i]);
#pragma unroll
                        for (int d = 0; d < 4; ++d) { const bfx2 p = __builtin_bit_cast(bfx2, xu[d]); ssq[i] = __builtin_amdgcn_fdot2_f32_bf16(p, p, ssq[i], false); }
                    }
                }
            }
        }
    }
    __syncthreads();
}


struct GemmPipe {
    static constexpr int A_BYTES = 128 * 128, STAGE = 2 * A_BYTES;
    const bf16_t* ap[4]; const bf16_t* bp[4];
    template <class AP>
    DI void setup(AP arow, const bf16_t* Bt, const int ldb) {
        const int tid = threadIdx.x;
#pragma unroll
        for (int i = 0; i < 4; ++i) {
            const int idx = tid + i * NTHR, row = idx >> 3, c = (idx & 7) ^ (row & 7);
            ap[i] = arow(row) + c * 8; bp[i] = Bt + (size_t)row * ldb + c * 8;
        }
    }
    DI void issue(const int kt, const int buf) const {
        const int tid = threadIdx.x;
        char* sa = lds + buf * STAGE; char* sb = sa + A_BYTES;
        const int ko = kt * 64;
#pragma unroll
        for (int i = 0; i < 4; ++i) dma16(ap[i] + ko, sa + (tid + i * NTHR) * 16);
#pragma unroll
        for (int i = 0; i < 4; ++i) dma16(bp[i] + ko, sb + (tid + i * NTHR) * 16);
    }
    template <int PM>
    DI void run_probe(const int K, f32x4 (&acc)[4][4]) const {
        const int tid = threadIdx.x, lane = tid & 63, wave = tid >> 6;
        const int wm = wave >> 1, wn = wave & 1, fr = lane & 15, fq = lane >> 4;
#pragma unroll
        for (int i = 0; i < 4; ++i)
#pragma unroll
            for (int j = 0; j < 4; ++j) acc[i][j] = (f32x4){0.f, 0.f, 0.f, 0.f};
        const int KT = K >> 6;
#pragma unroll 1
        for (int kt = 0; kt < KT; ++kt) {
            if (PM & 4) { wait_vm0(); __syncthreads(); }
            if ((PM & 1) && kt + 1 < KT) issue(kt + 1, (kt + 1) & 1);
            if (PM & 2) {
                const char* sa = lds + (kt & 1) * STAGE; const char* sb = sa + A_BYTES;
                bf16x8 xf[2][4], wf[2][4];
#pragma unroll
                for (int kk = 0; kk < 2; ++kk) {
#pragma unroll
                    for (int i = 0; i < 4; ++i) xf[kk][i] = ldsv8(sa + swz128(wm * 64 + i * 16 + fr, kk * 4 + fq));
#pragma unroll
                    for (int j = 0; j < 4; ++j) wf[kk][j] = ldsv8(sb + swz128(wn * 64 + j * 16 + fr, kk * 4 + fq));
                }
                __builtin_amdgcn_sched_barrier(0);
                __builtin_amdgcn_s_setprio(1);
#pragma unroll
                for (int kk = 0; kk < 2; ++kk)
#pragma unroll
                    for (int i = 0; i < 4; ++i)
#pragma unroll
                        for (int j = 0; j < 4; ++j) acc[i][j] = mfma16(wf[kk][j], xf[kk][i], acc[i][j]);
                __builtin_amdgcn_s_setprio(0);
            }
        }
        wait_vm0();
    }
    DI void run(const int K, f32x4 (&acc)[4][4]) const {
        const int tid = threadIdx.x, lane = tid & 63, wave = tid >> 6;
        const int wm = wave >> 1, wn = wave & 1, fr = lane & 15, fq = lane >> 4;
#pragma unroll
        for (int i = 0; i < 4; ++i)
#pragma unroll
            for (int j = 0; j < 4; ++j) acc[i][j] = (f32x4){0.f, 0.f, 0.f, 0.f};
        const int KT = K >> 6;
#pragma unroll 1
        for (int kt = 0; kt < KT; ++kt) {
            wait_vm0();
            __syncthreads();
            if (kt + 1 < KT) issue(kt + 1, (kt + 1) & 1);
            const char* sa = lds + (kt & 1) * STAGE; const char* sb = sa + A_BYTES;
            bf16x8 xf[2][4], wf[2][4];
#pragma unroll
            for (int kk = 0; kk < 2; ++kk) {
#pragma unroll
                for (int i = 0; i < 4; ++i) xf[kk][i] = ldsv8(sa + swz128(wm * 64 + i * 16 + fr, kk * 4 + fq));
#pragma unroll
                for (int j = 0; j < 4; ++j) wf[kk][j] = ldsv8(sb + swz128(wn * 64 + j * 16 + fr, kk * 4 + fq));
            }
            __builtin_amdgcn_sched_barrier(0);
            __builtin_amdgcn_s_setprio(1);
#pragma unroll
            for (int kk = 0; kk < 2; ++kk)
#pragma unroll
                for (int i = 0; i < 4; ++i)
#pragma unroll
                    for (int j = 0; j < 4; ++j) acc[i][j] = mfma16(wf[kk][j], xf[kk][i], acc[i][j]);
            __builtin_amdgcn_s_setprio(0);
        }
    }
};

constexpr int EPI_OFF = 32768;
DI int lane_m(int i) { const int t = threadIdx.x; return ((t >> 7) & 1) * 64 + i * 16 + (t & 15); }
DI int lane_n(int j) { const int t = threadIdx.x; return ((t >> 6) & 1) * 64 + j * 16 + ((t >> 4) & 3) * 4; }
DI int opaque_tid() { int t = threadIdx.x; asm volatile("" : "+v"(t)); return t; }
DI int lane_m(int t, int i) { return ((t >> 7) & 1) * 64 + i * 16 + (t & 15); }
DI int lane_n(int t, int j) { return ((t >> 6) & 1) * 64 + j * 16 + ((t >> 4) & 3) * 4; }
template <class XF>
DI void epi_stage_bf16(const f32x4 (&acc)[4][4], XF xf) {
    const int tz = opaque_tid();
#pragma unroll
    for (int i = 0; i < 4; ++i) {
        const int m = lane_m(tz, i);
#pragma unroll
        for (int j = 0; j < 4; ++j) {
            const int n = lane_n(tz, j);
            const f32x4 v = xf(i, j, acc[i][j]);
            u32x2 o; o[0] = pk2(v[0], v[1]); o[1] = pk2(v[2], v[3]);
            *(u32x2*)(lds + EPI_OFF + m * 256 + (((n >> 3) ^ (m & 15)) << 4) + (n & 4) * 2) = o;
        }
    }
}
template <class DP, class OK>
DI void epi_flush_bf16(DP dst, OK ok) {
    const int tz = opaque_tid();
#pragma unroll
    for (int it = 0; it < 8; ++it) {
        const int idx = tz + it * NTHR, row = idx >> 4, ch = idx & 15;
        const u32x4 v = *(const u32x4*)(lds + EPI_OFF + row * 256 + ((ch ^ (row & 15)) << 4));
        if (ok(row)) *(u32x4*)(dst(row) + ch * 8) = v;
    }
}
template <class XF>
DI void epi_stage_bf16_T(const f32x4 (&acc)[4][4], XF xf) {
    const int tz = opaque_tid();
    const bool odd = tz & 1;
#pragma unroll
    for (int i = 0; i < 4; ++i) {
        const int m = lane_m(tz, i) & ~1;
#pragma unroll
        for (int j = 0; j < 4; ++j) {
            const int n = lane_n(tz, j) + (odd ? 2 : 0);
            const f32x4 v = xf(i, j, acc[i][j]);
            const float r0 = __shfl_xor(odd ? v[0] : v[2], 1), r1 = __shfl_xor(odd ? v[1] : v[3], 1);
            const unsigned w0 = odd ? pk2(r0, v[2]) : pk2(v[0], r0), w1 = odd ? pk2(r1, v[3]) : pk2(v[1], r1);
            *(unsigned*)(lds + EPI_OFF + n * 256 + (((m >> 3) ^ (n & 15)) << 4) + (m & 6) * 2) = w0;
            *(unsigned*)(lds + EPI_OFF + (n + 1) * 256 + (((m >> 3) ^ ((n + 1) & 15)) << 4) + (m & 6) * 2) = w1;
        }
    }
}
DI void epi_resid_f32(const Args& a, const int li, const int m0, const int n0, const f32x4 (&acc)[4][4]) {
    const int tz = opaque_tid();
    float* X = (float*)(a.ws + WS_X);
    const float* gate = (const float*)(a.ws + WS_MOD) + ((size_t)li * 9 + tok_modrow(m0)) * 6144 + 2 * 1024 + n0;
#pragma unroll
    for (int j = 0; j < 4; ++j) {
        const int n = lane_n(tz, j);
        const f32x4 g = *(const f32x4*)(gate + n);
#pragma unroll
        for (int i = 0; i < 4; ++i) {
            float* xp = X + (size_t)(m0 + lane_m(tz, i)) * D + n0 + n;
            f32x4 x = *(const f32x4*)xp;
            x += g * acc[i][j];
            *(f32x4*)xp = x;
        }
    }
}

template <bool XPF = true, class TE>
DI void gemm_dense_phase(const bf16_t* A, const int lda, const int mrows, const bf16_t* Bt, const int N, const int K, TE tile_epi) {
    const int mt = mrows / 128, nt = N / 128;
    const int mpx = mt >> 3, bmb = mpx >> 1, full = mpx * 8;
    auto decode = [&](int u, int& m0, int& n0) {
        const int xc = u & 7, s = u >> 3;
        const int bn = s / full, rem = s - bn * full;
        const int w = min(8, nt - 8 * bn);
        const int bm = rem / (bmb * w), rem2 = rem - bm * (bmb * w);
        const int ni = rem2 / bmb, mi = rem2 - ni * bmb;
        m0 = (xc * mpx + bm * bmb + mi) * 128; n0 = (bn * 8 + ni) * 128;
    };
    GemmPipe g;
    int u = blockIdx.x, m0 = 0, n0 = 0;
    __syncthreads();
    if (u < mt * nt) { decode(u, m0, n0); g.setup([&](int r) { return A + (size_t)(m0 + r) * lda; }, Bt + (size_t)n0 * K, K); g.issue(0, 0); }
    while (u < mt * nt) {
        f32x4 acc[4][4];
        g.run(K, acc);
        const int cm0 = m0, cn0 = n0;
        u += gridDim.x;
        if (XPF) {
            if (u < mt * nt) { decode(u, m0, n0); g.setup([&](int r) { return A + (size_t)(m0 + r) * lda; }, Bt + (size_t)n0 * K, K); g.issue(0, 0); }
            tile_epi(cm0, cn0, acc);
        } else {
            tile_epi(cm0, cn0, acc);
            __syncthreads();
            if (u < mt * nt) { decode(u, m0, n0); g.setup([&](int r) { return A + (size_t)(m0 + r) * lda; }, Bt + (size_t)n0 * K, K); g.issue(0, 0); }
        }
    }
    __syncthreads();
}
template <class XF, class DP>
DI void epi_bf16_rowmajor(const f32x4 (&acc)[4][4], XF xf, DP dst) {
    __syncthreads();
    epi_stage_bf16(acc, xf);
    __syncthreads();
    epi_flush_bf16(dst, [](int) { return true; });
}

DI void phase_rg_in(const Args& a, int j) {
    bf16_t* G = (bf16_t*)(a.ws + RG_G); bf16_t* U = (bf16_t*)(a.ws + RG_U);
    gemm_dense_phase((const bf16_t*)(a.ws + WS_H), D, NTOK, (const bf16_t*)(a.ws + W_RGIN) + (size_t)j * 2048 * 1024, 2048, 1024,
        [&](int m0, int n0, const f32x4 (&acc)[4][4]) {
            if (n0 < 1024)
                epi_bf16_rowmajor(acc, [](int, int, const f32x4 v) { f32x4 g; g[0] = gelu_tanh(v[0]); g[1] = gelu_tanh(v[1]); g[2] = gelu_tanh(v[2]); g[3] = gelu_tanh(v[3]); return g; },
                                  [&](int row) { return G + (size_t)(m0 + row) * D + n0; });
            else
                epi_bf16_rowmajor(acc, [](int, int, const f32x4 v) { return v; }, [&](int row) { return U + (size_t)(m0 + row) * D + (n0 - 1024); });
        });
}

template <int VAR = 0, int HOST = 0>
DI void phase_rg_scan(const Args& a, int j) {
    const int tid = threadIdx.x, lane = tid & 63, wave = tid >> 6;
    const int fr = lane & 15, fq = lane >> 4;
    const bf16_t* U = (const bf16_t*)(a.ws + RG_U);
    bf16_t* HS = (bf16_t*)(a.ws + (VAR ? WS_Y : RG_HS));
    char* sW = lds;
    char* sX = lds + 8192;
    float* sUc = (float*)(lds + 16384);
    float* sA = (float*)(lds + 24576);
    float* sB = (float*)(lds + 33280);
    bf16_t* sO = (bf16_t*)(lds + 41984);
    unsigned* sCv = (unsigned*)(lds + 50176);
    const int c = tid & 7;
    for (int u = blockIdx.x; u < 512; u += gridDim.x) {
        const int half = u & 1, dir = (u >> 1) & 1, blk = (u >> 2) & 15, b = u >> 6;
        const int cin0 = blk * 64, co0 = blk * 64 + half * 32;
        __syncthreads();
        {
            const bf16_t* Wg = (const bf16_t*)(a.ws + W_RGG) + ((size_t)((j * 2 + dir) * 16 + blk)) * 128 * 64;
#pragma unroll
            for (int i = 0; i < 2; ++i) {
                const int idx = tid + i * NTHR, row = idx >> 3, cc = idx & 7;
                const int srow = (row >> 5) * 64 + half * 32 + (row & 31);
                *(u32x4*)(sW + swz128(row, cc)) = *(const u32x4*)(Wg + (size_t)srow * 64 + cc * 8);
            }
        }
        float carry = 0.f;
        float cw[4][8], cb[8];
        {
            const float* cwp = a.in[9] + (size_t)j * 4 * 1024 + cin0 + c * 8; const float* cbp = a.in[10] + (size_t)j * 1024 + cin0 + c * 8;
#pragma unroll
            for (int w = 0; w < 4; ++w) { const f32x4 v0 = *(const f32x4*)(cwp + w * 1024), v1 = *(const f32x4*)(cwp + w * 1024 + 4);
#pragma unroll
                for (int e = 0; e < 4; ++e) { cw[w][e] = v0[e]; cw[w][4 + e] = v1[e]; } }
            const f32x4 v0 = *(const f32x4*)cbp, v1 = *(const f32x4*)(cbp + 4);
#pragma unroll
            for (int e = 0; e < 4; ++e) { cb[e] = v0[e]; cb[4 + e] = v1[e]; }
        }
        float bg0[8], bg1[8], spl[8];
        {
            const float* gb = a.in[12] + ((size_t)(j * 2 + dir) * 2) * 1024 + co0;
            const float* lm = a.in[13] + (size_t)(j * 2 + dir) * 1024 + co0;
#pragma unroll
            for (int jt = 0; jt < 2; ++jt)
#pragma unroll
                for (int e = 0; e < 4; ++e) {
                    const int cc = jt * 16 + fq * 4 + e;
                    bg0[jt * 4 + e] = gb[cc]; bg1[jt * 4 + e] = gb[1024 + cc];
                    spl[jt * 4 + e] = -8.f * log1pf(__expf(-lm[cc]));
                }
        }
        u32x4 pu[2][4];
        auto load_chunk = [&](int ci) {
            const int seg = ci >= 4, L = seg ? SEQ : CTXL, nch = L / 64, jc = seg ? ci - 4 : ci;
            const int oc = dir ? nch - 1 - jc : jc;
            const int rb = seg ? b * SEQ : NLAT + b * CTXL;
            const int s0 = oc * 64;
#pragma unroll
            for (int it = 0; it < 2; ++it) {
                const int tk = (tid >> 3) + it * 32;
#pragma unroll
                for (int w = 0; w < 4; ++w) {
                    const int s = s0 + tk + w - 2;
                    const int sc_ = min(max(s, 0), L - 1);
                    const u32x4 ld = *(const u32x4*)(U + (size_t)(rb + sc_) * D + cin0 + c * 8);
                    const unsigned msk = (s >= 0 && s < L) ? 0xffffffffu : 0u;
                    pu[it][w] = (u32x4){ld[0] & msk, ld[1] & msk, ld[2] & msk, ld[3] & msk};
                }
            }
        };
        load_chunk(0);
        __syncthreads();
        size_t prev_base = 0;
        constexpr int CV_TILES = HOST ? 6144 : 0;
        CvTile cvp; cvp.src = nullptr; cvp.dst = nullptr; cvp.K = 0; cvp.N = 0; cvp.perm = 0; cvp.k0 = 0; cvp.n0 = 0;
        bool cvp_ok = false;
#pragma unroll 1
        for (int ci = 0; ci < 36; ++ci) {
            f32x4 cv0[4], cv1[4];
            CvTile cvc = cvp;
            const int cvq = (ci / 3) * 512 + u;
            const bool cv_ok = HOST && (ci % 3 == 0) && cvq < CV_TILES;
            if (cv_ok) { cvc = moe_cv_tile(a, 1, cvq); cv_load(cvc, cv0, cv1); }
            const int seg = ci >= 4, L = seg ? SEQ : CTXL, nch = L / 64, jc = seg ? ci - 4 : ci;
            const int oc = dir ? nch - 1 - jc : jc;
            const int rb = seg ? b * SEQ : NLAT + b * CTXL;
            const int s0 = oc * 64;
            char* sXc = sX; float* sUcc = sUc;
#pragma unroll
            for (int it = 0; it < 2; ++it) {
                const int tk = (tid >> 3) + it * 32;
                float o[8];
#pragma unroll
                for (int e = 0; e < 8; ++e) o[e] = cb[e];
#pragma unroll
                for (int w = 0; w < 4; ++w) {
                    const u32x4 r4 = pu[it][w];
#pragma unroll
                    for (int e = 0; e < 4; ++e) { o[2 * e] += cw[w][2 * e] * lof(r4[e]); o[2 * e + 1] += cw[w][2 * e + 1] * hif(r4[e]); }
                }
                u32x4 pv; pv[0] = pk2(o[0], o[1]); pv[1] = pk2(o[2], o[3]); pv[2] = pk2(o[4], o[5]); pv[3] = pk2(o[6], o[7]);
                *(u32x4*)(sXc + swz128(tk, c)) = pv;
                if ((c >> 2) == half) {
                    *(f32x4*)(sUcc + tk * 32 + (c & 3) * 8) = (f32x4){o[0], o[1], o[2], o[3]};
                    *(f32x4*)(sUcc + tk * 32 + (c & 3) * 8 + 4) = (f32x4){o[4], o[5], o[6], o[7]};
                }
            }
            if (ci + 1 < 36) load_chunk(ci + 1);
            __syncthreads();
            if (HOST && cvp_ok) cv_flush(cvp, sCv);
            if (ci > 0) {
                const u32x4 v = *(const u32x4*)(sO + ((ci - 1) & 1) * 2048 + tid * 8);
                *(u32x4*)(HS + prev_base + (size_t)(tid >> 2) * D + (tid & 3) * 8) = v;
            }
            {
                f32x4 acc[4];
#pragma unroll
                for (int jt = 0; jt < 4; ++jt) acc[jt] = (f32x4){0.f, 0.f, 0.f, 0.f};
#pragma unroll
                for (int kk = 0; kk < 2; ++kk) {
                    const bf16x8 xf = ldsv8(sXc + swz128(wave * 16 + fr, kk * 4 + fq));
#pragma unroll
                    for (int jt = 0; jt < 4; ++jt) acc[jt] = mfma16(ldsv8(sW + swz128(jt * 16 + fr, kk * 4 + fq)), xf, acc[jt]);
                }
                const int tk = wave * 16 + fr;
#pragma unroll
                for (int jt = 0; jt < 2; ++jt) {
                    const f32x4 uc = *(const f32x4*)(sUcc + tk * 32 + jt * 16 + fq * 4);
                    f32x4 av4, bv4;
#pragma unroll
                    for (int e = 0; e < 4; ++e) {
                        if (VAR & 2) { av4[e] = 0.5f + 0.001f * acc[jt][e]; bv4[e] = uc[e] + acc[jt + 2][e]; continue; }
                        const float rg = sigmoidf_(acc[jt][e] + bg0[jt * 4 + e]);
                        const float ig = sigmoidf_(acc[jt + 2][e] + bg1[jt * 4 + e]);
                        const float av = fexp(rg * spl[jt * 4 + e]);
                        av4[e] = av;
                        bv4[e] = __builtin_amdgcn_sqrtf(fmaxf(1.f - av * av, 0.f)) * ig * uc[e];
                    }
#pragma unroll
                    for (int e = 0; e < 4; ++e) { sA[(jt * 16 + fq * 4 + e) * 68 + tk] = av4[e]; sB[(jt * 16 + fq * 4 + e) * 68 + tk] = bv4[e]; }
                }
            }
            __syncthreads();
            if (!(VAR & 4)) {
                const int ch = wave * 8 + (lane & 7), sg = lane >> 3;
                const int tb = dir ? 56 - sg * 8 : sg * 8;
                const f32x4 a0 = *(const f32x4*)(sA + ch * 68 + tb), a1 = *(const f32x4*)(sA + ch * 68 + tb + 4);
                const f32x4 b0 = *(const f32x4*)(sB + ch * 68 + tb), b1 = *(const f32x4*)(sB + ch * 68 + tb + 4);
                float av[8], bv[8];
#pragma unroll
                for (int e = 0; e < 4; ++e) {
                    av[e] = dir ? a1[3 - e] : a0[e]; av[4 + e] = dir ? a0[3 - e] : a1[e];
                    bv[e] = dir ? b1[3 - e] : b0[e]; bv[4 + e] = dir ? b0[3 - e] : b1[e];
                }
                float Ap = 1.f, Hh = 0.f;
#pragma unroll
                for (int e = 0; e < 8; ++e) { Hh = av[e] * Hh + bv[e]; Ap *= av[e]; }
#pragma unroll
                for (int d = 8; d < 64; d <<= 1) {
                    const float Ao = __shfl_up(Ap, d), Ho = __shfl_up(Hh, d);
                    if (lane >= d) { Hh = Ap * Ho + Hh; Ap = Ap * Ao; }
                }
                float Aex = __shfl_up(Ap, 8), Hex = __shfl_up(Hh, 8);
                if (sg == 0) { Aex = 1.f; Hex = 0.f; }
                float hin = Aex * carry + Hex;
                const float cnew = Ap * carry + Hh;
                carry = __shfl(cnew, 56 + (lane & 7));
                bf16_t* so = sO + (ci & 1) * 2048 + ch;
#pragma unroll
                for (int e = 0; e < 8; ++e) {
                    hin = av[e] * hin + bv[e];
                    const int i = sg * 8 + e, tk = dir ? 63 - i : i;
                    so[tk * 32] = f2bf(hin);
                }
            }
            prev_base = (size_t)dir * NTOK * D + (size_t)(rb + s0) * D + co0;
            if (HOST) { if (cv_ok) cv_pack(sCv, cv0, cv1); cvp = cvc; cvp_ok = cv_ok; }
        }
        __syncthreads();
        if (HOST && cvp_ok) cv_flush(cvp, sCv);
        {
            const u32x4 v = *(const u32x4*)(sO + (35 & 1) * 2048 + tid * 8);
            *(u32x4*)(HS + prev_base + (size_t)(tid >> 2) * D + (tid & 3) * 8) = v;
        }
    }
}

DI void phase_rg_combine(const Args& a) {
    const u32x4* G = (const u32x4*)(a.ws + RG_G);
    const u32x4* H0 = (const u32x4*)(a.ws + RG_HS);
    const u32x4* H1 = (const u32x4*)(a.ws + RG_HS + TOKD2);
    u32x4* A2 = (u32x4*)(a.ws + RG_A2);
    const size_t n = (size_t)NTOK * D / 8;
    for (size_t i = (size_t)blockIdx.x * NTHR + threadIdx.x; i < n; i += (size_t)gridDim.x * NTHR) {
        const u32x4 g = G[i], h0 = H0[i], h1 = H1[i];
        u32x4 o;
#pragma unroll
        for (int e = 0; e < 4; ++e) o[e] = pk2(lof(g[e]) * (lof(h0[e]) + lof(h1[e])), hif(g[e]) * (hif(h0[e]) + hif(h1[e])));
        A2[i] = o;
    }
}

DI void phase_rg_out(const Args& a, int li, int j) {
    gemm_dense_phase((const bf16_t*)(a.ws + RG_A2), D, li == 3 ? NLAT : NTOK, (const bf16_t*)(a.ws + W_RGOUT) + (size_t)j * 1024 * 1024, 1024, 1024,
        [&](int m0, int n0, const f32x4 (&acc)[4][4]) { epi_resid_f32(a, li, m0, n0, acc); });
}

DI void phase_mla_down(const Args& a) {
    bf16_t* CQ = (bf16_t*)(a.ws + MLA_CQ); bf16_t* CKV = (bf16_t*)(a.ws + MLA_CKV); float* KR = (float*)(a.ws + MLA_KR);
    gemm_dense_phase((const bf16_t*)(a.ws + WS_H), D, NTOK, (const bf16_t*)(a.ws + W_MDOWN), 512, 1024,
        [&](int m0, int n0, const f32x4 (&acc)[4][4]) {
            if (n0 < 256) epi_bf16_rowmajor(acc, [](int, int, const f32x4 v) { return v; }, [&](int row) { return CQ + (size_t)(m0 + row) * 256 + n0; });
            else if (n0 == 256) epi_bf16_rowmajor(acc, [](int, int, const f32x4 v) { return v; }, [&](int row) { return CKV + (size_t)(m0 + row) * 128; });
            else {
#pragma unroll
                for (int i = 0; i < 4; ++i)
#pragma unroll
                    for (int j = 0; j < 2; ++j) { const int n = lane_n(j); if (n < 32) *(f32x4*)(KR + (size_t)(m0 + lane_m(i)) * 32 + n) = acc[i][j]; }
            }
        });
}

DI int perm_key(int kp) { return (kp & ~12) | ((kp & 4) << 1) | ((kp & 8) >> 1); }

DI void phase_mla_up(const Args& a) {
    const int tid = threadIdx.x;
    const bf16_t* CQ = (const bf16_t*)(a.ws + MLA_CQ); const bf16_t* CKV = (const bf16_t*)(a.ws + MLA_CKV); const float* KR = (const float*)(a.ws + MLA_KR);
    bf16_t* Q = (bf16_t*)(a.ws + MLA_Q); bf16_t* Kb = (bf16_t*)(a.ws + MLA_K); bf16_t* VT = (bf16_t*)(a.ws + MLA_VT);
    const float* qkn = a.in[20];
    const float* RC = (const float*)(a.ws + WS_CTL + CTL_ROPE); const float* RS = RC + 512;
    const int MT_ = NTOK / 128;
    const int nq = MT_ * 16, nkv = MT_ * 16;
    const float QSCALE = 0.10206207261596575f * 1.4426950408889634f;
    for (int u = blockIdx.x; u < nq + nkv; u += gridDim.x) {
        const bool isq = u < nq;
        const int uu = isq ? u : u - nq;
        const int m0 = (uu % MT_) * 128, head = uu / MT_;
        const bool islat = m0 < NLAT;
        const int bb = islat ? (m0 >> 11) : ((m0 - NLAT) >> 8);
        const int kp0 = islat ? CTXL + (m0 & (SEQ - 1)) : ((m0 - NLAT) & (CTXL - 1));
        __syncthreads();
        if (isq) {
            f32x4 hold[2][6];
            float ssq[2] = {0.f, 0.f};
            gemm_tile<4, 1, 2, 6, false>([&](int r) { return CQ + (size_t)(m0 + r) * 256; }, (const bf16_t*)(a.ws + W_MUQ) + (size_t)head * 96 * 256, 256, 256, hold, ssq);
            const int tz = opaque_tid();
            const int wave = tz >> 6, fq = (tz >> 4) & 3, fr = tz & 15;
#pragma unroll
            for (int i = 0; i < 2; ++i) {
                const int m = wave * 32 + i * 16 + fr;
                float sq = ssq[i]; sq += __shfl_xor(sq, 16); sq += __shfl_xor(sq, 32);
                const float rs0 = rsqrtf(sq * (1.f / 256.f) + EPS);
                float ss = 0.f;
#pragma unroll
                for (int jn = 0; jn < 6; ++jn) { hold[i][jn] *= rs0;
#pragma unroll
                    for (int e = 0; e < 4; ++e) ss += hold[i][jn][e] * hold[i][jn][e]; }
                ss += __shfl_xor(ss, 16); ss += __shfl_xor(ss, 32);
                const float rs = rsqrtf(ss * (1.f / 96.f) + EPS) ;
                f32x4 o[6];
#pragma unroll
                for (int jn = 0; jn < 6; ++jn) { const f32x4 g4 = *(const f32x4*)(qkn + jn * 16 + fq * 4); o[jn] = hold[i][jn] * rs * g4; }
#pragma unroll
                for (int jn = 4; jn < 6; ++jn) {
                    f32x4 other;
#pragma unroll
                    for (int e = 0; e < 4; ++e) other[e] = __shfl_xor(o[jn][e], 32);
                    if (islat) {
                        const int s = (m0 + m) & (SEQ - 1);
                        const int pos = jn == 4 ? (s >> 6) : (s & 63);
                        const f32x4 cs = *(const f32x4*)(RC + pos * 8 + (fq & 1) * 4), sn = *(const f32x4*)(RS + pos * 8 + (fq & 1) * 4);
#pragma unroll
                        for (int e = 0; e < 4; ++e) o[jn][e] = (fq < 2) ? o[jn][e] * cs[e] - other[e] * sn[e] : o[jn][e] * cs[e] + other[e] * sn[e];
                    }
                }
#pragma unroll
                for (int jn = 0; jn < 6; ++jn) {
                    const f32x4 v = o[jn] * QSCALE;
                    u32x2 pv; pv[0] = pk2(v[0], v[1]); pv[1] = pk2(v[2], v[3]);
                    *(u32x2*)(lds + m * 256 + (((jn * 2 + (fq >> 1)) ^ (m & 15)) << 4) + (fq & 1) * 8) = pv;
                }
            }
            __syncthreads();
#pragma unroll
            for (int it = 0; it < 8; ++it) {
                const int idx = tz + it * NTHR, row = idx >> 4, ch = idx & 15;
                if (ch < 12) {
                    const u32x4 v = *(const u32x4*)(lds + row * 256 + ((ch ^ (row & 15)) << 4));
                    *(u32x4*)(Q + (size_t)(m0 + row) * 1536 + head * 96 + ch * 8) = v;
                }
            }
        } else {
            f32x4 hold[4][4];
            float ssq[4] = {0.f, 0.f, 0.f, 0.f};
            gemm_tile<2, 2, 4, 4, false>([&](int r) { return CKV + (size_t)(m0 + r) * 128; }, (const bf16_t*)(a.ws + W_MUKV) + (size_t)head * 128 * 128, 128, 128, hold, ssq);
            const int tz = opaque_tid();
            const int wave = tz >> 6, wm = wave >> 1, wn = wave & 1, fq = (tz >> 4) & 3, fr = tz & 15;
            char* sK = lds; char* sV = lds + 32768;
#pragma unroll
            for (int i = 0; i < 4; ++i) {
                const int m = wm * 64 + i * 16 + fr, t = m0 + m;
                float sq = ssq[i]; sq += __shfl_xor(sq, 16); sq += __shfl_xor(sq, 32);
                const float rs0 = rsqrtf(sq * (1.f / 128.f) + EPS);
#pragma unroll
                for (int jn = 0; jn < 4; ++jn) hold[i][jn] *= rs0;
                if (wn == 0) {
                    const int base = (fq >> 1) * 16 + (fq & 1) * 4;
                    const f32x4 z1 = *(const f32x4*)(KR + (size_t)t * 32 + base);
                    const f32x4 z2 = *(const f32x4*)(KR + (size_t)t * 32 + base + 8);
                    float ss = 0.f;
#pragma unroll
                    for (int jn = 0; jn < 4; ++jn)
#pragma unroll
                        for (int e = 0; e < 4; ++e) ss += hold[i][jn][e] * hold[i][jn][e];
#pragma unroll
                    for (int e = 0; e < 4; ++e) ss += z1[e] * z1[e] + z2[e] * z2[e];
                    ss += __shfl_xor(ss, 16); ss += __shfl_xor(ss, 32);
                    const float rs = rsqrtf(ss * (1.f / 96.f) + EPS);
#pragma unroll
                    for (int jn = 0; jn < 4; ++jn) {
                        const f32x4 g4 = *(const f32x4*)(qkn + 96 + jn * 16 + fq * 4);
                        const f32x4 v = hold[i][jn] * rs * g4;
                        u32x2 pv; pv[0] = pk2(v[0], v[1]); pv[1] = pk2(v[2], v[3]);
                        *(u32x2*)(sK + m * 256 + (((jn * 2 + (fq >> 1)) ^ (m & 15)) << 4) + (fq & 1) * 8) = pv;
                    }
                    const f32x4 g1 = *(const f32x4*)(qkn + 96 + 64 + base), g2 = *(const f32x4*)(qkn + 96 + 64 + base + 8);
                    f32x4 a1 = z1 * rs * g1, a2 = z2 * rs * g2;
                    if (islat) {
                        const int s = t & (SEQ - 1);
                        const int pos = (fq >> 1) == 0 ? (s >> 6) : (s & 63);
                        const f32x4 cs = *(const f32x4*)(RC + pos * 8 + (fq & 1) * 4), sn = *(const f32x4*)(RS + pos * 8 + (fq & 1) * 4);
                        const f32x4 b1 = a1 * cs - a2 * sn, b2 = a2 * cs + a1 * sn;
                        a1 = b1; a2 = b2;
                    }
                    u32x2 p1, p2; p1[0] = pk2(a1[0], a1[1]); p1[1] = pk2(a1[2], a1[3]); p2[0] = pk2(a2[0], a2[1]); p2[1] = pk2(a2[2], a2[3]);
                    const int c1 = 8 + (fq >> 1) * 2;
                    *(u32x2*)(sK + m * 256 + ((c1 ^ (m & 15)) << 4) + (fq & 1) * 8) = p1;
                    *(u32x2*)(sK + m * 256 + (((c1 + 1) ^ (m & 15)) << 4) + (fq & 1) * 8) = p2;
                }
                {
                    const bool odd = fr & 1;
                    const int mp = perm_key(m & ~1);
#pragma unroll
                    for (int jn = 0; jn < 4; ++jn) {
                        const f32x4 v = hold[i][jn];
                        const float r0 = __shfl_xor(odd ? v[0] : v[2], 1), r1 = __shfl_xor(odd ? v[1] : v[3], 1);
                        if (wn == 1) {
                            const int e0 = jn * 16 + fq * 4 + (odd ? 2 : 0);
                            const unsigned w0 = odd ? pk2(r0, v[2]) : pk2(v[0], r0), w1 = odd ? pk2(r1, v[3]) : pk2(v[1], r1);
                            *(unsigned*)(sV + e0 * 256 + (((mp >> 3) ^ (e0 & 15)) << 4) + (mp & 6) * 2) = w0;
                            *(unsigned*)(sV + (e0 + 1) * 256 + (((mp >> 3) ^ ((e0 + 1) & 15)) << 4) + (mp & 6) * 2) = w1;
                        }
                    }
                }
            }
            __syncthreads();
            bf16_t* kdst = Kb + ((size_t)(bb * 16 + head) * NKEY + kp0) * 96;
#pragma unroll
            for (int it = 0; it < 8; ++it) {
                const int idx = tz + it * NTHR, row = idx >> 4, ch = idx & 15;
                if (ch < 12) {
                    const u32x4 v = *(const u32x4*)(sK + row * 256 + ((ch ^ (row & 15)) << 4));
                    *(u32x4*)(kdst + (size_t)row * 96 + ch * 8) = v;
                }
            }
            bf16_t* vdst = VT + ((size_t)(bb * 16 + head) * 64) * NKEY + kp0;
#pragma unroll
            for (int it = 0; it < 4; ++it) {
                const int idx = tz + it * NTHR, row = idx >> 4, ch = idx & 15;
                const u32x4 v = *(const u32x4*)(sV + row * 256 + ((ch ^ (row & 15)) << 4));
                *(u32x4*)(vdst + (size_t)row * NKEY + ch * 8) = v;
            }
        }
    }
}

DI void phase_mla_attn(const Args& a) {
    const int tid = threadIdx.x, lane = tid & 63, wave = tid >> 6;
    const int r = lane & 31, h = lane >> 5;
    const bf16_t* Q = (const bf16_t*)(a.ws + MLA_Q); const bf16_t* Kb = (const bf16_t*)(a.ws + MLA_K); const bf16_t* VT = (const bf16_t*)(a.ws + MLA_VT);
    bf16_t* O = (bf16_t*)(a.ws + MLA_O);
    constexpr int KT_B = 64 * 256, VT_B = 64 * 128, ST_B = KT_B + VT_B;
    unsigned* sCv = (unsigned*)(lds + 49152);
    const int cv_per = 18432 / gridDim.x;
    int cvn = 0, itc = 0;
    bool cv_pack_p = false, cv_flush_p = false;
    CvTile cvB, cvC; cvB.src = nullptr; cvB.dst = nullptr; cvB.K = 0; cvB.N = 0; cvB.perm = 0; cvB.k0 = 0; cvB.n0 = 0; cvC = cvB;
    f32x4 cv0[4], cv1[4];
#pragma unroll
    for (int i = 0; i < 4; ++i) { cv0[i] = (f32x4){0.f, 0.f, 0.f, 0.f}; cv1[i] = cv0[i]; }
    auto cv_step = [&](bool may_load) {
        if (cv_flush_p) { cv_flush(cvC, sCv); cv_flush_p = false; }
        if (cv_pack_p) { cv_pack(sCv, cv0, cv1); cvC = cvB; cv_flush_p = true; cv_pack_p = false; }
        if (may_load && cvn < cv_per) {
            const int t = cvn * gridDim.x + blockIdx.x;
            cvB = moe_cv_tile(a, 1 + t / 6144, t % 6144); cv_load(cvB, cv0, cv1); cv_pack_p = true; ++cvn;
        }
    };
    for (int u = blockIdx.x; u < 2048 + 256; u += gridDim.x) {
        const bool isctx = u >= 2048;
        const int uu = isctx ? u - 2048 : u;
        const int qb = isctx ? (uu & 1) : (uu & 15), head = isctx ? ((uu >> 1) & 15) : ((uu >> 4) & 15), b = isctx ? (uu >> 5) : (uu >> 8);
        const int ntile = isctx ? CTXL / 64 : NKEY / 64;
        const int t = (isctx ? NLAT + b * CTXL : b * SEQ) + qb * 128 + wave * 32 + r;
        const bf16_t* kbase = Kb + (size_t)(b * 16 + head) * NKEY * 96;
        const bf16_t* vbase = VT + (size_t)(b * 16 + head) * 64 * NKEY;
        bf16x8 qf[6];
#pragma unroll
        for (int kk = 0; kk < 6; ++kk) qf[kk] = *(const bf16x8*)(Q + (size_t)t * 1536 + head * 96 + kk * 16 + h * 8);
        f32x16 o[2];
#pragma unroll
        for (int e = 0; e < 16; ++e) { o[0][e] = 0.f; o[1][e] = 0.f; }
        float lsum = 0.f;
        __syncthreads();
        auto stage = [&](int kt, int buf) {
            char* sk = lds + buf * ST_B; char* sv = sk + KT_B;
            const int key0 = kt * 64;
#pragma unroll
            for (int i = 0; i < 4; ++i) {
                const int idx = tid + i * NTHR, row = idx >> 4; int c = (idx & 15) ^ (row & 15); if (c >= 12) c = 0;
                dma16(kbase + (size_t)(key0 + row) * 96 + c * 8, sk + idx * 16);
            }
#pragma unroll
            for (int i = 0; i < 2; ++i) {
                const int idx = tid + i * NTHR, row = idx >> 3, c = (idx & 7) ^ ((row >> 1) & 7);
                dma16(vbase + (size_t)row * NKEY + key0 + c * 8, sv + idx * 16);
            }
        };
        stage(0, 0);
#pragma unroll 1
        for (int kt = 0; kt < ntile; ++kt) {
            wait_vm0();
            __syncthreads();
            if (kt + 1 < ntile) stage(kt + 1, (kt + 1) & 1);
            cv_step((itc & 3) == 0); ++itc;
            const char* sk = lds + (kt & 1) * ST_B; const char* sv = sk + KT_B;
            f32x16 st[2];
#pragma unroll
            for (int e = 0; e < 16; ++e) { st[0][e] = -8.f; st[1][e] = -8.f; }
#pragma unroll
            for (int kk = 0; kk < 6; ++kk)
#pragma unroll
                for (int si = 0; si < 2; ++si) {
                    const int s = si * 32 + r;
                    st[si] = mfma32(ldsv8(sk + swz256(s, kk * 2 + h)), qf[kk], st[si]);
                }
            float ps = 0.f;
#pragma unroll
            for (int si = 0; si < 2; ++si)
#pragma unroll
                for (int e = 0; e < 16; ++e) { const float p = __builtin_amdgcn_exp2f(st[si][e]); st[si][e] = p; ps += p; }
            lsum += ps;
#pragma unroll
            for (int si = 0; si < 2; ++si)
#pragma unroll
                for (int ks = 0; ks < 2; ++ks) {
                    u32x4 pp;
                    pp[0] = pk2(st[si][8 * ks + 0], st[si][8 * ks + 1]); pp[1] = pk2(st[si][8 * ks + 2], st[si][8 * ks + 3]);
                    pp[2] = pk2(st[si][8 * ks + 4], st[si][8 * ks + 5]); pp[3] = pk2(st[si][8 * ks + 6], st[si][8 * ks + 7]);
                    const bf16x8 pf = __builtin_bit_cast(bf16x8, pp);
#pragma unroll
                    for (int et = 0; et < 2; ++et) {
                        const int e = et * 32 + r;
                        o[et] = mfma32(ldsv8(sv + e * 128 + (((si * 4 + ks * 2 + h) ^ ((e >> 1) & 7)) << 4)), pf, o[et]);
                    }
                }
        }
        lsum += __shfl_xor(lsum, 32);
        const float inv = 1.f / lsum;
#pragma unroll
        for (int et = 0; et < 2; ++et)
#pragma unroll
            for (int g = 0; g < 4; ++g) {
                f32x4 v; v[0] = o[et][4 * g] * inv; v[1] = o[et][4 * g + 1] * inv; v[2] = o[et][4 * g + 2] * inv; v[3] = o[et][4 * g + 3] * inv;
                st_bf4(O + (size_t)t * D + head * 64 + et * 32 + 8 * g + 4 * h, v);
            }
    }
    while (cvn < cv_per || cv_pack_p || cv_flush_p) { __syncthreads(); cv_step(!cv_pack_p && !cv_flush_p); }
}

DI void phase_mla_out(const Args& a, int li) {
    gemm_dense_phase((const bf16_t*)(a.ws + MLA_O), D, NTOK, (const bf16_t*)(a.ws + W_MO), 1024, 1024,
        [&](int m0, int n0, const f32x4 (&acc)[4][4]) { epi_resid_f32(a, li, m0, n0, acc); });
}

DI void phase_ml_in(const Args& a) {
    bf16_t* Qm = (bf16_t*)(a.ws + ML_Q); bf16_t* Km = (bf16_t*)(a.ws + ML_K); bf16_t* KT = (bf16_t*)(a.ws + ML_KT); bf16_t* VT = (bf16_t*)(a.ws + ML_VT);
    bf16_t* OG = (bf16_t*)(a.ws + ML_OG); float* GT = (float*)(a.ws + ML_GT);
    const float* gb = a.in[23];
    auto ident = [](int, int, const f32x4 v) { return v; };
    gemm_dense_phase<false>((const bf16_t*)(a.ws + WS_H), D, NTOK, (const bf16_t*)(a.ws + W_MLIN), 3200, 1024,
        [&](int m0, int n0, const f32x4 (&acc)[4][4]) {
            if (n0 < 512) {
                epi_bf16_rowmajor(acc, [](int, int, const f32x4 v) { return v * 0.08838834764831845f; }, [&](int row) { return Qm + (size_t)(m0 + row) * 512 + n0; });
            } else if (n0 < 1024) {
                epi_bf16_rowmajor(acc, ident, [&](int row) { return Km + (size_t)(m0 + row) * 512 + (n0 - 512); });
                __syncthreads();
                epi_stage_bf16_T(acc, ident);
                __syncthreads();
                epi_flush_bf16([&](int row) { return KT + (size_t)(n0 - 512 + row) * NTOK + m0; }, [](int) { return true; });
            } else if (n0 < 2048) {
                __syncthreads();
                epi_stage_bf16_T(acc, ident);
                __syncthreads();
                epi_flush_bf16([&](int row) { return VT + (size_t)(n0 - 1024 + row) * NTOK + m0; }, [](int) { return true; });
            } else if (n0 < 3072) {
                epi_bf16_rowmajor(acc, [](int, int, const f32x4 v) { f32x4 s; s[0] = sigmoidf_(v[0]); s[1] = sigmoidf_(v[1]); s[2] = sigmoidf_(v[2]); s[3] = sigmoidf_(v[3]); return s; },
                                  [&](int row) { return OG + (size_t)(m0 + row) * D + (n0 - 2048); });
            } else {
#pragma unroll
                for (int i = 0; i < 4; ++i) {
                    const int n = lane_n(0);
                    if (n < 16) { f32x4 s = acc[i][0]; s[0] += gb[n]; s[1] += gb[n + 1]; s[2] += gb[n + 2]; s[3] += gb[n + 3]; *(f32x4*)(GT + (size_t)(m0 + lane_m(i)) * 16 + n) = s; }
                }
            }
        });
}

DI void phase_ml_scan(const Args& a) {
    const int tid = threadIdx.x, lane = tid & 63, wave = tid >> 6;
    const int fr = lane & 15, fq = lane >> 4;
    const bf16_t* Qm = (const bf16_t*)(a.ws + ML_Q); const bf16_t* Km = (const bf16_t*)(a.ws + ML_K);
    const bf16_t* KT = (const bf16_t*)(a.ws + ML_KT); const bf16_t* VT = (const bf16_t*)(a.ws + ML_VT);
    const float* GT = (const float*)(a.ws + ML_GT);
    bf16_t* HS = (bf16_t*)(a.ws + ML_HS);
    char* sQ = lds;
    char* sK = lds + 16384;
    char* sS = sK;
    char* sKT = lds + 32768;
    char* sVT = lds + 49152;
    char* sCT = lds + 55296;
    float* sRow = (float*)(lds + 67584);
    float* sCol = sRow + 64;
    float* sInt = sCol + 64;
    float* sNrm = sInt + 64;
    float* sWv = sNrm + 64;
    float* sSc = sWv + 64;
    for (int u = blockIdx.x; u < 512; u += gridDim.x) {
        const int sl = u & 7, dir = (u >> 3) & 1, head = (u >> 4) & 3, b = u >> 6;
        auto chunk_t0 = [&](int ci) {
            const int seg = ci >= 4, L = seg ? SEQ : CTXL, nch = L / 64, jc = seg ? ci - 4 : ci;
            const int oc = dir ? nch - 1 - jc : jc;
            return (seg ? b * SEQ : NLAT + b * CTXL) + oc * 64;
        };
        u32x4 pq[4], pk[4], pkt[4], pvt;
        float gi_n = 0.f, gf_n = 0.f;
        auto load_tiles = [&](int t0) {
#pragma unroll
            for (int i = 0; i < 4; ++i) {
                const int idx = tid + i * NTHR, row = idx >> 4, c = (idx & 15) ^ (row & 15);
                pq[i] = *(const u32x4*)(Qm + (size_t)(t0 + row) * 512 + head * 128 + c * 8);
                pk[i] = *(const u32x4*)(Km + (size_t)(t0 + row) * 512 + head * 128 + c * 8);
            }
#pragma unroll
            for (int i = 0; i < 4; ++i) {
                const int idx = tid + i * NTHR, row = idx >> 3, c = (idx & 7) ^ (row & 7);
                pkt[i] = *(const u32x4*)(KT + (size_t)(head * 128 + row) * NTOK + t0 + c * 8);
            }
            { const int row = tid >> 3, c = (tid & 7) ^ (row & 7); pvt = *(const u32x4*)(VT + (size_t)(head * 256 + sl * 32 + row) * NTOK + t0 + c * 8); }
            if (wave == 0) {
                const int s = dir ? 63 - lane : lane;
                gi_n = GT[(size_t)(t0 + s) * 16 + dir * 8 + head];
                gf_n = GT[(size_t)(t0 + s) * 16 + dir * 8 + 4 + head];
            }
        };
        auto store_tiles = [&]() {
#pragma unroll
            for (int i = 0; i < 4; ++i) { *(u32x4*)(sQ + (tid + i * NTHR) * 16) = pq[i]; *(u32x4*)(sK + (tid + i * NTHR) * 16) = pk[i]; *(u32x4*)(sKT + (tid + i * NTHR) * 16) = pkt[i]; }
            *(u32x4*)(sVT + tid * 16) = pvt;
        };
        auto gate_scalars = [&]() {
            const int s = dir ? 63 - lane : lane;
            const float ig = gi_n, fg = gf_n;
            const float lf = fminf(fg, 0.f) - __logf(1.f + fexp(-fabsf(fg)));
            float bc = lf;
#pragma unroll
            for (int d = 1; d < 64; d <<= 1) { const float o = __shfl_up(bc, d); if (lane >= d) bc += o; }
            const float av = ig - bc;
            float pm = av;
#pragma unroll
            for (int d = 1; d < 64; d <<= 1) { const float o = __shfl_up(pm, d); if (lane >= d) pm = fmaxf(pm, o); }
            const float mst = sSc[1];
            const float mm = fmaxf(mst, pm);
            sRow[s] = -mm;
            sCol[s] = av;
            sInt[s] = fexp(mst - mm);
            sNrm[s] = fexp(-(bc + mm));
            const float mmL = __shfl(mm, 63), bL = __shfl(bc, 63);
            sWv[s] = fexp(av - mmL);
            if (lane == 0) { sSc[0] = fexp(mst - mmL); sSc[1] = bL + mmL; }
        };
        __syncthreads();
        for (int i = tid; i < 12288 / 16; i += NTHR) *(u32x4*)(sCT + i * 16) = (u32x4){0u, 0u, 0u, 0u};
        for (int i = tid; i < 16 * 8; i += NTHR) {
            const int row = 32 + (i >> 3), c = i & 7;
            const unsigned v = row == 32 ? 0x3f803f80u : 0u;
            *(u32x4*)(sVT + swz128(row, c)) = (u32x4){v, v, v, v};
        }
        if (tid == 0) sSc[1] = -1e30f;
        f32x4 accC[2][3];
#pragma unroll
        for (int i = 0; i < 2; ++i)
#pragma unroll
            for (int jn = 0; jn < 3; ++jn) accC[i][jn] = (f32x4){0.f, 0.f, 0.f, 0.f};
        load_tiles(chunk_t0(0));
        __syncthreads();
        store_tiles();
        if (wave == 0) gate_scalars();
        __syncthreads();
#pragma unroll 1
        for (int ci = 0; ci < 36; ++ci) {
            const int t0 = chunk_t0(ci);
            if (ci + 1 < 36) load_tiles(chunk_t0(ci + 1));
            f32x4 sacc[4];
#pragma unroll
            for (int jt = 0; jt < 4; ++jt) sacc[jt] = (f32x4){0.f, 0.f, 0.f, 0.f};
#pragma unroll
            for (int kk = 0; kk < 4; ++kk) {
                const bf16x8 qf = ldsv8(sQ + swz256(wave * 16 + fr, kk * 4 + fq));
#pragma unroll
                for (int jt = 0; jt < 4; ++jt) sacc[jt] = mfma16(ldsv8(sK + swz256(jt * 16 + fr, kk * 4 + fq)), qf, sacc[jt]);
            }
            __syncthreads();
            {
                const int tq = wave * 16 + fr;
                const float rt = sRow[tq];
#pragma unroll
                for (int jt = 0; jt < 4; ++jt) {
                    const f32x4 cl = *(const f32x4*)(sCol + jt * 16 + fq * 4);
                    f32x4 v;
#pragma unroll
                    for (int e = 0; e < 4; ++e) {
                        const int s = jt * 16 + fq * 4 + e;
                        const bool ok = dir ? (s >= tq) : (s <= tq);
                        v[e] = ok ? sacc[jt][e] * fexp(rt + cl[e]) : 0.f;
                    }
                    u32x2 pv; pv[0] = pk2(v[0], v[1]); pv[1] = pk2(v[2], v[3]);
                    *(u32x2*)(sS + swz128(tq, jt * 2 + (fq >> 1)) + (fq & 1) * 8) = pv;
                }
            }
            __syncthreads();
            {
                f32x4 n1[3], n2[3];
#pragma unroll
                for (int jt = 0; jt < 3; ++jt) { n1[jt] = (f32x4){0.f, 0.f, 0.f, 0.f}; n2[jt] = (f32x4){0.f, 0.f, 0.f, 0.f}; }
#pragma unroll
                for (int kk = 0; kk < 2; ++kk) {
                    const bf16x8 sf = ldsv8(sS + swz128(wave * 16 + fr, kk * 4 + fq));
#pragma unroll
                    for (int jt = 0; jt < 3; ++jt) n1[jt] = mfma16(ldsv8(sVT + swz128(jt * 16 + fr, kk * 4 + fq)), sf, n1[jt]);
                }
#pragma unroll
                for (int kk = 0; kk < 4; ++kk) {
                    const bf16x8 qf = ldsv8(sQ + swz256(wave * 16 + fr, kk * 4 + fq));
#pragma unroll
                    for (int jt = 0; jt < 3; ++jt) n2[jt] = mfma16(ldsv8(sCT + swz256(jt * 16 + fr, kk * 4 + fq)), qf, n2[jt]);
                }
                const int tq = wave * 16 + fr;
                const float it = sInt[tq];
                float den = n1[2][0] + it * n2[2][0];
                den = __shfl(den, fr);
                const float dn = fmaxf(fabsf(den), sNrm[tq]);
                const float inv = rcpf_(dn);
                bf16_t* hp = HS + (size_t)dir * NTOK * D + (size_t)(t0 + tq) * D + head * 256 + sl * 32 + fq * 4;
#pragma unroll
                for (int jt = 0; jt < 2; ++jt) {
                    f32x4 v;
#pragma unroll
                    for (int e = 0; e < 4; ++e) v[e] = (n1[jt][e] + it * n2[jt][e]) * inv;
                    st_bf4(hp + jt * 16, v);
                }
            }
            {
                const float decay = sSc[0];
#pragma unroll
                for (int i = 0; i < 2; ++i)
#pragma unroll
                    for (int jn = 0; jn < 3; ++jn) accC[i][jn] *= decay;
#pragma unroll
                for (int kk = 0; kk < 2; ++kk) {
                    bf16x8 vf[3];
#pragma unroll
                    for (int jn = 0; jn < 3; ++jn) vf[jn] = ldsv8(sVT + swz128(jn * 16 + fr, kk * 4 + fq));
                    const f32x4 w0 = *(const f32x4*)(sWv + kk * 32 + fq * 8), w1 = *(const f32x4*)(sWv + kk * 32 + fq * 8 + 4);
#pragma unroll
                    for (int i = 0; i < 2; ++i) {
                        const u32x4 kr = *(const u32x4*)(sKT + swz128((wave * 2 + i) * 16 + fr, kk * 4 + fq));
                        u32x4 ks;
                        ks[0] = pk2(lof(kr[0]) * w0[0], hif(kr[0]) * w0[1]); ks[1] = pk2(lof(kr[1]) * w0[2], hif(kr[1]) * w0[3]);
                        ks[2] = pk2(lof(kr[2]) * w1[0], hif(kr[2]) * w1[1]); ks[3] = pk2(lof(kr[3]) * w1[2], hif(kr[3]) * w1[3]);
                        const bf16x8 kf = __builtin_bit_cast(bf16x8, ks);
#pragma unroll
                        for (int jn = 0; jn < 3; ++jn) accC[i][jn] = mfma16(kf, vf[jn], accC[i][jn]);
                    }
                }
            }
            __syncthreads();
#pragma unroll
            for (int i = 0; i < 2; ++i)
#pragma unroll
                for (int jn = 0; jn < 3; ++jn) {
                    const int dd = (wave * 2 + i) * 16 + fq * 4, ee = jn * 16 + fr;
                    u32x2 pv; pv[0] = pk2(accC[i][jn][0], accC[i][jn][1]); pv[1] = pk2(accC[i][jn][2], accC[i][jn][3]);
                    *(u32x2*)(sCT + swz256(ee, dd >> 3) + (dd & 7) * 2) = pv;
                }
            if (ci + 1 < 36) {
                store_tiles();
                if (wave == 0) gate_scalars();
            }
            __syncthreads();
        }
    }
}

DI void phase_ml_readout(const Args& a) {
    const int tid = threadIdx.x, lane = tid & 63, wave = tid >> 6;
    const bf16_t* H0 = (const bf16_t*)(a.ws + ML_HS); const bf16_t* H1 = H0 + (size_t)NTOK * D;
    const bf16_t* OG = (const bf16_t*)(a.ws + ML_OG); bf16_t* A2 = (bf16_t*)(a.ws + ML_A2);
    const float* on = a.in[24];
    for (int t = blockIdx.x * 4 + wave; t < NTOK; t += gridDim.x * 4) {
        const size_t off = (size_t)t * D + lane * 16;
        const u32x4 a0 = *(const u32x4*)(H0 + off), a1 = *(const u32x4*)(H0 + off + 8);
        const u32x4 b0 = *(const u32x4*)(H1 + off), b1 = *(const u32x4*)(H1 + off + 8);
        float v[16];
#pragma unroll
        for (int e = 0; e < 4; ++e) {
            v[2 * e] = lof(a0[e]) + lof(b0[e]); v[2 * e + 1] = hif(a0[e]) + hif(b0[e]);
            v[8 + 2 * e] = lof(a1[e]) + lof(b1[e]); v[8 + 2 * e + 1] = hif(a1[e]) + hif(b1[e]);
        }
        float ss = 0.f;
#pragma unroll
        for (int e = 0; e < 16; ++e) ss += v[e] * v[e];
        ss += __shfl_xor(ss, 1); ss += __shfl_xor(ss, 2); ss += __shfl_xor(ss, 4); ss += __shfl_xor(ss, 8);
        const float rs = rsqrtf(ss * (1.f / 256.f) + EPS);
        const u32x4 g0 = *(const u32x4*)(OG + off), g1 = *(const u32x4*)(OG + off + 8);
        const float* onp = on + lane * 16;
        u32x4 o0, o1;
#pragma unroll
        for (int e = 0; e < 4; ++e) {
            o0[e] = pk2(v[2 * e] * rs * onp[2 * e] * lof(g0[e]), v[2 * e + 1] * rs * onp[2 * e + 1] * hif(g0[e]));
            o1[e] = pk2(v[8 + 2 * e] * rs * onp[8 + 2 * e] * lof(g1[e]), v[8 + 2 * e + 1] * rs * onp[8 + 2 * e + 1] * hif(g1[e]));
        }
        *(u32x4*)(A2 + off) = o0; *(u32x4*)(A2 + off + 8) = o1;
    }
}

DI void phase_ml_out(const Args& a, int li) {
    gemm_dense_phase((const bf16_t*)(a.ws + ML_A2), D, NTOK, (const bf16_t*)(a.ws + W_MLOUT), 1024, 1024,
        [&](int m0, int n0, const f32x4 (&acc)[4][4]) { epi_resid_f32(a, li, m0, n0, acc); });
}

template <int STAGE>
DI void phase_moe(const Args& a, int li) {
    const int tid = threadIdx.x, lane = tid & 63, wave = tid >> 6;
    const int fr = lane & 15, fq = lane >> 4, wm = wave >> 1, wn = wave & 1;
    const int* cnt = (const int*)(a.ws + WS_CTL + CTL_CNT) + li * 64;
    const int* list = (const int*)(a.ws + WS_LIST);
    const float* wsl = (const float*)(a.ws + WS_WSLOT);
    const bf16_t* F = (const bf16_t*)(a.ws + WS_H);
    bf16_t* HM = (bf16_t*)(a.ws + WS_HMID); bf16_t* Y = (bf16_t*)(a.ws + WS_Y);
    int* pre = (int*)(lds + LDS_AUX);
    int* srowb = pre + 16;
    const int xc = blockIdx.x & 7, rank = blockIdx.x >> 3, nrank = gridDim.x >> 3;
    __syncthreads();
    if (tid == 0) { int s = 0; for (int i = 0; i < 8; ++i) { pre[i] = s; s += (cnt[xc + 8 * i] + 127) >> 7; } pre[8] = s; }
    __syncthreads();
    const int T = pre[8];
    constexpr int NTN = STAGE == 0 ? 4 : 8;
    constexpr int KK = STAGE == 0 ? 1024 : 256;
    const int total = T * NTN;
    int e = 0, r0 = 0, ce = 0, nt = 0, cur = 0;
    auto decode = [&](int u) {
        const int ti = u / NTN; nt = u % NTN;
        int ei = 0;
#pragma unroll 1
        for (int s = 4; s > 0; s >>= 1) if (pre[ei + s] <= ti) ei += s;
        e = xc + 8 * ei; r0 = (ti - pre[ei]) * 128; ce = cnt[e];
    };
    GemmPipe g;
    auto prep = [&](int buf) {
        int* srow = srowb + buf * 128;
        if (tid < 128) srow[tid] = list[(size_t)e * NTOK + min(r0 + tid, ce - 1)];
        __syncthreads();
        if (STAGE == 0) g.setup([&](int r) { return F + (size_t)(srow[r] >> 1) * D; }, (const bf16_t*)(a.ws + W_GU) + ((size_t)(li * 64 + e) * 512 + nt * 128) * 1024, 1024);
        else g.setup([&](int r) { return HM + (size_t)srow[r] * 256; }, (const bf16_t*)(a.ws + W_DN) + ((size_t)(li * 64 + e) * 1024 + nt * 128) * 256, 256);
        g.issue(0, 0);
    };
    int u = rank;
    if (u < total) { decode(u); prep(cur); }
    while (u < total) {
        f32x4 acc[4][4];
        g.run(KK, acc);
        const int cr0 = r0, cce = ce, cnt_ = nt;
        const int* srow = srowb + cur * 128;
        u += nrank;
        if (u < total) { decode(u); prep(cur ^ 1); }
        if (STAGE == 0) {
            __syncthreads();
            {
                const int tz = opaque_tid();
#pragma unroll
                for (int i = 0; i < 4; ++i) {
                    const int m = lane_m(tz, i);
#pragma unroll
                    for (int p = 0; p < 2; ++p) {
                        const int c = (((tz >> 6) & 1) * 2 + p) * 16 + ((tz >> 4) & 3) * 4;
                        f32x4 v;
#pragma unroll
                        for (int x = 0; x < 4; ++x) { const float gg = acc[i][2 * p][x]; v[x] = gg * rcpf_(1.f + fexp(-gg)) * acc[i][2 * p + 1][x]; }
                        u32x2 o; o[0] = pk2(v[0], v[1]); o[1] = pk2(v[2], v[3]);
                        *(u32x2*)(lds + EPI_OFF + m * 128 + (((c >> 3) ^ (m & 7)) << 4) + (c & 4) * 2) = o;
                    }
                }
            }
            __syncthreads();
            {
                const int tz = opaque_tid();
#pragma unroll
                for (int it = 0; it < 4; ++it) {
                    const int idx = tz + it * NTHR, row = idx >> 3, ch = idx & 7;
                    const u32x4 v = *(const u32x4*)(lds + EPI_OFF + row * 128 + ((ch ^ (row & 7)) << 4));
                    if (cr0 + row < cce) *(u32x4*)(HM + (size_t)srow[row] * 256 + cnt_ * 64 + ch * 8) = v;
                }
            }
        } else {
            float wrow[4];
            {
                const int tz = opaque_tid();
#pragma unroll
                for (int i = 0; i < 4; ++i) wrow[i] = wsl[srow[lane_m(tz, i)]];
            }
            __syncthreads();
            epi_stage_bf16(acc, [&](int i, int, const f32x4 v) { return v * wrow[i]; });
            __syncthreads();
            epi_flush_bf16([&](int row) { return Y + (size_t)srow[row] * D + cnt_ * 128; }, [&](int row) { return cr0 + row < cce; });
        }
        cur ^= 1;
    }
    __syncthreads();
}

#ifndef DBG_GPROBE
#define DBG_GPROBE -1
#endif
template <int PM>
DI void phase_gemm_probe(const Args& a) {
    const bf16_t* A = (const bf16_t*)(a.ws + WS_H); const bf16_t* Bt = (const bf16_t*)(a.ws + W_RGIN);
    float* dummy = (float*)(a.ws + RG_A2);
    const int mt = 144, nt = 16, K = 1024;
    GemmPipe g;
    __syncthreads();
    for (int u = blockIdx.x; u < mt * nt; u += gridDim.x) {
        const int m0 = (u % mt) * 128, n0 = (u / mt) * 128;
        g.setup([&](int r) { return A + (size_t)(m0 + r) * 1024; }, Bt + (size_t)n0 * K, K);
        if (PM & 1) g.issue(0, 0);
        f32x4 acc[4][4];
        g.run_probe<PM>(K, acc);
        float s = 0.f;
#pragma unroll
        for (int i = 0; i < 4; ++i)
#pragma unroll
            for (int j = 0; j < 4; ++j) s += acc[i][j][0] + acc[i][j][1] + acc[i][j][2] + acc[i][j][3];
        if (s == 12345.678f) dummy[threadIdx.x] = s;
        if (PM & 8) {
            bf16_t* Yd = (bf16_t*)(a.ws + WS_Y);
            const int lane = threadIdx.x & 63, wave = threadIdx.x >> 6;
            const int mb = m0 + (wave >> 1) * 64 + (lane & 15), nb = n0 + (wave & 1) * 64 + (lane >> 4) * 4;
#pragma unroll
            for (int i = 0; i < 4; ++i)
#pragma unroll
                for (int j = 0; j < 4; ++j) {
                    f32x4 v = acc[i][j];
                    if (PM & 16) { v[0] = gelu_tanh(v[0]); v[1] = gelu_tanh(v[1]); v[2] = gelu_tanh(v[2]); v[3] = gelu_tanh(v[3]); }
                    st_bf4(Yd + (size_t)(mb + i * 16) * 2048 + nb + j * 16, v);
                }
        }
        __syncthreads();
    }
}

#ifndef DBG_STOP
#define DBG_STOP 99
#endif
#ifndef DBG_OFF
#define DBG_OFF 0
#endif
DI void phase_dbg(const Args& a) {
    const size_t n = (size_t)NLAT * D;
    const float* X = (const float*)(a.ws + WS_X);
    const bf16_t* B = (const bf16_t*)(a.ws + (size_t)DBG_OFF);
    for (size_t i = (size_t)blockIdx.x * NTHR + threadIdx.x; i < n; i += (size_t)gridDim.x * NTHR)
        a.out[i] = DBG_OFF ? bf2f(B[i]) : X[i];
}

constexpr int NPH = 34;
__global__ void __launch_bounds__(NTHR, 2) fwd(const Args a) {
    if (threadIdx.x == 0) *(uint4*)(lds + LDS_BARW) = make_uint4(0u, 0u, 0u, 0u);
    __syncthreads();
    XcdBarrier bar;
    const bool multi = (a.ph_hi - a.ph_lo) > 1;
    if (multi) bar = xcd_barrier_post((unsigned*)(a.ws + WS_CTL), (volatile LAS unsigned*)(lds + LDS_BARW));
#ifndef DBG_REP
#define DBG_REP -1
#endif
#ifndef DBG_REPN
#define DBG_REPN 3
#endif
#define RUN(id, ...) do { if (a.ph_lo <= (id) && (id) < a.ph_hi) { \
        if ((id) == DBG_REP) { for (int rep_ = 1; rep_ < DBG_REPN; ++rep_) { __VA_ARGS__; xcd_barrier(bar); } } \
        __VA_ARGS__; if ((id) + 1 < a.ph_hi) xcd_barrier(bar); } } while (0)
    RUN(0, phase_prologue(a));
    RUN(1, phase_token_row<0>(a, 0));
    RUN(2, phase_rg_in(a, 0));
    if (DBG_GPROBE >= 0) { RUN(2, phase_gemm_probe<(DBG_GPROBE < 0 ? 7 : DBG_GPROBE)>(a)); }
#ifdef DBG_SCANVAR
    RUN(3, phase_rg_scan<DBG_SCANVAR>(a, 0));
#endif
    RUN(3, phase_rg_scan(a, 0));
    RUN(4, phase_rg_combine(a));
    RUN(5, phase_rg_out(a, 0, 0));
    RUN(6, phase_token_router(a, 0));
    RUN(7, phase_moe<0>(a, 0));
    RUN(8, phase_moe<1>(a, 0));
    RUN(9, phase_token_row<0>(a, 1));
    RUN(10, phase_mla_down(a));
    RUN(11, phase_mla_up(a));
    RUN(12, phase_mla_attn(a));
    RUN(13, phase_mla_out(a, 1));
    RUN(14, phase_token_router(a, 1));
    RUN(15, phase_moe<0>(a, 1));
    RUN(16, phase_moe<1>(a, 1));
    RUN(17, phase_token_row<0>(a, 2));
    RUN(18, phase_ml_in(a));
    RUN(19, phase_ml_scan(a));
    RUN(20, phase_ml_readout(a));
    RUN(21, phase_ml_out(a, 2));
    RUN(22, phase_token_router(a, 2));
    RUN(23, phase_moe<0>(a, 2));
    RUN(24, phase_moe<1>(a, 2));
    RUN(25, phase_token_row<0>(a, 3));
    RUN(26, phase_rg_in(a, 1));
    RUN(27, phase_rg_scan(a, 1));
    RUN(28, phase_rg_combine(a));
    RUN(29, phase_rg_out(a, 3, 1));
    RUN(30, phase_token_router(a, 3));
    RUN(31, phase_moe<0>(a, 3));
    RUN(32, phase_moe<1>(a, 3));
    RUN(33, phase_token_row<2>(a, 3));
    RUN(34, phase_dbg(a));
#undef RUN
}

static void add_td(Args& a, int& n, int& tile0, const float* src, bf16_t* dst, const float* rscale, long sb, long db, int K, int N, int Npad, int batch, int perm) {
    TDesc& t = a.td[n++];
    t.src = src; t.dst = dst; t.rscale = rscale; t.sb = sb; t.db = db; t.K = K; t.N = N; t.Npad = Npad; t.batch = batch; t.perm = perm;
    t.tiles_k = (K + 127) / 128; t.tiles_n = (Npad + 63) / 64; t.tile0 = tile0;
    tile0 += batch * t.tiles_k * t.tiles_n;
}

extern "C" void kernel_launch(void* const* d_in, const int* in_sizes, int n_in, void* d_out, int out_size, void* d_ws, size_t ws_size, hipStream_t stream) {
    static int grid = 0;
    if (grid == 0) {
        if (n_in != 32 || out_size != NLAT * D || ws_size < WS_END) { fprintf(stderr, "kernel_launch: unexpected sizes (n_in %d out %d ws %zu need %zu)\n", n_in, out_size, ws_size, (size_t)WS_END); grid = -1; return; }
        int dev = 0, cus = 0, per_cu = 0;
        (void)hipGetDevice(&dev);
        (void)hipDeviceGetAttribute(&cus, hipDeviceAttributeMultiprocessorCount, dev);
        if (hipOccupancyMaxActiveBlocksPerMultiprocessor(&per_cu, (const void*)fwd, NTHR, 0) != hipSuccess) per_cu = 0;
        (void)hipGetLastError();
        if (per_cu < 2) fprintf(stderr, "kernel_launch: note: occupancy query reports %d blocks per CU (need 2)\n", per_cu);
        grid = cus * (per_cu >= 2 ? 2 : (per_cu >= 1 ? 1 : 2));
    }
    if (grid < 0) return;
    (void)in_sizes;
    (void)hipMemsetAsync((char*)d_ws + WS_CTL, 0, CTL_BYTES, stream);
    Args a;
    memset(&a, 0, sizeof(a));
    for (int i = 0; i < 32; ++i) a.in[i] = (const float*)d_in[i];
    a.out = (float*)d_out; a.ws = (unsigned char*)d_ws;
    unsigned char* ws = (unsigned char*)d_ws;
    int n = 0, tile0 = 0;
    add_td(a, n, tile0, a.in[8], (bf16_t*)(ws + W_RGIN), nullptr, 1024L * 2048, 2048L * 1024, 1024, 2048, 2048, 2, 0);
    add_td(a, n, tile0, a.in[14], (bf16_t*)(ws + W_RGOUT), nullptr, 1024L * 1024, 1024L * 1024, 1024, 1024, 1024, 2, 0);
    for (int j = 0; j < 2; ++j) for (int dir = 0; dir < 2; ++dir) for (int g = 0; g < 2; ++g)
        add_td(a, n, tile0, a.in[11] + (size_t)((j * 2 + dir) * 2 + g) * 16 * 4096, (bf16_t*)(ws + W_RGG) + (size_t)(j * 2 + dir) * 16 * 8192 + g * 4096, nullptr, 4096, 8192, 64, 64, 64, 16, 0);
    add_td(a, n, tile0, a.in[15], (bf16_t*)(ws + W_MDOWN), nullptr, 0, 0, 1024, 416, 512, 1, 0);
    add_td(a, n, tile0, a.in[18], (bf16_t*)(ws + W_MUQ), a.in[16], 0, 0, 256, 1536, 1536, 1, 0);
    add_td(a, n, tile0, a.in[19], (bf16_t*)(ws + W_MUKV), a.in[17], 0, 0, 128, 2048, 2048, 1, 0);
    add_td(a, n, tile0, a.in[21], (bf16_t*)(ws + W_MO), nullptr, 0, 0, 1024, 1024, 1024, 1, 0);
    add_td(a, n, tile0, a.in[22], (bf16_t*)(ws + W_MLIN), nullptr, 0, 0, 1024, 3088, 3200, 1, 0);
    add_td(a, n, tile0, a.in[25], (bf16_t*)(ws + W_MLOUT), nullptr, 0, 0, 1024, 1024, 1024, 1, 0);
    add_td(a, n, tile0, a.in[30], (bf16_t*)(ws + W_GU), nullptr, 1024L * 512, 512L * 1024, 1024, 512, 512, 64, 1);
    add_td(a, n, tile0, a.in[31], (bf16_t*)(ws + W_DN), nullptr, 256L * 1024, 1024L * 256, 256, 1024, 1024, 64, 0);
    a.ntiles_total = tile0;
    if (n != NTD) { fprintf(stderr, "kernel_launch: descriptor count %d != %d\n", n, NTD); return; }
#if MK_ONE_LAUNCH
    a.ph_lo = 0; a.ph_hi = NPH;
    hipLaunchKernelGGL(fwd, dim3(grid), dim3(NTHR), 0, stream, a);
#else
    for (int ph = 0; ph < NPH && ph <= DBG_STOP; ++ph) {
        a.ph_lo = ph; a.ph_hi = ph + 1;
        hipLaunchKernelGGL(fwd, dim3(grid), dim3(NTHR), 0, stream, a);
    }
    if (DBG_STOP < NPH) { a.ph_lo = 34; a.ph_hi = 35; hipLaunchKernelGGL(fwd, dim3(grid), dim3(NTHR), 0, stream, a); }
#endif
}
```

```cpp
#include <hip/hip_runtime.h>
#include <stdint.h>
#include <string.h>
#include <stdio.h>

#ifndef MK_ONE_LAUNCH
#define MK_ONE_LAUNCH 1
#endif

#define DI __device__ __forceinline__
typedef unsigned short bf16_t;
typedef __attribute__((ext_vector_type(8))) short bf16x8;
typedef __attribute__((ext_vector_type(4))) float f32x4;
typedef __attribute__((ext_vector_type(16))) float f32x16;
typedef __attribute__((ext_vector_type(2))) float f32x2;
typedef __attribute__((ext_vector_type(2))) __bf16 bfx2;
typedef __attribute__((ext_vector_type(4))) unsigned u32x4;
typedef __attribute__((ext_vector_type(2))) unsigned u32x2;

constexpr int D = 1024, NB = 8, SEQ = 2048, CTXL = 256;
constexpr int NLAT = NB * SEQ, NCTX = NB * CTXL, NTOK = NLAT + NCTX;
constexpr int NKEY = CTXL + SEQ;
constexpr int NTHR = 256;
constexpr int LDS_BYTES = 73728;
constexpr int LDS_AUX = 65536;
constexpr int LDS_BARW = LDS_BYTES - 16;
constexpr float EPS = 1e-6f;

constexpr size_t al256(size_t x) { return (x + 255) & ~(size_t)255; }
constexpr size_t WS_CTL = 0;
constexpr size_t CTL_BYTES = 65536;
constexpr size_t CTL_CNT = 16384;
constexpr size_t CTL_ROPE = 32768;
constexpr size_t WS_MOD = WS_CTL + CTL_BYTES;
constexpr size_t WS_X = al256(WS_MOD + 4 * 9 * 6144 * 4);
constexpr size_t WS_H = al256(WS_X + (size_t)NTOK * D * 4);
constexpr size_t WS_SCR = al256(WS_H + (size_t)NTOK * D * 2);
constexpr size_t SCR_BYTES = (size_t)256 << 20;
constexpr size_t TOKD2 = (size_t)NTOK * D * 2;
constexpr size_t RG_G = WS_SCR, RG_U = RG_G + TOKD2, RG_HS = RG_U + TOKD2, RG_A2 = RG_HS + 2 * TOKD2;
constexpr size_t MLA_CQ = WS_SCR;
constexpr size_t MLA_CKV = MLA_CQ + (size_t)NTOK * 256 * 2;
constexpr size_t MLA_KR = MLA_CKV + (size_t)NTOK * 128 * 2;
constexpr size_t MLA_Q = MLA_KR + (size_t)NTOK * 32 * 4;
constexpr size_t MLA_K = MLA_Q + (size_t)NTOK * 1536 * 2;
constexpr size_t MLA_VT = MLA_K + (size_t)NB * 16 * NKEY * 96 * 2;
constexpr size_t MLA_O = MLA_VT + (size_t)NB * 16 * 64 * NKEY * 2;
constexpr size_t MLA_END = MLA_O + TOKD2;
constexpr size_t ML_Q = WS_SCR;
constexpr size_t ML_K = ML_Q + (size_t)NTOK * 512 * 2;
constexpr size_t ML_KT = ML_K + (size_t)NTOK * 512 * 2;
constexpr size_t ML_VT = ML_KT + (size_t)NTOK * 512 * 2;
constexpr size_t ML_OG = ML_VT + TOKD2;
constexpr size_t ML_GT = ML_OG + TOKD2;
constexpr size_t ML_HS = ML_GT + (size_t)NTOK * 16 * 4;
constexpr size_t ML_A2 = ML_HS + 2 * TOKD2;
constexpr size_t ML_END = ML_A2 + TOKD2;
static_assert(RG_A2 + TOKD2 <= WS_SCR + SCR_BYTES && MLA_END <= WS_SCR + SCR_BYTES && ML_END <= WS_SCR + SCR_BYTES, "scratch");
constexpr size_t WS_LIST = WS_SCR + SCR_BYTES;
constexpr size_t WS_WSLOT = al256(WS_LIST + (size_t)64 * NTOK * 4);
constexpr size_t WS_HMID = al256(WS_WSLOT + (size_t)2 * NTOK * 4);
constexpr size_t WS_Y = al256(WS_HMID + (size_t)2 * NTOK * 256 * 2);
constexpr size_t WS_W = al256(WS_Y + (size_t)2 * NTOK * D * 2);
constexpr size_t W_RGIN = WS_W;
constexpr size_t W_RGOUT = W_RGIN + (size_t)2 * 2048 * 1024 * 2;
constexpr size_t W_RGG = W_RGOUT + (size_t)2 * 1024 * 1024 * 2;
constexpr size_t W_MDOWN = W_RGG + (size_t)2 * 2 * 16 * 128 * 64 * 2;
constexpr size_t W_MUQ = W_MDOWN + (size_t)512 * 1024 * 2;
constexpr size_t W_MUKV = W_MUQ + (size_t)1536 * 256 * 2;
constexpr size_t W_MO = W_MUKV + (size_t)2048 * 128 * 2;
constexpr size_t W_MLIN = W_MO + (size_t)1024 * 1024 * 2;
constexpr size_t W_MLOUT = W_MLIN + (size_t)3200 * 1024 * 2;
constexpr size_t W_RT = W_MLOUT + (size_t)1024 * 1024 * 2;
constexpr size_t W_GU = al256(W_RT + (size_t)4 * 2 * 80 * 1024 * 2);
constexpr size_t W_DN = W_GU + (size_t)256 * 512 * 1024 * 2;
constexpr size_t WS_END = W_DN + (size_t)256 * 1024 * 256 * 2;

struct TDesc {
    const float* src; bf16_t* dst; const float* rscale;
    long sb, db;
    int K, N, Npad, batch;
    int perm, tiles_k, tiles_n, tile0;
};
constexpr int NTD = 18;
struct Args {
    const float* in[32];
    float* out;
    unsigned char* ws;
    TDesc td[NTD];
    int ntiles_total, ph_lo, ph_hi, pad0;
};

DI float bf2f(bf16_t v) { return __uint_as_float((unsigned)v << 16); }
DI unsigned pk2(float a, float b) { f32x2 v = {a, b}; bfx2 r = __builtin_convertvector(v, bfx2); return __builtin_bit_cast(unsigned, r); }
DI bf16_t f2bf(float a) { return (bf16_t)(pk2(a, 0.f) & 0xffffu); }
DI float lof(unsigned u) { return __uint_as_float(u << 16); }
DI float hif(unsigned u) { return __uint_as_float(u & 0xffff0000u); }
DI float rcpf_(float x) { return __builtin_amdgcn_rcpf(x); }
DI float fexp(float x) { return __builtin_amdgcn_exp2f(x * 1.4426950408889634f); }
DI float sigmoidf_(float x) { return rcpf_(1.f + fexp(-x)); }
DI float gelu_tanh(float x) { float u = 0.7978845608028654f * (x + 0.044715f * x * x * x); float e = fexp(2.f * u); return x * (1.f - rcpf_(e + 1.f)); }
DI int tok_modrow(int t) { return t < NLAT ? (t >> 11) : 8; }
DI void dma16(const void* g, char* l) { __builtin_amdgcn_global_load_lds((const unsigned*)g, (unsigned*)l, 16, 0, 0); }
DI void wait_vm0() { asm volatile("s_waitcnt vmcnt(0)" ::: "memory"); }
DI int swz128(int row, int chunk) { return row * 128 + ((chunk ^ (row & 7)) << 4); }
DI int swz256(int row, int chunk) { return row * 256 + ((chunk ^ (row & 15)) << 4); }
DI f32x4 mfma16(bf16x8 a, bf16x8 b, f32x4 c) { return __builtin_amdgcn_mfma_f32_16x16x32_bf16(a, b, c, 0, 0, 0); }
DI f32x16 mfma32(bf16x8 a, bf16x8 b, f32x16 c) { return __builtin_amdgcn_mfma_f32_32x32x16_bf16(a, b, c, 0, 0, 0); }
DI bf16x8 ldsv8(const char* p) { return *(const bf16x8*)p; }
DI void st_bf4(bf16_t* p, const f32x4 v) { u32x2 o; o[0] = pk2(v[0], v[1]); o[1] = pk2(v[2], v[3]); *(u32x2*)p = o; }

__shared__ __attribute__((aligned(16))) char lds[LDS_BYTES];

#define XB_TMO      128
#define XB_XCNT(j)  (256  + 64 * (j))
#define XB_XSUB(j)  (1280 + 64 * (j))
#define XB_XGEN(j)  (2304 + 64 * (j))
#define XB_TOP      3328
#define XB_TOPGEN   3392
#define XCD_BAR_WORDS 3456
#define XB_SPIN_CAP (1u << 22)
#define LAS __attribute__((address_space(3)))
DI unsigned xb_ld(unsigned* p)              { return __hip_atomic_load(p, __ATOMIC_RELAXED, __HIP_MEMORY_SCOPE_AGENT); }
DI unsigned xb_add(unsigned* p, unsigned v) { return __hip_atomic_fetch_add(p, v, __ATOMIC_RELAXED, __HIP_MEMORY_SCOPE_AGENT); }
DI unsigned xb_xcc_id() { return (unsigned)__builtin_amdgcn_s_getreg((3 << 11) | 20) & 0xFu; }
#define XB_SPIN(cond, bar) do { unsigned _sp = 0; while (cond) { __builtin_amdgcn_s_sleep(1); \
    if ((++_sp & 255u) == 0u) { if (xb_ld(&(bar)[XB_TMO])) break; if (_sp > XB_SPIN_CAP) { atomicAdd(&(bar)[XB_TMO], 1u); break; } } } } while (0)
struct XcdBarrier { unsigned* bar; unsigned x; volatile LAS unsigned* st; };
DI XcdBarrier xcd_barrier_post(unsigned* bar, volatile LAS unsigned* st) {
    XcdBarrier b; b.bar = bar; b.x = xb_xcc_id(); b.st = st;
    if (threadIdx.x == 0) (void)xb_add(&bar[XB_XCNT(b.x)], 1u);
    return b;
}
DI void xcd_barrier_complete(unsigned* bar, unsigned x, unsigned& nloc, unsigned& nx) {
    const unsigned G = gridDim.x * gridDim.y * gridDim.z;
    unsigned sum, cnt, mine, sp = 0u;
    for (;;) {
        sum = 0u; cnt = 0u; mine = 0u;
#pragma unroll
        for (unsigned j = 0; j < 16; ++j) { const unsigned c = xb_ld(&bar[XB_XCNT(j)]); sum += c; cnt += (c > 0u) ? 1u : 0u; mine = (j == x) ? c : mine; }
        if (sum == G) break;
        __builtin_amdgcn_s_sleep(1);
        if ((++sp & 255u) == 0u) { if (xb_ld(&bar[XB_TMO])) break; if (sp > XB_SPIN_CAP) { atomicAdd(&bar[XB_TMO], 1u); break; } }
    }
    nloc = mine > 0u ? mine : 1u; nx = cnt > 0u ? cnt : 1u;
}
DI void xcd_barrier(const XcdBarrier& b) {
    asm volatile("s_waitcnt vmcnt(0)" ::: "memory");
    __syncthreads();
    if (threadIdx.x == 0) {
        unsigned* bar = b.bar;
        __builtin_amdgcn_s_waitcnt(0);
        unsigned nloc = b.st[0], nx = b.st[1];
        if (nloc == 0u) { xcd_barrier_complete(bar, b.x, nloc, nx); b.st[0] = nloc; b.st[1] = nx; }
        const unsigned old = xb_add(&bar[XB_XSUB(b.x)], 1u);
        const unsigned gen = old / nloc;
        if (old + 1u == (gen + 1u) * nloc) {
            __builtin_amdgcn_fence(__ATOMIC_RELEASE, "agent");
            asm volatile("s_waitcnt vmcnt(0)" ::: "memory");
            const unsigned og = xb_add(&bar[XB_TOP], 1u);
            const unsigned tg = og / nx;
            if (og + 1u == (tg + 1u) * nx) xb_add(&bar[XB_TOPGEN], 1u);
            else XB_SPIN(xb_ld(&bar[XB_TOPGEN]) == tg, bar);
            __builtin_amdgcn_fence(__ATOMIC_ACQUIRE, "agent");
            xb_add(&bar[XB_XGEN(b.x)], 1u);
            asm volatile("s_waitcnt vmcnt(0)" ::: "memory");
        } else {
            XB_SPIN(xb_ld(&bar[XB_XGEN(b.x)]) == gen, bar);
            __builtin_amdgcn_fence(__ATOMIC_ACQUIRE, "agent");
            asm volatile("s_waitcnt vmcnt(0)" ::: "memory");
        }
    }
    __syncthreads();
}

struct CvTile { const float* src; bf16_t* dst; int K, N, perm, k0, n0; };
DI CvTile moe_cv_tile(const Args& a, const int L, const int t) {
    CvTile c;
    const int e = t / 96, r = t - e * 96;
    if (r < 64) {
        c.src = a.in[30] + (size_t)(L * 64 + e) * 1024 * 512; c.dst = (bf16_t*)(a.ws + W_GU) + (size_t)(L * 64 + e) * 512 * 1024;
        c.K = 1024; c.N = 512; c.perm = 1; c.k0 = (r & 7) * 128; c.n0 = (r >> 3) * 64;
    } else {
        const int r2 = r - 64;
        c.src = a.in[31] + (size_t)(L * 64 + e) * 256 * 1024; c.dst = (bf16_t*)(a.ws + W_DN) + (size_t)(L * 64 + e) * 1024 * 256;
        c.K = 256; c.N = 1024; c.perm = 0; c.k0 = (r2 & 1) * 128; c.n0 = (r2 >> 1) * 64;
    }
    return c;
}
DI void cv_load(const CvTile& c, f32x4 (&L0)[4], f32x4 (&L1)[4]) {
    const int tid = threadIdx.x, c4 = tid & 15, kr = tid >> 4;
    const float* p = c.src + (size_t)(c.k0 + 2 * kr) * c.N + c.n0 + 4 * c4;
#pragma unroll
    for (int i = 0; i < 4; ++i) { L0[i] = *(const f32x4*)(p + (size_t)(32 * i) * c.N); L1[i] = *(const f32x4*)(p + (size_t)(32 * i + 1) * c.N); }
}
DI void cv_pack(unsigned* st, const f32x4 (&L0)[4], const f32x4 (&L1)[4]) {
    const int tid = threadIdx.x, c4 = tid & 15, kr = tid >> 4;
#pragma unroll
    for (int i = 0; i < 4; ++i)
#pragma unroll
        for (int j = 0; j < 4; ++j) st[(4 * c4 + j) * 68 + 16 * i + kr] = pk2(L0[i][j], L1[i][j]);
}
DI void cv_flush(const CvTile& c, const unsigned* st) {
    const int tid = threadIdx.x;
#pragma unroll
    for (int i = 0; i < 4; ++i) {
        const int id = tid + i * 256, n = id >> 4, kc = id & 15;
        const u32x4 o = *(const u32x4*)(st + n * 68 + kc * 4);
        int nd = c.n0 + n;
        if (c.perm) { const int cc = nd & 255, up = nd >> 8; nd = ((cc >> 4) << 5) + (up << 4) + (cc & 15); }
        *(u32x4*)(c.dst + (size_t)nd * c.K + c.k0 + kc * 8) = o;
    }
}

DI void phase_prologue(const Args& a) {
    const int tid = threadIdx.x;
    const int n_ada = 384, n_rt = 4;
    const int total = n_ada + n_rt;
    float* sc = (float*)lds;
    for (int u = blockIdx.x; u < total; u += gridDim.x) {
        __syncthreads();
        if (u < n_ada) {
            const float* c = a.in[1]; const float* cc = a.in[3];
            for (int i = tid; i < 9 * 1024; i += NTHR) {
                float v = i < 8192 ? c[i] : cc[i - 8192];
                sc[i] = v / (1.f + __expf(-v));
            }
            __syncthreads();
            const int n = u * 64 + (tid & 63), li = n / 6144, nn = n - li * 6144, kq = tid >> 6;
            const float* wp = a.in[4] + (size_t)li * 1024 * 6144 + (size_t)(kq * 256) * 6144 + nn;
            float acc[9];
#pragma unroll
            for (int r = 0; r < 9; ++r) acc[r] = 0.f;
#pragma unroll 1
            for (int k0 = kq * 256; k0 < kq * 256 + 256; k0 += 16) {
                float wv[16];
#pragma unroll
                for (int kk = 0; kk < 16; ++kk) { wv[kk] = *wp; wp += 6144; }
#pragma unroll
                for (int kk = 0; kk < 16; kk += 4)
#pragma unroll
                    for (int r = 0; r < 9; ++r) {
                        const f32x4 s4 = *(const f32x4*)(sc + r * 1024 + k0 + kk);
                        acc[r] += s4[0] * wv[kk] + s4[1] * wv[kk + 1] + s4[2] * wv[kk + 2] + s4[3] * wv[kk + 3];
                    }
            }
            float* part = sc + 9 * 1024;
#pragma unroll
            for (int r = 0; r < 9; ++r) part[(kq * 9 + r) * 64 + (tid & 63)] = acc[r];
            __syncthreads();
            for (int i = tid; i < 9 * 64; i += NTHR) {
                const int r = i >> 6, cidx = i & 63;
                const int n2 = u * 64 + cidx, l2 = n2 / 6144, nn2 = n2 - l2 * 6144;
                const float v = ((part[(0 * 9 + r) * 64 + cidx] + part[(1 * 9 + r) * 64 + cidx]) + part[(2 * 9 + r) * 64 + cidx]) + part[(3 * 9 + r) * 64 + cidx];
                ((float*)(a.ws + WS_MOD))[((size_t)l2 * 9 + r) * 6144 + nn2] = v + a.in[5][l2 * 6144 + nn2];
            }
        } else if (u < n_ada + n_rt) {
            const int li = u - n_ada;
            bf16_t* rt = (bf16_t*)(a.ws + W_RT) + (size_t)li * 2 * 80 * 1024;
            const float* wg = a.in[26] + (size_t)li * 1024 * 8;
            const float* we = a.in[28] + (size_t)li * 1024 * 64;
            if (li == 0) {
                float* rt_ = (float*)(a.ws + WS_CTL + CTL_ROPE);
                for (int i = tid; i < 512; i += NTHR) {
                    const int pos = i >> 3, fi = i & 7;
                    const float ang = (float)pos * powf(10000.f, -(float)fi * 0.125f);
                    rt_[i] = cosf(ang); rt_[512 + i] = sinf(ang);
                }
            }
            for (int i = tid; i < 80 * 1024; i += NTHR) {
                const int n = i >> 10, k = i & 1023;
                float v = n < 8 ? wg[k * 8 + n] : (n < 72 ? we[k * 64 + (n - 8)] : 0.f);
                const bf16_t h = f2bf(v);
                rt[i] = h;
                rt[80 * 1024 + i] = f2bf(v - bf2f(h));
            }
        }
    }
    struct PTile { const float* src; bf16_t* dst; const float* rscale; int K, N, Npad, perm, k0, n0; };
    auto decode = [&](int tix) {
        int di = 0;
#pragma unroll 1
        for (int i = 1; i < NTD; ++i) if (tix >= a.td[i].tile0) di = i;
        const TDesc& td = a.td[di];
        int rem = tix - td.tile0;
        const int per = td.tiles_k * td.tiles_n;
        const int bi = rem / per; rem -= bi * per;
        PTile p;
        p.src = td.src + (size_t)bi * td.sb; p.dst = td.dst + (size_t)bi * td.db; p.rscale = td.rscale;
        p.K = td.K; p.N = td.N; p.Npad = td.Npad; p.perm = td.perm;
        p.n0 = (rem % td.tiles_n) * 64; p.k0 = (rem / td.tiles_n) * 128;
        return p;
    };
    auto pload = [&](const PTile& p, f32x4 (&L0)[4], f32x4 (&L1)[4]) {
        const int c4 = tid & 15, kr = tid >> 4;
        const bool nok = p.n0 + 4 * c4 < p.N;
#pragma unroll
        for (int i = 0; i < 4; ++i) {
            const int k = p.k0 + 32 * i + 2 * kr;
            L0[i] = (f32x4){0.f, 0.f, 0.f, 0.f}; L1[i] = L0[i];
            if (nok && k < p.K) {
                L0[i] = *(const f32x4*)(p.src + (size_t)k * p.N + p.n0 + 4 * c4);
                L1[i] = *(const f32x4*)(p.src + (size_t)(k + 1) * p.N + p.n0 + 4 * c4);
                if (p.rscale) { L0[i] *= p.rscale[k]; L1[i] *= p.rscale[k + 1]; }
            }
        }
    };
    auto pflush = [&](const PTile& p, const unsigned* st) {
#pragma unroll
        for (int i = 0; i < 4; ++i) {
            const int id = tid + i * 256, n = id >> 4, kc = id & 15;
            const u32x4 o = *(const u32x4*)(st + n * 68 + kc * 4);
            int nd = p.n0 + n;
            if (nd < p.Npad && p.k0 + kc * 8 < p.K) {
                if (p.perm) { const int c = nd & 255, up = nd >> 8; nd = ((c >> 4) << 5) + (up << 4) + (c & 15); }
                *(u32x4*)(p.dst + (size_t)nd * p.K + p.k0 + kc * 8) = o;
            }
        }
    };
    {
        unsigned* st0 = (unsigned*)lds; unsigned* st1 = st0 + 64 * 68;
        const int nt_ = a.ntiles_total, G = gridDim.x;
        int t0 = blockIdx.x, t1 = blockIdx.x + G;
        PTile p0 = decode(0), p1 = p0;
        f32x4 A0[4], A1[4], B0[4], B1[4];
        __syncthreads();
        if (t0 < nt_) { p0 = decode(t0); pload(p0, A0, A1); }
        if (t1 < nt_) { p1 = decode(t1); pload(p1, B0, B1); }
        while (t0 < nt_) {
            PTile q0 = p0, q1 = p1;
            const bool v1 = t1 < nt_;
            cv_pack(st0, A0, A1);
            if (t0 + 2 * G < nt_) { p0 = decode(t0 + 2 * G); pload(p0, A0, A1); }
            if (v1) {
                cv_pack(st1, B0, B1);
                if (t1 + 2 * G < nt_) { p1 = decode(t1 + 2 * G); pload(p1, B0, B1); }
            }
            __syncthreads();
            pflush(q0, st0);
            if (v1) pflush(q1, st1);
            __syncthreads();
            t0 += 2 * G; t1 += 2 * G;
        }
    }
}

template <int MODE>
DI void phase_token(const Args& a, const int li) {
    const int tid = threadIdx.x, lane = tid & 63, wave = tid >> 6;
    const int r = lane & 15, q = lane >> 4;
    float* X = (float*)(a.ws + WS_X);
    bf16_t* H = (bf16_t*)(a.ws + WS_H);
    const bf16_t* Y = (const bf16_t*)(a.ws + WS_Y);
    const float* MOD = (const float*)(a.ws + WS_MOD);
    const bool combine = (MODE == 0 && li > 0) || MODE == 2;
    const int ngroups = (MODE == 2 || (MODE == 1 && li == 3)) ? NLAT / 16 : NTOK / 16;
    float* lg = (float*)(lds + wave * 16 * 80 * 4);
    for (int g = blockIdx.x * 4 + wave; g < ngroups; g += gridDim.x * 4) {
        const int t = g * 16 + r;
        const int mr = tok_modrow(g * 16);
        const float* xsrc = (MODE == 0 && li == 0) ? (t < NLAT ? a.in[0] + (size_t)t * D : a.in[2] + (size_t)(t - NLAT) * D) : X + (size_t)t * D;
        const bf16_t* y0 = Y + (size_t)(2 * t) * D;
        const bf16_t* y1 = y0 + D;
        const int lprev = MODE == 2 ? 3 : li - 1;
        const float* g5 = MOD + ((size_t)(lprev < 0 ? 0 : lprev) * 9 + mr) * 6144 + 5 * 1024;
        float ss = 0.f;
        if (MODE != 2) {
#pragma unroll 4
            for (int kk = 0; kk < 32; ++kk) {
                const int k = kk * 32 + q * 8;
                f32x4 x0 = *(const f32x4*)(xsrc + k), x1 = *(const f32x4*)(xsrc + k + 4);
                if (combine) {
                    const u32x4 ya = *(const u32x4*)(y0 + k), yb = *(const u32x4*)(y1 + k);
                    const f32x4 ga = *(const f32x4*)(g5 + k), gb = *(const f32x4*)(g5 + k + 4);
                    x0[0] += ga[0] * (lof(ya[0]) + lof(yb[0])); x0[1] += ga[1] * (hif(ya[0]) + hif(yb[0]));
                    x0[2] += ga[2] * (lof(ya[1]) + lof(yb[1])); x0[3] += ga[3] * (hif(ya[1]) + hif(yb[1]));
                    x1[0] += gb[0] * (lof(ya[2]) + lof(yb[2])); x1[1] += gb[1] * (hif(ya[2]) + hif(yb[2]));
                    x1[2] += gb[2] * (lof(ya[3]) + lof(yb[3])); x1[3] += gb[3] * (hif(ya[3]) + hif(yb[3]));
                }
#pragma unroll
                for (int j = 0; j < 4; ++j) ss += x0[j] * x0[j] + x1[j] * x1[j];
            }
            ss += __shfl_xor(ss, 16); ss += __shfl_xor(ss, 32);
        }
        const float rstd = rsqrtf(ss * (1.f / 1024.f) + EPS);
        const float* gn = (MODE == 1 ? a.in[7] : a.in[6]) + (size_t)li * D;
        const float* mscale = MOD + ((size_t)li * 9 + mr) * 6144 + (MODE == 1 ? 4 : 1) * 1024;
        const float* mshift = MOD + ((size_t)li * 9 + mr) * 6144 + (MODE == 1 ? 3 : 0) * 1024;
        const bf16_t* rwh = (const bf16_t*)(a.ws + W_RT) + (size_t)li * 2 * 80 * 1024 + (size_t)r * 1024 + q * 8;
        f32x4 lacc[5];
#pragma unroll
        for (int i = 0; i < 5; ++i) lacc[i] = (f32x4){0.f, 0.f, 0.f, 0.f};
#pragma unroll 2
        for (int kk = 0; kk < 32; ++kk) {
            const int k = kk * 32 + q * 8;
            f32x4 x0 = *(const f32x4*)(xsrc + k), x1 = *(const f32x4*)(xsrc + k + 4);
            if (combine) {
                const u32x4 ya = *(const u32x4*)(y0 + k), yb = *(const u32x4*)(y1 + k);
                const f32x4 ga = *(const f32x4*)(g5 + k), gb = *(const f32x4*)(g5 + k + 4);
                x0[0] += ga[0] * (lof(ya[0]) + lof(yb[0])); x0[1] += ga[1] * (hif(ya[0]) + hif(yb[0]));
                x0[2] += ga[2] * (lof(ya[1]) + lof(yb[1])); x0[3] += ga[3] * (hif(ya[1]) + hif(yb[1]));
                x1[0] += gb[0] * (lof(ya[2]) + lof(yb[2])); x1[1] += gb[1] * (hif(ya[2]) + hif(yb[2]));
                x1[2] += gb[2] * (lof(ya[3]) + lof(yb[3])); x1[3] += gb[3] * (hif(ya[3]) + hif(yb[3]));
            }
            if (MODE == 2) {
                *(f32x4*)(a.out + (size_t)t * D + k) = x0; *(f32x4*)(a.out + (size_t)t * D + k + 4) = x1;
                continue;
            }
            if (MODE == 0 && (li == 0 || combine)) { *(f32x4*)(X + (size_t)t * D + k) = x0; *(f32x4*)(X + (size_t)t * D + k + 4) = x1; }
            const f32x4 n0 = *(const f32x4*)(gn + k), n1 = *(const f32x4*)(gn + k + 4);
            const f32x4 s0 = *(const f32x4*)(mscale + k), s1 = *(const f32x4*)(mscale + k + 4);
            const f32x4 h0 = *(const f32x4*)(mshift + k), h1 = *(const f32x4*)(mshift + k + 4);
            float f[8];
#pragma unroll
            for (int j = 0; j < 4; ++j) {
                f[j] = x0[j] * rstd * n0[j] * (1.f + s0[j]) + h0[j];
                f[4 + j] = x1[j] * rstd * n1[j] * (1.f + s1[j]) + h1[j];
            }
            u32x4 hv;
            hv[0] = pk2(f[0], f[1]); hv[1] = pk2(f[2], f[3]); hv[2] = pk2(f[4], f[5]); hv[3] = pk2(f[6], f[7]);
            *(u32x4*)(H + (size_t)t * D + k) = hv;
            if (MODE == 1) {
                u32x4 lv;
                lv[0] = pk2(f[0] - lof(hv[0]), f[1] - hif(hv[0])); lv[1] = pk2(f[2] - lof(hv[1]), f[3] - hif(hv[1]));
                lv[2] = pk2(f[4] - lof(hv[2]), f[5] - hif(hv[2])); lv[3] = pk2(f[6] - lof(hv[3]), f[7] - hif(hv[3]));
                const bf16x8 fh = __builtin_bit_cast(bf16x8, hv), fl = __builtin_bit_cast(bf16x8, lv);
#pragma unroll
                for (int nt = 0; nt < 5; ++nt) {
                    const bf16x8 wh = *(const bf16x8*)(rwh + (size_t)nt * 16 * 1024 + kk * 32);
                    const bf16x8 wl = *(const bf16x8*)(rwh + (size_t)(80 + nt * 16) * 1024 + kk * 32);
                    lacc[nt] = mfma16(fh, wh, lacc[nt]);
                    lacc[nt] = mfma16(fh, wl, lacc[nt]);
                    lacc[nt] = mfma16(fl, wh, lacc[nt]);
                }
            }
        }
        if (MODE == 1) {
#pragma unroll
            for (int nt = 0; nt < 5; ++nt)
#pragma unroll
                for (int j = 0; j < 4; ++j) lg[(q * 4 + j) * 80 + nt * 16 + r] = lacc[nt][j];
            asm volatile("s_waitcnt lgkmcnt(0)" ::: "memory");
            __builtin_amdgcn_wave_barrier();
            if (lane < 16) {
                const float* L = lg + lane * 80;
                const float* bg = a.in[27] + li * 8;
                const float* be = a.in[29] + li * 64;
                float gmax = -3.0e38f; int gi = 0; float gl[8];
#pragma unroll
                for (int j = 0; j < 8; ++j) { gl[j] = L[j] + bg[j]; if (gl[j] > gmax) { gmax = gl[j]; gi = j; } }
                float ps = 0.f;
#pragma unroll
                for (int j = 0; j < 8; ++j) ps += __expf(gl[j] - gmax);
                const float ptop = 1.f / ps;
                float e1 = -3.0e38f, e2 = -3.0e38f; int i1 = 0, i2 = 0;
#pragma unroll
                for (int j = 0; j < 8; ++j) {
                    const float v = L[8 + gi * 8 + j] + be[gi * 8 + j];
                    if (v > e1) { e2 = e1; i2 = i1; e1 = v; i1 = j; } else if (v > e2) { e2 = v; i2 = j; }
                }
                const float ex = __expf(e2 - e1);
                const float w1 = ptop / (1.f + ex), w2 = ptop * ex / (1.f + ex);
                const int tt = g * 16 + lane;
                int* cnt = (int*)(a.ws + WS_CTL + CTL_CNT) + li * 64;
                int* list = (int*)(a.ws + WS_LIST);
                float* wsl = (float*)(a.ws + WS_WSLOT);
                const int ea = gi * 8 + i1, eb = gi * 8 + i2;
                const int pa = atomicAdd(&cnt[ea], 1); list[(size_t)ea * NTOK + pa] = 2 * tt; wsl[2 * tt] = w1;
                const int pb = atomicAdd(&cnt[eb], 1); list[(size_t)eb * NTOK + pb] = 2 * tt + 1; wsl[2 * tt + 1] = w2;
            }
            __builtin_amdgcn_wave_barrier();
        }
    }
}

DI float wave_sum(float v) {
    v += __shfl_xor(v, 1); v += __shfl_xor(v, 2); v += __shfl_xor(v, 4); v += __shfl_xor(v, 8); v += __shfl_xor(v, 16); v += __shfl_xor(v, 32);
    return v;
}
template <int MODE>
DI void phase_token_row(const Args& a, const int li) {
    const int tid = threadIdx.x, lane = tid & 63, wave = tid >> 6;
    float* X = (float*)(a.ws + WS_X);
    bf16_t* H = (bf16_t*)(a.ws + WS_H);
    const bf16_t* Y = (const bf16_t*)(a.ws + WS_Y);
    const float* MOD = (const float*)(a.ws + WS_MOD);
    const bool combine = MODE == 2 || li > 0;
    const bool first = MODE == 0 && li == 0;
    const int npairs = (MODE == 2 ? NLAT : NTOK) / 2;
    const int lprev = MODE == 2 ? 3 : (li > 0 ? li - 1 : 0);
    const float* gn = a.in[6] + (size_t)li * D;
    for (int p = blockIdx.x * 4 + wave; p < npairs; p += gridDim.x * 4) {
        const int t0 = 2 * p, mr = tok_modrow(t0);
        f32x4 x[2][4];
#pragma unroll
        for (int i = 0; i < 2; ++i) {
            const int t = t0 + i;
            const float* xs = first ? (t < NLAT ? a.in[0] + (size_t)t * D : a.in[2] + (size_t)(t - NLAT) * D) : X + (size_t)t * D;
#pragma unroll
            for (int j = 0; j < 4; ++j) x[i][j] = *(const f32x4*)(xs + 256 * j + 4 * lane);
        }
        if (combine) {
            const float* g5 = MOD + ((size_t)lprev * 9 + mr) * 6144 + 5 * 1024;
            f32x4 g[4];
#pragma unroll
            for (int j = 0; j < 4; ++j) g[j] = *(const f32x4*)(g5 + 256 * j + 4 * lane);
#pragma unroll
            for (int i = 0; i < 2; ++i) {
                const bf16_t* y0 = Y + (size_t)(2 * (t0 + i)) * D;
#pragma unroll
                for (int j = 0; j < 4; ++j) {
                    const u32x2 ya = *(const u32x2*)(y0 + 256 * j + 4 * lane), yb = *(const u32x2*)(y0 + D + 256 * j + 4 * lane);
                    x[i][j][0] += g[j][0] * (lof(ya[0]) + lof(yb[0])); x[i][j][1] += g[j][1] * (hif(ya[0]) + hif(yb[0]));
                    x[i][j][2] += g[j][2] * (lof(ya[1]) + lof(yb[1])); x[i][j][3] += g[j][3] * (hif(ya[1]) + hif(yb[1]));
                }
            }
        }
        if (MODE == 2) {
#pragma unroll
            for (int i = 0; i < 2; ++i)
#pragma unroll
                for (int j = 0; j < 4; ++j) *(f32x4*)(a.out + (size_t)(t0 + i) * D + 256 * j + 4 * lane) = x[i][j];
            continue;
        }
        float rstd[2];
#pragma unroll
        for (int i = 0; i < 2; ++i) {
            float ss = 0.f;
#pragma unroll
            for (int j = 0; j < 4; ++j) ss += x[i][j][0] * x[i][j][0] + x[i][j][1] * x[i][j][1] + x[i][j][2] * x[i][j][2] + x[i][j][3] * x[i][j][3];
            rstd[i] = rsqrtf(wave_sum(ss) * (1.f / 1024.f) + EPS);
        }
        const float* msc = MOD + ((size_t)li * 9 + mr) * 6144 + 1 * 1024;
        const float* msh = MOD + ((size_t)li * 9 + mr) * 6144;
#pragma unroll
        for (int j = 0; j < 4; ++j) {
            const f32x4 n4 = *(const f32x4*)(gn + 256 * j + 4 * lane), s4 = *(const f32x4*)(msc + 256 * j + 4 * lane), h4 = *(const f32x4*)(msh + 256 * j + 4 * lane);
            const f32x4 gs = n4 * (s4 + 1.f);
#pragma unroll
            for (int i = 0; i < 2; ++i) {
                const f32x4 f = x[i][j] * rstd[i] * gs + h4;
                st_bf4(H + (size_t)(t0 + i) * D + 256 * j + 4 * lane, f);
                if (first || combine) *(f32x4*)(X + (size_t)(t0 + i) * D + 256 * j + 4 * lane) = x[i][j];
            }
        }
    }
}

DI void phase_token_router(const Args& a, const int li) {
    const int tid = threadIdx.x, lane = tid & 63, wave = tid >> 6;
    const int r = lane & 15, q = lane >> 4;
    const float* X = (const float*)(a.ws + WS_X);
    bf16_t* H = (bf16_t*)(a.ws + WS_H);
    const float* MOD = (const float*)(a.ws + WS_MOD);
    const float* gn = a.in[7] + (size_t)li * D;
    const int ngroups = (li == 3 ? NLAT : NTOK) / 16;
    char* sHi = lds; char* sLo = lds + 32768;
    float* sP = (float*)lds;
    float* sL = (float*)(lds + 32768);
    const bf16_t* rwh = (const bf16_t*)(a.ws + W_RT) + (size_t)li * 2 * 80 * 1024 + (size_t)r * 1024 + q * 8;
    for (int g = blockIdx.x; g < ngroups; g += gridDim.x) {
        const int mr = tok_modrow(g * 16);
        const float* msc = MOD + ((size_t)li * 9 + mr) * 6144 + 4 * 1024;
        const float* msh = MOD + ((size_t)li * 9 + mr) * 6144 + 3 * 1024;
        __syncthreads();
        {
            f32x4 x[4][4];
#pragma unroll
            for (int i = 0; i < 4; ++i)
#pragma unroll
                for (int j = 0; j < 4; ++j) x[i][j] = *(const f32x4*)(X + (size_t)(g * 16 + wave * 4 + i) * D + 256 * j + 4 * lane);
            float rstd[4];
#pragma unroll
            for (int i = 0; i < 4; ++i) {
                float ss = 0.f;
#pragma unroll
                for (int j = 0; j < 4; ++j) ss += x[i][j][0] * x[i][j][0] + x[i][j][1] * x[i][j][1] + x[i][j][2] * x[i][j][2] + x[i][j][3] * x[i][j][3];
                rstd[i] = rsqrtf(wave_sum(ss) * (1.f / 1024.f) + EPS);
            }
#pragma unroll
            for (int j = 0; j < 4; ++j) {
                const f32x4 n4 = *(const f32x4*)(gn + 256 * j + 4 * lane), s4 = *(const f32x4*)(msc + 256 * j + 4 * lane), h4 = *(const f32x4*)(msh + 256 * j + 4 * lane);
                const f32x4 gs = n4 * (s4 + 1.f);
#pragma unroll
                for (int i = 0; i < 4; ++i) {
                    const int row = wave * 4 + i;
                    const f32x4 f = x[i][j] * rstd[i] * gs + h4;
                    u32x2 hv; hv[0] = pk2(f[0], f[1]); hv[1] = pk2(f[2], f[3]);
                    u32x2 lv; lv[0] = pk2(f[0] - lof(hv[0]), f[1] - hif(hv[0])); lv[1] = pk2(f[2] - lof(hv[1]), f[3] - hif(hv[1]));
                    *(u32x2*)(H + (size_t)(g * 16 + row) * D + 256 * j + 4 * lane) = hv;
                    const int off = row * 2048 + (((32 * j + (lane >> 1)) ^ row) << 4) + (lane & 1) * 8;
                    *(u32x2*)(sHi + off) = hv; *(u32x2*)(sLo + off) = lv;
                }
            }
        }
        __syncthreads();
        f32x4 lacc[5];
#pragma unroll
        for (int i = 0; i < 5; ++i) lacc[i] = (f32x4){0.f, 0.f, 0.f, 0.f};
#pragma unroll 2
        for (int s = 0; s < 8; ++s) {
            const int kk = wave * 8 + s;
            const int off = r * 2048 + (((kk * 4 + q) ^ r) << 4);
            const bf16x8 fh = ldsv8(sHi + off), fl = ldsv8(sLo + off);
#pragma unroll
            for (int nt = 0; nt < 5; ++nt) {
                const bf16x8 wh = *(const bf16x8*)(rwh + (size_t)nt * 16 * 1024 + kk * 32);
                const bf16x8 wl = *(const bf16x8*)(rwh + (size_t)(80 + nt * 16) * 1024 + kk * 32);
                lacc[nt] = mfma16(fh, wh, lacc[nt]);
                lacc[nt] = mfma16(fh, wl, lacc[nt]);
                lacc[nt] = mfma16(fl, wh, lacc[nt]);
            }
        }
        __syncthreads();
#pragma unroll
        for (int nt = 0; nt < 5; ++nt)
#pragma unroll
            for (int j = 0; j < 4; ++j) sP[(wave * 16 + q * 4 + j) * 80 + nt * 16 + r] = lacc[nt][j];
        __syncthreads();
        for (int i = tid; i < 16 * 80; i += NTHR) sL[i] = sP[i] + sP[1280 + i] + sP[2560 + i] + sP[3840 + i];
        __syncthreads();
        if (tid < 16) {
            const float* L = sL + tid * 80;
            const float* bg = a.in[27] + li * 8;
            const float* be = a.in[29] + li * 64;
            float gmax = -3.0e38f; int gi = 0; float gl[8];
#pragma unroll
            for (int j = 0; j < 8; ++j) { gl[j] = L[j] + bg[j]; if (gl[j] > gmax) { gmax = gl[j]; gi = j; } }
            float ps = 0.f;
#pragma unroll
            for (int j = 0; j < 8; ++j) ps += __expf(gl[j] - gmax);
            const float ptop = 1.f / ps;
            float e1 = -3.0e38f, e2 = -3.0e38f; int i1 = 0, i2 = 0;
#pragma unroll
            for (int j = 0; j < 8; ++j) {
                const float v = L[8 + gi * 8 + j] + be[gi * 8 + j];
                if (v > e1) { e2 = e1; i2 = i1; e1 = v; i1 = j; } else if (v > e2) { e2 = v; i2 = j; }
            }
            const float ex = __expf(e2 - e1);
            const float w1 = ptop / (1.f + ex), w2 = ptop * ex / (1.f + ex);
            const int tt = g * 16 + tid;
            int* cnt = (int*)(a.ws + WS_CTL + CTL_CNT) + li * 64;
            int* list = (int*)(a.ws + WS_LIST);
            float* wsl = (float*)(a.ws + WS_WSLOT);
            const int ea = gi * 8 + i1, eb = gi * 8 + i2;
            const int pa = atomicAdd(&cnt[ea], 1); list[(size_t)ea * NTOK + pa] = 2 * tt; wsl[2 * tt] = w1;
            const int pb = atomicAdd(&cnt[eb], 1); list[(size_t)eb * NTOK + pb] = 2 * tt + 1; wsl[2 * tt + 1] = w2;
        }
    }
}

template <int WM, int WN, int MT, int NT, bool PFALL = true, class AP>
DI void gemm_tile(AP arow, const bf16_t* Bt, const int ldb, const int K, f32x4 (&acc)[MT][NT], float* ssq = nullptr) {
    constexpr int BM = WM * MT * 16, BN = WN * NT * 16;
    constexpr int A_BYTES = BM * 128, B_BYTES = BN * 128, STAGE = A_BYTES + B_BYTES;
    constexpr int ACH = BM * 8 / NTHR, BCH = BN * 8 / NTHR;
    static_assert(2 * STAGE <= LDS_AUX, "gemm LDS");
    const int tid = threadIdx.x, lane = tid & 63, wave = tid >> 6;
    const int wm = wave / WN, wn = wave % WN;
    const int fr = lane & 15, fq = lane >> 4;
    const bf16_t* ap[ACH]; const bf16_t* bp[BCH];
#pragma unroll
    for (int i = 0; i < ACH; ++i) { const int idx = tid + i * NTHR, row = idx >> 3, c = (idx & 7) ^ (row & 7); ap[i] = arow(row) + c * 8; }
#pragma unroll
    for (int i = 0; i < BCH; ++i) { const int idx = tid + i * NTHR, row = idx >> 3, c = (idx & 7) ^ (row & 7); bp[i] = Bt + (size_t)row * ldb + c * 8; }
#pragma unroll
    for (int i = 0; i < MT; ++i)
#pragma unroll
        for (int j = 0; j < NT; ++j) acc[i][j] = (f32x4){0.f, 0.f, 0.f, 0.f};
    const int KT = K >> 6;
    {
        char* sa = lds; char* sb = lds + A_BYTES;
#pragma unroll
        for (int i = 0; i < ACH; ++i) dma16(ap[i], sa + (tid + i * NTHR) * 16);
#pragma unroll
        for (int i = 0; i < BCH; ++i) dma16(bp[i], sb + (tid + i * NTHR) * 16);
    }
#pragma unroll 1
    for (int kt = 0; kt < KT; ++kt) {
        wait_vm0();
        __syncthreads();
        if (kt + 1 < KT) {
            char* sa = lds + ((kt + 1) & 1) * STAGE; char* sb = sa + A_BYTES;
            const int ko = (kt + 1) * 64;
#pragma unroll
            for (int i = 0; i < ACH; ++i) dma16(ap[i] + ko, sa + (tid + i * NTHR) * 16);
#pragma unroll
            for (int i = 0; i < BCH; ++i) dma16(bp[i] + ko, sb + (tid + i * NTHR) * 16);
        }
        const char* sa = lds + (kt & 1) * STAGE; const char* sb = sa + A_BYTES;
        if (PFALL) {
            bf16x8 xf[2][MT], wf[2][NT];
#pragma unroll
            for (int kk = 0; kk < 2; ++kk) {
#pragma unroll
                for (int i = 0; i < MT; ++i) xf[kk][i] = ldsv8(sa + swz128(wm * MT * 16 + i * 16 + fr, kk * 4 + fq));
#pragma unroll
                for (int j = 0; j < NT; ++j) wf[kk][j] = ldsv8(sb + swz128(wn * NT * 16 + j * 16 + fr, kk * 4 + fq));
            }
            __builtin_amdgcn_sched_barrier(0);
            __builtin_amdgcn_s_setprio(1);
#pragma unroll
            for (int kk = 0; kk < 2; ++kk)
#pragma unroll
                for (int i = 0; i < MT; ++i)
#pragma unroll
                    for (int j = 0; j < NT; ++j) acc[i][j] = mfma16(wf[kk][j], xf[kk][i], acc[i][j]);
            __builtin_amdgcn_s_setprio(0);
        } else {
#pragma unroll
            for (int kk = 0; kk < 2; ++kk) {
                bf16x8 xf[MT], wf[NT];
#pragma unroll
                for (int i = 0; i < MT; ++i) xf[i] = ldsv8(sa + swz128(wm * MT * 16 + i * 16 + fr, kk * 4 + fq));
#pragma unroll
                for (int j = 0; j < NT; ++j) wf[j] = ldsv8(sb + swz128(wn * NT * 16 + j * 16 + fr, kk * 4 + fq));
#pragma unroll
                for (int i = 0; i < MT; ++i)
#pragma unroll
                    for (int j = 0; j < NT; ++j) acc[i][j] = mfma16(wf[j], xf[i], acc[i][j]);
                if (ssq) {
#pragma unroll
                    for (int i = 0; i < MT; ++i) {
                        const u32x4 xu = __builtin_bit_cast(u32x4, xf[i]);
#pragma unroll
                        for (int d = 0; d < 4; ++d) { const bfx2 p = __builtin_bit_cast(bfx2, xu[d]); ssq[i] = __builtin_amdgcn_fdot2_f32_bf16(p, p, ssq[i], false); }
                    }
                }
            }
        }
    }
    __syncthreads();
}


struct GemmPipe {
    static constexpr int A_BYTES = 128 * 128, STAGE = 2 * A_BYTES;
    const bf16_t* ap[4]; const bf16_t* bp[4];
    template <class AP>
    DI void setup(AP arow, const bf16_t* Bt, const int ldb) {
        const int tid = threadIdx.x;
#pragma unroll
        for (int i = 0; i < 4; ++i) {
            const int idx = tid + i * NTHR, row = idx >> 3, c = (idx & 7) ^ (row & 7);
            ap[i] = arow(row) + c * 8; bp[i] = Bt + (size_t)row * ldb + c * 8;
        }
    }
    DI void issue(const int kt, const int buf) const {
        const int tid = threadIdx.x;
        char* sa = lds + buf * STAGE; char* sb = sa + A_BYTES;
        const int ko = kt * 64;
#pragma unroll
        for (int i = 0; i < 4; ++i) dma16(ap[i] + ko, sa + (tid + i * NTHR) * 16);
#pragma unroll
        for (int i = 0; i < 4; ++i) dma16(bp[i] + ko, sb + (tid + i * NTHR) * 16);
    }
    template <int PM>
    DI void run_probe(const int K, f32x4 (&acc)[4][4]) const {
        const int tid = threadIdx.x, lane = tid & 63, wave = tid >> 6;
        const int wm = wave >> 1, wn = wave & 1, fr = lane & 15, fq = lane >> 4;
#pragma unroll
        for (int i = 0; i < 4; ++i)
#pragma unroll
            for (int j = 0; j < 4; ++j) acc[i][j] = (f32x4){0.f, 0.f, 0.f, 0.f};
        const int KT = K >> 6;
#pragma unroll 1
        for (int kt = 0; kt < KT; ++kt) {
            if (PM & 4) { wait_vm0(); __syncthreads(); }
            if ((PM & 1) && kt + 1 < KT) issue(kt + 1, (kt + 1) & 1);
            if (PM & 2) {
                const char* sa = lds + (kt & 1) * STAGE; const char* sb = sa + A_BYTES;
                bf16x8 xf[2][4], wf[2][4];
#pragma unroll
                for (int kk = 0; kk < 2; ++kk) {
#pragma unroll
                    for (int i = 0; i < 4; ++i) xf[kk][i] = ldsv8(sa + swz128(wm * 64 + i * 16 + fr, kk * 4 + fq));
#pragma unroll
                    for (int j = 0; j < 4; ++j) wf[kk][j] = ldsv8(sb + swz128(wn * 64 + j * 16 + fr, kk * 4 + fq));
                }
                __builtin_amdgcn_sched_barrier(0);
                __builtin_amdgcn_s_setprio(1);
#pragma unroll
                for (int kk = 0; kk < 2; ++kk)
#pragma unroll
                    for (int i = 0; i < 4; ++i)
#pragma unroll
                        for (int j = 0; j < 4; ++j) acc[i][j] = mfma16(wf[kk][j], xf[kk][i], acc[i][j]);
                __builtin_amdgcn_s_setprio(0);
            }
        }
        wait_vm0();
    }
    DI void run(const int K, f32x4 (&acc)[4][4]) const {
        const int tid = threadIdx.x, lane = tid & 63, wave = tid >> 6;
        const int wm = wave >> 1, wn = wave & 1, fr = lane & 15, fq = lane >> 4;
#pragma unroll
        for (int i = 0; i < 4; ++i)
#pragma unroll
            for (int j = 0; j < 4; ++j) acc[i][j] = (f32x4){0.f, 0.f, 0.f, 0.f};
        const int KT = K >> 6;
#pragma unroll 1
        for (int kt = 0; kt < KT; ++kt) {
            wait_vm0();
            __syncthreads();
            if (kt + 1 < KT) issue(kt + 1, (kt + 1) & 1);
            const char* sa = lds + (kt & 1) * STAGE; const char* sb = sa + A_BYTES;
            bf16x8 xf[2][4], wf[2][4];
#pragma unroll
            for (int kk = 0; kk < 2; ++kk) {
#pragma unroll
                for (int i = 0; i < 4; ++i) xf[kk][i] = ldsv8(sa + swz128(wm * 64 + i * 16 + fr, kk * 4 + fq));
#pragma unroll
                for (int j = 0; j < 4; ++j) wf[kk][j] = ldsv8(sb + swz128(wn * 64 + j * 16 + fr, kk * 4 + fq));
            }
            __builtin_amdgcn_sched_barrier(0);
            __builtin_amdgcn_s_setprio(1);
#pragma unroll
            for (int kk = 0; kk < 2; ++kk)
#pragma unroll
                for (int i = 0; i < 4; ++i)
#pragma unroll
                    for (int j = 0; j < 4; ++j) acc[i][j] = mfma16(wf[kk][j], xf[kk][i], acc[i][j]);
            __builtin_amdgcn_s_setprio(0);
        }
    }
};

constexpr int EPI_OFF = 32768;
DI int lane_m(int i) { const int t = threadIdx.x; return ((t >> 7) & 1) * 64 + i * 16 + (t & 15); }
DI int lane_n(int j) { const int t = threadIdx.x; return ((t >> 6) & 1) * 64 + j * 16 + ((t >> 4) & 3) * 4; }
DI int opaque_tid() { int t = threadIdx.x; asm volatile("" : "+v"(t)); return t; }
DI int lane_m(int t, int i) { return ((t >> 7) & 1) * 64 + i * 16 + (t & 15); }
DI int lane_n(int t, int j) { return ((t >> 6) & 1) * 64 + j * 16 + ((t >> 4) & 3) * 4; }
template <class XF>
DI void epi_stage_bf16(const f32x4 (&acc)[4][4], XF xf) {
    const int tz = opaque_tid();
#pragma unroll
    for (int i = 0; i < 4; ++i) {
        const int m = lane_m(tz, i);
#pragma unroll
        for (int j = 0; j < 4; ++j) {
            const int n = lane_n(tz, j);
            const f32x4 v = xf(i, j, acc[i][j]);
            u32x2 o; o[0] = pk2(v[0], v[1]); o[1] = pk2(v[2], v[3]);
            *(u32x2*)(lds + EPI_OFF + m * 256 + (((n >> 3) ^ (m & 15)) << 4) + (n & 4) * 2) = o;
        }
    }
}
template <class DP, class OK>
DI void epi_flush_bf16(DP dst, OK ok) {
    const int tz = opaque_tid();
#pragma unroll
    for (int it = 0; it < 8; ++it) {
        const int idx = tz + it * NTHR, row = idx >> 4, ch = idx & 15;
        const u32x4 v = *(const u32x4*)(lds + EPI_OFF + row * 256 + ((ch ^ (row & 15)) << 4));
        if (ok(row)) *(u32x4*)(dst(row) + ch * 8) = v;
    }
}
template <class XF>
DI void epi_stage_bf16_T(const f32x4 (&acc)[4][4], XF xf) {
    const int tz = opaque_tid();
    const bool odd = tz & 1;
#pragma unroll
    for (int i = 0; i < 4; ++i) {
        const int m = lane_m(tz, i) & ~1;
#pragma unroll
        for (int j = 0; j < 4; ++j) {
            const int n = lane_n(tz, j) + (odd ? 2 : 0);
            const f32x4 v = xf(i, j, acc[i][j]);
            const float r0 = __shfl_xor(odd ? v[0] : v[2], 1), r1 = __shfl_xor(odd ? v[1] : v[3], 1);
            const unsigned w0 = odd ? pk2(r0, v[2]) : pk2(v[0], r0), w1 = odd ? pk2(r1, v[3]) : pk2(v[1], r1);
            *(unsigned*)(lds + EPI_OFF + n * 256 + (((m >> 3) ^ (n & 15)) << 4) + (m & 6) * 2) = w0;
            *(unsigned*)(lds + EPI_OFF + (n + 1) * 256 + (((m >> 3) ^ ((n + 1) & 15)) << 4) + (m & 6) * 2) = w1;
        }
    }
}
DI void epi_resid_f32(const Args& a, const int li, const int m0, const int n0, const f32x4 (&acc)[4][4]) {
    const int tz = opaque_tid();
    float* X = (float*)(a.ws + WS_X);
    const float* gate = (const float*)(a.ws + WS_MOD) + ((size_t)li * 9 + tok_modrow(m0)) * 6144 + 2 * 1024 + n0;
#pragma unroll
    for (int j = 0; j < 4; ++j) {
        const int n = lane_n(tz, j);
        const f32x4 g = *(const f32x4*)(gate + n);
#pragma unroll
        for (int i = 0; i < 4; ++i) {
            float* xp = X + (size_t)(m0 + lane_m(tz, i)) * D + n0 + n;
            f32x4 x = *(const f32x4*)xp;
            x += g * acc[i][j];
            *(f32x4*)xp = x;
        }
    }
}

template <bool XPF = true, class TE>
DI void gemm_dense_phase(const bf16_t* A, const int lda, const int mrows, const bf16_t* Bt, const int N, const int K, TE tile_epi) {
    const int mt = mrows / 128, nt = N / 128;
    const int mpx = mt >> 3, bmb = mpx >> 1, full = mpx * 8;
    auto decode = [&](int u, int& m0, int& n0) {
        const int xc = u & 7, s = u >> 3;
        const int bn = s / full, rem = s - bn * full;
        const int w = min(8, nt - 8 * bn);
        const int bm = rem / (bmb * w), rem2 = rem - bm * (bmb * w);
        const int ni = rem2 / bmb, mi = rem2 - ni * bmb;
        m0 = (xc * mpx + bm * bmb + mi) * 128; n0 = (bn * 8 + ni) * 128;
    };
    GemmPipe g;
    int u = blockIdx.x, m0 = 0, n0 = 0;
    __syncthreads();
    if (u < mt * nt) { decode(u, m0, n0); g.setup([&](int r) { return A + (size_t)(m0 + r) * lda; }, Bt + (size_t)n0 * K, K); g.issue(0, 0); }
    while (u < mt * nt) {
        f32x4 acc[4][4];
        g.run(K, acc);
        const int cm0 = m0, cn0 = n0;
        u += gridDim.x;
        if (XPF) {
            if (u < mt * nt) { decode(u, m0, n0); g.setup([&](int r) { return A + (size_t)(m0 + r) * lda; }, Bt + (size_t)n0 * K, K); g.issue(0, 0); }
            tile_epi(cm0, cn0, acc);
        } else {
            tile_epi(cm0, cn0, acc);
            __syncthreads();
            if (u < mt * nt) { decode(u, m0, n0); g.setup([&](int r) { return A + (size_t)(m0 + r) * lda; }, Bt + (size_t)n0 * K, K); g.issue(0, 0); }
        }
    }
    __syncthreads();
}
template <class XF, class DP>
DI void epi_bf16_rowmajor(const f32x4 (&acc)[4][4], XF xf, DP dst) {
    __syncthreads();
    epi_stage_bf16(acc, xf);
    __syncthreads();
    epi_flush_bf16(dst, [](int) { return true; });
}

DI void phase_rg_in(const Args& a, int j) {
    bf16_t* G = (bf16_t*)(a.ws + RG_G); bf16_t* U = (bf16_t*)(a.ws + RG_U);
    gemm_dense_phase((const bf16_t*)(a.ws + WS_H), D, NTOK, (const bf16_t*)(a.ws + W_RGIN) + (size_t)j * 2048 * 1024, 2048, 1024,
        [&](int m0, int n0, const f32x4 (&acc)[4][4]) {
            if (n0 < 1024)
                epi_bf16_rowmajor(acc, [](int, int, const f32x4 v) { f32x4 g; g[0] = gelu_tanh(v[0]); g[1] = gelu_tanh(v[1]); g[2] = gelu_tanh(v[2]); g[3] = gelu_tanh(v[3]); return g; },
                                  [&](int row) { return G + (size_t)(m0 + row) * D + n0; });
            else
                epi_bf16_rowmajor(acc, [](int, int, const f32x4 v) { return v; }, [&](int row) { return U + (size_t)(m0 + row) * D + (n0 - 1024); });
        });
}

template <int VAR = 0, int HOST = 0>
DI void phase_rg_scan(const Args& a, int j) {
    const int tid = threadIdx.x, lane = tid & 63, wave = tid >> 6;
    const int fr = lane & 15, fq = lane >> 4;
    const bf16_t* U = (const bf16_t*)(a.ws + RG_U);
    bf16_t* HS = (bf16_t*)(a.ws + (VAR ? WS_Y : RG_HS));
    char* sW = lds;
    char* sX = lds + 8192;
    float* sUc = (float*)(lds + 16384);
    float* sA = (float*)(lds + 24576);
    float* sB = (float*)(lds + 33280);
    bf16_t* sO = (bf16_t*)(lds + 41984);
    unsigned* sCv = (unsigned*)(lds + 50176);
    const int c = tid & 7;
    for (int u = blockIdx.x; u < 512; u += gridDim.x) {
        const int half = u & 1, dir = (u >> 1) & 1, blk = (u >> 2) & 15, b = u >> 6;
        const int cin0 = blk * 64, co0 = blk * 64 + half * 32;
        __syncthreads();
        {
            const bf16_t* Wg = (const bf16_t*)(a.ws + W_RGG) + ((size_t)((j * 2 + dir) * 16 + blk)) * 128 * 64;
#pragma unroll
            for (int i = 0; i < 2; ++i) {
                const int idx = tid + i * NTHR, row = idx >> 3, cc = idx & 7;
                const int srow = (row >> 5) * 64 + half * 32 + (row & 31);
                *(u32x4*)(sW + swz128(row, cc)) = *(const u32x4*)(Wg + (size_t)srow * 64 + cc * 8);
            }
        }
        float carry = 0.f;
        float cw[4][8], cb[8];
        {
            const float* cwp = a.in[9] + (size_t)j * 4 * 1024 + cin0 + c * 8; const float* cbp = a.in[10] + (size_t)j * 1024 + cin0 + c * 8;
#pragma unroll
            for (int w = 0; w < 4; ++w) { const f32x4 v0 = *(const f32x4*)(cwp + w * 1024), v1 = *(const f32x4*)(cwp + w * 1024 + 4);
#pragma unroll
                for (int e = 0; e < 4; ++e) { cw[w][e] = v0[e]; cw[w][4 + e] = v1[e]; } }
            const f32x4 v0 = *(const f32x4*)cbp, v1 = *(const f32x4*)(cbp + 4);
#pragma unroll
            for (int e = 0; e < 4; ++e) { cb[e] = v0[e]; cb[4 + e] = v1[e]; }
        }
        float bg0[8], bg1[8], spl[8];
        {
            const float* gb = a.in[12] + ((size_t)(j * 2 + dir) * 2) * 1024 + co0;
            const float* lm = a.in[13] + (size_t)(j * 2 + dir) * 1024 + co0;
#pragma unroll
            for (int jt = 0; jt < 2; ++jt)
#pragma unroll
                for (int e = 0; e < 4; ++e) {
                    const int cc = jt * 16 + fq * 4 + e;
                    bg0[jt * 4 + e] = gb[cc]; bg1[jt * 4 + e] = gb[1024 + cc];
                    spl[jt * 4 + e] = -8.f * log1pf(__expf(-lm[cc]));
                }
        }
        u32x4 pu[2][4];
        auto load_chunk = [&](int ci) {
            const int seg = ci >= 4, L = seg ? SEQ : CTXL, nch = L / 64, jc = seg ? ci - 4 : ci;
            const int oc = dir ? nch - 1 - jc : jc;
            const int rb = seg ? b * SEQ : NLAT + b * CTXL;
            const int s0 = oc * 64;
#pragma unroll
            for (int it = 0; it < 2; ++it) {
                const int tk = (tid >> 3) + it * 32;
#pragma unroll
                for (int w = 0; w < 4; ++w) {
                    const int s = s0 + tk + w - 2;
                    const int sc_ = min(max(s, 0), L - 1);
                    const u32x4 ld = *(const u32x4*)(U + (size_t)(rb + sc_) * D + cin0 + c * 8);
                    const unsigned msk = (s >= 0 && s < L) ? 0xffffffffu : 0u;
                    pu[it][w] = (u32x4){ld[0] & msk, ld[1] & msk, ld[2] & msk, ld[3] & msk};
                }
            }
        };
        load_chunk(0);
        __syncthreads();
        size_t prev_base = 0;
        constexpr int CV_TILES = HOST ? 6144 : 0;
        CvTile cvp; cvp.src = nullptr; cvp.dst = nullptr; cvp.K = 0; cvp.N = 0; cvp.perm = 0; cvp.k0 = 0; cvp.n0 = 0;
        bool cvp_ok = false;
#pragma unroll 1
        for (int ci = 0; ci < 36; ++ci) {
            f32x4 cv0[4], cv1[4];
            CvTile cvc = cvp;
            const int cvq = (ci / 3) * 512 + u;
            const bool cv_ok = HOST && (ci % 3 == 0) && cvq < CV_TILES;
            if (cv_ok) { cvc = moe_cv_tile(a, 1, cvq); cv_load(cvc, cv0, cv1); }
            const int seg = ci >= 4, L = seg ? SEQ : CTXL, nch = L / 64, jc = seg ? ci - 4 : ci;
            const int oc = dir ? nch - 1 - jc : jc;
            const int rb = seg ? b * SEQ : NLAT + b * CTXL;
            const int s0 = oc * 64;
            char* sXc = sX; float* sUcc = sUc;
#pragma unroll
            for (int it = 0; it < 2; ++it) {
                const int tk = (tid >> 3) + it * 32;
                float o[8];
#pragma unroll
                for (int e = 0; e < 8; ++e) o[e] = cb[e];
#pragma unroll
                for (int w = 0; w < 4; ++w) {
                    const u32x4 r4 = pu[it][w];
#pragma unroll
                    for (int e = 0; e < 4; ++e) { o[2 * e] += cw[w][2 * e] * lof(r4[e]); o[2 * e + 1] += cw[w][2 * e + 1] * hif(r4[e]); }
                }
                u32x4 pv; pv[0] = pk2(o[0], o[1]); pv[1] = pk2(o[2], o[3]); pv[2] = pk2(o[4], o[5]); pv[3] = pk2(o[6], o[7]);
                *(u32x4*)(sXc + swz128(tk, c)) = pv;
                if ((c >> 2) == half) {
                    *(f32x4*)(sUcc + tk * 32 + (c & 3) * 8) = (f32x4){o[0], o[1], o[2], o[3]};
                    *(f32x4*)(sUcc + tk * 32 + (c & 3) * 8 + 4) = (f32x4){o[4], o[5], o[6], o[7]};
                }
            }
            if (ci + 1 < 36) load_chunk(ci + 1);
            __syncthreads();
            if (HOST && cvp_ok) cv_flush(cvp, sCv);
            if (ci > 0) {
                const u32x4 v = *(const u32x4*)(sO + ((ci - 1) & 1) * 2048 + tid * 8);
                *(u32x4*)(HS + prev_base + (size_t)(tid >> 2) * D + (tid & 3) * 8) = v;
            }
            {
                f32x4 acc[4];
#pragma unroll
                for (int jt = 0; jt < 4; ++jt) acc[jt] = (f32x4){0.f, 0.f, 0.f, 0.f};
#pragma unroll
                for (int kk = 0; kk < 2; ++kk) {
                    const bf16x8 xf = ldsv8(sXc + swz128(wave * 16 + fr, kk * 4 + fq));
#pragma unroll
                    for (int jt = 0; jt < 4; ++jt) acc[jt] = mfma16(ldsv8(sW + swz128(jt * 16 + fr, kk * 4 + fq)), xf, acc[jt]);
                }
                const int tk = wave * 16 + fr;
#pragma unroll
                for (int jt = 0; jt < 2; ++jt) {
                    const f32x4 uc = *(const f32x4*)(sUcc + tk * 32 + jt * 16 + fq * 4);
                    f32x4 av4, bv4;
#pragma unroll
                    for (int e = 0; e < 4; ++e) {
                        if (VAR & 2) { av4[e] = 0.5f + 0.001f * acc[jt][e]; bv4[e] = uc[e] + acc[jt + 2][e]; continue; }
                        const float rg = sigmoidf_(acc[jt][e] + bg0[jt * 4 + e]);
                        const float ig = sigmoidf_(acc[jt + 2][e] + bg1[jt * 4 + e]);
                        const float av = fexp(rg * spl[jt * 4 + e]);
                        av4[e] = av;
                        bv4[e] = __builtin_amdgcn_sqrtf(fmaxf(1.f - av * av, 0.f)) * ig * uc[e];
                    }
#pragma unroll
                    for (int e = 0; e < 4; ++e) { sA[(jt * 16 + fq * 4 + e) * 68 + tk] = av4[e]; sB[(jt * 16 + fq * 4 + e) * 68 + tk] = bv4[e]; }
                }
            }
            __syncthreads();
            if (!(VAR & 4)) {
                const int ch = wave * 8 + (lane & 7), sg = lane >> 3;
                const int tb = dir ? 56 - sg * 8 : sg * 8;
                const f32x4 a0 = *(const f32x4*)(sA + ch * 68 + tb), a1 = *(const f32x4*)(sA + ch * 68 + tb + 4);
                const f32x4 b0 = *(const f32x4*)(sB + ch * 68 + tb), b1 = *(const f32x4*)(sB + ch * 68 + tb + 4);
                float av[8], bv[8];
#pragma unroll
                for (int e = 0; e < 4; ++e) {
                    av[e] = dir ? a1[3 - e] : a0[e]; av[4 + e] = dir ? a0[3 - e] : a1[e];
                    bv[e] = dir ? b1[3 - e] : b0[e]; bv[4 + e] = dir ? b0[3 - e] : b1[e];
                }
                float Ap = 1.f, Hh = 0.f;
#pragma unroll
                for (int e = 0; e < 8; ++e) { Hh = av[e] * Hh + bv[e]; Ap *= av[e]; }
#pragma unroll
                for (int d = 8; d < 64; d <<= 1) {
                    const float Ao = __shfl_up(Ap, d), Ho = __shfl_up(Hh, d);
                    if (lane >= d) { Hh = Ap * Ho + Hh; Ap = Ap * Ao; }
                }
                float Aex = __shfl_up(Ap, 8), Hex = __shfl_up(Hh, 8);
                if (sg == 0) { Aex = 1.f; Hex = 0.f; }
                float hin = Aex * carry + Hex;
                const float cnew = Ap * carry + Hh;
                carry = __shfl(cnew, 56 + (lane & 7));
                bf16_t* so = sO + (ci & 1) * 2048 + ch;
#pragma unroll
                for (int e = 0; e < 8; ++e) {
                    hin = av[e] * hin + bv[e];
                    const int i = sg * 8 + e, tk = dir ? 63 - i : i;
                    so[tk * 32] = f2bf(hin);
                }
            }
            prev_base = (size_t)dir * NTOK * D + (size_t)(rb + s0) * D + co0;
            if (HOST) { if (cv_ok) cv_pack(sCv, cv0, cv1); cvp = cvc; cvp_ok = cv_ok; }
        }
        __syncthreads();
        if (HOST && cvp_ok) cv_flush(cvp, sCv);
        {
            const u32x4 v = *(const u32x4*)(sO + (35 & 1) * 2048 + tid * 8);
            *(u32x4*)(HS + prev_base + (size_t)(tid >> 2) * D + (tid & 3) * 8) = v;
        }
    }
}

DI void phase_rg_combine(const Args& a) {
    const u32x4* G = (const u32x4*)(a.ws + RG_G);
    const u32x4* H0 = (const u32x4*)(a.ws + RG_HS);
    const u32x4* H1 = (const u32x4*)(a.ws + RG_HS + TOKD2);
    u32x4* A2 = (u32x4*)(a.ws + RG_A2);
    const size_t n = (size_t)NTOK * D / 8;
    for (size_t i = (size_t)blockIdx.x * NTHR + threadIdx.x; i < n; i += (size_t)gridDim.x * NTHR) {
        const u32x4 g = G[i], h0 = H0[i], h1 = H1[i];
        u32x4 o;
#pragma unroll
        for (int e = 0; e < 4; ++e) o[e] = pk2(lof(g[e]) * (lof(h0[e]) + lof(h1[e])), hif(g[e]) * (hif(h0[e]) + hif(h1[e])));
        A2[i] = o;
    }
}

DI void phase_rg_out(const Args& a, int li, int j) {
    gemm_dense_phase((const bf16_t*)(a.ws + RG_A2), D, li == 3 ? NLAT : NTOK, (const bf16_t*)(a.ws + W_RGOUT) + (size_t)j * 1024 * 1024, 1024, 1024,
        [&](int m0, int n0, const f32x4 (&acc)[4][4]) { epi_resid_f32(a, li, m0, n0, acc); });
}

DI void phase_mla_down(const Args& a) {
    bf16_t* CQ = (bf16_t*)(a.ws + MLA_CQ); bf16_t* CKV = (bf16_t*)(a.ws + MLA_CKV); float* KR = (float*)(a.ws + MLA_KR);
    gemm_dense_phase((const bf16_t*)(a.ws + WS_H), D, NTOK, (const bf16_t*)(a.ws + W_MDOWN), 512, 1024,
        [&](int m0, int n0, const f32x4 (&acc)[4][4]) {
            if (n0 < 256) epi_bf16_rowmajor(acc, [](int, int, const f32x4 v) { return v; }, [&](int row) { return CQ + (size_t)(m0 + row) * 256 + n0; });
            else if (n0 == 256) epi_bf16_rowmajor(acc, [](int, int, const f32x4 v) { return v; }, [&](int row) { return CKV + (size_t)(m0 + row) * 128; });
            else {
#pragma unroll
                for (int i = 0; i < 4; ++i)
#pragma unroll
                    for (int j = 0; j < 2; ++j) { const int n = lane_n(j); if (n < 32) *(f32x4*)(KR + (size_t)(m0 + lane_m(i)) * 32 + n) = acc[i][j]; }
            }
        });
}

DI int perm_key(int kp) { return (kp & ~12) | ((kp & 4) << 1) | ((kp & 8) >> 1); }

DI void phase_mla_up(const Args& a) {
    const int tid = threadIdx.x;
    const bf16_t* CQ = (const bf16_t*)(a.ws + MLA_CQ); const bf16_t* CKV = (const bf16_t*)(a.ws + MLA_CKV); const float* KR = (const float*)(a.ws + MLA_KR);
    bf16_t* Q = (bf16_t*)(a.ws + MLA_Q); bf16_t* Kb = (bf16_t*)(a.ws + MLA_K); bf16_t* VT = (bf16_t*)(a.ws + MLA_VT);
    const float* qkn = a.in[20];
    const float* RC = (const float*)(a.ws + WS_CTL + CTL_ROPE); const float* RS = RC + 512;
    const int MT_ = NTOK / 128;
    const int nq = MT_ * 16, nkv = MT_ * 16;
    const float QSCALE = 0.10206207261596575f * 1.4426950408889634f;
    for (int u = blockIdx.x; u < nq + nkv; u += gridDim.x) {
        const bool isq = u < nq;
        const int uu = isq ? u : u - nq;
        const int xc_ = uu & 7, s_ = uu >> 3;
        const int m0 = (((s_ >> 4) << 3) + xc_) * 128, head = s_ & 15;
        const bool islat = m0 < NLAT;
        const int bb = islat ? (m0 >> 11) : ((m0 - NLAT) >> 8);
        const int kp0 = islat ? CTXL + (m0 & (SEQ - 1)) : ((m0 - NLAT) & (CTXL - 1));
        __syncthreads();
        if (isq) {
            f32x4 hold[2][6];
            float ssq[2] = {0.f, 0.f};
            gemm_tile<4, 1, 2, 6, false>([&](int r) { return CQ + (size_t)(m0 + r) * 256; }, (const bf16_t*)(a.ws + W_MUQ) + (size_t)head * 96 * 256, 256, 256, hold, ssq);
            const int tz = opaque_tid();
            const int wave = tz >> 6, fq = (tz >> 4) & 3, fr = tz & 15;
#pragma unroll
            for (int i = 0; i < 2; ++i) {
                const int m = wave * 32 + i * 16 + fr;
                float sq = ssq[i]; sq += __shfl_xor(sq, 16); sq += __shfl_xor(sq, 32);
                const float rs0 = rsqrtf(sq * (1.f / 256.f) + EPS);
                float ss = 0.f;
#pragma unroll
                for (int jn = 0; jn < 6; ++jn) { hold[i][jn] *= rs0;
#pragma unroll
                    for (int e = 0; e < 4; ++e) ss += hold[i][jn][e] * hold[i][jn][e]; }
                ss += __shfl_xor(ss, 16); ss += __shfl_xor(ss, 32);
                const float rs = rsqrtf(ss * (1.f / 96.f) + EPS) ;
                f32x4 o[6];
#pragma unroll
                for (int jn = 0; jn < 6; ++jn) { const f32x4 g4 = *(const f32x4*)(qkn + jn * 16 + fq * 4); o[jn] = hold[i][jn] * rs * g4; }
#pragma unroll
                for (int jn = 4; jn < 6; ++jn) {
                    f32x4 other;
#pragma unroll
                    for (int e = 0; e < 4; ++e) other[e] = __shfl_xor(o[jn][e], 32);
                    if (islat) {
                        const int s = (m0 + m) & (SEQ - 1);
                        const int pos = jn == 4 ? (s >> 6) : (s & 63);
                        const f32x4 cs = *(const f32x4*)(RC + pos * 8 + (fq & 1) * 4), sn = *(const f32x4*)(RS + pos * 8 + (fq & 1) * 4);
#pragma unroll
                        for (int e = 0; e < 4; ++e) o[jn][e] = (fq < 2) ? o[jn][e] * cs[e] - other[e] * sn[e] : o[jn][e] * cs[e] + other[e] * sn[e];
                    }
                }
#pragma unroll
                for (int jn = 0; jn < 6; ++jn) {
                    const f32x4 v = o[jn] * QSCALE;
                    u32x2 pv; pv[0] = pk2(v[0], v[1]); pv[1] = pk2(v[2], v[3]);
                    *(u32x2*)(lds + m * 256 + (((jn * 2 + (fq >> 1)) ^ (m & 15)) << 4) + (fq & 1) * 8) = pv;
                }
            }
            __syncthreads();
#pragma unroll
            for (int it = 0; it < 8; ++it) {
                const int idx = tz + it * NTHR, row = idx >> 4, ch = idx & 15;
                if (ch < 12) {
                    const u32x4 v = *(const u32x4*)(lds + row * 256 + ((ch ^ (row & 15)) << 4));
                    *(u32x4*)(Q + (size_t)(m0 + row) * 1536 + head * 96 + ch * 8) = v;
                }
            }
        } else {
            f32x4 hold[4][4];
            float ssq[4] = {0.f, 0.f, 0.f, 0.f};
            gemm_tile<2, 2, 4, 4, false>([&](int r) { return CKV + (size_t)(m0 + r) * 128; }, (const bf16_t*)(a.ws + W_MUKV) + (size_t)head * 128 * 128, 128, 128, hold, ssq);
            const int tz = opaque_tid();
            const int wave = tz >> 6, wm = wave >> 1, wn = wave & 1, fq = (tz >> 4) & 3, fr = tz & 15;
            char* sK = lds; char* sV = lds + 32768;
#pragma unroll
            for (int i = 0; i < 4; ++i) {
                const int m = wm * 64 + i * 16 + fr, t = m0 + m;
                float sq = ssq[i]; sq += __shfl_xor(sq, 16); sq += __shfl_xor(sq, 32);
                const float rs0 = rsqrtf(sq * (1.f / 128.f) + EPS);
#pragma unroll
                for (int jn = 0; jn < 4; ++jn) hold[i][jn] *= rs0;
                if (wn == 0) {
                    const int base = (fq >> 1) * 16 + (fq & 1) * 4;
                    const f32x4 z1 = *(const f32x4*)(KR + (size_t)t * 32 + base);
                    const f32x4 z2 = *(const f32x4*)(KR + (size_t)t * 32 + base + 8);
                    float ss = 0.f;
#pragma unroll
                    for (int jn = 0; jn < 4; ++jn)
#pragma unroll
                        for (int e = 0; e < 4; ++e) ss += hold[i][jn][e] * hold[i][jn][e];
#pragma unroll
                    for (int e = 0; e < 4; ++e) ss += z1[e] * z1[e] + z2[e] * z2[e];
                    ss += __shfl_xor(ss, 16); ss += __shfl_xor(ss, 32);
                    const float rs = rsqrtf(ss * (1.f / 96.f) + EPS);
#pragma unroll
                    for (int jn = 0; jn < 4; ++jn) {
                        const f32x4 g4 = *(const f32x4*)(qkn + 96 + jn * 16 + fq * 4);
                        const f32x4 v = hold[i][jn] * rs * g4;
                        u32x2 pv; pv[0] = pk2(v[0], v[1]); pv[1] = pk2(v[2], v[3]);
                        *(u32x2*)(sK + m * 256 + (((jn * 2 + (fq >> 1)) ^ (m & 15)) << 4) + (fq & 1) * 8) = pv;
                    }
                    const f32x4 g1 = *(const f32x4*)(qkn + 96 + 64 + base), g2 = *(const f32x4*)(qkn + 96 + 64 + base + 8);
                    f32x4 a1 = z1 * rs * g1, a2 = z2 * rs * g2;
                    if (islat) {
                        const int s = t & (SEQ - 1);
                        const int pos = (fq >> 1) == 0 ? (s >> 6) : (s & 63);
                        const f32x4 cs = *(const f32x4*)(RC + pos * 8 + (fq & 1) * 4), sn = *(const f32x4*)(RS + pos * 8 + (fq & 1) * 4);
                        const f32x4 b1 = a1 * cs - a2 * sn, b2 = a2 * cs + a1 * sn;
                        a1 = b1; a2 = b2;
                    }
                    u32x2 p1, p2; p1[0] = pk2(a1[0], a1[1]); p1[1] = pk2(a1[2], a1[3]); p2[0] = pk2(a2[0], a2[1]); p2[1] = pk2(a2[2], a2[3]);
                    const int c1 = 8 + (fq >> 1) * 2;
                    *(u32x2*)(sK + m * 256 + ((c1 ^ (m & 15)) << 4) + (fq & 1) * 8) = p1;
                    *(u32x2*)(sK + m * 256 + (((c1 + 1) ^ (m & 15)) << 4) + (fq & 1) * 8) = p2;
                }
                {
                    const bool odd = fr & 1;
                    const int mp = perm_key(m & ~1);
#pragma unroll
                    for (int jn = 0; jn < 4; ++jn) {
                        const f32x4 v = hold[i][jn];
                        const float r0 = __shfl_xor(odd ? v[0] : v[2], 1), r1 = __shfl_xor(odd ? v[1] : v[3], 1);
                        if (wn == 1) {
                            const int e0 = jn * 16 + fq * 4 + (odd ? 2 : 0);
                            const unsigned w0 = odd ? pk2(r0, v[2]) : pk2(v[0], r0), w1 = odd ? pk2(r1, v[3]) : pk2(v[1], r1);
                            *(unsigned*)(sV + e0 * 256 + (((mp >> 3) ^ (e0 & 15)) << 4) + (mp & 6) * 2) = w0;
                            *(unsigned*)(sV + (e0 + 1) * 256 + (((mp >> 3) ^ ((e0 + 1) & 15)) << 4) + (mp & 6) * 2) = w1;
                        }
                    }
                }
            }
            __syncthreads();
            bf16_t* kdst = Kb + ((size_t)(bb * 16 + head) * NKEY + kp0) * 96;
#pragma unroll
            for (int it = 0; it < 8; ++it) {
                const int idx = tz + it * NTHR, row = idx >> 4, ch = idx & 15;
                if (ch < 12) {
                    const u32x4 v = *(const u32x4*)(sK + row * 256 + ((ch ^ (row & 15)) << 4));
                    *(u32x4*)(kdst + (size_t)row * 96 + ch * 8) = v;
                }
            }
            bf16_t* vdst = VT + ((size_t)(bb * 16 + head) * 64) * NKEY + kp0;
#pragma unroll
            for (int it = 0; it < 4; ++it) {
                const int idx = tz + it * NTHR, row = idx >> 4, ch = idx & 15;
                const u32x4 v = *(const u32x4*)(sV + row * 256 + ((ch ^ (row & 15)) << 4));
                *(u32x4*)(vdst + (size_t)row * NKEY + ch * 8) = v;
            }
        }
    }
}

DI void phase_mla_attn(const Args& a) {
    const int tid = threadIdx.x, lane = tid & 63, wave = tid >> 6;
    const int r = lane & 31, h = lane >> 5;
    const bf16_t* Q = (const bf16_t*)(a.ws + MLA_Q); const bf16_t* Kb = (const bf16_t*)(a.ws + MLA_K); const bf16_t* VT = (const bf16_t*)(a.ws + MLA_VT);
    bf16_t* O = (bf16_t*)(a.ws + MLA_O);
    constexpr int KT_B = 64 * 256, VT_B = 64 * 128, ST_B = KT_B + VT_B;
    unsigned* sCv = (unsigned*)(lds + 49152);
    const int cv_per = 18432 / gridDim.x;
    int cvn = 0, itc = 0;
    bool cv_pack_p = false, cv_flush_p = false;
    CvTile cvB, cvC; cvB.src = nullptr; cvB.dst = nullptr; cvB.K = 0; cvB.N = 0; cvB.perm = 0; cvB.k0 = 0; cvB.n0 = 0; cvC = cvB;
    f32x4 cv0[4], cv1[4];
#pragma unroll
    for (int i = 0; i < 4; ++i) { cv0[i] = (f32x4){0.f, 0.f, 0.f, 0.f}; cv1[i] = cv0[i]; }
    auto cv_step = [&](bool may_load) {
        if (cv_flush_p) { cv_flush(cvC, sCv); cv_flush_p = false; }
        if (cv_pack_p) { cv_pack(sCv, cv0, cv1); cvC = cvB; cv_flush_p = true; cv_pack_p = false; }
        if (may_load && cvn < cv_per) {
            const int t = cvn * gridDim.x + blockIdx.x;
            cvB = moe_cv_tile(a, 1 + t / 6144, t % 6144); cv_load(cvB, cv0, cv1); cv_pack_p = true; ++cvn;
        }
    };
    for (int u = blockIdx.x; u < 2048 + 256; u += gridDim.x) {
        const bool isctx = u >= 2048;
        const int uu = isctx ? u - 2048 : u;
        const int xc_ = uu & 7, s_ = uu >> 3, bh_ = ((s_ >> 4) << 3) + xc_;
        const int qb = isctx ? (uu & 1) : (s_ & 15), head = isctx ? ((uu >> 1) & 15) : (bh_ & 15), b = isctx ? (uu >> 5) : (bh_ >> 4);
        const int ntile = isctx ? CTXL / 64 : NKEY / 64;
        const int t = (isctx ? NLAT + b * CTXL : b * SEQ) + qb * 128 + wave * 32 + r;
        const bf16_t* kbase = Kb + (size_t)(b * 16 + head) * NKEY * 96;
        const bf16_t* vbase = VT + (size_t)(b * 16 + head) * 64 * NKEY;
        bf16x8 qf[6];
#pragma unroll
        for (int kk = 0; kk < 6; ++kk) qf[kk] = *(const bf16x8*)(Q + (size_t)t * 1536 + head * 96 + kk * 16 + h * 8);
        f32x16 o[2];
#pragma unroll
        for (int e = 0; e < 16; ++e) { o[0][e] = 0.f; o[1][e] = 0.f; }
        float lsum = 0.f;
        __syncthreads();
        auto stage = [&](int kt, int buf) {
            char* sk = lds + buf * ST_B; char* sv = sk + KT_B;
            const int key0 = kt * 64;
#pragma unroll
            for (int i = 0; i < 4; ++i) {
                const int idx = tid + i * NTHR, row = idx >> 4; int c = (idx & 15) ^ (row & 15); if (c >= 12) c = 0;
                dma16(kbase + (size_t)(key0 + row) * 96 + c * 8, sk + idx * 16);
            }
#pragma unroll
            for (int i = 0; i < 2; ++i) {
                const int idx = tid + i * NTHR, row = idx >> 3, c = (idx & 7) ^ ((row >> 1) & 7);
                dma16(vbase + (size_t)row * NKEY + key0 + c * 8, sv + idx * 16);
            }
        };
        stage(0, 0);
#pragma unroll 1
        for (int kt = 0; kt < ntile; ++kt) {
            wait_vm0();
            __syncthreads();
            if (kt + 1 < ntile) stage(kt + 1, (kt + 1) & 1);
            cv_step((itc & 3) == 0); ++itc;
            const char* sk = lds + (kt & 1) * ST_B; const char* sv = sk + KT_B;
            f32x16 st[2];
#pragma unroll
            for (int e = 0; e < 16; ++e) { st[0][e] = -8.f; st[1][e] = -8.f; }
#pragma unroll
            for (int kk = 0; kk < 6; ++kk)
#pragma unroll
                for (int si = 0; si < 2; ++si) {
                    const int s = si * 32 + r;
                    st[si] = mfma32(ldsv8(sk + swz256(s, kk * 2 + h)), qf[kk], st[si]);
                }
            float ps = 0.f;
#pragma unroll
            for (int si = 0; si < 2; ++si)
#pragma unroll
                for (int e = 0; e < 16; ++e) { const float p = __builtin_amdgcn_exp2f(st[si][e]); st[si][e] = p; ps += p; }
            lsum += ps;
#pragma unroll
            for (int si = 0; si < 2; ++si)
#pragma unroll
                for (int ks = 0; ks < 2; ++ks) {
                    u32x4 pp;
                    pp[0] = pk2(st[si][8 * ks + 0], st[si][8 * ks + 1]); pp[1] = pk2(st[si][8 * ks + 2], st[si][8 * ks + 3]);
                    pp[2] = pk2(st[si][8 * ks + 4], st[si][8 * ks + 5]); pp[3] = pk2(st[si][8 * ks + 6], st[si][8 * ks + 7]);
                    const bf16x8 pf = __builtin_bit_cast(bf16x8, pp);
#pragma unroll
                    for (int et = 0; et < 2; ++et) {
                        const int e = et * 32 + r;
                        o[et] = mfma32(ldsv8(sv + e * 128 + (((si * 4 + ks * 2 + h) ^ ((e >> 1) & 7)) << 4)), pf, o[et]);
                    }
                }
        }
        lsum += __shfl_xor(lsum, 32);
        const float inv = 1.f / lsum;
#pragma unroll
        for (int et = 0; et < 2; ++et)
#pragma unroll
            for (int g = 0; g < 4; ++g) {
                f32x4 v; v[0] = o[et][4 * g] * inv; v[1] = o[et][4 * g + 1] * inv; v[2] = o[et][4 * g + 2] * inv; v[3] = o[et][4 * g + 3] * inv;
                st_bf4(O + (size_t)t * D + head * 64 + et * 32 + 8 * g + 4 * h, v);
            }
    }
    while (cvn < cv_per || cv_pack_p || cv_flush_p) { __syncthreads(); cv_step(!cv_pack_p && !cv_flush_p); }
}

DI void phase_mla_out(const Args& a, int li) {
    gemm_dense_phase((const bf16_t*)(a.ws + MLA_O), D, NTOK, (const bf16_t*)(a.ws + W_MO), 1024, 1024,
        [&](int m0, int n0, const f32x4 (&acc)[4][4]) { epi_resid_f32(a, li, m0, n0, acc); });
}

DI void phase_ml_in(const Args& a) {
    bf16_t* Qm = (bf16_t*)(a.ws + ML_Q); bf16_t* Km = (bf16_t*)(a.ws + ML_K); bf16_t* KT = (bf16_t*)(a.ws + ML_KT); bf16_t* VT = (bf16_t*)(a.ws + ML_VT);
    bf16_t* OG = (bf16_t*)(a.ws + ML_OG); float* GT = (float*)(a.ws + ML_GT);
    const float* gb = a.in[23];
    auto ident = [](int, int, const f32x4 v) { return v; };
    gemm_dense_phase<false>((const bf16_t*)(a.ws + WS_H), D, NTOK, (const bf16_t*)(a.ws + W_MLIN), 3200, 1024,
        [&](int m0, int n0, const f32x4 (&acc)[4][4]) {
            if (n0 < 512) {
                epi_bf16_rowmajor(acc, [](int, int, const f32x4 v) { return v * 0.08838834764831845f; }, [&](int row) { return Qm + (size_t)(m0 + row) * 512 + n0; });
            } else if (n0 < 1024) {
                epi_bf16_rowmajor(acc, ident, [&](int row) { return Km + (size_t)(m0 + row) * 512 + (n0 - 512); });
                __syncthreads();
                epi_stage_bf16_T(acc, ident);
                __syncthreads();
                epi_flush_bf16([&](int row) { return KT + (size_t)(n0 - 512 + row) * NTOK + m0; }, [](int) { return true; });
            } else if (n0 < 2048) {
                __syncthreads();
                epi_stage_bf16_T(acc, ident);
                __syncthreads();
                epi_flush_bf16([&](int row) { return VT + (size_t)(n0 - 1024 + row) * NTOK + m0; }, [](int) { return true; });
            } else if (n0 < 3072) {
                epi_bf16_rowmajor(acc, [](int, int, const f32x4 v) { f32x4 s; s[0] = sigmoidf_(v[0]); s[1] = sigmoidf_(v[1]); s[2] = sigmoidf_(v[2]); s[3] = sigmoidf_(v[3]); return s; },
                                  [&](int row) { return OG + (size_t)(m0 + row) * D + (n0 - 2048); });
            } else {
#pragma unroll
                for (int i = 0; i < 4; ++i) {
                    const int n = lane_n(0);
                    if (n < 16) { f32x4 s = acc[i][0]; s[0] += gb[n]; s[1] += gb[n + 1]; s[2] += gb[n + 2]; s[3] += gb[n + 3]; *(f32x4*)(GT + (size_t)(m0 + lane_m(i)) * 16 + n) = s; }
                }
            }
        });
}

DI void phase_ml_scan(const Args& a) {
    const int tid = threadIdx.x, lane = tid & 63, wave = tid >> 6;
    const int fr = lane & 15, fq = lane >> 4;
    const bf16_t* Qm = (const bf16_t*)(a.ws + ML_Q); const bf16_t* Km = (const bf16_t*)(a.ws + ML_K);
    const bf16_t* KT = (const bf16_t*)(a.ws + ML_KT); const bf16_t* VT = (const bf16_t*)(a.ws + ML_VT);
    const float* GT = (const float*)(a.ws + ML_GT);
    bf16_t* HS = (bf16_t*)(a.ws + ML_HS);
    char* sQ = lds;
    char* sK = lds + 16384;
    char* sS = sK;
    char* sKT = lds + 32768;
    char* sVT = lds + 49152;
    char* sCT = lds + 55296;
    float* sRow = (float*)(lds + 67584);
    float* sCol = sRow + 64;
    float* sInt = sCol + 64;
    float* sNrm = sInt + 64;
    float* sWv = sNrm + 64;
    float* sSc = sWv + 64;
    for (int u = blockIdx.x; u < 512; u += gridDim.x) {
        const int xc_ = u & 7, s_ = u >> 3, bh_ = ((s_ >> 4) << 3) + xc_;
        const int sl = s_ & 7, dir = (s_ >> 3) & 1, head = bh_ & 3, b = bh_ >> 2;
        auto chunk_t0 = [&](int ci) {
            const int seg = ci >= 4, L = seg ? SEQ : CTXL, nch = L / 64, jc = seg ? ci - 4 : ci;
            const int oc = dir ? nch - 1 - jc : jc;
            return (seg ? b * SEQ : NLAT + b * CTXL) + oc * 64;
        };
        u32x4 pq[4], pk[4], pkt[4], pvt;
        float gi_n = 0.f, gf_n = 0.f;
        auto load_tiles = [&](int t0) {
#pragma unroll
            for (int i = 0; i < 4; ++i) {
                const int idx = tid + i * NTHR, row = idx >> 4, c = (idx & 15) ^ (row & 15);
                pq[i] = *(const u32x4*)(Qm + (size_t)(t0 + row) * 512 + head * 128 + c * 8);
                pk[i] = *(const u32x4*)(Km + (size_t)(t0 + row) * 512 + head * 128 + c * 8);
            }
#pragma unroll
            for (int i = 0; i < 4; ++i) {
                const int idx = tid + i * NTHR, row = idx >> 3, c = (idx & 7) ^ (row & 7);
                pkt[i] = *(const u32x4*)(KT + (size_t)(head * 128 + row) * NTOK + t0 + c * 8);
            }
            { const int row = tid >> 3, c = (tid & 7) ^ (row & 7); pvt = *(const u32x4*)(VT + (size_t)(head * 256 + sl * 32 + row) * NTOK + t0 + c * 8); }
            if (wave == 0) {
                const int s = dir ? 63 - lane : lane;
                gi_n = GT[(size_t)(t0 + s) * 16 + dir * 8 + head];
                gf_n = GT[(size_t)(t0 + s) * 16 + dir * 8 + 4 + head];
            }
        };
        auto store_tiles = [&]() {
#pragma unroll
            for (int i = 0; i < 4; ++i) { *(u32x4*)(sQ + (tid + i * NTHR) * 16) = pq[i]; *(u32x4*)(sK + (tid + i * NTHR) * 16) = pk[i]; *(u32x4*)(sKT + (tid + i * NTHR) * 16) = pkt[i]; }
            *(u32x4*)(sVT + tid * 16) = pvt;
        };
        auto gate_scalars = [&]() {
            const int s = dir ? 63 - lane : lane;
            const float ig = gi_n, fg = gf_n;
            const float lf = fminf(fg, 0.f) - __logf(1.f + fexp(-fabsf(fg)));
            float bc = lf;
#pragma unroll
            for (int d = 1; d < 64; d <<= 1) { const float o = __shfl_up(bc, d); if (lane >= d) bc += o; }
            const float av = ig - bc;
            float pm = av;
#pragma unroll
            for (int d = 1; d < 64; d <<= 1) { const float o = __shfl_up(pm, d); if (lane >= d) pm = fmaxf(pm, o); }
            const float mst = sSc[1];
            const float mm = fmaxf(mst, pm);
            sRow[s] = -mm;
            sCol[s] = av;
            sInt[s] = fexp(mst - mm);
            sNrm[s] = fexp(-(bc + mm));
            const float mmL = __shfl(mm, 63), bL = __shfl(bc, 63);
            sWv[s] = fexp(av - mmL);
            if (lane == 0) { sSc[0] = fexp(mst - mmL); sSc[1] = bL + mmL; }
        };
        __syncthreads();
        for (int i = tid; i < 12288 / 16; i += NTHR) *(u32x4*)(sCT + i * 16) = (u32x4){0u, 0u, 0u, 0u};
        for (int i = tid; i < 16 * 8; i += NTHR) {
            const int row = 32 + (i >> 3), c = i & 7;
            const unsigned v = row == 32 ? 0x3f803f80u : 0u;
            *(u32x4*)(sVT + swz128(row, c)) = (u32x4){v, v, v, v};
        }
        if (tid == 0) sSc[1] = -1e30f;
        f32x4 accC[2][3];
#pragma unroll
        for (int i = 0; i < 2; ++i)
#pragma unroll
            for (int jn = 0; jn < 3; ++jn) accC[i][jn] = (f32x4){0.f, 0.f, 0.f, 0.f};
        load_tiles(chunk_t0(0));
        __syncthreads();
        store_tiles();
        if (wave == 0) gate_scalars();
        __syncthreads();
#pragma unroll 1
        for (int ci = 0; ci < 36; ++ci) {
            const int t0 = chunk_t0(ci);
            if (ci + 1 < 36) load_tiles(chunk_t0(ci + 1));
            f32x4 sacc[4];
#pragma unroll
            for (int jt = 0; jt < 4; ++jt) sacc[jt] = (f32x4){0.f, 0.f, 0.f, 0.f};
#pragma unroll
            for (int kk = 0; kk < 4; ++kk) {
                const bf16x8 qf = ldsv8(sQ + swz256(wave * 16 + fr, kk * 4 + fq));
#pragma unroll
                for (int jt = 0; jt < 4; ++jt) sacc[jt] = mfma16(ldsv8(sK + swz256(jt * 16 + fr, kk * 4 + fq)), qf, sacc[jt]);
            }
            __syncthreads();
            {
                const int tq = wave * 16 + fr;
                const float rt = sRow[tq];
#pragma unroll
                for (int jt = 0; jt < 4; ++jt) {
                    const f32x4 cl = *(const f32x4*)(sCol + jt * 16 + fq * 4);
                    f32x4 v;
#pragma unroll
                    for (int e = 0; e < 4; ++e) {
                        const int s = jt * 16 + fq * 4 + e;
                        const bool ok = dir ? (s >= tq) : (s <= tq);
                        v[e] = ok ? sacc[jt][e] * fexp(rt + cl[e]) : 0.f;
                    }
                    u32x2 pv; pv[0] = pk2(v[0], v[1]); pv[1] = pk2(v[2], v[3]);
                    *(u32x2*)(sS + swz128(tq, jt * 2 + (fq >> 1)) + (fq & 1) * 8) = pv;
                }
            }
            __syncthreads();
            {
                f32x4 n1[3], n2[3];
#pragma unroll
                for (int jt = 0; jt < 3; ++jt) { n1[jt] = (f32x4){0.f, 0.f, 0.f, 0.f}; n2[jt] = (f32x4){0.f, 0.f, 0.f, 0.f}; }
#pragma unroll
                for (int kk = 0; kk < 2; ++kk) {
                    const bf16x8 sf = ldsv8(sS + swz128(wave * 16 + fr, kk * 4 + fq));
#pragma unroll
                    for (int jt = 0; jt < 3; ++jt) n1[jt] = mfma16(ldsv8(sVT + swz128(jt * 16 + fr, kk * 4 + fq)), sf, n1[jt]);
                }
#pragma unroll
                for (int kk = 0; kk < 4; ++kk) {
                    const bf16x8 qf = ldsv8(sQ + swz256(wave * 16 + fr, kk * 4 + fq));
#pragma unroll
                    for (int jt = 0; jt < 3; ++jt) n2[jt] = mfma16(ldsv8(sCT + swz256(jt * 16 + fr, kk * 4 + fq)), qf, n2[jt]);
                }
                const int tq = wave * 16 + fr;
                const float it = sInt[tq];
                float den = n1[2][0] + it * n2[2][0];
                den = __shfl(den, fr);
                const float dn = fmaxf(fabsf(den), sNrm[tq]);
                const float inv = rcpf_(dn);
                bf16_t* hp = HS + (size_t)dir * NTOK * D + (size_t)(t0 + tq) * D + head * 256 + sl * 32 + fq * 4;
#pragma unroll
                for (int jt = 0; jt < 2; ++jt) {
                    f32x4 v;
#pragma unroll
                    for (int e = 0; e < 4; ++e) v[e] = (n1[jt][e] + it * n2[jt][e]) * inv;
                    st_bf4(hp + jt * 16, v);
                }
            }
            {
                const float decay = sSc[0];
#pragma unroll
                for (int i = 0; i < 2; ++i)
#pragma unroll
                    for (int jn = 0; jn < 3; ++jn) accC[i][jn] *= decay;
#pragma unroll
                for (int kk = 0; kk < 2; ++kk) {
                    bf16x8 vf[3];
#pragma unroll
                    for (int jn = 0; jn < 3; ++jn) vf[jn] = ldsv8(sVT + swz128(jn * 16 + fr, kk * 4 + fq));
                    const f32x4 w0 = *(const f32x4*)(sWv + kk * 32 + fq * 8), w1 = *(const f32x4*)(sWv + kk * 32 + fq * 8 + 4);
#pragma unroll
                    for (int i = 0; i < 2; ++i) {
                        const u32x4 kr = *(const u32x4*)(sKT + swz128((wave * 2 + i) * 16 + fr, kk * 4 + fq));
                        u32x4 ks;
                        ks[0] = pk2(lof(kr[0]) * w0[0], hif(kr[0]) * w0[1]); ks[1] = pk2(lof(kr[1]) * w0[2], hif(kr[1]) * w0[3]);
                        ks[2] = pk2(lof(kr[2]) * w1[0], hif(kr[2]) * w1[1]); ks[3] = pk2(lof(kr[3]) * w1[2], hif(kr[3]) * w1[3]);
                        const bf16x8 kf = __builtin_bit_cast(bf16x8, ks);
#pragma unroll
                        for (int jn = 0; jn < 3; ++jn) accC[i][jn] = mfma16(kf, vf[jn], accC[i][jn]);
                    }
                }
            }
            __syncthreads();
#pragma unroll
            for (int i = 0; i < 2; ++i)
#pragma unroll
                for (int jn = 0; jn < 3; ++jn) {
                    const int dd = (wave * 2 + i) * 16 + fq * 4, ee = jn * 16 + fr;
                    u32x2 pv; pv[0] = pk2(accC[i][jn][0], accC[i][jn][1]); pv[1] = pk2(accC[i][jn][2], accC[i][jn][3]);
                    *(u32x2*)(sCT + swz256(ee, dd >> 3) + (dd & 7) * 2) = pv;
                }
            if (ci + 1 < 36) {
                store_tiles();
                if (wave == 0) gate_scalars();
            }
            __syncthreads();
        }
    }
}

DI void phase_ml_readout(const Args& a) {
    const int tid = threadIdx.x, lane = tid & 63, wave = tid >> 6;
    const bf16_t* H0 = (const bf16_t*)(a.ws + ML_HS); const bf16_t* H1 = H0 + (size_t)NTOK * D;
    const bf16_t* OG = (const bf16_t*)(a.ws + ML_OG); bf16_t* A2 = (bf16_t*)(a.ws + ML_A2);
    const float* on = a.in[24];
    for (int t = blockIdx.x * 4 + wave; t < NTOK; t += gridDim.x * 4) {
        const size_t off = (size_t)t * D + lane * 16;
        const u32x4 a0 = *(const u32x4*)(H0 + off), a1 = *(const u32x4*)(H0 + off + 8);
        const u32x4 b0 = *(const u32x4*)(H1 + off), b1 = *(const u32x4*)(H1 + off + 8);
        float v[16];
#pragma unroll
        for (int e = 0; e < 4; ++e) {
            v[2 * e] = lof(a0[e]) + lof(b0[e]); v[2 * e + 1] = hif(a0[e]) + hif(b0[e]);
            v[8 + 2 * e] = lof(a1[e]) + lof(b1[e]); v[8 + 2 * e + 1] = hif(a1[e]) + hif(b1[e]);
        }
        float ss = 0.f;
#pragma unroll
        for (int e = 0; e < 16; ++e) ss += v[e] * v[e];
        ss += __shfl_xor(ss, 1); ss += __shfl_xor(ss, 2); ss += __shfl_xor(ss, 4); ss += __shfl_xor(ss, 8);
        const float rs = rsqrtf(ss * (1.f / 256.f) + EPS);
        const u32x4 g0 = *(const u32x4*)(OG + off), g1 = *(const u32x4*)(OG + off + 8);
        const float* onp = on + lane * 16;
        u32x4 o0, o1;
#pragma unroll
        for (int e = 0; e < 4; ++e) {
            o0[e] = pk2(v[2 * e] * rs * onp[2 * e] * lof(g0[e]), v[2 * e + 1] * rs * onp[2 * e + 1] * hif(g0[e]));
            o1[e] = pk2(v[8 + 2 * e] * rs * onp[8 + 2 * e] * lof(g1[e]), v[8 + 2 * e + 1] * rs * onp[8 + 2 * e + 1] * hif(g1[e]));
        }
        *(u32x4*)(A2 + off) = o0; *(u32x4*)(A2 + off + 8) = o1;
    }
}

DI void phase_ml_out(const Args& a, int li) {
    gemm_dense_phase((const bf16_t*)(a.ws + ML_A2), D, NTOK, (const bf16_t*)(a.ws + W_MLOUT), 1024, 1024,
        [&](int m0, int n0, const f32x4 (&acc)[4][4]) { epi_resid_f32(a, li, m0, n0, acc); });
}

template <int STAGE>
DI void phase_moe(const Args& a, int li) {
    const int tid = threadIdx.x, lane = tid & 63, wave = tid >> 6;
    const int fr = lane & 15, fq = lane >> 4, wm = wave >> 1, wn = wave & 1;
    const int* cnt = (const int*)(a.ws + WS_CTL + CTL_CNT) + li * 64;
    const int* list = (const int*)(a.ws + WS_LIST);
    const float* wsl = (const float*)(a.ws + WS_WSLOT);
    const bf16_t* F = (const bf16_t*)(a.ws + WS_H);
    bf16_t* HM = (bf16_t*)(a.ws + WS_HMID); bf16_t* Y = (bf16_t*)(a.ws + WS_Y);
    int* pre = (int*)(lds + LDS_AUX);
    int* srowb = pre + 16;
    const int xc = blockIdx.x & 7, rank = blockIdx.x >> 3, nrank = gridDim.x >> 3;
    __syncthreads();
    if (tid == 0) { int s = 0; for (int i = 0; i < 8; ++i) { pre[i] = s; s += (cnt[xc + 8 * i] + 127) >> 7; } pre[8] = s; }
    __syncthreads();
    const int T = pre[8];
    constexpr int NTN = STAGE == 0 ? 4 : 8;
    constexpr int KK = STAGE == 0 ? 1024 : 256;
    const int total = T * NTN;
    int e = 0, r0 = 0, ce = 0, nt = 0, cur = 0;
    auto decode = [&](int u) {
        const int ti = u / NTN; nt = u % NTN;
        int ei = 0;
#pragma unroll 1
        for (int s = 4; s > 0; s >>= 1) if (pre[ei + s] <= ti) ei += s;
        e = xc + 8 * ei; r0 = (ti - pre[ei]) * 128; ce = cnt[e];
    };
    GemmPipe g;
    auto prep = [&](int buf) {
        int* srow = srowb + buf * 128;
        if (tid < 128) srow[tid] = list[(size_t)e * NTOK + min(r0 + tid, ce - 1)];
        __syncthreads();
        if (STAGE == 0) g.setup([&](int r) { return F + (size_t)(srow[r] >> 1) * D; }, (const bf16_t*)(a.ws + W_GU) + ((size_t)(li * 64 + e) * 512 + nt * 128) * 1024, 1024);
        else g.setup([&](int r) { return HM + (size_t)srow[r] * 256; }, (const bf16_t*)(a.ws + W_DN) + ((size_t)(li * 64 + e) * 1024 + nt * 128) * 256, 256);
        g.issue(0, 0);
    };
    int u = rank;
    if (u < total) { decode(u); prep(cur); }
    while (u < total) {
        f32x4 acc[4][4];
        g.run(KK, acc);
        const int cr0 = r0, cce = ce, cnt_ = nt;
        const int* srow = srowb + cur * 128;
        u += nrank;
        if (u < total) { decode(u); prep(cur ^ 1); }
        if (STAGE == 0) {
            __syncthreads();
            {
                const int tz = opaque_tid();
#pragma unroll
                for (int i = 0; i < 4; ++i) {
                    const int m = lane_m(tz, i);
#pragma unroll
                    for (int p = 0; p < 2; ++p) {
                        const int c = (((tz >> 6) & 1) * 2 + p) * 16 + ((tz >> 4) & 3) * 4;
                        f32x4 v;
#pragma unroll
                        for (int x = 0; x < 4; ++x) { const float gg = acc[i][2 * p][x]; v[x] = gg * rcpf_(1.f + fexp(-gg)) * acc[i][2 * p + 1][x]; }
                        u32x2 o; o[0] = pk2(v[0], v[1]); o[1] = pk2(v[2], v[3]);
                        *(u32x2*)(lds + EPI_OFF + m * 128 + (((c >> 3) ^ (m & 7)) << 4) + (c & 4) * 2) = o;
                    }
                }
            }
            __syncthreads();
            {
                const int tz = opaque_tid();
#pragma unroll
                for (int it = 0; it < 4; ++it) {
                    const int idx = tz + it * NTHR, row = idx >> 3, ch = idx & 7;
                    const u32x4 v = *(const u32x4*)(lds + EPI_OFF + row * 128 + ((ch ^ (row & 7)) << 4));
                    if (cr0 + row < cce) *(u32x4*)(HM + (size_t)srow[row] * 256 + cnt_ * 64 + ch * 8) = v;
                }
            }
        } else {
            float wrow[4];
            {
                const int tz = opaque_tid();
#pragma unroll
                for (int i = 0; i < 4; ++i) wrow[i] = wsl[srow[lane_m(tz, i)]];
            }
            __syncthreads();
            epi_stage_bf16(acc, [&](int i, int, const f32x4 v) { return v * wrow[i]; });
            __syncthreads();
            epi_flush_bf16([&](int row) { return Y + (size_t)srow[row] * D + cnt_ * 128; }, [&](int row) { return cr0 + row < cce; });
        }
        cur ^= 1;
    }
    __syncthreads();
}

#ifndef DBG_GPROBE
#define DBG_GPROBE -1
#endif
template <int PM>
DI void phase_gemm_probe(const Args& a) {
    const bf16_t* A = (const bf16_t*)(a.ws + WS_H); const bf16_t* Bt = (const bf16_t*)(a.ws + W_RGIN);
    float* dummy = (float*)(a.ws + RG_A2);
    const int mt = 144, nt = 16, K = 1024;
    GemmPipe g;
    __syncthreads();
    for (int u = blockIdx.x; u < mt * nt; u += gridDim.x) {
        const int m0 = (u % mt) * 128, n0 = (u / mt) * 128;
        g.setup([&](int r) { return A + (size_t)(m0 + r) * 1024; }, Bt + (size_t)n0 * K, K);
        if (PM & 1) g.issue(0, 0);
        f32x4 acc[4][4];
        g.run_probe<PM>(K, acc);
        float s = 0.f;
#pragma unroll
        for (int i = 0; i < 4; ++i)
#pragma unroll
            for (int j = 0; j < 4; ++j) s += acc[i][j][0] + acc[i][j][1] + acc[i][j][2] + acc[i][j][3];
        if (s == 12345.678f) dummy[threadIdx.x] = s;
        if (PM & 8) {
            bf16_t* Yd = (bf16_t*)(a.ws + WS_Y);
            const int lane = threadIdx.x & 63, wave = threadIdx.x >> 6;
            const int mb = m0 + (wave >> 1) * 64 + (lane & 15), nb = n0 + (wave & 1) * 64 + (lane >> 4) * 4;
#pragma unroll
            for (int i = 0; i < 4; ++i)
#pragma unroll
                for (int j = 0; j < 4; ++j) {
                    f32x4 v = acc[i][j];
                    if (PM & 16) { v[0] = gelu_tanh(v[0]); v[1] = gelu_tanh(v[1]); v[2] = gelu_tanh(v[2]); v[3] = gelu_tanh(v[3]); }
                    st_bf4(Yd + (size_t)(mb + i * 16) * 2048 + nb + j * 16, v);
                }
        }
        __syncthreads();
    }
}

#ifndef DBG_STOP
#define DBG_STOP 99
#endif
#ifndef DBG_OFF
#define DBG_OFF 0
#endif
DI void phase_dbg(const Args& a) {
    const size_t n = (size_t)NLAT * D;
    const float* X = (const float*)(a.ws + WS_X);
    const bf16_t* B = (const bf16_t*)(a.ws + (size_t)DBG_OFF);
    for (size_t i = (size_t)blockIdx.x * NTHR + threadIdx.x; i < n; i += (size_t)gridDim.x * NTHR)
        a.out[i] = DBG_OFF ? bf2f(B[i]) : X[i];
}

constexpr int NPH = 34;
__global__ void __launch_bounds__(NTHR, 2) fwd(const Args a) {
    if (threadIdx.x == 0) *(uint4*)(lds + LDS_BARW) = make_uint4(0u, 0u, 0u, 0u);
    __syncthreads();
    XcdBarrier bar;
    const bool multi = (a.ph_hi - a.ph_lo) > 1;
    if (multi) bar = xcd_barrier_post((unsigned*)(a.ws + WS_CTL), (volatile LAS unsigned*)(lds + LDS_BARW));
#ifndef DBG_REP
#define DBG_REP -1
#endif
#ifndef DBG_REPN
#define DBG_REPN 3
#endif
#define RUN(id, ...) do { if (a.ph_lo <= (id) && (id) < a.ph_hi) { \
        if ((id) == DBG_REP) { for (int rep_ = 1; rep_ < DBG_REPN; ++rep_) { __VA_ARGS__; xcd_barrier(bar); } } \
        __VA_ARGS__; if ((id) + 1 < a.ph_hi) xcd_barrier(bar); } } while (0)
    RUN(0, phase_prologue(a));
    RUN(1, phase_token_row<0>(a, 0));
    RUN(2, phase_rg_in(a, 0));
    if (DBG_GPROBE >= 0) { RUN(2, phase_gemm_probe<(DBG_GPROBE < 0 ? 7 : DBG_GPROBE)>(a)); }
#ifdef DBG_SCANVAR
    RUN(3, phase_rg_scan<DBG_SCANVAR>(a, 0));
#endif
    RUN(3, phase_rg_scan(a, 0));
    RUN(4, phase_rg_combine(a));
    RUN(5, phase_rg_out(a, 0, 0));
    RUN(6, phase_token_router(a, 0));
    RUN(7, phase_moe<0>(a, 0));
    RUN(8, phase_moe<1>(a, 0));
    RUN(9, phase_token_row<0>(a, 1));
    RUN(10, phase_mla_down(a));
    RUN(11, phase_mla_up(a));
    RUN(12, phase_mla_attn(a));
    RUN(13, phase_mla_out(a, 1));
    RUN(14, phase_token_router(a, 1));
    RUN(15, phase_moe<0>(a, 1));
    RUN(16, phase_moe<1>(a, 1));
    RUN(17, phase_token_row<0>(a, 2));
    RUN(18, phase_ml_in(a));
    RUN(19, phase_ml_scan(a));
    RUN(20, phase_ml_readout(a));
    RUN(21, phase_ml_out(a, 2));
    RUN(22, phase_token_router(a, 2));
    RUN(23, phase_moe<0>(a, 2));
    RUN(24, phase_moe<1>(a, 2));
    RUN(25, phase_token_row<0>(a, 3));
    RUN(26, phase_rg_in(a, 1));
    RUN(27, phase_rg_scan(a, 1));
    RUN(28, phase_rg_combine(a));
    RUN(29, phase_rg_out(a, 3, 1));
    RUN(30, phase_token_router(a, 3));
    RUN(31, phase_moe<0>(a, 3));
    RUN(32, phase_moe<1>(a, 3));
    RUN(33, phase_token_row<2>(a, 3));
    RUN(34, phase_dbg(a));
#undef RUN
}

static void add_td(Args& a, int& n, int& tile0, const float* src, bf16_t* dst, const float* rscale, long sb, long db, int K, int N, int Npad, int batch, int perm) {
    TDesc& t = a.td[n++];
    t.src = src; t.dst = dst; t.rscale = rscale; t.sb = sb; t.db = db; t.K = K; t.N = N; t.Npad = Npad; t.batch = batch; t.perm = perm;
    t.tiles_k = (K + 127) / 128; t.tiles_n = (Npad + 63) / 64; t.tile0 = tile0;
    tile0 += batch * t.tiles_k * t.tiles_n;
}

extern "C" void kernel_launch(void* const* d_in, const int* in_sizes, int n_in, void* d_out, int out_size, void* d_ws, size_t ws_size, hipStream_t stream) {
    static int grid = 0;
    if (grid == 0) {
        if (n_in != 32 || out_size != NLAT * D || ws_size < WS_END) { fprintf(stderr, "kernel_launch: unexpected sizes (n_in %d out %d ws %zu need %zu)\n", n_in, out_size, ws_size, (size_t)WS_END); grid = -1; return; }
        int dev = 0, cus = 0, per_cu = 0;
        (void)hipGetDevice(&dev);
        (void)hipDeviceGetAttribute(&cus, hipDeviceAttributeMultiprocessorCount, dev);
        if (hipOccupancyMaxActiveBlocksPerMultiprocessor(&per_cu, (const void*)fwd, NTHR, 0) != hipSuccess) per_cu = 0;
        (void)hipGetLastError();
        if (per_cu < 2) fprintf(stderr, "kernel_launch: note: occupancy query reports %d blocks per CU (need 2)\n", per_cu);
        grid = cus * (per_cu >= 2 ? 2 : (per_cu >= 1 ? 1 : 2));
    }
    if (grid < 0) return;
    (void)in_sizes;
    (void)hipMemsetAsync((char*)d_ws + WS_CTL, 0, CTL_BYTES, stream);
    Args a;
    memset(&a, 0, sizeof(a));
    for (int i = 0; i < 32; ++i) a.in[i] = (const float*)d_in[i];
    a.out = (float*)d_out; a.ws = (unsigned char*)d_ws;
    unsigned char* ws = (unsigned char*)d_ws;
    int n = 0, tile0 = 0;
    add_td(a, n, tile0, a.in[8], (bf16_t*)(ws + W_RGIN), nullptr, 1024L * 2048, 2048L * 1024, 1024, 2048, 2048, 2, 0);
    add_td(a, n, tile0, a.in[14], (bf16_t*)(ws + W_RGOUT), nullptr, 1024L * 1024, 1024L * 1024, 1024, 1024, 1024, 2, 0);
    for (int j = 0; j < 2; ++j) for (int dir = 0; dir < 2; ++dir) for (int g = 0; g < 2; ++g)
        add_td(a, n, tile0, a.in[11] + (size_t)((j * 2 + dir) * 2 + g) * 16 * 4096, (bf16_t*)(ws + W_RGG) + (size_t)(j * 2 + dir) * 16 * 8192 + g * 4096, nullptr, 4096, 8192, 64, 64, 64, 16, 0);
    add_td(a, n, tile0, a.in[15], (bf16_t*)(ws + W_MDOWN), nullptr, 0, 0, 1024, 416, 512, 1, 0);
    add_td(a, n, tile0, a.in[18], (bf16_t*)(ws + W_MUQ), a.in[16], 0, 0, 256, 1536, 1536, 1, 0);
    add_td(a, n, tile0, a.in[19], (bf16_t*)(ws + W_MUKV), a.in[17], 0, 0, 128, 2048, 2048, 1, 0);
    add_td(a, n, tile0, a.in[21], (bf16_t*)(ws + W_MO), nullptr, 0, 0, 1024, 1024, 1024, 1, 0);
    add_td(a, n, tile0, a.in[22], (bf16_t*)(ws + W_MLIN), nullptr, 0, 0, 1024, 3088, 3200, 1, 0);
    add_td(a, n, tile0, a.in[25], (bf16_t*)(ws + W_MLOUT), nullptr, 0, 0, 1024, 1024, 1024, 1, 0);
    add_td(a, n, tile0, a.in[30], (bf16_t*)(ws + W_GU), nullptr, 1024L * 512, 512L * 1024, 1024, 512, 512, 64, 1);
    add_td(a, n, tile0, a.in[31], (bf16_t*)(ws + W_DN), nullptr, 256L * 1024, 1024L * 256, 256, 1024, 1024, 64, 0);
    a.ntiles_total = tile0;
    if (n != NTD) { fprintf(stderr, "kernel_launch: descriptor count %d != %d\n", n, NTD); return; }
#if MK_ONE_LAUNCH
    a.ph_lo = 0; a.ph_hi = NPH;
    hipLaunchKernelGGL(fwd, dim3(grid), dim3(NTHR), 0, stream, a);
#else
    for (int ph = 0; ph < NPH && ph <= DBG_STOP; ++ph) {
        a.ph_lo = ph; a.ph_hi = ph + 1;
        hipLaunchKernelGGL(fwd, dim3(grid), dim3(NTHR), 0, stream, a);
    }
    if (DBG_STOP < NPH) { a.ph_lo = 34; a.ph_hi = 35; hipLaunchKernelGGL(fwd, dim3(grid), dim3(NTHR), 0, stream, a); }
#endif
}
```

```cpp
#include <hip/hip_runtime.h>
#include <stdint.h>
#include <string.h>
#include <stdio.h>

#ifndef MK_ONE_LAUNCH
#define MK_ONE_LAUNCH 1
#endif

#define DI __device__ __forceinline__
typedef unsigned short bf16_t;
typedef __attribute__((ext_vector_type(8))) short bf16x8;
typedef __attribute__((ext_vector_type(4))) float f32x4;
typedef __attribute__((ext_vector_type(16))) float f32x16;
typedef __attribute__((ext_vector_type(2))) float f32x2;
typedef __attribute__((ext_vector_type(2))) __bf16 bfx2;
typedef __attribute__((ext_vector_type(4))) unsigned u32x4;
typedef __attribute__((ext_vector_type(2))) unsigned u32x2;

constexpr int D = 1024, NB = 8, SEQ = 2048, CTXL = 256;
constexpr int NLAT = NB * SEQ, NCTX = NB * CTXL, NTOK = NLAT + NCTX;
constexpr int NKEY = CTXL + SEQ;
constexpr int NTHR = 256;
constexpr int LDS_BYTES = 73728;
constexpr int LDS_AUX = 65536;
constexpr int LDS_BARW = LDS_BYTES - 16;
constexpr float EPS = 1e-6f;

constexpr size_t al256(size_t x) { return (x + 255) & ~(size_t)255; }
constexpr size_t WS_CTL = 0;
constexpr size_t CTL_BYTES = 65536;
constexpr size_t CTL_CNT = 16384;
constexpr size_t CTL_ROPE = 32768;
constexpr size_t WS_MOD = WS_CTL + CTL_BYTES;
constexpr size_t WS_X = al256(WS_MOD + 4 * 9 * 6144 * 4);
constexpr size_t WS_H = al256(WS_X + (size_t)NTOK * D * 4);
constexpr size_t WS_SCR = al256(WS_H + (size_t)NTOK * D * 2);
constexpr size_t SCR_BYTES = (size_t)256 << 20;
constexpr size_t TOKD2 = (size_t)NTOK * D * 2;
constexpr size_t RG_G = WS_SCR, RG_U = RG_G + TOKD2, RG_HS = RG_U + TOKD2, RG_A2 = RG_HS + 2 * TOKD2;
constexpr size_t MLA_CQ = WS_SCR;
constexpr size_t MLA_CKV = MLA_CQ + (size_t)NTOK * 256 * 2;
constexpr size_t MLA_KR = MLA_CKV + (size_t)NTOK * 128 * 2;
constexpr size_t MLA_Q = MLA_KR + (size_t)NTOK * 32 * 4;
constexpr size_t MLA_K = MLA_Q + (size_t)NTOK * 1536 * 2;
constexpr size_t MLA_VT = MLA_K + (size_t)NB * 16 * NKEY * 96 * 2;
constexpr size_t MLA_O = MLA_VT + (size_t)NB * 16 * 64 * NKEY * 2;
constexpr size_t MLA_END = MLA_O + TOKD2;
constexpr size_t ML_Q = WS_SCR;
constexpr size_t ML_K = ML_Q + (size_t)NTOK * 512 * 2;
constexpr size_t ML_KT = ML_K + (size_t)NTOK * 512 * 2;
constexpr size_t ML_VT = ML_KT + (size_t)NTOK * 512 * 2;
constexpr size_t ML_OG = ML_VT + TOKD2;
constexpr size_t ML_GT = ML_OG + TOKD2;
constexpr size_t ML_HS = ML_GT + (size_t)NTOK * 16 * 4;
constexpr size_t ML_A2 = ML_HS + 2 * TOKD2;
constexpr size_t ML_END = ML_A2 + TOKD2;
static_assert(RG_A2 + TOKD2 <= WS_SCR + SCR_BYTES && MLA_END <= WS_SCR + SCR_BYTES && ML_END <= WS_SCR + SCR_BYTES, "scratch");
constexpr size_t WS_LIST = WS_SCR + SCR_BYTES;
constexpr size_t WS_WSLOT = al256(WS_LIST + (size_t)64 * NTOK * 4);
constexpr size_t WS_HMID = al256(WS_WSLOT + (size_t)2 * NTOK * 4);
constexpr size_t WS_Y = al256(WS_HMID + (size_t)2 * NTOK * 256 * 2);
constexpr size_t WS_W = al256(WS_Y + (size_t)2 * NTOK * D * 2);
constexpr size_t W_RGIN = WS_W;
constexpr size_t W_RGOUT = W_RGIN + (size_t)2 * 2048 * 1024 * 2;
constexpr size_t W_RGG = W_RGOUT + (size_t)2 * 1024 * 1024 * 2;
constexpr size_t W_MDOWN = W_RGG + (size_t)2 * 2 * 16 * 128 * 64 * 2;
constexpr size_t W_MUQ = W_MDOWN + (size_t)512 * 1024 * 2;
constexpr size_t W_MUKV = W_MUQ + (size_t)1536 * 256 * 2;
constexpr size_t W_MO = W_MUKV + (size_t)2048 * 128 * 2;
constexpr size_t W_MLIN = W_MO + (size_t)1024 * 1024 * 2;
constexpr size_t W_MLOUT = W_MLIN + (size_t)3200 * 1024 * 2;
constexpr size_t W_RT = W_MLOUT + (size_t)1024 * 1024 * 2;
constexpr size_t W_GU = al256(W_RT + (size_t)4 * 2 * 80 * 1024 * 2);
constexpr size_t W_DN = W_GU + (size_t)256 * 512 * 1024 * 2;
constexpr size_t WS_END = W_DN + (size_t)256 * 1024 * 256 * 2;

struct TDesc {
    const float* src; bf16_t* dst; const float* rscale;
    long sb, db;
    int K, N, Npad, batch;
    int perm, tiles_k, tiles_n, tile0;
};
constexpr int NTD = 18;
struct Args {
    const float* in[32];
    float* out;
    unsigned char* ws;
    TDesc td[NTD];
    int ntiles_total, ph_lo, ph_hi, pad0;
};

DI float bf2f(bf16_t v) { return __uint_as_float((unsigned)v << 16); }
DI unsigned pk2(float a, float b) { f32x2 v = {a, b}; bfx2 r = __builtin_convertvector(v, bfx2); return __builtin_bit_cast(unsigned, r); }
DI bf16_t f2bf(float a) { return (bf16_t)(pk2(a, 0.f) & 0xffffu); }
DI float lof(unsigned u) { return __uint_as_float(u << 16); }
DI float hif(unsigned u) { return __uint_as_float(u & 0xffff0000u); }
DI float rcpf_(float x) { return __builtin_amdgcn_rcpf(x); }
DI float fexp(float x) { return __builtin_amdgcn_exp2f(x * 1.4426950408889634f); }
DI float sigmoidf_(float x) { return rcpf_(1.f + fexp(-x)); }
DI float gelu_tanh(float x) { float u = 0.7978845608028654f * (x + 0.044715f * x * x * x); float e = fexp(2.f * u); return x * (1.f - rcpf_(e + 1.f)); }
DI int tok_modrow(int t) { return t < NLAT ? (t >> 11) : 8; }
DI void dma16(const void* g, char* l) { __builtin_amdgcn_global_load_lds((const unsigned*)g, (unsigned*)l, 16, 0, 0); }
DI void wait_vm0() { asm volatile("s_waitcnt vmcnt(0)" ::: "memory"); }
DI int swz128(int row, int chunk) { return row * 128 + ((chunk ^ (row & 7)) << 4); }
DI int swz256(int row, int chunk) { return row * 256 + ((chunk ^ (row & 15)) << 4); }
DI f32x4 mfma16(bf16x8 a, bf16x8 b, f32x4 c) { return __builtin_amdgcn_mfma_f32_16x16x32_bf16(a, b, c, 0, 0, 0); }
DI f32x16 mfma32(bf16x8 a, bf16x8 b, f32x16 c) { return __builtin_amdgcn_mfma_f32_32x32x16_bf16(a, b, c, 0, 0, 0); }
DI bf16x8 ldsv8(const char* p) { return *(const bf16x8*)p; }
DI void st_bf4(bf16_t* p, const f32x4 v) { u32x2 o; o[0] = pk2(v[0], v[1]); o[1] = pk2(v[2], v[3]); *(u32x2*)p = o; }

__shared__ __attribute__((aligned(16))) char lds[LDS_BYTES];

#define XB_TMO      128
#define XB_XCNT(j)  (256  + 64 * (j))
#define XB_XSUB(j)  (1280 + 64 * (j))
#define XB_XGEN(j)  (2304 + 64 * (j))
#define XB_TOP      3328
#define XB_TOPGEN   3392
#define XCD_BAR_WORDS 3456
#define XB_SPIN_CAP (1u << 22)
#define LAS __attribute__((address_space(3)))
DI unsigned xb_ld(unsigned* p)              { return __hip_atomic_load(p, __ATOMIC_RELAXED, __HIP_MEMORY_SCOPE_AGENT); }
DI unsigned xb_add(unsigned* p, unsigned v) { return __hip_atomic_fetch_add(p, v, __ATOMIC_RELAXED, __HIP_MEMORY_SCOPE_AGENT); }
DI unsigned xb_xcc_id() { return (unsigned)__builtin_amdgcn_s_getreg((3 << 11) | 20) & 0xFu; }
#define XB_SPIN(cond, bar) do { unsigned _sp = 0; while (cond) { __builtin_amdgcn_s_sleep(1); \
    if ((++_sp & 255u) == 0u) { if (xb_ld(&(bar)[XB_TMO])) break; if (_sp > XB_SPIN_CAP) { atomicAdd(&(bar)[XB_TMO], 1u); break; } } } } while (0)
struct XcdBarrier { unsigned* bar; unsigned x; volatile LAS unsigned* st; };
DI XcdBarrier xcd_barrier_post(unsigned* bar, volatile LAS unsigned* st) {
    XcdBarrier b; b.bar = bar; b.x = xb_xcc_id(); b.st = st;
    if (threadIdx.x == 0) (void)xb_add(&bar[XB_XCNT(b.x)], 1u);
    return b;
}
DI void xcd_barrier_complete(unsigned* bar, unsigned x, unsigned& nloc, unsigned& nx) {
    const unsigned G = gridDim.x * gridDim.y * gridDim.z;
    unsigned sum, cnt, mine, sp = 0u;
    for (;;) {
        sum = 0u; cnt = 0u; mine = 0u;
#pragma unroll
        for (unsigned j = 0; j < 16; ++j) { const unsigned c = xb_ld(&bar[XB_XCNT(j)]); sum += c; cnt += (c > 0u) ? 1u : 0u; mine = (j == x) ? c : mine; }
        if (sum == G) break;
        __builtin_amdgcn_s_sleep(1);
        if ((++sp & 255u) == 0u) { if (xb_ld(&bar[XB_TMO])) break; if (sp > XB_SPIN_CAP) { atomicAdd(&bar[XB_TMO], 1u); break; } }
    }
    nloc = mine > 0u ? mine : 1u; nx = cnt > 0u ? cnt : 1u;
}
DI void xcd_barrier(const XcdBarrier& b) {
    asm volatile("s_waitcnt vmcnt(0)" ::: "memory");
    __syncthreads();
    if (threadIdx.x == 0) {
        unsigned* bar = b.bar;
        __builtin_amdgcn_s_waitcnt(0);
        unsigned nloc = b.st[0], nx = b.st[1];
        if (nloc == 0u) { xcd_barrier_complete(bar, b.x, nloc, nx); b.st[0] = nloc; b.st[1] = nx; }
        const unsigned old = xb_add(&bar[XB_XSUB(b.x)], 1u);
        const unsigned gen = old / nloc;
        if (old + 1u == (gen + 1u) * nloc) {
            __builtin_amdgcn_fence(__ATOMIC_RELEASE, "agent");
            asm volatile("s_waitcnt vmcnt(0)" ::: "memory");
            const unsigned og = xb_add(&bar[XB_TOP], 1u);
            const unsigned tg = og / nx;
            if (og + 1u == (tg + 1u) * nx) xb_add(&bar[XB_TOPGEN], 1u);
            else XB_SPIN(xb_ld(&bar[XB_TOPGEN]) == tg, bar);
            __builtin_amdgcn_fence(__ATOMIC_ACQUIRE, "agent");
            xb_add(&bar[XB_XGEN(b.x)], 1u);
            asm volatile("s_waitcnt vmcnt(0)" ::: "memory");
        } else {
            XB_SPIN(xb_ld(&bar[XB_XGEN(b.x)]) == gen, bar);
            __builtin_amdgcn_fence(__ATOMIC_ACQUIRE, "agent");
            asm volatile("s_waitcnt vmcnt(0)" ::: "memory");
        }
    }
    __syncthreads();
}

struct CvTile { const float* src; bf16_t* dst; int K, N, perm, k0, n0; };
DI CvTile moe_cv_tile(const Args& a, const int L, const int t) {
    CvTile c;
    const int e = t / 96, r = t - e * 96;
    if (r < 64) {
        c.src = a.in[30] + (size_t)(L * 64 + e) * 1024 * 512; c.dst = (bf16_t*)(a.ws + W_GU) + (size_t)(L * 64 + e) * 512 * 1024;
        c.K = 1024; c.N = 512; c.perm = 1; c.k0 = (r & 7) * 128; c.n0 = (r >> 3) * 64;
    } else {
        const int r2 = r - 64;
        c.src = a.in[31] + (size_t)(L * 64 + e) * 256 * 1024; c.dst = (bf16_t*)(a.ws + W_DN) + (size_t)(L * 64 + e) * 1024 * 256;
        c.K = 256; c.N = 1024; c.perm = 0; c.k0 = (r2 & 1) * 128; c.n0 = (r2 >> 1) * 64;
    }
    return c;
}
DI void cv_load(const CvTile& c, f32x4 (&L0)[4], f32x4 (&L1)[4]) {
    const int tid = threadIdx.x, c4 = tid & 15, kr = tid >> 4;
    const float* p = c.src + (size_t)(c.k0 + 2 * kr) * c.N + c.n0 + 4 * c4;
#pragma unroll
    for (int i = 0; i < 4; ++i) { L0[i] = *(const f32x4*)(p + (size_t)(32 * i) * c.N); L1[i] = *(const f32x4*)(p + (size_t)(32 * i + 1) * c.N); }
}
DI void cv_pack(unsigned* st, const f32x4 (&L0)[4], const f32x4 (&L1)[4]) {
    const int tid = threadIdx.x, c4 = tid & 15, kr = tid >> 4;
#pragma unroll
    for (int i = 0; i < 4; ++i)
#pragma unroll
        for (int j = 0; j < 4; ++j) st[(4 * c4 + j) * 68 + 16 * i + kr] = pk2(L0[i][j], L1[i][j]);
}
DI void cv_flush(const CvTile& c, const unsigned* st) {
    const int tid = threadIdx.x;
#pragma unroll
    for (int i = 0; i < 4; ++i) {
        const int id = tid + i * 256, n = id >> 4, kc = id & 15;
        const u32x4 o = *(const u32x4*)(st + n * 68 + kc * 4);
        int nd = c.n0 + n;
        if (c.perm) { const int cc = nd & 255, up = nd >> 8; nd = ((cc >> 4) << 5) + (up << 4) + (cc & 15); }
        *(u32x4*)(c.dst + (size_t)nd * c.K + c.k0 + kc * 8) = o;
    }
}

DI void phase_prologue(const Args& a) {
    const int tid = threadIdx.x;
    const int n_ada = 384, n_rt = 4;
    const int total = n_ada + n_rt;
    float* sc = (float*)lds;
    for (int u = blockIdx.x; u < total; u += gridDim.x) {
        __syncthreads();
        if (u < n_ada) {
            const float* c = a.in[1]; const float* cc = a.in[3];
            for (int i = tid; i < 9 * 1024; i += NTHR) {
                float v = i < 8192 ? c[i] : cc[i - 8192];
                sc[i] = v / (1.f + __expf(-v));
            }
            __syncthreads();
            const int n = u * 64 + (tid & 63), li = n / 6144, nn = n - li * 6144, kq = tid >> 6;
            const float* wp = a.in[4] + (size_t)li * 1024 * 6144 + (size_t)(kq * 256) * 6144 + nn;
            float acc[9];
#pragma unroll
            for (int r = 0; r < 9; ++r) acc[r] = 0.f;
#pragma unroll 1
            for (int k0 = kq * 256; k0 < kq * 256 + 256; k0 += 16) {
                float wv[16];
#pragma unroll
                for (int kk = 0; kk < 16; ++kk) { wv[kk] = *wp; wp += 6144; }
#pragma unroll
                for (int kk = 0; kk < 16; kk += 4)
#pragma unroll
                    for (int r = 0; r < 9; ++r) {
                        const f32x4 s4 = *(const f32x4*)(sc + r * 1024 + k0 + kk);
                        acc[r] += s4[0] * wv[kk] + s4[1] * wv[kk + 1] + s4[2] * wv[kk + 2] + s4[3] * wv[kk + 3];
                    }
            }
            float* part = sc + 9 * 1024;
#pragma unroll
            for (int r = 0; r < 9; ++r) part[(kq * 9 + r) * 64 + (tid & 63)] = acc[r];
            __syncthreads();
            for (int i = tid; i < 9 * 64; i += NTHR) {
                const int r = i >> 6, cidx = i & 63;
                const int n2 = u * 64 + cidx, l2 = n2 / 6144, nn2 = n2 - l2 * 6144;
                const float v = ((part[(0 * 9 + r) * 64 + cidx] + part[(1 * 9 + r) * 64 + cidx]) + part[(2 * 9 + r) * 64 + cidx]) + part[(3 * 9 + r) * 64 + cidx];
                ((float*)(a.ws + WS_MOD))[((size_t)l2 * 9 + r) * 6144 + nn2] = v + a.in[5][l2 * 6144 + nn2];
            }
        } else if (u < n_ada + n_rt) {
            const int li = u - n_ada;
            bf16_t* rt = (bf16_t*)(a.ws + W_RT) + (size_t)li * 2 * 80 * 1024;
            const float* wg = a.in[26] + (size_t)li * 1024 * 8;
            const float* we = a.in[28] + (size_t)li * 1024 * 64;
            if (li == 0) {
                float* rt_ = (float*)(a.ws + WS_CTL + CTL_ROPE);
                for (int i = tid; i < 512; i += NTHR) {
                    const int pos = i >> 3, fi = i & 7;
                    const float ang = (float)pos * powf(10000.f, -(float)fi * 0.125f);
                    rt_[i] = cosf(ang); rt_[512 + i] = sinf(ang);
                }
            }
            for (int i = tid; i < 80 * 1024; i += NTHR) {
                const int n = i >> 10, k = i & 1023;
                float v = n < 8 ? wg[k * 8 + n] : (n < 72 ? we[k * 64 + (n - 8)] : 0.f);
                const bf16_t h = f2bf(v);
                rt[i] = h;
                rt[80 * 1024 + i] = f2bf(v - bf2f(h));
            }
        }
    }
    struct PTile { const float* src; bf16_t* dst; const float* rscale; int K, N, Npad, perm, k0, n0; };
    auto decode = [&](int tix) {
        int di = 0;
#pragma unroll 1
        for (int i = 1; i < NTD; ++i) if (tix >= a.td[i].tile0) di = i;
        const TDesc& td = a.td[di];
        int rem = tix - td.tile0;
        const int per = td.tiles_k * td.tiles_n;
        const int bi = rem / per; rem -= bi * per;
        PTile p;
        p.src = td.src + (size_t)bi * td.sb; p.dst = td.dst + (size_t)bi * td.db; p.rscale = td.rscale;
        p.K = td.K; p.N = td.N; p.Npad = td.Npad; p.perm = td.perm;
        p.n0 = (rem % td.tiles_n) * 64; p.k0 = (rem / td.tiles_n) * 128;
        return p;
    };
    auto pload = [&](const PTile& p, f32x4 (&L0)[4], f32x4 (&L1)[4]) {
        const int c4 = tid & 15, kr = tid >> 4;
        const bool nok = p.n0 + 4 * c4 < p.N;
#pragma unroll
        for (int i = 0; i < 4; ++i) {
            const int k = p.k0 + 32 * i + 2 * kr;
            L0[i] = (f32x4){0.f, 0.f, 0.f, 0.f}; L1[i] = L0[i];
            if (nok && k < p.K) {
                L0[i] = *(const f32x4*)(p.src + (size_t)k * p.N + p.n0 + 4 * c4);
                L1[i] = *(const f32x4*)(p.src + (size_t)(k + 1) * p.N + p.n0 + 4 * c4);
                if (p.rscale) { L0[i] *= p.rscale[k]; L1[i] *= p.rscale[k + 1]; }
            }
        }
    };
    auto pflush = [&](const PTile& p, const unsigned* st) {
#pragma unroll
        for (int i = 0; i < 4; ++i) {
            const int id = tid + i * 256, n = id >> 4, kc = id & 15;
            const u32x4 o = *(const u32x4*)(st + n * 68 + kc * 4);
            int nd = p.n0 + n;
            if (nd < p.Npad && p.k0 + kc * 8 < p.K) {
                if (p.perm) { const int c = nd & 255, up = nd >> 8; nd = ((c >> 4) << 5) + (up << 4) + (c & 15); }
                *(u32x4*)(p.dst + (size_t)nd * p.K + p.k0 + kc * 8) = o;
            }
        }
    };
    {
        unsigned* st0 = (unsigned*)lds; unsigned* st1 = st0 + 64 * 68;
        const int nt_ = a.ntiles_total, G = gridDim.x;
        int t0 = blockIdx.x, t1 = blockIdx.x + G;
        PTile p0 = decode(0), p1 = p0;
        f32x4 A0[4], A1[4], B0[4], B1[4];
        __syncthreads();
        if (t0 < nt_) { p0 = decode(t0); pload(p0, A0, A1); }
        if (t1 < nt_) { p1 = decode(t1); pload(p1, B0, B1); }
        while (t0 < nt_) {
            PTile q0 = p0, q1 = p1;
            const bool v1 = t1 < nt_;
            cv_pack(st0, A0, A1);
            if (t0 + 2 * G < nt_) { p0 = decode(t0 + 2 * G); pload(p0, A0, A1); }
            if (v1) {
                cv_pack(st1, B0, B1);
                if (t1 + 2 * G < nt_) { p1 = decode(t1 + 2 * G); pload(p1, B0, B1); }
            }
            __syncthreads();
            pflush(q0, st0);
            if (v1) pflush(q1, st1);
            __syncthreads();
            t0 += 2 * G; t1 += 2 * G;
        }
    }
}

template <int MODE>
DI void phase_token(const Args& a, const int li) {
    const int tid = threadIdx.x, lane = tid & 63, wave = tid >> 6;
    const int r = lane & 15, q = lane >> 4;
    float* X = (float*)(a.ws + WS_X);
    bf16_t* H = (bf16_t*)(a.ws + WS_H);
    const bf16_t* Y = (const bf16_t*)(a.ws + WS_Y);
    const float* MOD = (const float*)(a.ws + WS_MOD);
    const bool combine = (MODE == 0 && li > 0) || MODE == 2;
    const int ngroups = (MODE == 2 || (MODE == 1 && li == 3)) ? NLAT / 16 : NTOK / 16;
    float* lg = (float*)(lds + wave * 16 * 80 * 4);
    for (int g = blockIdx.x * 4 + wave; g < ngroups; g += gridDim.x * 4) {
        const int t = g * 16 + r;
        const int mr = tok_modrow(g * 16);
        const float* xsrc = (MODE == 0 && li == 0) ? (t < NLAT ? a.in[0] + (size_t)t * D : a.in[2] + (size_t)(t - NLAT) * D) : X + (size_t)t * D;
        const bf16_t* y0 = Y + (size_t)(2 * t) * D;
        const bf16_t* y1 = y0 + D;
        const int lprev = MODE == 2 ? 3 : li - 1;
        const float* g5 = MOD + ((size_t)(lprev < 0 ? 0 : lprev) * 9 + mr) * 6144 + 5 * 1024;
        float ss = 0.f;
        if (MODE != 2) {
#pragma unroll 4
            for (int kk = 0; kk < 32; ++kk) {
                const int k = kk * 32 + q * 8;
                f32x4 x0 = *(const f32x4*)(xsrc + k), x1 = *(const f32x4*)(xsrc + k + 4);
                if (combine) {
                    const u32x4 ya = *(const u32x4*)(y0 + k), yb = *(const u32x4*)(y1 + k);
                    const f32x4 ga = *(const f32x4*)(g5 + k), gb = *(const f32x4*)(g5 + k + 4);
                    x0[0] += ga[0] * (lof(ya[0]) + lof(yb[0])); x0[1] += ga[1] * (hif(ya[0]) + hif(yb[0]));
                    x0[2] += ga[2] * (lof(ya[1]) + lof(yb[1])); x0[3] += ga[3] * (hif(ya[1]) + hif(yb[1]));
                    x1[0] += gb[0] * (lof(ya[2]) + lof(yb[2])); x1[1] += gb[1] * (hif(ya[2]) + hif(yb[2]));
                    x1[2] += gb[2] * (lof(ya[3]) + lof(yb[3])); x1[3] += gb[3] * (hif(ya[3]) + hif(yb[3]));
                }
#pragma unroll
                for (int j = 0; j < 4; ++j) ss += x0[j] * x0[j] + x1[j] * x1[j];
            }
            ss += __shfl_xor(ss, 16); ss += __shfl_xor(ss, 32);
        }
        const float rstd = rsqrtf(ss * (1.f / 1024.f) + EPS);
        const float* gn = (MODE == 1 ? a.in[7] : a.in[6]) + (size_t)li * D;
        const float* mscale = MOD + ((size_t)li * 9 + mr) * 6144 + (MODE == 1 ? 4 : 1) * 1024;
        const float* mshift = MOD + ((size_t)li * 9 + mr) * 6144 + (MODE == 1 ? 3 : 0) * 1024;
        const bf16_t* rwh = (const bf16_t*)(a.ws + W_RT) + (size_t)li * 2 * 80 * 1024 + (size_t)r * 1024 + q * 8;
        f32x4 lacc[5];
#pragma unroll
        for (int i = 0; i < 5; ++i) lacc[i] = (f32x4){0.f, 0.f, 0.f, 0.f};
#pragma unroll 2
        for (int kk = 0; kk < 32; ++kk) {
            const int k = kk * 32 + q * 8;
            f32x4 x0 = *(const f32x4*)(xsrc + k), x1 = *(const f32x4*)(xsrc + k + 4);
            if (combine) {
                const u32x4 ya = *(const u32x4*)(y0 + k), yb = *(const u32x4*)(y1 + k);
                const f32x4 ga = *(const f32x4*)(g5 + k), gb = *(const f32x4*)(g5 + k + 4);
                x0[0] += ga[0] * (lof(ya[0]) + lof(yb[0])); x0[1] += ga[1] * (hif(ya[0]) + hif(yb[0]));
                x0[2] += ga[2] * (lof(ya[1]) + lof(yb[1])); x0[3] += ga[3] * (hif(ya[1]) + hif(yb[1]));
                x1[0] += gb[0] * (lof(ya[2]) + lof(yb[2])); x1[1] += gb[1] * (hif(ya[2]) + hif(yb[2]));
                x1[2] += gb[2] * (lof(ya[3]) + lof(yb[3])); x1[3] += gb[3] * (hif(ya[3]) + hif(yb[3]));
            }
            if (MODE == 2) {
                *(f32x4*)(a.out + (size_t)t * D + k) = x0; *(f32x4*)(a.out + (size_t)t * D + k + 4) = x1;
                continue;
            }
            if (MODE == 0 && (li == 0 || combine)) { *(f32x4*)(X + (size_t)t * D + k) = x0; *(f32x4*)(X + (size_t)t * D + k + 4) = x1; }
            const f32x4 n0 = *(const f32x4*)(gn + k), n1 = *(const f32x4*)(gn + k + 4);
            const f32x4 s0 = *(const f32x4*)(mscale + k), s1 = *(const f32x4*)(mscale + k + 4);
            const f32x4 h0 = *(const f32x4*)(mshift + k), h1 = *(const f32x4*)(mshift + k + 4);
            float f[8];
#pragma unroll
            for (int j = 0; j < 4; ++j) {
                f[j] = x0[j] * rstd * n0[j] * (1.f + s0[j]) + h0[j];
                f[4 + j] = x1[j] * rstd * n1[j] * (1.f + s1[j]) + h1[j];
            }
            u32x4 hv;
            hv[0] = pk2(f[0], f[1]); hv[1] = pk2(f[2], f[3]); hv[2] = pk2(f[4], f[5]); hv[3] = pk2(f[6], f[7]);
            *(u32x4*)(H + (size_t)t * D + k) = hv;
            if (MODE == 1) {
                u32x4 lv;
                lv[0] = pk2(f[0] - lof(hv[0]), f[1] - hif(hv[0])); lv[1] = pk2(f[2] - lof(hv[1]), f[3] - hif(hv[1]));
                lv[2] = pk2(f[4] - lof(hv[2]), f[5] - hif(hv[2])); lv[3] = pk2(f[6] - lof(hv[3]), f[7] - hif(hv[3]));
                const bf16x8 fh = __builtin_bit_cast(bf16x8, hv), fl = __builtin_bit_cast(bf16x8, lv);
#pragma unroll
                for (int nt = 0; nt < 5; ++nt) {
                    const bf16x8 wh = *(const bf16x8*)(rwh + (size_t)nt * 16 * 1024 + kk * 32);
                    const bf16x8 wl = *(const bf16x8*)(rwh + (size_t)(80 + nt * 16) * 1024 + kk * 32);
                    lacc[nt] = mfma16(fh, wh, lacc[nt]);
                    lacc[nt] = mfma16(fh, wl, lacc[nt]);
                    lacc[nt] = mfma16(fl, wh, lacc[nt]);
                }
            }
        }
        if (MODE == 1) {
#pragma unroll
            for (int nt = 0; nt < 5; ++nt)
#pragma unroll
                for (int j = 0; j < 4; ++j) lg[(q * 4 + j) * 80 + nt * 16 + r] = lacc[nt][j];
            asm volatile("s_waitcnt lgkmcnt(0)" ::: "memory");
            __builtin_amdgcn_wave_barrier();
            if (lane < 16) {
                const float* L = lg + lane * 80;
                const float* bg = a.in[27] + li * 8;
                const float* be = a.in[29] + li * 64;
                float gmax = -3.0e38f; int gi = 0; float gl[8];
#pragma unroll
                for (int j = 0; j < 8; ++j) { gl[j] = L[j] + bg[j]; if (gl[j] > gmax) { gmax = gl[j]; gi = j; } }
                float ps = 0.f;
#pragma unroll
                for (int j = 0; j < 8; ++j) ps += __expf(gl[j] - gmax);
                const float ptop = 1.f / ps;
                float e1 = -3.0e38f, e2 = -3.0e38f; int i1 = 0, i2 = 0;
#pragma unroll
                for (int j = 0; j < 8; ++j) {
                    const float v = L[8 + gi * 8 + j] + be[gi * 8 + j];
                    if (v > e1) { e2 = e1; i2 = i1; e1 = v; i1 = j; } else if (v > e2) { e2 = v; i2 = j; }
                }
                const float ex = __expf(e2 - e1);
                const float w1 = ptop / (1.f + ex), w2 = ptop * ex / (1.f + ex);
                const int tt = g * 16 + lane;
                int* cnt = (int*)(a.ws + WS_CTL + CTL_CNT) + li * 64;
                int* list = (int*)(a.ws + WS_LIST);
                float* wsl = (float*)(a.ws + WS_WSLOT);
                const int ea = gi * 8 + i1, eb = gi * 8 + i2;
                const int pa = atomicAdd(&cnt[ea], 1); list[(size_t)ea * NTOK + pa] = 2 * tt; wsl[2 * tt] = w1;
                const int pb = atomicAdd(&cnt[eb], 1); list[(size_t)eb * NTOK + pb] = 2 * tt + 1; wsl[2 * tt + 1] = w2;
            }
            __builtin_amdgcn_wave_barrier();
        }
    }
}

DI float wave_sum(float v) {
    v += __shfl_xor(v, 1); v += __shfl_xor(v, 2); v += __shfl_xor(v, 4); v += __shfl_xor(v, 8); v += __shfl_xor(v, 16); v += __shfl_xor(v, 32);
    return v;
}
template <int MODE>
DI void phase_token_row(const Args& a, const int li) {
    const int tid = threadIdx.x, lane = tid & 63, wave = tid >> 6;
    float* X = (float*)(a.ws + WS_X);
    bf16_t* H = (bf16_t*)(a.ws + WS_H);
    const bf16_t* Y = (const bf16_t*)(a.ws + WS_Y);
    const float* MOD = (const float*)(a.ws + WS_MOD);
    const bool combine = MODE == 2 || li > 0;
    const bool first = MODE == 0 && li == 0;
    const int npairs = (MODE == 2 ? NLAT : NTOK) / 2;
    const int lprev = MODE == 2 ? 3 : (li > 0 ? li - 1 : 0);
    const float* gn = a.in[6] + (size_t)li * D;
    for (int p = blockIdx.x * 4 + wave; p < npairs; p += gridDim.x * 4) {
        const int t0 = 2 * p, mr = tok_modrow(t0);
        f32x4 x[2][4];
#pragma unroll
        for (int i = 0; i < 2; ++i) {
            const int t = t0 + i;
            const float* xs = first ? (t < NLAT ? a.in[0] + (size_t)t * D : a.in[2] + (size_t)(t - NLAT) * D) : X + (size_t)t * D;
#pragma unroll
            for (int j = 0; j < 4; ++j) x[i][j] = *(const f32x4*)(xs + 256 * j + 4 * lane);
        }
        if (combine) {
            const float* g5 = MOD + ((size_t)lprev * 9 + mr) * 6144 + 5 * 1024;
            f32x4 g[4];
#pragma unroll
            for (int j = 0; j < 4; ++j) g[j] = *(const f32x4*)(g5 + 256 * j + 4 * lane);
#pragma unroll
            for (int i = 0; i < 2; ++i) {
                const bf16_t* y0 = Y + (size_t)(2 * (t0 + i)) * D;
#pragma unroll
                for (int j = 0; j < 4; ++j) {
                    const u32x2 ya = *(const u32x2*)(y0 + 256 * j + 4 * lane), yb = *(const u32x2*)(y0 + D + 256 * j + 4 * lane);
                    x[i][j][0] += g[j][0] * (lof(ya[0]) + lof(yb[0])); x[i][j][1] += g[j][1] * (hif(ya[0]) + hif(yb[0]));
                    x[i][j][2] += g[j][2] * (lof(ya[1]) + lof(yb[1])); x[i][j][3] += g[j][3] * (hif(ya[1]) + hif(yb[1]));
                }
            }
        }
        if (MODE == 2) {
#pragma unroll
            for (int i = 0; i < 2; ++i)
#pragma unroll
                for (int j = 0; j < 4; ++j) *(f32x4*)(a.out + (size_t)(t0 + i) * D + 256 * j + 4 * lane) = x[i][j];
            continue;
        }
        float rstd[2];
#pragma unroll
        for (int i = 0; i < 2; ++i) {
            float ss = 0.f;
#pragma unroll
            for (int j = 0; j < 4; ++j) ss += x[i][j][0] * x[i][j][0] + x[i][j][1] * x[i][j][1] + x[i][j][2] * x[i][j][2] + x[i][j][3] * x[i][j][3];
            rstd[i] = rsqrtf(wave_sum(ss) * (1.f / 1024.f) + EPS);
        }
        const float* msc = MOD + ((size_t)li * 9 + mr) * 6144 + 1 * 1024;
        const float* msh = MOD + ((size_t)li * 9 + mr) * 6144;
#pragma unroll
        for (int j = 0; j < 4; ++j) {
            const f32x4 n4 = *(const f32x4*)(gn + 256 * j + 4 * lane), s4 = *(const f32x4*)(msc + 256 * j + 4 * lane), h4 = *(const f32x4*)(msh + 256 * j + 4 * lane);
            const f32x4 gs = n4 * (s4 + 1.f);
#pragma unroll
            for (int i = 0; i < 2; ++i) {
                const f32x4 f = x[i][j] * rstd[i] * gs + h4;
                st_bf4(H + (size_t)(t0 + i) * D + 256 * j + 4 * lane, f);
                if (combine) *(f32x4*)(X + (size_t)(t0 + i) * D + 256 * j + 4 * lane) = x[i][j];
            }
        }
    }
}

DI void phase_token_router(const Args& a, const int li) {
    const int tid = threadIdx.x, lane = tid & 63, wave = tid >> 6;
    const int r = lane & 15, q = lane >> 4;
    const float* X = (const float*)(a.ws + WS_X);
    bf16_t* H = (bf16_t*)(a.ws + WS_H);
    const float* MOD = (const float*)(a.ws + WS_MOD);
    const float* gn = a.in[7] + (size_t)li * D;
    const int ngroups = (li == 3 ? NLAT : NTOK) / 16;
    char* sHi = lds; char* sLo = lds + 32768;
    float* sP = (float*)lds;
    float* sL = (float*)(lds + 32768);
    const bf16_t* rwh = (const bf16_t*)(a.ws + W_RT) + (size_t)li * 2 * 80 * 1024 + (size_t)r * 1024 + q * 8;
    for (int g = blockIdx.x; g < ngroups; g += gridDim.x) {
        const int mr = tok_modrow(g * 16);
        const float* msc = MOD + ((size_t)li * 9 + mr) * 6144 + 4 * 1024;
        const float* msh = MOD + ((size_t)li * 9 + mr) * 6144 + 3 * 1024;
        __syncthreads();
        {
            f32x4 x[4][4];
#pragma unroll
            for (int i = 0; i < 4; ++i)
#pragma unroll
                for (int j = 0; j < 4; ++j) x[i][j] = *(const f32x4*)(X + (size_t)(g * 16 + wave * 4 + i) * D + 256 * j + 4 * lane);
            float rstd[4];
#pragma unroll
            for (int i = 0; i < 4; ++i) {
                float ss = 0.f;
#pragma unroll
                for (int j = 0; j < 4; ++j) ss += x[i][j][0] * x[i][j][0] + x[i][j][1] * x[i][j][1] + x[i][j][2] * x[i][j][2] + x[i][j][3] * x[i][j][3];
                rstd[i] = rsqrtf(wave_sum(ss) * (1.f / 1024.f) + EPS);
            }
#pragma unroll
            for (int j = 0; j < 4; ++j) {
                const f32x4 n4 = *(const f32x4*)(gn + 256 * j + 4 * lane), s4 = *(const f32x4*)(msc + 256 * j + 4 * lane), h4 = *(const f32x4*)(msh + 256 * j + 4 * lane);
                const f32x4 gs = n4 * (s4 + 1.f);
#pragma unroll
                for (int i = 0; i < 4; ++i) {
                    const int row = wave * 4 + i;
                    const f32x4 f = x[i][j] * rstd[i] * gs + h4;
                    u32x2 hv; hv[0] = pk2(f[0], f[1]); hv[1] = pk2(f[2], f[3]);
                    u32x2 lv; lv[0] = pk2(f[0] - lof(hv[0]), f[1] - hif(hv[0])); lv[1] = pk2(f[2] - lof(hv[1]), f[3] - hif(hv[1]));
                    *(u32x2*)(H + (size_t)(g * 16 + row) * D + 256 * j + 4 * lane) = hv;
                    const int off = row * 2048 + (((32 * j + (lane >> 1)) ^ row) << 4) + (lane & 1) * 8;
                    *(u32x2*)(sHi + off) = hv; *(u32x2*)(sLo + off) = lv;
                }
            }
        }
        __syncthreads();
        f32x4 lacc[5];
#pragma unroll
        for (int i = 0; i < 5; ++i) lacc[i] = (f32x4){0.f, 0.f, 0.f, 0.f};
#pragma unroll 2
        for (int s = 0; s < 8; ++s) {
            const int kk = wave * 8 + s;
            const int off = r * 2048 + (((kk * 4 + q) ^ r) << 4);
            const bf16x8 fh = ldsv8(sHi + off), fl = ldsv8(sLo + off);
#pragma unroll
            for (int nt = 0; nt < 5; ++nt) {
                const bf16x8 wh = *(const bf16x8*)(rwh + (size_t)nt * 16 * 1024 + kk * 32);
                const bf16x8 wl = *(const bf16x8*)(rwh + (size_t)(80 + nt * 16) * 1024 + kk * 32);
                lacc[nt] = mfma16(fh, wh, lacc[nt]);
                lacc[nt] = mfma16(fh, wl, lacc[nt]);
                lacc[nt] = mfma16(fl, wh, lacc[nt]);
            }
        }
        __syncthreads();
#pragma unroll
        for (int nt = 0; nt < 5; ++nt)
#pragma unroll
            for (int j = 0; j < 4; ++j) sP[(wave * 16 + q * 4 + j) * 80 + nt * 16 + r] = lacc[nt][j];
        __syncthreads();
        for (int i = tid; i < 16 * 80; i += NTHR) sL[i] = sP[i] + sP[1280 + i] + sP[2560 + i] + sP[3840 + i];
        __syncthreads();
        if (tid < 16) {
            const float* L = sL + tid * 80;
            const float* bg = a.in[27] + li * 8;
            const float* be = a.in[29] + li * 64;
            float gmax = -3.0e38f; int gi = 0; float gl[8];
#pragma unroll
            for (int j = 0; j < 8; ++j) { gl[j] = L[j] + bg[j]; if (gl[j] > gmax) { gmax = gl[j]; gi = j; } }
            float ps = 0.f;
#pragma unroll
            for (int j = 0; j < 8; ++j) ps += __expf(gl[j] - gmax);
            const float ptop = 1.f / ps;
            float e1 = -3.0e38f, e2 = -3.0e38f; int i1 = 0, i2 = 0;
#pragma unroll
            for (int j = 0; j < 8; ++j) {
                const float v = L[8 + gi * 8 + j] + be[gi * 8 + j];
                if (v > e1) { e2 = e1; i2 = i1; e1 = v; i1 = j; } else if (v > e2) { e2 = v; i2 = j; }
            }
            const float ex = __expf(e2 - e1);
            const float w1 = ptop / (1.f + ex), w2 = ptop * ex / (1.f + ex);
            const int tt = g * 16 + tid;
            int* cnt = (int*)(a.ws + WS_CTL + CTL_CNT) + li * 64;
            int* list = (int*)(a.ws + WS_LIST);
            float* wsl = (float*)(a.ws + WS_WSLOT);
            const int ea = gi * 8 + i1, eb = gi * 8 + i2;
            const int pa = atomicAdd(&cnt[ea], 1); list[(size_t)ea * NTOK + pa] = 2 * tt; wsl[2 * tt] = w1;
            const int pb = atomicAdd(&cnt[eb], 1); list[(size_t)eb * NTOK + pb] = 2 * tt + 1; wsl[2 * tt + 1] = w2;
        }
    }
}

template <int WM, int WN, int MT, int NT, bool PFALL = true, class AP>
DI void gemm_tile(AP arow, const bf16_t* Bt, const int ldb, const int K, f32x4 (&acc)[MT][NT], float* ssq = nullptr) {
    constexpr int BM = WM * MT * 16, BN = WN * NT * 16;
    constexpr int A_BYTES = BM * 128, B_BYTES = BN * 128, STAGE = A_BYTES + B_BYTES;
    constexpr int ACH = BM * 8 / NTHR, BCH = BN * 8 / NTHR;
    static_assert(2 * STAGE <= LDS_AUX, "gemm LDS");
    const int tid = threadIdx.x, lane = tid & 63, wave = tid >> 6;
    const int wm = wave / WN, wn = wave % WN;
    const int fr = lane & 15, fq = lane >> 4;
    const bf16_t* ap[ACH]; const bf16_t* bp[BCH];
#pragma unroll
    for (int i = 0; i < ACH; ++i) { const int idx = tid + i * NTHR, row = idx >> 3, c = (idx & 7) ^ (row & 7); ap[i] = arow(row) + c * 8; }
#pragma unroll
    for (int i = 0; i < BCH; ++i) { const int idx = tid + i * NTHR, row = idx >> 3, c = (idx & 7) ^ (row & 7); bp[i] = Bt + (size_t)row * ldb + c * 8; }
#pragma unroll
    for (int i = 0; i < MT; ++i)
#pragma unroll
        for (int j = 0; j < NT; ++j) acc[i][j] = (f32x4){0.f, 0.f, 0.f, 0.f};
    const int KT = K >> 6;
    {
        char* sa = lds; char* sb = lds + A_BYTES;
#pragma unroll
        for (int i = 0; i < ACH; ++i) dma16(ap[i], sa + (tid + i * NTHR) * 16);
#pragma unroll
        for (int i = 0; i < BCH; ++i) dma16(bp[i], sb + (tid + i * NTHR) * 16);
    }
#pragma unroll 1
    for (int kt = 0; kt < KT; ++kt) {
        wait_vm0();
        __syncthreads();
        if (kt + 1 < KT) {
            char* sa = lds + ((kt + 1) & 1) * STAGE; char* sb = sa + A_BYTES;
            const int ko = (kt + 1) * 64;
#pragma unroll
            for (int i = 0; i < ACH; ++i) dma16(ap[i] + ko, sa + (tid + i * NTHR) * 16);
#pragma unroll
            for (int i = 0; i < BCH; ++i) dma16(bp[i] + ko, sb + (tid + i * NTHR) * 16);
        }
        const char* sa = lds + (kt & 1) * STAGE; const char* sb = sa + A_BYTES;
        if (PFALL) {
            bf16x8 xf[2][MT], wf[2][NT];
#pragma unroll
            for (int kk = 0; kk < 2; ++kk) {
#pragma unroll
                for (int i = 0; i < MT; ++i) xf[kk][i] = ldsv8(sa + swz128(wm * MT * 16 + i * 16 + fr, kk * 4 + fq));
#pragma unroll
                for (int j = 0; j < NT; ++j) wf[kk][j] = ldsv8(sb + swz128(wn * NT * 16 + j * 16 + fr, kk * 4 + fq));
            }
            __builtin_amdgcn_sched_barrier(0);
            __builtin_amdgcn_s_setprio(1);
#pragma unroll
            for (int kk = 0; kk < 2; ++kk)
#pragma unroll
                for (int i = 0; i < MT; ++i)
#pragma unroll
                    for (int j = 0; j < NT; ++j) acc[i][j] = mfma16(wf[kk][j], xf[kk][i], acc[i][j]);
            __builtin_amdgcn_s_setprio(0);
        } else {
#pragma unroll
            for (int kk = 0; kk < 2; ++kk) {
                bf16x8 xf[MT], wf[NT];
#pragma unroll
                for (int i = 0; i < MT; ++i) xf[i] = ldsv8(sa + swz128(wm * MT * 16 + i * 16 + fr, kk * 4 + fq));
#pragma unroll
                for (int j = 0; j < NT; ++j) wf[j] = ldsv8(sb + swz128(wn * NT * 16 + j * 16 + fr, kk * 4 + fq));
#pragma unroll
                for (int i = 0; i < MT; ++i)
#pragma unroll
                    for (int j = 0; j < NT; ++j) acc[i][j] = mfma16(wf[j], xf[i], acc[i][j]);
                if (ssq) {
#pragma unroll
                    for (int i = 0; i < MT; ++i) {
                        const u32x4 xu = __builtin_bit_cast(u32x4, xf[i]);
#pragma unroll
                        for (int d = 0; d < 4; ++d) { const bfx2 p = __builtin_bit_cast(bfx2, xu[d]); ssq[i] = __builtin_amdgcn_fdot2_f32_bf16(p, p, ssq[i], false); }
                    }
                }
            }
        }
    }
    __syncthreads();
}


struct GemmPipe {
    static constexpr int A_BYTES = 128 * 128, STAGE = 2 * A_BYTES;
    const bf16_t* ap[4]; const bf16_t* bp[4];
    template <class AP>
    DI void setup(AP arow, const bf16_t* Bt, const int ldb) {
        const int tid = threadIdx.x;
#pragma unroll
        for (int i = 0; i < 4; ++i) {
            const int idx = tid + i * NTHR, row = idx >> 3, c = (idx & 7) ^ (row & 7);
            ap[i] = arow(row) + c * 8; bp[i] = Bt + (size_t)row * ldb + c * 8;
        }
    }
    DI void issue(const int kt, const int buf) const {
        const int tid = threadIdx.x;
        char* sa = lds + buf * STAGE; char* sb = sa + A_BYTES;
        const int ko = kt * 64;
#pragma unroll
        for (int i = 0; i < 4; ++i) dma16(ap[i] + ko, sa + (tid + i * NTHR) * 16);
#pragma unroll
        for (int i = 0; i < 4; ++i) dma16(bp[i] + ko, sb + (tid + i * NTHR) * 16);
    }
    template <int PM>
    DI void run_probe(const int K, f32x4 (&acc)[4][4]) const {
        const int tid = threadIdx.x, lane = tid & 63, wave = tid >> 6;
        const int wm = wave >> 1, wn = wave & 1, fr = lane & 15, fq = lane >> 4;
#pragma unroll
        for (int i = 0; i < 4; ++i)
#pragma unroll
            for (int j = 0; j < 4; ++j) acc[i][j] = (f32x4){0.f, 0.f, 0.f, 0.f};
        const int KT = K >> 6;
#pragma unroll 1
        for (int kt = 0; kt < KT; ++kt) {
            if (PM & 4) { wait_vm0(); __syncthreads(); }
            if ((PM & 1) && kt + 1 < KT) issue(kt + 1, (kt + 1) & 1);
            if (PM & 2) {
                const char* sa = lds + (kt & 1) * STAGE; const char* sb = sa + A_BYTES;
                bf16x8 xf[2][4], wf[2][4];
#pragma unroll
                for (int kk = 0; kk < 2; ++kk) {
#pragma unroll
                    for (int i = 0; i < 4; ++i) xf[kk][i] = ldsv8(sa + swz128(wm * 64 + i * 16 + fr, kk * 4 + fq));
#pragma unroll
                    for (int j = 0; j < 4; ++j) wf[kk][j] = ldsv8(sb + swz128(wn * 64 + j * 16 + fr, kk * 4 + fq));
                }
                __builtin_amdgcn_sched_barrier(0);
                __builtin_amdgcn_s_setprio(1);
#pragma unroll
                for (int kk = 0; kk < 2; ++kk)
#pragma unroll
                    for (int i = 0; i < 4; ++i)
#pragma unroll
                        for (int j = 0; j < 4; ++j) acc[i][j] = mfma16(wf[kk][j], xf[kk][i], acc[i][j]);
                __builtin_amdgcn_s_setprio(0);
            }
        }
        wait_vm0();
    }
    DI void run(const int K, f32x4 (&acc)[4][4]) const {
        const int tid = threadIdx.x, lane = tid & 63, wave = tid >> 6;
        const int wm = wave >> 1, wn = wave & 1, fr = lane & 15, fq = lane >> 4;
#pragma unroll
        for (int i = 0; i < 4; ++i)
#pragma unroll
            for (int j = 0; j < 4; ++j) acc[i][j] = (f32x4){0.f, 0.f, 0.f, 0.f};
        const int KT = K >> 6;
#pragma unroll 1
        for (int kt = 0; kt < KT; ++kt) {
            wait_vm0();
            __syncthreads();
            if (kt + 1 < KT) issue(kt + 1, (kt + 1) & 1);
            const char* sa = lds + (kt & 1) * STAGE; const char* sb = sa + A_BYTES;
            bf16x8 xf[2][4], wf[2][4];
#pragma unroll
            for (int kk = 0; kk < 2; ++kk) {
#pragma unroll
                for (int i = 0; i < 4; ++i) xf[kk][i] = ldsv8(sa + swz128(wm * 64 + i * 16 + fr, kk * 4 + fq));
#pragma unroll
                for (int j = 0; j < 4; ++j) wf[kk][j] = ldsv8(sb + swz128(wn * 64 + j * 16 + fr, kk * 4 + fq));
            }
            __builtin_amdgcn_sched_barrier(0);
            __builtin_amdgcn_s_setprio(1);
#pragma unroll
            for (int kk = 0; kk < 2; ++kk)
#pragma unroll
                for (int i = 0; i < 4; ++i)
#pragma unroll
                    for (int j = 0; j < 4; ++j) acc[i][j] = mfma16(wf[kk][j], xf[kk][i], acc[i][j]);
            __builtin_amdgcn_s_setprio(0);
        }
    }
};

constexpr int EPI_OFF = 32768;
DI int lane_m(int i) { const int t = threadIdx.x; return ((t >> 7) & 1) * 64 + i * 16 + (t & 15); }
DI int lane_n(int j) { const int t = threadIdx.x; return ((t >> 6) & 1) * 64 + j * 16 + ((t >> 4) & 3) * 4; }
DI int opaque_tid() { int t = threadIdx.x; asm volatile("" : "+v"(t)); return t; }
DI int lane_m(int t, int i) { return ((t >> 7) & 1) * 64 + i * 16 + (t & 15); }
DI int lane_n(int t, int j) { return ((t >> 6) & 1) * 64 + j * 16 + ((t >> 4) & 3) * 4; }
template <class XF>
DI void epi_stage_bf16(const f32x4 (&acc)[4][4], XF xf) {
    const int tz = opaque_tid();
#pragma unroll
    for (int i = 0; i < 4; ++i) {
        const int m = lane_m(tz, i);
#pragma unroll
        for (int j = 0; j < 4; ++j) {
            const int n = lane_n(tz, j);
            const f32x4 v = xf(i, j, acc[i][j]);
            u32x2 o; o[0] = pk2(v[0], v[1]); o[1] = pk2(v[2], v[3]);
            *(u32x2*)(lds + EPI_OFF + m * 256 + (((n >> 3) ^ (m & 15)) << 4) + (n & 4) * 2) = o;
        }
    }
}
template <class DP, class OK>
DI void epi_flush_bf16(DP dst, OK ok) {
    const int tz = opaque_tid();
#pragma unroll
    for (int it = 0; it < 8; ++it) {
        const int idx = tz + it * NTHR, row = idx >> 4, ch = idx & 15;
        const u32x4 v = *(const u32x4*)(lds + EPI_OFF + row * 256 + ((ch ^ (row & 15)) << 4));
        if (ok(row)) *(u32x4*)(dst(row) + ch * 8) = v;
    }
}
template <class XF>
DI void epi_stage_bf16_T(const f32x4 (&acc)[4][4], XF xf) {
    const int tz = opaque_tid();
    const bool odd = tz & 1;
#pragma unroll
    for (int i = 0; i < 4; ++i) {
        const int m = lane_m(tz, i) & ~1;
#pragma unroll
        for (int j = 0; j < 4; ++j) {
            const int n = lane_n(tz, j) + (odd ? 2 : 0);
            const f32x4 v = xf(i, j, acc[i][j]);
            const float r0 = __shfl_xor(odd ? v[0] : v[2], 1), r1 = __shfl_xor(odd ? v[1] : v[3], 1);
            const unsigned w0 = odd ? pk2(r0, v[2]) : pk2(v[0], r0), w1 = odd ? pk2(r1, v[3]) : pk2(v[1], r1);
            *(unsigned*)(lds + EPI_OFF + n * 256 + (((m >> 3) ^ (n & 15)) << 4) + (m & 6) * 2) = w0;
            *(unsigned*)(lds + EPI_OFF + (n + 1) * 256 + (((m >> 3) ^ ((n + 1) & 15)) << 4) + (m & 6) * 2) = w1;
        }
    }
}
DI void epi_resid_f32(const Args& a, const int li, const int m0, const int n0, const f32x4 (&acc)[4][4]) {
    const int tz = opaque_tid();
    float* X = (float*)(a.ws + WS_X);
    const float* gate = (const float*)(a.ws + WS_MOD) + ((size_t)li * 9 + tok_modrow(m0)) * 6144 + 2 * 1024 + n0;
#pragma unroll
    for (int j = 0; j < 4; ++j) {
        const int n = lane_n(tz, j);
        const f32x4 g = *(const f32x4*)(gate + n);
#pragma unroll
        for (int i = 0; i < 4; ++i) {
            const int t = m0 + lane_m(tz, i);
            float* xp = X + (size_t)t * D + n0 + n;
            const float* xs = li == 0 ? (t < NLAT ? a.in[0] + (size_t)t * D : a.in[2] + (size_t)(t - NLAT) * D) + n0 + n : xp;
            f32x4 x = *(const f32x4*)xs;
            x += g * acc[i][j];
            *(f32x4*)xp = x;
        }
    }
}

template <bool XPF = true, class TE>
DI void gemm_dense_phase(const bf16_t* A, const int lda, const int mrows, const bf16_t* Bt, const int N, const int K, TE tile_epi) {
    const int mt = mrows / 128, nt = N / 128;
    const int mpx = mt >> 3, bmb = mpx >> 1, full = mpx * 8;
    auto decode = [&](int u, int& m0, int& n0) {
        const int xc = u & 7, s = u >> 3;
        const int bn = s / full, rem = s - bn * full;
        const int w = min(8, nt - 8 * bn);
        const int bm = rem / (bmb * w), rem2 = rem - bm * (bmb * w);
        const int ni = rem2 / bmb, mi = rem2 - ni * bmb;
        m0 = (xc * mpx + bm * bmb + mi) * 128; n0 = (bn * 8 + ni) * 128;
    };
    GemmPipe g;
    int u = blockIdx.x, m0 = 0, n0 = 0;
    __syncthreads();
    if (u < mt * nt) { decode(u, m0, n0); g.setup([&](int r) { return A + (size_t)(m0 + r) * lda; }, Bt + (size_t)n0 * K, K); g.issue(0, 0); }
    while (u < mt * nt) {
        f32x4 acc[4][4];
        g.run(K, acc);
        const int cm0 = m0, cn0 = n0;
        u += gridDim.x;
        if (XPF) {
            if (u < mt * nt) { decode(u, m0, n0); g.setup([&](int r) { return A + (size_t)(m0 + r) * lda; }, Bt + (size_t)n0 * K, K); g.issue(0, 0); }
            tile_epi(cm0, cn0, acc);
        } else {
            tile_epi(cm0, cn0, acc);
            __syncthreads();
            if (u < mt * nt) { decode(u, m0, n0); g.setup([&](int r) { return A + (size_t)(m0 + r) * lda; }, Bt + (size_t)n0 * K, K); g.issue(0, 0); }
        }
    }
    __syncthreads();
}
template <class XF, class DP>
DI void epi_bf16_rowmajor(const f32x4 (&acc)[4][4], XF xf, DP dst) {
    __syncthreads();
    epi_stage_bf16(acc, xf);
    __syncthreads();
    epi_flush_bf16(dst, [](int) { return true; });
}

DI void phase_rg_in(const Args& a, int j) {
    bf16_t* G = (bf16_t*)(a.ws + RG_G); bf16_t* U = (bf16_t*)(a.ws + RG_U);
    gemm_dense_phase((const bf16_t*)(a.ws + WS_H), D, NTOK, (const bf16_t*)(a.ws + W_RGIN) + (size_t)j * 2048 * 1024, 2048, 1024,
        [&](int m0, int n0, const f32x4 (&acc)[4][4]) {
            if (n0 < 1024)
                epi_bf16_rowmajor(acc, [](int, int, const f32x4 v) { f32x4 g; g[0] = gelu_tanh(v[0]); g[1] = gelu_tanh(v[1]); g[2] = gelu_tanh(v[2]); g[3] = gelu_tanh(v[3]); return g; },
                                  [&](int row) { return G + (size_t)(m0 + row) * D + n0; });
            else
                epi_bf16_rowmajor(acc, [](int, int, const f32x4 v) { return v; }, [&](int row) { return U + (size_t)(m0 + row) * D + (n0 - 1024); });
        });
}

template <int VAR = 0, int HOST = 0>
DI void phase_rg_scan(const Args& a, int j) {
    const int tid = threadIdx.x, lane = tid & 63, wave = tid >> 6;
    const int fr = lane & 15, fq = lane >> 4;
    const bf16_t* U = (const bf16_t*)(a.ws + RG_U);
    bf16_t* HS = (bf16_t*)(a.ws + (VAR ? WS_Y : RG_HS));
    char* sW = lds;
    char* sX = lds + 8192;
    float* sUc = (float*)(lds + 16384);
    float* sA = (float*)(lds + 24576);
    float* sB = (float*)(lds + 33280);
    bf16_t* sO = (bf16_t*)(lds + 41984);
    unsigned* sCv = (unsigned*)(lds + 50176);
    const int c = tid & 7;
    for (int u = blockIdx.x; u < 512; u += gridDim.x) {
        const int half = u & 1, dir = (u >> 1) & 1, blk = (u >> 2) & 15, b = u >> 6;
        const int cin0 = blk * 64, co0 = blk * 64 + half * 32;
        __syncthreads();
        {
            const bf16_t* Wg = (const bf16_t*)(a.ws + W_RGG) + ((size_t)((j * 2 + dir) * 16 + blk)) * 128 * 64;
#pragma unroll
            for (int i = 0; i < 2; ++i) {
                const int idx = tid + i * NTHR, row = idx >> 3, cc = idx & 7;
                const int srow = (row >> 5) * 64 + half * 32 + (row & 31);
                *(u32x4*)(sW + swz128(row, cc)) = *(const u32x4*)(Wg + (size_t)srow * 64 + cc * 8);
            }
        }
        float carry = 0.f;
        float cw[4][8], cb[8];
        {
            const float* cwp = a.in[9] + (size_t)j * 4 * 1024 + cin0 + c * 8; const float* cbp = a.in[10] + (size_t)j * 1024 + cin0 + c * 8;
#pragma unroll
            for (int w = 0; w < 4; ++w) { const f32x4 v0 = *(const f32x4*)(cwp + w * 1024), v1 = *(const f32x4*)(cwp + w * 1024 + 4);
#pragma unroll
                for (int e = 0; e < 4; ++e) { cw[w][e] = v0[e]; cw[w][4 + e] = v1[e]; } }
            const f32x4 v0 = *(const f32x4*)cbp, v1 = *(const f32x4*)(cbp + 4);
#pragma unroll
            for (int e = 0; e < 4; ++e) { cb[e] = v0[e]; cb[4 + e] = v1[e]; }
        }
        float bg0[8], bg1[8], spl[8];
        {
            const float* gb = a.in[12] + ((size_t)(j * 2 + dir) * 2) * 1024 + co0;
            const float* lm = a.in[13] + (size_t)(j * 2 + dir) * 1024 + co0;
#pragma unroll
            for (int jt = 0; jt < 2; ++jt)
#pragma unroll
                for (int e = 0; e < 4; ++e) {
                    const int cc = jt * 16 + fq * 4 + e;
                    bg0[jt * 4 + e] = gb[cc]; bg1[jt * 4 + e] = gb[1024 + cc];
                    spl[jt * 4 + e] = -8.f * log1pf(__expf(-lm[cc]));
                }
        }
        u32x4 pu[2][4];
        auto load_chunk = [&](int ci) {
            const int seg = ci >= 4, L = seg ? SEQ : CTXL, nch = L / 64, jc = seg ? ci - 4 : ci;
            const int oc = dir ? nch - 1 - jc : jc;
            const int rb = seg ? b * SEQ : NLAT + b * CTXL;
            const int s0 = oc * 64;
#pragma unroll
            for (int it = 0; it < 2; ++it) {
                const int tk = (tid >> 3) + it * 32;
#pragma unroll
                for (int w = 0; w < 4; ++w) {
                    const int s = s0 + tk + w - 2;
                    const int sc_ = min(max(s, 0), L - 1);
                    const u32x4 ld = *(const u32x4*)(U + (size_t)(rb + sc_) * D + cin0 + c * 8);
                    const unsigned msk = (s >= 0 && s < L) ? 0xffffffffu : 0u;
                    pu[it][w] = (u32x4){ld[0] & msk, ld[1] & msk, ld[2] & msk, ld[3] & msk};
                }
            }
        };
        load_chunk(0);
        __syncthreads();
        size_t prev_base = 0;
        constexpr int CV_TILES = HOST ? 6144 : 0;
        CvTile cvp; cvp.src = nullptr; cvp.dst = nullptr; cvp.K = 0; cvp.N = 0; cvp.perm = 0; cvp.k0 = 0; cvp.n0 = 0;
        bool cvp_ok = false;
#pragma unroll 1
        for (int ci = 0; ci < 36; ++ci) {
            f32x4 cv0[4], cv1[4];
            CvTile cvc = cvp;
            const int cvq = (ci / 3) * 512 + u;
            const bool cv_ok = HOST && (ci % 3 == 0) && cvq < CV_TILES;
            if (cv_ok) { cvc = moe_cv_tile(a, 1, cvq); cv_load(cvc, cv0, cv1); }
            const int seg = ci >= 4, L = seg ? SEQ : CTXL, nch = L / 64, jc = seg ? ci - 4 : ci;
            const int oc = dir ? nch - 1 - jc : jc;
            const int rb = seg ? b * SEQ : NLAT + b * CTXL;
            const int s0 = oc * 64;
            char* sXc = sX; float* sUcc = sUc;
#pragma unroll
            for (int it = 0; it < 2; ++it) {
                const int tk = (tid >> 3) + it * 32;
                float o[8];
#pragma unroll
                for (int e = 0; e < 8; ++e) o[e] = cb[e];
#pragma unroll
                for (int w = 0; w < 4; ++w) {
                    const u32x4 r4 = pu[it][w];
#pragma unroll
                    for (int e = 0; e < 4; ++e) { o[2 * e] += cw[w][2 * e] * lof(r4[e]); o[2 * e + 1] += cw[w][2 * e + 1] * hif(r4[e]); }
                }
                u32x4 pv; pv[0] = pk2(o[0], o[1]); pv[1] = pk2(o[2], o[3]); pv[2] = pk2(o[4], o[5]); pv[3] = pk2(o[6], o[7]);
                *(u32x4*)(sXc + swz128(tk, c)) = pv;
                if ((c >> 2) == half) {
                    *(f32x4*)(sUcc + tk * 32 + (c & 3) * 8) = (f32x4){o[0], o[1], o[2], o[3]};
                    *(f32x4*)(sUcc + tk * 32 + (c & 3) * 8 + 4) = (f32x4){o[4], o[5], o[6], o[7]};
                }
            }
            if (ci + 1 < 36) load_chunk(ci + 1);
            __syncthreads();
            if (HOST && cvp_ok) cv_flush(cvp, sCv);
            if (ci > 0) {
                const u32x4 v = *(const u32x4*)(sO + ((ci - 1) & 1) * 2048 + tid * 8);
                *(u32x4*)(HS + prev_base + (size_t)(tid >> 2) * D + (tid & 3) * 8) = v;
            }
            {
                f32x4 acc[4];
#pragma unroll
                for (int jt = 0; jt < 4; ++jt) acc[jt] = (f32x4){0.f, 0.f, 0.f, 0.f};
#pragma unroll
                for (int kk = 0; kk < 2; ++kk) {
                    const bf16x8 xf = ldsv8(sXc + swz128(wave * 16 + fr, kk * 4 + fq));
#pragma unroll
                    for (int jt = 0; jt < 4; ++jt) acc[jt] = mfma16(ldsv8(sW + swz128(jt * 16 + fr, kk * 4 + fq)), xf, acc[jt]);
                }
                const int tk = wave * 16 + fr;
#pragma unroll
                for (int jt = 0; jt < 2; ++jt) {
                    const f32x4 uc = *(const f32x4*)(sUcc + tk * 32 + jt * 16 + fq * 4);
                    f32x4 av4, bv4;
#pragma unroll
                    for (int e = 0; e < 4; ++e) {
                        if (VAR & 2) { av4[e] = 0.5f + 0.001f * acc[jt][e]; bv4[e] = uc[e] + acc[jt + 2][e]; continue; }
                        const float rg = sigmoidf_(acc[jt][e] + bg0[jt * 4 + e]);
                        const float ig = sigmoidf_(acc[jt + 2][e] + bg1[jt * 4 + e]);
                        const float av = fexp(rg * spl[jt * 4 + e]);
                        av4[e] = av;
                        bv4[e] = __builtin_amdgcn_sqrtf(fmaxf(1.f - av * av, 0.f)) * ig * uc[e];
                    }
#pragma unroll
                    for (int e = 0; e < 4; ++e) { sA[(jt * 16 + fq * 4 + e) * 68 + tk] = av4[e]; sB[(jt * 16 + fq * 4 + e) * 68 + tk] = bv4[e]; }
                }
            }
            __syncthreads();
            if (!(VAR & 4)) {
                const int ch = wave * 8 + (lane & 7), sg = lane >> 3;
                const int tb = dir ? 56 - sg * 8 : sg * 8;
                const f32x4 a0 = *(const f32x4*)(sA + ch * 68 + tb), a1 = *(const f32x4*)(sA + ch * 68 + tb + 4);
                const f32x4 b0 = *(const f32x4*)(sB + ch * 68 + tb), b1 = *(const f32x4*)(sB + ch * 68 + tb + 4);
                float av[8], bv[8];
#pragma unroll
                for (int e = 0; e < 4; ++e) {
                    av[e] = dir ? a1[3 - e] : a0[e]; av[4 + e] = dir ? a0[3 - e] : a1[e];
                    bv[e] = dir ? b1[3 - e] : b0[e]; bv[4 + e] = dir ? b0[3 - e] : b1[e];
                }
                float Ap = 1.f, Hh = 0.f;
#pragma unroll
                for (int e = 0; e < 8; ++e) { Hh = av[e] * Hh + bv[e]; Ap *= av[e]; }
#pragma unroll
                for (int d = 8; d < 64; d <<= 1) {
                    const float Ao = __shfl_up(Ap, d), Ho = __shfl_up(Hh, d);
                    if (lane >= d) { Hh = Ap * Ho + Hh; Ap = Ap * Ao; }
                }
                float Aex = __shfl_up(Ap, 8), Hex = __shfl_up(Hh, 8);
                if (sg == 0) { Aex = 1.f; Hex = 0.f; }
                float hin = Aex * carry + Hex;
                const float cnew = Ap * carry + Hh;
                carry = __shfl(cnew, 56 + (lane & 7));
                bf16_t* so = sO + (ci & 1) * 2048 + ch;
#pragma unroll
                for (int e = 0; e < 8; ++e) {
                    hin = av[e] * hin + bv[e];
                    const int i = sg * 8 + e, tk = dir ? 63 - i : i;
                    so[tk * 32] = f2bf(hin);
                }
            }
            prev_base = (size_t)dir * NTOK * D + (size_t)(rb + s0) * D + co0;
            if (HOST) { if (cv_ok) cv_pack(sCv, cv0, cv1); cvp = cvc; cvp_ok = cv_ok; }
        }
        __syncthreads();
        if (HOST && cvp_ok) cv_flush(cvp, sCv);
        {
            const u32x4 v = *(const u32x4*)(sO + (35 & 1) * 2048 + tid * 8);
            *(u32x4*)(HS + prev_base + (size_t)(tid >> 2) * D + (tid & 3) * 8) = v;
        }
    }
}

DI void phase_rg_combine(const Args& a) {
    const u32x4* G = (const u32x4*)(a.ws + RG_G);
    const u32x4* H0 = (const u32x4*)(a.ws + RG_HS);
    const u32x4* H1 = (const u32x4*)(a.ws + RG_HS + TOKD2);
    u32x4* A2 = (u32x4*)(a.ws + RG_A2);
    const size_t n = (size_t)NTOK * D / 8;
    for (size_t i = (size_t)blockIdx.x * NTHR + threadIdx.x; i < n; i += (size_t)gridDim.x * NTHR) {
        const u32x4 g = G[i], h0 = H0[i], h1 = H1[i];
        u32x4 o;
#pragma unroll
        for (int e = 0; e < 4; ++e) o[e] = pk2(lof(g[e]) * (lof(h0[e]) + lof(h1[e])), hif(g[e]) * (hif(h0[e]) + hif(h1[e])));
        A2[i] = o;
    }
}

DI void phase_rg_out(const Args& a, int li, int j) {
    gemm_dense_phase((const bf16_t*)(a.ws + RG_A2), D, li == 3 ? NLAT : NTOK, (const bf16_t*)(a.ws + W_RGOUT) + (size_t)j * 1024 * 1024, 1024, 1024,
        [&](int m0, int n0, const f32x4 (&acc)[4][4]) { epi_resid_f32(a, li, m0, n0, acc); });
}

DI void phase_mla_down(const Args& a) {
    bf16_t* CQ = (bf16_t*)(a.ws + MLA_CQ); bf16_t* CKV = (bf16_t*)(a.ws + MLA_CKV); float* KR = (float*)(a.ws + MLA_KR);
    gemm_dense_phase((const bf16_t*)(a.ws + WS_H), D, NTOK, (const bf16_t*)(a.ws + W_MDOWN), 512, 1024,
        [&](int m0, int n0, const f32x4 (&acc)[4][4]) {
            if (n0 < 256) epi_bf16_rowmajor(acc, [](int, int, const f32x4 v) { return v; }, [&](int row) { return CQ + (size_t)(m0 + row) * 256 + n0; });
            else if (n0 == 256) epi_bf16_rowmajor(acc, [](int, int, const f32x4 v) { return v; }, [&](int row) { return CKV + (size_t)(m0 + row) * 128; });
            else {
#pragma unroll
                for (int i = 0; i < 4; ++i)
#pragma unroll
                    for (int j = 0; j < 2; ++j) { const int n = lane_n(j); if (n < 32) *(f32x4*)(KR + (size_t)(m0 + lane_m(i)) * 32 + n) = acc[i][j]; }
            }
        });
}

DI int perm_key(int kp) { return (kp & ~12) | ((kp & 4) << 1) | ((kp & 8) >> 1); }

DI void phase_mla_up(const Args& a) {
    const int tid = threadIdx.x;
    const bf16_t* CQ = (const bf16_t*)(a.ws + MLA_CQ); const bf16_t* CKV = (const bf16_t*)(a.ws + MLA_CKV); const float* KR = (const float*)(a.ws + MLA_KR);
    bf16_t* Q = (bf16_t*)(a.ws + MLA_Q); bf16_t* Kb = (bf16_t*)(a.ws + MLA_K); bf16_t* VT = (bf16_t*)(a.ws + MLA_VT);
    const float* qkn = a.in[20];
    const float* RC = (const float*)(a.ws + WS_CTL + CTL_ROPE); const float* RS = RC + 512;
    const int MT_ = NTOK / 128;
    const int nq = MT_ * 16, nkv = MT_ * 16;
    const float QSCALE = 0.10206207261596575f * 1.4426950408889634f;
    for (int u = blockIdx.x; u < nq + nkv; u += gridDim.x) {
        const bool isq = u < nq;
        const int uu = isq ? u : u - nq;
        const int xc_ = uu & 7, s_ = uu >> 3;
        const int m0 = (((s_ >> 4) << 3) + xc_) * 128, head = s_ & 15;
        const bool islat = m0 < NLAT;
        const int bb = islat ? (m0 >> 11) : ((m0 - NLAT) >> 8);
        const int kp0 = islat ? CTXL + (m0 & (SEQ - 1)) : ((m0 - NLAT) & (CTXL - 1));
        __syncthreads();
        if (isq) {
            f32x4 hold[2][6];
            float ssq[2] = {0.f, 0.f};
            gemm_tile<4, 1, 2, 6, false>([&](int r) { return CQ + (size_t)(m0 + r) * 256; }, (const bf16_t*)(a.ws + W_MUQ) + (size_t)head * 96 * 256, 256, 256, hold, ssq);
            const int tz = opaque_tid();
            const int wave = tz >> 6, fq = (tz >> 4) & 3, fr = tz & 15;
#pragma unroll
            for (int i = 0; i < 2; ++i) {
                const int m = wave * 32 + i * 16 + fr;
                float sq = ssq[i]; sq += __shfl_xor(sq, 16); sq += __shfl_xor(sq, 32);
                const float rs0 = rsqrtf(sq * (1.f / 256.f) + EPS);
                float ss = 0.f;
#pragma unroll
                for (int jn = 0; jn < 6; ++jn) { hold[i][jn] *= rs0;
#pragma unroll
                    for (int e = 0; e < 4; ++e) ss += hold[i][jn][e] * hold[i][jn][e]; }
                ss += __shfl_xor(ss, 16); ss += __shfl_xor(ss, 32);
                const float rs = rsqrtf(ss * (1.f / 96.f) + EPS) ;
                f32x4 o[6];
#pragma unroll
                for (int jn = 0; jn < 6; ++jn) { const f32x4 g4 = *(const f32x4*)(qkn + jn * 16 + fq * 4); o[jn] = hold[i][jn] * rs * g4; }
#pragma unroll
                for (int jn = 4; jn < 6; ++jn) {
                    f32x4 other;
#pragma unroll
                    for (int e = 0; e < 4; ++e) other[e] = __shfl_xor(o[jn][e], 32);
                    if (islat) {
                        const int s = (m0 + m) & (SEQ - 1);
                        const int pos = jn == 4 ? (s >> 6) : (s & 63);
                        const f32x4 cs = *(const f32x4*)(RC + pos * 8 + (fq & 1) * 4), sn = *(const f32x4*)(RS + pos * 8 + (fq & 1) * 4);
#pragma unroll
                        for (int e = 0; e < 4; ++e) o[jn][e] = (fq < 2) ? o[jn][e] * cs[e] - other[e] * sn[e] : o[jn][e] * cs[e] + other[e] * sn[e];
                    }
                }
#pragma unroll
                for (int jn = 0; jn < 6; ++jn) {
                    const f32x4 v = o[jn] * QSCALE;
                    u32x2 pv; pv[0] = pk2(v[0], v[1]); pv[1] = pk2(v[2], v[3]);
                    *(u32x2*)(lds + m * 256 + (((jn * 2 + (fq >> 1)) ^ (m & 15)) << 4) + (fq & 1) * 8) = pv;
                }
            }
            __syncthreads();
#pragma unroll
            for (int it = 0; it < 8; ++it) {
                const int idx = tz + it * NTHR, row = idx >> 4, ch = idx & 15;
                if (ch < 12) {
                    const u32x4 v = *(const u32x4*)(lds + row * 256 + ((ch ^ (row & 15)) << 4));
                    *(u32x4*)(Q + (size_t)(m0 + row) * 1536 + head * 96 + ch * 8) = v;
                }
            }
        } else {
            f32x4 hold[4][4];
            float ssq[4] = {0.f, 0.f, 0.f, 0.f};
            gemm_tile<2, 2, 4, 4, false>([&](int r) { return CKV + (size_t)(m0 + r) * 128; }, (const bf16_t*)(a.ws + W_MUKV) + (size_t)head * 128 * 128, 128, 128, hold, ssq);
            const int tz = opaque_tid();
            const int wave = tz >> 6, wm = wave >> 1, wn = wave & 1, fq = (tz >> 4) & 3, fr = tz & 15;
            char* sK = lds; char* sV = lds + 32768;
#pragma unroll
            for (int i = 0; i < 4; ++i) {
                const int m = wm * 64 + i * 16 + fr, t = m0 + m;
                float sq = ssq[i]; sq += __shfl_xor(sq, 16); sq += __shfl_xor(sq, 32);
                const float rs0 = rsqrtf(sq * (1.f / 128.f) + EPS);
#pragma unroll
                for (int jn = 0; jn < 4; ++jn) hold[i][jn] *= rs0;
                if (wn == 0) {
                    const int base = (fq >> 1) * 16 + (fq & 1) * 4;
                    const f32x4 z1 = *(const f32x4*)(KR + (size_t)t * 32 + base);
                    const f32x4 z2 = *(const f32x4*)(KR + (size_t)t * 32 + base + 8);
                    float ss = 0.f;
#pragma unroll
                    for (int jn = 0; jn < 4; ++jn)
#pragma unroll
                        for (int e = 0; e < 4; ++e) ss += hold[i][jn][e] * hold[i][jn][e];
#pragma unroll
                    for (int e = 0; e < 4; ++e) ss += z1[e] * z1[e] + z2[e] * z2[e];
                    ss += __shfl_xor(ss, 16); ss += __shfl_xor(ss, 32);
                    const float rs = rsqrtf(ss * (1.f / 96.f) + EPS);
#pragma unroll
                    for (int jn = 0; jn < 4; ++jn) {
                        const f32x4 g4 = *(const f32x4*)(qkn + 96 + jn * 16 + fq * 4);
                        const f32x4 v = hold[i][jn] * rs * g4;
                        u32x2 pv; pv[0] = pk2(v[0], v[1]); pv[1] = pk2(v[2], v[3]);
                        *(u32x2*)(sK + m * 256 + (((jn * 2 + (fq >> 1)) ^ (m & 15)) << 4) + (fq & 1) * 8) = pv;
                    }
                    const f32x4 g1 = *(const f32x4*)(qkn + 96 + 64 + base), g2 = *(const f32x4*)(qkn + 96 + 64 + base + 8);
                    f32x4 a1 = z1 * rs * g1, a2 = z2 * rs * g2;
                    if (islat) {
                        const int s = t & (SEQ - 1);
                        const int pos = (fq >> 1) == 0 ? (s >> 6) : (s & 63);
                        const f32x4 cs = *(const f32x4*)(RC + pos * 8 + (fq & 1) * 4), sn = *(const f32x4*)(RS + pos * 8 + (fq & 1) * 4);
                        const f32x4 b1 = a1 * cs - a2 * sn, b2 = a2 * cs + a1 * sn;
                        a1 = b1; a2 = b2;
                    }
                    u32x2 p1, p2; p1[0] = pk2(a1[0], a1[1]); p1[1] = pk2(a1[2], a1[3]); p2[0] = pk2(a2[0], a2[1]); p2[1] = pk2(a2[2], a2[3]);
                    const int c1 = 8 + (fq >> 1) * 2;
                    *(u32x2*)(sK + m * 256 + ((c1 ^ (m & 15)) << 4) + (fq & 1) * 8) = p1;
                    *(u32x2*)(sK + m * 256 + (((c1 + 1) ^ (m & 15)) << 4) + (fq & 1) * 8) = p2;
                }
                {
                    const bool odd = fr & 1;
                    const int mp = perm_key(m & ~1);
#pragma unroll
                    for (int jn = 0; jn < 4; ++jn) {
                        const f32x4 v = hold[i][jn];
                        const float r0 = __shfl_xor(odd ? v[0] : v[2], 1), r1 = __shfl_xor(odd ? v[1] : v[3], 1);
                        if (wn == 1) {
                            const int e0 = jn * 16 + fq * 4 + (odd ? 2 : 0);
                            const unsigned w0 = odd ? pk2(r0, v[2]) : pk2(v[0], r0), w1 = odd ? pk2(r1, v[3]) : pk2(v[1], r1);
                            *(unsigned*)(sV + e0 * 256 + (((mp >> 3) ^ (e0 & 15)) << 4) + (mp & 6) * 2) = w0;
                            *(unsigned*)(sV + (e0 + 1) * 256 + (((mp >> 3) ^ ((e0 + 1) & 15)) << 4) + (mp & 6) * 2) = w1;
                        }
                    }
                }
            }
            __syncthreads();
            bf16_t* kdst = Kb + ((size_t)(bb * 16 + head) * NKEY + kp0) * 96;
#pragma unroll
            for (int it = 0; it < 8; ++it) {
                const int idx = tz + it * NTHR, row = idx >> 4, ch = idx & 15;
                if (ch < 12) {
                    const u32x4 v = *(const u32x4*)(sK + row * 256 + ((ch ^ (row & 15)) << 4));
                    *(u32x4*)(kdst + (size_t)row * 96 + ch * 8) = v;
                }
            }
            bf16_t* vdst = VT + ((size_t)(bb * 16 + head) * 64) * NKEY + kp0;
#pragma unroll
            for (int it = 0; it < 4; ++it) {
                const int idx = tz + it * NTHR, row = idx >> 4, ch = idx & 15;
                const u32x4 v = *(const u32x4*)(sV + row * 256 + ((ch ^ (row & 15)) << 4));
                *(u32x4*)(vdst + (size_t)row * NKEY + ch * 8) = v;
            }
        }
    }
}

DI void phase_mla_attn(const Args& a) {
    const int tid = threadIdx.x, lane = tid & 63, wave = tid >> 6;
    const int r = lane & 31, h = lane >> 5;
    const bf16_t* Q = (const bf16_t*)(a.ws + MLA_Q); const bf16_t* Kb = (const bf16_t*)(a.ws + MLA_K); const bf16_t* VT = (const bf16_t*)(a.ws + MLA_VT);
    bf16_t* O = (bf16_t*)(a.ws + MLA_O);
    constexpr int KT_B = 64 * 256, VT_B = 64 * 128, ST_B = KT_B + VT_B;
    unsigned* sCv = (unsigned*)(lds + 49152);
    const int cv_per = 18432 / gridDim.x;
    int cvn = 0, itc = 0;
    bool cv_pack_p = false, cv_flush_p = false;
    CvTile cvB, cvC; cvB.src = nullptr; cvB.dst = nullptr; cvB.K = 0; cvB.N = 0; cvB.perm = 0; cvB.k0 = 0; cvB.n0 = 0; cvC = cvB;
    f32x4 cv0[4], cv1[4];
#pragma unroll
    for (int i = 0; i < 4; ++i) { cv0[i] = (f32x4){0.f, 0.f, 0.f, 0.f}; cv1[i] = cv0[i]; }
    auto cv_step = [&](bool may_load) {
        if (cv_flush_p) { cv_flush(cvC, sCv); cv_flush_p = false; }
        if (cv_pack_p) { cv_pack(sCv, cv0, cv1); cvC = cvB; cv_flush_p = true; cv_pack_p = false; }
        if (may_load && cvn < cv_per) {
            const int t = cvn * gridDim.x + blockIdx.x;
            cvB = moe_cv_tile(a, 1 + t / 6144, t % 6144); cv_load(cvB, cv0, cv1); cv_pack_p = true; ++cvn;
        }
    };
    for (int u = blockIdx.x; u < 2048 + 256; u += gridDim.x) {
        const bool isctx = u >= 2048;
        const int uu = isctx ? u - 2048 : u;
        const int xc_ = uu & 7, s_ = uu >> 3, bh_ = ((s_ >> 4) << 3) + xc_;
        const int qb = isctx ? (uu & 1) : (s_ & 15), head = isctx ? ((uu >> 1) & 15) : (bh_ & 15), b = isctx ? (uu >> 5) : (bh_ >> 4);
        const int ntile = isctx ? CTXL / 64 : NKEY / 64;
        const int t = (isctx ? NLAT + b * CTXL : b * SEQ) + qb * 128 + wave * 32 + r;
        const bf16_t* kbase = Kb + (size_t)(b * 16 + head) * NKEY * 96;
        const bf16_t* vbase = VT + (size_t)(b * 16 + head) * 64 * NKEY;
        bf16x8 qf[6];
#pragma unroll
        for (int kk = 0; kk < 6; ++kk) qf[kk] = *(const bf16x8*)(Q + (size_t)t * 1536 + head * 96 + kk * 16 + h * 8);
        f32x16 o[2];
#pragma unroll
        for (int e = 0; e < 16; ++e) { o[0][e] = 0.f; o[1][e] = 0.f; }
        float lsum = 0.f;
        __syncthreads();
        auto stage = [&](int kt, int buf) {
            char* sk = lds + buf * ST_B; char* sv = sk + KT_B;
            const int key0 = kt * 64;
#pragma unroll
            for (int i = 0; i < 4; ++i) {
                const int idx = tid + i * NTHR, row = idx >> 4; int c = (idx & 15) ^ (row & 15); if (c >= 12) c = 0;
                dma16(kbase + (size_t)(key0 + row) * 96 + c * 8, sk + idx * 16);
            }
#pragma unroll
            for (int i = 0; i < 2; ++i) {
                const int idx = tid + i * NTHR, row = idx >> 3, c = (idx & 7) ^ ((row >> 1) & 7);
                dma16(vbase + (size_t)row * NKEY + key0 + c * 8, sv + idx * 16);
            }
        };
        stage(0, 0);
#pragma unroll 1
        for (int kt = 0; kt < ntile; ++kt) {
            wait_vm0();
            __syncthreads();
            if (kt + 1 < ntile) stage(kt + 1, (kt + 1) & 1);
            cv_step((itc & 3) == 0); ++itc;
            const char* sk = lds + (kt & 1) * ST_B; const char* sv = sk + KT_B;
            f32x16 st[2];
#pragma unroll
            for (int e = 0; e < 16; ++e) { st[0][e] = -8.f; st[1][e] = -8.f; }
#pragma unroll
            for (int kk = 0; kk < 6; ++kk)
#pragma unroll
                for (int si = 0; si < 2; ++si) {
                    const int s = si * 32 + r;
                    st[si] = mfma32(ldsv8(sk + swz256(s, kk * 2 + h)), qf[kk], st[si]);
                }
            float ps = 0.f;
#pragma unroll
            for (int si = 0; si < 2; ++si)
#pragma unroll
                for (int e = 0; e < 16; ++e) { const float p = __builtin_amdgcn_exp2f(st[si][e]); st[si][e] = p; ps += p; }
            lsum += ps;
#pragma unroll
            for (int si = 0; si < 2; ++si)
#pragma unroll
                for (int ks = 0; ks < 2; ++ks) {
                    u32x4 pp;
                    pp[0] = pk2(st[si][8 * ks + 0], st[si][8 * ks + 1]); pp[1] = pk2(st[si][8 * ks + 2], st[si][8 * ks + 3]);
                    pp[2] = pk2(st[si][8 * ks + 4], st[si][8 * ks + 5]); pp[3] = pk2(st[si][8 * ks + 6], st[si][8 * ks + 7]);
                    const bf16x8 pf = __builtin_bit_cast(bf16x8, pp);
#pragma unroll
                    for (int et = 0; et < 2; ++et) {
                        const int e = et * 32 + r;
                        o[et] = mfma32(ldsv8(sv + e * 128 + (((si * 4 + ks * 2 + h) ^ ((e >> 1) & 7)) << 4)), pf, o[et]);
                    }
                }
        }
        lsum += __shfl_xor(lsum, 32);
        const float inv = 1.f / lsum;
#pragma unroll
        for (int et = 0; et < 2; ++et)
#pragma unroll
            for (int g = 0; g < 4; ++g) {
                f32x4 v; v[0] = o[et][4 * g] * inv; v[1] = o[et][4 * g + 1] * inv; v[2] = o[et][4 * g + 2] * inv; v[3] = o[et][4 * g + 3] * inv;
                st_bf4(O + (size_t)t * D + head * 64 + et * 32 + 8 * g + 4 * h, v);
            }
    }
    while (cvn < cv_per || cv_pack_p || cv_flush_p) { __syncthreads(); cv_step(!cv_pack_p && !cv_flush_p); }
}

DI void phase_mla_out(const Args& a, int li) {
    gemm_dense_phase((const bf16_t*)(a.ws + MLA_O), D, NTOK, (const bf16_t*)(a.ws + W_MO), 1024, 1024,
        [&](int m0, int n0, const f32x4 (&acc)[4][4]) { epi_resid_f32(a, li, m0, n0, acc); });
}

DI void phase_ml_in(const Args& a) {
    bf16_t* Qm = (bf16_t*)(a.ws + ML_Q); bf16_t* Km = (bf16_t*)(a.ws + ML_K); bf16_t* KT = (bf16_t*)(a.ws + ML_KT); bf16_t* VT = (bf16_t*)(a.ws + ML_VT);
    bf16_t* OG = (bf16_t*)(a.ws + ML_OG); float* GT = (float*)(a.ws + ML_GT);
    const float* gb = a.in[23];
    auto ident = [](int, int, const f32x4 v) { return v; };
    gemm_dense_phase<false>((const bf16_t*)(a.ws + WS_H), D, NTOK, (const bf16_t*)(a.ws + W_MLIN), 3200, 1024,
        [&](int m0, int n0, const f32x4 (&acc)[4][4]) {
            if (n0 < 512) {
                epi_bf16_rowmajor(acc, [](int, int, const f32x4 v) { return v * 0.08838834764831845f; }, [&](int row) { return Qm + (size_t)(m0 + row) * 512 + n0; });
            } else if (n0 < 1024) {
                epi_bf16_rowmajor(acc, ident, [&](int row) { return Km + (size_t)(m0 + row) * 512 + (n0 - 512); });
                __syncthreads();
                epi_stage_bf16_T(acc, ident);
                __syncthreads();
                epi_flush_bf16([&](int row) { return KT + (size_t)(n0 - 512 + row) * NTOK + m0; }, [](int) { return true; });
            } else if (n0 < 2048) {
                __syncthreads();
                epi_stage_bf16_T(acc, ident);
                __syncthreads();
                epi_flush_bf16([&](int row) { return VT + (size_t)(n0 - 1024 + row) * NTOK + m0; }, [](int) { return true; });
            } else if (n0 < 3072) {
                epi_bf16_rowmajor(acc, [](int, int, const f32x4 v) { f32x4 s; s[0] = sigmoidf_(v[0]); s[1] = sigmoidf_(v[1]); s[2] = sigmoidf_(v[2]); s[3] = sigmoidf_(v[3]); return s; },
                                  [&](int row) { return OG + (size_t)(m0 + row) * D + (n0 - 2048); });
            } else {
#pragma unroll
                for (int i = 0; i < 4; ++i) {
                    const int n = lane_n(0);
                    if (n < 16) { f32x4 s = acc[i][0]; s[0] += gb[n]; s[1] += gb[n + 1]; s[2] += gb[n + 2]; s[3] += gb[n + 3]; *(f32x4*)(GT + (size_t)(m0 + lane_m(i)) * 16 + n) = s; }
                }
            }
        });
}

DI void phase_ml_scan(const Args& a) {
    const int tid = threadIdx.x, lane = tid & 63, wave = tid >> 6;
    const int fr = lane & 15, fq = lane >> 4;
    const bf16_t* Qm = (const bf16_t*)(a.ws + ML_Q); const bf16_t* Km = (const bf16_t*)(a.ws + ML_K);
    const bf16_t* KT = (const bf16_t*)(a.ws + ML_KT); const bf16_t* VT = (const bf16_t*)(a.ws + ML_VT);
    const float* GT = (const float*)(a.ws + ML_GT);
    bf16_t* HS = (bf16_t*)(a.ws + ML_HS);
    char* sQ = lds;
    char* sK = lds + 16384;
    char* sS = sK;
    char* sKT = lds + 32768;
    char* sVT = lds + 49152;
    char* sCT = lds + 55296;
    float* sRow = (float*)(lds + 67584);
    float* sCol = sRow + 64;
    float* sInt = sCol + 64;
    float* sNrm = sInt + 64;
    float* sWv = sNrm + 64;
    float* sSc = sWv + 64;
    for (int u = blockIdx.x; u < 512; u += gridDim.x) {
        const int xc_ = u & 7, s_ = u >> 3, bh_ = ((s_ >> 4) << 3) + xc_;
        const int sl = s_ & 7, dir = (s_ >> 3) & 1, head = bh_ & 3, b = bh_ >> 2;
        auto chunk_t0 = [&](int ci) {
            const int seg = ci >= 4, L = seg ? SEQ : CTXL, nch = L / 64, jc = seg ? ci - 4 : ci;
            const int oc = dir ? nch - 1 - jc : jc;
            return (seg ? b * SEQ : NLAT + b * CTXL) + oc * 64;
        };
        u32x4 pq[4], pk[4], pkt[4], pvt;
        float gi_n = 0.f, gf_n = 0.f;
        auto load_tiles = [&](int t0) {
#pragma unroll
            for (int i = 0; i < 4; ++i) {
                const int idx = tid + i * NTHR, row = idx >> 4, c = (idx & 15) ^ (row & 15);
                pq[i] = *(const u32x4*)(Qm + (size_t)(t0 + row) * 512 + head * 128 + c * 8);
                pk[i] = *(const u32x4*)(Km + (size_t)(t0 + row) * 512 + head * 128 + c * 8);
            }
#pragma unroll
            for (int i = 0; i < 4; ++i) {
                const int idx = tid + i * NTHR, row = idx >> 3, c = (idx & 7) ^ (row & 7);
                pkt[i] = *(const u32x4*)(KT + (size_t)(head * 128 + row) * NTOK + t0 + c * 8);
            }
            { const int row = tid >> 3, c = (tid & 7) ^ (row & 7); pvt = *(const u32x4*)(VT + (size_t)(head * 256 + sl * 32 + row) * NTOK + t0 + c * 8); }
            if (wave == 0) {
                const int s = dir ? 63 - lane : lane;
                gi_n = GT[(size_t)(t0 + s) * 16 + dir * 8 + head];
                gf_n = GT[(size_t)(t0 + s) * 16 + dir * 8 + 4 + head];
            }
        };
        auto store_tiles = [&]() {
#pragma unroll
            for (int i = 0; i < 4; ++i) { *(u32x4*)(sQ + (tid + i * NTHR) * 16) = pq[i]; *(u32x4*)(sK + (tid + i * NTHR) * 16) = pk[i]; *(u32x4*)(sKT + (tid + i * NTHR) * 16) = pkt[i]; }
            *(u32x4*)(sVT + tid * 16) = pvt;
        };
        auto gate_scalars = [&]() {
            const int s = dir ? 63 - lane : lane;
            const float ig = gi_n, fg = gf_n;
            const float lf = fminf(fg, 0.f) - __logf(1.f + fexp(-fabsf(fg)));
            float bc = lf;
#pragma unroll
            for (int d = 1; d < 64; d <<= 1) { const float o = __shfl_up(bc, d); if (lane >= d) bc += o; }
            const float av = ig - bc;
            float pm = av;
#pragma unroll
            for (int d = 1; d < 64; d <<= 1) { const float o = __shfl_up(pm, d); if (lane >= d) pm = fmaxf(pm, o); }
            const float mst = sSc[1];
            const float mm = fmaxf(mst, pm);
            sRow[s] = -mm;
            sCol[s] = av;
            sInt[s] = fexp(mst - mm);
            sNrm[s] = fexp(-(bc + mm));
            const float mmL = __shfl(mm, 63), bL = __shfl(bc, 63);
            sWv[s] = fexp(av - mmL);
            if (lane == 0) { sSc[0] = fexp(mst - mmL); sSc[1] = bL + mmL; }
        };
        __syncthreads();
        for (int i = tid; i < 12288 / 16; i += NTHR) *(u32x4*)(sCT + i * 16) = (u32x4){0u, 0u, 0u, 0u};
        for (int i = tid; i < 16 * 8; i += NTHR) {
            const int row = 32 + (i >> 3), c = i & 7;
            const unsigned v = row == 32 ? 0x3f803f80u : 0u;
            *(u32x4*)(sVT + swz128(row, c)) = (u32x4){v, v, v, v};
        }
        if (tid == 0) sSc[1] = -1e30f;
        f32x4 accC[2][3];
#pragma unroll
        for (int i = 0; i < 2; ++i)
#pragma unroll
            for (int jn = 0; jn < 3; ++jn) accC[i][jn] = (f32x4){0.f, 0.f, 0.f, 0.f};
        load_tiles(chunk_t0(0));
        __syncthreads();
        store_tiles();
        if (wave == 0) gate_scalars();
        __syncthreads();
#pragma unroll 1
        for (int ci = 0; ci < 36; ++ci) {
            const int t0 = chunk_t0(ci);
            if (ci + 1 < 36) load_tiles(chunk_t0(ci + 1));
            f32x4 sacc[4];
#pragma unroll
            for (int jt = 0; jt < 4; ++jt) sacc[jt] = (f32x4){0.f, 0.f, 0.f, 0.f};
#pragma unroll
            for (int kk = 0; kk < 4; ++kk) {
                const bf16x8 qf = ldsv8(sQ + swz256(wave * 16 + fr, kk * 4 + fq));
#pragma unroll
                for (int jt = 0; jt < 4; ++jt) sacc[jt] = mfma16(ldsv8(sK + swz256(jt * 16 + fr, kk * 4 + fq)), qf, sacc[jt]);
            }
            __syncthreads();
            {
                const int tq = wave * 16 + fr;
                const float rt = sRow[tq];
#pragma unroll
                for (int jt = 0; jt < 4; ++jt) {
                    const f32x4 cl = *(const f32x4*)(sCol + jt * 16 + fq * 4);
                    f32x4 v;
#pragma unroll
                    for (int e = 0; e < 4; ++e) {
                        const int s = jt * 16 + fq * 4 + e;
                        const bool ok = dir ? (s >= tq) : (s <= tq);
                        v[e] = ok ? sacc[jt][e] * fexp(rt + cl[e]) : 0.f;
                    }
                    u32x2 pv; pv[0] = pk2(v[0], v[1]); pv[1] = pk2(v[2], v[3]);
                    *(u32x2*)(sS + swz128(tq, jt * 2 + (fq >> 1)) + (fq & 1) * 8) = pv;
                }
            }
            __syncthreads();
            {
                f32x4 n1[3], n2[3];
#pragma unroll
                for (int jt = 0; jt < 3; ++jt) { n1[jt] = (f32x4){0.f, 0.f, 0.f, 0.f}; n2[jt] = (f32x4){0.f, 0.f, 0.f, 0.f}; }
#pragma unroll
                for (int kk = 0; kk < 2; ++kk) {
                    const bf16x8 sf = ldsv8(sS + swz128(wave * 16 + fr, kk * 4 + fq));
#pragma unroll
                    for (int jt = 0; jt < 3; ++jt) n1[jt] = mfma16(ldsv8(sVT + swz128(jt * 16 + fr, kk * 4 + fq)), sf, n1[jt]);
                }
#pragma unroll
                for (int kk = 0; kk < 4; ++kk) {
                    const bf16x8 qf = ldsv8(sQ + swz256(wave * 16 + fr, kk * 4 + fq));
#pragma unroll
                    for (int jt = 0; jt < 3; ++jt) n2[jt] = mfma16(ldsv8(sCT + swz256(jt * 16 + fr, kk * 4 + fq)), qf, n2[jt]);
                }
                const int tq = wave * 16 + fr;
                const float it = sInt[tq];
                float den = n1[2][0] + it * n2[2][0];
                den = __shfl(den, fr);
                const float dn = fmaxf(fabsf(den), sNrm[tq]);
                const float inv = rcpf_(dn);
                bf16_t* hp = HS + (size_t)dir * NTOK * D + (size_t)(t0 + tq) * D + head * 256 + sl * 32 + fq * 4;
#pragma unroll
                for (int jt = 0; jt < 2; ++jt) {
                    f32x4 v;
#pragma unroll
                    for (int e = 0; e < 4; ++e) v[e] = (n1[jt][e] + it * n2[jt][e]) * inv;
                    st_bf4(hp + jt * 16, v);
                }
            }
            {
                const float decay = sSc[0];
#pragma unroll
                for (int i = 0; i < 2; ++i)
#pragma unroll
                    for (int jn = 0; jn < 3; ++jn) accC[i][jn] *= decay;
#pragma unroll
                for (int kk = 0; kk < 2; ++kk) {
                    bf16x8 vf[3];
#pragma unroll
                    for (int jn = 0; jn < 3; ++jn) vf[jn] = ldsv8(sVT + swz128(jn * 16 + fr, kk * 4 + fq));
                    const f32x4 w0 = *(const f32x4*)(sWv + kk * 32 + fq * 8), w1 = *(const f32x4*)(sWv + kk * 32 + fq * 8 + 4);
#pragma unroll
                    for (int i = 0; i < 2; ++i) {
                        const u32x4 kr = *(const u32x4*)(sKT + swz128((wave * 2 + i) * 16 + fr, kk * 4 + fq));
                        u32x4 ks;
                        ks[0] = pk2(lof(kr[0]) * w0[0], hif(kr[0]) * w0[1]); ks[1] = pk2(lof(kr[1]) * w0[2], hif(kr[1]) * w0[3]);
                        ks[2] = pk2(lof(kr[2]) * w1[0], hif(kr[2]) * w1[1]); ks[3] = pk2(lof(kr[3]) * w1[2], hif(kr[3]) * w1[3]);
                        const bf16x8 kf = __builtin_bit_cast(bf16x8, ks);
#pragma unroll
                        for (int jn = 0; jn < 3; ++jn) accC[i][jn] = mfma16(kf, vf[jn], accC[i][jn]);
                    }
                }
            }
            __syncthreads();
#pragma unroll
            for (int i = 0; i < 2; ++i)
#pragma unroll
                for (int jn = 0; jn < 3; ++jn) {
                    const int dd = (wave * 2 + i) * 16 + fq * 4, ee = jn * 16 + fr;
                    u32x2 pv; pv[0] = pk2(accC[i][jn][0], accC[i][jn][1]); pv[1] = pk2(accC[i][jn][2], accC[i][jn][3]);
                    *(u32x2*)(sCT + swz256(ee, dd >> 3) + (dd & 7) * 2) = pv;
                }
            if (ci + 1 < 36) {
                store_tiles();
                if (wave == 0) gate_scalars();
            }
            __syncthreads();
        }
    }
}

DI void phase_ml_readout(const Args& a) {
    const int tid = threadIdx.x, lane = tid & 63, wave = tid >> 6;
    const bf16_t* H0 = (const bf16_t*)(a.ws + ML_HS); const bf16_t* H1 = H0 + (size_t)NTOK * D;
    const bf16_t* OG = (const bf16_t*)(a.ws + ML_OG); bf16_t* A2 = (bf16_t*)(a.ws + ML_A2);
    const float* on = a.in[24];
    for (int t = blockIdx.x * 4 + wave; t < NTOK; t += gridDim.x * 4) {
        const size_t off = (size_t)t * D + lane * 16;
        const u32x4 a0 = *(const u32x4*)(H0 + off), a1 = *(const u32x4*)(H0 + off + 8);
        const u32x4 b0 = *(const u32x4*)(H1 + off), b1 = *(const u32x4*)(H1 + off + 8);
        float v[16];
#pragma unroll
        for (int e = 0; e < 4; ++e) {
            v[2 * e] = lof(a0[e]) + lof(b0[e]); v[2 * e + 1] = hif(a0[e]) + hif(b0[e]);
            v[8 + 2 * e] = lof(a1[e]) + lof(b1[e]); v[8 + 2 * e + 1] = hif(a1[e]) + hif(b1[e]);
        }
        float ss = 0.f;
#pragma unroll
        for (int e = 0; e < 16; ++e) ss += v[e] * v[e];
        ss += __shfl_xor(ss, 1); ss += __shfl_xor(ss, 2); ss += __shfl_xor(ss, 4); ss += __shfl_xor(ss, 8);
        const float rs = rsqrtf(ss * (1.f / 256.f) + EPS);
        const u32x4 g0 = *(const u32x4*)(OG + off), g1 = *(const u32x4*)(OG + off + 8);
        const float* onp = on + lane * 16;
        u32x4 o0, o1;
#pragma unroll
        for (int e = 0; e < 4; ++e) {
            o0[e] = pk2(v[2 * e] * rs * onp[2 * e] * lof(g0[e]), v[2 * e + 1] * rs * onp[2 * e + 1] * hif(g0[e]));
            o1[e] = pk2(v[8 + 2 * e] * rs * onp[8 + 2 * e] * lof(g1[e]), v[8 + 2 * e + 1] * rs * onp[8 + 2 * e + 1] * hif(g1[e]));
        }
        *(u32x4*)(A2 + off) = o0; *(u32x4*)(A2 + off + 8) = o1;
    }
}

DI void phase_ml_out(const Args& a, int li) {
    gemm_dense_phase((const bf16_t*)(a.ws + ML_A2), D, NTOK, (const bf16_t*)(a.ws + W_MLOUT), 1024, 1024,
        [&](int m0, int n0, const f32x4 (&acc)[4][4]) { epi_resid_f32(a, li, m0, n0, acc); });
}

template <int STAGE>
DI void phase_moe(const Args& a, int li) {
    const int tid = threadIdx.x, lane = tid & 63, wave = tid >> 6;
    const int fr = lane & 15, fq = lane >> 4, wm = wave >> 1, wn = wave & 1;
    const int* cnt = (const int*)(a.ws + WS_CTL + CTL_CNT) + li * 64;
    const int* list = (const int*)(a.ws + WS_LIST);
    const float* wsl = (const float*)(a.ws + WS_WSLOT);
    const bf16_t* F = (const bf16_t*)(a.ws + WS_H);
    bf16_t* HM = (bf16_t*)(a.ws + WS_HMID); bf16_t* Y = (bf16_t*)(a.ws + WS_Y);
    int* pre = (int*)(lds + LDS_AUX);
    int* srowb = pre + 16;
    const int xc = blockIdx.x & 7, rank = blockIdx.x >> 3, nrank = gridDim.x >> 3;
    __syncthreads();
    if (tid == 0) { int s = 0; for (int i = 0; i < 8; ++i) { pre[i] = s; s += (cnt[xc + 8 * i] + 127) >> 7; } pre[8] = s; }
    __syncthreads();
    const int T = pre[8];
    constexpr int NTN = STAGE == 0 ? 4 : 8;
    constexpr int KK = STAGE == 0 ? 1024 : 256;
    const int total = T * NTN;
    int e = 0, r0 = 0, ce = 0, nt = 0, cur = 0;
    auto decode = [&](int u) {
        const int ti = u / NTN; nt = u % NTN;
        int ei = 0;
#pragma unroll 1
        for (int s = 4; s > 0; s >>= 1) if (pre[ei + s] <= ti) ei += s;
        e = xc + 8 * ei; r0 = (ti - pre[ei]) * 128; ce = cnt[e];
    };
    GemmPipe g;
    auto prep = [&](int buf) {
        int* srow = srowb + buf * 128;
        if (tid < 128) srow[tid] = list[(size_t)e * NTOK + min(r0 + tid, ce - 1)];
        __syncthreads();
        if (STAGE == 0) g.setup([&](int r) { return F + (size_t)(srow[r] >> 1) * D; }, (const bf16_t*)(a.ws + W_GU) + ((size_t)(li * 64 + e) * 512 + nt * 128) * 1024, 1024);
        else g.setup([&](int r) { return HM + (size_t)srow[r] * 256; }, (const bf16_t*)(a.ws + W_DN) + ((size_t)(li * 64 + e) * 1024 + nt * 128) * 256, 256);
        g.issue(0, 0);
    };
    int u = rank;
    if (u < total) { decode(u); prep(cur); }
    while (u < total) {
        f32x4 acc[4][4];
        g.run(KK, acc);
        const int cr0 = r0, cce = ce, cnt_ = nt;
        const int* srow = srowb + cur * 128;
        u += nrank;
        if (u < total) { decode(u); prep(cur ^ 1); }
        if (STAGE == 0) {
            __syncthreads();
            {
                const int tz = opaque_tid();
#pragma unroll
                for (int i = 0; i < 4; ++i) {
                    const int m = lane_m(tz, i);
#pragma unroll
                    for (int p = 0; p < 2; ++p) {
                        const int c = (((tz >> 6) & 1) * 2 + p) * 16 + ((tz >> 4) & 3) * 4;
                        f32x4 v;
#pragma unroll
                        for (int x = 0; x < 4; ++x) { const float gg = acc[i][2 * p][x]; v[x] = gg * rcpf_(1.f + fexp(-gg)) * acc[i][2 * p + 1][x]; }
                        u32x2 o; o[0] = pk2(v[0], v[1]); o[1] = pk2(v[2], v[3]);
                        *(u32x2*)(lds + EPI_OFF + m * 128 + (((c >> 3) ^ (m & 7)) << 4) + (c & 4) * 2) = o;
                    }
                }
            }
            __syncthreads();
            {
                const int tz = opaque_tid();
#pragma unroll
                for (int it = 0; it < 4; ++it) {
                    const int idx = tz + it * NTHR, row = idx >> 3, ch = idx & 7;
                    const u32x4 v = *(const u32x4*)(lds + EPI_OFF + row * 128 + ((ch ^ (row & 7)) << 4));
                    if (cr0 + row < cce) *(u32x4*)(HM + (size_t)srow[row] * 256 + cnt_ * 64 + ch * 8) = v;
                }
            }
        } else {
            float wrow[4];
            {
                const int tz = opaque_tid();
#pragma unroll
                for (int i = 0; i < 4; ++i) wrow[i] = wsl[srow[lane_m(tz, i)]];
            }
            __syncthreads();
            epi_stage_bf16(acc, [&](int i, int, const f32x4 v) { return v * wrow[i]; });
            __syncthreads();
            epi_flush_bf16([&](int row) { return Y + (size_t)srow[row] * D + cnt_ * 128; }, [&](int row) { return cr0 + row < cce; });
        }
        cur ^= 1;
    }
    __syncthreads();
}

#ifndef DBG_GPROBE
#define DBG_GPROBE -1
#endif
template <int PM>
DI void phase_gemm_probe(const Args& a) {
    const bf16_t* A = (const bf16_t*)(a.ws + WS_H); const bf16_t* Bt = (const bf16_t*)(a.ws + W_RGIN);
    float* dummy = (float*)(a.ws + RG_A2);
    const int mt = 144, nt = 16, K = 1024;
    GemmPipe g;
    __syncthreads();
    for (int u = blockIdx.x; u < mt * nt; u += gridDim.x) {
        const int m0 = (u % mt) * 128, n0 = (u / mt) * 128;
        g.setup([&](int r) { return A + (size_t)(m0 + r) * 1024; }, Bt + (size_t)n0 * K, K);
        if (PM & 1) g.issue(0, 0);
        f32x4 acc[4][4];
        g.run_probe<PM>(K, acc);
        float s = 0.f;
#pragma unroll
        for (int i = 0; i < 4; ++i)
#pragma unroll
            for (int j = 0; j < 4; ++j) s += acc[i][j][0] + acc[i][j][1] + acc[i][j][2] + acc[i][j][3];
        if (s == 12345.678f) dummy[threadIdx.x] = s;
        if (PM & 8) {
            bf16_t* Yd = (bf16_t*)(a.ws + WS_Y);
            const int lane = threadIdx.x & 63, wave = threadIdx.x >> 6;
            const int mb = m0 + (wave >> 1) * 64 + (lane & 15), nb = n0 + (wave & 1) * 64 + (lane >> 4) * 4;
#pragma unroll
            for (int i = 0; i < 4; ++i)
#pragma unroll
                for (int j = 0; j < 4; ++j) {
                    f32x4 v = acc[i][j];
                    if (PM & 16) { v[0] = gelu_tanh(v[0]); v[1] = gelu_tanh(v[1]); v[2] = gelu_tanh(v[2]); v[3] = gelu_tanh(v[3]); }
                    st_bf4(Yd + (size_t)(mb + i * 16) * 2048 + nb + j * 16, v);
                }
        }
        __syncthreads();
    }
}

#ifndef DBG_STOP
#define DBG_STOP 99
#endif
#ifndef DBG_OFF
#define DBG_OFF 0
#endif
DI void phase_dbg(const Args& a) {
    const size_t n = (size_t)NLAT * D;
    const float* X = (const float*)(a.ws + WS_X);
    const bf16_t* B = (const bf16_t*)(a.ws + (size_t)DBG_OFF);
    for (size_t i = (size_t)blockIdx.x * NTHR + threadIdx.x; i < n; i += (size_t)gridDim.x * NTHR)
        a.out[i] = DBG_OFF ? bf2f(B[i]) : X[i];
}

constexpr int NPH = 34;
__global__ void __launch_bounds__(NTHR, 2) fwd(const Args a) {
    if (threadIdx.x == 0) *(uint4*)(lds + LDS_BARW) = make_uint4(0u, 0u, 0u, 0u);
    __syncthreads();
    XcdBarrier bar;
    const bool multi = (a.ph_hi - a.ph_lo) > 1;
    if (multi) bar = xcd_barrier_post((unsigned*)(a.ws + WS_CTL), (volatile LAS unsigned*)(lds + LDS_BARW));
#ifndef DBG_REP
#define DBG_REP -1
#endif
#ifndef DBG_REPN
#define DBG_REPN 3
#endif
#define RUN(id, ...) do { if (a.ph_lo <= (id) && (id) < a.ph_hi) { \
        if ((id) == DBG_REP) { for (int rep_ = 1; rep_ < DBG_REPN; ++rep_) { __VA_ARGS__; xcd_barrier(bar); } } \
        __VA_ARGS__; if ((id) + 1 < a.ph_hi) xcd_barrier(bar); } } while (0)
    RUN(0, phase_prologue(a));
    RUN(1, phase_token_row<0>(a, 0));
    RUN(2, phase_rg_in(a, 0));
    if (DBG_GPROBE >= 0) { RUN(2, phase_gemm_probe<(DBG_GPROBE < 0 ? 7 : DBG_GPROBE)>(a)); }
#ifdef DBG_SCANVAR
    RUN(3, phase_rg_scan<DBG_SCANVAR>(a, 0));
#endif
    RUN(3, phase_rg_scan(a, 0));
    RUN(4, phase_rg_combine(a));
    RUN(5, phase_rg_out(a, 0, 0));
    RUN(6, phase_token_router(a, 0));
    RUN(7, phase_moe<0>(a, 0));
    RUN(8, phase_moe<1>(a, 0));
    RUN(9, phase_token_row<0>(a, 1));
    RUN(10, phase_mla_down(a));
    RUN(11, phase_mla_up(a));
    RUN(12, phase_mla_attn(a));
    RUN(13, phase_mla_out(a, 1));
    RUN(14, phase_token_router(a, 1));
    RUN(15, phase_moe<0>(a, 1));
    RUN(16, phase_moe<1>(a, 1));
    RUN(17, phase_token_row<0>(a, 2));
    RUN(18, phase_ml_in(a));
    RUN(19, phase_ml_scan(a));
    RUN(20, phase_ml_readout(a));
    RUN(21, phase_ml_out(a, 2));
    RUN(22, phase_token_router(a, 2));
    RUN(23, phase_moe<0>(a, 2));
    RUN(24, phase_moe<1>(a, 2));
    RUN(25, phase_token_row<0>(a, 3));
    RUN(26, phase_rg_in(a, 1));
    RUN(27, phase_rg_scan(a, 1));
    RUN(28, phase_rg_combine(a));
    RUN(29, phase_rg_out(a, 3, 1));
    RUN(30, phase_token_router(a, 3));
    RUN(31, phase_moe<0>(a, 3));
    RUN(32, phase_moe<1>(a, 3));
    RUN(33, phase_token_row<2>(a, 3));
    RUN(34, phase_dbg(a));
#undef RUN
}

static void add_td(Args& a, int& n, int& tile0, const float* src, bf16_t* dst, const float* rscale, long sb, long db, int K, int N, int Npad, int batch, int perm) {
    TDesc& t = a.td[n++];
    t.src = src; t.dst = dst; t.rscale = rscale; t.sb = sb; t.db = db; t.K = K; t.N = N; t.Npad = Npad; t.batch = batch; t.perm = perm;
    t.tiles_k = (K + 127) / 128; t.tiles_n = (Npad + 63) / 64; t.tile0 = tile0;
    tile0 += batch * t.tiles_k * t.tiles_n;
}

extern "C" void kernel_launch(void* const* d_in, const int* in_sizes, int n_in, void* d_out, int out_size, void* d_ws, size_t ws_size, hipStream_t stream) {
    static int grid = 0;
    if (grid == 0) {
        if (n_in != 32 || out_size != NLAT * D || ws_size < WS_END) { fprintf(stderr, "kernel_launch: unexpected sizes (n_in %d out %d ws %zu need %zu)\n", n_in, out_size, ws_size, (size_t)WS_END); grid = -1; return; }
        int dev = 0, cus = 0, per_cu = 0;
        (void)hipGetDevice(&dev);
        (void)hipDeviceGetAttribute(&cus, hipDeviceAttributeMultiprocessorCount, dev);
        if (hipOccupancyMaxActiveBlocksPerMultiprocessor(&per_cu, (const void*)fwd, NTHR, 0) != hipSuccess) per_cu = 0;
        (void)hipGetLastError();
        if (per_cu < 2) fprintf(stderr, "kernel_launch: note: occupancy query reports %d blocks per CU (need 2)\n", per_cu);
        grid = cus * (per_cu >= 2 ? 2 : (per_cu >= 1 ? 1 : 2));
    }
    if (grid < 0) return;
    (void)in_sizes;
    (void)hipMemsetAsync((char*)d_ws + WS_CTL, 0, CTL_BYTES, stream);
    Args a;
    memset(&a, 0, sizeof(a));
    for (int i = 0; i < 32; ++i) a.in[i] = (const float*)d_in[i];
    a.out = (float*)d_out; a.ws = (unsigned char*)d_ws;
    unsigned char* ws = (unsigned char*)d_ws;
    int n = 0, tile0 = 0;
    add_td(a, n, tile0, a.in[8], (bf16_t*)(ws + W_RGIN), nullptr, 1024L * 2048, 2048L * 1024, 1024, 2048, 2048, 2, 0);
    add_td(a, n, tile0, a.in[14], (bf16_t*)(ws + W_RGOUT), nullptr, 1024L * 1024, 1024L * 1024, 1024, 1024, 1024, 2, 0);
    for (int j = 0; j < 2; ++j) for (int dir = 0; dir < 2; ++dir) for (int g = 0; g < 2; ++g)
        add_td(a, n, tile0, a.in[11] + (size_t)((j * 2 + dir) * 2 + g) * 16 * 4096, (bf16_t*)(ws + W_RGG) + (size_t)(j * 2 + dir) * 16 * 8192 + g * 4096, nullptr, 4096, 8192, 64, 64, 64, 16, 0);
    add_td(a, n, tile0, a.in[15], (bf16_t*)(ws + W_MDOWN), nullptr, 0, 0, 1024, 416, 512, 1, 0);
    add_td(a, n, tile0, a.in[18], (bf16_t*)(ws + W_MUQ), a.in[16], 0, 0, 256, 1536, 1536, 1, 0);
    add_td(a, n, tile0, a.in[19], (bf16_t*)(ws + W_MUKV), a.in[17], 0, 0, 128, 2048, 2048, 1, 0);
    add_td(a, n, tile0, a.in[21], (bf16_t*)(ws + W_MO), nullptr, 0, 0, 1024, 1024, 1024, 1, 0);
    add_td(a, n, tile0, a.in[22], (bf16_t*)(ws + W_MLIN), nullptr, 0, 0, 1024, 3088, 3200, 1, 0);
    add_td(a, n, tile0, a.in[25], (bf16_t*)(ws + W_MLOUT), nullptr, 0, 0, 1024, 1024, 1024, 1, 0);
    add_td(a, n, tile0, a.in[30], (bf16_t*)(ws + W_GU), nullptr, 1024L * 512, 512L * 1024, 1024, 512, 512, 64, 1);
    add_td(a, n, tile0, a.in[31], (bf16_t*)(ws + W_DN), nullptr, 256L * 1024, 1024L * 256, 256, 1024, 1024, 64, 0);
    a.ntiles_total = tile0;
    if (n != NTD) { fprintf(stderr, "kernel_launch: descriptor count %d != %d\n", n, NTD); return; }
#if MK_ONE_LAUNCH
    a.ph_lo = 0; a.ph_hi = NPH;
    hipLaunchKernelGGL(fwd, dim3(grid), dim3(NTHR), 0, stream, a);
#else
    for (int ph = 0; ph < NPH && ph <= DBG_STOP; ++ph) {
        a.ph_lo = ph; a.ph_hi = ph + 1;
        hipLaunchKernelGGL(fwd, dim3(grid), dim3(NTHR), 0, stream, a);
    }
    if (DBG_STOP < NPH) { a.ph_lo = 34; a.ph_hi = 35; hipLaunchKernelGGL(fwd, dim3(grid), dim3(NTHR), 0, stream, a); }
#endif
}
```

```cpp
#include <hip/hip_runtime.h>
#include <stdint.h>
#include <string.h>
#include <stdio.h>

#ifndef MK_ONE_LAUNCH
#define MK_ONE_LAUNCH 1
#endif

#define DI __device__ __forceinline__
typedef unsigned short bf16_t;
typedef __attribute__((ext_vector_type(8))) short bf16x8;
typedef __attribute__((ext_vector_type(4))) float f32x4;
typedef __attribute__((ext_vector_type(16))) float f32x16;
typedef __attribute__((ext_vector_type(2))) float f32x2;
typedef __attribute__((ext_vector_type(2))) __bf16 bfx2;
typedef __attribute__((ext_vector_type(4))) unsigned u32x4;
typedef __attribute__((ext_vector_type(2))) unsigned u32x2;

constexpr int D = 1024, NB = 8, SEQ = 2048, CTXL = 256;
constexpr int NLAT = NB * SEQ, NCTX = NB * CTXL, NTOK = NLAT + NCTX;
constexpr int NKEY = CTXL + SEQ;
constexpr int NTHR = 256;
constexpr int LDS_BYTES = 73728;
constexpr int LDS_AUX = 65536;
constexpr int LDS_BARW = LDS_BYTES - 16;
constexpr float EPS = 1e-6f;

constexpr size_t al256(size_t x) { return (x + 255) & ~(size_t)255; }
constexpr size_t WS_CTL = 0;
constexpr size_t CTL_BYTES = 65536;
constexpr size_t CTL_CNT = 16384;
constexpr size_t CTL_ROPE = 32768;
constexpr size_t WS_MOD = WS_CTL + CTL_BYTES;
constexpr size_t WS_X = al256(WS_MOD + 4 * 9 * 6144 * 4);
constexpr size_t WS_H = al256(WS_X + (size_t)NTOK * D * 4);
constexpr size_t WS_SCR = al256(WS_H + (size_t)NTOK * D * 2);
constexpr size_t SCR_BYTES = (size_t)256 << 20;
constexpr size_t TOKD2 = (size_t)NTOK * D * 2;
constexpr size_t RG_G = WS_SCR, RG_U = RG_G + TOKD2, RG_HS = RG_U + TOKD2, RG_A2 = RG_HS + 2 * TOKD2;
constexpr size_t MLA_CQ = WS_SCR;
constexpr size_t MLA_CKV = MLA_CQ + (size_t)NTOK * 256 * 2;
constexpr size_t MLA_KR = MLA_CKV + (size_t)NTOK * 128 * 2;
constexpr size_t MLA_Q = MLA_KR + (size_t)NTOK * 32 * 4;
constexpr size_t MLA_K = MLA_Q + (size_t)NTOK * 1536 * 2;
constexpr size_t MLA_VT = MLA_K + (size_t)NB * 16 * NKEY * 96 * 2;
constexpr size_t MLA_O = MLA_VT + (size_t)NB * 16 * 64 * NKEY * 2;
constexpr size_t MLA_END = MLA_O + TOKD2;
constexpr size_t ML_Q = WS_SCR;
constexpr size_t ML_K = ML_Q + (size_t)NTOK * 512 * 2;
constexpr size_t ML_KT = ML_K + (size_t)NTOK * 512 * 2;
constexpr size_t ML_VT = ML_KT + (size_t)NTOK * 512 * 2;
constexpr size_t ML_OG = ML_VT + TOKD2;
constexpr size_t ML_GT = ML_OG + TOKD2;
constexpr size_t ML_HS = ML_GT + (size_t)NTOK * 16 * 4;
constexpr size_t ML_A2 = ML_HS + 2 * TOKD2;
constexpr size_t ML_END = ML_A2 + TOKD2;
static_assert(RG_A2 + TOKD2 <= WS_SCR + SCR_BYTES && MLA_END <= WS_SCR + SCR_BYTES && ML_END <= WS_SCR + SCR_BYTES, "scratch");
constexpr size_t WS_LIST = WS_SCR + SCR_BYTES;
constexpr size_t WS_WSLOT = al256(WS_LIST + (size_t)64 * NTOK * 4);
constexpr size_t WS_HMID = al256(WS_WSLOT + (size_t)2 * NTOK * 4);
constexpr size_t WS_Y = al256(WS_HMID + (size_t)2 * NTOK * 256 * 2);
constexpr size_t WS_W = al256(WS_Y + (size_t)2 * NTOK * D * 2);
constexpr size_t W_RGIN = WS_W;
constexpr size_t W_RGOUT = W_RGIN + (size_t)2 * 2048 * 1024 * 2;
constexpr size_t W_RGG = W_RGOUT + (size_t)2 * 1024 * 1024 * 2;
constexpr size_t W_MDOWN = W_RGG + (size_t)2 * 2 * 16 * 128 * 64 * 2;
constexpr size_t W_MUQ = W_MDOWN + (size_t)512 * 1024 * 2;
constexpr size_t W_MUKV = W_MUQ + (size_t)1536 * 256 * 2;
constexpr size_t W_MO = W_MUKV + (size_t)2048 * 128 * 2;
constexpr size_t W_MLIN = W_MO + (size_t)1024 * 1024 * 2;
constexpr size_t W_MLOUT = W_MLIN + (size_t)3200 * 1024 * 2;
constexpr size_t W_RT = W_MLOUT + (size_t)1024 * 1024 * 2;
constexpr size_t W_GU = al256(W_RT + (size_t)4 * 2 * 80 * 1024 * 2);
constexpr size_t W_DN = W_GU + (size_t)256 * 512 * 1024 * 2;
constexpr size_t WS_END = W_DN + (size_t)256 * 1024 * 256 * 2;

struct TDesc {
    const float* src; bf16_t* dst; const float* rscale;
    long sb, db;
    int K, N, Npad, batch;
    int perm, tiles_k, tiles_n, tile0;
};
constexpr int NTD = 18;
struct Args {
    const float* in[32];
    float* out;
    unsigned char* ws;
    TDesc td[NTD];
    int ntiles_total, ph_lo, ph_hi, pad0;
};

DI float bf2f(bf16_t v) { return __uint_as_float((unsigned)v << 16); }
DI unsigned pk2(float a, float b) { f32x2 v = {a, b}; bfx2 r = __builtin_convertvector(v, bfx2); return __builtin_bit_cast(unsigned, r); }
DI bf16_t f2bf(float a) { return (bf16_t)(pk2(a, 0.f) & 0xffffu); }
DI float lof(unsigned u) { return __uint_as_float(u << 16); }
DI float hif(unsigned u) { return __uint_as_float(u & 0xffff0000u); }
DI float rcpf_(float x) { return __builtin_amdgcn_rcpf(x); }
DI float fexp(float x) { return __builtin_amdgcn_exp2f(x * 1.4426950408889634f); }
DI float sigmoidf_(float x) { return rcpf_(1.f + fexp(-x)); }
DI float gelu_tanh(float x) { float u = 0.7978845608028654f * (x + 0.044715f * x * x * x); float e = fexp(2.f * u); return x * (1.f - rcpf_(e + 1.f)); }
DI int tok_modrow(int t) { return t < NLAT ? (t >> 11) : 8; }
DI void dma16(const void* g, char* l) { __builtin_amdgcn_global_load_lds((const unsigned*)g, (unsigned*)l, 16, 0, 0); }
DI void wait_vm0() { asm volatile("s_waitcnt vmcnt(0)" ::: "memory"); }
DI int swz128(int row, int chunk) { return row * 128 + ((chunk ^ (row & 7)) << 4); }
DI int swz256(int row, int chunk) { return row * 256 + ((chunk ^ (row & 15)) << 4); }
DI f32x4 mfma16(bf16x8 a, bf16x8 b, f32x4 c) { return __builtin_amdgcn_mfma_f32_16x16x32_bf16(a, b, c, 0, 0, 0); }
DI f32x16 mfma32(bf16x8 a, bf16x8 b, f32x16 c) { return __builtin_amdgcn_mfma_f32_32x32x16_bf16(a, b, c, 0, 0, 0); }
DI bf16x8 ldsv8(const char* p) { return *(const bf16x8*)p; }
DI void st_bf4(bf16_t* p, const f32x4 v) { u32x2 o; o[0] = pk2(v[0], v[1]); o[1] = pk2(v[2], v[3]); *(u32x2*)p = o; }

__shared__ __attribute__((aligned(16))) char lds[LDS_BYTES];

#define XB_TMO      128
#define XB_XCNT(j)  (256  + 64 * (j))
#define XB_XSUB(j)  (1280 + 64 * (j))
#define XB_XGEN(j)  (2304 + 64 * (j))
#define XB_TOP      3328
#define XB_TOPGEN   3392
#define XCD_BAR_WORDS 3456
#define XB_SPIN_CAP (1u << 22)
#define LAS __attribute__((address_space(3)))
DI unsigned xb_ld(unsigned* p)              { return __hip_atomic_load(p, __ATOMIC_RELAXED, __HIP_MEMORY_SCOPE_AGENT); }
DI unsigned xb_add(unsigned* p, unsigned v) { return __hip_atomic_fetch_add(p, v, __ATOMIC_RELAXED, __HIP_MEMORY_SCOPE_AGENT); }
DI unsigned xb_xcc_id() { return (unsigned)__builtin_amdgcn_s_getreg((3 << 11) | 20) & 0xFu; }
#define XB_SPIN(cond, bar) do { unsigned _sp = 0; while (cond) { __builtin_amdgcn_s_sleep(1); \
    if ((++_sp & 255u) == 0u) { if (xb_ld(&(bar)[XB_TMO])) break; if (_sp > XB_SPIN_CAP) { atomicAdd(&(bar)[XB_TMO], 1u); break; } } } } while (0)
struct XcdBarrier { unsigned* bar; unsigned x; volatile LAS unsigned* st; };
DI XcdBarrier xcd_barrier_post(unsigned* bar, volatile LAS unsigned* st) {
    XcdBarrier b; b.bar = bar; b.x = xb_xcc_id(); b.st = st;
    if (threadIdx.x == 0) (void)xb_add(&bar[XB_XCNT(b.x)], 1u);
    return b;
}
DI void xcd_barrier_complete(unsigned* bar, unsigned x, unsigned& nloc, unsigned& nx) {
    const unsigned G = gridDim.x * gridDim.y * gridDim.z;
    unsigned sum, cnt, mine, sp = 0u;
    for (;;) {
        sum = 0u; cnt = 0u; mine = 0u;
#pragma unroll
        for (unsigned j = 0; j < 16; ++j) { const unsigned c = xb_ld(&bar[XB_XCNT(j)]); sum += c; cnt += (c > 0u) ? 1u : 0u; mine = (j == x) ? c : mine; }
        if (sum == G) break;
        __builtin_amdgcn_s_sleep(1);
        if ((++sp & 255u) == 0u) { if (xb_ld(&bar[XB_TMO])) break; if (sp > XB_SPIN_CAP) { atomicAdd(&bar[XB_TMO], 1u); break; } }
    }
    nloc = mine > 0u ? mine : 1u; nx = cnt > 0u ? cnt : 1u;
}
DI void xcd_barrier(const XcdBarrier& b) {
    asm volatile("s_waitcnt vmcnt(0)" ::: "memory");
    __syncthreads();
    if (threadIdx.x == 0) {
        unsigned* bar = b.bar;
        __builtin_amdgcn_s_waitcnt(0);
        unsigned nloc = b.st[0], nx = b.st[1];
        if (nloc == 0u) { xcd_barrier_complete(bar, b.x, nloc, nx); b.st[0] = nloc; b.st[1] = nx; }
        const unsigned old = xb_add(&bar[XB_XSUB(b.x)], 1u);
        const unsigned gen = old / nloc;
        if (old + 1u == (gen + 1u) * nloc) {
            __builtin_amdgcn_fence(__ATOMIC_RELEASE, "agent");
            asm volatile("s_waitcnt vmcnt(0)" ::: "memory");
            const unsigned og = xb_add(&bar[XB_TOP], 1u);
            const unsigned tg = og / nx;
            if (og + 1u == (tg + 1u) * nx) xb_add(&bar[XB_TOPGEN], 1u);
            else XB_SPIN(xb_ld(&bar[XB_TOPGEN]) == tg, bar);
            __builtin_amdgcn_fence(__ATOMIC_ACQUIRE, "agent");
            xb_add(&bar[XB_XGEN(b.x)], 1u);
            asm volatile("s_waitcnt vmcnt(0)" ::: "memory");
        } else {
            XB_SPIN(xb_ld(&bar[XB_XGEN(b.x)]) == gen, bar);
            __builtin_amdgcn_fence(__ATOMIC_ACQUIRE, "agent");
            asm volatile("s_waitcnt vmcnt(0)" ::: "memory");
        }
    }
    __syncthreads();
}

struct CvTile { const float* src; bf16_t* dst; int K, N, perm, k0, n0; };
DI CvTile moe_cv_tile(const Args& a, const int L, const int t) {
    CvTile c;
    const int e = t / 96, r = t - e * 96;
    if (r < 64) {
        c.src = a.in[30] + (size_t)(L * 64 + e) * 1024 * 512; c.dst = (bf16_t*)(a.ws + W_GU) + (size_t)(L * 64 + e) * 512 * 1024;
        c.K = 1024; c.N = 512; c.perm = 1; c.k0 = (r & 7) * 128; c.n0 = (r >> 3) * 64;
    } else {
        const int r2 = r - 64;
        c.src = a.in[31] + (size_t)(L * 64 + e) * 256 * 1024; c.dst = (bf16_t*)(a.ws + W_DN) + (size_t)(L * 64 + e) * 1024 * 256;
        c.K = 256; c.N = 1024; c.perm = 0; c.k0 = (r2 & 1) * 128; c.n0 = (r2 >> 1) * 64;
    }
    return c;
}
DI void cv_load(const CvTile& c, f32x4 (&L0)[4], f32x4 (&L1)[4]) {
    const int tid = threadIdx.x, c4 = tid & 15, kr = tid >> 4;
    const float* p = c.src + (size_t)(c.k0 + 2 * kr) * c.N + c.n0 + 4 * c4;
#pragma unroll
    for (int i = 0; i < 4; ++i) { L0[i] = *(const f32x4*)(p + (size_t)(32 * i) * c.N); L1[i] = *(const f32x4*)(p + (size_t)(32 * i + 1) * c.N); }
}
DI void cv_pack(unsigned* st, const f32x4 (&L0)[4], const f32x4 (&L1)[4]) {
    const int tid = threadIdx.x, c4 = tid & 15, kr = tid >> 4;
#pragma unroll
    for (int i = 0; i < 4; ++i)
#pragma unroll
        for (int j = 0; j < 4; ++j) st[(4 * c4 + j) * 68 + 16 * i + kr] = pk2(L0[i][j], L1[i][j]);
}
DI void cv_flush(const CvTile& c, const unsigned* st) {
    const int tid = threadIdx.x;
#pragma unroll
    for (int i = 0; i < 4; ++i) {
        const int id = tid + i * 256, n = id >> 4, kc = id & 15;
        const u32x4 o = *(const u32x4*)(st + n * 68 + kc * 4);
        int nd = c.n0 + n;
        if (c.perm) { const int cc = nd & 255, up = nd >> 8; nd = ((cc >> 4) << 5) + (up << 4) + (cc & 15); }
        *(u32x4*)(c.dst + (size_t)nd * c.K + c.k0 + kc * 8) = o;
    }
}

DI void phase_prologue(const Args& a) {
    const int tid = threadIdx.x;
    const int n_ada = 384, n_rt = 320;
    const int total = n_ada + n_rt;
    float* sc = (float*)lds;
    for (int u = blockIdx.x; u < total; u += gridDim.x) {
        __syncthreads();
        if (u < n_ada) {
            const float* c = a.in[1]; const float* cc = a.in[3];
            for (int i = tid; i < 9 * 1024; i += NTHR) {
                float v = i < 8192 ? c[i] : cc[i - 8192];
                sc[i] = v / (1.f + __expf(-v));
            }
            __syncthreads();
            const int n = u * 64 + (tid & 63), li = n / 6144, nn = n - li * 6144, kq = tid >> 6;
            const float* wp = a.in[4] + (size_t)li * 1024 * 6144 + (size_t)(kq * 256) * 6144 + nn;
            float acc[9];
#pragma unroll
            for (int r = 0; r < 9; ++r) acc[r] = 0.f;
#pragma unroll 1
            for (int k0 = kq * 256; k0 < kq * 256 + 256; k0 += 16) {
                float wv[16];
#pragma unroll
                for (int kk = 0; kk < 16; ++kk) { wv[kk] = *wp; wp += 6144; }
#pragma unroll
                for (int kk = 0; kk < 16; kk += 4)
#pragma unroll
                    for (int r = 0; r < 9; ++r) {
                        const f32x4 s4 = *(const f32x4*)(sc + r * 1024 + k0 + kk);
                        acc[r] += s4[0] * wv[kk] + s4[1] * wv[kk + 1] + s4[2] * wv[kk + 2] + s4[3] * wv[kk + 3];
                    }
            }
            float* part = sc + 9 * 1024;
#pragma unroll
            for (int r = 0; r < 9; ++r) part[(kq * 9 + r) * 64 + (tid & 63)] = acc[r];
            __syncthreads();
            for (int i = tid; i < 9 * 64; i += NTHR) {
                const int r = i >> 6, cidx = i & 63;
                const int n2 = u * 64 + cidx, l2 = n2 / 6144, nn2 = n2 - l2 * 6144;
                const float v = ((part[(0 * 9 + r) * 64 + cidx] + part[(1 * 9 + r) * 64 + cidx]) + part[(2 * 9 + r) * 64 + cidx]) + part[(3 * 9 + r) * 64 + cidx];
                ((float*)(a.ws + WS_MOD))[((size_t)l2 * 9 + r) * 6144 + nn2] = v + a.in[5][l2 * 6144 + nn2];
            }
        } else if (u < n_ada + n_rt) {
            const int r_ = u - n_ada, li = r_ / 80, n = r_ - li * 80;
            if (r_ == 0) {
                float* rt_ = (float*)(a.ws + WS_CTL + CTL_ROPE);
                for (int i = tid; i < 512; i += NTHR) {
                    const int pos = i >> 3, fi = i & 7;
                    const float ang = (float)pos * powf(10000.f, -(float)fi * 0.125f);
                    rt_[i] = cosf(ang); rt_[512 + i] = sinf(ang);
                }
            }
            bf16_t* rt = (bf16_t*)(a.ws + W_RT) + (size_t)li * 2 * 80 * 1024;
            const float* wg = a.in[26] + (size_t)li * 1024 * 8;
            const float* we = a.in[28] + (size_t)li * 1024 * 64;
            float v[4];
#pragma unroll
            for (int j = 0; j < 4; ++j) { const int k = tid * 4 + j; v[j] = n < 8 ? wg[k * 8 + n] : (n < 72 ? we[k * 64 + (n - 8)] : 0.f); }
            u32x2 hi, lo;
            hi[0] = pk2(v[0], v[1]); hi[1] = pk2(v[2], v[3]);
            lo[0] = pk2(v[0] - lof(hi[0]), v[1] - hif(hi[0])); lo[1] = pk2(v[2] - lof(hi[1]), v[3] - hif(hi[1]));
            *(u32x2*)(rt + n * 1024 + tid * 4) = hi;
            *(u32x2*)(rt + 80 * 1024 + n * 1024 + tid * 4) = lo;
        }
    }
    struct PTile { const float* src; bf16_t* dst; const float* rscale; int K, N, Npad, perm, k0, n0; };
    auto decode = [&](int tix) {
        int di = 0;
#pragma unroll 1
        for (int i = 1; i < NTD; ++i) if (tix >= a.td[i].tile0) di = i;
        const TDesc& td = a.td[di];
        int rem = tix - td.tile0;
        const int per = td.tiles_k * td.tiles_n;
        const int bi = rem / per; rem -= bi * per;
        PTile p;
        p.src = td.src + (size_t)bi * td.sb; p.dst = td.dst + (size_t)bi * td.db; p.rscale = td.rscale;
        p.K = td.K; p.N = td.N; p.Npad = td.Npad; p.perm = td.perm;
        p.n0 = (rem % td.tiles_n) * 64; p.k0 = (rem / td.tiles_n) * 128;
        return p;
    };
    auto pload = [&](const PTile& p, f32x4 (&L0)[4], f32x4 (&L1)[4]) {
        const int c4 = tid & 15, kr = tid >> 4;
        const bool nok = p.n0 + 4 * c4 < p.N;
#pragma unroll
        for (int i = 0; i < 4; ++i) {
            const int k = p.k0 + 32 * i + 2 * kr;
            L0[i] = (f32x4){0.f, 0.f, 0.f, 0.f}; L1[i] = L0[i];
            if (nok && k < p.K) {
                L0[i] = *(const f32x4*)(p.src + (size_t)k * p.N + p.n0 + 4 * c4);
                L1[i] = *(const f32x4*)(p.src + (size_t)(k + 1) * p.N + p.n0 + 4 * c4);
                if (p.rscale) { L0[i] *= p.rscale[k]; L1[i] *= p.rscale[k + 1]; }
            }
        }
    };
    auto pflush = [&](const PTile& p, const unsigned* st) {
#pragma unroll
        for (int i = 0; i < 4; ++i) {
            const int id = tid + i * 256, n = id >> 4, kc = id & 15;
            const u32x4 o = *(const u32x4*)(st + n * 68 + kc * 4);
            int nd = p.n0 + n;
            if (nd < p.Npad && p.k0 + kc * 8 < p.K) {
                if (p.perm) { const int c = nd & 255, up = nd >> 8; nd = ((c >> 4) << 5) + (up << 4) + (c & 15); }
                *(u32x4*)(p.dst + (size_t)nd * p.K + p.k0 + kc * 8) = o;
            }
        }
    };
    {
        unsigned* st0 = (unsigned*)lds; unsigned* st1 = st0 + 64 * 68;
        const int nt_ = a.ntiles_total, G = gridDim.x;
        int t0 = blockIdx.x, t1 = blockIdx.x + G;
        PTile p0 = decode(0), p1 = p0;
        f32x4 A0[4], A1[4], B0[4], B1[4];
        __syncthreads();
        if (t0 < nt_) { p0 = decode(t0); pload(p0, A0, A1); }
        if (t1 < nt_) { p1 = decode(t1); pload(p1, B0, B1); }
        while (t0 < nt_) {
            PTile q0 = p0, q1 = p1;
            const bool v1 = t1 < nt_;
            cv_pack(st0, A0, A1);
            if (t0 + 2 * G < nt_) { p0 = decode(t0 + 2 * G); pload(p0, A0, A1); }
            if (v1) {
                cv_pack(st1, B0, B1);
                if (t1 + 2 * G < nt_) { p1 = decode(t1 + 2 * G); pload(p1, B0, B1); }
            }
            __syncthreads();
            pflush(q0, st0);
            if (v1) pflush(q1, st1);
            __syncthreads();
            t0 += 2 * G; t1 += 2 * G;
        }
    }
}

template <int MODE>
DI void phase_token(const Args& a, const int li) {
    const int tid = threadIdx.x, lane = tid & 63, wave = tid >> 6;
    const int r = lane & 15, q = lane >> 4;
    float* X = (float*)(a.ws + WS_X);
    bf16_t* H = (bf16_t*)(a.ws + WS_H);
    const bf16_t* Y = (const bf16_t*)(a.ws + WS_Y);
    const float* MOD = (const float*)(a.ws + WS_MOD);
    const bool combine = (MODE == 0 && li > 0) || MODE == 2;
    const int ngroups = (MODE == 2 || (MODE == 1 && li == 3)) ? NLAT / 16 : NTOK / 16;
    float* lg = (float*)(lds + wave * 16 * 80 * 4);
    for (int g = blockIdx.x * 4 + wave; g < ngroups; g += gridDim.x * 4) {
        const int t = g * 16 + r;
        const int mr = tok_modrow(g * 16);
        const float* xsrc = (MODE == 0 && li == 0) ? (t < NLAT ? a.in[0] + (size_t)t * D : a.in[2] + (size_t)(t - NLAT) * D) : X + (size_t)t * D;
        const bf16_t* y0 = Y + (size_t)(2 * t) * D;
        const bf16_t* y1 = y0 + D;
        const int lprev = MODE == 2 ? 3 : li - 1;
        const float* g5 = MOD + ((size_t)(lprev < 0 ? 0 : lprev) * 9 + mr) * 6144 + 5 * 1024;
        float ss = 0.f;
        if (MODE != 2) {
#pragma unroll 4
            for (int kk = 0; kk < 32; ++kk) {
                const int k = kk * 32 + q * 8;
                f32x4 x0 = *(const f32x4*)(xsrc + k), x1 = *(const f32x4*)(xsrc + k + 4);
                if (combine) {
                    const u32x4 ya = *(const u32x4*)(y0 + k), yb = *(const u32x4*)(y1 + k);
                    const f32x4 ga = *(const f32x4*)(g5 + k), gb = *(const f32x4*)(g5 + k + 4);
                    x0[0] += ga[0] * (lof(ya[0]) + lof(yb[0])); x0[1] += ga[1] * (hif(ya[0]) + hif(yb[0]));
                    x0[2] += ga[2] * (lof(ya[1]) + lof(yb[1])); x0[3] += ga[3] * (hif(ya[1]) + hif(yb[1]));
                    x1[0] += gb[0] * (lof(ya[2]) + lof(yb[2])); x1[1] += gb[1] * (hif(ya[2]) + hif(yb[2]));
                    x1[2] += gb[2] * (lof(ya[3]) + lof(yb[3])); x1[3] += gb[3] * (hif(ya[3]) + hif(yb[3]));
                }
#pragma unroll
                for (int j = 0; j < 4; ++j) ss += x0[j] * x0[j] + x1[j] * x1[j];
            }
            ss += __shfl_xor(ss, 16); ss += __shfl_xor(ss, 32);
        }
        const float rstd = rsqrtf(ss * (1.f / 1024.f) + EPS);
        const float* gn = (MODE == 1 ? a.in[7] : a.in[6]) + (size_t)li * D;
        const float* mscale = MOD + ((size_t)li * 9 + mr) * 6144 + (MODE == 1 ? 4 : 1) * 1024;
        const float* mshift = MOD + ((size_t)li * 9 + mr) * 6144 + (MODE == 1 ? 3 : 0) * 1024;
        const bf16_t* rwh = (const bf16_t*)(a.ws + W_RT) + (size_t)li * 2 * 80 * 1024 + (size_t)r * 1024 + q * 8;
        f32x4 lacc[5];
#pragma unroll
        for (int i = 0; i < 5; ++i) lacc[i] = (f32x4){0.f, 0.f, 0.f, 0.f};
#pragma unroll 2
        for (int kk = 0; kk < 32; ++kk) {
            const int k = kk * 32 + q * 8;
            f32x4 x0 = *(const f32x4*)(xsrc + k), x1 = *(const f32x4*)(xsrc + k + 4);
            if (combine) {
                const u32x4 ya = *(const u32x4*)(y0 + k), yb = *(const u32x4*)(y1 + k);
                const f32x4 ga = *(const f32x4*)(g5 + k), gb = *(const f32x4*)(g5 + k + 4);
                x0[0] += ga[0] * (lof(ya[0]) + lof(yb[0])); x0[1] += ga[1] * (hif(ya[0]) + hif(yb[0]));
                x0[2] += ga[2] * (lof(ya[1]) + lof(yb[1])); x0[3] += ga[3] * (hif(ya[1]) + hif(yb[1]));
                x1[0] += gb[0] * (lof(ya[2]) + lof(yb[2])); x1[1] += gb[1] * (hif(ya[2]) + hif(yb[2]));
                x1[2] += gb[2] * (lof(ya[3]) + lof(yb[3])); x1[3] += gb[3] * (hif(ya[3]) + hif(yb[3]));
            }
            if (MODE == 2) {
                *(f32x4*)(a.out + (size_t)t * D + k) = x0; *(f32x4*)(a.out + (size_t)t * D + k + 4) = x1;
                continue;
            }
            if (MODE == 0 && (li == 0 || combine)) { *(f32x4*)(X + (size_t)t * D + k) = x0; *(f32x4*)(X + (size_t)t * D + k + 4) = x1; }
            const f32x4 n0 = *(const f32x4*)(gn + k), n1 = *(const f32x4*)(gn + k + 4);
            const f32x4 s0 = *(const f32x4*)(mscale + k), s1 = *(const f32x4*)(mscale + k + 4);
            const f32x4 h0 = *(const f32x4*)(mshift + k), h1 = *(const f32x4*)(mshift + k + 4);
            float f[8];
#pragma unroll
            for (int j = 0; j < 4; ++j) {
                f[j] = x0[j] * rstd * n0[j] * (1.f + s0[j]) + h0[j];
                f[4 + j] = x1[j] * rstd * n1[j] * (1.f + s1[j]) + h1[j];
            }
            u32x4 hv;
            hv[0] = pk2(f[0], f[1]); hv[1] = pk2(f[2], f[3]); hv[2] = pk2(f[4], f[5]); hv[3] = pk2(f[6], f[7]);
            *(u32x4*)(H + (size_t)t * D + k) = hv;
            if (MODE == 1) {
                u32x4 lv;
                lv[0] = pk2(f[0] - lof(hv[0]), f[1] - hif(hv[0])); lv[1] = pk2(f[2] - lof(hv[1]), f[3] - hif(hv[1]));
                lv[2] = pk2(f[4] - lof(hv[2]), f[5] - hif(hv[2])); lv[3] = pk2(f[6] - lof(hv[3]), f[7] - hif(hv[3]));
                const bf16x8 fh = __builtin_bit_cast(bf16x8, hv), fl = __builtin_bit_cast(bf16x8, lv);
#pragma unroll
                for (int nt = 0; nt < 5; ++nt) {
                    const bf16x8 wh = *(const bf16x8*)(rwh + (size_t)nt * 16 * 1024 + kk * 32);
                    const bf16x8 wl = *(const bf16x8*)(rwh + (size_t)(80 + nt * 16) * 1024 + kk * 32);
                    lacc[nt] = mfma16(fh, wh, lacc[nt]);
                    lacc[nt] = mfma16(fh, wl, lacc[nt]);
                    lacc[nt] = mfma16(fl, wh, lacc[nt]);
                }
            }
        }
        if (MODE == 1) {
#pragma unroll
            for (int nt = 0; nt < 5; ++nt)
#pragma unroll
                for (int j = 0; j < 4; ++j) lg[(q * 4 + j) * 80 + nt * 16 + r] = lacc[nt][j];
            asm volatile("s_waitcnt lgkmcnt(0)" ::: "memory");
            __builtin_amdgcn_wave_barrier();
            if (lane < 16) {
                const float* L = lg + lane * 80;
                const float* bg = a.in[27] + li * 8;
                const float* be = a.in[29] + li * 64;
                float gmax = -3.0e38f; int gi = 0; float gl[8];
#pragma unroll
                for (int j = 0; j < 8; ++j) { gl[j] = L[j] + bg[j]; if (gl[j] > gmax) { gmax = gl[j]; gi = j; } }
                float ps = 0.f;
#pragma unroll
                for (int j = 0; j < 8; ++j) ps += __expf(gl[j] - gmax);
                const float ptop = 1.f / ps;
                float e1 = -3.0e38f, e2 = -3.0e38f; int i1 = 0, i2 = 0;
#pragma unroll
                for (int j = 0; j < 8; ++j) {
                    const float v = L[8 + gi * 8 + j] + be[gi * 8 + j];
                    if (v > e1) { e2 = e1; i2 = i1; e1 = v; i1 = j; } else if (v > e2) { e2 = v; i2 = j; }
                }
                const float ex = __expf(e2 - e1);
                const float w1 = ptop / (1.f + ex), w2 = ptop * ex / (1.f + ex);
                const int tt = g * 16 + lane;
                int* cnt = (int*)(a.ws + WS_CTL + CTL_CNT) + li * 64;
                int* list = (int*)(a.ws + WS_LIST);
                float* wsl = (float*)(a.ws + WS_WSLOT);
                const int ea = gi * 8 + i1, eb = gi * 8 + i2;
                const int pa = atomicAdd(&cnt[ea], 1); list[(size_t)ea * NTOK + pa] = 2 * tt; wsl[2 * tt] = w1;
                const int pb = atomicAdd(&cnt[eb], 1); list[(size_t)eb * NTOK + pb] = 2 * tt + 1; wsl[2 * tt + 1] = w2;
            }
            __builtin_amdgcn_wave_barrier();
        }
    }
}

DI float wave_sum(float v) {
    v += __shfl_xor(v, 1); v += __shfl_xor(v, 2); v += __shfl_xor(v, 4); v += __shfl_xor(v, 8); v += __shfl_xor(v, 16); v += __shfl_xor(v, 32);
    return v;
}
template <int MODE>
DI void phase_token_row(const Args& a, const int li) {
    const int tid = threadIdx.x, lane = tid & 63, wave = tid >> 6;
    float* X = (float*)(a.ws + WS_X);
    bf16_t* H = (bf16_t*)(a.ws + WS_H);
    const bf16_t* Y = (const bf16_t*)(a.ws + WS_Y);
    const float* MOD = (const float*)(a.ws + WS_MOD);
    const bool combine = MODE == 2 || li > 0;
    const bool first = MODE == 0 && li == 0;
    const int npairs = (MODE == 2 ? NLAT : NTOK) / 2;
    const int lprev = MODE == 2 ? 3 : (li > 0 ? li - 1 : 0);
    const float* gn = a.in[6] + (size_t)li * D;
    for (int p = blockIdx.x * 4 + wave; p < npairs; p += gridDim.x * 4) {
        const int t0 = 2 * p, mr = tok_modrow(t0);
        f32x4 x[2][4];
#pragma unroll
        for (int i = 0; i < 2; ++i) {
            const int t = t0 + i;
            const float* xs = first ? (t < NLAT ? a.in[0] + (size_t)t * D : a.in[2] + (size_t)(t - NLAT) * D) : X + (size_t)t * D;
#pragma unroll
            for (int j = 0; j < 4; ++j) x[i][j] = *(const f32x4*)(xs + 256 * j + 4 * lane);
        }
        if (combine) {
            const float* g5 = MOD + ((size_t)lprev * 9 + mr) * 6144 + 5 * 1024;
            f32x4 g[4];
#pragma unroll
            for (int j = 0; j < 4; ++j) g[j] = *(const f32x4*)(g5 + 256 * j + 4 * lane);
#pragma unroll
            for (int i = 0; i < 2; ++i) {
                const bf16_t* y0 = Y + (size_t)(2 * (t0 + i)) * D;
#pragma unroll
                for (int j = 0; j < 4; ++j) {
                    const u32x2 ya = *(const u32x2*)(y0 + 256 * j + 4 * lane), yb = *(const u32x2*)(y0 + D + 256 * j + 4 * lane);
                    x[i][j][0] += g[j][0] * (lof(ya[0]) + lof(yb[0])); x[i][j][1] += g[j][1] * (hif(ya[0]) + hif(yb[0]));
                    x[i][j][2] += g[j][2] * (lof(ya[1]) + lof(yb[1])); x[i][j][3] += g[j][3] * (hif(ya[1]) + hif(yb[1]));
                }
            }
        }
        if (MODE == 2) {
#pragma unroll
            for (int i = 0; i < 2; ++i)
#pragma unroll
                for (int j = 0; j < 4; ++j) *(f32x4*)(a.out + (size_t)(t0 + i) * D + 256 * j + 4 * lane) = x[i][j];
            continue;
        }
        float rstd[2];
#pragma unroll
        for (int i = 0; i < 2; ++i) {
            float ss = 0.f;
#pragma unroll
            for (int j = 0; j < 4; ++j) ss += x[i][j][0] * x[i][j][0] + x[i][j][1] * x[i][j][1] + x[i][j][2] * x[i][j][2] + x[i][j][3] * x[i][j][3];
            rstd[i] = rsqrtf(wave_sum(ss) * (1.f / 1024.f) + EPS);
        }
        const float* msc = MOD + ((size_t)li * 9 + mr) * 6144 + 1 * 1024;
        const float* msh = MOD + ((size_t)li * 9 + mr) * 6144;
#pragma unroll
        for (int j = 0; j < 4; ++j) {
            const f32x4 n4 = *(const f32x4*)(gn + 256 * j + 4 * lane), s4 = *(const f32x4*)(msc + 256 * j + 4 * lane), h4 = *(const f32x4*)(msh + 256 * j + 4 * lane);
            const f32x4 gs = n4 * (s4 + 1.f);
#pragma unroll
            for (int i = 0; i < 2; ++i) {
                const f32x4 f = x[i][j] * rstd[i] * gs + h4;
                st_bf4(H + (size_t)(t0 + i) * D + 256 * j + 4 * lane, f);
                if (combine) *(f32x4*)(X + (size_t)(t0 + i) * D + 256 * j + 4 * lane) = x[i][j];
            }
        }
    }
}

DI void phase_token_router(const Args& a, const int li) {
    const int tid = threadIdx.x, lane = tid & 63, wave = tid >> 6;
    const int r = lane & 15, q = lane >> 4;
    const float* X = (const float*)(a.ws + WS_X);
    bf16_t* H = (bf16_t*)(a.ws + WS_H);
    const float* MOD = (const float*)(a.ws + WS_MOD);
    const float* gn = a.in[7] + (size_t)li * D;
    const int ngroups = (li == 3 ? NLAT : NTOK) / 16;
    char* sHi = lds; char* sLo = lds + 32768;
    float* sP = (float*)lds;
    float* sL = (float*)(lds + 32768);
    const bf16_t* rwh = (const bf16_t*)(a.ws + W_RT) + (size_t)li * 2 * 80 * 1024 + (size_t)r * 1024 + q * 8;
    for (int g = blockIdx.x; g < ngroups; g += gridDim.x) {
        const int mr = tok_modrow(g * 16);
        const float* msc = MOD + ((size_t)li * 9 + mr) * 6144 + 4 * 1024;
        const float* msh = MOD + ((size_t)li * 9 + mr) * 6144 + 3 * 1024;
        __syncthreads();
        {
            f32x4 x[4][4];
#pragma unroll
            for (int i = 0; i < 4; ++i)
#pragma unroll
                for (int j = 0; j < 4; ++j) x[i][j] = *(const f32x4*)(X + (size_t)(g * 16 + wave * 4 + i) * D + 256 * j + 4 * lane);
            float rstd[4];
#pragma unroll
            for (int i = 0; i < 4; ++i) {
                float ss = 0.f;
#pragma unroll
                for (int j = 0; j < 4; ++j) ss += x[i][j][0] * x[i][j][0] + x[i][j][1] * x[i][j][1] + x[i][j][2] * x[i][j][2] + x[i][j][3] * x[i][j][3];
                rstd[i] = rsqrtf(wave_sum(ss) * (1.f / 1024.f) + EPS);
            }
#pragma unroll
            for (int j = 0; j < 4; ++j) {
                const f32x4 n4 = *(const f32x4*)(gn + 256 * j + 4 * lane), s4 = *(const f32x4*)(msc + 256 * j + 4 * lane), h4 = *(const f32x4*)(msh + 256 * j + 4 * lane);
                const f32x4 gs = n4 * (s4 + 1.f);
#pragma unroll
                for (int i = 0; i < 4; ++i) {
                    const int row = wave * 4 + i;
                    const f32x4 f = x[i][j] * rstd[i] * gs + h4;
                    u32x2 hv; hv[0] = pk2(f[0], f[1]); hv[1] = pk2(f[2], f[3]);
                    u32x2 lv; lv[0] = pk2(f[0] - lof(hv[0]), f[1] - hif(hv[0])); lv[1] = pk2(f[2] - lof(hv[1]), f[3] - hif(hv[1]));
                    *(u32x2*)(H + (size_t)(g * 16 + row) * D + 256 * j + 4 * lane) = hv;
                    const int off = row * 2048 + (((32 * j + (lane >> 1)) ^ row) << 4) + (lane & 1) * 8;
                    *(u32x2*)(sHi + off) = hv; *(u32x2*)(sLo + off) = lv;
                }
            }
        }
        __syncthreads();
        f32x4 lacc[5];
#pragma unroll
        for (int i = 0; i < 5; ++i) lacc[i] = (f32x4){0.f, 0.f, 0.f, 0.f};
#pragma unroll 2
        for (int s = 0; s < 8; ++s) {
            const int kk = wave * 8 + s;
            const int off = r * 2048 + (((kk * 4 + q) ^ r) << 4);
            const bf16x8 fh = ldsv8(sHi + off), fl = ldsv8(sLo + off);
#pragma unroll
            for (int nt = 0; nt < 5; ++nt) {
                const bf16x8 wh = *(const bf16x8*)(rwh + (size_t)nt * 16 * 1024 + kk * 32);
                const bf16x8 wl = *(const bf16x8*)(rwh + (size_t)(80 + nt * 16) * 1024 + kk * 32);
                lacc[nt] = mfma16(fh, wh, lacc[nt]);
                lacc[nt] = mfma16(fh, wl, lacc[nt]);
                lacc[nt] = mfma16(fl, wh, lacc[nt]);
            }
        }
        __syncthreads();
#pragma unroll
        for (int nt = 0; nt < 5; ++nt)
#pragma unroll
            for (int j = 0; j < 4; ++j) sP[(wave * 16 + q * 4 + j) * 80 + nt * 16 + r] = lacc[nt][j];
        __syncthreads();
        for (int i = tid; i < 16 * 80; i += NTHR) sL[i] = sP[i] + sP[1280 + i] + sP[2560 + i] + sP[3840 + i];
        __syncthreads();
        if (tid < 16) {
            const float* L = sL + tid * 80;
            const float* bg = a.in[27] + li * 8;
            const float* be = a.in[29] + li * 64;
            float gmax = -3.0e38f; int gi = 0; float gl[8];
#pragma unroll
            for (int j = 0; j < 8; ++j) { gl[j] = L[j] + bg[j]; if (gl[j] > gmax) { gmax = gl[j]; gi = j; } }
            float ps = 0.f;
#pragma unroll
            for (int j = 0; j < 8; ++j) ps += __expf(gl[j] - gmax);
            const float ptop = 1.f / ps;
            float e1 = -3.0e38f, e2 = -3.0e38f; int i1 = 0, i2 = 0;
#pragma unroll
            for (int j = 0; j < 8; ++j) {
                const float v = L[8 + gi * 8 + j] + be[gi * 8 + j];
                if (v > e1) { e2 = e1; i2 = i1; e1 = v; i1 = j; } else if (v > e2) { e2 = v; i2 = j; }
            }
            const float ex = __expf(e2 - e1);
            const float w1 = ptop / (1.f + ex), w2 = ptop * ex / (1.f + ex);
            const int tt = g * 16 + tid;
            int* cnt = (int*)(a.ws + WS_CTL + CTL_CNT) + li * 64;
            int* list = (int*)(a.ws + WS_LIST);
            float* wsl = (float*)(a.ws + WS_WSLOT);
            const int ea = gi * 8 + i1, eb = gi * 8 + i2;
            const int pa = atomicAdd(&cnt[ea], 1); list[(size_t)ea * NTOK + pa] = 2 * tt; wsl[2 * tt] = w1;
            const int pb = atomicAdd(&cnt[eb], 1); list[(size_t)eb * NTOK + pb] = 2 * tt + 1; wsl[2 * tt + 1] = w2;
        }
    }
}

template <int WM, int WN, int MT, int NT, bool PFALL = true, class AP>
DI void gemm_tile(AP arow, const bf16_t* Bt, const int ldb, const int K, f32x4 (&acc)[MT][NT], float* ssq = nullptr) {
    constexpr int BM = WM * MT * 16, BN = WN * NT * 16;
    constexpr int A_BYTES = BM * 128, B_BYTES = BN * 128, STAGE = A_BYTES + B_BYTES;
    constexpr int ACH = BM * 8 / NTHR, BCH = BN * 8 / NTHR;
    static_assert(2 * STAGE <= LDS_AUX, "gemm LDS");
    const int tid = threadIdx.x, lane = tid & 63, wave = tid >> 6;
    const int wm = wave / WN, wn = wave % WN;
    const int fr = lane & 15, fq = lane >> 4;
    const bf16_t* ap[ACH]; const bf16_t* bp[BCH];
#pragma unroll
    for (int i = 0; i < ACH; ++i) { const int idx = tid + i * NTHR, row = idx >> 3, c = (idx & 7) ^ (row & 7); ap[i] = arow(row) + c * 8; }
#pragma unroll
    for (int i = 0; i < BCH; ++i) { const int idx = tid + i * NTHR, row = idx >> 3, c = (idx & 7) ^ (row & 7); bp[i] = Bt + (size_t)row * ldb + c * 8; }
#pragma unroll
    for (int i = 0; i < MT; ++i)
#pragma unroll
        for (int j = 0; j < NT; ++j) acc[i][j] = (f32x4){0.f, 0.f, 0.f, 0.f};
    const int KT = K >> 6;
    {
        char* sa = lds; char* sb = lds + A_BYTES;
#pragma unroll
        for (int i = 0; i < ACH; ++i) dma16(ap[i], sa + (tid + i * NTHR) * 16);
#pragma unroll
        for (int i = 0; i < BCH; ++i) dma16(bp[i], sb + (tid + i * NTHR) * 16);
    }
#pragma unroll 1
    for (int kt = 0; kt < KT; ++kt) {
        wait_vm0();
        __syncthreads();
        if (kt + 1 < KT) {
            char* sa = lds + ((kt + 1) & 1) * STAGE; char* sb = sa + A_BYTES;
            const int ko = (kt + 1) * 64;
#pragma unroll
            for (int i = 0; i < ACH; ++i) dma16(ap[i] + ko, sa + (tid + i * NTHR) * 16);
#pragma unroll
            for (int i = 0; i < BCH; ++i) dma16(bp[i] + ko, sb + (tid + i * NTHR) * 16);
        }
        const char* sa = lds + (kt & 1) * STAGE; const char* sb = sa + A_BYTES;
        if (PFALL) {
            bf16x8 xf[2][MT], wf[2][NT];
#pragma unroll
            for (int kk = 0; kk < 2; ++kk) {
#pragma unroll
                for (int i = 0; i < MT; ++i) xf[kk][i] = ldsv8(sa + swz128(wm * MT * 16 + i * 16 + fr, kk * 4 + fq));
#pragma unroll
                for (int j = 0; j < NT; ++j) wf[kk][j] = ldsv8(sb + swz128(wn * NT * 16 + j * 16 + fr, kk * 4 + fq));
            }
            __builtin_amdgcn_sched_barrier(0);
            __builtin_amdgcn_s_setprio(1);
#pragma unroll
            for (int kk = 0; kk < 2; ++kk)
#pragma unroll
                for (int i = 0; i < MT; ++i)
#pragma unroll
                    for (int j = 0; j < NT; ++j) acc[i][j] = mfma16(wf[kk][j], xf[kk][i], acc[i][j]);
            __builtin_amdgcn_s_setprio(0);
        } else {
#pragma unroll
            for (int kk = 0; kk < 2; ++kk) {
                bf16x8 xf[MT], wf[NT];
#pragma unroll
                for (int i = 0; i < MT; ++i) xf[i] = ldsv8(sa + swz128(wm * MT * 16 + i * 16 + fr, kk * 4 + fq));
#pragma unroll
                for (int j = 0; j < NT; ++j) wf[j] = ldsv8(sb + swz128(wn * NT * 16 + j * 16 + fr, kk * 4 + fq));
#pragma unroll
                for (int i = 0; i < MT; ++i)
#pragma unroll
                    for (int j = 0; j < NT; ++j) acc[i][j] = mfma16(wf[j], xf[i], acc[i][j]);
                if (ssq) {
#pragma unroll
                    for (int i = 0; i < MT; ++i) {
                        const u32x4 xu = __builtin_bit_cast(u32x4, xf[i]);
#pragma unroll
                        for (int d = 0; d < 4; ++d) { const bfx2 p = __builtin_bit_cast(bfx2, xu[d]); ssq[i] = __builtin_amdgcn_fdot2_f32_bf16(p, p, ssq[i], false); }
                    }
                }
            }
        }
    }
    __syncthreads();
}


struct GemmPipe {
    static constexpr int A_BYTES = 128 * 128, STAGE = 2 * A_BYTES;
    const bf16_t* ap[4]; const bf16_t* bp[4];
    template <class AP>
    DI void setup(AP arow, const bf16_t* Bt, const int ldb) {
        const int tid = threadIdx.x;
#pragma unroll
        for (int i = 0; i < 4; ++i) {
            const int idx = tid + i * NTHR, row = idx >> 3, c = (idx & 7) ^ (row & 7);
            ap[i] = arow(row) + c * 8; bp[i] = Bt + (size_t)row * ldb + c * 8;
        }
    }
    DI void issue(const int kt, const int buf) const {
        const int tid = threadIdx.x;
        char* sa = lds + buf * STAGE; char* sb = sa + A_BYTES;
        const int ko = kt * 64;
#pragma unroll
        for (int i = 0; i < 4; ++i) dma16(ap[i] + ko, sa + (tid + i * NTHR) * 16);
#pragma unroll
        for (int i = 0; i < 4; ++i) dma16(bp[i] + ko, sb + (tid + i * NTHR) * 16);
    }
    template <int PM>
    DI void run_probe(const int K, f32x4 (&acc)[4][4]) const {
        const int tid = threadIdx.x, lane = tid & 63, wave = tid >> 6;
        const int wm = wave >> 1, wn = wave & 1, fr = lane & 15, fq = lane >> 4;
#pragma unroll
        for (int i = 0; i < 4; ++i)
#pragma unroll
            for (int j = 0; j < 4; ++j) acc[i][j] = (f32x4){0.f, 0.f, 0.f, 0.f};
        const int KT = K >> 6;
#pragma unroll 1
        for (int kt = 0; kt < KT; ++kt) {
            if (PM & 4) { wait_vm0(); __syncthreads(); }
            if ((PM & 1) && kt + 1 < KT) issue(kt + 1, (kt + 1) & 1);
            if (PM & 2) {
                const char* sa = lds + (kt & 1) * STAGE; const char* sb = sa + A_BYTES;
                bf16x8 xf[2][4], wf[2][4];
#pragma unroll
                for (int kk = 0; kk < 2; ++kk) {
#pragma unroll
                    for (int i = 0; i < 4; ++i) xf[kk][i] = ldsv8(sa + swz128(wm * 64 + i * 16 + fr, kk * 4 + fq));
#pragma unroll
                    for (int j = 0; j < 4; ++j) wf[kk][j] = ldsv8(sb + swz128(wn * 64 + j * 16 + fr, kk * 4 + fq));
                }
                __builtin_amdgcn_sched_barrier(0);
                __builtin_amdgcn_s_setprio(1);
#pragma unroll
                for (int kk = 0; kk < 2; ++kk)
#pragma unroll
                    for (int i = 0; i < 4; ++i)
#pragma unroll
                        for (int j = 0; j < 4; ++j) acc[i][j] = mfma16(wf[kk][j], xf[kk][i], acc[i][j]);
                __builtin_amdgcn_s_setprio(0);
            }
        }
        wait_vm0();
    }
    DI void run(const int K, f32x4 (&acc)[4][4]) const {
        const int tid = threadIdx.x, lane = tid & 63, wave = tid >> 6;
        const int wm = wave >> 1, wn = wave & 1, fr = lane & 15, fq = lane >> 4;
#pragma unroll
        for (int i = 0; i < 4; ++i)
#pragma unroll
            for (int j = 0; j < 4; ++j) acc[i][j] = (f32x4){0.f, 0.f, 0.f, 0.f};
        const int KT = K >> 6;
#pragma unroll 1
        for (int kt = 0; kt < KT; ++kt) {
            wait_vm0();
            __syncthreads();
            if (kt + 1 < KT) issue(kt + 1, (kt + 1) & 1);
            const char* sa = lds + (kt & 1) * STAGE; const char* sb = sa + A_BYTES;
            bf16x8 xf[2][4], wf[2][4];
#pragma unroll
            for (int kk = 0; kk < 2; ++kk) {
#pragma unroll
                for (int i = 0; i < 4; ++i) xf[kk][i] = ldsv8(sa + swz128(wm * 64 + i * 16 + fr, kk * 4 + fq));
#pragma unroll
                for (int j = 0; j < 4; ++j) wf[kk][j] = ldsv8(sb + swz128(wn * 64 + j * 16 + fr, kk * 4 + fq));
            }
            __builtin_amdgcn_sched_barrier(0);
            __builtin_amdgcn_s_setprio(1);
#pragma unroll
            for (int kk = 0; kk < 2; ++kk)
#pragma unroll
                for (int i = 0; i < 4; ++i)
#pragma unroll
                    for (int j = 0; j < 4; ++j) acc[i][j] = mfma16(wf[kk][j], xf[kk][i], acc[i][j]);
            __builtin_amdgcn_s_setprio(0);
        }
    }
};

constexpr int EPI_OFF = 32768;
DI int lane_m(int i) { const int t = threadIdx.x; return ((t >> 7) & 1) * 64 + i * 16 + (t & 15); }
DI int lane_n(int j) { const int t = threadIdx.x; return ((t >> 6) & 1) * 64 + j * 16 + ((t >> 4) & 3) * 4; }
DI int opaque_tid() { int t = threadIdx.x; asm volatile("" : "+v"(t)); return t; }
DI int lane_m(int t, int i) { return ((t >> 7) & 1) * 64 + i * 16 + (t & 15); }
DI int lane_n(int t, int j) { return ((t >> 6) & 1) * 64 + j * 16 + ((t >> 4) & 3) * 4; }
template <class XF>
DI void epi_stage_bf16(const f32x4 (&acc)[4][4], XF xf) {
    const int tz = opaque_tid();
#pragma unroll
    for (int i = 0; i < 4; ++i) {
        const int m = lane_m(tz, i);
#pragma unroll
        for (int j = 0; j < 4; ++j) {
            const int n = lane_n(tz, j);
            const f32x4 v = xf(i, j, acc[i][j]);
            u32x2 o; o[0] = pk2(v[0], v[1]); o[1] = pk2(v[2], v[3]);
            *(u32x2*)(lds + EPI_OFF + m * 256 + (((n >> 3) ^ (m & 15)) << 4) + (n & 4) * 2) = o;
        }
    }
}
template <class DP, class OK>
DI void epi_flush_bf16(DP dst, OK ok) {
    const int tz = opaque_tid();
#pragma unroll
    for (int it = 0; it < 8; ++it) {
        const int idx = tz + it * NTHR, row = idx >> 4, ch = idx & 15;
        const u32x4 v = *(const u32x4*)(lds + EPI_OFF + row * 256 + ((ch ^ (row & 15)) << 4));
        if (ok(row)) *(u32x4*)(dst(row) + ch * 8) = v;
    }
}
template <class XF>
DI void epi_stage_bf16_T(const f32x4 (&acc)[4][4], XF xf) {
    const int tz = opaque_tid();
    const bool odd = tz & 1;
#pragma unroll
    for (int i = 0; i < 4; ++i) {
        const int m = lane_m(tz, i) & ~1;
#pragma unroll
        for (int j = 0; j < 4; ++j) {
            const int n = lane_n(tz, j) + (odd ? 2 : 0);
            const f32x4 v = xf(i, j, acc[i][j]);
            const float r0 = __shfl_xor(odd ? v[0] : v[2], 1), r1 = __shfl_xor(odd ? v[1] : v[3], 1);
            const unsigned w0 = odd ? pk2(r0, v[2]) : pk2(v[0], r0), w1 = odd ? pk2(r1, v[3]) : pk2(v[1], r1);
            *(unsigned*)(lds + EPI_OFF + n * 256 + (((m >> 3) ^ (n & 15)) << 4) + (m & 6) * 2) = w0;
            *(unsigned*)(lds + EPI_OFF + (n + 1) * 256 + (((m >> 3) ^ ((n + 1) & 15)) << 4) + (m & 6) * 2) = w1;
        }
    }
}
DI void epi_resid_f32(const Args& a, const int li, const int m0, const int n0, const f32x4 (&acc)[4][4]) {
    const int tz = opaque_tid();
    float* X = (float*)(a.ws + WS_X);
    const float* gate = (const float*)(a.ws + WS_MOD) + ((size_t)li * 9 + tok_modrow(m0)) * 6144 + 2 * 1024 + n0;
#pragma unroll
    for (int j = 0; j < 4; ++j) {
        const int n = lane_n(tz, j);
        const f32x4 g = *(const f32x4*)(gate + n);
#pragma unroll
        for (int i = 0; i < 4; ++i) {
            const int t = m0 + lane_m(tz, i);
            float* xp = X + (size_t)t * D + n0 + n;
            const float* xs = li == 0 ? (t < NLAT ? a.in[0] + (size_t)t * D : a.in[2] + (size_t)(t - NLAT) * D) + n0 + n : xp;
            f32x4 x = *(const f32x4*)xs;
            x += g * acc[i][j];
            *(f32x4*)xp = x;
        }
    }
}

template <bool XPF = true, class TE>
DI void gemm_dense_phase(const bf16_t* A, const int lda, const int mrows, const bf16_t* Bt, const int N, const int K, TE tile_epi) {
    const int mt = mrows / 128, nt = N / 128;
    const int mpx = mt >> 3, bmb = mpx >> 1, full = mpx * 8;
    auto decode = [&](int u, int& m0, int& n0) {
        const int xc = u & 7, s = u >> 3;
        const int bn = s / full, rem = s - bn * full;
        const int w = min(8, nt - 8 * bn);
        const int bm = rem / (bmb * w), rem2 = rem - bm * (bmb * w);
        const int ni = rem2 / bmb, mi = rem2 - ni * bmb;
        m0 = (xc * mpx + bm * bmb + mi) * 128; n0 = (bn * 8 + ni) * 128;
    };
    GemmPipe g;
    int u = blockIdx.x, m0 = 0, n0 = 0;
    __syncthreads();
    if (u < mt * nt) { decode(u, m0, n0); g.setup([&](int r) { return A + (size_t)(m0 + r) * lda; }, Bt + (size_t)n0 * K, K); g.issue(0, 0); }
    while (u < mt * nt) {
        f32x4 acc[4][4];
        g.run(K, acc);
        const int cm0 = m0, cn0 = n0;
        u += gridDim.x;
        if (XPF) {
            if (u < mt * nt) { decode(u, m0, n0); g.setup([&](int r) { return A + (size_t)(m0 + r) * lda; }, Bt + (size_t)n0 * K, K); g.issue(0, 0); }
            tile_epi(cm0, cn0, acc);
        } else {
            tile_epi(cm0, cn0, acc);
            __syncthreads();
            if (u < mt * nt) { decode(u, m0, n0); g.setup([&](int r) { return A + (size_t)(m0 + r) * lda; }, Bt + (size_t)n0 * K, K); g.issue(0, 0); }
        }
    }
    __syncthreads();
}
template <class XF, class DP>
DI void epi_bf16_rowmajor(const f32x4 (&acc)[4][4], XF xf, DP dst) {
    __syncthreads();
    epi_stage_bf16(acc, xf);
    __syncthreads();
    epi_flush_bf16(dst, [](int) { return true; });
}

DI void phase_rg_in(const Args& a, int j) {
    bf16_t* G = (bf16_t*)(a.ws + RG_G); bf16_t* U = (bf16_t*)(a.ws + RG_U);
    gemm_dense_phase((const bf16_t*)(a.ws + WS_H), D, NTOK, (const bf16_t*)(a.ws + W_RGIN) + (size_t)j * 2048 * 1024, 2048, 1024,
        [&](int m0, int n0, const f32x4 (&acc)[4][4]) {
            if (n0 < 1024)
                epi_bf16_rowmajor(acc, [](int, int, const f32x4 v) { f32x4 g; g[0] = gelu_tanh(v[0]); g[1] = gelu_tanh(v[1]); g[2] = gelu_tanh(v[2]); g[3] = gelu_tanh(v[3]); return g; },
                                  [&](int row) { return G + (size_t)(m0 + row) * D + n0; });
            else
                epi_bf16_rowmajor(acc, [](int, int, const f32x4 v) { return v; }, [&](int row) { return U + (size_t)(m0 + row) * D + (n0 - 1024); });
        });
}

template <int VAR = 0, int HOST = 0>
DI void phase_rg_scan(const Args& a, int j) {
    const int tid = threadIdx.x, lane = tid & 63, wave = tid >> 6;
    const int fr = lane & 15, fq = lane >> 4;
    const bf16_t* U = (const bf16_t*)(a.ws + RG_U);
    bf16_t* HS = (bf16_t*)(a.ws + (VAR ? WS_Y : RG_HS));
    char* sW = lds;
    char* sX = lds + 8192;
    float* sUc = (float*)(lds + 16384);
    float* sA = (float*)(lds + 24576);
    float* sB = (float*)(lds + 33280);
    bf16_t* sO = (bf16_t*)(lds + 41984);
    unsigned* sCv = (unsigned*)(lds + 50176);
    const int c = tid & 7;
    for (int u = blockIdx.x; u < 512; u += gridDim.x) {
        const int half = u & 1, dir = (u >> 1) & 1, blk = (u >> 2) & 15, b = u >> 6;
        const int cin0 = blk * 64, co0 = blk * 64 + half * 32;
        __syncthreads();
        {
            const bf16_t* Wg = (const bf16_t*)(a.ws + W_RGG) + ((size_t)((j * 2 + dir) * 16 + blk)) * 128 * 64;
#pragma unroll
            for (int i = 0; i < 2; ++i) {
                const int idx = tid + i * NTHR, row = idx >> 3, cc = idx & 7;
                const int srow = (row >> 5) * 64 + half * 32 + (row & 31);
                *(u32x4*)(sW + swz128(row, cc)) = *(const u32x4*)(Wg + (size_t)srow * 64 + cc * 8);
            }
        }
        float carry = 0.f;
        float cw[4][8], cb[8];
        {
            const float* cwp = a.in[9] + (size_t)j * 4 * 1024 + cin0 + c * 8; const float* cbp = a.in[10] + (size_t)j * 1024 + cin0 + c * 8;
#pragma unroll
            for (int w = 0; w < 4; ++w) { const f32x4 v0 = *(const f32x4*)(cwp + w * 1024), v1 = *(const f32x4*)(cwp + w * 1024 + 4);
#pragma unroll
                for (int e = 0; e < 4; ++e) { cw[w][e] = v0[e]; cw[w][4 + e] = v1[e]; } }
            const f32x4 v0 = *(const f32x4*)cbp, v1 = *(const f32x4*)(cbp + 4);
#pragma unroll
            for (int e = 0; e < 4; ++e) { cb[e] = v0[e]; cb[4 + e] = v1[e]; }
        }
        float bg0[8], bg1[8], spl[8];
        {
            const float* gb = a.in[12] + ((size_t)(j * 2 + dir) * 2) * 1024 + co0;
            const float* lm = a.in[13] + (size_t)(j * 2 + dir) * 1024 + co0;
#pragma unroll
            for (int jt = 0; jt < 2; ++jt)
#pragma unroll
                for (int e = 0; e < 4; ++e) {
                    const int cc = jt * 16 + fq * 4 + e;
                    bg0[jt * 4 + e] = gb[cc]; bg1[jt * 4 + e] = gb[1024 + cc];
                    spl[jt * 4 + e] = -8.f * log1pf(__expf(-lm[cc]));
                }
        }
        u32x4 pu[2][4];
        auto load_chunk = [&](int ci) {
            const int seg = ci >= 4, L = seg ? SEQ : CTXL, nch = L / 64, jc = seg ? ci - 4 : ci;
            const int oc = dir ? nch - 1 - jc : jc;
            const int rb = seg ? b * SEQ : NLAT + b * CTXL;
            const int s0 = oc * 64;
#pragma unroll
            for (int it = 0; it < 2; ++it) {
                const int tk = (tid >> 3) + it * 32;
#pragma unroll
                for (int w = 0; w < 4; ++w) {
                    const int s = s0 + tk + w - 2;
                    const int sc_ = min(max(s, 0), L - 1);
                    const u32x4 ld = *(const u32x4*)(U + (size_t)(rb + sc_) * D + cin0 + c * 8);
                    const unsigned msk = (s >= 0 && s < L) ? 0xffffffffu : 0u;
                    pu[it][w] = (u32x4){ld[0] & msk, ld[1] & msk, ld[2] & msk, ld[3] & msk};
                }
            }
        };
        load_chunk(0);
        __syncthreads();
        size_t prev_base = 0;
        constexpr int CV_TILES = HOST ? 6144 : 0;
        CvTile cvp; cvp.src = nullptr; cvp.dst = nullptr; cvp.K = 0; cvp.N = 0; cvp.perm = 0; cvp.k0 = 0; cvp.n0 = 0;
        bool cvp_ok = false;
#pragma unroll 1
        for (int ci = 0; ci < 36; ++ci) {
            f32x4 cv0[4], cv1[4];
            CvTile cvc = cvp;
            const int cvq = (ci / 3) * 512 + u;
            const bool cv_ok = HOST && (ci % 3 == 0) && cvq < CV_TILES;
            if (cv_ok) { cvc = moe_cv_tile(a, 1, cvq); cv_load(cvc, cv0, cv1); }
            const int seg = ci >= 4, L = seg ? SEQ : CTXL, nch = L / 64, jc = seg ? ci - 4 : ci;
            const int oc = dir ? nch - 1 - jc : jc;
            const int rb = seg ? b * SEQ : NLAT + b * CTXL;
            const int s0 = oc * 64;
            char* sXc = sX; float* sUcc = sUc;
#pragma unroll
            for (int it = 0; it < 2; ++it) {
                const int tk = (tid >> 3) + it * 32;
                float o[8];
#pragma unroll
                for (int e = 0; e < 8; ++e) o[e] = cb[e];
#pragma unroll
                for (int w = 0; w < 4; ++w) {
                    const u32x4 r4 = pu[it][w];
#pragma unroll
                    for (int e = 0; e < 4; ++e) { o[2 * e] += cw[w][2 * e] * lof(r4[e]); o[2 * e + 1] += cw[w][2 * e + 1] * hif(r4[e]); }
                }
                u32x4 pv; pv[0] = pk2(o[0], o[1]); pv[1] = pk2(o[2], o[3]); pv[2] = pk2(o[4], o[5]); pv[3] = pk2(o[6], o[7]);
                *(u32x4*)(sXc + swz128(tk, c)) = pv;
                if ((c >> 2) == half) {
                    *(f32x4*)(sUcc + tk * 32 + (c & 3) * 8) = (f32x4){o[0], o[1], o[2], o[3]};
                    *(f32x4*)(sUcc + tk * 32 + (c & 3) * 8 + 4) = (f32x4){o[4], o[5], o[6], o[7]};
                }
            }
            if (ci + 1 < 36) load_chunk(ci + 1);
            __syncthreads();
            if (HOST && cvp_ok) cv_flush(cvp, sCv);
            if (ci > 0) {
                const u32x4 v = *(const u32x4*)(sO + ((ci - 1) & 1) * 2048 + tid * 8);
                *(u32x4*)(HS + prev_base + (size_t)(tid >> 2) * D + (tid & 3) * 8) = v;
            }
            {
                f32x4 acc[4];
#pragma unroll
                for (int jt = 0; jt < 4; ++jt) acc[jt] = (f32x4){0.f, 0.f, 0.f, 0.f};
#pragma unroll
                for (int kk = 0; kk < 2; ++kk) {
                    const bf16x8 xf = ldsv8(sXc + swz128(wave * 16 + fr, kk * 4 + fq));
#pragma unroll
                    for (int jt = 0; jt < 4; ++jt) acc[jt] = mfma16(ldsv8(sW + swz128(jt * 16 + fr, kk * 4 + fq)), xf, acc[jt]);
                }
                const int tk = wave * 16 + fr;
#pragma unroll
                for (int jt = 0; jt < 2; ++jt) {
                    const f32x4 uc = *(const f32x4*)(sUcc + tk * 32 + jt * 16 + fq * 4);
                    f32x4 av4, bv4;
#pragma unroll
                    for (int e = 0; e < 4; ++e) {
                        if (VAR & 2) { av4[e] = 0.5f + 0.001f * acc[jt][e]; bv4[e] = uc[e] + acc[jt + 2][e]; continue; }
                        const float rg = sigmoidf_(acc[jt][e] + bg0[jt * 4 + e]);
                        const float ig = sigmoidf_(acc[jt + 2][e] + bg1[jt * 4 + e]);
                        const float av = fexp(rg * spl[jt * 4 + e]);
                        av4[e] = av;
                        bv4[e] = __builtin_amdgcn_sqrtf(fmaxf(1.f - av * av, 0.f)) * ig * uc[e];
                    }
#pragma unroll
                    for (int e = 0; e < 4; ++e) { sA[(jt * 16 + fq * 4 + e) * 68 + tk] = av4[e]; sB[(jt * 16 + fq * 4 + e) * 68 + tk] = bv4[e]; }
                }
            }
            __syncthreads();
            if (!(VAR & 4)) {
                const int ch = wave * 8 + (lane & 7), sg = lane >> 3;
                const int tb = dir ? 56 - sg * 8 : sg * 8;
                const f32x4 a0 = *(const f32x4*)(sA + ch * 68 + tb), a1 = *(const f32x4*)(sA + ch * 68 + tb + 4);
                const f32x4 b0 = *(const f32x4*)(sB + ch * 68 + tb), b1 = *(const f32x4*)(sB + ch * 68 + tb + 4);
                float av[8], bv[8];
#pragma unroll
                for (int e = 0; e < 4; ++e) {
                    av[e] = dir ? a1[3 - e] : a0[e]; av[4 + e] = dir ? a0[3 - e] : a1[e];
                    bv[e] = dir ? b1[3 - e] : b0[e]; bv[4 + e] = dir ? b0[3 - e] : b1[e];
                }
                float Ap = 1.f, Hh = 0.f;
#pragma unroll
                for (int e = 0; e < 8; ++e) { Hh = av[e] * Hh + bv[e]; Ap *= av[e]; }
#pragma unroll
                for (int d = 8; d < 64; d <<= 1) {
                    const float Ao = __shfl_up(Ap, d), Ho = __shfl_up(Hh, d);
                    if (lane >= d) { Hh = Ap * Ho + Hh; Ap = Ap * Ao; }
                }
                float Aex = __shfl_up(Ap, 8), Hex = __shfl_up(Hh, 8);
                if (sg == 0) { Aex = 1.f; Hex = 0.f; }
                float hin = Aex * carry + Hex;
                const float cnew = Ap * carry + Hh;
                carry = __shfl(cnew, 56 + (lane & 7));
                bf16_t* so = sO + (ci & 1) * 2048 + ch;
#pragma unroll
                for (int e = 0; e < 8; ++e) {
                    hin = av[e] * hin + bv[e];
                    const int i = sg * 8 + e, tk = dir ? 63 - i : i;
                    so[tk * 32] = f2bf(hin);
                }
            }
            prev_base = (size_t)dir * NTOK * D + (size_t)(rb + s0) * D + co0;
            if (HOST) { if (cv_ok) cv_pack(sCv, cv0, cv1); cvp = cvc; cvp_ok = cv_ok; }
        }
        __syncthreads();
        if (HOST && cvp_ok) cv_flush(cvp, sCv);
        {
            const u32x4 v = *(const u32x4*)(sO + (35 & 1) * 2048 + tid * 8);
            *(u32x4*)(HS + prev_base + (size_t)(tid >> 2) * D + (tid & 3) * 8) = v;
        }
    }
}

DI void phase_rg_combine(const Args& a) {
    const u32x4* G = (const u32x4*)(a.ws + RG_G);
    const u32x4* H0 = (const u32x4*)(a.ws + RG_HS);
    const u32x4* H1 = (const u32x4*)(a.ws + RG_HS + TOKD2);
    u32x4* A2 = (u32x4*)(a.ws + RG_A2);
    const size_t n = (size_t)NTOK * D / 8;
    for (size_t i = (size_t)blockIdx.x * NTHR + threadIdx.x; i < n; i += (size_t)gridDim.x * NTHR) {
        const u32x4 g = G[i], h0 = H0[i], h1 = H1[i];
        u32x4 o;
#pragma unroll
        for (int e = 0; e < 4; ++e) o[e] = pk2(lof(g[e]) * (lof(h0[e]) + lof(h1[e])), hif(g[e]) * (hif(h0[e]) + hif(h1[e])));
        A2[i] = o;
    }
}

DI void phase_rg_out(const Args& a, int li, int j) {
    gemm_dense_phase((const bf16_t*)(a.ws + RG_A2), D, li == 3 ? NLAT : NTOK, (const bf16_t*)(a.ws + W_RGOUT) + (size_t)j * 1024 * 1024, 1024, 1024,
        [&](int m0, int n0, const f32x4 (&acc)[4][4]) { epi_resid_f32(a, li, m0, n0, acc); });
}

DI void phase_mla_down(const Args& a) {
    bf16_t* CQ = (bf16_t*)(a.ws + MLA_CQ); bf16_t* CKV = (bf16_t*)(a.ws + MLA_CKV); float* KR = (float*)(a.ws + MLA_KR);
    gemm_dense_phase((const bf16_t*)(a.ws + WS_H), D, NTOK, (const bf16_t*)(a.ws + W_MDOWN), 512, 1024,
        [&](int m0, int n0, const f32x4 (&acc)[4][4]) {
            if (n0 < 256) epi_bf16_rowmajor(acc, [](int, int, const f32x4 v) { return v; }, [&](int row) { return CQ + (size_t)(m0 + row) * 256 + n0; });
            else if (n0 == 256) epi_bf16_rowmajor(acc, [](int, int, const f32x4 v) { return v; }, [&](int row) { return CKV + (size_t)(m0 + row) * 128; });
            else {
#pragma unroll
                for (int i = 0; i < 4; ++i)
#pragma unroll
                    for (int j = 0; j < 2; ++j) { const int n = lane_n(j); if (n < 32) *(f32x4*)(KR + (size_t)(m0 + lane_m(i)) * 32 + n) = acc[i][j]; }
            }
        });
}

DI int perm_key(int kp) { return (kp & ~12) | ((kp & 4) << 1) | ((kp & 8) >> 1); }

DI void phase_mla_up(const Args& a) {
    const int tid = threadIdx.x;
    const bf16_t* CQ = (const bf16_t*)(a.ws + MLA_CQ); const bf16_t* CKV = (const bf16_t*)(a.ws + MLA_CKV); const float* KR = (const float*)(a.ws + MLA_KR);
    bf16_t* Q = (bf16_t*)(a.ws + MLA_Q); bf16_t* Kb = (bf16_t*)(a.ws + MLA_K); bf16_t* VT = (bf16_t*)(a.ws + MLA_VT);
    const float* qkn = a.in[20];
    const float* RC = (const float*)(a.ws + WS_CTL + CTL_ROPE); const float* RS = RC + 512;
    const int MT_ = NTOK / 128;
    const int nq = MT_ * 16, nkv = MT_ * 16;
    const float QSCALE = 0.10206207261596575f * 1.4426950408889634f;
    for (int u = blockIdx.x; u < nq + nkv; u += gridDim.x) {
        const bool isq = u < nq;
        const int uu = isq ? u : u - nq;
        const int xc_ = uu & 7, s_ = uu >> 3;
        const int m0 = (((s_ >> 4) << 3) + xc_) * 128, head = s_ & 15;
        const bool islat = m0 < NLAT;
        const int bb = islat ? (m0 >> 11) : ((m0 - NLAT) >> 8);
        const int kp0 = islat ? CTXL + (m0 & (SEQ - 1)) : ((m0 - NLAT) & (CTXL - 1));
        __syncthreads();
        if (isq) {
            f32x4 hold[2][6];
            float ssq[2] = {0.f, 0.f};
            gemm_tile<4, 1, 2, 6, false>([&](int r) { return CQ + (size_t)(m0 + r) * 256; }, (const bf16_t*)(a.ws + W_MUQ) + (size_t)head * 96 * 256, 256, 256, hold, ssq);
            const int tz = opaque_tid();
            const int wave = tz >> 6, fq = (tz >> 4) & 3, fr = tz & 15;
#pragma unroll
            for (int i = 0; i < 2; ++i) {
                const int m = wave * 32 + i * 16 + fr;
                float sq = ssq[i]; sq += __shfl_xor(sq, 16); sq += __shfl_xor(sq, 32);
                const float rs0 = rsqrtf(sq * (1.f / 256.f) + EPS);
                float ss = 0.f;
#pragma unroll
                for (int jn = 0; jn < 6; ++jn) { hold[i][jn] *= rs0;
#pragma unroll
                    for (int e = 0; e < 4; ++e) ss += hold[i][jn][e] * hold[i][jn][e]; }
                ss += __shfl_xor(ss, 16); ss += __shfl_xor(ss, 32);
                const float rs = rsqrtf(ss * (1.f / 96.f) + EPS) ;
                f32x4 o[6];
#pragma unroll
                for (int jn = 0; jn < 6; ++jn) { const f32x4 g4 = *(const f32x4*)(qkn + jn * 16 + fq * 4); o[jn] = hold[i][jn] * rs * g4; }
#pragma unroll
                for (int jn = 4; jn < 6; ++jn) {
                    f32x4 other;
#pragma unroll
                    for (int e = 0; e < 4; ++e) other[e] = __shfl_xor(o[jn][e], 32);
                    if (islat) {
                        const int s = (m0 + m) & (SEQ - 1);
                        const int pos = jn == 4 ? (s >> 6) : (s & 63);
                        const f32x4 cs = *(const f32x4*)(RC + pos * 8 + (fq & 1) * 4), sn = *(const f32x4*)(RS + pos * 8 + (fq & 1) * 4);
#pragma unroll
                        for (int e = 0; e < 4; ++e) o[jn][e] = (fq < 2) ? o[jn][e] * cs[e] - other[e] * sn[e] : o[jn][e] * cs[e] + other[e] * sn[e];
                    }
                }
#pragma unroll
                for (int jn = 0; jn < 6; ++jn) {
                    const f32x4 v = o[jn] * QSCALE;
                    u32x2 pv; pv[0] = pk2(v[0], v[1]); pv[1] = pk2(v[2], v[3]);
                    *(u32x2*)(lds + m * 256 + (((jn * 2 + (fq >> 1)) ^ (m & 15)) << 4) + (fq & 1) * 8) = pv;
                }
            }
            __syncthreads();
#pragma unroll
            for (int it = 0; it < 8; ++it) {
                const int idx = tz + it * NTHR, row = idx >> 4, ch = idx & 15;
                if (ch < 12) {
                    const u32x4 v = *(const u32x4*)(lds + row * 256 + ((ch ^ (row & 15)) << 4));
                    *(u32x4*)(Q + (size_t)(m0 + row) * 1536 + head * 96 + ch * 8) = v;
                }
            }
        } else {
            f32x4 hold[4][4];
            float ssq[4] = {0.f, 0.f, 0.f, 0.f};
            gemm_tile<2, 2, 4, 4, false>([&](int r) { return CKV + (size_t)(m0 + r) * 128; }, (const bf16_t*)(a.ws + W_MUKV) + (size_t)head * 128 * 128, 128, 128, hold, ssq);
            const int tz = opaque_tid();
            const int wave = tz >> 6, wm = wave >> 1, wn = wave & 1, fq = (tz >> 4) & 3, fr = tz & 15;
            char* sK = lds; char* sV = lds + 32768;
#pragma unroll
            for (int i = 0; i < 4; ++i) {
                const int m = wm * 64 + i * 16 + fr, t = m0 + m;
                float sq = ssq[i]; sq += __shfl_xor(sq, 16); sq += __shfl_xor(sq, 32);
                const float rs0 = rsqrtf(sq * (1.f / 128.f) + EPS);
#pragma unroll
                for (int jn = 0; jn < 4; ++jn) hold[i][jn] *= rs0;
                if (wn == 0) {
                    const int base = (fq >> 1) * 16 + (fq & 1) * 4;
                    const f32x4 z1 = *(const f32x4*)(KR + (size_t)t * 32 + base);
                    const f32x4 z2 = *(const f32x4*)(KR + (size_t)t * 32 + base + 8);
                    float ss = 0.f;
#pragma unroll
                    for (int jn = 0; jn < 4; ++jn)
#pragma unroll
                        for (int e = 0; e < 4; ++e) ss += hold[i][jn][e] * hold[i][jn][e];
#pragma unroll
                    for (int e = 0; e < 4; ++e) ss += z1[e] * z1[e] + z2[e] * z2[e];
                    ss += __shfl_xor(ss, 16); ss += __shfl_xor(ss, 32);
                    const float rs = rsqrtf(ss * (1.f / 96.f) + EPS);
#pragma unroll
                    for (int jn = 0; jn < 4; ++jn) {
                        const f32x4 g4 = *(const f32x4*)(qkn + 96 + jn * 16 + fq * 4);
                        const f32x4 v = hold[i][jn] * rs * g4;
                        u32x2 pv; pv[0] = pk2(v[0], v[1]); pv[1] = pk2(v[2], v[3]);
                        *(u32x2*)(sK + m * 256 + (((jn * 2 + (fq >> 1)) ^ (m & 15)) << 4) + (fq & 1) * 8) = pv;
                    }
                    const f32x4 g1 = *(const f32x4*)(qkn + 96 + 64 + base), g2 = *(const f32x4*)(qkn + 96 + 64 + base + 8);
                    f32x4 a1 = z1 * rs * g1, a2 = z2 * rs * g2;
                    if (islat) {
                        const int s = t & (SEQ - 1);
                        const int pos = (fq >> 1) == 0 ? (s >> 6) : (s & 63);
                        const f32x4 cs = *(const f32x4*)(RC + pos * 8 + (fq & 1) * 4), sn = *(const f32x4*)(RS + pos * 8 + (fq & 1) * 4);
                        const f32x4 b1 = a1 * cs - a2 * sn, b2 = a2 * cs + a1 * sn;
                        a1 = b1; a2 = b2;
                    }
                    u32x2 p1, p2; p1[0] = pk2(a1[0], a1[1]); p1[1] = pk2(a1[2], a1[3]); p2[0] = pk2(a2[0], a2[1]); p2[1] = pk2(a2[2], a2[3]);
                    const int c1 = 8 + (fq >> 1) * 2;
                    *(u32x2*)(sK + m * 256 + ((c1 ^ (m & 15)) << 4) + (fq & 1) * 8) = p1;
                    *(u32x2*)(sK + m * 256 + (((c1 + 1) ^ (m & 15)) << 4) + (fq & 1) * 8) = p2;
                }
                {
                    const bool odd = fr & 1;
                    const int mp = perm_key(m & ~1);
#pragma unroll
                    for (int jn = 0; jn < 4; ++jn) {
                        const f32x4 v = hold[i][jn];
                        const float r0 = __shfl_xor(odd ? v[0] : v[2], 1), r1 = __shfl_xor(odd ? v[1] : v[3], 1);
                        if (wn == 1) {
                            const int e0 = jn * 16 + fq * 4 + (odd ? 2 : 0);
                            const unsigned w0 = odd ? pk2(r0, v[2]) : pk2(v[0], r0), w1 = odd ? pk2(r1, v[3]) : pk2(v[1], r1);
                            *(unsigned*)(sV + e0 * 256 + (((mp >> 3) ^ (e0 & 15)) << 4) + (mp & 6) * 2) = w0;
                            *(unsigned*)(sV + (e0 + 1) * 256 + (((mp >> 3) ^ ((e0 + 1) & 15)) << 4) + (mp & 6) * 2) = w1;
                        }
                    }
                }
            }
            __syncthreads();
            bf16_t* kdst = Kb + ((size_t)(bb * 16 + head) * NKEY + kp0) * 96;
#pragma unroll
            for (int it = 0; it < 8; ++it) {
                const int idx = tz + it * NTHR, row = idx >> 4, ch = idx & 15;
                if (ch < 12) {
                    const u32x4 v = *(const u32x4*)(sK + row * 256 + ((ch ^ (row & 15)) << 4));
                    *(u32x4*)(kdst + (size_t)row * 96 + ch * 8) = v;
                }
            }
            bf16_t* vdst = VT + ((size_t)(bb * 16 + head) * 64) * NKEY + kp0;
#pragma unroll
            for (int it = 0; it < 4; ++it) {
                const int idx = tz + it * NTHR, row = idx >> 4, ch = idx & 15;
                const u32x4 v = *(const u32x4*)(sV + row * 256 + ((ch ^ (row & 15)) << 4));
                *(u32x4*)(vdst + (size_t)row * NKEY + ch * 8) = v;
            }
        }
    }
}

DI void phase_mla_attn(const Args& a) {
    const int tid = threadIdx.x, lane = tid & 63, wave = tid >> 6;
    const int r = lane & 31, h = lane >> 5;
    const bf16_t* Q = (const bf16_t*)(a.ws + MLA_Q); const bf16_t* Kb = (const bf16_t*)(a.ws + MLA_K); const bf16_t* VT = (const bf16_t*)(a.ws + MLA_VT);
    bf16_t* O = (bf16_t*)(a.ws + MLA_O);
    constexpr int KT_B = 64 * 256, VT_B = 64 * 128, ST_B = KT_B + VT_B;
    unsigned* sCv = (unsigned*)(lds + 49152);
    const int cv_per = 18432 / gridDim.x;
    int cvn = 0, itc = 0;
    bool cv_pack_p = false, cv_flush_p = false;
    CvTile cvB, cvC; cvB.src = nullptr; cvB.dst = nullptr; cvB.K = 0; cvB.N = 0; cvB.perm = 0; cvB.k0 = 0; cvB.n0 = 0; cvC = cvB;
    f32x4 cv0[4], cv1[4];
#pragma unroll
    for (int i = 0; i < 4; ++i) { cv0[i] = (f32x4){0.f, 0.f, 0.f, 0.f}; cv1[i] = cv0[i]; }
    auto cv_step = [&](bool may_load) {
        if (cv_flush_p) { cv_flush(cvC, sCv); cv_flush_p = false; }
        if (cv_pack_p) { cv_pack(sCv, cv0, cv1); cvC = cvB; cv_flush_p = true; cv_pack_p = false; }
        if (may_load && cvn < cv_per) {
            const int t = cvn * gridDim.x + blockIdx.x;
            cvB = moe_cv_tile(a, 1 + t / 6144, t % 6144); cv_load(cvB, cv0, cv1); cv_pack_p = true; ++cvn;
        }
    };
    for (int u = blockIdx.x; u < 2048 + 256; u += gridDim.x) {
        const bool isctx = u >= 2048;
        const int uu = isctx ? u - 2048 : u;
        const int xc_ = uu & 7, s_ = uu >> 3, bh_ = ((s_ >> 4) << 3) + xc_;
        const int qb = isctx ? (uu & 1) : (s_ & 15), head = isctx ? ((uu >> 1) & 15) : (bh_ & 15), b = isctx ? (uu >> 5) : (bh_ >> 4);
        const int ntile = isctx ? CTXL / 64 : NKEY / 64;
        const int t = (isctx ? NLAT + b * CTXL : b * SEQ) + qb * 128 + wave * 32 + r;
        const bf16_t* kbase = Kb + (size_t)(b * 16 + head) * NKEY * 96;
        const bf16_t* vbase = VT + (size_t)(b * 16 + head) * 64 * NKEY;
        bf16x8 qf[6];
#pragma unroll
        for (int kk = 0; kk < 6; ++kk) qf[kk] = *(const bf16x8*)(Q + (size_t)t * 1536 + head * 96 + kk * 16 + h * 8);
        f32x16 o[2];
#pragma unroll
        for (int e = 0; e < 16; ++e) { o[0][e] = 0.f; o[1][e] = 0.f; }
        float lsum = 0.f;
        __syncthreads();
        auto stage = [&](int kt, int buf) {
            char* sk = lds + buf * ST_B; char* sv = sk + KT_B;
            const int key0 = kt * 64;
#pragma unroll
            for (int i = 0; i < 4; ++i) {
                const int idx = tid + i * NTHR, row = idx >> 4; int c = (idx & 15) ^ (row & 15); if (c >= 12) c = 0;
                dma16(kbase + (size_t)(key0 + row) * 96 + c * 8, sk + idx * 16);
            }
#pragma unroll
            for (int i = 0; i < 2; ++i) {
                const int idx = tid + i * NTHR, row = idx >> 3, c = (idx & 7) ^ ((row >> 1) & 7);
                dma16(vbase + (size_t)row * NKEY + key0 + c * 8, sv + idx * 16);
            }
        };
        stage(0, 0);
#pragma unroll 1
        for (int kt = 0; kt < ntile; ++kt) {
            wait_vm0();
            __syncthreads();
            if (kt + 1 < ntile) stage(kt + 1, (kt + 1) & 1);
            cv_step((itc & 3) == 0); ++itc;
            const char* sk = lds + (kt & 1) * ST_B; const char* sv = sk + KT_B;
            f32x16 st[2];
#pragma unroll
            for (int e = 0; e < 16; ++e) { st[0][e] = -8.f; st[1][e] = -8.f; }
#pragma unroll
            for (int kk = 0; kk < 6; ++kk)
#pragma unroll
                for (int si = 0; si < 2; ++si) {
                    const int s = si * 32 + r;
                    st[si] = mfma32(ldsv8(sk + swz256(s, kk * 2 + h)), qf[kk], st[si]);
                }
            float ps = 0.f;
#pragma unroll
            for (int si = 0; si < 2; ++si)
#pragma unroll
                for (int e = 0; e < 16; ++e) { const float p = __builtin_amdgcn_exp2f(st[si][e]); st[si][e] = p; ps += p; }
            lsum += ps;
#pragma unroll
            for (int si = 0; si < 2; ++si)
#pragma unroll
                for (int ks = 0; ks < 2; ++ks) {
                    u32x4 pp;
                    pp[0] = pk2(st[si][8 * ks + 0], st[si][8 * ks + 1]); pp[1] = pk2(st[si][8 * ks + 2], st[si][8 * ks + 3]);
                    pp[2] = pk2(st[si][8 * ks + 4], st[si][8 * ks + 5]); pp[3] = pk2(st[si][8 * ks + 6], st[si][8 * ks + 7]);
                    const bf16x8 pf = __builtin_bit_cast(bf16x8, pp);
#pragma unroll
                    for (int et = 0; et < 2; ++et) {
                        const int e = et * 32 + r;
                        o[et] = mfma32(ldsv8(sv + e * 128 + (((si * 4 + ks * 2 + h) ^ ((e >> 1) & 7)) << 4)), pf, o[et]);
                    }
                }
        }
        lsum += __shfl_xor(lsum, 32);
        const float inv = 1.f / lsum;
#pragma unroll
        for (int et = 0; et < 2; ++et)
#pragma unroll
            for (int g = 0; g < 4; ++g) {
                f32x4 v; v[0] = o[et][4 * g] * inv; v[1] = o[et][4 * g + 1] * inv; v[2] = o[et][4 * g + 2] * inv; v[3] = o[et][4 * g + 3] * inv;
                st_bf4(O + (size_t)t * D + head * 64 + et * 32 + 8 * g + 4 * h, v);
            }
    }
    while (cvn < cv_per || cv_pack_p || cv_flush_p) { __syncthreads(); cv_step(!cv_pack_p && !cv_flush_p); }
}

DI void phase_mla_out(const Args& a, int li) {
    gemm_dense_phase((const bf16_t*)(a.ws + MLA_O), D, NTOK, (const bf16_t*)(a.ws + W_MO), 1024, 1024,
        [&](int m0, int n0, const f32x4 (&acc)[4][4]) { epi_resid_f32(a, li, m0, n0, acc); });
}

DI void phase_ml_in(const Args& a) {
    bf16_t* Qm = (bf16_t*)(a.ws + ML_Q); bf16_t* Km = (bf16_t*)(a.ws + ML_K); bf16_t* KT = (bf16_t*)(a.ws + ML_KT); bf16_t* VT = (bf16_t*)(a.ws + ML_VT);
    bf16_t* OG = (bf16_t*)(a.ws + ML_OG); float* GT = (float*)(a.ws + ML_GT);
    const float* gb = a.in[23];
    auto ident = [](int, int, const f32x4 v) { return v; };
    gemm_dense_phase<false>((const bf16_t*)(a.ws + WS_H), D, NTOK, (const bf16_t*)(a.ws + W_MLIN), 3200, 1024,
        [&](int m0, int n0, const f32x4 (&acc)[4][4]) {
            if (n0 < 512) {
                epi_bf16_rowmajor(acc, [](int, int, const f32x4 v) { return v * 0.08838834764831845f; }, [&](int row) { return Qm + (size_t)(m0 + row) * 512 + n0; });
            } else if (n0 < 1024) {
                epi_bf16_rowmajor(acc, ident, [&](int row) { return Km + (size_t)(m0 + row) * 512 + (n0 - 512); });
                __syncthreads();
                epi_stage_bf16_T(acc, ident);
                __syncthreads();
                epi_flush_bf16([&](int row) { return KT + (size_t)(n0 - 512 + row) * NTOK + m0; }, [](int) { return true; });
            } else if (n0 < 2048) {
                __syncthreads();
                epi_stage_bf16_T(acc, ident);
                __syncthreads();
                epi_flush_bf16([&](int row) { return VT + (size_t)(n0 - 1024 + row) * NTOK + m0; }, [](int) { return true; });
            } else if (n0 < 3072) {
                epi_bf16_rowmajor(acc, [](int, int, const f32x4 v) { f32x4 s; s[0] = sigmoidf_(v[0]); s[1] = sigmoidf_(v[1]); s[2] = sigmoidf_(v[2]); s[3] = sigmoidf_(v[3]); return s; },
                                  [&](int row) { return OG + (size_t)(m0 + row) * D + (n0 - 2048); });
            } else {
#pragma unroll
                for (int i = 0; i < 4; ++i) {
                    const int n = lane_n(0);
                    if (n < 16) { f32x4 s = acc[i][0]; s[0] += gb[n]; s[1] += gb[n + 1]; s[2] += gb[n + 2]; s[3] += gb[n + 3]; *(f32x4*)(GT + (size_t)(m0 + lane_m(i)) * 16 + n) = s; }
                }
            }
        });
}

DI void phase_ml_scan(const Args& a) {
    const int tid = threadIdx.x, lane = tid & 63, wave = tid >> 6;
    const int fr = lane & 15, fq = lane >> 4;
    const bf16_t* Qm = (const bf16_t*)(a.ws + ML_Q); const bf16_t* Km = (const bf16_t*)(a.ws + ML_K);
    const bf16_t* KT = (const bf16_t*)(a.ws + ML_KT); const bf16_t* VT = (const bf16_t*)(a.ws + ML_VT);
    const float* GT = (const float*)(a.ws + ML_GT);
    bf16_t* HS = (bf16_t*)(a.ws + ML_HS);
    char* sQ = lds;
    char* sK = lds + 16384;
    char* sS = sK;
    char* sKT = lds + 32768;
    char* sVT = lds + 49152;
    char* sCT = lds + 55296;
    float* sRow = (float*)(lds + 67584);
    float* sCol = sRow + 64;
    float* sInt = sCol + 64;
    float* sNrm = sInt + 64;
    float* sWv = sNrm + 64;
    float* sSc = sWv + 64;
    for (int u = blockIdx.x; u < 512; u += gridDim.x) {
        const int xc_ = u & 7, s_ = u >> 3, bh_ = ((s_ >> 4) << 3) + xc_;
        const int sl = s_ & 7, dir = (s_ >> 3) & 1, head = bh_ & 3, b = bh_ >> 2;
        auto chunk_t0 = [&](int ci) {
            const int seg = ci >= 4, L = seg ? SEQ : CTXL, nch = L / 64, jc = seg ? ci - 4 : ci;
            const int oc = dir ? nch - 1 - jc : jc;
            return (seg ? b * SEQ : NLAT + b * CTXL) + oc * 64;
        };
        u32x4 pq[4], pk[4], pkt[4], pvt;
        float gi_n = 0.f, gf_n = 0.f;
        auto load_tiles = [&](int t0) {
#pragma unroll
            for (int i = 0; i < 4; ++i) {
                const int idx = tid + i * NTHR, row = idx >> 4, c = (idx & 15) ^ (row & 15);
                pq[i] = *(const u32x4*)(Qm + (size_t)(t0 + row) * 512 + head * 128 + c * 8);
                pk[i] = *(const u32x4*)(Km + (size_t)(t0 + row) * 512 + head * 128 + c * 8);
            }
#pragma unroll
            for (int i = 0; i < 4; ++i) {
                const int idx = tid + i * NTHR, row = idx >> 3, c = (idx & 7) ^ (row & 7);
                pkt[i] = *(const u32x4*)(KT + (size_t)(head * 128 + row) * NTOK + t0 + c * 8);
            }
            { const int row = tid >> 3, c = (tid & 7) ^ (row & 7); pvt = *(const u32x4*)(VT + (size_t)(head * 256 + sl * 32 + row) * NTOK + t0 + c * 8); }
            if (wave == 0) {
                const int s = dir ? 63 - lane : lane;
                gi_n = GT[(size_t)(t0 + s) * 16 + dir * 8 + head];
                gf_n = GT[(size_t)(t0 + s) * 16 + dir * 8 + 4 + head];
            }
        };
        auto store_tiles = [&]() {
#pragma unroll
            for (int i = 0; i < 4; ++i) { *(u32x4*)(sQ + (tid + i * NTHR) * 16) = pq[i]; *(u32x4*)(sK + (tid + i * NTHR) * 16) = pk[i]; *(u32x4*)(sKT + (tid + i * NTHR) * 16) = pkt[i]; }
            *(u32x4*)(sVT + tid * 16) = pvt;
        };
        auto gate_scalars = [&]() {
            const int s = dir ? 63 - lane : lane;
            const float ig = gi_n, fg = gf_n;
            const float lf = fminf(fg, 0.f) - __logf(1.f + fexp(-fabsf(fg)));
            float bc = lf;
#pragma unroll
            for (int d = 1; d < 64; d <<= 1) { const float o = __shfl_up(bc, d); if (lane >= d) bc += o; }
            const float av = ig - bc;
            float pm = av;
#pragma unroll
            for (int d = 1; d < 64; d <<= 1) { const float o = __shfl_up(pm, d); if (lane >= d) pm = fmaxf(pm, o); }
            const float mst = sSc[1];
            const float mm = fmaxf(mst, pm);
            sRow[s] = -mm;
            sCol[s] = av;
            sInt[s] = fexp(mst - mm);
            sNrm[s] = fexp(-(bc + mm));
            const float mmL = __shfl(mm, 63), bL = __shfl(bc, 63);
            sWv[s] = fexp(av - mmL);
            if (lane == 0) { sSc[0] = fexp(mst - mmL); sSc[1] = bL + mmL; }
        };
        __syncthreads();
        for (int i = tid; i < 12288 / 16; i += NTHR) *(u32x4*)(sCT + i * 16) = (u32x4){0u, 0u, 0u, 0u};
        for (int i = tid; i < 16 * 8; i += NTHR) {
            const int row = 32 + (i >> 3), c = i & 7;
            const unsigned v = row == 32 ? 0x3f803f80u : 0u;
            *(u32x4*)(sVT + swz128(row, c)) = (u32x4){v, v, v, v};
        }
        if (tid == 0) sSc[1] = -1e30f;
        f32x4 accC[2][3];
#pragma unroll
        for (int i = 0; i < 2; ++i)
#pragma unroll
            for (int jn = 0; jn < 3; ++jn) accC[i][jn] = (f32x4){0.f, 0.f, 0.f, 0.f};
        load_tiles(chunk_t0(0));
        __syncthreads();
        store_tiles();
        if (wave == 0) gate_scalars();
        __syncthreads();
#pragma unroll 1
        for (int ci = 0; ci < 36; ++ci) {
            const int t0 = chunk_t0(ci);
            if (ci + 1 < 36) load_tiles(chunk_t0(ci + 1));
            f32x4 sacc[4];
#pragma unroll
            for (int jt = 0; jt < 4; ++jt) sacc[jt] = (f32x4){0.f, 0.f, 0.f, 0.f};
#pragma unroll
            for (int kk = 0; kk < 4; ++kk) {
                const bf16x8 qf = ldsv8(sQ + swz256(wave * 16 + fr, kk * 4 + fq));
#pragma unroll
                for (int jt = 0; jt < 4; ++jt) sacc[jt] = mfma16(ldsv8(sK + swz256(jt * 16 + fr, kk * 4 + fq)), qf, sacc[jt]);
            }
            __syncthreads();
            {
                const int tq = wave * 16 + fr;
                const float rt = sRow[tq];
#pragma unroll
                for (int jt = 0; jt < 4; ++jt) {
                    const f32x4 cl = *(const f32x4*)(sCol + jt * 16 + fq * 4);
                    f32x4 v;
#pragma unroll
                    for (int e = 0; e < 4; ++e) {
                        const int s = jt * 16 + fq * 4 + e;
                        const bool ok = dir ? (s >= tq) : (s <= tq);
                        v[e] = ok ? sacc[jt][e] * fexp(rt + cl[e]) : 0.f;
                    }
                    u32x2 pv; pv[0] = pk2(v[0], v[1]); pv[1] = pk2(v[2], v[3]);
                    *(u32x2*)(sS + swz128(tq, jt * 2 + (fq >> 1)) + (fq & 1) * 8) = pv;
                }
            }
            __syncthreads();
            {
                f32x4 n1[3], n2[3];
#pragma unroll
                for (int jt = 0; jt < 3; ++jt) { n1[jt] = (f32x4){0.f, 0.f, 0.f, 0.f}; n2[jt] = (f32x4){0.f, 0.f, 0.f, 0.f}; }
#pragma unroll
                for (int kk = 0; kk < 2; ++kk) {
                    const bf16x8 sf = ldsv8(sS + swz128(wave * 16 + fr, kk * 4 + fq));
#pragma unroll
                    for (int jt = 0; jt < 3; ++jt) n1[jt] = mfma16(ldsv8(sVT + swz128(jt * 16 + fr, kk * 4 + fq)), sf, n1[jt]);
                }
#pragma unroll
                for (int kk = 0; kk < 4; ++kk) {
                    const bf16x8 qf = ldsv8(sQ + swz256(wave * 16 + fr, kk * 4 + fq));
#pragma unroll
                    for (int jt = 0; jt < 3; ++jt) n2[jt] = mfma16(ldsv8(sCT + swz256(jt * 16 + fr, kk * 4 + fq)), qf, n2[jt]);
                }
                const int tq = wave * 16 + fr;
                const float it = sInt[tq];
                float den = n1[2][0] + it * n2[2][0];
                den = __shfl(den, fr);
                const float dn = fmaxf(fabsf(den), sNrm[tq]);
                const float inv = rcpf_(dn);
                bf16_t* hp = HS + (size_t)dir * NTOK * D + (size_t)(t0 + tq) * D + head * 256 + sl * 32 + fq * 4;
#pragma unroll
                for (int jt = 0; jt < 2; ++jt) {
                    f32x4 v;
#pragma unroll
                    for (int e = 0; e < 4; ++e) v[e] = (n1[jt][e] + it * n2[jt][e]) * inv;
                    st_bf4(hp + jt * 16, v);
                }
            }
            {
                const float decay = sSc[0];
#pragma unroll
                for (int i = 0; i < 2; ++i)
#pragma unroll
                    for (int jn = 0; jn < 3; ++jn) accC[i][jn] *= decay;
#pragma unroll
                for (int kk = 0; kk < 2; ++kk) {
                    bf16x8 vf[3];
#pragma unroll
                    for (int jn = 0; jn < 3; ++jn) vf[jn] = ldsv8(sVT + swz128(jn * 16 + fr, kk * 4 + fq));
                    const f32x4 w0 = *(const f32x4*)(sWv + kk * 32 + fq * 8), w1 = *(const f32x4*)(sWv + kk * 32 + fq * 8 + 4);
#pragma unroll
                    for (int i = 0; i < 2; ++i) {
                        const u32x4 kr = *(const u32x4*)(sKT + swz128((wave * 2 + i) * 16 + fr, kk * 4 + fq));
                        u32x4 ks;
                        ks[0] = pk2(lof(kr[0]) * w0[0], hif(kr[0]) * w0[1]); ks[1] = pk2(lof(kr[1]) * w0[2], hif(kr[1]) * w0[3]);
                        ks[2] = pk2(lof(kr[2]) * w1[0], hif(kr[2]) * w1[1]); ks[3] = pk2(lof(kr[3]) * w1[2], hif(kr[3]) * w1[3]);
                        const bf16x8 kf = __builtin_bit_cast(bf16x8, ks);
#pragma unroll
                        for (int jn = 0; jn < 3; ++jn) accC[i][jn] = mfma16(kf, vf[jn], accC[i][jn]);
                    }
                }
            }
            __syncthreads();
#pragma unroll
            for (int i = 0; i < 2; ++i)
#pragma unroll
                for (int jn = 0; jn < 3; ++jn) {
                    const int dd = (wave * 2 + i) * 16 + fq * 4, ee = jn * 16 + fr;
                    u32x2 pv; pv[0] = pk2(accC[i][jn][0], accC[i][jn][1]); pv[1] = pk2(accC[i][jn][2], accC[i][jn][3]);
                    *(u32x2*)(sCT + swz256(ee, dd >> 3) + (dd & 7) * 2) = pv;
                }
            if (ci + 1 < 36) {
                store_tiles();
                if (wave == 0) gate_scalars();
            }
            __syncthreads();
        }
    }
}

DI void phase_ml_readout(const Args& a) {
    const int tid = threadIdx.x, lane = tid & 63, wave = tid >> 6;
    const bf16_t* H0 = (const bf16_t*)(a.ws + ML_HS); const bf16_t* H1 = H0 + (size_t)NTOK * D;
    const bf16_t* OG = (const bf16_t*)(a.ws + ML_OG); bf16_t* A2 = (bf16_t*)(a.ws + ML_A2);
    const float* on = a.in[24];
    for (int t = blockIdx.x * 4 + wave; t < NTOK; t += gridDim.x * 4) {
        const size_t off = (size_t)t * D + lane * 16;
        const u32x4 a0 = *(const u32x4*)(H0 + off), a1 = *(const u32x4*)(H0 + off + 8);
        const u32x4 b0 = *(const u32x4*)(H1 + off), b1 = *(const u32x4*)(H1 + off + 8);
        float v[16];
#pragma unroll
        for (int e = 0; e < 4; ++e) {
            v[2 * e] = lof(a0[e]) + lof(b0[e]); v[2 * e + 1] = hif(a0[e]) + hif(b0[e]);
            v[8 + 2 * e] = lof(a1[e]) + lof(b1[e]); v[8 + 2 * e + 1] = hif(a1[e]) + hif(b1[e]);
        }
        float ss = 0.f;
#pragma unroll
        for (int e = 0; e < 16; ++e) ss += v[e] * v[e];
        ss += __shfl_xor(ss, 1); ss += __shfl_xor(ss, 2); ss += __shfl_xor(ss, 4); ss += __shfl_xor(ss, 8);
        const float rs = rsqrtf(ss * (1.f / 256.f) + EPS);
        const u32x4 g0 = *(const u32x4*)(OG + off), g1 = *(const u32x4*)(OG + off + 8);
        const float* onp = on + lane * 16;
        u32x4 o0, o1;
#pragma unroll
        for (int e = 0; e < 4; ++e) {
            o0[e] = pk2(v[2 * e] * rs * onp[2 * e] * lof(g0[e]), v[2 * e + 1] * rs * onp[2 * e + 1] * hif(g0[e]));
            o1[e] = pk2(v[8 + 2 * e] * rs * onp[8 + 2 * e] * lof(g1[e]), v[8 + 2 * e + 1] * rs * onp[8 + 2 * e + 1] * hif(g1[e]));
        }
        *(u32x4*)(A2 + off) = o0; *(u32x4*)(A2 + off + 8) = o1;
    }
}

DI void phase_ml_out(const Args& a, int li) {
    gemm_dense_phase((const bf16_t*)(a.ws + ML_A2), D, NTOK, (const bf16_t*)(a.ws + W_MLOUT), 1024, 1024,
        [&](int m0, int n0, const f32x4 (&acc)[4][4]) { epi_resid_f32(a, li, m0, n0, acc); });
}

template <int STAGE>
DI void phase_moe(const Args& a, int li) {
    const int tid = threadIdx.x, lane = tid & 63, wave = tid >> 6;
    const int fr = lane & 15, fq = lane >> 4, wm = wave >> 1, wn = wave & 1;
    const int* cnt = (const int*)(a.ws + WS_CTL + CTL_CNT) + li * 64;
    const int* list = (const int*)(a.ws + WS_LIST);
    const float* wsl = (const float*)(a.ws + WS_WSLOT);
    const bf16_t* F = (const bf16_t*)(a.ws + WS_H);
    bf16_t* HM = (bf16_t*)(a.ws + WS_HMID); bf16_t* Y = (bf16_t*)(a.ws + WS_Y);
    int* pre = (int*)(lds + LDS_AUX);
    int* srowb = pre + 16;
    const int xc = blockIdx.x & 7, rank = blockIdx.x >> 3, nrank = gridDim.x >> 3;
    __syncthreads();
    if (tid == 0) { int s = 0; for (int i = 0; i < 8; ++i) { pre[i] = s; s += (cnt[xc + 8 * i] + 127) >> 7; } pre[8] = s; }
    __syncthreads();
    const int T = pre[8];
    constexpr int NTN = STAGE == 0 ? 4 : 8;
    constexpr int KK = STAGE == 0 ? 1024 : 256;
    const int total = T * NTN;
    int e = 0, r0 = 0, ce = 0, nt = 0, cur = 0;
    auto decode = [&](int u) {
        const int ti = u / NTN; nt = u % NTN;
        int ei = 0;
#pragma unroll 1
        for (int s = 4; s > 0; s >>= 1) if (pre[ei + s] <= ti) ei += s;
        e = xc + 8 * ei; r0 = (ti - pre[ei]) * 128; ce = cnt[e];
    };
    GemmPipe g;
    auto prep = [&](int buf) {
        int* srow = srowb + buf * 128;
        if (tid < 128) srow[tid] = list[(size_t)e * NTOK + min(r0 + tid, ce - 1)];
        __syncthreads();
        if (STAGE == 0) g.setup([&](int r) { return F + (size_t)(srow[r] >> 1) * D; }, (const bf16_t*)(a.ws + W_GU) + ((size_t)(li * 64 + e) * 512 + nt * 128) * 1024, 1024);
        else g.setup([&](int r) { return HM + (size_t)srow[r] * 256; }, (const bf16_t*)(a.ws + W_DN) + ((size_t)(li * 64 + e) * 1024 + nt * 128) * 256, 256);
        g.issue(0, 0);
    };
    int u = rank;
    if (u < total) { decode(u); prep(cur); }
    while (u < total) {
        f32x4 acc[4][4];
        g.run(KK, acc);
        const int cr0 = r0, cce = ce, cnt_ = nt;
        const int* srow = srowb + cur * 128;
        u += nrank;
        if (u < total) { decode(u); prep(cur ^ 1); }
        if (STAGE == 0) {
            __syncthreads();
            {
                const int tz = opaque_tid();
#pragma unroll
                for (int i = 0; i < 4; ++i) {
                    const int m = lane_m(tz, i);
#pragma unroll
                    for (int p = 0; p < 2; ++p) {
                        const int c = (((tz >> 6) & 1) * 2 + p) * 16 + ((tz >> 4) & 3) * 4;
                        f32x4 v;
#pragma unroll
                        for (int x = 0; x < 4; ++x) { const float gg = acc[i][2 * p][x]; v[x] = gg * rcpf_(1.f + fexp(-gg)) * acc[i][2 * p + 1][x]; }
                        u32x2 o; o[0] = pk2(v[0], v[1]); o[1] = pk2(v[2], v[3]);
                        *(u32x2*)(lds + EPI_OFF + m * 128 + (((c >> 3) ^ (m & 7)) << 4) + (c & 4) * 2) = o;
                    }
                }
            }
            __syncthreads();
            {
                const int tz = opaque_tid();
#pragma unroll
                for (int it = 0; it < 4; ++it) {
                    const int idx = tz + it * NTHR, row = idx >> 3, ch = idx & 7;
                    const u32x4 v = *(const u32x4*)(lds + EPI_OFF + row * 128 + ((ch ^ (row & 7)) << 4));
                    if (cr0 + row < cce) *(u32x4*)(HM + (size_t)srow[row] * 256 + cnt_ * 64 + ch * 8) = v;
                }
            }
        } else {
            float wrow[4];
            {
                const int tz = opaque_tid();
#pragma unroll
                for (int i = 0; i < 4; ++i) wrow[i] = wsl[srow[lane_m(tz, i)]];
            }
            __syncthreads();
            epi_stage_bf16(acc, [&](int i, int, const f32x4 v) { return v * wrow[i]; });
            __syncthreads();
            epi_flush_bf16([&](int row) { return Y + (size_t)srow[row] * D + cnt_ * 128; }, [&](int row) { return cr0 + row < cce; });
        }
        cur ^= 1;
    }
    __syncthreads();
}

#ifndef DBG_GPROBE
#define DBG_GPROBE -1
#endif
template <int PM>
DI void phase_gemm_probe(const Args& a) {
    const bf16_t* A = (const bf16_t*)(a.ws + WS_H); const bf16_t* Bt = (const bf16_t*)(a.ws + W_RGIN);
    float* dummy = (float*)(a.ws + RG_A2);
    const int mt = 144, nt = 16, K = 1024;
    GemmPipe g;
    __syncthreads();
    for (int u = blockIdx.x; u < mt * nt; u += gridDim.x) {
        const int m0 = (u % mt) * 128, n0 = (u / mt) * 128;
        g.setup([&](int r) { return A + (size_t)(m0 + r) * 1024; }, Bt + (size_t)n0 * K, K);
        if (PM & 1) g.issue(0, 0);
        f32x4 acc[4][4];
        g.run_probe<PM>(K, acc);
        float s = 0.f;
#pragma unroll
        for (int i = 0; i < 4; ++i)
#pragma unroll
            for (int j = 0; j < 4; ++j) s += acc[i][j][0] + acc[i][j][1] + acc[i][j][2] + acc[i][j][3];
        if (s == 12345.678f) dummy[threadIdx.x] = s;
        if (PM & 8) {
            bf16_t* Yd = (bf16_t*)(a.ws + WS_Y);
            const int lane = threadIdx.x & 63, wave = threadIdx.x >> 6;
            const int mb = m0 + (wave >> 1) * 64 + (lane & 15), nb = n0 + (wave & 1) * 64 + (lane >> 4) * 4;
#pragma unroll
            for (int i = 0; i < 4; ++i)
#pragma unroll
                for (int j = 0; j < 4; ++j) {
                    f32x4 v = acc[i][j];
                    if (PM & 16) { v[0] = gelu_tanh(v[0]); v[1] = gelu_tanh(v[1]); v[2] = gelu_tanh(v[2]); v[3] = gelu_tanh(v[3]); }
                    st_bf4(Yd + (size_t)(mb + i * 16) * 2048 + nb + j * 16, v);
                }
        }
        __syncthreads();
    }
}

#ifndef DBG_STOP
#define DBG_STOP 99
#endif
#ifndef DBG_OFF
#define DBG_OFF 0
#endif
DI void phase_dbg(const Args& a) {
    const size_t n = (size_t)NLAT * D;
    const float* X = (const float*)(a.ws + WS_X);
    const bf16_t* B = (const bf16_t*)(a.ws + (size_t)DBG_OFF);
    for (size_t i = (size_t)blockIdx.x * NTHR + threadIdx.x; i < n; i += (size_t)gridDim.x * NTHR)
        a.out[i] = DBG_OFF ? bf2f(B[i]) : X[i];
}

constexpr int NPH = 34;
__global__ void __launch_bounds__(NTHR, 2) fwd(const Args a) {
    if (threadIdx.x == 0) *(uint4*)(lds + LDS_BARW) = make_uint4(0u, 0u, 0u, 0u);
    __syncthreads();
    XcdBarrier bar;
    const bool multi = (a.ph_hi - a.ph_lo) > 1;
    if (multi) bar = xcd_barrier_post((unsigned*)(a.ws + WS_CTL), (volatile LAS unsigned*)(lds + LDS_BARW));
#ifndef DBG_REP
#define DBG_REP -1
#endif
#ifndef DBG_REPN
#define DBG_REPN 3
#endif
#define RUN(id, ...) do { if (a.ph_lo <= (id) && (id) < a.ph_hi) { \
        if ((id) == DBG_REP) { for (int rep_ = 1; rep_ < DBG_REPN; ++rep_) { __VA_ARGS__; xcd_barrier(bar); } } \
        __VA_ARGS__; if ((id) + 1 < a.ph_hi) xcd_barrier(bar); } } while (0)
    RUN(0, phase_prologue(a));
    RUN(1, phase_token_row<0>(a, 0));
    RUN(2, phase_rg_in(a, 0));
    if (DBG_GPROBE >= 0) { RUN(2, phase_gemm_probe<(DBG_GPROBE < 0 ? 7 : DBG_GPROBE)>(a)); }
#ifdef DBG_SCANVAR
    RUN(3, phase_rg_scan<DBG_SCANVAR>(a, 0));
#endif
    RUN(3, phase_rg_scan(a, 0));
    RUN(4, phase_rg_combine(a));
    RUN(5, phase_rg_out(a, 0, 0));
    RUN(6, phase_token_router(a, 0));
    RUN(7, phase_moe<0>(a, 0));
    RUN(8, phase_moe<1>(a, 0));
    RUN(9, phase_token_row<0>(a, 1));
    RUN(10, phase_mla_down(a));
    RUN(11, phase_mla_up(a));
    RUN(12, phase_mla_attn(a));
    RUN(13, phase_mla_out(a, 1));
    RUN(14, phase_token_router(a, 1));
    RUN(15, phase_moe<0>(a, 1));
    RUN(16, phase_moe<1>(a, 1));
    RUN(17, phase_token_row<0>(a, 2));
    RUN(18, phase_ml_in(a));
    RUN(19, phase_ml_scan(a));
    RUN(20, phase_ml_readout(a));
    RUN(21, phase_ml_out(a, 2));
    RUN(22, phase_token_router(a, 2));
    RUN(23, phase_moe<0>(a, 2));
    RUN(24, phase_moe<1>(a, 2));
    RUN(25, phase_token_row<0>(a, 3));
    RUN(26, phase_rg_in(a, 1));
    RUN(27, phase_rg_scan(a, 1));
    RUN(28, phase_rg_combine(a));
    RUN(29, phase_rg_out(a, 3, 1));
    RUN(30, phase_token_router(a, 3));
    RUN(31, phase_moe<0>(a, 3));
    RUN(32, phase_moe<1>(a, 3));
    RUN(33, phase_token_row<2>(a, 3));
    RUN(34, phase_dbg(a));
#undef RUN
}

static void add_td(Args& a, int& n, int& tile0, const float* src, bf16_t* dst, const float* rscale, long sb, long db, int K, int N, int Npad, int batch, int perm) {
    TDesc& t = a.td[n++];
    t.src = src; t.dst = dst; t.rscale = rscale; t.sb = sb; t.db = db; t.K = K; t.N = N; t.Npad = Npad; t.batch = batch; t.perm = perm;
    t.tiles_k = (K + 127) / 128; t.tiles_n = (Npad + 63) / 64; t.tile0 = tile0;
    tile0 += batch * t.tiles_k * t.tiles_n;
}

extern "C" void kernel_launch(void* const* d_in, const int* in_sizes, int n_in, void* d_out, int out_size, void* d_ws, size_t ws_size, hipStream_t stream) {
    static int grid = 0;
    if (grid == 0) {
        if (n_in != 32 || out_size != NLAT * D || ws_size < WS_END) { fprintf(stderr, "kernel_launch: unexpected sizes (n_in %d out %d ws %zu need %zu)\n", n_in, out_size, ws_size, (size_t)WS_END); grid = -1; return; }
        int dev = 0, cus = 0, per_cu = 0;
        (void)hipGetDevice(&dev);
        (void)hipDeviceGetAttribute(&cus, hipDeviceAttributeMultiprocessorCount, dev);
        if (hipOccupancyMaxActiveBlocksPerMultiprocessor(&per_cu, (const void*)fwd, NTHR, 0) != hipSuccess) per_cu = 0;
        (void)hipGetLastError();
        if (per_cu < 2) fprintf(stderr, "kernel_launch: note: occupancy query reports %d blocks per CU (need 2)\n", per_cu);
        grid = cus * (per_cu >= 2 ? 2 : (per_cu >= 1 ? 1 : 2));
    }
    if (grid < 0) return;
    (void)in_sizes;
    (void)hipMemsetAsync((char*)d_ws + WS_CTL, 0, CTL_BYTES, stream);
    Args a;
    memset(&a, 0, sizeof(a));
    for (int i = 0; i < 32; ++i) a.in[i] = (const float*)d_in[i];
    a.out = (float*)d_out; a.ws = (unsigned char*)d_ws;
    unsigned char* ws = (unsigned char*)d_ws;
    int n = 0, tile0 = 0;
    add_td(a, n, tile0, a.in[8], (bf16_t*)(ws + W_RGIN), nullptr, 1024L * 2048, 2048L * 1024, 1024, 2048, 2048, 2, 0);
    add_td(a, n, tile0, a.in[14], (bf16_t*)(ws + W_RGOUT), nullptr, 1024L * 1024, 1024L * 1024, 1024, 1024, 1024, 2, 0);
    for (int j = 0; j < 2; ++j) for (int dir = 0; dir < 2; ++dir) for (int g = 0; g < 2; ++g)
        add_td(a, n, tile0, a.in[11] + (size_t)((j * 2 + dir) * 2 + g) * 16 * 4096, (bf16_t*)(ws + W_RGG) + (size_t)(j * 2 + dir) * 16 * 8192 + g * 4096, nullptr, 4096, 8192, 64, 64, 64, 16, 0);
    add_td(a, n, tile0, a.in[15], (bf16_t*)(ws + W_MDOWN), nullptr, 0, 0, 1024, 416, 512, 1, 0);
    add_td(a, n, tile0, a.in[18], (bf16_t*)(ws + W_MUQ), a.in[16], 0, 0, 256, 1536, 1536, 1, 0);
    add_td(a, n, tile0, a.in[19], (bf16_t*)(ws + W_MUKV), a.in[17], 0, 0, 128, 2048, 2048, 1, 0);
    add_td(a, n, tile0, a.in[21], (bf16_t*)(ws + W_MO), nullptr, 0, 0, 1024, 1024, 1024, 1, 0);
    add_td(a, n, tile0, a.in[22], (bf16_t*)(ws + W_MLIN), nullptr, 0, 0, 1024, 3088, 3200, 1, 0);
    add_td(a, n, tile0, a.in[25], (bf16_t*)(ws + W_MLOUT), nullptr, 0, 0, 1024, 1024, 1024, 1, 0);
    add_td(a, n, tile0, a.in[30], (bf16_t*)(ws + W_GU), nullptr, 1024L * 512, 512L * 1024, 1024, 512, 512, 64, 1);
    add_td(a, n, tile0, a.in[31], (bf16_t*)(ws + W_DN), nullptr, 256L * 1024, 1024L * 256, 256, 1024, 1024, 64, 0);
    a.ntiles_total = tile0;
    if (n != NTD) { fprintf(stderr, "kernel_launch: descriptor count %d != %d\n", n, NTD); return; }
#if MK_ONE_LAUNCH
    a.ph_lo = 0; a.ph_hi = NPH;
    hipLaunchKernelGGL(fwd, dim3(grid), dim3(NTHR), 0, stream, a);
#else
    for (int ph = 0; ph < NPH && ph <= DBG_STOP; ++ph) {
        a.ph_lo = ph; a.ph_hi = ph + 1;
        hipLaunchKernelGGL(fwd, dim3(grid), dim3(NTHR), 0, stream, a);
    }
    if (DBG_STOP < NPH) { a.ph_lo = 34; a.ph_hi = 35; hipLaunchKernelGGL(fwd, dim3(grid), dim3(NTHR), 0, stream, a); }
#endif
}
```

```cpp
#include <hip/hip_runtime.h>
#include <stdint.h>
#include <string.h>
#include <stdio.h>

#ifndef MK_ONE_LAUNCH
#define MK_ONE_LAUNCH 1
#endif

#define DI __device__ __forceinline__
typedef unsigned short bf16_t;
typedef __attribute__((ext_vector_type(8))) short bf16x8;
typedef __attribute__((ext_vector_type(4))) float f32x4;
typedef __attribute__((ext_vector_type(16))) float f32x16;
typedef __attribute__((ext_vector_type(2))) float f32x2;
typedef __attribute__((ext_vector_type(2))) __bf16 bfx2;
typedef __attribute__((ext_vector_type(4))) unsigned u32x4;
typedef __attribute__((ext_vector_type(2))) unsigned u32x2;

constexpr int D = 1024, NB = 8, SEQ = 2048, CTXL = 256;
constexpr int NLAT = NB * SEQ, NCTX = NB * CTXL, NTOK = NLAT + NCTX;
constexpr int NKEY = CTXL + SEQ;
constexpr int NTHR = 256;
constexpr int LDS_BYTES = 73728;
constexpr int LDS_AUX = 65536;
constexpr int LDS_BARW = LDS_BYTES - 16;
constexpr float EPS = 1e-6f;

constexpr size_t al256(size_t x) { return (x + 255) & ~(size_t)255; }
constexpr size_t WS_CTL = 0;
constexpr size_t CTL_BYTES = 65536;
constexpr size_t CTL_CNT = 16384;
constexpr size_t CTL_ROPE = 32768;
constexpr size_t WS_MOD = WS_CTL + CTL_BYTES;
constexpr size_t WS_X = al256(WS_MOD + 4 * 9 * 6144 * 4);
constexpr size_t WS_H = al256(WS_X + (size_t)NTOK * D * 4);
constexpr size_t WS_SCR = al256(WS_H + (size_t)NTOK * D * 2);
constexpr size_t SCR_BYTES = (size_t)256 << 20;
constexpr size_t TOKD2 = (size_t)NTOK * D * 2;
constexpr size_t RG_G = WS_SCR, RG_U = RG_G + TOKD2, RG_HS = RG_U + TOKD2, RG_A2 = RG_HS + 2 * TOKD2;
constexpr size_t MLA_CQ = WS_SCR;
constexpr size_t MLA_CKV = MLA_CQ + (size_t)NTOK * 256 * 2;
constexpr size_t MLA_KR = MLA_CKV + (size_t)NTOK * 128 * 2;
constexpr size_t MLA_Q = MLA_KR + (size_t)NTOK * 32 * 4;
constexpr size_t MLA_K = MLA_Q + (size_t)NTOK * 1536 * 2;
constexpr size_t MLA_VT = MLA_K + (size_t)NB * 16 * NKEY * 96 * 2;
constexpr size_t MLA_O = MLA_VT + (size_t)NB * 16 * 64 * NKEY * 2;
constexpr size_t MLA_END = MLA_O + TOKD2;
constexpr size_t ML_Q = WS_SCR;
constexpr size_t ML_K = ML_Q + (size_t)NTOK * 512 * 2;
constexpr size_t ML_KT = ML_K + (size_t)NTOK * 512 * 2;
constexpr size_t ML_VT = ML_KT + (size_t)NTOK * 512 * 2;
constexpr size_t ML_OG = ML_VT + TOKD2;
constexpr size_t ML_GT = ML_OG + TOKD2;
constexpr size_t ML_HS = ML_GT + (size_t)NTOK * 16 * 4;
constexpr size_t ML_A2 = ML_HS + 2 * TOKD2;
constexpr size_t ML_END = ML_A2 + TOKD2;
static_assert(RG_A2 + TOKD2 <= WS_SCR + SCR_BYTES && MLA_END <= WS_SCR + SCR_BYTES && ML_END <= WS_SCR + SCR_BYTES, "scratch");
constexpr size_t WS_LIST = WS_SCR + SCR_BYTES;
constexpr size_t WS_WSLOT = al256(WS_LIST + (size_t)64 * NTOK * 4);
constexpr size_t WS_HMID = al256(WS_WSLOT + (size_t)2 * NTOK * 4);
constexpr size_t WS_Y = al256(WS_HMID + (size_t)2 * NTOK * 256 * 2);
constexpr size_t WS_W = al256(WS_Y + (size_t)2 * NTOK * D * 2);
constexpr size_t W_RGIN = WS_W;
constexpr size_t W_RGOUT = W_RGIN + (size_t)2 * 2048 * 1024 * 2;
constexpr size_t W_RGG = W_RGOUT + (size_t)2 * 1024 * 1024 * 2;
constexpr size_t W_MDOWN = W_RGG + (size_t)2 * 2 * 16 * 128 * 64 * 2;
constexpr size_t W_MUQ = W_MDOWN + (size_t)512 * 1024 * 2;
constexpr size_t W_MUKV = W_MUQ + (size_t)1536 * 256 * 2;
constexpr size_t W_MO = W_MUKV + (size_t)2048 * 128 * 2;
constexpr size_t W_MLIN = W_MO + (size_t)1024 * 1024 * 2;
constexpr size_t W_MLOUT = W_MLIN + (size_t)3200 * 1024 * 2;
constexpr size_t W_RT = W_MLOUT + (size_t)1024 * 1024 * 2;
constexpr size_t W_GU = al256(W_RT + (size_t)4 * 2 * 80 * 1024 * 2);
constexpr size_t W_DN = W_GU + (size_t)256 * 512 * 1024 * 2;
constexpr size_t WS_GS = W_DN + (size_t)256 * 1024 * 256 * 2;
constexpr size_t WS_END = WS_GS + (size_t)512 * 36 * 3 * 64 * 4;

struct TDesc {
    const float* src; bf16_t* dst; const float* rscale;
    long sb, db;
    int K, N, Npad, batch;
    int perm, tiles_k, tiles_n, tile0;
};
constexpr int NTD = 18;
struct Args {
    const float* in[32];
    float* out;
    unsigned char* ws;
    TDesc td[NTD];
    int ntiles_total, ph_lo, ph_hi, pad0;
};

DI float bf2f(bf16_t v) { return __uint_as_float((unsigned)v << 16); }
DI unsigned pk2(float a, float b) { f32x2 v = {a, b}; bfx2 r = __builtin_convertvector(v, bfx2); return __builtin_bit_cast(unsigned, r); }
DI bf16_t f2bf(float a) { return (bf16_t)(pk2(a, 0.f) & 0xffffu); }
DI float lof(unsigned u) { return __uint_as_float(u << 16); }
DI float hif(unsigned u) { return __uint_as_float(u & 0xffff0000u); }
DI float rcpf_(float x) { return __builtin_amdgcn_rcpf(x); }
DI float fexp(float x) { return __builtin_amdgcn_exp2f(x * 1.4426950408889634f); }
DI float sigmoidf_(float x) { return rcpf_(1.f + fexp(-x)); }
DI float gelu_tanh(float x) { float u = 0.7978845608028654f * (x + 0.044715f * x * x * x); float e = fexp(2.f * u); return x * (1.f - rcpf_(e + 1.f)); }
DI int tok_modrow(int t) { return t < NLAT ? (t >> 11) : 8; }
DI void dma16(const void* g, char* l) { __builtin_amdgcn_global_load_lds((const unsigned*)g, (unsigned*)l, 16, 0, 0); }
DI void wait_vm0() { asm volatile("s_waitcnt vmcnt(0)" ::: "memory"); }
DI void lds_barrier() { asm volatile("s_waitcnt lgkmcnt(0)" ::: "memory"); __builtin_amdgcn_s_barrier(); asm volatile("" ::: "memory"); }
DI int swz128(int row, int chunk) { return row * 128 + ((chunk ^ (row & 7)) << 4); }
DI int swz256(int row, int chunk) { return row * 256 + ((chunk ^ (row & 15)) << 4); }
DI f32x4 mfma16(bf16x8 a, bf16x8 b, f32x4 c) { return __builtin_amdgcn_mfma_f32_16x16x32_bf16(a, b, c, 0, 0, 0); }
DI f32x16 mfma32(bf16x8 a, bf16x8 b, f32x16 c) { return __builtin_amdgcn_mfma_f32_32x32x16_bf16(a, b, c, 0, 0, 0); }
DI bf16x8 ldsv8(const char* p) { return *(const bf16x8*)p; }
DI void st_bf4(bf16_t* p, const f32x4 v) { u32x2 o; o[0] = pk2(v[0], v[1]); o[1] = pk2(v[2], v[3]); *(u32x2*)p = o; }

__shared__ __attribute__((aligned(16))) char lds[LDS_BYTES];

#define XB_TMO      128
#define XB_XCNT(j)  (256  + 64 * (j))
#define XB_XSUB(j)  (1280 + 64 * (j))
#define XB_XGEN(j)  (2304 + 64 * (j))
#define XB_TOP      3328
#define XB_TOPGEN   3392
#define XCD_BAR_WORDS 3456
#define XB_SPIN_CAP (1u << 22)
#define LAS __attribute__((address_space(3)))
DI unsigned xb_ld(unsigned* p)              { return __hip_atomic_load(p, __ATOMIC_RELAXED, __HIP_MEMORY_SCOPE_AGENT); }
DI unsigned xb_add(unsigned* p, unsigned v) { return __hip_atomic_fetch_add(p, v, __ATOMIC_RELAXED, __HIP_MEMORY_SCOPE_AGENT); }
DI unsigned xb_xcc_id() { return (unsigned)__builtin_amdgcn_s_getreg((3 << 11) | 20) & 0xFu; }
#define XB_SPIN(cond, bar) do { unsigned _sp = 0; while (cond) { __builtin_amdgcn_s_sleep(1); \
    if ((++_sp & 255u) == 0u) { if (xb_ld(&(bar)[XB_TMO])) break; if (_sp > XB_SPIN_CAP) { atomicAdd(&(bar)[XB_TMO], 1u); break; } } } } while (0)
struct XcdBarrier { unsigned* bar; unsigned x; volatile LAS unsigned* st; };
DI XcdBarrier xcd_barrier_post(unsigned* bar, volatile LAS unsigned* st) {
    XcdBarrier b; b.bar = bar; b.x = xb_xcc_id(); b.st = st;
    if (threadIdx.x == 0) (void)xb_add(&bar[XB_XCNT(b.x)], 1u);
    return b;
}
DI void xcd_barrier_complete(unsigned* bar, unsigned x, unsigned& nloc, unsigned& nx) {
    const unsigned G = gridDim.x * gridDim.y * gridDim.z;
    unsigned sum, cnt, mine, sp = 0u;
    for (;;) {
        sum = 0u; cnt = 0u; mine = 0u;
#pragma unroll
        for (unsigned j = 0; j < 16; ++j) { const unsigned c = xb_ld(&bar[XB_XCNT(j)]); sum += c; cnt += (c > 0u) ? 1u : 0u; mine = (j == x) ? c : mine; }
        if (sum == G) break;
        __builtin_amdgcn_s_sleep(1);
        if ((++sp & 255u) == 0u) { if (xb_ld(&bar[XB_TMO])) break; if (sp > XB_SPIN_CAP) { atomicAdd(&bar[XB_TMO], 1u); break; } }
    }
    nloc = mine > 0u ? mine : 1u; nx = cnt > 0u ? cnt : 1u;
}
DI void xcd_barrier(const XcdBarrier& b) {
    asm volatile("s_waitcnt vmcnt(0)" ::: "memory");
    __syncthreads();
    if (threadIdx.x == 0) {
        unsigned* bar = b.bar;
        __builtin_amdgcn_s_waitcnt(0);
        unsigned nloc = b.st[0], nx = b.st[1];
        if (nloc == 0u) { xcd_barrier_complete(bar, b.x, nloc, nx); b.st[0] = nloc; b.st[1] = nx; }
        const unsigned old = xb_add(&bar[XB_XSUB(b.x)], 1u);
        const unsigned gen = old / nloc;
        if (old + 1u == (gen + 1u) * nloc) {
            __builtin_amdgcn_fence(__ATOMIC_RELEASE, "agent");
            asm volatile("s_waitcnt vmcnt(0)" ::: "memory");
            const unsigned og = xb_add(&bar[XB_TOP], 1u);
            const unsigned tg = og / nx;
            if (og + 1u == (tg + 1u) * nx) xb_add(&bar[XB_TOPGEN], 1u);
            else XB_SPIN(xb_ld(&bar[XB_TOPGEN]) == tg, bar);
            __builtin_amdgcn_fence(__ATOMIC_ACQUIRE, "agent");
            xb_add(&bar[XB_XGEN(b.x)], 1u);
            asm volatile("s_waitcnt vmcnt(0)" ::: "memory");
        } else {
            XB_SPIN(xb_ld(&bar[XB_XGEN(b.x)]) == gen, bar);
            __builtin_amdgcn_fence(__ATOMIC_ACQUIRE, "agent");
            asm volatile("s_waitcnt vmcnt(0)" ::: "memory");
        }
    }
    __syncthreads();
}

struct CvTile { const float* src; bf16_t* dst; int K, N, perm, k0, n0; };
DI CvTile moe_cv_tile(const Args& a, const int L, const int t) {
    CvTile c;
    const int e = t / 96, r = t - e * 96;
    if (r < 64) {
        c.src = a.in[30] + (size_t)(L * 64 + e) * 1024 * 512; c.dst = (bf16_t*)(a.ws + W_GU) + (size_t)(L * 64 + e) * 512 * 1024;
        c.K = 1024; c.N = 512; c.perm = 1; c.k0 = (r & 7) * 128; c.n0 = (r >> 3) * 64;
    } else {
        const int r2 = r - 64;
        c.src = a.in[31] + (size_t)(L * 64 + e) * 256 * 1024; c.dst = (bf16_t*)(a.ws + W_DN) + (size_t)(L * 64 + e) * 1024 * 256;
        c.K = 256; c.N = 1024; c.perm = 0; c.k0 = (r2 & 1) * 128; c.n0 = (r2 >> 1) * 64;
    }
    return c;
}
DI void cv_load(const CvTile& c, f32x4 (&L0)[4], f32x4 (&L1)[4]) {
    const int tid = threadIdx.x, c4 = tid & 15, kr = tid >> 4;
    const float* p = c.src + (size_t)(c.k0 + 2 * kr) * c.N + c.n0 + 4 * c4;
#pragma unroll
    for (int i = 0; i < 4; ++i) { L0[i] = *(const f32x4*)(p + (size_t)(32 * i) * c.N); L1[i] = *(const f32x4*)(p + (size_t)(32 * i + 1) * c.N); }
}
DI void cv_pack(unsigned* st, const f32x4 (&L0)[4], const f32x4 (&L1)[4]) {
    const int tid = threadIdx.x, c4 = tid & 15, kr = tid >> 4;
#pragma unroll
    for (int i = 0; i < 4; ++i)
#pragma unroll
        for (int j = 0; j < 4; ++j) st[(4 * c4 + j) * 68 + 16 * i + kr] = pk2(L0[i][j], L1[i][j]);
}
DI void cv_flush(const CvTile& c, const unsigned* st) {
    const int tid = threadIdx.x;
#pragma unroll
    for (int i = 0; i < 4; ++i) {
        const int id = tid + i * 256, n = id >> 4, kc = id & 15;
        const u32x4 o = *(const u32x4*)(st + n * 68 + kc * 4);
        int nd = c.n0 + n;
        if (c.perm) { const int cc = nd & 255, up = nd >> 8; nd = ((cc >> 4) << 5) + (up << 4) + (cc & 15); }
        *(u32x4*)(c.dst + (size_t)nd * c.K + c.k0 + kc * 8) = o;
    }
}

DI void phase_prologue(const Args& a) {
    const int tid = threadIdx.x;
    const int n_ada = 384, n_rt = 320;
    const int total = n_ada + n_rt;
    float* sc = (float*)lds;
    for (int u = blockIdx.x; u < total; u += gridDim.x) {
        __syncthreads();
        if (u < n_ada) {
            const float* c = a.in[1]; const float* cc = a.in[3];
            for (int i = tid; i < 9 * 1024; i += NTHR) {
                float v = i < 8192 ? c[i] : cc[i - 8192];
                sc[i] = v / (1.f + __expf(-v));
            }
            __syncthreads();
            const int n = u * 64 + (tid & 63), li = n / 6144, nn = n - li * 6144, kq = tid >> 6;
            const float* wp = a.in[4] + (size_t)li * 1024 * 6144 + (size_t)(kq * 256) * 6144 + nn;
            float acc[9];
#pragma unroll
            for (int r = 0; r < 9; ++r) acc[r] = 0.f;
#pragma unroll 1
            for (int k0 = kq * 256; k0 < kq * 256 + 256; k0 += 16) {
                float wv[16];
#pragma unroll
                for (int kk = 0; kk < 16; ++kk) { wv[kk] = *wp; wp += 6144; }
#pragma unroll
                for (int kk = 0; kk < 16; kk += 4)
#pragma unroll
                    for (int r = 0; r < 9; ++r) {
                        const f32x4 s4 = *(const f32x4*)(sc + r * 1024 + k0 + kk);
                        acc[r] += s4[0] * wv[kk] + s4[1] * wv[kk + 1] + s4[2] * wv[kk + 2] + s4[3] * wv[kk + 3];
                    }
            }
            float* part = sc + 9 * 1024;
#pragma unroll
            for (int r = 0; r < 9; ++r) part[(kq * 9 + r) * 64 + (tid & 63)] = acc[r];
            __syncthreads();
            for (int i = tid; i < 9 * 64; i += NTHR) {
                const int r = i >> 6, cidx = i & 63;
                const int n2 = u * 64 + cidx, l2 = n2 / 6144, nn2 = n2 - l2 * 6144;
                const float v = ((part[(0 * 9 + r) * 64 + cidx] + part[(1 * 9 + r) * 64 + cidx]) + part[(2 * 9 + r) * 64 + cidx]) + part[(3 * 9 + r) * 64 + cidx];
                ((float*)(a.ws + WS_MOD))[((size_t)l2 * 9 + r) * 6144 + nn2] = v + a.in[5][l2 * 6144 + nn2];
            }
        } else if (u < n_ada + n_rt) {
            const int r_ = u - n_ada, li = r_ / 80, n = r_ - li * 80;
            if (r_ == 0) {
                float* rt_ = (float*)(a.ws + WS_CTL + CTL_ROPE);
                for (int i = tid; i < 512; i += NTHR) {
                    const int pos = i >> 3, fi = i & 7;
                    const float ang = (float)pos * powf(10000.f, -(float)fi * 0.125f);
                    rt_[i] = cosf(ang); rt_[512 + i] = sinf(ang);
                }
            }
            bf16_t* rt = (bf16_t*)(a.ws + W_RT) + (size_t)li * 2 * 80 * 1024;
            const float* wg = a.in[26] + (size_t)li * 1024 * 8;
            const float* we = a.in[28] + (size_t)li * 1024 * 64;
            float v[4];
#pragma unroll
            for (int j = 0; j < 4; ++j) { const int k = tid * 4 + j; v[j] = n < 8 ? wg[k * 8 + n] : (n < 72 ? we[k * 64 + (n - 8)] : 0.f); }
            u32x2 hi, lo;
            hi[0] = pk2(v[0], v[1]); hi[1] = pk2(v[2], v[3]);
            lo[0] = pk2(v[0] - lof(hi[0]), v[1] - hif(hi[0])); lo[1] = pk2(v[2] - lof(hi[1]), v[3] - hif(hi[1]));
            *(u32x2*)(rt + n * 1024 + tid * 4) = hi;
            *(u32x2*)(rt + 80 * 1024 + n * 1024 + tid * 4) = lo;
        }
    }
    struct PTile { const float* src; bf16_t* dst; const float* rscale; int K, N, Npad, perm, k0, n0; };
    auto decode = [&](int tix) {
        int di = 0;
#pragma unroll 1
        for (int i = 1; i < NTD; ++i) if (tix >= a.td[i].tile0) di = i;
        const TDesc& td = a.td[di];
        int rem = tix - td.tile0;
        const int per = td.tiles_k * td.tiles_n;
        const int bi = rem / per; rem -= bi * per;
        PTile p;
        p.src = td.src + (size_t)bi * td.sb; p.dst = td.dst + (size_t)bi * td.db; p.rscale = td.rscale;
        p.K = td.K; p.N = td.N; p.Npad = td.Npad; p.perm = td.perm;
        p.n0 = (rem % td.tiles_n) * 64; p.k0 = (rem / td.tiles_n) * 128;
        return p;
    };
    auto pload = [&](const PTile& p, f32x4 (&L0)[4], f32x4 (&L1)[4]) {
        const int c4 = tid & 15, kr = tid >> 4;
        const bool nok = p.n0 + 4 * c4 < p.N;
#pragma unroll
        for (int i = 0; i < 4; ++i) {
            const int k = p.k0 + 32 * i + 2 * kr;
            L0[i] = (f32x4){0.f, 0.f, 0.f, 0.f}; L1[i] = L0[i];
            if (nok && k < p.K) {
                L0[i] = *(const f32x4*)(p.src + (size_t)k * p.N + p.n0 + 4 * c4);
                L1[i] = *(const f32x4*)(p.src + (size_t)(k + 1) * p.N + p.n0 + 4 * c4);
                if (p.rscale) { L0[i] *= p.rscale[k]; L1[i] *= p.rscale[k + 1]; }
            }
        }
    };
    auto pflush = [&](const PTile& p, const unsigned* st) {
#pragma unroll
        for (int i = 0; i < 4; ++i) {
            const int id = tid + i * 256, n = id >> 4, kc = id & 15;
            const u32x4 o = *(const u32x4*)(st + n * 68 + kc * 4);
            int nd = p.n0 + n;
            if (nd < p.Npad && p.k0 + kc * 8 < p.K) {
                if (p.perm) { const int c = nd & 255, up = nd >> 8; nd = ((c >> 4) << 5) + (up << 4) + (c & 15); }
                *(u32x4*)(p.dst + (size_t)nd * p.K + p.k0 + kc * 8) = o;
            }
        }
    };
    {
        unsigned* st0 = (unsigned*)lds; unsigned* st1 = st0 + 64 * 68;
        const int nt_ = a.ntiles_total, G = gridDim.x;
        int t0 = blockIdx.x, t1 = blockIdx.x + G;
        PTile p0 = decode(0), p1 = p0;
        f32x4 A0[4], A1[4], B0[4], B1[4];
        __syncthreads();
        if (t0 < nt_) { p0 = decode(t0); pload(p0, A0, A1); }
        if (t1 < nt_) { p1 = decode(t1); pload(p1, B0, B1); }
        while (t0 < nt_) {
            PTile q0 = p0, q1 = p1;
            const bool v1 = t1 < nt_;
            cv_pack(st0, A0, A1);
            if (t0 + 2 * G < nt_) { p0 = decode(t0 + 2 * G); pload(p0, A0, A1); }
            if (v1) {
                cv_pack(st1, B0, B1);
                if (t1 + 2 * G < nt_) { p1 = decode(t1 + 2 * G); pload(p1, B0, B1); }
            }
            __syncthreads();
            pflush(q0, st0);
            if (v1) pflush(q1, st1);
            __syncthreads();
            t0 += 2 * G; t1 += 2 * G;
        }
    }
}

template <int MODE>
DI void phase_token(const Args& a, const int li) {
    const int tid = threadIdx.x, lane = tid & 63, wave = tid >> 6;
    const int r = lane & 15, q = lane >> 4;
    float* X = (float*)(a.ws + WS_X);
    bf16_t* H = (bf16_t*)(a.ws + WS_H);
    const bf16_t* Y = (const bf16_t*)(a.ws + WS_Y);
    const float* MOD = (const float*)(a.ws + WS_MOD);
    const bool combine = (MODE == 0 && li > 0) || MODE == 2;
    const int ngroups = (MODE == 2 || (MODE == 1 && li == 3)) ? NLAT / 16 : NTOK / 16;
    float* lg = (float*)(lds + wave * 16 * 80 * 4);
    for (int g = blockIdx.x * 4 + wave; g < ngroups; g += gridDim.x * 4) {
        const int t = g * 16 + r;
        const int mr = tok_modrow(g * 16);
        const float* xsrc = (MODE == 0 && li == 0) ? (t < NLAT ? a.in[0] + (size_t)t * D : a.in[2] + (size_t)(t - NLAT) * D) : X + (size_t)t * D;
        const bf16_t* y0 = Y + (size_t)(2 * t) * D;
        const bf16_t* y1 = y0 + D;
        const int lprev = MODE == 2 ? 3 : li - 1;
        const float* g5 = MOD + ((size_t)(lprev < 0 ? 0 : lprev) * 9 + mr) * 6144 + 5 * 1024;
        float ss = 0.f;
        if (MODE != 2) {
#pragma unroll 4
            for (int kk = 0; kk < 32; ++kk) {
                const int k = kk * 32 + q * 8;
                f32x4 x0 = *(const f32x4*)(xsrc + k), x1 = *(const f32x4*)(xsrc + k + 4);
                if (combine) {
                    const u32x4 ya = *(const u32x4*)(y0 + k), yb = *(const u32x4*)(y1 + k);
                    const f32x4 ga = *(const f32x4*)(g5 + k), gb = *(const f32x4*)(g5 + k + 4);
                    x0[0] += ga[0] * (lof(ya[0]) + lof(yb[0])); x0[1] += ga[1] * (hif(ya[0]) + hif(yb[0]));
                    x0[2] += ga[2] * (lof(ya[1]) + lof(yb[1])); x0[3] += ga[3] * (hif(ya[1]) + hif(yb[1]));
                    x1[0] += gb[0] * (lof(ya[2]) + lof(yb[2])); x1[1] += gb[1] * (hif(ya[2]) + hif(yb[2]));
                    x1[2] += gb[2] * (lof(ya[3]) + lof(yb[3])); x1[3] += gb[3] * (hif(ya[3]) + hif(yb[3]));
                }
#pragma unroll
                for (int j = 0; j < 4; ++j) ss += x0[j] * x0[j] + x1[j] * x1[j];
            }
            ss += __shfl_xor(ss, 16); ss += __shfl_xor(ss, 32);
        }
        const float rstd = rsqrtf(ss * (1.f / 1024.f) + EPS);
        const float* gn = (MODE == 1 ? a.in[7] : a.in[6]) + (size_t)li * D;
        const float* mscale = MOD + ((size_t)li * 9 + mr) * 6144 + (MODE == 1 ? 4 : 1) * 1024;
        const float* mshift = MOD + ((size_t)li * 9 + mr) * 6144 + (MODE == 1 ? 3 : 0) * 1024;
        const bf16_t* rwh = (const bf16_t*)(a.ws + W_RT) + (size_t)li * 2 * 80 * 1024 + (size_t)r * 1024 + q * 8;
        f32x4 lacc[5];
#pragma unroll
        for (int i = 0; i < 5; ++i) lacc[i] = (f32x4){0.f, 0.f, 0.f, 0.f};
#pragma unroll 2
        for (int kk = 0; kk < 32; ++kk) {
            const int k = kk * 32 + q * 8;
            f32x4 x0 = *(const f32x4*)(xsrc + k), x1 = *(const f32x4*)(xsrc + k + 4);
            if (combine) {
                const u32x4 ya = *(const u32x4*)(y0 + k), yb = *(const u32x4*)(y1 + k);
                const f32x4 ga = *(const f32x4*)(g5 + k), gb = *(const f32x4*)(g5 + k + 4);
                x0[0] += ga[0] * (lof(ya[0]) + lof(yb[0])); x0[1] += ga[1] * (hif(ya[0]) + hif(yb[0]));
                x0[2] += ga[2] * (lof(ya[1]) + lof(yb[1])); x0[3] += ga[3] * (hif(ya[1]) + hif(yb[1]));
                x1[0] += gb[0] * (lof(ya[2]) + lof(yb[2])); x1[1] += gb[1] * (hif(ya[2]) + hif(yb[2]));
                x1[2] += gb[2] * (lof(ya[3]) + lof(yb[3])); x1[3] += gb[3] * (hif(ya[3]) + hif(yb[3]));
            }
            if (MODE == 2) {
                *(f32x4*)(a.out + (size_t)t * D + k) = x0; *(f32x4*)(a.out + (size_t)t * D + k + 4) = x1;
                continue;
            }
            if (MODE == 0 && (li == 0 || combine)) { *(f32x4*)(X + (size_t)t * D + k) = x0; *(f32x4*)(X + (size_t)t * D + k + 4) = x1; }
            const f32x4 n0 = *(const f32x4*)(gn + k), n1 = *(const f32x4*)(gn + k + 4);
            const f32x4 s0 = *(const f32x4*)(mscale + k), s1 = *(const f32x4*)(mscale + k + 4);
            const f32x4 h0 = *(const f32x4*)(mshift + k), h1 = *(const f32x4*)(mshift + k + 4);
            float f[8];
#pragma unroll
            for (int j = 0; j < 4; ++j) {
                f[j] = x0[j] * rstd * n0[j] * (1.f + s0[j]) + h0[j];
                f[4 + j] = x1[j] * rstd * n1[j] * (1.f + s1[j]) + h1[j];
            }
            u32x4 hv;
            hv[0] = pk2(f[0], f[1]); hv[1] = pk2(f[2], f[3]); hv[2] = pk2(f[4], f[5]); hv[3] = pk2(f[6], f[7]);
            *(u32x4*)(H + (size_t)t * D + k) = hv;
            if (MODE == 1) {
                u32x4 lv;
                lv[0] = pk2(f[0] - lof(hv[0]), f[1] - hif(hv[0])); lv[1] = pk2(f[2] - lof(hv[1]), f[3] - hif(hv[1]));
                lv[2] = pk2(f[4] - lof(hv[2]), f[5] - hif(hv[2])); lv[3] = pk2(f[6] - lof(hv[3]), f[7] - hif(hv[3]));
                const bf16x8 fh = __builtin_bit_cast(bf16x8, hv), fl = __builtin_bit_cast(bf16x8, lv);
#pragma unroll
                for (int nt = 0; nt < 5; ++nt) {
                    const bf16x8 wh = *(const bf16x8*)(rwh + (size_t)nt * 16 * 1024 + kk * 32);
                    const bf16x8 wl = *(const bf16x8*)(rwh + (size_t)(80 + nt * 16) * 1024 + kk * 32);
                    lacc[nt] = mfma16(fh, wh, lacc[nt]);
                    lacc[nt] = mfma16(fh, wl, lacc[nt]);
                    lacc[nt] = mfma16(fl, wh, lacc[nt]);
                }
            }
        }
        if (MODE == 1) {
#pragma unroll
            for (int nt = 0; nt < 5; ++nt)
#pragma unroll
                for (int j = 0; j < 4; ++j) lg[(q * 4 + j) * 80 + nt * 16 + r] = lacc[nt][j];
            asm volatile("s_waitcnt lgkmcnt(0)" ::: "memory");
            __builtin_amdgcn_wave_barrier();
            if (lane < 16) {
                const float* L = lg + lane * 80;
                const float* bg = a.in[27] + li * 8;
                const float* be = a.in[29] + li * 64;
                float gmax = -3.0e38f; int gi = 0; float gl[8];
#pragma unroll
                for (int j = 0; j < 8; ++j) { gl[j] = L[j] + bg[j]; if (gl[j] > gmax) { gmax = gl[j]; gi = j; } }
                float ps = 0.f;
#pragma unroll
                for (int j = 0; j < 8; ++j) ps += __expf(gl[j] - gmax);
                const float ptop = 1.f / ps;
                float e1 = -3.0e38f, e2 = -3.0e38f; int i1 = 0, i2 = 0;
#pragma unroll
                for (int j = 0; j < 8; ++j) {
                    const float v = L[8 + gi * 8 + j] + be[gi * 8 + j];
                    if (v > e1) { e2 = e1; i2 = i1; e1 = v; i1 = j; } else if (v > e2) { e2 = v; i2 = j; }
                }
                const float ex = __expf(e2 - e1);
                const float w1 = ptop / (1.f + ex), w2 = ptop * ex / (1.f + ex);
                const int tt = g * 16 + lane;
                int* cnt = (int*)(a.ws + WS_CTL + CTL_CNT) + li * 64;
                int* list = (int*)(a.ws + WS_LIST);
                float* wsl = (float*)(a.ws + WS_WSLOT);
                const int ea = gi * 8 + i1, eb = gi * 8 + i2;
                const int pa = atomicAdd(&cnt[ea], 1); list[(size_t)ea * NTOK + pa] = 2 * tt; wsl[2 * tt] = w1;
                const int pb = atomicAdd(&cnt[eb], 1); list[(size_t)eb * NTOK + pb] = 2 * tt + 1; wsl[2 * tt + 1] = w2;
            }
            __builtin_amdgcn_wave_barrier();
        }
    }
}

DI float wave_sum(float v) {
    v += __shfl_xor(v, 1); v += __shfl_xor(v, 2); v += __shfl_xor(v, 4); v += __shfl_xor(v, 8); v += __shfl_xor(v, 16); v += __shfl_xor(v, 32);
    return v;
}
template <int MODE>
DI void phase_token_row(const Args& a, const int li) {
    const int tid = threadIdx.x, lane = tid & 63, wave = tid >> 6;
    float* X = (float*)(a.ws + WS_X);
    bf16_t* H = (bf16_t*)(a.ws + WS_H);
    const bf16_t* Y = (const bf16_t*)(a.ws + WS_Y);
    const float* MOD = (const float*)(a.ws + WS_MOD);
    const bool combine = MODE == 2 || li > 0;
    const bool first = MODE == 0 && li == 0;
    const int npairs = (MODE == 2 ? NLAT : NTOK) / 2;
    const int lprev = MODE == 2 ? 3 : (li > 0 ? li - 1 : 0);
    const float* gn = a.in[6] + (size_t)li * D;
    for (int p = blockIdx.x * 4 + wave; p < npairs; p += gridDim.x * 4) {
        const int t0 = 2 * p, mr = tok_modrow(t0);
        f32x4 x[2][4];
#pragma unroll
        for (int i = 0; i < 2; ++i) {
            const int t = t0 + i;
            const float* xs = first ? (t < NLAT ? a.in[0] + (size_t)t * D : a.in[2] + (size_t)(t - NLAT) * D) : X + (size_t)t * D;
#pragma unroll
            for (int j = 0; j < 4; ++j) x[i][j] = *(const f32x4*)(xs + 256 * j + 4 * lane);
        }
        if (combine) {
            const float* g5 = MOD + ((size_t)lprev * 9 + mr) * 6144 + 5 * 1024;
            f32x4 g[4];
#pragma unroll
            for (int j = 0; j < 4; ++j) g[j] = *(const f32x4*)(g5 + 256 * j + 4 * lane);
#pragma unroll
            for (int i = 0; i < 2; ++i) {
                const bf16_t* y0 = Y + (size_t)(2 * (t0 + i)) * D;
#pragma unroll
                for (int j = 0; j < 4; ++j) {
                    const u32x2 ya = *(const u32x2*)(y0 + 256 * j + 4 * lane), yb = *(const u32x2*)(y0 + D + 256 * j + 4 * lane);
                    x[i][j][0] += g[j][0] * (lof(ya[0]) + lof(yb[0])); x[i][j][1] += g[j][1] * (hif(ya[0]) + hif(yb[0]));
                    x[i][j][2] += g[j][2] * (lof(ya[1]) + lof(yb[1])); x[i][j][3] += g[j][3] * (hif(ya[1]) + hif(yb[1]));
                }
            }
        }
        if (MODE == 2) {
#pragma unroll
            for (int i = 0; i < 2; ++i)
#pragma unroll
                for (int j = 0; j < 4; ++j) *(f32x4*)(a.out + (size_t)(t0 + i) * D + 256 * j + 4 * lane) = x[i][j];
            continue;
        }
        float rstd[2];
#pragma unroll
        for (int i = 0; i < 2; ++i) {
            float ss = 0.f;
#pragma unroll
            for (int j = 0; j < 4; ++j) ss += x[i][j][0] * x[i][j][0] + x[i][j][1] * x[i][j][1] + x[i][j][2] * x[i][j][2] + x[i][j][3] * x[i][j][3];
            rstd[i] = rsqrtf(wave_sum(ss) * (1.f / 1024.f) + EPS);
        }
        const float* msc = MOD + ((size_t)li * 9 + mr) * 6144 + 1 * 1024;
        const float* msh = MOD + ((size_t)li * 9 + mr) * 6144;
#pragma unroll
        for (int j = 0; j < 4; ++j) {
            const f32x4 n4 = *(const f32x4*)(gn + 256 * j + 4 * lane), s4 = *(const f32x4*)(msc + 256 * j + 4 * lane), h4 = *(const f32x4*)(msh + 256 * j + 4 * lane);
            const f32x4 gs = n4 * (s4 + 1.f);
#pragma unroll
            for (int i = 0; i < 2; ++i) {
                const f32x4 f = x[i][j] * rstd[i] * gs + h4;
                st_bf4(H + (size_t)(t0 + i) * D + 256 * j + 4 * lane, f);
                if (combine) *(f32x4*)(X + (size_t)(t0 + i) * D + 256 * j + 4 * lane) = x[i][j];
            }
        }
    }
}

DI void phase_token_router(const Args& a, const int li) {
    const int tid = threadIdx.x, lane = tid & 63, wave = tid >> 6;
    const int r = lane & 15, q = lane >> 4;
    const float* X = (const float*)(a.ws + WS_X);
    bf16_t* H = (bf16_t*)(a.ws + WS_H);
    const float* MOD = (const float*)(a.ws + WS_MOD);
    const float* gn = a.in[7] + (size_t)li * D;
    const int ngroups = (li == 3 ? NLAT : NTOK) / 16;
    char* sHi = lds; char* sLo = lds + 32768;
    float* sP = (float*)lds;
    float* sL = (float*)(lds + 32768);
    const bf16_t* rwh = (const bf16_t*)(a.ws + W_RT) + (size_t)li * 2 * 80 * 1024 + (size_t)r * 1024 + q * 8;
    for (int g = blockIdx.x; g < ngroups; g += gridDim.x) {
        const int mr = tok_modrow(g * 16);
        const float* msc = MOD + ((size_t)li * 9 + mr) * 6144 + 4 * 1024;
        const float* msh = MOD + ((size_t)li * 9 + mr) * 6144 + 3 * 1024;
        __syncthreads();
        {
            f32x4 x[4][4];
#pragma unroll
            for (int i = 0; i < 4; ++i)
#pragma unroll
                for (int j = 0; j < 4; ++j) x[i][j] = *(const f32x4*)(X + (size_t)(g * 16 + wave * 4 + i) * D + 256 * j + 4 * lane);
            float rstd[4];
#pragma unroll
            for (int i = 0; i < 4; ++i) {
                float ss = 0.f;
#pragma unroll
                for (int j = 0; j < 4; ++j) ss += x[i][j][0] * x[i][j][0] + x[i][j][1] * x[i][j][1] + x[i][j][2] * x[i][j][2] + x[i][j][3] * x[i][j][3];
                rstd[i] = rsqrtf(wave_sum(ss) * (1.f / 1024.f) + EPS);
            }
#pragma unroll
            for (int j = 0; j < 4; ++j) {
                const f32x4 n4 = *(const f32x4*)(gn + 256 * j + 4 * lane), s4 = *(const f32x4*)(msc + 256 * j + 4 * lane), h4 = *(const f32x4*)(msh + 256 * j + 4 * lane);
                const f32x4 gs = n4 * (s4 + 1.f);
#pragma unroll
                for (int i = 0; i < 4; ++i) {
                    const int row = wave * 4 + i;
                    const f32x4 f = x[i][j] * rstd[i] * gs + h4;
                    u32x2 hv; hv[0] = pk2(f[0], f[1]); hv[1] = pk2(f[2], f[3]);
                    u32x2 lv; lv[0] = pk2(f[0] - lof(hv[0]), f[1] - hif(hv[0])); lv[1] = pk2(f[2] - lof(hv[1]), f[3] - hif(hv[1]));
                    *(u32x2*)(H + (size_t)(g * 16 + row) * D + 256 * j + 4 * lane) = hv;
                    const int off = row * 2048 + (((32 * j + (lane >> 1)) ^ row) << 4) + (lane & 1) * 8;
                    *(u32x2*)(sHi + off) = hv; *(u32x2*)(sLo + off) = lv;
                }
            }
        }
        __syncthreads();
        f32x4 lacc[5];
#pragma unroll
        for (int i = 0; i < 5; ++i) lacc[i] = (f32x4){0.f, 0.f, 0.f, 0.f};
#pragma unroll 2
        for (int s = 0; s < 8; ++s) {
            const int kk = wave * 8 + s;
            const int off = r * 2048 + (((kk * 4 + q) ^ r) << 4);
            const bf16x8 fh = ldsv8(sHi + off), fl = ldsv8(sLo + off);
#pragma unroll
            for (int nt = 0; nt < 5; ++nt) {
                const bf16x8 wh = *(const bf16x8*)(rwh + (size_t)nt * 16 * 1024 + kk * 32);
                const bf16x8 wl = *(const bf16x8*)(rwh + (size_t)(80 + nt * 16) * 1024 + kk * 32);
                lacc[nt] = mfma16(fh, wh, lacc[nt]);
                lacc[nt] = mfma16(fh, wl, lacc[nt]);
                lacc[nt] = mfma16(fl, wh, lacc[nt]);
            }
        }
        __syncthreads();
#pragma unroll
        for (int nt = 0; nt < 5; ++nt)
#pragma unroll
            for (int j = 0; j < 4; ++j) sP[(wave * 16 + q * 4 + j) * 80 + nt * 16 + r] = lacc[nt][j];
        __syncthreads();
        for (int i = tid; i < 16 * 80; i += NTHR) sL[i] = sP[i] + sP[1280 + i] + sP[2560 + i] + sP[3840 + i];
        __syncthreads();
        if (tid < 16) {
            const float* L = sL + tid * 80;
            const float* bg = a.in[27] + li * 8;
            const float* be = a.in[29] + li * 64;
            float gmax = -3.0e38f; int gi = 0; float gl[8];
#pragma unroll
            for (int j = 0; j < 8; ++j) { gl[j] = L[j] + bg[j]; if (gl[j] > gmax) { gmax = gl[j]; gi = j; } }
            float ps = 0.f;
#pragma unroll
            for (int j = 0; j < 8; ++j) ps += __expf(gl[j] - gmax);
            const float ptop = 1.f / ps;
            float e1 = -3.0e38f, e2 = -3.0e38f; int i1 = 0, i2 = 0;
#pragma unroll
            for (int j = 0; j < 8; ++j) {
                const float v = L[8 + gi * 8 + j] + be[gi * 8 + j];
                if (v > e1) { e2 = e1; i2 = i1; e1 = v; i1 = j; } else if (v > e2) { e2 = v; i2 = j; }
            }
            const float ex = __expf(e2 - e1);
            const float w1 = ptop / (1.f + ex), w2 = ptop * ex / (1.f + ex);
            const int tt = g * 16 + tid;
            int* cnt = (int*)(a.ws + WS_CTL + CTL_CNT) + li * 64;
            int* list = (int*)(a.ws + WS_LIST);
            float* wsl = (float*)(a.ws + WS_WSLOT);
            const int ea = gi * 8 + i1, eb = gi * 8 + i2;
            const int pa = atomicAdd(&cnt[ea], 1); list[(size_t)ea * NTOK + pa] = 2 * tt; wsl[2 * tt] = w1;
            const int pb = atomicAdd(&cnt[eb], 1); list[(size_t)eb * NTOK + pb] = 2 * tt + 1; wsl[2 * tt + 1] = w2;
        }
    }
}

template <int WM, int WN, int MT, int NT, bool PFALL = true, class AP>
DI void gemm_tile(AP arow, const bf16_t* Bt, const int ldb, const int K, f32x4 (&acc)[MT][NT], float* ssq = nullptr) {
    constexpr int BM = WM * MT * 16, BN = WN * NT * 16;
    constexpr int A_BYTES = BM * 128, B_BYTES = BN * 128, STAGE = A_BYTES + B_BYTES;
    constexpr int ACH = BM * 8 / NTHR, BCH = BN * 8 / NTHR;
    static_assert(2 * STAGE <= LDS_AUX, "gemm LDS");
    const int tid = threadIdx.x, lane = tid & 63, wave = tid >> 6;
    const int wm = wave / WN, wn = wave % WN;
    const int fr = lane & 15, fq = lane >> 4;
    const bf16_t* ap[ACH]; const bf16_t* bp[BCH];
#pragma unroll
    for (int i = 0; i < ACH; ++i) { const int idx = tid + i * NTHR, row = idx >> 3, c = (idx & 7) ^ (row & 7); ap[i] = arow(row) + c * 8; }
#pragma unroll
    for (int i = 0; i < BCH; ++i) { const int idx = tid + i * NTHR, row = idx >> 3, c = (idx & 7) ^ (row & 7); bp[i] = Bt + (size_t)row * ldb + c * 8; }
#pragma unroll
    for (int i = 0; i < MT; ++i)
#pragma unroll
        for (int j = 0; j < NT; ++j) acc[i][j] = (f32x4){0.f, 0.f, 0.f, 0.f};
    const int KT = K >> 6;
    {
        char* sa = lds; char* sb = lds + A_BYTES;
#pragma unroll
        for (int i = 0; i < ACH; ++i) dma16(ap[i], sa + (tid + i * NTHR) * 16);
#pragma unroll
        for (int i = 0; i < BCH; ++i) dma16(bp[i], sb + (tid + i * NTHR) * 16);
    }
#pragma unroll 1
    for (int kt = 0; kt < KT; ++kt) {
        wait_vm0();
        __syncthreads();
        if (kt + 1 < KT) {
            char* sa = lds + ((kt + 1) & 1) * STAGE; char* sb = sa + A_BYTES;
            const int ko = (kt + 1) * 64;
#pragma unroll
            for (int i = 0; i < ACH; ++i) dma16(ap[i] + ko, sa + (tid + i * NTHR) * 16);
#pragma unroll
            for (int i = 0; i < BCH; ++i) dma16(bp[i] + ko, sb + (tid + i * NTHR) * 16);
        }
        const char* sa = lds + (kt & 1) * STAGE; const char* sb = sa + A_BYTES;
        if (PFALL) {
            bf16x8 xf[2][MT], wf[2][NT];
#pragma unroll
            for (int kk = 0; kk < 2; ++kk) {
#pragma unroll
                for (int i = 0; i < MT; ++i) xf[kk][i] = ldsv8(sa + swz128(wm * MT * 16 + i * 16 + fr, kk * 4 + fq));
#pragma unroll
                for (int j = 0; j < NT; ++j) wf[kk][j] = ldsv8(sb + swz128(wn * NT * 16 + j * 16 + fr, kk * 4 + fq));
            }
            __builtin_amdgcn_sched_barrier(0);
            __builtin_amdgcn_s_setprio(1);
#pragma unroll
            for (int kk = 0; kk < 2; ++kk)
#pragma unroll
                for (int i = 0; i < MT; ++i)
#pragma unroll
                    for (int j = 0; j < NT; ++j) acc[i][j] = mfma16(wf[kk][j], xf[kk][i], acc[i][j]);
            __builtin_amdgcn_s_setprio(0);
        } else {
#pragma unroll
            for (int kk = 0; kk < 2; ++kk) {
                bf16x8 xf[MT], wf[NT];
#pragma unroll
                for (int i = 0; i < MT; ++i) xf[i] = ldsv8(sa + swz128(wm * MT * 16 + i * 16 + fr, kk * 4 + fq));
#pragma unroll
                for (int j = 0; j < NT; ++j) wf[j] = ldsv8(sb + swz128(wn * NT * 16 + j * 16 + fr, kk * 4 + fq));
#pragma unroll
                for (int i = 0; i < MT; ++i)
#pragma unroll
                    for (int j = 0; j < NT; ++j) acc[i][j] = mfma16(wf[j], xf[i], acc[i][j]);
                if (ssq) {
#pragma unroll
                    for (int i = 0; i < MT; ++i) {
                        const u32x4 xu = __builtin_bit_cast(u32x4, xf[i]);
#pragma unroll
                        for (int d = 0; d < 4; ++d) { const bfx2 p = __builtin_bit_cast(bfx2, xu[d]); ssq[i] = __builtin_amdgcn_fdot2_f32_bf16(p, p, ssq[i], false); }
                    }
                }
            }
        }
    }
    __syncthreads();
}


struct GemmPipe {
    static constexpr int A_BYTES = 128 * 128, STAGE = 2 * A_BYTES;
    const bf16_t* ap[4]; const bf16_t* bp[4];
    template <class AP>
    DI void setup(AP arow, const bf16_t* Bt, const int ldb) {
        const int tid = threadIdx.x;
#pragma unroll
        for (int i = 0; i < 4; ++i) {
            const int idx = tid + i * NTHR, row = idx >> 3, c = (idx & 7) ^ (row & 7);
            ap[i] = arow(row) + c * 8; bp[i] = Bt + (size_t)row * ldb + c * 8;
        }
    }
    DI void issue(const int kt, const int buf) const {
        const int tid = threadIdx.x;
        char* sa = lds + buf * STAGE; char* sb = sa + A_BYTES;
        const int ko = kt * 64;
#pragma unroll
        for (int i = 0; i < 4; ++i) dma16(ap[i] + ko, sa + (tid + i * NTHR) * 16);
#pragma unroll
        for (int i = 0; i < 4; ++i) dma16(bp[i] + ko, sb + (tid + i * NTHR) * 16);
    }
    template <int PM>
    DI void run_probe(const int K, f32x4 (&acc)[4][4]) const {
        const int tid = threadIdx.x, lane = tid & 63, wave = tid >> 6;
        const int wm = wave >> 1, wn = wave & 1, fr = lane & 15, fq = lane >> 4;
#pragma unroll
        for (int i = 0; i < 4; ++i)
#pragma unroll
            for (int j = 0; j < 4; ++j) acc[i][j] = (f32x4){0.f, 0.f, 0.f, 0.f};
        const int KT = K >> 6;
#pragma unroll 1
        for (int kt = 0; kt < KT; ++kt) {
            if (PM & 4) { wait_vm0(); __syncthreads(); }
            if ((PM & 1) && kt + 1 < KT) issue(kt + 1, (kt + 1) & 1);
            if (PM & 2) {
                const char* sa = lds + (kt & 1) * STAGE; const char* sb = sa + A_BYTES;
                bf16x8 xf[2][4], wf[2][4];
#pragma unroll
                for (int kk = 0; kk < 2; ++kk) {
#pragma unroll
                    for (int i = 0; i < 4; ++i) xf[kk][i] = ldsv8(sa + swz128(wm * 64 + i * 16 + fr, kk * 4 + fq));
#pragma unroll
                    for (int j = 0; j < 4; ++j) wf[kk][j] = ldsv8(sb + swz128(wn * 64 + j * 16 + fr, kk * 4 + fq));
                }
                __builtin_amdgcn_sched_barrier(0);
                __builtin_amdgcn_s_setprio(1);
#pragma unroll
                for (int kk = 0; kk < 2; ++kk)
#pragma unroll
                    for (int i = 0; i < 4; ++i)
#pragma unroll
                        for (int j = 0; j < 4; ++j) acc[i][j] = mfma16(wf[kk][j], xf[kk][i], acc[i][j]);
                __builtin_amdgcn_s_setprio(0);
            }
        }
        wait_vm0();
    }
    DI void run(const int K, f32x4 (&acc)[4][4]) const {
        const int tid = threadIdx.x, lane = tid & 63, wave = tid >> 6;
        const int wm = wave >> 1, wn = wave & 1, fr = lane & 15, fq = lane >> 4;
#pragma unroll
        for (int i = 0; i < 4; ++i)
#pragma unroll
            for (int j = 0; j < 4; ++j) acc[i][j] = (f32x4){0.f, 0.f, 0.f, 0.f};
        const int KT = K >> 6;
#pragma unroll 1
        for (int kt = 0; kt < KT; ++kt) {
            wait_vm0();
            __syncthreads();
            if (kt + 1 < KT) issue(kt + 1, (kt + 1) & 1);
            const char* sa = lds + (kt & 1) * STAGE; const char* sb = sa + A_BYTES;
            bf16x8 xf[2][4], wf[2][4];
#pragma unroll
            for (int kk = 0; kk < 2; ++kk) {
#pragma unroll
                for (int i = 0; i < 4; ++i) xf[kk][i] = ldsv8(sa + swz128(wm * 64 + i * 16 + fr, kk * 4 + fq));
#pragma unroll
                for (int j = 0; j < 4; ++j) wf[kk][j] = ldsv8(sb + swz128(wn * 64 + j * 16 + fr, kk * 4 + fq));
            }
            __builtin_amdgcn_sched_barrier(0);
            __builtin_amdgcn_s_setprio(1);
#pragma unroll
            for (int kk = 0; kk < 2; ++kk)
#pragma unroll
                for (int i = 0; i < 4; ++i)
#pragma unroll
                    for (int j = 0; j < 4; ++j) acc[i][j] = mfma16(wf[kk][j], xf[kk][i], acc[i][j]);
            __builtin_amdgcn_s_setprio(0);
        }
    }
};

constexpr int EPI_OFF = 32768;
DI int lane_m(int i) { const int t = threadIdx.x; return ((t >> 7) & 1) * 64 + i * 16 + (t & 15); }
DI int lane_n(int j) { const int t = threadIdx.x; return ((t >> 6) & 1) * 64 + j * 16 + ((t >> 4) & 3) * 4; }
DI int opaque_tid() { int t = threadIdx.x; asm volatile("" : "+v"(t)); return t; }
DI int lane_m(int t, int i) { return ((t >> 7) & 1) * 64 + i * 16 + (t & 15); }
DI int lane_n(int t, int j) { return ((t >> 6) & 1) * 64 + j * 16 + ((t >> 4) & 3) * 4; }
template <class XF>
DI void epi_stage_bf16(const f32x4 (&acc)[4][4], XF xf) {
    const int tz = opaque_tid();
#pragma unroll
    for (int i = 0; i < 4; ++i) {
        const int m = lane_m(tz, i);
#pragma unroll
        for (int j = 0; j < 4; ++j) {
            const int n = lane_n(tz, j);
            const f32x4 v = xf(i, j, acc[i][j]);
            u32x2 o; o[0] = pk2(v[0], v[1]); o[1] = pk2(v[2], v[3]);
            *(u32x2*)(lds + EPI_OFF + m * 256 + (((n >> 3) ^ (m & 15)) << 4) + (n & 4) * 2) = o;
        }
    }
}
template <class DP, class OK>
DI void epi_flush_bf16(DP dst, OK ok) {
    const int tz = opaque_tid();
#pragma unroll
    for (int it = 0; it < 8; ++it) {
        const int idx = tz + it * NTHR, row = idx >> 4, ch = idx & 15;
        const u32x4 v = *(const u32x4*)(lds + EPI_OFF + row * 256 + ((ch ^ (row & 15)) << 4));
        if (ok(row)) *(u32x4*)(dst(row) + ch * 8) = v;
    }
}
template <class XF>
DI void epi_stage_bf16_T(const f32x4 (&acc)[4][4], XF xf) {
    const int tz = opaque_tid();
    const bool odd = tz & 1;
#pragma unroll
    for (int i = 0; i < 4; ++i) {
        const int m = lane_m(tz, i) & ~1;
#pragma unroll
        for (int j = 0; j < 4; ++j) {
            const int n = lane_n(tz, j) + (odd ? 2 : 0);
            const f32x4 v = xf(i, j, acc[i][j]);
            const float r0 = __shfl_xor(odd ? v[0] : v[2], 1), r1 = __shfl_xor(odd ? v[1] : v[3], 1);
            const unsigned w0 = odd ? pk2(r0, v[2]) : pk2(v[0], r0), w1 = odd ? pk2(r1, v[3]) : pk2(v[1], r1);
            *(unsigned*)(lds + EPI_OFF + n * 256 + (((m >> 3) ^ (n & 15)) << 4) + (m & 6) * 2) = w0;
            *(unsigned*)(lds + EPI_OFF + (n + 1) * 256 + (((m >> 3) ^ ((n + 1) & 15)) << 4) + (m & 6) * 2) = w1;
        }
    }
}
DI void epi_resid_f32(const Args& a, const int li, const int m0, const int n0, const f32x4 (&acc)[4][4]) {
    const int tz = opaque_tid();
    float* X = (float*)(a.ws + WS_X);
    const float* gate = (const float*)(a.ws + WS_MOD) + ((size_t)li * 9 + tok_modrow(m0)) * 6144 + 2 * 1024 + n0;
#pragma unroll
    for (int j = 0; j < 4; ++j) {
        const int n = lane_n(tz, j);
        const f32x4 g = *(const f32x4*)(gate + n);
#pragma unroll
        for (int i = 0; i < 4; ++i) {
            const int t = m0 + lane_m(tz, i);
            float* xp = X + (size_t)t * D + n0 + n;
            const float* xs = li == 0 ? (t < NLAT ? a.in[0] + (size_t)t * D : a.in[2] + (size_t)(t - NLAT) * D) + n0 + n : xp;
            f32x4 x = *(const f32x4*)xs;
            x += g * acc[i][j];
            *(f32x4*)xp = x;
        }
    }
}

template <bool XPF = true, class TE>
DI void gemm_dense_phase(const bf16_t* A, const int lda, const int mrows, const bf16_t* Bt, const int N, const int K, TE tile_epi) {
    const int mt = mrows / 128, nt = N / 128;
    const int mpx = mt >> 3, bmb = mpx >> 1, full = mpx * 8;
    auto decode = [&](int u, int& m0, int& n0) {
        const int xc = u & 7, s = u >> 3;
        const int bn = s / full, rem = s - bn * full;
        const int w = min(8, nt - 8 * bn);
        const int bm = rem / (bmb * w), rem2 = rem - bm * (bmb * w);
        const int ni = rem2 / bmb, mi = rem2 - ni * bmb;
        m0 = (xc * mpx + bm * bmb + mi) * 128; n0 = (bn * 8 + ni) * 128;
    };
    GemmPipe g;
    int u = blockIdx.x, m0 = 0, n0 = 0;
    __syncthreads();
    if (u < mt * nt) { decode(u, m0, n0); g.setup([&](int r) { return A + (size_t)(m0 + r) * lda; }, Bt + (size_t)n0 * K, K); g.issue(0, 0); }
    while (u < mt * nt) {
        f32x4 acc[4][4];
        g.run(K, acc);
        const int cm0 = m0, cn0 = n0;
        u += gridDim.x;
        if (XPF) {
            if (u < mt * nt) { decode(u, m0, n0); g.setup([&](int r) { return A + (size_t)(m0 + r) * lda; }, Bt + (size_t)n0 * K, K); g.issue(0, 0); }
            tile_epi(cm0, cn0, acc);
        } else {
            tile_epi(cm0, cn0, acc);
            __syncthreads();
            if (u < mt * nt) { decode(u, m0, n0); g.setup([&](int r) { return A + (size_t)(m0 + r) * lda; }, Bt + (size_t)n0 * K, K); g.issue(0, 0); }
        }
    }
    __syncthreads();
}
template <class XF, class DP>
DI void epi_bf16_rowmajor(const f32x4 (&acc)[4][4], XF xf, DP dst) {
    __syncthreads();
    epi_stage_bf16(acc, xf);
    __syncthreads();
    epi_flush_bf16(dst, [](int) { return true; });
}

DI void phase_rg_in(const Args& a, int j) {
    bf16_t* G = (bf16_t*)(a.ws + RG_G); bf16_t* U = (bf16_t*)(a.ws + RG_U);
    gemm_dense_phase((const bf16_t*)(a.ws + WS_H), D, NTOK, (const bf16_t*)(a.ws + W_RGIN) + (size_t)j * 2048 * 1024, 2048, 1024,
        [&](int m0, int n0, const f32x4 (&acc)[4][4]) {
            if (n0 < 1024)
                epi_bf16_rowmajor(acc, [](int, int, const f32x4 v) { f32x4 g; g[0] = gelu_tanh(v[0]); g[1] = gelu_tanh(v[1]); g[2] = gelu_tanh(v[2]); g[3] = gelu_tanh(v[3]); return g; },
                                  [&](int row) { return G + (size_t)(m0 + row) * D + n0; });
            else
                epi_bf16_rowmajor(acc, [](int, int, const f32x4 v) { return v; }, [&](int row) { return U + (size_t)(m0 + row) * D + (n0 - 1024); });
        });
}

template <int VAR = 0, int HOST = 0>
DI void phase_rg_scan(const Args& a, int j) {
    const int tid = threadIdx.x, lane = tid & 63, wave = tid >> 6;
    const int fr = lane & 15, fq = lane >> 4;
    const bf16_t* U = (const bf16_t*)(a.ws + RG_U);
    bf16_t* HS = (bf16_t*)(a.ws + (VAR ? WS_Y : RG_HS));
    char* sW = lds;
    char* sX = lds + 8192;
    float* sUc = (float*)(lds + 16384);
    float* sA = (float*)(lds + 24576);
    float* sB = (float*)(lds + 33280);
    bf16_t* sO = (bf16_t*)(lds + 41984);
    unsigned* sCv = (unsigned*)(lds + 50176);
    const int c = tid & 7;
    for (int u = blockIdx.x; u < 512; u += gridDim.x) {
        const int half = u & 1, dir = (u >> 1) & 1, blk = (u >> 2) & 15, b = u >> 6;
        const int cin0 = blk * 64, co0 = blk * 64 + half * 32;
        __syncthreads();
        {
            const bf16_t* Wg = (const bf16_t*)(a.ws + W_RGG) + ((size_t)((j * 2 + dir) * 16 + blk)) * 128 * 64;
#pragma unroll
            for (int i = 0; i < 2; ++i) {
                const int idx = tid + i * NTHR, row = idx >> 3, cc = idx & 7;
                const int srow = (row >> 5) * 64 + half * 32 + (row & 31);
                *(u32x4*)(sW + swz128(row, cc)) = *(const u32x4*)(Wg + (size_t)srow * 64 + cc * 8);
            }
        }
        float carry = 0.f;
        float cw[4][8], cb[8];
        {
            const float* cwp = a.in[9] + (size_t)j * 4 * 1024 + cin0 + c * 8; const float* cbp = a.in[10] + (size_t)j * 1024 + cin0 + c * 8;
#pragma unroll
            for (int w = 0; w < 4; ++w) { const f32x4 v0 = *(const f32x4*)(cwp + w * 1024), v1 = *(const f32x4*)(cwp + w * 1024 + 4);
#pragma unroll
                for (int e = 0; e < 4; ++e) { cw[w][e] = v0[e]; cw[w][4 + e] = v1[e]; } }
            const f32x4 v0 = *(const f32x4*)cbp, v1 = *(const f32x4*)(cbp + 4);
#pragma unroll
            for (int e = 0; e < 4; ++e) { cb[e] = v0[e]; cb[4 + e] = v1[e]; }
        }
        float bg0[8], bg1[8], spl[8];
        {
            const float* gb = a.in[12] + ((size_t)(j * 2 + dir) * 2) * 1024 + co0;
            const float* lm = a.in[13] + (size_t)(j * 2 + dir) * 1024 + co0;
#pragma unroll
            for (int jt = 0; jt < 2; ++jt)
#pragma unroll
                for (int e = 0; e < 4; ++e) {
                    const int cc = jt * 16 + fq * 4 + e;
                    bg0[jt * 4 + e] = gb[cc]; bg1[jt * 4 + e] = gb[1024 + cc];
                    spl[jt * 4 + e] = -8.f * log1pf(__expf(-lm[cc]));
                }
        }
        u32x4 pu[2][4];
        auto load_chunk = [&](int ci) {
            const int seg = ci >= 4, L = seg ? SEQ : CTXL, nch = L / 64, jc = seg ? ci - 4 : ci;
            const int oc = dir ? nch - 1 - jc : jc;
            const int rb = seg ? b * SEQ : NLAT + b * CTXL;
            const int s0 = oc * 64;
#pragma unroll
            for (int it = 0; it < 2; ++it) {
                const int tk = (tid >> 3) + it * 32;
#pragma unroll
                for (int w = 0; w < 4; ++w) {
                    const int s = s0 + tk + w - 2;
                    const int sc_ = min(max(s, 0), L - 1);
                    const u32x4 ld = *(const u32x4*)(U + (size_t)(rb + sc_) * D + cin0 + c * 8);
                    const unsigned msk = (s >= 0 && s < L) ? 0xffffffffu : 0u;
                    pu[it][w] = (u32x4){ld[0] & msk, ld[1] & msk, ld[2] & msk, ld[3] & msk};
                }
            }
        };
        load_chunk(0);
        __syncthreads();
        size_t prev_base = 0;
        constexpr int CV_TILES = HOST ? 6144 : 0;
        CvTile cvp; cvp.src = nullptr; cvp.dst = nullptr; cvp.K = 0; cvp.N = 0; cvp.perm = 0; cvp.k0 = 0; cvp.n0 = 0;
        bool cvp_ok = false;
#pragma unroll 1
        for (int ci = 0; ci < 36; ++ci) {
            f32x4 cv0[4], cv1[4];
            CvTile cvc = cvp;
            const int cvq = (ci / 3) * 512 + u;
            const bool cv_ok = HOST && (ci % 3 == 0) && cvq < CV_TILES;
            if (cv_ok) { cvc = moe_cv_tile(a, 1, cvq); cv_load(cvc, cv0, cv1); }
            const int seg = ci >= 4, L = seg ? SEQ : CTXL, nch = L / 64, jc = seg ? ci - 4 : ci;
            const int oc = dir ? nch - 1 - jc : jc;
            const int rb = seg ? b * SEQ : NLAT + b * CTXL;
            const int s0 = oc * 64;
            char* sXc = sX; float* sUcc = sUc;
#pragma unroll
            for (int it = 0; it < 2; ++it) {
                const int tk = (tid >> 3) + it * 32;
                float o[8];
#pragma unroll
                for (int e = 0; e < 8; ++e) o[e] = cb[e];
#pragma unroll
                for (int w = 0; w < 4; ++w) {
                    const u32x4 r4 = pu[it][w];
#pragma unroll
                    for (int e = 0; e < 4; ++e) { o[2 * e] += cw[w][2 * e] * lof(r4[e]); o[2 * e + 1] += cw[w][2 * e + 1] * hif(r4[e]); }
                }
                u32x4 pv; pv[0] = pk2(o[0], o[1]); pv[1] = pk2(o[2], o[3]); pv[2] = pk2(o[4], o[5]); pv[3] = pk2(o[6], o[7]);
                *(u32x4*)(sXc + swz128(tk, c)) = pv;
                if ((c >> 2) == half) {
                    *(f32x4*)(sUcc + tk * 32 + (c & 3) * 8) = (f32x4){o[0], o[1], o[2], o[3]};
                    *(f32x4*)(sUcc + tk * 32 + (c & 3) * 8 + 4) = (f32x4){o[4], o[5], o[6], o[7]};
                }
            }
            if (ci + 1 < 36) load_chunk(ci + 1);
            lds_barrier();
            if (HOST && cvp_ok) cv_flush(cvp, sCv);
            if (ci > 0) {
                const u32x4 v = *(const u32x4*)(sO + ((ci - 1) & 1) * 2048 + tid * 8);
                *(u32x4*)(HS + prev_base + (size_t)(tid >> 2) * D + (tid & 3) * 8) = v;
            }
            {
                f32x4 acc[4];
#pragma unroll
                for (int jt = 0; jt < 4; ++jt) acc[jt] = (f32x4){0.f, 0.f, 0.f, 0.f};
#pragma unroll
                for (int kk = 0; kk < 2; ++kk) {
                    const bf16x8 xf = ldsv8(sXc + swz128(wave * 16 + fr, kk * 4 + fq));
#pragma unroll
                    for (int jt = 0; jt < 4; ++jt) acc[jt] = mfma16(ldsv8(sW + swz128(jt * 16 + fr, kk * 4 + fq)), xf, acc[jt]);
                }
                const int tk = wave * 16 + fr;
#pragma unroll
                for (int jt = 0; jt < 2; ++jt) {
                    const f32x4 uc = *(const f32x4*)(sUcc + tk * 32 + jt * 16 + fq * 4);
                    f32x4 av4, bv4;
#pragma unroll
                    for (int e = 0; e < 4; ++e) {
                        if (VAR & 2) { av4[e] = 0.5f + 0.001f * acc[jt][e]; bv4[e] = uc[e] + acc[jt + 2][e]; continue; }
                        const float rg = sigmoidf_(acc[jt][e] + bg0[jt * 4 + e]);
                        const float ig = sigmoidf_(acc[jt + 2][e] + bg1[jt * 4 + e]);
                        const float av = fexp(rg * spl[jt * 4 + e]);
                        av4[e] = av;
                        bv4[e] = __builtin_amdgcn_sqrtf(fmaxf(1.f - av * av, 0.f)) * ig * uc[e];
                    }
#pragma unroll
                    for (int e = 0; e < 4; ++e) { sA[(jt * 16 + fq * 4 + e) * 68 + tk] = av4[e]; sB[(jt * 16 + fq * 4 + e) * 68 + tk] = bv4[e]; }
                }
            }
            lds_barrier();
            if (!(VAR & 4)) {
                const int ch = wave * 8 + (lane & 7), sg = lane >> 3;
                const int tb = dir ? 56 - sg * 8 : sg * 8;
                const f32x4 a0 = *(const f32x4*)(sA + ch * 68 + tb), a1 = *(const f32x4*)(sA + ch * 68 + tb + 4);
                const f32x4 b0 = *(const f32x4*)(sB + ch * 68 + tb), b1 = *(const f32x4*)(sB + ch * 68 + tb + 4);
                float av[8], bv[8];
#pragma unroll
                for (int e = 0; e < 4; ++e) {
                    av[e] = dir ? a1[3 - e] : a0[e]; av[4 + e] = dir ? a0[3 - e] : a1[e];
                    bv[e] = dir ? b1[3 - e] : b0[e]; bv[4 + e] = dir ? b0[3 - e] : b1[e];
                }
                float Ap = 1.f, Hh = 0.f;
#pragma unroll
                for (int e = 0; e < 8; ++e) { Hh = av[e] * Hh + bv[e]; Ap *= av[e]; }
#pragma unroll
                for (int d = 8; d < 64; d <<= 1) {
                    const float Ao = __shfl_up(Ap, d), Ho = __shfl_up(Hh, d);
                    if (lane >= d) { Hh = Ap * Ho + Hh; Ap = Ap * Ao; }
                }
                float Aex = __shfl_up(Ap, 8), Hex = __shfl_up(Hh, 8);
                if (sg == 0) { Aex = 1.f; Hex = 0.f; }
                float hin = Aex * carry + Hex;
                const float cnew = Ap * carry + Hh;
                carry = __shfl(cnew, 56 + (lane & 7));
                bf16_t* so = sO + (ci & 1) * 2048 + ch;
#pragma unroll
                for (int e = 0; e < 8; ++e) {
                    hin = av[e] * hin + bv[e];
                    const int i = sg * 8 + e, tk = dir ? 63 - i : i;
                    so[tk * 32] = f2bf(hin);
                }
            }
            prev_base = (size_t)dir * NTOK * D + (size_t)(rb + s0) * D + co0;
            if (HOST) { if (cv_ok) cv_pack(sCv, cv0, cv1); cvp = cvc; cvp_ok = cv_ok; }
        }
        __syncthreads();
        if (HOST && cvp_ok) cv_flush(cvp, sCv);
        {
            const u32x4 v = *(const u32x4*)(sO + (35 & 1) * 2048 + tid * 8);
            *(u32x4*)(HS + prev_base + (size_t)(tid >> 2) * D + (tid & 3) * 8) = v;
        }
    }
}

DI void phase_rg_combine(const Args& a) {
    const u32x4* G = (const u32x4*)(a.ws + RG_G);
    const u32x4* H0 = (const u32x4*)(a.ws + RG_HS);
    const u32x4* H1 = (const u32x4*)(a.ws + RG_HS + TOKD2);
    u32x4* A2 = (u32x4*)(a.ws + RG_A2);
    const size_t n = (size_t)NTOK * D / 8;
    for (size_t i = (size_t)blockIdx.x * NTHR + threadIdx.x; i < n; i += (size_t)gridDim.x * NTHR) {
        const u32x4 g = G[i], h0 = H0[i], h1 = H1[i];
        u32x4 o;
#pragma unroll
        for (int e = 0; e < 4; ++e) o[e] = pk2(lof(g[e]) * (lof(h0[e]) + lof(h1[e])), hif(g[e]) * (hif(h0[e]) + hif(h1[e])));
        A2[i] = o;
    }
}

DI void phase_rg_out(const Args& a, int li, int j) {
    gemm_dense_phase((const bf16_t*)(a.ws + RG_A2), D, li == 3 ? NLAT : NTOK, (const bf16_t*)(a.ws + W_RGOUT) + (size_t)j * 1024 * 1024, 1024, 1024,
        [&](int m0, int n0, const f32x4 (&acc)[4][4]) { epi_resid_f32(a, li, m0, n0, acc); });
}

DI void phase_mla_down(const Args& a) {
    bf16_t* CQ = (bf16_t*)(a.ws + MLA_CQ); bf16_t* CKV = (bf16_t*)(a.ws + MLA_CKV); float* KR = (float*)(a.ws + MLA_KR);
    gemm_dense_phase((const bf16_t*)(a.ws + WS_H), D, NTOK, (const bf16_t*)(a.ws + W_MDOWN), 512, 1024,
        [&](int m0, int n0, const f32x4 (&acc)[4][4]) {
            if (n0 < 256) epi_bf16_rowmajor(acc, [](int, int, const f32x4 v) { return v; }, [&](int row) { return CQ + (size_t)(m0 + row) * 256 + n0; });
            else if (n0 == 256) epi_bf16_rowmajor(acc, [](int, int, const f32x4 v) { return v; }, [&](int row) { return CKV + (size_t)(m0 + row) * 128; });
            else {
#pragma unroll
                for (int i = 0; i < 4; ++i)
#pragma unroll
                    for (int j = 0; j < 2; ++j) { const int n = lane_n(j); if (n < 32) *(f32x4*)(KR + (size_t)(m0 + lane_m(i)) * 32 + n) = acc[i][j]; }
            }
        });
}

DI int perm_key(int kp) { return (kp & ~12) | ((kp & 4) << 1) | ((kp & 8) >> 1); }

DI void phase_mla_up(const Args& a) {
    const int tid = threadIdx.x;
    const bf16_t* CQ = (const bf16_t*)(a.ws + MLA_CQ); const bf16_t* CKV = (const bf16_t*)(a.ws + MLA_CKV); const float* KR = (const float*)(a.ws + MLA_KR);
    bf16_t* Q = (bf16_t*)(a.ws + MLA_Q); bf16_t* Kb = (bf16_t*)(a.ws + MLA_K); bf16_t* VT = (bf16_t*)(a.ws + MLA_VT);
    const float* qkn = a.in[20];
    const float* RC = (const float*)(a.ws + WS_CTL + CTL_ROPE); const float* RS = RC + 512;
    const int MT_ = NTOK / 128;
    const int nq = MT_ * 16, nkv = MT_ * 16;
    const float QSCALE = 0.10206207261596575f * 1.4426950408889634f;
    for (int u = blockIdx.x; u < nq + nkv; u += gridDim.x) {
        const bool isq = u < nq;
        const int uu = isq ? u : u - nq;
        const int xc_ = uu & 7, s_ = uu >> 3;
        const int m0 = (((s_ >> 4) << 3) + xc_) * 128, head = s_ & 15;
        const bool islat = m0 < NLAT;
        const int bb = islat ? (m0 >> 11) : ((m0 - NLAT) >> 8);
        const int kp0 = islat ? CTXL + (m0 & (SEQ - 1)) : ((m0 - NLAT) & (CTXL - 1));
        __syncthreads();
        if (isq) {
            f32x4 hold[2][6];
            float ssq[2] = {0.f, 0.f};
            gemm_tile<4, 1, 2, 6, false>([&](int r) { return CQ + (size_t)(m0 + r) * 256; }, (const bf16_t*)(a.ws + W_MUQ) + (size_t)head * 96 * 256, 256, 256, hold, ssq);
            const int tz = opaque_tid();
            const int wave = tz >> 6, fq = (tz >> 4) & 3, fr = tz & 15;
#pragma unroll
            for (int i = 0; i < 2; ++i) {
                const int m = wave * 32 + i * 16 + fr;
                float sq = ssq[i]; sq += __shfl_xor(sq, 16); sq += __shfl_xor(sq, 32);
                const float rs0 = rsqrtf(sq * (1.f / 256.f) + EPS);
                float ss = 0.f;
#pragma unroll
                for (int jn = 0; jn < 6; ++jn) { hold[i][jn] *= rs0;
#pragma unroll
                    for (int e = 0; e < 4; ++e) ss += hold[i][jn][e] * hold[i][jn][e]; }
                ss += __shfl_xor(ss, 16); ss += __shfl_xor(ss, 32);
                const float rs = rsqrtf(ss * (1.f / 96.f) + EPS) ;
                f32x4 o[6];
#pragma unroll
                for (int jn = 0; jn < 6; ++jn) { const f32x4 g4 = *(const f32x4*)(qkn + jn * 16 + fq * 4); o[jn] = hold[i][jn] * rs * g4; }
#pragma unroll
                for (int jn = 4; jn < 6; ++jn) {
                    f32x4 other;
#pragma unroll
                    for (int e = 0; e < 4; ++e) other[e] = __shfl_xor(o[jn][e], 32);
                    if (islat) {
                        const int s = (m0 + m) & (SEQ - 1);
                        const int pos = jn == 4 ? (s >> 6) : (s & 63);
                        const f32x4 cs = *(const f32x4*)(RC + pos * 8 + (fq & 1) * 4), sn = *(const f32x4*)(RS + pos * 8 + (fq & 1) * 4);
#pragma unroll
                        for (int e = 0; e < 4; ++e) o[jn][e] = (fq < 2) ? o[jn][e] * cs[e] - other[e] * sn[e] : o[jn][e] * cs[e] + other[e] * sn[e];
                    }
                }
#pragma unroll
                for (int jn = 0; jn < 6; ++jn) {
                    const f32x4 v = o[jn] * QSCALE;
                    u32x2 pv; pv[0] = pk2(v[0], v[1]); pv[1] = pk2(v[2], v[3]);
                    *(u32x2*)(lds + m * 256 + (((jn * 2 + (fq >> 1)) ^ (m & 15)) << 4) + (fq & 1) * 8) = pv;
                }
            }
            __syncthreads();
#pragma unroll
            for (int it = 0; it < 8; ++it) {
                const int idx = tz + it * NTHR, row = idx >> 4, ch = idx & 15;
                if (ch < 12) {
                    const u32x4 v = *(const u32x4*)(lds + row * 256 + ((ch ^ (row & 15)) << 4));
                    *(u32x4*)(Q + (size_t)(m0 + row) * 1536 + head * 96 + ch * 8) = v;
                }
            }
        } else {
            f32x4 hold[4][4];
            float ssq[4] = {0.f, 0.f, 0.f, 0.f};
            gemm_tile<2, 2, 4, 4, false>([&](int r) { return CKV + (size_t)(m0 + r) * 128; }, (const bf16_t*)(a.ws + W_MUKV) + (size_t)head * 128 * 128, 128, 128, hold, ssq);
            const int tz = opaque_tid();
            const int wave = tz >> 6, wm = wave >> 1, wn = wave & 1, fq = (tz >> 4) & 3, fr = tz & 15;
            char* sK = lds; char* sV = lds + 32768;
#pragma unroll
            for (int i = 0; i < 4; ++i) {
                const int m = wm * 64 + i * 16 + fr, t = m0 + m;
                float sq = ssq[i]; sq += __shfl_xor(sq, 16); sq += __shfl_xor(sq, 32);
                const float rs0 = rsqrtf(sq * (1.f / 128.f) + EPS);
#pragma unroll
                for (int jn = 0; jn < 4; ++jn) hold[i][jn] *= rs0;
                if (wn == 0) {
                    const int base = (fq >> 1) * 16 + (fq & 1) * 4;
                    const f32x4 z1 = *(const f32x4*)(KR + (size_t)t * 32 + base);
                    const f32x4 z2 = *(const f32x4*)(KR + (size_t)t * 32 + base + 8);
                    float ss = 0.f;
#pragma unroll
                    for (int jn = 0; jn < 4; ++jn)
#pragma unroll
                        for (int e = 0; e < 4; ++e) ss += hold[i][jn][e] * hold[i][jn][e];
#pragma unroll
                    for (int e = 0; e < 4; ++e) ss += z1[e] * z1[e] + z2[e] * z2[e];
                    ss += __shfl_xor(ss, 16); ss += __shfl_xor(ss, 32);
                    const float rs = rsqrtf(ss * (1.f / 96.f) + EPS);
#pragma unroll
                    for (int jn = 0; jn < 4; ++jn) {
                        const f32x4 g4 = *(const f32x4*)(qkn + 96 + jn * 16 + fq * 4);
                        const f32x4 v = hold[i][jn] * rs * g4;
                        u32x2 pv; pv[0] = pk2(v[0], v[1]); pv[1] = pk2(v[2], v[3]);
                        *(u32x2*)(sK + m * 256 + (((jn * 2 + (fq >> 1)) ^ (m & 15)) << 4) + (fq & 1) * 8) = pv;
                    }
                    const f32x4 g1 = *(const f32x4*)(qkn + 96 + 64 + base), g2 = *(const f32x4*)(qkn + 96 + 64 + base + 8);
                    f32x4 a1 = z1 * rs * g1, a2 = z2 * rs * g2;
                    if (islat) {
                        const int s = t & (SEQ - 1);
                        const int pos = (fq >> 1) == 0 ? (s >> 6) : (s & 63);
                        const f32x4 cs = *(const f32x4*)(RC + pos * 8 + (fq & 1) * 4), sn = *(const f32x4*)(RS + pos * 8 + (fq & 1) * 4);
                        const f32x4 b1 = a1 * cs - a2 * sn, b2 = a2 * cs + a1 * sn;
                        a1 = b1; a2 = b2;
                    }
                    u32x2 p1, p2; p1[0] = pk2(a1[0], a1[1]); p1[1] = pk2(a1[2], a1[3]); p2[0] = pk2(a2[0], a2[1]); p2[1] = pk2(a2[2], a2[3]);
                    const int c1 = 8 + (fq >> 1) * 2;
                    *(u32x2*)(sK + m * 256 + ((c1 ^ (m & 15)) << 4) + (fq & 1) * 8) = p1;
                    *(u32x2*)(sK + m * 256 + (((c1 + 1) ^ (m & 15)) << 4) + (fq & 1) * 8) = p2;
                }
                {
                    const bool odd = fr & 1;
                    const int mp = perm_key(m & ~1);
#pragma unroll
                    for (int jn = 0; jn < 4; ++jn) {
                        const f32x4 v = hold[i][jn];
                        const float r0 = __shfl_xor(odd ? v[0] : v[2], 1), r1 = __shfl_xor(odd ? v[1] : v[3], 1);
                        if (wn == 1) {
                            const int e0 = jn * 16 + fq * 4 + (odd ? 2 : 0);
                            const unsigned w0 = odd ? pk2(r0, v[2]) : pk2(v[0], r0), w1 = odd ? pk2(r1, v[3]) : pk2(v[1], r1);
                            *(unsigned*)(sV + e0 * 256 + (((mp >> 3) ^ (e0 & 15)) << 4) + (mp & 6) * 2) = w0;
                            *(unsigned*)(sV + (e0 + 1) * 256 + (((mp >> 3) ^ ((e0 + 1) & 15)) << 4) + (mp & 6) * 2) = w1;
                        }
                    }
                }
            }
            __syncthreads();
            bf16_t* kdst = Kb + ((size_t)(bb * 16 + head) * NKEY + kp0) * 96;
#pragma unroll
            for (int it = 0; it < 8; ++it) {
                const int idx = tz + it * NTHR, row = idx >> 4, ch = idx & 15;
                if (ch < 12) {
                    const u32x4 v = *(const u32x4*)(sK + row * 256 + ((ch ^ (row & 15)) << 4));
                    *(u32x4*)(kdst + (size_t)row * 96 + ch * 8) = v;
                }
            }
            bf16_t* vdst = VT + ((size_t)(bb * 16 + head) * 64) * NKEY + kp0;
#pragma unroll
            for (int it = 0; it < 4; ++it) {
                const int idx = tz + it * NTHR, row = idx >> 4, ch = idx & 15;
                const u32x4 v = *(const u32x4*)(sV + row * 256 + ((ch ^ (row & 15)) << 4));
                *(u32x4*)(vdst + (size_t)row * NKEY + ch * 8) = v;
            }
        }
    }
}

DI void phase_mla_attn(const Args& a) {
    const int tid = threadIdx.x, lane = tid & 63, wave = tid >> 6;
    const int r = lane & 31, h = lane >> 5;
    const bf16_t* Q = (const bf16_t*)(a.ws + MLA_Q); const bf16_t* Kb = (const bf16_t*)(a.ws + MLA_K); const bf16_t* VT = (const bf16_t*)(a.ws + MLA_VT);
    bf16_t* O = (bf16_t*)(a.ws + MLA_O);
    constexpr int KT_B = 64 * 256, VT_B = 64 * 128, ST_B = KT_B + VT_B;
    unsigned* sCv = (unsigned*)(lds + 49152);
    const int cv_per = 18432 / gridDim.x;
    int cvn = 0, itc = 0;
    bool cv_pack_p = false, cv_flush_p = false;
    CvTile cvB, cvC; cvB.src = nullptr; cvB.dst = nullptr; cvB.K = 0; cvB.N = 0; cvB.perm = 0; cvB.k0 = 0; cvB.n0 = 0; cvC = cvB;
    f32x4 cv0[4], cv1[4];
#pragma unroll
    for (int i = 0; i < 4; ++i) { cv0[i] = (f32x4){0.f, 0.f, 0.f, 0.f}; cv1[i] = cv0[i]; }
    auto cv_step = [&](bool may_load) {
        if (cv_flush_p) { cv_flush(cvC, sCv); cv_flush_p = false; }
        if (cv_pack_p) { cv_pack(sCv, cv0, cv1); cvC = cvB; cv_flush_p = true; cv_pack_p = false; }
        if (may_load && cvn < cv_per) {
            const int t = cvn * gridDim.x + blockIdx.x;
            cvB = moe_cv_tile(a, 1 + t / 6144, t % 6144); cv_load(cvB, cv0, cv1); cv_pack_p = true; ++cvn;
        }
    };
    for (int u = blockIdx.x; u < 2048 + 256; u += gridDim.x) {
        const bool isctx = u >= 2048;
        const int uu = isctx ? u - 2048 : u;
        const int xc_ = uu & 7, s_ = uu >> 3, bh_ = ((s_ >> 4) << 3) + xc_;
        const int qb = isctx ? (uu & 1) : (s_ & 15), head = isctx ? ((uu >> 1) & 15) : (bh_ & 15), b = isctx ? (uu >> 5) : (bh_ >> 4);
        const int ntile = isctx ? CTXL / 64 : NKEY / 64;
        const int t = (isctx ? NLAT + b * CTXL : b * SEQ) + qb * 128 + wave * 32 + r;
        const bf16_t* kbase = Kb + (size_t)(b * 16 + head) * NKEY * 96;
        const bf16_t* vbase = VT + (size_t)(b * 16 + head) * 64 * NKEY;
        bf16x8 qf[6];
#pragma unroll
        for (int kk = 0; kk < 6; ++kk) qf[kk] = *(const bf16x8*)(Q + (size_t)t * 1536 + head * 96 + kk * 16 + h * 8);
        f32x16 o[2];
#pragma unroll
        for (int e = 0; e < 16; ++e) { o[0][e] = 0.f; o[1][e] = 0.f; }
        float lsum = 0.f;
        __syncthreads();
        auto stage = [&](int kt, int buf) {
            char* sk = lds + buf * ST_B; char* sv = sk + KT_B;
            const int key0 = kt * 64;
#pragma unroll
            for (int i = 0; i < 4; ++i) {
                const int idx = tid + i * NTHR, row = idx >> 4; int c = (idx & 15) ^ (row & 15); if (c >= 12) c = 0;
                dma16(kbase + (size_t)(key0 + row) * 96 + c * 8, sk + idx * 16);
            }
#pragma unroll
            for (int i = 0; i < 2; ++i) {
                const int idx = tid + i * NTHR, row = idx >> 3, c = (idx & 7) ^ ((row >> 1) & 7);
                dma16(vbase + (size_t)row * NKEY + key0 + c * 8, sv + idx * 16);
            }
        };
        stage(0, 0);
#pragma unroll 1
        for (int kt = 0; kt < ntile; ++kt) {
            wait_vm0();
            __syncthreads();
            if (kt + 1 < ntile) stage(kt + 1, (kt + 1) & 1);
            cv_step((itc & 3) == 0); ++itc;
            const char* sk = lds + (kt & 1) * ST_B; const char* sv = sk + KT_B;
            f32x16 st[2];
#pragma unroll
            for (int e = 0; e < 16; ++e) { st[0][e] = -8.f; st[1][e] = -8.f; }
#pragma unroll
            for (int kk = 0; kk < 6; ++kk)
#pragma unroll
                for (int si = 0; si < 2; ++si) {
                    const int s = si * 32 + r;
                    st[si] = mfma32(ldsv8(sk + swz256(s, kk * 2 + h)), qf[kk], st[si]);
                }
            float ps = 0.f;
#pragma unroll
            for (int si = 0; si < 2; ++si)
#pragma unroll
                for (int e = 0; e < 16; ++e) { const float p = __builtin_amdgcn_exp2f(st[si][e]); st[si][e] = p; ps += p; }
            lsum += ps;
#pragma unroll
            for (int si = 0; si < 2; ++si)
#pragma unroll
                for (int ks = 0; ks < 2; ++ks) {
                    u32x4 pp;
                    pp[0] = pk2(st[si][8 * ks + 0], st[si][8 * ks + 1]); pp[1] = pk2(st[si][8 * ks + 2], st[si][8 * ks + 3]);
                    pp[2] = pk2(st[si][8 * ks + 4], st[si][8 * ks + 5]); pp[3] = pk2(st[si][8 * ks + 6], st[si][8 * ks + 7]);
                    const bf16x8 pf = __builtin_bit_cast(bf16x8, pp);
#pragma unroll
                    for (int et = 0; et < 2; ++et) {
                        const int e = et * 32 + r;
                        o[et] = mfma32(ldsv8(sv + e * 128 + (((si * 4 + ks * 2 + h) ^ ((e >> 1) & 7)) << 4)), pf, o[et]);
                    }
                }
        }
        lsum += __shfl_xor(lsum, 32);
        const float inv = 1.f / lsum;
#pragma unroll
        for (int et = 0; et < 2; ++et)
#pragma unroll
            for (int g = 0; g < 4; ++g) {
                f32x4 v; v[0] = o[et][4 * g] * inv; v[1] = o[et][4 * g + 1] * inv; v[2] = o[et][4 * g + 2] * inv; v[3] = o[et][4 * g + 3] * inv;
                st_bf4(O + (size_t)t * D + head * 64 + et * 32 + 8 * g + 4 * h, v);
            }
    }
    while (cvn < cv_per || cv_pack_p || cv_flush_p) { __syncthreads(); cv_step(!cv_pack_p && !cv_flush_p); }
}

DI void phase_mla_out(const Args& a, int li) {
    gemm_dense_phase((const bf16_t*)(a.ws + MLA_O), D, NTOK, (const bf16_t*)(a.ws + W_MO), 1024, 1024,
        [&](int m0, int n0, const f32x4 (&acc)[4][4]) { epi_resid_f32(a, li, m0, n0, acc); });
}

DI void phase_ml_in(const Args& a) {
    bf16_t* Qm = (bf16_t*)(a.ws + ML_Q); bf16_t* Km = (bf16_t*)(a.ws + ML_K); bf16_t* KT = (bf16_t*)(a.ws + ML_KT); bf16_t* VT = (bf16_t*)(a.ws + ML_VT);
    bf16_t* OG = (bf16_t*)(a.ws + ML_OG); float* GT = (float*)(a.ws + ML_GT);
    const float* gb = a.in[23];
    auto ident = [](int, int, const f32x4 v) { return v; };
    gemm_dense_phase<false>((const bf16_t*)(a.ws + WS_H), D, NTOK, (const bf16_t*)(a.ws + W_MLIN), 3200, 1024,
        [&](int m0, int n0, const f32x4 (&acc)[4][4]) {
            if (n0 < 512) {
                epi_bf16_rowmajor(acc, [](int, int, const f32x4 v) { return v * 0.08838834764831845f; }, [&](int row) { return Qm + (size_t)(m0 + row) * 512 + n0; });
            } else if (n0 < 1024) {
                epi_bf16_rowmajor(acc, ident, [&](int row) { return Km + (size_t)(m0 + row) * 512 + (n0 - 512); });
                __syncthreads();
                epi_stage_bf16_T(acc, ident);
                __syncthreads();
                epi_flush_bf16([&](int row) { return KT + (size_t)(n0 - 512 + row) * NTOK + m0; }, [](int) { return true; });
            } else if (n0 < 2048) {
                __syncthreads();
                epi_stage_bf16_T(acc, ident);
                __syncthreads();
                epi_flush_bf16([&](int row) { return VT + (size_t)(n0 - 1024 + row) * NTOK + m0; }, [](int) { return true; });
            } else if (n0 < 3072) {
                epi_bf16_rowmajor(acc, [](int, int, const f32x4 v) { f32x4 s; s[0] = sigmoidf_(v[0]); s[1] = sigmoidf_(v[1]); s[2] = sigmoidf_(v[2]); s[3] = sigmoidf_(v[3]); return s; },
                                  [&](int row) { return OG + (size_t)(m0 + row) * D + (n0 - 2048); });
            } else {
#pragma unroll
                for (int i = 0; i < 4; ++i) {
                    const int n = lane_n(0);
                    if (n < 16) { f32x4 s = acc[i][0]; s[0] += gb[n]; s[1] += gb[n + 1]; s[2] += gb[n + 2]; s[3] += gb[n + 3]; *(f32x4*)(GT + (size_t)(m0 + lane_m(i)) * 16 + n) = s; }
                }
            }
        });
}

template <int VAR = 0>
DI void phase_ml_scan(const Args& a) {
    const int tid = threadIdx.x, lane = tid & 63, wave = tid >> 6;
    const int fr = lane & 15, fq = lane >> 4;
    const bf16_t* Qm = (const bf16_t*)(a.ws + ML_Q); const bf16_t* Km = (const bf16_t*)(a.ws + ML_K);
    const bf16_t* KT = (const bf16_t*)(a.ws + ML_KT); const bf16_t* VT = (const bf16_t*)(a.ws + ML_VT);
    const float* GT = (const float*)(a.ws + ML_GT);
    bf16_t* HS = (bf16_t*)(a.ws + (VAR ? WS_Y : ML_HS));
    char* sQ = lds;
    char* sK = lds + 16384;
    char* sS = sK;
    char* sKT = lds + 32768;
    char* sVT = lds + 49152;
    char* sCT = lds + 55296;
    float* sRow = (float*)(lds + 67584);
    float* sCol = sRow + 64;
    float* sInt = sCol + 64;
    float* sNrm = sInt + 64;
    float* sWv = sNrm + 64;
    float* sSc = sWv + 64;
    for (int u = blockIdx.x; u < 512; u += gridDim.x) {
        const int xc_ = u & 7, s_ = u >> 3, bh_ = ((s_ >> 4) << 3) + xc_;
        const int sl = s_ & 7, dir = (s_ >> 3) & 1, head = bh_ & 3, b = bh_ >> 2;
        auto chunk_t0 = [&](int ci) {
            const int seg = ci >= 4, L = seg ? SEQ : CTXL, nch = L / 64, jc = seg ? ci - 4 : ci;
            const int oc = dir ? nch - 1 - jc : jc;
            return (seg ? b * SEQ : NLAT + b * CTXL) + oc * 64;
        };
        u32x4 pq[4], pk[4], pkt[4], pvt;
        float g_bc = 0.f, g_av = 0.f, g_pm = 0.f;
        auto load_tiles = [&](int t0) {
            const int tid = opaque_tid();
#pragma unroll
            for (int i = 0; i < 4; ++i) {
                const int idx = tid + i * NTHR, row = idx >> 4, c = (idx & 15) ^ (row & 15);
                pq[i] = *(const u32x4*)(Qm + (size_t)(t0 + row) * 512 + head * 128 + c * 8);
                pk[i] = *(const u32x4*)(Km + (size_t)(t0 + row) * 512 + head * 128 + c * 8);
            }
#pragma unroll
            for (int i = 0; i < 4; ++i) {
                const int idx = tid + i * NTHR, row = idx >> 3, c = (idx & 7) ^ (row & 7);
                pkt[i] = *(const u32x4*)(KT + (size_t)(head * 128 + row) * NTOK + t0 + c * 8);
            }
            { const int row = tid >> 3, c = (tid & 7) ^ (row & 7); pvt = *(const u32x4*)(VT + (size_t)(head * 256 + sl * 32 + row) * NTOK + t0 + c * 8); }
        };
        auto load_gates = [&](int ci) {
            if (wave == 0) { const float* g = (const float*)(a.ws + WS_GS) + ((size_t)u * 36 + ci) * 192 + lane; g_bc = g[0]; g_av = g[64]; g_pm = g[128]; }
        };
        auto store_tiles = [&]() {
            const int tid = opaque_tid();
#pragma unroll
            for (int i = 0; i < 4; ++i) { *(u32x4*)(sQ + (tid + i * NTHR) * 16) = pq[i]; *(u32x4*)(sK + (tid + i * NTHR) * 16) = pk[i]; *(u32x4*)(sKT + (tid + i * NTHR) * 16) = pkt[i]; }
            *(u32x4*)(sVT + tid * 16) = pvt;
        };
        auto gate_scalars = [&]() {
            const int s = dir ? 63 - lane : lane;
            const float bc = g_bc, av = g_av, pm = g_pm;
            const float mst = sSc[1];
            const float mm = fmaxf(mst, pm);
            sRow[s] = -mm;
            sCol[s] = av;
            sInt[s] = fexp(mst - mm);
            sNrm[s] = fexp(-(bc + mm));
            const float mmL = __shfl(mm, 63), bL = __shfl(bc, 63);
            sWv[s] = fexp(av - mmL);
            if (lane == 0) { sSc[0] = fexp(mst - mmL); sSc[1] = bL + mmL; }
        };
#pragma unroll 1
        for (int ci = wave; ci < 36; ci += 4) {
            const int t0 = chunk_t0(ci);
            const int s = dir ? 63 - lane : lane;
            const float ig = GT[(size_t)(t0 + s) * 16 + dir * 8 + head];
            const float fg = GT[(size_t)(t0 + s) * 16 + dir * 8 + 4 + head];
            const float lf = fminf(fg, 0.f) - __logf(1.f + fexp(-fabsf(fg)));
            float bc = lf;
#pragma unroll
            for (int d = 1; d < 64; d <<= 1) { const float o = __shfl_up(bc, d); if (lane >= d) bc += o; }
            const float av = ig - bc;
            float pm = av;
#pragma unroll
            for (int d = 1; d < 64; d <<= 1) { const float o = __shfl_up(pm, d); if (lane >= d) pm = fmaxf(pm, o); }
            float* g = (float*)(a.ws + WS_GS) + ((size_t)u * 36 + ci) * 192 + lane; g[0] = bc; g[64] = av; g[128] = pm;
        }
        __syncthreads();
        for (int i = tid; i < 12288 / 16; i += NTHR) *(u32x4*)(sCT + i * 16) = (u32x4){0u, 0u, 0u, 0u};
        for (int i = tid; i < 16 * 8; i += NTHR) {
            const int row = 32 + (i >> 3), c = i & 7;
            const unsigned v = row == 32 ? 0x3f803f80u : 0u;
            *(u32x4*)(sVT + swz128(row, c)) = (u32x4){v, v, v, v};
        }
        if (tid == 0) sSc[1] = -1e30f;
        f32x4 accC[2][3];
#pragma unroll
        for (int i = 0; i < 2; ++i)
#pragma unroll
            for (int jn = 0; jn < 3; ++jn) accC[i][jn] = (f32x4){0.f, 0.f, 0.f, 0.f};
        load_tiles(chunk_t0(0));
        __syncthreads();
        load_gates(0);
        store_tiles();
        if (wave == 0) gate_scalars();
        __syncthreads();
#pragma unroll 1
        for (int ci = 0; ci < 36; ++ci) {
            const int t0 = chunk_t0(ci);
            if (!(VAR & 8) && ci + 1 < 36) { load_tiles(chunk_t0(ci + 1)); load_gates(ci + 1); }
            f32x4 sacc[4];
#pragma unroll
            for (int jt = 0; jt < 4; ++jt) sacc[jt] = (f32x4){0.f, 0.f, 0.f, 0.f};
#pragma unroll
            for (int kk = 0; kk < 4; ++kk) {
                const bf16x8 qf = ldsv8(sQ + swz256(wave * 16 + fr, kk * 4 + fq));
#pragma unroll
                for (int jt = 0; jt < 4; ++jt) sacc[jt] = mfma16(ldsv8(sK + swz256(jt * 16 + fr, kk * 4 + fq)), qf, sacc[jt]);
            }
            lds_barrier();
            {
                const int tq = wave * 16 + fr;
                const float rt = sRow[tq];
#pragma unroll
                for (int jt = 0; jt < 4; ++jt) {
                    const f32x4 cl = *(const f32x4*)(sCol + jt * 16 + fq * 4);
                    f32x4 v;
#pragma unroll
                    for (int e = 0; e < 4; ++e) {
                        const int s = jt * 16 + fq * 4 + e;
                        const bool ok = dir ? (s >= tq) : (s <= tq);
                        v[e] = ok ? sacc[jt][e] * fexp(rt + cl[e]) : 0.f;
                    }
                    u32x2 pv; pv[0] = pk2(v[0], v[1]); pv[1] = pk2(v[2], v[3]);
                    *(u32x2*)(sS + swz128(tq, jt * 2 + (fq >> 1)) + (fq & 1) * 8) = pv;
                }
            }
            lds_barrier();
            if (!(VAR & 2)) {
                f32x4 n1[3], n2[3];
#pragma unroll
                for (int jt = 0; jt < 3; ++jt) { n1[jt] = (f32x4){0.f, 0.f, 0.f, 0.f}; n2[jt] = (f32x4){0.f, 0.f, 0.f, 0.f}; }
#pragma unroll
                for (int kk = 0; kk < 2; ++kk) {
                    const bf16x8 sf = ldsv8(sS + swz128(wave * 16 + fr, kk * 4 + fq));
#pragma unroll
                    for (int jt = 0; jt < 3; ++jt) n1[jt] = mfma16(ldsv8(sVT + swz128(jt * 16 + fr, kk * 4 + fq)), sf, n1[jt]);
                }
#pragma unroll
                for (int kk = 0; kk < 4; ++kk) {
                    const bf16x8 qf = ldsv8(sQ + swz256(wave * 16 + fr, kk * 4 + fq));
#pragma unroll
                    for (int jt = 0; jt < 3; ++jt) n2[jt] = mfma16(ldsv8(sCT + swz256(jt * 16 + fr, kk * 4 + fq)), qf, n2[jt]);
                }
                const int tq = wave * 16 + fr;
                const float it = sInt[tq];
                float den = n1[2][0] + it * n2[2][0];
                den = __shfl(den, fr);
                const float dn = fmaxf(fabsf(den), sNrm[tq]);
                const float inv = rcpf_(dn);
                bf16_t* hp = HS + (size_t)dir * NTOK * D + (size_t)(t0 + tq) * D + head * 256 + sl * 32 + fq * 4;
#pragma unroll
                for (int jt = 0; jt < 2; ++jt) {
                    f32x4 v;
#pragma unroll
                    for (int e = 0; e < 4; ++e) v[e] = (n1[jt][e] + it * n2[jt][e]) * inv;
                    st_bf4(hp + jt * 16, v);
                }
            }
            if (!(VAR & 4)) {
                const float decay = sSc[0];
#pragma unroll
                for (int i = 0; i < 2; ++i)
#pragma unroll
                    for (int jn = 0; jn < 3; ++jn) accC[i][jn] *= decay;
#pragma unroll
                for (int kk = 0; kk < 2; ++kk) {
                    bf16x8 vf[3];
#pragma unroll
                    for (int jn = 0; jn < 3; ++jn) vf[jn] = ldsv8(sVT + swz128(jn * 16 + fr, kk * 4 + fq));
                    const f32x4 w0 = *(const f32x4*)(sWv + kk * 32 + fq * 8), w1 = *(const f32x4*)(sWv + kk * 32 + fq * 8 + 4);
#pragma unroll
                    for (int i = 0; i < 2; ++i) {
                        const u32x4 kr = *(const u32x4*)(sKT + swz128((wave * 2 + i) * 16 + fr, kk * 4 + fq));
                        u32x4 ks;
                        ks[0] = pk2(lof(kr[0]) * w0[0], hif(kr[0]) * w0[1]); ks[1] = pk2(lof(kr[1]) * w0[2], hif(kr[1]) * w0[3]);
                        ks[2] = pk2(lof(kr[2]) * w1[0], hif(kr[2]) * w1[1]); ks[3] = pk2(lof(kr[3]) * w1[2], hif(kr[3]) * w1[3]);
                        const bf16x8 kf = __builtin_bit_cast(bf16x8, ks);
#pragma unroll
                        for (int jn = 0; jn < 3; ++jn) accC[i][jn] = mfma16(kf, vf[jn], accC[i][jn]);
                    }
                }
            }
            lds_barrier();
#pragma unroll
            for (int i = 0; i < 2; ++i)
#pragma unroll
                for (int jn = 0; jn < 3; ++jn) {
                    const int dd = (wave * 2 + i) * 16 + fq * 4, ee = jn * 16 + fr;
                    u32x2 pv; pv[0] = pk2(accC[i][jn][0], accC[i][jn][1]); pv[1] = pk2(accC[i][jn][2], accC[i][jn][3]);
                    *(u32x2*)(sCT + swz256(ee, dd >> 3) + (dd & 7) * 2) = pv;
                }
            if (ci + 1 < 36) {
                if (!(VAR & 8)) store_tiles();
                if (wave == 0 && !(VAR & 16)) gate_scalars();
            }
            lds_barrier();
        }
    }
}

DI void phase_ml_readout(const Args& a) {
    const int tid = threadIdx.x, lane = tid & 63, wave = tid >> 6;
    const bf16_t* H0 = (const bf16_t*)(a.ws + ML_HS); const bf16_t* H1 = H0 + (size_t)NTOK * D;
    const bf16_t* OG = (const bf16_t*)(a.ws + ML_OG); bf16_t* A2 = (bf16_t*)(a.ws + ML_A2);
    const float* on = a.in[24];
    for (int t = blockIdx.x * 4 + wave; t < NTOK; t += gridDim.x * 4) {
        const size_t off = (size_t)t * D + lane * 16;
        const u32x4 a0 = *(const u32x4*)(H0 + off), a1 = *(const u32x4*)(H0 + off + 8);
        const u32x4 b0 = *(const u32x4*)(H1 + off), b1 = *(const u32x4*)(H1 + off + 8);
        float v[16];
#pragma unroll
        for (int e = 0; e < 4; ++e) {
            v[2 * e] = lof(a0[e]) + lof(b0[e]); v[2 * e + 1] = hif(a0[e]) + hif(b0[e]);
            v[8 + 2 * e] = lof(a1[e]) + lof(b1[e]); v[8 + 2 * e + 1] = hif(a1[e]) + hif(b1[e]);
        }
        float ss = 0.f;
#pragma unroll
        for (int e = 0; e < 16; ++e) ss += v[e] * v[e];
        ss += __shfl_xor(ss, 1); ss += __shfl_xor(ss, 2); ss += __shfl_xor(ss, 4); ss += __shfl_xor(ss, 8);
        const float rs = rsqrtf(ss * (1.f / 256.f) + EPS);
        const u32x4 g0 = *(const u32x4*)(OG + off), g1 = *(const u32x4*)(OG + off + 8);
        const float* onp = on + lane * 16;
        u32x4 o0, o1;
#pragma unroll
        for (int e = 0; e < 4; ++e) {
            o0[e] = pk2(v[2 * e] * rs * onp[2 * e] * lof(g0[e]), v[2 * e + 1] * rs * onp[2 * e + 1] * hif(g0[e]));
            o1[e] = pk2(v[8 + 2 * e] * rs * onp[8 + 2 * e] * lof(g1[e]), v[8 + 2 * e + 1] * rs * onp[8 + 2 * e + 1] * hif(g1[e]));
        }
        *(u32x4*)(A2 + off) = o0; *(u32x4*)(A2 + off + 8) = o1;
    }
}

DI void phase_ml_out(const Args& a, int li) {
    gemm_dense_phase((const bf16_t*)(a.ws + ML_A2), D, NTOK, (const bf16_t*)(a.ws + W_MLOUT), 1024, 1024,
        [&](int m0, int n0, const f32x4 (&acc)[4][4]) { epi_resid_f32(a, li, m0, n0, acc); });
}

template <int STAGE>
DI void phase_moe(const Args& a, int li) {
    const int tid = threadIdx.x, lane = tid & 63, wave = tid >> 6;
    const int fr = lane & 15, fq = lane >> 4, wm = wave >> 1, wn = wave & 1;
    const int* cnt = (const int*)(a.ws + WS_CTL + CTL_CNT) + li * 64;
    const int* list = (const int*)(a.ws + WS_LIST);
    const float* wsl = (const float*)(a.ws + WS_WSLOT);
    const bf16_t* F = (const bf16_t*)(a.ws + WS_H);
    bf16_t* HM = (bf16_t*)(a.ws + WS_HMID); bf16_t* Y = (bf16_t*)(a.ws + WS_Y);
    int* pre = (int*)(lds + LDS_AUX);
    int* srowb = pre + 16;
    const int xc = blockIdx.x & 7, rank = blockIdx.x >> 3, nrank = gridDim.x >> 3;
    __syncthreads();
    if (tid == 0) { int s = 0; for (int i = 0; i < 8; ++i) { pre[i] = s; s += (cnt[xc + 8 * i] + 127) >> 7; } pre[8] = s; }
    __syncthreads();
    const int T = pre[8];
    constexpr int NTN = STAGE == 0 ? 4 : 8;
    constexpr int KK = STAGE == 0 ? 1024 : 256;
    const int total = T * NTN;
    int e = 0, r0 = 0, ce = 0, nt = 0, cur = 0;
    auto decode = [&](int u) {
        const int ti = u / NTN; nt = u % NTN;
        int ei = 0;
#pragma unroll 1
        for (int s = 4; s > 0; s >>= 1) if (pre[ei + s] <= ti) ei += s;
        e = xc + 8 * ei; r0 = (ti - pre[ei]) * 128; ce = cnt[e];
    };
    GemmPipe g;
    auto prep = [&](int buf) {
        int* srow = srowb + buf * 128;
        if (tid < 128) srow[tid] = list[(size_t)e * NTOK + min(r0 + tid, ce - 1)];
        __syncthreads();
        if (STAGE == 0) g.setup([&](int r) { return F + (size_t)(srow[r] >> 1) * D; }, (const bf16_t*)(a.ws + W_GU) + ((size_t)(li * 64 + e) * 512 + nt * 128) * 1024, 1024);
        else g.setup([&](int r) { return HM + (size_t)srow[r] * 256; }, (const bf16_t*)(a.ws + W_DN) + ((size_t)(li * 64 + e) * 1024 + nt * 128) * 256, 256);
        g.issue(0, 0);
    };
    int u = rank;
    if (u < total) { decode(u); prep(cur); }
    while (u < total) {
        f32x4 acc[4][4];
        g.run(KK, acc);
        const int cr0 = r0, cce = ce, cnt_ = nt;
        const int* srow = srowb + cur * 128;
        u += nrank;
        if (u < total) { decode(u); prep(cur ^ 1); }
        if (STAGE == 0) {
            __syncthreads();
            {
                const int tz = opaque_tid();
#pragma unroll
                for (int i = 0; i < 4; ++i) {
                    const int m = lane_m(tz, i);
#pragma unroll
                    for (int p = 0; p < 2; ++p) {
                        const int c = (((tz >> 6) & 1) * 2 + p) * 16 + ((tz >> 4) & 3) * 4;
                        f32x4 v;
#pragma unroll
                        for (int x = 0; x < 4; ++x) { const float gg = acc[i][2 * p][x]; v[x] = gg * rcpf_(1.f + fexp(-gg)) * acc[i][2 * p + 1][x]; }
                        u32x2 o; o[0] = pk2(v[0], v[1]); o[1] = pk2(v[2], v[3]);
                        *(u32x2*)(lds + EPI_OFF + m * 128 + (((c >> 3) ^ (m & 7)) << 4) + (c & 4) * 2) = o;
                    }
                }
            }
            __syncthreads();
            {
                const int tz = opaque_tid();
#pragma unroll
                for (int it = 0; it < 4; ++it) {
                    const int idx = tz + it * NTHR, row = idx >> 3, ch = idx & 7;
                    const u32x4 v = *(const u32x4*)(lds + EPI_OFF + row * 128 + ((ch ^ (row & 7)) << 4));
                    if (cr0 + row < cce) *(u32x4*)(HM + (size_t)srow[row] * 256 + cnt_ * 64 + ch * 8) = v;
                }
            }
        } else {
            float wrow[4];
            {
                const int tz = opaque_tid();
#pragma unroll
                for (int i = 0; i < 4; ++i) wrow[i] = wsl[srow[lane_m(tz, i)]];
            }
            __syncthreads();
            epi_stage_bf16(acc, [&](int i, int, const f32x4 v) { return v * wrow[i]; });
            __syncthreads();
            epi_flush_bf16([&](int row) { return Y + (size_t)srow[row] * D + cnt_ * 128; }, [&](int row) { return cr0 + row < cce; });
        }
        cur ^= 1;
    }
    __syncthreads();
}

#ifndef DBG_GPROBE
#define DBG_GPROBE -1
#endif
template <int PM>
DI void phase_gemm_probe(const Args& a) {
    const bf16_t* A = (const bf16_t*)(a.ws + WS_H); const bf16_t* Bt = (const bf16_t*)(a.ws + W_RGIN);
    float* dummy = (float*)(a.ws + RG_A2);
    const int mt = 144, nt = 16, K = 1024;
    GemmPipe g;
    __syncthreads();
    for (int u = blockIdx.x; u < mt * nt; u += gridDim.x) {
        const int m0 = (u % mt) * 128, n0 = (u / mt) * 128;
        g.setup([&](int r) { return A + (size_t)(m0 + r) * 1024; }, Bt + (size_t)n0 * K, K);
        if (PM & 1) g.issue(0, 0);
        f32x4 acc[4][4];
        g.run_probe<PM>(K, acc);
        float s = 0.f;
#pragma unroll
        for (int i = 0; i < 4; ++i)
#pragma unroll
            for (int j = 0; j < 4; ++j) s += acc[i][j][0] + acc[i][j][1] + acc[i][j][2] + acc[i][j][3];
        if (s == 12345.678f) dummy[threadIdx.x] = s;
        if (PM & 8) {
            bf16_t* Yd = (bf16_t*)(a.ws + WS_Y);
            const int lane = threadIdx.x & 63, wave = threadIdx.x >> 6;
            const int mb = m0 + (wave >> 1) * 64 + (lane & 15), nb = n0 + (wave & 1) * 64 + (lane >> 4) * 4;
#pragma unroll
            for (int i = 0; i < 4; ++i)
#pragma unroll
                for (int j = 0; j < 4; ++j) {
                    f32x4 v = acc[i][j];
                    if (PM & 16) { v[0] = gelu_tanh(v[0]); v[1] = gelu_tanh(v[1]); v[2] = gelu_tanh(v[2]); v[3] = gelu_tanh(v[3]); }
                    st_bf4(Yd + (size_t)(mb + i * 16) * 2048 + nb + j * 16, v);
                }
        }
        __syncthreads();
    }
}

#ifndef DBG_STOP
#define DBG_STOP 99
#endif
#ifndef DBG_OFF
#define DBG_OFF 0
#endif
DI void phase_dbg(const Args& a) {
    const size_t n = (size_t)NLAT * D;
    const float* X = (const float*)(a.ws + WS_X);
    const bf16_t* B = (const bf16_t*)(a.ws + (size_t)DBG_OFF);
    for (size_t i = (size_t)blockIdx.x * NTHR + threadIdx.x; i < n; i += (size_t)gridDim.x * NTHR)
        a.out[i] = DBG_OFF ? bf2f(B[i]) : X[i];
}

constexpr int NPH = 34;
__global__ void __launch_bounds__(NTHR, 2) fwd(const Args a) {
    if (threadIdx.x == 0) *(uint4*)(lds + LDS_BARW) = make_uint4(0u, 0u, 0u, 0u);
    __syncthreads();
    XcdBarrier bar;
    const bool multi = (a.ph_hi - a.ph_lo) > 1;
    if (multi) bar = xcd_barrier_post((unsigned*)(a.ws + WS_CTL), (volatile LAS unsigned*)(lds + LDS_BARW));
#ifndef DBG_REP
#define DBG_REP -1
#endif
#ifndef DBG_REPN
#define DBG_REPN 3
#endif
#define RUN(id, ...) do { if (a.ph_lo <= (id) && (id) < a.ph_hi) { \
        if ((id) == DBG_REP) { for (int rep_ = 1; rep_ < DBG_REPN; ++rep_) { __VA_ARGS__; xcd_barrier(bar); } } \
        __VA_ARGS__; if ((id) + 1 < a.ph_hi) xcd_barrier(bar); } } while (0)
    RUN(0, phase_prologue(a));
    RUN(1, phase_token_row<0>(a, 0));
    RUN(2, phase_rg_in(a, 0));
    if (DBG_GPROBE >= 0) { RUN(2, phase_gemm_probe<(DBG_GPROBE < 0 ? 7 : DBG_GPROBE)>(a)); }
#ifdef DBG_SCANVAR
    RUN(3, phase_rg_scan<DBG_SCANVAR>(a, 0));
#endif
    RUN(3, phase_rg_scan(a, 0));
    RUN(4, phase_rg_combine(a));
    RUN(5, phase_rg_out(a, 0, 0));
    RUN(6, phase_token_router(a, 0));
    RUN(7, phase_moe<0>(a, 0));
    RUN(8, phase_moe<1>(a, 0));
    RUN(9, phase_token_row<0>(a, 1));
    RUN(10, phase_mla_down(a));
    RUN(11, phase_mla_up(a));
    RUN(12, phase_mla_attn(a));
    RUN(13, phase_mla_out(a, 1));
    RUN(14, phase_token_router(a, 1));
    RUN(15, phase_moe<0>(a, 1));
    RUN(16, phase_moe<1>(a, 1));
    RUN(17, phase_token_row<0>(a, 2));
    RUN(18, phase_ml_in(a));
#ifdef DBG_MLVAR
    RUN(19, phase_ml_scan<DBG_MLVAR>(a));
#endif
    RUN(19, phase_ml_scan(a));
    RUN(20, phase_ml_readout(a));
    RUN(21, phase_ml_out(a, 2));
    RUN(22, phase_token_router(a, 2));
    RUN(23, phase_moe<0>(a, 2));
    RUN(24, phase_moe<1>(a, 2));
    RUN(25, phase_token_row<0>(a, 3));
    RUN(26, phase_rg_in(a, 1));
    RUN(27, phase_rg_scan(a, 1));
    RUN(28, phase_rg_combine(a));
    RUN(29, phase_rg_out(a, 3, 1));
    RUN(30, phase_token_router(a, 3));
    RUN(31, phase_moe<0>(a, 3));
    RUN(32, phase_moe<1>(a, 3));
    RUN(33, phase_token_row<2>(a, 3));
    RUN(34, phase_dbg(a));
#undef RUN
}

static void add_td(Args& a, int& n, int& tile0, const float* src, bf16_t* dst, const float* rscale, long sb, long db, int K, int N, int Npad, int batch, int perm) {
    TDesc& t = a.td[n++];
    t.src = src; t.dst = dst; t.rscale = rscale; t.sb = sb; t.db = db; t.K = K; t.N = N; t.Npad = Npad; t.batch = batch; t.perm = perm;
    t.tiles_k = (K + 127) / 128; t.tiles_n = (Npad + 63) / 64; t.tile0 = tile0;
    tile0 += batch * t.tiles_k * t.tiles_n;
}

extern "C" void kernel_launch(void* const* d_in, const int* in_sizes, int n_in, void* d_out, int out_size, void* d_ws, size_t ws_size, hipStream_t stream) {
    static int grid = 0;
    if (grid == 0) {
        if (n_in != 32 || out_size != NLAT * D || ws_size < WS_END) { fprintf(stderr, "kernel_launch: unexpected sizes (n_in %d out %d ws %zu need %zu)\n", n_in, out_size, ws_size, (size_t)WS_END); grid = -1; return; }
        int dev = 0, cus = 0, per_cu = 0;
        (void)hipGetDevice(&dev);
        (void)hipDeviceGetAttribute(&cus, hipDeviceAttributeMultiprocessorCount, dev);
        if (hipOccupancyMaxActiveBlocksPerMultiprocessor(&per_cu, (const void*)fwd, NTHR, 0) != hipSuccess) per_cu = 0;
        (void)hipGetLastError();
        if (per_cu < 2) fprintf(stderr, "kernel_launch: note: occupancy query reports %d blocks per CU (need 2)\n", per_cu);
        grid = cus * (per_cu >= 2 ? 2 : (per_cu >= 1 ? 1 : 2));
    }
    if (grid < 0) return;
    (void)in_sizes;
    (void)hipMemsetAsync((char*)d_ws + WS_CTL, 0, CTL_BYTES, stream);
    Args a;
    memset(&a, 0, sizeof(a));
    for (int i = 0; i < 32; ++i) a.in[i] = (const float*)d_in[i];
    a.out = (float*)d_out; a.ws = (unsigned char*)d_ws;
    unsigned char* ws = (unsigned char*)d_ws;
    int n = 0, tile0 = 0;
    add_td(a, n, tile0, a.in[8], (bf16_t*)(ws + W_RGIN), nullptr, 1024L * 2048, 2048L * 1024, 1024, 2048, 2048, 2, 0);
    add_td(a, n, tile0, a.in[14], (bf16_t*)(ws + W_RGOUT), nullptr, 1024L * 1024, 1024L * 1024, 1024, 1024, 1024, 2, 0);
    for (int j = 0; j < 2; ++j) for (int dir = 0; dir < 2; ++dir) for (int g = 0; g < 2; ++g)
        add_td(a, n, tile0, a.in[11] + (size_t)((j * 2 + dir) * 2 + g) * 16 * 4096, (bf16_t*)(ws + W_RGG) + (size_t)(j * 2 + dir) * 16 * 8192 + g * 4096, nullptr, 4096, 8192, 64, 64, 64, 16, 0);
    add_td(a, n, tile0, a.in[15], (bf16_t*)(ws + W_MDOWN), nullptr, 0, 0, 1024, 416, 512, 1, 0);
    add_td(a, n, tile0, a.in[18], (bf16_t*)(ws + W_MUQ), a.in[16], 0, 0, 256, 1536, 1536, 1, 0);
    add_td(a, n, tile0, a.in[19], (bf16_t*)(ws + W_MUKV), a.in[17], 0, 0, 128, 2048, 2048, 1, 0);
    add_td(a, n, tile0, a.in[21], (bf16_t*)(ws + W_MO), nullptr, 0, 0, 1024, 1024, 1024, 1, 0);
    add_td(a, n, tile0, a.in[22], (bf16_t*)(ws + W_MLIN), nullptr, 0, 0, 1024, 3088, 3200, 1, 0);
    add_td(a, n, tile0, a.in[25], (bf16_t*)(ws + W_MLOUT), nullptr, 0, 0, 1024, 1024, 1024, 1, 0);
    add_td(a, n, tile0, a.in[30], (bf16_t*)(ws + W_GU), nullptr, 1024L * 512, 512L * 1024, 1024, 512, 512, 64, 1);
    add_td(a, n, tile0, a.in[31], (bf16_t*)(ws + W_DN), nullptr, 256L * 1024, 1024L * 256, 256, 1024, 1024, 64, 0);
    a.ntiles_total = tile0;
    if (n != NTD) { fprintf(stderr, "kernel_launch: descriptor count %d != %d\n", n, NTD); return; }
#if MK_ONE_LAUNCH
    a.ph_lo = 0; a.ph_hi = NPH;
    hipLaunchKernelGGL(fwd, dim3(grid), dim3(NTHR), 0, stream, a);
#else
    for (int ph = 0; ph < NPH && ph <= DBG_STOP; ++ph) {
        a.ph_lo = ph; a.ph_hi = ph + 1;
        hipLaunchKernelGGL(fwd, dim3(grid), dim3(NTHR), 0, stream, a);
    }
    if (DBG_STOP < NPH) { a.ph_lo = 34; a.ph_hi = 35; hipLaunchKernelGGL(fwd, dim3(grid), dim3(NTHR), 0, stream, a); }
#endif
}
```

```cpp
#include <hip/hip_runtime.h>
#include <stdint.h>
#include <string.h>
#include <stdio.h>

#ifndef MK_ONE_LAUNCH
#define MK_ONE_LAUNCH 1
#endif

#define DI __device__ __forceinline__
typedef unsigned short bf16_t;
typedef __attribute__((ext_vector_type(8))) short bf16x8;
typedef __attribute__((ext_vector_type(4))) float f32x4;
typedef __attribute__((ext_vector_type(16))) float f32x16;
typedef __attribute__((ext_vector_type(2))) float f32x2;
typedef __attribute__((ext_vector_type(2))) __bf16 bfx2;
typedef __attribute__((ext_vector_type(4))) unsigned u32x4;
typedef __attribute__((ext_vector_type(2))) unsigned u32x2;

constexpr int D = 1024, NB = 8, SEQ = 2048, CTXL = 256;
constexpr int NLAT = NB * SEQ, NCTX = NB * CTXL, NTOK = NLAT + NCTX;
constexpr int NKEY = CTXL + SEQ;
constexpr int NTHR = 256;
constexpr int LDS_BYTES = 73728;
constexpr int LDS_AUX = 65536;
constexpr int LDS_BARW = LDS_BYTES - 16;
constexpr float EPS = 1e-6f;

constexpr size_t al256(size_t x) { return (x + 255) & ~(size_t)255; }
constexpr size_t WS_CTL = 0;
constexpr size_t CTL_BYTES = 65536;
constexpr size_t CTL_CNT = 16384;
constexpr size_t CTL_ROPE = 32768;
constexpr size_t WS_MOD = WS_CTL + CTL_BYTES;
constexpr size_t WS_X = al256(WS_MOD + 4 * 9 * 6144 * 4);
constexpr size_t WS_H = al256(WS_X + (size_t)NTOK * D * 4);
constexpr size_t WS_SCR = al256(WS_H + (size_t)NTOK * D * 2);
constexpr size_t SCR_BYTES = (size_t)256 << 20;
constexpr size_t TOKD2 = (size_t)NTOK * D * 2;
constexpr size_t RG_G = WS_SCR, RG_U = RG_G + TOKD2, RG_HS = RG_U + TOKD2, RG_A2 = RG_HS + 2 * TOKD2;
constexpr size_t MLA_CQ = WS_SCR;
constexpr size_t MLA_CKV = MLA_CQ + (size_t)NTOK * 256 * 2;
constexpr size_t MLA_KR = MLA_CKV + (size_t)NTOK * 128 * 2;
constexpr size_t MLA_Q = MLA_KR + (size_t)NTOK * 32 * 4;
constexpr size_t MLA_K = MLA_Q + (size_t)NTOK * 1536 * 2;
constexpr size_t MLA_VT = MLA_K + (size_t)NB * 16 * NKEY * 96 * 2;
constexpr size_t MLA_O = MLA_VT + (size_t)NB * 16 * 64 * NKEY * 2;
constexpr size_t MLA_END = MLA_O + TOKD2;
constexpr size_t ML_Q = WS_SCR;
constexpr size_t ML_K = ML_Q + (size_t)NTOK * 512 * 2;
constexpr size_t ML_KT = ML_K + (size_t)NTOK * 512 * 2;
constexpr size_t ML_VT = ML_KT + (size_t)NTOK * 512 * 2;
constexpr size_t ML_OG = ML_VT + TOKD2;
constexpr size_t ML_GT = ML_OG + TOKD2;
constexpr size_t ML_HS = ML_GT + (size_t)NTOK * 16 * 4;
constexpr size_t ML_A2 = ML_HS + 2 * TOKD2;
constexpr size_t ML_END = ML_A2 + TOKD2;
static_assert(RG_A2 + TOKD2 <= WS_SCR + SCR_BYTES && MLA_END <= WS_SCR + SCR_BYTES && ML_END <= WS_SCR + SCR_BYTES, "scratch");
constexpr size_t WS_LIST = WS_SCR + SCR_BYTES;
constexpr size_t WS_WSLOT = al256(WS_LIST + (size_t)64 * NTOK * 4);
constexpr size_t WS_HMID = al256(WS_WSLOT + (size_t)2 * NTOK * 4);
constexpr size_t WS_Y = al256(WS_HMID + (size_t)2 * NTOK * 256 * 2);
constexpr size_t WS_W = al256(WS_Y + (size_t)2 * NTOK * D * 2);
constexpr size_t W_RGIN = WS_W;
constexpr size_t W_RGOUT = W_RGIN + (size_t)2 * 2048 * 1024 * 2;
constexpr size_t W_RGG = W_RGOUT + (size_t)2 * 1024 * 1024 * 2;
constexpr size_t W_MDOWN = W_RGG + (size_t)2 * 2 * 16 * 128 * 64 * 2;
constexpr size_t W_MUQ = W_MDOWN + (size_t)512 * 1024 * 2;
constexpr size_t W_MUKV = W_MUQ + (size_t)1536 * 256 * 2;
constexpr size_t W_MO = W_MUKV + (size_t)2048 * 128 * 2;
constexpr size_t W_MLIN = W_MO + (size_t)1024 * 1024 * 2;
constexpr size_t W_MLOUT = W_MLIN + (size_t)3200 * 1024 * 2;
constexpr size_t W_RT = W_MLOUT + (size_t)1024 * 1024 * 2;
constexpr size_t W_GU = al256(W_RT + (size_t)4 * 2 * 80 * 1024 * 2);
constexpr size_t W_DN = W_GU + (size_t)256 * 512 * 1024 * 2;
constexpr size_t WS_GS = W_DN + (size_t)256 * 1024 * 256 * 2;
constexpr size_t WS_END = WS_GS + (size_t)512 * 36 * 3 * 64 * 4;

struct TDesc {
    const float* src; bf16_t* dst; const float* rscale;
    long sb, db;
    int K, N, Npad, batch;
    int perm, tiles_k, tiles_n, tile0;
};
constexpr int NTD = 18;
struct Args {
    const float* in[32];
    float* out;
    unsigned char* ws;
    TDesc td[NTD];
    int ntiles_total, ph_lo, ph_hi, pad0;
};

DI float bf2f(bf16_t v) { return __uint_as_float((unsigned)v << 16); }
DI unsigned pk2(float a, float b) { f32x2 v = {a, b}; bfx2 r = __builtin_convertvector(v, bfx2); return __builtin_bit_cast(unsigned, r); }
DI bf16_t f2bf(float a) { return (bf16_t)(pk2(a, 0.f) & 0xffffu); }
DI float lof(unsigned u) { return __uint_as_float(u << 16); }
DI float hif(unsigned u) { return __uint_as_float(u & 0xffff0000u); }
DI float rcpf_(float x) { return __builtin_amdgcn_rcpf(x); }
DI float fexp(float x) { return __builtin_amdgcn_exp2f(x * 1.4426950408889634f); }
DI float sigmoidf_(float x) { return rcpf_(1.f + fexp(-x)); }
DI float gelu_tanh(float x) { float u = 0.7978845608028654f * (x + 0.044715f * x * x * x); float e = fexp(2.f * u); return x * (1.f - rcpf_(e + 1.f)); }
DI int tok_modrow(int t) { return t < NLAT ? (t >> 11) : 8; }
DI void dma16(const void* g, char* l) { __builtin_amdgcn_global_load_lds((const unsigned*)g, (unsigned*)l, 16, 0, 0); }
DI void wait_vm0() { asm volatile("s_waitcnt vmcnt(0)" ::: "memory"); }
DI void lds_barrier() { asm volatile("s_waitcnt lgkmcnt(0)" ::: "memory"); __builtin_amdgcn_s_barrier(); asm volatile("" ::: "memory"); }
DI int swz128(int row, int chunk) { return row * 128 + ((chunk ^ (row & 7)) << 4); }
DI int swz256(int row, int chunk) { return row * 256 + ((chunk ^ (row & 15)) << 4); }
DI f32x4 mfma16(bf16x8 a, bf16x8 b, f32x4 c) { return __builtin_amdgcn_mfma_f32_16x16x32_bf16(a, b, c, 0, 0, 0); }
DI f32x16 mfma32(bf16x8 a, bf16x8 b, f32x16 c) { return __builtin_amdgcn_mfma_f32_32x32x16_bf16(a, b, c, 0, 0, 0); }
DI bf16x8 ldsv8(const char* p) { return *(const bf16x8*)p; }
DI void st_bf4(bf16_t* p, const f32x4 v) { u32x2 o; o[0] = pk2(v[0], v[1]); o[1] = pk2(v[2], v[3]); *(u32x2*)p = o; }

__shared__ __attribute__((aligned(16))) char lds[LDS_BYTES];

#define XB_TMO      128
#define XB_XCNT(j)  (256  + 64 * (j))
#define XB_XSUB(j)  (1280 + 64 * (j))
#define XB_XGEN(j)  (2304 + 64 * (j))
#define XB_TOP      3328
#define XB_TOPGEN   3392
#define XCD_BAR_WORDS 3456
#define XB_SPIN_CAP (1u << 22)
#define LAS __attribute__((address_space(3)))
DI unsigned xb_ld(unsigned* p)              { return __hip_atomic_load(p, __ATOMIC_RELAXED, __HIP_MEMORY_SCOPE_AGENT); }
DI unsigned xb_add(unsigned* p, unsigned v) { return __hip_atomic_fetch_add(p, v, __ATOMIC_RELAXED, __HIP_MEMORY_SCOPE_AGENT); }
DI unsigned xb_xcc_id() { return (unsigned)__builtin_amdgcn_s_getreg((3 << 11) | 20) & 0xFu; }
#define XB_SPIN(cond, bar) do { unsigned _sp = 0; while (cond) { __builtin_amdgcn_s_sleep(1); \
    if ((++_sp & 255u) == 0u) { if (xb_ld(&(bar)[XB_TMO])) break; if (_sp > XB_SPIN_CAP) { atomicAdd(&(bar)[XB_TMO], 1u); break; } } } } while (0)
struct XcdBarrier { unsigned* bar; unsigned x; volatile LAS unsigned* st; };
DI XcdBarrier xcd_barrier_post(unsigned* bar, volatile LAS unsigned* st) {
    XcdBarrier b; b.bar = bar; b.x = xb_xcc_id(); b.st = st;
    if (threadIdx.x == 0) (void)xb_add(&bar[XB_XCNT(b.x)], 1u);
    return b;
}
DI void xcd_barrier_complete(unsigned* bar, unsigned x, unsigned& nloc, unsigned& nx) {
    const unsigned G = gridDim.x * gridDim.y * gridDim.z;
    unsigned sum, cnt, mine, sp = 0u;
    for (;;) {
        sum = 0u; cnt = 0u; mine = 0u;
#pragma unroll
        for (unsigned j = 0; j < 16; ++j) { const unsigned c = xb_ld(&bar[XB_XCNT(j)]); sum += c; cnt += (c > 0u) ? 1u : 0u; mine = (j == x) ? c : mine; }
        if (sum == G) break;
        __builtin_amdgcn_s_sleep(1);
        if ((++sp & 255u) == 0u) { if (xb_ld(&bar[XB_TMO])) break; if (sp > XB_SPIN_CAP) { atomicAdd(&bar[XB_TMO], 1u); break; } }
    }
    nloc = mine > 0u ? mine : 1u; nx = cnt > 0u ? cnt : 1u;
}
DI void xcd_barrier(const XcdBarrier& b) {
    asm volatile("s_waitcnt vmcnt(0)" ::: "memory");
    __syncthreads();
    if (threadIdx.x == 0) {
        unsigned* bar = b.bar;
        __builtin_amdgcn_s_waitcnt(0);
        unsigned nloc = b.st[0], nx = b.st[1];
        if (nloc == 0u) { xcd_barrier_complete(bar, b.x, nloc, nx); b.st[0] = nloc; b.st[1] = nx; }
        const unsigned old = xb_add(&bar[XB_XSUB(b.x)], 1u);
        const unsigned gen = old / nloc;
        if (old + 1u == (gen + 1u) * nloc) {
            __builtin_amdgcn_fence(__ATOMIC_RELEASE, "agent");
            asm volatile("s_waitcnt vmcnt(0)" ::: "memory");
            const unsigned og = xb_add(&bar[XB_TOP], 1u);
            const unsigned tg = og / nx;
            if (og + 1u == (tg + 1u) * nx) xb_add(&bar[XB_TOPGEN], 1u);
            else XB_SPIN(xb_ld(&bar[XB_TOPGEN]) == tg, bar);
            __builtin_amdgcn_fence(__ATOMIC_ACQUIRE, "agent");
            xb_add(&bar[XB_XGEN(b.x)], 1u);
            asm volatile("s_waitcnt vmcnt(0)" ::: "memory");
        } else {
            XB_SPIN(xb_ld(&bar[XB_XGEN(b.x)]) == gen, bar);
            __builtin_amdgcn_fence(__ATOMIC_ACQUIRE, "agent");
            asm volatile("s_waitcnt vmcnt(0)" ::: "memory");
        }
    }
    __syncthreads();
}

struct CvTile { const float* src; bf16_t* dst; int K, N, perm, k0, n0; };
DI CvTile moe_cv_tile(const Args& a, const int L, const int t) {
    CvTile c;
    const int e = t / 96, r = t - e * 96;
    if (r < 64) {
        c.src = a.in[30] + (size_t)(L * 64 + e) * 1024 * 512; c.dst = (bf16_t*)(a.ws + W_GU) + (size_t)(L * 64 + e) * 512 * 1024;
        c.K = 1024; c.N = 512; c.perm = 1; c.k0 = (r & 7) * 128; c.n0 = (r >> 3) * 64;
    } else {
        const int r2 = r - 64;
        c.src = a.in[31] + (size_t)(L * 64 + e) * 256 * 1024; c.dst = (bf16_t*)(a.ws + W_DN) + (size_t)(L * 64 + e) * 1024 * 256;
        c.K = 256; c.N = 1024; c.perm = 0; c.k0 = (r2 & 1) * 128; c.n0 = (r2 >> 1) * 64;
    }
    return c;
}
DI void cv_load(const CvTile& c, f32x4 (&L0)[4], f32x4 (&L1)[4]) {
    const int tid = threadIdx.x, c4 = tid & 15, kr = tid >> 4;
    const float* p = c.src + (size_t)(c.k0 + 2 * kr) * c.N + c.n0 + 4 * c4;
#pragma unroll
    for (int i = 0; i < 4; ++i) { L0[i] = *(const f32x4*)(p + (size_t)(32 * i) * c.N); L1[i] = *(const f32x4*)(p + (size_t)(32 * i + 1) * c.N); }
}
DI void cv_pack(unsigned* st, const f32x4 (&L0)[4], const f32x4 (&L1)[4]) {
    const int tid = threadIdx.x, c4 = tid & 15, kr = tid >> 4;
#pragma unroll
    for (int i = 0; i < 4; ++i)
#pragma unroll
        for (int j = 0; j < 4; ++j) st[(4 * c4 + j) * 68 + 16 * i + kr] = pk2(L0[i][j], L1[i][j]);
}
DI void cv_flush(const CvTile& c, const unsigned* st) {
    const int tid = threadIdx.x;
#pragma unroll
    for (int i = 0; i < 4; ++i) {
        const int id = tid + i * 256, n = id >> 4, kc = id & 15;
        const u32x4 o = *(const u32x4*)(st + n * 68 + kc * 4);
        int nd = c.n0 + n;
        if (c.perm) { const int cc = nd & 255, up = nd >> 8; nd = ((cc >> 4) << 5) + (up << 4) + (cc & 15); }
        *(u32x4*)(c.dst + (size_t)nd * c.K + c.k0 + kc * 8) = o;
    }
}

DI void phase_prologue(const Args& a) {
    const int tid = threadIdx.x;
    const int n_ada = 384, n_rt = 320;
    const int total = n_ada + n_rt;
    float* sc = (float*)lds;
    for (int u = blockIdx.x; u < total; u += gridDim.x) {
        __syncthreads();
        if (u < n_ada) {
            const float* c = a.in[1]; const float* cc = a.in[3];
            for (int i = tid; i < 9 * 1024; i += NTHR) {
                float v = i < 8192 ? c[i] : cc[i - 8192];
                sc[i] = v / (1.f + __expf(-v));
            }
            __syncthreads();
            const int n = u * 64 + (tid & 63), li = n / 6144, nn = n - li * 6144, kq = tid >> 6;
            const float* wp = a.in[4] + (size_t)li * 1024 * 6144 + (size_t)(kq * 256) * 6144 + nn;
            float acc[9];
#pragma unroll
            for (int r = 0; r < 9; ++r) acc[r] = 0.f;
#pragma unroll 1
            for (int k0 = kq * 256; k0 < kq * 256 + 256; k0 += 16) {
                float wv[16];
#pragma unroll
                for (int kk = 0; kk < 16; ++kk) { wv[kk] = *wp; wp += 6144; }
#pragma unroll
                for (int kk = 0; kk < 16; kk += 4)
#pragma unroll
                    for (int r = 0; r < 9; ++r) {
                        const f32x4 s4 = *(const f32x4*)(sc + r * 1024 + k0 + kk);
                        acc[r] += s4[0] * wv[kk] + s4[1] * wv[kk + 1] + s4[2] * wv[kk + 2] + s4[3] * wv[kk + 3];
                    }
            }
            float* part = sc + 9 * 1024;
#pragma unroll
            for (int r = 0; r < 9; ++r) part[(kq * 9 + r) * 64 + (tid & 63)] = acc[r];
            __syncthreads();
            for (int i = tid; i < 9 * 64; i += NTHR) {
                const int r = i >> 6, cidx = i & 63;
                const int n2 = u * 64 + cidx, l2 = n2 / 6144, nn2 = n2 - l2 * 6144;
                const float v = ((part[(0 * 9 + r) * 64 + cidx] + part[(1 * 9 + r) * 64 + cidx]) + part[(2 * 9 + r) * 64 + cidx]) + part[(3 * 9 + r) * 64 + cidx];
                ((float*)(a.ws + WS_MOD))[((size_t)l2 * 9 + r) * 6144 + nn2] = v + a.in[5][l2 * 6144 + nn2];
            }
        } else if (u < n_ada + n_rt) {
            const int r_ = u - n_ada, li = r_ / 80, n = r_ - li * 80;
            if (r_ == 0) {
                float* rt_ = (float*)(a.ws + WS_CTL + CTL_ROPE);
                for (int i = tid; i < 512; i += NTHR) {
                    const int pos = i >> 3, fi = i & 7;
                    const float ang = (float)pos * powf(10000.f, -(float)fi * 0.125f);
                    rt_[i] = cosf(ang); rt_[512 + i] = sinf(ang);
                }
            }
            bf16_t* rt = (bf16_t*)(a.ws + W_RT) + (size_t)li * 2 * 80 * 1024;
            const float* wg = a.in[26] + (size_t)li * 1024 * 8;
            const float* we = a.in[28] + (size_t)li * 1024 * 64;
            float v[4];
#pragma unroll
            for (int j = 0; j < 4; ++j) { const int k = tid * 4 + j; v[j] = n < 8 ? wg[k * 8 + n] : (n < 72 ? we[k * 64 + (n - 8)] : 0.f); }
            u32x2 hi, lo;
            hi[0] = pk2(v[0], v[1]); hi[1] = pk2(v[2], v[3]);
            lo[0] = pk2(v[0] - lof(hi[0]), v[1] - hif(hi[0])); lo[1] = pk2(v[2] - lof(hi[1]), v[3] - hif(hi[1]));
            *(u32x2*)(rt + n * 1024 + tid * 4) = hi;
            *(u32x2*)(rt + 80 * 1024 + n * 1024 + tid * 4) = lo;
        }
    }
    struct PTile { const float* src; bf16_t* dst; const float* rscale; int K, N, Npad, perm, k0, n0; };
    auto decode = [&](int tix) {
        int di = 0;
#pragma unroll 1
        for (int i = 1; i < NTD; ++i) if (tix >= a.td[i].tile0) di = i;
        const TDesc& td = a.td[di];
        int rem = tix - td.tile0;
        const int per = td.tiles_k * td.tiles_n;
        const int bi = rem / per; rem -= bi * per;
        PTile p;
        p.src = td.src + (size_t)bi * td.sb; p.dst = td.dst + (size_t)bi * td.db; p.rscale = td.rscale;
        p.K = td.K; p.N = td.N; p.Npad = td.Npad; p.perm = td.perm;
        p.n0 = (rem % td.tiles_n) * 64; p.k0 = (rem / td.tiles_n) * 128;
        return p;
    };
    auto pload = [&](const PTile& p, f32x4 (&L0)[4], f32x4 (&L1)[4]) {
        const int c4 = tid & 15, kr = tid >> 4;
        const bool nok = p.n0 + 4 * c4 < p.N;
#pragma unroll
        for (int i = 0; i < 4; ++i) {
            const int k = p.k0 + 32 * i + 2 * kr;
            L0[i] = (f32x4){0.f, 0.f, 0.f, 0.f}; L1[i] = L0[i];
            if (nok && k < p.K) {
                L0[i] = *(const f32x4*)(p.src + (size_t)k * p.N + p.n0 + 4 * c4);
                L1[i] = *(const f32x4*)(p.src + (size_t)(k + 1) * p.N + p.n0 + 4 * c4);
                if (p.rscale) { L0[i] *= p.rscale[k]; L1[i] *= p.rscale[k + 1]; }
            }
        }
    };
    auto pflush = [&](const PTile& p, const unsigned* st) {
#pragma unroll
        for (int i = 0; i < 4; ++i) {
            const int id = tid + i * 256, n = id >> 4, kc = id & 15;
            const u32x4 o = *(const u32x4*)(st + n * 68 + kc * 4);
            int nd = p.n0 + n;
            if (nd < p.Npad && p.k0 + kc * 8 < p.K) {
                if (p.perm) { const int c = nd & 255, up = nd >> 8; nd = ((c >> 4) << 5) + (up << 4) + (c & 15); }
                *(u32x4*)(p.dst + (size_t)nd * p.K + p.k0 + kc * 8) = o;
            }
        }
    };
    {
        unsigned* st0 = (unsigned*)lds; unsigned* st1 = st0 + 64 * 68;
        const int nt_ = a.ntiles_total, G = gridDim.x;
        int t0 = blockIdx.x, t1 = blockIdx.x + G;
        PTile p0 = decode(0), p1 = p0;
        f32x4 A0[4], A1[4], B0[4], B1[4];
        __syncthreads();
        if (t0 < nt_) { p0 = decode(t0); pload(p0, A0, A1); }
        if (t1 < nt_) { p1 = decode(t1); pload(p1, B0, B1); }
        while (t0 < nt_) {
            PTile q0 = p0, q1 = p1;
            const bool v1 = t1 < nt_;
            cv_pack(st0, A0, A1);
            if (t0 + 2 * G < nt_) { p0 = decode(t0 + 2 * G); pload(p0, A0, A1); }
            if (v1) {
                cv_pack(st1, B0, B1);
                if (t1 + 2 * G < nt_) { p1 = decode(t1 + 2 * G); pload(p1, B0, B1); }
            }
            __syncthreads();
            pflush(q0, st0);
            if (v1) pflush(q1, st1);
            __syncthreads();
            t0 += 2 * G; t1 += 2 * G;
        }
    }
}

template <int MODE>
DI void phase_token(const Args& a, const int li) {
    const int tid = threadIdx.x, lane = tid & 63, wave = tid >> 6;
    const int r = lane & 15, q = lane >> 4;
    float* X = (float*)(a.ws + WS_X);
    bf16_t* H = (bf16_t*)(a.ws + WS_H);
    const bf16_t* Y = (const bf16_t*)(a.ws + WS_Y);
    const float* MOD = (const float*)(a.ws + WS_MOD);
    const bool combine = (MODE == 0 && li > 0) || MODE == 2;
    const int ngroups = (MODE == 2 || (MODE == 1 && li == 3)) ? NLAT / 16 : NTOK / 16;
    float* lg = (float*)(lds + wave * 16 * 80 * 4);
    for (int g = blockIdx.x * 4 + wave; g < ngroups; g += gridDim.x * 4) {
        const int t = g * 16 + r;
        const int mr = tok_modrow(g * 16);
        const float* xsrc = (MODE == 0 && li == 0) ? (t < NLAT ? a.in[0] + (size_t)t * D : a.in[2] + (size_t)(t - NLAT) * D) : X + (size_t)t * D;
        const bf16_t* y0 = Y + (size_t)(2 * t) * D;
        const bf16_t* y1 = y0 + D;
        const int lprev = MODE == 2 ? 3 : li - 1;
        const float* g5 = MOD + ((size_t)(lprev < 0 ? 0 : lprev) * 9 + mr) * 6144 + 5 * 1024;
        float ss = 0.f;
        if (MODE != 2) {
#pragma unroll 4
            for (int kk = 0; kk < 32; ++kk) {
                const int k = kk * 32 + q * 8;
                f32x4 x0 = *(const f32x4*)(xsrc + k), x1 = *(const f32x4*)(xsrc + k + 4);
                if (combine) {
                    const u32x4 ya = *(const u32x4*)(y0 + k), yb = *(const u32x4*)(y1 + k);
                    const f32x4 ga = *(const f32x4*)(g5 + k), gb = *(const f32x4*)(g5 + k + 4);
                    x0[0] += ga[0] * (lof(ya[0]) + lof(yb[0])); x0[1] += ga[1] * (hif(ya[0]) + hif(yb[0]));
                    x0[2] += ga[2] * (lof(ya[1]) + lof(yb[1])); x0[3] += ga[3] * (hif(ya[1]) + hif(yb[1]));
                    x1[0] += gb[0] * (lof(ya[2]) + lof(yb[2])); x1[1] += gb[1] * (hif(ya[2]) + hif(yb[2]));
                    x1[2] += gb[2] * (lof(ya[3]) + lof(yb[3])); x1[3] += gb[3] * (hif(ya[3]) + hif(yb[3]));
                }
#pragma unroll
                for (int j = 0; j < 4; ++j) ss += x0[j] * x0[j] + x1[j] * x1[j];
            }
            ss += __shfl_xor(ss, 16); ss += __shfl_xor(ss, 32);
        }
        const float rstd = rsqrtf(ss * (1.f / 1024.f) + EPS);
        const float* gn = (MODE == 1 ? a.in[7] : a.in[6]) + (size_t)li * D;
        const float* mscale = MOD + ((size_t)li * 9 + mr) * 6144 + (MODE == 1 ? 4 : 1) * 1024;
        const float* mshift = MOD + ((size_t)li * 9 + mr) * 6144 + (MODE == 1 ? 3 : 0) * 1024;
        const bf16_t* rwh = (const bf16_t*)(a.ws + W_RT) + (size_t)li * 2 * 80 * 1024 + (size_t)r * 1024 + q * 8;
        f32x4 lacc[5];
#pragma unroll
        for (int i = 0; i < 5; ++i) lacc[i] = (f32x4){0.f, 0.f, 0.f, 0.f};
#pragma unroll 2
        for (int kk = 0; kk < 32; ++kk) {
            const int k = kk * 32 + q * 8;
            f32x4 x0 = *(const f32x4*)(xsrc + k), x1 = *(const f32x4*)(xsrc + k + 4);
            if (combine) {
                const u32x4 ya = *(const u32x4*)(y0 + k), yb = *(const u32x4*)(y1 + k);
                const f32x4 ga = *(const f32x4*)(g5 + k), gb = *(const f32x4*)(g5 + k + 4);
                x0[0] += ga[0] * (lof(ya[0]) + lof(yb[0])); x0[1] += ga[1] * (hif(ya[0]) + hif(yb[0]));
                x0[2] += ga[2] * (lof(ya[1]) + lof(yb[1])); x0[3] += ga[3] * (hif(ya[1]) + hif(yb[1]));
                x1[0] += gb[0] * (lof(ya[2]) + lof(yb[2])); x1[1] += gb[1] * (hif(ya[2]) + hif(yb[2]));
                x1[2] += gb[2] * (lof(ya[3]) + lof(yb[3])); x1[3] += gb[3] * (hif(ya[3]) + hif(yb[3]));
            }
            if (MODE == 2) {
                *(f32x4*)(a.out + (size_t)t * D + k) = x0; *(f32x4*)(a.out + (size_t)t * D + k + 4) = x1;
                continue;
            }
            if (MODE == 0 && (li == 0 || combine)) { *(f32x4*)(X + (size_t)t * D + k) = x0; *(f32x4*)(X + (size_t)t * D + k + 4) = x1; }
            const f32x4 n0 = *(const f32x4*)(gn + k), n1 = *(const f32x4*)(gn + k + 4);
            const f32x4 s0 = *(const f32x4*)(mscale + k), s1 = *(const f32x4*)(mscale + k + 4);
            const f32x4 h0 = *(const f32x4*)(mshift + k), h1 = *(const f32x4*)(mshift + k + 4);
            float f[8];
#pragma unroll
            for (int j = 0; j < 4; ++j) {
                f[j] = x0[j] * rstd * n0[j] * (1.f + s0[j]) + h0[j];
                f[4 + j] = x1[j] * rstd * n1[j] * (1.f + s1[j]) + h1[j];
            }
            u32x4 hv;
            hv[0] = pk2(f[0], f[1]); hv[1] = pk2(f[2], f[3]); hv[2] = pk2(f[4], f[5]); hv[3] = pk2(f[6], f[7]);
            *(u32x4*)(H + (size_t)t * D + k) = hv;
            if (MODE == 1) {
                u32x4 lv;
                lv[0] = pk2(f[0] - lof(hv[0]), f[1] - hif(hv[0])); lv[1] = pk2(f[2] - lof(hv[1]), f[3] - hif(hv[1]));
                lv[2] = pk2(f[4] - lof(hv[2]), f[5] - hif(hv[2])); lv[3] = pk2(f[6] - lof(hv[3]), f[7] - hif(hv[3]));
                const bf16x8 fh = __builtin_bit_cast(bf16x8, hv), fl = __builtin_bit_cast(bf16x8, lv);
#pragma unroll
                for (int nt = 0; nt < 5; ++nt) {
                    const bf16x8 wh = *(const bf16x8*)(rwh + (size_t)nt * 16 * 1024 + kk * 32);
                    const bf16x8 wl = *(const bf16x8*)(rwh + (size_t)(80 + nt * 16) * 1024 + kk * 32);
                    lacc[nt] = mfma16(fh, wh, lacc[nt]);
                    lacc[nt] = mfma16(fh, wl, lacc[nt]);
                    lacc[nt] = mfma16(fl, wh, lacc[nt]);
                }
            }
        }
        if (MODE == 1) {
#pragma unroll
            for (int nt = 0; nt < 5; ++nt)
#pragma unroll
                for (int j = 0; j < 4; ++j) lg[(q * 4 + j) * 80 + nt * 16 + r] = lacc[nt][j];
            asm volatile("s_waitcnt lgkmcnt(0)" ::: "memory");
            __builtin_amdgcn_wave_barrier();
            if (lane < 16) {
                const float* L = lg + lane * 80;
                const float* bg = a.in[27] + li * 8;
                const float* be = a.in[29] + li * 64;
                float gmax = -3.0e38f; int gi = 0; float gl[8];
#pragma unroll
                for (int j = 0; j < 8; ++j) { gl[j] = L[j] + bg[j]; if (gl[j] > gmax) { gmax = gl[j]; gi = j; } }
                float ps = 0.f;
#pragma unroll
                for (int j = 0; j < 8; ++j) ps += __expf(gl[j] - gmax);
                const float ptop = 1.f / ps;
                float e1 = -3.0e38f, e2 = -3.0e38f; int i1 = 0, i2 = 0;
#pragma unroll
                for (int j = 0; j < 8; ++j) {
                    const float v = L[8 + gi * 8 + j] + be[gi * 8 + j];
                    if (v > e1) { e2 = e1; i2 = i1; e1 = v; i1 = j; } else if (v > e2) { e2 = v; i2 = j; }
                }
                const float ex = __expf(e2 - e1);
                const float w1 = ptop / (1.f + ex), w2 = ptop * ex / (1.f + ex);
                const int tt = g * 16 + lane;
                int* cnt = (int*)(a.ws + WS_CTL + CTL_CNT) + li * 64;
                int* list = (int*)(a.ws + WS_LIST);
                float* wsl = (float*)(a.ws + WS_WSLOT);
                const int ea = gi * 8 + i1, eb = gi * 8 + i2;
                const int pa = atomicAdd(&cnt[ea], 1); list[(size_t)ea * NTOK + pa] = 2 * tt; wsl[2 * tt] = w1;
                const int pb = atomicAdd(&cnt[eb], 1); list[(size_t)eb * NTOK + pb] = 2 * tt + 1; wsl[2 * tt + 1] = w2;
            }
            __builtin_amdgcn_wave_barrier();
        }
    }
}

DI float wave_sum(float v) {
    v += __shfl_xor(v, 1); v += __shfl_xor(v, 2); v += __shfl_xor(v, 4); v += __shfl_xor(v, 8); v += __shfl_xor(v, 16); v += __shfl_xor(v, 32);
    return v;
}
template <int MODE>
DI void phase_token_row(const Args& a, const int li) {
    const int tid = threadIdx.x, lane = tid & 63, wave = tid >> 6;
    float* X = (float*)(a.ws + WS_X);
    bf16_t* H = (bf16_t*)(a.ws + WS_H);
    const bf16_t* Y = (const bf16_t*)(a.ws + WS_Y);
    const float* MOD = (const float*)(a.ws + WS_MOD);
    const bool combine = MODE == 2 || li > 0;
    const bool first = MODE == 0 && li == 0;
    const int npairs = (MODE == 2 ? NLAT : NTOK) / 2;
    const int lprev = MODE == 2 ? 3 : (li > 0 ? li - 1 : 0);
    const float* gn = a.in[6] + (size_t)li * D;
    for (int p = blockIdx.x * 4 + wave; p < npairs; p += gridDim.x * 4) {
        const int t0 = 2 * p, mr = tok_modrow(t0);
        f32x4 x[2][4];
#pragma unroll
        for (int i = 0; i < 2; ++i) {
            const int t = t0 + i;
            const float* xs = first ? (t < NLAT ? a.in[0] + (size_t)t * D : a.in[2] + (size_t)(t - NLAT) * D) : X + (size_t)t * D;
#pragma unroll
            for (int j = 0; j < 4; ++j) x[i][j] = *(const f32x4*)(xs + 256 * j + 4 * lane);
        }
        if (combine) {
            const float* g5 = MOD + ((size_t)lprev * 9 + mr) * 6144 + 5 * 1024;
            f32x4 g[4];
#pragma unroll
            for (int j = 0; j < 4; ++j) g[j] = *(const f32x4*)(g5 + 256 * j + 4 * lane);
#pragma unroll
            for (int i = 0; i < 2; ++i) {
                const bf16_t* y0 = Y + (size_t)(2 * (t0 + i)) * D;
#pragma unroll
                for (int j = 0; j < 4; ++j) {
                    const u32x2 ya = *(const u32x2*)(y0 + 256 * j + 4 * lane), yb = *(const u32x2*)(y0 + D + 256 * j + 4 * lane);
                    x[i][j][0] += g[j][0] * (lof(ya[0]) + lof(yb[0])); x[i][j][1] += g[j][1] * (hif(ya[0]) + hif(yb[0]));
                    x[i][j][2] += g[j][2] * (lof(ya[1]) + lof(yb[1])); x[i][j][3] += g[j][3] * (hif(ya[1]) + hif(yb[1]));
                }
            }
        }
        if (MODE == 2) {
#pragma unroll
            for (int i = 0; i < 2; ++i)
#pragma unroll
                for (int j = 0; j < 4; ++j) *(f32x4*)(a.out + (size_t)(t0 + i) * D + 256 * j + 4 * lane) = x[i][j];
            continue;
        }
        float rstd[2];
#pragma unroll
        for (int i = 0; i < 2; ++i) {
            float ss = 0.f;
#pragma unroll
            for (int j = 0; j < 4; ++j) ss += x[i][j][0] * x[i][j][0] + x[i][j][1] * x[i][j][1] + x[i][j][2] * x[i][j][2] + x[i][j][3] * x[i][j][3];
            rstd[i] = rsqrtf(wave_sum(ss) * (1.f / 1024.f) + EPS);
        }
        const float* msc = MOD + ((size_t)li * 9 + mr) * 6144 + 1 * 1024;
        const float* msh = MOD + ((size_t)li * 9 + mr) * 6144;
#pragma unroll
        for (int j = 0; j < 4; ++j) {
            const f32x4 n4 = *(const f32x4*)(gn + 256 * j + 4 * lane), s4 = *(const f32x4*)(msc + 256 * j + 4 * lane), h4 = *(const f32x4*)(msh + 256 * j + 4 * lane);
            const f32x4 gs = n4 * (s4 + 1.f);
#pragma unroll
            for (int i = 0; i < 2; ++i) {
                const f32x4 f = x[i][j] * rstd[i] * gs + h4;
                st_bf4(H + (size_t)(t0 + i) * D + 256 * j + 4 * lane, f);
                if (combine) *(f32x4*)(X + (size_t)(t0 + i) * D + 256 * j + 4 * lane) = x[i][j];
            }
        }
    }
}

DI void phase_token_router(const Args& a, const int li) {
    const int tid = threadIdx.x, lane = tid & 63, wave = tid >> 6;
    const int r = lane & 15, q = lane >> 4;
    const float* X = (const float*)(a.ws + WS_X);
    bf16_t* H = (bf16_t*)(a.ws + WS_H);
    const float* MOD = (const float*)(a.ws + WS_MOD);
    const float* gn = a.in[7] + (size_t)li * D;
    const int ngroups = (li == 3 ? NLAT : NTOK) / 16;
    char* sHi = lds; char* sLo = lds + 32768;
    float* sP = (float*)lds;
    float* sL = (float*)(lds + 32768);
    const bf16_t* rwh = (const bf16_t*)(a.ws + W_RT) + (size_t)li * 2 * 80 * 1024 + (size_t)r * 1024 + q * 8;
    for (int g = blockIdx.x; g < ngroups; g += gridDim.x) {
        const int mr = tok_modrow(g * 16);
        const float* msc = MOD + ((size_t)li * 9 + mr) * 6144 + 4 * 1024;
        const float* msh = MOD + ((size_t)li * 9 + mr) * 6144 + 3 * 1024;
        __syncthreads();
        {
            f32x4 x[4][4];
#pragma unroll
            for (int i = 0; i < 4; ++i)
#pragma unroll
                for (int j = 0; j < 4; ++j) x[i][j] = *(const f32x4*)(X + (size_t)(g * 16 + wave * 4 + i) * D + 256 * j + 4 * lane);
            float rstd[4];
#pragma unroll
            for (int i = 0; i < 4; ++i) {
                float ss = 0.f;
#pragma unroll
                for (int j = 0; j < 4; ++j) ss += x[i][j][0] * x[i][j][0] + x[i][j][1] * x[i][j][1] + x[i][j][2] * x[i][j][2] + x[i][j][3] * x[i][j][3];
                rstd[i] = rsqrtf(wave_sum(ss) * (1.f / 1024.f) + EPS);
            }
#pragma unroll
            for (int j = 0; j < 4; ++j) {
                const f32x4 n4 = *(const f32x4*)(gn + 256 * j + 4 * lane), s4 = *(const f32x4*)(msc + 256 * j + 4 * lane), h4 = *(const f32x4*)(msh + 256 * j + 4 * lane);
                const f32x4 gs = n4 * (s4 + 1.f);
#pragma unroll
                for (int i = 0; i < 4; ++i) {
                    const int row = wave * 4 + i;
                    const f32x4 f = x[i][j] * rstd[i] * gs + h4;
                    u32x2 hv; hv[0] = pk2(f[0], f[1]); hv[1] = pk2(f[2], f[3]);
                    u32x2 lv; lv[0] = pk2(f[0] - lof(hv[0]), f[1] - hif(hv[0])); lv[1] = pk2(f[2] - lof(hv[1]), f[3] - hif(hv[1]));
                    *(u32x2*)(H + (size_t)(g * 16 + row) * D + 256 * j + 4 * lane) = hv;
                    const int off = row * 2048 + (((32 * j + (lane >> 1)) ^ row) << 4) + (lane & 1) * 8;
                    *(u32x2*)(sHi + off) = hv; *(u32x2*)(sLo + off) = lv;
                }
            }
        }
        __syncthreads();
        f32x4 lacc[5];
#pragma unroll
        for (int i = 0; i < 5; ++i) lacc[i] = (f32x4){0.f, 0.f, 0.f, 0.f};
#pragma unroll 2
        for (int s = 0; s < 8; ++s) {
            const int kk = wave * 8 + s;
            const int off = r * 2048 + (((kk * 4 + q) ^ r) << 4);
            const bf16x8 fh = ldsv8(sHi + off), fl = ldsv8(sLo + off);
#pragma unroll
            for (int nt = 0; nt < 5; ++nt) {
                const bf16x8 wh = *(const bf16x8*)(rwh + (size_t)nt * 16 * 1024 + kk * 32);
                const bf16x8 wl = *(const bf16x8*)(rwh + (size_t)(80 + nt * 16) * 1024 + kk * 32);
                lacc[nt] = mfma16(fh, wh, lacc[nt]);
                lacc[nt] = mfma16(fh, wl, lacc[nt]);
                lacc[nt] = mfma16(fl, wh, lacc[nt]);
            }
        }
        __syncthreads();
#pragma unroll
        for (int nt = 0; nt < 5; ++nt)
#pragma unroll
            for (int j = 0; j < 4; ++j) sP[(wave * 16 + q * 4 + j) * 80 + nt * 16 + r] = lacc[nt][j];
        __syncthreads();
        for (int i = tid; i < 16 * 80; i += NTHR) sL[i] = sP[i] + sP[1280 + i] + sP[2560 + i] + sP[3840 + i];
        __syncthreads();
        if (tid < 16) {
            const float* L = sL + tid * 80;
            const float* bg = a.in[27] + li * 8;
            const float* be = a.in[29] + li * 64;
            float gmax = -3.0e38f; int gi = 0; float gl[8];
#pragma unroll
            for (int j = 0; j < 8; ++j) { gl[j] = L[j] + bg[j]; if (gl[j] > gmax) { gmax = gl[j]; gi = j; } }
            float ps = 0.f;
#pragma unroll
            for (int j = 0; j < 8; ++j) ps += __expf(gl[j] - gmax);
            const float ptop = 1.f / ps;
            float e1 = -3.0e38f, e2 = -3.0e38f; int i1 = 0, i2 = 0;
#pragma unroll
            for (int j = 0; j < 8; ++j) {
                const float v = L[8 + gi * 8 + j] + be[gi * 8 + j];
                if (v > e1) { e2 = e1; i2 = i1; e1 = v; i1 = j; } else if (v > e2) { e2 = v; i2 = j; }
            }
            const float ex = __expf(e2 - e1);
            const float w1 = ptop / (1.f + ex), w2 = ptop * ex / (1.f + ex);
            const int tt = g * 16 + tid;
            int* cnt = (int*)(a.ws + WS_CTL + CTL_CNT) + li * 64;
            int* list = (int*)(a.ws + WS_LIST);
            float* wsl = (float*)(a.ws + WS_WSLOT);
            const int ea = gi * 8 + i1, eb = gi * 8 + i2;
            const int pa = atomicAdd(&cnt[ea], 1); list[(size_t)ea * NTOK + pa] = 2 * tt; wsl[2 * tt] = w1;
            const int pb = atomicAdd(&cnt[eb], 1); list[(size_t)eb * NTOK + pb] = 2 * tt + 1; wsl[2 * tt + 1] = w2;
        }
    }
}

template <int WM, int WN, int MT, int NT, bool PFALL = true, class AP>
DI void gemm_tile(AP arow, const bf16_t* Bt, const int ldb, const int K, f32x4 (&acc)[MT][NT], float* ssq = nullptr) {
    constexpr int BM = WM * MT * 16, BN = WN * NT * 16;
    constexpr int A_BYTES = BM * 128, B_BYTES = BN * 128, STAGE = A_BYTES + B_BYTES;
    constexpr int ACH = BM * 8 / NTHR, BCH = BN * 8 / NTHR;
    static_assert(2 * STAGE <= LDS_AUX, "gemm LDS");
    const int tid = threadIdx.x, lane = tid & 63, wave = tid >> 6;
    const int wm = wave / WN, wn = wave % WN;
    const int fr = lane & 15, fq = lane >> 4;
    const bf16_t* ap[ACH]; const bf16_t* bp[BCH];
#pragma unroll
    for (int i = 0; i < ACH; ++i) { const int idx = tid + i * NTHR, row = idx >> 3, c = (idx & 7) ^ (row & 7); ap[i] = arow(row) + c * 8; }
#pragma unroll
    for (int i = 0; i < BCH; ++i) { const int idx = tid + i * NTHR, row = idx >> 3, c = (idx & 7) ^ (row & 7); bp[i] = Bt + (size_t)row * ldb + c * 8; }
#pragma unroll
    for (int i = 0; i < MT; ++i)
#pragma unroll
        for (int j = 0; j < NT; ++j) acc[i][j] = (f32x4){0.f, 0.f, 0.f, 0.f};
    const int KT = K >> 6;
    {
        char* sa = lds; char* sb = lds + A_BYTES;
#pragma unroll
        for (int i = 0; i < ACH; ++i) dma16(ap[i], sa + (tid + i * NTHR) * 16);
#pragma unroll
        for (int i = 0; i < BCH; ++i) dma16(bp[i], sb + (tid + i * NTHR) * 16);
    }
#pragma unroll 1
    for (int kt = 0; kt < KT; ++kt) {
        wait_vm0();
        __syncthreads();
        if (kt + 1 < KT) {
            char* sa = lds + ((kt + 1) & 1) * STAGE; char* sb = sa + A_BYTES;
            const int ko = (kt + 1) * 64;
#pragma unroll
            for (int i = 0; i < ACH; ++i) dma16(ap[i] + ko, sa + (tid + i * NTHR) * 16);
#pragma unroll
            for (int i = 0; i < BCH; ++i) dma16(bp[i] + ko, sb + (tid + i * NTHR) * 16);
        }
        const char* sa = lds + (kt & 1) * STAGE; const char* sb = sa + A_BYTES;
        if (PFALL) {
            bf16x8 xf[2][MT], wf[2][NT];
#pragma unroll
            for (int kk = 0; kk < 2; ++kk) {
#pragma unroll
                for (int i = 0; i < MT; ++i) xf[kk][i] = ldsv8(sa + swz128(wm * MT * 16 + i * 16 + fr, kk * 4 + fq));
#pragma unroll
                for (int j = 0; j < NT; ++j) wf[kk][j] = ldsv8(sb + swz128(wn * NT * 16 + j * 16 + fr, kk * 4 + fq));
            }
            __builtin_amdgcn_sched_barrier(0);
            __builtin_amdgcn_s_setprio(1);
#pragma unroll
            for (int kk = 0; kk < 2; ++kk)
#pragma unroll
                for (int i = 0; i < MT; ++i)
#pragma unroll
                    for (int j = 0; j < NT; ++j) acc[i][j] = mfma16(wf[kk][j], xf[kk][i], acc[i][j]);
            __builtin_amdgcn_s_setprio(0);
        } else {
#pragma unroll
            for (int kk = 0; kk < 2; ++kk) {
                bf16x8 xf[MT], wf[NT];
#pragma unroll
                for (int i = 0; i < MT; ++i) xf[i] = ldsv8(sa + swz128(wm * MT * 16 + i * 16 + fr, kk * 4 + fq));
#pragma unroll
                for (int j = 0; j < NT; ++j) wf[j] = ldsv8(sb + swz128(wn * NT * 16 + j * 16 + fr, kk * 4 + fq));
#pragma unroll
                for (int i = 0; i < MT; ++i)
#pragma unroll
                    for (int j = 0; j < NT; ++j) acc[i][j] = mfma16(wf[j], xf[i], acc[i][j]);
                if (ssq) {
#pragma unroll
                    for (int i = 0; i < MT; ++i) {
                        const u32x4 xu = __builtin_bit_cast(u32x4, xf[i]);
#pragma unroll
                        for (int d = 0; d < 4; ++d) { const bfx2 p = __builtin_bit_cast(bfx2, xu[d]); ssq[i] = __builtin_amdgcn_fdot2_f32_bf16(p, p, ssq[i], false); }
                    }
                }
            }
        }
    }
    __syncthreads();
}


struct GemmPipe {
    static constexpr int A_BYTES = 128 * 128, STAGE = 2 * A_BYTES;
    const bf16_t* ap[4]; const bf16_t* bp[4];
    template <class AP>
    DI void setup(AP arow, const bf16_t* Bt, const int ldb) {
        const int tid = threadIdx.x;
#pragma unroll
        for (int i = 0; i < 4; ++i) {
            const int idx = tid + i * NTHR, row = idx >> 3, c = (idx & 7) ^ (row & 7);
            ap[i] = arow(row) + c * 8; bp[i] = Bt + (size_t)row * ldb + c * 8;
        }
    }
    DI void issue(const int kt, const int buf) const {
        const int tid = threadIdx.x;
        char* sa = lds + buf * STAGE; char* sb = sa + A_BYTES;
        const int ko = kt * 64;
#pragma unroll
        for (int i = 0; i < 4; ++i) dma16(ap[i] + ko, sa + (tid + i * NTHR) * 16);
#pragma unroll
        for (int i = 0; i < 4; ++i) dma16(bp[i] + ko, sb + (tid + i * NTHR) * 16);
    }
    template <int PM>
    DI void run_probe(const int K, f32x4 (&acc)[4][4]) const {
        const int tid = threadIdx.x, lane = tid & 63, wave = tid >> 6;
        const int wm = wave >> 1, wn = wave & 1, fr = lane & 15, fq = lane >> 4;
#pragma unroll
        for (int i = 0; i < 4; ++i)
#pragma unroll
            for (int j = 0; j < 4; ++j) acc[i][j] = (f32x4){0.f, 0.f, 0.f, 0.f};
        const int KT = K >> 6;
#pragma unroll 1
        for (int kt = 0; kt < KT; ++kt) {
            if (PM & 4) { wait_vm0(); __syncthreads(); }
            if ((PM & 1) && kt + 1 < KT) issue(kt + 1, (kt + 1) & 1);
            if (PM & 2) {
                const char* sa = lds + (kt & 1) * STAGE; const char* sb = sa + A_BYTES;
                bf16x8 xf[2][4], wf[2][4];
#pragma unroll
                for (int kk = 0; kk < 2; ++kk) {
#pragma unroll
                    for (int i = 0; i < 4; ++i) xf[kk][i] = ldsv8(sa + swz128(wm * 64 + i * 16 + fr, kk * 4 + fq));
#pragma unroll
                    for (int j = 0; j < 4; ++j) wf[kk][j] = ldsv8(sb + swz128(wn * 64 + j * 16 + fr, kk * 4 + fq));
                }
                __builtin_amdgcn_sched_barrier(0);
                __builtin_amdgcn_s_setprio(1);
#pragma unroll
                for (int kk = 0; kk < 2; ++kk)
#pragma unroll
                    for (int i = 0; i < 4; ++i)
#pragma unroll
                        for (int j = 0; j < 4; ++j) acc[i][j] = mfma16(wf[kk][j], xf[kk][i], acc[i][j]);
                __builtin_amdgcn_s_setprio(0);
            }
        }
        wait_vm0();
    }
    DI void run(const int K, f32x4 (&acc)[4][4]) const {
        const int tid = threadIdx.x, lane = tid & 63, wave = tid >> 6;
        const int wm = wave >> 1, wn = wave & 1, fr = lane & 15, fq = lane >> 4;
#pragma unroll
        for (int i = 0; i < 4; ++i)
#pragma unroll
            for (int j = 0; j < 4; ++j) acc[i][j] = (f32x4){0.f, 0.f, 0.f, 0.f};
        const int KT = K >> 6;
#pragma unroll 1
        for (int kt = 0; kt < KT; ++kt) {
            wait_vm0();
            __syncthreads();
            if (kt + 1 < KT) issue(kt + 1, (kt + 1) & 1);
            const char* sa = lds + (kt & 1) * STAGE; const char* sb = sa + A_BYTES;
            bf16x8 xf[2][4], wf[2][4];
#pragma unroll
            for (int kk = 0; kk < 2; ++kk) {
#pragma unroll
                for (int i = 0; i < 4; ++i) xf[kk][i] = ldsv8(sa + swz128(wm * 64 + i * 16 + fr, kk * 4 + fq));
#pragma unroll
                for (int j = 0; j < 4; ++j) wf[kk][j] = ldsv8(sb + swz128(wn * 64 + j * 16 + fr, kk * 4 + fq));
            }
            __builtin_amdgcn_sched_barrier(0);
            __builtin_amdgcn_s_setprio(1);
#pragma unroll
            for (int kk = 0; kk < 2; ++kk)
#pragma unroll
                for (int i = 0; i < 4; ++i)
#pragma unroll
                    for (int j = 0; j < 4; ++j) acc[i][j] = mfma16(wf[kk][j], xf[kk][i], acc[i][j]);
            __builtin_amdgcn_s_setprio(0);
        }
    }
};

constexpr int EPI_OFF = 32768;
DI int lane_m(int i) { const int t = threadIdx.x; return ((t >> 7) & 1) * 64 + i * 16 + (t & 15); }
DI int lane_n(int j) { const int t = threadIdx.x; return ((t >> 6) & 1) * 64 + j * 16 + ((t >> 4) & 3) * 4; }
DI int opaque_tid() { int t = threadIdx.x; asm volatile("" : "+v"(t)); return t; }
DI int lane_m(int t, int i) { return ((t >> 7) & 1) * 64 + i * 16 + (t & 15); }
DI int lane_n(int t, int j) { return ((t >> 6) & 1) * 64 + j * 16 + ((t >> 4) & 3) * 4; }
template <class XF>
DI void epi_stage_bf16(const f32x4 (&acc)[4][4], XF xf) {
    const int tz = opaque_tid();
#pragma unroll
    for (int i = 0; i < 4; ++i) {
        const int m = lane_m(tz, i);
#pragma unroll
        for (int j = 0; j < 4; ++j) {
            const int n = lane_n(tz, j);
            const f32x4 v = xf(i, j, acc[i][j]);
            u32x2 o; o[0] = pk2(v[0], v[1]); o[1] = pk2(v[2], v[3]);
            *(u32x2*)(lds + EPI_OFF + m * 256 + (((n >> 3) ^ (m & 15)) << 4) + (n & 4) * 2) = o;
        }
    }
}
template <class DP, class OK>
DI void epi_flush_bf16(DP dst, OK ok) {
    const int tz = opaque_tid();
#pragma unroll
    for (int it = 0; it < 8; ++it) {
        const int idx = tz + it * NTHR, row = idx >> 4, ch = idx & 15;
        const u32x4 v = *(const u32x4*)(lds + EPI_OFF + row * 256 + ((ch ^ (row & 15)) << 4));
        if (ok(row)) *(u32x4*)(dst(row) + ch * 8) = v;
    }
}
template <class XF>
DI void epi_stage_bf16_T(const f32x4 (&acc)[4][4], XF xf) {
    const int tz = opaque_tid();
    const bool odd = tz & 1;
#pragma unroll
    for (int i = 0; i < 4; ++i) {
        const int m = lane_m(tz, i) & ~1;
#pragma unroll
        for (int j = 0; j < 4; ++j) {
            const int n = lane_n(tz, j) + (odd ? 2 : 0);
            const f32x4 v = xf(i, j, acc[i][j]);
            const float r0 = __shfl_xor(odd ? v[0] : v[2], 1), r1 = __shfl_xor(odd ? v[1] : v[3], 1);
            const unsigned w0 = odd ? pk2(r0, v[2]) : pk2(v[0], r0), w1 = odd ? pk2(r1, v[3]) : pk2(v[1], r1);
            *(unsigned*)(lds + EPI_OFF + n * 256 + (((m >> 3) ^ (n & 15)) << 4) + (m & 6) * 2) = w0;
            *(unsigned*)(lds + EPI_OFF + (n + 1) * 256 + (((m >> 3) ^ ((n + 1) & 15)) << 4) + (m & 6) * 2) = w1;
        }
    }
}
DI void epi_resid_f32(const Args& a, const int li, const int m0, const int n0, const f32x4 (&acc)[4][4]) {
    const int tz = opaque_tid();
    float* X = (float*)(a.ws + WS_X);
    const float* gate = (const float*)(a.ws + WS_MOD) + ((size_t)li * 9 + tok_modrow(m0)) * 6144 + 2 * 1024 + n0;
#pragma unroll
    for (int j = 0; j < 4; ++j) {
        const int n = lane_n(tz, j);
        const f32x4 g = *(const f32x4*)(gate + n);
#pragma unroll
        for (int i = 0; i < 4; ++i) {
            const int t = m0 + lane_m(tz, i);
            float* xp = X + (size_t)t * D + n0 + n;
            const float* xs = li == 0 ? (t < NLAT ? a.in[0] + (size_t)t * D : a.in[2] + (size_t)(t - NLAT) * D) + n0 + n : xp;
            f32x4 x = *(const f32x4*)xs;
            x += g * acc[i][j];
            *(f32x4*)xp = x;
        }
    }
}

template <bool XPF = true, class TE>
DI void gemm_dense_phase(const bf16_t* A, const int lda, const int mrows, const bf16_t* Bt, const int N, const int K, TE tile_epi) {
    const int mt = mrows / 128, nt = N / 128;
    const int mpx = mt >> 3, bmb = mpx >> 1, full = mpx * 8;
    auto decode = [&](int u, int& m0, int& n0) {
        const int xc = u & 7, s = u >> 3;
        const int bn = s / full, rem = s - bn * full;
        const int w = min(8, nt - 8 * bn);
        const int bm = rem / (bmb * w), rem2 = rem - bm * (bmb * w);
        const int ni = rem2 / bmb, mi = rem2 - ni * bmb;
        m0 = (xc * mpx + bm * bmb + mi) * 128; n0 = (bn * 8 + ni) * 128;
    };
    GemmPipe g;
    int u = blockIdx.x, m0 = 0, n0 = 0;
    __syncthreads();
    if (u < mt * nt) { decode(u, m0, n0); g.setup([&](int r) { return A + (size_t)(m0 + r) * lda; }, Bt + (size_t)n0 * K, K); g.issue(0, 0); }
    while (u < mt * nt) {
        f32x4 acc[4][4];
        g.run(K, acc);
        const int cm0 = m0, cn0 = n0;
        u += gridDim.x;
        if (XPF) {
            if (u < mt * nt) { decode(u, m0, n0); g.setup([&](int r) { return A + (size_t)(m0 + r) * lda; }, Bt + (size_t)n0 * K, K); g.issue(0, 0); }
            tile_epi(cm0, cn0, acc);
        } else {
            tile_epi(cm0, cn0, acc);
            __syncthreads();
            if (u < mt * nt) { decode(u, m0, n0); g.setup([&](int r) { return A + (size_t)(m0 + r) * lda; }, Bt + (size_t)n0 * K, K); g.issue(0, 0); }
        }
    }
    __syncthreads();
}
template <class XF, class DP>
DI void epi_bf16_rowmajor(const f32x4 (&acc)[4][4], XF xf, DP dst) {
    __syncthreads();
    epi_stage_bf16(acc, xf);
    __syncthreads();
    epi_flush_bf16(dst, [](int) { return true; });
}

DI void phase_rg_in(const Args& a, int j) {
    bf16_t* G = (bf16_t*)(a.ws + RG_G); bf16_t* U = (bf16_t*)(a.ws + RG_U);
    gemm_dense_phase((const bf16_t*)(a.ws + WS_H), D, NTOK, (const bf16_t*)(a.ws + W_RGIN) + (size_t)j * 2048 * 1024, 2048, 1024,
        [&](int m0, int n0, const f32x4 (&acc)[4][4]) {
            if (n0 < 1024)
                epi_bf16_rowmajor(acc, [](int, int, const f32x4 v) { f32x4 g; g[0] = gelu_tanh(v[0]); g[1] = gelu_tanh(v[1]); g[2] = gelu_tanh(v[2]); g[3] = gelu_tanh(v[3]); return g; },
                                  [&](int row) { return G + (size_t)(m0 + row) * D + n0; });
            else
                epi_bf16_rowmajor(acc, [](int, int, const f32x4 v) { return v; }, [&](int row) { return U + (size_t)(m0 + row) * D + (n0 - 1024); });
        });
}

template <int VAR = 0, int HOST = 0>
DI void phase_rg_scan(const Args& a, int j) {
    const int tid = threadIdx.x, lane = tid & 63, wave = tid >> 6;
    const int fr = lane & 15, fq = lane >> 4;
    const bf16_t* U = (const bf16_t*)(a.ws + RG_U);
    bf16_t* HS = (bf16_t*)(a.ws + (VAR ? WS_Y : RG_HS));
    char* sW = lds;
    char* sX = lds + 8192;
    float* sUc = (float*)(lds + 16384);
    float* sA = (float*)(lds + 24576);
    float* sB = (float*)(lds + 33280);
    bf16_t* sO = (bf16_t*)(lds + 41984);
    unsigned* sCv = (unsigned*)(lds + 50176);
    const int c = tid & 7;
    for (int u = blockIdx.x; u < 512; u += gridDim.x) {
        const int half = u & 1, dir = (u >> 1) & 1, blk = (u >> 2) & 15, b = u >> 6;
        const int cin0 = blk * 64, co0 = blk * 64 + half * 32;
        __syncthreads();
        {
            const bf16_t* Wg = (const bf16_t*)(a.ws + W_RGG) + ((size_t)((j * 2 + dir) * 16 + blk)) * 128 * 64;
#pragma unroll
            for (int i = 0; i < 2; ++i) {
                const int idx = tid + i * NTHR, row = idx >> 3, cc = idx & 7;
                const int srow = (row >> 5) * 64 + half * 32 + (row & 31);
                *(u32x4*)(sW + swz128(row, cc)) = *(const u32x4*)(Wg + (size_t)srow * 64 + cc * 8);
            }
        }
        float carry = 0.f;
        float cw[4][8], cb[8];
        {
            const float* cwp = a.in[9] + (size_t)j * 4 * 1024 + cin0 + c * 8; const float* cbp = a.in[10] + (size_t)j * 1024 + cin0 + c * 8;
#pragma unroll
            for (int w = 0; w < 4; ++w) { const f32x4 v0 = *(const f32x4*)(cwp + w * 1024), v1 = *(const f32x4*)(cwp + w * 1024 + 4);
#pragma unroll
                for (int e = 0; e < 4; ++e) { cw[w][e] = v0[e]; cw[w][4 + e] = v1[e]; } }
            const f32x4 v0 = *(const f32x4*)cbp, v1 = *(const f32x4*)(cbp + 4);
#pragma unroll
            for (int e = 0; e < 4; ++e) { cb[e] = v0[e]; cb[4 + e] = v1[e]; }
        }
        float bg0[8], bg1[8], spl[8];
        {
            const float* gb = a.in[12] + ((size_t)(j * 2 + dir) * 2) * 1024 + co0;
            const float* lm = a.in[13] + (size_t)(j * 2 + dir) * 1024 + co0;
#pragma unroll
            for (int jt = 0; jt < 2; ++jt)
#pragma unroll
                for (int e = 0; e < 4; ++e) {
                    const int cc = jt * 16 + fq * 4 + e;
                    bg0[jt * 4 + e] = gb[cc]; bg1[jt * 4 + e] = gb[1024 + cc];
                    spl[jt * 4 + e] = -8.f * log1pf(__expf(-lm[cc]));
                }
        }
        u32x4 pu[2][4];
        auto load_chunk = [&](int ci) {
            const int seg = ci >= 4, L = seg ? SEQ : CTXL, nch = L / 64, jc = seg ? ci - 4 : ci;
            const int oc = dir ? nch - 1 - jc : jc;
            const int rb = seg ? b * SEQ : NLAT + b * CTXL;
            const int s0 = oc * 64;
#pragma unroll
            for (int it = 0; it < 2; ++it) {
                const int tk = (tid >> 3) + it * 32;
#pragma unroll
                for (int w = 0; w < 4; ++w) {
                    const int s = s0 + tk + w - 2;
                    const int sc_ = min(max(s, 0), L - 1);
                    const u32x4 ld = *(const u32x4*)(U + (size_t)(rb + sc_) * D + cin0 + c * 8);
                    const unsigned msk = (s >= 0 && s < L) ? 0xffffffffu : 0u;
                    pu[it][w] = (u32x4){ld[0] & msk, ld[1] & msk, ld[2] & msk, ld[3] & msk};
                }
            }
        };
        load_chunk(0);
        __syncthreads();
        size_t prev_base = 0;
        constexpr int CV_TILES = HOST ? 6144 : 0;
        CvTile cvp; cvp.src = nullptr; cvp.dst = nullptr; cvp.K = 0; cvp.N = 0; cvp.perm = 0; cvp.k0 = 0; cvp.n0 = 0;
        bool cvp_ok = false;
#pragma unroll 1
        for (int ci = 0; ci < 36; ++ci) {
            f32x4 cv0[4], cv1[4];
            CvTile cvc = cvp;
            const int cvq = (ci / 3) * 512 + u;
            const bool cv_ok = HOST && (ci % 3 == 0) && cvq < CV_TILES;
            if (cv_ok) { cvc = moe_cv_tile(a, 1, cvq); cv_load(cvc, cv0, cv1); }
            const int seg = ci >= 4, L = seg ? SEQ : CTXL, nch = L / 64, jc = seg ? ci - 4 : ci;
            const int oc = dir ? nch - 1 - jc : jc;
            const int rb = seg ? b * SEQ : NLAT + b * CTXL;
            const int s0 = oc * 64;
            char* sXc = sX; float* sUcc = sUc;
#pragma unroll
            for (int it = 0; it < 2; ++it) {
                const int tk = (tid >> 3) + it * 32;
                float o[8];
#pragma unroll
                for (int e = 0; e < 8; ++e) o[e] = cb[e];
#pragma unroll
                for (int w = 0; w < 4; ++w) {
                    const u32x4 r4 = pu[it][w];
#pragma unroll
                    for (int e = 0; e < 4; ++e) { o[2 * e] += cw[w][2 * e] * lof(r4[e]); o[2 * e + 1] += cw[w][2 * e + 1] * hif(r4[e]); }
                }
                u32x4 pv; pv[0] = pk2(o[0], o[1]); pv[1] = pk2(o[2], o[3]); pv[2] = pk2(o[4], o[5]); pv[3] = pk2(o[6], o[7]);
                *(u32x4*)(sXc + swz128(tk, c)) = pv;
                if ((c >> 2) == half) {
                    *(f32x4*)(sUcc + tk * 32 + (c & 3) * 8) = (f32x4){o[0], o[1], o[2], o[3]};
                    *(f32x4*)(sUcc + tk * 32 + (c & 3) * 8 + 4) = (f32x4){o[4], o[5], o[6], o[7]};
                }
            }
            if (ci + 1 < 36) load_chunk(ci + 1);
            lds_barrier();
            if (HOST && cvp_ok) cv_flush(cvp, sCv);
            if (ci > 0) {
                const u32x4 v = *(const u32x4*)(sO + ((ci - 1) & 1) * 2048 + tid * 8);
                *(u32x4*)(HS + prev_base + (size_t)(tid >> 2) * D + (tid & 3) * 8) = v;
            }
            {
                f32x4 acc[4];
#pragma unroll
                for (int jt = 0; jt < 4; ++jt) acc[jt] = (f32x4){0.f, 0.f, 0.f, 0.f};
#pragma unroll
                for (int kk = 0; kk < 2; ++kk) {
                    const bf16x8 xf = ldsv8(sXc + swz128(wave * 16 + fr, kk * 4 + fq));
#pragma unroll
                    for (int jt = 0; jt < 4; ++jt) acc[jt] = mfma16(ldsv8(sW + swz128(jt * 16 + fr, kk * 4 + fq)), xf, acc[jt]);
                }
                const int tk = wave * 16 + fr;
#pragma unroll
                for (int jt = 0; jt < 2; ++jt) {
                    const f32x4 uc = *(const f32x4*)(sUcc + tk * 32 + jt * 16 + fq * 4);
                    f32x4 av4, bv4;
#pragma unroll
                    for (int e = 0; e < 4; ++e) {
                        if (VAR & 2) { av4[e] = 0.5f + 0.001f * acc[jt][e]; bv4[e] = uc[e] + acc[jt + 2][e]; continue; }
                        const float rg = sigmoidf_(acc[jt][e] + bg0[jt * 4 + e]);
                        const float ig = sigmoidf_(acc[jt + 2][e] + bg1[jt * 4 + e]);
                        const float av = fexp(rg * spl[jt * 4 + e]);
                        av4[e] = av;
                        bv4[e] = __builtin_amdgcn_sqrtf(fmaxf(1.f - av * av, 0.f)) * ig * uc[e];
                    }
#pragma unroll
                    for (int e = 0; e < 4; ++e) { sA[(jt * 16 + fq * 4 + e) * 68 + tk] = av4[e]; sB[(jt * 16 + fq * 4 + e) * 68 + tk] = bv4[e]; }
                }
            }
            lds_barrier();
            if (!(VAR & 4)) {
                const int ch = wave * 8 + (lane & 7), sg = lane >> 3;
                const int tb = dir ? 56 - sg * 8 : sg * 8;
                const f32x4 a0 = *(const f32x4*)(sA + ch * 68 + tb), a1 = *(const f32x4*)(sA + ch * 68 + tb + 4);
                const f32x4 b0 = *(const f32x4*)(sB + ch * 68 + tb), b1 = *(const f32x4*)(sB + ch * 68 + tb + 4);
                float av[8], bv[8];
#pragma unroll
                for (int e = 0; e < 4; ++e) {
                    av[e] = dir ? a1[3 - e] : a0[e]; av[4 + e] = dir ? a0[3 - e] : a1[e];
                    bv[e] = dir ? b1[3 - e] : b0[e]; bv[4 + e] = dir ? b0[3 - e] : b1[e];
                }
                float Ap = 1.f, Hh = 0.f;
#pragma unroll
                for (int e = 0; e < 8; ++e) { Hh = av[e] * Hh + bv[e]; Ap *= av[e]; }
#pragma unroll
                for (int d = 8; d < 64; d <<= 1) {
                    const float Ao = __shfl_up(Ap, d), Ho = __shfl_up(Hh, d);
                    if (lane >= d) { Hh = Ap * Ho + Hh; Ap = Ap * Ao; }
                }
                float Aex = __shfl_up(Ap, 8), Hex = __shfl_up(Hh, 8);
                if (sg == 0) { Aex = 1.f; Hex = 0.f; }
                float hin = Aex * carry + Hex;
                const float cnew = Ap * carry + Hh;
                carry = __shfl(cnew, 56 + (lane & 7));
                bf16_t* so = sO + (ci & 1) * 2048 + ch;
#pragma unroll
                for (int e = 0; e < 8; ++e) {
                    hin = av[e] * hin + bv[e];
                    const int i = sg * 8 + e, tk = dir ? 63 - i : i;
                    so[tk * 32] = f2bf(hin);
                }
            }
            prev_base = (size_t)dir * NTOK * D + (size_t)(rb + s0) * D + co0;
            if (HOST) { if (cv_ok) cv_pack(sCv, cv0, cv1); cvp = cvc; cvp_ok = cv_ok; }
        }
        __syncthreads();
        if (HOST && cvp_ok) cv_flush(cvp, sCv);
        {
            const u32x4 v = *(const u32x4*)(sO + (35 & 1) * 2048 + tid * 8);
            *(u32x4*)(HS + prev_base + (size_t)(tid >> 2) * D + (tid & 3) * 8) = v;
        }
    }
}

DI void phase_rg_combine(const Args& a) {
    const u32x4* G = (const u32x4*)(a.ws + RG_G);
    const u32x4* H0 = (const u32x4*)(a.ws + RG_HS);
    const u32x4* H1 = (const u32x4*)(a.ws + RG_HS + TOKD2);
    u32x4* A2 = (u32x4*)(a.ws + RG_A2);
    const size_t n = (size_t)NTOK * D / 8;
    for (size_t i = (size_t)blockIdx.x * NTHR + threadIdx.x; i < n; i += (size_t)gridDim.x * NTHR) {
        const u32x4 g = G[i], h0 = H0[i], h1 = H1[i];
        u32x4 o;
#pragma unroll
        for (int e = 0; e < 4; ++e) o[e] = pk2(lof(g[e]) * (lof(h0[e]) + lof(h1[e])), hif(g[e]) * (hif(h0[e]) + hif(h1[e])));
        A2[i] = o;
    }
}

DI void phase_rg_out(const Args& a, int li, int j) {
    gemm_dense_phase((const bf16_t*)(a.ws + RG_A2), D, li == 3 ? NLAT : NTOK, (const bf16_t*)(a.ws + W_RGOUT) + (size_t)j * 1024 * 1024, 1024, 1024,
        [&](int m0, int n0, const f32x4 (&acc)[4][4]) { epi_resid_f32(a, li, m0, n0, acc); });
}

DI void phase_mla_down(const Args& a) {
    bf16_t* CQ = (bf16_t*)(a.ws + MLA_CQ); bf16_t* CKV = (bf16_t*)(a.ws + MLA_CKV); float* KR = (float*)(a.ws + MLA_KR);
    gemm_dense_phase((const bf16_t*)(a.ws + WS_H), D, NTOK, (const bf16_t*)(a.ws + W_MDOWN), 512, 1024,
        [&](int m0, int n0, const f32x4 (&acc)[4][4]) {
            if (n0 < 256) epi_bf16_rowmajor(acc, [](int, int, const f32x4 v) { return v; }, [&](int row) { return CQ + (size_t)(m0 + row) * 256 + n0; });
            else if (n0 == 256) epi_bf16_rowmajor(acc, [](int, int, const f32x4 v) { return v; }, [&](int row) { return CKV + (size_t)(m0 + row) * 128; });
            else {
#pragma unroll
                for (int i = 0; i < 4; ++i)
#pragma unroll
                    for (int j = 0; j < 2; ++j) { const int n = lane_n(j); if (n < 32) *(f32x4*)(KR + (size_t)(m0 + lane_m(i)) * 32 + n) = acc[i][j]; }
            }
        });
}

DI int perm_key(int kp) { return (kp & ~12) | ((kp & 4) << 1) | ((kp & 8) >> 1); }

DI void phase_mla_up(const Args& a) {
    const int tid = threadIdx.x;
    const bf16_t* CQ = (const bf16_t*)(a.ws + MLA_CQ); const bf16_t* CKV = (const bf16_t*)(a.ws + MLA_CKV); const float* KR = (const float*)(a.ws + MLA_KR);
    bf16_t* Q = (bf16_t*)(a.ws + MLA_Q); bf16_t* Kb = (bf16_t*)(a.ws + MLA_K); bf16_t* VT = (bf16_t*)(a.ws + MLA_VT);
    const float* qkn = a.in[20];
    const float* RC = (const float*)(a.ws + WS_CTL + CTL_ROPE); const float* RS = RC + 512;
    const int MT_ = NTOK / 128;
    const int nq = MT_ * 16, nkv = MT_ * 16;
    const float QSCALE = 0.10206207261596575f * 1.4426950408889634f;
    for (int u = blockIdx.x; u < nq + nkv; u += gridDim.x) {
        const bool isq = u < nq;
        const int uu = isq ? u : u - nq;
        const int xc_ = uu & 7, s_ = uu >> 3;
        const int m0 = (((s_ >> 4) << 3) + xc_) * 128, head = s_ & 15;
        const bool islat = m0 < NLAT;
        const int bb = islat ? (m0 >> 11) : ((m0 - NLAT) >> 8);
        const int kp0 = islat ? CTXL + (m0 & (SEQ - 1)) : ((m0 - NLAT) & (CTXL - 1));
        __syncthreads();
        if (isq) {
            f32x4 hold[2][6];
            float ssq[2] = {0.f, 0.f};
            gemm_tile<4, 1, 2, 6, false>([&](int r) { return CQ + (size_t)(m0 + r) * 256; }, (const bf16_t*)(a.ws + W_MUQ) + (size_t)head * 96 * 256, 256, 256, hold, ssq);
            const int tz = opaque_tid();
            const int wave = tz >> 6, fq = (tz >> 4) & 3, fr = tz & 15;
#pragma unroll
            for (int i = 0; i < 2; ++i) {
                const int m = wave * 32 + i * 16 + fr;
                float sq = ssq[i]; sq += __shfl_xor(sq, 16); sq += __shfl_xor(sq, 32);
                const float rs0 = rsqrtf(sq * (1.f / 256.f) + EPS);
                float ss = 0.f;
#pragma unroll
                for (int jn = 0; jn < 6; ++jn) { hold[i][jn] *= rs0;
#pragma unroll
                    for (int e = 0; e < 4; ++e) ss += hold[i][jn][e] * hold[i][jn][e]; }
                ss += __shfl_xor(ss, 16); ss += __shfl_xor(ss, 32);
                const float rs = rsqrtf(ss * (1.f / 96.f) + EPS) ;
                f32x4 o[6];
#pragma unroll
                for (int jn = 0; jn < 6; ++jn) { const f32x4 g4 = *(const f32x4*)(qkn + jn * 16 + fq * 4); o[jn] = hold[i][jn] * rs * g4; }
#pragma unroll
                for (int jn = 4; jn < 6; ++jn) {
                    f32x4 other;
#pragma unroll
                    for (int e = 0; e < 4; ++e) other[e] = __shfl_xor(o[jn][e], 32);
                    if (islat) {
                        const int s = (m0 + m) & (SEQ - 1);
                        const int pos = jn == 4 ? (s >> 6) : (s & 63);
                        const f32x4 cs = *(const f32x4*)(RC + pos * 8 + (fq & 1) * 4), sn = *(const f32x4*)(RS + pos * 8 + (fq & 1) * 4);
#pragma unroll
                        for (int e = 0; e < 4; ++e) o[jn][e] = (fq < 2) ? o[jn][e] * cs[e] - other[e] * sn[e] : o[jn][e] * cs[e] + other[e] * sn[e];
                    }
                }
#pragma unroll
                for (int jn = 0; jn < 6; ++jn) {
                    const f32x4 v = o[jn] * QSCALE;
                    u32x2 pv; pv[0] = pk2(v[0], v[1]); pv[1] = pk2(v[2], v[3]);
                    *(u32x2*)(lds + m * 256 + (((jn * 2 + (fq >> 1)) ^ (m & 15)) << 4) + (fq & 1) * 8) = pv;
                }
            }
            __syncthreads();
#pragma unroll
            for (int it = 0; it < 8; ++it) {
                const int idx = tz + it * NTHR, row = idx >> 4, ch = idx & 15;
                if (ch < 12) {
                    const u32x4 v = *(const u32x4*)(lds + row * 256 + ((ch ^ (row & 15)) << 4));
                    *(u32x4*)(Q + (size_t)(m0 + row) * 1536 + head * 96 + ch * 8) = v;
                }
            }
        } else {
            f32x4 hold[4][4];
            float ssq[4] = {0.f, 0.f, 0.f, 0.f};
            gemm_tile<2, 2, 4, 4, false>([&](int r) { return CKV + (size_t)(m0 + r) * 128; }, (const bf16_t*)(a.ws + W_MUKV) + (size_t)head * 128 * 128, 128, 128, hold, ssq);
            const int tz = opaque_tid();
            const int wave = tz >> 6, wm = wave >> 1, wn = wave & 1, fq = (tz >> 4) & 3, fr = tz & 15;
            char* sK = lds; char* sV = lds + 32768;
#pragma unroll
            for (int i = 0; i < 4; ++i) {
                const int m = wm * 64 + i * 16 + fr, t = m0 + m;
                float sq = ssq[i]; sq += __shfl_xor(sq, 16); sq += __shfl_xor(sq, 32);
                const float rs0 = rsqrtf(sq * (1.f / 128.f) + EPS);
#pragma unroll
                for (int jn = 0; jn < 4; ++jn) hold[i][jn] *= rs0;
                if (wn == 0) {
                    const int base = (fq >> 1) * 16 + (fq & 1) * 4;
                    const f32x4 z1 = *(const f32x4*)(KR + (size_t)t * 32 + base);
                    const f32x4 z2 = *(const f32x4*)(KR + (size_t)t * 32 + base + 8);
                    float ss = 0.f;
#pragma unroll
                    for (int jn = 0; jn < 4; ++jn)
#pragma unroll
                        for (int e = 0; e < 4; ++e) ss += hold[i][jn][e] * hold[i][jn][e];
#pragma unroll
                    for (int e = 0; e < 4; ++e) ss += z1[e] * z1[e] + z2[e] * z2[e];
                    ss += __shfl_xor(ss, 16); ss += __shfl_xor(ss, 32);
                    const float rs = rsqrtf(ss * (1.f / 96.f) + EPS);
#pragma unroll
                    for (int jn = 0; jn < 4; ++jn) {
                        const f32x4 g4 = *(const f32x4*)(qkn + 96 + jn * 16 + fq * 4);
                        const f32x4 v = hold[i][jn] * rs * g4;
                        u32x2 pv; pv[0] = pk2(v[0], v[1]); pv[1] = pk2(v[2], v[3]);
                        *(u32x2*)(sK + m * 256 + (((jn * 2 + (fq >> 1)) ^ (m & 15)) << 4) + (fq & 1) * 8) = pv;
                    }
                    const f32x4 g1 = *(const f32x4*)(qkn + 96 + 64 + base), g2 = *(const f32x4*)(qkn + 96 + 64 + base + 8);
                    f32x4 a1 = z1 * rs * g1, a2 = z2 * rs * g2;
                    if (islat) {
                        const int s = t & (SEQ - 1);
                        const int pos = (fq >> 1) == 0 ? (s >> 6) : (s & 63);
                        const f32x4 cs = *(const f32x4*)(RC + pos * 8 + (fq & 1) * 4), sn = *(const f32x4*)(RS + pos * 8 + (fq & 1) * 4);
                        const f32x4 b1 = a1 * cs - a2 * sn, b2 = a2 * cs + a1 * sn;
                        a1 = b1; a2 = b2;
                    }
                    u32x2 p1, p2; p1[0] = pk2(a1[0], a1[1]); p1[1] = pk2(a1[2], a1[3]); p2[0] = pk2(a2[0], a2[1]); p2[1] = pk2(a2[2], a2[3]);
                    const int c1 = 8 + (fq >> 1) * 2;
                    *(u32x2*)(sK + m * 256 + ((c1 ^ (m & 15)) << 4) + (fq & 1) * 8) = p1;
                    *(u32x2*)(sK + m * 256 + (((c1 + 1) ^ (m & 15)) << 4) + (fq & 1) * 8) = p2;
                }
                {
                    const bool odd = fr & 1;
                    const int mp = perm_key(m & ~1);
#pragma unroll
                    for (int jn = 0; jn < 4; ++jn) {
                        const f32x4 v = hold[i][jn];
                        const float r0 = __shfl_xor(odd ? v[0] : v[2], 1), r1 = __shfl_xor(odd ? v[1] : v[3], 1);
                        if (wn == 1) {
                            const int e0 = jn * 16 + fq * 4 + (odd ? 2 : 0);
                            const unsigned w0 = odd ? pk2(r0, v[2]) : pk2(v[0], r0), w1 = odd ? pk2(r1, v[3]) : pk2(v[1], r1);
                            *(unsigned*)(sV + e0 * 256 + (((mp >> 3) ^ (e0 & 15)) << 4) + (mp & 6) * 2) = w0;
                            *(unsigned*)(sV + (e0 + 1) * 256 + (((mp >> 3) ^ ((e0 + 1) & 15)) << 4) + (mp & 6) * 2) = w1;
                        }
                    }
                }
            }
            __syncthreads();
            bf16_t* kdst = Kb + ((size_t)(bb * 16 + head) * NKEY + kp0) * 96;
#pragma unroll
            for (int it = 0; it < 8; ++it) {
                const int idx = tz + it * NTHR, row = idx >> 4, ch = idx & 15;
                if (ch < 12) {
                    const u32x4 v = *(const u32x4*)(sK + row * 256 + ((ch ^ (row & 15)) << 4));
                    *(u32x4*)(kdst + (size_t)row * 96 + ch * 8) = v;
                }
            }
            bf16_t* vdst = VT + ((size_t)(bb * 16 + head) * 64) * NKEY + kp0;
#pragma unroll
            for (int it = 0; it < 4; ++it) {
                const int idx = tz + it * NTHR, row = idx >> 4, ch = idx & 15;
                const u32x4 v = *(const u32x4*)(sV + row * 256 + ((ch ^ (row & 15)) << 4));
                *(u32x4*)(vdst + (size_t)row * NKEY + ch * 8) = v;
            }
        }
    }
}

DI void phase_mla_attn(const Args& a) {
    const int tid = threadIdx.x, lane = tid & 63, wave = tid >> 6;
    const int r = lane & 31, h = lane >> 5;
    const bf16_t* Q = (const bf16_t*)(a.ws + MLA_Q); const bf16_t* Kb = (const bf16_t*)(a.ws + MLA_K); const bf16_t* VT = (const bf16_t*)(a.ws + MLA_VT);
    bf16_t* O = (bf16_t*)(a.ws + MLA_O);
    constexpr int KT_B = 64 * 192, VT_B = 64 * 128, ST_B = KT_B + VT_B;
    unsigned* sCv = (unsigned*)(lds + 49152);
    const int cv_per = 18432 / gridDim.x;
    int cvn = 0, itc = 0;
    bool cv_pack_p = false, cv_flush_p = false;
    CvTile cvB, cvC; cvB.src = nullptr; cvB.dst = nullptr; cvB.K = 0; cvB.N = 0; cvB.perm = 0; cvB.k0 = 0; cvB.n0 = 0; cvC = cvB;
    f32x4 cv0[4], cv1[4];
#pragma unroll
    for (int i = 0; i < 4; ++i) { cv0[i] = (f32x4){0.f, 0.f, 0.f, 0.f}; cv1[i] = cv0[i]; }
    auto cv_step = [&](bool may_load) {
        if (cv_flush_p) { cv_flush(cvC, sCv); cv_flush_p = false; }
        if (cv_pack_p) { cv_pack(sCv, cv0, cv1); cvC = cvB; cv_flush_p = true; cv_pack_p = false; }
        if (may_load && cvn < cv_per) {
            const int t = cvn * gridDim.x + blockIdx.x;
            cvB = moe_cv_tile(a, 1 + t / 6144, t % 6144); cv_load(cvB, cv0, cv1); cv_pack_p = true; ++cvn;
        }
    };
    for (int u = blockIdx.x; u < 2048 + 256; u += gridDim.x) {
        const bool isctx = u >= 2048;
        const int uu = isctx ? u - 2048 : u;
        const int xc_ = uu & 7, s_ = uu >> 3, bh_ = ((s_ >> 4) << 3) + xc_;
        const int qb = isctx ? (uu & 1) : (s_ & 15), head = isctx ? ((uu >> 1) & 15) : (bh_ & 15), b = isctx ? (uu >> 5) : (bh_ >> 4);
        const int ntile = isctx ? CTXL / 64 : NKEY / 64;
        const int t = (isctx ? NLAT + b * CTXL : b * SEQ) + qb * 128 + wave * 32 + r;
        const bf16_t* kbase = Kb + (size_t)(b * 16 + head) * NKEY * 96;
        const bf16_t* vbase = VT + (size_t)(b * 16 + head) * 64 * NKEY;
        bf16x8 qf[6];
#pragma unroll
        for (int kk = 0; kk < 6; ++kk) qf[kk] = *(const bf16x8*)(Q + (size_t)t * 1536 + head * 96 + kk * 16 + h * 8);
        f32x16 o[2];
#pragma unroll
        for (int e = 0; e < 16; ++e) { o[0][e] = 0.f; o[1][e] = 0.f; }
        float lsum = 0.f;
        __syncthreads();
        auto stage = [&](int kt, int buf) {
            char* sk = lds + buf * ST_B; char* sv = sk + KT_B;
            const int key0 = kt * 64;
#pragma unroll
            for (int i = 0; i < 3; ++i) {
                const int idx = tid + i * NTHR, row = idx / 12, slot = idx - row * 12;
                int c = slot - ((row >> 2) % 12); if (c < 0) c += 12;
                dma16(kbase + (size_t)(key0 + row) * 96 + c * 8, sk + idx * 16);
            }
#pragma unroll
            for (int i = 0; i < 2; ++i) {
                const int idx = tid + i * NTHR, row = idx >> 3, c = (idx & 7) ^ ((row >> 1) & 7);
                dma16(vbase + (size_t)row * NKEY + key0 + c * 8, sv + idx * 16);
            }
        };
        stage(0, 0);
#pragma unroll 1
        for (int kt = 0; kt < ntile; ++kt) {
            wait_vm0();
            __syncthreads();
            if (kt + 1 < ntile) stage(kt + 1, (kt + 1) & 1);
            cv_step((itc & 3) == 0); ++itc;
            const char* sk = lds + (kt & 1) * ST_B; const char* sv = sk + KT_B;
            f32x16 st[2];
#pragma unroll
            for (int e = 0; e < 16; ++e) { st[0][e] = -8.f; st[1][e] = -8.f; }
#pragma unroll
            for (int kk = 0; kk < 6; ++kk)
#pragma unroll
                for (int si = 0; si < 2; ++si) {
                    const int s = si * 32 + r;
                    int slot = kk * 2 + h + ((s >> 2) % 12); if (slot >= 12) slot -= 12;
                    st[si] = mfma32(ldsv8(sk + s * 192 + slot * 16), qf[kk], st[si]);
                }
            float ps = 0.f;
#pragma unroll
            for (int si = 0; si < 2; ++si)
#pragma unroll
                for (int e = 0; e < 16; ++e) { const float p = __builtin_amdgcn_exp2f(st[si][e]); st[si][e] = p; ps += p; }
            lsum += ps;
#pragma unroll
            for (int si = 0; si < 2; ++si)
#pragma unroll
                for (int ks = 0; ks < 2; ++ks) {
                    u32x4 pp;
                    pp[0] = pk2(st[si][8 * ks + 0], st[si][8 * ks + 1]); pp[1] = pk2(st[si][8 * ks + 2], st[si][8 * ks + 3]);
                    pp[2] = pk2(st[si][8 * ks + 4], st[si][8 * ks + 5]); pp[3] = pk2(st[si][8 * ks + 6], st[si][8 * ks + 7]);
                    const bf16x8 pf = __builtin_bit_cast(bf16x8, pp);
#pragma unroll
                    for (int et = 0; et < 2; ++et) {
                        const int e = et * 32 + r;
                        o[et] = mfma32(ldsv8(sv + e * 128 + (((si * 4 + ks * 2 + h) ^ ((e >> 1) & 7)) << 4)), pf, o[et]);
                    }
                }
        }
        lsum += __shfl_xor(lsum, 32);
        const float inv = 1.f / lsum;
#pragma unroll
        for (int et = 0; et < 2; ++et)
#pragma unroll
            for (int g = 0; g < 4; ++g) {
                f32x4 v; v[0] = o[et][4 * g] * inv; v[1] = o[et][4 * g + 1] * inv; v[2] = o[et][4 * g + 2] * inv; v[3] = o[et][4 * g + 3] * inv;
                st_bf4(O + (size_t)t * D + head * 64 + et * 32 + 8 * g + 4 * h, v);
            }
    }
    while (cvn < cv_per || cv_pack_p || cv_flush_p) { __syncthreads(); cv_step(!cv_pack_p && !cv_flush_p); }
}

DI void phase_mla_out(const Args& a, int li) {
    gemm_dense_phase((const bf16_t*)(a.ws + MLA_O), D, NTOK, (const bf16_t*)(a.ws + W_MO), 1024, 1024,
        [&](int m0, int n0, const f32x4 (&acc)[4][4]) { epi_resid_f32(a, li, m0, n0, acc); });
}

DI void phase_ml_in(const Args& a) {
    bf16_t* Qm = (bf16_t*)(a.ws + ML_Q); bf16_t* Km = (bf16_t*)(a.ws + ML_K); bf16_t* KT = (bf16_t*)(a.ws + ML_KT); bf16_t* VT = (bf16_t*)(a.ws + ML_VT);
    bf16_t* OG = (bf16_t*)(a.ws + ML_OG); float* GT = (float*)(a.ws + ML_GT);
    const float* gb = a.in[23];
    auto ident = [](int, int, const f32x4 v) { return v; };
    gemm_dense_phase<false>((const bf16_t*)(a.ws + WS_H), D, NTOK, (const bf16_t*)(a.ws + W_MLIN), 3200, 1024,
        [&](int m0, int n0, const f32x4 (&acc)[4][4]) {
            if (n0 < 512) {
                epi_bf16_rowmajor(acc, [](int, int, const f32x4 v) { return v * 0.08838834764831845f; }, [&](int row) { return Qm + (size_t)(m0 + row) * 512 + n0; });
            } else if (n0 < 1024) {
                epi_bf16_rowmajor(acc, ident, [&](int row) { return Km + (size_t)(m0 + row) * 512 + (n0 - 512); });
                __syncthreads();
                epi_stage_bf16_T(acc, ident);
                __syncthreads();
                epi_flush_bf16([&](int row) { return KT + (size_t)(n0 - 512 + row) * NTOK + m0; }, [](int) { return true; });
            } else if (n0 < 2048) {
                __syncthreads();
                epi_stage_bf16_T(acc, ident);
                __syncthreads();
                epi_flush_bf16([&](int row) { return VT + (size_t)(n0 - 1024 + row) * NTOK + m0; }, [](int) { return true; });
            } else if (n0 < 3072) {
                epi_bf16_rowmajor(acc, [](int, int, const f32x4 v) { f32x4 s; s[0] = sigmoidf_(v[0]); s[1] = sigmoidf_(v[1]); s[2] = sigmoidf_(v[2]); s[3] = sigmoidf_(v[3]); return s; },
                                  [&](int row) { return OG + (size_t)(m0 + row) * D + (n0 - 2048); });
            } else {
#pragma unroll
                for (int i = 0; i < 4; ++i) {
                    const int n = lane_n(0);
                    if (n < 16) { f32x4 s = acc[i][0]; s[0] += gb[n]; s[1] += gb[n + 1]; s[2] += gb[n + 2]; s[3] += gb[n + 3]; *(f32x4*)(GT + (size_t)(m0 + lane_m(i)) * 16 + n) = s; }
                }
            }
        });
}

template <int VAR = 0>
DI void phase_ml_scan(const Args& a) {
    const int tid = threadIdx.x, lane = tid & 63, wave = tid >> 6;
    const int fr = lane & 15, fq = lane >> 4;
    const bf16_t* Qm = (const bf16_t*)(a.ws + ML_Q); const bf16_t* Km = (const bf16_t*)(a.ws + ML_K);
    const bf16_t* KT = (const bf16_t*)(a.ws + ML_KT); const bf16_t* VT = (const bf16_t*)(a.ws + ML_VT);
    const float* GT = (const float*)(a.ws + ML_GT);
    bf16_t* HS = (bf16_t*)(a.ws + (VAR ? WS_Y : ML_HS));
    char* sQ = lds;
    char* sK = lds + 16384;
    char* sS = sK;
    char* sKT = lds + 32768;
    char* sVT = lds + 49152;
    char* sCT = lds + 55296;
    float* sRow = (float*)(lds + 67584);
    float* sCol = sRow + 64;
    float* sInt = sCol + 64;
    float* sNrm = sInt + 64;
    float* sWv = sNrm + 64;
    float* sSc = sWv + 64;
    for (int u = blockIdx.x; u < 512; u += gridDim.x) {
        const int xc_ = u & 7, s_ = u >> 3, bh_ = ((s_ >> 4) << 3) + xc_;
        const int sl = s_ & 7, dir = (s_ >> 3) & 1, head = bh_ & 3, b = bh_ >> 2;
        auto chunk_t0 = [&](int ci) {
            const int seg = ci >= 4, L = seg ? SEQ : CTXL, nch = L / 64, jc = seg ? ci - 4 : ci;
            const int oc = dir ? nch - 1 - jc : jc;
            return (seg ? b * SEQ : NLAT + b * CTXL) + oc * 64;
        };
        u32x4 pq[4], pk[4], pkt[4], pvt;
        float g_bc = 0.f, g_av = 0.f, g_pm = 0.f;
        auto load_tiles = [&](int t0) {
            const int tid = opaque_tid();
#pragma unroll
            for (int i = 0; i < 4; ++i) {
                const int idx = tid + i * NTHR, row = idx >> 4, c = (idx & 15) ^ (row & 15);
                pq[i] = *(const u32x4*)(Qm + (size_t)(t0 + row) * 512 + head * 128 + c * 8);
                pk[i] = *(const u32x4*)(Km + (size_t)(t0 + row) * 512 + head * 128 + c * 8);
            }
#pragma unroll
            for (int i = 0; i < 4; ++i) {
                const int idx = tid + i * NTHR, row = idx >> 3, c = (idx & 7) ^ (row & 7);
                pkt[i] = *(const u32x4*)(KT + (size_t)(head * 128 + row) * NTOK + t0 + c * 8);
            }
            { const int row = tid >> 3, c = (tid & 7) ^ (row & 7); pvt = *(const u32x4*)(VT + (size_t)(head * 256 + sl * 32 + row) * NTOK + t0 + c * 8); }
        };
        auto load_gates = [&](int ci) {
            if (wave == 0) { const float* g = (const float*)(a.ws + WS_GS) + ((size_t)u * 36 + ci) * 192 + lane; g_bc = g[0]; g_av = g[64]; g_pm = g[128]; }
        };
        auto store_tiles = [&]() {
            const int tid = opaque_tid();
#pragma unroll
            for (int i = 0; i < 4; ++i) { *(u32x4*)(sQ + (tid + i * NTHR) * 16) = pq[i]; *(u32x4*)(sK + (tid + i * NTHR) * 16) = pk[i]; *(u32x4*)(sKT + (tid + i * NTHR) * 16) = pkt[i]; }
            *(u32x4*)(sVT + tid * 16) = pvt;
        };
        auto gate_scalars = [&]() {
            const int s = dir ? 63 - lane : lane;
            const float bc = g_bc, av = g_av, pm = g_pm;
            const float mst = sSc[1];
            const float mm = fmaxf(mst, pm);
            sRow[s] = -mm;
            sCol[s] = av;
            sInt[s] = fexp(mst - mm);
            sNrm[s] = fexp(-(bc + mm));
            const float mmL = __shfl(mm, 63), bL = __shfl(bc, 63);
            sWv[s] = fexp(av - mmL);
            if (lane == 0) { sSc[0] = fexp(mst - mmL); sSc[1] = bL + mmL; }
        };
#pragma unroll 1
        for (int ci = wave; ci < 36; ci += 4) {
            const int t0 = chunk_t0(ci);
            const int s = dir ? 63 - lane : lane;
            const float ig = GT[(size_t)(t0 + s) * 16 + dir * 8 + head];
            const float fg = GT[(size_t)(t0 + s) * 16 + dir * 8 + 4 + head];
            const float lf = fminf(fg, 0.f) - __logf(1.f + fexp(-fabsf(fg)));
            float bc = lf;
#pragma unroll
            for (int d = 1; d < 64; d <<= 1) { const float o = __shfl_up(bc, d); if (lane >= d) bc += o; }
            const float av = ig - bc;
            float pm = av;
#pragma unroll
            for (int d = 1; d < 64; d <<= 1) { const float o = __shfl_up(pm, d); if (lane >= d) pm = fmaxf(pm, o); }
            float* g = (float*)(a.ws + WS_GS) + ((size_t)u * 36 + ci) * 192 + lane; g[0] = bc; g[64] = av; g[128] = pm;
        }
        __syncthreads();
        for (int i = tid; i < 12288 / 16; i += NTHR) *(u32x4*)(sCT + i * 16) = (u32x4){0u, 0u, 0u, 0u};
        for (int i = tid; i < 16 * 8; i += NTHR) {
            const int row = 32 + (i >> 3), c = i & 7;
            const unsigned v = row == 32 ? 0x3f803f80u : 0u;
            *(u32x4*)(sVT + swz128(row, c)) = (u32x4){v, v, v, v};
        }
        if (tid == 0) sSc[1] = -1e30f;
        f32x4 accC[2][3];
#pragma unroll
        for (int i = 0; i < 2; ++i)
#pragma unroll
            for (int jn = 0; jn < 3; ++jn) accC[i][jn] = (f32x4){0.f, 0.f, 0.f, 0.f};
        load_tiles(chunk_t0(0));
        __syncthreads();
        load_gates(0);
        store_tiles();
        if (wave == 0) gate_scalars();
        __syncthreads();
#pragma unroll 1
        for (int ci = 0; ci < 36; ++ci) {
            const int t0 = chunk_t0(ci);
            if (!(VAR & 8) && ci + 1 < 36) { load_tiles(chunk_t0(ci + 1)); load_gates(ci + 1); }
            f32x4 sacc[4];
#pragma unroll
            for (int jt = 0; jt < 4; ++jt) sacc[jt] = (f32x4){0.f, 0.f, 0.f, 0.f};
#pragma unroll
            for (int kk = 0; kk < 4; ++kk) {
                const bf16x8 qf = ldsv8(sQ + swz256(wave * 16 + fr, kk * 4 + fq));
#pragma unroll
                for (int jt = 0; jt < 4; ++jt) sacc[jt] = mfma16(ldsv8(sK + swz256(jt * 16 + fr, kk * 4 + fq)), qf, sacc[jt]);
            }
            lds_barrier();
            {
                const int tq = wave * 16 + fr;
                const float rt = sRow[tq];
#pragma unroll
                for (int jt = 0; jt < 4; ++jt) {
                    const f32x4 cl = *(const f32x4*)(sCol + jt * 16 + fq * 4);
                    f32x4 v;
#pragma unroll
                    for (int e = 0; e < 4; ++e) {
                        const int s = jt * 16 + fq * 4 + e;
                        const bool ok = dir ? (s >= tq) : (s <= tq);
                        v[e] = ok ? sacc[jt][e] * fexp(rt + cl[e]) : 0.f;
                    }
                    u32x2 pv; pv[0] = pk2(v[0], v[1]); pv[1] = pk2(v[2], v[3]);
                    *(u32x2*)(sS + swz128(tq, jt * 2 + (fq >> 1)) + (fq & 1) * 8) = pv;
                }
            }
            lds_barrier();
            if (!(VAR & 2)) {
                f32x4 n1[3], n2[3];
#pragma unroll
                for (int jt = 0; jt < 3; ++jt) { n1[jt] = (f32x4){0.f, 0.f, 0.f, 0.f}; n2[jt] = (f32x4){0.f, 0.f, 0.f, 0.f}; }
#pragma unroll
                for (int kk = 0; kk < 2; ++kk) {
                    const bf16x8 sf = ldsv8(sS + swz128(wave * 16 + fr, kk * 4 + fq));
#pragma unroll
                    for (int jt = 0; jt < 3; ++jt) n1[jt] = mfma16(ldsv8(sVT + swz128(jt * 16 + fr, kk * 4 + fq)), sf, n1[jt]);
                }
#pragma unroll
                for (int kk = 0; kk < 4; ++kk) {
                    const bf16x8 qf = ldsv8(sQ + swz256(wave * 16 + fr, kk * 4 + fq));
#pragma unroll
                    for (int jt = 0; jt < 3; ++jt) n2[jt] = mfma16(ldsv8(sCT + swz256(jt * 16 + fr, kk * 4 + fq)), qf, n2[jt]);
                }
                const int tq = wave * 16 + fr;
                const float it = sInt[tq];
                float den = n1[2][0] + it * n2[2][0];
                den = __shfl(den, fr);
                const float dn = fmaxf(fabsf(den), sNrm[tq]);
                const float inv = rcpf_(dn);
                bf16_t* hp = HS + (size_t)dir * NTOK * D + (size_t)(t0 + tq) * D + head * 256 + sl * 32 + fq * 4;
#pragma unroll
                for (int jt = 0; jt < 2; ++jt) {
                    f32x4 v;
#pragma unroll
                    for (int e = 0; e < 4; ++e) v[e] = (n1[jt][e] + it * n2[jt][e]) * inv;
                    st_bf4(hp + jt * 16, v);
                }
            }
            if (!(VAR & 4)) {
                const float decay = sSc[0];
#pragma unroll
                for (int i = 0; i < 2; ++i)
#pragma unroll
                    for (int jn = 0; jn < 3; ++jn) accC[i][jn] *= decay;
#pragma unroll
                for (int kk = 0; kk < 2; ++kk) {
                    bf16x8 vf[3];
#pragma unroll
                    for (int jn = 0; jn < 3; ++jn) vf[jn] = ldsv8(sVT + swz128(jn * 16 + fr, kk * 4 + fq));
                    const f32x4 w0 = *(const f32x4*)(sWv + kk * 32 + fq * 8), w1 = *(const f32x4*)(sWv + kk * 32 + fq * 8 + 4);
#pragma unroll
                    for (int i = 0; i < 2; ++i) {
                        const u32x4 kr = *(const u32x4*)(sKT + swz128((wave * 2 + i) * 16 + fr, kk * 4 + fq));
                        u32x4 ks;
                        ks[0] = pk2(lof(kr[0]) * w0[0], hif(kr[0]) * w0[1]); ks[1] = pk2(lof(kr[1]) * w0[2], hif(kr[1]) * w0[3]);
                        ks[2] = pk2(lof(kr[2]) * w1[0], hif(kr[2]) * w1[1]); ks[3] = pk2(lof(kr[3]) * w1[2], hif(kr[3]) * w1[3]);
                        const bf16x8 kf = __builtin_bit_cast(bf16x8, ks);
#pragma unroll
                        for (int jn = 0; jn < 3; ++jn) accC[i][jn] = mfma16(kf, vf[jn], accC[i][jn]);
                    }
                }
            }
            lds_barrier();
#pragma unroll
            for (int i = 0; i < 2; ++i)
#pragma unroll
                for (int jn = 0; jn < 3; ++jn) {
                    const int dd = (wave * 2 + i) * 16 + fq * 4, ee = jn * 16 + fr;
                    u32x2 pv; pv[0] = pk2(accC[i][jn][0], accC[i][jn][1]); pv[1] = pk2(accC[i][jn][2], accC[i][jn][3]);
                    *(u32x2*)(sCT + swz256(ee, dd >> 3) + (dd & 7) * 2) = pv;
                }
            if (ci + 1 < 36) {
                if (!(VAR & 8)) store_tiles();
                if (wave == 0 && !(VAR & 16)) gate_scalars();
            }
            lds_barrier();
        }
    }
}

DI void phase_ml_readout(const Args& a) {
    const int tid = threadIdx.x, lane = tid & 63, wave = tid >> 6;
    const bf16_t* H0 = (const bf16_t*)(a.ws + ML_HS); const bf16_t* H1 = H0 + (size_t)NTOK * D;
    const bf16_t* OG = (const bf16_t*)(a.ws + ML_OG); bf16_t* A2 = (bf16_t*)(a.ws + ML_A2);
    const float* on = a.in[24];
    for (int t = blockIdx.x * 4 + wave; t < NTOK; t += gridDim.x * 4) {
        const size_t off = (size_t)t * D + lane * 16;
        const u32x4 a0 = *(const u32x4*)(H0 + off), a1 = *(const u32x4*)(H0 + off + 8);
        const u32x4 b0 = *(const u32x4*)(H1 + off), b1 = *(const u32x4*)(H1 + off + 8);
        float v[16];
#pragma unroll
        for (int e = 0; e < 4; ++e) {
            v[2 * e] = lof(a0[e]) + lof(b0[e]); v[2 * e + 1] = hif(a0[e]) + hif(b0[e]);
            v[8 + 2 * e] = lof(a1[e]) + lof(b1[e]); v[8 + 2 * e + 1] = hif(a1[e]) + hif(b1[e]);
        }
        float ss = 0.f;
#pragma unroll
        for (int e = 0; e < 16; ++e) ss += v[e] * v[e];
        ss += __shfl_xor(ss, 1); ss += __shfl_xor(ss, 2); ss += __shfl_xor(ss, 4); ss += __shfl_xor(ss, 8);
        const float rs = rsqrtf(ss * (1.f / 256.f) + EPS);
        const u32x4 g0 = *(const u32x4*)(OG + off), g1 = *(const u32x4*)(OG + off + 8);
        const float* onp = on + lane * 16;
        u32x4 o0, o1;
#pragma unroll
        for (int e = 0; e < 4; ++e) {
            o0[e] = pk2(v[2 * e] * rs * onp[2 * e] * lof(g0[e]), v[2 * e + 1] * rs * onp[2 * e + 1] * hif(g0[e]));
            o1[e] = pk2(v[8 + 2 * e] * rs * onp[8 + 2 * e] * lof(g1[e]), v[8 + 2 * e + 1] * rs * onp[8 + 2 * e + 1] * hif(g1[e]));
        }
        *(u32x4*)(A2 + off) = o0; *(u32x4*)(A2 + off + 8) = o1;
    }
}

DI void phase_ml_out(const Args& a, int li) {
    gemm_dense_phase((const bf16_t*)(a.ws + ML_A2), D, NTOK, (const bf16_t*)(a.ws + W_MLOUT), 1024, 1024,
        [&](int m0, int n0, const f32x4 (&acc)[4][4]) { epi_resid_f32(a, li, m0, n0, acc); });
}

template <int STAGE>
DI void phase_moe(const Args& a, int li) {
    const int tid = threadIdx.x, lane = tid & 63, wave = tid >> 6;
    const int fr = lane & 15, fq = lane >> 4, wm = wave >> 1, wn = wave & 1;
    const int* cnt = (const int*)(a.ws + WS_CTL + CTL_CNT) + li * 64;
    const int* list = (const int*)(a.ws + WS_LIST);
    const float* wsl = (const float*)(a.ws + WS_WSLOT);
    const bf16_t* F = (const bf16_t*)(a.ws + WS_H);
    bf16_t* HM = (bf16_t*)(a.ws + WS_HMID); bf16_t* Y = (bf16_t*)(a.ws + WS_Y);
    int* pre = (int*)(lds + LDS_AUX);
    int* srowb = pre + 16;
    const int xc = blockIdx.x & 7, rank = blockIdx.x >> 3, nrank = gridDim.x >> 3;
    __syncthreads();
    if (tid == 0) { int s = 0; for (int i = 0; i < 8; ++i) { pre[i] = s; s += (cnt[xc + 8 * i] + 127) >> 7; } pre[8] = s; }
    __syncthreads();
    const int T = pre[8];
    constexpr int NTN = STAGE == 0 ? 4 : 8;
    constexpr int KK = STAGE == 0 ? 1024 : 256;
    const int total = T * NTN;
    int e = 0, r0 = 0, ce = 0, nt = 0, cur = 0;
    auto decode = [&](int u) {
        const int ti = u / NTN; nt = u % NTN;
        int ei = 0;
#pragma unroll 1
        for (int s = 4; s > 0; s >>= 1) if (pre[ei + s] <= ti) ei += s;
        e = xc + 8 * ei; r0 = (ti - pre[ei]) * 128; ce = cnt[e];
    };
    GemmPipe g;
    auto prep = [&](int buf) {
        int* srow = srowb + buf * 128;
        if (tid < 128) srow[tid] = list[(size_t)e * NTOK + min(r0 + tid, ce - 1)];
        __syncthreads();
        if (STAGE == 0) g.setup([&](int r) { return F + (size_t)(srow[r] >> 1) * D; }, (const bf16_t*)(a.ws + W_GU) + ((size_t)(li * 64 + e) * 512 + nt * 128) * 1024, 1024);
        else g.setup([&](int r) { return HM + (size_t)srow[r] * 256; }, (const bf16_t*)(a.ws + W_DN) + ((size_t)(li * 64 + e) * 1024 + nt * 128) * 256, 256);
        g.issue(0, 0);
    };
    int u = rank;
    if (u < total) { decode(u); prep(cur); }
    while (u < total) {
        f32x4 acc[4][4];
        g.run(KK, acc);
        const int cr0 = r0, cce = ce, cnt_ = nt;
        const int* srow = srowb + cur * 128;
        u += nrank;
        if (u < total) { decode(u); prep(cur ^ 1); }
        if (STAGE == 0) {
            __syncthreads();
            {
                const int tz = opaque_tid();
#pragma unroll
                for (int i = 0; i < 4; ++i) {
                    const int m = lane_m(tz, i);
#pragma unroll
                    for (int p = 0; p < 2; ++p) {
                        const int c = (((tz >> 6) & 1) * 2 + p) * 16 + ((tz >> 4) & 3) * 4;
                        f32x4 v;
#pragma unroll
                        for (int x = 0; x < 4; ++x) { const float gg = acc[i][2 * p][x]; v[x] = gg * rcpf_(1.f + fexp(-gg)) * acc[i][2 * p + 1][x]; }
                        u32x2 o; o[0] = pk2(v[0], v[1]); o[1] = pk2(v[2], v[3]);
                        *(u32x2*)(lds + EPI_OFF + m * 128 + (((c >> 3) ^ (m & 7)) << 4) + (c & 4) * 2) = o;
                    }
                }
            }
            __syncthreads();
            {
                const int tz = opaque_tid();
#pragma unroll
                for (int it = 0; it < 4; ++it) {
                    const int idx = tz + it * NTHR, row = idx >> 3, ch = idx & 7;
                    const u32x4 v = *(const u32x4*)(lds + EPI_OFF + row * 128 + ((ch ^ (row & 7)) << 4));
                    if (cr0 + row < cce) *(u32x4*)(HM + (size_t)srow[row] * 256 + cnt_ * 64 + ch * 8) = v;
                }
            }
        } else {
            float wrow[4];
            {
                const int tz = opaque_tid();
#pragma unroll
                for (int i = 0; i < 4; ++i) wrow[i] = wsl[srow[lane_m(tz, i)]];
            }
            __syncthreads();
            epi_stage_bf16(acc, [&](int i, int, const f32x4 v) { return v * wrow[i]; });
            __syncthreads();
            epi_flush_bf16([&](int row) { return Y + (size_t)srow[row] * D + cnt_ * 128; }, [&](int row) { return cr0 + row < cce; });
        }
        cur ^= 1;
    }
    __syncthreads();
}

#ifndef DBG_GPROBE
#define DBG_GPROBE -1
#endif
template <int PM>
DI void phase_gemm_probe(const Args& a) {
    const bf16_t* A = (const bf16_t*)(a.ws + WS_H); const bf16_t* Bt = (const bf16_t*)(a.ws + W_RGIN);
    float* dummy = (float*)(a.ws + RG_A2);
    const int mt = 144, nt = 16, K = 1024;
    GemmPipe g;
    __syncthreads();
    for (int u = blockIdx.x; u < mt * nt; u += gridDim.x) {
        const int m0 = (u % mt) * 128, n0 = (u / mt) * 128;
        g.setup([&](int r) { return A + (size_t)(m0 + r) * 1024; }, Bt + (size_t)n0 * K, K);
        if (PM & 1) g.issue(0, 0);
        f32x4 acc[4][4];
        g.run_probe<PM>(K, acc);
        float s = 0.f;
#pragma unroll
        for (int i = 0; i < 4; ++i)
#pragma unroll
            for (int j = 0; j < 4; ++j) s += acc[i][j][0] + acc[i][j][1] + acc[i][j][2] + acc[i][j][3];
        if (s == 12345.678f) dummy[threadIdx.x] = s;
        if (PM & 8) {
            bf16_t* Yd = (bf16_t*)(a.ws + WS_Y);
            const int lane = threadIdx.x & 63, wave = threadIdx.x >> 6;
            const int mb = m0 + (wave >> 1) * 64 + (lane & 15), nb = n0 + (wave & 1) * 64 + (lane >> 4) * 4;
#pragma unroll
            for (int i = 0; i < 4; ++i)
#pragma unroll
                for (int j = 0; j < 4; ++j) {
                    f32x4 v = acc[i][j];
                    if (PM & 16) { v[0] = gelu_tanh(v[0]); v[1] = gelu_tanh(v[1]); v[2] = gelu_tanh(v[2]); v[3] = gelu_tanh(v[3]); }
                    st_bf4(Yd + (size_t)(mb + i * 16) * 2048 + nb + j * 16, v);
                }
        }
        __syncthreads();
    }
}

#ifndef DBG_STOP
#define DBG_STOP 99
#endif
#ifndef DBG_OFF
#define DBG_OFF 0
#endif
DI void phase_dbg(const Args& a) {
    const size_t n = (size_t)NLAT * D;
    const float* X = (const float*)(a.ws + WS_X);
    const bf16_t* B = (const bf16_t*)(a.ws + (size_t)DBG_OFF);
    for (size_t i = (size_t)blockIdx.x * NTHR + threadIdx.x; i < n; i += (size_t)gridDim.x * NTHR)
        a.out[i] = DBG_OFF ? bf2f(B[i]) : X[i];
}

constexpr int NPH = 34;
__global__ void __launch_bounds__(NTHR, 2) fwd(const Args a) {
    if (threadIdx.x == 0) *(uint4*)(lds + LDS_BARW) = make_uint4(0u, 0u, 0u, 0u);
    __syncthreads();
    XcdBarrier bar;
    const bool multi = (a.ph_hi - a.ph_lo) > 1;
    if (multi) bar = xcd_barrier_post((unsigned*)(a.ws + WS_CTL), (volatile LAS unsigned*)(lds + LDS_BARW));
#ifndef DBG_REP
#define DBG_REP -1
#endif
#ifndef DBG_REPN
#define DBG_REPN 3
#endif
#define RUN(id, ...) do { if (a.ph_lo <= (id) && (id) < a.ph_hi) { \
        if ((id) == DBG_REP) { for (int rep_ = 1; rep_ < DBG_REPN; ++rep_) { __VA_ARGS__; xcd_barrier(bar); } } \
        __VA_ARGS__; if ((id) + 1 < a.ph_hi) xcd_barrier(bar); } } while (0)
    RUN(0, phase_prologue(a));
    RUN(1, phase_token_row<0>(a, 0));
    RUN(2, phase_rg_in(a, 0));
    if (DBG_GPROBE >= 0) { RUN(2, phase_gemm_probe<(DBG_GPROBE < 0 ? 7 : DBG_GPROBE)>(a)); }
#ifdef DBG_SCANVAR
    RUN(3, phase_rg_scan<DBG_SCANVAR>(a, 0));
#endif
    RUN(3, phase_rg_scan(a, 0));
    RUN(4, phase_rg_combine(a));
    RUN(5, phase_rg_out(a, 0, 0));
    RUN(6, phase_token_router(a, 0));
    RUN(7, phase_moe<0>(a, 0));
    RUN(8, phase_moe<1>(a, 0));
    RUN(9, phase_token_row<0>(a, 1));
    RUN(10, phase_mla_down(a));
    RUN(11, phase_mla_up(a));
    RUN(12, phase_mla_attn(a));
    RUN(13, phase_mla_out(a, 1));
    RUN(14, phase_token_router(a, 1));
    RUN(15, phase_moe<0>(a, 1));
    RUN(16, phase_moe<1>(a, 1));
    RUN(17, phase_token_row<0>(a, 2));
    RUN(18, phase_ml_in(a));
#ifdef DBG_MLVAR
    RUN(19, phase_ml_scan<DBG_MLVAR>(a));
#endif
    RUN(19, phase_ml_scan(a));
    RUN(20, phase_ml_readout(a));
    RUN(21, phase_ml_out(a, 2));
    RUN(22, phase_token_router(a, 2));
    RUN(23, phase_moe<0>(a, 2));
    RUN(24, phase_moe<1>(a, 2));
    RUN(25, phase_token_row<0>(a, 3));
    RUN(26, phase_rg_in(a, 1));
    RUN(27, phase_rg_scan(a, 1));
    RUN(28, phase_rg_combine(a));
    RUN(29, phase_rg_out(a, 3, 1));
    RUN(30, phase_token_router(a, 3));
    RUN(31, phase_moe<0>(a, 3));
    RUN(32, phase_moe<1>(a, 3));
    RUN(33, phase_token_row<2>(a, 3));
    RUN(34, phase_dbg(a));
#undef RUN
}

static void add_td(Args& a, int& n, int& tile0, const float* src, bf16_t* dst, const float* rscale, long sb, long db, int K, int N, int Npad, int batch, int perm) {
    TDesc& t = a.td[n++];
    t.src = src; t.dst = dst; t.rscale = rscale; t.sb = sb; t.db = db; t.K = K; t.N = N; t.Npad = Npad; t.batch = batch; t.perm = perm;
    t.tiles_k = (K + 127) / 128; t.tiles_n = (Npad + 63) / 64; t.tile0 = tile0;
    tile0 += batch * t.tiles_k * t.tiles_n;
}

extern "C" void kernel_launch(void* const* d_in, const int* in_sizes, int n_in, void* d_out, int out_size, void* d_ws, size_t ws_size, hipStream_t stream) {
    static int grid = 0;
    if (grid == 0) {
        if (n_in != 32 || out_size != NLAT * D || ws_size < WS_END) { fprintf(stderr, "kernel_launch: unexpected sizes (n_in %d out %d ws %zu need %zu)\n", n_in, out_size, ws_size, (size_t)WS_END); grid = -1; return; }
        int dev = 0, cus = 0, per_cu = 0;
        (void)hipGetDevice(&dev);
        (void)hipDeviceGetAttribute(&cus, hipDeviceAttributeMultiprocessorCount, dev);
        if (hipOccupancyMaxActiveBlocksPerMultiprocessor(&per_cu, (const void*)fwd, NTHR, 0) != hipSuccess) per_cu = 0;
        (void)hipGetLastError();
        if (per_cu < 2) fprintf(stderr, "kernel_launch: note: occupancy query reports %d blocks per CU (need 2)\n", per_cu);
        grid = cus * (per_cu >= 2 ? 2 : (per_cu >= 1 ? 1 : 2));
    }
    if (grid < 0) return;
    (void)in_sizes;
    (void)hipMemsetAsync((char*)d_ws + WS_CTL, 0, CTL_BYTES, stream);
    Args a;
    memset(&a, 0, sizeof(a));
    for (int i = 0; i < 32; ++i) a.in[i] = (const float*)d_in[i];
    a.out = (float*)d_out; a.ws = (unsigned char*)d_ws;
    unsigned char* ws = (unsigned char*)d_ws;
    int n = 0, tile0 = 0;
    add_td(a, n, tile0, a.in[8], (bf16_t*)(ws + W_RGIN), nullptr, 1024L * 2048, 2048L * 1024, 1024, 2048, 2048, 2, 0);
    add_td(a, n, tile0, a.in[14], (bf16_t*)(ws + W_RGOUT), nullptr, 1024L * 1024, 1024L * 1024, 1024, 1024, 1024, 2, 0);
    for (int j = 0; j < 2; ++j) for (int dir = 0; dir < 2; ++dir) for (int g = 0; g < 2; ++g)
        add_td(a, n, tile0, a.in[11] + (size_t)((j * 2 + dir) * 2 + g) * 16 * 4096, (bf16_t*)(ws + W_RGG) + (size_t)(j * 2 + dir) * 16 * 8192 + g * 4096, nullptr, 4096, 8192, 64, 64, 64, 16, 0);
    add_td(a, n, tile0, a.in[15], (bf16_t*)(ws + W_MDOWN), nullptr, 0, 0, 1024, 416, 512, 1, 0);
    add_td(a, n, tile0, a.in[18], (bf16_t*)(ws + W_MUQ), a.in[16], 0, 0, 256, 1536, 1536, 1, 0);
    add_td(a, n, tile0, a.in[19], (bf16_t*)(ws + W_MUKV), a.in[17], 0, 0, 128, 2048, 2048, 1, 0);
    add_td(a, n, tile0, a.in[21], (bf16_t*)(ws + W_MO), nullptr, 0, 0, 1024, 1024, 1024, 1, 0);
    add_td(a, n, tile0, a.in[22], (bf16_t*)(ws + W_MLIN), nullptr, 0, 0, 1024, 3088, 3200, 1, 0);
    add_td(a, n, tile0, a.in[25], (bf16_t*)(ws + W_MLOUT), nullptr, 0, 0, 1024, 1024, 1024, 1, 0);
    add_td(a, n, tile0, a.in[30], (bf16_t*)(ws + W_GU), nullptr, 1024L * 512, 512L * 1024, 1024, 512, 512, 64, 1);
    add_td(a, n, tile0, a.in[31], (bf16_t*)(ws + W_DN), nullptr, 256L * 1024, 1024L * 256, 256, 1024, 1024, 64, 0);
    a.ntiles_total = tile0;
    if (n != NTD) { fprintf(stderr, "kernel_launch: descriptor count %d != %d\n", n, NTD); return; }
#if MK_ONE_LAUNCH
    a.ph_lo = 0; a.ph_hi = NPH;
    hipLaunchKernelGGL(fwd, dim3(grid), dim3(NTHR), 0, stream, a);
#else
    for (int ph = 0; ph < NPH && ph <= DBG_STOP; ++ph) {
        a.ph_lo = ph; a.ph_hi = ph + 1;
        hipLaunchKernelGGL(fwd, dim3(grid), dim3(NTHR), 0, stream, a);
    }
    if (DBG_STOP < NPH) { a.ph_lo = 34; a.ph_hi = 35; hipLaunchKernelGGL(fwd, dim3(grid), dim3(NTHR), 0, stream, a); }
#endif
}
```

```cpp
#include <hip/hip_runtime.h>
#include <stdint.h>
#include <string.h>
#include <stdio.h>

#ifndef MK_ONE_LAUNCH
#define MK_ONE_LAUNCH 1
#endif

#define DI __device__ __forceinline__
typedef unsigned short bf16_t;
typedef __attribute__((ext_vector_type(8))) short bf16x8;
typedef __attribute__((ext_vector_type(4))) float f32x4;
typedef __attribute__((ext_vector_type(16))) float f32x16;
typedef __attribute__((ext_vector_type(2))) float f32x2;
typedef __attribute__((ext_vector_type(2))) __bf16 bfx2;
typedef __attribute__((ext_vector_type(4))) unsigned u32x4;
typedef __attribute__((ext_vector_type(2))) unsigned u32x2;

constexpr int D = 1024, NB = 8, SEQ = 2048, CTXL = 256;
constexpr int NLAT = NB * SEQ, NCTX = NB * CTXL, NTOK = NLAT + NCTX;
constexpr int NKEY = CTXL + SEQ;
constexpr int NTHR = 256;
constexpr int LDS_BYTES = 73728;
constexpr int LDS_AUX = 65536;
constexpr int LDS_BARW = LDS_BYTES - 16;
constexpr float EPS = 1e-6f;

constexpr size_t al256(size_t x) { return (x + 255) & ~(size_t)255; }
constexpr size_t WS_CTL = 0;
constexpr size_t CTL_BYTES = 65536;
constexpr size_t CTL_CNT = 16384;
constexpr size_t CTL_ROPE = 32768;
constexpr size_t WS_MOD = WS_CTL + CTL_BYTES;
constexpr size_t WS_X = al256(WS_MOD + 4 * 9 * 6144 * 4);
constexpr size_t WS_H = al256(WS_X + (size_t)NTOK * D * 4);
constexpr size_t WS_SCR = al256(WS_H + (size_t)NTOK * D * 2);
constexpr size_t SCR_BYTES = (size_t)256 << 20;
constexpr size_t TOKD2 = (size_t)NTOK * D * 2;
constexpr size_t RG_G = WS_SCR, RG_U = RG_G + TOKD2, RG_HS = RG_U + TOKD2, RG_A2 = RG_HS + 2 * TOKD2;
constexpr size_t MLA_CQ = WS_SCR;
constexpr size_t MLA_CKV = MLA_CQ + (size_t)NTOK * 256 * 2;
constexpr size_t MLA_KR = MLA_CKV + (size_t)NTOK * 128 * 2;
constexpr size_t MLA_Q = MLA_KR + (size_t)NTOK * 32 * 4;
constexpr size_t MLA_K = MLA_Q + (size_t)NTOK * 1536 * 2;
constexpr size_t MLA_VT = MLA_K + (size_t)NB * 16 * NKEY * 96 * 2;
constexpr size_t MLA_O = MLA_VT + (size_t)NB * 16 * 64 * NKEY * 2;
constexpr size_t MLA_END = MLA_O + TOKD2;
constexpr size_t ML_Q = WS_SCR;
constexpr size_t ML_K = ML_Q + (size_t)NTOK * 512 * 2;
constexpr size_t ML_KT = ML_K + (size_t)NTOK * 512 * 2;
constexpr size_t ML_VT = ML_KT + (size_t)NTOK * 512 * 2;
constexpr size_t ML_OG = ML_VT + TOKD2;
constexpr size_t ML_GT = ML_OG + TOKD2;
constexpr size_t ML_HS = ML_GT + (size_t)NTOK * 16 * 4;
constexpr size_t ML_A2 = ML_HS + 2 * TOKD2;
constexpr size_t ML_END = ML_A2 + TOKD2;
static_assert(RG_A2 + TOKD2 <= WS_SCR + SCR_BYTES && MLA_END <= WS_SCR + SCR_BYTES && ML_END <= WS_SCR + SCR_BYTES, "scratch");
constexpr size_t WS_LIST = WS_SCR + SCR_BYTES;
constexpr size_t WS_WSLOT = al256(WS_LIST + (size_t)64 * NTOK * 4);
constexpr size_t WS_HMID = al256(WS_WSLOT + (size_t)2 * NTOK * 4);
constexpr size_t WS_Y = al256(WS_HMID + (size_t)2 * NTOK * 256 * 2);
constexpr size_t WS_W = al256(WS_Y + (size_t)2 * NTOK * D * 2);
constexpr size_t W_RGIN = WS_W;
constexpr size_t W_RGOUT = W_RGIN + (size_t)2 * 2048 * 1024 * 2;
constexpr size_t W_RGG = W_RGOUT + (size_t)2 * 1024 * 1024 * 2;
constexpr size_t W_MDOWN = W_RGG + (size_t)2 * 2 * 16 * 128 * 64 * 2;
constexpr size_t W_MUQ = W_MDOWN + (size_t)512 * 1024 * 2;
constexpr size_t W_MUKV = W_MUQ + (size_t)1536 * 256 * 2;
constexpr size_t W_MO = W_MUKV + (size_t)2048 * 128 * 2;
constexpr size_t W_MLIN = W_MO + (size_t)1024 * 1024 * 2;
constexpr size_t W_MLOUT = W_MLIN + (size_t)3200 * 1024 * 2;
constexpr size_t W_RT = W_MLOUT + (size_t)1024 * 1024 * 2;
constexpr size_t W_GU = al256(W_RT + (size_t)4 * 2 * 80 * 1024 * 2);
constexpr size_t W_DN = W_GU + (size_t)256 * 512 * 1024 * 2;
constexpr size_t WS_GS = W_DN + (size_t)256 * 1024 * 256 * 2;
constexpr size_t WS_END = WS_GS + (size_t)512 * 36 * 3 * 64 * 4;

struct TDesc {
    const float* src; bf16_t* dst; const float* rscale;
    long sb, db;
    int K, N, Npad, batch;
    int perm, tiles_k, tiles_n, tile0;
};
constexpr int NTD = 18;
struct Args {
    const float* in[32];
    float* out;
    unsigned char* ws;
    TDesc td[NTD];
    int ntiles_total, ph_lo, ph_hi, pad0;
};

DI float bf2f(bf16_t v) { return __uint_as_float((unsigned)v << 16); }
DI unsigned pk2(float a, float b) { f32x2 v = {a, b}; bfx2 r = __builtin_convertvector(v, bfx2); return __builtin_bit_cast(unsigned, r); }
DI bf16_t f2bf(float a) { return (bf16_t)(pk2(a, 0.f) & 0xffffu); }
DI float lof(unsigned u) { return __uint_as_float(u << 16); }
DI float hif(unsigned u) { return __uint_as_float(u & 0xffff0000u); }
DI float rcpf_(float x) { return __builtin_amdgcn_rcpf(x); }
DI float fexp(float x) { return __builtin_amdgcn_exp2f(x * 1.4426950408889634f); }
DI float sigmoidf_(float x) { return rcpf_(1.f + fexp(-x)); }
DI float gelu_tanh(float x) { float u = 0.7978845608028654f * (x + 0.044715f * x * x * x); float e = fexp(2.f * u); return x * (1.f - rcpf_(e + 1.f)); }
DI int tok_modrow(int t) { return t < NLAT ? (t >> 11) : 8; }
DI void dma16(const void* g, char* l) { __builtin_amdgcn_global_load_lds((const unsigned*)g, (unsigned*)l, 16, 0, 0); }
DI void wait_vm0() { asm volatile("s_waitcnt vmcnt(0)" ::: "memory"); }
DI void lds_barrier() { asm volatile("s_waitcnt lgkmcnt(0)" ::: "memory"); __builtin_amdgcn_s_barrier(); asm volatile("" ::: "memory"); }
DI int swz128(int row, int chunk) { return row * 128 + ((chunk ^ (row & 7)) << 4); }
DI int swz256(int row, int chunk) { return row * 256 + ((chunk ^ (row & 15)) << 4); }
DI f32x4 mfma16(bf16x8 a, bf16x8 b, f32x4 c) { return __builtin_amdgcn_mfma_f32_16x16x32_bf16(a, b, c, 0, 0, 0); }
DI f32x16 mfma32(bf16x8 a, bf16x8 b, f32x16 c) { return __builtin_amdgcn_mfma_f32_32x32x16_bf16(a, b, c, 0, 0, 0); }
DI bf16x8 ldsv8(const char* p) { return *(const bf16x8*)p; }
DI void st_bf4(bf16_t* p, const f32x4 v) { u32x2 o; o[0] = pk2(v[0], v[1]); o[1] = pk2(v[2], v[3]); *(u32x2*)p = o; }

__shared__ __attribute__((aligned(16))) char lds[LDS_BYTES];

#define XB_TMO      128
#define XB_XCNT(j)  (256  + 64 * (j))
#define XB_XSUB(j)  (1280 + 64 * (j))
#define XB_XGEN(j)  (2304 + 64 * (j))
#define XB_TOP      3328
#define XB_TOPGEN   3392
#define XCD_BAR_WORDS 3456
#define XB_SPIN_CAP (1u << 22)
#define LAS __attribute__((address_space(3)))
DI unsigned xb_ld(unsigned* p)              { return __hip_atomic_load(p, __ATOMIC_RELAXED, __HIP_MEMORY_SCOPE_AGENT); }
DI unsigned xb_add(unsigned* p, unsigned v) { return __hip_atomic_fetch_add(p, v, __ATOMIC_RELAXED, __HIP_MEMORY_SCOPE_AGENT); }
DI unsigned xb_xcc_id() { return (unsigned)__builtin_amdgcn_s_getreg((3 << 11) | 20) & 0xFu; }
#define XB_SPIN(cond, bar) do { unsigned _sp = 0; while (cond) { __builtin_amdgcn_s_sleep(1); \
    if ((++_sp & 255u) == 0u) { if (xb_ld(&(bar)[XB_TMO])) break; if (_sp > XB_SPIN_CAP) { atomicAdd(&(bar)[XB_TMO], 1u); break; } } } } while (0)
struct XcdBarrier { unsigned* bar; unsigned x; volatile LAS unsigned* st; };
DI XcdBarrier xcd_barrier_post(unsigned* bar, volatile LAS unsigned* st) {
    XcdBarrier b; b.bar = bar; b.x = xb_xcc_id(); b.st = st;
    if (threadIdx.x == 0) (void)xb_add(&bar[XB_XCNT(b.x)], 1u);
    return b;
}
DI void xcd_barrier_complete(unsigned* bar, unsigned x, unsigned& nloc, unsigned& nx) {
    const unsigned G = gridDim.x * gridDim.y * gridDim.z;
    unsigned sum, cnt, mine, sp = 0u;
    for (;;) {
        sum = 0u; cnt = 0u; mine = 0u;
#pragma unroll
        for (unsigned j = 0; j < 16; ++j) { const unsigned c = xb_ld(&bar[XB_XCNT(j)]); sum += c; cnt += (c > 0u) ? 1u : 0u; mine = (j == x) ? c : mine; }
        if (sum == G) break;
        __builtin_amdgcn_s_sleep(1);
        if ((++sp & 255u) == 0u) { if (xb_ld(&bar[XB_TMO])) break; if (sp > XB_SPIN_CAP) { atomicAdd(&bar[XB_TMO], 1u); break; } }
    }
    nloc = mine > 0u ? mine : 1u; nx = cnt > 0u ? cnt : 1u;
}
DI void xcd_barrier(const XcdBarrier& b) {
    asm volatile("s_waitcnt vmcnt(0)" ::: "memory");
    __syncthreads();
    if (threadIdx.x == 0) {
        unsigned* bar = b.bar;
        __builtin_amdgcn_s_waitcnt(0);
        unsigned nloc = b.st[0], nx = b.st[1];
        if (nloc == 0u) { xcd_barrier_complete(bar, b.x, nloc, nx); b.st[0] = nloc; b.st[1] = nx; }
        const unsigned old = xb_add(&bar[XB_XSUB(b.x)], 1u);
        const unsigned gen = old / nloc;
        if (old + 1u == (gen + 1u) * nloc) {
            __builtin_amdgcn_fence(__ATOMIC_RELEASE, "agent");
            asm volatile("s_waitcnt vmcnt(0)" ::: "memory");
            const unsigned og = xb_add(&bar[XB_TOP], 1u);
            const unsigned tg = og / nx;
            if (og + 1u == (tg + 1u) * nx) xb_add(&bar[XB_TOPGEN], 1u);
            else XB_SPIN(xb_ld(&bar[XB_TOPGEN]) == tg, bar);
            __builtin_amdgcn_fence(__ATOMIC_ACQUIRE, "agent");
            xb_add(&bar[XB_XGEN(b.x)], 1u);
            asm volatile("s_waitcnt vmcnt(0)" ::: "memory");
        } else {
            XB_SPIN(xb_ld(&bar[XB_XGEN(b.x)]) == gen, bar);
            __builtin_amdgcn_fence(__ATOMIC_ACQUIRE, "agent");
            asm volatile("s_waitcnt vmcnt(0)" ::: "memory");
        }
    }
    __syncthreads();
}

typedef __attribute__((ext_vector_type(4))) short s16x4;
typedef __attribute__((address_space(3))) s16x4 lds_s16x4;
DI s16x4 lds_tr(const char* p) { return __builtin_amdgcn_ds_read_tr16_b64_v4i16((lds_s16x4*)p); }
DI int trswz(int row) { return ((row & 3) << 2) | ((row >> 2) & 3); }
struct CvTile { const float* src; bf16_t* dst; int K, N, perm, k0, n0; };
DI CvTile moe_cv_tile(const Args& a, const int L, const int t) {
    CvTile c;
    const int e = t / 96, r = t - e * 96;
    if (r < 64) {
        c.src = a.in[30] + (size_t)(L * 64 + e) * 1024 * 512; c.dst = (bf16_t*)(a.ws + W_GU) + (size_t)(L * 64 + e) * 512 * 1024;
        c.K = 1024; c.N = 512; c.perm = 1; c.k0 = (r & 7) * 128; c.n0 = (r >> 3) * 64;
    } else {
        const int r2 = r - 64;
        c.src = a.in[31] + (size_t)(L * 64 + e) * 256 * 1024; c.dst = (bf16_t*)(a.ws + W_DN) + (size_t)(L * 64 + e) * 1024 * 256;
        c.K = 256; c.N = 1024; c.perm = 0; c.k0 = (r2 & 1) * 128; c.n0 = (r2 >> 1) * 64;
    }
    return c;
}
DI void cv_load(const CvTile& c, f32x4 (&L0)[4], f32x4 (&L1)[4]) {
    const int tid = threadIdx.x, c4 = tid & 15, kr = tid >> 4;
    const float* p = c.src + (size_t)(c.k0 + 2 * kr) * c.N + c.n0 + 4 * c4;
#pragma unroll
    for (int i = 0; i < 4; ++i) { L0[i] = *(const f32x4*)(p + (size_t)(32 * i) * c.N); L1[i] = *(const f32x4*)(p + (size_t)(32 * i + 1) * c.N); }
}
DI void cv_pack(unsigned* st, const f32x4 (&L0)[4], const f32x4 (&L1)[4]) {
    const int tid = threadIdx.x, c4 = tid & 15, kr = tid >> 4;
#pragma unroll
    for (int i = 0; i < 4; ++i)
#pragma unroll
        for (int j = 0; j < 4; ++j) st[(4 * c4 + j) * 68 + 16 * i + kr] = pk2(L0[i][j], L1[i][j]);
}
DI void cv_flush(const CvTile& c, const unsigned* st) {
    const int tid = threadIdx.x;
#pragma unroll
    for (int i = 0; i < 4; ++i) {
        const int id = tid + i * 256, n = id >> 4, kc = id & 15;
        const u32x4 o = *(const u32x4*)(st + n * 68 + kc * 4);
        int nd = c.n0 + n;
        if (c.perm) { const int cc = nd & 255, up = nd >> 8; nd = ((cc >> 4) << 5) + (up << 4) + (cc & 15); }
        *(u32x4*)(c.dst + (size_t)nd * c.K + c.k0 + kc * 8) = o;
    }
}

DI void phase_prologue(const Args& a) {
    const int tid = threadIdx.x;
    const int n_ada = 384, n_rt = 320;
    const int total = n_ada + n_rt;
    float* sc = (float*)lds;
    for (int u = blockIdx.x; u < total; u += gridDim.x) {
        __syncthreads();
        if (u < n_ada) {
            const float* c = a.in[1]; const float* cc = a.in[3];
            for (int i = tid; i < 9 * 1024; i += NTHR) {
                float v = i < 8192 ? c[i] : cc[i - 8192];
                sc[i] = v / (1.f + __expf(-v));
            }
            __syncthreads();
            const int n = u * 64 + (tid & 63), li = n / 6144, nn = n - li * 6144, kq = tid >> 6;
            const float* wp = a.in[4] + (size_t)li * 1024 * 6144 + (size_t)(kq * 256) * 6144 + nn;
            float acc[9];
#pragma unroll
            for (int r = 0; r < 9; ++r) acc[r] = 0.f;
#pragma unroll 1
            for (int k0 = kq * 256; k0 < kq * 256 + 256; k0 += 16) {
                float wv[16];
#pragma unroll
                for (int kk = 0; kk < 16; ++kk) { wv[kk] = *wp; wp += 6144; }
#pragma unroll
                for (int kk = 0; kk < 16; kk += 4)
#pragma unroll
                    for (int r = 0; r < 9; ++r) {
                        const f32x4 s4 = *(const f32x4*)(sc + r * 1024 + k0 + kk);
                        acc[r] += s4[0] * wv[kk] + s4[1] * wv[kk + 1] + s4[2] * wv[kk + 2] + s4[3] * wv[kk + 3];
                    }
            }
            float* part = sc + 9 * 1024;
#pragma unroll
            for (int r = 0; r < 9; ++r) part[(kq * 9 + r) * 64 + (tid & 63)] = acc[r];
            __syncthreads();
            for (int i = tid; i < 9 * 64; i += NTHR) {
                const int r = i >> 6, cidx = i & 63;
                const int n2 = u * 64 + cidx, l2 = n2 / 6144, nn2 = n2 - l2 * 6144;
                const float v = ((part[(0 * 9 + r) * 64 + cidx] + part[(1 * 9 + r) * 64 + cidx]) + part[(2 * 9 + r) * 64 + cidx]) + part[(3 * 9 + r) * 64 + cidx];
                ((float*)(a.ws + WS_MOD))[((size_t)l2 * 9 + r) * 6144 + nn2] = v + a.in[5][l2 * 6144 + nn2];
            }
        } else if (u < n_ada + n_rt) {
            const int r_ = u - n_ada, li = r_ / 80, n = r_ - li * 80;
            if (r_ == 0) {
                float* rt_ = (float*)(a.ws + WS_CTL + CTL_ROPE);
                for (int i = tid; i < 512; i += NTHR) {
                    const int pos = i >> 3, fi = i & 7;
                    const float ang = (float)pos * powf(10000.f, -(float)fi * 0.125f);
                    rt_[i] = cosf(ang); rt_[512 + i] = sinf(ang);
                }
            }
            bf16_t* rt = (bf16_t*)(a.ws + W_RT) + (size_t)li * 2 * 80 * 1024;
            const float* wg = a.in[26] + (size_t)li * 1024 * 8;
            const float* we = a.in[28] + (size_t)li * 1024 * 64;
            float v[4];
#pragma unroll
            for (int j = 0; j < 4; ++j) { const int k = tid * 4 + j; v[j] = n < 8 ? wg[k * 8 + n] : (n < 72 ? we[k * 64 + (n - 8)] : 0.f); }
            u32x2 hi, lo;
            hi[0] = pk2(v[0], v[1]); hi[1] = pk2(v[2], v[3]);
            lo[0] = pk2(v[0] - lof(hi[0]), v[1] - hif(hi[0])); lo[1] = pk2(v[2] - lof(hi[1]), v[3] - hif(hi[1]));
            *(u32x2*)(rt + n * 1024 + tid * 4) = hi;
            *(u32x2*)(rt + 80 * 1024 + n * 1024 + tid * 4) = lo;
        }
    }
    struct PTile { const float* src; bf16_t* dst; const float* rscale; int K, N, Npad, perm, k0, n0; };
    auto decode = [&](int tix) {
        int di = 0;
#pragma unroll 1
        for (int i = 1; i < NTD; ++i) if (tix >= a.td[i].tile0) di = i;
        const TDesc& td = a.td[di];
        int rem = tix - td.tile0;
        const int per = td.tiles_k * td.tiles_n;
        const int bi = rem / per; rem -= bi * per;
        PTile p;
        p.src = td.src + (size_t)bi * td.sb; p.dst = td.dst + (size_t)bi * td.db; p.rscale = td.rscale;
        p.K = td.K; p.N = td.N; p.Npad = td.Npad; p.perm = td.perm;
        p.n0 = (rem % td.tiles_n) * 64; p.k0 = (rem / td.tiles_n) * 128;
        return p;
    };
    auto pload = [&](const PTile& p, f32x4 (&L0)[4], f32x4 (&L1)[4]) {
        const int c4 = tid & 15, kr = tid >> 4;
        const bool nok = p.n0 + 4 * c4 < p.N;
#pragma unroll
        for (int i = 0; i < 4; ++i) {
            const int k = p.k0 + 32 * i + 2 * kr;
            L0[i] = (f32x4){0.f, 0.f, 0.f, 0.f}; L1[i] = L0[i];
            if (nok && k < p.K) {
                L0[i] = *(const f32x4*)(p.src + (size_t)k * p.N + p.n0 + 4 * c4);
                L1[i] = *(const f32x4*)(p.src + (size_t)(k + 1) * p.N + p.n0 + 4 * c4);
                if (p.rscale) { L0[i] *= p.rscale[k]; L1[i] *= p.rscale[k + 1]; }
            }
        }
    };
    auto pflush = [&](const PTile& p, const unsigned* st) {
#pragma unroll
        for (int i = 0; i < 4; ++i) {
            const int id = tid + i * 256, n = id >> 4, kc = id & 15;
            const u32x4 o = *(const u32x4*)(st + n * 68 + kc * 4);
            int nd = p.n0 + n;
            if (nd < p.Npad && p.k0 + kc * 8 < p.K) {
                if (p.perm) { const int c = nd & 255, up = nd >> 8; nd = ((c >> 4) << 5) + (up << 4) + (c & 15); }
                *(u32x4*)(p.dst + (size_t)nd * p.K + p.k0 + kc * 8) = o;
            }
        }
    };
    {
        unsigned* st0 = (unsigned*)lds; unsigned* st1 = st0 + 64 * 68;
        const int nt_ = a.ntiles_total, G = gridDim.x;
        int t0 = blockIdx.x, t1 = blockIdx.x + G;
        PTile p0 = decode(0), p1 = p0;
        f32x4 A0[4], A1[4], B0[4], B1[4];
        __syncthreads();
        if (t0 < nt_) { p0 = decode(t0); pload(p0, A0, A1); }
        if (t1 < nt_) { p1 = decode(t1); pload(p1, B0, B1); }
        while (t0 < nt_) {
            PTile q0 = p0, q1 = p1;
            const bool v1 = t1 < nt_;
            cv_pack(st0, A0, A1);
            if (t0 + 2 * G < nt_) { p0 = decode(t0 + 2 * G); pload(p0, A0, A1); }
            if (v1) {
                cv_pack(st1, B0, B1);
                if (t1 + 2 * G < nt_) { p1 = decode(t1 + 2 * G); pload(p1, B0, B1); }
            }
            __syncthreads();
            pflush(q0, st0);
            if (v1) pflush(q1, st1);
            __syncthreads();
            t0 += 2 * G; t1 += 2 * G;
        }
    }
}

template <int MODE>
DI void phase_token(const Args& a, const int li) {
    const int tid = threadIdx.x, lane = tid & 63, wave = tid >> 6;
    const int r = lane & 15, q = lane >> 4;
    float* X = (float*)(a.ws + WS_X);
    bf16_t* H = (bf16_t*)(a.ws + WS_H);
    const bf16_t* Y = (const bf16_t*)(a.ws + WS_Y);
    const float* MOD = (const float*)(a.ws + WS_MOD);
    const bool combine = (MODE == 0 && li > 0) || MODE == 2;
    const int ngroups = (MODE == 2 || (MODE == 1 && li == 3)) ? NLAT / 16 : NTOK / 16;
    float* lg = (float*)(lds + wave * 16 * 80 * 4);
    for (int g = blockIdx.x * 4 + wave; g < ngroups; g += gridDim.x * 4) {
        const int t = g * 16 + r;
        const int mr = tok_modrow(g * 16);
        const float* xsrc = (MODE == 0 && li == 0) ? (t < NLAT ? a.in[0] + (size_t)t * D : a.in[2] + (size_t)(t - NLAT) * D) : X + (size_t)t * D;
        const bf16_t* y0 = Y + (size_t)(2 * t) * D;
        const bf16_t* y1 = y0 + D;
        const int lprev = MODE == 2 ? 3 : li - 1;
        const float* g5 = MOD + ((size_t)(lprev < 0 ? 0 : lprev) * 9 + mr) * 6144 + 5 * 1024;
        float ss = 0.f;
        if (MODE != 2) {
#pragma unroll 4
            for (int kk = 0; kk < 32; ++kk) {
                const int k = kk * 32 + q * 8;
                f32x4 x0 = *(const f32x4*)(xsrc + k), x1 = *(const f32x4*)(xsrc + k + 4);
                if (combine) {
                    const u32x4 ya = *(const u32x4*)(y0 + k), yb = *(const u32x4*)(y1 + k);
                    const f32x4 ga = *(const f32x4*)(g5 + k), gb = *(const f32x4*)(g5 + k + 4);
                    x0[0] += ga[0] * (lof(ya[0]) + lof(yb[0])); x0[1] += ga[1] * (hif(ya[0]) + hif(yb[0]));
                    x0[2] += ga[2] * (lof(ya[1]) + lof(yb[1])); x0[3] += ga[3] * (hif(ya[1]) + hif(yb[1]));
                    x1[0] += gb[0] * (lof(ya[2]) + lof(yb[2])); x1[1] += gb[1] * (hif(ya[2]) + hif(yb[2]));
                    x1[2] += gb[2] * (lof(ya[3]) + lof(yb[3])); x1[3] += gb[3] * (hif(ya[3]) + hif(yb[3]));
                }
#pragma unroll
                for (int j = 0; j < 4; ++j) ss += x0[j] * x0[j] + x1[j] * x1[j];
            }
            ss += __shfl_xor(ss, 16); ss += __shfl_xor(ss, 32);
        }
        const float rstd = rsqrtf(ss * (1.f / 1024.f) + EPS);
        const float* gn = (MODE == 1 ? a.in[7] : a.in[6]) + (size_t)li * D;
        const float* mscale = MOD + ((size_t)li * 9 + mr) * 6144 + (MODE == 1 ? 4 : 1) * 1024;
        const float* mshift = MOD + ((size_t)li * 9 + mr) * 6144 + (MODE == 1 ? 3 : 0) * 1024;
        const bf16_t* rwh = (const bf16_t*)(a.ws + W_RT) + (size_t)li * 2 * 80 * 1024 + (size_t)r * 1024 + q * 8;
        f32x4 lacc[5];
#pragma unroll
        for (int i = 0; i < 5; ++i) lacc[i] = (f32x4){0.f, 0.f, 0.f, 0.f};
#pragma unroll 2
        for (int kk = 0; kk < 32; ++kk) {
            const int k = kk * 32 + q * 8;
            f32x4 x0 = *(const f32x4*)(xsrc + k), x1 = *(const f32x4*)(xsrc + k + 4);
            if (combine) {
                const u32x4 ya = *(const u32x4*)(y0 + k), yb = *(const u32x4*)(y1 + k);
                const f32x4 ga = *(const f32x4*)(g5 + k), gb = *(const f32x4*)(g5 + k + 4);
                x0[0] += ga[0] * (lof(ya[0]) + lof(yb[0])); x0[1] += ga[1] * (hif(ya[0]) + hif(yb[0]));
                x0[2] += ga[2] * (lof(ya[1]) + lof(yb[1])); x0[3] += ga[3] * (hif(ya[1]) + hif(yb[1]));
                x1[0] += gb[0] * (lof(ya[2]) + lof(yb[2])); x1[1] += gb[1] * (hif(ya[2]) + hif(yb[2]));
                x1[2] += gb[2] * (lof(ya[3]) + lof(yb[3])); x1[3] += gb[3] * (hif(ya[3]) + hif(yb[3]));
            }
            if (MODE == 2) {
                *(f32x4*)(a.out + (size_t)t * D + k) = x0; *(f32x4*)(a.out + (size_t)t * D + k + 4) = x1;
                continue;
            }
            if (MODE == 0 && (li == 0 || combine)) { *(f32x4*)(X + (size_t)t * D + k) = x0; *(f32x4*)(X + (size_t)t * D + k + 4) = x1; }
            const f32x4 n0 = *(const f32x4*)(gn + k), n1 = *(const f32x4*)(gn + k + 4);
            const f32x4 s0 = *(const f32x4*)(mscale + k), s1 = *(const f32x4*)(mscale + k + 4);
            const f32x4 h0 = *(const f32x4*)(mshift + k), h1 = *(const f32x4*)(mshift + k + 4);
            float f[8];
#pragma unroll
            for (int j = 0; j < 4; ++j) {
                f[j] = x0[j] * rstd * n0[j] * (1.f + s0[j]) + h0[j];
                f[4 + j] = x1[j] * rstd * n1[j] * (1.f + s1[j]) + h1[j];
            }
            u32x4 hv;
            hv[0] = pk2(f[0], f[1]); hv[1] = pk2(f[2], f[3]); hv[2] = pk2(f[4], f[5]); hv[3] = pk2(f[6], f[7]);
            *(u32x4*)(H + (size_t)t * D + k) = hv;
            if (MODE == 1) {
                u32x4 lv;
                lv[0] = pk2(f[0] - lof(hv[0]), f[1] - hif(hv[0])); lv[1] = pk2(f[2] - lof(hv[1]), f[3] - hif(hv[1]));
                lv[2] = pk2(f[4] - lof(hv[2]), f[5] - hif(hv[2])); lv[3] = pk2(f[6] - lof(hv[3]), f[7] - hif(hv[3]));
                const bf16x8 fh = __builtin_bit_cast(bf16x8, hv), fl = __builtin_bit_cast(bf16x8, lv);
#pragma unroll
                for (int nt = 0; nt < 5; ++nt) {
                    const bf16x8 wh = *(const bf16x8*)(rwh + (size_t)nt * 16 * 1024 + kk * 32);
                    const bf16x8 wl = *(const bf16x8*)(rwh + (size_t)(80 + nt * 16) * 1024 + kk * 32);
                    lacc[nt] = mfma16(fh, wh, lacc[nt]);
                    lacc[nt] = mfma16(fh, wl, lacc[nt]);
                    lacc[nt] = mfma16(fl, wh, lacc[nt]);
                }
            }
        }
        if (MODE == 1) {
#pragma unroll
            for (int nt = 0; nt < 5; ++nt)
#pragma unroll
                for (int j = 0; j < 4; ++j) lg[(q * 4 + j) * 80 + nt * 16 + r] = lacc[nt][j];
            asm volatile("s_waitcnt lgkmcnt(0)" ::: "memory");
            __builtin_amdgcn_wave_barrier();
            if (lane < 16) {
                const float* L = lg + lane * 80;
                const float* bg = a.in[27] + li * 8;
                const float* be = a.in[29] + li * 64;
                float gmax = -3.0e38f; int gi = 0; float gl[8];
#pragma unroll
                for (int j = 0; j < 8; ++j) { gl[j] = L[j] + bg[j]; if (gl[j] > gmax) { gmax = gl[j]; gi = j; } }
                float ps = 0.f;
#pragma unroll
                for (int j = 0; j < 8; ++j) ps += __expf(gl[j] - gmax);
                const float ptop = 1.f / ps;
                float e1 = -3.0e38f, e2 = -3.0e38f; int i1 = 0, i2 = 0;
#pragma unroll
                for (int j = 0; j < 8; ++j) {
                    const float v = L[8 + gi * 8 + j] + be[gi * 8 + j];
                    if (v > e1) { e2 = e1; i2 = i1; e1 = v; i1 = j; } else if (v > e2) { e2 = v; i2 = j; }
                }
                const float ex = __expf(e2 - e1);
                const float w1 = ptop / (1.f + ex), w2 = ptop * ex / (1.f + ex);
                const int tt = g * 16 + lane;
                int* cnt = (int*)(a.ws + WS_CTL + CTL_CNT) + li * 64;
                int* list = (int*)(a.ws + WS_LIST);
                float* wsl = (float*)(a.ws + WS_WSLOT);
                const int ea = gi * 8 + i1, eb = gi * 8 + i2;
                const int pa = atomicAdd(&cnt[ea], 1); list[(size_t)ea * NTOK + pa] = 2 * tt; wsl[2 * tt] = w1;
                const int pb = atomicAdd(&cnt[eb], 1); list[(size_t)eb * NTOK + pb] = 2 * tt + 1; wsl[2 * tt + 1] = w2;
            }
            __builtin_amdgcn_wave_barrier();
        }
    }
}

DI float wave_sum(float v) {
    v += __shfl_xor(v, 1); v += __shfl_xor(v, 2); v += __shfl_xor(v, 4); v += __shfl_xor(v, 8); v += __shfl_xor(v, 16); v += __shfl_xor(v, 32);
    return v;
}
template <int MODE>
DI void phase_token_row(const Args& a, const int li) {
    const int tid = threadIdx.x, lane = tid & 63, wave = tid >> 6;
    float* X = (float*)(a.ws + WS_X);
    bf16_t* H = (bf16_t*)(a.ws + WS_H);
    const bf16_t* Y = (const bf16_t*)(a.ws + WS_Y);
    const float* MOD = (const float*)(a.ws + WS_MOD);
    const bool combine = MODE == 2 || li > 0;
    const bool first = MODE == 0 && li == 0;
    const int npairs = (MODE == 2 ? NLAT : NTOK) / 2;
    const int lprev = MODE == 2 ? 3 : (li > 0 ? li - 1 : 0);
    const float* gn = a.in[6] + (size_t)li * D;
    for (int p = blockIdx.x * 4 + wave; p < npairs; p += gridDim.x * 4) {
        const int t0 = 2 * p, mr = tok_modrow(t0);
        f32x4 x[2][4];
#pragma unroll
        for (int i = 0; i < 2; ++i) {
            const int t = t0 + i;
            const float* xs = first ? (t < NLAT ? a.in[0] + (size_t)t * D : a.in[2] + (size_t)(t - NLAT) * D) : X + (size_t)t * D;
#pragma unroll
            for (int j = 0; j < 4; ++j) x[i][j] = *(const f32x4*)(xs + 256 * j + 4 * lane);
        }
        if (combine) {
            const float* g5 = MOD + ((size_t)lprev * 9 + mr) * 6144 + 5 * 1024;
            f32x4 g[4];
#pragma unroll
            for (int j = 0; j < 4; ++j) g[j] = *(const f32x4*)(g5 + 256 * j + 4 * lane);
#pragma unroll
            for (int i = 0; i < 2; ++i) {
                const bf16_t* y0 = Y + (size_t)(2 * (t0 + i)) * D;
#pragma unroll
                for (int j = 0; j < 4; ++j) {
                    const u32x2 ya = *(const u32x2*)(y0 + 256 * j + 4 * lane), yb = *(const u32x2*)(y0 + D + 256 * j + 4 * lane);
                    x[i][j][0] += g[j][0] * (lof(ya[0]) + lof(yb[0])); x[i][j][1] += g[j][1] * (hif(ya[0]) + hif(yb[0]));
                    x[i][j][2] += g[j][2] * (lof(ya[1]) + lof(yb[1])); x[i][j][3] += g[j][3] * (hif(ya[1]) + hif(yb[1]));
                }
            }
        }
        if (MODE == 2) {
#pragma unroll
            for (int i = 0; i < 2; ++i)
#pragma unroll
                for (int j = 0; j < 4; ++j) *(f32x4*)(a.out + (size_t)(t0 + i) * D + 256 * j + 4 * lane) = x[i][j];
            continue;
        }
        float rstd[2];
#pragma unroll
        for (int i = 0; i < 2; ++i) {
            float ss = 0.f;
#pragma unroll
            for (int j = 0; j < 4; ++j) ss += x[i][j][0] * x[i][j][0] + x[i][j][1] * x[i][j][1] + x[i][j][2] * x[i][j][2] + x[i][j][3] * x[i][j][3];
            rstd[i] = rsqrtf(wave_sum(ss) * (1.f / 1024.f) + EPS);
        }
        const float* msc = MOD + ((size_t)li * 9 + mr) * 6144 + 1 * 1024;
        const float* msh = MOD + ((size_t)li * 9 + mr) * 6144;
#pragma unroll
        for (int j = 0; j < 4; ++j) {
            const f32x4 n4 = *(const f32x4*)(gn + 256 * j + 4 * lane), s4 = *(const f32x4*)(msc + 256 * j + 4 * lane), h4 = *(const f32x4*)(msh + 256 * j + 4 * lane);
            const f32x4 gs = n4 * (s4 + 1.f);
#pragma unroll
            for (int i = 0; i < 2; ++i) {
                const f32x4 f = x[i][j] * rstd[i] * gs + h4;
                st_bf4(H + (size_t)(t0 + i) * D + 256 * j + 4 * lane, f);
                if (combine) *(f32x4*)(X + (size_t)(t0 + i) * D + 256 * j + 4 * lane) = x[i][j];
            }
        }
    }
}

DI void phase_token_router(const Args& a, const int li) {
    const int tid = threadIdx.x, lane = tid & 63, wave = tid >> 6;
    const int r = lane & 15, q = lane >> 4;
    const float* X = (const float*)(a.ws + WS_X);
    bf16_t* H = (bf16_t*)(a.ws + WS_H);
    const float* MOD = (const float*)(a.ws + WS_MOD);
    const float* gn = a.in[7] + (size_t)li * D;
    const int ngroups = (li == 3 ? NLAT : NTOK) / 16;
    char* sHi = lds; char* sLo = lds + 32768;
    float* sP = (float*)lds;
    float* sL = (float*)(lds + 32768);
    const bf16_t* rwh = (const bf16_t*)(a.ws + W_RT) + (size_t)li * 2 * 80 * 1024 + (size_t)r * 1024 + q * 8;
    for (int g = blockIdx.x; g < ngroups; g += gridDim.x) {
        const int mr = tok_modrow(g * 16);
        const float* msc = MOD + ((size_t)li * 9 + mr) * 6144 + 4 * 1024;
        const float* msh = MOD + ((size_t)li * 9 + mr) * 6144 + 3 * 1024;
        __syncthreads();
        {
            f32x4 x[4][4];
#pragma unroll
            for (int i = 0; i < 4; ++i)
#pragma unroll
                for (int j = 0; j < 4; ++j) x[i][j] = *(const f32x4*)(X + (size_t)(g * 16 + wave * 4 + i) * D + 256 * j + 4 * lane);
            float rstd[4];
#pragma unroll
            for (int i = 0; i < 4; ++i) {
                float ss = 0.f;
#pragma unroll
                for (int j = 0; j < 4; ++j) ss += x[i][j][0] * x[i][j][0] + x[i][j][1] * x[i][j][1] + x[i][j][2] * x[i][j][2] + x[i][j][3] * x[i][j][3];
                rstd[i] = rsqrtf(wave_sum(ss) * (1.f / 1024.f) + EPS);
            }
#pragma unroll
            for (int j = 0; j < 4; ++j) {
                const f32x4 n4 = *(const f32x4*)(gn + 256 * j + 4 * lane), s4 = *(const f32x4*)(msc + 256 * j + 4 * lane), h4 = *(const f32x4*)(msh + 256 * j + 4 * lane);
                const f32x4 gs = n4 * (s4 + 1.f);
#pragma unroll
                for (int i = 0; i < 4; ++i) {
                    const int row = wave * 4 + i;
                    const f32x4 f = x[i][j] * rstd[i] * gs + h4;
                    u32x2 hv; hv[0] = pk2(f[0], f[1]); hv[1] = pk2(f[2], f[3]);
                    u32x2 lv; lv[0] = pk2(f[0] - lof(hv[0]), f[1] - hif(hv[0])); lv[1] = pk2(f[2] - lof(hv[1]), f[3] - hif(hv[1]));
                    *(u32x2*)(H + (size_t)(g * 16 + row) * D + 256 * j + 4 * lane) = hv;
                    const int off = row * 2048 + (((32 * j + (lane >> 1)) ^ row) << 4) + (lane & 1) * 8;
                    *(u32x2*)(sHi + off) = hv; *(u32x2*)(sLo + off) = lv;
                }
            }
        }
        __syncthreads();
        f32x4 lacc[5];
#pragma unroll
        for (int i = 0; i < 5; ++i) lacc[i] = (f32x4){0.f, 0.f, 0.f, 0.f};
#pragma unroll 2
        for (int s = 0; s < 8; ++s) {
            const int kk = wave * 8 + s;
            const int off = r * 2048 + (((kk * 4 + q) ^ r) << 4);
            const bf16x8 fh = ldsv8(sHi + off), fl = ldsv8(sLo + off);
#pragma unroll
            for (int nt = 0; nt < 5; ++nt) {
                const bf16x8 wh = *(const bf16x8*)(rwh + (size_t)nt * 16 * 1024 + kk * 32);
                const bf16x8 wl = *(const bf16x8*)(rwh + (size_t)(80 + nt * 16) * 1024 + kk * 32);
                lacc[nt] = mfma16(fh, wh, lacc[nt]);
                lacc[nt] = mfma16(fh, wl, lacc[nt]);
                lacc[nt] = mfma16(fl, wh, lacc[nt]);
            }
        }
        __syncthreads();
#pragma unroll
        for (int nt = 0; nt < 5; ++nt)
#pragma unroll
            for (int j = 0; j < 4; ++j) sP[(wave * 16 + q * 4 + j) * 80 + nt * 16 + r] = lacc[nt][j];
        __syncthreads();
        for (int i = tid; i < 16 * 80; i += NTHR) sL[i] = sP[i] + sP[1280 + i] + sP[2560 + i] + sP[3840 + i];
        __syncthreads();
        if (tid < 16) {
            const float* L = sL + tid * 80;
            const float* bg = a.in[27] + li * 8;
            const float* be = a.in[29] + li * 64;
            float gmax = -3.0e38f; int gi = 0; float gl[8];
#pragma unroll
            for (int j = 0; j < 8; ++j) { gl[j] = L[j] + bg[j]; if (gl[j] > gmax) { gmax = gl[j]; gi = j; } }
            float ps = 0.f;
#pragma unroll
            for (int j = 0; j < 8; ++j) ps += __expf(gl[j] - gmax);
            const float ptop = 1.f / ps;
            float e1 = -3.0e38f, e2 = -3.0e38f; int i1 = 0, i2 = 0;
#pragma unroll
            for (int j = 0; j < 8; ++j) {
                const float v = L[8 + gi * 8 + j] + be[gi * 8 + j];
                if (v > e1) { e2 = e1; i2 = i1; e1 = v; i1 = j; } else if (v > e2) { e2 = v; i2 = j; }
            }
            const float ex = __expf(e2 - e1);
            const float w1 = ptop / (1.f + ex), w2 = ptop * ex / (1.f + ex);
            const int tt = g * 16 + tid;
            int* cnt = (int*)(a.ws + WS_CTL + CTL_CNT) + li * 64;
            int* list = (int*)(a.ws + WS_LIST);
            float* wsl = (float*)(a.ws + WS_WSLOT);
            const int ea = gi * 8 + i1, eb = gi * 8 + i2;
            const int pa = atomicAdd(&cnt[ea], 1); list[(size_t)ea * NTOK + pa] = 2 * tt; wsl[2 * tt] = w1;
            const int pb = atomicAdd(&cnt[eb], 1); list[(size_t)eb * NTOK + pb] = 2 * tt + 1; wsl[2 * tt + 1] = w2;
        }
    }
}

template <int WM, int WN, int MT, int NT, bool PFALL = true, class AP>
DI void gemm_tile(AP arow, const bf16_t* Bt, const int ldb, const int K, f32x4 (&acc)[MT][NT], float* ssq = nullptr) {
    constexpr int BM = WM * MT * 16, BN = WN * NT * 16;
    constexpr int A_BYTES = BM * 128, B_BYTES = BN * 128, STAGE = A_BYTES + B_BYTES;
    constexpr int ACH = BM * 8 / NTHR, BCH = BN * 8 / NTHR;
    static_assert(2 * STAGE <= LDS_AUX, "gemm LDS");
    const int tid = threadIdx.x, lane = tid & 63, wave = tid >> 6;
    const int wm = wave / WN, wn = wave % WN;
    const int fr = lane & 15, fq = lane >> 4;
    const bf16_t* ap[ACH]; const bf16_t* bp[BCH];
#pragma unroll
    for (int i = 0; i < ACH; ++i) { const int idx = tid + i * NTHR, row = idx >> 3, c = (idx & 7) ^ (row & 7); ap[i] = arow(row) + c * 8; }
#pragma unroll
    for (int i = 0; i < BCH; ++i) { const int idx = tid + i * NTHR, row = idx >> 3, c = (idx & 7) ^ (row & 7); bp[i] = Bt + (size_t)row * ldb + c * 8; }
#pragma unroll
    for (int i = 0; i < MT; ++i)
#pragma unroll
        for (int j = 0; j < NT; ++j) acc[i][j] = (f32x4){0.f, 0.f, 0.f, 0.f};
    const int KT = K >> 6;
    {
        char* sa = lds; char* sb = lds + A_BYTES;
#pragma unroll
        for (int i = 0; i < ACH; ++i) dma16(ap[i], sa + (tid + i * NTHR) * 16);
#pragma unroll
        for (int i = 0; i < BCH; ++i) dma16(bp[i], sb + (tid + i * NTHR) * 16);
    }
#pragma unroll 1
    for (int kt = 0; kt < KT; ++kt) {
        wait_vm0();
        __syncthreads();
        if (kt + 1 < KT) {
            char* sa = lds + ((kt + 1) & 1) * STAGE; char* sb = sa + A_BYTES;
            const int ko = (kt + 1) * 64;
#pragma unroll
            for (int i = 0; i < ACH; ++i) dma16(ap[i] + ko, sa + (tid + i * NTHR) * 16);
#pragma unroll
            for (int i = 0; i < BCH; ++i) dma16(bp[i] + ko, sb + (tid + i * NTHR) * 16);
        }
        const char* sa = lds + (kt & 1) * STAGE; const char* sb = sa + A_BYTES;
        if (PFALL) {
            bf16x8 xf[2][MT], wf[2][NT];
#pragma unroll
            for (int kk = 0; kk < 2; ++kk) {
#pragma unroll
                for (int i = 0; i < MT; ++i) xf[kk][i] = ldsv8(sa + swz128(wm * MT * 16 + i * 16 + fr, kk * 4 + fq));
#pragma unroll
                for (int j = 0; j < NT; ++j) wf[kk][j] = ldsv8(sb + swz128(wn * NT * 16 + j * 16 + fr, kk * 4 + fq));
            }
            __builtin_amdgcn_sched_barrier(0);
            __builtin_amdgcn_s_setprio(1);
#pragma unroll
            for (int kk = 0; kk < 2; ++kk)
#pragma unroll
                for (int i = 0; i < MT; ++i)
#pragma unroll
                    for (int j = 0; j < NT; ++j) acc[i][j] = mfma16(wf[kk][j], xf[kk][i], acc[i][j]);
            __builtin_amdgcn_s_setprio(0);
        } else {
#pragma unroll
            for (int kk = 0; kk < 2; ++kk) {
                bf16x8 xf[MT], wf[NT];
#pragma unroll
                for (int i = 0; i < MT; ++i) xf[i] = ldsv8(sa + swz128(wm * MT * 16 + i * 16 + fr, kk * 4 + fq));
#pragma unroll
                for (int j = 0; j < NT; ++j) wf[j] = ldsv8(sb + swz128(wn * NT * 16 + j * 16 + fr, kk * 4 + fq));
#pragma unroll
                for (int i = 0; i < MT; ++i)
#pragma unroll
                    for (int j = 0; j < NT; ++j) acc[i][j] = mfma16(wf[j], xf[i], acc[i][j]);
                if (ssq) {
#pragma unroll
                    for (int i = 0; i < MT; ++i) {
                        const u32x4 xu = __builtin_bit_cast(u32x4, xf[i]);
#pragma unroll
                        for (int d = 0; d < 4; ++d) { const bfx2 p = __builtin_bit_cast(bfx2, xu[d]); ssq[i] = __builtin_amdgcn_fdot2_f32_bf16(p, p, ssq[i], false); }
                    }
                }
            }
        }
    }
    __syncthreads();
}


struct GemmPipe {
    static constexpr int A_BYTES = 128 * 128, STAGE = 2 * A_BYTES;
    const bf16_t* ap[4]; const bf16_t* bp[4];
    template <class AP>
    DI void setup(AP arow, const bf16_t* Bt, const int ldb) {
        const int tid = threadIdx.x;
#pragma unroll
        for (int i = 0; i < 4; ++i) {
            const int idx = tid + i * NTHR, row = idx >> 3, c = (idx & 7) ^ (row & 7);
            ap[i] = arow(row) + c * 8; bp[i] = Bt + (size_t)row * ldb + c * 8;
        }
    }
    DI void issue(const int kt, const int buf) const {
        const int tid = threadIdx.x;
        char* sa = lds + buf * STAGE; char* sb = sa + A_BYTES;
        const int ko = kt * 64;
#pragma unroll
        for (int i = 0; i < 4; ++i) dma16(ap[i] + ko, sa + (tid + i * NTHR) * 16);
#pragma unroll
        for (int i = 0; i < 4; ++i) dma16(bp[i] + ko, sb + (tid + i * NTHR) * 16);
    }
    template <int PM>
    DI void run_probe(const int K, f32x4 (&acc)[4][4]) const {
        const int tid = threadIdx.x, lane = tid & 63, wave = tid >> 6;
        const int wm = wave >> 1, wn = wave & 1, fr = lane & 15, fq = lane >> 4;
#pragma unroll
        for (int i = 0; i < 4; ++i)
#pragma unroll
            for (int j = 0; j < 4; ++j) acc[i][j] = (f32x4){0.f, 0.f, 0.f, 0.f};
        const int KT = K >> 6;
#pragma unroll 1
        for (int kt = 0; kt < KT; ++kt) {
            if (PM & 4) { wait_vm0(); __syncthreads(); }
            if ((PM & 1) && kt + 1 < KT) issue(kt + 1, (kt + 1) & 1);
            if (PM & 2) {
                const char* sa = lds + (kt & 1) * STAGE; const char* sb = sa + A_BYTES;
                bf16x8 xf[2][4], wf[2][4];
#pragma unroll
                for (int kk = 0; kk < 2; ++kk) {
#pragma unroll
                    for (int i = 0; i < 4; ++i) xf[kk][i] = ldsv8(sa + swz128(wm * 64 + i * 16 + fr, kk * 4 + fq));
#pragma unroll
                    for (int j = 0; j < 4; ++j) wf[kk][j] = ldsv8(sb + swz128(wn * 64 + j * 16 + fr, kk * 4 + fq));
                }
                __builtin_amdgcn_sched_barrier(0);
                __builtin_amdgcn_s_setprio(1);
#pragma unroll
                for (int kk = 0; kk < 2; ++kk)
#pragma unroll
                    for (int i = 0; i < 4; ++i)
#pragma unroll
                        for (int j = 0; j < 4; ++j) acc[i][j] = mfma16(wf[kk][j], xf[kk][i], acc[i][j]);
                __builtin_amdgcn_s_setprio(0);
            }
        }
        wait_vm0();
    }
    DI void run(const int K, f32x4 (&acc)[4][4]) const {
        const int tid = threadIdx.x, lane = tid & 63, wave = tid >> 6;
        const int wm = wave >> 1, wn = wave & 1, fr = lane & 15, fq = lane >> 4;
#pragma unroll
        for (int i = 0; i < 4; ++i)
#pragma unroll
            for (int j = 0; j < 4; ++j) acc[i][j] = (f32x4){0.f, 0.f, 0.f, 0.f};
        const int KT = K >> 6;
#pragma unroll 1
        for (int kt = 0; kt < KT; ++kt) {
            wait_vm0();
            __syncthreads();
            if (kt + 1 < KT) issue(kt + 1, (kt + 1) & 1);
            const char* sa = lds + (kt & 1) * STAGE; const char* sb = sa + A_BYTES;
            bf16x8 xf[2][4], wf[2][4];
#pragma unroll
            for (int kk = 0; kk < 2; ++kk) {
#pragma unroll
                for (int i = 0; i < 4; ++i) xf[kk][i] = ldsv8(sa + swz128(wm * 64 + i * 16 + fr, kk * 4 + fq));
#pragma unroll
                for (int j = 0; j < 4; ++j) wf[kk][j] = ldsv8(sb + swz128(wn * 64 + j * 16 + fr, kk * 4 + fq));
            }
            __builtin_amdgcn_sched_barrier(0);
            __builtin_amdgcn_s_setprio(1);
#pragma unroll
            for (int kk = 0; kk < 2; ++kk)
#pragma unroll
                for (int i = 0; i < 4; ++i)
#pragma unroll
                    for (int j = 0; j < 4; ++j) acc[i][j] = mfma16(wf[kk][j], xf[kk][i], acc[i][j]);
            __builtin_amdgcn_s_setprio(0);
        }
    }
};

constexpr int EPI_OFF = 32768;
DI int lane_m(int i) { const int t = threadIdx.x; return ((t >> 7) & 1) * 64 + i * 16 + (t & 15); }
DI int lane_n(int j) { const int t = threadIdx.x; return ((t >> 6) & 1) * 64 + j * 16 + ((t >> 4) & 3) * 4; }
DI int opaque_tid() { int t = threadIdx.x; asm volatile("" : "+v"(t)); return t; }
DI int lane_m(int t, int i) { return ((t >> 7) & 1) * 64 + i * 16 + (t & 15); }
DI int lane_n(int t, int j) { return ((t >> 6) & 1) * 64 + j * 16 + ((t >> 4) & 3) * 4; }
template <class XF>
DI void epi_stage_bf16(const f32x4 (&acc)[4][4], XF xf) {
    const int tz = opaque_tid();
#pragma unroll
    for (int i = 0; i < 4; ++i) {
        const int m = lane_m(tz, i);
#pragma unroll
        for (int j = 0; j < 4; ++j) {
            const int n = lane_n(tz, j);
            const f32x4 v = xf(i, j, acc[i][j]);
            u32x2 o; o[0] = pk2(v[0], v[1]); o[1] = pk2(v[2], v[3]);
            *(u32x2*)(lds + EPI_OFF + m * 256 + (((n >> 3) ^ (m & 15)) << 4) + (n & 4) * 2) = o;
        }
    }
}
template <class DP, class OK>
DI void epi_flush_bf16(DP dst, OK ok) {
    const int tz = opaque_tid();
#pragma unroll
    for (int it = 0; it < 8; ++it) {
        const int idx = tz + it * NTHR, row = idx >> 4, ch = idx & 15;
        const u32x4 v = *(const u32x4*)(lds + EPI_OFF + row * 256 + ((ch ^ (row & 15)) << 4));
        if (ok(row)) *(u32x4*)(dst(row) + ch * 8) = v;
    }
}
template <class XF>
DI void epi_stage_bf16_T(const f32x4 (&acc)[4][4], XF xf) {
    const int tz = opaque_tid();
    const bool odd = tz & 1;
#pragma unroll
    for (int i = 0; i < 4; ++i) {
        const int m = lane_m(tz, i) & ~1;
#pragma unroll
        for (int j = 0; j < 4; ++j) {
            const int n = lane_n(tz, j) + (odd ? 2 : 0);
            const f32x4 v = xf(i, j, acc[i][j]);
            const float r0 = __shfl_xor(odd ? v[0] : v[2], 1), r1 = __shfl_xor(odd ? v[1] : v[3], 1);
            const unsigned w0 = odd ? pk2(r0, v[2]) : pk2(v[0], r0), w1 = odd ? pk2(r1, v[3]) : pk2(v[1], r1);
            *(unsigned*)(lds + EPI_OFF + n * 256 + (((m >> 3) ^ (n & 15)) << 4) + (m & 6) * 2) = w0;
            *(unsigned*)(lds + EPI_OFF + (n + 1) * 256 + (((m >> 3) ^ ((n + 1) & 15)) << 4) + (m & 6) * 2) = w1;
        }
    }
}
DI void epi_resid_f32(const Args& a, const int li, const int m0, const int n0, const f32x4 (&acc)[4][4]) {
    const int tz = opaque_tid();
    float* X = (float*)(a.ws + WS_X);
    const float* gate = (const float*)(a.ws + WS_MOD) + ((size_t)li * 9 + tok_modrow(m0)) * 6144 + 2 * 1024 + n0;
#pragma unroll
    for (int j = 0; j < 4; ++j) {
        const int n = lane_n(tz, j);
        const f32x4 g = *(const f32x4*)(gate + n);
#pragma unroll
        for (int i = 0; i < 4; ++i) {
            const int t = m0 + lane_m(tz, i);
            float* xp = X + (size_t)t * D + n0 + n;
            const float* xs = li == 0 ? (t < NLAT ? a.in[0] + (size_t)t * D : a.in[2] + (size_t)(t - NLAT) * D) + n0 + n : xp;
            f32x4 x = *(const f32x4*)xs;
            x += g * acc[i][j];
            *(f32x4*)xp = x;
        }
    }
}

template <bool XPF = true, class TE>
DI void gemm_dense_phase(const bf16_t* A, const int lda, const int mrows, const bf16_t* Bt, const int N, const int K, TE tile_epi) {
    const int mt = mrows / 128, nt = N / 128;
    const int mpx = mt >> 3, bmb = mpx >> 1, full = mpx * 8;
    auto decode = [&](int u, int& m0, int& n0) {
        const int xc = u & 7, s = u >> 3;
        const int bn = s / full, rem = s - bn * full;
        const int w = min(8, nt - 8 * bn);
        const int bm = rem / (bmb * w), rem2 = rem - bm * (bmb * w);
        const int ni = rem2 / bmb, mi = rem2 - ni * bmb;
        m0 = (xc * mpx + bm * bmb + mi) * 128; n0 = (bn * 8 + ni) * 128;
    };
    GemmPipe g;
    int u = blockIdx.x, m0 = 0, n0 = 0;
    __syncthreads();
    if (u < mt * nt) { decode(u, m0, n0); g.setup([&](int r) { return A + (size_t)(m0 + r) * lda; }, Bt + (size_t)n0 * K, K); g.issue(0, 0); }
    while (u < mt * nt) {
        f32x4 acc[4][4];
        g.run(K, acc);
        const int cm0 = m0, cn0 = n0;
        u += gridDim.x;
        if (XPF) {
            if (u < mt * nt) { decode(u, m0, n0); g.setup([&](int r) { return A + (size_t)(m0 + r) * lda; }, Bt + (size_t)n0 * K, K); g.issue(0, 0); }
            tile_epi(cm0, cn0, acc);
        } else {
            tile_epi(cm0, cn0, acc);
            __syncthreads();
            if (u < mt * nt) { decode(u, m0, n0); g.setup([&](int r) { return A + (size_t)(m0 + r) * lda; }, Bt + (size_t)n0 * K, K); g.issue(0, 0); }
        }
    }
    __syncthreads();
}
template <class XF, class DP>
DI void epi_bf16_rowmajor(const f32x4 (&acc)[4][4], XF xf, DP dst) {
    __syncthreads();
    epi_stage_bf16(acc, xf);
    __syncthreads();
    epi_flush_bf16(dst, [](int) { return true; });
}

DI void phase_rg_in(const Args& a, int j) {
    bf16_t* G = (bf16_t*)(a.ws + RG_G); bf16_t* U = (bf16_t*)(a.ws + RG_U);
    gemm_dense_phase((const bf16_t*)(a.ws + WS_H), D, NTOK, (const bf16_t*)(a.ws + W_RGIN) + (size_t)j * 2048 * 1024, 2048, 1024,
        [&](int m0, int n0, const f32x4 (&acc)[4][4]) {
            if (n0 < 1024)
                epi_bf16_rowmajor(acc, [](int, int, const f32x4 v) { f32x4 g; g[0] = gelu_tanh(v[0]); g[1] = gelu_tanh(v[1]); g[2] = gelu_tanh(v[2]); g[3] = gelu_tanh(v[3]); return g; },
                                  [&](int row) { return G + (size_t)(m0 + row) * D + n0; });
            else
                epi_bf16_rowmajor(acc, [](int, int, const f32x4 v) { return v; }, [&](int row) { return U + (size_t)(m0 + row) * D + (n0 - 1024); });
        });
}

template <int VAR = 0, int HOST = 0>
DI void phase_rg_scan(const Args& a, int j) {
    const int tid = threadIdx.x, lane = tid & 63, wave = tid >> 6;
    const int fr = lane & 15, fq = lane >> 4;
    const bf16_t* U = (const bf16_t*)(a.ws + RG_U);
    bf16_t* HS = (bf16_t*)(a.ws + (VAR ? WS_Y : RG_HS));
    char* sW = lds;
    char* sX = lds + 8192;
    float* sUc = (float*)(lds + 16384);
    float* sA = (float*)(lds + 24576);
    float* sB = (float*)(lds + 33280);
    bf16_t* sO = (bf16_t*)(lds + 41984);
    unsigned* sCv = (unsigned*)(lds + 50176);
    const int c = tid & 7;
    for (int u = blockIdx.x; u < 512; u += gridDim.x) {
        const int half = u & 1, dir = (u >> 1) & 1, blk = (u >> 2) & 15, b = u >> 6;
        const int cin0 = blk * 64, co0 = blk * 64 + half * 32;
        __syncthreads();
        {
            const bf16_t* Wg = (const bf16_t*)(a.ws + W_RGG) + ((size_t)((j * 2 + dir) * 16 + blk)) * 128 * 64;
#pragma unroll
            for (int i = 0; i < 2; ++i) {
                const int idx = tid + i * NTHR, row = idx >> 3, cc = idx & 7;
                const int srow = (row >> 5) * 64 + half * 32 + (row & 31);
                *(u32x4*)(sW + swz128(row, cc)) = *(const u32x4*)(Wg + (size_t)srow * 64 + cc * 8);
            }
        }
        float carry = 0.f;
        float cw[4][8], cb[8];
        {
            const float* cwp = a.in[9] + (size_t)j * 4 * 1024 + cin0 + c * 8; const float* cbp = a.in[10] + (size_t)j * 1024 + cin0 + c * 8;
#pragma unroll
            for (int w = 0; w < 4; ++w) { const f32x4 v0 = *(const f32x4*)(cwp + w * 1024), v1 = *(const f32x4*)(cwp + w * 1024 + 4);
#pragma unroll
                for (int e = 0; e < 4; ++e) { cw[w][e] = v0[e]; cw[w][4 + e] = v1[e]; } }
            const f32x4 v0 = *(const f32x4*)cbp, v1 = *(const f32x4*)(cbp + 4);
#pragma unroll
            for (int e = 0; e < 4; ++e) { cb[e] = v0[e]; cb[4 + e] = v1[e]; }
        }
        float bg0[8], bg1[8], spl[8];
        {
            const float* gb = a.in[12] + ((size_t)(j * 2 + dir) * 2) * 1024 + co0;
            const float* lm = a.in[13] + (size_t)(j * 2 + dir) * 1024 + co0;
#pragma unroll
            for (int jt = 0; jt < 2; ++jt)
#pragma unroll
                for (int e = 0; e < 4; ++e) {
                    const int cc = jt * 16 + fq * 4 + e;
                    bg0[jt * 4 + e] = gb[cc]; bg1[jt * 4 + e] = gb[1024 + cc];
                    spl[jt * 4 + e] = -8.f * log1pf(__expf(-lm[cc]));
                }
        }
        u32x4 pu[2][4];
        auto load_chunk = [&](int ci) {
            const int seg = ci >= 4, L = seg ? SEQ : CTXL, nch = L / 64, jc = seg ? ci - 4 : ci;
            const int oc = dir ? nch - 1 - jc : jc;
            const int rb = seg ? b * SEQ : NLAT + b * CTXL;
            const int s0 = oc * 64;
#pragma unroll
            for (int it = 0; it < 2; ++it) {
                const int tk = (tid >> 3) + it * 32;
#pragma unroll
                for (int w = 0; w < 4; ++w) {
                    const int s = s0 + tk + w - 2;
                    const int sc_ = min(max(s, 0), L - 1);
                    const u32x4 ld = *(const u32x4*)(U + (size_t)(rb + sc_) * D + cin0 + c * 8);
                    const unsigned msk = (s >= 0 && s < L) ? 0xffffffffu : 0u;
                    pu[it][w] = (u32x4){ld[0] & msk, ld[1] & msk, ld[2] & msk, ld[3] & msk};
                }
            }
        };
        load_chunk(0);
        __syncthreads();
        size_t prev_base = 0;
        constexpr int CV_TILES = HOST ? 6144 : 0;
        CvTile cvp; cvp.src = nullptr; cvp.dst = nullptr; cvp.K = 0; cvp.N = 0; cvp.perm = 0; cvp.k0 = 0; cvp.n0 = 0;
        bool cvp_ok = false;
#pragma unroll 1
        for (int ci = 0; ci < 36; ++ci) {
            f32x4 cv0[4], cv1[4];
            CvTile cvc = cvp;
            const int cvq = (ci / 3) * 512 + u;
            const bool cv_ok = HOST && (ci % 3 == 0) && cvq < CV_TILES;
            if (cv_ok) { cvc = moe_cv_tile(a, 1, cvq); cv_load(cvc, cv0, cv1); }
            const int seg = ci >= 4, L = seg ? SEQ : CTXL, nch = L / 64, jc = seg ? ci - 4 : ci;
            const int oc = dir ? nch - 1 - jc : jc;
            const int rb = seg ? b * SEQ : NLAT + b * CTXL;
            const int s0 = oc * 64;
            char* sXc = sX; float* sUcc = sUc;
#pragma unroll
            for (int it = 0; it < 2; ++it) {
                const int tk = (tid >> 3) + it * 32;
                float o[8];
#pragma unroll
                for (int e = 0; e < 8; ++e) o[e] = cb[e];
#pragma unroll
                for (int w = 0; w < 4; ++w) {
                    const u32x4 r4 = pu[it][w];
#pragma unroll
                    for (int e = 0; e < 4; ++e) { o[2 * e] += cw[w][2 * e] * lof(r4[e]); o[2 * e + 1] += cw[w][2 * e + 1] * hif(r4[e]); }
                }
                u32x4 pv; pv[0] = pk2(o[0], o[1]); pv[1] = pk2(o[2], o[3]); pv[2] = pk2(o[4], o[5]); pv[3] = pk2(o[6], o[7]);
                *(u32x4*)(sXc + swz128(tk, c)) = pv;
                if ((c >> 2) == half) {
                    *(f32x4*)(sUcc + tk * 32 + (c & 3) * 8) = (f32x4){o[0], o[1], o[2], o[3]};
                    *(f32x4*)(sUcc + tk * 32 + (c & 3) * 8 + 4) = (f32x4){o[4], o[5], o[6], o[7]};
                }
            }
            if (ci + 1 < 36) load_chunk(ci + 1);
            lds_barrier();
            if (HOST && cvp_ok) cv_flush(cvp, sCv);
            if (ci > 0) {
                const u32x4 v = *(const u32x4*)(sO + ((ci - 1) & 1) * 2048 + tid * 8);
                *(u32x4*)(HS + prev_base + (size_t)(tid >> 2) * D + (tid & 3) * 8) = v;
            }
            {
                f32x4 acc[4];
#pragma unroll
                for (int jt = 0; jt < 4; ++jt) acc[jt] = (f32x4){0.f, 0.f, 0.f, 0.f};
#pragma unroll
                for (int kk = 0; kk < 2; ++kk) {
                    const bf16x8 xf = ldsv8(sXc + swz128(wave * 16 + fr, kk * 4 + fq));
#pragma unroll
                    for (int jt = 0; jt < 4; ++jt) acc[jt] = mfma16(ldsv8(sW + swz128(jt * 16 + fr, kk * 4 + fq)), xf, acc[jt]);
                }
                const int tk = wave * 16 + fr;
#pragma unroll
                for (int jt = 0; jt < 2; ++jt) {
                    const f32x4 uc = *(const f32x4*)(sUcc + tk * 32 + jt * 16 + fq * 4);
                    f32x4 av4, bv4;
#pragma unroll
                    for (int e = 0; e < 4; ++e) {
                        if (VAR & 2) { av4[e] = 0.5f + 0.001f * acc[jt][e]; bv4[e] = uc[e] + acc[jt + 2][e]; continue; }
                        const float rg = sigmoidf_(acc[jt][e] + bg0[jt * 4 + e]);
                        const float ig = sigmoidf_(acc[jt + 2][e] + bg1[jt * 4 + e]);
                        const float av = fexp(rg * spl[jt * 4 + e]);
                        av4[e] = av;
                        bv4[e] = __builtin_amdgcn_sqrtf(fmaxf(1.f - av * av, 0.f)) * ig * uc[e];
                    }
#pragma unroll
                    for (int e = 0; e < 4; ++e) { sA[(jt * 16 + fq * 4 + e) * 68 + tk] = av4[e]; sB[(jt * 16 + fq * 4 + e) * 68 + tk] = bv4[e]; }
                }
            }
            lds_barrier();
            if (!(VAR & 4)) {
                const int ch = wave * 8 + (lane & 7), sg = lane >> 3;
                const int tb = dir ? 56 - sg * 8 : sg * 8;
                const f32x4 a0 = *(const f32x4*)(sA + ch * 68 + tb), a1 = *(const f32x4*)(sA + ch * 68 + tb + 4);
                const f32x4 b0 = *(const f32x4*)(sB + ch * 68 + tb), b1 = *(const f32x4*)(sB + ch * 68 + tb + 4);
                float av[8], bv[8];
#pragma unroll
                for (int e = 0; e < 4; ++e) {
                    av[e] = dir ? a1[3 - e] : a0[e]; av[4 + e] = dir ? a0[3 - e] : a1[e];
                    bv[e] = dir ? b1[3 - e] : b0[e]; bv[4 + e] = dir ? b0[3 - e] : b1[e];
                }
                float Ap = 1.f, Hh = 0.f;
#pragma unroll
                for (int e = 0; e < 8; ++e) { Hh = av[e] * Hh + bv[e]; Ap *= av[e]; }
#pragma unroll
                for (int d = 8; d < 64; d <<= 1) {
                    const float Ao = __shfl_up(Ap, d), Ho = __shfl_up(Hh, d);
                    if (lane >= d) { Hh = Ap * Ho + Hh; Ap = Ap * Ao; }
                }
                float Aex = __shfl_up(Ap, 8), Hex = __shfl_up(Hh, 8);
                if (sg == 0) { Aex = 1.f; Hex = 0.f; }
                float hin = Aex * carry + Hex;
                const float cnew = Ap * carry + Hh;
                carry = __shfl(cnew, 56 + (lane & 7));
                bf16_t* so = sO + (ci & 1) * 2048 + ch;
#pragma unroll
                for (int e = 0; e < 8; ++e) {
                    hin = av[e] * hin + bv[e];
                    const int i = sg * 8 + e, tk = dir ? 63 - i : i;
                    so[tk * 32] = f2bf(hin);
                }
            }
            prev_base = (size_t)dir * NTOK * D + (size_t)(rb + s0) * D + co0;
            if (HOST) { if (cv_ok) cv_pack(sCv, cv0, cv1); cvp = cvc; cvp_ok = cv_ok; }
        }
        __syncthreads();
        if (HOST && cvp_ok) cv_flush(cvp, sCv);
        {
            const u32x4 v = *(const u32x4*)(sO + (35 & 1) * 2048 + tid * 8);
            *(u32x4*)(HS + prev_base + (size_t)(tid >> 2) * D + (tid & 3) * 8) = v;
        }
    }
}

DI void phase_rg_combine(const Args& a) {
    const u32x4* G = (const u32x4*)(a.ws + RG_G);
    const u32x4* H0 = (const u32x4*)(a.ws + RG_HS);
    const u32x4* H1 = (const u32x4*)(a.ws + RG_HS + TOKD2);
    u32x4* A2 = (u32x4*)(a.ws + RG_A2);
    const size_t n = (size_t)NTOK * D / 8;
    for (size_t i = (size_t)blockIdx.x * NTHR + threadIdx.x; i < n; i += (size_t)gridDim.x * NTHR) {
        const u32x4 g = G[i], h0 = H0[i], h1 = H1[i];
        u32x4 o;
#pragma unroll
        for (int e = 0; e < 4; ++e) o[e] = pk2(lof(g[e]) * (lof(h0[e]) + lof(h1[e])), hif(g[e]) * (hif(h0[e]) + hif(h1[e])));
        A2[i] = o;
    }
}

DI void phase_rg_out(const Args& a, int li, int j) {
    gemm_dense_phase((const bf16_t*)(a.ws + RG_A2), D, li == 3 ? NLAT : NTOK, (const bf16_t*)(a.ws + W_RGOUT) + (size_t)j * 1024 * 1024, 1024, 1024,
        [&](int m0, int n0, const f32x4 (&acc)[4][4]) { epi_resid_f32(a, li, m0, n0, acc); });
}

DI void phase_mla_down(const Args& a) {
    bf16_t* CQ = (bf16_t*)(a.ws + MLA_CQ); bf16_t* CKV = (bf16_t*)(a.ws + MLA_CKV); float* KR = (float*)(a.ws + MLA_KR);
    gemm_dense_phase((const bf16_t*)(a.ws + WS_H), D, NTOK, (const bf16_t*)(a.ws + W_MDOWN), 512, 1024,
        [&](int m0, int n0, const f32x4 (&acc)[4][4]) {
            if (n0 < 256) epi_bf16_rowmajor(acc, [](int, int, const f32x4 v) { return v; }, [&](int row) { return CQ + (size_t)(m0 + row) * 256 + n0; });
            else if (n0 == 256) epi_bf16_rowmajor(acc, [](int, int, const f32x4 v) { return v; }, [&](int row) { return CKV + (size_t)(m0 + row) * 128; });
            else {
#pragma unroll
                for (int i = 0; i < 4; ++i)
#pragma unroll
                    for (int j = 0; j < 2; ++j) { const int n = lane_n(j); if (n < 32) *(f32x4*)(KR + (size_t)(m0 + lane_m(i)) * 32 + n) = acc[i][j]; }
            }
        });
}

DI int perm_key(int kp) { return (kp & ~12) | ((kp & 4) << 1) | ((kp & 8) >> 1); }

DI void phase_mla_up(const Args& a) {
    const int tid = threadIdx.x;
    const bf16_t* CQ = (const bf16_t*)(a.ws + MLA_CQ); const bf16_t* CKV = (const bf16_t*)(a.ws + MLA_CKV); const float* KR = (const float*)(a.ws + MLA_KR);
    bf16_t* Q = (bf16_t*)(a.ws + MLA_Q); bf16_t* Kb = (bf16_t*)(a.ws + MLA_K); bf16_t* VT = (bf16_t*)(a.ws + MLA_VT);
    const float* qkn = a.in[20];
    const float* RC = (const float*)(a.ws + WS_CTL + CTL_ROPE); const float* RS = RC + 512;
    const int MT_ = NTOK / 128;
    const int nq = MT_ * 16, nkv = MT_ * 16;
    const float QSCALE = 0.10206207261596575f * 1.4426950408889634f;
    for (int u = blockIdx.x; u < nq + nkv; u += gridDim.x) {
        const bool isq = u < nq;
        const int uu = isq ? u : u - nq;
        const int xc_ = uu & 7, s_ = uu >> 3;
        const int m0 = (((s_ >> 4) << 3) + xc_) * 128, head = s_ & 15;
        const bool islat = m0 < NLAT;
        const int bb = islat ? (m0 >> 11) : ((m0 - NLAT) >> 8);
        const int kp0 = islat ? CTXL + (m0 & (SEQ - 1)) : ((m0 - NLAT) & (CTXL - 1));
        __syncthreads();
        if (isq) {
            f32x4 hold[2][6];
            float ssq[2] = {0.f, 0.f};
            gemm_tile<4, 1, 2, 6, false>([&](int r) { return CQ + (size_t)(m0 + r) * 256; }, (const bf16_t*)(a.ws + W_MUQ) + (size_t)head * 96 * 256, 256, 256, hold, ssq);
            const int tz = opaque_tid();
            const int wave = tz >> 6, fq = (tz >> 4) & 3, fr = tz & 15;
#pragma unroll
            for (int i = 0; i < 2; ++i) {
                const int m = wave * 32 + i * 16 + fr;
                float sq = ssq[i]; sq += __shfl_xor(sq, 16); sq += __shfl_xor(sq, 32);
                const float rs0 = rsqrtf(sq * (1.f / 256.f) + EPS);
                float ss = 0.f;
#pragma unroll
                for (int jn = 0; jn < 6; ++jn) { hold[i][jn] *= rs0;
#pragma unroll
                    for (int e = 0; e < 4; ++e) ss += hold[i][jn][e] * hold[i][jn][e]; }
                ss += __shfl_xor(ss, 16); ss += __shfl_xor(ss, 32);
                const float rs = rsqrtf(ss * (1.f / 96.f) + EPS) ;
                f32x4 o[6];
#pragma unroll
                for (int jn = 0; jn < 6; ++jn) { const f32x4 g4 = *(const f32x4*)(qkn + jn * 16 + fq * 4); o[jn] = hold[i][jn] * rs * g4; }
#pragma unroll
                for (int jn = 4; jn < 6; ++jn) {
                    f32x4 other;
#pragma unroll
                    for (int e = 0; e < 4; ++e) other[e] = __shfl_xor(o[jn][e], 32);
                    if (islat) {
                        const int s = (m0 + m) & (SEQ - 1);
                        const int pos = jn == 4 ? (s >> 6) : (s & 63);
                        const f32x4 cs = *(const f32x4*)(RC + pos * 8 + (fq & 1) * 4), sn = *(const f32x4*)(RS + pos * 8 + (fq & 1) * 4);
#pragma unroll
                        for (int e = 0; e < 4; ++e) o[jn][e] = (fq < 2) ? o[jn][e] * cs[e] - other[e] * sn[e] : o[jn][e] * cs[e] + other[e] * sn[e];
                    }
                }
#pragma unroll
                for (int jn = 0; jn < 6; ++jn) {
                    const f32x4 v = o[jn] * QSCALE;
                    u32x2 pv; pv[0] = pk2(v[0], v[1]); pv[1] = pk2(v[2], v[3]);
                    *(u32x2*)(lds + m * 256 + (((jn * 2 + (fq >> 1)) ^ (m & 15)) << 4) + (fq & 1) * 8) = pv;
                }
            }
            __syncthreads();
#pragma unroll
            for (int it = 0; it < 8; ++it) {
                const int idx = tz + it * NTHR, row = idx >> 4, ch = idx & 15;
                if (ch < 12) {
                    const u32x4 v = *(const u32x4*)(lds + row * 256 + ((ch ^ (row & 15)) << 4));
                    *(u32x4*)(Q + (size_t)(m0 + row) * 1536 + head * 96 + ch * 8) = v;
                }
            }
        } else {
            f32x4 hold[4][4];
            float ssq[4] = {0.f, 0.f, 0.f, 0.f};
            gemm_tile<2, 2, 4, 4, false>([&](int r) { return CKV + (size_t)(m0 + r) * 128; }, (const bf16_t*)(a.ws + W_MUKV) + (size_t)head * 128 * 128, 128, 128, hold, ssq);
            const int tz = opaque_tid();
            const int wave = tz >> 6, wm = wave >> 1, wn = wave & 1, fq = (tz >> 4) & 3, fr = tz & 15;
            char* sK = lds; char* sV = lds + 32768;
#pragma unroll
            for (int i = 0; i < 4; ++i) {
                const int m = wm * 64 + i * 16 + fr, t = m0 + m;
                float sq = ssq[i]; sq += __shfl_xor(sq, 16); sq += __shfl_xor(sq, 32);
                const float rs0 = rsqrtf(sq * (1.f / 128.f) + EPS);
#pragma unroll
                for (int jn = 0; jn < 4; ++jn) hold[i][jn] *= rs0;
                if (wn == 0) {
                    const int base = (fq >> 1) * 16 + (fq & 1) * 4;
                    const f32x4 z1 = *(const f32x4*)(KR + (size_t)t * 32 + base);
                    const f32x4 z2 = *(const f32x4*)(KR + (size_t)t * 32 + base + 8);
                    float ss = 0.f;
#pragma unroll
                    for (int jn = 0; jn < 4; ++jn)
#pragma unroll
                        for (int e = 0; e < 4; ++e) ss += hold[i][jn][e] * hold[i][jn][e];
#pragma unroll
                    for (int e = 0; e < 4; ++e) ss += z1[e] * z1[e] + z2[e] * z2[e];
                    ss += __shfl_xor(ss, 16); ss += __shfl_xor(ss, 32);
                    const float rs = rsqrtf(ss * (1.f / 96.f) + EPS);
#pragma unroll
                    for (int jn = 0; jn < 4; ++jn) {
                        const f32x4 g4 = *(const f32x4*)(qkn + 96 + jn * 16 + fq * 4);
                        const f32x4 v = hold[i][jn] * rs * g4;
                        u32x2 pv; pv[0] = pk2(v[0], v[1]); pv[1] = pk2(v[2], v[3]);
                        *(u32x2*)(sK + m * 256 + (((jn * 2 + (fq >> 1)) ^ (m & 15)) << 4) + (fq & 1) * 8) = pv;
                    }
                    const f32x4 g1 = *(const f32x4*)(qkn + 96 + 64 + base), g2 = *(const f32x4*)(qkn + 96 + 64 + base + 8);
                    f32x4 a1 = z1 * rs * g1, a2 = z2 * rs * g2;
                    if (islat) {
                        const int s = t & (SEQ - 1);
                        const int pos = (fq >> 1) == 0 ? (s >> 6) : (s & 63);
                        const f32x4 cs = *(const f32x4*)(RC + pos * 8 + (fq & 1) * 4), sn = *(const f32x4*)(RS + pos * 8 + (fq & 1) * 4);
                        const f32x4 b1 = a1 * cs - a2 * sn, b2 = a2 * cs + a1 * sn;
                        a1 = b1; a2 = b2;
                    }
                    u32x2 p1, p2; p1[0] = pk2(a1[0], a1[1]); p1[1] = pk2(a1[2], a1[3]); p2[0] = pk2(a2[0], a2[1]); p2[1] = pk2(a2[2], a2[3]);
                    const int c1 = 8 + (fq >> 1) * 2;
                    *(u32x2*)(sK + m * 256 + ((c1 ^ (m & 15)) << 4) + (fq & 1) * 8) = p1;
                    *(u32x2*)(sK + m * 256 + (((c1 + 1) ^ (m & 15)) << 4) + (fq & 1) * 8) = p2;
                }
                {
                    const bool odd = fr & 1;
                    const int mp = perm_key(m & ~1);
#pragma unroll
                    for (int jn = 0; jn < 4; ++jn) {
                        const f32x4 v = hold[i][jn];
                        const float r0 = __shfl_xor(odd ? v[0] : v[2], 1), r1 = __shfl_xor(odd ? v[1] : v[3], 1);
                        if (wn == 1) {
                            const int e0 = jn * 16 + fq * 4 + (odd ? 2 : 0);
                            const unsigned w0 = odd ? pk2(r0, v[2]) : pk2(v[0], r0), w1 = odd ? pk2(r1, v[3]) : pk2(v[1], r1);
                            *(unsigned*)(sV + e0 * 256 + (((mp >> 3) ^ (e0 & 15)) << 4) + (mp & 6) * 2) = w0;
                            *(unsigned*)(sV + (e0 + 1) * 256 + (((mp >> 3) ^ ((e0 + 1) & 15)) << 4) + (mp & 6) * 2) = w1;
                        }
                    }
                }
            }
            __syncthreads();
            bf16_t* kdst = Kb + ((size_t)(bb * 16 + head) * NKEY + kp0) * 96;
#pragma unroll
            for (int it = 0; it < 8; ++it) {
                const int idx = tz + it * NTHR, row = idx >> 4, ch = idx & 15;
                if (ch < 12) {
                    const u32x4 v = *(const u32x4*)(sK + row * 256 + ((ch ^ (row & 15)) << 4));
                    *(u32x4*)(kdst + (size_t)row * 96 + ch * 8) = v;
                }
            }
            bf16_t* vdst = VT + ((size_t)(bb * 16 + head) * 64) * NKEY + kp0;
#pragma unroll
            for (int it = 0; it < 4; ++it) {
                const int idx = tz + it * NTHR, row = idx >> 4, ch = idx & 15;
                const u32x4 v = *(const u32x4*)(sV + row * 256 + ((ch ^ (row & 15)) << 4));
                *(u32x4*)(vdst + (size_t)row * NKEY + ch * 8) = v;
            }
        }
    }
}

DI void phase_mla_attn(const Args& a) {
    const int tid = threadIdx.x, lane = tid & 63, wave = tid >> 6;
    const int r = lane & 31, h = lane >> 5;
    const bf16_t* Q = (const bf16_t*)(a.ws + MLA_Q); const bf16_t* Kb = (const bf16_t*)(a.ws + MLA_K); const bf16_t* VT = (const bf16_t*)(a.ws + MLA_VT);
    bf16_t* O = (bf16_t*)(a.ws + MLA_O);
    constexpr int KT_B = 64 * 192, VT_B = 64 * 128, ST_B = KT_B + VT_B;
    unsigned* sCv = (unsigned*)(lds + 49152);
    const int cv_per = 18432 / gridDim.x;
    int cvn = 0, itc = 0;
    bool cv_pack_p = false, cv_flush_p = false;
    CvTile cvB, cvC; cvB.src = nullptr; cvB.dst = nullptr; cvB.K = 0; cvB.N = 0; cvB.perm = 0; cvB.k0 = 0; cvB.n0 = 0; cvC = cvB;
    f32x4 cv0[4], cv1[4];
#pragma unroll
    for (int i = 0; i < 4; ++i) { cv0[i] = (f32x4){0.f, 0.f, 0.f, 0.f}; cv1[i] = cv0[i]; }
    auto cv_step = [&](bool may_load) {
        if (cv_flush_p) { cv_flush(cvC, sCv); cv_flush_p = false; }
        if (cv_pack_p) { cv_pack(sCv, cv0, cv1); cvC = cvB; cv_flush_p = true; cv_pack_p = false; }
        if (may_load && cvn < cv_per) {
            const int t = cvn * gridDim.x + blockIdx.x;
            cvB = moe_cv_tile(a, 1 + t / 6144, t % 6144); cv_load(cvB, cv0, cv1); cv_pack_p = true; ++cvn;
        }
    };
    for (int u = blockIdx.x; u < 2048 + 256; u += gridDim.x) {
        const bool isctx = u >= 2048;
        const int uu = isctx ? u - 2048 : u;
        const int xc_ = uu & 7, s_ = uu >> 3, bh_ = ((s_ >> 4) << 3) + xc_;
        const int qb = isctx ? (uu & 1) : (s_ & 15), head = isctx ? ((uu >> 1) & 15) : (bh_ & 15), b = isctx ? (uu >> 5) : (bh_ >> 4);
        const int ntile = isctx ? CTXL / 64 : NKEY / 64;
        const int t = (isctx ? NLAT + b * CTXL : b * SEQ) + qb * 128 + wave * 32 + r;
        const bf16_t* kbase = Kb + (size_t)(b * 16 + head) * NKEY * 96;
        const bf16_t* vbase = VT + (size_t)(b * 16 + head) * 64 * NKEY;
        bf16x8 qf[6];
#pragma unroll
        for (int kk = 0; kk < 6; ++kk) qf[kk] = *(const bf16x8*)(Q + (size_t)t * 1536 + head * 96 + kk * 16 + h * 8);
        f32x16 o[2];
#pragma unroll
        for (int e = 0; e < 16; ++e) { o[0][e] = 0.f; o[1][e] = 0.f; }
        float lsum = 0.f;
        __syncthreads();
        auto stage = [&](int kt, int buf) {
            char* sk = lds + buf * ST_B; char* sv = sk + KT_B;
            const int key0 = kt * 64;
#pragma unroll
            for (int i = 0; i < 3; ++i) {
                const int idx = tid + i * NTHR, row = idx / 12, slot = idx - row * 12;
                int c = slot - ((row >> 2) % 12); if (c < 0) c += 12;
                dma16(kbase + (size_t)(key0 + row) * 96 + c * 8, sk + idx * 16);
            }
#pragma unroll
            for (int i = 0; i < 2; ++i) {
                const int idx = tid + i * NTHR, row = idx >> 3, c = (idx & 7) ^ ((row >> 1) & 7);
                dma16(vbase + (size_t)row * NKEY + key0 + c * 8, sv + idx * 16);
            }
        };
        stage(0, 0);
#pragma unroll 1
        for (int kt = 0; kt < ntile; ++kt) {
            wait_vm0();
            __syncthreads();
            if (kt + 1 < ntile) stage(kt + 1, (kt + 1) & 1);
            cv_step((itc & 3) == 0); ++itc;
            const char* sk = lds + (kt & 1) * ST_B; const char* sv = sk + KT_B;
            f32x16 st[2];
#pragma unroll
            for (int e = 0; e < 16; ++e) { st[0][e] = -8.f; st[1][e] = -8.f; }
#pragma unroll
            for (int kk = 0; kk < 6; ++kk)
#pragma unroll
                for (int si = 0; si < 2; ++si) {
                    const int s = si * 32 + r;
                    int slot = kk * 2 + h + ((s >> 2) % 12); if (slot >= 12) slot -= 12;
                    st[si] = mfma32(ldsv8(sk + s * 192 + slot * 16), qf[kk], st[si]);
                }
            float ps = 0.f;
#pragma unroll
            for (int si = 0; si < 2; ++si)
#pragma unroll
                for (int e = 0; e < 16; ++e) { const float p = __builtin_amdgcn_exp2f(st[si][e]); st[si][e] = p; ps += p; }
            lsum += ps;
#pragma unroll
            for (int si = 0; si < 2; ++si)
#pragma unroll
                for (int ks = 0; ks < 2; ++ks) {
                    u32x4 pp;
                    pp[0] = pk2(st[si][8 * ks + 0], st[si][8 * ks + 1]); pp[1] = pk2(st[si][8 * ks + 2], st[si][8 * ks + 3]);
                    pp[2] = pk2(st[si][8 * ks + 4], st[si][8 * ks + 5]); pp[3] = pk2(st[si][8 * ks + 6], st[si][8 * ks + 7]);
                    const bf16x8 pf = __builtin_bit_cast(bf16x8, pp);
#pragma unroll
                    for (int et = 0; et < 2; ++et) {
                        const int e = et * 32 + r;
                        o[et] = mfma32(ldsv8(sv + e * 128 + (((si * 4 + ks * 2 + h) ^ ((e >> 1) & 7)) << 4)), pf, o[et]);
                    }
                }
        }
        lsum += __shfl_xor(lsum, 32);
        const float inv = 1.f / lsum;
#pragma unroll
        for (int et = 0; et < 2; ++et)
#pragma unroll
            for (int g = 0; g < 4; ++g) {
                f32x4 v; v[0] = o[et][4 * g] * inv; v[1] = o[et][4 * g + 1] * inv; v[2] = o[et][4 * g + 2] * inv; v[3] = o[et][4 * g + 3] * inv;
                st_bf4(O + (size_t)t * D + head * 64 + et * 32 + 8 * g + 4 * h, v);
            }
    }
    while (cvn < cv_per || cv_pack_p || cv_flush_p) { __syncthreads(); cv_step(!cv_pack_p && !cv_flush_p); }
}

DI void phase_mla_out(const Args& a, int li) {
    gemm_dense_phase((const bf16_t*)(a.ws + MLA_O), D, NTOK, (const bf16_t*)(a.ws + W_MO), 1024, 1024,
        [&](int m0, int n0, const f32x4 (&acc)[4][4]) { epi_resid_f32(a, li, m0, n0, acc); });
}

DI void phase_ml_in(const Args& a) {
    bf16_t* Qm = (bf16_t*)(a.ws + ML_Q); bf16_t* Km = (bf16_t*)(a.ws + ML_K); bf16_t* VT = (bf16_t*)(a.ws + ML_VT);
    bf16_t* OG = (bf16_t*)(a.ws + ML_OG); float* GT = (float*)(a.ws + ML_GT);
    const float* gb = a.in[23];
    auto ident = [](int, int, const f32x4 v) { return v; };
    gemm_dense_phase<false>((const bf16_t*)(a.ws + WS_H), D, NTOK, (const bf16_t*)(a.ws + W_MLIN), 3200, 1024,
        [&](int m0, int n0, const f32x4 (&acc)[4][4]) {
            if (n0 < 512) {
                epi_bf16_rowmajor(acc, [](int, int, const f32x4 v) { return v * 0.08838834764831845f; }, [&](int row) { return Qm + (size_t)(m0 + row) * 512 + n0; });
            } else if (n0 < 1024) {
                epi_bf16_rowmajor(acc, ident, [&](int row) { return Km + (size_t)(m0 + row) * 512 + (n0 - 512); });
            } else if (n0 < 2048) {
                __syncthreads();
                epi_stage_bf16_T(acc, ident);
                __syncthreads();
                epi_flush_bf16([&](int row) { return VT + (size_t)(n0 - 1024 + row) * NTOK + m0; }, [](int) { return true; });
            } else if (n0 < 3072) {
                epi_bf16_rowmajor(acc, [](int, int, const f32x4 v) { f32x4 s; s[0] = sigmoidf_(v[0]); s[1] = sigmoidf_(v[1]); s[2] = sigmoidf_(v[2]); s[3] = sigmoidf_(v[3]); return s; },
                                  [&](int row) { return OG + (size_t)(m0 + row) * D + (n0 - 2048); });
            } else {
#pragma unroll
                for (int i = 0; i < 4; ++i) {
                    const int n = lane_n(0);
                    if (n < 16) { f32x4 s = acc[i][0]; s[0] += gb[n]; s[1] += gb[n + 1]; s[2] += gb[n + 2]; s[3] += gb[n + 3]; *(f32x4*)(GT + (size_t)(m0 + lane_m(i)) * 16 + n) = s; }
                }
            }
        });
}

template <int VAR = 0>
DI void phase_ml_scan(const Args& a) {
    const int tid = threadIdx.x, lane = tid & 63, wave = tid >> 6;
    const int fr = lane & 15, fq = lane >> 4;
    const bf16_t* Qm = (const bf16_t*)(a.ws + ML_Q); const bf16_t* Km = (const bf16_t*)(a.ws + ML_K);
    const bf16_t* VT = (const bf16_t*)(a.ws + ML_VT);
    const float* GT = (const float*)(a.ws + ML_GT);
    bf16_t* HS = (bf16_t*)(a.ws + (VAR ? WS_Y : ML_HS));
    char* sQ = lds;
    char* sK = lds + 16384;
    char* sS = lds + 32768;
    char* sVT = lds + 40960;
    char* sCT = lds + 47104;
    float* sRow = (float*)(lds + 59392);
    float* sCol = sRow + 64;
    float* sInt = sCol + 64;
    float* sNrm = sInt + 64;
    float* sWv = sNrm + 64;
    float* sSc = sWv + 64;
    for (int u = blockIdx.x; u < 512; u += gridDim.x) {
        const int xc_ = u & 7, s_ = u >> 3, bh_ = ((s_ >> 4) << 3) + xc_;
        const int sl = s_ & 7, dir = (s_ >> 3) & 1, head = bh_ & 3, b = bh_ >> 2;
        auto chunk_t0 = [&](int ci) {
            const int seg = ci >= 4, L = seg ? SEQ : CTXL, nch = L / 64, jc = seg ? ci - 4 : ci;
            const int oc = dir ? nch - 1 - jc : jc;
            return (seg ? b * SEQ : NLAT + b * CTXL) + oc * 64;
        };
        u32x4 pq[4], pk[4], pvt;
        float g_bc = 0.f, g_av = 0.f, g_pm = 0.f;
        auto load_tiles = [&](int t0) {
            const int tid = opaque_tid();
#pragma unroll
            for (int i = 0; i < 4; ++i) {
                const int idx = tid + i * NTHR, row = idx >> 4, c = (idx & 15) ^ (row & 15), ck = (idx & 15) ^ trswz(row);
                pq[i] = *(const u32x4*)(Qm + (size_t)(t0 + row) * 512 + head * 128 + c * 8);
                pk[i] = *(const u32x4*)(Km + (size_t)(t0 + row) * 512 + head * 128 + ck * 8);
            }
            { const int row = tid >> 3, c = (tid & 7) ^ (row & 7); pvt = *(const u32x4*)(VT + (size_t)(head * 256 + sl * 32 + row) * NTOK + t0 + c * 8); }
        };
        auto load_gates = [&](int ci) {
            if (wave == 0) { const float* g = (const float*)(a.ws + WS_GS) + ((size_t)u * 36 + ci) * 192 + lane; g_bc = g[0]; g_av = g[64]; g_pm = g[128]; }
        };
        auto store_tiles = [&]() {
            const int tid = opaque_tid();
#pragma unroll
            for (int i = 0; i < 4; ++i) { *(u32x4*)(sQ + (tid + i * NTHR) * 16) = pq[i]; *(u32x4*)(sK + (tid + i * NTHR) * 16) = pk[i]; }
            *(u32x4*)(sVT + tid * 16) = pvt;
        };
        auto gate_scalars = [&]() {
            const int s = dir ? 63 - lane : lane;
            const float bc = g_bc, av = g_av, pm = g_pm;
            const float mst = sSc[1];
            const float mm = fmaxf(mst, pm);
            sRow[s] = -mm;
            sCol[s] = av;
            sInt[s] = fexp(mst - mm);
            sNrm[s] = fexp(-(bc + mm));
            const float mmL = __shfl(mm, 63), bL = __shfl(bc, 63);
            sWv[s] = fexp(av - mmL);
            if (lane == 0) { sSc[0] = fexp(mst - mmL); sSc[1] = bL + mmL; }
        };
#pragma unroll 1
        for (int ci = wave; ci < 36; ci += 4) {
            const int t0 = chunk_t0(ci);
            const int s = dir ? 63 - lane : lane;
            const float ig = GT[(size_t)(t0 + s) * 16 + dir * 8 + head];
            const float fg = GT[(size_t)(t0 + s) * 16 + dir * 8 + 4 + head];
            const float lf = fminf(fg, 0.f) - __logf(1.f + fexp(-fabsf(fg)));
            float bc = lf;
#pragma unroll
            for (int d = 1; d < 64; d <<= 1) { const float o = __shfl_up(bc, d); if (lane >= d) bc += o; }
            const float av = ig - bc;
            float pm = av;
#pragma unroll
            for (int d = 1; d < 64; d <<= 1) { const float o = __shfl_up(pm, d); if (lane >= d) pm = fmaxf(pm, o); }
            float* g = (float*)(a.ws + WS_GS) + ((size_t)u * 36 + ci) * 192 + lane; g[0] = bc; g[64] = av; g[128] = pm;
        }
        __syncthreads();
        for (int i = tid; i < 12288 / 16; i += NTHR) *(u32x4*)(sCT + i * 16) = (u32x4){0u, 0u, 0u, 0u};
        for (int i = tid; i < 16 * 8; i += NTHR) {
            const int row = 32 + (i >> 3), c = i & 7;
            const unsigned v = row == 32 ? 0x3f803f80u : 0u;
            *(u32x4*)(sVT + swz128(row, c)) = (u32x4){v, v, v, v};
        }
        if (tid == 0) sSc[1] = -1e30f;
        f32x4 accC[2][3];
#pragma unroll
        for (int i = 0; i < 2; ++i)
#pragma unroll
            for (int jn = 0; jn < 3; ++jn) accC[i][jn] = (f32x4){0.f, 0.f, 0.f, 0.f};
        load_tiles(chunk_t0(0));
        __syncthreads();
        load_gates(0);
        store_tiles();
        if (wave == 0) gate_scalars();
        __syncthreads();
#pragma unroll 1
        for (int ci = 0; ci < 36; ++ci) {
            const int t0 = chunk_t0(ci);
            if (!(VAR & 8) && ci + 1 < 36) { load_tiles(chunk_t0(ci + 1)); load_gates(ci + 1); }
            f32x4 sacc[4];
#pragma unroll
            for (int jt = 0; jt < 4; ++jt) sacc[jt] = (f32x4){0.f, 0.f, 0.f, 0.f};
#pragma unroll
            for (int kk = 0; kk < 4; ++kk) {
                const bf16x8 qf = ldsv8(sQ + swz256(wave * 16 + fr, kk * 4 + fq));
#pragma unroll
                for (int jt = 0; jt < 4; ++jt) { const int sr = jt * 16 + fr; sacc[jt] = mfma16(ldsv8(sK + sr * 256 + (((kk * 4 + fq) ^ trswz(sr)) << 4)), qf, sacc[jt]); }
            }
            {
                const int tq = wave * 16 + fr;
                const float rt = sRow[tq];
#pragma unroll
                for (int jt = 0; jt < 4; ++jt) {
                    const f32x4 cl = *(const f32x4*)(sCol + jt * 16 + fq * 4);
                    f32x4 v;
#pragma unroll
                    for (int e = 0; e < 4; ++e) {
                        const int s = jt * 16 + fq * 4 + e;
                        const bool ok = dir ? (s >= tq) : (s <= tq);
                        v[e] = ok ? sacc[jt][e] * fexp(rt + cl[e]) : 0.f;
                    }
                    u32x2 pv; pv[0] = pk2(v[0], v[1]); pv[1] = pk2(v[2], v[3]);
                    *(u32x2*)(sS + swz128(tq, jt * 2 + (fq >> 1)) + (fq & 1) * 8) = pv;
                }
            }
            lds_barrier();
            if (!(VAR & 2)) {
                f32x4 n1[3], n2[3];
#pragma unroll
                for (int jt = 0; jt < 3; ++jt) { n1[jt] = (f32x4){0.f, 0.f, 0.f, 0.f}; n2[jt] = (f32x4){0.f, 0.f, 0.f, 0.f}; }
#pragma unroll
                for (int kk = 0; kk < 2; ++kk) {
                    const bf16x8 sf = ldsv8(sS + swz128(wave * 16 + fr, kk * 4 + fq));
#pragma unroll
                    for (int jt = 0; jt < 3; ++jt) n1[jt] = mfma16(ldsv8(sVT + swz128(jt * 16 + fr, kk * 4 + fq)), sf, n1[jt]);
                }
#pragma unroll
                for (int kk = 0; kk < 4; ++kk) {
                    const bf16x8 qf = ldsv8(sQ + swz256(wave * 16 + fr, kk * 4 + fq));
#pragma unroll
                    for (int jt = 0; jt < 3; ++jt) n2[jt] = mfma16(ldsv8(sCT + swz256(jt * 16 + fr, kk * 4 + fq)), qf, n2[jt]);
                }
                const int tq = wave * 16 + fr;
                const float it = sInt[tq];
                float den = n1[2][0] + it * n2[2][0];
                den = __shfl(den, fr);
                const float dn = fmaxf(fabsf(den), sNrm[tq]);
                const float inv = rcpf_(dn);
                bf16_t* hp = HS + (size_t)dir * NTOK * D + (size_t)(t0 + tq) * D + head * 256 + sl * 32 + fq * 4;
#pragma unroll
                for (int jt = 0; jt < 2; ++jt) {
                    f32x4 v;
#pragma unroll
                    for (int e = 0; e < 4; ++e) v[e] = (n1[jt][e] + it * n2[jt][e]) * inv;
                    st_bf4(hp + jt * 16, v);
                }
            }
            if (!(VAR & 4)) {
                const float decay = sSc[0];
#pragma unroll
                for (int i = 0; i < 2; ++i)
#pragma unroll
                    for (int jn = 0; jn < 3; ++jn) accC[i][jn] *= decay;
#pragma unroll
                for (int kk = 0; kk < 2; ++kk) {
                    bf16x8 vf[3];
#pragma unroll
                    for (int jn = 0; jn < 3; ++jn) vf[jn] = ldsv8(sVT + swz128(jn * 16 + fr, kk * 4 + fq));
                    const f32x4 w0 = *(const f32x4*)(sWv + kk * 32 + fq * 8), w1 = *(const f32x4*)(sWv + kk * 32 + fq * 8 + 4);
#pragma unroll
                    for (int i = 0; i < 2; ++i) {
                        const int tq_ = (lane >> 2) & 3, tp_ = lane & 3, chd = (wave * 2 + i) * 2 + (tp_ >> 1);
                        const int sA_ = kk * 32 + 8 * fq + tq_, sB_ = sA_ + 4;
                        const s16x4 klo = lds_tr(sK + sA_ * 256 + ((chd ^ trswz(sA_)) << 4) + (tp_ & 1) * 8);
                        const s16x4 khi = lds_tr(sK + sB_ * 256 + ((chd ^ trswz(sB_)) << 4) + (tp_ & 1) * 8);
                        const u32x4 kr = __builtin_bit_cast(u32x4, __builtin_shufflevector(klo, khi, 0, 1, 2, 3, 4, 5, 6, 7));
                        u32x4 ks;
                        ks[0] = pk2(lof(kr[0]) * w0[0], hif(kr[0]) * w0[1]); ks[1] = pk2(lof(kr[1]) * w0[2], hif(kr[1]) * w0[3]);
                        ks[2] = pk2(lof(kr[2]) * w1[0], hif(kr[2]) * w1[1]); ks[3] = pk2(lof(kr[3]) * w1[2], hif(kr[3]) * w1[3]);
                        const bf16x8 kf = __builtin_bit_cast(bf16x8, ks);
#pragma unroll
                        for (int jn = 0; jn < 3; ++jn) accC[i][jn] = mfma16(kf, vf[jn], accC[i][jn]);
                    }
                }
            }
            lds_barrier();
#pragma unroll
            for (int i = 0; i < 2; ++i)
#pragma unroll
                for (int jn = 0; jn < 3; ++jn) {
                    const int dd = (wave * 2 + i) * 16 + fq * 4, ee = jn * 16 + fr;
                    u32x2 pv; pv[0] = pk2(accC[i][jn][0], accC[i][jn][1]); pv[1] = pk2(accC[i][jn][2], accC[i][jn][3]);
                    *(u32x2*)(sCT + swz256(ee, dd >> 3) + (dd & 7) * 2) = pv;
                }
            if (ci + 1 < 36) {
                if (!(VAR & 8)) store_tiles();
                if (wave == 0 && !(VAR & 16)) gate_scalars();
            }
            lds_barrier();
        }
    }
}

DI void phase_ml_readout(const Args& a) {
    const int tid = threadIdx.x, lane = tid & 63, wave = tid >> 6;
    const bf16_t* H0 = (const bf16_t*)(a.ws + ML_HS); const bf16_t* H1 = H0 + (size_t)NTOK * D;
    const bf16_t* OG = (const bf16_t*)(a.ws + ML_OG); bf16_t* A2 = (bf16_t*)(a.ws + ML_A2);
    const float* on = a.in[24];
    for (int t = blockIdx.x * 4 + wave; t < NTOK; t += gridDim.x * 4) {
        const size_t off = (size_t)t * D + lane * 16;
        const u32x4 a0 = *(const u32x4*)(H0 + off), a1 = *(const u32x4*)(H0 + off + 8);
        const u32x4 b0 = *(const u32x4*)(H1 + off), b1 = *(const u32x4*)(H1 + off + 8);
        float v[16];
#pragma unroll
        for (int e = 0; e < 4; ++e) {
            v[2 * e] = lof(a0[e]) + lof(b0[e]); v[2 * e + 1] = hif(a0[e]) + hif(b0[e]);
            v[8 + 2 * e] = lof(a1[e]) + lof(b1[e]); v[8 + 2 * e + 1] = hif(a1[e]) + hif(b1[e]);
        }
        float ss = 0.f;
#pragma unroll
        for (int e = 0; e < 16; ++e) ss += v[e] * v[e];
        ss += __shfl_xor(ss, 1); ss += __shfl_xor(ss, 2); ss += __shfl_xor(ss, 4); ss += __shfl_xor(ss, 8);
        const float rs = rsqrtf(ss * (1.f / 256.f) + EPS);
        const u32x4 g0 = *(const u32x4*)(OG + off), g1 = *(const u32x4*)(OG + off + 8);
        const float* onp = on + lane * 16;
        u32x4 o0, o1;
#pragma unroll
        for (int e = 0; e < 4; ++e) {
            o0[e] = pk2(v[2 * e] * rs * onp[2 * e] * lof(g0[e]), v[2 * e + 1] * rs * onp[2 * e + 1] * hif(g0[e]));
            o1[e] = pk2(v[8 + 2 * e] * rs * onp[8 + 2 * e] * lof(g1[e]), v[8 + 2 * e + 1] * rs * onp[8 + 2 * e + 1] * hif(g1[e]));
        }
        *(u32x4*)(A2 + off) = o0; *(u32x4*)(A2 + off + 8) = o1;
    }
}

DI void phase_ml_out(const Args& a, int li) {
    gemm_dense_phase((const bf16_t*)(a.ws + ML_A2), D, NTOK, (const bf16_t*)(a.ws + W_MLOUT), 1024, 1024,
        [&](int m0, int n0, const f32x4 (&acc)[4][4]) { epi_resid_f32(a, li, m0, n0, acc); });
}

template <int STAGE>
DI void phase_moe(const Args& a, int li) {
    const int tid = threadIdx.x, lane = tid & 63, wave = tid >> 6;
    const int fr = lane & 15, fq = lane >> 4, wm = wave >> 1, wn = wave & 1;
    const int* cnt = (const int*)(a.ws + WS_CTL + CTL_CNT) + li * 64;
    const int* list = (const int*)(a.ws + WS_LIST);
    const float* wsl = (const float*)(a.ws + WS_WSLOT);
    const bf16_t* F = (const bf16_t*)(a.ws + WS_H);
    bf16_t* HM = (bf16_t*)(a.ws + WS_HMID); bf16_t* Y = (bf16_t*)(a.ws + WS_Y);
    int* pre = (int*)(lds + LDS_AUX);
    int* srowb = pre + 16;
    const int xc = blockIdx.x & 7, rank = blockIdx.x >> 3, nrank = gridDim.x >> 3;
    __syncthreads();
    if (tid == 0) { int s = 0; for (int i = 0; i < 8; ++i) { pre[i] = s; s += (cnt[xc + 8 * i] + 127) >> 7; } pre[8] = s; }
    __syncthreads();
    const int T = pre[8];
    constexpr int NTN = STAGE == 0 ? 4 : 8;
    constexpr int KK = STAGE == 0 ? 1024 : 256;
    const int total = T * NTN;
    int e = 0, r0 = 0, ce = 0, nt = 0, cur = 0;
    auto decode = [&](int u) {
        const int ti = u / NTN; nt = u % NTN;
        int ei = 0;
#pragma unroll 1
        for (int s = 4; s > 0; s >>= 1) if (pre[ei + s] <= ti) ei += s;
        e = xc + 8 * ei; r0 = (ti - pre[ei]) * 128; ce = cnt[e];
    };
    GemmPipe g;
    auto prep = [&](int buf) {
        int* srow = srowb + buf * 128;
        if (tid < 128) srow[tid] = list[(size_t)e * NTOK + min(r0 + tid, ce - 1)];
        __syncthreads();
        if (STAGE == 0) g.setup([&](int r) { return F + (size_t)(srow[r] >> 1) * D; }, (const bf16_t*)(a.ws + W_GU) + ((size_t)(li * 64 + e) * 512 + nt * 128) * 1024, 1024);
        else g.setup([&](int r) { return HM + (size_t)srow[r] * 256; }, (const bf16_t*)(a.ws + W_DN) + ((size_t)(li * 64 + e) * 1024 + nt * 128) * 256, 256);
        g.issue(0, 0);
    };
    int u = rank;
    if (u < total) { decode(u); prep(cur); }
    while (u < total) {
        f32x4 acc[4][4];
        g.run(KK, acc);
        const int cr0 = r0, cce = ce, cnt_ = nt;
        const int* srow = srowb + cur * 128;
        u += nrank;
        if (u < total) { decode(u); prep(cur ^ 1); }
        if (STAGE == 0) {
            __syncthreads();
            {
                const int tz = opaque_tid();
#pragma unroll
                for (int i = 0; i < 4; ++i) {
                    const int m = lane_m(tz, i);
#pragma unroll
                    for (int p = 0; p < 2; ++p) {
                        const int c = (((tz >> 6) & 1) * 2 + p) * 16 + ((tz >> 4) & 3) * 4;
                        f32x4 v;
#pragma unroll
                        for (int x = 0; x < 4; ++x) { const float gg = acc[i][2 * p][x]; v[x] = gg * rcpf_(1.f + fexp(-gg)) * acc[i][2 * p + 1][x]; }
                        u32x2 o; o[0] = pk2(v[0], v[1]); o[1] = pk2(v[2], v[3]);
                        *(u32x2*)(lds + EPI_OFF + m * 128 + (((c >> 3) ^ (m & 7)) << 4) + (c & 4) * 2) = o;
                    }
                }
            }
            __syncthreads();
            {
                const int tz = opaque_tid();
#pragma unroll
                for (int it = 0; it < 4; ++it) {
                    const int idx = tz + it * NTHR, row = idx >> 3, ch = idx & 7;
                    const u32x4 v = *(const u32x4*)(lds + EPI_OFF + row * 128 + ((ch ^ (row & 7)) << 4));
                    if (cr0 + row < cce) *(u32x4*)(HM + (size_t)srow[row] * 256 + cnt_ * 64 + ch * 8) = v;
                }
            }
        } else {
            float wrow[4];
            {
                const int tz = opaque_tid();
#pragma unroll
                for (int i = 0; i < 4; ++i) wrow[i] = wsl[srow[lane_m(tz, i)]];
            }
            __syncthreads();
            epi_stage_bf16(acc, [&](int i, int, const f32x4 v) { return v * wrow[i]; });
            __syncthreads();
            epi_flush_bf16([&](int row) { return Y + (size_t)srow[row] * D + cnt_ * 128; }, [&](int row) { return cr0 + row < cce; });
        }
        cur ^= 1;
    }
    __syncthreads();
}

#ifndef DBG_GPROBE
#define DBG_GPROBE -1
#endif
template <int PM>
DI void phase_gemm_probe(const Args& a) {
    const bf16_t* A = (const bf16_t*)(a.ws + WS_H); const bf16_t* Bt = (const bf16_t*)(a.ws + W_RGIN);
    float* dummy = (float*)(a.ws + RG_A2);
    const int mt = 144, nt = 16, K = 1024;
    GemmPipe g;
    __syncthreads();
    for (int u = blockIdx.x; u < mt * nt; u += gridDim.x) {
        const int m0 = (u % mt) * 128, n0 = (u / mt) * 128;
        g.setup([&](int r) { return A + (size_t)(m0 + r) * 1024; }, Bt + (size_t)n0 * K, K);
        if (PM & 1) g.issue(0, 0);
        f32x4 acc[4][4];
        g.run_probe<PM>(K, acc);
        float s = 0.f;
#pragma unroll
        for (int i = 0; i < 4; ++i)
#pragma unroll
            for (int j = 0; j < 4; ++j) s += acc[i][j][0] + acc[i][j][1] + acc[i][j][2] + acc[i][j][3];
        if (s == 12345.678f) dummy[threadIdx.x] = s;
        if (PM & 8) {
            bf16_t* Yd = (bf16_t*)(a.ws + WS_Y);
            const int lane = threadIdx.x & 63, wave = threadIdx.x >> 6;
            const int mb = m0 + (wave >> 1) * 64 + (lane & 15), nb = n0 + (wave & 1) * 64 + (lane >> 4) * 4;
#pragma unroll
            for (int i = 0; i < 4; ++i)
#pragma unroll
                for (int j = 0; j < 4; ++j) {
                    f32x4 v = acc[i][j];
                    if (PM & 16) { v[0] = gelu_tanh(v[0]); v[1] = gelu_tanh(v[1]); v[2] = gelu_tanh(v[2]); v[3] = gelu_tanh(v[3]); }
                    st_bf4(Yd + (size_t)(mb + i * 16) * 2048 + nb + j * 16, v);
                }
        }
        __syncthreads();
    }
}

#ifndef DBG_STOP
#define DBG_STOP 99
#endif
#ifndef DBG_OFF
#define DBG_OFF 0
#endif
DI void phase_dbg(const Args& a) {
    const size_t n = (size_t)NLAT * D;
    const float* X = (const float*)(a.ws + WS_X);
    const bf16_t* B = (const bf16_t*)(a.ws + (size_t)DBG_OFF);
    for (size_t i = (size_t)blockIdx.x * NTHR + threadIdx.x; i < n; i += (size_t)gridDim.x * NTHR)
        a.out[i] = DBG_OFF ? bf2f(B[i]) : X[i];
}

constexpr int NPH = 34;
__global__ void __launch_bounds__(NTHR, 2) fwd(const Args a) {
    if (threadIdx.x == 0) *(uint4*)(lds + LDS_BARW) = make_uint4(0u, 0u, 0u, 0u);
    __syncthreads();
    XcdBarrier bar;
    const bool multi = (a.ph_hi - a.ph_lo) > 1;
    if (multi) bar = xcd_barrier_post((unsigned*)(a.ws + WS_CTL), (volatile LAS unsigned*)(lds + LDS_BARW));
#ifndef DBG_REP
#define DBG_REP -1
#endif
#ifndef DBG_REPN
#define DBG_REPN 3
#endif
#define RUN(id, ...) do { if (a.ph_lo <= (id) && (id) < a.ph_hi) { \
        if ((id) == DBG_REP) { for (int rep_ = 1; rep_ < DBG_REPN; ++rep_) { __VA_ARGS__; xcd_barrier(bar); } } \
        __VA_ARGS__; if ((id) + 1 < a.ph_hi) xcd_barrier(bar); } } while (0)
    RUN(0, phase_prologue(a));
    RUN(1, phase_token_row<0>(a, 0));
    RUN(2, phase_rg_in(a, 0));
    if (DBG_GPROBE >= 0) { RUN(2, phase_gemm_probe<(DBG_GPROBE < 0 ? 7 : DBG_GPROBE)>(a)); }
#ifdef DBG_SCANVAR
    RUN(3, phase_rg_scan<DBG_SCANVAR>(a, 0));
#endif
    RUN(3, phase_rg_scan(a, 0));
    RUN(4, phase_rg_combine(a));
    RUN(5, phase_rg_out(a, 0, 0));
    RUN(6, phase_token_router(a, 0));
    RUN(7, phase_moe<0>(a, 0));
    RUN(8, phase_moe<1>(a, 0));
    RUN(9, phase_token_row<0>(a, 1));
    RUN(10, phase_mla_down(a));
    RUN(11, phase_mla_up(a));
    RUN(12, phase_mla_attn(a));
    RUN(13, phase_mla_out(a, 1));
    RUN(14, phase_token_router(a, 1));
    RUN(15, phase_moe<0>(a, 1));
    RUN(16, phase_moe<1>(a, 1));
    RUN(17, phase_token_row<0>(a, 2));
    RUN(18, phase_ml_in(a));
#ifdef DBG_MLVAR
    RUN(19, phase_ml_scan<DBG_MLVAR>(a));
#endif
    RUN(19, phase_ml_scan(a));
    RUN(20, phase_ml_readout(a));
    RUN(21, phase_ml_out(a, 2));
    RUN(22, phase_token_router(a, 2));
    RUN(23, phase_moe<0>(a, 2));
    RUN(24, phase_moe<1>(a, 2));
    RUN(25, phase_token_row<0>(a, 3));
    RUN(26, phase_rg_in(a, 1));
    RUN(27, phase_rg_scan(a, 1));
    RUN(28, phase_rg_combine(a));
    RUN(29, phase_rg_out(a, 3, 1));
    RUN(30, phase_token_router(a, 3));
    RUN(31, phase_moe<0>(a, 3));
    RUN(32, phase_moe<1>(a, 3));
    RUN(33, phase_token_row<2>(a, 3));
    RUN(34, phase_dbg(a));
#undef RUN
}

static void add_td(Args& a, int& n, int& tile0, const float* src, bf16_t* dst, const float* rscale, long sb, long db, int K, int N, int Npad, int batch, int perm) {
    TDesc& t = a.td[n++];
    t.src = src; t.dst = dst; t.rscale = rscale; t.sb = sb; t.db = db; t.K = K; t.N = N; t.Npad = Npad; t.batch = batch; t.perm = perm;
    t.tiles_k = (K + 127) / 128; t.tiles_n = (Npad + 63) / 64; t.tile0 = tile0;
    tile0 += batch * t.tiles_k * t.tiles_n;
}

extern "C" void kernel_launch(void* const* d_in, const int* in_sizes, int n_in, void* d_out, int out_size, void* d_ws, size_t ws_size, hipStream_t stream) {
    static int grid = 0;
    if (grid == 0) {
        if (n_in != 32 || out_size != NLAT * D || ws_size < WS_END) { fprintf(stderr, "kernel_launch: unexpected sizes (n_in %d out %d ws %zu need %zu)\n", n_in, out_size, ws_size, (size_t)WS_END); grid = -1; return; }
        int dev = 0, cus = 0, per_cu = 0;
        (void)hipGetDevice(&dev);
        (void)hipDeviceGetAttribute(&cus, hipDeviceAttributeMultiprocessorCount, dev);
        if (hipOccupancyMaxActiveBlocksPerMultiprocessor(&per_cu, (const void*)fwd, NTHR, 0) != hipSuccess) per_cu = 0;
        (void)hipGetLastError();
        if (per_cu < 2) fprintf(stderr, "kernel_launch: note: occupancy query reports %d blocks per CU (need 2)\n", per_cu);
        grid = cus * (per_cu >= 2 ? 2 : (per_cu >= 1 ? 1 : 2));
    }
    if (grid < 0) return;
    (void)in_sizes;
    (void)hipMemsetAsync((char*)d_ws + WS_CTL, 0, CTL_BYTES, stream);
    Args a;
    memset(&a, 0, sizeof(a));
    for (int i = 0; i < 32; ++i) a.in[i] = (const float*)d_in[i];
    a.out = (float*)d_out; a.ws = (unsigned char*)d_ws;
    unsigned char* ws = (unsigned char*)d_ws;
    int n = 0, tile0 = 0;
    add_td(a, n, tile0, a.in[8], (bf16_t*)(ws + W_RGIN), nullptr, 1024L * 2048, 2048L * 1024, 1024, 2048, 2048, 2, 0);
    add_td(a, n, tile0, a.in[14], (bf16_t*)(ws + W_RGOUT), nullptr, 1024L * 1024, 1024L * 1024, 1024, 1024, 1024, 2, 0);
    for (int j = 0; j < 2; ++j) for (int dir = 0; dir < 2; ++dir) for (int g = 0; g < 2; ++g)
        add_td(a, n, tile0, a.in[11] + (size_t)((j * 2 + dir) * 2 + g) * 16 * 4096, (bf16_t*)(ws + W_RGG) + (size_t)(j * 2 + dir) * 16 * 8192 + g * 4096, nullptr, 4096, 8192, 64, 64, 64, 16, 0);
    add_td(a, n, tile0, a.in[15], (bf16_t*)(ws + W_MDOWN), nullptr, 0, 0, 1024, 416, 512, 1, 0);
    add_td(a, n, tile0, a.in[18], (bf16_t*)(ws + W_MUQ), a.in[16], 0, 0, 256, 1536, 1536, 1, 0);
    add_td(a, n, tile0, a.in[19], (bf16_t*)(ws + W_MUKV), a.in[17], 0, 0, 128, 2048, 2048, 1, 0);
    add_td(a, n, tile0, a.in[21], (bf16_t*)(ws + W_MO), nullptr, 0, 0, 1024, 1024, 1024, 1, 0);
    add_td(a, n, tile0, a.in[22], (bf16_t*)(ws + W_MLIN), nullptr, 0, 0, 1024, 3088, 3200, 1, 0);
    add_td(a, n, tile0, a.in[25], (bf16_t*)(ws + W_MLOUT), nullptr, 0, 0, 1024, 1024, 1024, 1, 0);
    add_td(a, n, tile0, a.in[30], (bf16_t*)(ws + W_GU), nullptr, 1024L * 512, 512L * 1024, 1024, 512, 512, 64, 1);
    add_td(a, n, tile0, a.in[31], (bf16_t*)(ws + W_DN), nullptr, 256L * 1024, 1024L * 256, 256, 1024, 1024, 64, 0);
    a.ntiles_total = tile0;
    if (n != NTD) { fprintf(stderr, "kernel_launch: descriptor count %d != %d\n", n, NTD); return; }
#if MK_ONE_LAUNCH
    a.ph_lo = 0; a.ph_hi = NPH;
    hipLaunchKernelGGL(fwd, dim3(grid), dim3(NTHR), 0, stream, a);
#else
    for (int ph = 0; ph < NPH && ph <= DBG_STOP; ++ph) {
        a.ph_lo = ph; a.ph_hi = ph + 1;
        hipLaunchKernelGGL(fwd, dim3(grid), dim3(NTHR), 0, stream, a);
    }
    if (DBG_STOP < NPH) { a.ph_lo = 34; a.ph_hi = 35; hipLaunchKernelGGL(fwd, dim3(grid), dim3(NTHR), 0, stream, a); }
#endif
}
```

```cpp
#include <hip/hip_runtime.h>
#include <stdint.h>
#include <string.h>
#include <stdio.h>

#ifndef MK_ONE_LAUNCH
#define MK_ONE_LAUNCH 1
#endif

#define DI __device__ __forceinline__
typedef unsigned short bf16_t;
typedef __attribute__((ext_vector_type(8))) short bf16x8;
typedef __attribute__((ext_vector_type(4))) float f32x4;
typedef __attribute__((ext_vector_type(16))) float f32x16;
typedef __attribute__((ext_vector_type(2))) float f32x2;
typedef __attribute__((ext_vector_type(2))) __bf16 bfx2;
typedef __attribute__((ext_vector_type(4))) unsigned u32x4;
typedef __attribute__((ext_vector_type(2))) unsigned u32x2;

constexpr int D = 1024, NB = 8, SEQ = 2048, CTXL = 256;
constexpr int NLAT = NB * SEQ, NCTX = NB * CTXL, NTOK = NLAT + NCTX;
constexpr int NKEY = CTXL + SEQ;
constexpr int NTHR = 256;
constexpr int LDS_BYTES = 73728;
constexpr int LDS_AUX = 65536;
constexpr int LDS_BARW = LDS_BYTES - 16;
constexpr float EPS = 1e-6f;

constexpr size_t al256(size_t x) { return (x + 255) & ~(size_t)255; }
constexpr size_t WS_CTL = 0;
constexpr size_t CTL_BYTES = 65536;
constexpr size_t CTL_CNT = 16384;
constexpr size_t CTL_ROPE = 32768;
constexpr size_t WS_MOD = WS_CTL + CTL_BYTES;
constexpr size_t WS_X = al256(WS_MOD + 4 * 9 * 6144 * 4);
constexpr size_t WS_H = al256(WS_X + (size_t)NTOK * D * 4);
constexpr size_t WS_SCR = al256(WS_H + (size_t)NTOK * D * 2);
constexpr size_t SCR_BYTES = (size_t)256 << 20;
constexpr size_t TOKD2 = (size_t)NTOK * D * 2;
constexpr size_t RG_G = WS_SCR, RG_U = RG_G + TOKD2, RG_HS = RG_U + TOKD2, RG_A2 = RG_HS + 2 * TOKD2;
constexpr size_t MLA_CQ = WS_SCR;
constexpr size_t MLA_CKV = MLA_CQ + (size_t)NTOK * 256 * 2;
constexpr size_t MLA_KR = MLA_CKV + (size_t)NTOK * 128 * 2;
constexpr size_t MLA_Q = MLA_KR + (size_t)NTOK * 32 * 4;
constexpr size_t MLA_K = MLA_Q + (size_t)NTOK * 1536 * 2;
constexpr size_t MLA_VT = MLA_K + (size_t)NB * 16 * NKEY * 96 * 2;
constexpr size_t MLA_O = MLA_VT + (size_t)NB * 16 * 64 * NKEY * 2;
constexpr size_t MLA_END = MLA_O + TOKD2;
constexpr size_t ML_Q = WS_SCR;
constexpr size_t ML_K = ML_Q + (size_t)NTOK * 512 * 2;
constexpr size_t ML_KT = ML_K + (size_t)NTOK * 512 * 2;
constexpr size_t ML_VT = ML_KT + (size_t)NTOK * 512 * 2;
constexpr size_t ML_OG = ML_VT + TOKD2;
constexpr size_t ML_GT = ML_OG + TOKD2;
constexpr size_t ML_HS = ML_GT + (size_t)NTOK * 16 * 4;
constexpr size_t ML_A2 = ML_HS + 2 * TOKD2;
constexpr size_t ML_END = ML_A2 + TOKD2;
static_assert(RG_A2 + TOKD2 <= WS_SCR + SCR_BYTES && MLA_END <= WS_SCR + SCR_BYTES && ML_END <= WS_SCR + SCR_BYTES, "scratch");
constexpr size_t WS_LIST = WS_SCR + SCR_BYTES;
constexpr size_t WS_WSLOT = al256(WS_LIST + (size_t)64 * NTOK * 4);
constexpr size_t WS_HMID = al256(WS_WSLOT + (size_t)2 * NTOK * 4);
constexpr size_t WS_Y = al256(WS_HMID + (size_t)2 * NTOK * 256 * 2);
constexpr size_t WS_W = al256(WS_Y + (size_t)2 * NTOK * D * 2);
constexpr size_t W_RGIN = WS_W;
constexpr size_t W_RGOUT = W_RGIN + (size_t)2 * 2048 * 1024 * 2;
constexpr size_t W_RGG = W_RGOUT + (size_t)2 * 1024 * 1024 * 2;
constexpr size_t W_MDOWN = W_RGG + (size_t)2 * 2 * 16 * 128 * 64 * 2;
constexpr size_t W_MUQ = W_MDOWN + (size_t)512 * 1024 * 2;
constexpr size_t W_MUKV = W_MUQ + (size_t)1536 * 256 * 2;
constexpr size_t W_MO = W_MUKV + (size_t)2048 * 128 * 2;
constexpr size_t W_MLIN = W_MO + (size_t)1024 * 1024 * 2;
constexpr size_t W_MLOUT = W_MLIN + (size_t)3200 * 1024 * 2;
constexpr size_t W_RT = W_MLOUT + (size_t)1024 * 1024 * 2;
constexpr size_t W_GU = al256(W_RT + (size_t)4 * 2 * 80 * 1024 * 2);
constexpr size_t W_DN = W_GU + (size_t)256 * 512 * 1024 * 2;
constexpr size_t WS_GS = W_DN + (size_t)256 * 1024 * 256 * 2;
constexpr size_t WS_END = WS_GS + (size_t)512 * 36 * 3 * 64 * 4;

struct TDesc {
    const float* src; bf16_t* dst; const float* rscale;
    long sb, db;
    int K, N, Npad, batch;
    int perm, tiles_k, tiles_n, tile0;
};
constexpr int NTD = 18;
struct Args {
    const float* in[32];
    float* out;
    unsigned char* ws;
    TDesc td[NTD];
    int ntiles_total, ph_lo, ph_hi, pad0;
};

DI float bf2f(bf16_t v) { return __uint_as_float((unsigned)v << 16); }
DI unsigned pk2(float a, float b) { f32x2 v = {a, b}; bfx2 r = __builtin_convertvector(v, bfx2); return __builtin_bit_cast(unsigned, r); }
DI bf16_t f2bf(float a) { return (bf16_t)(pk2(a, 0.f) & 0xffffu); }
DI float lof(unsigned u) { return __uint_as_float(u << 16); }
DI float hif(unsigned u) { return __uint_as_float(u & 0xffff0000u); }
DI float rcpf_(float x) { return __builtin_amdgcn_rcpf(x); }
DI float fexp(float x) { return __builtin_amdgcn_exp2f(x * 1.4426950408889634f); }
DI float sigmoidf_(float x) { return rcpf_(1.f + fexp(-x)); }
DI float gelu_tanh(float x) { float u = 0.7978845608028654f * (x + 0.044715f * x * x * x); float e = fexp(2.f * u); return x * (1.f - rcpf_(e + 1.f)); }
DI int tok_modrow(int t) { return t < NLAT ? (t >> 11) : 8; }
DI void dma16(const void* g, char* l) { __builtin_amdgcn_global_load_lds((const unsigned*)g, (unsigned*)l, 16, 0, 0); }
DI void wait_vm0() { asm volatile("s_waitcnt vmcnt(0)" ::: "memory"); }
DI void lds_barrier() { asm volatile("s_waitcnt lgkmcnt(0)" ::: "memory"); __builtin_amdgcn_s_barrier(); asm volatile("" ::: "memory"); }
DI int swz128(int row, int chunk) { return row * 128 + ((chunk ^ (row & 7)) << 4); }
DI int swz256(int row, int chunk) { return row * 256 + ((chunk ^ (row & 15)) << 4); }
DI f32x4 mfma16(bf16x8 a, bf16x8 b, f32x4 c) { return __builtin_amdgcn_mfma_f32_16x16x32_bf16(a, b, c, 0, 0, 0); }
DI f32x16 mfma32(bf16x8 a, bf16x8 b, f32x16 c) { return __builtin_amdgcn_mfma_f32_32x32x16_bf16(a, b, c, 0, 0, 0); }
DI bf16x8 ldsv8(const char* p) { return *(const bf16x8*)p; }
typedef __attribute__((ext_vector_type(8))) _Float16 f16x8;
typedef __attribute__((ext_vector_type(2))) _Float16 f16x2;
DI unsigned pkh(float a, float b) { f32x2 v = {a, b}; f16x2 r = __builtin_convertvector(v, f16x2); return __builtin_bit_cast(unsigned, r); }
DI float hlof(unsigned u) { return (float)__builtin_bit_cast(f16x2, u)[0]; }
DI float hhif(unsigned u) { return (float)__builtin_bit_cast(f16x2, u)[1]; }
DI f32x4 mfma16h(f16x8 a, f16x8 b, f32x4 c) { return __builtin_amdgcn_mfma_f32_16x16x32_f16(a, b, c, 0, 0, 0); }
DI void st_bf4(bf16_t* p, const f32x4 v) { u32x2 o; o[0] = pk2(v[0], v[1]); o[1] = pk2(v[2], v[3]); *(u32x2*)p = o; }

__shared__ __attribute__((aligned(16))) char lds[LDS_BYTES];

#define XB_TMO      128
#define XB_XCNT(j)  (256  + 64 * (j))
#define XB_XSUB(j)  (1280 + 64 * (j))
#define XB_XGEN(j)  (2304 + 64 * (j))
#define XB_TOP      3328
#define XB_TOPGEN   3392
#define XCD_BAR_WORDS 3456
#define XB_SPIN_CAP (1u << 22)
#define LAS __attribute__((address_space(3)))
DI unsigned xb_ld(unsigned* p)              { return __hip_atomic_load(p, __ATOMIC_RELAXED, __HIP_MEMORY_SCOPE_AGENT); }
DI unsigned xb_add(unsigned* p, unsigned v) { return __hip_atomic_fetch_add(p, v, __ATOMIC_RELAXED, __HIP_MEMORY_SCOPE_AGENT); }
DI unsigned xb_xcc_id() { return (unsigned)__builtin_amdgcn_s_getreg((3 << 11) | 20) & 0xFu; }
#define XB_SPIN(cond, bar) do { unsigned _sp = 0; while (cond) { __builtin_amdgcn_s_sleep(1); \
    if ((++_sp & 255u) == 0u) { if (xb_ld(&(bar)[XB_TMO])) break; if (_sp > XB_SPIN_CAP) { atomicAdd(&(bar)[XB_TMO], 1u); break; } } } } while (0)
struct XcdBarrier { unsigned* bar; unsigned x; volatile LAS unsigned* st; };
DI XcdBarrier xcd_barrier_post(unsigned* bar, volatile LAS unsigned* st) {
    XcdBarrier b; b.bar = bar; b.x = xb_xcc_id(); b.st = st;
    if (threadIdx.x == 0) (void)xb_add(&bar[XB_XCNT(b.x)], 1u);
    return b;
}
DI void xcd_barrier_complete(unsigned* bar, unsigned x, unsigned& nloc, unsigned& nx) {
    const unsigned G = gridDim.x * gridDim.y * gridDim.z;
    unsigned sum, cnt, mine, sp = 0u;
    for (;;) {
        sum = 0u; cnt = 0u; mine = 0u;
#pragma unroll
        for (unsigned j = 0; j < 16; ++j) { const unsigned c = xb_ld(&bar[XB_XCNT(j)]); sum += c; cnt += (c > 0u) ? 1u : 0u; mine = (j == x) ? c : mine; }
        if (sum == G) break;
        __builtin_amdgcn_s_sleep(1);
        if ((++sp & 255u) == 0u) { if (xb_ld(&bar[XB_TMO])) break; if (sp > XB_SPIN_CAP) { atomicAdd(&bar[XB_TMO], 1u); break; } }
    }
    nloc = mine > 0u ? mine : 1u; nx = cnt > 0u ? cnt : 1u;
}
DI void xcd_barrier(const XcdBarrier& b) {
    asm volatile("s_waitcnt vmcnt(0)" ::: "memory");
    __syncthreads();
    if (threadIdx.x == 0) {
        unsigned* bar = b.bar;
        __builtin_amdgcn_s_waitcnt(0);
        unsigned nloc = b.st[0], nx = b.st[1];
        if (nloc == 0u) { xcd_barrier_complete(bar, b.x, nloc, nx); b.st[0] = nloc; b.st[1] = nx; }
        const unsigned old = xb_add(&bar[XB_XSUB(b.x)], 1u);
        const unsigned gen = old / nloc;
        if (old + 1u == (gen + 1u) * nloc) {
            __builtin_amdgcn_fence(__ATOMIC_RELEASE, "agent");
            asm volatile("s_waitcnt vmcnt(0)" ::: "memory");
            const unsigned og = xb_add(&bar[XB_TOP], 1u);
            const unsigned tg = og / nx;
            if (og + 1u == (tg + 1u) * nx) xb_add(&bar[XB_TOPGEN], 1u);
            else XB_SPIN(xb_ld(&bar[XB_TOPGEN]) == tg, bar);
            __builtin_amdgcn_fence(__ATOMIC_ACQUIRE, "agent");
            xb_add(&bar[XB_XGEN(b.x)], 1u);
            asm volatile("s_waitcnt vmcnt(0)" ::: "memory");
        } else {
            XB_SPIN(xb_ld(&bar[XB_XGEN(b.x)]) == gen, bar);
            __builtin_amdgcn_fence(__ATOMIC_ACQUIRE, "agent");
            asm volatile("s_waitcnt vmcnt(0)" ::: "memory");
        }
    }
    __syncthreads();
}

typedef __attribute__((ext_vector_type(4))) short s16x4;
typedef __attribute__((address_space(3))) s16x4 lds_s16x4;
DI s16x4 lds_tr(const char* p) { return __builtin_amdgcn_ds_read_tr16_b64_v4i16((lds_s16x4*)p); }
DI int trswz(int row) { return ((row & 3) << 2) | ((row >> 2) & 3); }
struct CvTile { const float* src; bf16_t* dst; int K, N, perm, k0, n0; };
DI CvTile moe_cv_tile(const Args& a, const int L, const int t) {
    CvTile c;
    const int e = t / 96, r = t - e * 96;
    if (r < 64) {
        c.src = a.in[30] + (size_t)(L * 64 + e) * 1024 * 512; c.dst = (bf16_t*)(a.ws + W_GU) + (size_t)(L * 64 + e) * 512 * 1024;
        c.K = 1024; c.N = 512; c.perm = 1; c.k0 = (r & 7) * 128; c.n0 = (r >> 3) * 64;
    } else {
        const int r2 = r - 64;
        c.src = a.in[31] + (size_t)(L * 64 + e) * 256 * 1024; c.dst = (bf16_t*)(a.ws + W_DN) + (size_t)(L * 64 + e) * 1024 * 256;
        c.K = 256; c.N = 1024; c.perm = 0; c.k0 = (r2 & 1) * 128; c.n0 = (r2 >> 1) * 64;
    }
    return c;
}
DI void cv_load(const CvTile& c, f32x4 (&L0)[4], f32x4 (&L1)[4]) {
    const int tid = threadIdx.x, c4 = tid & 15, kr = tid >> 4;
    const float* p = c.src + (size_t)(c.k0 + 2 * kr) * c.N + c.n0 + 4 * c4;
#pragma unroll
    for (int i = 0; i < 4; ++i) { L0[i] = *(const f32x4*)(p + (size_t)(32 * i) * c.N); L1[i] = *(const f32x4*)(p + (size_t)(32 * i + 1) * c.N); }
}
DI void cv_pack(unsigned* st, const f32x4 (&L0)[4], const f32x4 (&L1)[4]) {
    const int tid = threadIdx.x, c4 = tid & 15, kr = tid >> 4;
#pragma unroll
    for (int i = 0; i < 4; ++i)
#pragma unroll
        for (int j = 0; j < 4; ++j) st[(4 * c4 + j) * 68 + 16 * i + kr] = pk2(L0[i][j], L1[i][j]);
}
DI void cv_flush(const CvTile& c, const unsigned* st) {
    const int tid = threadIdx.x;
#pragma unroll
    for (int i = 0; i < 4; ++i) {
        const int id = tid + i * 256, n = id >> 4, kc = id & 15;
        const u32x4 o = *(const u32x4*)(st + n * 68 + kc * 4);
        int nd = c.n0 + n;
        if (c.perm) { const int cc = nd & 255, up = nd >> 8; nd = ((cc >> 4) << 5) + (up << 4) + (cc & 15); }
        *(u32x4*)(c.dst + (size_t)nd * c.K + c.k0 + kc * 8) = o;
    }
}

DI void phase_prologue(const Args& a) {
    const int tid = threadIdx.x;
    const int n_ada = 384, n_rt = 320;
    const int total = n_ada + n_rt;
    float* sc = (float*)lds;
    for (int u = blockIdx.x; u < total; u += gridDim.x) {
        __syncthreads();
        if (u < n_ada) {
            const float* c = a.in[1]; const float* cc = a.in[3];
            for (int i = tid; i < 9 * 1024; i += NTHR) {
                float v = i < 8192 ? c[i] : cc[i - 8192];
                sc[i] = v / (1.f + __expf(-v));
            }
            __syncthreads();
            const int n = u * 64 + (tid & 63), li = n / 6144, nn = n - li * 6144, kq = tid >> 6;
            const float* wp = a.in[4] + (size_t)li * 1024 * 6144 + (size_t)(kq * 256) * 6144 + nn;
            float acc[9];
#pragma unroll
            for (int r = 0; r < 9; ++r) acc[r] = 0.f;
#pragma unroll 1
            for (int k0 = kq * 256; k0 < kq * 256 + 256; k0 += 16) {
                float wv[16];
#pragma unroll
                for (int kk = 0; kk < 16; ++kk) { wv[kk] = *wp; wp += 6144; }
#pragma unroll
                for (int kk = 0; kk < 16; kk += 4)
#pragma unroll
                    for (int r = 0; r < 9; ++r) {
                        const f32x4 s4 = *(const f32x4*)(sc + r * 1024 + k0 + kk);
                        acc[r] += s4[0] * wv[kk] + s4[1] * wv[kk + 1] + s4[2] * wv[kk + 2] + s4[3] * wv[kk + 3];
                    }
            }
            float* part = sc + 9 * 1024;
#pragma unroll
            for (int r = 0; r < 9; ++r) part[(kq * 9 + r) * 64 + (tid & 63)] = acc[r];
            __syncthreads();
            for (int i = tid; i < 9 * 64; i += NTHR) {
                const int r = i >> 6, cidx = i & 63;
                const int n2 = u * 64 + cidx, l2 = n2 / 6144, nn2 = n2 - l2 * 6144;
                const float v = ((part[(0 * 9 + r) * 64 + cidx] + part[(1 * 9 + r) * 64 + cidx]) + part[(2 * 9 + r) * 64 + cidx]) + part[(3 * 9 + r) * 64 + cidx];
                ((float*)(a.ws + WS_MOD))[((size_t)l2 * 9 + r) * 6144 + nn2] = v + a.in[5][l2 * 6144 + nn2];
            }
        } else if (u < n_ada + n_rt) {
            const int r_ = u - n_ada, li = r_ / 80, n = r_ - li * 80;
            if (r_ == 0) {
                float* rt_ = (float*)(a.ws + WS_CTL + CTL_ROPE);
                for (int i = tid; i < 512; i += NTHR) {
                    const int pos = i >> 3, fi = i & 7;
                    const float ang = (float)pos * powf(10000.f, -(float)fi * 0.125f);
                    rt_[i] = cosf(ang); rt_[512 + i] = sinf(ang);
                }
            }
            bf16_t* rt = (bf16_t*)(a.ws + W_RT) + (size_t)li * 80 * 1024;
            const float* wg = a.in[26] + (size_t)li * 1024 * 8;
            const float* we = a.in[28] + (size_t)li * 1024 * 64;
            float v[4];
#pragma unroll
            for (int j = 0; j < 4; ++j) { const int k = tid * 4 + j; v[j] = n < 8 ? wg[k * 8 + n] : (n < 72 ? we[k * 64 + (n - 8)] : 0.f); }
            u32x2 hw;
            hw[0] = pkh(v[0], v[1]); hw[1] = pkh(v[2], v[3]);
            *(u32x2*)(rt + n * 1024 + tid * 4) = hw;
        }
    }
    struct PTile { const float* src; bf16_t* dst; const float* rscale; int K, N, Npad, perm, k0, n0; };
    auto decode = [&](int tix) {
        int di = 0;
#pragma unroll 1
        for (int i = 1; i < NTD; ++i) if (tix >= a.td[i].tile0) di = i;
        const TDesc& td = a.td[di];
        int rem = tix - td.tile0;
        const int per = td.tiles_k * td.tiles_n;
        const int bi = rem / per; rem -= bi * per;
        PTile p;
        p.src = td.src + (size_t)bi * td.sb; p.dst = td.dst + (size_t)bi * td.db; p.rscale = td.rscale;
        p.K = td.K; p.N = td.N; p.Npad = td.Npad; p.perm = td.perm;
        p.n0 = (rem % td.tiles_n) * 64; p.k0 = (rem / td.tiles_n) * 128;
        return p;
    };
    auto pload = [&](const PTile& p, f32x4 (&L0)[4], f32x4 (&L1)[4]) {
        const int c4 = tid & 15, kr = tid >> 4;
        const bool nok = p.n0 + 4 * c4 < p.N;
#pragma unroll
        for (int i = 0; i < 4; ++i) {
            const int k = p.k0 + 32 * i + 2 * kr;
            L0[i] = (f32x4){0.f, 0.f, 0.f, 0.f}; L1[i] = L0[i];
            if (nok && k < p.K) {
                L0[i] = *(const f32x4*)(p.src + (size_t)k * p.N + p.n0 + 4 * c4);
                L1[i] = *(const f32x4*)(p.src + (size_t)(k + 1) * p.N + p.n0 + 4 * c4);
                if (p.rscale) { L0[i] *= p.rscale[k]; L1[i] *= p.rscale[k + 1]; }
            }
        }
    };
    auto pflush = [&](const PTile& p, const unsigned* st) {
#pragma unroll
        for (int i = 0; i < 4; ++i) {
            const int id = tid + i * 256, n = id >> 4, kc = id & 15;
            const u32x4 o = *(const u32x4*)(st + n * 68 + kc * 4);
            int nd = p.n0 + n;
            if (nd < p.Npad && p.k0 + kc * 8 < p.K) {
                if (p.perm) { const int c = nd & 255, up = nd >> 8; nd = ((c >> 4) << 5) + (up << 4) + (c & 15); }
                *(u32x4*)(p.dst + (size_t)nd * p.K + p.k0 + kc * 8) = o;
            }
        }
    };
    {
        unsigned* st0 = (unsigned*)lds; unsigned* st1 = st0 + 64 * 68;
        const int nt_ = a.ntiles_total, G = gridDim.x;
        int t0 = blockIdx.x, t1 = blockIdx.x + G;
        PTile p0 = decode(0), p1 = p0;
        f32x4 A0[4], A1[4], B0[4], B1[4];
        __syncthreads();
        if (t0 < nt_) { p0 = decode(t0); pload(p0, A0, A1); }
        if (t1 < nt_) { p1 = decode(t1); pload(p1, B0, B1); }
        while (t0 < nt_) {
            PTile q0 = p0, q1 = p1;
            const bool v1 = t1 < nt_;
            cv_pack(st0, A0, A1);
            if (t0 + 2 * G < nt_) { p0 = decode(t0 + 2 * G); pload(p0, A0, A1); }
            if (v1) {
                cv_pack(st1, B0, B1);
                if (t1 + 2 * G < nt_) { p1 = decode(t1 + 2 * G); pload(p1, B0, B1); }
            }
            __syncthreads();
            pflush(q0, st0);
            if (v1) pflush(q1, st1);
            __syncthreads();
            t0 += 2 * G; t1 += 2 * G;
        }
    }
}

DI float wave_sum(float v) {
    v += __shfl_xor(v, 1); v += __shfl_xor(v, 2); v += __shfl_xor(v, 4); v += __shfl_xor(v, 8); v += __shfl_xor(v, 16); v += __shfl_xor(v, 32);
    return v;
}
template <int MODE>
DI void phase_token_row(const Args& a, const int li) {
    const int tid = threadIdx.x, lane = tid & 63, wave = tid >> 6;
    float* X = (float*)(a.ws + WS_X);
    bf16_t* H = (bf16_t*)(a.ws + WS_H);
    const bf16_t* Y = (const bf16_t*)(a.ws + WS_Y);
    const float* MOD = (const float*)(a.ws + WS_MOD);
    const bool combine = MODE == 2 || li > 0;
    const bool first = MODE == 0 && li == 0;
    const int npairs = (MODE == 2 ? NLAT : NTOK) / 2;
    const int lprev = MODE == 2 ? 3 : (li > 0 ? li - 1 : 0);
    const float* gn = a.in[6] + (size_t)li * D;
    for (int p = blockIdx.x * 4 + wave; p < npairs; p += gridDim.x * 4) {
        const int t0 = 2 * p, mr = tok_modrow(t0);
        f32x4 x[2][4];
#pragma unroll
        for (int i = 0; i < 2; ++i) {
            const int t = t0 + i;
            const float* xs = first ? (t < NLAT ? a.in[0] + (size_t)t * D : a.in[2] + (size_t)(t - NLAT) * D) : X + (size_t)t * D;
#pragma unroll
            for (int j = 0; j < 4; ++j) x[i][j] = *(const f32x4*)(xs + 256 * j + 4 * lane);
        }
        if (combine) {
            const float* g5 = MOD + ((size_t)lprev * 9 + mr) * 6144 + 5 * 1024;
            f32x4 g[4];
#pragma unroll
            for (int j = 0; j < 4; ++j) g[j] = *(const f32x4*)(g5 + 256 * j + 4 * lane);
#pragma unroll
            for (int i = 0; i < 2; ++i) {
                const bf16_t* y0 = Y + (size_t)(2 * (t0 + i)) * D;
#pragma unroll
                for (int j = 0; j < 4; ++j) {
                    const u32x2 ya = *(const u32x2*)(y0 + 256 * j + 4 * lane), yb = *(const u32x2*)(y0 + D + 256 * j + 4 * lane);
                    x[i][j][0] += g[j][0] * (lof(ya[0]) + lof(yb[0])); x[i][j][1] += g[j][1] * (hif(ya[0]) + hif(yb[0]));
                    x[i][j][2] += g[j][2] * (lof(ya[1]) + lof(yb[1])); x[i][j][3] += g[j][3] * (hif(ya[1]) + hif(yb[1]));
                }
            }
        }
        if (MODE == 2) {
#pragma unroll
            for (int i = 0; i < 2; ++i)
#pragma unroll
                for (int j = 0; j < 4; ++j) *(f32x4*)(a.out + (size_t)(t0 + i) * D + 256 * j + 4 * lane) = x[i][j];
            continue;
        }
        float rstd[2];
#pragma unroll
        for (int i = 0; i < 2; ++i) {
            float ss = 0.f;
#pragma unroll
            for (int j = 0; j < 4; ++j) ss += x[i][j][0] * x[i][j][0] + x[i][j][1] * x[i][j][1] + x[i][j][2] * x[i][j][2] + x[i][j][3] * x[i][j][3];
            rstd[i] = rsqrtf(wave_sum(ss) * (1.f / 1024.f) + EPS);
        }
        const float* msc = MOD + ((size_t)li * 9 + mr) * 6144 + 1 * 1024;
        const float* msh = MOD + ((size_t)li * 9 + mr) * 6144;
#pragma unroll
        for (int j = 0; j < 4; ++j) {
            const f32x4 n4 = *(const f32x4*)(gn + 256 * j + 4 * lane), s4 = *(const f32x4*)(msc + 256 * j + 4 * lane), h4 = *(const f32x4*)(msh + 256 * j + 4 * lane);
            const f32x4 gs = n4 * (s4 + 1.f);
#pragma unroll
            for (int i = 0; i < 2; ++i) {
                const f32x4 f = x[i][j] * rstd[i] * gs + h4;
                st_bf4(H + (size_t)(t0 + i) * D + 256 * j + 4 * lane, f);
                if (combine) *(f32x4*)(X + (size_t)(t0 + i) * D + 256 * j + 4 * lane) = x[i][j];
            }
        }
    }
}

DI void phase_token_router(const Args& a, const int li) {
    const int tid = threadIdx.x, lane = tid & 63, wave = tid >> 6;
    const int r = lane & 15, q = lane >> 4;
    const float* X = (const float*)(a.ws + WS_X);
    bf16_t* H = (bf16_t*)(a.ws + WS_H);
    const float* MOD = (const float*)(a.ws + WS_MOD);
    const float* gn = a.in[7] + (size_t)li * D;
    const int ngroups = (li == 3 ? NLAT : NTOK) / 16;
    char* sHi = lds; char* sLo = lds + 32768;
    float* sP = (float*)lds;
    float* sL = (float*)(lds + 32768);
    const bf16_t* rwh = (const bf16_t*)(a.ws + W_RT) + (size_t)li * 80 * 1024 + (size_t)r * 1024 + q * 8;
    for (int g = blockIdx.x; g < ngroups; g += gridDim.x) {
        const int mr = tok_modrow(g * 16);
        const float* msc = MOD + ((size_t)li * 9 + mr) * 6144 + 4 * 1024;
        const float* msh = MOD + ((size_t)li * 9 + mr) * 6144 + 3 * 1024;
        __syncthreads();
        {
            f32x4 x[4][4];
#pragma unroll
            for (int i = 0; i < 4; ++i)
#pragma unroll
                for (int j = 0; j < 4; ++j) x[i][j] = *(const f32x4*)(X + (size_t)(g * 16 + wave * 4 + i) * D + 256 * j + 4 * lane);
            float rstd[4];
#pragma unroll
            for (int i = 0; i < 4; ++i) {
                float ss = 0.f;
#pragma unroll
                for (int j = 0; j < 4; ++j) ss += x[i][j][0] * x[i][j][0] + x[i][j][1] * x[i][j][1] + x[i][j][2] * x[i][j][2] + x[i][j][3] * x[i][j][3];
                rstd[i] = rsqrtf(wave_sum(ss) * (1.f / 1024.f) + EPS);
            }
#pragma unroll
            for (int j = 0; j < 4; ++j) {
                const f32x4 n4 = *(const f32x4*)(gn + 256 * j + 4 * lane), s4 = *(const f32x4*)(msc + 256 * j + 4 * lane), h4 = *(const f32x4*)(msh + 256 * j + 4 * lane);
                const f32x4 gs = n4 * (s4 + 1.f);
#pragma unroll
                for (int i = 0; i < 4; ++i) {
                    const int row = wave * 4 + i;
                    const f32x4 f = x[i][j] * rstd[i] * gs + h4;
                    u32x2 hv; hv[0] = pk2(f[0], f[1]); hv[1] = pk2(f[2], f[3]);
                    *(u32x2*)(H + (size_t)(g * 16 + row) * D + 256 * j + 4 * lane) = hv;
                    u32x2 hh; hh[0] = pkh(f[0], f[1]); hh[1] = pkh(f[2], f[3]);
                    u32x2 lv; lv[0] = pkh(f[0] - hlof(hh[0]), f[1] - hhif(hh[0])); lv[1] = pkh(f[2] - hlof(hh[1]), f[3] - hhif(hh[1]));
                    const int off = row * 2048 + (((32 * j + (lane >> 1)) ^ row) << 4) + (lane & 1) * 8;
                    *(u32x2*)(sHi + off) = hh; *(u32x2*)(sLo + off) = lv;
                }
            }
        }
        __syncthreads();
        f32x4 lacc[5];
#pragma unroll
        for (int i = 0; i < 5; ++i) lacc[i] = (f32x4){0.f, 0.f, 0.f, 0.f};
#pragma unroll 2
        for (int s = 0; s < 8; ++s) {
            const int kk = wave * 8 + s;
            const int off = r * 2048 + (((kk * 4 + q) ^ r) << 4);
            const f16x8 fh = __builtin_bit_cast(f16x8, ldsv8(sHi + off)), fl = __builtin_bit_cast(f16x8, ldsv8(sLo + off));
#pragma unroll
            for (int nt = 0; nt < 5; ++nt) {
                const f16x8 w = __builtin_bit_cast(f16x8, *(const bf16x8*)(rwh + (size_t)nt * 16 * 1024 + kk * 32));
                lacc[nt] = mfma16h(fh, w, lacc[nt]);
                lacc[nt] = mfma16h(fl, w, lacc[nt]);
            }
        }
        __syncthreads();
#pragma unroll
        for (int nt = 0; nt < 5; ++nt)
#pragma unroll
            for (int j = 0; j < 4; ++j) sP[(wave * 16 + q * 4 + j) * 80 + nt * 16 + r] = lacc[nt][j];
        __syncthreads();
        for (int i = tid; i < 16 * 80; i += NTHR) sL[i] = sP[i] + sP[1280 + i] + sP[2560 + i] + sP[3840 + i];
        __syncthreads();
        if (tid < 16) {
            const float* L = sL + tid * 80;
            const float* bg = a.in[27] + li * 8;
            const float* be = a.in[29] + li * 64;
            float gmax = -3.0e38f; int gi = 0; float gl[8];
#pragma unroll
            for (int j = 0; j < 8; ++j) { gl[j] = L[j] + bg[j]; if (gl[j] > gmax) { gmax = gl[j]; gi = j; } }
            float ps = 0.f;
#pragma unroll
            for (int j = 0; j < 8; ++j) ps += __expf(gl[j] - gmax);
            const float ptop = 1.f / ps;
            float e1 = -3.0e38f, e2 = -3.0e38f; int i1 = 0, i2 = 0;
#pragma unroll
            for (int j = 0; j < 8; ++j) {
                const float v = L[8 + gi * 8 + j] + be[gi * 8 + j];
                if (v > e1) { e2 = e1; i2 = i1; e1 = v; i1 = j; } else if (v > e2) { e2 = v; i2 = j; }
            }
            const float ex = __expf(e2 - e1);
            const float w1 = ptop / (1.f + ex), w2 = ptop * ex / (1.f + ex);
            const int tt = g * 16 + tid;
            int* cnt = (int*)(a.ws + WS_CTL + CTL_CNT) + li * 64;
            int* list = (int*)(a.ws + WS_LIST);
            float* wsl = (float*)(a.ws + WS_WSLOT);
            const int ea = gi * 8 + i1, eb = gi * 8 + i2;
            const int pa = atomicAdd(&cnt[ea], 1); list[(size_t)ea * NTOK + pa] = 2 * tt; wsl[2 * tt] = w1;
            const int pb = atomicAdd(&cnt[eb], 1); list[(size_t)eb * NTOK + pb] = 2 * tt + 1; wsl[2 * tt + 1] = w2;
        }
    }
}

template <int WM, int WN, int MT, int NT, bool PFALL = true, class AP>
DI void gemm_tile(AP arow, const bf16_t* Bt, const int ldb, const int K, f32x4 (&acc)[MT][NT], float* ssq = nullptr) {
    constexpr int BM = WM * MT * 16, BN = WN * NT * 16;
    constexpr int A_BYTES = BM * 128, B_BYTES = BN * 128, STAGE = A_BYTES + B_BYTES;
    constexpr int ACH = BM * 8 / NTHR, BCH = BN * 8 / NTHR;
    static_assert(2 * STAGE <= LDS_AUX, "gemm LDS");
    const int tid = threadIdx.x, lane = tid & 63, wave = tid >> 6;
    const int wm = wave / WN, wn = wave % WN;
    const int fr = lane & 15, fq = lane >> 4;
    const bf16_t* ap[ACH]; const bf16_t* bp[BCH];
#pragma unroll
    for (int i = 0; i < ACH; ++i) { const int idx = tid + i * NTHR, row = idx >> 3, c = (idx & 7) ^ (row & 7); ap[i] = arow(row) + c * 8; }
#pragma unroll
    for (int i = 0; i < BCH; ++i) { const int idx = tid + i * NTHR, row = idx >> 3, c = (idx & 7) ^ (row & 7); bp[i] = Bt + (size_t)row * ldb + c * 8; }
#pragma unroll
    for (int i = 0; i < MT; ++i)
#pragma unroll
        for (int j = 0; j < NT; ++j) acc[i][j] = (f32x4){0.f, 0.f, 0.f, 0.f};
    const int KT = K >> 6;
    {
        char* sa = lds; char* sb = lds + A_BYTES;
#pragma unroll
        for (int i = 0; i < ACH; ++i) dma16(ap[i], sa + (tid + i * NTHR) * 16);
#pragma unroll
        for (int i = 0; i < BCH; ++i) dma16(bp[i], sb + (tid + i * NTHR) * 16);
    }
#pragma unroll 1
    for (int kt = 0; kt < KT; ++kt) {
        wait_vm0();
        __syncthreads();
        if (kt + 1 < KT) {
            char* sa = lds + ((kt + 1) & 1) * STAGE; char* sb = sa + A_BYTES;
            const int ko = (kt + 1) * 64;
#pragma unroll
            for (int i = 0; i < ACH; ++i) dma16(ap[i] + ko, sa + (tid + i * NTHR) * 16);
#pragma unroll
            for (int i = 0; i < BCH; ++i) dma16(bp[i] + ko, sb + (tid + i * NTHR) * 16);
        }
        const char* sa = lds + (kt & 1) * STAGE; const char* sb = sa + A_BYTES;
        if (PFALL) {
            bf16x8 xf[2][MT], wf[2][NT];
#pragma unroll
            for (int kk = 0; kk < 2; ++kk) {
#pragma unroll
                for (int i = 0; i < MT; ++i) xf[kk][i] = ldsv8(sa + swz128(wm * MT * 16 + i * 16 + fr, kk * 4 + fq));
#pragma unroll
                for (int j = 0; j < NT; ++j) wf[kk][j] = ldsv8(sb + swz128(wn * NT * 16 + j * 16 + fr, kk * 4 + fq));
            }
            __builtin_amdgcn_sched_barrier(0);
            __builtin_amdgcn_s_setprio(1);
#pragma unroll
            for (int kk = 0; kk < 2; ++kk)
#pragma unroll
                for (int i = 0; i < MT; ++i)
#pragma unroll
                    for (int j = 0; j < NT; ++j) acc[i][j] = mfma16(wf[kk][j], xf[kk][i], acc[i][j]);
            __builtin_amdgcn_s_setprio(0);
        } else {
#pragma unroll
            for (int kk = 0; kk < 2; ++kk) {
                bf16x8 xf[MT], wf[NT];
#pragma unroll
                for (int i = 0; i < MT; ++i) xf[i] = ldsv8(sa + swz128(wm * MT * 16 + i * 16 + fr, kk * 4 + fq));
#pragma unroll
                for (int j = 0; j < NT; ++j) wf[j] = ldsv8(sb + swz128(wn * NT * 16 + j * 16 + fr, kk * 4 + fq));
#pragma unroll
                for (int i = 0; i < MT; ++i)
#pragma unroll
                    for (int j = 0; j < NT; ++j) acc[i][j] = mfma16(wf[j], xf[i], acc[i][j]);
                if (ssq) {
#pragma unroll
                    for (int i = 0; i < MT; ++i) {
                        const u32x4 xu = __builtin_bit_cast(u32x4, xf[i]);
#pragma unroll
                        for (int d = 0; d < 4; ++d) { const bfx2 p = __builtin_bit_cast(bfx2, xu[d]); ssq[i] = __builtin_amdgcn_fdot2_f32_bf16(p, p, ssq[i], false); }
                    }
                }
            }
        }
    }
    __syncthreads();
}


struct GemmPipe {
    static constexpr int A_BYTES = 128 * 128, STAGE = 2 * A_BYTES;
    const bf16_t* ap[4]; const bf16_t* bp[4];
    template <class AP>
    DI void setup(AP arow, const bf16_t* Bt, const int ldb) {
        const int tid = threadIdx.x;
#pragma unroll
        for (int i = 0; i < 4; ++i) {
            const int idx = tid + i * NTHR, row = idx >> 3, c = (idx & 7) ^ (row & 7);
            ap[i] = arow(row) + c * 8; bp[i] = Bt + (size_t)row * ldb + c * 8;
        }
    }
    DI void issue(const int kt, const int buf) const {
        const int tid = threadIdx.x;
        char* sa = lds + buf * STAGE; char* sb = sa + A_BYTES;
        const int ko = kt * 64;
#pragma unroll
        for (int i = 0; i < 4; ++i) dma16(ap[i] + ko, sa + (tid + i * NTHR) * 16);
#pragma unroll
        for (int i = 0; i < 4; ++i) dma16(bp[i] + ko, sb + (tid + i * NTHR) * 16);
    }
    template <int PM>
    DI void run_probe(const int K, f32x4 (&acc)[4][4]) const {
        const int tid = threadIdx.x, lane = tid & 63, wave = tid >> 6;
        const int wm = wave >> 1, wn = wave & 1, fr = lane & 15, fq = lane >> 4;
#pragma unroll
        for (int i = 0; i < 4; ++i)
#pragma unroll
            for (int j = 0; j < 4; ++j) acc[i][j] = (f32x4){0.f, 0.f, 0.f, 0.f};
        const int KT = K >> 6;
#pragma unroll 1
        for (int kt = 0; kt < KT; ++kt) {
            if (PM & 4) { wait_vm0(); __syncthreads(); }
            if ((PM & 1) && kt + 1 < KT) issue(kt + 1, (kt + 1) & 1);
            if (PM & 2) {
                const char* sa = lds + (kt & 1) * STAGE; const char* sb = sa + A_BYTES;
                bf16x8 xf[2][4], wf[2][4];
#pragma unroll
                for (int kk = 0; kk < 2; ++kk) {
#pragma unroll
                    for (int i = 0; i < 4; ++i) xf[kk][i] = ldsv8(sa + swz128(wm * 64 + i * 16 + fr, kk * 4 + fq));
#pragma unroll
                    for (int j = 0; j < 4; ++j) wf[kk][j] = ldsv8(sb + swz128(wn * 64 + j * 16 + fr, kk * 4 + fq));
                }
                __builtin_amdgcn_sched_barrier(0);
                __builtin_amdgcn_s_setprio(1);
#pragma unroll
                for (int kk = 0; kk < 2; ++kk)
#pragma unroll
                    for (int i = 0; i < 4; ++i)
#pragma unroll
                        for (int j = 0; j < 4; ++j) acc[i][j] = mfma16(wf[kk][j], xf[kk][i], acc[i][j]);
                __builtin_amdgcn_s_setprio(0);
            }
        }
        wait_vm0();
    }
    DI void run(const int K, f32x4 (&acc)[4][4]) const {
        const int tid = threadIdx.x, lane = tid & 63, wave = tid >> 6;
        const int wm = wave >> 1, wn = wave & 1, fr = lane & 15, fq = lane >> 4;
#pragma unroll
        for (int i = 0; i < 4; ++i)
#pragma unroll
            for (int j = 0; j < 4; ++j) acc[i][j] = (f32x4){0.f, 0.f, 0.f, 0.f};
        const int KT = K >> 6;
#pragma unroll 1
        for (int kt = 0; kt < KT; ++kt) {
            wait_vm0();
            __syncthreads();
            if (kt + 1 < KT) issue(kt + 1, (kt + 1) & 1);
            const char* sa = lds + (kt & 1) * STAGE; const char* sb = sa + A_BYTES;
            bf16x8 xf[2][4], wf[2][4];
#pragma unroll
            for (int kk = 0; kk < 2; ++kk) {
#pragma unroll
                for (int i = 0; i < 4; ++i) xf[kk][i] = ldsv8(sa + swz128(wm * 64 + i * 16 + fr, kk * 4 + fq));
#pragma unroll
                for (int j = 0; j < 4; ++j) wf[kk][j] = ldsv8(sb + swz128(wn * 64 + j * 16 + fr, kk * 4 + fq));
            }
            __builtin_amdgcn_sched_barrier(0);
            __builtin_amdgcn_s_setprio(1);
#pragma unroll
            for (int kk = 0; kk < 2; ++kk)
#pragma unroll
                for (int i = 0; i < 4; ++i)
#pragma unroll
                    for (int j = 0; j < 4; ++j) acc[i][j] = mfma16(wf[kk][j], xf[kk][i], acc[i][j]);
            __builtin_amdgcn_s_setprio(0);
        }
    }
};

constexpr int EPI_OFF = 32768;
DI int lane_m(int i) { const int t = threadIdx.x; return ((t >> 7) & 1) * 64 + i * 16 + (t & 15); }
DI int lane_n(int j) { const int t = threadIdx.x; return ((t >> 6) & 1) * 64 + j * 16 + ((t >> 4) & 3) * 4; }
DI int opaque_tid() { int t = threadIdx.x; asm volatile("" : "+v"(t)); return t; }
DI int lane_m(int t, int i) { return ((t >> 7) & 1) * 64 + i * 16 + (t & 15); }
DI int lane_n(int t, int j) { return ((t >> 6) & 1) * 64 + j * 16 + ((t >> 4) & 3) * 4; }
template <class XF>
DI void epi_stage_bf16(const f32x4 (&acc)[4][4], XF xf) {
    const int tz = opaque_tid();
#pragma unroll
    for (int i = 0; i < 4; ++i) {
        const int m = lane_m(tz, i);
#pragma unroll
        for (int j = 0; j < 4; ++j) {
            const int n = lane_n(tz, j);
            const f32x4 v = xf(i, j, acc[i][j]);
            u32x2 o; o[0] = pk2(v[0], v[1]); o[1] = pk2(v[2], v[3]);
            *(u32x2*)(lds + EPI_OFF + m * 256 + (((n >> 3) ^ (m & 15)) << 4) + (n & 4) * 2) = o;
        }
    }
}
template <class DP, class OK>
DI void epi_flush_bf16(DP dst, OK ok) {
    const int tz = opaque_tid();
#pragma unroll
    for (int it = 0; it < 8; ++it) {
        const int idx = tz + it * NTHR, row = idx >> 4, ch = idx & 15;
        const u32x4 v = *(const u32x4*)(lds + EPI_OFF + row * 256 + ((ch ^ (row & 15)) << 4));
        if (ok(row)) *(u32x4*)(dst(row) + ch * 8) = v;
    }
}
template <class XF>
DI void epi_stage_bf16_T(const f32x4 (&acc)[4][4], XF xf) {
    const int tz = opaque_tid();
    const bool odd = tz & 1;
#pragma unroll
    for (int i = 0; i < 4; ++i) {
        const int m = lane_m(tz, i) & ~1;
#pragma unroll
        for (int j = 0; j < 4; ++j) {
            const int n = lane_n(tz, j) + (odd ? 2 : 0);
            const f32x4 v = xf(i, j, acc[i][j]);
            const float r0 = __shfl_xor(odd ? v[0] : v[2], 1), r1 = __shfl_xor(odd ? v[1] : v[3], 1);
            const unsigned w0 = odd ? pk2(r0, v[2]) : pk2(v[0], r0), w1 = odd ? pk2(r1, v[3]) : pk2(v[1], r1);
            *(unsigned*)(lds + EPI_OFF + n * 256 + (((m >> 3) ^ (n & 15)) << 4) + (m & 6) * 2) = w0;
            *(unsigned*)(lds + EPI_OFF + (n + 1) * 256 + (((m >> 3) ^ ((n + 1) & 15)) << 4) + (m & 6) * 2) = w1;
        }
    }
}
DI void epi_resid_f32(const Args& a, const int li, const int m0, const int n0, const f32x4 (&acc)[4][4]) {
    const int tz = opaque_tid();
    float* X = (float*)(a.ws + WS_X);
    const float* gate = (const float*)(a.ws + WS_MOD) + ((size_t)li * 9 + tok_modrow(m0)) * 6144 + 2 * 1024 + n0;
#pragma unroll
    for (int j = 0; j < 4; ++j) {
        const int n = lane_n(tz, j);
        const f32x4 g = *(const f32x4*)(gate + n);
#pragma unroll
        for (int i = 0; i < 4; ++i) {
            const int t = m0 + lane_m(tz, i);
            float* xp = X + (size_t)t * D + n0 + n;
            const float* xs = li == 0 ? (t < NLAT ? a.in[0] + (size_t)t * D : a.in[2] + (size_t)(t - NLAT) * D) + n0 + n : xp;
            f32x4 x = *(const f32x4*)xs;
            x += g * acc[i][j];
            *(f32x4*)xp = x;
        }
    }
}

template <bool XPF = true, class TE>
DI void gemm_dense_phase(const bf16_t* A, const int lda, const int mrows, const bf16_t* Bt, const int N, const int K, TE tile_epi) {
    const int mt = mrows / 128, nt = N / 128;
    const int mpx = mt >> 3, bmb = mpx >> 1, full = mpx * 8;
    auto decode = [&](int u, int& m0, int& n0) {
        const int xc = u & 7, s = u >> 3;
        const int bn = s / full, rem = s - bn * full;
        const int w = min(8, nt - 8 * bn);
        const int bm = rem / (bmb * w), rem2 = rem - bm * (bmb * w);
        const int ni = rem2 / bmb, mi = rem2 - ni * bmb;
        m0 = (xc * mpx + bm * bmb + mi) * 128; n0 = (bn * 8 + ni) * 128;
    };
    GemmPipe g;
    int u = blockIdx.x, m0 = 0, n0 = 0;
    __syncthreads();
    if (u < mt * nt) { decode(u, m0, n0); g.setup([&](int r) { return A + (size_t)(m0 + r) * lda; }, Bt + (size_t)n0 * K, K); g.issue(0, 0); }
    while (u < mt * nt) {
        f32x4 acc[4][4];
        g.run(K, acc);
        const int cm0 = m0, cn0 = n0;
        u += gridDim.x;
        if (XPF) {
            if (u < mt * nt) { decode(u, m0, n0); g.setup([&](int r) { return A + (size_t)(m0 + r) * lda; }, Bt + (size_t)n0 * K, K); g.issue(0, 0); }
            tile_epi(cm0, cn0, acc);
        } else {
            tile_epi(cm0, cn0, acc);
            __syncthreads();
            if (u < mt * nt) { decode(u, m0, n0); g.setup([&](int r) { return A + (size_t)(m0 + r) * lda; }, Bt + (size_t)n0 * K, K); g.issue(0, 0); }
        }
    }
    __syncthreads();
}
template <class XF, class DP>
DI void epi_bf16_rowmajor(const f32x4 (&acc)[4][4], XF xf, DP dst) {
    __syncthreads();
    epi_stage_bf16(acc, xf);
    __syncthreads();
    epi_flush_bf16(dst, [](int) { return true; });
}

DI void phase_rg_in(const Args& a, int j) {
    bf16_t* G = (bf16_t*)(a.ws + RG_G); bf16_t* U = (bf16_t*)(a.ws + RG_U);
    gemm_dense_phase((const bf16_t*)(a.ws + WS_H), D, NTOK, (const bf16_t*)(a.ws + W_RGIN) + (size_t)j * 2048 * 1024, 2048, 1024,
        [&](int m0, int n0, const f32x4 (&acc)[4][4]) {
            if (n0 < 1024)
                epi_bf16_rowmajor(acc, [](int, int, const f32x4 v) { f32x4 g; g[0] = gelu_tanh(v[0]); g[1] = gelu_tanh(v[1]); g[2] = gelu_tanh(v[2]); g[3] = gelu_tanh(v[3]); return g; },
                                  [&](int row) { return G + (size_t)(m0 + row) * D + n0; });
            else
                epi_bf16_rowmajor(acc, [](int, int, const f32x4 v) { return v; }, [&](int row) { return U + (size_t)(m0 + row) * D + (n0 - 1024); });
        });
}

template <int VAR = 0, int HOST = 0>
DI void phase_rg_scan(const Args& a, int j) {
    const int tid = threadIdx.x, lane = tid & 63, wave = tid >> 6;
    const int fr = lane & 15, fq = lane >> 4;
    const bf16_t* U = (const bf16_t*)(a.ws + RG_U);
    bf16_t* HS = (bf16_t*)(a.ws + (VAR ? WS_Y : RG_HS));
    char* sW = lds;
    char* sX = lds + 8192;
    float* sUc = (float*)(lds + 16384);
    float* sA = (float*)(lds + 24576);
    float* sB = (float*)(lds + 33280);
    bf16_t* sO = (bf16_t*)(lds + 41984);
    unsigned* sCv = (unsigned*)(lds + 50176);
    const int c = tid & 7;
    for (int u = blockIdx.x; u < 512; u += gridDim.x) {
        const int half = u & 1, dir = (u >> 1) & 1, blk = (u >> 2) & 15, b = u >> 6;
        const int cin0 = blk * 64, co0 = blk * 64 + half * 32;
        __syncthreads();
        {
            const bf16_t* Wg = (const bf16_t*)(a.ws + W_RGG) + ((size_t)((j * 2 + dir) * 16 + blk)) * 128 * 64;
#pragma unroll
            for (int i = 0; i < 2; ++i) {
                const int idx = tid + i * NTHR, row = idx >> 3, cc = idx & 7;
                const int srow = (row >> 5) * 64 + half * 32 + (row & 31);
                *(u32x4*)(sW + swz128(row, cc)) = *(const u32x4*)(Wg + (size_t)srow * 64 + cc * 8);
            }
        }
        float carry = 0.f;
        float cw[4][8], cb[8];
        {
            const float* cwp = a.in[9] + (size_t)j * 4 * 1024 + cin0 + c * 8; const float* cbp = a.in[10] + (size_t)j * 1024 + cin0 + c * 8;
#pragma unroll
            for (int w = 0; w < 4; ++w) { const f32x4 v0 = *(const f32x4*)(cwp + w * 1024), v1 = *(const f32x4*)(cwp + w * 1024 + 4);
#pragma unroll
                for (int e = 0; e < 4; ++e) { cw[w][e] = v0[e]; cw[w][4 + e] = v1[e]; } }
            const f32x4 v0 = *(const f32x4*)cbp, v1 = *(const f32x4*)(cbp + 4);
#pragma unroll
            for (int e = 0; e < 4; ++e) { cb[e] = v0[e]; cb[4 + e] = v1[e]; }
        }
        float bg0[8], bg1[8], spl[8];
        {
            const float* gb = a.in[12] + ((size_t)(j * 2 + dir) * 2) * 1024 + co0;
            const float* lm = a.in[13] + (size_t)(j * 2 + dir) * 1024 + co0;
#pragma unroll
            for (int jt = 0; jt < 2; ++jt)
#pragma unroll
                for (int e = 0; e < 4; ++e) {
                    const int cc = jt * 16 + fq * 4 + e;
                    bg0[jt * 4 + e] = gb[cc]; bg1[jt * 4 + e] = gb[1024 + cc];
                    spl[jt * 4 + e] = -8.f * log1pf(__expf(-lm[cc]));
                }
        }
        u32x4 pu[2][4];
        auto load_chunk = [&](int ci) {
            const int seg = ci >= 4, L = seg ? SEQ : CTXL, nch = L / 64, jc = seg ? ci - 4 : ci;
            const int oc = dir ? nch - 1 - jc : jc;
            const int rb = seg ? b * SEQ : NLAT + b * CTXL;
            const int s0 = oc * 64;
#pragma unroll
            for (int it = 0; it < 2; ++it) {
                const int tk = (tid >> 3) + it * 32;
#pragma unroll
                for (int w = 0; w < 4; ++w) {
                    const int s = s0 + tk + w - 2;
                    const int sc_ = min(max(s, 0), L - 1);
                    const u32x4 ld = *(const u32x4*)(U + (size_t)(rb + sc_) * D + cin0 + c * 8);
                    const unsigned msk = (s >= 0 && s < L) ? 0xffffffffu : 0u;
                    pu[it][w] = (u32x4){ld[0] & msk, ld[1] & msk, ld[2] & msk, ld[3] & msk};
                }
            }
        };
        load_chunk(0);
        __syncthreads();
        size_t prev_base = 0;
        constexpr int CV_TILES = HOST ? 6144 : 0;
        CvTile cvp; cvp.src = nullptr; cvp.dst = nullptr; cvp.K = 0; cvp.N = 0; cvp.perm = 0; cvp.k0 = 0; cvp.n0 = 0;
        bool cvp_ok = false;
#pragma unroll 1
        for (int ci = 0; ci < 36; ++ci) {
            f32x4 cv0[4], cv1[4];
            CvTile cvc = cvp;
            const int cvq = (ci / 3) * 512 + u;
            const bool cv_ok = HOST && (ci % 3 == 0) && cvq < CV_TILES;
            if (cv_ok) { cvc = moe_cv_tile(a, 1, cvq); cv_load(cvc, cv0, cv1); }
            const int seg = ci >= 4, L = seg ? SEQ : CTXL, nch = L / 64, jc = seg ? ci - 4 : ci;
            const int oc = dir ? nch - 1 - jc : jc;
            const int rb = seg ? b * SEQ : NLAT + b * CTXL;
            const int s0 = oc * 64;
            char* sXc = sX; float* sUcc = sUc;
#pragma unroll
            for (int it = 0; it < 2; ++it) {
                const int tk = (tid >> 3) + it * 32;
                float o[8];
#pragma unroll
                for (int e = 0; e < 8; ++e) o[e] = cb[e];
#pragma unroll
                for (int w = 0; w < 4; ++w) {
                    const u32x4 r4 = pu[it][w];
#pragma unroll
                    for (int e = 0; e < 4; ++e) { o[2 * e] += cw[w][2 * e] * lof(r4[e]); o[2 * e + 1] += cw[w][2 * e + 1] * hif(r4[e]); }
                }
                u32x4 pv; pv[0] = pk2(o[0], o[1]); pv[1] = pk2(o[2], o[3]); pv[2] = pk2(o[4], o[5]); pv[3] = pk2(o[6], o[7]);
                *(u32x4*)(sXc + swz128(tk, c)) = pv;
                if ((c >> 2) == half) {
                    *(f32x4*)(sUcc + tk * 32 + (c & 3) * 8) = (f32x4){o[0], o[1], o[2], o[3]};
                    *(f32x4*)(sUcc + tk * 32 + (c & 3) * 8 + 4) = (f32x4){o[4], o[5], o[6], o[7]};
                }
            }
            if (ci + 1 < 36) load_chunk(ci + 1);
            lds_barrier();
            if (HOST && cvp_ok) cv_flush(cvp, sCv);
            if (ci > 0) {
                const u32x4 v = *(const u32x4*)(sO + ((ci - 1) & 1) * 2048 + tid * 8);
                *(u32x4*)(HS + prev_base + (size_t)(tid >> 2) * D + (tid & 3) * 8) = v;
            }
            {
                f32x4 acc[4];
#pragma unroll
                for (int jt = 0; jt < 4; ++jt) acc[jt] = (f32x4){0.f, 0.f, 0.f, 0.f};
#pragma unroll
                for (int kk = 0; kk < 2; ++kk) {
                    const bf16x8 xf = ldsv8(sXc + swz128(wave * 16 + fr, kk * 4 + fq));
#pragma unroll
                    for (int jt = 0; jt < 4; ++jt) acc[jt] = mfma16(ldsv8(sW + swz128(jt * 16 + fr, kk * 4 + fq)), xf, acc[jt]);
                }
                const int tk = wave * 16 + fr;
#pragma unroll
                for (int jt = 0; jt < 2; ++jt) {
                    const f32x4 uc = *(const f32x4*)(sUcc + tk * 32 + jt * 16 + fq * 4);
                    f32x4 av4, bv4;
#pragma unroll
                    for (int e = 0; e < 4; ++e) {
                        if (VAR & 2) { av4[e] = 0.5f + 0.001f * acc[jt][e]; bv4[e] = uc[e] + acc[jt + 2][e]; continue; }
                        const float rg = sigmoidf_(acc[jt][e] + bg0[jt * 4 + e]);
                        const float ig = sigmoidf_(acc[jt + 2][e] + bg1[jt * 4 + e]);
                        const float av = fexp(rg * spl[jt * 4 + e]);
                        av4[e] = av;
                        bv4[e] = __builtin_amdgcn_sqrtf(fmaxf(1.f - av * av, 0.f)) * ig * uc[e];
                    }
#pragma unroll
                    for (int e = 0; e < 4; ++e) { sA[(jt * 16 + fq * 4 + e) * 68 + tk] = av4[e]; sB[(jt * 16 + fq * 4 + e) * 68 + tk] = bv4[e]; }
                }
            }
            lds_barrier();
            if (!(VAR & 4)) {
                const int ch = wave * 8 + (lane & 7), sg = lane >> 3;
                const int tb = dir ? 56 - sg * 8 : sg * 8;
                const f32x4 a0 = *(const f32x4*)(sA + ch * 68 + tb), a1 = *(const f32x4*)(sA + ch * 68 + tb + 4);
                const f32x4 b0 = *(const f32x4*)(sB + ch * 68 + tb), b1 = *(const f32x4*)(sB + ch * 68 + tb + 4);
                float av[8], bv[8];
#pragma unroll
                for (int e = 0; e < 4; ++e) {
                    av[e] = dir ? a1[3 - e] : a0[e]; av[4 + e] = dir ? a0[3 - e] : a1[e];
                    bv[e] = dir ? b1[3 - e] : b0[e]; bv[4 + e] = dir ? b0[3 - e] : b1[e];
                }
                float Ap = 1.f, Hh = 0.f;
#pragma unroll
                for (int e = 0; e < 8; ++e) { Hh = av[e] * Hh + bv[e]; Ap *= av[e]; }
#pragma unroll
                for (int d = 8; d < 64; d <<= 1) {
                    const float Ao = __shfl_up(Ap, d), Ho = __shfl_up(Hh, d);
                    if (lane >= d) { Hh = Ap * Ho + Hh; Ap = Ap * Ao; }
                }
                float Aex = __shfl_up(Ap, 8), Hex = __shfl_up(Hh, 8);
                if (sg == 0) { Aex = 1.f; Hex = 0.f; }
                float hin = Aex * carry + Hex;
                const float cnew = Ap * carry + Hh;
                carry = __shfl(cnew, 56 + (lane & 7));
                bf16_t* so = sO + (ci & 1) * 2048 + ch;
#pragma unroll
                for (int e = 0; e < 8; ++e) {
                    hin = av[e] * hin + bv[e];
                    const int i = sg * 8 + e, tk = dir ? 63 - i : i;
                    so[tk * 32] = f2bf(hin);
                }
            }
            prev_base = (size_t)dir * NTOK * D + (size_t)(rb + s0) * D + co0;
            if (HOST) { if (cv_ok) cv_pack(sCv, cv0, cv1); cvp = cvc; cvp_ok = cv_ok; }
        }
        __syncthreads();
        if (HOST && cvp_ok) cv_flush(cvp, sCv);
        {
            const u32x4 v = *(const u32x4*)(sO + (35 & 1) * 2048 + tid * 8);
            *(u32x4*)(HS + prev_base + (size_t)(tid >> 2) * D + (tid & 3) * 8) = v;
        }
    }
}

DI void phase_rg_combine(const Args& a) {
    const u32x4* G = (const u32x4*)(a.ws + RG_G);
    const u32x4* H0 = (const u32x4*)(a.ws + RG_HS);
    const u32x4* H1 = (const u32x4*)(a.ws + RG_HS + TOKD2);
    u32x4* A2 = (u32x4*)(a.ws + RG_A2);
    const size_t n = (size_t)NTOK * D / 8;
    for (size_t i = (size_t)blockIdx.x * NTHR + threadIdx.x; i < n; i += (size_t)gridDim.x * NTHR) {
        const u32x4 g = G[i], h0 = H0[i], h1 = H1[i];
        u32x4 o;
#pragma unroll
        for (int e = 0; e < 4; ++e) o[e] = pk2(lof(g[e]) * (lof(h0[e]) + lof(h1[e])), hif(g[e]) * (hif(h0[e]) + hif(h1[e])));
        A2[i] = o;
    }
}

DI void phase_rg_out(const Args& a, int li, int j) {
    gemm_dense_phase((const bf16_t*)(a.ws + RG_A2), D, li == 3 ? NLAT : NTOK, (const bf16_t*)(a.ws + W_RGOUT) + (size_t)j * 1024 * 1024, 1024, 1024,
        [&](int m0, int n0, const f32x4 (&acc)[4][4]) { epi_resid_f32(a, li, m0, n0, acc); });
}

DI void phase_mla_down(const Args& a) {
    bf16_t* CQ = (bf16_t*)(a.ws + MLA_CQ); bf16_t* CKV = (bf16_t*)(a.ws + MLA_CKV); float* KR = (float*)(a.ws + MLA_KR);
    gemm_dense_phase((const bf16_t*)(a.ws + WS_H), D, NTOK, (const bf16_t*)(a.ws + W_MDOWN), 512, 1024,
        [&](int m0, int n0, const f32x4 (&acc)[4][4]) {
            if (n0 < 256) epi_bf16_rowmajor(acc, [](int, int, const f32x4 v) { return v; }, [&](int row) { return CQ + (size_t)(m0 + row) * 256 + n0; });
            else if (n0 == 256) epi_bf16_rowmajor(acc, [](int, int, const f32x4 v) { return v; }, [&](int row) { return CKV + (size_t)(m0 + row) * 128; });
            else {
#pragma unroll
                for (int i = 0; i < 4; ++i)
#pragma unroll
                    for (int j = 0; j < 2; ++j) { const int n = lane_n(j); if (n < 32) *(f32x4*)(KR + (size_t)(m0 + lane_m(i)) * 32 + n) = acc[i][j]; }
            }
        });
}

DI int perm_key(int kp) { return (kp & ~12) | ((kp & 4) << 1) | ((kp & 8) >> 1); }

DI void phase_mla_up(const Args& a) {
    const int tid = threadIdx.x;
    const bf16_t* CQ = (const bf16_t*)(a.ws + MLA_CQ); const bf16_t* CKV = (const bf16_t*)(a.ws + MLA_CKV); const float* KR = (const float*)(a.ws + MLA_KR);
    bf16_t* Q = (bf16_t*)(a.ws + MLA_Q); bf16_t* Kb = (bf16_t*)(a.ws + MLA_K); bf16_t* VT = (bf16_t*)(a.ws + MLA_VT);
    const float* qkn = a.in[20];
    const float* RC = (const float*)(a.ws + WS_CTL + CTL_ROPE); const float* RS = RC + 512;
    const int MT_ = NTOK / 128;
    const int nq = MT_ * 16, nkv = MT_ * 16;
    const float QSCALE = 0.10206207261596575f * 1.4426950408889634f;
    for (int u = blockIdx.x; u < nq + nkv; u += gridDim.x) {
        const bool isq = u < nq;
        const int uu = isq ? u : u - nq;
        const int xc_ = uu & 7, s_ = uu >> 3;
        const int m0 = (((s_ >> 4) << 3) + xc_) * 128, head = s_ & 15;
        const bool islat = m0 < NLAT;
        const int bb = islat ? (m0 >> 11) : ((m0 - NLAT) >> 8);
        const int kp0 = islat ? CTXL + (m0 & (SEQ - 1)) : ((m0 - NLAT) & (CTXL - 1));
        __syncthreads();
        if (isq) {
            f32x4 hold[2][6];
            float ssq[2] = {0.f, 0.f};
            gemm_tile<4, 1, 2, 6, false>([&](int r) { return CQ + (size_t)(m0 + r) * 256; }, (const bf16_t*)(a.ws + W_MUQ) + (size_t)head * 96 * 256, 256, 256, hold, ssq);
            const int tz = opaque_tid();
            const int wave = tz >> 6, fq = (tz >> 4) & 3, fr = tz & 15;
#pragma unroll
            for (int i = 0; i < 2; ++i) {
                const int m = wave * 32 + i * 16 + fr;
                float sq = ssq[i]; sq += __shfl_xor(sq, 16); sq += __shfl_xor(sq, 32);
                const float rs0 = rsqrtf(sq * (1.f / 256.f) + EPS);
                float ss = 0.f;
#pragma unroll
                for (int jn = 0; jn < 6; ++jn) { hold[i][jn] *= rs0;
#pragma unroll
                    for (int e = 0; e < 4; ++e) ss += hold[i][jn][e] * hold[i][jn][e]; }
                ss += __shfl_xor(ss, 16); ss += __shfl_xor(ss, 32);
                const float rs = rsqrtf(ss * (1.f / 96.f) + EPS) ;
                f32x4 o[6];
#pragma unroll
                for (int jn = 0; jn < 6; ++jn) { const f32x4 g4 = *(const f32x4*)(qkn + jn * 16 + fq * 4); o[jn] = hold[i][jn] * rs * g4; }
#pragma unroll
                for (int jn = 4; jn < 6; ++jn) {
                    f32x4 other;
#pragma unroll
                    for (int e = 0; e < 4; ++e) other[e] = __shfl_xor(o[jn][e], 32);
                    if (islat) {
                        const int s = (m0 + m) & (SEQ - 1);
                        const int pos = jn == 4 ? (s >> 6) : (s & 63);
                        const f32x4 cs = *(const f32x4*)(RC + pos * 8 + (fq & 1) * 4), sn = *(const f32x4*)(RS + pos * 8 + (fq & 1) * 4);
#pragma unroll
                        for (int e = 0; e < 4; ++e) o[jn][e] = (fq < 2) ? o[jn][e] * cs[e] - other[e] * sn[e] : o[jn][e] * cs[e] + other[e] * sn[e];
                    }
                }
#pragma unroll
                for (int jn = 0; jn < 6; ++jn) {
                    const f32x4 v = o[jn] * QSCALE;
                    u32x2 pv; pv[0] = pk2(v[0], v[1]); pv[1] = pk2(v[2], v[3]);
                    *(u32x2*)(lds + m * 256 + (((jn * 2 + (fq >> 1)) ^ (m & 15)) << 4) + (fq & 1) * 8) = pv;
                }
            }
            __syncthreads();
#pragma unroll
            for (int it = 0; it < 8; ++it) {
                const int idx = tz + it * NTHR, row = idx >> 4, ch = idx & 15;
                if (ch < 12) {
                    const u32x4 v = *(const u32x4*)(lds + row * 256 + ((ch ^ (row & 15)) << 4));
                    *(u32x4*)(Q + (size_t)(m0 + row) * 1536 + head * 96 + ch * 8) = v;
                }
            }
        } else {
            f32x4 hold[4][4];
            float ssq[4] = {0.f, 0.f, 0.f, 0.f};
            gemm_tile<2, 2, 4, 4, false>([&](int r) { return CKV + (size_t)(m0 + r) * 128; }, (const bf16_t*)(a.ws + W_MUKV) + (size_t)head * 128 * 128, 128, 128, hold, ssq);
            const int tz = opaque_tid();
            const int wave = tz >> 6, wm = wave >> 1, wn = wave & 1, fq = (tz >> 4) & 3, fr = tz & 15;
            char* sK = lds; char* sV = lds + 32768;
#pragma unroll
            for (int i = 0; i < 4; ++i) {
                const int m = wm * 64 + i * 16 + fr, t = m0 + m;
                float sq = ssq[i]; sq += __shfl_xor(sq, 16); sq += __shfl_xor(sq, 32);
                const float rs0 = rsqrtf(sq * (1.f / 128.f) + EPS);
#pragma unroll
                for (int jn = 0; jn < 4; ++jn) hold[i][jn] *= rs0;
                if (wn == 0) {
                    const int base = (fq >> 1) * 16 + (fq & 1) * 4;
                    const f32x4 z1 = *(const f32x4*)(KR + (size_t)t * 32 + base);
                    const f32x4 z2 = *(const f32x4*)(KR + (size_t)t * 32 + base + 8);
                    float ss = 0.f;
#pragma unroll
                    for (int jn = 0; jn < 4; ++jn)
#pragma unroll
                        for (int e = 0; e < 4; ++e) ss += hold[i][jn][e] * hold[i][jn][e];
#pragma unroll
                    for (int e = 0; e < 4; ++e) ss += z1[e] * z1[e] + z2[e] * z2[e];
                    ss += __shfl_xor(ss, 16); ss += __shfl_xor(ss, 32);
                    const float rs = rsqrtf(ss * (1.f / 96.f) + EPS);
#pragma unroll
                    for (int jn = 0; jn < 4; ++jn) {
                        const f32x4 g4 = *(const f32x4*)(qkn + 96 + jn * 16 + fq * 4);
                        const f32x4 v = hold[i][jn] * rs * g4;
                        u32x2 pv; pv[0] = pk2(v[0], v[1]); pv[1] = pk2(v[2], v[3]);
                        *(u32x2*)(sK + m * 256 + (((jn * 2 + (fq >> 1)) ^ (m & 15)) << 4) + (fq & 1) * 8) = pv;
                    }
                    const f32x4 g1 = *(const f32x4*)(qkn + 96 + 64 + base), g2 = *(const f32x4*)(qkn + 96 + 64 + base + 8);
                    f32x4 a1 = z1 * rs * g1, a2 = z2 * rs * g2;
                    if (islat) {
                        const int s = t & (SEQ - 1);
                        const int pos = (fq >> 1) == 0 ? (s >> 6) : (s & 63);
                        const f32x4 cs = *(const f32x4*)(RC + pos * 8 + (fq & 1) * 4), sn = *(const f32x4*)(RS + pos * 8 + (fq & 1) * 4);
                        const f32x4 b1 = a1 * cs - a2 * sn, b2 = a2 * cs + a1 * sn;
                        a1 = b1; a2 = b2;
                    }
                    u32x2 p1, p2; p1[0] = pk2(a1[0], a1[1]); p1[1] = pk2(a1[2], a1[3]); p2[0] = pk2(a2[0], a2[1]); p2[1] = pk2(a2[2], a2[3]);
                    const int c1 = 8 + (fq >> 1) * 2;
                    *(u32x2*)(sK + m * 256 + ((c1 ^ (m & 15)) << 4) + (fq & 1) * 8) = p1;
                    *(u32x2*)(sK + m * 256 + (((c1 + 1) ^ (m & 15)) << 4) + (fq & 1) * 8) = p2;
                }
                {
                    const bool odd = fr & 1;
                    const int mp = perm_key(m & ~1);
#pragma unroll
                    for (int jn = 0; jn < 4; ++jn) {
                        const f32x4 v = hold[i][jn];
                        const float r0 = __shfl_xor(odd ? v[0] : v[2], 1), r1 = __shfl_xor(odd ? v[1] : v[3], 1);
                        if (wn == 1) {
                            const int e0 = jn * 16 + fq * 4 + (odd ? 2 : 0);
                            const unsigned w0 = odd ? pk2(r0, v[2]) : pk2(v[0], r0), w1 = odd ? pk2(r1, v[3]) : pk2(v[1], r1);
                            *(unsigned*)(sV + e0 * 256 + (((mp >> 3) ^ (e0 & 15)) << 4) + (mp & 6) * 2) = w0;
                            *(unsigned*)(sV + (e0 + 1) * 256 + (((mp >> 3) ^ ((e0 + 1) & 15)) << 4) + (mp & 6) * 2) = w1;
                        }
                    }
                }
            }
            __syncthreads();
            bf16_t* kdst = Kb + ((size_t)(bb * 16 + head) * NKEY + kp0) * 96;
#pragma unroll
            for (int it = 0; it < 8; ++it) {
                const int idx = tz + it * NTHR, row = idx >> 4, ch = idx & 15;
                if (ch < 12) {
                    const u32x4 v = *(const u32x4*)(sK + row * 256 + ((ch ^ (row & 15)) << 4));
                    *(u32x4*)(kdst + (size_t)row * 96 + ch * 8) = v;
                }
            }
            bf16_t* vdst = VT + ((size_t)(bb * 16 + head) * 64) * NKEY + kp0;
#pragma unroll
            for (int it = 0; it < 4; ++it) {
                const int idx = tz + it * NTHR, row = idx >> 4, ch = idx & 15;
                const u32x4 v = *(const u32x4*)(sV + row * 256 + ((ch ^ (row & 15)) << 4));
                *(u32x4*)(vdst + (size_t)row * NKEY + ch * 8) = v;
            }
        }
    }
}

DI void phase_mla_attn(const Args& a) {
    const int tid = threadIdx.x, lane = tid & 63, wave = tid >> 6;
    const int r = lane & 31, h = lane >> 5;
    const bf16_t* Q = (const bf16_t*)(a.ws + MLA_Q); const bf16_t* Kb = (const bf16_t*)(a.ws + MLA_K); const bf16_t* VT = (const bf16_t*)(a.ws + MLA_VT);
    bf16_t* O = (bf16_t*)(a.ws + MLA_O);
    constexpr int KT_B = 64 * 192, VT_B = 64 * 128, ST_B = KT_B + VT_B;
    unsigned* sCv = (unsigned*)(lds + 49152);
    const int cv_per = 18432 / gridDim.x;
    int cvn = 0, itc = 0;
    bool cv_pack_p = false, cv_flush_p = false;
    CvTile cvB, cvC; cvB.src = nullptr; cvB.dst = nullptr; cvB.K = 0; cvB.N = 0; cvB.perm = 0; cvB.k0 = 0; cvB.n0 = 0; cvC = cvB;
    f32x4 cv0[4], cv1[4];
#pragma unroll
    for (int i = 0; i < 4; ++i) { cv0[i] = (f32x4){0.f, 0.f, 0.f, 0.f}; cv1[i] = cv0[i]; }
    auto cv_step = [&](bool may_load) {
        if (cv_flush_p) { cv_flush(cvC, sCv); cv_flush_p = false; }
        if (cv_pack_p) { cv_pack(sCv, cv0, cv1); cvC = cvB; cv_flush_p = true; cv_pack_p = false; }
        if (may_load && cvn < cv_per) {
            const int t = cvn * gridDim.x + blockIdx.x;
            cvB = moe_cv_tile(a, 1 + t / 6144, t % 6144); cv_load(cvB, cv0, cv1); cv_pack_p = true; ++cvn;
        }
    };
    for (int u = blockIdx.x; u < 2048 + 256; u += gridDim.x) {
        const bool isctx = u >= 2048;
        const int uu = isctx ? u - 2048 : u;
        const int xc_ = uu & 7, s_ = uu >> 3, bh_ = ((s_ >> 4) << 3) + xc_;
        const int qb = isctx ? (uu & 1) : (s_ & 15), head = isctx ? ((uu >> 1) & 15) : (bh_ & 15), b = isctx ? (uu >> 5) : (bh_ >> 4);
        const int ntile = isctx ? CTXL / 64 : NKEY / 64;
        const int t = (isctx ? NLAT + b * CTXL : b * SEQ) + qb * 128 + wave * 32 + r;
        const bf16_t* kbase = Kb + (size_t)(b * 16 + head) * NKEY * 96;
        const bf16_t* vbase = VT + (size_t)(b * 16 + head) * 64 * NKEY;
        bf16x8 qf[6];
#pragma unroll
        for (int kk = 0; kk < 6; ++kk) qf[kk] = *(const bf16x8*)(Q + (size_t)t * 1536 + head * 96 + kk * 16 + h * 8);
        f32x16 o[2];
#pragma unroll
        for (int e = 0; e < 16; ++e) { o[0][e] = 0.f; o[1][e] = 0.f; }
        float lsum = 0.f;
        __syncthreads();
        auto stage = [&](int kt, int buf) {
            char* sk = lds + buf * ST_B; char* sv = sk + KT_B;
            const int key0 = kt * 64;
#pragma unroll
            for (int i = 0; i < 3; ++i) {
                const int idx = tid + i * NTHR, row = idx / 12, slot = idx - row * 12;
                int c = slot - ((row >> 2) % 12); if (c < 0) c += 12;
                dma16(kbase + (size_t)(key0 + row) * 96 + c * 8, sk + idx * 16);
            }
#pragma unroll
            for (int i = 0; i < 2; ++i) {
                const int idx = tid + i * NTHR, row = idx >> 3, c = (idx & 7) ^ ((row >> 1) & 7);
                dma16(vbase + (size_t)row * NKEY + key0 + c * 8, sv + idx * 16);
            }
        };
        stage(0, 0);
#pragma unroll 1
        for (int kt = 0; kt < ntile; ++kt) {
            wait_vm0();
            __syncthreads();
            if (kt + 1 < ntile) stage(kt + 1, (kt + 1) & 1);
            cv_step((itc & 3) == 0); ++itc;
            const char* sk = lds + (kt & 1) * ST_B; const char* sv = sk + KT_B;
            f32x16 st[2];
#pragma unroll
            for (int e = 0; e < 16; ++e) { st[0][e] = -8.f; st[1][e] = -8.f; }
#pragma unroll
            for (int kk = 0; kk < 6; ++kk)
#pragma unroll
                for (int si = 0; si < 2; ++si) {
                    const int s = si * 32 + r;
                    int slot = kk * 2 + h + ((s >> 2) % 12); if (slot >= 12) slot -= 12;
                    st[si] = mfma32(ldsv8(sk + s * 192 + slot * 16), qf[kk], st[si]);
                }
            float ps = 0.f;
#pragma unroll
            for (int si = 0; si < 2; ++si)
#pragma unroll
                for (int e = 0; e < 16; ++e) { const float p = __builtin_amdgcn_exp2f(st[si][e]); st[si][e] = p; ps += p; }
            lsum += ps;
#pragma unroll
            for (int si = 0; si < 2; ++si)
#pragma unroll
                for (int ks = 0; ks < 2; ++ks) {
                    u32x4 pp;
                    pp[0] = pk2(st[si][8 * ks + 0], st[si][8 * ks + 1]); pp[1] = pk2(st[si][8 * ks + 2], st[si][8 * ks + 3]);
                    pp[2] = pk2(st[si][8 * ks + 4], st[si][8 * ks + 5]); pp[3] = pk2(st[si][8 * ks + 6], st[si][8 * ks + 7]);
                    const bf16x8 pf = __builtin_bit_cast(bf16x8, pp);
#pragma unroll
                    for (int et = 0; et < 2; ++et) {
                        const int e = et * 32 + r;
                        o[et] = mfma32(ldsv8(sv + e * 128 + (((si * 4 + ks * 2 + h) ^ ((e >> 1) & 7)) << 4)), pf, o[et]);
                    }
                }
        }
        lsum += __shfl_xor(lsum, 32);
        const float inv = 1.f / lsum;
#pragma unroll
        for (int et = 0; et < 2; ++et)
#pragma unroll
            for (int g = 0; g < 4; ++g) {
                f32x4 v; v[0] = o[et][4 * g] * inv; v[1] = o[et][4 * g + 1] * inv; v[2] = o[et][4 * g + 2] * inv; v[3] = o[et][4 * g + 3] * inv;
                st_bf4(O + (size_t)t * D + head * 64 + et * 32 + 8 * g + 4 * h, v);
            }
    }
    while (cvn < cv_per || cv_pack_p || cv_flush_p) { __syncthreads(); cv_step(!cv_pack_p && !cv_flush_p); }
}

DI void phase_mla_out(const Args& a, int li) {
    gemm_dense_phase((const bf16_t*)(a.ws + MLA_O), D, NTOK, (const bf16_t*)(a.ws + W_MO), 1024, 1024,
        [&](int m0, int n0, const f32x4 (&acc)[4][4]) { epi_resid_f32(a, li, m0, n0, acc); });
}

DI void phase_ml_in(const Args& a) {
    bf16_t* Qm = (bf16_t*)(a.ws + ML_Q); bf16_t* Km = (bf16_t*)(a.ws + ML_K); bf16_t* VT = (bf16_t*)(a.ws + ML_VT);
    bf16_t* OG = (bf16_t*)(a.ws + ML_OG); float* GT = (float*)(a.ws + ML_GT);
    const float* gb = a.in[23];
    auto ident = [](int, int, const f32x4 v) { return v; };
    gemm_dense_phase<false>((const bf16_t*)(a.ws + WS_H), D, NTOK, (const bf16_t*)(a.ws + W_MLIN), 3200, 1024,
        [&](int m0, int n0, const f32x4 (&acc)[4][4]) {
            if (n0 < 512) {
                epi_bf16_rowmajor(acc, [](int, int, const f32x4 v) { return v * 0.08838834764831845f; }, [&](int row) { return Qm + (size_t)(m0 + row) * 512 + n0; });
            } else if (n0 < 1024) {
                epi_bf16_rowmajor(acc, ident, [&](int row) { return Km + (size_t)(m0 + row) * 512 + (n0 - 512); });
            } else if (n0 < 2048) {
                __syncthreads();
                epi_stage_bf16_T(acc, ident);
                __syncthreads();
                epi_flush_bf16([&](int row) { return VT + (size_t)(n0 - 1024 + row) * NTOK + m0; }, [](int) { return true; });
            } else if (n0 < 3072) {
                epi_bf16_rowmajor(acc, [](int, int, const f32x4 v) { f32x4 s; s[0] = sigmoidf_(v[0]); s[1] = sigmoidf_(v[1]); s[2] = sigmoidf_(v[2]); s[3] = sigmoidf_(v[3]); return s; },
                                  [&](int row) { return OG + (size_t)(m0 + row) * D + (n0 - 2048); });
            } else {
#pragma unroll
                for (int i = 0; i < 4; ++i) {
                    const int n = lane_n(0);
                    if (n < 16) { f32x4 s = acc[i][0]; s[0] += gb[n]; s[1] += gb[n + 1]; s[2] += gb[n + 2]; s[3] += gb[n + 3]; *(f32x4*)(GT + (size_t)(m0 + lane_m(i)) * 16 + n) = s; }
                }
            }
        });
}

template <int VAR = 0>
DI void phase_ml_scan(const Args& a) {
    const int tid = threadIdx.x, lane = tid & 63, wave = tid >> 6;
    const int fr = lane & 15, fq = lane >> 4;
    const bf16_t* Qm = (const bf16_t*)(a.ws + ML_Q); const bf16_t* Km = (const bf16_t*)(a.ws + ML_K);
    const bf16_t* VT = (const bf16_t*)(a.ws + ML_VT);
    const float* GT = (const float*)(a.ws + ML_GT);
    bf16_t* HS = (bf16_t*)(a.ws + (VAR ? WS_Y : ML_HS));
    char* sQ = lds;
    char* sK = lds + 16384;
    char* sS = lds + 32768;
    char* sVT = lds + 40960;
    char* sCT = lds + 47104;
    float* sRow = (float*)(lds + 59392);
    float* sCol = sRow + 64;
    float* sInt = sCol + 64;
    float* sNrm = sInt + 64;
    float* sWv = sNrm + 64;
    float* sSc = sWv + 64;
    for (int u = blockIdx.x; u < 512; u += gridDim.x) {
        const int xc_ = u & 7, s_ = u >> 3, bh_ = ((s_ >> 4) << 3) + xc_;
        const int sl = s_ & 7, dir = (s_ >> 3) & 1, head = bh_ & 3, b = bh_ >> 2;
        auto chunk_t0 = [&](int ci) {
            const int seg = ci >= 4, L = seg ? SEQ : CTXL, nch = L / 64, jc = seg ? ci - 4 : ci;
            const int oc = dir ? nch - 1 - jc : jc;
            return (seg ? b * SEQ : NLAT + b * CTXL) + oc * 64;
        };
        u32x4 pq[4], pk[4], pvt;
        float g_bc = 0.f, g_av = 0.f, g_pm = 0.f;
        auto load_tiles = [&](int t0) {
            const int tid = opaque_tid();
#pragma unroll
            for (int i = 0; i < 4; ++i) {
                const int idx = tid + i * NTHR, row = idx >> 4, c = (idx & 15) ^ (row & 15), ck = (idx & 15) ^ trswz(row);
                pq[i] = *(const u32x4*)(Qm + (size_t)(t0 + row) * 512 + head * 128 + c * 8);
                pk[i] = *(const u32x4*)(Km + (size_t)(t0 + row) * 512 + head * 128 + ck * 8);
            }
            { const int row = tid >> 3, c = (tid & 7) ^ (row & 7); pvt = *(const u32x4*)(VT + (size_t)(head * 256 + sl * 32 + row) * NTOK + t0 + c * 8); }
        };
        auto load_gates = [&](int ci) {
            if (wave == 0) { const float* g = (const float*)(a.ws + WS_GS) + ((size_t)u * 36 + ci) * 192 + lane; g_bc = g[0]; g_av = g[64]; g_pm = g[128]; }
        };
        auto store_tiles = [&]() {
            const int tid = opaque_tid();
#pragma unroll
            for (int i = 0; i < 4; ++i) { *(u32x4*)(sQ + (tid + i * NTHR) * 16) = pq[i]; *(u32x4*)(sK + (tid + i * NTHR) * 16) = pk[i]; }
            *(u32x4*)(sVT + tid * 16) = pvt;
        };
        auto gate_scalars = [&]() {
            const int s = dir ? 63 - lane : lane;
            const float bc = g_bc, av = g_av, pm = g_pm;
            const float mst = sSc[1];
            const float mm = fmaxf(mst, pm);
            sRow[s] = -mm;
            sCol[s] = av;
            sInt[s] = fexp(mst - mm);
            sNrm[s] = fexp(-(bc + mm));
            const float mmL = __shfl(mm, 63), bL = __shfl(bc, 63);
            sWv[s] = fexp(av - mmL);
            if (lane == 0) { sSc[0] = fexp(mst - mmL); sSc[1] = bL + mmL; }
        };
#pragma unroll 1
        for (int ci = wave; ci < 36; ci += 4) {
            const int t0 = chunk_t0(ci);
            const int s = dir ? 63 - lane : lane;
            const float ig = GT[(size_t)(t0 + s) * 16 + dir * 8 + head];
            const float fg = GT[(size_t)(t0 + s) * 16 + dir * 8 + 4 + head];
            const float lf = fminf(fg, 0.f) - __logf(1.f + fexp(-fabsf(fg)));
            float bc = lf;
#pragma unroll
            for (int d = 1; d < 64; d <<= 1) { const float o = __shfl_up(bc, d); if (lane >= d) bc += o; }
            const float av = ig - bc;
            float pm = av;
#pragma unroll
            for (int d = 1; d < 64; d <<= 1) { const float o = __shfl_up(pm, d); if (lane >= d) pm = fmaxf(pm, o); }
            float* g = (float*)(a.ws + WS_GS) + ((size_t)u * 36 + ci) * 192 + lane; g[0] = bc; g[64] = av; g[128] = pm;
        }
        __syncthreads();
        for (int i = tid; i < 12288 / 16; i += NTHR) *(u32x4*)(sCT + i * 16) = (u32x4){0u, 0u, 0u, 0u};
        for (int i = tid; i < 16 * 8; i += NTHR) {
            const int row = 32 + (i >> 3), c = i & 7;
            const unsigned v = row == 32 ? 0x3f803f80u : 0u;
            *(u32x4*)(sVT + swz128(row, c)) = (u32x4){v, v, v, v};
        }
        if (tid == 0) sSc[1] = -1e30f;
        f32x4 accC[2][3];
#pragma unroll
        for (int i = 0; i < 2; ++i)
#pragma unroll
            for (int jn = 0; jn < 3; ++jn) accC[i][jn] = (f32x4){0.f, 0.f, 0.f, 0.f};
        load_tiles(chunk_t0(0));
        __syncthreads();
        load_gates(0);
        store_tiles();
        if (wave == 0) gate_scalars();
        __syncthreads();
#pragma unroll 1
        for (int ci = 0; ci < 36; ++ci) {
            const int t0 = chunk_t0(ci);
            if (!(VAR & 8) && ci + 1 < 36) { load_tiles(chunk_t0(ci + 1)); load_gates(ci + 1); }
            f32x4 sacc[4];
#pragma unroll
            for (int jt = 0; jt < 4; ++jt) sacc[jt] = (f32x4){0.f, 0.f, 0.f, 0.f};
#pragma unroll
            for (int kk = 0; kk < 4; ++kk) {
                const bf16x8 qf = ldsv8(sQ + swz256(wave * 16 + fr, kk * 4 + fq));
#pragma unroll
                for (int jt = 0; jt < 4; ++jt) { const int sr = jt * 16 + fr; sacc[jt] = mfma16(ldsv8(sK + sr * 256 + (((kk * 4 + fq) ^ trswz(sr)) << 4)), qf, sacc[jt]); }
            }
            {
                const int tq = wave * 16 + fr;
                const float rt = sRow[tq];
#pragma unroll
                for (int jt = 0; jt < 4; ++jt) {
                    const f32x4 cl = *(const f32x4*)(sCol + jt * 16 + fq * 4);
                    f32x4 v;
#pragma unroll
                    for (int e = 0; e < 4; ++e) {
                        const int s = jt * 16 + fq * 4 + e;
                        const bool ok = dir ? (s >= tq) : (s <= tq);
                        v[e] = ok ? sacc[jt][e] * fexp(rt + cl[e]) : 0.f;
                    }
                    u32x2 pv; pv[0] = pk2(v[0], v[1]); pv[1] = pk2(v[2], v[3]);
                    *(u32x2*)(sS + swz128(tq, jt * 2 + (fq >> 1)) + (fq & 1) * 8) = pv;
                }
            }
            lds_barrier();
            if (!(VAR & 2)) {
                f32x4 n1[3], n2[3];
#pragma unroll
                for (int jt = 0; jt < 3; ++jt) { n1[jt] = (f32x4){0.f, 0.f, 0.f, 0.f}; n2[jt] = (f32x4){0.f, 0.f, 0.f, 0.f}; }
#pragma unroll
                for (int kk = 0; kk < 2; ++kk) {
                    const bf16x8 sf = ldsv8(sS + swz128(wave * 16 + fr, kk * 4 + fq));
#pragma unroll
                    for (int jt = 0; jt < 3; ++jt) n1[jt] = mfma16(ldsv8(sVT + swz128(jt * 16 + fr, kk * 4 + fq)), sf, n1[jt]);
                }
#pragma unroll
                for (int kk = 0; kk < 4; ++kk) {
                    const bf16x8 qf = ldsv8(sQ + swz256(wave * 16 + fr, kk * 4 + fq));
#pragma unroll
                    for (int jt = 0; jt < 3; ++jt) n2[jt] = mfma16(ldsv8(sCT + swz256(jt * 16 + fr, kk * 4 + fq)), qf, n2[jt]);
                }
                const int tq = wave * 16 + fr;
                const float it = sInt[tq];
                float den = n1[2][0] + it * n2[2][0];
                den = __shfl(den, fr);
                const float dn = fmaxf(fabsf(den), sNrm[tq]);
                const float inv = rcpf_(dn);
                bf16_t* hp = HS + (size_t)dir * NTOK * D + (size_t)(t0 + tq) * D + head * 256 + sl * 32 + fq * 4;
#pragma unroll
                for (int jt = 0; jt < 2; ++jt) {
                    f32x4 v;
#pragma unroll
                    for (int e = 0; e < 4; ++e) v[e] = (n1[jt][e] + it * n2[jt][e]) * inv;
                    st_bf4(hp + jt * 16, v);
                }
            }
            if (!(VAR & 4)) {
                const float decay = sSc[0];
#pragma unroll
                for (int i = 0; i < 2; ++i)
#pragma unroll
                    for (int jn = 0; jn < 3; ++jn) accC[i][jn] *= decay;
#pragma unroll
                for (int kk = 0; kk < 2; ++kk) {
                    bf16x8 vf[3];
#pragma unroll
                    for (int jn = 0; jn < 3; ++jn) vf[jn] = ldsv8(sVT + swz128(jn * 16 + fr, kk * 4 + fq));
                    const f32x4 w0 = *(const f32x4*)(sWv + kk * 32 + fq * 8), w1 = *(const f32x4*)(sWv + kk * 32 + fq * 8 + 4);
#pragma unroll
                    for (int i = 0; i < 2; ++i) {
                        const int tq_ = (lane >> 2) & 3, tp_ = lane & 3, chd = (wave * 2 + i) * 2 + (tp_ >> 1);
                        const int sA_ = kk * 32 + 8 * fq + tq_, sB_ = sA_ + 4;
                        const s16x4 klo = lds_tr(sK + sA_ * 256 + ((chd ^ trswz(sA_)) << 4) + (tp_ & 1) * 8);
                        const s16x4 khi = lds_tr(sK + sB_ * 256 + ((chd ^ trswz(sB_)) << 4) + (tp_ & 1) * 8);
                        const u32x4 kr = __builtin_bit_cast(u32x4, __builtin_shufflevector(klo, khi, 0, 1, 2, 3, 4, 5, 6, 7));
                        u32x4 ks;
                        ks[0] = pk2(lof(kr[0]) * w0[0], hif(kr[0]) * w0[1]); ks[1] = pk2(lof(kr[1]) * w0[2], hif(kr[1]) * w0[3]);
                        ks[2] = pk2(lof(kr[2]) * w1[0], hif(kr[2]) * w1[1]); ks[3] = pk2(lof(kr[3]) * w1[2], hif(kr[3]) * w1[3]);
                        const bf16x8 kf = __builtin_bit_cast(bf16x8, ks);
#pragma unroll
                        for (int jn = 0; jn < 3; ++jn) accC[i][jn] = mfma16(kf, vf[jn], accC[i][jn]);
                    }
                }
            }
            lds_barrier();
#pragma unroll
            for (int i = 0; i < 2; ++i)
#pragma unroll
                for (int jn = 0; jn < 3; ++jn) {
                    const int dd = (wave * 2 + i) * 16 + fq * 4, ee = jn * 16 + fr;
                    u32x2 pv; pv[0] = pk2(accC[i][jn][0], accC[i][jn][1]); pv[1] = pk2(accC[i][jn][2], accC[i][jn][3]);
                    *(u32x2*)(sCT + swz256(ee, dd >> 3) + (dd & 7) * 2) = pv;
                }
            if (ci + 1 < 36) {
                if (!(VAR & 8)) store_tiles();
                if (wave == 0 && !(VAR & 16)) gate_scalars();
            }
            lds_barrier();
        }
    }
}

DI void phase_ml_readout(const Args& a) {
    const int tid = threadIdx.x, lane = tid & 63, wave = tid >> 6;
    const bf16_t* H0 = (const bf16_t*)(a.ws + ML_HS); const bf16_t* H1 = H0 + (size_t)NTOK * D;
    const bf16_t* OG = (const bf16_t*)(a.ws + ML_OG); bf16_t* A2 = (bf16_t*)(a.ws + ML_A2);
    const float* on = a.in[24];
    for (int t = blockIdx.x * 4 + wave; t < NTOK; t += gridDim.x * 4) {
        const size_t off = (size_t)t * D + lane * 16;
        const u32x4 a0 = *(const u32x4*)(H0 + off), a1 = *(const u32x4*)(H0 + off + 8);
        const u32x4 b0 = *(const u32x4*)(H1 + off), b1 = *(const u32x4*)(H1 + off + 8);
        float v[16];
#pragma unroll
        for (int e = 0; e < 4; ++e) {
            v[2 * e] = lof(a0[e]) + lof(b0[e]); v[2 * e + 1] = hif(a0[e]) + hif(b0[e]);
            v[8 + 2 * e] = lof(a1[e]) + lof(b1[e]); v[8 + 2 * e + 1] = hif(a1[e]) + hif(b1[e]);
        }
        float ss = 0.f;
#pragma unroll
        for (int e = 0; e < 16; ++e) ss += v[e] * v[e];
        ss += __shfl_xor(ss, 1); ss += __shfl_xor(ss, 2); ss += __shfl_xor(ss, 4); ss += __shfl_xor(ss, 8);
        const float rs = rsqrtf(ss * (1.f / 256.f) + EPS);
        const u32x4 g0 = *(const u32x4*)(OG + off), g1 = *(const u32x4*)(OG + off + 8);
        const float* onp = on + lane * 16;
        u32x4 o0, o1;
#pragma unroll
        for (int e = 0; e < 4; ++e) {
            o0[e] = pk2(v[2 * e] * rs * onp[2 * e] * lof(g0[e]), v[2 * e + 1] * rs * onp[2 * e + 1] * hif(g0[e]));
            o1[e] = pk2(v[8 + 2 * e] * rs * onp[8 + 2 * e] * lof(g1[e]), v[8 + 2 * e + 1] * rs * onp[8 + 2 * e + 1] * hif(g1[e]));
        }
        *(u32x4*)(A2 + off) = o0; *(u32x4*)(A2 + off + 8) = o1;
    }
}

DI void phase_ml_out(const Args& a, int li) {
    gemm_dense_phase((const bf16_t*)(a.ws + ML_A2), D, NTOK, (const bf16_t*)(a.ws + W_MLOUT), 1024, 1024,
        [&](int m0, int n0, const f32x4 (&acc)[4][4]) { epi_resid_f32(a, li, m0, n0, acc); });
}

template <int STAGE>
DI void phase_moe(const Args& a, int li) {
    const int tid = threadIdx.x, lane = tid & 63, wave = tid >> 6;
    const int fr = lane & 15, fq = lane >> 4, wm = wave >> 1, wn = wave & 1;
    const int* cnt = (const int*)(a.ws + WS_CTL + CTL_CNT) + li * 64;
    const int* list = (const int*)(a.ws + WS_LIST);
    const float* wsl = (const float*)(a.ws + WS_WSLOT);
    const bf16_t* F = (const bf16_t*)(a.ws + WS_H);
    bf16_t* HM = (bf16_t*)(a.ws + WS_HMID); bf16_t* Y = (bf16_t*)(a.ws + WS_Y);
    int* pre = (int*)(lds + LDS_AUX);
    int* srowb = pre + 16;
    const int xc = blockIdx.x & 7, rank = blockIdx.x >> 3, nrank = gridDim.x >> 3;
    __syncthreads();
    if (tid == 0) { int s = 0; for (int i = 0; i < 8; ++i) { pre[i] = s; s += (cnt[xc + 8 * i] + 127) >> 7; } pre[8] = s; }
    __syncthreads();
    const int T = pre[8];
    constexpr int NTN = STAGE == 0 ? 4 : 8;
    constexpr int KK = STAGE == 0 ? 1024 : 256;
    const int total = T * NTN;
    int e = 0, r0 = 0, ce = 0, nt = 0, cur = 0;
    auto decode = [&](int u) {
        const int ti = u / NTN; nt = u % NTN;
        int ei = 0;
#pragma unroll 1
        for (int s = 4; s > 0; s >>= 1) if (pre[ei + s] <= ti) ei += s;
        e = xc + 8 * ei; r0 = (ti - pre[ei]) * 128; ce = cnt[e];
    };
    GemmPipe g;
    auto prep = [&](int buf) {
        int* srow = srowb + buf * 128;
        if (tid < 128) srow[tid] = list[(size_t)e * NTOK + min(r0 + tid, ce - 1)];
        __syncthreads();
        if (STAGE == 0) g.setup([&](int r) { return F + (size_t)(srow[r] >> 1) * D; }, (const bf16_t*)(a.ws + W_GU) + ((size_t)(li * 64 + e) * 512 + nt * 128) * 1024, 1024);
        else g.setup([&](int r) { return HM + (size_t)srow[r] * 256; }, (const bf16_t*)(a.ws + W_DN) + ((size_t)(li * 64 + e) * 1024 + nt * 128) * 256, 256);
        g.issue(0, 0);
    };
    int u = rank;
    if (u < total) { decode(u); prep(cur); }
    while (u < total) {
        f32x4 acc[4][4];
        g.run(KK, acc);
        const int cr0 = r0, cce = ce, cnt_ = nt;
        const int* srow = srowb + cur * 128;
        u += nrank;
        if (u < total) { decode(u); prep(cur ^ 1); }
        if (STAGE == 0) {
            __syncthreads();
            {
                const int tz = opaque_tid();
#pragma unroll
                for (int i = 0; i < 4; ++i) {
                    const int m = lane_m(tz, i);
#pragma unroll
                    for (int p = 0; p < 2; ++p) {
                        const int c = (((tz >> 6) & 1) * 2 + p) * 16 + ((tz >> 4) & 3) * 4;
                        f32x4 v;
#pragma unroll
                        for (int x = 0; x < 4; ++x) { const float gg = acc[i][2 * p][x]; v[x] = gg * rcpf_(1.f + fexp(-gg)) * acc[i][2 * p + 1][x]; }
                        u32x2 o; o[0] = pk2(v[0], v[1]); o[1] = pk2(v[2], v[3]);
                        *(u32x2*)(lds + EPI_OFF + m * 128 + (((c >> 3) ^ (m & 7)) << 4) + (c & 4) * 2) = o;
                    }
                }
            }
            __syncthreads();
            {
                const int tz = opaque_tid();
#pragma unroll
                for (int it = 0; it < 4; ++it) {
                    const int idx = tz + it * NTHR, row = idx >> 3, ch = idx & 7;
                    const u32x4 v = *(const u32x4*)(lds + EPI_OFF + row * 128 + ((ch ^ (row & 7)) << 4));
                    if (cr0 + row < cce) *(u32x4*)(HM + (size_t)srow[row] * 256 + cnt_ * 64 + ch * 8) = v;
                }
            }
        } else {
            float wrow[4];
            {
                const int tz = opaque_tid();
#pragma unroll
                for (int i = 0; i < 4; ++i) wrow[i] = wsl[srow[lane_m(tz, i)]];
            }
            __syncthreads();
            epi_stage_bf16(acc, [&](int i, int, const f32x4 v) { return v * wrow[i]; });
            __syncthreads();
            epi_flush_bf16([&](int row) { return Y + (size_t)srow[row] * D + cnt_ * 128; }, [&](int row) { return cr0 + row < cce; });
        }
        cur ^= 1;
    }
    __syncthreads();
}

#ifndef DBG_GPROBE
#define DBG_GPROBE -1
#endif
template <int PM>
DI void phase_gemm_probe(const Args& a) {
    const bf16_t* A = (const bf16_t*)(a.ws + WS_H); const bf16_t* Bt = (const bf16_t*)(a.ws + W_RGIN);
    float* dummy = (float*)(a.ws + RG_A2);
    const int mt = 144, nt = 16, K = 1024;
    GemmPipe g;
    __syncthreads();
    for (int u = blockIdx.x; u < mt * nt; u += gridDim.x) {
        const int m0 = (u % mt) * 128, n0 = (u / mt) * 128;
        g.setup([&](int r) { return A + (size_t)(m0 + r) * 1024; }, Bt + (size_t)n0 * K, K);
        if (PM & 1) g.issue(0, 0);
        f32x4 acc[4][4];
        g.run_probe<PM>(K, acc);
        float s = 0.f;
#pragma unroll
        for (int i = 0; i < 4; ++i)
#pragma unroll
            for (int j = 0; j < 4; ++j) s += acc[i][j][0] + acc[i][j][1] + acc[i][j][2] + acc[i][j][3];
        if (s == 12345.678f) dummy[threadIdx.x] = s;
        if (PM & 8) {
            bf16_t* Yd = (bf16_t*)(a.ws + WS_Y);
            const int lane = threadIdx.x & 63, wave = threadIdx.x >> 6;
            const int mb = m0 + (wave >> 1) * 64 + (lane & 15), nb = n0 + (wave & 1) * 64 + (lane >> 4) * 4;
#pragma unroll
            for (int i = 0; i < 4; ++i)
#pragma unroll
                for (int j = 0; j < 4; ++j) {
                    f32x4 v = acc[i][j];
                    if (PM & 16) { v[0] = gelu_tanh(v[0]); v[1] = gelu_tanh(v[1]); v[2] = gelu_tanh(v[2]); v[3] = gelu_tanh(v[3]); }
                    st_bf4(Yd + (size_t)(mb + i * 16) * 2048 + nb + j * 16, v);
                }
        }
        __syncthreads();
    }
}

#ifndef DBG_STOP
#define DBG_STOP 99
#endif
#ifndef DBG_OFF
#define DBG_OFF 0
#endif
DI void phase_dbg(const Args& a) {
    const size_t n = (size_t)NLAT * D;
    const float* X = (const float*)(a.ws + WS_X);
    const bf16_t* B = (const bf16_t*)(a.ws + (size_t)DBG_OFF);
    for (size_t i = (size_t)blockIdx.x * NTHR + threadIdx.x; i < n; i += (size_t)gridDim.x * NTHR)
        a.out[i] = DBG_OFF ? bf2f(B[i]) : X[i];
}

constexpr int NPH = 34;
__global__ void __launch_bounds__(NTHR, 2) fwd(const Args a) {
    if (threadIdx.x == 0) *(uint4*)(lds + LDS_BARW) = make_uint4(0u, 0u, 0u, 0u);
    __syncthreads();
    XcdBarrier bar;
    const bool multi = (a.ph_hi - a.ph_lo) > 1;
    if (multi) bar = xcd_barrier_post((unsigned*)(a.ws + WS_CTL), (volatile LAS unsigned*)(lds + LDS_BARW));
#ifndef DBG_REP
#define DBG_REP -1
#endif
#ifndef DBG_REPN
#define DBG_REPN 3
#endif
#define RUN(id, ...) do { if (a.ph_lo <= (id) && (id) < a.ph_hi) { \
        if ((id) == DBG_REP) { for (int rep_ = 1; rep_ < DBG_REPN; ++rep_) { __VA_ARGS__; xcd_barrier(bar); } } \
        __VA_ARGS__; if ((id) + 1 < a.ph_hi) xcd_barrier(bar); } } while (0)
    RUN(0, phase_prologue(a));
    RUN(1, phase_token_row<0>(a, 0));
    RUN(2, phase_rg_in(a, 0));
    if (DBG_GPROBE >= 0) { RUN(2, phase_gemm_probe<(DBG_GPROBE < 0 ? 7 : DBG_GPROBE)>(a)); }
#ifdef DBG_SCANVAR
    RUN(3, phase_rg_scan<DBG_SCANVAR>(a, 0));
#endif
    RUN(3, phase_rg_scan(a, 0));
    RUN(4, phase_rg_combine(a));
    RUN(5, phase_rg_out(a, 0, 0));
    RUN(6, phase_token_router(a, 0));
    RUN(7, phase_moe<0>(a, 0));
    RUN(8, phase_moe<1>(a, 0));
    RUN(9, phase_token_row<0>(a, 1));
    RUN(10, phase_mla_down(a));
    RUN(11, phase_mla_up(a));
    RUN(12, phase_mla_attn(a));
    RUN(13, phase_mla_out(a, 1));
    RUN(14, phase_token_router(a, 1));
    RUN(15, phase_moe<0>(a, 1));
    RUN(16, phase_moe<1>(a, 1));
    RUN(17, phase_token_row<0>(a, 2));
    RUN(18, phase_ml_in(a));
#ifdef DBG_MLVAR
    RUN(19, phase_ml_scan<DBG_MLVAR>(a));
#endif
    RUN(19, phase_ml_scan(a));
    RUN(20, phase_ml_readout(a));
    RUN(21, phase_ml_out(a, 2));
    RUN(22, phase_token_router(a, 2));
    RUN(23, phase_moe<0>(a, 2));
    RUN(24, phase_moe<1>(a, 2));
    RUN(25, phase_token_row<0>(a, 3));
    RUN(26, phase_rg_in(a, 1));
    RUN(27, phase_rg_scan(a, 1));
    RUN(28, phase_rg_combine(a));
    RUN(29, phase_rg_out(a, 3, 1));
    RUN(30, phase_token_router(a, 3));
    RUN(31, phase_moe<0>(a, 3));
    RUN(32, phase_moe<1>(a, 3));
    RUN(33, phase_token_row<2>(a, 3));
    RUN(34, phase_dbg(a));
#undef RUN
}

static void add_td(Args& a, int& n, int& tile0, const float* src, bf16_t* dst, const float* rscale, long sb, long db, int K, int N, int Npad, int batch, int perm) {
    TDesc& t = a.td[n++];
    t.src = src; t.dst = dst; t.rscale = rscale; t.sb = sb; t.db = db; t.K = K; t.N = N; t.Npad = Npad; t.batch = batch; t.perm = perm;
    t.tiles_k = (K + 127) / 128; t.tiles_n = (Npad + 63) / 64; t.tile0 = tile0;
    tile0 += batch * t.tiles_k * t.tiles_n;
}

extern "C" void kernel_launch(void* const* d_in, const int* in_sizes, int n_in, void* d_out, int out_size, void* d_ws, size_t ws_size, hipStream_t stream) {
    static int grid = 0;
    if (grid == 0) {
        if (n_in != 32 || out_size != NLAT * D || ws_size < WS_END) { fprintf(stderr, "kernel_launch: unexpected sizes (n_in %d out %d ws %zu need %zu)\n", n_in, out_size, ws_size, (size_t)WS_END); grid = -1; return; }
        int dev = 0, cus = 0, per_cu = 0;
        (void)hipGetDevice(&dev);
        (void)hipDeviceGetAttribute(&cus, hipDeviceAttributeMultiprocessorCount, dev);
        if (hipOccupancyMaxActiveBlocksPerMultiprocessor(&per_cu, (const void*)fwd, NTHR, 0) != hipSuccess) per_cu = 0;
        (void)hipGetLastError();
        if (per_cu < 2) fprintf(stderr, "kernel_launch: note: occupancy query reports %d blocks per CU (need 2)\n", per_cu);
        grid = cus * (per_cu >= 2 ? 2 : (per_cu >= 1 ? 1 : 2));
    }
    if (grid < 0) return;
    (void)in_sizes;
    (void)hipMemsetAsync((char*)d_ws + WS_CTL, 0, CTL_BYTES, stream);
    Args a;
    memset(&a, 0, sizeof(a));
    for (int i = 0; i < 32; ++i) a.in[i] = (const float*)d_in[i];
    a.out = (float*)d_out; a.ws = (unsigned char*)d_ws;
    unsigned char* ws = (unsigned char*)d_ws;
    int n = 0, tile0 = 0;
    add_td(a, n, tile0, a.in[8], (bf16_t*)(ws + W_RGIN), nullptr, 1024L * 2048, 2048L * 1024, 1024, 2048, 2048, 2, 0);
    add_td(a, n, tile0, a.in[14], (bf16_t*)(ws + W_RGOUT), nullptr, 1024L * 1024, 1024L * 1024, 1024, 1024, 1024, 2, 0);
    for (int j = 0; j < 2; ++j) for (int dir = 0; dir < 2; ++dir) for (int g = 0; g < 2; ++g)
        add_td(a, n, tile0, a.in[11] + (size_t)((j * 2 + dir) * 2 + g) * 16 * 4096, (bf16_t*)(ws + W_RGG) + (size_t)(j * 2 + dir) * 16 * 8192 + g * 4096, nullptr, 4096, 8192, 64, 64, 64, 16, 0);
    add_td(a, n, tile0, a.in[15], (bf16_t*)(ws + W_MDOWN), nullptr, 0, 0, 1024, 416, 512, 1, 0);
    add_td(a, n, tile0, a.in[18], (bf16_t*)(ws + W_MUQ), a.in[16], 0, 0, 256, 1536, 1536, 1, 0);
    add_td(a, n, tile0, a.in[19], (bf16_t*)(ws + W_MUKV), a.in[17], 0, 0, 128, 2048, 2048, 1, 0);
    add_td(a, n, tile0, a.in[21], (bf16_t*)(ws + W_MO), nullptr, 0, 0, 1024, 1024, 1024, 1, 0);
    add_td(a, n, tile0, a.in[22], (bf16_t*)(ws + W_MLIN), nullptr, 0, 0, 1024, 3088, 3200, 1, 0);
    add_td(a, n, tile0, a.in[25], (bf16_t*)(ws + W_MLOUT), nullptr, 0, 0, 1024, 1024, 1024, 1, 0);
    add_td(a, n, tile0, a.in[30], (bf16_t*)(ws + W_GU), nullptr, 1024L * 512, 512L * 1024, 1024, 512, 512, 64, 1);
    add_td(a, n, tile0, a.in[31], (bf16_t*)(ws + W_DN), nullptr, 256L * 1024, 1024L * 256, 256, 1024, 1024, 64, 0);
    a.ntiles_total = tile0;
    if (n != NTD) { fprintf(stderr, "kernel_launch: descriptor count %d != %d\n", n, NTD); return; }
#if MK_ONE_LAUNCH
    a.ph_lo = 0; a.ph_hi = NPH;
    hipLaunchKernelGGL(fwd, dim3(grid), dim3(NTHR), 0, stream, a);
#else
    for (int ph = 0; ph < NPH && ph <= DBG_STOP; ++ph) {
        a.ph_lo = ph; a.ph_hi = ph + 1;
        hipLaunchKernelGGL(fwd, dim3(grid), dim3(NTHR), 0, stream, a);
    }
    if (DBG_STOP < NPH) { a.ph_lo = 34; a.ph_hi = 35; hipLaunchKernelGGL(fwd, dim3(grid), dim3(NTHR), 0, stream, a); }
#endif
}
```

```cpp
#include <hip/hip_runtime.h>
#include <stdint.h>
#include <string.h>
#include <stdio.h>

#ifndef MK_ONE_LAUNCH
#define MK_ONE_LAUNCH 1
#endif

#define DI __device__ __forceinline__
typedef unsigned short bf16_t;
typedef __attribute__((ext_vector_type(8))) short bf16x8;
typedef __attribute__((ext_vector_type(4))) float f32x4;
typedef __attribute__((ext_vector_type(16))) float f32x16;
typedef __attribute__((ext_vector_type(2))) float f32x2;
typedef __attribute__((ext_vector_type(2))) __bf16 bfx2;
typedef __attribute__((ext_vector_type(4))) unsigned u32x4;
typedef __attribute__((ext_vector_type(2))) unsigned u32x2;

constexpr int D = 1024, NB = 8, SEQ = 2048, CTXL = 256;
constexpr int NLAT = NB * SEQ, NCTX = NB * CTXL, NTOK = NLAT + NCTX;
constexpr int NKEY = CTXL + SEQ;
constexpr int NTHR = 256;
constexpr int LDS_BYTES = 74752;
constexpr int LDS_AUX = 65536;
constexpr int LDS_BARW = LDS_BYTES - 16;
constexpr float EPS = 1e-6f;

constexpr size_t al256(size_t x) { return (x + 255) & ~(size_t)255; }
constexpr size_t WS_CTL = 0;
constexpr size_t CTL_BYTES = 65536;
constexpr size_t CTL_CNT = 16384;
constexpr size_t CTL_ROPE = 32768;
constexpr size_t WS_MOD = WS_CTL + CTL_BYTES;
constexpr size_t WS_X = al256(WS_MOD + 4 * 9 * 6144 * 4);
constexpr size_t WS_H = al256(WS_X + (size_t)NTOK * D * 4);
constexpr size_t WS_SCR = al256(WS_H + (size_t)NTOK * D * 2);
constexpr size_t SCR_BYTES = (size_t)256 << 20;
constexpr size_t TOKD2 = (size_t)NTOK * D * 2;
constexpr size_t RG_G = WS_SCR, RG_U = RG_G + TOKD2, RG_HS = RG_U + TOKD2, RG_A2 = RG_HS + 2 * TOKD2;
constexpr size_t MLA_CQ = WS_SCR;
constexpr size_t MLA_CKV = MLA_CQ + (size_t)NTOK * 256 * 2;
constexpr size_t MLA_KR = MLA_CKV + (size_t)NTOK * 128 * 2;
constexpr size_t MLA_Q = MLA_KR + (size_t)NTOK * 32 * 4;
constexpr size_t MLA_K = MLA_Q + (size_t)NTOK * 1536 * 2;
constexpr size_t MLA_VT = MLA_K + (size_t)NB * 16 * NKEY * 96 * 2;
constexpr size_t MLA_O = MLA_VT + (size_t)NB * 16 * 64 * NKEY * 2;
constexpr size_t MLA_END = MLA_O + TOKD2;
constexpr size_t ML_Q = WS_SCR;
constexpr size_t ML_K = ML_Q + (size_t)NTOK * 512 * 2;
constexpr size_t ML_KT = ML_K + (size_t)NTOK * 512 * 2;
constexpr size_t ML_VT = ML_KT + (size_t)NTOK * 512 * 2;
constexpr size_t ML_OG = ML_VT + TOKD2;
constexpr size_t ML_GT = ML_OG + TOKD2;
constexpr size_t ML_HS = ML_GT + (size_t)NTOK * 16 * 4;
constexpr size_t ML_A2 = ML_HS + 2 * TOKD2;
constexpr size_t ML_END = ML_A2 + TOKD2;
static_assert(RG_A2 + TOKD2 <= WS_SCR + SCR_BYTES && MLA_END <= WS_SCR + SCR_BYTES && ML_END <= WS_SCR + SCR_BYTES, "scratch");
constexpr size_t WS_LIST = WS_SCR + SCR_BYTES;
constexpr size_t WS_WSLOT = al256(WS_LIST + (size_t)64 * NTOK * 4);
constexpr size_t WS_HMID = al256(WS_WSLOT + (size_t)2 * NTOK * 4);
constexpr size_t WS_Y = al256(WS_HMID + (size_t)2 * NTOK * 256 * 2);
constexpr size_t WS_W = al256(WS_Y + (size_t)2 * NTOK * D * 2);
constexpr size_t W_RGIN = WS_W;
constexpr size_t W_RGOUT = W_RGIN + (size_t)2 * 2048 * 1024 * 2;
constexpr size_t W_RGG = W_RGOUT + (size_t)2 * 1024 * 1024 * 2;
constexpr size_t W_MDOWN = W_RGG + (size_t)2 * 2 * 16 * 128 * 64 * 2;
constexpr size_t W_MUQ = W_MDOWN + (size_t)512 * 1024 * 2;
constexpr size_t W_MUKV = W_MUQ + (size_t)1536 * 256 * 2;
constexpr size_t W_MO = W_MUKV + (size_t)2048 * 128 * 2;
constexpr size_t W_MLIN = W_MO + (size_t)1024 * 1024 * 2;
constexpr size_t W_MLOUT = W_MLIN + (size_t)3200 * 1024 * 2;
constexpr size_t W_RT = W_MLOUT + (size_t)1024 * 1024 * 2;
constexpr size_t W_GU = al256(W_RT + (size_t)4 * 2 * 80 * 1024 * 2);
constexpr size_t W_DN = W_GU + (size_t)256 * 512 * 1024 * 2;
constexpr size_t WS_GS = W_DN + (size_t)256 * 1024 * 256 * 2;
constexpr size_t WS_END = WS_GS + (size_t)512 * 36 * 3 * 64 * 4;

struct TDesc {
    const float* src; bf16_t* dst; const float* rscale;
    long sb, db;
    int K, N, Npad, batch;
    int perm, tiles_k, tiles_n, tile0;
};
constexpr int NTD = 18;
struct Args {
    const float* in[32];
    float* out;
    unsigned char* ws;
    TDesc td[NTD];
    int ntiles_total, ph_lo, ph_hi, pad0;
};

DI float bf2f(bf16_t v) { return __uint_as_float((unsigned)v << 16); }
DI unsigned pk2(float a, float b) { f32x2 v = {a, b}; bfx2 r = __builtin_convertvector(v, bfx2); return __builtin_bit_cast(unsigned, r); }
DI bf16_t f2bf(float a) { return (bf16_t)(pk2(a, 0.f) & 0xffffu); }
DI float lof(unsigned u) { return __uint_as_float(u << 16); }
DI float hif(unsigned u) { return __uint_as_float(u & 0xffff0000u); }
DI float rcpf_(float x) { return __builtin_amdgcn_rcpf(x); }
DI float fexp(float x) { return __builtin_amdgcn_exp2f(x * 1.4426950408889634f); }
DI float sigmoidf_(float x) { return rcpf_(1.f + fexp(-x)); }
DI float gelu_tanh(float x) { float u = 0.7978845608028654f * (x + 0.044715f * x * x * x); float e = fexp(2.f * u); return x * (1.f - rcpf_(e + 1.f)); }
DI int tok_modrow(int t) { return t < NLAT ? (t >> 11) : 8; }
DI void dma16(const void* g, char* l) { __builtin_amdgcn_global_load_lds((const unsigned*)g, (unsigned*)l, 16, 0, 0); }
DI void wait_vm0() { asm volatile("s_waitcnt vmcnt(0)" ::: "memory"); }
DI void lds_barrier() { asm volatile("s_waitcnt lgkmcnt(0)" ::: "memory"); __builtin_amdgcn_s_barrier(); asm volatile("" ::: "memory"); }
DI int swz128(int row, int chunk) { return row * 128 + ((chunk ^ (row & 7)) << 4); }
DI int swz256(int row, int chunk) { return row * 256 + ((chunk ^ (row & 15)) << 4); }
DI f32x4 mfma16(bf16x8 a, bf16x8 b, f32x4 c) { return __builtin_amdgcn_mfma_f32_16x16x32_bf16(a, b, c, 0, 0, 0); }
DI f32x16 mfma32(bf16x8 a, bf16x8 b, f32x16 c) { return __builtin_amdgcn_mfma_f32_32x32x16_bf16(a, b, c, 0, 0, 0); }
DI bf16x8 ldsv8(const char* p) { return *(const bf16x8*)p; }
typedef __attribute__((ext_vector_type(8))) _Float16 f16x8;
typedef __attribute__((ext_vector_type(2))) _Float16 f16x2;
DI unsigned pkh(float a, float b) { f32x2 v = {a, b}; f16x2 r = __builtin_convertvector(v, f16x2); return __builtin_bit_cast(unsigned, r); }
DI float hlof(unsigned u) { return (float)__builtin_bit_cast(f16x2, u)[0]; }
DI float hhif(unsigned u) { return (float)__builtin_bit_cast(f16x2, u)[1]; }
DI f32x4 mfma16h(f16x8 a, f16x8 b, f32x4 c) { return __builtin_amdgcn_mfma_f32_16x16x32_f16(a, b, c, 0, 0, 0); }
DI void st_bf4(bf16_t* p, const f32x4 v) { u32x2 o; o[0] = pk2(v[0], v[1]); o[1] = pk2(v[2], v[3]); *(u32x2*)p = o; }

__shared__ __attribute__((aligned(16))) char lds[LDS_BYTES];

#define XB_TMO      128
#define XB_XCNT(j)  (256  + 64 * (j))
#define XB_XSUB(j)  (1280 + 64 * (j))
#define XB_XGEN(j)  (2304 + 64 * (j))
#define XB_TOP      3328
#define XB_TOPGEN   3392
#define XCD_BAR_WORDS 3456
#define XB_SPIN_CAP (1u << 22)
#define LAS __attribute__((address_space(3)))
DI unsigned xb_ld(unsigned* p)              { return __hip_atomic_load(p, __ATOMIC_RELAXED, __HIP_MEMORY_SCOPE_AGENT); }
DI unsigned xb_add(unsigned* p, unsigned v) { return __hip_atomic_fetch_add(p, v, __ATOMIC_RELAXED, __HIP_MEMORY_SCOPE_AGENT); }
DI unsigned xb_xcc_id() { return (unsigned)__builtin_amdgcn_s_getreg((3 << 11) | 20) & 0xFu; }
#define XB_SPIN(cond, bar) do { unsigned _sp = 0; while (cond) { __builtin_amdgcn_s_sleep(1); \
    if ((++_sp & 255u) == 0u) { if (xb_ld(&(bar)[XB_TMO])) break; if (_sp > XB_SPIN_CAP) { atomicAdd(&(bar)[XB_TMO], 1u); break; } } } } while (0)
struct XcdBarrier { unsigned* bar; unsigned x; volatile LAS unsigned* st; };
DI XcdBarrier xcd_barrier_post(unsigned* bar, volatile LAS unsigned* st) {
    XcdBarrier b; b.bar = bar; b.x = xb_xcc_id(); b.st = st;
    if (threadIdx.x == 0) (void)xb_add(&bar[XB_XCNT(b.x)], 1u);
    return b;
}
DI void xcd_barrier_complete(unsigned* bar, unsigned x, unsigned& nloc, unsigned& nx) {
    const unsigned G = gridDim.x * gridDim.y * gridDim.z;
    unsigned sum, cnt, mine, sp = 0u;
    for (;;) {
        sum = 0u; cnt = 0u; mine = 0u;
#pragma unroll
        for (unsigned j = 0; j < 16; ++j) { const unsigned c = xb_ld(&bar[XB_XCNT(j)]); sum += c; cnt += (c > 0u) ? 1u : 0u; mine = (j == x) ? c : mine; }
        if (sum == G) break;
        __builtin_amdgcn_s_sleep(1);
        if ((++sp & 255u) == 0u) { if (xb_ld(&bar[XB_TMO])) break; if (sp > XB_SPIN_CAP) { atomicAdd(&bar[XB_TMO], 1u); break; } }
    }
    nloc = mine > 0u ? mine : 1u; nx = cnt > 0u ? cnt : 1u;
}
DI void xcd_barrier(const XcdBarrier& b) {
    asm volatile("s_waitcnt vmcnt(0)" ::: "memory");
    __syncthreads();
    if (threadIdx.x == 0) {
        unsigned* bar = b.bar;
        __builtin_amdgcn_s_waitcnt(0);
        unsigned nloc = b.st[0], nx = b.st[1];
        if (nloc == 0u) { xcd_barrier_complete(bar, b.x, nloc, nx); b.st[0] = nloc; b.st[1] = nx; }
        const unsigned old = xb_add(&bar[XB_XSUB(b.x)], 1u);
        const unsigned gen = old / nloc;
        if (old + 1u == (gen + 1u) * nloc) {
            __builtin_amdgcn_fence(__ATOMIC_RELEASE, "agent");
            asm volatile("s_waitcnt vmcnt(0)" ::: "memory");
            const unsigned og = xb_add(&bar[XB_TOP], 1u);
            const unsigned tg = og / nx;
            if (og + 1u == (tg + 1u) * nx) xb_add(&bar[XB_TOPGEN], 1u);
            else XB_SPIN(xb_ld(&bar[XB_TOPGEN]) == tg, bar);
            __builtin_amdgcn_fence(__ATOMIC_ACQUIRE, "agent");
            xb_add(&bar[XB_XGEN(b.x)], 1u);
            asm volatile("s_waitcnt vmcnt(0)" ::: "memory");
        } else {
            XB_SPIN(xb_ld(&bar[XB_XGEN(b.x)]) == gen, bar);
            __builtin_amdgcn_fence(__ATOMIC_ACQUIRE, "agent");
            asm volatile("s_waitcnt vmcnt(0)" ::: "memory");
        }
    }
    __syncthreads();
}

typedef __attribute__((ext_vector_type(4))) short s16x4;
typedef __attribute__((address_space(3))) s16x4 lds_s16x4;
DI s16x4 lds_tr(const char* p) { return __builtin_amdgcn_ds_read_tr16_b64_v4i16((lds_s16x4*)p); }
DI int trswz(int row) { return ((row & 3) << 2) | ((row >> 2) & 3); }
struct CvTile { const float* src; bf16_t* dst; int K, N, perm, k0, n0; };
DI CvTile moe_cv_tile(const Args& a, const int L, const int t) {
    CvTile c;
    const int e = t / 96, r = t - e * 96;
    if (r < 64) {
        c.src = a.in[30] + (size_t)(L * 64 + e) * 1024 * 512; c.dst = (bf16_t*)(a.ws + W_GU) + (size_t)(L * 64 + e) * 512 * 1024;
        c.K = 1024; c.N = 512; c.perm = 1; c.k0 = (r & 7) * 128; c.n0 = (r >> 3) * 64;
    } else {
        const int r2 = r - 64;
        c.src = a.in[31] + (size_t)(L * 64 + e) * 256 * 1024; c.dst = (bf16_t*)(a.ws + W_DN) + (size_t)(L * 64 + e) * 1024 * 256;
        c.K = 256; c.N = 1024; c.perm = 0; c.k0 = (r2 & 1) * 128; c.n0 = (r2 >> 1) * 64;
    }
    return c;
}
DI void cv_load(const CvTile& c, f32x4 (&L0)[4], f32x4 (&L1)[4]) {
    const int tid = threadIdx.x, c4 = tid & 15, kr = tid >> 4;
    const float* p = c.src + (size_t)(c.k0 + 2 * kr) * c.N + c.n0 + 4 * c4;
#pragma unroll
    for (int i = 0; i < 4; ++i) { L0[i] = *(const f32x4*)(p + (size_t)(32 * i) * c.N); L1[i] = *(const f32x4*)(p + (size_t)(32 * i + 1) * c.N); }
}
DI void cv_pack(unsigned* st, const f32x4 (&L0)[4], const f32x4 (&L1)[4]) {
    const int tid = threadIdx.x, c4 = tid & 15, kr = tid >> 4;
#pragma unroll
    for (int i = 0; i < 4; ++i)
#pragma unroll
        for (int j = 0; j < 4; ++j) st[(4 * c4 + j) * 68 + 16 * i + kr] = pk2(L0[i][j], L1[i][j]);
}
DI void cv_flush(const CvTile& c, const unsigned* st) {
    const int tid = threadIdx.x;
#pragma unroll
    for (int i = 0; i < 4; ++i) {
        const int id = tid + i * 256, n = id >> 4, kc = id & 15;
        const u32x4 o = *(const u32x4*)(st + n * 68 + kc * 4);
        int nd = c.n0 + n;
        if (c.perm) { const int cc = nd & 255, up = nd >> 8; nd = ((cc >> 4) << 5) + (up << 4) + (cc & 15); }
        *(u32x4*)(c.dst + (size_t)nd * c.K + c.k0 + kc * 8) = o;
    }
}

DI void phase_prologue(const Args& a) {
    const int tid = threadIdx.x;
    const int n_ada = 384, n_rt = 320;
    const int total = n_ada + n_rt;
    float* sc = (float*)lds;
    for (int u = blockIdx.x; u < total; u += gridDim.x) {
        __syncthreads();
        if (u < n_ada) {
            const float* c = a.in[1]; const float* cc = a.in[3];
            for (int i = tid; i < 9 * 1024; i += NTHR) {
                float v = i < 8192 ? c[i] : cc[i - 8192];
                sc[i] = v / (1.f + __expf(-v));
            }
            __syncthreads();
            const int n = u * 64 + (tid & 63), li = n / 6144, nn = n - li * 6144, kq = tid >> 6;
            const float* wp = a.in[4] + (size_t)li * 1024 * 6144 + (size_t)(kq * 256) * 6144 + nn;
            float acc[9];
#pragma unroll
            for (int r = 0; r < 9; ++r) acc[r] = 0.f;
#pragma unroll 1
            for (int k0 = kq * 256; k0 < kq * 256 + 256; k0 += 16) {
                float wv[16];
#pragma unroll
                for (int kk = 0; kk < 16; ++kk) { wv[kk] = *wp; wp += 6144; }
#pragma unroll
                for (int kk = 0; kk < 16; kk += 4)
#pragma unroll
                    for (int r = 0; r < 9; ++r) {
                        const f32x4 s4 = *(const f32x4*)(sc + r * 1024 + k0 + kk);
                        acc[r] += s4[0] * wv[kk] + s4[1] * wv[kk + 1] + s4[2] * wv[kk + 2] + s4[3] * wv[kk + 3];
                    }
            }
            float* part = sc + 9 * 1024;
#pragma unroll
            for (int r = 0; r < 9; ++r) part[(kq * 9 + r) * 64 + (tid & 63)] = acc[r];
            __syncthreads();
            for (int i = tid; i < 9 * 64; i += NTHR) {
                const int r = i >> 6, cidx = i & 63;
                const int n2 = u * 64 + cidx, l2 = n2 / 6144, nn2 = n2 - l2 * 6144;
                const float v = ((part[(0 * 9 + r) * 64 + cidx] + part[(1 * 9 + r) * 64 + cidx]) + part[(2 * 9 + r) * 64 + cidx]) + part[(3 * 9 + r) * 64 + cidx];
                float o = v + a.in[5][l2 * 6144 + nn2];
                const int ch = nn2 >> 10;
                if (ch == 1) o = a.in[6][l2 * 1024 + (nn2 & 1023)] * (1.f + o);
                else if (ch == 4) o = a.in[7][l2 * 1024 + (nn2 & 1023)] * (1.f + o);
                ((float*)(a.ws + WS_MOD))[((size_t)l2 * 9 + r) * 6144 + nn2] = o;
            }
        } else if (u < n_ada + n_rt) {
            const int r_ = u - n_ada, li = r_ / 80, n = r_ - li * 80;
            if (r_ == 0) {
                float* rt_ = (float*)(a.ws + WS_CTL + CTL_ROPE);
                for (int i = tid; i < 512; i += NTHR) {
                    const int pos = i >> 3, fi = i & 7;
                    const float ang = (float)pos * powf(10000.f, -(float)fi * 0.125f);
                    rt_[i] = cosf(ang); rt_[512 + i] = sinf(ang);
                }
            }
            bf16_t* rt = (bf16_t*)(a.ws + W_RT) + (size_t)li * 80 * 1024;
            const float* wg = a.in[26] + (size_t)li * 1024 * 8;
            const float* we = a.in[28] + (size_t)li * 1024 * 64;
            float v[4];
#pragma unroll
            for (int j = 0; j < 4; ++j) { const int k = tid * 4 + j; v[j] = n < 8 ? wg[k * 8 + n] : (n < 72 ? we[k * 64 + (n - 8)] : 0.f); }
            u32x2 hw;
            hw[0] = pkh(v[0], v[1]); hw[1] = pkh(v[2], v[3]);
            *(u32x2*)(rt + n * 1024 + tid * 4) = hw;
        }
    }
    struct PTile { const float* src; bf16_t* dst; const float* rscale; int K, N, Npad, perm, k0, n0; };
    auto decode = [&](int tix) {
        int di = 0;
#pragma unroll 1
        for (int i = 1; i < NTD; ++i) if (tix >= a.td[i].tile0) di = i;
        const TDesc& td = a.td[di];
        int rem = tix - td.tile0;
        const int per = td.tiles_k * td.tiles_n;
        const int bi = rem / per; rem -= bi * per;
        PTile p;
        p.src = td.src + (size_t)bi * td.sb; p.dst = td.dst + (size_t)bi * td.db; p.rscale = td.rscale;
        p.K = td.K; p.N = td.N; p.Npad = td.Npad; p.perm = td.perm;
        p.n0 = (rem % td.tiles_n) * 64; p.k0 = (rem / td.tiles_n) * 128;
        return p;
    };
    auto pload = [&](const PTile& p, f32x4 (&L0)[4], f32x4 (&L1)[4]) {
        const int c4 = tid & 15, kr = tid >> 4;
        const bool nok = p.n0 + 4 * c4 < p.N;
#pragma unroll
        for (int i = 0; i < 4; ++i) {
            const int k = p.k0 + 32 * i + 2 * kr;
            L0[i] = (f32x4){0.f, 0.f, 0.f, 0.f}; L1[i] = L0[i];
            if (nok && k < p.K) {
                L0[i] = *(const f32x4*)(p.src + (size_t)k * p.N + p.n0 + 4 * c4);
                L1[i] = *(const f32x4*)(p.src + (size_t)(k + 1) * p.N + p.n0 + 4 * c4);
                if (p.rscale) { L0[i] *= p.rscale[k]; L1[i] *= p.rscale[k + 1]; }
            }
        }
    };
    auto pflush = [&](const PTile& p, const unsigned* st) {
#pragma unroll
        for (int i = 0; i < 4; ++i) {
            const int id = tid + i * 256, n = id >> 4, kc = id & 15;
            const u32x4 o = *(const u32x4*)(st + n * 68 + kc * 4);
            int nd = p.n0 + n;
            if (nd < p.Npad && p.k0 + kc * 8 < p.K) {
                if (p.perm) { const int c = nd & 255, up = nd >> 8; nd = ((c >> 4) << 5) + (up << 4) + (c & 15); }
                *(u32x4*)(p.dst + (size_t)nd * p.K + p.k0 + kc * 8) = o;
            }
        }
    };
    {
        unsigned* st0 = (unsigned*)lds; unsigned* st1 = st0 + 64 * 68;
        const int nt_ = a.ntiles_total, G = gridDim.x;
        int t0 = blockIdx.x, t1 = blockIdx.x + G;
        PTile p0 = decode(0), p1 = p0;
        f32x4 A0[4], A1[4], B0[4], B1[4];
        __syncthreads();
        if (t0 < nt_) { p0 = decode(t0); pload(p0, A0, A1); }
        if (t1 < nt_) { p1 = decode(t1); pload(p1, B0, B1); }
        while (t0 < nt_) {
            PTile q0 = p0, q1 = p1;
            const bool v1 = t1 < nt_;
            cv_pack(st0, A0, A1);
            if (t0 + 2 * G < nt_) { p0 = decode(t0 + 2 * G); pload(p0, A0, A1); }
            if (v1) {
                cv_pack(st1, B0, B1);
                if (t1 + 2 * G < nt_) { p1 = decode(t1 + 2 * G); pload(p1, B0, B1); }
            }
            __syncthreads();
            pflush(q0, st0);
            if (v1) pflush(q1, st1);
            __syncthreads();
            t0 += 2 * G; t1 += 2 * G;
        }
    }
}

DI float wave_sum(float v) {
    v += __shfl_xor(v, 1); v += __shfl_xor(v, 2); v += __shfl_xor(v, 4); v += __shfl_xor(v, 8); v += __shfl_xor(v, 16); v += __shfl_xor(v, 32);
    return v;
}
template <int MODE>
DI void phase_token_row(const Args& a, const int li) {
    const int tid = threadIdx.x, lane = tid & 63, wave = tid >> 6;
    float* X = (float*)(a.ws + WS_X);
    bf16_t* H = (bf16_t*)(a.ws + WS_H);
    const bf16_t* Y = (const bf16_t*)(a.ws + WS_Y);
    const float* MOD = (const float*)(a.ws + WS_MOD);
    const bool combine = MODE == 2 || li > 0;
    const bool first = MODE == 0 && li == 0;
    const int npairs = (MODE == 2 ? NLAT : NTOK) / 2;
    const int lprev = MODE == 2 ? 3 : (li > 0 ? li - 1 : 0);
    for (int p = blockIdx.x * 4 + wave; p < npairs; p += gridDim.x * 4) {
        const int t0 = 2 * p, mr = tok_modrow(t0);
        f32x4 x[2][4];
#pragma unroll
        for (int i = 0; i < 2; ++i) {
            const int t = t0 + i;
            const float* xs = first ? (t < NLAT ? a.in[0] + (size_t)t * D : a.in[2] + (size_t)(t - NLAT) * D) : X + (size_t)t * D;
#pragma unroll
            for (int j = 0; j < 4; ++j) x[i][j] = *(const f32x4*)(xs + 256 * j + 4 * lane);
        }
        if (combine) {
            const float* g5 = MOD + ((size_t)lprev * 9 + mr) * 6144 + 5 * 1024;
            f32x4 g[4];
#pragma unroll
            for (int j = 0; j < 4; ++j) g[j] = *(const f32x4*)(g5 + 256 * j + 4 * lane);
#pragma unroll
            for (int i = 0; i < 2; ++i) {
                const bf16_t* y0 = Y + (size_t)(2 * (t0 + i)) * D;
#pragma unroll
                for (int j = 0; j < 4; ++j) {
                    const u32x2 ya = *(const u32x2*)(y0 + 256 * j + 4 * lane), yb = *(const u32x2*)(y0 + D + 256 * j + 4 * lane);
                    x[i][j][0] += g[j][0] * (lof(ya[0]) + lof(yb[0])); x[i][j][1] += g[j][1] * (hif(ya[0]) + hif(yb[0]));
                    x[i][j][2] += g[j][2] * (lof(ya[1]) + lof(yb[1])); x[i][j][3] += g[j][3] * (hif(ya[1]) + hif(yb[1]));
                }
            }
        }
        if (MODE == 2) {
#pragma unroll
            for (int i = 0; i < 2; ++i)
#pragma unroll
                for (int j = 0; j < 4; ++j) *(f32x4*)(a.out + (size_t)(t0 + i) * D + 256 * j + 4 * lane) = x[i][j];
            continue;
        }
        float rstd[2];
#pragma unroll
        for (int i = 0; i < 2; ++i) {
            float ss = 0.f;
#pragma unroll
            for (int j = 0; j < 4; ++j) ss += x[i][j][0] * x[i][j][0] + x[i][j][1] * x[i][j][1] + x[i][j][2] * x[i][j][2] + x[i][j][3] * x[i][j][3];
            rstd[i] = rsqrtf(wave_sum(ss) * (1.f / 1024.f) + EPS);
        }
        const float* msc = MOD + ((size_t)li * 9 + mr) * 6144 + 1 * 1024;
        const float* msh = MOD + ((size_t)li * 9 + mr) * 6144;
#pragma unroll
        for (int j = 0; j < 4; ++j) {
            const f32x4 gs = *(const f32x4*)(msc + 256 * j + 4 * lane), h4 = *(const f32x4*)(msh + 256 * j + 4 * lane);
#pragma unroll
            for (int i = 0; i < 2; ++i) {
                const f32x4 f = x[i][j] * rstd[i] * gs + h4;
                st_bf4(H + (size_t)(t0 + i) * D + 256 * j + 4 * lane, f);
                if (combine) *(f32x4*)(X + (size_t)(t0 + i) * D + 256 * j + 4 * lane) = x[i][j];
            }
        }
    }
}

template <int UR>
DI void phase_token_router(const Args& a, const int li, const bool dry = false) {
    constexpr int RPW = UR / 4, RB = (RPW % 3 == 0) ? 3 : 4, NB = RPW / RB, MTN = (UR + 15) / 16;
    static_assert(UR % 4 == 0 && RPW % RB == 0 && UR * 2048 + 16 <= LDS_BYTES && 5 * UR * 80 * 4 <= UR * 2048, "router unit");
    const int tid = threadIdx.x, lane = tid & 63, wave = tid >> 6;
    const int r = lane & 15, q = lane >> 4;
    const float* X = (const float*)(a.ws + WS_X);
    bf16_t* H = (bf16_t*)(a.ws + WS_H);
    const float* MOD = (const float*)(a.ws + WS_MOD);
    const int nunits = (li == 3 ? NLAT : NTOK) / UR;
    char* sF = lds;
    float* sP = (float*)lds;
    float* sL = (float*)(lds + 4 * UR * 80 * 4);
    const bf16_t* rwh = (const bf16_t*)(a.ws + W_RT) + (size_t)li * 80 * 1024 + (size_t)r * 1024 + q * 8;
    for (int g = blockIdx.x; g < nunits; g += gridDim.x) {
        __syncthreads();
        {
            int cur_mr = -1;
            f32x4 gs[4], h4[4];
            f32x4 xq[2][RB][4];
            auto xload = [&](f32x4 (&x)[RB][4], const int b) {
#pragma unroll
                for (int i = 0; i < RB; ++i)
#pragma unroll
                    for (int j = 0; j < 4; ++j) x[i][j] = *(const f32x4*)(X + (size_t)(g * UR + wave * RPW + b * RB + i) * D + 256 * j + 4 * lane);
            };
            xload(xq[0], 0);
            if (NB > 1) xload(xq[1], 1);
#pragma unroll
            for (int b = 0; b < NB; ++b) {
                const int lr0 = wave * RPW + b * RB;
                f32x4 (&x)[RB][4] = xq[b & 1];
#pragma unroll
                for (int i = 0; i < RB; ++i) {
                    const int lr = lr0 + i, row = g * UR + lr;
                    const int mr = tok_modrow(row);
                    if (mr != cur_mr) {
                        cur_mr = mr;
                        const float* mb = MOD + ((size_t)li * 9 + mr) * 6144;
#pragma unroll
                        for (int j = 0; j < 4; ++j) { gs[j] = *(const f32x4*)(mb + 4 * 1024 + 256 * j + 4 * lane); h4[j] = *(const f32x4*)(mb + 3 * 1024 + 256 * j + 4 * lane); }
                    }
                    float ss = 0.f;
#pragma unroll
                    for (int j = 0; j < 4; ++j) ss += x[i][j][0] * x[i][j][0] + x[i][j][1] * x[i][j][1] + x[i][j][2] * x[i][j][2] + x[i][j][3] * x[i][j][3];
                    const float rstd = rsqrtf(wave_sum(ss) * (1.f / 1024.f) + EPS);
#pragma unroll
                    for (int j = 0; j < 4; ++j) {
                        const f32x4 f = x[i][j] * rstd * gs[j] + h4[j];
                        u32x2 hv; hv[0] = pk2(f[0], f[1]); hv[1] = pk2(f[2], f[3]);
                        *(u32x2*)(H + (size_t)row * D + 256 * j + 4 * lane) = hv;
                        u32x2 hh; hh[0] = pkh(f[0], f[1]); hh[1] = pkh(f[2], f[3]);
                        *(u32x2*)(sF + lr * 2048 + (((32 * j + (lane >> 1)) ^ lr) << 4) + (lane & 1) * 8) = hh;
                    }
                }
                if (b + 2 < NB) xload(xq[b & 1], b + 2);
            }
        }
        __syncthreads();
        f32x4 lacc[MTN][5];
#pragma unroll
        for (int mt = 0; mt < MTN; ++mt)
#pragma unroll
            for (int i = 0; i < 5; ++i) lacc[mt][i] = (f32x4){0.f, 0.f, 0.f, 0.f};
#pragma unroll 4
        for (int s = 0; s < 8; ++s) {
            const int kk = wave * 8 + s;
            f16x8 fh[MTN];
#pragma unroll
            for (int mt = 0; mt < MTN; ++mt) {
                const int lr = (mt * 16 + r) < UR ? mt * 16 + r : UR - 1;
                fh[mt] = __builtin_bit_cast(f16x8, ldsv8(sF + lr * 2048 + (((kk * 4 + q) ^ lr) << 4)));
            }
#pragma unroll
            for (int nt = 0; nt < 5; ++nt) {
                const f16x8 w = __builtin_bit_cast(f16x8, *(const bf16x8*)(rwh + (size_t)nt * 16 * 1024 + kk * 32));
#pragma unroll
                for (int mt = 0; mt < MTN; ++mt) lacc[mt][nt] = mfma16h(fh[mt], w, lacc[mt][nt]);
            }
        }
        __syncthreads();
#pragma unroll
        for (int mt = 0; mt < MTN; ++mt)
#pragma unroll
            for (int nt = 0; nt < 5; ++nt)
#pragma unroll
                for (int j = 0; j < 4; ++j) {
                    const int lr = mt * 16 + q * 4 + j;
                    if (lr < UR) sP[(wave * UR + lr) * 80 + nt * 16 + r] = lacc[mt][nt][j];
                }
        __syncthreads();
        for (int i = tid; i < UR * 80; i += NTHR) sL[i] = sP[i] + sP[UR * 80 + i] + sP[2 * UR * 80 + i] + sP[3 * UR * 80 + i];
        __syncthreads();
        if (tid < UR && !dry) {
            const float* L = sL + tid * 80;
            const float* bg = a.in[27] + li * 8;
            const float* be = a.in[29] + li * 64;
            float gmax = -3.0e38f; int gi = 0; float gl[8];
#pragma unroll
            for (int j = 0; j < 8; ++j) { gl[j] = L[j] + bg[j]; if (gl[j] > gmax) { gmax = gl[j]; gi = j; } }
            float ps = 0.f;
#pragma unroll
            for (int j = 0; j < 8; ++j) ps += __expf(gl[j] - gmax);
            const float ptop = 1.f / ps;
            float e1 = -3.0e38f, e2 = -3.0e38f; int i1 = 0, i2 = 0;
#pragma unroll
            for (int j = 0; j < 8; ++j) {
                const float v = L[8 + gi * 8 + j] + be[gi * 8 + j];
                if (v > e1) { e2 = e1; i2 = i1; e1 = v; i1 = j; } else if (v > e2) { e2 = v; i2 = j; }
            }
            const float ex = __expf(e2 - e1);
            const float w1 = ptop / (1.f + ex), w2 = ptop * ex / (1.f + ex);
            const int tt = g * UR + tid;
            int* cnt = (int*)(a.ws + WS_CTL + CTL_CNT) + li * 64;
            int* list = (int*)(a.ws + WS_LIST);
            float* wsl = (float*)(a.ws + WS_WSLOT);
            const int ea = gi * 8 + i1, eb = gi * 8 + i2;
            const int pa = atomicAdd(&cnt[ea], 1); list[(size_t)ea * NTOK + pa] = 2 * tt; wsl[2 * tt] = w1;
            const int pb = atomicAdd(&cnt[eb], 1); list[(size_t)eb * NTOK + pb] = 2 * tt + 1; wsl[2 * tt + 1] = w2;
        }
    }
}

template <int WM, int WN, int MT, int NT, bool PFALL = true, class AP>
DI void gemm_tile(AP arow, const bf16_t* Bt, const int ldb, const int K, f32x4 (&acc)[MT][NT], float* ssq = nullptr) {
    constexpr int BM = WM * MT * 16, BN = WN * NT * 16;
    constexpr int A_BYTES = BM * 128, B_BYTES = BN * 128, STAGE = A_BYTES + B_BYTES;
    constexpr int ACH = BM * 8 / NTHR, BCH = BN * 8 / NTHR;
    static_assert(2 * STAGE <= LDS_AUX, "gemm LDS");
    const int tid = threadIdx.x, lane = tid & 63, wave = tid >> 6;
    const int wm = wave / WN, wn = wave % WN;
    const int fr = lane & 15, fq = lane >> 4;
    const bf16_t* ap[ACH]; const bf16_t* bp[BCH];
#pragma unroll
    for (int i = 0; i < ACH; ++i) { const int idx = tid + i * NTHR, row = idx >> 3, c = (idx & 7) ^ (row & 7); ap[i] = arow(row) + c * 8; }
#pragma unroll
    for (int i = 0; i < BCH; ++i) { const int idx = tid + i * NTHR, row = idx >> 3, c = (idx & 7) ^ (row & 7); bp[i] = Bt + (size_t)row * ldb + c * 8; }
#pragma unroll
    for (int i = 0; i < MT; ++i)
#pragma unroll
        for (int j = 0; j < NT; ++j) acc[i][j] = (f32x4){0.f, 0.f, 0.f, 0.f};
    const int KT = K >> 6;
    {
        char* sa = lds; char* sb = lds + A_BYTES;
#pragma unroll
        for (int i = 0; i < ACH; ++i) dma16(ap[i], sa + (tid + i * NTHR) * 16);
#pragma unroll
        for (int i = 0; i < BCH; ++i) dma16(bp[i], sb + (tid + i * NTHR) * 16);
    }
#pragma unroll 1
    for (int kt = 0; kt < KT; ++kt) {
        wait_vm0();
        __syncthreads();
        if (kt + 1 < KT) {
            char* sa = lds + ((kt + 1) & 1) * STAGE; char* sb = sa + A_BYTES;
            const int ko = (kt + 1) * 64;
#pragma unroll
            for (int i = 0; i < ACH; ++i) dma16(ap[i] + ko, sa + (tid + i * NTHR) * 16);
#pragma unroll
            for (int i = 0; i < BCH; ++i) dma16(bp[i] + ko, sb + (tid + i * NTHR) * 16);
        }
        const char* sa = lds + (kt & 1) * STAGE; const char* sb = sa + A_BYTES;
        if (PFALL) {
            bf16x8 xf[2][MT], wf[2][NT];
#pragma unroll
            for (int kk = 0; kk < 2; ++kk) {
#pragma unroll
                for (int i = 0; i < MT; ++i) xf[kk][i] = ldsv8(sa + swz128(wm * MT * 16 + i * 16 + fr, kk * 4 + fq));
#pragma unroll
                for (int j = 0; j < NT; ++j) wf[kk][j] = ldsv8(sb + swz128(wn * NT * 16 + j * 16 + fr, kk * 4 + fq));
            }
            __builtin_amdgcn_sched_barrier(0);
            __builtin_amdgcn_s_setprio(1);
#pragma unroll
            for (int kk = 0; kk < 2; ++kk)
#pragma unroll
                for (int i = 0; i < MT; ++i)
#pragma unroll
                    for (int j = 0; j < NT; ++j) acc[i][j] = mfma16(wf[kk][j], xf[kk][i], acc[i][j]);
            __builtin_amdgcn_s_setprio(0);
        } else {
#pragma unroll
            for (int kk = 0; kk < 2; ++kk) {
                bf16x8 xf[MT], wf[NT];
#pragma unroll
                for (int i = 0; i < MT; ++i) xf[i] = ldsv8(sa + swz128(wm * MT * 16 + i * 16 + fr, kk * 4 + fq));
#pragma unroll
                for (int j = 0; j < NT; ++j) wf[j] = ldsv8(sb + swz128(wn * NT * 16 + j * 16 + fr, kk * 4 + fq));
#pragma unroll
                for (int i = 0; i < MT; ++i)
#pragma unroll
                    for (int j = 0; j < NT; ++j) acc[i][j] = mfma16(wf[j], xf[i], acc[i][j]);
                if (ssq) {
#pragma unroll
                    for (int i = 0; i < MT; ++i) {
                        const u32x4 xu = __builtin_bit_cast(u32x4, xf[i]);
#pragma unroll
                        for (int d = 0; d < 4; ++d) { const bfx2 p = __builtin_bit_cast(bfx2, xu[d]); ssq[i] = __builtin_amdgcn_fdot2_f32_bf16(p, p, ssq[i], false); }
                    }
                }
            }
        }
    }
    __syncthreads();
}


struct GemmPipe {
    static constexpr int A_BYTES = 128 * 128, STAGE = 2 * A_BYTES;
    const bf16_t* ap[4]; const bf16_t* bp[4];
    template <class AP>
    DI void setup(AP arow, const bf16_t* Bt, const int ldb) {
        const int tid = threadIdx.x;
#pragma unroll
        for (int i = 0; i < 4; ++i) {
            const int idx = tid + i * NTHR, row = idx >> 3, c = (idx & 7) ^ (row & 7);
            ap[i] = arow(row) + c * 8; bp[i] = Bt + (size_t)row * ldb + c * 8;
        }
    }
    DI void issue(const int kt, const int buf) const {
        const int tid = threadIdx.x;
        char* sa = lds + buf * STAGE; char* sb = sa + A_BYTES;
        const int ko = kt * 64;
#pragma unroll
        for (int i = 0; i < 4; ++i) dma16(ap[i] + ko, sa + (tid + i * NTHR) * 16);
#pragma unroll
        for (int i = 0; i < 4; ++i) dma16(bp[i] + ko, sb + (tid + i * NTHR) * 16);
    }
    template <int PM>
    DI void run_probe(const int K, f32x4 (&acc)[4][4]) const {
        const int tid = threadIdx.x, lane = tid & 63, wave = tid >> 6;
        const int wm = wave >> 1, wn = wave & 1, fr = lane & 15, fq = lane >> 4;
#pragma unroll
        for (int i = 0; i < 4; ++i)
#pragma unroll
            for (int j = 0; j < 4; ++j) acc[i][j] = (f32x4){0.f, 0.f, 0.f, 0.f};
        const int KT = K >> 6;
#pragma unroll 1
        for (int kt = 0; kt < KT; ++kt) {
            if (PM & 4) { wait_vm0(); __syncthreads(); }
            if ((PM & 1) && kt + 1 < KT) issue(kt + 1, (kt + 1) & 1);
            if (PM & 2) {
                const char* sa = lds + (kt & 1) * STAGE; const char* sb = sa + A_BYTES;
                bf16x8 xf[2][4], wf[2][4];
#pragma unroll
                for (int kk = 0; kk < 2; ++kk) {
#pragma unroll
                    for (int i = 0; i < 4; ++i) xf[kk][i] = ldsv8(sa + swz128(wm * 64 + i * 16 + fr, kk * 4 + fq));
#pragma unroll
                    for (int j = 0; j < 4; ++j) wf[kk][j] = ldsv8(sb + swz128(wn * 64 + j * 16 + fr, kk * 4 + fq));
                }
                __builtin_amdgcn_sched_barrier(0);
                __builtin_amdgcn_s_setprio(1);
#pragma unroll
                for (int kk = 0; kk < 2; ++kk)
#pragma unroll
                    for (int i = 0; i < 4; ++i)
#pragma unroll
                        for (int j = 0; j < 4; ++j) acc[i][j] = mfma16(wf[kk][j], xf[kk][i], acc[i][j]);
                __builtin_amdgcn_s_setprio(0);
            }
        }
        wait_vm0();
    }
    DI void run(const int K, f32x4 (&acc)[4][4]) const {
        const int tid = threadIdx.x, lane = tid & 63, wave = tid >> 6;
        const int wm = wave >> 1, wn = wave & 1, fr = lane & 15, fq = lane >> 4;
#pragma unroll
        for (int i = 0; i < 4; ++i)
#pragma unroll
            for (int j = 0; j < 4; ++j) acc[i][j] = (f32x4){0.f, 0.f, 0.f, 0.f};
        const int KT = K >> 6;
#pragma unroll 1
        for (int kt = 0; kt < KT; ++kt) {
            wait_vm0();
            __syncthreads();
            if (kt + 1 < KT) issue(kt + 1, (kt + 1) & 1);
            const char* sa = lds + (kt & 1) * STAGE; const char* sb = sa + A_BYTES;
            bf16x8 xf[2][4], wf[2][4];
#pragma unroll
            for (int kk = 0; kk < 2; ++kk) {
#pragma unroll
                for (int i = 0; i < 4; ++i) xf[kk][i] = ldsv8(sa + swz128(wm * 64 + i * 16 + fr, kk * 4 + fq));
#pragma unroll
                for (int j = 0; j < 4; ++j) wf[kk][j] = ldsv8(sb + swz128(wn * 64 + j * 16 + fr, kk * 4 + fq));
            }
            __builtin_amdgcn_sched_barrier(0);
            __builtin_amdgcn_s_setprio(1);
#pragma unroll
            for (int kk = 0; kk < 2; ++kk)
#pragma unroll
                for (int i = 0; i < 4; ++i)
#pragma unroll
                    for (int j = 0; j < 4; ++j) acc[i][j] = mfma16(wf[kk][j], xf[kk][i], acc[i][j]);
            __builtin_amdgcn_s_setprio(0);
        }
    }
};

constexpr int EPI_OFF = 32768;
DI int lane_m(int i) { const int t = threadIdx.x; return ((t >> 7) & 1) * 64 + i * 16 + (t & 15); }
DI int lane_n(int j) { const int t = threadIdx.x; return ((t >> 6) & 1) * 64 + j * 16 + ((t >> 4) & 3) * 4; }
DI int opaque_tid() { int t = threadIdx.x; asm volatile("" : "+v"(t)); return t; }
DI int lane_m(int t, int i) { return ((t >> 7) & 1) * 64 + i * 16 + (t & 15); }
DI int lane_n(int t, int j) { return ((t >> 6) & 1) * 64 + j * 16 + ((t >> 4) & 3) * 4; }
template <class XF>
DI void epi_stage_bf16(const f32x4 (&acc)[4][4], XF xf) {
    const int tz = opaque_tid();
#pragma unroll
    for (int i = 0; i < 4; ++i) {
        const int m = lane_m(tz, i);
#pragma unroll
        for (int j = 0; j < 4; ++j) {
            const int n = lane_n(tz, j);
            const f32x4 v = xf(i, j, acc[i][j]);
            u32x2 o; o[0] = pk2(v[0], v[1]); o[1] = pk2(v[2], v[3]);
            *(u32x2*)(lds + EPI_OFF + m * 256 + (((n >> 3) ^ (m & 15)) << 4) + (n & 4) * 2) = o;
        }
    }
}
template <class DP, class OK>
DI void epi_flush_bf16(DP dst, OK ok) {
    const int tz = opaque_tid();
#pragma unroll
    for (int it = 0; it < 8; ++it) {
        const int idx = tz + it * NTHR, row = idx >> 4, ch = idx & 15;
        const u32x4 v = *(const u32x4*)(lds + EPI_OFF + row * 256 + ((ch ^ (row & 15)) << 4));
        if (ok(row)) *(u32x4*)(dst(row) + ch * 8) = v;
    }
}
template <class XF>
DI void epi_stage_bf16_T(const f32x4 (&acc)[4][4], XF xf) {
    const int tz = opaque_tid();
    const bool odd = tz & 1;
#pragma unroll
    for (int i = 0; i < 4; ++i) {
        const int m = lane_m(tz, i) & ~1;
#pragma unroll
        for (int j = 0; j < 4; ++j) {
            const int n = lane_n(tz, j) + (odd ? 2 : 0);
            const f32x4 v = xf(i, j, acc[i][j]);
            const float r0 = __shfl_xor(odd ? v[0] : v[2], 1), r1 = __shfl_xor(odd ? v[1] : v[3], 1);
            const unsigned w0 = odd ? pk2(r0, v[2]) : pk2(v[0], r0), w1 = odd ? pk2(r1, v[3]) : pk2(v[1], r1);
            *(unsigned*)(lds + EPI_OFF + n * 256 + (((m >> 3) ^ (n & 15)) << 4) + (m & 6) * 2) = w0;
            *(unsigned*)(lds + EPI_OFF + (n + 1) * 256 + (((m >> 3) ^ ((n + 1) & 15)) << 4) + (m & 6) * 2) = w1;
        }
    }
}
DI void epi_resid_f32(const Args& a, const int li, const int m0, const int n0, const f32x4 (&acc)[4][4]) {
    const int tz = opaque_tid();
    float* X = (float*)(a.ws + WS_X);
    const float* gate = (const float*)(a.ws + WS_MOD) + ((size_t)li * 9 + tok_modrow(m0)) * 6144 + 2 * 1024 + n0;
#pragma unroll
    for (int j = 0; j < 4; ++j) {
        const int n = lane_n(tz, j);
        const f32x4 g = *(const f32x4*)(gate + n);
#pragma unroll
        for (int i = 0; i < 4; ++i) {
            const int t = m0 + lane_m(tz, i);
            float* xp = X + (size_t)t * D + n0 + n;
            const float* xs = li == 0 ? (t < NLAT ? a.in[0] + (size_t)t * D : a.in[2] + (size_t)(t - NLAT) * D) + n0 + n : xp;
            f32x4 x = *(const f32x4*)xs;
            x += g * acc[i][j];
            *(f32x4*)xp = x;
        }
    }
}

template <bool XPF = true, class TE>
DI void gemm_dense_phase(const bf16_t* A, const int lda, const int mrows, const bf16_t* Bt, const int N, const int K, TE tile_epi) {
    const int mt = mrows / 128, nt = N / 128;
    const int mpx = mt >> 3, bmb = mpx >> 1, full = mpx * 8;
    auto decode = [&](int u, int& m0, int& n0) {
        const int xc = u & 7, s = u >> 3;
        const int bn = s / full, rem = s - bn * full;
        const int w = min(8, nt - 8 * bn);
        const int bm = rem / (bmb * w), rem2 = rem - bm * (bmb * w);
        const int ni = rem2 / bmb, mi = rem2 - ni * bmb;
        m0 = (xc * mpx + bm * bmb + mi) * 128; n0 = (bn * 8 + ni) * 128;
    };
    GemmPipe g;
    int u = blockIdx.x, m0 = 0, n0 = 0;
    __syncthreads();
    if (u < mt * nt) { decode(u, m0, n0); g.setup([&](int r) { return A + (size_t)(m0 + r) * lda; }, Bt + (size_t)n0 * K, K); g.issue(0, 0); }
    while (u < mt * nt) {
        f32x4 acc[4][4];
        g.run(K, acc);
        const int cm0 = m0, cn0 = n0;
        u += gridDim.x;
        if (XPF) {
            if (u < mt * nt) { decode(u, m0, n0); g.setup([&](int r) { return A + (size_t)(m0 + r) * lda; }, Bt + (size_t)n0 * K, K); g.issue(0, 0); }
            tile_epi(cm0, cn0, acc);
        } else {
            tile_epi(cm0, cn0, acc);
            __syncthreads();
            if (u < mt * nt) { decode(u, m0, n0); g.setup([&](int r) { return A + (size_t)(m0 + r) * lda; }, Bt + (size_t)n0 * K, K); g.issue(0, 0); }
        }
    }
    __syncthreads();
}
template <class XF, class DP>
DI void epi_bf16_rowmajor(const f32x4 (&acc)[4][4], XF xf, DP dst) {
    __syncthreads();
    epi_stage_bf16(acc, xf);
    __syncthreads();
    epi_flush_bf16(dst, [](int) { return true; });
}

DI void phase_rg_in(const Args& a, int j) {
    bf16_t* G = (bf16_t*)(a.ws + RG_G); bf16_t* U = (bf16_t*)(a.ws + RG_U);
    gemm_dense_phase((const bf16_t*)(a.ws + WS_H), D, NTOK, (const bf16_t*)(a.ws + W_RGIN) + (size_t)j * 2048 * 1024, 2048, 1024,
        [&](int m0, int n0, const f32x4 (&acc)[4][4]) {
            if (n0 < 1024)
                epi_bf16_rowmajor(acc, [](int, int, const f32x4 v) { f32x4 g; g[0] = gelu_tanh(v[0]); g[1] = gelu_tanh(v[1]); g[2] = gelu_tanh(v[2]); g[3] = gelu_tanh(v[3]); return g; },
                                  [&](int row) { return G + (size_t)(m0 + row) * D + n0; });
            else
                epi_bf16_rowmajor(acc, [](int, int, const f32x4 v) { return v; }, [&](int row) { return U + (size_t)(m0 + row) * D + (n0 - 1024); });
        });
}

template <int VAR = 0, int HOST = 0>
DI void phase_rg_scan(const Args& a, int j) {
    const int tid = threadIdx.x, lane = tid & 63, wave = tid >> 6;
    const int fr = lane & 15, fq = lane >> 4;
    const bf16_t* U = (const bf16_t*)(a.ws + RG_U);
    bf16_t* HS = (bf16_t*)(a.ws + (VAR ? WS_Y : RG_HS));
    char* sW = lds;
    char* sX = lds + 8192;
    float* sUc = (float*)(lds + 16384);
    float* sA = (float*)(lds + 24576);
    float* sB = (float*)(lds + 33280);
    bf16_t* sO = (bf16_t*)(lds + 41984);
    unsigned* sCv = (unsigned*)(lds + 50176);
    const int c = tid & 7;
    for (int u = blockIdx.x; u < 512; u += gridDim.x) {
        const int half = u & 1, dir = (u >> 1) & 1, blk = (u >> 2) & 15, b = u >> 6;
        const int cin0 = blk * 64, co0 = blk * 64 + half * 32;
        __syncthreads();
        {
            const bf16_t* Wg = (const bf16_t*)(a.ws + W_RGG) + ((size_t)((j * 2 + dir) * 16 + blk)) * 128 * 64;
#pragma unroll
            for (int i = 0; i < 2; ++i) {
                const int idx = tid + i * NTHR, row = idx >> 3, cc = idx & 7;
                const int srow = (row >> 5) * 64 + half * 32 + (row & 31);
                *(u32x4*)(sW + swz128(row, cc)) = *(const u32x4*)(Wg + (size_t)srow * 64 + cc * 8);
            }
        }
        float carry = 0.f;
        float cw[4][8], cb[8];
        {
            const float* cwp = a.in[9] + (size_t)j * 4 * 1024 + cin0 + c * 8; const float* cbp = a.in[10] + (size_t)j * 1024 + cin0 + c * 8;
#pragma unroll
            for (int w = 0; w < 4; ++w) { const f32x4 v0 = *(const f32x4*)(cwp + w * 1024), v1 = *(const f32x4*)(cwp + w * 1024 + 4);
#pragma unroll
                for (int e = 0; e < 4; ++e) { cw[w][e] = v0[e]; cw[w][4 + e] = v1[e]; } }
            const f32x4 v0 = *(const f32x4*)cbp, v1 = *(const f32x4*)(cbp + 4);
#pragma unroll
            for (int e = 0; e < 4; ++e) { cb[e] = v0[e]; cb[4 + e] = v1[e]; }
        }
        float bg0[8], bg1[8], spl[8];
        {
            const float* gb = a.in[12] + ((size_t)(j * 2 + dir) * 2) * 1024 + co0;
            const float* lm = a.in[13] + (size_t)(j * 2 + dir) * 1024 + co0;
#pragma unroll
            for (int jt = 0; jt < 2; ++jt)
#pragma unroll
                for (int e = 0; e < 4; ++e) {
                    const int cc = jt * 16 + fq * 4 + e;
                    bg0[jt * 4 + e] = gb[cc]; bg1[jt * 4 + e] = gb[1024 + cc];
                    spl[jt * 4 + e] = -8.f * log1pf(__expf(-lm[cc]));
                }
        }
        u32x4 pu[2][4];
        auto load_chunk = [&](int ci) {
            const int seg = ci >= 4, L = seg ? SEQ : CTXL, nch = L / 64, jc = seg ? ci - 4 : ci;
            const int oc = dir ? nch - 1 - jc : jc;
            const int rb = seg ? b * SEQ : NLAT + b * CTXL;
            const int s0 = oc * 64;
#pragma unroll
            for (int it = 0; it < 2; ++it) {
                const int tk = (tid >> 3) + it * 32;
#pragma unroll
                for (int w = 0; w < 4; ++w) {
                    const int s = s0 + tk + w - 2;
                    const int sc_ = min(max(s, 0), L - 1);
                    const u32x4 ld = *(const u32x4*)(U + (size_t)(rb + sc_) * D + cin0 + c * 8);
                    const unsigned msk = (s >= 0 && s < L) ? 0xffffffffu : 0u;
                    pu[it][w] = (u32x4){ld[0] & msk, ld[1] & msk, ld[2] & msk, ld[3] & msk};
                }
            }
        };
        load_chunk(0);
        __syncthreads();
        size_t prev_base = 0;
        constexpr int CV_TILES = HOST ? 6144 : 0;
        CvTile cvp; cvp.src = nullptr; cvp.dst = nullptr; cvp.K = 0; cvp.N = 0; cvp.perm = 0; cvp.k0 = 0; cvp.n0 = 0;
        bool cvp_ok = false;
#pragma unroll 1
        for (int ci = 0; ci < 36; ++ci) {
            f32x4 cv0[4], cv1[4];
            CvTile cvc = cvp;
            const int cvq = (ci / 3) * 512 + u;
            const bool cv_ok = HOST && (ci % 3 == 0) && cvq < CV_TILES;
            if (cv_ok) { cvc = moe_cv_tile(a, 1, cvq); cv_load(cvc, cv0, cv1); }
            const int seg = ci >= 4, L = seg ? SEQ : CTXL, nch = L / 64, jc = seg ? ci - 4 : ci;
            const int oc = dir ? nch - 1 - jc : jc;
            const int rb = seg ? b * SEQ : NLAT + b * CTXL;
            const int s0 = oc * 64;
            char* sXc = sX; float* sUcc = sUc;
#pragma unroll
            for (int it = 0; it < 2; ++it) {
                const int tk = (tid >> 3) + it * 32;
                float o[8];
#pragma unroll
                for (int e = 0; e < 8; ++e) o[e] = cb[e];
#pragma unroll
                for (int w = 0; w < 4; ++w) {
                    const u32x4 r4 = pu[it][w];
#pragma unroll
                    for (int e = 0; e < 4; ++e) { o[2 * e] += cw[w][2 * e] * lof(r4[e]); o[2 * e + 1] += cw[w][2 * e + 1] * hif(r4[e]); }
                }
                u32x4 pv; pv[0] = pk2(o[0], o[1]); pv[1] = pk2(o[2], o[3]); pv[2] = pk2(o[4], o[5]); pv[3] = pk2(o[6], o[7]);
                *(u32x4*)(sXc + swz128(tk, c)) = pv;
                if ((c >> 2) == half) {
                    *(f32x4*)(sUcc + tk * 32 + (c & 3) * 8) = (f32x4){o[0], o[1], o[2], o[3]};
                    *(f32x4*)(sUcc + tk * 32 + (c & 3) * 8 + 4) = (f32x4){o[4], o[5], o[6], o[7]};
                }
            }
            if (ci + 1 < 36) load_chunk(ci + 1);
            lds_barrier();
            if (HOST && cvp_ok) cv_flush(cvp, sCv);
            if (ci > 0) {
                const u32x4 v = *(const u32x4*)(sO + ((ci - 1) & 1) * 2048 + tid * 8);
                *(u32x4*)(HS + prev_base + (size_t)(tid >> 2) * D + (tid & 3) * 8) = v;
            }
            {
                f32x4 acc[4];
#pragma unroll
                for (int jt = 0; jt < 4; ++jt) acc[jt] = (f32x4){0.f, 0.f, 0.f, 0.f};
#pragma unroll
                for (int kk = 0; kk < 2; ++kk) {
                    const bf16x8 xf = ldsv8(sXc + swz128(wave * 16 + fr, kk * 4 + fq));
#pragma unroll
                    for (int jt = 0; jt < 4; ++jt) acc[jt] = mfma16(ldsv8(sW + swz128(jt * 16 + fr, kk * 4 + fq)), xf, acc[jt]);
                }
                const int tk = wave * 16 + fr;
#pragma unroll
                for (int jt = 0; jt < 2; ++jt) {
                    const f32x4 uc = *(const f32x4*)(sUcc + tk * 32 + jt * 16 + fq * 4);
                    f32x4 av4, bv4;
#pragma unroll
                    for (int e = 0; e < 4; ++e) {
                        if (VAR & 2) { av4[e] = 0.5f + 0.001f * acc[jt][e]; bv4[e] = uc[e] + acc[jt + 2][e]; continue; }
                        const float rg = sigmoidf_(acc[jt][e] + bg0[jt * 4 + e]);
                        const float ig = sigmoidf_(acc[jt + 2][e] + bg1[jt * 4 + e]);
                        const float av = fexp(rg * spl[jt * 4 + e]);
                        av4[e] = av;
                        bv4[e] = __builtin_amdgcn_sqrtf(fmaxf(1.f - av * av, 0.f)) * ig * uc[e];
                    }
#pragma unroll
                    for (int e = 0; e < 4; ++e) { sA[(jt * 16 + fq * 4 + e) * 68 + tk] = av4[e]; sB[(jt * 16 + fq * 4 + e) * 68 + tk] = bv4[e]; }
                }
            }
            lds_barrier();
            if (!(VAR & 4)) {
                const int ch = wave * 8 + (lane & 7), sg = lane >> 3;
                const int tb = dir ? 56 - sg * 8 : sg * 8;
                const f32x4 a0 = *(const f32x4*)(sA + ch * 68 + tb), a1 = *(const f32x4*)(sA + ch * 68 + tb + 4);
                const f32x4 b0 = *(const f32x4*)(sB + ch * 68 + tb), b1 = *(const f32x4*)(sB + ch * 68 + tb + 4);
                float av[8], bv[8];
#pragma unroll
                for (int e = 0; e < 4; ++e) {
                    av[e] = dir ? a1[3 - e] : a0[e]; av[4 + e] = dir ? a0[3 - e] : a1[e];
                    bv[e] = dir ? b1[3 - e] : b0[e]; bv[4 + e] = dir ? b0[3 - e] : b1[e];
                }
                float Ap = 1.f, Hh = 0.f;
#pragma unroll
                for (int e = 0; e < 8; ++e) { Hh = av[e] * Hh + bv[e]; Ap *= av[e]; }
#pragma unroll
                for (int d = 8; d < 64; d <<= 1) {
                    const float Ao = __shfl_up(Ap, d), Ho = __shfl_up(Hh, d);
                    if (lane >= d) { Hh = Ap * Ho + Hh; Ap = Ap * Ao; }
                }
                float Aex = __shfl_up(Ap, 8), Hex = __shfl_up(Hh, 8);
                if (sg == 0) { Aex = 1.f; Hex = 0.f; }
                float hin = Aex * carry + Hex;
                const float cnew = Ap * carry + Hh;
                carry = __shfl(cnew, 56 + (lane & 7));
                bf16_t* so = sO + (ci & 1) * 2048 + ch;
#pragma unroll
                for (int e = 0; e < 8; ++e) {
                    hin = av[e] * hin + bv[e];
                    const int i = sg * 8 + e, tk = dir ? 63 - i : i;
                    so[tk * 32] = f2bf(hin);
                }
            }
            prev_base = (size_t)dir * NTOK * D + (size_t)(rb + s0) * D + co0;
            if (HOST) { if (cv_ok) cv_pack(sCv, cv0, cv1); cvp = cvc; cvp_ok = cv_ok; }
        }
        __syncthreads();
        if (HOST && cvp_ok) cv_flush(cvp, sCv);
        {
            const u32x4 v = *(const u32x4*)(sO + (35 & 1) * 2048 + tid * 8);
            *(u32x4*)(HS + prev_base + (size_t)(tid >> 2) * D + (tid & 3) * 8) = v;
        }
    }
}

DI void phase_rg_combine(const Args& a) {
    const u32x4* G = (const u32x4*)(a.ws + RG_G);
    const u32x4* H0 = (const u32x4*)(a.ws + RG_HS);
    const u32x4* H1 = (const u32x4*)(a.ws + RG_HS + TOKD2);
    u32x4* A2 = (u32x4*)(a.ws + RG_A2);
    const size_t n = (size_t)NTOK * D / 8;
    for (size_t i = (size_t)blockIdx.x * NTHR + threadIdx.x; i < n; i += (size_t)gridDim.x * NTHR) {
        const u32x4 g = G[i], h0 = H0[i], h1 = H1[i];
        u32x4 o;
#pragma unroll
        for (int e = 0; e < 4; ++e) o[e] = pk2(lof(g[e]) * (lof(h0[e]) + lof(h1[e])), hif(g[e]) * (hif(h0[e]) + hif(h1[e])));
        A2[i] = o;
    }
}

DI void phase_rg_out(const Args& a, int li, int j) {
    gemm_dense_phase((const bf16_t*)(a.ws + RG_A2), D, li == 3 ? NLAT : NTOK, (const bf16_t*)(a.ws + W_RGOUT) + (size_t)j * 1024 * 1024, 1024, 1024,
        [&](int m0, int n0, const f32x4 (&acc)[4][4]) { epi_resid_f32(a, li, m0, n0, acc); });
}

DI void phase_mla_down(const Args& a) {
    bf16_t* CQ = (bf16_t*)(a.ws + MLA_CQ); bf16_t* CKV = (bf16_t*)(a.ws + MLA_CKV); float* KR = (float*)(a.ws + MLA_KR);
    gemm_dense_phase((const bf16_t*)(a.ws + WS_H), D, NTOK, (const bf16_t*)(a.ws + W_MDOWN), 512, 1024,
        [&](int m0, int n0, const f32x4 (&acc)[4][4]) {
            if (n0 < 256) epi_bf16_rowmajor(acc, [](int, int, const f32x4 v) { return v; }, [&](int row) { return CQ + (size_t)(m0 + row) * 256 + n0; });
            else if (n0 == 256) epi_bf16_rowmajor(acc, [](int, int, const f32x4 v) { return v; }, [&](int row) { return CKV + (size_t)(m0 + row) * 128; });
            else {
#pragma unroll
                for (int i = 0; i < 4; ++i)
#pragma unroll
                    for (int j = 0; j < 2; ++j) { const int n = lane_n(j); if (n < 32) *(f32x4*)(KR + (size_t)(m0 + lane_m(i)) * 32 + n) = acc[i][j]; }
            }
        });
}

DI int perm_key(int kp) { return (kp & ~12) | ((kp & 4) << 1) | ((kp & 8) >> 1); }

DI void phase_mla_up(const Args& a) {
    const int tid = threadIdx.x;
    const bf16_t* CQ = (const bf16_t*)(a.ws + MLA_CQ); const bf16_t* CKV = (const bf16_t*)(a.ws + MLA_CKV); const float* KR = (const float*)(a.ws + MLA_KR);
    bf16_t* Q = (bf16_t*)(a.ws + MLA_Q); bf16_t* Kb = (bf16_t*)(a.ws + MLA_K); bf16_t* VT = (bf16_t*)(a.ws + MLA_VT);
    const float* qkn = a.in[20];
    const float* RC = (const float*)(a.ws + WS_CTL + CTL_ROPE); const float* RS = RC + 512;
    const int MT_ = NTOK / 128;
    const int nq = MT_ * 16, nkv = MT_ * 16;
    const float QSCALE = 0.10206207261596575f * 1.4426950408889634f;
    for (int u = blockIdx.x; u < nq + nkv; u += gridDim.x) {
        const bool isq = u < nq;
        const int uu = isq ? u : u - nq;
        const int xc_ = uu & 7, s_ = uu >> 3;
        const int m0 = (((s_ >> 4) << 3) + xc_) * 128, head = s_ & 15;
        const bool islat = m0 < NLAT;
        const int bb = islat ? (m0 >> 11) : ((m0 - NLAT) >> 8);
        const int kp0 = islat ? CTXL + (m0 & (SEQ - 1)) : ((m0 - NLAT) & (CTXL - 1));
        __syncthreads();
        if (isq) {
            f32x4 hold[2][6];
            float ssq[2] = {0.f, 0.f};
            gemm_tile<4, 1, 2, 6, false>([&](int r) { return CQ + (size_t)(m0 + r) * 256; }, (const bf16_t*)(a.ws + W_MUQ) + (size_t)head * 96 * 256, 256, 256, hold, ssq);
            const int tz = opaque_tid();
            const int wave = tz >> 6, fq = (tz >> 4) & 3, fr = tz & 15;
#pragma unroll
            for (int i = 0; i < 2; ++i) {
                const int m = wave * 32 + i * 16 + fr;
                float sq = ssq[i]; sq += __shfl_xor(sq, 16); sq += __shfl_xor(sq, 32);
                const float rs0 = rsqrtf(sq * (1.f / 256.f) + EPS);
                float ss = 0.f;
#pragma unroll
                for (int jn = 0; jn < 6; ++jn) { hold[i][jn] *= rs0;
#pragma unroll
                    for (int e = 0; e < 4; ++e) ss += hold[i][jn][e] * hold[i][jn][e]; }
                ss += __shfl_xor(ss, 16); ss += __shfl_xor(ss, 32);
                const float rs = rsqrtf(ss * (1.f / 96.f) + EPS) ;
                f32x4 o[6];
#pragma unroll
                for (int jn = 0; jn < 6; ++jn) { const f32x4 g4 = *(const f32x4*)(qkn + jn * 16 + fq * 4); o[jn] = hold[i][jn] * rs * g4; }
#pragma unroll
                for (int jn = 4; jn < 6; ++jn) {
                    f32x4 other;
#pragma unroll
                    for (int e = 0; e < 4; ++e) other[e] = __shfl_xor(o[jn][e], 32);
                    if (islat) {
                        const int s = (m0 + m) & (SEQ - 1);
                        const int pos = jn == 4 ? (s >> 6) : (s & 63);
                        const f32x4 cs = *(const f32x4*)(RC + pos * 8 + (fq & 1) * 4), sn = *(const f32x4*)(RS + pos * 8 + (fq & 1) * 4);
#pragma unroll
                        for (int e = 0; e < 4; ++e) o[jn][e] = (fq < 2) ? o[jn][e] * cs[e] - other[e] * sn[e] : o[jn][e] * cs[e] + other[e] * sn[e];
                    }
                }
#pragma unroll
                for (int jn = 0; jn < 6; ++jn) {
                    const f32x4 v = o[jn] * QSCALE;
                    u32x2 pv; pv[0] = pk2(v[0], v[1]); pv[1] = pk2(v[2], v[3]);
                    *(u32x2*)(lds + m * 256 + (((jn * 2 + (fq >> 1)) ^ (m & 15)) << 4) + (fq & 1) * 8) = pv;
                }
            }
            __syncthreads();
#pragma unroll
            for (int it = 0; it < 8; ++it) {
                const int idx = tz + it * NTHR, row = idx >> 4, ch = idx & 15;
                if (ch < 12) {
                    const u32x4 v = *(const u32x4*)(lds + row * 256 + ((ch ^ (row & 15)) << 4));
                    *(u32x4*)(Q + (size_t)(m0 + row) * 1536 + head * 96 + ch * 8) = v;
                }
            }
        } else {
            f32x4 hold[4][4];
            float ssq[4] = {0.f, 0.f, 0.f, 0.f};
            gemm_tile<2, 2, 4, 4, false>([&](int r) { return CKV + (size_t)(m0 + r) * 128; }, (const bf16_t*)(a.ws + W_MUKV) + (size_t)head * 128 * 128, 128, 128, hold, ssq);
            const int tz = opaque_tid();
            const int wave = tz >> 6, wm = wave >> 1, wn = wave & 1, fq = (tz >> 4) & 3, fr = tz & 15;
            char* sK = lds; char* sV = lds + 32768;
#pragma unroll
            for (int i = 0; i < 4; ++i) {
                const int m = wm * 64 + i * 16 + fr, t = m0 + m;
                float sq = ssq[i]; sq += __shfl_xor(sq, 16); sq += __shfl_xor(sq, 32);
                const float rs0 = rsqrtf(sq * (1.f / 128.f) + EPS);
#pragma unroll
                for (int jn = 0; jn < 4; ++jn) hold[i][jn] *= rs0;
                if (wn == 0) {
                    const int base = (fq >> 1) * 16 + (fq & 1) * 4;
                    const f32x4 z1 = *(const f32x4*)(KR + (size_t)t * 32 + base);
                    const f32x4 z2 = *(const f32x4*)(KR + (size_t)t * 32 + base + 8);
                    float ss = 0.f;
#pragma unroll
                    for (int jn = 0; jn < 4; ++jn)
#pragma unroll
                        for (int e = 0; e < 4; ++e) ss += hold[i][jn][e] * hold[i][jn][e];
#pragma unroll
                    for (int e = 0; e < 4; ++e) ss += z1[e] * z1[e] + z2[e] * z2[e];
                    ss += __shfl_xor(ss, 16); ss += __shfl_xor(ss, 32);
                    const float rs = rsqrtf(ss * (1.f / 96.f) + EPS);
#pragma unroll
                    for (int jn = 0; jn < 4; ++jn) {
                        const f32x4 g4 = *(const f32x4*)(qkn + 96 + jn * 16 + fq * 4);
                        const f32x4 v = hold[i][jn] * rs * g4;
                        u32x2 pv; pv[0] = pk2(v[0], v[1]); pv[1] = pk2(v[2], v[3]);
                        *(u32x2*)(sK + m * 256 + (((jn * 2 + (fq >> 1)) ^ (m & 15)) << 4) + (fq & 1) * 8) = pv;
                    }
                    const f32x4 g1 = *(const f32x4*)(qkn + 96 + 64 + base), g2 = *(const f32x4*)(qkn + 96 + 64 + base + 8);
                    f32x4 a1 = z1 * rs * g1, a2 = z2 * rs * g2;
                    if (islat) {
                        const int s = t & (SEQ - 1);
                        const int pos = (fq >> 1) == 0 ? (s >> 6) : (s & 63);
                        const f32x4 cs = *(const f32x4*)(RC + pos * 8 + (fq & 1) * 4), sn = *(const f32x4*)(RS + pos * 8 + (fq & 1) * 4);
                        const f32x4 b1 = a1 * cs - a2 * sn, b2 = a2 * cs + a1 * sn;
                        a1 = b1; a2 = b2;
                    }
                    u32x2 p1, p2; p1[0] = pk2(a1[0], a1[1]); p1[1] = pk2(a1[2], a1[3]); p2[0] = pk2(a2[0], a2[1]); p2[1] = pk2(a2[2], a2[3]);
                    const int c1 = 8 + (fq >> 1) * 2;
                    *(u32x2*)(sK + m * 256 + ((c1 ^ (m & 15)) << 4) + (fq & 1) * 8) = p1;
                    *(u32x2*)(sK + m * 256 + (((c1 + 1) ^ (m & 15)) << 4) + (fq & 1) * 8) = p2;
                }
                {
                    const bool odd = fr & 1;
                    const int mp = perm_key(m & ~1);
#pragma unroll
                    for (int jn = 0; jn < 4; ++jn) {
                        const f32x4 v = hold[i][jn];
                        const float r0 = __shfl_xor(odd ? v[0] : v[2], 1), r1 = __shfl_xor(odd ? v[1] : v[3], 1);
                        if (wn == 1) {
                            const int e0 = jn * 16 + fq * 4 + (odd ? 2 : 0);
                            const unsigned w0 = odd ? pk2(r0, v[2]) : pk2(v[0], r0), w1 = odd ? pk2(r1, v[3]) : pk2(v[1], r1);
                            *(unsigned*)(sV + e0 * 256 + (((mp >> 3) ^ (e0 & 15)) << 4) + (mp & 6) * 2) = w0;
                            *(unsigned*)(sV + (e0 + 1) * 256 + (((mp >> 3) ^ ((e0 + 1) & 15)) << 4) + (mp & 6) * 2) = w1;
                        }
                    }
                }
            }
            __syncthreads();
            bf16_t* kdst = Kb + ((size_t)(bb * 16 + head) * NKEY + kp0) * 96;
#pragma unroll
            for (int it = 0; it < 8; ++it) {
                const int idx = tz + it * NTHR, row = idx >> 4, ch = idx & 15;
                if (ch < 12) {
                    const u32x4 v = *(const u32x4*)(sK + row * 256 + ((ch ^ (row & 15)) << 4));
                    *(u32x4*)(kdst + (size_t)row * 96 + ch * 8) = v;
                }
            }
            bf16_t* vdst = VT + ((size_t)(bb * 16 + head) * 64) * NKEY + kp0;
#pragma unroll
            for (int it = 0; it < 4; ++it) {
                const int idx = tz + it * NTHR, row = idx >> 4, ch = idx & 15;
                const u32x4 v = *(const u32x4*)(sV + row * 256 + ((ch ^ (row & 15)) << 4));
                *(u32x4*)(vdst + (size_t)row * NKEY + ch * 8) = v;
            }
        }
    }
}

DI void phase_mla_attn(const Args& a) {
    const int tid = threadIdx.x, lane = tid & 63, wave = tid >> 6;
    const int r = lane & 31, h = lane >> 5;
    const bf16_t* Q = (const bf16_t*)(a.ws + MLA_Q); const bf16_t* Kb = (const bf16_t*)(a.ws + MLA_K); const bf16_t* VT = (const bf16_t*)(a.ws + MLA_VT);
    bf16_t* O = (bf16_t*)(a.ws + MLA_O);
    constexpr int KT_B = 64 * 192, VT_B = 64 * 128, ST_B = KT_B + VT_B;
    unsigned* sCv = (unsigned*)(lds + 49152);
    const int cv_per = 18432 / gridDim.x;
    int cvn = 0, itc = 0;
    bool cv_pack_p = false, cv_flush_p = false;
    CvTile cvB, cvC; cvB.src = nullptr; cvB.dst = nullptr; cvB.K = 0; cvB.N = 0; cvB.perm = 0; cvB.k0 = 0; cvB.n0 = 0; cvC = cvB;
    f32x4 cv0[4], cv1[4];
#pragma unroll
    for (int i = 0; i < 4; ++i) { cv0[i] = (f32x4){0.f, 0.f, 0.f, 0.f}; cv1[i] = cv0[i]; }
    auto cv_step = [&](bool may_load) {
        if (cv_flush_p) { cv_flush(cvC, sCv); cv_flush_p = false; }
        if (cv_pack_p) { cv_pack(sCv, cv0, cv1); cvC = cvB; cv_flush_p = true; cv_pack_p = false; }
        if (may_load && cvn < cv_per) {
            const int t = cvn * gridDim.x + blockIdx.x;
            cvB = moe_cv_tile(a, 1 + t / 6144, t % 6144); cv_load(cvB, cv0, cv1); cv_pack_p = true; ++cvn;
        }
    };
    for (int u = blockIdx.x; u < 2048 + 256; u += gridDim.x) {
        const bool isctx = u >= 2048;
        const int uu = isctx ? u - 2048 : u;
        const int xc_ = uu & 7, s_ = uu >> 3, bh_ = ((s_ >> 4) << 3) + xc_;
        const int qb = isctx ? (uu & 1) : (s_ & 15), head = isctx ? ((uu >> 1) & 15) : (bh_ & 15), b = isctx ? (uu >> 5) : (bh_ >> 4);
        const int ntile = isctx ? CTXL / 64 : NKEY / 64;
        const int t = (isctx ? NLAT + b * CTXL : b * SEQ) + qb * 128 + wave * 32 + r;
        const bf16_t* kbase = Kb + (size_t)(b * 16 + head) * NKEY * 96;
        const bf16_t* vbase = VT + (size_t)(b * 16 + head) * 64 * NKEY;
        bf16x8 qf[6];
#pragma unroll
        for (int kk = 0; kk < 6; ++kk) qf[kk] = *(const bf16x8*)(Q + (size_t)t * 1536 + head * 96 + kk * 16 + h * 8);
        f32x16 o[2];
#pragma unroll
        for (int e = 0; e < 16; ++e) { o[0][e] = 0.f; o[1][e] = 0.f; }
        float lsum = 0.f;
        __syncthreads();
        auto stage = [&](int kt, int buf) {
            char* sk = lds + buf * ST_B; char* sv = sk + KT_B;
            const int key0 = kt * 64;
#pragma unroll
            for (int i = 0; i < 3; ++i) {
                const int idx = tid + i * NTHR, row = idx / 12, slot = idx - row * 12;
                int c = slot - ((row >> 2) % 12); if (c < 0) c += 12;
                dma16(kbase + (size_t)(key0 + row) * 96 + c * 8, sk + idx * 16);
            }
#pragma unroll
            for (int i = 0; i < 2; ++i) {
                const int idx = tid + i * NTHR, row = idx >> 3, c = (idx & 7) ^ ((row >> 1) & 7);
                dma16(vbase + (size_t)row * NKEY + key0 + c * 8, sv + idx * 16);
            }
        };
        stage(0, 0);
#pragma unroll 1
        for (int kt = 0; kt < ntile; ++kt) {
            wait_vm0();
            __syncthreads();
            if (kt + 1 < ntile) stage(kt + 1, (kt + 1) & 1);
            cv_step((itc & 3) == 0); ++itc;
            const char* sk = lds + (kt & 1) * ST_B; const char* sv = sk + KT_B;
            f32x16 st[2];
#pragma unroll
            for (int e = 0; e < 16; ++e) { st[0][e] = -8.f; st[1][e] = -8.f; }
#pragma unroll
            for (int kk = 0; kk < 6; ++kk)
#pragma unroll
                for (int si = 0; si < 2; ++si) {
                    const int s = si * 32 + r;
                    int slot = kk * 2 + h + ((s >> 2) % 12); if (slot >= 12) slot -= 12;
                    st[si] = mfma32(ldsv8(sk + s * 192 + slot * 16), qf[kk], st[si]);
                }
            float ps = 0.f;
#pragma unroll
            for (int si = 0; si < 2; ++si)
#pragma unroll
                for (int e = 0; e < 16; ++e) { const float p = __builtin_amdgcn_exp2f(st[si][e]); st[si][e] = p; ps += p; }
            lsum += ps;
#pragma unroll
            for (int si = 0; si < 2; ++si)
#pragma unroll
                for (int ks = 0; ks < 2; ++ks) {
                    u32x4 pp;
                    pp[0] = pk2(st[si][8 * ks + 0], st[si][8 * ks + 1]); pp[1] = pk2(st[si][8 * ks + 2], st[si][8 * ks + 3]);
                    pp[2] = pk2(st[si][8 * ks + 4], st[si][8 * ks + 5]); pp[3] = pk2(st[si][8 * ks + 6], st[si][8 * ks + 7]);
                    const bf16x8 pf = __builtin_bit_cast(bf16x8, pp);
#pragma unroll
                    for (int et = 0; et < 2; ++et) {
                        const int e = et * 32 + r;
                        o[et] = mfma32(ldsv8(sv + e * 128 + (((si * 4 + ks * 2 + h) ^ ((e >> 1) & 7)) << 4)), pf, o[et]);
                    }
                }
        }
        lsum += __shfl_xor(lsum, 32);
        const float inv = 1.f / lsum;
#pragma unroll
        for (int et = 0; et < 2; ++et)
#pragma unroll
            for (int g = 0; g < 4; ++g) {
                f32x4 v; v[0] = o[et][4 * g] * inv; v[1] = o[et][4 * g + 1] * inv; v[2] = o[et][4 * g + 2] * inv; v[3] = o[et][4 * g + 3] * inv;
                st_bf4(O + (size_t)t * D + head * 64 + et * 32 + 8 * g + 4 * h, v);
            }
    }
    while (cvn < cv_per || cv_pack_p || cv_flush_p) { __syncthreads(); cv_step(!cv_pack_p && !cv_flush_p); }
}

DI void phase_mla_out(const Args& a, int li) {
    gemm_dense_phase((const bf16_t*)(a.ws + MLA_O), D, NTOK, (const bf16_t*)(a.ws + W_MO), 1024, 1024,
        [&](int m0, int n0, const f32x4 (&acc)[4][4]) { epi_resid_f32(a, li, m0, n0, acc); });
}

DI void phase_ml_in(const Args& a) {
    bf16_t* Qm = (bf16_t*)(a.ws + ML_Q); bf16_t* Km = (bf16_t*)(a.ws + ML_K); bf16_t* VT = (bf16_t*)(a.ws + ML_VT);
    bf16_t* OG = (bf16_t*)(a.ws + ML_OG); float* GT = (float*)(a.ws + ML_GT);
    const float* gb = a.in[23];
    auto ident = [](int, int, const f32x4 v) { return v; };
    gemm_dense_phase<false>((const bf16_t*)(a.ws + WS_H), D, NTOK, (const bf16_t*)(a.ws + W_MLIN), 3200, 1024,
        [&](int m0, int n0, const f32x4 (&acc)[4][4]) {
            if (n0 < 512) {
                epi_bf16_rowmajor(acc, [](int, int, const f32x4 v) { return v * 0.08838834764831845f; }, [&](int row) { return Qm + (size_t)(m0 + row) * 512 + n0; });
            } else if (n0 < 1024) {
                epi_bf16_rowmajor(acc, ident, [&](int row) { return Km + (size_t)(m0 + row) * 512 + (n0 - 512); });
            } else if (n0 < 2048) {
                __syncthreads();
                epi_stage_bf16_T(acc, ident);
                __syncthreads();
                epi_flush_bf16([&](int row) { return VT + (size_t)(n0 - 1024 + row) * NTOK + m0; }, [](int) { return true; });
            } else if (n0 < 3072) {
                epi_bf16_rowmajor(acc, [](int, int, const f32x4 v) { f32x4 s; s[0] = sigmoidf_(v[0]); s[1] = sigmoidf_(v[1]); s[2] = sigmoidf_(v[2]); s[3] = sigmoidf_(v[3]); return s; },
                                  [&](int row) { return OG + (size_t)(m0 + row) * D + (n0 - 2048); });
            } else {
#pragma unroll
                for (int i = 0; i < 4; ++i) {
                    const int n = lane_n(0);
                    if (n < 16) { f32x4 s = acc[i][0]; s[0] += gb[n]; s[1] += gb[n + 1]; s[2] += gb[n + 2]; s[3] += gb[n + 3]; *(f32x4*)(GT + (size_t)(m0 + lane_m(i)) * 16 + n) = s; }
                }
            }
        });
}

template <int VAR = 0>
DI void phase_ml_scan(const Args& a) {
    const int tid = threadIdx.x, lane = tid & 63, wave = tid >> 6;
    const int fr = lane & 15, fq = lane >> 4;
    const bf16_t* Qm = (const bf16_t*)(a.ws + ML_Q); const bf16_t* Km = (const bf16_t*)(a.ws + ML_K);
    const bf16_t* VT = (const bf16_t*)(a.ws + ML_VT);
    const float* GT = (const float*)(a.ws + ML_GT);
    bf16_t* HS = (bf16_t*)(a.ws + (VAR ? WS_Y : ML_HS));
    char* sQ = lds;
    char* sK = lds + 16384;
    char* sS = lds + 32768;
    char* sVT = lds + 40960;
    char* sCT = lds + 47104;
    float* sRow = (float*)(lds + 59392);
    float* sCol = sRow + 64;
    float* sInt = sCol + 64;
    float* sNrm = sInt + 64;
    float* sWv = sNrm + 64;
    float* sSc = sWv + 64;
    for (int u = blockIdx.x; u < 512; u += gridDim.x) {
        const int xc_ = u & 7, s_ = u >> 3, bh_ = ((s_ >> 4) << 3) + xc_;
        const int sl = s_ & 7, dir = (s_ >> 3) & 1, head = bh_ & 3, b = bh_ >> 2;
        auto chunk_t0 = [&](int ci) {
            const int seg = ci >= 4, L = seg ? SEQ : CTXL, nch = L / 64, jc = seg ? ci - 4 : ci;
            const int oc = dir ? nch - 1 - jc : jc;
            return (seg ? b * SEQ : NLAT + b * CTXL) + oc * 64;
        };
        u32x4 pq[4], pk[4], pvt;
        float g_bc = 0.f, g_av = 0.f, g_pm = 0.f;
        auto load_tiles = [&](int t0) {
            const int tid = opaque_tid();
#pragma unroll
            for (int i = 0; i < 4; ++i) {
                const int idx = tid + i * NTHR, row = idx >> 4, c = (idx & 15) ^ (row & 15), ck = (idx & 15) ^ trswz(row);
                pq[i] = *(const u32x4*)(Qm + (size_t)(t0 + row) * 512 + head * 128 + c * 8);
                pk[i] = *(const u32x4*)(Km + (size_t)(t0 + row) * 512 + head * 128 + ck * 8);
            }
            { const int row = tid >> 3, c = (tid & 7) ^ (row & 7); pvt = *(const u32x4*)(VT + (size_t)(head * 256 + sl * 32 + row) * NTOK + t0 + c * 8); }
        };
        auto load_gates = [&](int ci) {
            if (wave == 0) { const float* g = (const float*)(a.ws + WS_GS) + ((size_t)u * 36 + ci) * 192 + lane; g_bc = g[0]; g_av = g[64]; g_pm = g[128]; }
        };
        auto store_tiles = [&]() {
            const int tid = opaque_tid();
#pragma unroll
            for (int i = 0; i < 4; ++i) { *(u32x4*)(sQ + (tid + i * NTHR) * 16) = pq[i]; *(u32x4*)(sK + (tid + i * NTHR) * 16) = pk[i]; }
            *(u32x4*)(sVT + tid * 16) = pvt;
        };
        auto gate_scalars = [&]() {
            const int s = dir ? 63 - lane : lane;
            const float bc = g_bc, av = g_av, pm = g_pm;
            const float mst = sSc[1];
            const float mm = fmaxf(mst, pm);
            sRow[s] = -mm;
            sCol[s] = av;
            sInt[s] = fexp(mst - mm);
            sNrm[s] = fexp(-(bc + mm));
            const float mmL = __shfl(mm, 63), bL = __shfl(bc, 63);
            sWv[s] = fexp(av - mmL);
            if (lane == 0) { sSc[0] = fexp(mst - mmL); sSc[1] = bL + mmL; }
        };
#pragma unroll 1
        for (int ci = wave; ci < 36; ci += 4) {
            const int t0 = chunk_t0(ci);
            const int s = dir ? 63 - lane : lane;
            const float ig = GT[(size_t)(t0 + s) * 16 + dir * 8 + head];
            const float fg = GT[(size_t)(t0 + s) * 16 + dir * 8 + 4 + head];
            const float lf = fminf(fg, 0.f) - __logf(1.f + fexp(-fabsf(fg)));
            float bc = lf;
#pragma unroll
            for (int d = 1; d < 64; d <<= 1) { const float o = __shfl_up(bc, d); if (lane >= d) bc += o; }
            const float av = ig - bc;
            float pm = av;
#pragma unroll
            for (int d = 1; d < 64; d <<= 1) { const float o = __shfl_up(pm, d); if (lane >= d) pm = fmaxf(pm, o); }
            float* g = (float*)(a.ws + WS_GS) + ((size_t)u * 36 + ci) * 192 + lane; g[0] = bc; g[64] = av; g[128] = pm;
        }
        __syncthreads();
        for (int i = tid; i < 12288 / 16; i += NTHR) *(u32x4*)(sCT + i * 16) = (u32x4){0u, 0u, 0u, 0u};
        for (int i = tid; i < 16 * 8; i += NTHR) {
            const int row = 32 + (i >> 3), c = i & 7;
            const unsigned v = row == 32 ? 0x3f803f80u : 0u;
            *(u32x4*)(sVT + swz128(row, c)) = (u32x4){v, v, v, v};
        }
        if (tid == 0) sSc[1] = -1e30f;
        f32x4 accC[2][3];
#pragma unroll
        for (int i = 0; i < 2; ++i)
#pragma unroll
            for (int jn = 0; jn < 3; ++jn) accC[i][jn] = (f32x4){0.f, 0.f, 0.f, 0.f};
        load_tiles(chunk_t0(0));
        __syncthreads();
        load_gates(0);
        store_tiles();
        if (wave == 0) gate_scalars();
        __syncthreads();
#pragma unroll 1
        for (int ci = 0; ci < 36; ++ci) {
            const int t0 = chunk_t0(ci);
            if (!(VAR & 8) && ci + 1 < 36) { load_tiles(chunk_t0(ci + 1)); load_gates(ci + 1); }
            f32x4 sacc[4];
#pragma unroll
            for (int jt = 0; jt < 4; ++jt) sacc[jt] = (f32x4){0.f, 0.f, 0.f, 0.f};
#pragma unroll
            for (int kk = 0; kk < 4; ++kk) {
                const bf16x8 qf = ldsv8(sQ + swz256(wave * 16 + fr, kk * 4 + fq));
#pragma unroll
                for (int jt = 0; jt < 4; ++jt) { const int sr = jt * 16 + fr; sacc[jt] = mfma16(ldsv8(sK + sr * 256 + (((kk * 4 + fq) ^ trswz(sr)) << 4)), qf, sacc[jt]); }
            }
            {
                const int tq = wave * 16 + fr;
                const float rt = sRow[tq];
#pragma unroll
                for (int jt = 0; jt < 4; ++jt) {
                    const f32x4 cl = *(const f32x4*)(sCol + jt * 16 + fq * 4);
                    f32x4 v;
#pragma unroll
                    for (int e = 0; e < 4; ++e) {
                        const int s = jt * 16 + fq * 4 + e;
                        const bool ok = dir ? (s >= tq) : (s <= tq);
                        v[e] = ok ? sacc[jt][e] * fexp(rt + cl[e]) : 0.f;
                    }
                    u32x2 pv; pv[0] = pk2(v[0], v[1]); pv[1] = pk2(v[2], v[3]);
                    *(u32x2*)(sS + swz128(tq, jt * 2 + (fq >> 1)) + (fq & 1) * 8) = pv;
                }
            }
            lds_barrier();
            if (!(VAR & 2)) {
                f32x4 n1[3], n2[3];
#pragma unroll
                for (int jt = 0; jt < 3; ++jt) { n1[jt] = (f32x4){0.f, 0.f, 0.f, 0.f}; n2[jt] = (f32x4){0.f, 0.f, 0.f, 0.f}; }
#pragma unroll
                for (int kk = 0; kk < 2; ++kk) {
                    const bf16x8 sf = ldsv8(sS + swz128(wave * 16 + fr, kk * 4 + fq));
#pragma unroll
                    for (int jt = 0; jt < 3; ++jt) n1[jt] = mfma16(ldsv8(sVT + swz128(jt * 16 + fr, kk * 4 + fq)), sf, n1[jt]);
                }
#pragma unroll
                for (int kk = 0; kk < 4; ++kk) {
                    const bf16x8 qf = ldsv8(sQ + swz256(wave * 16 + fr, kk * 4 + fq));
#pragma unroll
                    for (int jt = 0; jt < 3; ++jt) n2[jt] = mfma16(ldsv8(sCT + swz256(jt * 16 + fr, kk * 4 + fq)), qf, n2[jt]);
                }
                const int tq = wave * 16 + fr;
                const float it = sInt[tq];
                float den = n1[2][0] + it * n2[2][0];
                den = __shfl(den, fr);
                const float dn = fmaxf(fabsf(den), sNrm[tq]);
                const float inv = rcpf_(dn);
                bf16_t* hp = HS + (size_t)dir * NTOK * D + (size_t)(t0 + tq) * D + head * 256 + sl * 32 + fq * 4;
#pragma unroll
                for (int jt = 0; jt < 2; ++jt) {
                    f32x4 v;
#pragma unroll
                    for (int e = 0; e < 4; ++e) v[e] = (n1[jt][e] + it * n2[jt][e]) * inv;
                    st_bf4(hp + jt * 16, v);
                }
            }
            if (!(VAR & 4)) {
                const float decay = sSc[0];
#pragma unroll
                for (int i = 0; i < 2; ++i)
#pragma unroll
                    for (int jn = 0; jn < 3; ++jn) accC[i][jn] *= decay;
#pragma unroll
                for (int kk = 0; kk < 2; ++kk) {
                    bf16x8 vf[3];
#pragma unroll
                    for (int jn = 0; jn < 3; ++jn) vf[jn] = ldsv8(sVT + swz128(jn * 16 + fr, kk * 4 + fq));
                    const f32x4 w0 = *(const f32x4*)(sWv + kk * 32 + fq * 8), w1 = *(const f32x4*)(sWv + kk * 32 + fq * 8 + 4);
#pragma unroll
                    for (int i = 0; i < 2; ++i) {
                        const int tq_ = (lane >> 2) & 3, tp_ = lane & 3, chd = (wave * 2 + i) * 2 + (tp_ >> 1);
                        const int sA_ = kk * 32 + 8 * fq + tq_, sB_ = sA_ + 4;
                        const s16x4 klo = lds_tr(sK + sA_ * 256 + ((chd ^ trswz(sA_)) << 4) + (tp_ & 1) * 8);
                        const s16x4 khi = lds_tr(sK + sB_ * 256 + ((chd ^ trswz(sB_)) << 4) + (tp_ & 1) * 8);
                        const u32x4 kr = __builtin_bit_cast(u32x4, __builtin_shufflevector(klo, khi, 0, 1, 2, 3, 4, 5, 6, 7));
                        u32x4 ks;
                        ks[0] = pk2(lof(kr[0]) * w0[0], hif(kr[0]) * w0[1]); ks[1] = pk2(lof(kr[1]) * w0[2], hif(kr[1]) * w0[3]);
                        ks[2] = pk2(lof(kr[2]) * w1[0], hif(kr[2]) * w1[1]); ks[3] = pk2(lof(kr[3]) * w1[2], hif(kr[3]) * w1[3]);
                        const bf16x8 kf = __builtin_bit_cast(bf16x8, ks);
#pragma unroll
                        for (int jn = 0; jn < 3; ++jn) accC[i][jn] = mfma16(kf, vf[jn], accC[i][jn]);
                    }
                }
            }
            lds_barrier();
#pragma unroll
            for (int i = 0; i < 2; ++i)
#pragma unroll
                for (int jn = 0; jn < 3; ++jn) {
                    const int dd = (wave * 2 + i) * 16 + fq * 4, ee = jn * 16 + fr;
                    u32x2 pv; pv[0] = pk2(accC[i][jn][0], accC[i][jn][1]); pv[1] = pk2(accC[i][jn][2], accC[i][jn][3]);
                    *(u32x2*)(sCT + swz256(ee, dd >> 3) + (dd & 7) * 2) = pv;
                }
            if (ci + 1 < 36) {
                if (!(VAR & 8)) store_tiles();
                if (wave == 0 && !(VAR & 16)) gate_scalars();
            }
            lds_barrier();
        }
    }
}

DI void phase_ml_readout(const Args& a) {
    const int tid = threadIdx.x, lane = tid & 63, wave = tid >> 6;
    const bf16_t* H0 = (const bf16_t*)(a.ws + ML_HS); const bf16_t* H1 = H0 + (size_t)NTOK * D;
    const bf16_t* OG = (const bf16_t*)(a.ws + ML_OG); bf16_t* A2 = (bf16_t*)(a.ws + ML_A2);
    const float* on = a.in[24];
    for (int t = blockIdx.x * 4 + wave; t < NTOK; t += gridDim.x * 4) {
        const size_t off = (size_t)t * D + lane * 16;
        const u32x4 a0 = *(const u32x4*)(H0 + off), a1 = *(const u32x4*)(H0 + off + 8);
        const u32x4 b0 = *(const u32x4*)(H1 + off), b1 = *(const u32x4*)(H1 + off + 8);
        float v[16];
#pragma unroll
        for (int e = 0; e < 4; ++e) {
            v[2 * e] = lof(a0[e]) + lof(b0[e]); v[2 * e + 1] = hif(a0[e]) + hif(b0[e]);
            v[8 + 2 * e] = lof(a1[e]) + lof(b1[e]); v[8 + 2 * e + 1] = hif(a1[e]) + hif(b1[e]);
        }
        float ss = 0.f;
#pragma unroll
        for (int e = 0; e < 16; ++e) ss += v[e] * v[e];
        ss += __shfl_xor(ss, 1); ss += __shfl_xor(ss, 2); ss += __shfl_xor(ss, 4); ss += __shfl_xor(ss, 8);
        const float rs = rsqrtf(ss * (1.f / 256.f) + EPS);
        const u32x4 g0 = *(const u32x4*)(OG + off), g1 = *(const u32x4*)(OG + off + 8);
        const float* onp = on + lane * 16;
        u32x4 o0, o1;
#pragma unroll
        for (int e = 0; e < 4; ++e) {
            o0[e] = pk2(v[2 * e] * rs * onp[2 * e] * lof(g0[e]), v[2 * e + 1] * rs * onp[2 * e + 1] * hif(g0[e]));
            o1[e] = pk2(v[8 + 2 * e] * rs * onp[8 + 2 * e] * lof(g1[e]), v[8 + 2 * e + 1] * rs * onp[8 + 2 * e + 1] * hif(g1[e]));
        }
        *(u32x4*)(A2 + off) = o0; *(u32x4*)(A2 + off + 8) = o1;
    }
}

DI void phase_ml_out(const Args& a, int li) {
    gemm_dense_phase((const bf16_t*)(a.ws + ML_A2), D, NTOK, (const bf16_t*)(a.ws + W_MLOUT), 1024, 1024,
        [&](int m0, int n0, const f32x4 (&acc)[4][4]) { epi_resid_f32(a, li, m0, n0, acc); });
}

template <int STAGE>
DI void phase_moe(const Args& a, int li) {
    const int tid = threadIdx.x, lane = tid & 63, wave = tid >> 6;
    const int fr = lane & 15, fq = lane >> 4, wm = wave >> 1, wn = wave & 1;
    const int* cnt = (const int*)(a.ws + WS_CTL + CTL_CNT) + li * 64;
    const int* list = (const int*)(a.ws + WS_LIST);
    const float* wsl = (const float*)(a.ws + WS_WSLOT);
    const bf16_t* F = (const bf16_t*)(a.ws + WS_H);
    bf16_t* HM = (bf16_t*)(a.ws + WS_HMID); bf16_t* Y = (bf16_t*)(a.ws + WS_Y);
    int* pre = (int*)(lds + LDS_AUX);
    int* srowb = pre + 16;
    const int xc = blockIdx.x & 7, rank = blockIdx.x >> 3, nrank = gridDim.x >> 3;
    __syncthreads();
    if (tid == 0) { int s = 0; for (int i = 0; i < 8; ++i) { pre[i] = s; s += (cnt[xc + 8 * i] + 127) >> 7; } pre[8] = s; }
    __syncthreads();
    const int T = pre[8];
    constexpr int NTN = STAGE == 0 ? 4 : 8;
    constexpr int KK = STAGE == 0 ? 1024 : 256;
    const int total = T * NTN;
    int e = 0, r0 = 0, ce = 0, nt = 0, cur = 0;
    auto decode = [&](int u) {
        const int ti = u / NTN; nt = u % NTN;
        int ei = 0;
#pragma unroll 1
        for (int s = 4; s > 0; s >>= 1) if (pre[ei + s] <= ti) ei += s;
        e = xc + 8 * ei; r0 = (ti - pre[ei]) * 128; ce = cnt[e];
    };
    GemmPipe g;
    auto prep = [&](int buf) {
        int* srow = srowb + buf * 128;
        if (tid < 128) srow[tid] = list[(size_t)e * NTOK + min(r0 + tid, ce - 1)];
        __syncthreads();
        if (STAGE == 0) g.setup([&](int r) { return F + (size_t)(srow[r] >> 1) * D; }, (const bf16_t*)(a.ws + W_GU) + ((size_t)(li * 64 + e) * 512 + nt * 128) * 1024, 1024);
        else g.setup([&](int r) { return HM + (size_t)srow[r] * 256; }, (const bf16_t*)(a.ws + W_DN) + ((size_t)(li * 64 + e) * 1024 + nt * 128) * 256, 256);
        g.issue(0, 0);
    };
    int u = rank;
    if (u < total) { decode(u); prep(cur); }
    while (u < total) {
        f32x4 acc[4][4];
        g.run(KK, acc);
        const int cr0 = r0, cce = ce, cnt_ = nt;
        const int* srow = srowb + cur * 128;
        u += nrank;
        if (u < total) { decode(u); prep(cur ^ 1); }
        if (STAGE == 0) {
            __syncthreads();
            {
                const int tz = opaque_tid();
#pragma unroll
                for (int i = 0; i < 4; ++i) {
                    const int m = lane_m(tz, i);
#pragma unroll
                    for (int p = 0; p < 2; ++p) {
                        const int c = (((tz >> 6) & 1) * 2 + p) * 16 + ((tz >> 4) & 3) * 4;
                        f32x4 v;
#pragma unroll
                        for (int x = 0; x < 4; ++x) { const float gg = acc[i][2 * p][x]; v[x] = gg * rcpf_(1.f + fexp(-gg)) * acc[i][2 * p + 1][x]; }
                        u32x2 o; o[0] = pk2(v[0], v[1]); o[1] = pk2(v[2], v[3]);
                        *(u32x2*)(lds + EPI_OFF + m * 128 + (((c >> 3) ^ (m & 7)) << 4) + (c & 4) * 2) = o;
                    }
                }
            }
            __syncthreads();
            {
                const int tz = opaque_tid();
#pragma unroll
                for (int it = 0; it < 4; ++it) {
                    const int idx = tz + it * NTHR, row = idx >> 3, ch = idx & 7;
                    const u32x4 v = *(const u32x4*)(lds + EPI_OFF + row * 128 + ((ch ^ (row & 7)) << 4));
                    if (cr0 + row < cce) *(u32x4*)(HM + (size_t)srow[row] * 256 + cnt_ * 64 + ch * 8) = v;
                }
            }
        } else {
            float wrow[4];
            {
                const int tz = opaque_tid();
#pragma unroll
                for (int i = 0; i < 4; ++i) wrow[i] = wsl[srow[lane_m(tz, i)]];
            }
            __syncthreads();
            epi_stage_bf16(acc, [&](int i, int, const f32x4 v) { return v * wrow[i]; });
            __syncthreads();
            epi_flush_bf16([&](int row) { return Y + (size_t)srow[row] * D + cnt_ * 128; }, [&](int row) { return cr0 + row < cce; });
        }
        cur ^= 1;
    }
    __syncthreads();
}

#ifndef DBG_GPROBE
#define DBG_GPROBE -1
#endif
template <int PM>
DI void phase_gemm_probe(const Args& a) {
    const bf16_t* A = (const bf16_t*)(a.ws + WS_H); const bf16_t* Bt = (const bf16_t*)(a.ws + W_RGIN);
    float* dummy = (float*)(a.ws + RG_A2);
    const int mt = 144, nt = 16, K = 1024;
    GemmPipe g;
    __syncthreads();
    for (int u = blockIdx.x; u < mt * nt; u += gridDim.x) {
        const int m0 = (u % mt) * 128, n0 = (u / mt) * 128;
        g.setup([&](int r) { return A + (size_t)(m0 + r) * 1024; }, Bt + (size_t)n0 * K, K);
        if (PM & 1) g.issue(0, 0);
        f32x4 acc[4][4];
        g.run_probe<PM>(K, acc);
        float s = 0.f;
#pragma unroll
        for (int i = 0; i < 4; ++i)
#pragma unroll
            for (int j = 0; j < 4; ++j) s += acc[i][j][0] + acc[i][j][1] + acc[i][j][2] + acc[i][j][3];
        if (s == 12345.678f) dummy[threadIdx.x] = s;
        if (PM & 8) {
            bf16_t* Yd = (bf16_t*)(a.ws + WS_Y);
            const int lane = threadIdx.x & 63, wave = threadIdx.x >> 6;
            const int mb = m0 + (wave >> 1) * 64 + (lane & 15), nb = n0 + (wave & 1) * 64 + (lane >> 4) * 4;
#pragma unroll
            for (int i = 0; i < 4; ++i)
#pragma unroll
                for (int j = 0; j < 4; ++j) {
                    f32x4 v = acc[i][j];
                    if (PM & 16) { v[0] = gelu_tanh(v[0]); v[1] = gelu_tanh(v[1]); v[2] = gelu_tanh(v[2]); v[3] = gelu_tanh(v[3]); }
                    st_bf4(Yd + (size_t)(mb + i * 16) * 2048 + nb + j * 16, v);
                }
        }
        __syncthreads();
    }
}

#ifndef DBG_STOP
#define DBG_STOP 99
#endif
#ifndef DBG_OFF
#define DBG_OFF 0
#endif
DI void phase_dbg(const Args& a) {
    const size_t n = (size_t)NLAT * D;
    const float* X = (const float*)(a.ws + WS_X);
    const bf16_t* B = (const bf16_t*)(a.ws + (size_t)DBG_OFF);
    for (size_t i = (size_t)blockIdx.x * NTHR + threadIdx.x; i < n; i += (size_t)gridDim.x * NTHR)
        a.out[i] = DBG_OFF ? bf2f(B[i]) : X[i];
}

constexpr int NPH = 34;
__global__ void __launch_bounds__(NTHR, 2) fwd(const Args a) {
    if (threadIdx.x == 0) *(uint4*)(lds + LDS_BARW) = make_uint4(0u, 0u, 0u, 0u);
    __syncthreads();
    XcdBarrier bar;
    const bool multi = (a.ph_hi - a.ph_lo) > 1;
    if (multi) bar = xcd_barrier_post((unsigned*)(a.ws + WS_CTL), (volatile LAS unsigned*)(lds + LDS_BARW));
#ifndef DBG_REP
#define DBG_REP -1
#endif
#ifndef DBG_REPN
#define DBG_REPN 3
#endif
#define RUN(id, ...) do { if (a.ph_lo <= (id) && (id) < a.ph_hi) { \
        if ((id) == DBG_REP) { for (int rep_ = 1; rep_ < DBG_REPN; ++rep_) { __VA_ARGS__; xcd_barrier(bar); } } \
        __VA_ARGS__; if ((id) + 1 < a.ph_hi) xcd_barrier(bar); } } while (0)
    RUN(0, phase_prologue(a));
    RUN(1, phase_token_row<0>(a, 0));
    RUN(2, phase_rg_in(a, 0));
    if (DBG_GPROBE >= 0) { RUN(2, phase_gemm_probe<(DBG_GPROBE < 0 ? 7 : DBG_GPROBE)>(a)); }
#ifdef DBG_SCANVAR
    RUN(3, phase_rg_scan<DBG_SCANVAR>(a, 0));
#endif
    RUN(3, phase_rg_scan(a, 0));
    RUN(4, phase_rg_combine(a));
    RUN(5, phase_rg_out(a, 0, 0));
    RUN(6, phase_token_router<36>(a, 0));
#ifdef DBG_T2DRY
    RUN(6, phase_token_router<36>(a, 0, true));
    RUN(6, phase_token_router<36>(a, 0, true));
#endif
    RUN(7, phase_moe<0>(a, 0));
    RUN(8, phase_moe<1>(a, 0));
    RUN(9, phase_token_row<0>(a, 1));
    RUN(10, phase_mla_down(a));
    RUN(11, phase_mla_up(a));
    RUN(12, phase_mla_attn(a));
    RUN(13, phase_mla_out(a, 1));
    RUN(14, phase_token_router<36>(a, 1));
    RUN(15, phase_moe<0>(a, 1));
    RUN(16, phase_moe<1>(a, 1));
    RUN(17, phase_token_row<0>(a, 2));
    RUN(18, phase_ml_in(a));
#ifdef DBG_MLVAR
    RUN(19, phase_ml_scan<DBG_MLVAR>(a));
#endif
    RUN(19, phase_ml_scan(a));
    RUN(20, phase_ml_readout(a));
    RUN(21, phase_ml_out(a, 2));
    RUN(22, phase_token_router<36>(a, 2));
    RUN(23, phase_moe<0>(a, 2));
    RUN(24, phase_moe<1>(a, 2));
    RUN(25, phase_token_row<0>(a, 3));
    RUN(26, phase_rg_in(a, 1));
    RUN(27, phase_rg_scan(a, 1));
    RUN(28, phase_rg_combine(a));
    RUN(29, phase_rg_out(a, 3, 1));
    RUN(30, phase_token_router<32>(a, 3));
    RUN(31, phase_moe<0>(a, 3));
    RUN(32, phase_moe<1>(a, 3));
    RUN(33, phase_token_row<2>(a, 3));
    RUN(34, phase_dbg(a));
#undef RUN
}

static void add_td(Args& a, int& n, int& tile0, const float* src, bf16_t* dst, const float* rscale, long sb, long db, int K, int N, int Npad, int batch, int perm) {
    TDesc& t = a.td[n++];
    t.src = src; t.dst = dst; t.rscale = rscale; t.sb = sb; t.db = db; t.K = K; t.N = N; t.Npad = Npad; t.batch = batch; t.perm = perm;
    t.tiles_k = (K + 127) / 128; t.tiles_n = (Npad + 63) / 64; t.tile0 = tile0;
    tile0 += batch * t.tiles_k * t.tiles_n;
}

extern "C" void kernel_launch(void* const* d_in, const int* in_sizes, int n_in, void* d_out, int out_size, void* d_ws, size_t ws_size, hipStream_t stream) {
    static int grid = 0;
    if (grid == 0) {
        if (n_in != 32 || out_size != NLAT * D || ws_size < WS_END) { fprintf(stderr, "kernel_launch: unexpected sizes (n_in %d out %d ws %zu need %zu)\n", n_in, out_size, ws_size, (size_t)WS_END); grid = -1; return; }
        int dev = 0, cus = 0, per_cu = 0;
        (void)hipGetDevice(&dev);
        (void)hipDeviceGetAttribute(&cus, hipDeviceAttributeMultiprocessorCount, dev);
        if (hipOccupancyMaxActiveBlocksPerMultiprocessor(&per_cu, (const void*)fwd, NTHR, 0) != hipSuccess) per_cu = 0;
        (void)hipGetLastError();
        if (per_cu < 2) fprintf(stderr, "kernel_launch: note: occupancy query reports %d blocks per CU (need 2)\n", per_cu);
        grid = cus * (per_cu >= 2 ? 2 : (per_cu >= 1 ? 1 : 2));
    }
    if (grid < 0) return;
    (void)in_sizes;
    (void)hipMemsetAsync((char*)d_ws + WS_CTL, 0, CTL_BYTES, stream);
    Args a;
    memset(&a, 0, sizeof(a));
    for (int i = 0; i < 32; ++i) a.in[i] = (const float*)d_in[i];
    a.out = (float*)d_out; a.ws = (unsigned char*)d_ws;
    unsigned char* ws = (unsigned char*)d_ws;
    int n = 0, tile0 = 0;
    add_td(a, n, tile0, a.in[8], (bf16_t*)(ws + W_RGIN), nullptr, 1024L * 2048, 2048L * 1024, 1024, 2048, 2048, 2, 0);
    add_td(a, n, tile0, a.in[14], (bf16_t*)(ws + W_RGOUT), nullptr, 1024L * 1024, 1024L * 1024, 1024, 1024, 1024, 2, 0);
    for (int j = 0; j < 2; ++j) for (int dir = 0; dir < 2; ++dir) for (int g = 0; g < 2; ++g)
        add_td(a, n, tile0, a.in[11] + (size_t)((j * 2 + dir) * 2 + g) * 16 * 4096, (bf16_t*)(ws + W_RGG) + (size_t)(j * 2 + dir) * 16 * 8192 + g * 4096, nullptr, 4096, 8192, 64, 64, 64, 16, 0);
    add_td(a, n, tile0, a.in[15], (bf16_t*)(ws + W_MDOWN), nullptr, 0, 0, 1024, 416, 512, 1, 0);
    add_td(a, n, tile0, a.in[18], (bf16_t*)(ws + W_MUQ), a.in[16], 0, 0, 256, 1536, 1536, 1, 0);
    add_td(a, n, tile0, a.in[19], (bf16_t*)(ws + W_MUKV), a.in[17], 0, 0, 128, 2048, 2048, 1, 0);
    add_td(a, n, tile0, a.in[21], (bf16_t*)(ws + W_MO), nullptr, 0, 0, 1024, 1024, 1024, 1, 0);
    add_td(a, n, tile0, a.in[22], (bf16_t*)(ws + W_MLIN), nullptr, 0, 0, 1024, 3088, 3200, 1, 0);
    add_td(a, n, tile0, a.in[25], (bf16_t*)(ws + W_MLOUT), nullptr, 0, 0, 1024, 1024, 1024, 1, 0);
    add_td(a, n, tile0, a.in[30], (bf16_t*)(ws + W_GU), nullptr, 1024L * 512, 512L * 1024, 1024, 512, 512, 64, 1);
    add_td(a, n, tile0, a.in[31], (bf16_t*)(ws + W_DN), nullptr, 256L * 1024, 1024L * 256, 256, 1024, 1024, 64, 0);
    a.ntiles_total = tile0;
    if (n != NTD) { fprintf(stderr, "kernel_launch: descriptor count %d != %d\n", n, NTD); return; }
#if MK_ONE_LAUNCH
    a.ph_lo = 0; a.ph_hi = NPH;
    hipLaunchKernelGGL(fwd, dim3(grid), dim3(NTHR), 0, stream, a);
#else
    for (int ph = 0; ph < NPH && ph <= DBG_STOP; ++ph) {
        a.ph_lo = ph; a.ph_hi = ph + 1;
        hipLaunchKernelGGL(fwd, dim3(grid), dim3(NTHR), 0, stream, a);
    }
    if (DBG_STOP < NPH) { a.ph_lo = 34; a.ph_hi = 35; hipLaunchKernelGGL(fwd, dim3(grid), dim3(NTHR), 0, stream, a); }
#endif
}
```

```cpp
#include <hip/hip_runtime.h>
#include <stdint.h>
#include <string.h>
#include <stdio.h>

#ifndef MK_ONE_LAUNCH
#define MK_ONE_LAUNCH 1
#endif

#define DI __device__ __forceinline__
typedef unsigned short bf16_t;
typedef __attribute__((ext_vector_type(8))) short bf16x8;
typedef __attribute__((ext_vector_type(4))) float f32x4;
typedef __attribute__((ext_vector_type(16))) float f32x16;
typedef __attribute__((ext_vector_type(2))) float f32x2;
typedef __attribute__((ext_vector_type(2))) __bf16 bfx2;
typedef __attribute__((ext_vector_type(4))) unsigned u32x4;
typedef __attribute__((ext_vector_type(2))) unsigned u32x2;

constexpr int D = 1024, NB = 8, SEQ = 2048, CTXL = 256;
constexpr int NLAT = NB * SEQ, NCTX = NB * CTXL, NTOK = NLAT + NCTX;
constexpr int NKEY = CTXL + SEQ;
constexpr int NTHR = 256;
constexpr int LDS_BYTES = 74752;
constexpr int LDS_AUX = 65536;
constexpr int LDS_BARW = LDS_BYTES - 16;
constexpr float EPS = 1e-6f;

constexpr size_t al256(size_t x) { return (x + 255) & ~(size_t)255; }
constexpr size_t WS_CTL = 0;
constexpr size_t CTL_BYTES = 65536;
constexpr size_t CTL_CNT = 16384;
constexpr size_t CTL_ROPE = 32768;
constexpr size_t WS_MOD = WS_CTL + CTL_BYTES;
constexpr size_t WS_X = al256(WS_MOD + 4 * 9 * 6144 * 4);
constexpr size_t WS_H = al256(WS_X + (size_t)NTOK * D * 4);
constexpr size_t WS_SCR = al256(WS_H + (size_t)NTOK * D * 2);
constexpr size_t SCR_BYTES = (size_t)256 << 20;
constexpr size_t TOKD2 = (size_t)NTOK * D * 2;
constexpr size_t RG_G = WS_SCR, RG_U = RG_G + TOKD2, RG_HS = RG_U + TOKD2, RG_A2 = RG_HS + 2 * TOKD2;
constexpr size_t MLA_CQ = WS_SCR;
constexpr size_t MLA_CKV = MLA_CQ + (size_t)NTOK * 256 * 2;
constexpr size_t MLA_KR = MLA_CKV + (size_t)NTOK * 128 * 2;
constexpr size_t MLA_Q = MLA_KR + (size_t)NTOK * 32 * 4;
constexpr size_t MLA_K = MLA_Q + (size_t)NTOK * 1536 * 2;
constexpr size_t MLA_VT = MLA_K + (size_t)NB * 16 * NKEY * 96 * 2;
constexpr size_t MLA_O = MLA_VT + (size_t)NB * 16 * 64 * NKEY * 2;
constexpr size_t MLA_END = MLA_O + TOKD2;
constexpr size_t ML_Q = WS_SCR;
constexpr size_t ML_K = ML_Q + (size_t)NTOK * 512 * 2;
constexpr size_t ML_KT = ML_K + (size_t)NTOK * 512 * 2;
constexpr size_t ML_VT = ML_KT + (size_t)NTOK * 512 * 2;
constexpr size_t ML_OG = ML_VT + TOKD2;
constexpr size_t ML_GT = ML_OG + TOKD2;
constexpr size_t ML_HS = ML_GT + (size_t)NTOK * 16 * 4;
constexpr size_t ML_A2 = ML_HS + 2 * TOKD2;
constexpr size_t ML_END = ML_A2 + TOKD2;
static_assert(RG_A2 + TOKD2 <= WS_SCR + SCR_BYTES && MLA_END <= WS_SCR + SCR_BYTES && ML_END <= WS_SCR + SCR_BYTES, "scratch");
constexpr size_t WS_LIST = WS_SCR + SCR_BYTES;
constexpr size_t WS_WSLOT = al256(WS_LIST + (size_t)64 * NTOK * 4);
constexpr size_t WS_HMID = al256(WS_WSLOT + (size_t)2 * NTOK * 4);
constexpr size_t WS_Y = al256(WS_HMID + (size_t)2 * NTOK * 256 * 2);
constexpr size_t WS_W = al256(WS_Y + (size_t)2 * NTOK * D * 2);
constexpr size_t W_RGIN = WS_W;
constexpr size_t W_RGOUT = W_RGIN + (size_t)2 * 2048 * 1024 * 2;
constexpr size_t W_RGG = W_RGOUT + (size_t)2 * 1024 * 1024 * 2;
constexpr size_t W_MDOWN = W_RGG + (size_t)2 * 2 * 16 * 128 * 64 * 2;
constexpr size_t W_MUQ = W_MDOWN + (size_t)512 * 1024 * 2;
constexpr size_t W_MUKV = W_MUQ + (size_t)1536 * 256 * 2;
constexpr size_t W_MO = W_MUKV + (size_t)2048 * 128 * 2;
constexpr size_t W_MLIN = W_MO + (size_t)1024 * 1024 * 2;
constexpr size_t W_MLOUT = W_MLIN + (size_t)3200 * 1024 * 2;
constexpr size_t W_RT = W_MLOUT + (size_t)1024 * 1024 * 2;
constexpr size_t W_GU = al256(W_RT + (size_t)4 * 2 * 80 * 1024 * 2);
constexpr size_t W_DN = W_GU + (size_t)256 * 512 * 1024 * 2;
constexpr size_t WS_GS = W_DN + (size_t)256 * 1024 * 256 * 2;
constexpr size_t WS_END = WS_GS + (size_t)512 * 36 * 3 * 64 * 4;

struct TDesc {
    const float* src; bf16_t* dst; const float* rscale;
    long sb, db;
    int K, N, Npad, batch;
    int perm, tiles_k, tiles_n, tile0;
};
constexpr int NTD = 18;
struct Args {
    const float* in[32];
    float* out;
    unsigned char* ws;
    TDesc td[NTD];
    int ntiles_total, ph_lo, ph_hi, pad0;
};

DI float bf2f(bf16_t v) { return __uint_as_float((unsigned)v << 16); }
DI unsigned pk2(float a, float b) { f32x2 v = {a, b}; bfx2 r = __builtin_convertvector(v, bfx2); return __builtin_bit_cast(unsigned, r); }
DI bf16_t f2bf(float a) { return (bf16_t)(pk2(a, 0.f) & 0xffffu); }
DI float lof(unsigned u) { return __uint_as_float(u << 16); }
DI float hif(unsigned u) { return __uint_as_float(u & 0xffff0000u); }
DI float rcpf_(float x) { return __builtin_amdgcn_rcpf(x); }
DI float fexp(float x) { return __builtin_amdgcn_exp2f(x * 1.4426950408889634f); }
DI float sigmoidf_(float x) { return rcpf_(1.f + fexp(-x)); }
DI float gelu_tanh(float x) { float u = 0.7978845608028654f * (x + 0.044715f * x * x * x); float e = fexp(2.f * u); return x * (1.f - rcpf_(e + 1.f)); }
DI int tok_modrow(int t) { return t < NLAT ? (t >> 11) : 8; }
DI void dma16(const void* g, char* l) { __builtin_amdgcn_global_load_lds((const unsigned*)g, (unsigned*)l, 16, 0, 0); }
DI void wait_vm0() { asm volatile("s_waitcnt vmcnt(0)" ::: "memory"); }
DI void lds_barrier() { asm volatile("s_waitcnt lgkmcnt(0)" ::: "memory"); __builtin_amdgcn_s_barrier(); asm volatile("" ::: "memory"); }
DI int swz128(int row, int chunk) { return row * 128 + ((chunk ^ (row & 7)) << 4); }
DI int swz256(int row, int chunk) { return row * 256 + ((chunk ^ (row & 15)) << 4); }
DI f32x4 mfma16(bf16x8 a, bf16x8 b, f32x4 c) { return __builtin_amdgcn_mfma_f32_16x16x32_bf16(a, b, c, 0, 0, 0); }
DI f32x16 mfma32(bf16x8 a, bf16x8 b, f32x16 c) { return __builtin_amdgcn_mfma_f32_32x32x16_bf16(a, b, c, 0, 0, 0); }
DI bf16x8 ldsv8(const char* p) { return *(const bf16x8*)p; }
typedef __attribute__((ext_vector_type(8))) _Float16 f16x8;
typedef __attribute__((ext_vector_type(2))) _Float16 f16x2;
DI unsigned pkh(float a, float b) { f32x2 v = {a, b}; f16x2 r = __builtin_convertvector(v, f16x2); return __builtin_bit_cast(unsigned, r); }
DI float hlof(unsigned u) { return (float)__builtin_bit_cast(f16x2, u)[0]; }
DI float hhif(unsigned u) { return (float)__builtin_bit_cast(f16x2, u)[1]; }
DI f32x4 mfma16h(f16x8 a, f16x8 b, f32x4 c) { return __builtin_amdgcn_mfma_f32_16x16x32_f16(a, b, c, 0, 0, 0); }
DI void unpk8(const u32x4 v, f32x4& lo4, f32x4& hi4) {
    lo4[0] = lof(v[0]); lo4[1] = hif(v[0]); lo4[2] = lof(v[1]); lo4[3] = hif(v[1]);
    hi4[0] = lof(v[2]); hi4[1] = hif(v[2]); hi4[2] = lof(v[3]); hi4[3] = hif(v[3]);
}
DI u32x4 pk8(const f32x4 a, const f32x4 b) { u32x4 o; o[0] = pk2(a[0], a[1]); o[1] = pk2(a[2], a[3]); o[2] = pk2(b[0], b[1]); o[3] = pk2(b[2], b[3]); return o; }
DI void st_bf4(bf16_t* p, const f32x4 v) { u32x2 o; o[0] = pk2(v[0], v[1]); o[1] = pk2(v[2], v[3]); *(u32x2*)p = o; }

__shared__ __attribute__((aligned(16))) char lds[LDS_BYTES];

#define XB_TMO      128
#define XB_XCNT(j)  (256  + 64 * (j))
#define XB_XSUB(j)  (1280 + 64 * (j))
#define XB_XGEN(j)  (2304 + 64 * (j))
#define XB_TOP      3328
#define XB_TOPGEN   3392
#define XCD_BAR_WORDS 3456
#define XB_SPIN_CAP (1u << 22)
#define LAS __attribute__((address_space(3)))
DI unsigned xb_ld(unsigned* p)              { return __hip_atomic_load(p, __ATOMIC_RELAXED, __HIP_MEMORY_SCOPE_AGENT); }
DI unsigned xb_add(unsigned* p, unsigned v) { return __hip_atomic_fetch_add(p, v, __ATOMIC_RELAXED, __HIP_MEMORY_SCOPE_AGENT); }
DI unsigned xb_xcc_id() { return (unsigned)__builtin_amdgcn_s_getreg((3 << 11) | 20) & 0xFu; }
#define XB_SPIN(cond, bar) do { unsigned _sp = 0; while (cond) { __builtin_amdgcn_s_sleep(1); \
    if ((++_sp & 255u) == 0u) { if (xb_ld(&(bar)[XB_TMO])) break; if (_sp > XB_SPIN_CAP) { atomicAdd(&(bar)[XB_TMO], 1u); break; } } } } while (0)
struct XcdBarrier { unsigned* bar; unsigned x; volatile LAS unsigned* st; };
DI XcdBarrier xcd_barrier_post(unsigned* bar, volatile LAS unsigned* st) {
    XcdBarrier b; b.bar = bar; b.x = xb_xcc_id(); b.st = st;
    if (threadIdx.x == 0) (void)xb_add(&bar[XB_XCNT(b.x)], 1u);
    return b;
}
DI void xcd_barrier_complete(unsigned* bar, unsigned x, unsigned& nloc, unsigned& nx) {
    const unsigned G = gridDim.x * gridDim.y * gridDim.z;
    unsigned sum, cnt, mine, sp = 0u;
    for (;;) {
        sum = 0u; cnt = 0u; mine = 0u;
#pragma unroll
        for (unsigned j = 0; j < 16; ++j) { const unsigned c = xb_ld(&bar[XB_XCNT(j)]); sum += c; cnt += (c > 0u) ? 1u : 0u; mine = (j == x) ? c : mine; }
        if (sum == G) break;
        __builtin_amdgcn_s_sleep(1);
        if ((++sp & 255u) == 0u) { if (xb_ld(&bar[XB_TMO])) break; if (sp > XB_SPIN_CAP) { atomicAdd(&bar[XB_TMO], 1u); break; } }
    }
    nloc = mine > 0u ? mine : 1u; nx = cnt > 0u ? cnt : 1u;
}
DI void xcd_barrier(const XcdBarrier& b) {
    asm volatile("s_waitcnt vmcnt(0)" ::: "memory");
    __syncthreads();
    if (threadIdx.x == 0) {
        unsigned* bar = b.bar;
        __builtin_amdgcn_s_waitcnt(0);
        unsigned nloc = b.st[0], nx = b.st[1];
        if (nloc == 0u) { xcd_barrier_complete(bar, b.x, nloc, nx); b.st[0] = nloc; b.st[1] = nx; }
        const unsigned old = xb_add(&bar[XB_XSUB(b.x)], 1u);
        const unsigned gen = old / nloc;
        if (old + 1u == (gen + 1u) * nloc) {
            __builtin_amdgcn_fence(__ATOMIC_RELEASE, "agent");
            asm volatile("s_waitcnt vmcnt(0)" ::: "memory");
            const unsigned og = xb_add(&bar[XB_TOP], 1u);
            const unsigned tg = og / nx;
            if (og + 1u == (tg + 1u) * nx) xb_add(&bar[XB_TOPGEN], 1u);
            else XB_SPIN(xb_ld(&bar[XB_TOPGEN]) == tg, bar);
            __builtin_amdgcn_fence(__ATOMIC_ACQUIRE, "agent");
            xb_add(&bar[XB_XGEN(b.x)], 1u);
            asm volatile("s_waitcnt vmcnt(0)" ::: "memory");
        } else {
            XB_SPIN(xb_ld(&bar[XB_XGEN(b.x)]) == gen, bar);
            __builtin_amdgcn_fence(__ATOMIC_ACQUIRE, "agent");
            asm volatile("s_waitcnt vmcnt(0)" ::: "memory");
        }
    }
    __syncthreads();
}

typedef __attribute__((ext_vector_type(4))) short s16x4;
typedef __attribute__((address_space(3))) s16x4 lds_s16x4;
DI s16x4 lds_tr(const char* p) { return __builtin_amdgcn_ds_read_tr16_b64_v4i16((lds_s16x4*)p); }
DI int trswz(int row) { return ((row & 3) << 2) | ((row >> 2) & 3); }
struct CvTile { const float* src; bf16_t* dst; int K, N, perm, k0, n0; };
DI CvTile moe_cv_tile(const Args& a, const int L, const int t) {
    CvTile c;
    const int e = t / 96, r = t - e * 96;
    if (r < 64) {
        c.src = a.in[30] + (size_t)(L * 64 + e) * 1024 * 512; c.dst = (bf16_t*)(a.ws + W_GU) + (size_t)(L * 64 + e) * 512 * 1024;
        c.K = 1024; c.N = 512; c.perm = 1; c.k0 = (r & 7) * 128; c.n0 = (r >> 3) * 64;
    } else {
        const int r2 = r - 64;
        c.src = a.in[31] + (size_t)(L * 64 + e) * 256 * 1024; c.dst = (bf16_t*)(a.ws + W_DN) + (size_t)(L * 64 + e) * 1024 * 256;
        c.K = 256; c.N = 1024; c.perm = 0; c.k0 = (r2 & 1) * 128; c.n0 = (r2 >> 1) * 64;
    }
    return c;
}
DI void cv_load(const CvTile& c, f32x4 (&L0)[4], f32x4 (&L1)[4]) {
    const int tid = threadIdx.x, c4 = tid & 15, kr = tid >> 4;
    const float* p = c.src + (size_t)(c.k0 + 2 * kr) * c.N + c.n0 + 4 * c4;
#pragma unroll
    for (int i = 0; i < 4; ++i) { L0[i] = *(const f32x4*)(p + (size_t)(32 * i) * c.N); L1[i] = *(const f32x4*)(p + (size_t)(32 * i + 1) * c.N); }
}
DI void cv_pack(unsigned* st, const f32x4 (&L0)[4], const f32x4 (&L1)[4]) {
    const int tid = threadIdx.x, c4 = tid & 15, kr = tid >> 4;
#pragma unroll
    for (int i = 0; i < 4; ++i)
#pragma unroll
        for (int j = 0; j < 4; ++j) st[(4 * c4 + j) * 68 + 16 * i + kr] = pk2(L0[i][j], L1[i][j]);
}
DI void cv_flush(const CvTile& c, const unsigned* st) {
    const int tid = threadIdx.x;
#pragma unroll
    for (int i = 0; i < 4; ++i) {
        const int id = tid + i * 256, n = id >> 4, kc = id & 15;
        const u32x4 o = *(const u32x4*)(st + n * 68 + kc * 4);
        int nd = c.n0 + n;
        if (c.perm) { const int cc = nd & 255, up = nd >> 8; nd = ((cc >> 4) << 5) + (up << 4) + (cc & 15); }
        *(u32x4*)(c.dst + (size_t)nd * c.K + c.k0 + kc * 8) = o;
    }
}

DI void phase_prologue(const Args& a) {
    const int tid = threadIdx.x;
    const int n_ada = 384, n_rt = 320;
    const int total = n_ada + n_rt;
    float* sc = (float*)lds;
    for (int u = blockIdx.x; u < total; u += gridDim.x) {
        __syncthreads();
        if (u < n_ada) {
            const float* c = a.in[1]; const float* cc = a.in[3];
            for (int i = tid; i < 9 * 1024; i += NTHR) {
                float v = i < 8192 ? c[i] : cc[i - 8192];
                sc[i] = v / (1.f + __expf(-v));
            }
            __syncthreads();
            const int n = u * 64 + (tid & 63), li = n / 6144, nn = n - li * 6144, kq = tid >> 6;
            const float* wp = a.in[4] + (size_t)li * 1024 * 6144 + (size_t)(kq * 256) * 6144 + nn;
            float acc[9];
#pragma unroll
            for (int r = 0; r < 9; ++r) acc[r] = 0.f;
#pragma unroll 1
            for (int k0 = kq * 256; k0 < kq * 256 + 256; k0 += 16) {
                float wv[16];
#pragma unroll
                for (int kk = 0; kk < 16; ++kk) { wv[kk] = *wp; wp += 6144; }
#pragma unroll
                for (int kk = 0; kk < 16; kk += 4)
#pragma unroll
                    for (int r = 0; r < 9; ++r) {
                        const f32x4 s4 = *(const f32x4*)(sc + r * 1024 + k0 + kk);
                        acc[r] += s4[0] * wv[kk] + s4[1] * wv[kk + 1] + s4[2] * wv[kk + 2] + s4[3] * wv[kk + 3];
                    }
            }
            float* part = sc + 9 * 1024;
#pragma unroll
            for (int r = 0; r < 9; ++r) part[(kq * 9 + r) * 64 + (tid & 63)] = acc[r];
            __syncthreads();
            for (int i = tid; i < 9 * 64; i += NTHR) {
                const int r = i >> 6, cidx = i & 63;
                const int n2 = u * 64 + cidx, l2 = n2 / 6144, nn2 = n2 - l2 * 6144;
                const float v = ((part[(0 * 9 + r) * 64 + cidx] + part[(1 * 9 + r) * 64 + cidx]) + part[(2 * 9 + r) * 64 + cidx]) + part[(3 * 9 + r) * 64 + cidx];
                float o = v + a.in[5][l2 * 6144 + nn2];
                const int ch = nn2 >> 10;
                if (ch == 1) o = a.in[6][l2 * 1024 + (nn2 & 1023)] * (1.f + o);
                else if (ch == 4) o = a.in[7][l2 * 1024 + (nn2 & 1023)] * (1.f + o);
                ((float*)(a.ws + WS_MOD))[((size_t)l2 * 9 + r) * 6144 + nn2] = o;
            }
        } else if (u < n_ada + n_rt) {
            const int r_ = u - n_ada, li = r_ / 80, n = r_ - li * 80;
            if (r_ == 0) {
                float* rt_ = (float*)(a.ws + WS_CTL + CTL_ROPE);
                for (int i = tid; i < 512; i += NTHR) {
                    const int pos = i >> 3, fi = i & 7;
                    const float ang = (float)pos * powf(10000.f, -(float)fi * 0.125f);
                    rt_[i] = cosf(ang); rt_[512 + i] = sinf(ang);
                }
            }
            bf16_t* rt = (bf16_t*)(a.ws + W_RT) + (size_t)li * 80 * 1024;
            const float* wg = a.in[26] + (size_t)li * 1024 * 8;
            const float* we = a.in[28] + (size_t)li * 1024 * 64;
            float v[4];
#pragma unroll
            for (int j = 0; j < 4; ++j) { const int k = tid * 4 + j; v[j] = n < 8 ? wg[k * 8 + n] : (n < 72 ? we[k * 64 + (n - 8)] : 0.f); }
            u32x2 hw;
            hw[0] = pkh(v[0], v[1]); hw[1] = pkh(v[2], v[3]);
            *(u32x2*)(rt + n * 1024 + tid * 4) = hw;
        }
    }
    struct PTile { const float* src; bf16_t* dst; const float* rscale; int K, N, Npad, perm, k0, n0; };
    auto decode = [&](int tix) {
        int di = 0;
#pragma unroll 1
        for (int i = 1; i < NTD; ++i) if (tix >= a.td[i].tile0) di = i;
        const TDesc& td = a.td[di];
        int rem = tix - td.tile0;
        const int per = td.tiles_k * td.tiles_n;
        const int bi = rem / per; rem -= bi * per;
        PTile p;
        p.src = td.src + (size_t)bi * td.sb; p.dst = td.dst + (size_t)bi * td.db; p.rscale = td.rscale;
        p.K = td.K; p.N = td.N; p.Npad = td.Npad; p.perm = td.perm;
        p.n0 = (rem % td.tiles_n) * 64; p.k0 = (rem / td.tiles_n) * 128;
        return p;
    };
    auto pload = [&](const PTile& p, f32x4 (&L0)[4], f32x4 (&L1)[4]) {
        const int c4 = tid & 15, kr = tid >> 4;
        const bool nok = p.n0 + 4 * c4 < p.N;
#pragma unroll
        for (int i = 0; i < 4; ++i) {
            const int k = p.k0 + 32 * i + 2 * kr;
            L0[i] = (f32x4){0.f, 0.f, 0.f, 0.f}; L1[i] = L0[i];
            if (nok && k < p.K) {
                L0[i] = *(const f32x4*)(p.src + (size_t)k * p.N + p.n0 + 4 * c4);
                L1[i] = *(const f32x4*)(p.src + (size_t)(k + 1) * p.N + p.n0 + 4 * c4);
                if (p.rscale) { L0[i] *= p.rscale[k]; L1[i] *= p.rscale[k + 1]; }
            }
        }
    };
    auto pflush = [&](const PTile& p, const unsigned* st) {
#pragma unroll
        for (int i = 0; i < 4; ++i) {
            const int id = tid + i * 256, n = id >> 4, kc = id & 15;
            const u32x4 o = *(const u32x4*)(st + n * 68 + kc * 4);
            int nd = p.n0 + n;
            if (nd < p.Npad && p.k0 + kc * 8 < p.K) {
                if (p.perm) { const int c = nd & 255, up = nd >> 8; nd = ((c >> 4) << 5) + (up << 4) + (c & 15); }
                *(u32x4*)(p.dst + (size_t)nd * p.K + p.k0 + kc * 8) = o;
            }
        }
    };
    {
        unsigned* st0 = (unsigned*)lds; unsigned* st1 = st0 + 64 * 68;
        const int nt_ = a.ntiles_total, G = gridDim.x;
        int t0 = blockIdx.x, t1 = blockIdx.x + G;
        PTile p0 = decode(0), p1 = p0;
        f32x4 A0[4], A1[4], B0[4], B1[4];
        __syncthreads();
        if (t0 < nt_) { p0 = decode(t0); pload(p0, A0, A1); }
        if (t1 < nt_) { p1 = decode(t1); pload(p1, B0, B1); }
        while (t0 < nt_) {
            PTile q0 = p0, q1 = p1;
            const bool v1 = t1 < nt_;
            cv_pack(st0, A0, A1);
            if (t0 + 2 * G < nt_) { p0 = decode(t0 + 2 * G); pload(p0, A0, A1); }
            if (v1) {
                cv_pack(st1, B0, B1);
                if (t1 + 2 * G < nt_) { p1 = decode(t1 + 2 * G); pload(p1, B0, B1); }
            }
            __syncthreads();
            pflush(q0, st0);
            if (v1) pflush(q1, st1);
            __syncthreads();
            t0 += 2 * G; t1 += 2 * G;
        }
    }
}

DI float wave_sum(float v) {
    v += __shfl_xor(v, 1); v += __shfl_xor(v, 2); v += __shfl_xor(v, 4); v += __shfl_xor(v, 8); v += __shfl_xor(v, 16); v += __shfl_xor(v, 32);
    return v;
}
template <int MODE>
DI void phase_token_row(const Args& a, const int li) {
    const int tid = threadIdx.x, lane = tid & 63, wave = tid >> 6;
    bf16_t* X = (bf16_t*)(a.ws + WS_X);
    bf16_t* H = (bf16_t*)(a.ws + WS_H);
    const bf16_t* Y = (const bf16_t*)(a.ws + WS_Y);
    const float* MOD = (const float*)(a.ws + WS_MOD);
    const bool combine = MODE == 2 || li > 0;
    const bool first = MODE == 0 && li == 0;
    const int npairs = (MODE == 2 ? NLAT : NTOK) / 2;
    const int lprev = MODE == 2 ? 3 : (li > 0 ? li - 1 : 0);
    for (int p = blockIdx.x * 4 + wave; p < npairs; p += gridDim.x * 4) {
        const int t0 = 2 * p, mr = tok_modrow(t0);
        f32x4 x[2][2][2];
#pragma unroll
        for (int i = 0; i < 2; ++i) {
            const int t = t0 + i;
            if (first) {
                const float* xs = t < NLAT ? a.in[0] + (size_t)t * D : a.in[2] + (size_t)(t - NLAT) * D;
#pragma unroll
                for (int j = 0; j < 2; ++j) { x[i][j][0] = *(const f32x4*)(xs + 512 * j + 8 * lane); x[i][j][1] = *(const f32x4*)(xs + 512 * j + 8 * lane + 4); }
            } else {
#pragma unroll
                for (int j = 0; j < 2; ++j) unpk8(*(const u32x4*)(X + (size_t)t * D + 512 * j + 8 * lane), x[i][j][0], x[i][j][1]);
            }
        }
        if (combine) {
            const float* g5 = MOD + ((size_t)lprev * 9 + mr) * 6144 + 5 * 1024;
            f32x4 g[2][2];
#pragma unroll
            for (int j = 0; j < 2; ++j) { g[j][0] = *(const f32x4*)(g5 + 512 * j + 8 * lane); g[j][1] = *(const f32x4*)(g5 + 512 * j + 8 * lane + 4); }
#pragma unroll
            for (int i = 0; i < 2; ++i) {
                const bf16_t* y0 = Y + (size_t)(2 * (t0 + i)) * D;
#pragma unroll
                for (int j = 0; j < 2; ++j) {
                    f32x4 a0, a1, b0, b1;
                    unpk8(*(const u32x4*)(y0 + 512 * j + 8 * lane), a0, a1);
                    unpk8(*(const u32x4*)(y0 + D + 512 * j + 8 * lane), b0, b1);
                    x[i][j][0] += g[j][0] * (a0 + b0); x[i][j][1] += g[j][1] * (a1 + b1);
                }
            }
        }
        if (MODE == 2) {
#pragma unroll
            for (int i = 0; i < 2; ++i)
#pragma unroll
                for (int j = 0; j < 2; ++j) {
                    *(f32x4*)(a.out + (size_t)(t0 + i) * D + 512 * j + 8 * lane) = x[i][j][0];
                    *(f32x4*)(a.out + (size_t)(t0 + i) * D + 512 * j + 8 * lane + 4) = x[i][j][1];
                }
            continue;
        }
        float rstd[2];
#pragma unroll
        for (int i = 0; i < 2; ++i) {
            float ss = 0.f;
#pragma unroll
            for (int j = 0; j < 2; ++j)
#pragma unroll
                for (int h = 0; h < 2; ++h) ss += x[i][j][h][0] * x[i][j][h][0] + x[i][j][h][1] * x[i][j][h][1] + x[i][j][h][2] * x[i][j][h][2] + x[i][j][h][3] * x[i][j][h][3];
            rstd[i] = rsqrtf(wave_sum(ss) * (1.f / 1024.f) + EPS);
        }
        const float* msc = MOD + ((size_t)li * 9 + mr) * 6144 + 1 * 1024;
        const float* msh = MOD + ((size_t)li * 9 + mr) * 6144;
#pragma unroll
        for (int j = 0; j < 2; ++j) {
            const f32x4 gs0 = *(const f32x4*)(msc + 512 * j + 8 * lane), gs1 = *(const f32x4*)(msc + 512 * j + 8 * lane + 4);
            const f32x4 h0 = *(const f32x4*)(msh + 512 * j + 8 * lane), h1 = *(const f32x4*)(msh + 512 * j + 8 * lane + 4);
#pragma unroll
            for (int i = 0; i < 2; ++i) {
                *(u32x4*)(H + (size_t)(t0 + i) * D + 512 * j + 8 * lane) = pk8(x[i][j][0] * rstd[i] * gs0 + h0, x[i][j][1] * rstd[i] * gs1 + h1);
                if (combine) *(u32x4*)(X + (size_t)(t0 + i) * D + 512 * j + 8 * lane) = pk8(x[i][j][0], x[i][j][1]);
            }
        }
    }
}

template <int UR>
DI void phase_token_router(const Args& a, const int li, const bool dry = false) {
    constexpr int RPW = UR / 4, RB = (RPW % 3 == 0) ? 3 : 4, NB = RPW / RB, MTN = (UR + 15) / 16;
    static_assert(UR % 4 == 0 && RPW % RB == 0 && UR * 2048 + 16 <= LDS_BYTES && 5 * UR * 80 * 4 <= UR * 2048, "router unit");
    const int tid = threadIdx.x, lane = tid & 63, wave = tid >> 6;
    const int r = lane & 15, q = lane >> 4;
    const bf16_t* X = (const bf16_t*)(a.ws + WS_X);
    bf16_t* H = (bf16_t*)(a.ws + WS_H);
    const float* MOD = (const float*)(a.ws + WS_MOD);
    const int nunits = (li == 3 ? NLAT : NTOK) / UR;
    char* sF = lds;
    float* sP = (float*)lds;
    float* sL = (float*)(lds + 4 * UR * 80 * 4);
    const bf16_t* rwh = (const bf16_t*)(a.ws + W_RT) + (size_t)li * 80 * 1024 + (size_t)r * 1024 + q * 8;
    for (int g = blockIdx.x; g < nunits; g += gridDim.x) {
        __syncthreads();
        {
            int cur_mr = -1;
            f32x4 gs[2][2], h4[2][2];
            u32x4 xq[2][RB][2];
            auto xload = [&](u32x4 (&x)[RB][2], const int b) {
#pragma unroll
                for (int i = 0; i < RB; ++i)
#pragma unroll
                    for (int j = 0; j < 2; ++j) x[i][j] = *(const u32x4*)(X + (size_t)(g * UR + wave * RPW + b * RB + i) * D + 512 * j + 8 * lane);
            };
            xload(xq[0], 0);
            if (NB > 1) xload(xq[1], 1);
#pragma unroll
            for (int b = 0; b < NB; ++b) {
                const int lr0 = wave * RPW + b * RB;
                u32x4 (&xr)[RB][2] = xq[b & 1];
#pragma unroll
                for (int i = 0; i < RB; ++i) {
                    const int lr = lr0 + i, row = g * UR + lr;
                    const int mr = tok_modrow(row);
                    if (mr != cur_mr) {
                        cur_mr = mr;
                        const float* mb = MOD + ((size_t)li * 9 + mr) * 6144;
#pragma unroll
                        for (int j = 0; j < 2; ++j)
#pragma unroll
                            for (int h = 0; h < 2; ++h) { gs[j][h] = *(const f32x4*)(mb + 4 * 1024 + 512 * j + 8 * lane + 4 * h); h4[j][h] = *(const f32x4*)(mb + 3 * 1024 + 512 * j + 8 * lane + 4 * h); }
                    }
                    f32x4 x[2][2];
#pragma unroll
                    for (int j = 0; j < 2; ++j) unpk8(xr[i][j], x[j][0], x[j][1]);
                    float ss = 0.f;
#pragma unroll
                    for (int j = 0; j < 2; ++j)
#pragma unroll
                        for (int h = 0; h < 2; ++h) ss += x[j][h][0] * x[j][h][0] + x[j][h][1] * x[j][h][1] + x[j][h][2] * x[j][h][2] + x[j][h][3] * x[j][h][3];
                    const float rstd = rsqrtf(wave_sum(ss) * (1.f / 1024.f) + EPS);
#pragma unroll
                    for (int j = 0; j < 2; ++j) {
                        const f32x4 f0 = x[j][0] * rstd * gs[j][0] + h4[j][0], f1 = x[j][1] * rstd * gs[j][1] + h4[j][1];
                        *(u32x4*)(H + (size_t)row * D + 512 * j + 8 * lane) = pk8(f0, f1);
                        u32x4 hh; hh[0] = pkh(f0[0], f0[1]); hh[1] = pkh(f0[2], f0[3]); hh[2] = pkh(f1[0], f1[1]); hh[3] = pkh(f1[2], f1[3]);
                        *(u32x4*)(sF + lr * 2048 + (((64 * j + lane) ^ lr) << 4)) = hh;
                    }
                }
                if (b + 2 < NB) xload(xq[b & 1], b + 2);
            }
        }
        __syncthreads();
        f32x4 lacc[MTN][5];
#pragma unroll
        for (int mt = 0; mt < MTN; ++mt)
#pragma unroll
            for (int i = 0; i < 5; ++i) lacc[mt][i] = (f32x4){0.f, 0.f, 0.f, 0.f};
#pragma unroll 4
        for (int s = 0; s < 8; ++s) {
            const int kk = wave * 8 + s;
            f16x8 fh[MTN];
#pragma unroll
            for (int mt = 0; mt < MTN; ++mt) {
                const int lr = (mt * 16 + r) < UR ? mt * 16 + r : UR - 1;
                fh[mt] = __builtin_bit_cast(f16x8, ldsv8(sF + lr * 2048 + (((kk * 4 + q) ^ lr) << 4)));
            }
#pragma unroll
            for (int nt = 0; nt < 5; ++nt) {
                const f16x8 w = __builtin_bit_cast(f16x8, *(const bf16x8*)(rwh + (size_t)nt * 16 * 1024 + kk * 32));
#pragma unroll
                for (int mt = 0; mt < MTN; ++mt) lacc[mt][nt] = mfma16h(fh[mt], w, lacc[mt][nt]);
            }
        }
        __syncthreads();
#pragma unroll
        for (int mt = 0; mt < MTN; ++mt)
#pragma unroll
            for (int nt = 0; nt < 5; ++nt)
#pragma unroll
                for (int j = 0; j < 4; ++j) {
                    const int lr = mt * 16 + q * 4 + j;
                    if (lr < UR) sP[(wave * UR + lr) * 80 + nt * 16 + r] = lacc[mt][nt][j];
                }
        __syncthreads();
        for (int i = tid; i < UR * 80; i += NTHR) sL[i] = sP[i] + sP[UR * 80 + i] + sP[2 * UR * 80 + i] + sP[3 * UR * 80 + i];
        __syncthreads();
        if (tid < UR && !dry) {
            const float* L = sL + tid * 80;
            const float* bg = a.in[27] + li * 8;
            const float* be = a.in[29] + li * 64;
            float gmax = -3.0e38f; int gi = 0; float gl[8];
#pragma unroll
            for (int j = 0; j < 8; ++j) { gl[j] = L[j] + bg[j]; if (gl[j] > gmax) { gmax = gl[j]; gi = j; } }
            float ps = 0.f;
#pragma unroll
            for (int j = 0; j < 8; ++j) ps += __expf(gl[j] - gmax);
            const float ptop = 1.f / ps;
            float e1 = -3.0e38f, e2 = -3.0e38f; int i1 = 0, i2 = 0;
#pragma unroll
            for (int j = 0; j < 8; ++j) {
                const float v = L[8 + gi * 8 + j] + be[gi * 8 + j];
                if (v > e1) { e2 = e1; i2 = i1; e1 = v; i1 = j; } else if (v > e2) { e2 = v; i2 = j; }
            }
            const float ex = __expf(e2 - e1);
            const float w1 = ptop / (1.f + ex), w2 = ptop * ex / (1.f + ex);
            const int tt = g * UR + tid;
            int* cnt = (int*)(a.ws + WS_CTL + CTL_CNT) + li * 64;
            int* list = (int*)(a.ws + WS_LIST);
            float* wsl = (float*)(a.ws + WS_WSLOT);
            const int ea = gi * 8 + i1, eb = gi * 8 + i2;
            const int pa = atomicAdd(&cnt[ea], 1); list[(size_t)ea * NTOK + pa] = 2 * tt; wsl[2 * tt] = w1;
            const int pb = atomicAdd(&cnt[eb], 1); list[(size_t)eb * NTOK + pb] = 2 * tt + 1; wsl[2 * tt + 1] = w2;
        }
    }
}

template <int WM, int WN, int MT, int NT, bool PFALL = true, class AP>
DI void gemm_tile(AP arow, const bf16_t* Bt, const int ldb, const int K, f32x4 (&acc)[MT][NT], float* ssq = nullptr) {
    constexpr int BM = WM * MT * 16, BN = WN * NT * 16;
    constexpr int A_BYTES = BM * 128, B_BYTES = BN * 128, STAGE = A_BYTES + B_BYTES;
    constexpr int ACH = BM * 8 / NTHR, BCH = BN * 8 / NTHR;
    static_assert(2 * STAGE <= LDS_AUX, "gemm LDS");
    const int tid = threadIdx.x, lane = tid & 63, wave = tid >> 6;
    const int wm = wave / WN, wn = wave % WN;
    const int fr = lane & 15, fq = lane >> 4;
    const bf16_t* ap[ACH]; const bf16_t* bp[BCH];
#pragma unroll
    for (int i = 0; i < ACH; ++i) { const int idx = tid + i * NTHR, row = idx >> 3, c = (idx & 7) ^ (row & 7); ap[i] = arow(row) + c * 8; }
#pragma unroll
    for (int i = 0; i < BCH; ++i) { const int idx = tid + i * NTHR, row = idx >> 3, c = (idx & 7) ^ (row & 7); bp[i] = Bt + (size_t)row * ldb + c * 8; }
#pragma unroll
    for (int i = 0; i < MT; ++i)
#pragma unroll
        for (int j = 0; j < NT; ++j) acc[i][j] = (f32x4){0.f, 0.f, 0.f, 0.f};
    const int KT = K >> 6;
    {
        char* sa = lds; char* sb = lds + A_BYTES;
#pragma unroll
        for (int i = 0; i < ACH; ++i) dma16(ap[i], sa + (tid + i * NTHR) * 16);
#pragma unroll
        for (int i = 0; i < BCH; ++i) dma16(bp[i], sb + (tid + i * NTHR) * 16);
    }
#pragma unroll 1
    for (int kt = 0; kt < KT; ++kt) {
        wait_vm0();
        __syncthreads();
        if (kt + 1 < KT) {
            char* sa = lds + ((kt + 1) & 1) * STAGE; char* sb = sa + A_BYTES;
            const int ko = (kt + 1) * 64;
#pragma unroll
            for (int i = 0; i < ACH; ++i) dma16(ap[i] + ko, sa + (tid + i * NTHR) * 16);
#pragma unroll
            for (int i = 0; i < BCH; ++i) dma16(bp[i] + ko, sb + (tid + i * NTHR) * 16);
        }
        const char* sa = lds + (kt & 1) * STAGE; const char* sb = sa + A_BYTES;
        if (PFALL) {
            bf16x8 xf[2][MT], wf[2][NT];
#pragma unroll
            for (int kk = 0; kk < 2; ++kk) {
#pragma unroll
                for (int i = 0; i < MT; ++i) xf[kk][i] = ldsv8(sa + swz128(wm * MT * 16 + i * 16 + fr, kk * 4 + fq));
#pragma unroll
                for (int j = 0; j < NT; ++j) wf[kk][j] = ldsv8(sb + swz128(wn * NT * 16 + j * 16 + fr, kk * 4 + fq));
            }
            __builtin_amdgcn_sched_barrier(0);
            __builtin_amdgcn_s_setprio(1);
#pragma unroll
            for (int kk = 0; kk < 2; ++kk)
#pragma unroll
                for (int i = 0; i < MT; ++i)
#pragma unroll
                    for (int j = 0; j < NT; ++j) acc[i][j] = mfma16(wf[kk][j], xf[kk][i], acc[i][j]);
            __builtin_amdgcn_s_setprio(0);
        } else {
#pragma unroll
            for (int kk = 0; kk < 2; ++kk) {
                bf16x8 xf[MT], wf[NT];
#pragma unroll
                for (int i = 0; i < MT; ++i) xf[i] = ldsv8(sa + swz128(wm * MT * 16 + i * 16 + fr, kk * 4 + fq));
#pragma unroll
                for (int j = 0; j < NT; ++j) wf[j] = ldsv8(sb + swz128(wn * NT * 16 + j * 16 + fr, kk * 4 + fq));
#pragma unroll
                for (int i = 0; i < MT; ++i)
#pragma unroll
                    for (int j = 0; j < NT; ++j) acc[i][j] = mfma16(wf[j], xf[i], acc[i][j]);
                if (ssq) {
#pragma unroll
                    for (int i = 0; i < MT; ++i) {
                        const u32x4 xu = __builtin_bit_cast(u32x4, xf[i]);
#pragma unroll
                        for (int d = 0; d < 4; ++d) { const bfx2 p = __builtin_bit_cast(bfx2, xu[d]); ssq[i] = __builtin_amdgcn_fdot2_f32_bf16(p, p, ssq[i], false); }
                    }
                }
            }
        }
    }
    __syncthreads();
}


struct GemmPipe {
    static constexpr int A_BYTES = 128 * 128, STAGE = 2 * A_BYTES;
    const bf16_t* ap[4]; const bf16_t* bp[4];
    template <class AP>
    DI void setup(AP arow, const bf16_t* Bt, const int ldb) {
        const int tid = threadIdx.x;
#pragma unroll
        for (int i = 0; i < 4; ++i) {
            const int idx = tid + i * NTHR, row = idx >> 3, c = (idx & 7) ^ (row & 7);
            ap[i] = arow(row) + c * 8; bp[i] = Bt + (size_t)row * ldb + c * 8;
        }
    }
    DI void issue(const int kt, const int buf) const {
        const int tid = threadIdx.x;
        char* sa = lds + buf * STAGE; char* sb = sa + A_BYTES;
        const int ko = kt * 64;
#pragma unroll
        for (int i = 0; i < 4; ++i) dma16(ap[i] + ko, sa + (tid + i * NTHR) * 16);
#pragma unroll
        for (int i = 0; i < 4; ++i) dma16(bp[i] + ko, sb + (tid + i * NTHR) * 16);
    }
    template <int PM>
    DI void run_probe(const int K, f32x4 (&acc)[4][4]) const {
        const int tid = threadIdx.x, lane = tid & 63, wave = tid >> 6;
        const int wm = wave >> 1, wn = wave & 1, fr = lane & 15, fq = lane >> 4;
#pragma unroll
        for (int i = 0; i < 4; ++i)
#pragma unroll
            for (int j = 0; j < 4; ++j) acc[i][j] = (f32x4){0.f, 0.f, 0.f, 0.f};
        const int KT = K >> 6;
#pragma unroll 1
        for (int kt = 0; kt < KT; ++kt) {
            if (PM & 4) { wait_vm0(); __syncthreads(); }
            if ((PM & 1) && kt + 1 < KT) issue(kt + 1, (kt + 1) & 1);
            if (PM & 2) {
                const char* sa = lds + (kt & 1) * STAGE; const char* sb = sa + A_BYTES;
                bf16x8 xf[2][4], wf[2][4];
#pragma unroll
                for (int kk = 0; kk < 2; ++kk) {
#pragma unroll
                    for (int i = 0; i < 4; ++i) xf[kk][i] = ldsv8(sa + swz128(wm * 64 + i * 16 + fr, kk * 4 + fq));
#pragma unroll
                    for (int j = 0; j < 4; ++j) wf[kk][j] = ldsv8(sb + swz128(wn * 64 + j * 16 + fr, kk * 4 + fq));
                }
                __builtin_amdgcn_sched_barrier(0);
                __builtin_amdgcn_s_setprio(1);
#pragma unroll
                for (int kk = 0; kk < 2; ++kk)
#pragma unroll
                    for (int i = 0; i < 4; ++i)
#pragma unroll
                        for (int j = 0; j < 4; ++j) acc[i][j] = mfma16(wf[kk][j], xf[kk][i], acc[i][j]);
                __builtin_amdgcn_s_setprio(0);
            }
        }
        wait_vm0();
    }
    DI void run(const int K, f32x4 (&acc)[4][4]) const {
        const int tid = threadIdx.x, lane = tid & 63, wave = tid >> 6;
        const int wm = wave >> 1, wn = wave & 1, fr = lane & 15, fq = lane >> 4;
#pragma unroll
        for (int i = 0; i < 4; ++i)
#pragma unroll
            for (int j = 0; j < 4; ++j) acc[i][j] = (f32x4){0.f, 0.f, 0.f, 0.f};
        const int KT = K >> 6;
#pragma unroll 1
        for (int kt = 0; kt < KT; ++kt) {
            wait_vm0();
            __syncthreads();
            if (kt + 1 < KT) issue(kt + 1, (kt + 1) & 1);
            const char* sa = lds + (kt & 1) * STAGE; const char* sb = sa + A_BYTES;
            bf16x8 xf[2][4], wf[2][4];
#pragma unroll
            for (int kk = 0; kk < 2; ++kk) {
#pragma unroll
                for (int i = 0; i < 4; ++i) xf[kk][i] = ldsv8(sa + swz128(wm * 64 + i * 16 + fr, kk * 4 + fq));
#pragma unroll
                for (int j = 0; j < 4; ++j) wf[kk][j] = ldsv8(sb + swz128(wn * 64 + j * 16 + fr, kk * 4 + fq));
            }
            __builtin_amdgcn_sched_barrier(0);
            __builtin_amdgcn_s_setprio(1);
#pragma unroll
            for (int kk = 0; kk < 2; ++kk)
#pragma unroll
                for (int i = 0; i < 4; ++i)
#pragma unroll
                    for (int j = 0; j < 4; ++j) acc[i][j] = mfma16(wf[kk][j], xf[kk][i], acc[i][j]);
            __builtin_amdgcn_s_setprio(0);
        }
    }
};

constexpr int EPI_OFF = 32768;
DI int lane_m(int i) { const int t = threadIdx.x; return ((t >> 7) & 1) * 64 + i * 16 + (t & 15); }
DI int lane_n(int j) { const int t = threadIdx.x; return ((t >> 6) & 1) * 64 + j * 16 + ((t >> 4) & 3) * 4; }
DI int opaque_tid() { int t = threadIdx.x; asm volatile("" : "+v"(t)); return t; }
DI int lane_m(int t, int i) { return ((t >> 7) & 1) * 64 + i * 16 + (t & 15); }
DI int lane_n(int t, int j) { return ((t >> 6) & 1) * 64 + j * 16 + ((t >> 4) & 3) * 4; }
template <class XF>
DI void epi_stage_bf16(const f32x4 (&acc)[4][4], XF xf) {
    const int tz = opaque_tid();
#pragma unroll
    for (int i = 0; i < 4; ++i) {
        const int m = lane_m(tz, i);
#pragma unroll
        for (int j = 0; j < 4; ++j) {
            const int n = lane_n(tz, j);
            const f32x4 v = xf(i, j, acc[i][j]);
            u32x2 o; o[0] = pk2(v[0], v[1]); o[1] = pk2(v[2], v[3]);
            *(u32x2*)(lds + EPI_OFF + m * 256 + (((n >> 3) ^ (m & 15)) << 4) + (n & 4) * 2) = o;
        }
    }
}
template <class DP, class OK>
DI void epi_flush_bf16(DP dst, OK ok) {
    const int tz = opaque_tid();
#pragma unroll
    for (int it = 0; it < 8; ++it) {
        const int idx = tz + it * NTHR, row = idx >> 4, ch = idx & 15;
        const u32x4 v = *(const u32x4*)(lds + EPI_OFF + row * 256 + ((ch ^ (row & 15)) << 4));
        if (ok(row)) *(u32x4*)(dst(row) + ch * 8) = v;
    }
}
template <class XF>
DI void epi_stage_bf16_T(const f32x4 (&acc)[4][4], XF xf) {
    const int tz = opaque_tid();
    const bool odd = tz & 1;
#pragma unroll
    for (int i = 0; i < 4; ++i) {
        const int m = lane_m(tz, i) & ~1;
#pragma unroll
        for (int j = 0; j < 4; ++j) {
            const int n = lane_n(tz, j) + (odd ? 2 : 0);
            const f32x4 v = xf(i, j, acc[i][j]);
            const float r0 = __shfl_xor(odd ? v[0] : v[2], 1), r1 = __shfl_xor(odd ? v[1] : v[3], 1);
            const unsigned w0 = odd ? pk2(r0, v[2]) : pk2(v[0], r0), w1 = odd ? pk2(r1, v[3]) : pk2(v[1], r1);
            *(unsigned*)(lds + EPI_OFF + n * 256 + (((m >> 3) ^ (n & 15)) << 4) + (m & 6) * 2) = w0;
            *(unsigned*)(lds + EPI_OFF + (n + 1) * 256 + (((m >> 3) ^ ((n + 1) & 15)) << 4) + (m & 6) * 2) = w1;
        }
    }
}
DI void epi_resid_f32(const Args& a, const int li, const int m0, const int n0, const f32x4 (&acc)[4][4]) {
    const int tz = opaque_tid();
    bf16_t* X = (bf16_t*)(a.ws + WS_X);
    const float* gate = (const float*)(a.ws + WS_MOD) + ((size_t)li * 9 + tok_modrow(m0)) * 6144 + 2 * 1024 + n0;
    f32x4 g4[4];
#pragma unroll
    for (int j = 0; j < 4; ++j) g4[j] = *(const f32x4*)(gate + lane_n(tz, j));
    __syncthreads();
    epi_stage_bf16(acc, [&](int, int j, const f32x4 v) { return v * g4[j]; });
    __syncthreads();
#pragma unroll
    for (int it = 0; it < 8; ++it) {
        const int idx = tz + it * NTHR, row = idx >> 4, ch = idx & 15;
        const int t = m0 + row;
        f32x4 d0, d1, x0, x1;
        unpk8(*(const u32x4*)(lds + EPI_OFF + row * 256 + ((ch ^ (row & 15)) << 4)), d0, d1);
        bf16_t* xp = X + (size_t)t * D + n0 + ch * 8;
        if (li == 0) {
            const float* xs = (t < NLAT ? a.in[0] + (size_t)t * D : a.in[2] + (size_t)(t - NLAT) * D) + n0 + ch * 8;
            x0 = *(const f32x4*)xs; x1 = *(const f32x4*)(xs + 4);
        } else {
            unpk8(*(const u32x4*)xp, x0, x1);
        }
        *(u32x4*)xp = pk8(x0 + d0, x1 + d1);
    }
}

template <bool XPF = true, class TE>
DI void gemm_dense_phase(const bf16_t* A, const int lda, const int mrows, const bf16_t* Bt, const int N, const int K, TE tile_epi) {
    const int mt = mrows / 128, nt = N / 128;
    const int mpx = mt >> 3, bmb = mpx >> 1, full = mpx * 8;
    auto decode = [&](int u, int& m0, int& n0) {
        const int xc = u & 7, s = u >> 3;
        const int bn = s / full, rem = s - bn * full;
        const int w = min(8, nt - 8 * bn);
        const int bm = rem / (bmb * w), rem2 = rem - bm * (bmb * w);
        const int ni = rem2 / bmb, mi = rem2 - ni * bmb;
        m0 = (xc * mpx + bm * bmb + mi) * 128; n0 = (bn * 8 + ni) * 128;
    };
    GemmPipe g;
    int u = blockIdx.x, m0 = 0, n0 = 0;
    __syncthreads();
    if (u < mt * nt) { decode(u, m0, n0); g.setup([&](int r) { return A + (size_t)(m0 + r) * lda; }, Bt + (size_t)n0 * K, K); g.issue(0, 0); }
    while (u < mt * nt) {
        f32x4 acc[4][4];
        g.run(K, acc);
        const int cm0 = m0, cn0 = n0;
        u += gridDim.x;
        if (XPF) {
            if (u < mt * nt) { decode(u, m0, n0); g.setup([&](int r) { return A + (size_t)(m0 + r) * lda; }, Bt + (size_t)n0 * K, K); g.issue(0, 0); }
            tile_epi(cm0, cn0, acc);
        } else {
            tile_epi(cm0, cn0, acc);
            __syncthreads();
            if (u < mt * nt) { decode(u, m0, n0); g.setup([&](int r) { return A + (size_t)(m0 + r) * lda; }, Bt + (size_t)n0 * K, K); g.issue(0, 0); }
        }
    }
    __syncthreads();
}
template <class XF, class DP>
DI void epi_bf16_rowmajor(const f32x4 (&acc)[4][4], XF xf, DP dst) {
    __syncthreads();
    epi_stage_bf16(acc, xf);
    __syncthreads();
    epi_flush_bf16(dst, [](int) { return true; });
}

DI void phase_rg_in(const Args& a, int j) {
    bf16_t* G = (bf16_t*)(a.ws + RG_G); bf16_t* U = (bf16_t*)(a.ws + RG_U);
    gemm_dense_phase((const bf16_t*)(a.ws + WS_H), D, NTOK, (const bf16_t*)(a.ws + W_RGIN) + (size_t)j * 2048 * 1024, 2048, 1024,
        [&](int m0, int n0, const f32x4 (&acc)[4][4]) {
            if (n0 < 1024)
                epi_bf16_rowmajor(acc, [](int, int, const f32x4 v) { f32x4 g; g[0] = gelu_tanh(v[0]); g[1] = gelu_tanh(v[1]); g[2] = gelu_tanh(v[2]); g[3] = gelu_tanh(v[3]); return g; },
                                  [&](int row) { return G + (size_t)(m0 + row) * D + n0; });
            else
                epi_bf16_rowmajor(acc, [](int, int, const f32x4 v) { return v; }, [&](int row) { return U + (size_t)(m0 + row) * D + (n0 - 1024); });
        });
}

template <int VAR = 0, int HOST = 0>
DI void phase_rg_scan(const Args& a, int j) {
    const int tid = threadIdx.x, lane = tid & 63, wave = tid >> 6;
    const int fr = lane & 15, fq = lane >> 4;
    const bf16_t* U = (const bf16_t*)(a.ws + RG_U);
    bf16_t* HS = (bf16_t*)(a.ws + (VAR ? WS_Y : RG_HS));
    char* sW = lds;
    char* sX = lds + 8192;
    float* sUc = (float*)(lds + 16384);
    float* sA = (float*)(lds + 24576);
    float* sB = (float*)(lds + 33280);
    bf16_t* sO = (bf16_t*)(lds + 41984);
    unsigned* sCv = (unsigned*)(lds + 50176);
    const int c = tid & 7;
    for (int u = blockIdx.x; u < 512; u += gridDim.x) {
        const int half = u & 1, dir = (u >> 1) & 1, blk = (u >> 2) & 15, b = u >> 6;
        const int cin0 = blk * 64, co0 = blk * 64 + half * 32;
        __syncthreads();
        {
            const bf16_t* Wg = (const bf16_t*)(a.ws + W_RGG) + ((size_t)((j * 2 + dir) * 16 + blk)) * 128 * 64;
#pragma unroll
            for (int i = 0; i < 2; ++i) {
                const int idx = tid + i * NTHR, row = idx >> 3, cc = idx & 7;
                const int srow = (row >> 5) * 64 + half * 32 + (row & 31);
                *(u32x4*)(sW + swz128(row, cc)) = *(const u32x4*)(Wg + (size_t)srow * 64 + cc * 8);
            }
        }
        float carry = 0.f;
        float cw[4][8], cb[8];
        {
            const float* cwp = a.in[9] + (size_t)j * 4 * 1024 + cin0 + c * 8; const float* cbp = a.in[10] + (size_t)j * 1024 + cin0 + c * 8;
#pragma unroll
            for (int w = 0; w < 4; ++w) { const f32x4 v0 = *(const f32x4*)(cwp + w * 1024), v1 = *(const f32x4*)(cwp + w * 1024 + 4);
#pragma unroll
                for (int e = 0; e < 4; ++e) { cw[w][e] = v0[e]; cw[w][4 + e] = v1[e]; } }
            const f32x4 v0 = *(const f32x4*)cbp, v1 = *(const f32x4*)(cbp + 4);
#pragma unroll
            for (int e = 0; e < 4; ++e) { cb[e] = v0[e]; cb[4 + e] = v1[e]; }
        }
        float bg0[8], bg1[8], spl[8];
        {
            const float* gb = a.in[12] + ((size_t)(j * 2 + dir) * 2) * 1024 + co0;
            const float* lm = a.in[13] + (size_t)(j * 2 + dir) * 1024 + co0;
#pragma unroll
            for (int jt = 0; jt < 2; ++jt)
#pragma unroll
                for (int e = 0; e < 4; ++e) {
                    const int cc = jt * 16 + fq * 4 + e;
                    bg0[jt * 4 + e] = gb[cc]; bg1[jt * 4 + e] = gb[1024 + cc];
                    spl[jt * 4 + e] = -8.f * log1pf(__expf(-lm[cc]));
                }
        }
        u32x4 pu[2][4];
        auto load_chunk = [&](int ci) {
            const int seg = ci >= 4, L = seg ? SEQ : CTXL, nch = L / 64, jc = seg ? ci - 4 : ci;
            const int oc = dir ? nch - 1 - jc : jc;
            const int rb = seg ? b * SEQ : NLAT + b * CTXL;
            const int s0 = oc * 64;
#pragma unroll
            for (int it = 0; it < 2; ++it) {
                const int tk = (tid >> 3) + it * 32;
#pragma unroll
                for (int w = 0; w < 4; ++w) {
                    const int s = s0 + tk + w - 2;
                    const int sc_ = min(max(s, 0), L - 1);
                    const u32x4 ld = *(const u32x4*)(U + (size_t)(rb + sc_) * D + cin0 + c * 8);
                    const unsigned msk = (s >= 0 && s < L) ? 0xffffffffu : 0u;
                    pu[it][w] = (u32x4){ld[0] & msk, ld[1] & msk, ld[2] & msk, ld[3] & msk};
                }
            }
        };
        load_chunk(0);
        __syncthreads();
        size_t prev_base = 0;
        constexpr int CV_TILES = HOST ? 6144 : 0;
        CvTile cvp; cvp.src = nullptr; cvp.dst = nullptr; cvp.K = 0; cvp.N = 0; cvp.perm = 0; cvp.k0 = 0; cvp.n0 = 0;
        bool cvp_ok = false;
#pragma unroll 1
        for (int ci = 0; ci < 36; ++ci) {
            f32x4 cv0[4], cv1[4];
            CvTile cvc = cvp;
            const int cvq = (ci / 3) * 512 + u;
            const bool cv_ok = HOST && (ci % 3 == 0) && cvq < CV_TILES;
            if (cv_ok) { cvc = moe_cv_tile(a, 1, cvq); cv_load(cvc, cv0, cv1); }
            const int seg = ci >= 4, L = seg ? SEQ : CTXL, nch = L / 64, jc = seg ? ci - 4 : ci;
            const int oc = dir ? nch - 1 - jc : jc;
            const int rb = seg ? b * SEQ : NLAT + b * CTXL;
            const int s0 = oc * 64;
            char* sXc = sX; float* sUcc = sUc;
#pragma unroll
            for (int it = 0; it < 2; ++it) {
                const int tk = (tid >> 3) + it * 32;
                float o[8];
#pragma unroll
                for (int e = 0; e < 8; ++e) o[e] = cb[e];
#pragma unroll
                for (int w = 0; w < 4; ++w) {
                    const u32x4 r4 = pu[it][w];
#pragma unroll
                    for (int e = 0; e < 4; ++e) { o[2 * e] += cw[w][2 * e] * lof(r4[e]); o[2 * e + 1] += cw[w][2 * e + 1] * hif(r4[e]); }
                }
                u32x4 pv; pv[0] = pk2(o[0], o[1]); pv[1] = pk2(o[2], o[3]); pv[2] = pk2(o[4], o[5]); pv[3] = pk2(o[6], o[7]);
                *(u32x4*)(sXc + swz128(tk, c)) = pv;
                if ((c >> 2) == half) {
                    *(f32x4*)(sUcc + tk * 32 + (c & 3) * 8) = (f32x4){o[0], o[1], o[2], o[3]};
                    *(f32x4*)(sUcc + tk * 32 + (c & 3) * 8 + 4) = (f32x4){o[4], o[5], o[6], o[7]};
                }
            }
            if (ci + 1 < 36) load_chunk(ci + 1);
            lds_barrier();
            if (HOST && cvp_ok) cv_flush(cvp, sCv);
            if (ci > 0) {
                const u32x4 v = *(const u32x4*)(sO + ((ci - 1) & 1) * 2048 + tid * 8);
                *(u32x4*)(HS + prev_base + (size_t)(tid >> 2) * D + (tid & 3) * 8) = v;
            }
            {
                f32x4 acc[4];
#pragma unroll
                for (int jt = 0; jt < 4; ++jt) acc[jt] = (f32x4){0.f, 0.f, 0.f, 0.f};
#pragma unroll
                for (int kk = 0; kk < 2; ++kk) {
                    const bf16x8 xf = ldsv8(sXc + swz128(wave * 16 + fr, kk * 4 + fq));
#pragma unroll
                    for (int jt = 0; jt < 4; ++jt) acc[jt] = mfma16(ldsv8(sW + swz128(jt * 16 + fr, kk * 4 + fq)), xf, acc[jt]);
                }
                const int tk = wave * 16 + fr;
#pragma unroll
                for (int jt = 0; jt < 2; ++jt) {
                    const f32x4 uc = *(const f32x4*)(sUcc + tk * 32 + jt * 16 + fq * 4);
                    f32x4 av4, bv4;
#pragma unroll
                    for (int e = 0; e < 4; ++e) {
                        if (VAR & 2) { av4[e] = 0.5f + 0.001f * acc[jt][e]; bv4[e] = uc[e] + acc[jt + 2][e]; continue; }
                        const float rg = sigmoidf_(acc[jt][e] + bg0[jt * 4 + e]);
                        const float ig = sigmoidf_(acc[jt + 2][e] + bg1[jt * 4 + e]);
                        const float av = fexp(rg * spl[jt * 4 + e]);
                        av4[e] = av;
                        bv4[e] = __builtin_amdgcn_sqrtf(fmaxf(1.f - av * av, 0.f)) * ig * uc[e];
                    }
#pragma unroll
                    for (int e = 0; e < 4; ++e) { sA[(jt * 16 + fq * 4 + e) * 68 + tk] = av4[e]; sB[(jt * 16 + fq * 4 + e) * 68 + tk] = bv4[e]; }
                }
            }
            lds_barrier();
            if (!(VAR & 4)) {
                const int ch = wave * 8 + (lane & 7), sg = lane >> 3;
                const int tb = dir ? 56 - sg * 8 : sg * 8;
                const f32x4 a0 = *(const f32x4*)(sA + ch * 68 + tb), a1 = *(const f32x4*)(sA + ch * 68 + tb + 4);
                const f32x4 b0 = *(const f32x4*)(sB + ch * 68 + tb), b1 = *(const f32x4*)(sB + ch * 68 + tb + 4);
                float av[8], bv[8];
#pragma unroll
                for (int e = 0; e < 4; ++e) {
                    av[e] = dir ? a1[3 - e] : a0[e]; av[4 + e] = dir ? a0[3 - e] : a1[e];
                    bv[e] = dir ? b1[3 - e] : b0[e]; bv[4 + e] = dir ? b0[3 - e] : b1[e];
                }
                float Ap = 1.f, Hh = 0.f;
#pragma unroll
                for (int e = 0; e < 8; ++e) { Hh = av[e] * Hh + bv[e]; Ap *= av[e]; }
#pragma unroll
                for (int d = 8; d < 64; d <<= 1) {
                    const float Ao = __shfl_up(Ap, d), Ho = __shfl_up(Hh, d);
                    if (lane >= d) { Hh = Ap * Ho + Hh; Ap = Ap * Ao; }
                }
                float Aex = __shfl_up(Ap, 8), Hex = __shfl_up(Hh, 8);
                if (sg == 0) { Aex = 1.f; Hex = 0.f; }
                float hin = Aex * carry + Hex;
                const float cnew = Ap * carry + Hh;
                carry = __shfl(cnew, 56 + (lane & 7));
                bf16_t* so = sO + (ci & 1) * 2048 + ch;
#pragma unroll
                for (int e = 0; e < 8; ++e) {
                    hin = av[e] * hin + bv[e];
                    const int i = sg * 8 + e, tk = dir ? 63 - i : i;
                    so[tk * 32] = f2bf(hin);
                }
            }
            prev_base = (size_t)dir * NTOK * D + (size_t)(rb + s0) * D + co0;
            if (HOST) { if (cv_ok) cv_pack(sCv, cv0, cv1); cvp = cvc; cvp_ok = cv_ok; }
        }
        __syncthreads();
        if (HOST && cvp_ok) cv_flush(cvp, sCv);
        {
            const u32x4 v = *(const u32x4*)(sO + (35 & 1) * 2048 + tid * 8);
            *(u32x4*)(HS + prev_base + (size_t)(tid >> 2) * D + (tid & 3) * 8) = v;
        }
    }
}

DI void phase_rg_combine(const Args& a) {
    const u32x4* G = (const u32x4*)(a.ws + RG_G);
    const u32x4* H0 = (const u32x4*)(a.ws + RG_HS);
    const u32x4* H1 = (const u32x4*)(a.ws + RG_HS + TOKD2);
    u32x4* A2 = (u32x4*)(a.ws + RG_A2);
    const size_t n = (size_t)NTOK * D / 8;
    for (size_t i = (size_t)blockIdx.x * NTHR + threadIdx.x; i < n; i += (size_t)gridDim.x * NTHR) {
        const u32x4 g = G[i], h0 = H0[i], h1 = H1[i];
        u32x4 o;
#pragma unroll
        for (int e = 0; e < 4; ++e) o[e] = pk2(lof(g[e]) * (lof(h0[e]) + lof(h1[e])), hif(g[e]) * (hif(h0[e]) + hif(h1[e])));
        A2[i] = o;
    }
}

DI void phase_rg_out(const Args& a, int li, int j) {
    gemm_dense_phase((const bf16_t*)(a.ws + RG_A2), D, li == 3 ? NLAT : NTOK, (const bf16_t*)(a.ws + W_RGOUT) + (size_t)j * 1024 * 1024, 1024, 1024,
        [&](int m0, int n0, const f32x4 (&acc)[4][4]) { epi_resid_f32(a, li, m0, n0, acc); });
}

DI void phase_mla_down(const Args& a) {
    bf16_t* CQ = (bf16_t*)(a.ws + MLA_CQ); bf16_t* CKV = (bf16_t*)(a.ws + MLA_CKV); float* KR = (float*)(a.ws + MLA_KR);
    gemm_dense_phase((const bf16_t*)(a.ws + WS_H), D, NTOK, (const bf16_t*)(a.ws + W_MDOWN), 512, 1024,
        [&](int m0, int n0, const f32x4 (&acc)[4][4]) {
            if (n0 < 256) epi_bf16_rowmajor(acc, [](int, int, const f32x4 v) { return v; }, [&](int row) { return CQ + (size_t)(m0 + row) * 256 + n0; });
            else if (n0 == 256) epi_bf16_rowmajor(acc, [](int, int, const f32x4 v) { return v; }, [&](int row) { return CKV + (size_t)(m0 + row) * 128; });
            else {
#pragma unroll
                for (int i = 0; i < 4; ++i)
#pragma unroll
                    for (int j = 0; j < 2; ++j) { const int n = lane_n(j); if (n < 32) *(f32x4*)(KR + (size_t)(m0 + lane_m(i)) * 32 + n) = acc[i][j]; }
            }
        });
}

DI int perm_key(int kp) { return (kp & ~12) | ((kp & 4) << 1) | ((kp & 8) >> 1); }

DI void phase_mla_up(const Args& a) {
    const int tid = threadIdx.x;
    const bf16_t* CQ = (const bf16_t*)(a.ws + MLA_CQ); const bf16_t* CKV = (const bf16_t*)(a.ws + MLA_CKV); const float* KR = (const float*)(a.ws + MLA_KR);
    bf16_t* Q = (bf16_t*)(a.ws + MLA_Q); bf16_t* Kb = (bf16_t*)(a.ws + MLA_K); bf16_t* VT = (bf16_t*)(a.ws + MLA_VT);
    const float* qkn = a.in[20];
    const float* RC = (const float*)(a.ws + WS_CTL + CTL_ROPE); const float* RS = RC + 512;
    const int MT_ = NTOK / 128;
    const int nq = MT_ * 16, nkv = MT_ * 16;
    const float QSCALE = 0.10206207261596575f * 1.4426950408889634f;
    for (int u = blockIdx.x; u < nq + nkv; u += gridDim.x) {
        const bool isq = u < nq;
        const int uu = isq ? u : u - nq;
        const int xc_ = uu & 7, s_ = uu >> 3;
        const int m0 = (((s_ >> 4) << 3) + xc_) * 128, head = s_ & 15;
        const bool islat = m0 < NLAT;
        const int bb = islat ? (m0 >> 11) : ((m0 - NLAT) >> 8);
        const int kp0 = islat ? CTXL + (m0 & (SEQ - 1)) : ((m0 - NLAT) & (CTXL - 1));
        __syncthreads();
        if (isq) {
            f32x4 hold[2][6];
            float ssq[2] = {0.f, 0.f};
            gemm_tile<4, 1, 2, 6, false>([&](int r) { return CQ + (size_t)(m0 + r) * 256; }, (const bf16_t*)(a.ws + W_MUQ) + (size_t)head * 96 * 256, 256, 256, hold, ssq);
            const int tz = opaque_tid();
            const int wave = tz >> 6, fq = (tz >> 4) & 3, fr = tz & 15;
#pragma unroll
            for (int i = 0; i < 2; ++i) {
                const int m = wave * 32 + i * 16 + fr;
                float sq = ssq[i]; sq += __shfl_xor(sq, 16); sq += __shfl_xor(sq, 32);
                const float rs0 = rsqrtf(sq * (1.f / 256.f) + EPS);
                float ss = 0.f;
#pragma unroll
                for (int jn = 0; jn < 6; ++jn) { hold[i][jn] *= rs0;
#pragma unroll
                    for (int e = 0; e < 4; ++e) ss += hold[i][jn][e] * hold[i][jn][e]; }
                ss += __shfl_xor(ss, 16); ss += __shfl_xor(ss, 32);
                const float rs = rsqrtf(ss * (1.f / 96.f) + EPS) ;
                f32x4 o[6];
#pragma unroll
                for (int jn = 0; jn < 6; ++jn) { const f32x4 g4 = *(const f32x4*)(qkn + jn * 16 + fq * 4); o[jn] = hold[i][jn] * rs * g4; }
#pragma unroll
                for (int jn = 4; jn < 6; ++jn) {
                    f32x4 other;
#pragma unroll
                    for (int e = 0; e < 4; ++e) other[e] = __shfl_xor(o[jn][e], 32);
                    if (islat) {
                        const int s = (m0 + m) & (SEQ - 1);
                        const int pos = jn == 4 ? (s >> 6) : (s & 63);
                        const f32x4 cs = *(const f32x4*)(RC + pos * 8 + (fq & 1) * 4), sn = *(const f32x4*)(RS + pos * 8 + (fq & 1) * 4);
#pragma unroll
                        for (int e = 0; e < 4; ++e) o[jn][e] = (fq < 2) ? o[jn][e] * cs[e] - other[e] * sn[e] : o[jn][e] * cs[e] + other[e] * sn[e];
                    }
                }
#pragma unroll
                for (int jn = 0; jn < 6; ++jn) {
                    const f32x4 v = o[jn] * QSCALE;
                    u32x2 pv; pv[0] = pk2(v[0], v[1]); pv[1] = pk2(v[2], v[3]);
                    *(u32x2*)(lds + m * 256 + (((jn * 2 + (fq >> 1)) ^ (m & 15)) << 4) + (fq & 1) * 8) = pv;
                }
            }
            __syncthreads();
#pragma unroll
            for (int it = 0; it < 8; ++it) {
                const int idx = tz + it * NTHR, row = idx >> 4, ch = idx & 15;
                if (ch < 12) {
                    const u32x4 v = *(const u32x4*)(lds + row * 256 + ((ch ^ (row & 15)) << 4));
                    *(u32x4*)(Q + (size_t)(m0 + row) * 1536 + head * 96 + ch * 8) = v;
                }
            }
        } else {
            f32x4 hold[4][4];
            float ssq[4] = {0.f, 0.f, 0.f, 0.f};
            gemm_tile<2, 2, 4, 4, false>([&](int r) { return CKV + (size_t)(m0 + r) * 128; }, (const bf16_t*)(a.ws + W_MUKV) + (size_t)head * 128 * 128, 128, 128, hold, ssq);
            const int tz = opaque_tid();
            const int wave = tz >> 6, wm = wave >> 1, wn = wave & 1, fq = (tz >> 4) & 3, fr = tz & 15;
            char* sK = lds; char* sV = lds + 32768;
#pragma unroll
            for (int i = 0; i < 4; ++i) {
                const int m = wm * 64 + i * 16 + fr, t = m0 + m;
                float sq = ssq[i]; sq += __shfl_xor(sq, 16); sq += __shfl_xor(sq, 32);
                const float rs0 = rsqrtf(sq * (1.f / 128.f) + EPS);
#pragma unroll
                for (int jn = 0; jn < 4; ++jn) hold[i][jn] *= rs0;
                if (wn == 0) {
                    const int base = (fq >> 1) * 16 + (fq & 1) * 4;
                    const f32x4 z1 = *(const f32x4*)(KR + (size_t)t * 32 + base);
                    const f32x4 z2 = *(const f32x4*)(KR + (size_t)t * 32 + base + 8);
                    float ss = 0.f;
#pragma unroll
                    for (int jn = 0; jn < 4; ++jn)
#pragma unroll
                        for (int e = 0; e < 4; ++e) ss += hold[i][jn][e] * hold[i][jn][e];
#pragma unroll
                    for (int e = 0; e < 4; ++e) ss += z1[e] * z1[e] + z2[e] * z2[e];
                    ss += __shfl_xor(ss, 16); ss += __shfl_xor(ss, 32);
                    const float rs = rsqrtf(ss * (1.f / 96.f) + EPS);
#pragma unroll
                    for (int jn = 0; jn < 4; ++jn) {
                        const f32x4 g4 = *(const f32x4*)(qkn + 96 + jn * 16 + fq * 4);
                        const f32x4 v = hold[i][jn] * rs * g4;
                        u32x2 pv; pv[0] = pk2(v[0], v[1]); pv[1] = pk2(v[2], v[3]);
                        *(u32x2*)(sK + m * 256 + (((jn * 2 + (fq >> 1)) ^ (m & 15)) << 4) + (fq & 1) * 8) = pv;
                    }
                    const f32x4 g1 = *(const f32x4*)(qkn + 96 + 64 + base), g2 = *(const f32x4*)(qkn + 96 + 64 + base + 8);
                    f32x4 a1 = z1 * rs * g1, a2 = z2 * rs * g2;
                    if (islat) {
                        const int s = t & (SEQ - 1);
                        const int pos = (fq >> 1) == 0 ? (s >> 6) : (s & 63);
                        const f32x4 cs = *(const f32x4*)(RC + pos * 8 + (fq & 1) * 4), sn = *(const f32x4*)(RS + pos * 8 + (fq & 1) * 4);
                        const f32x4 b1 = a1 * cs - a2 * sn, b2 = a2 * cs + a1 * sn;
                        a1 = b1; a2 = b2;
                    }
                    u32x2 p1, p2; p1[0] = pk2(a1[0], a1[1]); p1[1] = pk2(a1[2], a1[3]); p2[0] = pk2(a2[0], a2[1]); p2[1] = pk2(a2[2], a2[3]);
                    const int c1 = 8 + (fq >> 1) * 2;
                    *(u32x2*)(sK + m * 256 + ((c1 ^ (m & 15)) << 4) + (fq & 1) * 8) = p1;
                    *(u32x2*)(sK + m * 256 + (((c1 + 1) ^ (m & 15)) << 4) + (fq & 1) * 8) = p2;
                }
                {
                    const bool odd = fr & 1;
                    const int mp = perm_key(m & ~1);
#pragma unroll
                    for (int jn = 0; jn < 4; ++jn) {
                        const f32x4 v = hold[i][jn];
                        const float r0 = __shfl_xor(odd ? v[0] : v[2], 1), r1 = __shfl_xor(odd ? v[1] : v[3], 1);
                        if (wn == 1) {
                            const int e0 = jn * 16 + fq * 4 + (odd ? 2 : 0);
                            const unsigned w0 = odd ? pk2(r0, v[2]) : pk2(v[0], r0), w1 = odd ? pk2(r1, v[3]) : pk2(v[1], r1);
                            *(unsigned*)(sV + e0 * 256 + (((mp >> 3) ^ (e0 & 15)) << 4) + (mp & 6) * 2) = w0;
                            *(unsigned*)(sV + (e0 + 1) * 256 + (((mp >> 3) ^ ((e0 + 1) & 15)) << 4) + (mp & 6) * 2) = w1;
                        }
                    }
                }
            }
            __syncthreads();
            bf16_t* kdst = Kb + ((size_t)(bb * 16 + head) * NKEY + kp0) * 96;
#pragma unroll
            for (int it = 0; it < 8; ++it) {
                const int idx = tz + it * NTHR, row = idx >> 4, ch = idx & 15;
                if (ch < 12) {
                    const u32x4 v = *(const u32x4*)(sK + row * 256 + ((ch ^ (row & 15)) << 4));
                    *(u32x4*)(kdst + (size_t)row * 96 + ch * 8) = v;
                }
            }
            bf16_t* vdst = VT + ((size_t)(bb * 16 + head) * 64) * NKEY + kp0;
#pragma unroll
            for (int it = 0; it < 4; ++it) {
                const int idx = tz + it * NTHR, row = idx >> 4, ch = idx & 15;
                const u32x4 v = *(const u32x4*)(sV + row * 256 + ((ch ^ (row & 15)) << 4));
                *(u32x4*)(vdst + (size_t)row * NKEY + ch * 8) = v;
            }
        }
    }
}

DI void phase_mla_attn(const Args& a) {
    const int tid = threadIdx.x, lane = tid & 63, wave = tid >> 6;
    const int r = lane & 31, h = lane >> 5;
    const bf16_t* Q = (const bf16_t*)(a.ws + MLA_Q); const bf16_t* Kb = (const bf16_t*)(a.ws + MLA_K); const bf16_t* VT = (const bf16_t*)(a.ws + MLA_VT);
    bf16_t* O = (bf16_t*)(a.ws + MLA_O);
    constexpr int KT_B = 64 * 192, VT_B = 64 * 128, ST_B = KT_B + VT_B;
    unsigned* sCv = (unsigned*)(lds + 49152);
    const int cv_per = 18432 / gridDim.x;
    int cvn = 0, itc = 0;
    bool cv_pack_p = false, cv_flush_p = false;
    CvTile cvB, cvC; cvB.src = nullptr; cvB.dst = nullptr; cvB.K = 0; cvB.N = 0; cvB.perm = 0; cvB.k0 = 0; cvB.n0 = 0; cvC = cvB;
    f32x4 cv0[4], cv1[4];
#pragma unroll
    for (int i = 0; i < 4; ++i) { cv0[i] = (f32x4){0.f, 0.f, 0.f, 0.f}; cv1[i] = cv0[i]; }
    auto cv_step = [&](bool may_load) {
        if (cv_flush_p) { cv_flush(cvC, sCv); cv_flush_p = false; }
        if (cv_pack_p) { cv_pack(sCv, cv0, cv1); cvC = cvB; cv_flush_p = true; cv_pack_p = false; }
        if (may_load && cvn < cv_per) {
            const int t = cvn * gridDim.x + blockIdx.x;
            cvB = moe_cv_tile(a, 1 + t / 6144, t % 6144); cv_load(cvB, cv0, cv1); cv_pack_p = true; ++cvn;
        }
    };
    for (int u = blockIdx.x; u < 2048 + 256; u += gridDim.x) {
        const bool isctx = u >= 2048;
        const int uu = isctx ? u - 2048 : u;
        const int xc_ = uu & 7, s_ = uu >> 3, bh_ = ((s_ >> 4) << 3) + xc_;
        const int qb = isctx ? (uu & 1) : (s_ & 15), head = isctx ? ((uu >> 1) & 15) : (bh_ & 15), b = isctx ? (uu >> 5) : (bh_ >> 4);
        const int ntile = isctx ? CTXL / 64 : NKEY / 64;
        const int t = (isctx ? NLAT + b * CTXL : b * SEQ) + qb * 128 + wave * 32 + r;
        const bf16_t* kbase = Kb + (size_t)(b * 16 + head) * NKEY * 96;
        const bf16_t* vbase = VT + (size_t)(b * 16 + head) * 64 * NKEY;
        bf16x8 qf[6];
#pragma unroll
        for (int kk = 0; kk < 6; ++kk) qf[kk] = *(const bf16x8*)(Q + (size_t)t * 1536 + head * 96 + kk * 16 + h * 8);
        f32x16 o[2];
#pragma unroll
        for (int e = 0; e < 16; ++e) { o[0][e] = 0.f; o[1][e] = 0.f; }
        float lsum = 0.f;
        __syncthreads();
        auto stage = [&](int kt, int buf) {
            char* sk = lds + buf * ST_B; char* sv = sk + KT_B;
            const int key0 = kt * 64;
#pragma unroll
            for (int i = 0; i < 3; ++i) {
                const int idx = tid + i * NTHR, row = idx / 12, slot = idx - row * 12;
                int c = slot - ((row >> 2) % 12); if (c < 0) c += 12;
                dma16(kbase + (size_t)(key0 + row) * 96 + c * 8, sk + idx * 16);
            }
#pragma unroll
            for (int i = 0; i < 2; ++i) {
                const int idx = tid + i * NTHR, row = idx >> 3, c = (idx & 7) ^ ((row >> 1) & 7);
                dma16(vbase + (size_t)row * NKEY + key0 + c * 8, sv + idx * 16);
            }
        };
        stage(0, 0);
#pragma unroll 1
        for (int kt = 0; kt < ntile; ++kt) {
            wait_vm0();
            __syncthreads();
            if (kt + 1 < ntile) stage(kt + 1, (kt + 1) & 1);
            cv_step((itc & 3) == 0); ++itc;
            const char* sk = lds + (kt & 1) * ST_B; const char* sv = sk + KT_B;
            f32x16 st[2];
#pragma unroll
            for (int e = 0; e < 16; ++e) { st[0][e] = -8.f; st[1][e] = -8.f; }
#pragma unroll
            for (int kk = 0; kk < 6; ++kk)
#pragma unroll
                for (int si = 0; si < 2; ++si) {
                    const int s = si * 32 + r;
                    int slot = kk * 2 + h + ((s >> 2) % 12); if (slot >= 12) slot -= 12;
                    st[si] = mfma32(ldsv8(sk + s * 192 + slot * 16), qf[kk], st[si]);
                }
            float ps = 0.f;
#pragma unroll
            for (int si = 0; si < 2; ++si)
#pragma unroll
                for (int e = 0; e < 16; ++e) { const float p = __builtin_amdgcn_exp2f(st[si][e]); st[si][e] = p; ps += p; }
            lsum += ps;
#pragma unroll
            for (int si = 0; si < 2; ++si)
#pragma unroll
                for (int ks = 0; ks < 2; ++ks) {
                    u32x4 pp;
                    pp[0] = pk2(st[si][8 * ks + 0], st[si][8 * ks + 1]); pp[1] = pk2(st[si][8 * ks + 2], st[si][8 * ks + 3]);
                    pp[2] = pk2(st[si][8 * ks + 4], st[si][8 * ks + 5]); pp[3] = pk2(st[si][8 * ks + 6], st[si][8 * ks + 7]);
                    const bf16x8 pf = __builtin_bit_cast(bf16x8, pp);
#pragma unroll
                    for (int et = 0; et < 2; ++et) {
                        const int e = et * 32 + r;
                        o[et] = mfma32(ldsv8(sv + e * 128 + (((si * 4 + ks * 2 + h) ^ ((e >> 1) & 7)) << 4)), pf, o[et]);
                    }
                }
        }
        lsum += __shfl_xor(lsum, 32);
        const float inv = 1.f / lsum;
#pragma unroll
        for (int et = 0; et < 2; ++et)
#pragma unroll
            for (int g = 0; g < 4; ++g) {
                f32x4 v; v[0] = o[et][4 * g] * inv; v[1] = o[et][4 * g + 1] * inv; v[2] = o[et][4 * g + 2] * inv; v[3] = o[et][4 * g + 3] * inv;
                st_bf4(O + (size_t)t * D + head * 64 + et * 32 + 8 * g + 4 * h, v);
            }
    }
    while (cvn < cv_per || cv_pack_p || cv_flush_p) { __syncthreads(); cv_step(!cv_pack_p && !cv_flush_p); }
}

DI void phase_mla_out(const Args& a, int li) {
    gemm_dense_phase((const bf16_t*)(a.ws + MLA_O), D, NTOK, (const bf16_t*)(a.ws + W_MO), 1024, 1024,
        [&](int m0, int n0, const f32x4 (&acc)[4][4]) { epi_resid_f32(a, li, m0, n0, acc); });
}

DI void phase_ml_in(const Args& a) {
    bf16_t* Qm = (bf16_t*)(a.ws + ML_Q); bf16_t* Km = (bf16_t*)(a.ws + ML_K); bf16_t* VT = (bf16_t*)(a.ws + ML_VT);
    bf16_t* OG = (bf16_t*)(a.ws + ML_OG); float* GT = (float*)(a.ws + ML_GT);
    const float* gb = a.in[23];
    auto ident = [](int, int, const f32x4 v) { return v; };
    gemm_dense_phase<false>((const bf16_t*)(a.ws + WS_H), D, NTOK, (const bf16_t*)(a.ws + W_MLIN), 3200, 1024,
        [&](int m0, int n0, const f32x4 (&acc)[4][4]) {
            if (n0 < 512) {
                epi_bf16_rowmajor(acc, [](int, int, const f32x4 v) { return v * 0.08838834764831845f; }, [&](int row) { return Qm + (size_t)(m0 + row) * 512 + n0; });
            } else if (n0 < 1024) {
                epi_bf16_rowmajor(acc, ident, [&](int row) { return Km + (size_t)(m0 + row) * 512 + (n0 - 512); });
            } else if (n0 < 2048) {
                __syncthreads();
                epi_stage_bf16_T(acc, ident);
                __syncthreads();
                epi_flush_bf16([&](int row) { return VT + (size_t)(n0 - 1024 + row) * NTOK + m0; }, [](int) { return true; });
            } else if (n0 < 3072) {
                epi_bf16_rowmajor(acc, [](int, int, const f32x4 v) { f32x4 s; s[0] = sigmoidf_(v[0]); s[1] = sigmoidf_(v[1]); s[2] = sigmoidf_(v[2]); s[3] = sigmoidf_(v[3]); return s; },
                                  [&](int row) { return OG + (size_t)(m0 + row) * D + (n0 - 2048); });
            } else {
#pragma unroll
                for (int i = 0; i < 4; ++i) {
                    const int n = lane_n(0);
                    if (n < 16) { f32x4 s = acc[i][0]; s[0] += gb[n]; s[1] += gb[n + 1]; s[2] += gb[n + 2]; s[3] += gb[n + 3]; *(f32x4*)(GT + (size_t)(m0 + lane_m(i)) * 16 + n) = s; }
                }
            }
        });
}

template <int VAR = 0>
DI void phase_ml_scan(const Args& a) {
    const int tid = threadIdx.x, lane = tid & 63, wave = tid >> 6;
    const int fr = lane & 15, fq = lane >> 4;
    const bf16_t* Qm = (const bf16_t*)(a.ws + ML_Q); const bf16_t* Km = (const bf16_t*)(a.ws + ML_K);
    const bf16_t* VT = (const bf16_t*)(a.ws + ML_VT);
    const float* GT = (const float*)(a.ws + ML_GT);
    bf16_t* HS = (bf16_t*)(a.ws + (VAR ? WS_Y : ML_HS));
    char* sQ = lds;
    char* sK = lds + 16384;
    char* sS = lds + 32768;
    char* sVT = lds + 40960;
    char* sCT = lds + 47104;
    float* sRow = (float*)(lds + 59392);
    float* sCol = sRow + 64;
    float* sInt = sCol + 64;
    float* sNrm = sInt + 64;
    float* sWv = sNrm + 64;
    float* sSc = sWv + 64;
    for (int u = blockIdx.x; u < 512; u += gridDim.x) {
        const int xc_ = u & 7, s_ = u >> 3, bh_ = ((s_ >> 4) << 3) + xc_;
        const int sl = s_ & 7, dir = (s_ >> 3) & 1, head = bh_ & 3, b = bh_ >> 2;
        auto chunk_t0 = [&](int ci) {
            const int seg = ci >= 4, L = seg ? SEQ : CTXL, nch = L / 64, jc = seg ? ci - 4 : ci;
            const int oc = dir ? nch - 1 - jc : jc;
            return (seg ? b * SEQ : NLAT + b * CTXL) + oc * 64;
        };
        u32x4 pq[4], pk[4], pvt;
        float g_bc = 0.f, g_av = 0.f, g_pm = 0.f;
        auto load_tiles = [&](int t0) {
            const int tid = opaque_tid();
#pragma unroll
            for (int i = 0; i < 4; ++i) {
                const int idx = tid + i * NTHR, row = idx >> 4, c = (idx & 15) ^ (row & 15), ck = (idx & 15) ^ trswz(row);
                pq[i] = *(const u32x4*)(Qm + (size_t)(t0 + row) * 512 + head * 128 + c * 8);
                pk[i] = *(const u32x4*)(Km + (size_t)(t0 + row) * 512 + head * 128 + ck * 8);
            }
            { const int row = tid >> 3, c = (tid & 7) ^ (row & 7); pvt = *(const u32x4*)(VT + (size_t)(head * 256 + sl * 32 + row) * NTOK + t0 + c * 8); }
        };
        auto load_gates = [&](int ci) {
            if (wave == 0) { const float* g = (const float*)(a.ws + WS_GS) + ((size_t)u * 36 + ci) * 192 + lane; g_bc = g[0]; g_av = g[64]; g_pm = g[128]; }
        };
        auto store_tiles = [&]() {
            const int tid = opaque_tid();
#pragma unroll
            for (int i = 0; i < 4; ++i) { *(u32x4*)(sQ + (tid + i * NTHR) * 16) = pq[i]; *(u32x4*)(sK + (tid + i * NTHR) * 16) = pk[i]; }
            *(u32x4*)(sVT + tid * 16) = pvt;
        };
        auto gate_scalars = [&]() {
            const int s = dir ? 63 - lane : lane;
            const float bc = g_bc, av = g_av, pm = g_pm;
            const float mst = sSc[1];
            const float mm = fmaxf(mst, pm);
            sRow[s] = -mm;
            sCol[s] = av;
            sInt[s] = fexp(mst - mm);
            sNrm[s] = fexp(-(bc + mm));
            const float mmL = __shfl(mm, 63), bL = __shfl(bc, 63);
            sWv[s] = fexp(av - mmL);
            if (lane == 0) { sSc[0] = fexp(mst - mmL); sSc[1] = bL + mmL; }
        };
#pragma unroll 1
        for (int ci = wave; ci < 36; ci += 4) {
            const int t0 = chunk_t0(ci);
            const int s = dir ? 63 - lane : lane;
            const float ig = GT[(size_t)(t0 + s) * 16 + dir * 8 + head];
            const float fg = GT[(size_t)(t0 + s) * 16 + dir * 8 + 4 + head];
            const float lf = fminf(fg, 0.f) - __logf(1.f + fexp(-fabsf(fg)));
            float bc = lf;
#pragma unroll
            for (int d = 1; d < 64; d <<= 1) { const float o = __shfl_up(bc, d); if (lane >= d) bc += o; }
            const float av = ig - bc;
            float pm = av;
#pragma unroll
            for (int d = 1; d < 64; d <<= 1) { const float o = __shfl_up(pm, d); if (lane >= d) pm = fmaxf(pm, o); }
            float* g = (float*)(a.ws + WS_GS) + ((size_t)u * 36 + ci) * 192 + lane; g[0] = bc; g[64] = av; g[128] = pm;
        }
        __syncthreads();
        for (int i = tid; i < 12288 / 16; i += NTHR) *(u32x4*)(sCT + i * 16) = (u32x4){0u, 0u, 0u, 0u};
        for (int i = tid; i < 16 * 8; i += NTHR) {
            const int row = 32 + (i >> 3), c = i & 7;
            const unsigned v = row == 32 ? 0x3f803f80u : 0u;
            *(u32x4*)(sVT + swz128(row, c)) = (u32x4){v, v, v, v};
        }
        if (tid == 0) sSc[1] = -1e30f;
        f32x4 accC[2][3];
#pragma unroll
        for (int i = 0; i < 2; ++i)
#pragma unroll
            for (int jn = 0; jn < 3; ++jn) accC[i][jn] = (f32x4){0.f, 0.f, 0.f, 0.f};
        load_tiles(chunk_t0(0));
        __syncthreads();
        load_gates(0);
        store_tiles();
        if (wave == 0) gate_scalars();
        __syncthreads();
#pragma unroll 1
        for (int ci = 0; ci < 36; ++ci) {
            const int t0 = chunk_t0(ci);
            if (!(VAR & 8) && ci + 1 < 36) { load_tiles(chunk_t0(ci + 1)); load_gates(ci + 1); }
            f32x4 sacc[4];
#pragma unroll
            for (int jt = 0; jt < 4; ++jt) sacc[jt] = (f32x4){0.f, 0.f, 0.f, 0.f};
#pragma unroll
            for (int kk = 0; kk < 4; ++kk) {
                const bf16x8 qf = ldsv8(sQ + swz256(wave * 16 + fr, kk * 4 + fq));
#pragma unroll
                for (int jt = 0; jt < 4; ++jt) { const int sr = jt * 16 + fr; sacc[jt] = mfma16(ldsv8(sK + sr * 256 + (((kk * 4 + fq) ^ trswz(sr)) << 4)), qf, sacc[jt]); }
            }
            {
                const int tq = wave * 16 + fr;
                const float rt = sRow[tq];
#pragma unroll
                for (int jt = 0; jt < 4; ++jt) {
                    const f32x4 cl = *(const f32x4*)(sCol + jt * 16 + fq * 4);
                    f32x4 v;
#pragma unroll
                    for (int e = 0; e < 4; ++e) {
                        const int s = jt * 16 + fq * 4 + e;
                        const bool ok = dir ? (s >= tq) : (s <= tq);
                        v[e] = ok ? sacc[jt][e] * fexp(rt + cl[e]) : 0.f;
                    }
                    u32x2 pv; pv[0] = pk2(v[0], v[1]); pv[1] = pk2(v[2], v[3]);
                    *(u32x2*)(sS + swz128(tq, jt * 2 + (fq >> 1)) + (fq & 1) * 8) = pv;
                }
            }
            lds_barrier();
            if (!(VAR & 2)) {
                f32x4 n1[3], n2[3];
#pragma unroll
                for (int jt = 0; jt < 3; ++jt) { n1[jt] = (f32x4){0.f, 0.f, 0.f, 0.f}; n2[jt] = (f32x4){0.f, 0.f, 0.f, 0.f}; }
#pragma unroll
                for (int kk = 0; kk < 2; ++kk) {
                    const bf16x8 sf = ldsv8(sS + swz128(wave * 16 + fr, kk * 4 + fq));
#pragma unroll
                    for (int jt = 0; jt < 3; ++jt) n1[jt] = mfma16(ldsv8(sVT + swz128(jt * 16 + fr, kk * 4 + fq)), sf, n1[jt]);
                }
#pragma unroll
                for (int kk = 0; kk < 4; ++kk) {
                    const bf16x8 qf = ldsv8(sQ + swz256(wave * 16 + fr, kk * 4 + fq));
#pragma unroll
                    for (int jt = 0; jt < 3; ++jt) n2[jt] = mfma16(ldsv8(sCT + swz256(jt * 16 + fr, kk * 4 + fq)), qf, n2[jt]);
                }
                const int tq = wave * 16 + fr;
                const float it = sInt[tq];
                float den = n1[2][0] + it * n2[2][0];
                den = __shfl(den, fr);
                const float dn = fmaxf(fabsf(den), sNrm[tq]);
                const float inv = rcpf_(dn);
                bf16_t* hp = HS + (size_t)dir * NTOK * D + (size_t)(t0 + tq) * D + head * 256 + sl * 32 + fq * 4;
#pragma unroll
                for (int jt = 0; jt < 2; ++jt) {
                    f32x4 v;
#pragma unroll
                    for (int e = 0; e < 4; ++e) v[e] = (n1[jt][e] + it * n2[jt][e]) * inv;
                    st_bf4(hp + jt * 16, v);
                }
            }
            if (!(VAR & 4)) {
                const float decay = sSc[0];
#pragma unroll
                for (int i = 0; i < 2; ++i)
#pragma unroll
                    for (int jn = 0; jn < 3; ++jn) accC[i][jn] *= decay;
#pragma unroll
                for (int kk = 0; kk < 2; ++kk) {
                    bf16x8 vf[3];
#pragma unroll
                    for (int jn = 0; jn < 3; ++jn) vf[jn] = ldsv8(sVT + swz128(jn * 16 + fr, kk * 4 + fq));
                    const f32x4 w0 = *(const f32x4*)(sWv + kk * 32 + fq * 8), w1 = *(const f32x4*)(sWv + kk * 32 + fq * 8 + 4);
#pragma unroll
                    for (int i = 0; i < 2; ++i) {
                        const int tq_ = (lane >> 2) & 3, tp_ = lane & 3, chd = (wave * 2 + i) * 2 + (tp_ >> 1);
                        const int sA_ = kk * 32 + 8 * fq + tq_, sB_ = sA_ + 4;
                        const s16x4 klo = lds_tr(sK + sA_ * 256 + ((chd ^ trswz(sA_)) << 4) + (tp_ & 1) * 8);
                        const s16x4 khi = lds_tr(sK + sB_ * 256 + ((chd ^ trswz(sB_)) << 4) + (tp_ & 1) * 8);
                        const u32x4 kr = __builtin_bit_cast(u32x4, __builtin_shufflevector(klo, khi, 0, 1, 2, 3, 4, 5, 6, 7));
                        u32x4 ks;
                        ks[0] = pk2(lof(kr[0]) * w0[0], hif(kr[0]) * w0[1]); ks[1] = pk2(lof(kr[1]) * w0[2], hif(kr[1]) * w0[3]);
                        ks[2] = pk2(lof(kr[2]) * w1[0], hif(kr[2]) * w1[1]); ks[3] = pk2(lof(kr[3]) * w1[2], hif(kr[3]) * w1[3]);
                        const bf16x8 kf = __builtin_bit_cast(bf16x8, ks);
#pragma unroll
                        for (int jn = 0; jn < 3; ++jn) accC[i][jn] = mfma16(kf, vf[jn], accC[i][jn]);
                    }
                }
            }
            lds_barrier();
#pragma unroll
            for (int i = 0; i < 2; ++i)
#pragma unroll
                for (int jn = 0; jn < 3; ++jn) {
                    const int dd = (wave * 2 + i) * 16 + fq * 4, ee = jn * 16 + fr;
                    u32x2 pv; pv[0] = pk2(accC[i][jn][0], accC[i][jn][1]); pv[1] = pk2(accC[i][jn][2], accC[i][jn][3]);
                    *(u32x2*)(sCT + swz256(ee, dd >> 3) + (dd & 7) * 2) = pv;
                }
            if (ci + 1 < 36) {
                if (!(VAR & 8)) store_tiles();
                if (wave == 0 && !(VAR & 16)) gate_scalars();
            }
            lds_barrier();
        }
    }
}

DI void phase_ml_readout(const Args& a) {
    const int tid = threadIdx.x, lane = tid & 63, wave = tid >> 6;
    const bf16_t* H0 = (const bf16_t*)(a.ws + ML_HS); const bf16_t* H1 = H0 + (size_t)NTOK * D;
    const bf16_t* OG = (const bf16_t*)(a.ws + ML_OG); bf16_t* A2 = (bf16_t*)(a.ws + ML_A2);
    const float* on = a.in[24];
    for (int t = blockIdx.x * 4 + wave; t < NTOK; t += gridDim.x * 4) {
        const size_t off = (size_t)t * D + lane * 16;
        const u32x4 a0 = *(const u32x4*)(H0 + off), a1 = *(const u32x4*)(H0 + off + 8);
        const u32x4 b0 = *(const u32x4*)(H1 + off), b1 = *(const u32x4*)(H1 + off + 8);
        float v[16];
#pragma unroll
        for (int e = 0; e < 4; ++e) {
            v[2 * e] = lof(a0[e]) + lof(b0[e]); v[2 * e + 1] = hif(a0[e]) + hif(b0[e]);
            v[8 + 2 * e] = lof(a1[e]) + lof(b1[e]); v[8 + 2 * e + 1] = hif(a1[e]) + hif(b1[e]);
        }
        float ss = 0.f;
#pragma unroll
        for (int e = 0; e < 16; ++e) ss += v[e] * v[e];
        ss += __shfl_xor(ss, 1); ss += __shfl_xor(ss, 2); ss += __shfl_xor(ss, 4); ss += __shfl_xor(ss, 8);
        const float rs = rsqrtf(ss * (1.f / 256.f) + EPS);
        const u32x4 g0 = *(const u32x4*)(OG + off), g1 = *(const u32x4*)(OG + off + 8);
        const float* onp = on + lane * 16;
        u32x4 o0, o1;
#pragma unroll
        for (int e = 0; e < 4; ++e) {
            o0[e] = pk2(v[2 * e] * rs * onp[2 * e] * lof(g0[e]), v[2 * e + 1] * rs * onp[2 * e + 1] * hif(g0[e]));
            o1[e] = pk2(v[8 + 2 * e] * rs * onp[8 + 2 * e] * lof(g1[e]), v[8 + 2 * e + 1] * rs * onp[8 + 2 * e + 1] * hif(g1[e]));
        }
        *(u32x4*)(A2 + off) = o0; *(u32x4*)(A2 + off + 8) = o1;
    }
}

DI void phase_ml_out(const Args& a, int li) {
    gemm_dense_phase((const bf16_t*)(a.ws + ML_A2), D, NTOK, (const bf16_t*)(a.ws + W_MLOUT), 1024, 1024,
        [&](int m0, int n0, const f32x4 (&acc)[4][4]) { epi_resid_f32(a, li, m0, n0, acc); });
}

template <int STAGE>
DI void phase_moe(const Args& a, int li) {
    const int tid = threadIdx.x, lane = tid & 63, wave = tid >> 6;
    const int fr = lane & 15, fq = lane >> 4, wm = wave >> 1, wn = wave & 1;
    const int* cnt = (const int*)(a.ws + WS_CTL + CTL_CNT) + li * 64;
    const int* list = (const int*)(a.ws + WS_LIST);
    const float* wsl = (const float*)(a.ws + WS_WSLOT);
    const bf16_t* F = (const bf16_t*)(a.ws + WS_H);
    bf16_t* HM = (bf16_t*)(a.ws + WS_HMID); bf16_t* Y = (bf16_t*)(a.ws + WS_Y);
    int* pre = (int*)(lds + LDS_AUX);
    int* srowb = pre + 16;
    const int xc = blockIdx.x & 7, rank = blockIdx.x >> 3, nrank = gridDim.x >> 3;
    __syncthreads();
    if (tid == 0) { int s = 0; for (int i = 0; i < 8; ++i) { pre[i] = s; s += (cnt[xc + 8 * i] + 127) >> 7; } pre[8] = s; }
    __syncthreads();
    const int T = pre[8];
    constexpr int NTN = STAGE == 0 ? 4 : 8;
    constexpr int KK = STAGE == 0 ? 1024 : 256;
    const int total = T * NTN;
    int e = 0, r0 = 0, ce = 0, nt = 0, cur = 0;
    auto decode = [&](int u) {
        const int ti = u / NTN; nt = u % NTN;
        int ei = 0;
#pragma unroll 1
        for (int s = 4; s > 0; s >>= 1) if (pre[ei + s] <= ti) ei += s;
        e = xc + 8 * ei; r0 = (ti - pre[ei]) * 128; ce = cnt[e];
    };
    GemmPipe g;
    auto prep = [&](int buf) {
        int* srow = srowb + buf * 128;
        if (tid < 128) srow[tid] = list[(size_t)e * NTOK + min(r0 + tid, ce - 1)];
        __syncthreads();
        if (STAGE == 0) g.setup([&](int r) { return F + (size_t)(srow[r] >> 1) * D; }, (const bf16_t*)(a.ws + W_GU) + ((size_t)(li * 64 + e) * 512 + nt * 128) * 1024, 1024);
        else g.setup([&](int r) { return HM + (size_t)srow[r] * 256; }, (const bf16_t*)(a.ws + W_DN) + ((size_t)(li * 64 + e) * 1024 + nt * 128) * 256, 256);
        g.issue(0, 0);
    };
    int u = rank;
    if (u < total) { decode(u); prep(cur); }
    while (u < total) {
        f32x4 acc[4][4];
        g.run(KK, acc);
        const int cr0 = r0, cce = ce, cnt_ = nt;
        const int* srow = srowb + cur * 128;
        u += nrank;
        if (u < total) { decode(u); prep(cur ^ 1); }
        if (STAGE == 0) {
            __syncthreads();
            {
                const int tz = opaque_tid();
#pragma unroll
                for (int i = 0; i < 4; ++i) {
                    const int m = lane_m(tz, i);
#pragma unroll
                    for (int p = 0; p < 2; ++p) {
                        const int c = (((tz >> 6) & 1) * 2 + p) * 16 + ((tz >> 4) & 3) * 4;
                        f32x4 v;
#pragma unroll
                        for (int x = 0; x < 4; ++x) { const float gg = acc[i][2 * p][x]; v[x] = gg * rcpf_(1.f + fexp(-gg)) * acc[i][2 * p + 1][x]; }
                        u32x2 o; o[0] = pk2(v[0], v[1]); o[1] = pk2(v[2], v[3]);
                        *(u32x2*)(lds + EPI_OFF + m * 128 + (((c >> 3) ^ (m & 7)) << 4) + (c & 4) * 2) = o;
                    }
                }
            }
            __syncthreads();
            {
                const int tz = opaque_tid();
#pragma unroll
                for (int it = 0; it < 4; ++it) {
                    const int idx = tz + it * NTHR, row = idx >> 3, ch = idx & 7;
                    const u32x4 v = *(const u32x4*)(lds + EPI_OFF + row * 128 + ((ch ^ (row & 7)) << 4));
                    if (cr0 + row < cce) *(u32x4*)(HM + (size_t)srow[row] * 256 + cnt_ * 64 + ch * 8) = v;
                }
            }
        } else {
            float wrow[4];
            {
                const int tz = opaque_tid();
#pragma unroll
                for (int i = 0; i < 4; ++i) wrow[i] = wsl[srow[lane_m(tz, i)]];
            }
            __syncthreads();
            epi_stage_bf16(acc, [&](int i, int, const f32x4 v) { return v * wrow[i]; });
            __syncthreads();
            epi_flush_bf16([&](int row) { return Y + (size_t)srow[row] * D + cnt_ * 128; }, [&](int row) { return cr0 + row < cce; });
        }
        cur ^= 1;
    }
    __syncthreads();
}

#ifndef DBG_GPROBE
#define DBG_GPROBE -1
#endif
template <int PM>
DI void phase_gemm_probe(const Args& a) {
    const bf16_t* A = (const bf16_t*)(a.ws + WS_H); const bf16_t* Bt = (const bf16_t*)(a.ws + W_RGIN);
    float* dummy = (float*)(a.ws + RG_A2);
    const int mt = 144, nt = 16, K = 1024;
    GemmPipe g;
    __syncthreads();
    for (int u = blockIdx.x; u < mt * nt; u += gridDim.x) {
        const int m0 = (u % mt) * 128, n0 = (u / mt) * 128;
        g.setup([&](int r) { return A + (size_t)(m0 + r) * 1024; }, Bt + (size_t)n0 * K, K);
        if (PM & 1) g.issue(0, 0);
        f32x4 acc[4][4];
        g.run_probe<PM>(K, acc);
        float s = 0.f;
#pragma unroll
        for (int i = 0; i < 4; ++i)
#pragma unroll
            for (int j = 0; j < 4; ++j) s += acc[i][j][0] + acc[i][j][1] + acc[i][j][2] + acc[i][j][3];
        if (s == 12345.678f) dummy[threadIdx.x] = s;
        if (PM & 8) {
            bf16_t* Yd = (bf16_t*)(a.ws + WS_Y);
            const int lane = threadIdx.x & 63, wave = threadIdx.x >> 6;
            const int mb = m0 + (wave >> 1) * 64 + (lane & 15), nb = n0 + (wave & 1) * 64 + (lane >> 4) * 4;
#pragma unroll
            for (int i = 0; i < 4; ++i)
#pragma unroll
                for (int j = 0; j < 4; ++j) {
                    f32x4 v = acc[i][j];
                    if (PM & 16) { v[0] = gelu_tanh(v[0]); v[1] = gelu_tanh(v[1]); v[2] = gelu_tanh(v[2]); v[3] = gelu_tanh(v[3]); }
                    st_bf4(Yd + (size_t)(mb + i * 16) * 2048 + nb + j * 16, v);
                }
        }
        __syncthreads();
    }
}

#ifndef DBG_STOP
#define DBG_STOP 99
#endif
#ifndef DBG_OFF
#define DBG_OFF 0
#endif
DI void phase_dbg(const Args& a) {
    const size_t n = (size_t)NLAT * D;
    const bf16_t* X = (const bf16_t*)(a.ws + WS_X);
    const bf16_t* B = (const bf16_t*)(a.ws + (size_t)DBG_OFF);
    for (size_t i = (size_t)blockIdx.x * NTHR + threadIdx.x; i < n; i += (size_t)gridDim.x * NTHR)
        a.out[i] = DBG_OFF ? bf2f(B[i]) : bf2f(X[i]);
}

constexpr int NPH = 34;
__global__ void __launch_bounds__(NTHR, 2) fwd(const Args a) {
    if (threadIdx.x == 0) *(uint4*)(lds + LDS_BARW) = make_uint4(0u, 0u, 0u, 0u);
    __syncthreads();
    XcdBarrier bar;
    const bool multi = (a.ph_hi - a.ph_lo) > 1;
    if (multi) bar = xcd_barrier_post((unsigned*)(a.ws + WS_CTL), (volatile LAS unsigned*)(lds + LDS_BARW));
#ifndef DBG_REP
#define DBG_REP -1
#endif
#ifndef DBG_REPN
#define DBG_REPN 3
#endif
#define RUN(id, ...) do { if (a.ph_lo <= (id) && (id) < a.ph_hi) { \
        if ((id) == DBG_REP) { for (int rep_ = 1; rep_ < DBG_REPN; ++rep_) { __VA_ARGS__; xcd_barrier(bar); } } \
        __VA_ARGS__; if ((id) + 1 < a.ph_hi) xcd_barrier(bar); } } while (0)
    RUN(0, phase_prologue(a));
    RUN(1, phase_token_row<0>(a, 0));
    RUN(2, phase_rg_in(a, 0));
    if (DBG_GPROBE >= 0) { RUN(2, phase_gemm_probe<(DBG_GPROBE < 0 ? 7 : DBG_GPROBE)>(a)); }
#ifdef DBG_SCANVAR
    RUN(3, phase_rg_scan<DBG_SCANVAR>(a, 0));
#endif
    RUN(3, phase_rg_scan(a, 0));
    RUN(4, phase_rg_combine(a));
    RUN(5, phase_rg_out(a, 0, 0));
    RUN(6, phase_token_router<36>(a, 0));
#ifdef DBG_T2DRY
    RUN(6, phase_token_router<36>(a, 0, true));
    RUN(6, phase_token_router<36>(a, 0, true));
#endif
    RUN(7, phase_moe<0>(a, 0));
    RUN(8, phase_moe<1>(a, 0));
    RUN(9, phase_token_row<0>(a, 1));
    RUN(10, phase_mla_down(a));
    RUN(11, phase_mla_up(a));
    RUN(12, phase_mla_attn(a));
    RUN(13, phase_mla_out(a, 1));
    RUN(14, phase_token_router<36>(a, 1));
    RUN(15, phase_moe<0>(a, 1));
    RUN(16, phase_moe<1>(a, 1));
    RUN(17, phase_token_row<0>(a, 2));
    RUN(18, phase_ml_in(a));
#ifdef DBG_MLVAR
    RUN(19, phase_ml_scan<DBG_MLVAR>(a));
#endif
    RUN(19, phase_ml_scan(a));
    RUN(20, phase_ml_readout(a));
    RUN(21, phase_ml_out(a, 2));
    RUN(22, phase_token_router<36>(a, 2));
    RUN(23, phase_moe<0>(a, 2));
    RUN(24, phase_moe<1>(a, 2));
    RUN(25, phase_token_row<0>(a, 3));
    RUN(26, phase_rg_in(a, 1));
    RUN(27, phase_rg_scan(a, 1));
    RUN(28, phase_rg_combine(a));
    RUN(29, phase_rg_out(a, 3, 1));
    RUN(30, phase_token_router<32>(a, 3));
    RUN(31, phase_moe<0>(a, 3));
    RUN(32, phase_moe<1>(a, 3));
    RUN(33, phase_token_row<2>(a, 3));
    RUN(34, phase_dbg(a));
#undef RUN
}

static void add_td(Args& a, int& n, int& tile0, const float* src, bf16_t* dst, const float* rscale, long sb, long db, int K, int N, int Npad, int batch, int perm) {
    TDesc& t = a.td[n++];
    t.src = src; t.dst = dst; t.rscale = rscale; t.sb = sb; t.db = db; t.K = K; t.N = N; t.Npad = Npad; t.batch = batch; t.perm = perm;
    t.tiles_k = (K + 127) / 128; t.tiles_n = (Npad + 63) / 64; t.tile0 = tile0;
    tile0 += batch * t.tiles_k * t.tiles_n;
}

extern "C" void kernel_launch(void* const* d_in, const int* in_sizes, int n_in, void* d_out, int out_size, void* d_ws, size_t ws_size, hipStream_t stream) {
    static int grid = 0;
    if (grid == 0) {
        if (n_in != 32 || out_size != NLAT * D || ws_size < WS_END) { fprintf(stderr, "kernel_launch: unexpected sizes (n_in %d out %d ws %zu need %zu)\n", n_in, out_size, ws_size, (size_t)WS_END); grid = -1; return; }
        int dev = 0, cus = 0, per_cu = 0;
        (void)hipGetDevice(&dev);
        (void)hipDeviceGetAttribute(&cus, hipDeviceAttributeMultiprocessorCount, dev);
        if (hipOccupancyMaxActiveBlocksPerMultiprocessor(&per_cu, (const void*)fwd, NTHR, 0) != hipSuccess) per_cu = 0;
        (void)hipGetLastError();
        if (per_cu < 2) fprintf(stderr, "kernel_launch: note: occupancy query reports %d blocks per CU (need 2)\n", per_cu);
        grid = cus * (per_cu >= 2 ? 2 : (per_cu >= 1 ? 1 : 2));
    }
    if (grid < 0) return;
    (void)in_sizes;
    (void)hipMemsetAsync((char*)d_ws + WS_CTL, 0, CTL_BYTES, stream);
    Args a;
    memset(&a, 0, sizeof(a));
    for (int i = 0; i < 32; ++i) a.in[i] = (const float*)d_in[i];
    a.out = (float*)d_out; a.ws = (unsigned char*)d_ws;
    unsigned char* ws = (unsigned char*)d_ws;
    int n = 0, tile0 = 0;
    add_td(a, n, tile0, a.in[8], (bf16_t*)(ws + W_RGIN), nullptr, 1024L * 2048, 2048L * 1024, 1024, 2048, 2048, 2, 0);
    add_td(a, n, tile0, a.in[14], (bf16_t*)(ws + W_RGOUT), nullptr, 1024L * 1024, 1024L * 1024, 1024, 1024, 1024, 2, 0);
    for (int j = 0; j < 2; ++j) for (int dir = 0; dir < 2; ++dir) for (int g = 0; g < 2; ++g)
        add_td(a, n, tile0, a.in[11] + (size_t)((j * 2 + dir) * 2 + g) * 16 * 4096, (bf16_t*)(ws + W_RGG) + (size_t)(j * 2 + dir) * 16 * 8192 + g * 4096, nullptr, 4096, 8192, 64, 64, 64, 16, 0);
    add_td(a, n, tile0, a.in[15], (bf16_t*)(ws + W_MDOWN), nullptr, 0, 0, 1024, 416, 512, 1, 0);
    add_td(a, n, tile0, a.in[18], (bf16_t*)(ws + W_MUQ), a.in[16], 0, 0, 256, 1536, 1536, 1, 0);
    add_td(a, n, tile0, a.in[19], (bf16_t*)(ws + W_MUKV), a.in[17], 0, 0, 128, 2048, 2048, 1, 0);
    add_td(a, n, tile0, a.in[21], (bf16_t*)(ws + W_MO), nullptr, 0, 0, 1024, 1024, 1024, 1, 0);
    add_td(a, n, tile0, a.in[22], (bf16_t*)(ws + W_MLIN), nullptr, 0, 0, 1024, 3088, 3200, 1, 0);
    add_td(a, n, tile0, a.in[25], (bf16_t*)(ws + W_MLOUT), nullptr, 0, 0, 1024, 1024, 1024, 1, 0);
    add_td(a, n, tile0, a.in[30], (bf16_t*)(ws + W_GU), nullptr, 1024L * 512, 512L * 1024, 1024, 512, 512, 64, 1);
    add_td(a, n, tile0, a.in[31], (bf16_t*)(ws + W_DN), nullptr, 256L * 1024, 1024L * 256, 256, 1024, 1024, 64, 0);
    a.ntiles_total = tile0;
    if (n != NTD) { fprintf(stderr, "kernel_launch: descriptor count %d != %d\n", n, NTD); return; }
#if MK_ONE_LAUNCH
    a.ph_lo = 0; a.ph_hi = NPH;
    hipLaunchKernelGGL(fwd, dim3(grid), dim3(NTHR), 0, stream, a);
#else
    for (int ph = 0; ph < NPH && ph <= DBG_STOP; ++ph) {
        a.ph_lo = ph; a.ph_hi = ph + 1;
        hipLaunchKernelGGL(fwd, dim3(grid), dim3(NTHR), 0, stream, a);
    }
    if (DBG_STOP < NPH) { a.ph_lo = 34; a.ph_hi = 35; hipLaunchKernelGGL(fwd, dim3(grid), dim3(NTHR), 0, stream, a); }
#endif
}
```

```cpp
#include <hip/hip_runtime.h>
#include <stdint.h>
#include <string.h>
#include <stdio.h>

#ifndef MK_ONE_LAUNCH
#define MK_ONE_LAUNCH 1
#endif

#define DI __device__ __forceinline__
typedef unsigned short bf16_t;
typedef __attribute__((ext_vector_type(8))) short bf16x8;
typedef __attribute__((ext_vector_type(4))) float f32x4;
typedef __attribute__((ext_vector_type(16))) float f32x16;
typedef __attribute__((ext_vector_type(2))) float f32x2;
typedef __attribute__((ext_vector_type(2))) __bf16 bfx2;
typedef __attribute__((ext_vector_type(4))) unsigned u32x4;
typedef __attribute__((ext_vector_type(2))) unsigned u32x2;

constexpr int D = 1024, NB = 8, SEQ = 2048, CTXL = 256;
constexpr int NLAT = NB * SEQ, NCTX = NB * CTXL, NTOK = NLAT + NCTX;
constexpr int NKEY = CTXL + SEQ;
constexpr int NTHR = 256;
constexpr int LDS_BYTES = 74752;
constexpr int LDS_AUX = 65536;
constexpr int LDS_BARW = LDS_BYTES - 16;
constexpr float EPS = 1e-6f;

constexpr size_t al256(size_t x) { return (x + 255) & ~(size_t)255; }
constexpr size_t WS_CTL = 0;
constexpr size_t CTL_BYTES = 131072;
constexpr size_t CTL_DEP = 65536;
constexpr size_t CTL_DEP2 = CTL_DEP + 4 * 8 * 320 * 4;
constexpr size_t CTL_DEP4 = CTL_DEP2 + 4 * 160 * 4;
constexpr size_t CTL_DEP5 = CTL_DEP4 + 64;
constexpr size_t CTL_CNT = 16384;
constexpr size_t CTL_ROPE = 32768;
constexpr size_t WS_MOD = WS_CTL + CTL_BYTES;
constexpr size_t WS_X = al256(WS_MOD + 4 * 9 * 6144 * 4);
constexpr size_t WS_H = al256(WS_X + (size_t)NTOK * D * 4);
constexpr size_t WS_SCR = al256(WS_H + (size_t)NTOK * D * 2);
constexpr size_t SCR_BYTES = (size_t)256 << 20;
constexpr size_t TOKD2 = (size_t)NTOK * D * 2;
constexpr size_t RG_G = WS_SCR, RG_U = RG_G + TOKD2, RG_HS = RG_U + TOKD2, RG_A2 = RG_HS + 2 * TOKD2;
constexpr size_t MLA_CQ = WS_SCR;
constexpr size_t MLA_CKV = MLA_CQ + (size_t)NTOK * 256 * 2;
constexpr size_t MLA_KR = MLA_CKV + (size_t)NTOK * 128 * 2;
constexpr size_t MLA_Q = MLA_KR + (size_t)NTOK * 32 * 4;
constexpr size_t MLA_K = MLA_Q + (size_t)NTOK * 1536 * 2;
constexpr size_t MLA_VT = MLA_K + (size_t)NB * 16 * NKEY * 96 * 2;
constexpr size_t MLA_O = MLA_VT + (size_t)NB * 16 * 64 * NKEY * 2;
constexpr size_t MLA_END = MLA_O + TOKD2;
constexpr size_t ML_Q = WS_SCR;
constexpr size_t ML_K = ML_Q + (size_t)NTOK * 512 * 2;
constexpr size_t ML_KT = ML_K + (size_t)NTOK * 512 * 2;
constexpr size_t ML_VT = ML_KT + (size_t)NTOK * 512 * 2;
constexpr size_t ML_OG = ML_VT + TOKD2;
constexpr size_t ML_GT = ML_OG + TOKD2;
constexpr size_t ML_HS = ML_GT + (size_t)NTOK * 16 * 4;
constexpr size_t ML_A2 = ML_HS + 2 * TOKD2;
constexpr size_t ML_END = ML_A2 + TOKD2;
static_assert(RG_A2 + TOKD2 <= WS_SCR + SCR_BYTES && MLA_END <= WS_SCR + SCR_BYTES && ML_END <= WS_SCR + SCR_BYTES, "scratch");
constexpr size_t WS_LIST = WS_SCR + SCR_BYTES;
constexpr size_t WS_WSLOT = al256(WS_LIST + (size_t)64 * NTOK * 4);
constexpr size_t WS_HMID = al256(WS_WSLOT + (size_t)2 * NTOK * 4);
constexpr size_t WS_Y = al256(WS_HMID + (size_t)2 * NTOK * 256 * 2);
constexpr size_t WS_W = al256(WS_Y + (size_t)2 * NTOK * D * 2);
constexpr size_t W_RGIN = WS_W;
constexpr size_t W_RGOUT = W_RGIN + (size_t)2 * 2048 * 1024 * 2;
constexpr size_t W_RGG = W_RGOUT + (size_t)2 * 1024 * 1024 * 2;
constexpr size_t W_MDOWN = W_RGG + (size_t)2 * 2 * 16 * 128 * 64 * 2;
constexpr size_t W_MUQ = W_MDOWN + (size_t)512 * 1024 * 2;
constexpr size_t W_MUKV = W_MUQ + (size_t)1536 * 256 * 2;
constexpr size_t W_MO = W_MUKV + (size_t)2048 * 128 * 2;
constexpr size_t W_MLIN = W_MO + (size_t)1024 * 1024 * 2;
constexpr size_t W_MLOUT = W_MLIN + (size_t)3200 * 1024 * 2;
constexpr size_t W_RT = W_MLOUT + (size_t)1024 * 1024 * 2;
constexpr size_t W_GU = al256(W_RT + (size_t)4 * 2 * 80 * 1024 * 2);
constexpr size_t W_DN = W_GU + (size_t)256 * 512 * 1024 * 2;
constexpr size_t WS_GS = W_DN + (size_t)256 * 1024 * 256 * 2;
constexpr size_t WS_END = WS_GS + (size_t)512 * 36 * 3 * 64 * 4;

struct TDesc {
    const float* src; bf16_t* dst; const float* rscale;
    long sb, db;
    int K, N, Npad, batch;
    int perm, tiles_k, tiles_n, tile0;
};
constexpr int NTD = 18;
struct Args {
    const float* in[32];
    float* out;
    unsigned char* ws;
    TDesc td[NTD];
    int ntiles_total, ph_lo, ph_hi, pad0;
};

DI float bf2f(bf16_t v) { return __uint_as_float((unsigned)v << 16); }
DI unsigned pk2(float a, float b) { f32x2 v = {a, b}; bfx2 r = __builtin_convertvector(v, bfx2); return __builtin_bit_cast(unsigned, r); }
DI bf16_t f2bf(float a) { return (bf16_t)(pk2(a, 0.f) & 0xffffu); }
DI float lof(unsigned u) { return __uint_as_float(u << 16); }
DI float hif(unsigned u) { return __uint_as_float(u & 0xffff0000u); }
DI float rcpf_(float x) { return __builtin_amdgcn_rcpf(x); }
DI float fexp(float x) { return __builtin_amdgcn_exp2f(x * 1.4426950408889634f); }
DI float sigmoidf_(float x) { return rcpf_(1.f + fexp(-x)); }
DI float gelu_tanh(float x) { float u = 0.7978845608028654f * (x + 0.044715f * x * x * x); float e = fexp(2.f * u); return x * (1.f - rcpf_(e + 1.f)); }
DI int tok_modrow(int t) { return t < NLAT ? (t >> 11) : 8; }
DI void dma16(const void* g, char* l) { __builtin_amdgcn_global_load_lds((const unsigned*)g, (unsigned*)l, 16, 0, 0); }
DI void wait_vm0() { asm volatile("s_waitcnt vmcnt(0)" ::: "memory"); }
DI void lds_barrier() { asm volatile("s_waitcnt lgkmcnt(0)" ::: "memory"); __builtin_amdgcn_s_barrier(); asm volatile("" ::: "memory"); }
DI int swz128(int row, int chunk) { return row * 128 + ((chunk ^ (row & 7)) << 4); }
DI int swz256(int row, int chunk) { return row * 256 + ((chunk ^ (row & 15)) << 4); }
DI f32x4 mfma16(bf16x8 a, bf16x8 b, f32x4 c) { return __builtin_amdgcn_mfma_f32_16x16x32_bf16(a, b, c, 0, 0, 0); }
template <int CTRL, int ROWMASK> DI float dpp_mov(float old, float v) {
    return __builtin_bit_cast(float, __builtin_amdgcn_update_dpp(__builtin_bit_cast(int, old), __builtin_bit_cast(int, v), CTRL, ROWMASK, 0xF, false));
}
DI float wave_scan_add(float v) {
    v += dpp_mov<0x111, 0xF>(0.f, v); v += dpp_mov<0x112, 0xF>(0.f, v); v += dpp_mov<0x114, 0xF>(0.f, v); v += dpp_mov<0x118, 0xF>(0.f, v);
    v += dpp_mov<0x142, 0xA>(0.f, v); v += dpp_mov<0x143, 0xC>(0.f, v);
    return v;
}
DI float wave_scan_max(float v) {
    const float ninf = -3.0e38f;
    v = fmaxf(v, dpp_mov<0x111, 0xF>(ninf, v)); v = fmaxf(v, dpp_mov<0x112, 0xF>(ninf, v)); v = fmaxf(v, dpp_mov<0x114, 0xF>(ninf, v)); v = fmaxf(v, dpp_mov<0x118, 0xF>(ninf, v));
    v = fmaxf(v, dpp_mov<0x142, 0xA>(ninf, v)); v = fmaxf(v, dpp_mov<0x143, 0xC>(ninf, v));
    return v;
}
DI float lane63(float v) { return __builtin_bit_cast(float, __builtin_amdgcn_readlane(__builtin_bit_cast(int, v), 63)); }
template <int N> DI float dpp_shr(float old, float v) {
    return __builtin_bit_cast(float, __builtin_amdgcn_update_dpp(__builtin_bit_cast(int, old), __builtin_bit_cast(int, v), 0x110 + N, 0xF, 0xF, false));
}
DI f32x16 mfma32(bf16x8 a, bf16x8 b, f32x16 c) { return __builtin_amdgcn_mfma_f32_32x32x16_bf16(a, b, c, 0, 0, 0); }
DI bf16x8 ldsv8(const char* p) { return *(const bf16x8*)p; }
typedef __attribute__((ext_vector_type(8))) _Float16 f16x8;
typedef __attribute__((ext_vector_type(2))) _Float16 f16x2;
DI unsigned pkh(float a, float b) { f32x2 v = {a, b}; f16x2 r = __builtin_convertvector(v, f16x2); return __builtin_bit_cast(unsigned, r); }
DI float hlof(unsigned u) { return (float)__builtin_bit_cast(f16x2, u)[0]; }
DI float hhif(unsigned u) { return (float)__builtin_bit_cast(f16x2, u)[1]; }
DI f32x4 mfma16h(f16x8 a, f16x8 b, f32x4 c) { return __builtin_amdgcn_mfma_f32_16x16x32_f16(a, b, c, 0, 0, 0); }
DI void unpk8(const u32x4 v, f32x4& lo4, f32x4& hi4) {
    lo4[0] = lof(v[0]); lo4[1] = hif(v[0]); lo4[2] = lof(v[1]); lo4[3] = hif(v[1]);
    hi4[0] = lof(v[2]); hi4[1] = hif(v[2]); hi4[2] = lof(v[3]); hi4[3] = hif(v[3]);
}
DI u32x4 pk8(const f32x4 a, const f32x4 b) { u32x4 o; o[0] = pk2(a[0], a[1]); o[1] = pk2(a[2], a[3]); o[2] = pk2(b[0], b[1]); o[3] = pk2(b[2], b[3]); return o; }
DI void st_bf4(bf16_t* p, const f32x4 v) { u32x2 o; o[0] = pk2(v[0], v[1]); o[1] = pk2(v[2], v[3]); *(u32x2*)p = o; }

__shared__ __attribute__((aligned(16))) char lds[LDS_BYTES];

#define XB_TMO      128
#define XB_XCNT(j)  (256  + 64 * (j))
#define XB_XSUB(j)  (1280 + 64 * (j))
#define XB_XGEN(j)  (2304 + 64 * (j))
#define XB_TOP      3328
#define XB_TOPGEN   3392
#define XCD_BAR_WORDS 3456
#define XB_SPIN_CAP (1u << 22)
#define LAS __attribute__((address_space(3)))
DI unsigned xb_ld(unsigned* p)              { return __hip_atomic_load(p, __ATOMIC_RELAXED, __HIP_MEMORY_SCOPE_AGENT); }
DI unsigned xb_add(unsigned* p, unsigned v) { return __hip_atomic_fetch_add(p, v, __ATOMIC_RELAXED, __HIP_MEMORY_SCOPE_AGENT); }
DI unsigned xl_add(unsigned* p, unsigned v) { return __hip_atomic_fetch_add(p, v, __ATOMIC_RELAXED, __HIP_MEMORY_SCOPE_WORKGROUP); }
DI unsigned xb_xcc_id() { return (unsigned)__builtin_amdgcn_s_getreg((3 << 11) | 20) & 0xFu; }
#define XB_SPIN(cond, bar) do { unsigned _sp = 0; while (cond) { __builtin_amdgcn_s_sleep(1); \
    if ((++_sp & 255u) == 0u) { if (xb_ld(&(bar)[XB_TMO])) break; if (_sp > XB_SPIN_CAP) { atomicAdd(&(bar)[XB_TMO], 1u); break; } } } } while (0)
struct XcdBarrier { unsigned* bar; unsigned x; volatile LAS unsigned* st; };
DI XcdBarrier xcd_barrier_post(unsigned* bar, volatile LAS unsigned* st) {
    XcdBarrier b; b.bar = bar; b.x = xb_xcc_id(); b.st = st;
    if (threadIdx.x == 0) (void)xb_add(&bar[XB_XCNT(b.x)], 1u);
    return b;
}
DI void xcd_barrier_complete(unsigned* bar, unsigned x, unsigned& nloc, unsigned& nx) {
    const unsigned G = gridDim.x * gridDim.y * gridDim.z;
    unsigned sum, cnt, mine, sp = 0u;
    for (;;) {
        sum = 0u; cnt = 0u; mine = 0u;
#pragma unroll
        for (unsigned j = 0; j < 16; ++j) { const unsigned c = xb_ld(&bar[XB_XCNT(j)]); sum += c; cnt += (c > 0u) ? 1u : 0u; mine = (j == x) ? c : mine; }
        if (sum == G) break;
        __builtin_amdgcn_s_sleep(1);
        if ((++sp & 255u) == 0u) { if (xb_ld(&bar[XB_TMO])) break; if (sp > XB_SPIN_CAP) { atomicAdd(&bar[XB_TMO], 1u); break; } }
    }
    nloc = mine > 0u ? mine : 1u; nx = cnt > 0u ? cnt : 1u;
}
DI void xcd_barrier(const XcdBarrier& b) {
    asm volatile("s_waitcnt vmcnt(0)" ::: "memory");
    __syncthreads();
    if (threadIdx.x == 0) {
        unsigned* bar = b.bar;
        __builtin_amdgcn_s_waitcnt(0);
        unsigned nloc = b.st[0], nx = b.st[1];
        if (nloc == 0u) { xcd_barrier_complete(bar, b.x, nloc, nx); b.st[0] = nloc; b.st[1] = nx; }
        const unsigned old = xl_add(&bar[XB_XSUB(b.x)], 1u);
        const unsigned gen = old / nloc;
        if (old + 1u == (gen + 1u) * nloc) {
            __builtin_amdgcn_fence(__ATOMIC_RELEASE, "agent");
            asm volatile("s_waitcnt vmcnt(0)" ::: "memory");
            const unsigned og = xb_add(&bar[XB_TOP], 1u);
            const unsigned tg = og / nx;
            const unsigned tgt = (tg + 1u) * nx;
            if (og + 1u != tgt) XB_SPIN((int)(xb_ld(&bar[XB_TOP]) - tgt) < 0, bar);
            __builtin_amdgcn_fence(__ATOMIC_ACQUIRE, "agent");
            asm volatile("s_waitcnt vmcnt(0)" ::: "memory");
            xb_add(&bar[XB_XGEN(b.x)], 1u);
        } else {
            __builtin_amdgcn_fence(__ATOMIC_ACQUIRE, "agent");
            XB_SPIN(xb_ld(&bar[XB_XGEN(b.x)]) == gen, bar);
            asm volatile("s_waitcnt vmcnt(0)" ::: "memory");
        }
    }
    __syncthreads();
}

typedef __attribute__((ext_vector_type(4))) short s16x4;
typedef __attribute__((address_space(3))) s16x4 lds_s16x4;
DI s16x4 lds_tr(const char* p) { return __builtin_amdgcn_ds_read_tr16_b64_v4i16((lds_s16x4*)p); }
DI int trswz(int row) { return ((row & 3) << 2) | ((row >> 2) & 3); }
struct CvTile { const float* src; bf16_t* dst; int K, N, perm, k0, n0; };
DI CvTile moe_cv_tile(const Args& a, const int L, const int t) {
    CvTile c;
    const int e = t / 96, r = t - e * 96;
    if (r < 64) {
        c.src = a.in[30] + (size_t)(L * 64 + e) * 1024 * 512; c.dst = (bf16_t*)(a.ws + W_GU) + (size_t)(L * 64 + e) * 512 * 1024;
        c.K = 1024; c.N = 512; c.perm = 1; c.k0 = (r & 7) * 128; c.n0 = (r >> 3) * 64;
    } else {
        const int r2 = r - 64;
        c.src = a.in[31] + (size_t)(L * 64 + e) * 256 * 1024; c.dst = (bf16_t*)(a.ws + W_DN) + (size_t)(L * 64 + e) * 1024 * 256;
        c.K = 256; c.N = 1024; c.perm = 0; c.k0 = (r2 & 1) * 128; c.n0 = (r2 >> 1) * 64;
    }
    return c;
}
DI void cv_load(const CvTile& c, f32x4 (&L0)[4], f32x4 (&L1)[4]) {
    const int tid = threadIdx.x, c4 = tid & 15, kr = tid >> 4;
    const float* p = c.src + (size_t)(c.k0 + 2 * kr) * c.N + c.n0 + 4 * c4;
#pragma unroll
    for (int i = 0; i < 4; ++i) { L0[i] = *(const f32x4*)(p + (size_t)(32 * i) * c.N); L1[i] = *(const f32x4*)(p + (size_t)(32 * i + 1) * c.N); }
}
DI int cv_st(int n, int kd) { return n * 64 + ((((kd >> 2) ^ (n >> 2)) & 15) << 2) + (kd & 3); }
DI void cv_pack(unsigned* st, const f32x4 (&L0)[4], const f32x4 (&L1)[4]) {
    const int tid = threadIdx.x, c4 = tid & 15, kr = tid >> 4;
#pragma unroll
    for (int i = 0; i < 4; ++i)
#pragma unroll
        for (int j = 0; j < 4; ++j) st[cv_st(4 * c4 + j, 16 * i + kr)] = pk2(L0[i][j], L1[i][j]);
}
DI void cv_flush(const CvTile& c, const unsigned* st) {
    const int tid = threadIdx.x;
#pragma unroll
    for (int i = 0; i < 4; ++i) {
        const int id = tid + i * 256, n = id >> 4, kc = id & 15;
        const u32x4 o = *(const u32x4*)(st + cv_st(n, kc * 4));
        int nd = c.n0 + n;
        if (c.perm) { const int cc = nd & 255, up = nd >> 8; nd = ((cc >> 4) << 5) + (up << 4) + (cc & 15); }
        *(u32x4*)(c.dst + (size_t)nd * c.K + c.k0 + kc * 8) = o;
    }
}

DI void phase_prologue(const Args& a) {
    const int tid = threadIdx.x;
    const int n_ada = 384, n_rt = 320;
    const int total = n_ada + n_rt;
    float* sc = (float*)lds;
    for (int u = blockIdx.x; u < total; u += gridDim.x) {
        __syncthreads();
        if (u < n_ada) {
            const float* c = a.in[1]; const float* cc = a.in[3];
            for (int i = tid; i < 9 * 1024; i += NTHR) {
                float v = i < 8192 ? c[i] : cc[i - 8192];
                sc[i] = v / (1.f + __expf(-v));
            }
            __syncthreads();
            const int n = u * 64 + (tid & 63), li = n / 6144, nn = n - li * 6144, kq = tid >> 6;
            const float* wp = a.in[4] + (size_t)li * 1024 * 6144 + (size_t)(kq * 256) * 6144 + nn;
            float acc[9];
#pragma unroll
            for (int r = 0; r < 9; ++r) acc[r] = 0.f;
#pragma unroll 1
            for (int k0 = kq * 256; k0 < kq * 256 + 256; k0 += 16) {
                float wv[16];
#pragma unroll
                for (int kk = 0; kk < 16; ++kk) { wv[kk] = *wp; wp += 6144; }
#pragma unroll
                for (int kk = 0; kk < 16; kk += 4)
#pragma unroll
                    for (int r = 0; r < 9; ++r) {
                        const f32x4 s4 = *(const f32x4*)(sc + r * 1024 + k0 + kk);
                        acc[r] += s4[0] * wv[kk] + s4[1] * wv[kk + 1] + s4[2] * wv[kk + 2] + s4[3] * wv[kk + 3];
                    }
            }
            float* part = sc + 9 * 1024;
#pragma unroll
            for (int r = 0; r < 9; ++r) part[(kq * 9 + r) * 64 + (tid & 63)] = acc[r];
            __syncthreads();
            for (int i = tid; i < 9 * 64; i += NTHR) {
                const int r = i >> 6, cidx = i & 63;
                const int n2 = u * 64 + cidx, l2 = n2 / 6144, nn2 = n2 - l2 * 6144;
                const float v = ((part[(0 * 9 + r) * 64 + cidx] + part[(1 * 9 + r) * 64 + cidx]) + part[(2 * 9 + r) * 64 + cidx]) + part[(3 * 9 + r) * 64 + cidx];
                float o = v + a.in[5][l2 * 6144 + nn2];
                const int ch = nn2 >> 10;
                if (ch == 1) o = a.in[6][l2 * 1024 + (nn2 & 1023)] * (1.f + o);
                else if (ch == 4) o = a.in[7][l2 * 1024 + (nn2 & 1023)] * (1.f + o);
                ((float*)(a.ws + WS_MOD))[((size_t)l2 * 9 + r) * 6144 + nn2] = o;
            }
            if (u < 96) {
                asm volatile("s_waitcnt vmcnt(0)" ::: "memory");
                __syncthreads();
                if (tid == 0) {
                    __builtin_amdgcn_fence(__ATOMIC_RELEASE, "agent");
                    asm volatile("s_waitcnt vmcnt(0)" ::: "memory");
                    xb_add((unsigned*)(a.ws + WS_CTL + CTL_DEP4), 1u);
                }
            }
        } else if (u < n_ada + n_rt) {
            const int r_ = u - n_ada, li = r_ / 80, n = r_ - li * 80;
            if (r_ == 0) {
                float* rt_ = (float*)(a.ws + WS_CTL + CTL_ROPE);
                for (int i = tid; i < 512; i += NTHR) {
                    const int pos = i >> 3, fi = i & 7;
                    const float ang = (float)pos * powf(10000.f, -(float)fi * 0.125f);
                    rt_[i] = cosf(ang); rt_[512 + i] = sinf(ang);
                }
            }
            bf16_t* rt = (bf16_t*)(a.ws + W_RT) + (size_t)li * 80 * 1024;
            const float* wg = a.in[26] + (size_t)li * 1024 * 8;
            const float* we = a.in[28] + (size_t)li * 1024 * 64;
            float v[4];
#pragma unroll
            for (int j = 0; j < 4; ++j) { const int k = tid * 4 + j; v[j] = n < 8 ? wg[k * 8 + n] : (n < 72 ? we[k * 64 + (n - 8)] : 0.f); }
            u32x2 hw;
            hw[0] = pkh(v[0], v[1]); hw[1] = pkh(v[2], v[3]);
            *(u32x2*)(rt + n * 1024 + tid * 4) = hw;
        }
    }
    struct PTile { const float* src; bf16_t* dst; const float* rscale; int K, N, Npad, perm, k0, n0; };
    auto decode = [&](int tix) {
        int di = 0;
#pragma unroll 1
        for (int i = 1; i < NTD; ++i) if (tix >= a.td[i].tile0) di = i;
        const TDesc& td = a.td[di];
        int rem = tix - td.tile0;
        const int per = td.tiles_k * td.tiles_n;
        const int bi = rem / per; rem -= bi * per;
        PTile p;
        p.src = td.src + (size_t)bi * td.sb; p.dst = td.dst + (size_t)bi * td.db; p.rscale = td.rscale;
        p.K = td.K; p.N = td.N; p.Npad = td.Npad; p.perm = td.perm;
        p.n0 = (rem % td.tiles_n) * 64; p.k0 = (rem / td.tiles_n) * 128;
        return p;
    };
    auto pload = [&](const PTile& p, f32x4 (&L0)[4], f32x4 (&L1)[4]) {
        const int c4 = tid & 15, kr = tid >> 4;
        const bool nok = p.n0 + 4 * c4 < p.N;
#pragma unroll
        for (int i = 0; i < 4; ++i) {
            const int k = p.k0 + 32 * i + 2 * kr;
            L0[i] = (f32x4){0.f, 0.f, 0.f, 0.f}; L1[i] = L0[i];
            if (nok && k < p.K) {
                L0[i] = *(const f32x4*)(p.src + (size_t)k * p.N + p.n0 + 4 * c4);
                L1[i] = *(const f32x4*)(p.src + (size_t)(k + 1) * p.N + p.n0 + 4 * c4);
                if (p.rscale) { L0[i] *= p.rscale[k]; L1[i] *= p.rscale[k + 1]; }
            }
        }
    };
    auto pflush = [&](const PTile& p, const unsigned* st) {
#pragma unroll
        for (int i = 0; i < 4; ++i) {
            const int id = tid + i * 256, n = id >> 4, kc = id & 15;
            const u32x4 o = *(const u32x4*)(st + cv_st(n, kc * 4));
            int nd = p.n0 + n;
            if (nd < p.Npad && p.k0 + kc * 8 < p.K) {
                if (p.perm) { const int c = nd & 255, up = nd >> 8; nd = ((c >> 4) << 5) + (up << 4) + (c & 15); }
                *(u32x4*)(p.dst + (size_t)nd * p.K + p.k0 + kc * 8) = o;
            }
        }
    };
    {
        unsigned* st0 = (unsigned*)lds; unsigned* st1 = st0 + 64 * 68;
        const int nt_ = a.ntiles_total, G = gridDim.x;
        int t0 = blockIdx.x, t1 = blockIdx.x + G;
        PTile p0 = decode(0), p1 = p0;
        f32x4 A0[4], A1[4], B0[4], B1[4];
        __syncthreads();
        if (t0 < nt_) { p0 = decode(t0); pload(p0, A0, A1); }
        if (t1 < nt_) { p1 = decode(t1); pload(p1, B0, B1); }
        while (t0 < nt_) {
            PTile q0 = p0, q1 = p1;
            const bool v1 = t1 < nt_;
            cv_pack(st0, A0, A1);
            if (t0 + 2 * G < nt_) { p0 = decode(t0 + 2 * G); pload(p0, A0, A1); }
            if (v1) {
                cv_pack(st1, B0, B1);
                if (t1 + 2 * G < nt_) { p1 = decode(t1 + 2 * G); pload(p1, B0, B1); }
            }
            __syncthreads();
            pflush(q0, st0);
            if (v1) pflush(q1, st1);
            __syncthreads();
            t0 += 2 * G; t1 += 2 * G;
        }
    }
}

DI float wave_sum(float v) { return lane63(wave_scan_add(v)); }
template <int MODE>
DI void phase_token_row(const Args& a, const int li) {
    const int tid = threadIdx.x, lane = tid & 63, wave = tid >> 6;
    bf16_t* X = (bf16_t*)(a.ws + WS_X);
    bf16_t* H = (bf16_t*)(a.ws + WS_H);
    const bf16_t* Y = (const bf16_t*)(a.ws + WS_Y);
    const float* MOD = (const float*)(a.ws + WS_MOD);
    const bool combine = MODE == 2 || li > 0;
    const bool first = MODE == 0 && li == 0;
    const int npairs = (MODE == 2 ? NLAT : NTOK) / 2;
    const int lprev = MODE == 2 ? 3 : (li > 0 ? li - 1 : 0);
    if (first) {
        if (tid < 64) {
            unsigned* dp = (unsigned*)(a.ws + WS_CTL + CTL_DEP4);
            unsigned* tmo = (unsigned*)(a.ws + WS_CTL) + XB_TMO;
            unsigned sp = 0u;
            while (xb_ld(dp) < 96u) {
                __builtin_amdgcn_s_sleep(2);
                if ((++sp & 255u) == 0u) { if (xb_ld(tmo)) break; if (sp > XB_SPIN_CAP) { atomicAdd(tmo, 1u); break; } }
            }
            __builtin_amdgcn_fence(__ATOMIC_ACQUIRE, "agent");
            asm volatile("s_waitcnt vmcnt(0)" ::: "memory");
        }
        __syncthreads();
    }
    for (int p = blockIdx.x * 4 + wave; p < npairs; p += gridDim.x * 4) {
        const int t0 = 2 * p, mr = tok_modrow(t0);
        f32x4 x[2][2][2];
#pragma unroll
        for (int i = 0; i < 2; ++i) {
            const int t = t0 + i;
            if (first) {
                const float* xs = t < NLAT ? a.in[0] + (size_t)t * D : a.in[2] + (size_t)(t - NLAT) * D;
#pragma unroll
                for (int j = 0; j < 2; ++j) { x[i][j][0] = *(const f32x4*)(xs + 512 * j + 8 * lane); x[i][j][1] = *(const f32x4*)(xs + 512 * j + 8 * lane + 4); }
            } else {
#pragma unroll
                for (int j = 0; j < 2; ++j) unpk8(*(const u32x4*)(X + (size_t)t * D + 512 * j + 8 * lane), x[i][j][0], x[i][j][1]);
            }
        }
        if (combine) {
            const float* g5 = MOD + ((size_t)lprev * 9 + mr) * 6144 + 5 * 1024;
            f32x4 g[2][2];
#pragma unroll
            for (int j = 0; j < 2; ++j) { g[j][0] = *(const f32x4*)(g5 + 512 * j + 8 * lane); g[j][1] = *(const f32x4*)(g5 + 512 * j + 8 * lane + 4); }
#pragma unroll
            for (int i = 0; i < 2; ++i) {
                const bf16_t* y0 = Y + (size_t)(2 * (t0 + i)) * D;
#pragma unroll
                for (int j = 0; j < 2; ++j) {
                    f32x4 a0, a1, b0, b1;
                    unpk8(*(const u32x4*)(y0 + 512 * j + 8 * lane), a0, a1);
                    unpk8(*(const u32x4*)(y0 + D + 512 * j + 8 * lane), b0, b1);
                    x[i][j][0] += g[j][0] * (a0 + b0); x[i][j][1] += g[j][1] * (a1 + b1);
                }
            }
        }
        if (MODE == 2) {
#pragma unroll
            for (int i = 0; i < 2; ++i)
#pragma unroll
                for (int j = 0; j < 2; ++j) {
                    *(f32x4*)(a.out + (size_t)(t0 + i) * D + 512 * j + 8 * lane) = x[i][j][0];
                    *(f32x4*)(a.out + (size_t)(t0 + i) * D + 512 * j + 8 * lane + 4) = x[i][j][1];
                }
            continue;
        }
        float rstd[2];
#pragma unroll
        for (int i = 0; i < 2; ++i) {
            float ss = 0.f;
#pragma unroll
            for (int j = 0; j < 2; ++j)
#pragma unroll
                for (int h = 0; h < 2; ++h) ss += x[i][j][h][0] * x[i][j][h][0] + x[i][j][h][1] * x[i][j][h][1] + x[i][j][h][2] * x[i][j][h][2] + x[i][j][h][3] * x[i][j][h][3];
            rstd[i] = rsqrtf(wave_sum(ss) * (1.f / 1024.f) + EPS);
        }
        const float* msc = MOD + ((size_t)li * 9 + mr) * 6144 + 1 * 1024;
        const float* msh = MOD + ((size_t)li * 9 + mr) * 6144;
#pragma unroll
        for (int j = 0; j < 2; ++j) {
            const f32x4 gs0 = *(const f32x4*)(msc + 512 * j + 8 * lane), gs1 = *(const f32x4*)(msc + 512 * j + 8 * lane + 4);
            const f32x4 h0 = *(const f32x4*)(msh + 512 * j + 8 * lane), h1 = *(const f32x4*)(msh + 512 * j + 8 * lane + 4);
#pragma unroll
            for (int i = 0; i < 2; ++i) {
                *(u32x4*)(H + (size_t)(t0 + i) * D + 512 * j + 8 * lane) = pk8(x[i][j][0] * rstd[i] * gs0 + h0, x[i][j][1] * rstd[i] * gs1 + h1);
                if (combine) *(u32x4*)(X + (size_t)(t0 + i) * D + 512 * j + 8 * lane) = pk8(x[i][j][0], x[i][j][1]);
            }
        }
    }
}

template <int UR>
DI void phase_token_router(const Args& a, const int li, const bool dry = false) {
    constexpr int RPW = UR / 4, RB = (RPW % 3 == 0) ? 3 : 4, NB = RPW / RB, MTN = (UR + 15) / 16;
    static_assert(UR % 4 == 0 && RPW % RB == 0 && UR * 2048 + 16 <= LDS_BYTES && 5 * UR * 80 * 4 <= UR * 2048, "router unit");
    const int tid = threadIdx.x, lane = tid & 63, wave = tid >> 6;
    const int r = lane & 15, q = lane >> 4;
    const bf16_t* X = (const bf16_t*)(a.ws + WS_X);
    bf16_t* H = (bf16_t*)(a.ws + WS_H);
    const float* MOD = (const float*)(a.ws + WS_MOD);
    const int nunits = (li == 3 ? NLAT : NTOK) / UR;
    char* sF = lds;
    float* sP = (float*)lds;
    float* sL = (float*)(lds + 4 * UR * 80 * 4);
    const bf16_t* rwh = (const bf16_t*)(a.ws + W_RT) + (size_t)li * 80 * 1024 + (size_t)r * 1024 + q * 8;
    for (int g = blockIdx.x; g < nunits; g += gridDim.x) {
        if (!dry) {
            if (tid < 64) {
                const unsigned* dp = (const unsigned*)(a.ws + WS_CTL + CTL_DEP2) + li * 160;
                unsigned* tmo = (unsigned*)(a.ws + WS_CTL) + XB_TMO;
                const int ta = (g * UR) >> 7, tb = (g * UR + UR - 1) >> 7;
                unsigned sp = 0u;
                while (xb_ld((unsigned*)dp + ta) < 8u || xb_ld((unsigned*)dp + tb) < 8u) {
                    __builtin_amdgcn_s_sleep(2);
                    if ((++sp & 255u) == 0u) { if (xb_ld(tmo)) break; if (sp > XB_SPIN_CAP) { atomicAdd(tmo, 1u); break; } }
                }
                __builtin_amdgcn_fence(__ATOMIC_ACQUIRE, "agent");
                asm volatile("s_waitcnt vmcnt(0)" ::: "memory");
            }
        }
        __syncthreads();
        {
            int cur_mr = -1;
            f32x4 gs[2][2], h4[2][2];
            u32x4 xq[2][RB][2];
            auto xload = [&](u32x4 (&x)[RB][2], const int b) {
#pragma unroll
                for (int i = 0; i < RB; ++i)
#pragma unroll
                    for (int j = 0; j < 2; ++j) x[i][j] = *(const u32x4*)(X + (size_t)(g * UR + wave * RPW + b * RB + i) * D + 512 * j + 8 * lane);
            };
            xload(xq[0], 0);
            if (NB > 1) xload(xq[1], 1);
#pragma unroll
            for (int b = 0; b < NB; ++b) {
                const int lr0 = wave * RPW + b * RB;
                u32x4 (&xr)[RB][2] = xq[b & 1];
#pragma unroll
                for (int i = 0; i < RB; ++i) {
                    const int lr = lr0 + i, row = g * UR + lr;
                    const int mr = tok_modrow(row);
                    if (mr != cur_mr) {
                        cur_mr = mr;
                        const float* mb = MOD + ((size_t)li * 9 + mr) * 6144;
#pragma unroll
                        for (int j = 0; j < 2; ++j)
#pragma unroll
                            for (int h = 0; h < 2; ++h) { gs[j][h] = *(const f32x4*)(mb + 4 * 1024 + 512 * j + 8 * lane + 4 * h); h4[j][h] = *(const f32x4*)(mb + 3 * 1024 + 512 * j + 8 * lane + 4 * h); }
                    }
                    f32x4 x[2][2];
#pragma unroll
                    for (int j = 0; j < 2; ++j) unpk8(xr[i][j], x[j][0], x[j][1]);
                    float ss = 0.f;
#pragma unroll
                    for (int j = 0; j < 2; ++j)
#pragma unroll
                        for (int h = 0; h < 2; ++h) ss += x[j][h][0] * x[j][h][0] + x[j][h][1] * x[j][h][1] + x[j][h][2] * x[j][h][2] + x[j][h][3] * x[j][h][3];
                    const float rstd = rsqrtf(wave_sum(ss) * (1.f / 1024.f) + EPS);
#pragma unroll
                    for (int j = 0; j < 2; ++j) {
                        const f32x4 f0 = x[j][0] * rstd * gs[j][0] + h4[j][0], f1 = x[j][1] * rstd * gs[j][1] + h4[j][1];
                        *(u32x4*)(H + (size_t)row * D + 512 * j + 8 * lane) = pk8(f0, f1);
                        u32x4 hh; hh[0] = pkh(f0[0], f0[1]); hh[1] = pkh(f0[2], f0[3]); hh[2] = pkh(f1[0], f1[1]); hh[3] = pkh(f1[2], f1[3]);
                        *(u32x4*)(sF + lr * 2048 + (((64 * j + lane) ^ lr) << 4)) = hh;
                    }
                }
                if (b + 2 < NB) xload(xq[b & 1], b + 2);
            }
        }
        __syncthreads();
        f32x4 lacc[MTN][5];
#pragma unroll
        for (int mt = 0; mt < MTN; ++mt)
#pragma unroll
            for (int i = 0; i < 5; ++i) lacc[mt][i] = (f32x4){0.f, 0.f, 0.f, 0.f};
#pragma unroll 4
        for (int s = 0; s < 8; ++s) {
            const int kk = wave * 8 + s;
            f16x8 fh[MTN];
#pragma unroll
            for (int mt = 0; mt < MTN; ++mt) {
                const int lr = (mt * 16 + r) < UR ? mt * 16 + r : UR - 1;
                fh[mt] = __builtin_bit_cast(f16x8, ldsv8(sF + lr * 2048 + (((kk * 4 + q) ^ lr) << 4)));
            }
#pragma unroll
            for (int nt = 0; nt < 5; ++nt) {
                const f16x8 w = __builtin_bit_cast(f16x8, *(const bf16x8*)(rwh + (size_t)nt * 16 * 1024 + kk * 32));
#pragma unroll
                for (int mt = 0; mt < MTN; ++mt) lacc[mt][nt] = mfma16h(fh[mt], w, lacc[mt][nt]);
            }
        }
        __syncthreads();
#pragma unroll
        for (int mt = 0; mt < MTN; ++mt)
#pragma unroll
            for (int nt = 0; nt < 5; ++nt)
#pragma unroll
                for (int j = 0; j < 4; ++j) {
                    const int lr = mt * 16 + q * 4 + j;
                    if (lr < UR) sP[(wave * UR + lr) * 80 + nt * 16 + r] = lacc[mt][nt][j];
                }
        __syncthreads();
        for (int i = tid; i < UR * 80; i += NTHR) sL[i] = sP[i] + sP[UR * 80 + i] + sP[2 * UR * 80 + i] + sP[3 * UR * 80 + i];
        __syncthreads();
        if (tid < UR && !dry) {
            const float* L = sL + tid * 80;
            const float* bg = a.in[27] + li * 8;
            const float* be = a.in[29] + li * 64;
            float gmax = -3.0e38f; int gi = 0; float gl[8];
#pragma unroll
            for (int j = 0; j < 8; ++j) { gl[j] = L[j] + bg[j]; if (gl[j] > gmax) { gmax = gl[j]; gi = j; } }
            float ps = 0.f;
#pragma unroll
            for (int j = 0; j < 8; ++j) ps += __expf(gl[j] - gmax);
            const float ptop = 1.f / ps;
            float e1 = -3.0e38f, e2 = -3.0e38f; int i1 = 0, i2 = 0;
#pragma unroll
            for (int j = 0; j < 8; ++j) {
                const float v = L[8 + gi * 8 + j] + be[gi * 8 + j];
                if (v > e1) { e2 = e1; i2 = i1; e1 = v; i1 = j; } else if (v > e2) { e2 = v; i2 = j; }
            }
            const float ex = __expf(e2 - e1);
            const float w1 = ptop / (1.f + ex), w2 = ptop * ex / (1.f + ex);
            const int tt = g * UR + tid;
            int* cnt = (int*)(a.ws + WS_CTL + CTL_CNT) + li * 64;
            int* list = (int*)(a.ws + WS_LIST);
            float* wsl = (float*)(a.ws + WS_WSLOT);
            const int ea = gi * 8 + i1, eb = gi * 8 + i2;
            const int pa = atomicAdd(&cnt[ea], 1); list[(size_t)ea * NTOK + pa] = 2 * tt; wsl[2 * tt] = w1;
            const int pb = atomicAdd(&cnt[eb], 1); list[(size_t)eb * NTOK + pb] = 2 * tt + 1; wsl[2 * tt + 1] = w2;
        }
    }
}

template <int WM, int WN, int MT, int NT, bool PFALL = true, class AP>
DI void gemm_tile(AP arow, const bf16_t* Bt, const int ldb, const int K, f32x4 (&acc)[MT][NT], float* ssq = nullptr) {
    constexpr int BM = WM * MT * 16, BN = WN * NT * 16;
    constexpr int A_BYTES = BM * 128, B_BYTES = BN * 128, STAGE = A_BYTES + B_BYTES;
    constexpr int ACH = BM * 8 / NTHR, BCH = BN * 8 / NTHR;
    static_assert(2 * STAGE <= LDS_AUX, "gemm LDS");
    const int tid = threadIdx.x, lane = tid & 63, wave = tid >> 6;
    const int wm = wave / WN, wn = wave % WN;
    const int fr = lane & 15, fq = lane >> 4;
    const bf16_t* ap[ACH]; const bf16_t* bp[BCH];
#pragma unroll
    for (int i = 0; i < ACH; ++i) { const int idx = tid + i * NTHR, row = idx >> 3, c = (idx & 7) ^ (row & 7); ap[i] = arow(row) + c * 8; }
#pragma unroll
    for (int i = 0; i < BCH; ++i) { const int idx = tid + i * NTHR, row = idx >> 3, c = (idx & 7) ^ (row & 7); bp[i] = Bt + (size_t)row * ldb + c * 8; }
#pragma unroll
    for (int i = 0; i < MT; ++i)
#pragma unroll
        for (int j = 0; j < NT; ++j) acc[i][j] = (f32x4){0.f, 0.f, 0.f, 0.f};
    const int KT = K >> 6;
    {
        char* sa = lds; char* sb = lds + A_BYTES;
#pragma unroll
        for (int i = 0; i < ACH; ++i) dma16(ap[i], sa + (tid + i * NTHR) * 16);
#pragma unroll
        for (int i = 0; i < BCH; ++i) dma16(bp[i], sb + (tid + i * NTHR) * 16);
    }
#pragma unroll 1
    for (int kt = 0; kt < KT; ++kt) {
        wait_vm0();
        __syncthreads();
        if (kt + 1 < KT) {
            char* sa = lds + ((kt + 1) & 1) * STAGE; char* sb = sa + A_BYTES;
            const int ko = (kt + 1) * 64;
#pragma unroll
            for (int i = 0; i < ACH; ++i) dma16(ap[i] + ko, sa + (tid + i * NTHR) * 16);
#pragma unroll
            for (int i = 0; i < BCH; ++i) dma16(bp[i] + ko, sb + (tid + i * NTHR) * 16);
        }
        const char* sa = lds + (kt & 1) * STAGE; const char* sb = sa + A_BYTES;
        if (PFALL) {
            bf16x8 xf[2][MT], wf[2][NT];
#pragma unroll
            for (int kk = 0; kk < 2; ++kk) {
#pragma unroll
                for (int i = 0; i < MT; ++i) xf[kk][i] = ldsv8(sa + swz128(wm * MT * 16 + i * 16 + fr, kk * 4 + fq));
#pragma unroll
                for (int j = 0; j < NT; ++j) wf[kk][j] = ldsv8(sb + swz128(wn * NT * 16 + j * 16 + fr, kk * 4 + fq));
            }
            __builtin_amdgcn_sched_barrier(0);
            __builtin_amdgcn_s_setprio(1);
#pragma unroll
            for (int kk = 0; kk < 2; ++kk)
#pragma unroll
                for (int i = 0; i < MT; ++i)
#pragma unroll
                    for (int j = 0; j < NT; ++j) acc[i][j] = mfma16(wf[kk][j], xf[kk][i], acc[i][j]);
            __builtin_amdgcn_s_setprio(0);
        } else {
#pragma unroll
            for (int kk = 0; kk < 2; ++kk) {
                bf16x8 xf[MT], wf[NT];
#pragma unroll
                for (int i = 0; i < MT; ++i) xf[i] = ldsv8(sa + swz128(wm * MT * 16 + i * 16 + fr, kk * 4 + fq));
#pragma unroll
                for (int j = 0; j < NT; ++j) wf[j] = ldsv8(sb + swz128(wn * NT * 16 + j * 16 + fr, kk * 4 + fq));
#pragma unroll
                for (int i = 0; i < MT; ++i)
#pragma unroll
                    for (int j = 0; j < NT; ++j) acc[i][j] = mfma16(wf[j], xf[i], acc[i][j]);
                if (ssq) {
#pragma unroll
                    for (int i = 0; i < MT; ++i) {
                        const u32x4 xu = __builtin_bit_cast(u32x4, xf[i]);
#pragma unroll
                        for (int d = 0; d < 4; ++d) { const bfx2 p = __builtin_bit_cast(bfx2, xu[d]); ssq[i] = __builtin_amdgcn_fdot2_f32_bf16(p, p, ssq[i], false); }
                    }
                }
            }
        }
    }
    __syncthreads();
}


struct GemmPipe {
    static constexpr int A_BYTES = 128 * 128, STAGE = 2 * A_BYTES;
    const bf16_t* ap[4]; const bf16_t* bp[4];
    template <class AP>
    DI void setup(AP arow, const bf16_t* Bt, const int ldb) {
        const int tid = threadIdx.x;
#pragma unroll
        for (int i = 0; i < 4; ++i) {
            const int idx = tid + i * NTHR, row = idx >> 3, c = (idx & 7) ^ (row & 7);
            ap[i] = arow(row) + c * 8; bp[i] = Bt + (size_t)row * ldb + c * 8;
        }
    }
    DI void issue(const int kt, const int buf) const {
        const int tid = threadIdx.x;
        char* sa = lds + buf * STAGE; char* sb = sa + A_BYTES;
        const int ko = kt * 64;
#pragma unroll
        for (int i = 0; i < 4; ++i) dma16(ap[i] + ko, sa + (tid + i * NTHR) * 16);
#pragma unroll
        for (int i = 0; i < 4; ++i) dma16(bp[i] + ko, sb + (tid + i * NTHR) * 16);
    }
    template <int PM>
    DI void run_probe(const int K, f32x4 (&acc)[4][4]) const {
        const int tid = threadIdx.x, lane = tid & 63, wave = tid >> 6;
        const int wm = wave >> 1, wn = wave & 1, fr = lane & 15, fq = lane >> 4;
#pragma unroll
        for (int i = 0; i < 4; ++i)
#pragma unroll
            for (int j = 0; j < 4; ++j) acc[i][j] = (f32x4){0.f, 0.f, 0.f, 0.f};
        const int KT = K >> 6;
#pragma unroll 1
        for (int kt = 0; kt < KT; ++kt) {
            if (PM & 4) { wait_vm0(); __syncthreads(); }
            if ((PM & 1) && kt + 1 < KT) issue(kt + 1, (kt + 1) & 1);
            if (PM & 2) {
                const char* sa = lds + (kt & 1) * STAGE; const char* sb = sa + A_BYTES;
                bf16x8 xf[2][4], wf[2][4];
#pragma unroll
                for (int kk = 0; kk < 2; ++kk) {
#pragma unroll
                    for (int i = 0; i < 4; ++i) xf[kk][i] = ldsv8(sa + swz128(wm * 64 + i * 16 + fr, kk * 4 + fq));
#pragma unroll
                    for (int j = 0; j < 4; ++j) wf[kk][j] = ldsv8(sb + swz128(wn * 64 + j * 16 + fr, kk * 4 + fq));
                }
                __builtin_amdgcn_sched_barrier(0);
                __builtin_amdgcn_s_setprio(1);
#pragma unroll
                for (int kk = 0; kk < 2; ++kk)
#pragma unroll
                    for (int i = 0; i < 4; ++i)
#pragma unroll
                        for (int j = 0; j < 4; ++j) acc[i][j] = mfma16(wf[kk][j], xf[kk][i], acc[i][j]);
                __builtin_amdgcn_s_setprio(0);
            }
        }
        wait_vm0();
    }
    DI void run(const int K, f32x4 (&acc)[4][4]) const {
        const int tid = threadIdx.x, lane = tid & 63, wave = tid >> 6;
        const int wm = wave >> 1, wn = wave & 1, fr = lane & 15, fq = lane >> 4;
#pragma unroll
        for (int i = 0; i < 4; ++i)
#pragma unroll
            for (int j = 0; j < 4; ++j) acc[i][j] = (f32x4){0.f, 0.f, 0.f, 0.f};
        const int KT = K >> 6;
#pragma unroll 1
        for (int kt = 0; kt < KT; ++kt) {
            wait_vm0();
            __syncthreads();
            if (kt + 1 < KT) issue(kt + 1, (kt + 1) & 1);
            const char* sa = lds + (kt & 1) * STAGE; const char* sb = sa + A_BYTES;
            bf16x8 xf[2][4], wf[2][4];
#pragma unroll
            for (int kk = 0; kk < 2; ++kk) {
#pragma unroll
                for (int i = 0; i < 4; ++i) xf[kk][i] = ldsv8(sa + swz128(wm * 64 + i * 16 + fr, kk * 4 + fq));
#pragma unroll
                for (int j = 0; j < 4; ++j) wf[kk][j] = ldsv8(sb + swz128(wn * 64 + j * 16 + fr, kk * 4 + fq));
            }
            __builtin_amdgcn_sched_barrier(0);
            __builtin_amdgcn_s_setprio(1);
#pragma unroll
            for (int kk = 0; kk < 2; ++kk)
#pragma unroll
                for (int i = 0; i < 4; ++i)
#pragma unroll
                    for (int j = 0; j < 4; ++j) acc[i][j] = mfma16(wf[kk][j], xf[kk][i], acc[i][j]);
            __builtin_amdgcn_s_setprio(0);
        }
    }
};

constexpr int EPI_OFF = 32768;
DI int lane_m(int i) { const int t = threadIdx.x; return ((t >> 7) & 1) * 64 + i * 16 + (t & 15); }
DI int lane_n(int j) { const int t = threadIdx.x; return ((t >> 6) & 1) * 64 + j * 16 + ((t >> 4) & 3) * 4; }
DI int opaque_tid() { int t = threadIdx.x; asm volatile("" : "+v"(t)); return t; }
DI int lane_m(int t, int i) { return ((t >> 7) & 1) * 64 + i * 16 + (t & 15); }
DI int lane_n(int t, int j) { return ((t >> 6) & 1) * 64 + j * 16 + ((t >> 4) & 3) * 4; }
template <class XF>
DI void epi_stage_bf16(const f32x4 (&acc)[4][4], XF xf) {
    const int tz = opaque_tid();
#pragma unroll
    for (int i = 0; i < 4; ++i) {
        const int m = lane_m(tz, i);
#pragma unroll
        for (int j = 0; j < 4; ++j) {
            const int n = lane_n(tz, j);
            const f32x4 v = xf(i, j, acc[i][j]);
            u32x2 o; o[0] = pk2(v[0], v[1]); o[1] = pk2(v[2], v[3]);
            *(u32x2*)(lds + EPI_OFF + m * 256 + (((n >> 3) ^ (m & 15)) << 4) + (n & 4) * 2) = o;
        }
    }
}
template <class DP, class OK>
DI void epi_flush_bf16(DP dst, OK ok) {
    const int tz = opaque_tid();
#pragma unroll
    for (int it = 0; it < 8; ++it) {
        const int idx = tz + it * NTHR, row = idx >> 4, ch = idx & 15;
        const u32x4 v = *(const u32x4*)(lds + EPI_OFF + row * 256 + ((ch ^ (row & 15)) << 4));
        if (ok(row)) *(u32x4*)(dst(row) + ch * 8) = v;
    }
}
template <class OF>
DI void epi_flush_bf16_sc1(const __amdgpu_buffer_rsrc_t rs, OF off) {
    const int tz = opaque_tid();
#pragma unroll
    for (int it = 0; it < 8; ++it) {
        const int idx = tz + it * NTHR, row = idx >> 4, ch = idx & 15;
        const u32x4 v = *(const u32x4*)(lds + EPI_OFF + row * 256 + ((ch ^ (row & 15)) << 4));
        __builtin_amdgcn_raw_buffer_store_b128(v, rs, (unsigned)((off(row) + ch * 8) * 2), 0, 16);
    }
}
template <class XF>
DI void epi_stage_bf16_T(const f32x4 (&acc)[4][4], XF xf) {
    const int tz = opaque_tid();
    const bool odd = tz & 1;
#pragma unroll
    for (int i = 0; i < 4; ++i) {
        const int m = lane_m(tz, i) & ~1;
#pragma unroll
        for (int j = 0; j < 4; ++j) {
            const int n = lane_n(tz, j) + (odd ? 2 : 0);
            const f32x4 v = xf(i, j, acc[i][j]);
            const float r0 = __shfl_xor(odd ? v[0] : v[2], 1), r1 = __shfl_xor(odd ? v[1] : v[3], 1);
            const unsigned w0 = odd ? pk2(r0, v[2]) : pk2(v[0], r0), w1 = odd ? pk2(r1, v[3]) : pk2(v[1], r1);
            *(unsigned*)(lds + EPI_OFF + n * 256 + (((m >> 3) ^ (n & 15)) << 4) + (m & 6) * 2) = w0;
            *(unsigned*)(lds + EPI_OFF + (n + 1) * 256 + (((m >> 3) ^ ((n + 1) & 15)) << 4) + (m & 6) * 2) = w1;
        }
    }
}
DI void epi_resid_f32(const Args& a, const int li, const int m0, const int n0, const f32x4 (&acc)[4][4]) {
    const int tz = opaque_tid();
    bf16_t* X = (bf16_t*)(a.ws + WS_X);
    const __amdgpu_buffer_rsrc_t x_rsrc = __builtin_amdgcn_make_buffer_rsrc((void*)X, 0, NTOK * D * 2, 0x00020000);
    const float* gate = (const float*)(a.ws + WS_MOD) + ((size_t)li * 9 + tok_modrow(m0)) * 6144 + 2 * 1024 + n0;
    f32x4 g4[4];
#pragma unroll
    for (int j = 0; j < 4; ++j) g4[j] = *(const f32x4*)(gate + lane_n(tz, j));
    __syncthreads();
    epi_stage_bf16(acc, [&](int, int j, const f32x4 v) { return v * g4[j]; });
    __syncthreads();
#pragma unroll
    for (int it = 0; it < 8; ++it) {
        const int idx = tz + it * NTHR, row = idx >> 4, ch = idx & 15;
        const int t = m0 + row;
        f32x4 d0, d1, x0, x1;
        unpk8(*(const u32x4*)(lds + EPI_OFF + row * 256 + ((ch ^ (row & 15)) << 4)), d0, d1);
        bf16_t* xp = X + (size_t)t * D + n0 + ch * 8;
        if (li == 0) {
            const float* xs = (t < NLAT ? a.in[0] + (size_t)t * D : a.in[2] + (size_t)(t - NLAT) * D) + n0 + ch * 8;
            x0 = *(const f32x4*)xs; x1 = *(const f32x4*)(xs + 4);
        } else {
            unpk8(*(const u32x4*)xp, x0, x1);
        }
        __builtin_amdgcn_raw_buffer_store_b128(pk8(x0 + d0, x1 + d1), x_rsrc, (unsigned)(((size_t)t * D + n0 + ch * 8) * 2), 0, 16);
    }
    asm volatile("s_waitcnt vmcnt(0)" ::: "memory");
    __syncthreads();
    if (threadIdx.x == 0) xb_add((unsigned*)(a.ws + WS_CTL + CTL_DEP2) + li * 160 + (m0 >> 7), 1u);
}

template <bool XPF = true, class TE>
DI void gemm_dense_phase(const bf16_t* A, const int lda, const int mrows, const bf16_t* Bt, const int N, const int K, TE tile_epi) {
    const int mt = mrows / 128, nt = N / 128;
    const int mpx = mt >> 3, bmb = mpx >> 1, full = mpx * 8;
    auto decode = [&](int u, int& m0, int& n0) {
        const int xc = u & 7, s = u >> 3;
        const int bn = s / full, rem = s - bn * full;
        const int w = min(8, nt - 8 * bn);
        const int bm = rem / (bmb * w), rem2 = rem - bm * (bmb * w);
        const int ni = rem2 / bmb, mi = rem2 - ni * bmb;
        m0 = (xc * mpx + bm * bmb + mi) * 128; n0 = (bn * 8 + ni) * 128;
    };
    GemmPipe g;
    int u = blockIdx.x, m0 = 0, n0 = 0;
    __syncthreads();
    if (u < mt * nt) { decode(u, m0, n0); g.setup([&](int r) { return A + (size_t)(m0 + r) * lda; }, Bt + (size_t)n0 * K, K); g.issue(0, 0); }
    while (u < mt * nt) {
        f32x4 acc[4][4];
        g.run(K, acc);
        const int cm0 = m0, cn0 = n0;
        u += gridDim.x;
        if (XPF) {
            if (u < mt * nt) { decode(u, m0, n0); g.setup([&](int r) { return A + (size_t)(m0 + r) * lda; }, Bt + (size_t)n0 * K, K); g.issue(0, 0); }
            tile_epi(cm0, cn0, acc);
        } else {
            tile_epi(cm0, cn0, acc);
            __syncthreads();
            if (u < mt * nt) { decode(u, m0, n0); g.setup([&](int r) { return A + (size_t)(m0 + r) * lda; }, Bt + (size_t)n0 * K, K); g.issue(0, 0); }
        }
    }
    __syncthreads();
}
template <class XF, class DP>
DI void epi_bf16_rowmajor(const f32x4 (&acc)[4][4], XF xf, DP dst) {
    __syncthreads();
    epi_stage_bf16(acc, xf);
    __syncthreads();
    epi_flush_bf16(dst, [](int) { return true; });
}

DI void phase_rg_in(const Args& a, int j) {
    bf16_t* G = (bf16_t*)(a.ws + RG_G); bf16_t* U = (bf16_t*)(a.ws + RG_U);
    gemm_dense_phase((const bf16_t*)(a.ws + WS_H), D, NTOK, (const bf16_t*)(a.ws + W_RGIN) + (size_t)j * 2048 * 1024, 2048, 1024,
        [&](int m0, int n0, const f32x4 (&acc)[4][4]) {
            if (n0 < 1024)
                epi_bf16_rowmajor(acc, [](int, int, const f32x4 v) { f32x4 g; g[0] = gelu_tanh(v[0]); g[1] = gelu_tanh(v[1]); g[2] = gelu_tanh(v[2]); g[3] = gelu_tanh(v[3]); return g; },
                                  [&](int row) { return G + (size_t)(m0 + row) * D + n0; });
            else
                epi_bf16_rowmajor(acc, [](int, int, const f32x4 v) { return v; }, [&](int row) { return U + (size_t)(m0 + row) * D + (n0 - 1024); });
        });
}

template <int VAR = 0, int HOST = 0>
DI void phase_rg_scan(const Args& a, int j) {
    const int tid = threadIdx.x, lane = tid & 63, wave = tid >> 6;
    const int fr = lane & 15, fq = lane >> 4;
    const bf16_t* U = (const bf16_t*)(a.ws + RG_U);
    bf16_t* HS = (bf16_t*)(a.ws + (VAR ? WS_Y : RG_HS));
    char* sW = lds;
    char* sX = lds + 8192;
    float* sUc = (float*)(lds + 16384);
    float* sA = (float*)(lds + 24576);
    float* sB = (float*)(lds + 33280);
    bf16_t* sO = (bf16_t*)(lds + 41984);
    unsigned* sCv = (unsigned*)(lds + 50176);
    const int c = tid & 7;
    for (int u = blockIdx.x; u < 512; u += gridDim.x) {
        const int half = u & 1, dir = (u >> 1) & 1, blk = (u >> 2) & 15, b = u >> 6;
        const int cin0 = blk * 64, co0 = blk * 64 + half * 32;
        __syncthreads();
        {
            const bf16_t* Wg = (const bf16_t*)(a.ws + W_RGG) + ((size_t)((j * 2 + dir) * 16 + blk)) * 128 * 64;
#pragma unroll
            for (int i = 0; i < 2; ++i) {
                const int idx = tid + i * NTHR, row = idx >> 3, cc = idx & 7;
                const int srow = (row >> 5) * 64 + half * 32 + (row & 31);
                *(u32x4*)(sW + swz128(row, cc)) = *(const u32x4*)(Wg + (size_t)srow * 64 + cc * 8);
            }
        }
        float carry = 0.f;
        float cw[4][8], cb[8];
        {
            const float* cwp = a.in[9] + (size_t)j * 4 * 1024 + cin0 + c * 8; const float* cbp = a.in[10] + (size_t)j * 1024 + cin0 + c * 8;
#pragma unroll
            for (int w = 0; w < 4; ++w) { const f32x4 v0 = *(const f32x4*)(cwp + w * 1024), v1 = *(const f32x4*)(cwp + w * 1024 + 4);
#pragma unroll
                for (int e = 0; e < 4; ++e) { cw[w][e] = v0[e]; cw[w][4 + e] = v1[e]; } }
            const f32x4 v0 = *(const f32x4*)cbp, v1 = *(const f32x4*)(cbp + 4);
#pragma unroll
            for (int e = 0; e < 4; ++e) { cb[e] = v0[e]; cb[4 + e] = v1[e]; }
        }
        float bg0[8], bg1[8], spl[8];
        {
            const float* gb = a.in[12] + ((size_t)(j * 2 + dir) * 2) * 1024 + co0;
            const float* lm = a.in[13] + (size_t)(j * 2 + dir) * 1024 + co0;
#pragma unroll
            for (int jt = 0; jt < 2; ++jt)
#pragma unroll
                for (int e = 0; e < 4; ++e) {
                    const int cc = jt * 16 + fq * 4 + e;
                    bg0[jt * 4 + e] = gb[cc]; bg1[jt * 4 + e] = gb[1024 + cc];
                    spl[jt * 4 + e] = -8.f * log1pf(__expf(-lm[cc]));
                }
        }
        u32x4 pu[2][4];
        auto load_chunk = [&](int ci) {
            const int seg = ci >= 4, L = seg ? SEQ : CTXL, nch = L / 64, jc = seg ? ci - 4 : ci;
            const int oc = dir ? nch - 1 - jc : jc;
            const int rb = seg ? b * SEQ : NLAT + b * CTXL;
            const int s0 = oc * 64;
#pragma unroll
            for (int it = 0; it < 2; ++it) {
                const int tk = (tid >> 3) + it * 32;
#pragma unroll
                for (int w = 0; w < 4; ++w) {
                    const int s = s0 + tk + w - 2;
                    const int sc_ = min(max(s, 0), L - 1);
                    const u32x4 ld = *(const u32x4*)(U + (size_t)(rb + sc_) * D + cin0 + c * 8);
                    const unsigned msk = (s >= 0 && s < L) ? 0xffffffffu : 0u;
                    pu[it][w] = (u32x4){ld[0] & msk, ld[1] & msk, ld[2] & msk, ld[3] & msk};
                }
            }
        };
        load_chunk(0);
        __syncthreads();
        size_t prev_base = 0;
        constexpr int CV_TILES = HOST ? 6144 : 0;
        CvTile cvp; cvp.src = nullptr; cvp.dst = nullptr; cvp.K = 0; cvp.N = 0; cvp.perm = 0; cvp.k0 = 0; cvp.n0 = 0;
        bool cvp_ok = false;
#pragma unroll 1
        for (int ci = 0; ci < 36; ++ci) {
            f32x4 cv0[4], cv1[4];
            CvTile cvc = cvp;
            const int cvq = (ci / 3) * 512 + u;
            const bool cv_ok = HOST && (ci % 3 == 0) && cvq < CV_TILES;
            if (cv_ok) { cvc = moe_cv_tile(a, 1, cvq); cv_load(cvc, cv0, cv1); }
            const int seg = ci >= 4, L = seg ? SEQ : CTXL, nch = L / 64, jc = seg ? ci - 4 : ci;
            const int oc = dir ? nch - 1 - jc : jc;
            const int rb = seg ? b * SEQ : NLAT + b * CTXL;
            const int s0 = oc * 64;
            char* sXc = sX; float* sUcc = sUc;
#pragma unroll
            for (int it = 0; it < 2; ++it) {
                const int tk = (tid >> 3) + it * 32;
                float o[8];
#pragma unroll
                for (int e = 0; e < 8; ++e) o[e] = cb[e];
#pragma unroll
                for (int w = 0; w < 4; ++w) {
                    const u32x4 r4 = pu[it][w];
#pragma unroll
                    for (int e = 0; e < 4; ++e) { o[2 * e] += cw[w][2 * e] * lof(r4[e]); o[2 * e + 1] += cw[w][2 * e + 1] * hif(r4[e]); }
                }
                u32x4 pv; pv[0] = pk2(o[0], o[1]); pv[1] = pk2(o[2], o[3]); pv[2] = pk2(o[4], o[5]); pv[3] = pk2(o[6], o[7]);
                *(u32x4*)(sXc + swz128(tk, c)) = pv;
                if ((c >> 2) == half) {
                    *(f32x4*)(sUcc + tk * 32 + (c & 3) * 8) = (f32x4){o[0], o[1], o[2], o[3]};
                    *(f32x4*)(sUcc + tk * 32 + (c & 3) * 8 + 4) = (f32x4){o[4], o[5], o[6], o[7]};
                }
            }
            if (ci + 1 < 36) load_chunk(ci + 1);
            lds_barrier();
            if (HOST && cvp_ok) cv_flush(cvp, sCv);
            if (ci > 0) {
                const u32x4 v = *(const u32x4*)(sO + ((ci - 1) & 1) * 2048 + tid * 8);
                *(u32x4*)(HS + prev_base + (size_t)(tid >> 2) * D + (tid & 3) * 8) = v;
            }
            {
                f32x4 acc[4];
#pragma unroll
                for (int jt = 0; jt < 4; ++jt) acc[jt] = (f32x4){0.f, 0.f, 0.f, 0.f};
#pragma unroll
                for (int kk = 0; kk < 2; ++kk) {
                    const bf16x8 xf = ldsv8(sXc + swz128(wave * 16 + fr, kk * 4 + fq));
#pragma unroll
                    for (int jt = 0; jt < 4; ++jt) acc[jt] = mfma16(ldsv8(sW + swz128(jt * 16 + fr, kk * 4 + fq)), xf, acc[jt]);
                }
                const int tk = wave * 16 + fr;
#pragma unroll
                for (int jt = 0; jt < 2; ++jt) {
                    const f32x4 uc = *(const f32x4*)(sUcc + tk * 32 + jt * 16 + fq * 4);
                    f32x4 av4, bv4;
#pragma unroll
                    for (int e = 0; e < 4; ++e) {
                        if (VAR & 2) { av4[e] = 0.5f + 0.001f * acc[jt][e]; bv4[e] = uc[e] + acc[jt + 2][e]; continue; }
                        const float rg = sigmoidf_(acc[jt][e] + bg0[jt * 4 + e]);
                        const float ig = sigmoidf_(acc[jt + 2][e] + bg1[jt * 4 + e]);
                        const float av = fexp(rg * spl[jt * 4 + e]);
                        av4[e] = av;
                        bv4[e] = __builtin_amdgcn_sqrtf(fmaxf(1.f - av * av, 0.f)) * ig * uc[e];
                    }
#pragma unroll
                    for (int e = 0; e < 4; ++e) { sA[(jt * 16 + fq * 4 + e) * 68 + tk] = av4[e]; sB[(jt * 16 + fq * 4 + e) * 68 + tk] = bv4[e]; }
                }
            }
            lds_barrier();
            if (!(VAR & 4)) {
                const int ch = wave * 8 + (lane >> 3), sg = lane & 7;
                const int tb = dir ? 56 - sg * 8 : sg * 8;
                const f32x4 a0 = *(const f32x4*)(sA + ch * 68 + tb), a1 = *(const f32x4*)(sA + ch * 68 + tb + 4);
                const f32x4 b0 = *(const f32x4*)(sB + ch * 68 + tb), b1 = *(const f32x4*)(sB + ch * 68 + tb + 4);
                float av[8], bv[8];
#pragma unroll
                for (int e = 0; e < 4; ++e) {
                    av[e] = dir ? a1[3 - e] : a0[e]; av[4 + e] = dir ? a0[3 - e] : a1[e];
                    bv[e] = dir ? b1[3 - e] : b0[e]; bv[4 + e] = dir ? b0[3 - e] : b1[e];
                }
                float Ap = 1.f, Hh = 0.f;
#pragma unroll
                for (int e = 0; e < 8; ++e) { Hh = av[e] * Hh + bv[e]; Ap *= av[e]; }
                { const float Ao = dpp_shr<1>(1.f, Ap), Ho = dpp_shr<1>(0.f, Hh); if (sg >= 1) { Hh = Ap * Ho + Hh; Ap = Ap * Ao; } }
                { const float Ao = dpp_shr<2>(1.f, Ap), Ho = dpp_shr<2>(0.f, Hh); if (sg >= 2) { Hh = Ap * Ho + Hh; Ap = Ap * Ao; } }
                { const float Ao = dpp_shr<4>(1.f, Ap), Ho = dpp_shr<4>(0.f, Hh); if (sg >= 4) { Hh = Ap * Ho + Hh; Ap = Ap * Ao; } }
                float Aex = dpp_shr<1>(1.f, Ap), Hex = dpp_shr<1>(0.f, Hh);
                if (sg == 0) { Aex = 1.f; Hex = 0.f; }
                float hin = Aex * carry + Hex;
                const float cnew = Ap * carry + Hh;
                {
                    const float t = dpp_mov<0xFF, 0xF>(cnew, cnew);
                    const float u = dpp_mov<0x104, 0xF>(t, t);
                    carry = (lane & 4) ? t : u;
                }
                bf16_t* so = sO + (ci & 1) * 2048 + ch;
#pragma unroll
                for (int e = 0; e < 8; ++e) {
                    hin = av[e] * hin + bv[e];
                    const int i = sg * 8 + e, tk = dir ? 63 - i : i;
                    so[tk * 32] = f2bf(hin);
                }
            }
            prev_base = (size_t)dir * NTOK * D + (size_t)(rb + s0) * D + co0;
            if (HOST) { if (cv_ok) cv_pack(sCv, cv0, cv1); cvp = cvc; cvp_ok = cv_ok; }
        }
        __syncthreads();
        if (HOST && cvp_ok) cv_flush(cvp, sCv);
        {
            const u32x4 v = *(const u32x4*)(sO + (35 & 1) * 2048 + tid * 8);
            *(u32x4*)(HS + prev_base + (size_t)(tid >> 2) * D + (tid & 3) * 8) = v;
        }
    }
}

DI void phase_rg_combine(const Args& a) {
    const u32x4* G = (const u32x4*)(a.ws + RG_G);
    const u32x4* H0 = (const u32x4*)(a.ws + RG_HS);
    const u32x4* H1 = (const u32x4*)(a.ws + RG_HS + TOKD2);
    u32x4* A2 = (u32x4*)(a.ws + RG_A2);
    const size_t n = (size_t)NTOK * D / 8;
    for (size_t i = (size_t)blockIdx.x * NTHR + threadIdx.x; i < n; i += (size_t)gridDim.x * NTHR) {
        const u32x4 g = G[i], h0 = H0[i], h1 = H1[i];
        u32x4 o;
#pragma unroll
        for (int e = 0; e < 4; ++e) o[e] = pk2(lof(g[e]) * (lof(h0[e]) + lof(h1[e])), hif(g[e]) * (hif(h0[e]) + hif(h1[e])));
        A2[i] = o;
    }
}

DI void phase_rg_out(const Args& a, int li, int j) {
    gemm_dense_phase((const bf16_t*)(a.ws + RG_A2), D, li == 3 ? NLAT : NTOK, (const bf16_t*)(a.ws + W_RGOUT) + (size_t)j * 1024 * 1024, 1024, 1024,
        [&](int m0, int n0, const f32x4 (&acc)[4][4]) { epi_resid_f32(a, li, m0, n0, acc); });
}

DI void phase_mla_down(const Args& a) {
    bf16_t* CQ = (bf16_t*)(a.ws + MLA_CQ); bf16_t* CKV = (bf16_t*)(a.ws + MLA_CKV); float* KR = (float*)(a.ws + MLA_KR);
    const __amdgpu_buffer_rsrc_t cq_rs = __builtin_amdgcn_make_buffer_rsrc((void*)CQ, 0, NTOK * 256 * 2, 0x00020000);
    const __amdgpu_buffer_rsrc_t ckv_rs = __builtin_amdgcn_make_buffer_rsrc((void*)CKV, 0, NTOK * 128 * 2, 0x00020000);
    const __amdgpu_buffer_rsrc_t kr_rs = __builtin_amdgcn_make_buffer_rsrc((void*)KR, 0, NTOK * 32 * 4, 0x00020000);
    auto ident = [](int, int, const f32x4 v) { return v; };
    gemm_dense_phase((const bf16_t*)(a.ws + WS_H), D, NTOK, (const bf16_t*)(a.ws + W_MDOWN), 512, 1024,
        [&](int m0, int n0, const f32x4 (&acc)[4][4]) {
            if (n0 < 384) {
                __syncthreads();
                epi_stage_bf16(acc, ident);
                __syncthreads();
                if (n0 < 256) epi_flush_bf16_sc1(cq_rs, [&](int row) { return (m0 + row) * 256 + n0; });
                else epi_flush_bf16_sc1(ckv_rs, [&](int row) { return (m0 + row) * 128; });
            } else {
#pragma unroll
                for (int i = 0; i < 4; ++i)
#pragma unroll
                    for (int j = 0; j < 2; ++j) {
                        const int n = lane_n(j);
                        if (n < 32) __builtin_amdgcn_raw_buffer_store_b128(__builtin_bit_cast(u32x4, acc[i][j]), kr_rs, (unsigned)(((m0 + lane_m(i)) * 32 + n) * 4), 0, 16);
                    }
            }
            asm volatile("s_waitcnt vmcnt(0)" ::: "memory");
            __syncthreads();
            if (threadIdx.x == 0) xb_add((unsigned*)(a.ws + WS_CTL + CTL_DEP5) + (m0 >> 7), 1u);
        });
}

DI int perm_key(int kp) { return (kp & ~12) | ((kp & 4) << 1) | ((kp & 8) >> 1); }

DI void phase_mla_up(const Args& a) {
    const int tid = threadIdx.x;
    const bf16_t* CQ = (const bf16_t*)(a.ws + MLA_CQ); const bf16_t* CKV = (const bf16_t*)(a.ws + MLA_CKV); const float* KR = (const float*)(a.ws + MLA_KR);
    bf16_t* Q = (bf16_t*)(a.ws + MLA_Q); bf16_t* Kb = (bf16_t*)(a.ws + MLA_K); bf16_t* VT = (bf16_t*)(a.ws + MLA_VT);
    const float* qkn = a.in[20];
    const float* RC = (const float*)(a.ws + WS_CTL + CTL_ROPE); const float* RS = RC + 512;
    const int MT_ = NTOK / 128;
    const float QSCALE = 0.10206207261596575f * 1.4426950408889634f;
    const int xc_ = blockIdx.x & 7, rank_ = blockIdx.x >> 3, nrank_ = gridDim.x >> 3, mpx_ = MT_ >> 3;
    unsigned* dp5 = (unsigned*)(a.ws + WS_CTL + CTL_DEP5);
    unsigned* tmo5 = (unsigned*)(a.ws + WS_CTL) + XB_TMO;
    unsigned okm = 0u;
    int* flag5 = (int*)(lds + LDS_AUX);
    for (int ui = rank_; ui < mpx_ * 32; ui += nrank_) {
        const int mi_ = ui >> 5, hh_ = ui & 31;
        const bool isq = hh_ < 16;
        const int head = hh_ & 15;
        const int m0 = (xc_ * mpx_ + mi_) * 128;
        if (!((okm >> mi_) & 1u)) {
            __syncthreads();
            if (tid < 64) {
                unsigned sp = 0u;
                while (xb_ld(dp5 + (m0 >> 7)) < 4u) {
                    __builtin_amdgcn_s_sleep(2);
                    if ((++sp & 255u) == 0u) { if (xb_ld(tmo5)) break; if (sp > XB_SPIN_CAP) { atomicAdd(tmo5, 1u); break; } }
                }
                const unsigned long long m = __ballot(tid < mpx_ && xb_ld(dp5 + xc_ * mpx_ + tid) >= 4u);
                __builtin_amdgcn_fence(__ATOMIC_ACQUIRE, "agent");
                asm volatile("s_waitcnt vmcnt(0)" ::: "memory");
                if (tid == 0) flag5[0] = (int)(unsigned)m;
            }
            __syncthreads();
            okm = (unsigned)flag5[0];
        }
        const bool islat = m0 < NLAT;
        const int bb = islat ? (m0 >> 11) : ((m0 - NLAT) >> 8);
        const int kp0 = islat ? CTXL + (m0 & (SEQ - 1)) : ((m0 - NLAT) & (CTXL - 1));
        __syncthreads();
        if (isq) {
            f32x4 hold[2][6];
            float ssq[2] = {0.f, 0.f};
            gemm_tile<4, 1, 2, 6, false>([&](int r) { return CQ + (size_t)(m0 + r) * 256; }, (const bf16_t*)(a.ws + W_MUQ) + (size_t)head * 96 * 256, 256, 256, hold, ssq);
            const int tz = opaque_tid();
            const int wave = tz >> 6, fq = (tz >> 4) & 3, fr = tz & 15;
#pragma unroll
            for (int i = 0; i < 2; ++i) {
                const int m = wave * 32 + i * 16 + fr;
                float sq = ssq[i]; sq += __shfl_xor(sq, 16); sq += __shfl_xor(sq, 32);
                const float rs0 = rsqrtf(sq * (1.f / 256.f) + EPS);
                float ss = 0.f;
#pragma unroll
                for (int jn = 0; jn < 6; ++jn) { hold[i][jn] *= rs0;
#pragma unroll
                    for (int e = 0; e < 4; ++e) ss += hold[i][jn][e] * hold[i][jn][e]; }
                ss += __shfl_xor(ss, 16); ss += __shfl_xor(ss, 32);
                const float rs = rsqrtf(ss * (1.f / 96.f) + EPS) ;
                f32x4 o[6];
#pragma unroll
                for (int jn = 0; jn < 6; ++jn) { const f32x4 g4 = *(const f32x4*)(qkn + jn * 16 + fq * 4); o[jn] = hold[i][jn] * rs * g4; }
#pragma unroll
                for (int jn = 4; jn < 6; ++jn) {
                    f32x4 other;
#pragma unroll
                    for (int e = 0; e < 4; ++e) other[e] = __shfl_xor(o[jn][e], 32);
                    if (islat) {
                        const int s = (m0 + m) & (SEQ - 1);
                        const int pos = jn == 4 ? (s >> 6) : (s & 63);
                        const f32x4 cs = *(const f32x4*)(RC + pos * 8 + (fq & 1) * 4), sn = *(const f32x4*)(RS + pos * 8 + (fq & 1) * 4);
#pragma unroll
                        for (int e = 0; e < 4; ++e) o[jn][e] = (fq < 2) ? o[jn][e] * cs[e] - other[e] * sn[e] : o[jn][e] * cs[e] + other[e] * sn[e];
                    }
                }
#pragma unroll
                for (int jn = 0; jn < 6; ++jn) {
                    const f32x4 v = o[jn] * QSCALE;
                    u32x2 pv; pv[0] = pk2(v[0], v[1]); pv[1] = pk2(v[2], v[3]);
                    *(u32x2*)(lds + m * 256 + (((jn * 2 + (fq >> 1)) ^ (m & 15)) << 4) + (fq & 1) * 8) = pv;
                }
            }
            __syncthreads();
#pragma unroll
            for (int it = 0; it < 8; ++it) {
                const int idx = tz + it * NTHR, row = idx >> 4, ch = idx & 15;
                if (ch < 12) {
                    const u32x4 v = *(const u32x4*)(lds + row * 256 + ((ch ^ (row & 15)) << 4));
                    *(u32x4*)(Q + (size_t)(m0 + row) * 1536 + head * 96 + ch * 8) = v;
                }
            }
        } else {
            f32x4 hold[4][4];
            float ssq[4] = {0.f, 0.f, 0.f, 0.f};
            gemm_tile<2, 2, 4, 4, false>([&](int r) { return CKV + (size_t)(m0 + r) * 128; }, (const bf16_t*)(a.ws + W_MUKV) + (size_t)head * 128 * 128, 128, 128, hold, ssq);
            const int tz = opaque_tid();
            const int wave = tz >> 6, wm = wave >> 1, wn = wave & 1, fq = (tz >> 4) & 3, fr = tz & 15;
            char* sK = lds; char* sV = lds + 32768;
#pragma unroll
            for (int i = 0; i < 4; ++i) {
                const int m = wm * 64 + i * 16 + fr, t = m0 + m;
                float sq = ssq[i]; sq += __shfl_xor(sq, 16); sq += __shfl_xor(sq, 32);
                const float rs0 = rsqrtf(sq * (1.f / 128.f) + EPS);
#pragma unroll
                for (int jn = 0; jn < 4; ++jn) hold[i][jn] *= rs0;
                if (wn == 0) {
                    const int base = (fq >> 1) * 16 + (fq & 1) * 4;
                    const f32x4 z1 = *(const f32x4*)(KR + (size_t)t * 32 + base);
                    const f32x4 z2 = *(const f32x4*)(KR + (size_t)t * 32 + base + 8);
                    float ss = 0.f;
#pragma unroll
                    for (int jn = 0; jn < 4; ++jn)
#pragma unroll
                        for (int e = 0; e < 4; ++e) ss += hold[i][jn][e] * hold[i][jn][e];
#pragma unroll
                    for (int e = 0; e < 4; ++e) ss += z1[e] * z1[e] + z2[e] * z2[e];
                    ss += __shfl_xor(ss, 16); ss += __shfl_xor(ss, 32);
                    const float rs = rsqrtf(ss * (1.f / 96.f) + EPS);
#pragma unroll
                    for (int jn = 0; jn < 4; ++jn) {
                        const f32x4 g4 = *(const f32x4*)(qkn + 96 + jn * 16 + fq * 4);
                        const f32x4 v = hold[i][jn] * rs * g4;
                        u32x2 pv; pv[0] = pk2(v[0], v[1]); pv[1] = pk2(v[2], v[3]);
                        *(u32x2*)(sK + m * 256 + (((jn * 2 + (fq >> 1)) ^ (m & 15)) << 4) + (fq & 1) * 8) = pv;
                    }
                    const f32x4 g1 = *(const f32x4*)(qkn + 96 + 64 + base), g2 = *(const f32x4*)(qkn + 96 + 64 + base + 8);
                    f32x4 a1 = z1 * rs * g1, a2 = z2 * rs * g2;
                    if (islat) {
                        const int s = t & (SEQ - 1);
                        const int pos = (fq >> 1) == 0 ? (s >> 6) : (s & 63);
                        const f32x4 cs = *(const f32x4*)(RC + pos * 8 + (fq & 1) * 4), sn = *(const f32x4*)(RS + pos * 8 + (fq & 1) * 4);
                        const f32x4 b1 = a1 * cs - a2 * sn, b2 = a2 * cs + a1 * sn;
                        a1 = b1; a2 = b2;
                    }
                    u32x2 p1, p2; p1[0] = pk2(a1[0], a1[1]); p1[1] = pk2(a1[2], a1[3]); p2[0] = pk2(a2[0], a2[1]); p2[1] = pk2(a2[2], a2[3]);
                    const int c1 = 8 + (fq >> 1) * 2;
                    *(u32x2*)(sK + m * 256 + ((c1 ^ (m & 15)) << 4) + (fq & 1) * 8) = p1;
                    *(u32x2*)(sK + m * 256 + (((c1 + 1) ^ (m & 15)) << 4) + (fq & 1) * 8) = p2;
                }
                {
                    const bool odd = fr & 1;
                    const int mp = perm_key(m & ~1);
#pragma unroll
                    for (int jn = 0; jn < 4; ++jn) {
                        const f32x4 v = hold[i][jn];
                        const float r0 = __shfl_xor(odd ? v[0] : v[2], 1), r1 = __shfl_xor(odd ? v[1] : v[3], 1);
                        if (wn == 1) {
                            const int e0 = jn * 16 + fq * 4 + (odd ? 2 : 0);
                            const unsigned w0 = odd ? pk2(r0, v[2]) : pk2(v[0], r0), w1 = odd ? pk2(r1, v[3]) : pk2(v[1], r1);
                            *(unsigned*)(sV + e0 * 256 + (((mp >> 3) ^ (e0 & 15)) << 4) + (mp & 6) * 2) = w0;
                            *(unsigned*)(sV + (e0 + 1) * 256 + (((mp >> 3) ^ ((e0 + 1) & 15)) << 4) + (mp & 6) * 2) = w1;
                        }
                    }
                }
            }
            __syncthreads();
            bf16_t* kdst = Kb + ((size_t)(bb * 16 + head) * NKEY + kp0) * 96;
#pragma unroll
            for (int it = 0; it < 8; ++it) {
                const int idx = tz + it * NTHR, row = idx >> 4, ch = idx & 15;
                if (ch < 12) {
                    const u32x4 v = *(const u32x4*)(sK + row * 256 + ((ch ^ (row & 15)) << 4));
                    *(u32x4*)(kdst + (size_t)row * 96 + ch * 8) = v;
                }
            }
            bf16_t* vdst = VT + ((size_t)(bb * 16 + head) * 64) * NKEY + kp0;
#pragma unroll
            for (int it = 0; it < 4; ++it) {
                const int idx = tz + it * NTHR, row = idx >> 4, ch = idx & 15;
                const u32x4 v = *(const u32x4*)(sV + row * 256 + ((ch ^ (row & 15)) << 4));
                *(u32x4*)(vdst + (size_t)row * NKEY + ch * 8) = v;
            }
        }
    }
}

DI void phase_mla_attn(const Args& a) {
    const int tid = threadIdx.x, lane = tid & 63, wave = tid >> 6;
    const int r = lane & 31, h = lane >> 5;
    const bf16_t* Q = (const bf16_t*)(a.ws + MLA_Q); const bf16_t* Kb = (const bf16_t*)(a.ws + MLA_K); const bf16_t* VT = (const bf16_t*)(a.ws + MLA_VT);
    bf16_t* O = (bf16_t*)(a.ws + MLA_O);
    constexpr int KT_B = 64 * 192, VT_B = 64 * 128, ST_B = KT_B + VT_B;
    unsigned* sCv = (unsigned*)(lds + 49152);
    const int cv_per = 18432 / gridDim.x;
    int cvn = 0, itc = 0;
    bool cv_pack_p = false, cv_flush_p = false;
    CvTile cvB, cvC; cvB.src = nullptr; cvB.dst = nullptr; cvB.K = 0; cvB.N = 0; cvB.perm = 0; cvB.k0 = 0; cvB.n0 = 0; cvC = cvB;
    f32x4 cv0[4], cv1[4];
#pragma unroll
    for (int i = 0; i < 4; ++i) { cv0[i] = (f32x4){0.f, 0.f, 0.f, 0.f}; cv1[i] = cv0[i]; }
    auto cv_step = [&](bool may_load) {
        if (cv_flush_p) { cv_flush(cvC, sCv); cv_flush_p = false; }
        if (cv_pack_p) { cv_pack(sCv, cv0, cv1); cvC = cvB; cv_flush_p = true; cv_pack_p = false; }
        if (may_load && cvn < cv_per) {
            const int t = cvn * gridDim.x + blockIdx.x;
            cvB = moe_cv_tile(a, 1 + t / 6144, t % 6144); cv_load(cvB, cv0, cv1); cv_pack_p = true; ++cvn;
        }
    };
    for (int u = blockIdx.x; u < 2048 + 256; u += gridDim.x) {
        const bool isctx = u >= 2048;
        const int uu = isctx ? u - 2048 : u;
        const int xc_ = uu & 7, s_ = uu >> 3, bh_ = ((s_ >> 4) << 3) + xc_;
        const int qb = isctx ? (uu & 1) : (s_ & 15), head = isctx ? ((uu >> 1) & 15) : (bh_ & 15), b = isctx ? (uu >> 5) : (bh_ >> 4);
        const int ntile = isctx ? CTXL / 64 : NKEY / 64;
        const int t = (isctx ? NLAT + b * CTXL : b * SEQ) + qb * 128 + wave * 32 + r;
        const bf16_t* kbase = Kb + (size_t)(b * 16 + head) * NKEY * 96;
        const bf16_t* vbase = VT + (size_t)(b * 16 + head) * 64 * NKEY;
        bf16x8 qf[6];
#pragma unroll
        for (int kk = 0; kk < 6; ++kk) qf[kk] = *(const bf16x8*)(Q + (size_t)t * 1536 + head * 96 + kk * 16 + h * 8);
        f32x16 o[2];
#pragma unroll
        for (int e = 0; e < 16; ++e) { o[0][e] = 0.f; o[1][e] = 0.f; }
        float lsum = 0.f;
        __syncthreads();
        auto stage = [&](int kt, int buf) {
            char* sk = lds + buf * ST_B; char* sv = sk + KT_B;
            const int key0 = kt * 64;
#pragma unroll
            for (int i = 0; i < 3; ++i) {
                const int idx = tid + i * NTHR, row = idx / 12, slot = idx - row * 12;
                int c = slot - ((row >> 2) % 12); if (c < 0) c += 12;
                dma16(kbase + (size_t)(key0 + row) * 96 + c * 8, sk + idx * 16);
            }
#pragma unroll
            for (int i = 0; i < 2; ++i) {
                const int idx = tid + i * NTHR, row = idx >> 3, c = (idx & 7) ^ ((row >> 1) & 7);
                dma16(vbase + (size_t)row * NKEY + key0 + c * 8, sv + idx * 16);
            }
        };
        stage(0, 0);
#pragma unroll 1
        for (int kt = 0; kt < ntile; ++kt) {
            wait_vm0();
            __syncthreads();
            if (kt + 1 < ntile) stage(kt + 1, (kt + 1) & 1);
            cv_step((itc & 3) == 0); ++itc;
            const char* sk = lds + (kt & 1) * ST_B; const char* sv = sk + KT_B;
            f32x16 st[2];
#pragma unroll
            for (int e = 0; e < 16; ++e) { st[0][e] = -8.f; st[1][e] = -8.f; }
#pragma unroll
            for (int kk = 0; kk < 6; ++kk)
#pragma unroll
                for (int si = 0; si < 2; ++si) {
                    const int s = si * 32 + r;
                    int slot = kk * 2 + h + ((s >> 2) % 12); if (slot >= 12) slot -= 12;
                    st[si] = mfma32(ldsv8(sk + s * 192 + slot * 16), qf[kk], st[si]);
                }
            float ps = 0.f;
#pragma unroll
            for (int si = 0; si < 2; ++si)
#pragma unroll
                for (int e = 0; e < 16; ++e) { const float p = __builtin_amdgcn_exp2f(st[si][e]); st[si][e] = p; ps += p; }
            lsum += ps;
#pragma unroll
            for (int si = 0; si < 2; ++si)
#pragma unroll
                for (int ks = 0; ks < 2; ++ks) {
                    u32x4 pp;
                    pp[0] = pk2(st[si][8 * ks + 0], st[si][8 * ks + 1]); pp[1] = pk2(st[si][8 * ks + 2], st[si][8 * ks + 3]);
                    pp[2] = pk2(st[si][8 * ks + 4], st[si][8 * ks + 5]); pp[3] = pk2(st[si][8 * ks + 6], st[si][8 * ks + 7]);
                    const bf16x8 pf = __builtin_bit_cast(bf16x8, pp);
#pragma unroll
                    for (int et = 0; et < 2; ++et) {
                        const int e = et * 32 + r;
                        o[et] = mfma32(ldsv8(sv + e * 128 + (((si * 4 + ks * 2 + h) ^ ((e >> 1) & 7)) << 4)), pf, o[et]);
                    }
                }
        }
        lsum += __shfl_xor(lsum, 32);
        const float inv = 1.f / lsum;
#pragma unroll
        for (int et = 0; et < 2; ++et)
#pragma unroll
            for (int g = 0; g < 4; ++g) {
                f32x4 v; v[0] = o[et][4 * g] * inv; v[1] = o[et][4 * g + 1] * inv; v[2] = o[et][4 * g + 2] * inv; v[3] = o[et][4 * g + 3] * inv;
                st_bf4(O + (size_t)t * D + head * 64 + et * 32 + 8 * g + 4 * h, v);
            }
    }
    while (cvn < cv_per || cv_pack_p || cv_flush_p) { __syncthreads(); cv_step(!cv_pack_p && !cv_flush_p); }
}

DI void phase_mla_out(const Args& a, int li) {
    gemm_dense_phase((const bf16_t*)(a.ws + MLA_O), D, NTOK, (const bf16_t*)(a.ws + W_MO), 1024, 1024,
        [&](int m0, int n0, const f32x4 (&acc)[4][4]) { epi_resid_f32(a, li, m0, n0, acc); });
}

DI void phase_ml_in(const Args& a) {
    bf16_t* Qm = (bf16_t*)(a.ws + ML_Q); bf16_t* Km = (bf16_t*)(a.ws + ML_K); bf16_t* VT = (bf16_t*)(a.ws + ML_VT);
    bf16_t* OG = (bf16_t*)(a.ws + ML_OG); float* GT = (float*)(a.ws + ML_GT);
    const float* gb = a.in[23];
    auto ident = [](int, int, const f32x4 v) { return v; };
    gemm_dense_phase<false>((const bf16_t*)(a.ws + WS_H), D, NTOK, (const bf16_t*)(a.ws + W_MLIN), 3200, 1024,
        [&](int m0, int n0, const f32x4 (&acc)[4][4]) {
            if (n0 < 512) {
                epi_bf16_rowmajor(acc, [](int, int, const f32x4 v) { return v * 0.08838834764831845f; }, [&](int row) { return Qm + (size_t)(m0 + row) * 512 + n0; });
            } else if (n0 < 1024) {
                epi_bf16_rowmajor(acc, ident, [&](int row) { return Km + (size_t)(m0 + row) * 512 + (n0 - 512); });
            } else if (n0 < 2048) {
                __syncthreads();
                epi_stage_bf16_T(acc, ident);
                __syncthreads();
                epi_flush_bf16([&](int row) { return VT + (size_t)(n0 - 1024 + row) * NTOK + m0; }, [](int) { return true; });
            } else if (n0 < 3072) {
                epi_bf16_rowmajor(acc, [](int, int, const f32x4 v) { f32x4 s; s[0] = sigmoidf_(v[0]); s[1] = sigmoidf_(v[1]); s[2] = sigmoidf_(v[2]); s[3] = sigmoidf_(v[3]); return s; },
                                  [&](int row) { return OG + (size_t)(m0 + row) * D + (n0 - 2048); });
            } else {
#pragma unroll
                for (int i = 0; i < 4; ++i) {
                    const int n = lane_n(0);
                    if (n < 16) { f32x4 s = acc[i][0]; s[0] += gb[n]; s[1] += gb[n + 1]; s[2] += gb[n + 2]; s[3] += gb[n + 3]; *(f32x4*)(GT + (size_t)(m0 + lane_m(i)) * 16 + n) = s; }
                }
            }
        });
}

template <int VAR = 0>
DI void phase_ml_scan(const Args& a) {
    const int tid = threadIdx.x, lane = tid & 63, wave = tid >> 6;
    const int fr = lane & 15, fq = lane >> 4;
    const bf16_t* Qm = (const bf16_t*)(a.ws + ML_Q); const bf16_t* Km = (const bf16_t*)(a.ws + ML_K);
    const bf16_t* VT = (const bf16_t*)(a.ws + ML_VT);
    const float* GT = (const float*)(a.ws + ML_GT);
    bf16_t* HS = (bf16_t*)(a.ws + (VAR ? WS_Y : ML_HS));
    char* sQ = lds;
    char* sK = lds + 16384;
    char* sS = lds + 32768;
    char* sVT = lds + 40960;
    char* sCT = lds + 47104;
    float* sRow = (float*)(lds + 59392);
    float* sCol = sRow + 64;
    float* sInt = sCol + 64;
    float* sNrm = sInt + 64;
    float* sWv = sNrm + 64;
    float* sSc = sWv + 64;
    for (int u = blockIdx.x; u < 512; u += gridDim.x) {
        const int xc_ = u & 7, s_ = u >> 3, bh_ = ((s_ >> 4) << 3) + xc_;
        const int sl = s_ & 7, dir = (s_ >> 3) & 1, head = bh_ & 3, b = bh_ >> 2;
        auto chunk_t0 = [&](int ci) {
            const int seg = ci >= 4, L = seg ? SEQ : CTXL, nch = L / 64, jc = seg ? ci - 4 : ci;
            const int oc = dir ? nch - 1 - jc : jc;
            return (seg ? b * SEQ : NLAT + b * CTXL) + oc * 64;
        };
        u32x4 pq[4], pk[4], pvt;
        float g_bc = 0.f, g_av = 0.f, g_pm = 0.f;
        auto load_tiles = [&](int t0) {
            const int tid = opaque_tid();
#pragma unroll
            for (int i = 0; i < 4; ++i) {
                const int idx = tid + i * NTHR, row = idx >> 4, c = (idx & 15) ^ (row & 15), ck = (idx & 15) ^ trswz(row);
                pq[i] = *(const u32x4*)(Qm + (size_t)(t0 + row) * 512 + head * 128 + c * 8);
                pk[i] = *(const u32x4*)(Km + (size_t)(t0 + row) * 512 + head * 128 + ck * 8);
            }
            { const int row = tid >> 3, c = (tid & 7) ^ (row & 7); pvt = *(const u32x4*)(VT + (size_t)(head * 256 + sl * 32 + row) * NTOK + t0 + c * 8); }
        };
        auto load_gates = [&](int ci) {
            if (wave == 0) { const float* g = (const float*)(a.ws + WS_GS) + ((size_t)u * 36 + ci) * 192 + lane; g_bc = g[0]; g_av = g[64]; g_pm = g[128]; }
        };
        auto store_tiles = [&]() {
            const int tid = opaque_tid();
#pragma unroll
            for (int i = 0; i < 4; ++i) { *(u32x4*)(sQ + (tid + i * NTHR) * 16) = pq[i]; *(u32x4*)(sK + (tid + i * NTHR) * 16) = pk[i]; }
            *(u32x4*)(sVT + tid * 16) = pvt;
        };
        auto gate_scalars = [&]() {
            const int s = dir ? 63 - lane : lane;
            const float bc = g_bc, av = g_av, pm = g_pm;
            const float mst = sSc[1];
            const float mm = fmaxf(mst, pm);
            sRow[s] = -mm;
            sCol[s] = av;
            sInt[s] = fexp(mst - mm);
            sNrm[s] = fexp(-(bc + mm));
            const float mmL = lane63(mm), bL = lane63(bc);
            sWv[s] = fexp(av - mmL);
            if (lane == 0) { sSc[0] = fexp(mst - mmL); sSc[1] = bL + mmL; }
        };
#pragma unroll 1
        for (int ci = wave; ci < 36; ci += 4) {
            const int t0 = chunk_t0(ci);
            const int s = dir ? 63 - lane : lane;
            const float ig = GT[(size_t)(t0 + s) * 16 + dir * 8 + head];
            const float fg = GT[(size_t)(t0 + s) * 16 + dir * 8 + 4 + head];
            const float lf = fminf(fg, 0.f) - __logf(1.f + fexp(-fabsf(fg)));
            const float bc = wave_scan_add(lf);
            const float av = ig - bc;
            const float pm = wave_scan_max(av);
            float* g = (float*)(a.ws + WS_GS) + ((size_t)u * 36 + ci) * 192 + lane; g[0] = bc; g[64] = av; g[128] = pm;
        }
        __syncthreads();
        for (int i = tid; i < 12288 / 16; i += NTHR) *(u32x4*)(sCT + i * 16) = (u32x4){0u, 0u, 0u, 0u};
        for (int i = tid; i < 16 * 8; i += NTHR) {
            const int row = 32 + (i >> 3), c = i & 7;
            const unsigned v = row == 32 ? 0x3f803f80u : 0u;
            *(u32x4*)(sVT + swz128(row, c)) = (u32x4){v, v, v, v};
        }
        if (tid == 0) sSc[1] = -1e30f;
        f32x4 accC[2][3];
#pragma unroll
        for (int i = 0; i < 2; ++i)
#pragma unroll
            for (int jn = 0; jn < 3; ++jn) accC[i][jn] = (f32x4){0.f, 0.f, 0.f, 0.f};
        load_tiles(chunk_t0(0));
        __syncthreads();
        load_gates(0);
        store_tiles();
        if (wave == 0) gate_scalars();
        __syncthreads();
#pragma unroll 1
        for (int ci = 0; ci < 36; ++ci) {
            const int t0 = chunk_t0(ci);
            if (!(VAR & 8) && ci + 1 < 36) { load_tiles(chunk_t0(ci + 1)); load_gates(ci + 1); }
            f32x4 sacc[4];
#pragma unroll
            for (int jt = 0; jt < 4; ++jt) sacc[jt] = (f32x4){0.f, 0.f, 0.f, 0.f};
#pragma unroll
            for (int kk = 0; kk < 4; ++kk) {
                const bf16x8 qf = ldsv8(sQ + swz256(wave * 16 + fr, kk * 4 + fq));
#pragma unroll
                for (int jt = 0; jt < 4; ++jt) { const int sr = jt * 16 + fr; sacc[jt] = mfma16(ldsv8(sK + sr * 256 + (((kk * 4 + fq) ^ trswz(sr)) << 4)), qf, sacc[jt]); }
            }
            {
                const int tq = wave * 16 + fr;
                const float rt = sRow[tq];
#pragma unroll
                for (int jt = 0; jt < 4; ++jt) {
                    const f32x4 cl = *(const f32x4*)(sCol + jt * 16 + fq * 4);
                    f32x4 v;
#pragma unroll
                    for (int e = 0; e < 4; ++e) {
                        const int s = jt * 16 + fq * 4 + e;
                        const bool ok = dir ? (s >= tq) : (s <= tq);
                        v[e] = ok ? sacc[jt][e] * fexp(rt + cl[e]) : 0.f;
                    }
                    u32x2 pv; pv[0] = pk2(v[0], v[1]); pv[1] = pk2(v[2], v[3]);
                    *(u32x2*)(sS + swz128(tq, jt * 2 + (fq >> 1)) + (fq & 1) * 8) = pv;
                }
            }
            lds_barrier();
            if (!(VAR & 2)) {
                f32x4 n1[3], n2[3];
#pragma unroll
                for (int jt = 0; jt < 3; ++jt) { n1[jt] = (f32x4){0.f, 0.f, 0.f, 0.f}; n2[jt] = (f32x4){0.f, 0.f, 0.f, 0.f}; }
#pragma unroll
                for (int kk = 0; kk < 2; ++kk) {
                    const bf16x8 sf = ldsv8(sS + swz128(wave * 16 + fr, kk * 4 + fq));
#pragma unroll
                    for (int jt = 0; jt < 3; ++jt) n1[jt] = mfma16(ldsv8(sVT + swz128(jt * 16 + fr, kk * 4 + fq)), sf, n1[jt]);
                }
#pragma unroll
                for (int kk = 0; kk < 4; ++kk) {
                    const bf16x8 qf = ldsv8(sQ + swz256(wave * 16 + fr, kk * 4 + fq));
#pragma unroll
                    for (int jt = 0; jt < 3; ++jt) n2[jt] = mfma16(ldsv8(sCT + swz256(jt * 16 + fr, kk * 4 + fq)), qf, n2[jt]);
                }
                const int tq = wave * 16 + fr;
                const float it = sInt[tq];
                float den = n1[2][0] + it * n2[2][0];
                den = __shfl(den, fr);
                const float dn = fmaxf(fabsf(den), sNrm[tq]);
                const float inv = rcpf_(dn);
                bf16_t* hp = HS + (size_t)dir * NTOK * D + (size_t)(t0 + tq) * D + head * 256 + sl * 32 + fq * 4;
#pragma unroll
                for (int jt = 0; jt < 2; ++jt) {
                    f32x4 v;
#pragma unroll
                    for (int e = 0; e < 4; ++e) v[e] = (n1[jt][e] + it * n2[jt][e]) * inv;
                    st_bf4(hp + jt * 16, v);
                }
            }
            if (!(VAR & 4)) {
                const float decay = sSc[0];
#pragma unroll
                for (int i = 0; i < 2; ++i)
#pragma unroll
                    for (int jn = 0; jn < 3; ++jn) accC[i][jn] *= decay;
#pragma unroll
                for (int kk = 0; kk < 2; ++kk) {
                    bf16x8 vf[3];
#pragma unroll
                    for (int jn = 0; jn < 3; ++jn) vf[jn] = ldsv8(sVT + swz128(jn * 16 + fr, kk * 4 + fq));
                    const f32x4 w0 = *(const f32x4*)(sWv + kk * 32 + fq * 8), w1 = *(const f32x4*)(sWv + kk * 32 + fq * 8 + 4);
#pragma unroll
                    for (int i = 0; i < 2; ++i) {
                        const int tq_ = (lane >> 2) & 3, tp_ = lane & 3, chd = (wave * 2 + i) * 2 + (tp_ >> 1);
                        const int sA_ = kk * 32 + 8 * fq + tq_, sB_ = sA_ + 4;
                        const s16x4 klo = lds_tr(sK + sA_ * 256 + ((chd ^ trswz(sA_)) << 4) + (tp_ & 1) * 8);
                        const s16x4 khi = lds_tr(sK + sB_ * 256 + ((chd ^ trswz(sB_)) << 4) + (tp_ & 1) * 8);
                        const u32x4 kr = __builtin_bit_cast(u32x4, __builtin_shufflevector(klo, khi, 0, 1, 2, 3, 4, 5, 6, 7));
                        u32x4 ks;
                        ks[0] = pk2(lof(kr[0]) * w0[0], hif(kr[0]) * w0[1]); ks[1] = pk2(lof(kr[1]) * w0[2], hif(kr[1]) * w0[3]);
                        ks[2] = pk2(lof(kr[2]) * w1[0], hif(kr[2]) * w1[1]); ks[3] = pk2(lof(kr[3]) * w1[2], hif(kr[3]) * w1[3]);
                        const bf16x8 kf = __builtin_bit_cast(bf16x8, ks);
#pragma unroll
                        for (int jn = 0; jn < 3; ++jn) accC[i][jn] = mfma16(kf, vf[jn], accC[i][jn]);
                    }
                }
            }
            lds_barrier();
#pragma unroll
            for (int i = 0; i < 2; ++i)
#pragma unroll
                for (int jn = 0; jn < 3; ++jn) {
                    const int dd = (wave * 2 + i) * 16 + fq * 4, ee = jn * 16 + fr;
                    u32x2 pv; pv[0] = pk2(accC[i][jn][0], accC[i][jn][1]); pv[1] = pk2(accC[i][jn][2], accC[i][jn][3]);
                    *(u32x2*)(sCT + swz256(ee, dd >> 3) + (dd & 7) * 2) = pv;
                }
            if (ci + 1 < 36) {
                if (!(VAR & 8)) store_tiles();
                if (wave == 0 && !(VAR & 16)) gate_scalars();
            }
            lds_barrier();
        }
    }
}

DI void phase_ml_readout(const Args& a) {
    const int tid = threadIdx.x, lane = tid & 63, wave = tid >> 6;
    const bf16_t* H0 = (const bf16_t*)(a.ws + ML_HS); const bf16_t* H1 = H0 + (size_t)NTOK * D;
    const bf16_t* OG = (const bf16_t*)(a.ws + ML_OG); bf16_t* A2 = (bf16_t*)(a.ws + ML_A2);
    const float* on = a.in[24];
    for (int t = blockIdx.x * 4 + wave; t < NTOK; t += gridDim.x * 4) {
        const size_t off = (size_t)t * D + lane * 16;
        const u32x4 a0 = *(const u32x4*)(H0 + off), a1 = *(const u32x4*)(H0 + off + 8);
        const u32x4 b0 = *(const u32x4*)(H1 + off), b1 = *(const u32x4*)(H1 + off + 8);
        float v[16];
#pragma unroll
        for (int e = 0; e < 4; ++e) {
            v[2 * e] = lof(a0[e]) + lof(b0[e]); v[2 * e + 1] = hif(a0[e]) + hif(b0[e]);
            v[8 + 2 * e] = lof(a1[e]) + lof(b1[e]); v[8 + 2 * e + 1] = hif(a1[e]) + hif(b1[e]);
        }
        float ss = 0.f;
#pragma unroll
        for (int e = 0; e < 16; ++e) ss += v[e] * v[e];
        ss += __shfl_xor(ss, 1); ss += __shfl_xor(ss, 2); ss += __shfl_xor(ss, 4); ss += __shfl_xor(ss, 8);
        const float rs = rsqrtf(ss * (1.f / 256.f) + EPS);
        const u32x4 g0 = *(const u32x4*)(OG + off), g1 = *(const u32x4*)(OG + off + 8);
        const float* onp = on + lane * 16;
        u32x4 o0, o1;
#pragma unroll
        for (int e = 0; e < 4; ++e) {
            o0[e] = pk2(v[2 * e] * rs * onp[2 * e] * lof(g0[e]), v[2 * e + 1] * rs * onp[2 * e + 1] * hif(g0[e]));
            o1[e] = pk2(v[8 + 2 * e] * rs * onp[8 + 2 * e] * lof(g1[e]), v[8 + 2 * e + 1] * rs * onp[8 + 2 * e + 1] * hif(g1[e]));
        }
        *(u32x4*)(A2 + off) = o0; *(u32x4*)(A2 + off + 8) = o1;
    }
}

DI void phase_ml_out(const Args& a, int li) {
    gemm_dense_phase((const bf16_t*)(a.ws + ML_A2), D, NTOK, (const bf16_t*)(a.ws + W_MLOUT), 1024, 1024,
        [&](int m0, int n0, const f32x4 (&acc)[4][4]) { epi_resid_f32(a, li, m0, n0, acc); });
}

template <int STAGE>
DI void phase_moe(const Args& a, int li) {
    const int tid = threadIdx.x, lane = tid & 63, wave = tid >> 6;
    const int fr = lane & 15, fq = lane >> 4, wm = wave >> 1, wn = wave & 1;
    const int* cnt = (const int*)(a.ws + WS_CTL + CTL_CNT) + li * 64;
    const int* list = (const int*)(a.ws + WS_LIST);
    const float* wsl = (const float*)(a.ws + WS_WSLOT);
    const bf16_t* F = (const bf16_t*)(a.ws + WS_H);
    bf16_t* HM = (bf16_t*)(a.ws + WS_HMID); bf16_t* Y = (bf16_t*)(a.ws + WS_Y);
    int* pre = (int*)(lds + LDS_AUX);
    int* srowb = pre + 16;
    const int xc = blockIdx.x & 7, rank = blockIdx.x >> 3, nrank = gridDim.x >> 3;
    __syncthreads();
    if (tid == 0) { int s = 0; for (int i = 0; i < 8; ++i) { pre[i] = s; s += (cnt[xc + 8 * i] + 127) >> 7; } pre[8] = s; }
    __syncthreads();
    const int T = pre[8];
    constexpr int NTN = STAGE == 0 ? 4 : 8;
    constexpr int KK = STAGE == 0 ? 1024 : 256;
    const int total = T * NTN;
    int e = 0, r0 = 0, ce = 0, nt = 0, cur = 0;
    auto decode = [&](int u) {
        const int ti = u / NTN; nt = u % NTN;
        int ei = 0;
#pragma unroll 1
        for (int s = 4; s > 0; s >>= 1) if (pre[ei + s] <= ti) ei += s;
        e = xc + 8 * ei; r0 = (ti - pre[ei]) * 128; ce = cnt[e];
    };
    GemmPipe g;
    auto prep = [&](int buf) {
        int* srow = srowb + buf * 128;
        if (tid < 128) srow[tid] = list[(size_t)e * NTOK + min(r0 + tid, ce - 1)];
        __syncthreads();
        if (STAGE == 0) g.setup([&](int r) { return F + (size_t)(srow[r] >> 1) * D; }, (const bf16_t*)(a.ws + W_GU) + ((size_t)(li * 64 + e) * 512 + nt * 128) * 1024, 1024);
        else g.setup([&](int r) { return HM + (size_t)srow[r] * 256; }, (const bf16_t*)(a.ws + W_DN) + ((size_t)(li * 64 + e) * 1024 + nt * 128) * 256, 256);
        g.issue(0, 0);
    };
    int u = rank;
    if (u < total) { decode(u); prep(cur); }
    while (u < total) {
        f32x4 acc[4][4];
        g.run(KK, acc);
        const int cr0 = r0, cce = ce, cnt_ = nt;
        const int* srow = srowb + cur * 128;
        u += nrank;
        if (u < total) { decode(u); prep(cur ^ 1); }
        if (STAGE == 0) {
            __syncthreads();
            {
                const int tz = opaque_tid();
#pragma unroll
                for (int i = 0; i < 4; ++i) {
                    const int m = lane_m(tz, i);
#pragma unroll
                    for (int p = 0; p < 2; ++p) {
                        const int c = (((tz >> 6) & 1) * 2 + p) * 16 + ((tz >> 4) & 3) * 4;
                        f32x4 v;
#pragma unroll
                        for (int x = 0; x < 4; ++x) { const float gg = acc[i][2 * p][x]; v[x] = gg * rcpf_(1.f + fexp(-gg)) * acc[i][2 * p + 1][x]; }
                        u32x2 o; o[0] = pk2(v[0], v[1]); o[1] = pk2(v[2], v[3]);
                        *(u32x2*)(lds + EPI_OFF + m * 128 + (((c >> 3) ^ (m & 7)) << 4) + (c & 4) * 2) = o;
                    }
                }
            }
            __syncthreads();
            {
                const int tz = opaque_tid();
#pragma unroll
                for (int it = 0; it < 4; ++it) {
                    const int idx = tz + it * NTHR, row = idx >> 3, ch = idx & 7;
                    const u32x4 v = *(const u32x4*)(lds + EPI_OFF + row * 128 + ((ch ^ (row & 7)) << 4));
                    if (cr0 + row < cce) *(u32x4*)(HM + (size_t)srow[row] * 256 + cnt_ * 64 + ch * 8) = v;
                }
            }
        } else {
            float wrow[4];
            {
                const int tz = opaque_tid();
#pragma unroll
                for (int i = 0; i < 4; ++i) wrow[i] = wsl[srow[lane_m(tz, i)]];
            }
            __syncthreads();
            epi_stage_bf16(acc, [&](int i, int, const f32x4 v) { return v * wrow[i]; });
            __syncthreads();
            epi_flush_bf16([&](int row) { return Y + (size_t)srow[row] * D + cnt_ * 128; }, [&](int row) { return cr0 + row < cce; });
        }
        cur ^= 1;
    }
    __syncthreads();
}

DI void phase_moe_all(const Args& a, int li) {
    const int tid = threadIdx.x;
    const int* cnt = (const int*)(a.ws + WS_CTL + CTL_CNT) + li * 64;
    const int* list = (const int*)(a.ws + WS_LIST);
    const float* wsl = (const float*)(a.ws + WS_WSLOT);
    const bf16_t* F = (const bf16_t*)(a.ws + WS_H);
    bf16_t* HM = (bf16_t*)(a.ws + WS_HMID); bf16_t* Y = (bf16_t*)(a.ws + WS_Y);
    int* pre = (int*)(lds + LDS_AUX);
    int* cnl = pre + 16;
    int* srowb = pre + 32;
    const int xc = blockIdx.x & 7, rank = blockIdx.x >> 3, nrank = gridDim.x >> 3;
    unsigned* dep = (unsigned*)(a.ws + WS_CTL + CTL_DEP) + (size_t)(li * 8 + xc) * 320;
    unsigned* tmo = (unsigned*)(a.ws + WS_CTL) + XB_TMO;
    const __amdgpu_buffer_rsrc_t hm_rsrc = __builtin_amdgcn_make_buffer_rsrc((void*)HM, 0, 2 * NTOK * 256 * 2, 0x00020000);
    __syncthreads();
    if (tid == 0) { int s = 0; for (int i = 0; i < 8; ++i) { const int c = cnt[xc + 8 * i]; cnl[i] = c; pre[i] = s; s += (c + 127) >> 7; } pre[8] = s; }
    __syncthreads();
    const int T = pre[8];
    const int n0u = 4 * T, total = 12 * T;
    struct Unit { int st, ti, e, r0, ce, nt; };
    auto decode = [&](int u) {
        Unit q;
        q.st = u >= n0u;
        const int v = q.st ? u - n0u : u;
        q.ti = q.st ? (v >> 3) : (v >> 2); q.nt = q.st ? (v & 7) : (v & 3);
        int ei = 0;
#pragma unroll 1
        for (int s = 4; s > 0; s >>= 1) if (pre[ei + s] <= q.ti) ei += s;
        q.e = xc + 8 * ei; q.r0 = (q.ti - pre[ei]) * 128; q.ce = cnl[ei];
        return q;
    };
    GemmPipe g;
    auto prep = [&](const Unit& q, int buf) {
        int* srow = srowb + buf * 128;
        if (tid < 128) srow[tid] = list[(size_t)q.e * NTOK + min(q.r0 + tid, q.ce - 1)];
        __syncthreads();
        if (q.st == 0) g.setup([&](int r) { return F + (size_t)(srow[r] >> 1) * D; }, (const bf16_t*)(a.ws + W_GU) + ((size_t)(li * 64 + q.e) * 512 + q.nt * 128) * 1024, 1024);
        else g.setup([&](int r) { return HM + (size_t)srow[r] * 256; }, (const bf16_t*)(a.ws + W_DN) + ((size_t)(li * 64 + q.e) * 1024 + q.nt * 128) * 256, 256);
        g.issue(0, 0);
    };
    bool synced = false;
    unsigned okm0 = 0u, okm1 = 0u;
    auto tile_ok = [&](int ti) { return synced || (ti < 32 ? (okm0 >> ti) & 1u : (ti < 64 ? (okm1 >> (ti - 32)) & 1u : 0u)) != 0u; };
    auto dep_wait = [&](int ti) {
        if (tid < 64) {
            unsigned sp = 0u;
            while (xb_ld(dep + ti) < 4u) {
                __builtin_amdgcn_s_sleep(2);
                if ((++sp & 255u) == 0u) { if (xb_ld(tmo)) break; if (sp > XB_SPIN_CAP) { atomicAdd(tmo, 1u); break; } }
            }
            const int all = xb_ld(dep + 319) >= (unsigned)n0u;
            const unsigned long long m = __ballot(tid < T && xb_ld(dep + tid) >= 4u);
            __builtin_amdgcn_fence(__ATOMIC_ACQUIRE, "agent");
            asm volatile("s_waitcnt vmcnt(0)" ::: "memory");
            if (tid == 0) { srowb[256] = all; srowb[257] = (int)(unsigned)m; srowb[258] = (int)(unsigned)(m >> 32); }
        }
        __syncthreads();
        synced = srowb[256] != 0; okm0 = (unsigned)srowb[257]; okm1 = (unsigned)srowb[258];
    };
    int u = rank, cur = 0;
    Unit cu = decode(0), nu = cu;
    if (u < total) { cu = decode(u); if (cu.st) dep_wait(cu.ti); prep(cu, cur); }
    while (u < total) {
        f32x4 acc[4][4];
        g.run(cu.st ? 256 : 1024, acc);
        const int cr0 = cu.r0, cce = cu.ce, cnt_ = cu.nt;
        const int* srow = srowb + cur * 128;
        const int un = u + nrank;
        const bool hn = un < total;
        if (hn) nu = decode(un);
        const bool defer = hn && nu.st && !tile_ok(nu.ti);
        if (hn && !defer) prep(nu, cur ^ 1);
        if (cu.st == 0) {
            __syncthreads();
            {
                const int tz = opaque_tid();
#pragma unroll
                for (int i = 0; i < 4; ++i) {
                    const int m = lane_m(tz, i);
#pragma unroll
                    for (int p = 0; p < 2; ++p) {
                        const int c = (((tz >> 6) & 1) * 2 + p) * 16 + ((tz >> 4) & 3) * 4;
                        f32x4 v;
#pragma unroll
                        for (int x = 0; x < 4; ++x) { const float gg = acc[i][2 * p][x]; v[x] = gg * rcpf_(1.f + fexp(-gg)) * acc[i][2 * p + 1][x]; }
                        u32x2 o; o[0] = pk2(v[0], v[1]); o[1] = pk2(v[2], v[3]);
                        *(u32x2*)(lds + EPI_OFF + m * 128 + (((c >> 3) ^ (m & 7)) << 4) + (c & 4) * 2) = o;
                    }
                }
            }
            __syncthreads();
            {
                const int tz = opaque_tid();
#pragma unroll
                for (int it = 0; it < 4; ++it) {
                    const int idx = tz + it * NTHR, row = idx >> 3, ch = idx & 7;
                    const u32x4 v = *(const u32x4*)(lds + EPI_OFF + row * 128 + ((ch ^ (row & 7)) << 4));
                    if (cr0 + row < cce) __builtin_amdgcn_raw_buffer_store_b128(v, hm_rsrc, (srow[row] * 256 + cnt_ * 64 + ch * 8) * 2, 0, 16);
                }
            }
            asm volatile("s_waitcnt vmcnt(0)" ::: "memory");
            __syncthreads();
            if (tid == 0) { xb_add(dep + cu.ti, 1u); xb_add(dep + 319, 1u); }
        } else {
            float wrow[4];
            {
                const int tz = opaque_tid();
#pragma unroll
                for (int i = 0; i < 4; ++i) wrow[i] = wsl[srow[lane_m(tz, i)]];
            }
            __syncthreads();
            epi_stage_bf16(acc, [&](int i, int, const f32x4 v) { return v * wrow[i]; });
            __syncthreads();
            epi_flush_bf16([&](int row) { return Y + (size_t)srow[row] * D + cnt_ * 128; }, [&](int row) { return cr0 + row < cce; });
        }
        if (defer) { dep_wait(nu.ti); prep(nu, cur ^ 1); }
        cu = nu; u = un; cur ^= 1;
    }
    __syncthreads();
}

#ifndef DBG_GPROBE
#define DBG_GPROBE -1
#endif
template <int PM>
DI void phase_gemm_probe(const Args& a) {
    const bf16_t* A = (const bf16_t*)(a.ws + WS_H); const bf16_t* Bt = (const bf16_t*)(a.ws + W_RGIN);
    float* dummy = (float*)(a.ws + RG_A2);
    const int mt = 144, nt = 16, K = 1024;
    GemmPipe g;
    __syncthreads();
    for (int u = blockIdx.x; u < mt * nt; u += gridDim.x) {
        const int m0 = (u % mt) * 128, n0 = (u / mt) * 128;
        g.setup([&](int r) { return A + (size_t)(m0 + r) * 1024; }, Bt + (size_t)n0 * K, K);
        if (PM & 1) g.issue(0, 0);
        f32x4 acc[4][4];
        g.run_probe<PM>(K, acc);
        float s = 0.f;
#pragma unroll
        for (int i = 0; i < 4; ++i)
#pragma unroll
            for (int j = 0; j < 4; ++j) s += acc[i][j][0] + acc[i][j][1] + acc[i][j][2] + acc[i][j][3];
        if (s == 12345.678f) dummy[threadIdx.x] = s;
        if (PM & 8) {
            bf16_t* Yd = (bf16_t*)(a.ws + WS_Y);
            const int lane = threadIdx.x & 63, wave = threadIdx.x >> 6;
            const int mb = m0 + (wave >> 1) * 64 + (lane & 15), nb = n0 + (wave & 1) * 64 + (lane >> 4) * 4;
#pragma unroll
            for (int i = 0; i < 4; ++i)
#pragma unroll
                for (int j = 0; j < 4; ++j) {
                    f32x4 v = acc[i][j];
                    if (PM & 16) { v[0] = gelu_tanh(v[0]); v[1] = gelu_tanh(v[1]); v[2] = gelu_tanh(v[2]); v[3] = gelu_tanh(v[3]); }
                    st_bf4(Yd + (size_t)(mb + i * 16) * 2048 + nb + j * 16, v);
                }
        }
        __syncthreads();
    }
}

#ifndef DBG_STOP
#define DBG_STOP 99
#endif
#ifndef DBG_OFF
#define DBG_OFF 0
#endif
DI void phase_dbg(const Args& a) {
    const size_t n = (size_t)NLAT * D;
    const bf16_t* X = (const bf16_t*)(a.ws + WS_X);
    const bf16_t* B = (const bf16_t*)(a.ws + (size_t)DBG_OFF);
    for (size_t i = (size_t)blockIdx.x * NTHR + threadIdx.x; i < n; i += (size_t)gridDim.x * NTHR)
        a.out[i] = DBG_OFF ? bf2f(B[i]) : bf2f(X[i]);
}

constexpr int NPH = 34;
__global__ void __launch_bounds__(NTHR, 2) fwd(const Args a) {
    if (threadIdx.x == 0) *(uint4*)(lds + LDS_BARW) = make_uint4(0u, 0u, 0u, 0u);
    __syncthreads();
    XcdBarrier bar;
    const bool multi = (a.ph_hi - a.ph_lo) > 1;
    if (multi) bar = xcd_barrier_post((unsigned*)(a.ws + WS_CTL), (volatile LAS unsigned*)(lds + LDS_BARW));
#ifndef DBG_REP
#define DBG_REP -1
#endif
#ifndef DBG_REPN
#define DBG_REPN 3
#endif
#define RUN(id, ...) do { if (a.ph_lo <= (id) && (id) < a.ph_hi) { \
        if ((id) == DBG_REP) { for (int rep_ = 1; rep_ < DBG_REPN; ++rep_) { __VA_ARGS__; xcd_barrier(bar); } } \
        __VA_ARGS__; if ((id) + 1 < a.ph_hi) xcd_barrier(bar); } } while (0)
    RUN(0, phase_prologue(a); phase_token_row<0>(a, 0));
    RUN(2, phase_rg_in(a, 0));
    if (DBG_GPROBE >= 0) { RUN(2, phase_gemm_probe<(DBG_GPROBE < 0 ? 7 : DBG_GPROBE)>(a)); }
#ifdef DBG_SCANVAR
    RUN(3, phase_rg_scan<DBG_SCANVAR>(a, 0));
#endif
    RUN(3, phase_rg_scan(a, 0));
    RUN(4, phase_rg_combine(a));
    RUN(5, phase_rg_out(a, 0, 0); phase_token_router<36>(a, 0));
#ifdef DBG_T2DRY
    RUN(6, phase_token_router<36>(a, 0, true));
    RUN(6, phase_token_router<36>(a, 0, true));
#endif
    RUN(7, phase_moe_all(a, 0));
    RUN(9, phase_token_row<0>(a, 1));
    RUN(10, phase_mla_down(a); phase_mla_up(a));
    RUN(12, phase_mla_attn(a));
    RUN(13, phase_mla_out(a, 1); phase_token_router<36>(a, 1));
    RUN(15, phase_moe_all(a, 1));
    RUN(17, phase_token_row<0>(a, 2));
    RUN(18, phase_ml_in(a));
#ifdef DBG_MLVAR
    RUN(19, phase_ml_scan<DBG_MLVAR>(a));
#endif
    RUN(19, phase_ml_scan(a));
    RUN(20, phase_ml_readout(a));
    RUN(21, phase_ml_out(a, 2); phase_token_router<36>(a, 2));
    RUN(23, phase_moe_all(a, 2));
    RUN(25, phase_token_row<0>(a, 3));
    RUN(26, phase_rg_in(a, 1));
    RUN(27, phase_rg_scan(a, 1));
    RUN(28, phase_rg_combine(a));
    RUN(29, phase_rg_out(a, 3, 1); phase_token_router<32>(a, 3));
    RUN(31, phase_moe_all(a, 3));
    RUN(33, phase_token_row<2>(a, 3));
    RUN(34, phase_dbg(a));
#undef RUN
}

static void add_td(Args& a, int& n, int& tile0, const float* src, bf16_t* dst, const float* rscale, long sb, long db, int K, int N, int Npad, int batch, int perm) {
    TDesc& t = a.td[n++];
    t.src = src; t.dst = dst; t.rscale = rscale; t.sb = sb; t.db = db; t.K = K; t.N = N; t.Npad = Npad; t.batch = batch; t.perm = perm;
    t.tiles_k = (K + 127) / 128; t.tiles_n = (Npad + 63) / 64; t.tile0 = tile0;
    tile0 += batch * t.tiles_k * t.tiles_n;
}

extern "C" void kernel_launch(void* const* d_in, const int* in_sizes, int n_in, void* d_out, int out_size, void* d_ws, size_t ws_size, hipStream_t stream) {
    static int grid = 0;
    if (grid == 0) {
        if (n_in != 32 || out_size != NLAT * D || ws_size < WS_END) { fprintf(stderr, "kernel_launch: unexpected sizes (n_in %d out %d ws %zu need %zu)\n", n_in, out_size, ws_size, (size_t)WS_END); grid = -1; return; }
        int dev = 0, cus = 0, per_cu = 0;
        (void)hipGetDevice(&dev);
        (void)hipDeviceGetAttribute(&cus, hipDeviceAttributeMultiprocessorCount, dev);
        if (hipOccupancyMaxActiveBlocksPerMultiprocessor(&per_cu, (const void*)fwd, NTHR, 0) != hipSuccess) per_cu = 0;
        (void)hipGetLastError();
        if (per_cu < 2) fprintf(stderr, "kernel_launch: note: occupancy query reports %d blocks per CU (need 2)\n", per_cu);
        grid = cus * (per_cu >= 2 ? 2 : (per_cu >= 1 ? 1 : 2));
    }
    if (grid < 0) return;
    (void)in_sizes;
    (void)hipMemsetAsync((char*)d_ws + WS_CTL, 0, CTL_BYTES, stream);
    Args a;
    memset(&a, 0, sizeof(a));
    for (int i = 0; i < 32; ++i) a.in[i] = (const float*)d_in[i];
    a.out = (float*)d_out; a.ws = (unsigned char*)d_ws;
    unsigned char* ws = (unsigned char*)d_ws;
    int n = 0, tile0 = 0;
    add_td(a, n, tile0, a.in[8], (bf16_t*)(ws + W_RGIN), nullptr, 1024L * 2048, 2048L * 1024, 1024, 2048, 2048, 2, 0);
    add_td(a, n, tile0, a.in[14], (bf16_t*)(ws + W_RGOUT), nullptr, 1024L * 1024, 1024L * 1024, 1024, 1024, 1024, 2, 0);
    for (int j = 0; j < 2; ++j) for (int dir = 0; dir < 2; ++dir) for (int g = 0; g < 2; ++g)
        add_td(a, n, tile0, a.in[11] + (size_t)((j * 2 + dir) * 2 + g) * 16 * 4096, (bf16_t*)(ws + W_RGG) + (size_t)(j * 2 + dir) * 16 * 8192 + g * 4096, nullptr, 4096, 8192, 64, 64, 64, 16, 0);
    add_td(a, n, tile0, a.in[15], (bf16_t*)(ws + W_MDOWN), nullptr, 0, 0, 1024, 416, 512, 1, 0);
    add_td(a, n, tile0, a.in[18], (bf16_t*)(ws + W_MUQ), a.in[16], 0, 0, 256, 1536, 1536, 1, 0);
    add_td(a, n, tile0, a.in[19], (bf16_t*)(ws + W_MUKV), a.in[17], 0, 0, 128, 2048, 2048, 1, 0);
    add_td(a, n, tile0, a.in[21], (bf16_t*)(ws + W_MO), nullptr, 0, 0, 1024, 1024, 1024, 1, 0);
    add_td(a, n, tile0, a.in[22], (bf16_t*)(ws + W_MLIN), nullptr, 0, 0, 1024, 3088, 3200, 1, 0);
    add_td(a, n, tile0, a.in[25], (bf16_t*)(ws + W_MLOUT), nullptr, 0, 0, 1024, 1024, 1024, 1, 0);
    add_td(a, n, tile0, a.in[30], (bf16_t*)(ws + W_GU), nullptr, 1024L * 512, 512L * 1024, 1024, 512, 512, 64, 1);
    add_td(a, n, tile0, a.in[31], (bf16_t*)(ws + W_DN), nullptr, 256L * 1024, 1024L * 256, 256, 1024, 1024, 64, 0);
    a.ntiles_total = tile0;
    if (n != NTD) { fprintf(stderr, "kernel_launch: descriptor count %d != %d\n", n, NTD); return; }
#if MK_ONE_LAUNCH
    a.ph_lo = 0; a.ph_hi = NPH;
    hipLaunchKernelGGL(fwd, dim3(grid), dim3(NTHR), 0, stream, a);
#else
    for (int ph = 0; ph < NPH && ph <= DBG_STOP; ++ph) {
        a.ph_lo = ph; a.ph_hi = ph + 1;
        hipLaunchKernelGGL(fwd, dim3(grid), dim3(NTHR), 0, stream, a);
    }
    if (DBG_STOP < NPH) { a.ph_lo = 34; a.ph_hi = 35; hipLaunchKernelGGL(fwd, dim3(grid), dim3(NTHR), 0, stream, a); }
#endif
}
```
